# Optimizing an MI355X kernel written in HIP

```python
import math
import jax, jax.numpy as jnp
from jax import lax
import numpy as np

D_MODEL = 1024
BATCH = 2
SEQ = 8192
DEPTH = 1

CHUNK = 64
N_META = 16
QBLOCK = 128
ROPE_THETA = 10000.0
EPS = 1e-6

DA_DIM = 64
DA_VDIM = 2 * DA_DIM
DA_WIDTH = D_MODEL // 2
DA_HEADS = DA_WIDTH // DA_VDIM
GDN_DK = 64
GDN_DV = 64
GDN_WIDTH = D_MODEL - DA_WIDTH
GDN_HEADS = GDN_WIDTH // GDN_DV
CONV_K = 4
MIX_WIDTH = DA_WIDTH + GDN_WIDTH

COL_QA = 2 * DA_HEADS * DA_DIM
COL_KA = 2 * DA_HEADS * DA_DIM
COL_VA = DA_WIDTH
COL_QKVB = 2 * GDN_HEADS * GDN_DK + GDN_WIDTH
COL_ZB = GDN_WIDTH
COL_AB = GDN_HEADS
COL_BB = GDN_HEADS
PROJ = COL_QA + COL_KA + COL_VA + COL_QKVB + COL_ZB + COL_AB + COL_BB
SPLITS = list(np.cumsum([COL_QA, COL_KA, COL_VA, COL_QKVB, COL_ZB, COL_AB])[:].tolist())

N_GROUPS = 4
EXPERTS_PER_GROUP = 8
N_EXPERTS = N_GROUPS * EXPERTS_PER_GROUP
TOP_K = 2
D_EXPERT = D_MODEL // 4

kernel_name = "hymba_diffattn_gdn_hmoe_block"


def rmsnorm(x, gain):
    xf = x.astype(jnp.float32)
    y = xf * lax.rsqrt(jnp.mean(xf * xf, axis=-1, keepdims=True) + EPS)
    return (y * gain.astype(jnp.float32)).astype(x.dtype)


def l2norm(x):
    xf = x.astype(jnp.float32)
    return xf * lax.rsqrt(jnp.sum(xf * xf, axis=-1, keepdims=True) + EPS)


def chunk_ids(n):
    p = jnp.arange(n, dtype=jnp.int32)
    return jnp.where(p < N_META, 0, 1 + (p - N_META) // CHUNK)


def rope(x, cos, sin):
    x1, x2 = jnp.split(x.astype(jnp.float32), 2, axis=-1)
    c, s = cos[None, :, None, :], sin[None, :, None, :]
    return jnp.concatenate([x1 * c - x2 * s, x2 * c + x1 * s], axis=-1).astype(x.dtype)


def masked_softmax(s, visible):
    return jax.nn.softmax(jnp.where(visible, s, -jnp.inf), axis=-1)


def diff_attention(q, k, v, lam):
    B, L = q.shape[0], q.shape[1]
    n_blocks = -(-L // QBLOCK)
    Lp = n_blocks * QBLOCK

    def pad(t):
        return jnp.pad(t, ((0, 0), (0, Lp - L)) + ((0, 0),) * (t.ndim - 2))

    q, k, v = pad(q), pad(k), pad(v)
    scale = DA_DIM ** -0.5
    q1 = (q[:, :, :, 0] * scale).transpose(0, 2, 1, 3)
    q2 = (q[:, :, :, 1] * scale).transpose(0, 2, 1, 3)
    k1 = k[:, :, :, 0].transpose(0, 2, 1, 3)
    k2 = k[:, :, :, 1].transpose(0, 2, 1, 3)
    vh = v.transpose(0, 2, 1, 3)
    cid = chunk_ids(Lp)

    def block(i):
        start = i * QBLOCK
        q1b = lax.dynamic_slice_in_dim(q1, start, QBLOCK, axis=2)
        q2b = lax.dynamic_slice_in_dim(q2, start, QBLOCK, axis=2)
        qc = lax.dynamic_slice_in_dim(cid, start, QBLOCK)
        visible = cid[None, :] <= qc[:, None]
        p1 = masked_softmax(jnp.einsum('bhqd,bhkd->bhqk', q1b, k1).astype(jnp.float32), visible)
        p2 = masked_softmax(jnp.einsum('bhqd,bhkd->bhqk', q2b, k2).astype(jnp.float32), visible)
        p = p1 - lam * p2
        return jnp.einsum('bhqk,bhkd->bhqd', p.astype(vh.dtype), vh)

    out = lax.map(block, jnp.arange(n_blocks))
    return out.transpose(1, 0, 3, 2, 4).reshape(B, Lp, DA_HEADS, DA_VDIM)[:, :L]


def causal_conv(x, w):
    C = x.shape[-1]
    return lax.conv_general_dilated(
        x, w[:, None, :].astype(x.dtype), window_strides=(1,), padding=[(CONV_K - 1, 0)],
        dimension_numbers=('NWC', 'WIO', 'NWC'), feature_group_count=C)


def gated_delta_rule(q, k, v, g, beta):
    B, L, H, DK = q.shape
    DV = v.shape[-1]
    n = -(-L // CHUNK)
    Lp = n * CHUNK
    f32 = jnp.float32

    def chunks(t):
        t = jnp.pad(t.astype(f32), ((0, 0), (0, Lp - L)) + ((0, 0),) * (t.ndim - 2))
        return jnp.moveaxis(t.reshape((B, n, CHUNK) + t.shape[2:]), 1, 0)

    q = chunks(q).transpose(0, 1, 3, 2, 4)
    k = chunks(k).transpose(0, 1, 3, 2, 4)
    v = chunks(v).transpose(0, 1, 3, 2, 4)
    g = chunks(g).transpose(0, 1, 3, 2)
    beta = chunks(beta).transpose(0, 1, 3, 2)

    causal = jnp.tril(jnp.ones((CHUNK, CHUNK), dtype=bool))
    strict = jnp.tril(jnp.ones((CHUNK, CHUNK), dtype=bool), -1)
    gc = jnp.cumsum(g, axis=-1)
    diff = gc[..., :, None] - gc[..., None, :]
    decay = jnp.where(causal, jnp.exp(jnp.where(causal, diff, 0.0)), 0.0)
    k_beta = k * beta[..., None]
    a_kk = jnp.where(strict, jnp.einsum('nbhcd,nbhsd->nbhcs', k_beta, k) * decay, 0.0)
    m = a_kk + jnp.eye(CHUNK, dtype=f32)
    rhs = jnp.concatenate([v * beta[..., None], k_beta * jnp.exp(gc)[..., None]], axis=-1)
    sol = lax.linalg.triangular_solve(m, rhs, left_side=True, lower=True, unit_diagonal=True)
    u, w = sol[..., :DV], sol[..., DV:]
    a_qk = jnp.where(causal, jnp.einsum('nbhcd,nbhsd->nbhcs', q, k) * decay, 0.0)
    q_g = q * jnp.exp(gc)[..., None]
    g_last = gc[..., -1]
    k_g = k * jnp.exp(g_last[..., None] - gc)[..., None]

    def step(S, xs):
        u_c, w_c, q_c, aqk_c, k_c, gl = xs
        v_new = u_c - jnp.einsum('bhck,bhkv->bhcv', w_c, S)
        o = jnp.einsum('bhck,bhkv->bhcv', q_c, S) + jnp.einsum('bhcs,bhsv->bhcv', aqk_c, v_new)
        S = S * jnp.exp(gl)[..., None, None] + jnp.einsum('bhck,bhcv->bhkv', k_c, v_new)
        return S, o

    S0 = jnp.zeros((B, H, DK, DV), f32)
    _, o = lax.scan(step, S0, (u, w, q_g, a_qk, k_g, g_last))
    return o.transpose(1, 0, 3, 2, 4).reshape(B, Lp, H, DV)[:, :L]


def hier_moe(u, w_group, b_group, w_router, b_router, w_gate, w_up, w_down):
    B, L, D = u.shape
    t = u.reshape(B * L, D)
    glog = (t @ w_group).astype(jnp.float32) + b_group.astype(jnp.float32)
    gprob = jax.nn.softmax(glog, axis=-1)
    gsel = jnp.argmax(glog, axis=-1)
    psel = jnp.take_along_axis(gprob, gsel[:, None], axis=-1)
    elog = ((t @ w_router).astype(jnp.float32) + b_router.astype(jnp.float32)).reshape(-1, N_GROUPS, EXPERTS_PER_GROUP)
    elog_g = jnp.take_along_axis(elog, gsel[:, None, None], axis=1)[:, 0]
    topv, topi = lax.top_k(jax.nn.softmax(elog_g, axis=-1), TOP_K)
    wts = topv / jnp.sum(topv, axis=-1, keepdims=True) * psel
    eidx = gsel[:, None] * EXPERTS_PER_GROUP + topi
    combine = jnp.einsum('tk,tke->te', wts, jax.nn.one_hot(eidx, N_EXPERTS, dtype=jnp.float32)).astype(t.dtype)
    y = jnp.zeros_like(t)
    for gi in range(N_GROUPS):
        sl = slice(gi * EXPERTS_PER_GROUP, (gi + 1) * EXPERTS_PER_GROUP)
        hg = jnp.einsum('td,edf->tef', t, w_gate[sl])
        hu = jnp.einsum('td,edf->tef', t, w_up[sl])
        act = jax.nn.silu(hg) * hu * combine[:, sl, None]
        y = y + jnp.einsum('tef,efd->td', act, w_down[sl])
    return y.reshape(B, L, D)


def setup_inputs(seed: int = 0) -> dict:
    key = jax.random.key(seed)
    ks = jax.random.split(key, 24)
    f32 = jnp.float32
    nrm = lambda k, shape, s: jax.random.normal(k, shape, f32) * s
    dt = jnp.exp(jax.random.uniform(ks[10], (DEPTH, GDN_HEADS), f32) * (math.log(0.1) - math.log(0.001)) + math.log(0.001))
    return {
        "x": nrm(ks[0], (BATCH, SEQ, D_MODEL), 1.0),
        "meta": nrm(ks[1], (N_META, D_MODEL), 1.0),
        "norm_mix": 1.0 + nrm(ks[2], (DEPTH, D_MODEL), 0.02),
        "w_in": nrm(ks[3], (DEPTH, D_MODEL, PROJ), D_MODEL ** -0.5),
        "lambda_q1": nrm(ks[4], (DEPTH, DA_DIM), 0.1),
        "lambda_k1": nrm(ks[5], (DEPTH, DA_DIM), 0.1),
        "lambda_q2": nrm(ks[6], (DEPTH, DA_DIM), 0.1),
        "lambda_k2": nrm(ks[7], (DEPTH, DA_DIM), 0.1),
        "diff_norm": 1.0 + nrm(ks[8], (DEPTH, DA_VDIM), 0.02),
        "conv_w": nrm(ks[9], (DEPTH, CONV_K, COL_QKVB), CONV_K ** -0.5),
        "a_log": jnp.log(jax.random.uniform(ks[11], (DEPTH, GDN_HEADS), f32, 1.0, 16.0)),
        "dt_bias": dt + jnp.log(-jnp.expm1(-dt)),
        "gdn_norm": 1.0 + nrm(ks[12], (DEPTH, GDN_DV), 0.02),
        "w_out": nrm(ks[13], (DEPTH, MIX_WIDTH, D_MODEL), MIX_WIDTH ** -0.5),
        "norm_ffn": 1.0 + nrm(ks[14], (DEPTH, D_MODEL), 0.02),
        "w_group": nrm(ks[15], (DEPTH, D_MODEL, N_GROUPS), D_MODEL ** -0.5),
        "b_group": nrm(ks[16], (DEPTH, N_GROUPS), 0.01),
        "w_router": nrm(ks[17], (DEPTH, D_MODEL, N_EXPERTS), D_MODEL ** -0.5),
        "b_router": nrm(ks[18], (DEPTH, N_EXPERTS), 0.01),
        "w_gate": nrm(ks[19], (DEPTH, N_EXPERTS, D_MODEL, D_EXPERT), D_MODEL ** -0.5),
        "w_up": nrm(ks[20], (DEPTH, N_EXPERTS, D_MODEL, D_EXPERT), D_MODEL ** -0.5),
        "w_down": nrm(ks[21], (DEPTH, N_EXPERTS, D_EXPERT, D_MODEL), D_EXPERT ** -0.5),
        "norm_final": 1.0 + nrm(ks[22], (D_MODEL,), 0.02),
    }


def reference(x, meta, norm_mix, w_in, lambda_q1, lambda_k1, lambda_q2, lambda_k2, diff_norm, conv_w,
              a_log, dt_bias, gdn_norm, w_out, norm_ffn, w_group, b_group, w_router, b_router,
              w_gate, w_up, w_down, norm_final):
    B, S, D = x.shape
    L = S + N_META
    h = jnp.concatenate([jnp.broadcast_to(meta[None].astype(x.dtype), (B, N_META, D)), x], axis=1)
    pos = jnp.arange(L, dtype=jnp.float32)
    inv_freq = ROPE_THETA ** (-jnp.arange(0, DA_DIM, 2, dtype=jnp.float32) / DA_DIM)
    ang = pos[:, None] * inv_freq[None, :]
    cos, sin = jnp.cos(ang), jnp.sin(ang)

    for l in range(DEPTH):
        lam_init = 0.8 - 0.6 * math.exp(-0.3 * l)
        u = rmsnorm(h, norm_mix[l])
        proj = u @ w_in[l]
        qa, ka, va, qkvb, zb, ab, bb = jnp.split(proj, SPLITS, axis=-1)

        qa = rope(qa.reshape(B, L, 2 * DA_HEADS, DA_DIM), cos, sin).reshape(B, L, DA_HEADS, 2, DA_DIM)
        ka = rope(ka.reshape(B, L, 2 * DA_HEADS, DA_DIM), cos, sin).reshape(B, L, DA_HEADS, 2, DA_DIM)
        lam = (jnp.exp(jnp.sum(lambda_q1[l].astype(jnp.float32) * lambda_k1[l].astype(jnp.float32)))
               - jnp.exp(jnp.sum(lambda_q2[l].astype(jnp.float32) * lambda_k2[l].astype(jnp.float32))) + lam_init)
        oa = diff_attention(qa, ka, va.reshape(B, L, DA_HEADS, DA_VDIM), lam)
        oa = rmsnorm(oa, diff_norm[l]) * (1.0 - lam_init)

        qkvb = jax.nn.silu(causal_conv(qkvb, conv_w[l]))
        qb, kb, vb = jnp.split(qkvb, [GDN_HEADS * GDN_DK, 2 * GDN_HEADS * GDN_DK], axis=-1)
        qb = l2norm(qb.reshape(B, L, GDN_HEADS, GDN_DK)) * (GDN_DK ** -0.5)
        kb = l2norm(kb.reshape(B, L, GDN_HEADS, GDN_DK))
        vb = vb.reshape(B, L, GDN_HEADS, GDN_DV)
        beta = jax.nn.sigmoid(bb.astype(jnp.float32))
        g = -jnp.exp(a_log[l].astype(jnp.float32)) * jax.nn.softplus(ab.astype(jnp.float32) + dt_bias[l].astype(jnp.float32))
        ob = gated_delta_rule(qb, kb, vb, g, beta).astype(h.dtype)
        ob = rmsnorm(ob, gdn_norm[l]) * jax.nn.silu(zb.reshape(B, L, GDN_HEADS, GDN_DV))

        mix = jnp.concatenate([oa.reshape(B, L, DA_WIDTH), ob.reshape(B, L, GDN_WIDTH)], axis=-1)
        h = h + mix @ w_out[l]

        h = h + hier_moe(rmsnorm(h, norm_ffn[l]), w_group[l], b_group[l], w_router[l], b_router[l],
                         w_gate[l], w_up[l], w_down[l])

    h = rmsnorm(h, norm_final)
    return h[:, N_META:]
```

```cpp
#include <hip/hip_runtime.h>
#include <hip/hip_cooperative_groups.h>
#include <cstdio>
#include <cstdint>
namespace cg = cooperative_groups;
namespace pg8 {
#define PG8_LAS __attribute__((address_space(3)))
typedef unsigned short bf16_t;
typedef short bf16x8 __attribute__((ext_vector_type(8)));
typedef float f32x4 __attribute__((ext_vector_type(4)));
typedef unsigned u32x4 __attribute__((ext_vector_type(4)));
constexpr int BM = 256, BK = 64, HALF = 128, HTB = HALF * BK * 2  , STAGE_BYTES = 8 * HTB, NXCD = 8, WGM = 8;

__host__ __device__ __forceinline__ int lds_byte(int r, int c) { const int st = (r >> 4) * 2 + (c >> 5), rr = r & 15, cc = c & 31, ob = rr * 64 + cc * 2; return st * 1024 + (ob ^ (((ob >> 9) & 1) << 5)); }
__host__ __device__ __forceinline__ void stage_rc(int b, int& R, int& C) { const int st = b / 1024, sb = b % 1024, swz = sb ^ (((sb >> 9) & 1) << 5); R = (st >> 1) * 16 + swz / 64; C = (st & 1) * 32 + (swz % 64) / 2; }
__host__ __device__ __forceinline__ int perm32(int rho) { const int n = rho >> 4, i = rho & 15; return 8 * (i >> 2) + 4 * n + (i & 3); }

struct Unit { int pm, pn; };
struct Gemm { const bf16_t* A; const bf16_t* Bt; int M, N, K; };

struct StaticOrder {
    int nM, nN, nwg, G, c;
    __host__ __device__ void init(int M, int N, int G_, int c_) { nM = M / BM; nN = N / BM; nwg = nM * nN; G = G_; c = c_; }
    __host__ __device__ bool next(int i, Unit& u) const {
        const long L = (long)i * G + c; if (L >= nwg) return false;
        int wgid = (int)L; { const int q = nwg / NXCD, r = nwg % NXCD, xcd = wgid % NXCD, off = wgid / NXCD; wgid = (xcd < r ? xcd * (q + 1) : r * (q + 1) + (xcd - r) * q) + off; }
        const int nig = WGM * nN, gid = wgid / nig, fm = gid * WGM, gsz = (nM - fm) < WGM ? (nM - fm) : WGM;
        u.pm = fm + ((wgid % nig) % gsz); u.pn = (wgid % nig) / gsz; return true;
    }
    __device__ __forceinline__ void a_ready(const Unit&) const {}
    __device__ __forceinline__ void done(const Unit&) const {}
};

__device__ __forceinline__ unsigned cvt_pk_bf16(float lo, float hi) { unsigned r; asm volatile("v_cvt_pk_bf16_f32 %0, %1, %2" : "=v"(r) : "v"(lo), "v"(hi)); return r; }
typedef float f32x2 __attribute__((ext_vector_type(2)));
template <class Epi, class Sched, bool ALIGN_EPI = false, bool SP2 = false>
__device__ __forceinline__ void gemm_phase(PG8_LAS unsigned char* lds, const Gemm g, const Sched& S, const Epi& E) {
    int tid_o = threadIdx.x; asm volatile("" : "+v"(tid_o));
    const int tid = tid_o, wid = __builtin_amdgcn_readfirstlane(tid >> 6), lane = tid & 63, wr = wid >> 2, wc = wid & 3, fr = lane & 15, fq = lane >> 4;
    const int K = g.K, nt = K / BK;
    unsigned voffA[2], voffB[2];
#pragma unroll
    for (int i = 0; i < 2; ++i) { int R, C; stage_rc(tid * 16 + i * 8192, R, C); const int Rb = Epi::PERM ? ((R & ~31) + perm32(R & 31)) : R;
        voffA[i] = (unsigned)(R * K + C) * 2u; voffB[i] = (unsigned)(Rb * K + C) * 2u; }
    const size_t kstep = (size_t)(BK * 2);
    const size_t hstep = (size_t)HALF * K * 2;
    const size_t tstep = 2 * hstep;
    const unsigned ldsw = (unsigned)wid * 1024u;
    const int aoff = lds_byte(wr * 64 + fr, fq * 8), boff = lds_byte(wc * 32 + fr, fq * 8);
#define PG8_SA(b, h) (((b) * 2 + (h)) * HTB)
#define PG8_SB(b, h) ((4 + (b) * 2 + (h)) * HTB)
#define PG8_STAGE(bufoff, gbase, voff) do { _Pragma("unroll") for (int _i = 0; _i < 2; ++_i) \
        __builtin_amdgcn_global_load_lds((const unsigned*)((const char*)(gbase) + (voff)[_i]), (PG8_LAS unsigned*)(lds + (bufoff) + ldsw + _i * 8192), 16, 0, 0); } while (0)
#define PG8_LDA(dst, b, h) do { _Pragma("unroll") for (int m = 0; m < 4; ++m) _Pragma("unroll") for (int k = 0; k < 2; ++k) dst[m][k] = *(const PG8_LAS bf16x8*)(lds + PG8_SA(b, h) + aoff + m * 2048 + k * 1024); } while (0)
#define PG8_LDB(dst, b, h) do { _Pragma("unroll") for (int n = 0; n < 2; ++n) _Pragma("unroll") for (int k = 0; k < 2; ++k) dst[n][k] = *(const PG8_LAS bf16x8*)(lds + PG8_SB(b, h) + boff + n * 2048 + k * 1024); } while (0)
#define PG8_MMA(ai, bj, At, Bt) do { __builtin_amdgcn_s_setprio(1); _Pragma("unroll") for (int m = 0; m < 4; ++m) _Pragma("unroll") for (int n = 0; n < 2; ++n) _Pragma("unroll") for (int k = 0; k < 2; ++k) \
        acc[ai][bj][m][n] = __builtin_amdgcn_mfma_f32_16x16x32_bf16(Bt[n][k], At[m][k], acc[ai][bj][m][n], 0, 0, 0); __builtin_amdgcn_s_setprio(0); } while (0)
#define PG8_WAIT_V(n) asm volatile("s_waitcnt vmcnt(" #n ")" ::: "memory")
#define PG8_WAIT_L(n) asm volatile("s_waitcnt lgkmcnt(" #n ")" ::: "memory")
#define PG8_BAR __builtin_amdgcn_s_barrier()
#define PG8_SCHED __builtin_amdgcn_sched_barrier(0)
    Unit cur, nxt; int ui = 0;
    if (!S.next(0, cur)) return;
    f32x4 acc[2][2][4][2];
#pragma unroll
    for (int a = 0; a < 2; ++a)
#pragma unroll
        for (int b = 0; b < 2; ++b)
#pragma unroll
            for (int m = 0; m < 4; ++m)
#pragma unroll
                for (int n = 0; n < 2; ++n) acc[a][b][m][n] = (f32x4){0.f, 0.f, 0.f, 0.f};
    bf16x8 At[4][2], B0[2][2], B1[2][2];
    const char* cA = (const char*)g.A + (size_t)cur.pm * tstep; const char* cB = (const char*)g.Bt + (size_t)cur.pn * tstep;
    S.a_ready(cur);
    if constexpr (SP2) {
        PG8_STAGE(PG8_SB(0, 0), cB, voffB); PG8_STAGE(PG8_SB(0, 1), cB + hstep, voffB); PG8_STAGE(PG8_SA(0, 0), cA, voffA); PG8_STAGE(PG8_SA(0, 1), cA + hstep, voffA);
        if (wr == 1) PG8_BAR;
        PG8_WAIT_V(2); PG8_BAR;
        PG8_STAGE(PG8_SB(1, 0), cB + kstep, voffB); PG8_STAGE(PG8_SA(1, 0), cA + kstep, voffA); PG8_STAGE(PG8_SB(1, 1), cB + hstep + kstep, voffB);
        PG8_WAIT_V(6); PG8_BAR;
    } else {
        PG8_STAGE(PG8_SB(0, 0), cB, voffB); PG8_STAGE(PG8_SA(0, 0), cA, voffA); PG8_STAGE(PG8_SB(0, 1), cB + hstep, voffB); PG8_STAGE(PG8_SA(0, 1), cA + hstep, voffA);
        if (wr == 1) PG8_BAR;
        PG8_WAIT_V(4); PG8_BAR;
        PG8_STAGE(PG8_SB(1, 0), cB + kstep, voffB); PG8_STAGE(PG8_SA(1, 0), cA + kstep, voffA); PG8_STAGE(PG8_SB(1, 1), cB + hstep + kstep, voffB);
        PG8_WAIT_V(6); PG8_BAR;
    }
    for (;;) {
        const bool has_next = S.next(ui + 1, nxt);
        const char* nA = has_next ? (const char*)g.A + (size_t)nxt.pm * tstep : cA; const char* nB = has_next ? (const char*)g.Bt + (size_t)nxt.pn * tstep : cB;
        for (int t = 0; t < nt; t += 2) {
            const bool last = (t == nt - 2);
            const char* a1 = cA + (size_t)(t + 1) * kstep;
            const char* a2 = last ? nA : cA + (size_t)(t + 2) * kstep; const char* b2 = last ? nB : cB + (size_t)(t + 2) * kstep;
            const char* a3 = a2 + kstep; const char* b3 = b2 + kstep;
            if (last && has_next) S.a_ready(nxt);
            if constexpr (SP2) {
            PG8_LDB(B0, 0, 0); PG8_LDB(B1, 0, 1); PG8_SCHED; PG8_LDA(At, 0, 0); PG8_STAGE(PG8_SA(1, 1), a1 + hstep, voffA);
            PG8_WAIT_V(8); PG8_WAIT_L(0); PG8_BAR; PG8_MMA(0, 0, At, B0); PG8_MMA(0, 1, At, B1); PG8_BAR; PG8_SCHED;
            PG8_LDA(At, 0, 1); PG8_STAGE(PG8_SB(0, 0), b2, voffB); PG8_STAGE(PG8_SB(0, 1), b2 + hstep, voffB); PG8_STAGE(PG8_SA(0, 0), a2, voffA);
            PG8_WAIT_V(8); PG8_WAIT_L(0); PG8_BAR; PG8_MMA(1, 0, At, B0); PG8_MMA(1, 1, At, B1); PG8_BAR; PG8_SCHED;
            PG8_LDB(B0, 1, 0); PG8_LDB(B1, 1, 1); PG8_SCHED; PG8_LDA(At, 1, 0); PG8_STAGE(PG8_SA(0, 1), a2 + hstep, voffA);
            PG8_WAIT_V(8); PG8_WAIT_L(0); PG8_BAR; PG8_MMA(0, 0, At, B0); PG8_MMA(0, 1, At, B1); PG8_BAR; PG8_SCHED;
            PG8_LDA(At, 1, 1); PG8_STAGE(PG8_SB(1, 0), b3, voffB); PG8_STAGE(PG8_SB(1, 1), b3 + hstep, voffB); PG8_STAGE(PG8_SA(1, 0), a3, voffA);
            PG8_WAIT_V(8); PG8_WAIT_L(0); PG8_BAR; PG8_MMA(1, 0, At, B0); PG8_MMA(1, 1, At, B1); PG8_BAR; PG8_SCHED;
            } else {
            PG8_LDB(B0, 0, 0); PG8_SCHED; PG8_LDA(At, 0, 0); PG8_STAGE(PG8_SA(1, 1), a1 + hstep, voffA);
            PG8_WAIT_L(8); PG8_BAR; PG8_WAIT_L(0); PG8_MMA(0, 0, At, B0); PG8_BAR; PG8_SCHED;
            PG8_LDB(B1, 0, 1); PG8_STAGE(PG8_SB(0, 0), b2, voffB);
            PG8_BAR; PG8_WAIT_L(0); PG8_MMA(0, 1, At, B1); PG8_BAR;
            PG8_LDA(At, 0, 1); PG8_STAGE(PG8_SA(0, 0), a2, voffA);
            PG8_BAR; PG8_WAIT_L(0); PG8_MMA(1, 0, At, B0); PG8_BAR; PG8_SCHED;
            PG8_STAGE(PG8_SB(0, 1), b2 + hstep, voffB);
            PG8_WAIT_V(6); PG8_BAR; PG8_MMA(1, 1, At, B1); PG8_BAR;
            PG8_LDB(B0, 1, 0); PG8_SCHED; PG8_LDA(At, 1, 0); PG8_STAGE(PG8_SA(0, 1), a2 + hstep, voffA);
            PG8_WAIT_L(8); PG8_BAR; PG8_WAIT_L(0); PG8_MMA(0, 0, At, B0); PG8_BAR; PG8_SCHED;
            PG8_LDB(B1, 1, 1); PG8_STAGE(PG8_SB(1, 0), b3, voffB);
            PG8_BAR; PG8_WAIT_L(0); PG8_MMA(0, 1, At, B1); PG8_BAR;
            PG8_LDA(At, 1, 1); PG8_STAGE(PG8_SA(1, 0), a3, voffA);
            PG8_BAR; PG8_WAIT_L(0); PG8_MMA(1, 0, At, B0); PG8_BAR; PG8_SCHED;
            PG8_STAGE(PG8_SB(1, 1), b3 + hstep, voffB);
            PG8_WAIT_V(6); PG8_BAR; PG8_MMA(1, 1, At, B1); PG8_BAR;
            }
        }
        if constexpr (ALIGN_EPI) { if (wr == 0) PG8_BAR; }
        if constexpr (!Epi::AFTER_DRAIN) { E(acc, cur, wr, wc, fr, fq); S.done(cur); }
        if (!has_next) break;
#pragma unroll
        for (int a = 0; a < 2; ++a)
#pragma unroll
            for (int b = 0; b < 2; ++b)
#pragma unroll
                for (int m = 0; m < 4; ++m)
#pragma unroll
                    for (int n = 0; n < 2; ++n) acc[a][b][m][n] = (f32x4){0.f, 0.f, 0.f, 0.f};
        cur = nxt; cA = nA; cB = nB; ++ui;
        if constexpr (ALIGN_EPI) { if (wr == 1) PG8_BAR; }
    }
    PG8_WAIT_V(0);
    if constexpr (!ALIGN_EPI) { if (wr == 0) PG8_BAR; }
    PG8_BAR;
    if constexpr (Epi::AFTER_DRAIN) { E.fused(acc, cur, wr, wc, fr, fq, lds, wid, lane); S.done(cur); }
#undef PG8_SA
#undef PG8_SB
#undef PG8_STAGE
#undef PG8_LDA
#undef PG8_LDB
#undef PG8_MMA
#undef PG8_WAIT_V
#undef PG8_WAIT_L
#undef PG8_BAR
#undef PG8_SCHED
}
}

#define DI __device__ __forceinline__
#define LAS __attribute__((address_space(3)))
typedef unsigned short bf16_t;
typedef short bf16x8 __attribute__((ext_vector_type(8)));
typedef short s16x4 __attribute__((ext_vector_type(4)));
typedef short v4i16_t __attribute__((ext_vector_type(4)));
typedef float f32x4 __attribute__((ext_vector_type(4)));
typedef float f32x16 __attribute__((ext_vector_type(16)));
typedef unsigned u32x4 __attribute__((ext_vector_type(4)));
typedef unsigned u32x2 __attribute__((ext_vector_type(2)));
typedef float f32x2_t __attribute__((ext_vector_type(2)));
typedef __bf16 bf16x2_t __attribute__((ext_vector_type(2)));

constexpr int NWAVES = 8, NTHREADS = 512;
constexpr int SEQ = 8192, DMODEL = 1024, NMETA = 16, LTOK = SEQ + NMETA  , LP = 8256  , NCHUNK = 129;
constexpr int MTOK = 2 * SEQ;
constexpr int MROWS = 16640;
constexpr int NPROJ = 3840;
constexpr int NKT = 129;
constexpr float EPS = 1e-6f;
constexpr float C2Q = 0.125f * 1.4426950408889634f;
constexpr int XS_ROWS = 41216;

constexpr size_t MiB = 1u << 20;
constexpr size_t WS_CTL = 0, CTL_BYTES = 1 * MiB;
constexpr size_t WS_RS1 = 1 * MiB;
constexpr size_t WS_RS2 = WS_RS1 + 128 * 1024;
constexpr size_t WS_TOKE = WS_RS2 + 128 * 1024;
constexpr size_t WS_TOKW = WS_TOKE + 128 * 1024;
constexpr size_t WS_TOKP = WS_TOKW + 128 * 1024;
constexpr size_t WS_SLOTW = WS_TOKP + 128 * 1024;
constexpr size_t WS_WR = WS_SLOTW + 192 * 1024;
constexpr size_t WS_GL = WS_WR + 160 * 1024;
constexpr size_t WS_COS = 2 * MiB;
constexpr size_t WS_SIN = WS_COS + 1280 * 1024;
constexpr size_t WS_GB = WS_SIN + 1280 * 1024;
constexpr size_t WS_WOUT = 6 * MiB;
constexpr size_t WS_WINT = 8 * MiB;
constexpr size_t WS_XB = WS_WINT + (size_t)NPROJ * 1024 * 2;
constexpr size_t WS_MIX = 8 * MiB;
constexpr size_t WS_QKVB = 48 * MiB;
constexpr size_t WS_QB = WS_QKVB + (size_t)2 * LP * 1536 * 2 + 128 * 1024;
constexpr size_t WS_KT = WS_QB + 16 * MiB;
constexpr size_t WS_VT = WS_KT + (size_t)16 * NKT * 4096 * 2;
constexpr size_t WS_ZB = WS_VT + (size_t)8 * NKT * 8192 * 2;
constexpr size_t WS_GP = WS_ZB + (size_t)2 * LP * 512 * 2;
constexpr size_t GP_ARR = (size_t)2064 * 4096 * 2;
constexpr size_t WS_GP_END = WS_GP + 5 * GP_ARR;
constexpr size_t WS_WGU = 48 * MiB;
constexpr size_t WS_WD = 80 * MiB;
constexpr size_t WS_XS = 96 * MiB;
constexpr size_t WS_YO = 96 * MiB;
constexpr size_t WS_YS = WS_XS + (size_t)XS_ROWS * 1024 * 2;
constexpr size_t WS_END = 256 * MiB;
static_assert(WS_GB + (size_t)2 * LP * 16 * 4 <= WS_WOUT, "small region");
static_assert(WS_XB + (size_t)MROWS * 1024 * 2 <= WS_QKVB, "XB");
static_assert(WS_GP_END <= WS_END, "GDN prep arrays");
static_assert(WS_YS + (size_t)XS_ROWS * 256 * 2 <= WS_END, "YS");
static_assert(WS_WD + (size_t)32 * 1024 * 256 * 2 <= WS_XS, "WD");
constexpr int CW_ATTQ = 0;
constexpr int CW_CNT = 64;

constexpr int LDS_BYTES = 147456;

struct Params { const float* in[23]; float* out; unsigned char* ws; };

DI unsigned f2bf(float f) { unsigned u = __float_as_uint(f); return (u + 0x7fffu + ((u >> 16) & 1u)) >> 16; }
DI unsigned pk2(float lo, float hi) { f32x2_t v = {lo, hi}; bf16x2_t b = __builtin_convertvector(v, bf16x2_t); return __builtin_bit_cast(unsigned, b); }
DI float bf2f(unsigned short h) { return __uint_as_float(((unsigned)h) << 16); }
DI float rlane(float v, int l) { return __int_as_float(__builtin_amdgcn_readlane(__float_as_int(v), l)); }
#define DPP_ADD(v, ctrl) ((v) + __int_as_float(__builtin_amdgcn_update_dpp(0, __float_as_int(v), (ctrl), 0xF, 0xF, true)))
DI float wave_sum_dpp(float v) {
    v = DPP_ADD(v, 0xB1);
    v = DPP_ADD(v, 0x4E);
    v = DPP_ADD(v, 0x141);
    v = DPP_ADD(v, 0x140);
    return (rlane(v, 0) + rlane(v, 16)) + (rlane(v, 32) + rlane(v, 48));
}
DI float wave_sum(float v) { return wave_sum_dpp(v); }
DI float swz_xor16(float v) { return __int_as_float(__builtin_amdgcn_ds_swizzle(__float_as_int(v), 0x401F)); }
DI float row_sum16(float v) { v = DPP_ADD(v, 0xB1); v = DPP_ADD(v, 0x4E); v = DPP_ADD(v, 0x141); v = DPP_ADD(v, 0x140); return v; }
DI float half_sum32(float v) { v = row_sum16(v); return v + swz_xor16(v); }
DI float swap32_add(float v) { auto rr = __builtin_amdgcn_permlane32_swap(__float_as_uint(v), __float_as_uint(v), false, false); return __uint_as_float(rr[0]) + __uint_as_float(rr[1]); }
DI float swap32_max(float v) { auto rr = __builtin_amdgcn_permlane32_swap(__float_as_uint(v), __float_as_uint(v), false, false); return fmaxf(__uint_as_float(rr[0]), __uint_as_float(rr[1])); }
#define LDS_WAIT() asm volatile("s_waitcnt lgkmcnt(0)" ::: "memory")
#define BAR_LDS() do { asm volatile("s_waitcnt lgkmcnt(0)" ::: "memory"); __builtin_amdgcn_s_barrier(); asm volatile("" ::: "memory"); } while (0)
#define MFMA32(a, b, c) __builtin_amdgcn_mfma_f32_32x32x16_bf16((a), (b), (c), 0, 0, 0)
DI int crow(int r, int hi) { return (r & 3) + 8 * (r >> 2) + 4 * hi; }
DI int perm16(int x) { return (x & ~12) | ((x & 4) << 1) | ((x & 8) >> 1); }
DI bf16x8 pack8(const f32x16& x, int s) {
    u32x4 p; p.x = pk2(x[8 * s], x[8 * s + 1]); p.y = pk2(x[8 * s + 2], x[8 * s + 3]); p.z = pk2(x[8 * s + 4], x[8 * s + 5]); p.w = pk2(x[8 * s + 6], x[8 * s + 7]);
    return __builtin_bit_cast(bf16x8, p);
}
DI int orig_col(int n) {
    if (n >= 1024) return n;
    const int hh = n >> 6, c2 = n & 63, g8 = c2 >> 3, i = c2 & 7;
    return (hh << 6) + ((i < 4) ? 4 * g8 + i : 32 + 4 * g8 + (i - 4));
}
DI size_t kt_off(int b, int hh, int p, int d) {
    const int tile = p < 16 ? 0 : 1 + ((p - 16) >> 6), kv = p < 16 ? p : ((p - 16) & 63);
    return ((size_t)((b * 8 + hh) * NKT + tile) << 12) + ((d >> 3) << 9) + (kv << 3) + (d & 7);
}
DI size_t vt_off(int b, int h, int p, int d) {
    const int tile = p < 16 ? 0 : 1 + ((p - 16) >> 6), kv = p < 16 ? p : ((p - 16) & 63);
    return ((size_t)((b * 4 + h) * NKT + tile) << 13) + ((d >> 5) << 11) + ((kv >> 4) << 9) + ((kv & 15) << 5) + (d & 31);
}

template <class Src> DI void transpose_item(const Src& src, bf16_t* WT, size_t ldk, int k0, int n0, LAS float* scr, int lane) {
#pragma unroll 8
    for (int i = 0; i < 32; ++i) { const int kk = 2 * i + (lane >> 5); scr[kk * 33 + (lane & 31)] = src(k0 + kk, n0 + (lane & 31)); }
    LDS_WAIT();
    const int c = lane & 7;
#pragma unroll
    for (int j = 0; j < 4; ++j) { const int n = (lane >> 3) + 8 * j; const LAS float* s = scr + (8 * c) * 33 + n;
        u32x4 o; o.x = pk2(s[0 * 33], s[1 * 33]); o.y = pk2(s[2 * 33], s[3 * 33]); o.z = pk2(s[4 * 33], s[5 * 33]); o.w = pk2(s[6 * 33], s[7 * 33]);
        *(u32x4*)(WT + (size_t)(n0 + n) * ldk + k0 + 8 * c) = o; }
    LDS_WAIT();
}
struct SrcWin { const float* w; const float* g; DI float operator()(int k, int n) const { return n >= 3600 ? 0.f : w[(size_t)k * 3600 + orig_col(n)] * g[k]; } };
struct SrcPlain { const float* w; int N; DI float operator()(int k, int n) const { return w[(size_t)k * N + n]; } };
struct SrcGU { const float* w; const float* g; int fadj; DI float operator()(int k, int n) const { return w[(size_t)k * 256 + n + fadj] * g[k]; } };

DI void phase0(const Params& P, LAS unsigned char* lds, int gw, int NGW, int gtid, int NGT, int wave, int lane) {
    LAS float* scr = (LAS float*)(lds + wave * 16384);
    bf16_t* WINT = (bf16_t*)(P.ws + WS_WINT); bf16_t* WOUT = (bf16_t*)(P.ws + WS_WOUT); bf16_t* XB = (bf16_t*)(P.ws + WS_XB);
    float* RS1 = (float*)(P.ws + WS_RS1);
    constexpr int I_IN = 16 * (NPROJ / 32), I_OUT = 16 * 32;
    const SrcWin sw{P.in[3], P.in[2]}; const SrcPlain so{P.in[13], 1024};
    for (int it = gw; it < I_IN + I_OUT; it += NGW) {
        if (it < I_IN) transpose_item(sw, WINT, 1024, (it / (NPROJ / 32)) * 64, (it % (NPROJ / 32)) * 32, scr, lane);
        else { const int r = it - I_IN; transpose_item(so, WOUT, 1024, (r >> 5) * 64, (r & 31) * 32, scr, lane); }
    }
    const float* x = P.in[0]; const float* meta = P.in[1];
    for (int m = gw; m < MROWS; m += NGW) {
        u32x2* orow = (u32x2*)(XB + (size_t)m * 1024);
        if (m >= MTOK + NMETA) {
#pragma unroll
            for (int j = 0; j < 4; ++j) orow[64 * j + lane] = (u32x2){0u, 0u};
            if (lane == 0) RS1[m] = 0.f;
            continue;
        }
        const f32x4* xr = (const f32x4*)((m < MTOK) ? x + (size_t)m * 1024 : meta + (size_t)(m - MTOK) * 1024);
        f32x4 v[4]; float s = 0.f;
#pragma unroll
        for (int j = 0; j < 4; ++j) { v[j] = xr[64 * j + lane]; s += (v[j].x * v[j].x + v[j].y * v[j].y) + (v[j].z * v[j].z + v[j].w * v[j].w); }
        s = wave_sum(s);
        if (lane == 0) RS1[m] = 1.0f / sqrtf(s * (1.0f / 1024.0f) + EPS);
#pragma unroll
        for (int j = 0; j < 4; ++j) orow[64 * j + lane] = (u32x2){pk2(v[j].x, v[j].y), pk2(v[j].z, v[j].w)};
    }
    float* COS = (float*)(P.ws + WS_COS); float* SIN = (float*)(P.ws + WS_SIN);
    for (int i = gtid; i < LTOK * 32; i += NGT) {
        const int p = i >> 5, f = i & 31;
        const float inv = exp2f(-(float)f * (13.287712379549449f / 32.0f));
        const float ang = (float)p * inv;
        COS[i] = cosf(ang); SIN[i] = sinf(ang);
    }
    float* WR = (float*)(P.ws + WS_WR); const float* gf = P.in[14]; const float* wgrp = P.in[15]; const float* wrt = P.in[17];
    for (int i = gtid; i < 36 * 1024; i += NGT) { const int j = i >> 10, k = i & 1023; WR[i] = gf[k] * (j < 4 ? wgrp[k * 4 + j] : wrt[k * 32 + (j - 4)]); }
}

struct EpiInProj {
    static constexpr bool PERM = true, AFTER_DRAIN = false;
    const float* RS1; const float* COS; const float* SIN; const float* a_log; const float* dt_bias;
    bf16_t* QB; bf16_t* KT; bf16_t* VT; bf16_t* QKVB; bf16_t* ZB; float* GB;
    DI void operator()(const pg8::f32x4 (&acc)[2][2][4][2], const pg8::Unit& u, int wr, int wc, int fr, int fq) const {
        const int pn = u.pn;
#pragma unroll
        for (int ai = 0; ai < 2; ++ai)
#pragma unroll
            for (int m = 0; m < 4; ++m) {
                const int row = u.pm * 256 + ai * 128 + wr * 64 + m * 16 + fr;
                if (row < MTOK + NMETA) {
                    const float rs = RS1[row];
                    const bool meta = row >= MTOK;
                    const int p = meta ? row - MTOK : (row & 8191) + NMETA;
                    const int b0 = meta ? 0 : (row >> 13), nb = meta ? 2 : 1;
#pragma unroll
                    for (int bj = 0; bj < 2; ++bj) {
                        float xv[8];
#pragma unroll
                        for (int i = 0; i < 4; ++i) { xv[i] = acc[ai][bj][m][0][i] * rs; xv[4 + i] = acc[ai][bj][m][1][i] * rs; }
                        if (pn < 4) {
                            const int hh = (pn & 1) * 4 + bj * 2 + (wc >> 1), d0 = 4 * (4 * (wc & 1) + fq);
                            const f32x4 cs = *(const f32x4*)(COS + p * 32 + d0), sn = *(const f32x4*)(SIN + p * 32 + d0);
                            float lo[4], hi[4];
#pragma unroll
                            for (int i = 0; i < 4; ++i) { lo[i] = xv[i] * cs[i] - xv[4 + i] * sn[i]; hi[i] = xv[4 + i] * cs[i] + xv[i] * sn[i]; }
                            if (pn < 2) {
                                if (!meta) {
                                    bf16_t* q = QB + ((size_t)((b0 * 8 + hh) * SEQ + (p - NMETA)) << 6) + d0;
                                    *(u32x2*)q = (u32x2){pk2(lo[0] * C2Q, lo[1] * C2Q), pk2(lo[2] * C2Q, lo[3] * C2Q)};
                                    *(u32x2*)(q + 32) = (u32x2){pk2(hi[0] * C2Q, hi[1] * C2Q), pk2(hi[2] * C2Q, hi[3] * C2Q)};
                                }
                            } else {
                                for (int bb = b0; bb < b0 + nb; ++bb) {
                                    *(u32x2*)(KT + kt_off(bb, hh, p, d0)) = (u32x2){pk2(lo[0], lo[1]), pk2(lo[2], lo[3])};
                                    *(u32x2*)(KT + kt_off(bb, hh, p, d0 + 32)) = (u32x2){pk2(hi[0], hi[1]), pk2(hi[2], hi[3])};
                                }
                            }
                        } else {
                            const u32x4 w = (u32x4){pk2(xv[0], xv[1]), pk2(xv[2], xv[3]), pk2(xv[4], xv[5]), pk2(xv[6], xv[7])};
                            const int cl = bj * 128 + wc * 32 + fq * 8;
                            if (pn < 6) {
                                const int h = (pn - 4) * 2 + bj, d = wc * 32 + fq * 8;
                                for (int bb = b0; bb < b0 + nb; ++bb) *(u32x4*)(VT + vt_off(bb, h, p, d)) = w;
                            } else if (pn < 12) {
                                for (int bb = b0; bb < b0 + nb; ++bb) *(u32x4*)(QKVB + (size_t)(bb * LP + p) * 1536 + (pn - 6) * 256 + cl) = w;
                            } else if (pn < 14) {
                                float sz[8];
#pragma unroll
                                for (int i = 0; i < 8; ++i) sz[i] = xv[i] * __builtin_amdgcn_rcpf(1.0f + __expf(-xv[i]));
                                const u32x4 wz = (u32x4){pk2(sz[0], sz[1]), pk2(sz[2], sz[3]), pk2(sz[4], sz[5]), pk2(sz[6], sz[7])};
                                for (int bb = b0; bb < b0 + nb; ++bb) *(u32x4*)(ZB + (size_t)(bb * LP + p) * 512 + (pn - 12) * 256 + cl) = wz;
                            } else if (cl < 16) {
                                float o[8];
                                if (cl == 0) {
#pragma unroll
                                    for (int i = 0; i < 8; ++i) { const float t = xv[i] + dt_bias[i]; const float sp = t > 20.f ? t : log1pf(expf(t)); o[i] = -expf(a_log[i]) * sp; }
                                } else {
#pragma unroll
                                    for (int i = 0; i < 8; ++i) o[i] = 1.0f / (1.0f + expf(-xv[i]));
                                }
                                for (int bb = b0; bb < b0 + nb; ++bb) { float* g = GB + ((size_t)(bb * LP + p) << 4) + cl;
                                    *(f32x4*)g = (f32x4){o[0], o[1], o[2], o[3]}; *(f32x4*)(g + 4) = (f32x4){o[4], o[5], o[6], o[7]}; }
                            }
                        }
                    }
                }
            }
    }
};

DI bf16x8 lds_frag(LAS const bf16_t* M, int row, int ch) { return *(LAS const bf16x8*)((LAS const unsigned char*)M + row * 128 + ((ch ^ (row & 7)) << 4)); }
DI bf16x8 lds_frag_plain(LAS const bf16_t* M, int row, int ch) { return *(LAS const bf16x8*)((LAS const unsigned char*)M + row * 128 + (ch << 4)); }
DI int swz_idx(int row, int d) { return row * 64 + ((((d >> 3) ^ (row & 7)) << 3) | (d & 7)); }

constexpr int PREP_PAIR = 35840;

template <int MAT> DI void prep_rows(const bf16_t* QKVB, const float* cw, int b, int h, int n, int lane, LAS const float* egS,
                                     LAS bf16_t* DS  , bf16_t* QG) {
    const int col = MAT * 512 + h * 64 + lane, p0 = n * 64;
    const float c0 = cw[col], c1 = cw[1536 + col], c2 = cw[3072 + col], c3 = cw[4608 + col];
    const bf16_t* rp = QKVB + (size_t)(b * LP + p0) * 1536 + col;
    float x0 = 0.f, x1 = 0.f, x2 = 0.f;
    if (n > 0) { x0 = bf2f(rp[-3 * 1536]); x1 = bf2f(rp[-2 * 1536]); x2 = bf2f(rp[-1 * 1536]); }
    const int nvalid = (LTOK - p0) < 64 ? (LTOK - p0) : 64;
#pragma unroll 4
    for (int c = 0; c < 64; ++c) {
        const bool valid = c < nvalid;
        const float x3 = valid ? bf2f(*rp) : 0.f;
        rp += 1536;
        float y = c0 * x0 + c1 * x1 + c2 * x2 + c3 * x3;
        y = y * __builtin_amdgcn_rcpf(1.0f + __expf(-y));
        if (!valid) y = 0.f;
        x0 = x1; x1 = x2; x2 = x3;
        if (MAT == 2) { DS[c * 64 + lane] = (bf16_t)f2bf(y); }
        else {
            const float ss = wave_sum(y * y);
            const float yn = y * __builtin_amdgcn_rsqf(ss + EPS);
            if (MAT == 0) {
                const float qn = yn * 0.125f;
                DS[c * 64 + lane] = (bf16_t)f2bf(qn);
                QG[c * 64 + perm16(lane)] = (bf16_t)f2bf(qn * egS[c]);
            } else {
                DS[c * 64 + lane] = (bf16_t)f2bf(yn);
            }
        }
    }
}

DI void solve_blocked(LAS const float* AST, LAS bf16_t* XB, LAS const float* scl, int lane, float sgn, bf16_t* out, int ocol) {
    for (int b = 0; b < 4; ++b) {
        float s[16];
#pragma unroll
        for (int r = 0; r < 16; ++r) s[r] = bf2f(XB[(16 * b + r) * 64 + lane]) * scl[16 * b + r];
        for (int j = 0; j < 16 * b; ++j) {
            const float xj = bf2f(XB[j * 64 + lane]);
            LAS const f32x4* ap = (LAS const f32x4*)(AST + j * 68 + 16 * b);
            const f32x4 a0 = ap[0], a1 = ap[1], a2 = ap[2], a3 = ap[3];
#pragma unroll
            for (int r = 0; r < 4; ++r) { s[r] -= a0[r] * xj; s[4 + r] -= a1[r] * xj; s[8 + r] -= a2[r] * xj; s[12 + r] -= a3[r] * xj; }
        }
#pragma unroll
        for (int jj = 0; jj < 15; ++jj) {
            const float xj = s[jj];
            LAS const float* ap = AST + (16 * b + jj) * 68 + 16 * b;
#pragma unroll
            for (int r = jj + 1; r < 16; ++r) s[r] -= ap[r] * xj;
        }
#pragma unroll
        for (int r = 0; r < 16; ++r) { XB[(16 * b + r) * 64 + lane] = (bf16_t)f2bf(s[r]); out[(16 * b + r) * 64 + ocol] = (bf16_t)f2bf(sgn * s[r]); }
    }
}

DI void gdn_prep_phase(const Params& P, LAS unsigned char* lds, int blk, int G, int wave, int lane_in) {
    const int pair = wave >> 1, role = wave & 1;
    LAS unsigned char* pb = lds + pair * PREP_PAIR;
    LAS bf16_t* QS = (LAS bf16_t*)pb; LAS bf16_t* KS = (LAS bf16_t*)(pb + 8192); LAS float* AS = (LAS float*)(pb + 16384);
    LAS float* gcS = (LAS float*)(pb + 16384 + 17408 + role * 1024); LAS float* betaS = gcS + 64; LAS float* egS = gcS + 128; LAS float* ekS = gcS + 192;
    const bf16_t* QKVB = (const bf16_t*)(P.ws + WS_QKVB); const float* GB = (const float*)(P.ws + WS_GB); const float* cw = P.in[9];
    const int NP = G * 4, NTASK = 2 * 8 * NCHUNK;
    for (int it = 0; it * NP < NTASK; ++it) {
        int lane = lane_in; asm volatile("" : "+v"(lane));
        const int r32 = lane & 31, hi = lane >> 5;
        const int task = it * NP + blk * 4 + pair;
        const bool active = task < NTASK;
        const int b = task / (8 * NCHUNK), h = (task / NCHUNK) & 7, n = task % NCHUNK;
        bf16_t* GPW = (bf16_t*)(P.ws + WS_GP) + (size_t)task * 4096; bf16_t* GPQG = GPW + GP_ARR / 2; bf16_t* GPAQK = GPQG + GP_ARR / 2; bf16_t* GPKGT = GPAQK + GP_ARR / 2; bf16_t* GPU = GPKGT + GP_ARR / 2;
        float gc = 0.f, beta = 0.f;
        if (active) {
            const int pl = n * 64 + lane;
            float g = 0.f;
            if (pl < LTOK) { const float* gb = GB + ((size_t)(b * LP + pl) << 4); g = gb[h]; beta = gb[8 + h]; }
            gcS[lane] = g; LDS_WAIT();
            gc = 0.f;
#pragma unroll
            for (int j4 = 0; j4 < 16; ++j4) { const f32x4 t = *(LAS const f32x4*)(gcS + 4 * j4);
                gc += (4 * j4 <= lane ? t[0] : 0.f) + (4 * j4 + 1 <= lane ? t[1] : 0.f) + (4 * j4 + 2 <= lane ? t[2] : 0.f) + (4 * j4 + 3 <= lane ? t[3] : 0.f); }
            const float glast = rlane(gc, 63);
            LDS_WAIT();
            gcS[lane] = gc; betaS[lane] = beta; egS[lane] = (role == 0) ? __expf(gc) : beta * __expf(gc); ekS[lane] = __expf(glast - gc);
            if (role == 0 && lane == 0) ((float*)(P.ws + WS_GL))[task] = __expf(glast);
            LDS_WAIT();
            if (role == 0) prep_rows<0>(QKVB, cw, b, h, n, lane, egS, QS, GPQG);
            else prep_rows<1>(QKVB, cw, b, h, n, lane, egS, KS, GPQG);
        }
        LDS_WAIT();
        __syncthreads();
        if (active) {
#pragma unroll
            for (int t4 = 0; t4 < 4; ++t4) {
                const int ct = t4 >> 1, st = t4 & 1;
                f32x16 acc = {};
                if (!(ct == 0 && st == 1)) {
#pragma unroll
                    for (int ks = 0; ks < 4; ++ks) {
                        const bf16x8 fa = lds_frag_plain(role == 0 ? QS : KS, 32 * ct + r32, 2 * ks + hi), fb = lds_frag_plain(KS, 32 * st + r32, 2 * ks + hi);
                        acc = MFMA32(fa, fb, acc);
                    }
                }
                const float gcs = gcS[32 * st + r32];
                bf16_t* aqb = GPAQK + hi * 256 + perm16(r32); LAS float* asb = AS + r32 * 68 + hi * 4;        LAS const float* gcb = gcS + hi * 4; LAS const float* beb = betaS + hi * 4;
                asm volatile("" : "+v"(aqb), "+v"(asb), "+v"(gcb), "+v"(beb));
#pragma unroll
                for (int i = 0; i < 16; ++i) {
                    const int cr = 32 * ct + (i & 3) + 8 * (i >> 2);
                    const int cmp = (32 * st + r32) - 4 * hi;
                    const float dec = __expf(gcb[cr] - gcs);
                    if (role == 0) aqb[cr * 64 + 32 * st] = (bf16_t)f2bf((cmp <= cr) ? acc[i] * dec : 0.f);
                    else asb[32 * st * 68 + cr] = (cmp < cr) ? acc[i] * beb[cr] * dec : 0.f;
                }
            }
        }
        LDS_WAIT();
        __syncthreads();
        if (active) {
            if (role == 0) {
                prep_rows<2>(QKVB, cw, b, h, n, lane, egS, QS  , GPQG);
                LDS_WAIT();
                solve_blocked(AS, QS, betaS, lane, 1.0f, GPU, lane);
            } else {
#pragma unroll
                for (int gq = 0; gq < 8; ++gq) {
                    float t[8];
#pragma unroll
                    for (int j = 0; j < 8; ++j) { const int c = perm16(8 * gq + j); t[j] = bf2f(KS[c * 64 + lane]) * ekS[c]; }
                    *(u32x4*)(GPKGT + lane * 64 + 8 * gq) = (u32x4){pk2(t[0], t[1]), pk2(t[2], t[3]), pk2(t[4], t[5]), pk2(t[6], t[7])};
                }
                solve_blocked(AS, KS, egS, lane, -1.0f, GPW, perm16(lane));
            }
        }
        LDS_WAIT();
    }
}

constexpr int GS_STAGE = 40960 + 256;
constexpr int GS_OBUF = 2 * GS_STAGE;
static_assert(GS_OBUF + 32768 <= 131072, "gdn scan LDS");

#define GS_STEP(n, HW, HGW, STGW) do { \
        if (wave < 2) { \
            if (n < NCHUNK) { \
                LAS const unsigned char* sg = lds + (n & 1) * GS_STAGE; \
                LAS const bf16_t* Wm = (LAS const bf16_t*)sg; LAS const bf16_t* QGm = (LAS const bf16_t*)(sg + 8192); LAS const bf16_t* AQm = (LAS const bf16_t*)(sg + 16384); \
                LAS const bf16_t* KGm = (LAS const bf16_t*)(sg + 24576); LAS const bf16_t* Um = (LAS const bf16_t*)(sg + 32768); \
                const float gl = *(LAS const float*)(sg + 40960); \
                bf16x8 Sb[2][2]; Sb[0][0] = pack8(S0, 0); Sb[0][1] = pack8(S0, 1); Sb[1][0] = pack8(S1, 0); Sb[1][1] = pack8(S1, 1); \
                f32x16 vn[2], o[2]; \
        _Pragma("unroll") \
                for (int ct = 0; ct < 2; ++ct) { \
                    f32x16 acc; \
        _Pragma("unroll") \
                    for (int i = 0; i < 16; ++i) acc[i] = bf2f(Um[(32 * ct + crow(i, hi)) * 64 + vbase + r32]); \
                    f32x16 oo = {}; \
        _Pragma("unroll") \
                    for (int kt = 0; kt < 2; ++kt) \
        _Pragma("unroll") \
                        for (int s2 = 0; s2 < 2; ++s2) { \
                            acc = MFMA32(lds_frag(Wm, 32 * ct + r32, (2 * kt + s2) * 2 + hi), Sb[kt][s2], acc); \
                            oo = MFMA32(lds_frag(QGm, 32 * ct + r32, (2 * kt + s2) * 2 + hi), Sb[kt][s2], oo); \
                        } \
                    vn[ct] = acc; o[ct] = oo; \
                } \
                bf16x8 Vb[2][2]; Vb[0][0] = pack8(vn[0], 0); Vb[0][1] = pack8(vn[0], 1); Vb[1][0] = pack8(vn[1], 0); Vb[1][1] = pack8(vn[1], 1); \
        _Pragma("unroll") \
                for (int i = 0; i < 16; ++i) { S0[i] *= gl; S1[i] *= gl; } \
        _Pragma("unroll") \
                for (int ct = 0; ct < 2; ++ct) \
        _Pragma("unroll") \
                    for (int s2 = 0; s2 < 2; ++s2) { \
                        const int ch = (2 * ct + s2) * 2 + hi; \
                        o[0] = MFMA32(lds_frag(AQm, r32, ch), Vb[ct][s2], o[0]); \
                        o[1] = MFMA32(lds_frag(AQm, 32 + r32, ch), Vb[ct][s2], o[1]); \
                        S0 = MFMA32(lds_frag(KGm, r32, ch), Vb[ct][s2], S0); \
                        S1 = MFMA32(lds_frag(KGm, 32 + r32, ch), Vb[ct][s2], S1); \
                    } \
                LAS float* ob = (LAS float*)(lds + GS_OBUF + (n & 1) * 16384); \
        _Pragma("unroll") \
                for (int ct = 0; ct < 2; ++ct) \
        _Pragma("unroll") \
                    for (int i = 0; i < 16; ++i) ob[(32 * ct + crow(i, hi)) * 64 + vbase + r32] = o[ct][i]; \
            } \
        } else if (wave < 4) { \
            if (n > 0) {         \
                LAS const float* ob = (LAS const float*)(lds + GS_OBUF + ((n - 1) & 1) * 16384); \
                const int vq = lane & 15, rg = lane >> 4; \
                const f32x4 gn = *(const f32x4*)(gnorm + 4 * vq); \
        _Pragma("unroll") \
                for (int it = 0; it < 8; ++it) { \
                    const int c = (wave - 2) * 32 + 4 * it + rg, p = (n - 1) * 64 + c; \
                    const bool ok = (p >= NMETA) && (p < LTOK); \
                    const int pc = p < LTOK ? p : LTOK - 1;         \
                    const f32x4 v = *(LAS const f32x4*)(ob + c * 64 + 4 * vq); \
                    const u32x2 zz = *(const u32x2*)(ZB + (size_t)(b * LP + pc) * 512 + h * 64 + 4 * vq); \
                    const float ss = row_sum16((v[0] * v[0] + v[1] * v[1]) + (v[2] * v[2] + v[3] * v[3])); \
                    const float rn = __builtin_amdgcn_rsqf(ss * (1.0f / 64.0f) + EPS); \
                    const float z0 = __uint_as_float(zz.x << 16), z1 = __uint_as_float(zz.x & 0xffff0000u), z2 = __uint_as_float(zz.y << 16), z3 = __uint_as_float(zz.y & 0xffff0000u); \
                    const float y0 = v[0] * rn * gn[0] * z0, y1 = v[1] * rn * gn[1] * z1, y2 = v[2] * rn * gn[2] * z2, y3 = v[3] * rn * gn[3] * z3;      \
                    if (ok) *(u32x2*)(MIX + (size_t)(b * SEQ + p - NMETA) * 1024 + 512 + h * 64 + 4 * vq) = (u32x2){pk2(y0, y1), pk2(y2, y3)}; \
                } \
            } \
        } else { \
            if (n + 1 < NCHUNK) { GS_WRITE(HW, HGW, STGW); if (n + 3 < NCHUNK) GS_ISSUE(HW, HGW, n + 3); } \
        } \
        BAR_LDS(); } while (0)
DI void gdn_scan(const Params& P, LAS unsigned char* lds, int bh, int tid, int wave, int lane) {
    const int b = bh >> 3, h = bh & 7, r32 = lane & 31, hi = lane >> 5;
    const int task0 = (b * 8 + h) * NCHUNK;
    const bf16_t* GP0 = (const bf16_t*)(P.ws + WS_GP);
    const float* GLg = (const float*)(P.ws + WS_GL);
    const int lt = tid - 256;
    u32x4 holdA[10], holdB[10]; float hglA = 0.f, hglB = 0.f;
#define GS_ISSUE(H, HG, n_) do { _Pragma("unroll") for (int i = 0; i < 10; ++i) { const int a_ = i >> 1, e_ = lt + 256 * (i & 1); \
            H[i] = *(const u32x4*)(GP0 + (size_t)a_ * (GP_ARR / 2) + (size_t)(task0 + (n_)) * 4096 + e_ * 8); } \
        if (lt == 0) HG = GLg[task0 + (n_)]; } while (0)
#define GS_WRITE(H, HG, stg_) do { LAS unsigned char* sg_ = lds + (stg_) * GS_STAGE; \
        _Pragma("unroll") for (int i = 0; i < 10; ++i) { const int a_ = i >> 1, e_ = lt + 256 * (i & 1), row_ = e_ >> 3, ch_ = e_ & 7; \
            *(LAS u32x4*)(sg_ + a_ * 8192 + row_ * 128 + (((a_ < 4) ? (ch_ ^ (row_ & 7)) : ch_) << 4)) = H[i]; } \
        if (lt == 0) *(LAS float*)(sg_ + 40960) = HG; } while (0)
    if (wave >= 4) { GS_ISSUE(holdA, hglA, 0); GS_WRITE(holdA, hglA, 0); GS_ISSUE(holdB, hglB, 1); GS_ISSUE(holdA, hglA, 2); }
    __syncthreads();
    f32x16 S0 = {}, S1 = {};
    const int vbase = 32 * wave;
    const bf16_t* ZB = (const bf16_t*)(P.ws + WS_ZB); bf16_t* MIX = (bf16_t*)(P.ws + WS_MIX); const float* gnorm = P.in[12];
    for (int n2 = 0; n2 <= NCHUNK; n2 += 2) { GS_STEP((n2), holdB, hglB, 1); GS_STEP((n2 + 1), holdA, hglA, 0); }
}

constexpr int AT_STAGE = 32768;
constexpr int AT_XBUF = 2 * AT_STAGE;
constexpr int AT_WSF = AT_XBUF + 65536;
constexpr int AT_UNIT = AT_WSF + 2048;
constexpr float AT_THR = 8.0f;

DI s16x4 tr_read(LAS const unsigned char* p) { return __builtin_bit_cast(s16x4, __builtin_amdgcn_ds_read_tr16_b64_v4i16((LAS v4i16_t*)p)); }

DI void attn_unit(const Params& P, LAS unsigned char* lds, int bh, int qi, int tid, int wave, int lane, float lam) {
    const int b = bh >> 2, h = bh & 3, r32 = lane & 31, hi = lane >> 5, qsub = wave >> 1, map = wave & 1, hh = 2 * h + map;
    const bf16_t* QB = (const bf16_t*)(P.ws + WS_QB); const bf16_t* KT = (const bf16_t*)(P.ws + WS_KT); const bf16_t* VT = (const bf16_t*)(P.ws + WS_VT);
    const int ntiles = 2 * qi + 3, my_nt = (qsub < 2) ? ntiles - 1 : ntiles;
    const bf16_t* k1 = KT + ((size_t)((b * 8 + 2 * h) * NKT) << 12) + tid * 8;
    const bf16_t* k2 = KT + ((size_t)((b * 8 + 2 * h + 1) * NKT) << 12) + tid * 8;
    const bf16_t* vv = VT + ((size_t)((b * 4 + h) * NKT) << 13) + tid * 8;
    u32x4 st[4];
#define AT_LOAD(t) do { st[0] = *(const u32x4*)(k1 + ((size_t)(t) << 12)); st[1] = *(const u32x4*)(k2 + ((size_t)(t) << 12)); \
                        st[2] = *(const u32x4*)(vv + ((size_t)(t) << 13)); st[3] = *(const u32x4*)(vv + ((size_t)(t) << 13) + 4096); } while (0)
#define AT_STORE(sb) do { LAS unsigned char* d_ = lds + (sb) * AT_STAGE + tid * 16; *(LAS u32x4*)d_ = st[0]; *(LAS u32x4*)(d_ + 8192) = st[1]; \
                          *(LAS u32x4*)(d_ + 16384) = st[2]; *(LAS u32x4*)(d_ + 24576) = st[3]; } while (0)
    AT_LOAD(0);
    bf16x8 qr[4];
    { const bf16_t* q = QB + ((size_t)((b * 8 + hh) * SEQ + qi * 128 + qsub * 32 + r32) << 6) + hi * 8;
#pragma unroll
      for (int d0 = 0; d0 < 4; ++d0) qr[d0] = *(const bf16x8*)(q + d0 * 16); }
    AT_STORE(0);
    __syncthreads();
    LAS float* wsf = (LAS float*)(lds + AT_WSF) + wave * 64;
    float m_run = -1e30f, l_run = 0.f;
    f32x16 o[4]; o[0] = f32x16{}; o[1] = f32x16{}; o[2] = f32x16{}; o[3] = f32x16{};
    for (int t = 0; t < ntiles; ++t) {
        if (t + 1 < ntiles) AT_LOAD(t + 1);
        if (t < my_nt) {
            LAS const unsigned char* sg = lds + (t & 1) * AT_STAGE;
            LAS const unsigned char* kb = sg + map * 8192 + hi * 1024 + r32 * 16;
            f32x16 p0 = {}, p1 = {};
#pragma unroll
            for (int d0 = 0; d0 < 4; ++d0) {
                const bf16x8 a0 = *(LAS const bf16x8*)(kb + d0 * 2048), a1 = *(LAS const bf16x8*)(kb + d0 * 2048 + 512);
                p0 = MFMA32(a0, qr[d0], p0); p1 = MFMA32(a1, qr[d0], p1);
            }
            if (t == 0) {
#pragma unroll
                for (int r = 0; r < 16; ++r) { if (crow(r, hi) >= NMETA) p0[r] = -INFINITY; p1[r] = -INFINITY; }
            }
            float rm = fmaxf(p0[0], p1[0]);
#pragma unroll
            for (int r = 1; r < 16; ++r) rm = fmaxf(rm, fmaxf(p0[r], p1[r]));
            rm = swap32_max(rm);
            if (__any(rm > m_run + AT_THR)) {
                const float mn = fmaxf(m_run, rm), alpha = exp2f(m_run - mn);
                l_run *= alpha; m_run = mn;
                if (hi == 0) wsf[r32] = alpha;
                LDS_WAIT();
#pragma unroll
                for (int r = 0; r < 16; ++r) { const float a = wsf[crow(r, hi)];
#pragma unroll
                    for (int d0 = 0; d0 < 4; ++d0) o[d0][r] *= a; }
                LDS_WAIT();
            }
            float ls = 0.f;
#pragma unroll
            for (int r = 0; r < 16; ++r) { p0[r] = exp2f(p0[r] - m_run); p1[r] = exp2f(p1[r] - m_run); ls += p0[r] + p1[r]; }
            l_run += ls;
            const bf16x8 pa0 = pack8(p0, 0), pa1 = pack8(p0, 1), pa2 = pack8(p1, 0), pa3 = pack8(p1, 1);
            LAS const unsigned char* vb = sg + 16384 + ((lane >> 4) & 1) * 32 + (lane & 3) * 8 + (4 * hi + ((lane & 15) >> 2)) * 64;
#pragma unroll
            for (int d0 = 0; d0 < 4; ++d0) {
#define AT_VF(ks) ({ const s16x4 lo_ = tr_read(vb + d0 * 4096 + (ks) * 1024), hi_ = tr_read(vb + d0 * 4096 + (ks) * 1024 + 512); \
                     (bf16x8){lo_[0], lo_[1], lo_[2], lo_[3], hi_[0], hi_[1], hi_[2], hi_[3]}; })
                o[d0] = MFMA32(pa0, AT_VF(0), o[d0]); o[d0] = MFMA32(pa1, AT_VF(1), o[d0]);
                o[d0] = MFMA32(pa2, AT_VF(2), o[d0]); o[d0] = MFMA32(pa3, AT_VF(3), o[d0]);
#undef AT_VF
            }
        }
        if (t + 1 < ntiles) AT_STORE((t + 1) & 1);
        __syncthreads();
    }
    l_run = swap32_add(l_run);
    const float sc = (map ? lam : 1.0f) / l_run;
    if (hi == 0) wsf[r32] = sc;
    LDS_WAIT();
#pragma unroll
    for (int r = 0; r < 16; ++r) { const float a = wsf[crow(r, hi)];
#pragma unroll
        for (int d0 = 0; d0 < 4; ++d0) o[d0][r] *= a; }
    LAS float* xb = (LAS float*)(lds + AT_XBUF + qsub * 16384);
    if (map) {
#pragma unroll
        for (int d0 = 0; d0 < 4; ++d0)
#pragma unroll
            for (int r = 0; r < 16; ++r) xb[(d0 * 16 + r) * 64 + lane] = o[d0][r];
    }
    __syncthreads();
    if (!map) {
        const float* dn = P.in[8];
        bf16_t* MIX = (bf16_t*)(P.ws + WS_MIX);
        float ss[16];
#pragma unroll
        for (int r = 0; r < 16; ++r) { ss[r] = 0.f;
#pragma unroll
            for (int d0 = 0; d0 < 4; ++d0) { o[d0][r] -= xb[(d0 * 16 + r) * 64 + lane]; ss[r] += o[d0][r] * o[d0][r]; } }
#pragma unroll
        for (int r = 0; r < 16; ++r) {
            ss[r] = half_sum32(ss[r]);
            ss[r] = 0.8f / sqrtf(ss[r] * (1.0f / 128.0f) + EPS);
        }
        float dg[4];
#pragma unroll
        for (int d0 = 0; d0 < 4; ++d0) dg[d0] = dn[32 * d0 + r32];
#pragma unroll
        for (int r = 0; r < 16; ++r) {
            bf16_t* orow = MIX + (size_t)(b * SEQ + qi * 128 + qsub * 32 + crow(r, hi)) * 1024 + h * 128 + r32;
#pragma unroll
            for (int d0 = 0; d0 < 4; ++d0) orow[32 * d0] = (bf16_t)f2bf(o[d0][r] * ss[r] * dg[d0]);
        }
    }
    __syncthreads();
#undef AT_LOAD
#undef AT_STORE
}

DI void attn_phase(const Params& P, LAS unsigned char* lds, int tid, int wave, int lane) {
    unsigned* ctl = (unsigned*)(P.ws + WS_CTL);
    const float* lq1 = P.in[4]; const float* lk1 = P.in[5]; const float* lq2 = P.in[6]; const float* lk2 = P.in[7];
    const float lam = __expf(wave_sum(lq1[lane] * lk1[lane])) - __expf(wave_sum(lq2[lane] * lk2[lane])) + 0.2f;
    LAS volatile int* ub = (LAS volatile int*)(lds + AT_UNIT);
    for (;;) {
        if (tid == 0) *ub = (int)__hip_atomic_fetch_add(ctl + CW_ATTQ, 1u, __ATOMIC_RELAXED, __HIP_MEMORY_SCOPE_AGENT);
        __syncthreads();
        const int u = *ub;
        __syncthreads();
        if (u >= 512) break;
        attn_unit(P, lds, u & 7, 63 - (u >> 3), tid, wave, lane, lam);
    }
}

struct EpiOutProj {
    static constexpr bool PERM = false, AFTER_DRAIN = false;
    const float* x; float* out;
    DI void operator()(const pg8::f32x4 (&acc)[2][2][4][2], const pg8::Unit& u, int wr, int wc, int fr, int fq) const {
        const int row0 = u.pm * 256 + wr * 64 + fr, col0 = u.pn * 256 + wc * 32 + 4 * fq;
#pragma unroll
        for (int ai = 0; ai < 2; ++ai)
#pragma unroll
            for (int m = 0; m < 4; ++m) { const size_t off = (size_t)(row0 + ai * 128 + m * 16) * 1024 + col0;
#pragma unroll
                for (int bj = 0; bj < 2; ++bj)
#pragma unroll
                    for (int n = 0; n < 2; ++n) { const f32x4 xv = *(const f32x4*)(x + off + bj * 128 + n * 16); *(f32x4*)(out + off + bj * 128 + n * 16) = acc[ai][bj][m][n] + xv; } }
    }
};

typedef float f32x4v __attribute__((ext_vector_type(4)));
DI void route_tile(const Params& P, int tile, LAS float* lg  , int lane) {
    const float* h2 = P.out; const float* WR = (const float*)(P.ws + WS_WR);
    const int r16 = lane & 15, kq = lane >> 4;
    const float* arow = h2 + (size_t)(tile * 16 + r16) * 1024 + kq * 256;
    const float* b0 = WR + (size_t)r16 * 1024 + kq * 256; const float* b1 = b0 + 16 * 1024; const float* b2 = WR + (size_t)(32 + (r16 & 3)) * 1024 + kq * 256;
    const float z2 = (r16 < 4) ? 1.0f : 0.0f;
    f32x4v c0 = {}, c1 = {}, c2 = {};
    float ss = 0.f;
    for (int t4 = 0; t4 < 64; ++t4) {
        const f32x4 a = *(const f32x4*)(arow + 4 * t4), w0 = *(const f32x4*)(b0 + 4 * t4), w1 = *(const f32x4*)(b1 + 4 * t4), w2 = *(const f32x4*)(b2 + 4 * t4);
        ss += (a.x * a.x + a.y * a.y) + (a.z * a.z + a.w * a.w);
#pragma unroll
        for (int i = 0; i < 4; ++i) {
            c0 = __builtin_amdgcn_mfma_f32_16x16x4f32(a[i], w0[i], c0, 0, 0, 0);
            c1 = __builtin_amdgcn_mfma_f32_16x16x4f32(a[i], w1[i], c1, 0, 0, 0);
            c2 = __builtin_amdgcn_mfma_f32_16x16x4f32(a[i], w2[i] * z2, c2, 0, 0, 0);
        }
    }
    ss += swz_xor16(ss); ss = swap32_add(ss);
    const float rs = 1.0f / sqrtf(ss * (1.0f / 1024.0f) + EPS);
#pragma unroll
    for (int r = 0; r < 4; ++r) { const int row = 4 * kq + r; lg[row * 48 + r16] = c0[r]; lg[row * 48 + 16 + r16] = c1[r]; lg[row * 48 + 32 + r16] = c2[r]; }
    LDS_WAIT();
    if (lane < 16) {
        const int t = tile * 16 + lane;
        const float* bg = P.in[16]; const float* br = P.in[18];
        LAS const float* l = lg + lane * 48;
        float gl[4]; int gs = 0; float gm;
#pragma unroll
        for (int j = 0; j < 4; ++j) gl[j] = l[j] * rs + bg[j];
        gm = gl[0];
#pragma unroll
        for (int j = 1; j < 4; ++j) if (gl[j] > gm) { gm = gl[j]; gs = j; }
        float gsum = 0.f;
#pragma unroll
        for (int j = 0; j < 4; ++j) gsum += __expf(gl[j] - gm);
        const float psel = 1.0f / gsum;
        float e1 = -INFINITY, e2 = -INFINITY; int i1 = 0, i2 = 0;
#pragma unroll
        for (int j = 0; j < 8; ++j) {
            const float v = l[4 + gs * 8 + j] * rs + br[gs * 8 + j];
            if (v > e1) { e2 = e1; i2 = i1; e1 = v; i1 = j; } else if (v > e2) { e2 = v; i2 = j; }
        }
        const float x2 = __expf(e2 - e1), w1 = psel / (1.0f + x2), w2 = psel * x2 / (1.0f + x2);
        const int ea = gs * 8 + i1, eb = gs * 8 + i2;
        unsigned* cnt = (unsigned*)(P.ws + WS_CTL) + CW_CNT;
        const int pa = (int)atomicAdd(cnt + ea, 1u), pb = (int)atomicAdd(cnt + eb, 1u);
        ((int*)(P.ws + WS_TOKE))[2 * t] = ea; ((int*)(P.ws + WS_TOKE))[2 * t + 1] = eb;
        ((float*)(P.ws + WS_TOKW))[2 * t] = w1; ((float*)(P.ws + WS_TOKW))[2 * t + 1] = w2;
        ((int*)(P.ws + WS_TOKP))[2 * t] = pa; ((int*)(P.ws + WS_TOKP))[2 * t + 1] = pb;
        ((float*)(P.ws + WS_RS2))[t] = rs;
    }
    LDS_WAIT();
}

DI void phase4a(const Params& P, LAS unsigned char* lds, int gw, int NGW, int wave, int lane) {
    LAS float* scr = (LAS float*)(lds + wave * 16384);
    for (int tile = gw; tile < MTOK / 16; tile += NGW) route_tile(P, tile, scr, lane);
    bf16_t* WGU = (bf16_t*)(P.ws + WS_WGU); bf16_t* WD = (bf16_t*)(P.ws + WS_WD);
    const float* wg = P.in[19]; const float* wu = P.in[20]; const float* wd = P.in[21]; const float* gf = P.in[14];
    constexpr int I_GU = 16 * 16, I_D = 4 * 32;
    for (int it = gw; it < 32 * (I_GU + I_D); it += NGW) {
        const int e = it / (I_GU + I_D), r = it % (I_GU + I_D);
        if (r < I_GU) { const int n0 = (r & 15) * 32, j = n0 >> 8, up = (n0 >> 7) & 1;
            const float* wsrc = (up ? wu : wg) + (size_t)e * 1024 * 256;
            const SrcGU s{wsrc, gf, 128 * j + (n0 & 127) - n0};
            transpose_item(s, WGU + (size_t)e * 512 * 1024, 1024, (r >> 4) * 64, n0, scr, lane); }
        else { const int r2 = r - I_GU; const SrcPlain s{wd + (size_t)e * 256 * 1024, 1024};
            transpose_item(s, WD + (size_t)e * 1024 * 256, 256, (r2 >> 5) * 64, (r2 & 31) * 32, scr, lane); }
    }
}

DI void expert_layout(const Params& P, int lane, int& cnt, int& base, int& tend) {
    const unsigned* c = (const unsigned*)(P.ws + WS_CTL) + CW_CNT;
    cnt = (lane < 32) ? (int)__hip_atomic_load(c + lane, __ATOMIC_RELAXED, __HIP_MEMORY_SCOPE_AGENT) : 0;
    const int tiles = (cnt + 255) >> 8;
    int inc = 0;
#pragma unroll
    for (int i = 0; i < 32; ++i) { const int ti = __builtin_amdgcn_readlane(tiles, i); inc += (i <= lane) ? ti : 0; }
    tend = inc; base = (inc - tiles) << 8;
}

DI void phase4b(const Params& P, int gw, int NGW, int lane) {
    int cnt, base, tend; expert_layout(P, lane, cnt, base, tend);
    bf16_t* XS = (bf16_t*)(P.ws + WS_XS); float* SLOTW = (float*)(P.ws + WS_SLOTW);
    const int* TOKE = (const int*)(P.ws + WS_TOKE); const float* TOKW = (const float*)(P.ws + WS_TOKW); int* TOKP = (int*)(P.ws + WS_TOKP); const float* RS2 = (const float*)(P.ws + WS_RS2);
    for (int t = gw; t < MTOK; t += NGW) {
        const f32x4* hr = (const f32x4*)(P.out + (size_t)t * 1024);
        const float rs = RS2[t];
        u32x2 w[4];
#pragma unroll
        for (int j = 0; j < 4; ++j) { const f32x4 v = hr[64 * j + lane]; w[j] = (u32x2){pk2(v.x * rs, v.y * rs), pk2(v.z * rs, v.w * rs)}; }
#pragma unroll
        for (int k = 0; k < 2; ++k) {
            const int e = __builtin_amdgcn_readfirstlane(TOKE[2 * t + k]), slot = __builtin_amdgcn_readlane(base, e) + TOKP[2 * t + k];
            u32x2* orow = (u32x2*)(XS + (size_t)slot * 1024);
#pragma unroll
            for (int j = 0; j < 4; ++j) orow[64 * j + lane] = w[j];
            if (lane == 0) { SLOTW[slot] = TOKW[2 * t + k]; TOKP[2 * t + k] = slot; }
        }
    }
    for (int e = 0; e < 32; ++e) {
        const int ce = __builtin_amdgcn_readlane(cnt, e), be = __builtin_amdgcn_readlane(base, e), end = be + (((ce + 255) >> 8) << 8);
        for (int r = be + ce + gw; r < end; r += NGW) { u32x2* orow = (u32x2*)(XS + (size_t)r * 1024);
#pragma unroll
            for (int j = 0; j < 4; ++j) orow[64 * j + lane] = (u32x2){0u, 0u};
            if (lane == 0) SLOTW[r] = 0.f; }
    }
}

struct GroupedOrder {
    int tend; int total; int G, c, NS;
    DI bool next(int i, pg8::Unit& u) const {
        const int L = i * G + c; if (L >= (total << NS)) return false;
        const int mt = L >> NS, j = L & ((1 << NS) - 1);
        const int e = __builtin_popcountll(__ballot(((int)(threadIdx.x & 63) < 32) && tend <= mt));
        u.pm = mt; u.pn = (e << NS) + j; return true;
    }
    DI void a_ready(const pg8::Unit&) const {}
    DI void done(const pg8::Unit&) const {}
};
struct EpiGateUp {
    static constexpr bool PERM = true, AFTER_DRAIN = false;
    const float* SLOTW; bf16_t* YS;
    DI void operator()(const pg8::f32x4 (&acc)[2][2][4][2], const pg8::Unit& u, int wr, int wc, int fr, int fq) const {
        const int f0 = (u.pn & 1) * 128 + wc * 32 + fq * 8;
#pragma unroll
        for (int ai = 0; ai < 2; ++ai)
#pragma unroll
            for (int m = 0; m < 4; ++m) {
                const int row = u.pm * 256 + ai * 128 + wr * 64 + m * 16 + fr;
                const float cw = SLOTW[row];
                float a[8];
#pragma unroll
                for (int i = 0; i < 4; ++i) {
                    const float g0 = acc[ai][0][m][0][i], g1 = acc[ai][0][m][1][i];
                    a[i] = g0 / (1.0f + __expf(-g0)) * acc[ai][1][m][0][i] * cw; a[4 + i] = g1 / (1.0f + __expf(-g1)) * acc[ai][1][m][1][i] * cw;
                }
                *(u32x4*)(YS + (size_t)row * 256 + f0) = (u32x4){pk2(a[0], a[1]), pk2(a[2], a[3]), pk2(a[4], a[5]), pk2(a[6], a[7])};
            }
    }
};
struct EpiDown {
    static constexpr bool PERM = true, AFTER_DRAIN = false;
    bf16_t* YO;
    DI void operator()(const pg8::f32x4 (&acc)[2][2][4][2], const pg8::Unit& u, int wr, int wc, int fr, int fq) const {
        const int c0 = (u.pn & 3) * 256 + wc * 32 + fq * 8;
#pragma unroll
        for (int ai = 0; ai < 2; ++ai)
#pragma unroll
            for (int m = 0; m < 4; ++m) {
                bf16_t* rowp = YO + (size_t)(u.pm * 256 + ai * 128 + wr * 64 + m * 16 + fr) * 1024 + c0;
#pragma unroll
                for (int bj = 0; bj < 2; ++bj) { const pg8::f32x4 v0 = acc[ai][bj][m][0], v1 = acc[ai][bj][m][1];
                    *(u32x4*)(rowp + bj * 128) = (u32x4){pk2(v0[0], v0[1]), pk2(v0[2], v0[3]), pk2(v1[0], v1[1]), pk2(v1[2], v1[3])}; }
            }
    }
};

DI void phase7(const Params& P, int gw, int NGW, int lane) {
    const bf16_t* YO = (const bf16_t*)(P.ws + WS_YO); const int* TOKP = (const int*)(P.ws + WS_TOKP); const f32x4* nf = (const f32x4*)P.in[22];
    for (int t = gw; t < MTOK; t += NGW) {
        f32x4* hr = (f32x4*)(P.out + (size_t)t * 1024);
        const u32x2* y0 = (const u32x2*)(YO + (size_t)TOKP[2 * t] * 1024); const u32x2* y1 = (const u32x2*)(YO + (size_t)TOKP[2 * t + 1] * 1024);
        f32x4 v[4]; float s = 0.f;
#pragma unroll
        for (int j = 0; j < 4; ++j) {
            v[j] = hr[64 * j + lane]; const u32x2 a = y0[64 * j + lane], c = y1[64 * j + lane];
            v[j].x += __uint_as_float(a.x << 16) + __uint_as_float(c.x << 16); v[j].y += __uint_as_float(a.x & 0xffff0000u) + __uint_as_float(c.x & 0xffff0000u);
            v[j].z += __uint_as_float(a.y << 16) + __uint_as_float(c.y << 16); v[j].w += __uint_as_float(a.y & 0xffff0000u) + __uint_as_float(c.y & 0xffff0000u);
            s += (v[j].x * v[j].x + v[j].y * v[j].y) + (v[j].z * v[j].z + v[j].w * v[j].w);
        }
        s = wave_sum(s);
        const float rs = 1.0f / sqrtf(s * (1.0f / 1024.0f) + EPS);
#pragma unroll
        for (int j = 0; j < 4; ++j) hr[64 * j + lane] = v[j] * rs * nf[64 * j + lane];
    }
}

#ifndef PHMASK
#define PHMASK 2047
#endif
#ifndef REPMASK
#define REPMASK 0
#endif
#define REP(bit) for (int rep_ = 0; rep_ < ((REPMASK & (bit)) ? 2 : 1); ++rep_)
#define REPSYNC(bit) if ((REPMASK & (bit)) && rep_ == 0) grid.sync()
typedef const __attribute__((address_space(4))) Params* KParams;
DI Params load_params(KParams kp) { Params p;
#pragma unroll
    for (int i = 0; i < 23; ++i) p.in[i] = kp->in[i];
    p.out = kp->out; p.ws = kp->ws; return p; }
__global__ void __launch_bounds__(NTHREADS, 2) hymba_fwd(Params Pin) {
    extern __shared__ __attribute__((aligned(16))) unsigned char lds_raw[];
    LAS unsigned char* lds = (LAS unsigned char*)lds_raw;
    cg::grid_group grid = cg::this_grid();
    const int G = gridDim.x, blk = blockIdx.x, NGW = G * NWAVES, NGT = G * NTHREADS;
#define PHASE_IDS() KParams kp_ = (KParams)__builtin_amdgcn_kernarg_segment_ptr(); asm volatile("" : "+s"(kp_)); const Params P = load_params(kp_); int tid = threadIdx.x; asm volatile("" : "+v"(tid)); const int lane = tid & 63, wave = __builtin_amdgcn_readfirstlane(tid >> 6), gw = blk * NWAVES + wave, gtid = blk * NTHREADS + tid; (void)lane; (void)gw; (void)gtid; (void)wave

    REP(1) { if (PHMASK & 1) { PHASE_IDS(); phase0(P, lds, gw, NGW, gtid, NGT, wave, lane); } REPSYNC(1); }
    grid.sync();
    REP(2) { if (PHMASK & 2) { PHASE_IDS();
        pg8::Gemm g{(const bf16_t*)(P.ws + WS_XB), (const bf16_t*)(P.ws + WS_WINT), MROWS, NPROJ, 1024};
        pg8::StaticOrder S; S.init(MROWS, NPROJ, G, blk);
        EpiInProj E{(const float*)(P.ws + WS_RS1), (const float*)(P.ws + WS_COS), (const float*)(P.ws + WS_SIN), P.in[10], P.in[11],
                    (bf16_t*)(P.ws + WS_QB), (bf16_t*)(P.ws + WS_KT), (bf16_t*)(P.ws + WS_VT), (bf16_t*)(P.ws + WS_QKVB), (bf16_t*)(P.ws + WS_ZB), (float*)(P.ws + WS_GB)};
        pg8::gemm_phase<EpiInProj, pg8::StaticOrder, true, true>(lds, g, S, E);
    } REPSYNC(2); }
    grid.sync();
    REP(4) { if (PHMASK & 4) { PHASE_IDS(); gdn_prep_phase(P, lds, blk, G, wave, lane); } REPSYNC(4); }
    grid.sync();
    REP(8) { if ((PHMASK & 8) && blk < 16) { PHASE_IDS(); gdn_scan(P, lds, blk, tid, wave, lane); } }
    REP(16) {
    if (PHMASK & 16) { PHASE_IDS(); attn_phase(P, lds, tid, wave, lane); }
    if ((REPMASK & 16) && rep_ == 0) { grid.sync(); if (blk == 0 && threadIdx.x == 0) { PHASE_IDS(); __hip_atomic_store((unsigned*)(P.ws + WS_CTL) + CW_ATTQ, 0u, __ATOMIC_RELAXED, __HIP_MEMORY_SCOPE_AGENT); } grid.sync(); }
    }
    grid.sync();
    REP(32) { if (PHMASK & 32) { PHASE_IDS();
        pg8::Gemm g{(const bf16_t*)(P.ws + WS_MIX), (const bf16_t*)(P.ws + WS_WOUT), MTOK, 1024, 1024};
        pg8::StaticOrder S; S.init(MTOK, 1024, G, blk);
        EpiOutProj E{P.in[0], P.out};
        pg8::gemm_phase<EpiOutProj, pg8::StaticOrder, true, true>(lds, g, S, E);
    } REPSYNC(32); }
    grid.sync();
    if (PHMASK & 64) { PHASE_IDS(); phase4a(P, lds, gw, NGW, wave, lane); }
    grid.sync();
    if (PHMASK & 128) { PHASE_IDS(); phase4b(P, gw, NGW, lane); }
    grid.sync();
    int cnt, base, tend, total; { PHASE_IDS(); expert_layout(P, lane, cnt, base, tend); total = __builtin_amdgcn_readlane(tend, 31); }
    REP(256) { if (PHMASK & 256) { PHASE_IDS();
        pg8::Gemm g{(const bf16_t*)(P.ws + WS_XS), (const bf16_t*)(P.ws + WS_WGU), XS_ROWS, 32 * 512, 1024};
        GroupedOrder S{tend, total, G, blk, 1};
        EpiGateUp E{(const float*)(P.ws + WS_SLOTW), (bf16_t*)(P.ws + WS_YS)};
        pg8::gemm_phase<EpiGateUp, GroupedOrder, true, true>(lds, g, S, E);
    } REPSYNC(256); }
    grid.sync();
    REP(512) { if (PHMASK & 512) { PHASE_IDS();
        int kd = 256; asm volatile("" : "+s"(kd));
        pg8::Gemm g{(const bf16_t*)(P.ws + WS_YS), (const bf16_t*)(P.ws + WS_WD), XS_ROWS, 32 * 1024, kd};
        GroupedOrder S{tend, total, G, blk, 2};
        EpiDown E{(bf16_t*)(P.ws + WS_YO)};
        pg8::gemm_phase<EpiDown, GroupedOrder, true, true>(lds, g, S, E);
    } REPSYNC(512); }
    grid.sync();
    if (PHMASK & 1024) { PHASE_IDS(); phase7(P, gw, NGW, lane); }
}

extern "C" void kernel_launch(void* const* d_in, const int* in_sizes, int n_in, void* d_out, int out_size, void* d_ws, size_t ws_size, hipStream_t stream) {
    static int grid_blocks = 0;
    if (grid_blocks == 0) {
        if (n_in != 23 || out_size != MTOK * DMODEL || ws_size < WS_END) { fprintf(stderr, "kernel_launch: unexpected shapes (n_in %d out %d ws %zu)\n", n_in, out_size, ws_size); grid_blocks = -1; return; }
        int dev = 0, cus = 0, per_cu = 0;
        hipGetDevice(&dev);
        hipDeviceGetAttribute(&cus, hipDeviceAttributeMultiprocessorCount, dev);
        hipFuncSetAttribute((const void*)hymba_fwd, hipFuncAttributeMaxDynamicSharedMemorySize, LDS_BYTES);
        hipOccupancyMaxActiveBlocksPerMultiprocessor(&per_cu, (const void*)hymba_fwd, NTHREADS, LDS_BYTES);
        if (per_cu < 1) { fprintf(stderr, "kernel_launch: occupancy query says %d blocks/CU\n", per_cu); per_cu = 1; }
        grid_blocks = cus;
        (void)hipGetLastError();
    }
    if (grid_blocks < 0) return;
    hipMemsetAsync((char*)d_ws + WS_CTL, 0, CTL_BYTES, stream);
    Params p{};
    for (int i = 0; i < 23; ++i) p.in[i] = (const float*)d_in[i];
    p.out = (float*)d_out; p.ws = (unsigned char*)d_ws;
    void* args[] = {&p};
    hipError_t e = hipLaunchCooperativeKernel((const void*)hymba_fwd, dim3(grid_blocks), dim3(NTHREADS), args, LDS_BYTES, stream);
    if (e != hipSuccess) fprintf(stderr, "cooperative launch failed: %s (grid %d)\n", hipGetErrorString(e), grid_blocks);
}
```

```cpp
#include <hip/hip_runtime.h>
#include <hip/hip_cooperative_groups.h>
#include <cstdio>
#include <cstdint>
namespace cg = cooperative_groups;
namespace pg8 {
#define PG8_LAS __attribute__((address_space(3)))
typedef unsigned short bf16_t;
typedef short bf16x8 __attribute__((ext_vector_type(8)));
typedef float f32x4 __attribute__((ext_vector_type(4)));
typedef unsigned u32x4 __attribute__((ext_vector_type(4)));
constexpr int BM = 256, BK = 64, HALF = 128, HTB = HALF * BK * 2  , STAGE_BYTES = 8 * HTB, NXCD = 8, WGM = 8;

__host__ __device__ __forceinline__ int lds_byte(int r, int c) { const int st = (r >> 4) * 2 + (c >> 5), rr = r & 15, cc = c & 31, ob = rr * 64 + cc * 2; return st * 1024 + (ob ^ (((ob >> 9) & 1) << 5)); }
__host__ __device__ __forceinline__ void stage_rc(int b, int& R, int& C) { const int st = b / 1024, sb = b % 1024, swz = sb ^ (((sb >> 9) & 1) << 5); R = (st >> 1) * 16 + swz / 64; C = (st & 1) * 32 + (swz % 64) / 2; }
__host__ __device__ __forceinline__ int perm32(int rho) { const int n = rho >> 4, i = rho & 15; return 8 * (i >> 2) + 4 * n + (i & 3); }

struct Unit { int pm, pn; };
struct Gemm { const bf16_t* A; const bf16_t* Bt; int M, N, K; };

struct StaticOrder {
    int nM, nN, nwg, G, c;
    __host__ __device__ void init(int M, int N, int G_, int c_) { nM = M / BM; nN = N / BM; nwg = nM * nN; G = G_; c = c_; }
    __host__ __device__ bool next(int i, Unit& u) const {
        const long L = (long)i * G + c; if (L >= nwg) return false;
        int wgid = (int)L; { const int q = nwg / NXCD, r = nwg % NXCD, xcd = wgid % NXCD, off = wgid / NXCD; wgid = (xcd < r ? xcd * (q + 1) : r * (q + 1) + (xcd - r) * q) + off; }
        const int nig = WGM * nN, gid = wgid / nig, fm = gid * WGM, gsz = (nM - fm) < WGM ? (nM - fm) : WGM;
        u.pm = fm + ((wgid % nig) % gsz); u.pn = (wgid % nig) / gsz; return true;
    }
    __device__ __forceinline__ void a_ready(const Unit&) const {}
    __device__ __forceinline__ void done(const Unit&) const {}
};

__device__ __forceinline__ unsigned cvt_pk_bf16(float lo, float hi) { unsigned r; asm volatile("v_cvt_pk_bf16_f32 %0, %1, %2" : "=v"(r) : "v"(lo), "v"(hi)); return r; }
typedef float f32x2 __attribute__((ext_vector_type(2)));
template <class Epi, class Sched, bool ALIGN_EPI = false, bool SP2 = false>
__device__ __forceinline__ void gemm_phase(PG8_LAS unsigned char* lds, const Gemm g, const Sched& S, const Epi& E) {
    int tid_o = threadIdx.x; asm volatile("" : "+v"(tid_o));
    const int tid = tid_o, wid = __builtin_amdgcn_readfirstlane(tid >> 6), lane = tid & 63, wr = wid >> 2, wc = wid & 3, fr = lane & 15, fq = lane >> 4;
    const int K = g.K, nt = K / BK;
    unsigned voffA[2], voffB[2];
#pragma unroll
    for (int i = 0; i < 2; ++i) { int R, C; stage_rc(tid * 16 + i * 8192, R, C); const int Rb = Epi::PERM ? ((R & ~31) + perm32(R & 31)) : R;
        voffA[i] = (unsigned)(R * K + C) * 2u; voffB[i] = (unsigned)(Rb * K + C) * 2u; }
    const size_t kstep = (size_t)(BK * 2);
    const size_t hstep = (size_t)HALF * K * 2;
    const size_t tstep = 2 * hstep;
    const unsigned ldsw = (unsigned)wid * 1024u;
    const int aoff = lds_byte(wr * 64 + fr, fq * 8), boff = lds_byte(wc * 32 + fr, fq * 8);
#define PG8_SA(b, h) (((b) * 2 + (h)) * HTB)
#define PG8_SB(b, h) ((4 + (b) * 2 + (h)) * HTB)
#define PG8_STAGE(bufoff, gbase, voff) do { _Pragma("unroll") for (int _i = 0; _i < 2; ++_i) \
        __builtin_amdgcn_global_load_lds((const unsigned*)((const char*)(gbase) + (voff)[_i]), (PG8_LAS unsigned*)(lds + (bufoff) + ldsw + _i * 8192), 16, 0, 0); } while (0)
#define PG8_LDA(dst, b, h) do { _Pragma("unroll") for (int m = 0; m < 4; ++m) _Pragma("unroll") for (int k = 0; k < 2; ++k) dst[m][k] = *(const PG8_LAS bf16x8*)(lds + PG8_SA(b, h) + aoff + m * 2048 + k * 1024); } while (0)
#define PG8_LDB(dst, b, h) do { _Pragma("unroll") for (int n = 0; n < 2; ++n) _Pragma("unroll") for (int k = 0; k < 2; ++k) dst[n][k] = *(const PG8_LAS bf16x8*)(lds + PG8_SB(b, h) + boff + n * 2048 + k * 1024); } while (0)
#define PG8_MMA(ai, bj, At, Bt) do { __builtin_amdgcn_s_setprio(1); _Pragma("unroll") for (int m = 0; m < 4; ++m) _Pragma("unroll") for (int n = 0; n < 2; ++n) _Pragma("unroll") for (int k = 0; k < 2; ++k) \
        acc[ai][bj][m][n] = __builtin_amdgcn_mfma_f32_16x16x32_bf16(Bt[n][k], At[m][k], acc[ai][bj][m][n], 0, 0, 0); __builtin_amdgcn_s_setprio(0); } while (0)
#define PG8_WAIT_V(n) asm volatile("s_waitcnt vmcnt(" #n ")" ::: "memory")
#define PG8_WAIT_L(n) asm volatile("s_waitcnt lgkmcnt(" #n ")" ::: "memory")
#define PG8_BAR __builtin_amdgcn_s_barrier()
#define PG8_SCHED __builtin_amdgcn_sched_barrier(0)
    Unit cur, nxt; int ui = 0;
    if (!S.next(0, cur)) return;
    f32x4 acc[2][2][4][2];
#pragma unroll
    for (int a = 0; a < 2; ++a)
#pragma unroll
        for (int b = 0; b < 2; ++b)
#pragma unroll
            for (int m = 0; m < 4; ++m)
#pragma unroll
                for (int n = 0; n < 2; ++n) acc[a][b][m][n] = (f32x4){0.f, 0.f, 0.f, 0.f};
    bf16x8 At[4][2], B0[2][2], B1[2][2];
    const char* cA = (const char*)g.A + (size_t)cur.pm * tstep; const char* cB = (const char*)g.Bt + (size_t)cur.pn * tstep;
    S.a_ready(cur);
    if constexpr (SP2) {
        PG8_STAGE(PG8_SB(0, 0), cB, voffB); PG8_STAGE(PG8_SB(0, 1), cB + hstep, voffB); PG8_STAGE(PG8_SA(0, 0), cA, voffA); PG8_STAGE(PG8_SA(0, 1), cA + hstep, voffA);
        if (wr == 1) PG8_BAR;
        PG8_WAIT_V(2); PG8_BAR;
        PG8_STAGE(PG8_SB(1, 0), cB + kstep, voffB); PG8_STAGE(PG8_SA(1, 0), cA + kstep, voffA); PG8_STAGE(PG8_SB(1, 1), cB + hstep + kstep, voffB);
        PG8_WAIT_V(6); PG8_BAR;
    } else {
        PG8_STAGE(PG8_SB(0, 0), cB, voffB); PG8_STAGE(PG8_SA(0, 0), cA, voffA); PG8_STAGE(PG8_SB(0, 1), cB + hstep, voffB); PG8_STAGE(PG8_SA(0, 1), cA + hstep, voffA);
        if (wr == 1) PG8_BAR;
        PG8_WAIT_V(4); PG8_BAR;
        PG8_STAGE(PG8_SB(1, 0), cB + kstep, voffB); PG8_STAGE(PG8_SA(1, 0), cA + kstep, voffA); PG8_STAGE(PG8_SB(1, 1), cB + hstep + kstep, voffB);
        PG8_WAIT_V(6); PG8_BAR;
    }
    for (;;) {
        const bool has_next = S.next(ui + 1, nxt);
        const char* nA = has_next ? (const char*)g.A + (size_t)nxt.pm * tstep : cA; const char* nB = has_next ? (const char*)g.Bt + (size_t)nxt.pn * tstep : cB;
        for (int t = 0; t < nt; t += 2) {
            const bool last = (t == nt - 2);
            const char* a1 = cA + (size_t)(t + 1) * kstep;
            const char* a2 = last ? nA : cA + (size_t)(t + 2) * kstep; const char* b2 = last ? nB : cB + (size_t)(t + 2) * kstep;
            const char* a3 = a2 + kstep; const char* b3 = b2 + kstep;
            if (last && has_next) S.a_ready(nxt);
            if constexpr (SP2) {
            PG8_LDB(B0, 0, 0); PG8_LDB(B1, 0, 1); PG8_SCHED; PG8_LDA(At, 0, 0); PG8_STAGE(PG8_SA(1, 1), a1 + hstep, voffA);
            PG8_WAIT_V(8); PG8_WAIT_L(0); PG8_BAR; PG8_MMA(0, 0, At, B0); PG8_MMA(0, 1, At, B1); PG8_BAR; PG8_SCHED;
            PG8_LDA(At, 0, 1); PG8_STAGE(PG8_SB(0, 0), b2, voffB); PG8_STAGE(PG8_SB(0, 1), b2 + hstep, voffB); PG8_STAGE(PG8_SA(0, 0), a2, voffA);
            PG8_WAIT_V(8); PG8_WAIT_L(0); PG8_BAR; PG8_MMA(1, 0, At, B0); PG8_MMA(1, 1, At, B1); PG8_BAR; PG8_SCHED;
            PG8_LDB(B0, 1, 0); PG8_LDB(B1, 1, 1); PG8_SCHED; PG8_LDA(At, 1, 0); PG8_STAGE(PG8_SA(0, 1), a2 + hstep, voffA);
            PG8_WAIT_V(8); PG8_WAIT_L(0); PG8_BAR; PG8_MMA(0, 0, At, B0); PG8_MMA(0, 1, At, B1); PG8_BAR; PG8_SCHED;
            PG8_LDA(At, 1, 1); PG8_STAGE(PG8_SB(1, 0), b3, voffB); PG8_STAGE(PG8_SB(1, 1), b3 + hstep, voffB); PG8_STAGE(PG8_SA(1, 0), a3, voffA);
            PG8_WAIT_V(8); PG8_WAIT_L(0); PG8_BAR; PG8_MMA(1, 0, At, B0); PG8_MMA(1, 1, At, B1); PG8_BAR; PG8_SCHED;
            } else {
            PG8_LDB(B0, 0, 0); PG8_SCHED; PG8_LDA(At, 0, 0); PG8_STAGE(PG8_SA(1, 1), a1 + hstep, voffA);
            PG8_WAIT_L(8); PG8_BAR; PG8_WAIT_L(0); PG8_MMA(0, 0, At, B0); PG8_BAR; PG8_SCHED;
            PG8_LDB(B1, 0, 1); PG8_STAGE(PG8_SB(0, 0), b2, voffB);
            PG8_BAR; PG8_WAIT_L(0); PG8_MMA(0, 1, At, B1); PG8_BAR;
            PG8_LDA(At, 0, 1); PG8_STAGE(PG8_SA(0, 0), a2, voffA);
            PG8_BAR; PG8_WAIT_L(0); PG8_MMA(1, 0, At, B0); PG8_BAR; PG8_SCHED;
            PG8_STAGE(PG8_SB(0, 1), b2 + hstep, voffB);
            PG8_WAIT_V(6); PG8_BAR; PG8_MMA(1, 1, At, B1); PG8_BAR;
            PG8_LDB(B0, 1, 0); PG8_SCHED; PG8_LDA(At, 1, 0); PG8_STAGE(PG8_SA(0, 1), a2 + hstep, voffA);
            PG8_WAIT_L(8); PG8_BAR; PG8_WAIT_L(0); PG8_MMA(0, 0, At, B0); PG8_BAR; PG8_SCHED;
            PG8_LDB(B1, 1, 1); PG8_STAGE(PG8_SB(1, 0), b3, voffB);
            PG8_BAR; PG8_WAIT_L(0); PG8_MMA(0, 1, At, B1); PG8_BAR;
            PG8_LDA(At, 1, 1); PG8_STAGE(PG8_SA(1, 0), a3, voffA);
            PG8_BAR; PG8_WAIT_L(0); PG8_MMA(1, 0, At, B0); PG8_BAR; PG8_SCHED;
            PG8_STAGE(PG8_SB(1, 1), b3 + hstep, voffB);
            PG8_WAIT_V(6); PG8_BAR; PG8_MMA(1, 1, At, B1); PG8_BAR;
            }
        }
        if constexpr (ALIGN_EPI) { if (wr == 0) PG8_BAR; }
        if constexpr (!Epi::AFTER_DRAIN) { E(acc, cur, wr, wc, fr, fq); S.done(cur); }
        if (!has_next) break;
#pragma unroll
        for (int a = 0; a < 2; ++a)
#pragma unroll
            for (int b = 0; b < 2; ++b)
#pragma unroll
                for (int m = 0; m < 4; ++m)
#pragma unroll
                    for (int n = 0; n < 2; ++n) acc[a][b][m][n] = (f32x4){0.f, 0.f, 0.f, 0.f};
        cur = nxt; cA = nA; cB = nB; ++ui;
        if constexpr (ALIGN_EPI) { if (wr == 1) PG8_BAR; }
    }
    PG8_WAIT_V(0);
    if constexpr (!ALIGN_EPI) { if (wr == 0) PG8_BAR; }
    PG8_BAR;
    if constexpr (Epi::AFTER_DRAIN) { E.fused(acc, cur, wr, wc, fr, fq, lds, wid, lane); S.done(cur); }
#undef PG8_SA
#undef PG8_SB
#undef PG8_STAGE
#undef PG8_LDA
#undef PG8_LDB
#undef PG8_MMA
#undef PG8_WAIT_V
#undef PG8_WAIT_L
#undef PG8_BAR
#undef PG8_SCHED
}
}

#define DI __device__ __forceinline__
#define LAS __attribute__((address_space(3)))
typedef unsigned short bf16_t;
typedef short bf16x8 __attribute__((ext_vector_type(8)));
typedef short s16x4 __attribute__((ext_vector_type(4)));
typedef short v4i16_t __attribute__((ext_vector_type(4)));
typedef float f32x4 __attribute__((ext_vector_type(4)));
typedef float f32x16 __attribute__((ext_vector_type(16)));
typedef unsigned u32x4 __attribute__((ext_vector_type(4)));
typedef unsigned u32x2 __attribute__((ext_vector_type(2)));
typedef float f32x2_t __attribute__((ext_vector_type(2)));
typedef __bf16 bf16x2_t __attribute__((ext_vector_type(2)));

constexpr int NWAVES = 8, NTHREADS = 512;
constexpr int SEQ = 8192, DMODEL = 1024, NMETA = 16, LTOK = SEQ + NMETA  , LP = 8256  , NCHUNK = 129;
constexpr int MTOK = 2 * SEQ;
constexpr int MROWS = 16640;
constexpr int NPROJ = 3840;
constexpr int NKT = 129;
constexpr float EPS = 1e-6f;
constexpr float C2Q = 0.125f * 1.4426950408889634f;
constexpr int XS_ROWS = 41216;

constexpr size_t MiB = 1u << 20;
constexpr size_t WS_CTL = 0, CTL_BYTES = 1 * MiB;
constexpr size_t WS_RS1 = 1 * MiB;
constexpr size_t WS_RS2 = WS_RS1 + 128 * 1024;
constexpr size_t WS_TOKE = WS_RS2 + 128 * 1024;
constexpr size_t WS_TOKW = WS_TOKE + 128 * 1024;
constexpr size_t WS_TOKP = WS_TOKW + 128 * 1024;
constexpr size_t WS_SLOTW = WS_TOKP + 128 * 1024;
constexpr size_t WS_WR = WS_SLOTW + 192 * 1024;
constexpr size_t WS_GL = WS_WR + 160 * 1024;
constexpr size_t WS_COS = 2 * MiB;
constexpr size_t WS_SIN = WS_COS + 1280 * 1024;
constexpr size_t WS_GB = WS_SIN + 1280 * 1024;
constexpr size_t WS_WOUT = 6 * MiB;
constexpr size_t WS_WINT = 8 * MiB;
constexpr size_t WS_XB = WS_WINT + (size_t)NPROJ * 1024 * 2;
constexpr size_t WS_MIX = 8 * MiB;
constexpr size_t WS_QKVB = 48 * MiB;
constexpr size_t WS_QB = WS_QKVB + (size_t)2 * LP * 1536 * 2 + 128 * 1024;
constexpr size_t WS_KT = WS_QB + 16 * MiB;
constexpr size_t WS_VT = WS_KT + (size_t)16 * NKT * 4096 * 2;
constexpr size_t WS_ZB = WS_VT + (size_t)8 * NKT * 8192 * 2;
constexpr size_t WS_GP = WS_ZB + (size_t)2 * LP * 512 * 2;
constexpr size_t GP_ARR = (size_t)2064 * 4096 * 2;
constexpr size_t WS_GP_END = WS_GP + 5 * GP_ARR;
constexpr size_t WS_WGU = 48 * MiB;
constexpr size_t WS_WD = 80 * MiB;
constexpr size_t WS_XS = 96 * MiB;
constexpr size_t WS_YO = 96 * MiB;
constexpr size_t WS_YS = WS_XS + (size_t)XS_ROWS * 1024 * 2;
constexpr size_t WS_END = 256 * MiB;
static_assert(WS_GB + (size_t)2 * LP * 16 * 4 <= WS_WOUT, "small region");
static_assert(WS_XB + (size_t)MROWS * 1024 * 2 <= WS_QKVB, "XB");
static_assert(WS_GP_END <= WS_END, "GDN prep arrays");
static_assert(WS_YS + (size_t)XS_ROWS * 256 * 2 <= WS_END, "YS");
static_assert(WS_WD + (size_t)32 * 1024 * 256 * 2 <= WS_XS, "WD");
constexpr int CW_ATTQ = 0;
constexpr int CW_CNT = 64;

constexpr int LDS_BYTES = 147456;

struct Params { const float* in[23]; float* out; unsigned char* ws; };

DI unsigned f2bf(float f) { unsigned u = __float_as_uint(f); return (u + 0x7fffu + ((u >> 16) & 1u)) >> 16; }
DI unsigned pk2(float lo, float hi) { f32x2_t v = {lo, hi}; bf16x2_t b = __builtin_convertvector(v, bf16x2_t); return __builtin_bit_cast(unsigned, b); }
DI float bf2f(unsigned short h) { return __uint_as_float(((unsigned)h) << 16); }
DI float rlane(float v, int l) { return __int_as_float(__builtin_amdgcn_readlane(__float_as_int(v), l)); }
#define DPP_ADD(v, ctrl) ((v) + __int_as_float(__builtin_amdgcn_update_dpp(0, __float_as_int(v), (ctrl), 0xF, 0xF, true)))
DI float wave_sum_dpp(float v) {
    v = DPP_ADD(v, 0xB1);
    v = DPP_ADD(v, 0x4E);
    v = DPP_ADD(v, 0x141);
    v = DPP_ADD(v, 0x140);
    return (rlane(v, 0) + rlane(v, 16)) + (rlane(v, 32) + rlane(v, 48));
}
DI float wave_sum(float v) { return wave_sum_dpp(v); }
DI float swz_xor16(float v) { return __int_as_float(__builtin_amdgcn_ds_swizzle(__float_as_int(v), 0x401F)); }
DI float row_sum16(float v) { v = DPP_ADD(v, 0xB1); v = DPP_ADD(v, 0x4E); v = DPP_ADD(v, 0x141); v = DPP_ADD(v, 0x140); return v; }
DI float half_sum32(float v) { v = row_sum16(v); return v + swz_xor16(v); }
DI float swap32_add(float v) { auto rr = __builtin_amdgcn_permlane32_swap(__float_as_uint(v), __float_as_uint(v), false, false); return __uint_as_float(rr[0]) + __uint_as_float(rr[1]); }
DI float swap32_max(float v) { auto rr = __builtin_amdgcn_permlane32_swap(__float_as_uint(v), __float_as_uint(v), false, false); return fmaxf(__uint_as_float(rr[0]), __uint_as_float(rr[1])); }
#define LDS_WAIT() asm volatile("s_waitcnt lgkmcnt(0)" ::: "memory")
#define BAR_LDS() do { asm volatile("s_waitcnt lgkmcnt(0)" ::: "memory"); __builtin_amdgcn_s_barrier(); asm volatile("" ::: "memory"); } while (0)
#define MFMA32(a, b, c) __builtin_amdgcn_mfma_f32_32x32x16_bf16((a), (b), (c), 0, 0, 0)
DI int crow(int r, int hi) { return (r & 3) + 8 * (r >> 2) + 4 * hi; }
DI int perm16(int x) { return (x & ~12) | ((x & 4) << 1) | ((x & 8) >> 1); }
DI bf16x8 pack8(const f32x16& x, int s) {
    u32x4 p; p.x = pk2(x[8 * s], x[8 * s + 1]); p.y = pk2(x[8 * s + 2], x[8 * s + 3]); p.z = pk2(x[8 * s + 4], x[8 * s + 5]); p.w = pk2(x[8 * s + 6], x[8 * s + 7]);
    return __builtin_bit_cast(bf16x8, p);
}
DI int orig_col(int n) {
    if (n >= 1024) return n;
    const int hh = n >> 6, c2 = n & 63, g8 = c2 >> 3, i = c2 & 7;
    return (hh << 6) + ((i < 4) ? 4 * g8 + i : 32 + 4 * g8 + (i - 4));
}
DI size_t kt_off(int b, int hh, int p, int d) {
    const int tile = p < 16 ? 0 : 1 + ((p - 16) >> 6), kv = p < 16 ? p : ((p - 16) & 63);
    return ((size_t)((b * 8 + hh) * NKT + tile) << 12) + ((d >> 3) << 9) + (kv << 3) + (d & 7);
}
DI size_t vt_off(int b, int h, int p, int d) {
    const int tile = p < 16 ? 0 : 1 + ((p - 16) >> 6), kv = p < 16 ? p : ((p - 16) & 63);
    return ((size_t)((b * 4 + h) * NKT + tile) << 13) + ((d >> 5) << 11) + ((kv >> 4) << 9) + ((kv & 15) << 5) + (d & 31);
}

template <class Src> DI void transpose_item(const Src& src, bf16_t* WT, size_t ldk, int k0, int n0, LAS float* scr, int lane) {
#pragma unroll 8
    for (int i = 0; i < 32; ++i) { const int kk = 2 * i + (lane >> 5); scr[kk * 33 + (lane & 31)] = src(k0 + kk, n0 + (lane & 31)); }
    LDS_WAIT();
    const int c = lane & 7;
#pragma unroll
    for (int j = 0; j < 4; ++j) { const int n = (lane >> 3) + 8 * j; const LAS float* s = scr + (8 * c) * 33 + n;
        u32x4 o; o.x = pk2(s[0 * 33], s[1 * 33]); o.y = pk2(s[2 * 33], s[3 * 33]); o.z = pk2(s[4 * 33], s[5 * 33]); o.w = pk2(s[6 * 33], s[7 * 33]);
        *(u32x4*)(WT + (size_t)(n0 + n) * ldk + k0 + 8 * c) = o; }
    LDS_WAIT();
}
struct SrcWin { const float* w; const float* g; DI float operator()(int k, int n) const { return n >= 3600 ? 0.f : w[(size_t)k * 3600 + orig_col(n)] * g[k]; } };
struct SrcPlain { const float* w; int N; DI float operator()(int k, int n) const { return w[(size_t)k * N + n]; } };
struct SrcGU { const float* w; const float* g; int fadj; DI float operator()(int k, int n) const { return w[(size_t)k * 256 + n + fadj] * g[k]; } };

DI void phase0(const Params& P, LAS unsigned char* lds, int gw, int NGW, int gtid, int NGT, int wave, int lane) {
    LAS float* scr = (LAS float*)(lds + wave * 16384);
    bf16_t* WINT = (bf16_t*)(P.ws + WS_WINT); bf16_t* WOUT = (bf16_t*)(P.ws + WS_WOUT); bf16_t* XB = (bf16_t*)(P.ws + WS_XB);
    float* RS1 = (float*)(P.ws + WS_RS1);
    constexpr int I_IN = 16 * (NPROJ / 32), I_OUT = 16 * 32;
    const SrcWin sw{P.in[3], P.in[2]}; const SrcPlain so{P.in[13], 1024};
    for (int it = gw; it < I_IN + I_OUT; it += NGW) {
        if (it < I_IN) transpose_item(sw, WINT, 1024, (it / (NPROJ / 32)) * 64, (it % (NPROJ / 32)) * 32, scr, lane);
        else { const int r = it - I_IN; transpose_item(so, WOUT, 1024, (r >> 5) * 64, (r & 31) * 32, scr, lane); }
    }
    const float* x = P.in[0]; const float* meta = P.in[1];
    for (int m = gw; m < MROWS; m += NGW) {
        u32x2* orow = (u32x2*)(XB + (size_t)m * 1024);
        if (m >= MTOK + NMETA) {
#pragma unroll
            for (int j = 0; j < 4; ++j) orow[64 * j + lane] = (u32x2){0u, 0u};
            if (lane == 0) RS1[m] = 0.f;
            continue;
        }
        const f32x4* xr = (const f32x4*)((m < MTOK) ? x + (size_t)m * 1024 : meta + (size_t)(m - MTOK) * 1024);
        f32x4 v[4]; float s = 0.f;
#pragma unroll
        for (int j = 0; j < 4; ++j) { v[j] = xr[64 * j + lane]; s += (v[j].x * v[j].x + v[j].y * v[j].y) + (v[j].z * v[j].z + v[j].w * v[j].w); }
        s = wave_sum(s);
        if (lane == 0) RS1[m] = 1.0f / sqrtf(s * (1.0f / 1024.0f) + EPS);
#pragma unroll
        for (int j = 0; j < 4; ++j) orow[64 * j + lane] = (u32x2){pk2(v[j].x, v[j].y), pk2(v[j].z, v[j].w)};
    }
    float* COS = (float*)(P.ws + WS_COS); float* SIN = (float*)(P.ws + WS_SIN);
    for (int i = gtid; i < LTOK * 32; i += NGT) {
        const int p = i >> 5, f = i & 31;
        const float inv = exp2f(-(float)f * (13.287712379549449f / 32.0f));
        const float ang = (float)p * inv;
        COS[i] = cosf(ang); SIN[i] = sinf(ang);
    }
    float* WR = (float*)(P.ws + WS_WR); const float* gf = P.in[14]; const float* wgrp = P.in[15]; const float* wrt = P.in[17];
    for (int i = gtid; i < 36 * 1024; i += NGT) { const int j = i >> 10, k = i & 1023; WR[i] = gf[k] * (j < 4 ? wgrp[k * 4 + j] : wrt[k * 32 + (j - 4)]); }
}

struct EpiInProj {
    static constexpr bool PERM = true, AFTER_DRAIN = false;
    const float* RS1; const float* COS; const float* SIN; const float* a_log; const float* dt_bias;
    bf16_t* QB; bf16_t* KT; bf16_t* VT; bf16_t* QKVB; bf16_t* ZB; float* GB;
    DI void operator()(const pg8::f32x4 (&acc)[2][2][4][2], const pg8::Unit& u, int wr, int wc, int fr, int fq) const {
        const int pn = u.pn;
#pragma unroll
        for (int ai = 0; ai < 2; ++ai)
#pragma unroll
            for (int m = 0; m < 4; ++m) {
                const int row = u.pm * 256 + ai * 128 + wr * 64 + m * 16 + fr;
                if (row < MTOK + NMETA) {
                    const float rs = RS1[row];
                    const bool meta = row >= MTOK;
                    const int p = meta ? row - MTOK : (row & 8191) + NMETA;
                    const int b0 = meta ? 0 : (row >> 13), nb = meta ? 2 : 1;
#pragma unroll
                    for (int bj = 0; bj < 2; ++bj) {
                        float xv[8];
#pragma unroll
                        for (int i = 0; i < 4; ++i) { xv[i] = acc[ai][bj][m][0][i] * rs; xv[4 + i] = acc[ai][bj][m][1][i] * rs; }
                        if (pn < 4) {
                            const int hh = (pn & 1) * 4 + bj * 2 + (wc >> 1), d0 = 4 * (4 * (wc & 1) + fq);
                            const f32x4 cs = *(const f32x4*)(COS + p * 32 + d0), sn = *(const f32x4*)(SIN + p * 32 + d0);
                            float lo[4], hi[4];
#pragma unroll
                            for (int i = 0; i < 4; ++i) { lo[i] = xv[i] * cs[i] - xv[4 + i] * sn[i]; hi[i] = xv[4 + i] * cs[i] + xv[i] * sn[i]; }
                            if (pn < 2) {
                                if (!meta) {
                                    bf16_t* q = QB + ((size_t)((b0 * 8 + hh) * SEQ + (p - NMETA)) << 6) + d0;
                                    *(u32x2*)q = (u32x2){pk2(lo[0] * C2Q, lo[1] * C2Q), pk2(lo[2] * C2Q, lo[3] * C2Q)};
                                    *(u32x2*)(q + 32) = (u32x2){pk2(hi[0] * C2Q, hi[1] * C2Q), pk2(hi[2] * C2Q, hi[3] * C2Q)};
                                }
                            } else {
                                for (int bb = b0; bb < b0 + nb; ++bb) {
                                    *(u32x2*)(KT + kt_off(bb, hh, p, d0)) = (u32x2){pk2(lo[0], lo[1]), pk2(lo[2], lo[3])};
                                    *(u32x2*)(KT + kt_off(bb, hh, p, d0 + 32)) = (u32x2){pk2(hi[0], hi[1]), pk2(hi[2], hi[3])};
                                }
                            }
                        } else {
                            const u32x4 w = (u32x4){pk2(xv[0], xv[1]), pk2(xv[2], xv[3]), pk2(xv[4], xv[5]), pk2(xv[6], xv[7])};
                            const int cl = bj * 128 + wc * 32 + fq * 8;
                            if (pn < 6) {
                                const int h = (pn - 4) * 2 + bj, d = wc * 32 + fq * 8;
                                for (int bb = b0; bb < b0 + nb; ++bb) *(u32x4*)(VT + vt_off(bb, h, p, d)) = w;
                            } else if (pn < 12) {
                                for (int bb = b0; bb < b0 + nb; ++bb) *(u32x4*)(QKVB + (size_t)(bb * LP + p) * 1536 + (pn - 6) * 256 + cl) = w;
                            } else if (pn < 14) {
                                float sz[8];
#pragma unroll
                                for (int i = 0; i < 8; ++i) sz[i] = xv[i] * __builtin_amdgcn_rcpf(1.0f + __expf(-xv[i]));
                                const u32x4 wz = (u32x4){pk2(sz[0], sz[1]), pk2(sz[2], sz[3]), pk2(sz[4], sz[5]), pk2(sz[6], sz[7])};
                                for (int bb = b0; bb < b0 + nb; ++bb) *(u32x4*)(ZB + (size_t)(bb * LP + p) * 512 + (pn - 12) * 256 + cl) = wz;
                            } else if (cl < 16) {
                                float o[8];
                                if (cl == 0) {
#pragma unroll
                                    for (int i = 0; i < 8; ++i) { const float t = xv[i] + dt_bias[i]; const float sp = t > 20.f ? t : log1pf(expf(t)); o[i] = -expf(a_log[i]) * sp; }
                                } else {
#pragma unroll
                                    for (int i = 0; i < 8; ++i) o[i] = 1.0f / (1.0f + expf(-xv[i]));
                                }
                                for (int bb = b0; bb < b0 + nb; ++bb) { float* g = GB + ((size_t)(bb * LP + p) << 4) + cl;
                                    *(f32x4*)g = (f32x4){o[0], o[1], o[2], o[3]}; *(f32x4*)(g + 4) = (f32x4){o[4], o[5], o[6], o[7]}; }
                            }
                        }
                    }
                }
            }
    }
};

DI bf16x8 lds_frag(LAS const bf16_t* M, int row, int ch) { return *(LAS const bf16x8*)((LAS const unsigned char*)M + row * 128 + ((ch ^ (row & 7)) << 4)); }
DI bf16x8 lds_frag_plain(LAS const bf16_t* M, int row, int ch) { return *(LAS const bf16x8*)((LAS const unsigned char*)M + row * 128 + (ch << 4)); }
DI int swz_idx(int row, int d) { return row * 64 + ((((d >> 3) ^ (row & 7)) << 3) | (d & 7)); }

constexpr int PREP_PAIR = 35840;

template <int MAT> DI void prep_rows(const bf16_t* QKVB, const float* cw, int b, int h, int n, int lane, LAS const float* egS,
                                     LAS bf16_t* DS  , bf16_t* QG) {
    const int col = MAT * 512 + h * 64 + lane, p0 = n * 64;
    const float c0 = cw[col], c1 = cw[1536 + col], c2 = cw[3072 + col], c3 = cw[4608 + col];
    const bf16_t* rp = QKVB + (size_t)(b * LP + p0) * 1536 + col;
    float x0 = 0.f, x1 = 0.f, x2 = 0.f;
    if (n > 0) { x0 = bf2f(rp[-3 * 1536]); x1 = bf2f(rp[-2 * 1536]); x2 = bf2f(rp[-1 * 1536]); }
    const int nvalid = (LTOK - p0) < 64 ? (LTOK - p0) : 64;
#pragma unroll 4
    for (int c = 0; c < 64; ++c) {
        const bool valid = c < nvalid;
        const float x3 = valid ? bf2f(*rp) : 0.f;
        rp += 1536;
        float y = c0 * x0 + c1 * x1 + c2 * x2 + c3 * x3;
        y = y * __builtin_amdgcn_rcpf(1.0f + __expf(-y));
        if (!valid) y = 0.f;
        x0 = x1; x1 = x2; x2 = x3;
        if (MAT == 2) { DS[c * 64 + lane] = (bf16_t)f2bf(y); }
        else {
            const float ss = wave_sum(y * y);
            const float yn = y * __builtin_amdgcn_rsqf(ss + EPS);
            if (MAT == 0) {
                const float qn = yn * 0.125f;
                DS[c * 64 + lane] = (bf16_t)f2bf(qn);
                QG[c * 64 + perm16(lane)] = (bf16_t)f2bf(qn * egS[c]);
            } else {
                DS[c * 64 + lane] = (bf16_t)f2bf(yn);
            }
        }
    }
}

DI void solve_blocked(LAS const float* AST, LAS bf16_t* XB, LAS const float* scl, int lane, float sgn, bf16_t* out, int ocol) {
    for (int b = 0; b < 4; ++b) {
        float s[16];
#pragma unroll
        for (int r = 0; r < 16; ++r) s[r] = bf2f(XB[(16 * b + r) * 64 + lane]) * scl[16 * b + r];
        for (int j = 0; j < 16 * b; ++j) {
            const float xj = bf2f(XB[j * 64 + lane]);
            LAS const f32x4* ap = (LAS const f32x4*)(AST + j * 68 + 16 * b);
            const f32x4 a0 = ap[0], a1 = ap[1], a2 = ap[2], a3 = ap[3];
#pragma unroll
            for (int r = 0; r < 4; ++r) { s[r] -= a0[r] * xj; s[4 + r] -= a1[r] * xj; s[8 + r] -= a2[r] * xj; s[12 + r] -= a3[r] * xj; }
        }
#pragma unroll
        for (int jj = 0; jj < 15; ++jj) {
            const float xj = s[jj];
            LAS const float* ap = AST + (16 * b + jj) * 68 + 16 * b;
#pragma unroll
            for (int r = jj + 1; r < 16; ++r) s[r] -= ap[r] * xj;
        }
#pragma unroll
        for (int r = 0; r < 16; ++r) { XB[(16 * b + r) * 64 + lane] = (bf16_t)f2bf(s[r]); out[(16 * b + r) * 64 + ocol] = (bf16_t)f2bf(sgn * s[r]); }
    }
}

DI void gdn_prep_phase(const Params& P, LAS unsigned char* lds, int blk, int G, int wave, int lane_in) {
    const int pair = wave >> 1, role = wave & 1;
    LAS unsigned char* pb = lds + pair * PREP_PAIR;
    LAS bf16_t* QS = (LAS bf16_t*)pb; LAS bf16_t* KS = (LAS bf16_t*)(pb + 8192); LAS float* AS = (LAS float*)(pb + 16384);
    LAS float* gcS = (LAS float*)(pb + 16384 + 17408 + role * 1024); LAS float* betaS = gcS + 64; LAS float* egS = gcS + 128; LAS float* ekS = gcS + 192;
    const bf16_t* QKVB = (const bf16_t*)(P.ws + WS_QKVB); const float* GB = (const float*)(P.ws + WS_GB); const float* cw = P.in[9];
    const int NP = G * 4, NTASK = 2 * 8 * NCHUNK;
    for (int it = 0; it * NP < NTASK; ++it) {
        int lane = lane_in; asm volatile("" : "+v"(lane));
        const int r32 = lane & 31, hi = lane >> 5;
        const int task = it * NP + blk * 4 + pair;
        const bool active = task < NTASK;
        const int b = task / (8 * NCHUNK), h = (task / NCHUNK) & 7, n = task % NCHUNK;
        bf16_t* GPW = (bf16_t*)(P.ws + WS_GP) + (size_t)task * 4096; bf16_t* GPQG = GPW + GP_ARR / 2; bf16_t* GPAQK = GPQG + GP_ARR / 2; bf16_t* GPKGT = GPAQK + GP_ARR / 2; bf16_t* GPU = GPKGT + GP_ARR / 2;
        float gc = 0.f, beta = 0.f;
        if (active) {
            const int pl = n * 64 + lane;
            float g = 0.f;
            if (pl < LTOK) { const float* gb = GB + ((size_t)(b * LP + pl) << 4); g = gb[h]; beta = gb[8 + h]; }
            gcS[lane] = g; LDS_WAIT();
            gc = 0.f;
#pragma unroll
            for (int j4 = 0; j4 < 16; ++j4) { const f32x4 t = *(LAS const f32x4*)(gcS + 4 * j4);
                gc += (4 * j4 <= lane ? t[0] : 0.f) + (4 * j4 + 1 <= lane ? t[1] : 0.f) + (4 * j4 + 2 <= lane ? t[2] : 0.f) + (4 * j4 + 3 <= lane ? t[3] : 0.f); }
            const float glast = rlane(gc, 63);
            LDS_WAIT();
            gcS[lane] = gc; betaS[lane] = beta; egS[lane] = (role == 0) ? __expf(gc) : beta * __expf(gc); ekS[lane] = __expf(glast - gc);
            if (role == 0 && lane == 0) ((float*)(P.ws + WS_GL))[task] = __expf(glast);
            LDS_WAIT();
            if (role == 0) prep_rows<0>(QKVB, cw, b, h, n, lane, egS, QS, GPQG);
            else prep_rows<1>(QKVB, cw, b, h, n, lane, egS, KS, GPQG);
        }
        LDS_WAIT();
        __syncthreads();
        if (active) {
#pragma unroll
            for (int t4 = 0; t4 < 4; ++t4) {
                const int ct = t4 >> 1, st = t4 & 1;
                f32x16 acc = {};
                if (!(ct == 0 && st == 1)) {
#pragma unroll
                    for (int ks = 0; ks < 4; ++ks) {
                        const bf16x8 fa = lds_frag_plain(role == 0 ? QS : KS, 32 * ct + r32, 2 * ks + hi), fb = lds_frag_plain(KS, 32 * st + r32, 2 * ks + hi);
                        acc = MFMA32(fa, fb, acc);
                    }
                }
                const float gcs = gcS[32 * st + r32];
                bf16_t* aqb = GPAQK + hi * 256 + perm16(r32); LAS float* asb = AS + r32 * 68 + hi * 4;        LAS const float* gcb = gcS + hi * 4; LAS const float* beb = betaS + hi * 4;
                asm volatile("" : "+v"(aqb), "+v"(asb), "+v"(gcb), "+v"(beb));
#pragma unroll
                for (int i = 0; i < 16; ++i) {
                    const int cr = 32 * ct + (i & 3) + 8 * (i >> 2);
                    const int cmp = (32 * st + r32) - 4 * hi;
                    const float dec = __expf(gcb[cr] - gcs);
                    if (role == 0) aqb[cr * 64 + 32 * st] = (bf16_t)f2bf((cmp <= cr) ? acc[i] * dec : 0.f);
                    else asb[32 * st * 68 + cr] = (cmp < cr) ? acc[i] * beb[cr] * dec : 0.f;
                }
            }
        }
        LDS_WAIT();
        __syncthreads();
        if (active) {
            if (role == 0) {
                prep_rows<2>(QKVB, cw, b, h, n, lane, egS, QS  , GPQG);
                LDS_WAIT();
                solve_blocked(AS, QS, betaS, lane, 1.0f, GPU, lane);
            } else {
#pragma unroll
                for (int gq = 0; gq < 8; ++gq) {
                    float t[8];
#pragma unroll
                    for (int j = 0; j < 8; ++j) { const int c = perm16(8 * gq + j); t[j] = bf2f(KS[c * 64 + lane]) * ekS[c]; }
                    *(u32x4*)(GPKGT + lane * 64 + 8 * gq) = (u32x4){pk2(t[0], t[1]), pk2(t[2], t[3]), pk2(t[4], t[5]), pk2(t[6], t[7])};
                }
                solve_blocked(AS, KS, egS, lane, -1.0f, GPW, perm16(lane));
            }
        }
        LDS_WAIT();
    }
}

constexpr int GS_STAGE = 40960 + 256;
constexpr int GS_OBUF = 2 * GS_STAGE;
static_assert(GS_OBUF + 32768 <= 131072, "gdn scan LDS");

#define GS_STEP(n, HW, HGW, STGW) do { \
        if (wave < 2) { \
            if (n < NCHUNK) { \
                LAS const unsigned char* sg = lds + (n & 1) * GS_STAGE; \
                LAS const bf16_t* Wm = (LAS const bf16_t*)sg; LAS const bf16_t* QGm = (LAS const bf16_t*)(sg + 8192); LAS const bf16_t* AQm = (LAS const bf16_t*)(sg + 16384); \
                LAS const bf16_t* KGm = (LAS const bf16_t*)(sg + 24576); LAS const bf16_t* Um = (LAS const bf16_t*)(sg + 32768); \
                const float gl = *(LAS const float*)(sg + 40960); \
                bf16x8 Sb[2][2]; Sb[0][0] = pack8(S0, 0); Sb[0][1] = pack8(S0, 1); Sb[1][0] = pack8(S1, 0); Sb[1][1] = pack8(S1, 1); \
                f32x16 vn[2], o[2]; \
        _Pragma("unroll") \
                for (int ct = 0; ct < 2; ++ct) { \
                    f32x16 acc; \
        _Pragma("unroll") \
                    for (int i = 0; i < 16; ++i) acc[i] = bf2f(Um[(32 * ct + crow(i, hi)) * 64 + vbase + r32]); \
                    f32x16 oo = {}; \
        _Pragma("unroll") \
                    for (int kt = 0; kt < 2; ++kt) \
        _Pragma("unroll") \
                        for (int s2 = 0; s2 < 2; ++s2) { \
                            acc = MFMA32(lds_frag(Wm, 32 * ct + r32, (2 * kt + s2) * 2 + hi), Sb[kt][s2], acc); \
                            oo = MFMA32(lds_frag(QGm, 32 * ct + r32, (2 * kt + s2) * 2 + hi), Sb[kt][s2], oo); \
                        } \
                    vn[ct] = acc; o[ct] = oo; \
                } \
                bf16x8 Vb[2][2]; Vb[0][0] = pack8(vn[0], 0); Vb[0][1] = pack8(vn[0], 1); Vb[1][0] = pack8(vn[1], 0); Vb[1][1] = pack8(vn[1], 1); \
        _Pragma("unroll") \
                for (int i = 0; i < 16; ++i) { S0[i] *= gl; S1[i] *= gl; } \
        _Pragma("unroll") \
                for (int ct = 0; ct < 2; ++ct) \
        _Pragma("unroll") \
                    for (int s2 = 0; s2 < 2; ++s2) { \
                        const int ch = (2 * ct + s2) * 2 + hi; \
                        o[0] = MFMA32(lds_frag(AQm, r32, ch), Vb[ct][s2], o[0]); \
                        o[1] = MFMA32(lds_frag(AQm, 32 + r32, ch), Vb[ct][s2], o[1]); \
                        S0 = MFMA32(lds_frag(KGm, r32, ch), Vb[ct][s2], S0); \
                        S1 = MFMA32(lds_frag(KGm, 32 + r32, ch), Vb[ct][s2], S1); \
                    } \
                LAS float* ob = (LAS float*)(lds + GS_OBUF + (n & 1) * 16384); \
        _Pragma("unroll") \
                for (int ct = 0; ct < 2; ++ct) \
        _Pragma("unroll") \
                    for (int i = 0; i < 16; ++i) ob[(32 * ct + crow(i, hi)) * 64 + vbase + r32] = o[ct][i]; \
            } \
        } else if (wave < 4) { \
            if (n > 0) { \
                LAS const float* ob = (LAS const float*)(lds + GS_OBUF + ((n - 1) & 1) * 16384); \
                const f32x4 gn = *(const f32x4*)(gnorm + 4 * vq); \
        _Pragma("unroll") \
                for (int it = 0; it < 8; ++it) { \
                    const int c = (wave - 2) * 32 + 4 * it + rg, p = (n - 1) * 64 + c; \
                    const f32x4 v = *(LAS const f32x4*)(ob + c * 64 + 4 * vq); \
                    const float ss = row_sum16((v[0] * v[0] + v[1] * v[1]) + (v[2] * v[2] + v[3] * v[3])); \
                    const float rn = __builtin_amdgcn_rsqf(ss * (1.0f / 64.0f) + EPS); \
                    const u32x2 zz = zq[it]; \
                    const float z0 = __uint_as_float(zz.x << 16), z1 = __uint_as_float(zz.x & 0xffff0000u), z2 = __uint_as_float(zz.y << 16), z3 = __uint_as_float(zz.y & 0xffff0000u); \
                    const float y0 = v[0] * rn * gn[0] * z0, y1 = v[1] * rn * gn[1] * z1, y2 = v[2] * rn * gn[2] * z2, y3 = v[3] * rn * gn[3] * z3; \
                    if ((p >= NMETA) && (p < LTOK)) *(u32x2*)(MIX + (size_t)(b * SEQ + p - NMETA) * 1024 + 512 + h * 64 + 4 * vq) = (u32x2){pk2(y0, y1), pk2(y2, y3)}; \
                } \
            } \
            if (n < NCHUNK) { GS_ZLOAD(n); } \
        } else { \
            if (n + 1 < NCHUNK) { GS_WRITE(HW, HGW, STGW); if (n + 2 < NCHUNK) GS_ISSUE(HW, HGW, n + 2); } \
        } \
        BAR_LDS(); } while (0)
DI void gdn_scan(const Params& P, LAS unsigned char* lds, int bh, int tid, int wave, int lane) {
    const int b = bh >> 3, h = bh & 7, r32 = lane & 31, hi = lane >> 5;
    const int task0 = (b * 8 + h) * NCHUNK;
    const bf16_t* GP0 = (const bf16_t*)(P.ws + WS_GP);
    const float* GLg = (const float*)(P.ws + WS_GL);
    const bf16_t* ZB = (const bf16_t*)(P.ws + WS_ZB); bf16_t* MIX = (bf16_t*)(P.ws + WS_MIX); const float* gnorm = P.in[12];
    const int lt = tid - 256;
    u32x4 holdA[10]; float hglA = 0.f;
#define GS_ISSUE(H, HG, n_) do { _Pragma("unroll") for (int i = 0; i < 10; ++i) { const int a_ = i >> 1, e_ = lt + 256 * (i & 1); \
            H[i] = *(const u32x4*)(GP0 + (size_t)a_ * (GP_ARR / 2) + (size_t)(task0 + (n_)) * 4096 + e_ * 8); } \
        if (lt == 0) HG = GLg[task0 + (n_)]; } while (0)
#define GS_WRITE(H, HG, stg_) do { LAS unsigned char* sg_ = lds + (stg_) * GS_STAGE; \
        _Pragma("unroll") for (int i = 0; i < 10; ++i) { const int a_ = i >> 1, e_ = lt + 256 * (i & 1), row_ = e_ >> 3, ch_ = e_ & 7; \
            *(LAS u32x4*)(sg_ + a_ * 8192 + row_ * 128 + (((a_ < 4) ? (ch_ ^ (row_ & 7)) : ch_) << 4)) = H[i]; } \
        if (lt == 0) *(LAS float*)(sg_ + 40960) = HG; } while (0)
    const int vq = lane & 15, rg = lane >> 4;
    u32x2 zq[8];
#define GS_ZLOAD(n_) do { _Pragma("unroll") for (int it = 0; it < 8; ++it) { int p_ = (n_) * 64 + (wave - 2) * 32 + 4 * it + rg; p_ = p_ < LTOK ? p_ : LTOK - 1; \
            zq[it] = *(const u32x2*)(ZB + (size_t)(b * LP + p_) * 512 + h * 64 + 4 * vq); } } while (0)
    if (wave >= 4) { GS_ISSUE(holdA, hglA, 0); GS_WRITE(holdA, hglA, 0); GS_ISSUE(holdA, hglA, 1); }
    if (wave == 2 || wave == 3) { GS_ZLOAD(0); }
    __syncthreads();
    f32x16 S0 = {}, S1 = {};
    const int vbase = 32 * wave;
    for (int n2 = 0; n2 <= NCHUNK; n2 += 2) { GS_STEP((n2), holdA, hglA, 1); GS_STEP((n2 + 1), holdA, hglA, 0); }
}

constexpr int AT_STAGE = 32768;
constexpr int AT_XBUF = 2 * AT_STAGE;
constexpr int AT_WSF = AT_XBUF + 65536;
constexpr int AT_UNIT = AT_WSF + 2048;
constexpr float AT_THR = 8.0f;

DI s16x4 tr_read(LAS const unsigned char* p) { return __builtin_bit_cast(s16x4, __builtin_amdgcn_ds_read_tr16_b64_v4i16((LAS v4i16_t*)p)); }

DI void attn_unit(const Params& P, LAS unsigned char* lds, int bh, int qi, int tid, int wave, int lane, float lam) {
    const int b = bh >> 2, h = bh & 3, r32 = lane & 31, hi = lane >> 5, qsub = wave >> 1, map = wave & 1, hh = 2 * h + map;
    const bf16_t* QB = (const bf16_t*)(P.ws + WS_QB); const bf16_t* KT = (const bf16_t*)(P.ws + WS_KT); const bf16_t* VT = (const bf16_t*)(P.ws + WS_VT);
    const int ntiles = 2 * qi + 3, my_nt = (qsub < 2) ? ntiles - 1 : ntiles;
    const bf16_t* k1 = KT + ((size_t)((b * 8 + 2 * h) * NKT) << 12) + tid * 8;
    const bf16_t* k2 = KT + ((size_t)((b * 8 + 2 * h + 1) * NKT) << 12) + tid * 8;
    const bf16_t* vv = VT + ((size_t)((b * 4 + h) * NKT) << 13) + tid * 8;
    u32x4 st[4];
#define AT_LOAD(t) do { st[0] = *(const u32x4*)(k1 + ((size_t)(t) << 12)); st[1] = *(const u32x4*)(k2 + ((size_t)(t) << 12)); \
                        st[2] = *(const u32x4*)(vv + ((size_t)(t) << 13)); st[3] = *(const u32x4*)(vv + ((size_t)(t) << 13) + 4096); } while (0)
#define AT_STORE(sb) do { LAS unsigned char* d_ = lds + (sb) * AT_STAGE + tid * 16; *(LAS u32x4*)d_ = st[0]; *(LAS u32x4*)(d_ + 8192) = st[1]; \
                          *(LAS u32x4*)(d_ + 16384) = st[2]; *(LAS u32x4*)(d_ + 24576) = st[3]; } while (0)
    AT_LOAD(0);
    bf16x8 qr[4];
    { const bf16_t* q = QB + ((size_t)((b * 8 + hh) * SEQ + qi * 128 + qsub * 32 + r32) << 6) + hi * 8;
#pragma unroll
      for (int d0 = 0; d0 < 4; ++d0) qr[d0] = *(const bf16x8*)(q + d0 * 16); }
    AT_STORE(0);
    __syncthreads();
    LAS float* wsf = (LAS float*)(lds + AT_WSF) + wave * 64;
    float m_run = -1e30f, l_run = 0.f;
    f32x16 o[4]; o[0] = f32x16{}; o[1] = f32x16{}; o[2] = f32x16{}; o[3] = f32x16{};
    for (int t = 0; t < ntiles; ++t) {
        if (t + 1 < ntiles) AT_LOAD(t + 1);
        if (t < my_nt) {
            LAS const unsigned char* sg = lds + (t & 1) * AT_STAGE;
            LAS const unsigned char* kb = sg + map * 8192 + hi * 1024 + r32 * 16;
            f32x16 p0 = {}, p1 = {};
#pragma unroll
            for (int d0 = 0; d0 < 4; ++d0) {
                const bf16x8 a0 = *(LAS const bf16x8*)(kb + d0 * 2048), a1 = *(LAS const bf16x8*)(kb + d0 * 2048 + 512);
                p0 = MFMA32(a0, qr[d0], p0); p1 = MFMA32(a1, qr[d0], p1);
            }
            if (t == 0) {
#pragma unroll
                for (int r = 0; r < 16; ++r) { if (crow(r, hi) >= NMETA) p0[r] = -INFINITY; p1[r] = -INFINITY; }
            }
            float rm = fmaxf(p0[0], p1[0]);
#pragma unroll
            for (int r = 1; r < 16; ++r) rm = fmaxf(rm, fmaxf(p0[r], p1[r]));
            rm = swap32_max(rm);
            if (__any(rm > m_run + AT_THR)) {
                const float mn = fmaxf(m_run, rm), alpha = exp2f(m_run - mn);
                l_run *= alpha; m_run = mn;
                if (hi == 0) wsf[r32] = alpha;
                LDS_WAIT();
#pragma unroll
                for (int r = 0; r < 16; ++r) { const float a = wsf[crow(r, hi)];
#pragma unroll
                    for (int d0 = 0; d0 < 4; ++d0) o[d0][r] *= a; }
                LDS_WAIT();
            }
            float ls = 0.f;
#pragma unroll
            for (int r = 0; r < 16; ++r) { p0[r] = exp2f(p0[r] - m_run); p1[r] = exp2f(p1[r] - m_run); ls += p0[r] + p1[r]; }
            l_run += ls;
            const bf16x8 pa0 = pack8(p0, 0), pa1 = pack8(p0, 1), pa2 = pack8(p1, 0), pa3 = pack8(p1, 1);
            LAS const unsigned char* vb = sg + 16384 + ((lane >> 4) & 1) * 32 + (lane & 3) * 8 + (4 * hi + ((lane & 15) >> 2)) * 64;
#pragma unroll
            for (int d0 = 0; d0 < 4; ++d0) {
#define AT_VF(ks) ({ const s16x4 lo_ = tr_read(vb + d0 * 4096 + (ks) * 1024), hi_ = tr_read(vb + d0 * 4096 + (ks) * 1024 + 512); \
                     (bf16x8){lo_[0], lo_[1], lo_[2], lo_[3], hi_[0], hi_[1], hi_[2], hi_[3]}; })
                o[d0] = MFMA32(pa0, AT_VF(0), o[d0]); o[d0] = MFMA32(pa1, AT_VF(1), o[d0]);
                o[d0] = MFMA32(pa2, AT_VF(2), o[d0]); o[d0] = MFMA32(pa3, AT_VF(3), o[d0]);
#undef AT_VF
            }
        }
        if (t + 1 < ntiles) AT_STORE((t + 1) & 1);
        __syncthreads();
    }
    l_run = swap32_add(l_run);
    const float sc = (map ? lam : 1.0f) / l_run;
    if (hi == 0) wsf[r32] = sc;
    LDS_WAIT();
#pragma unroll
    for (int r = 0; r < 16; ++r) { const float a = wsf[crow(r, hi)];
#pragma unroll
        for (int d0 = 0; d0 < 4; ++d0) o[d0][r] *= a; }
    LAS float* xb = (LAS float*)(lds + AT_XBUF + qsub * 16384);
    if (map) {
#pragma unroll
        for (int d0 = 0; d0 < 4; ++d0)
#pragma unroll
            for (int r = 0; r < 16; ++r) xb[(d0 * 16 + r) * 64 + lane] = o[d0][r];
    }
    __syncthreads();
    if (!map) {
        const float* dn = P.in[8];
        bf16_t* MIX = (bf16_t*)(P.ws + WS_MIX);
        float ss[16];
#pragma unroll
        for (int r = 0; r < 16; ++r) { ss[r] = 0.f;
#pragma unroll
            for (int d0 = 0; d0 < 4; ++d0) { o[d0][r] -= xb[(d0 * 16 + r) * 64 + lane]; ss[r] += o[d0][r] * o[d0][r]; } }
#pragma unroll
        for (int r = 0; r < 16; ++r) {
            ss[r] = half_sum32(ss[r]);
            ss[r] = 0.8f / sqrtf(ss[r] * (1.0f / 128.0f) + EPS);
        }
        float dg[4];
#pragma unroll
        for (int d0 = 0; d0 < 4; ++d0) dg[d0] = dn[32 * d0 + r32];
#pragma unroll
        for (int r = 0; r < 16; ++r) {
            bf16_t* orow = MIX + (size_t)(b * SEQ + qi * 128 + qsub * 32 + crow(r, hi)) * 1024 + h * 128 + r32;
#pragma unroll
            for (int d0 = 0; d0 < 4; ++d0) orow[32 * d0] = (bf16_t)f2bf(o[d0][r] * ss[r] * dg[d0]);
        }
    }
    __syncthreads();
#undef AT_LOAD
#undef AT_STORE
}

DI void attn_phase(const Params& P, LAS unsigned char* lds, int tid, int wave, int lane) {
    unsigned* ctl = (unsigned*)(P.ws + WS_CTL);
    const float* lq1 = P.in[4]; const float* lk1 = P.in[5]; const float* lq2 = P.in[6]; const float* lk2 = P.in[7];
    const float lam = __expf(wave_sum(lq1[lane] * lk1[lane])) - __expf(wave_sum(lq2[lane] * lk2[lane])) + 0.2f;
    LAS volatile int* ub = (LAS volatile int*)(lds + AT_UNIT);
    for (;;) {
        if (tid == 0) *ub = (int)__hip_atomic_fetch_add(ctl + CW_ATTQ, 1u, __ATOMIC_RELAXED, __HIP_MEMORY_SCOPE_AGENT);
        __syncthreads();
        const int u = *ub;
        __syncthreads();
        if (u >= 512) break;
        attn_unit(P, lds, u & 7, 63 - (u >> 3), tid, wave, lane, lam);
    }
}

struct EpiOutProj {
    static constexpr bool PERM = false, AFTER_DRAIN = false;
    const float* x; float* out;
    DI void operator()(const pg8::f32x4 (&acc)[2][2][4][2], const pg8::Unit& u, int wr, int wc, int fr, int fq) const {
        const int row0 = u.pm * 256 + wr * 64 + fr, col0 = u.pn * 256 + wc * 32 + 4 * fq;
#pragma unroll
        for (int ai = 0; ai < 2; ++ai)
#pragma unroll
            for (int m = 0; m < 4; ++m) { const size_t off = (size_t)(row0 + ai * 128 + m * 16) * 1024 + col0;
#pragma unroll
                for (int bj = 0; bj < 2; ++bj)
#pragma unroll
                    for (int n = 0; n < 2; ++n) { const f32x4 xv = *(const f32x4*)(x + off + bj * 128 + n * 16); *(f32x4*)(out + off + bj * 128 + n * 16) = acc[ai][bj][m][n] + xv; } }
    }
};

typedef float f32x4v __attribute__((ext_vector_type(4)));
DI void route_tile(const Params& P, int tile, LAS float* lg  , int lane) {
    const float* h2 = P.out; const float* WR = (const float*)(P.ws + WS_WR);
    const int r16 = lane & 15, kq = lane >> 4;
    const float* arow = h2 + (size_t)(tile * 16 + r16) * 1024 + kq * 256;
    const float* b0 = WR + (size_t)r16 * 1024 + kq * 256; const float* b1 = b0 + 16 * 1024; const float* b2 = WR + (size_t)(32 + (r16 & 3)) * 1024 + kq * 256;
    const float z2 = (r16 < 4) ? 1.0f : 0.0f;
    f32x4v c0 = {}, c1 = {}, c2 = {};
    float ss = 0.f;
    for (int t4 = 0; t4 < 64; ++t4) {
        const f32x4 a = *(const f32x4*)(arow + 4 * t4), w0 = *(const f32x4*)(b0 + 4 * t4), w1 = *(const f32x4*)(b1 + 4 * t4), w2 = *(const f32x4*)(b2 + 4 * t4);
        ss += (a.x * a.x + a.y * a.y) + (a.z * a.z + a.w * a.w);
#pragma unroll
        for (int i = 0; i < 4; ++i) {
            c0 = __builtin_amdgcn_mfma_f32_16x16x4f32(a[i], w0[i], c0, 0, 0, 0);
            c1 = __builtin_amdgcn_mfma_f32_16x16x4f32(a[i], w1[i], c1, 0, 0, 0);
            c2 = __builtin_amdgcn_mfma_f32_16x16x4f32(a[i], w2[i] * z2, c2, 0, 0, 0);
        }
    }
    ss += swz_xor16(ss); ss = swap32_add(ss);
    const float rs = 1.0f / sqrtf(ss * (1.0f / 1024.0f) + EPS);
#pragma unroll
    for (int r = 0; r < 4; ++r) { const int row = 4 * kq + r; lg[row * 48 + r16] = c0[r]; lg[row * 48 + 16 + r16] = c1[r]; lg[row * 48 + 32 + r16] = c2[r]; }
    LDS_WAIT();
    if (lane < 16) {
        const int t = tile * 16 + lane;
        const float* bg = P.in[16]; const float* br = P.in[18];
        LAS const float* l = lg + lane * 48;
        float gl[4]; int gs = 0; float gm;
#pragma unroll
        for (int j = 0; j < 4; ++j) gl[j] = l[j] * rs + bg[j];
        gm = gl[0];
#pragma unroll
        for (int j = 1; j < 4; ++j) if (gl[j] > gm) { gm = gl[j]; gs = j; }
        float gsum = 0.f;
#pragma unroll
        for (int j = 0; j < 4; ++j) gsum += __expf(gl[j] - gm);
        const float psel = 1.0f / gsum;
        float e1 = -INFINITY, e2 = -INFINITY; int i1 = 0, i2 = 0;
#pragma unroll
        for (int j = 0; j < 8; ++j) {
            const float v = l[4 + gs * 8 + j] * rs + br[gs * 8 + j];
            if (v > e1) { e2 = e1; i2 = i1; e1 = v; i1 = j; } else if (v > e2) { e2 = v; i2 = j; }
        }
        const float x2 = __expf(e2 - e1), w1 = psel / (1.0f + x2), w2 = psel * x2 / (1.0f + x2);
        const int ea = gs * 8 + i1, eb = gs * 8 + i2;
        unsigned* cnt = (unsigned*)(P.ws + WS_CTL) + CW_CNT;
        const int pa = (int)atomicAdd(cnt + ea, 1u), pb = (int)atomicAdd(cnt + eb, 1u);
        ((int*)(P.ws + WS_TOKE))[2 * t] = ea; ((int*)(P.ws + WS_TOKE))[2 * t + 1] = eb;
        ((float*)(P.ws + WS_TOKW))[2 * t] = w1; ((float*)(P.ws + WS_TOKW))[2 * t + 1] = w2;
        ((int*)(P.ws + WS_TOKP))[2 * t] = pa; ((int*)(P.ws + WS_TOKP))[2 * t + 1] = pb;
        ((float*)(P.ws + WS_RS2))[t] = rs;
    }
    LDS_WAIT();
}

DI void phase4a(const Params& P, LAS unsigned char* lds, int gw, int NGW, int wave, int lane) {
    LAS float* scr = (LAS float*)(lds + wave * 16384);
    for (int tile = gw; tile < MTOK / 16; tile += NGW) route_tile(P, tile, scr, lane);
    bf16_t* WGU = (bf16_t*)(P.ws + WS_WGU); bf16_t* WD = (bf16_t*)(P.ws + WS_WD);
    const float* wg = P.in[19]; const float* wu = P.in[20]; const float* wd = P.in[21]; const float* gf = P.in[14];
    constexpr int I_GU = 16 * 16, I_D = 4 * 32;
    for (int it = gw; it < 32 * (I_GU + I_D); it += NGW) {
        const int e = it / (I_GU + I_D), r = it % (I_GU + I_D);
        if (r < I_GU) { const int n0 = (r & 15) * 32, j = n0 >> 8, up = (n0 >> 7) & 1;
            const float* wsrc = (up ? wu : wg) + (size_t)e * 1024 * 256;
            const SrcGU s{wsrc, gf, 128 * j + (n0 & 127) - n0};
            transpose_item(s, WGU + (size_t)e * 512 * 1024, 1024, (r >> 4) * 64, n0, scr, lane); }
        else { const int r2 = r - I_GU; const SrcPlain s{wd + (size_t)e * 256 * 1024, 1024};
            transpose_item(s, WD + (size_t)e * 1024 * 256, 256, (r2 >> 5) * 64, (r2 & 31) * 32, scr, lane); }
    }
}

DI void expert_layout(const Params& P, int lane, int& cnt, int& base, int& tend) {
    const unsigned* c = (const unsigned*)(P.ws + WS_CTL) + CW_CNT;
    cnt = (lane < 32) ? (int)__hip_atomic_load(c + lane, __ATOMIC_RELAXED, __HIP_MEMORY_SCOPE_AGENT) : 0;
    const int tiles = (cnt + 255) >> 8;
    int inc = 0;
#pragma unroll
    for (int i = 0; i < 32; ++i) { const int ti = __builtin_amdgcn_readlane(tiles, i); inc += (i <= lane) ? ti : 0; }
    tend = inc; base = (inc - tiles) << 8;
}

DI void phase4b(const Params& P, int gw, int NGW, int lane) {
    int cnt, base, tend; expert_layout(P, lane, cnt, base, tend);
    bf16_t* XS = (bf16_t*)(P.ws + WS_XS); float* SLOTW = (float*)(P.ws + WS_SLOTW);
    const int* TOKE = (const int*)(P.ws + WS_TOKE); const float* TOKW = (const float*)(P.ws + WS_TOKW); int* TOKP = (int*)(P.ws + WS_TOKP); const float* RS2 = (const float*)(P.ws + WS_RS2);
    for (int t = gw; t < MTOK; t += NGW) {
        const f32x4* hr = (const f32x4*)(P.out + (size_t)t * 1024);
        const float rs = RS2[t];
        u32x2 w[4];
#pragma unroll
        for (int j = 0; j < 4; ++j) { const f32x4 v = hr[64 * j + lane]; w[j] = (u32x2){pk2(v.x * rs, v.y * rs), pk2(v.z * rs, v.w * rs)}; }
#pragma unroll
        for (int k = 0; k < 2; ++k) {
            const int e = __builtin_amdgcn_readfirstlane(TOKE[2 * t + k]), slot = __builtin_amdgcn_readlane(base, e) + TOKP[2 * t + k];
            u32x2* orow = (u32x2*)(XS + (size_t)slot * 1024);
#pragma unroll
            for (int j = 0; j < 4; ++j) orow[64 * j + lane] = w[j];
            if (lane == 0) { SLOTW[slot] = TOKW[2 * t + k]; TOKP[2 * t + k] = slot; }
        }
    }
    for (int e = 0; e < 32; ++e) {
        const int ce = __builtin_amdgcn_readlane(cnt, e), be = __builtin_amdgcn_readlane(base, e), end = be + (((ce + 255) >> 8) << 8);
        for (int r = be + ce + gw; r < end; r += NGW) { u32x2* orow = (u32x2*)(XS + (size_t)r * 1024);
#pragma unroll
            for (int j = 0; j < 4; ++j) orow[64 * j + lane] = (u32x2){0u, 0u};
            if (lane == 0) SLOTW[r] = 0.f; }
    }
}

struct GroupedOrder {
    int tend; int total; int G, c, NS;
    DI bool next(int i, pg8::Unit& u) const {
        const int L = i * G + c; if (L >= (total << NS)) return false;
        const int mt = L >> NS, j = L & ((1 << NS) - 1);
        const int e = __builtin_popcountll(__ballot(((int)(threadIdx.x & 63) < 32) && tend <= mt));
        u.pm = mt; u.pn = (e << NS) + j; return true;
    }
    DI void a_ready(const pg8::Unit&) const {}
    DI void done(const pg8::Unit&) const {}
};
struct EpiGateUp {
    static constexpr bool PERM = true, AFTER_DRAIN = false;
    const float* SLOTW; bf16_t* YS;
    DI void operator()(const pg8::f32x4 (&acc)[2][2][4][2], const pg8::Unit& u, int wr, int wc, int fr, int fq) const {
        const int f0 = (u.pn & 1) * 128 + wc * 32 + fq * 8;
#pragma unroll
        for (int ai = 0; ai < 2; ++ai)
#pragma unroll
            for (int m = 0; m < 4; ++m) {
                const int row = u.pm * 256 + ai * 128 + wr * 64 + m * 16 + fr;
                const float cw = SLOTW[row];
                float a[8];
#pragma unroll
                for (int i = 0; i < 4; ++i) {
                    const float g0 = acc[ai][0][m][0][i], g1 = acc[ai][0][m][1][i];
                    a[i] = g0 / (1.0f + __expf(-g0)) * acc[ai][1][m][0][i] * cw; a[4 + i] = g1 / (1.0f + __expf(-g1)) * acc[ai][1][m][1][i] * cw;
                }
                *(u32x4*)(YS + (size_t)row * 256 + f0) = (u32x4){pk2(a[0], a[1]), pk2(a[2], a[3]), pk2(a[4], a[5]), pk2(a[6], a[7])};
            }
    }
};
struct EpiDown {
    static constexpr bool PERM = true, AFTER_DRAIN = false;
    bf16_t* YO;
    DI void operator()(const pg8::f32x4 (&acc)[2][2][4][2], const pg8::Unit& u, int wr, int wc, int fr, int fq) const {
        const int c0 = (u.pn & 3) * 256 + wc * 32 + fq * 8;
#pragma unroll
        for (int ai = 0; ai < 2; ++ai)
#pragma unroll
            for (int m = 0; m < 4; ++m) {
                bf16_t* rowp = YO + (size_t)(u.pm * 256 + ai * 128 + wr * 64 + m * 16 + fr) * 1024 + c0;
#pragma unroll
                for (int bj = 0; bj < 2; ++bj) { const pg8::f32x4 v0 = acc[ai][bj][m][0], v1 = acc[ai][bj][m][1];
                    *(u32x4*)(rowp + bj * 128) = (u32x4){pk2(v0[0], v0[1]), pk2(v0[2], v0[3]), pk2(v1[0], v1[1]), pk2(v1[2], v1[3])}; }
            }
    }
};

DI void phase7(const Params& P, int gw, int NGW, int lane) {
    const bf16_t* YO = (const bf16_t*)(P.ws + WS_YO); const int* TOKP = (const int*)(P.ws + WS_TOKP); const f32x4* nf = (const f32x4*)P.in[22];
    for (int t = gw; t < MTOK; t += NGW) {
        f32x4* hr = (f32x4*)(P.out + (size_t)t * 1024);
        const u32x2* y0 = (const u32x2*)(YO + (size_t)TOKP[2 * t] * 1024); const u32x2* y1 = (const u32x2*)(YO + (size_t)TOKP[2 * t + 1] * 1024);
        f32x4 v[4]; float s = 0.f;
#pragma unroll
        for (int j = 0; j < 4; ++j) {
            v[j] = hr[64 * j + lane]; const u32x2 a = y0[64 * j + lane], c = y1[64 * j + lane];
            v[j].x += __uint_as_float(a.x << 16) + __uint_as_float(c.x << 16); v[j].y += __uint_as_float(a.x & 0xffff0000u) + __uint_as_float(c.x & 0xffff0000u);
            v[j].z += __uint_as_float(a.y << 16) + __uint_as_float(c.y << 16); v[j].w += __uint_as_float(a.y & 0xffff0000u) + __uint_as_float(c.y & 0xffff0000u);
            s += (v[j].x * v[j].x + v[j].y * v[j].y) + (v[j].z * v[j].z + v[j].w * v[j].w);
        }
        s = wave_sum(s);
        const float rs = 1.0f / sqrtf(s * (1.0f / 1024.0f) + EPS);
#pragma unroll
        for (int j = 0; j < 4; ++j) hr[64 * j + lane] = v[j] * rs * nf[64 * j + lane];
    }
}

#ifndef PHMASK
#define PHMASK 2047
#endif
#ifndef REPMASK
#define REPMASK 0
#endif
#define REP(bit) for (int rep_ = 0; rep_ < ((REPMASK & (bit)) ? 2 : 1); ++rep_)
#define REPSYNC(bit) if ((REPMASK & (bit)) && rep_ == 0) grid.sync()
typedef const __attribute__((address_space(4))) Params* KParams;
DI Params load_params(KParams kp) { Params p;
#pragma unroll
    for (int i = 0; i < 23; ++i) p.in[i] = kp->in[i];
    p.out = kp->out; p.ws = kp->ws; return p; }
__global__ void __launch_bounds__(NTHREADS, 2) hymba_fwd(Params Pin) {
    extern __shared__ __attribute__((aligned(16))) unsigned char lds_raw[];
    LAS unsigned char* lds = (LAS unsigned char*)lds_raw;
    cg::grid_group grid = cg::this_grid();
    const int G = gridDim.x, blk = blockIdx.x, NGW = G * NWAVES, NGT = G * NTHREADS;
#define PHASE_IDS() KParams kp_ = (KParams)__builtin_amdgcn_kernarg_segment_ptr(); asm volatile("" : "+s"(kp_)); const Params P = load_params(kp_); int tid = threadIdx.x; asm volatile("" : "+v"(tid)); const int lane = tid & 63, wave = __builtin_amdgcn_readfirstlane(tid >> 6), gw = blk * NWAVES + wave, gtid = blk * NTHREADS + tid; (void)lane; (void)gw; (void)gtid; (void)wave

    REP(1) { if (PHMASK & 1) { PHASE_IDS(); phase0(P, lds, gw, NGW, gtid, NGT, wave, lane); } REPSYNC(1); }
    grid.sync();
    REP(2) { if (PHMASK & 2) { PHASE_IDS();
        pg8::Gemm g{(const bf16_t*)(P.ws + WS_XB), (const bf16_t*)(P.ws + WS_WINT), MROWS, NPROJ, 1024};
        pg8::StaticOrder S; S.init(MROWS, NPROJ, G, blk);
        EpiInProj E{(const float*)(P.ws + WS_RS1), (const float*)(P.ws + WS_COS), (const float*)(P.ws + WS_SIN), P.in[10], P.in[11],
                    (bf16_t*)(P.ws + WS_QB), (bf16_t*)(P.ws + WS_KT), (bf16_t*)(P.ws + WS_VT), (bf16_t*)(P.ws + WS_QKVB), (bf16_t*)(P.ws + WS_ZB), (float*)(P.ws + WS_GB)};
        pg8::gemm_phase<EpiInProj, pg8::StaticOrder, true, true>(lds, g, S, E);
    } REPSYNC(2); }
    grid.sync();
    REP(4) { if (PHMASK & 4) { PHASE_IDS(); gdn_prep_phase(P, lds, blk, G, wave, lane); } REPSYNC(4); }
    grid.sync();
    REP(8) { if ((PHMASK & 8) && blk < 16) { PHASE_IDS(); gdn_scan(P, lds, blk, tid, wave, lane); } }
    REP(16) {
    if (PHMASK & 16) { PHASE_IDS(); attn_phase(P, lds, tid, wave, lane); }
    if ((REPMASK & 16) && rep_ == 0) { grid.sync(); if (blk == 0 && threadIdx.x == 0) { PHASE_IDS(); __hip_atomic_store((unsigned*)(P.ws + WS_CTL) + CW_ATTQ, 0u, __ATOMIC_RELAXED, __HIP_MEMORY_SCOPE_AGENT); } grid.sync(); }
    }
    grid.sync();
    REP(32) { if (PHMASK & 32) { PHASE_IDS();
        pg8::Gemm g{(const bf16_t*)(P.ws + WS_MIX), (const bf16_t*)(P.ws + WS_WOUT), MTOK, 1024, 1024};
        pg8::StaticOrder S; S.init(MTOK, 1024, G, blk);
        EpiOutProj E{P.in[0], P.out};
        pg8::gemm_phase<EpiOutProj, pg8::StaticOrder, true, true>(lds, g, S, E);
    } REPSYNC(32); }
    grid.sync();
    if (PHMASK & 64) { PHASE_IDS(); phase4a(P, lds, gw, NGW, wave, lane); }
    grid.sync();
    if (PHMASK & 128) { PHASE_IDS(); phase4b(P, gw, NGW, lane); }
    grid.sync();
    int cnt, base, tend, total; { PHASE_IDS(); expert_layout(P, lane, cnt, base, tend); total = __builtin_amdgcn_readlane(tend, 31); }
    REP(256) { if (PHMASK & 256) { PHASE_IDS();
        pg8::Gemm g{(const bf16_t*)(P.ws + WS_XS), (const bf16_t*)(P.ws + WS_WGU), XS_ROWS, 32 * 512, 1024};
        GroupedOrder S{tend, total, G, blk, 1};
        EpiGateUp E{(const float*)(P.ws + WS_SLOTW), (bf16_t*)(P.ws + WS_YS)};
        pg8::gemm_phase<EpiGateUp, GroupedOrder, true, true>(lds, g, S, E);
    } REPSYNC(256); }
    grid.sync();
    REP(512) { if (PHMASK & 512) { PHASE_IDS();
        int kd = 256; asm volatile("" : "+s"(kd));
        pg8::Gemm g{(const bf16_t*)(P.ws + WS_YS), (const bf16_t*)(P.ws + WS_WD), XS_ROWS, 32 * 1024, kd};
        GroupedOrder S{tend, total, G, blk, 2};
        EpiDown E{(bf16_t*)(P.ws + WS_YO)};
        pg8::gemm_phase<EpiDown, GroupedOrder, true, true>(lds, g, S, E);
    } REPSYNC(512); }
    grid.sync();
    if (PHMASK & 1024) { PHASE_IDS(); phase7(P, gw, NGW, lane); }
}

extern "C" void kernel_launch(void* const* d_in, const int* in_sizes, int n_in, void* d_out, int out_size, void* d_ws, size_t ws_size, hipStream_t stream) {
    static int grid_blocks = 0;
    if (grid_blocks == 0) {
        if (n_in != 23 || out_size != MTOK * DMODEL || ws_size < WS_END) { fprintf(stderr, "kernel_launch: unexpected shapes (n_in %d out %d ws %zu)\n", n_in, out_size, ws_size); grid_blocks = -1; return; }
        int dev = 0, cus = 0, per_cu = 0;
        hipGetDevice(&dev);
        hipDeviceGetAttribute(&cus, hipDeviceAttributeMultiprocessorCount, dev);
        hipFuncSetAttribute((const void*)hymba_fwd, hipFuncAttributeMaxDynamicSharedMemorySize, LDS_BYTES);
        hipOccupancyMaxActiveBlocksPerMultiprocessor(&per_cu, (const void*)hymba_fwd, NTHREADS, LDS_BYTES);
        if (per_cu < 1) { fprintf(stderr, "kernel_launch: occupancy query says %d blocks/CU\n", per_cu); per_cu = 1; }
        grid_blocks = cus;
        (void)hipGetLastError();
    }
    if (grid_blocks < 0) return;
    hipMemsetAsync((char*)d_ws + WS_CTL, 0, CTL_BYTES, stream);
    Params p{};
    for (int i = 0; i < 23; ++i) p.in[i] = (const float*)d_in[i];
    p.out = (float*)d_out; p.ws = (unsigned char*)d_ws;
    void* args[] = {&p};
    hipError_t e = hipLaunchCooperativeKernel((const void*)hymba_fwd, dim3(grid_blocks), dim3(NTHREADS), args, LDS_BYTES, stream);
    if (e != hipSuccess) fprintf(stderr, "cooperative launch failed: %s (grid %d)\n", hipGetErrorString(e), grid_blocks);
}
```

```cpp
#include <hip/hip_runtime.h>
#include <hip/hip_cooperative_groups.h>
#include <cstdio>
#include <cstdint>
namespace cg = cooperative_groups;
namespace pg8 {
#define PG8_LAS __attribute__((address_space(3)))
typedef unsigned short bf16_t;
typedef short bf16x8 __attribute__((ext_vector_type(8)));
typedef float f32x4 __attribute__((ext_vector_type(4)));
typedef unsigned u32x4 __attribute__((ext_vector_type(4)));
constexpr int BM = 256, BK = 64, HALF = 128, HTB = HALF * BK * 2  , STAGE_BYTES = 8 * HTB, NXCD = 8, WGM = 8;

__host__ __device__ __forceinline__ int lds_byte(int r, int c) { const int st = (r >> 4) * 2 + (c >> 5), rr = r & 15, cc = c & 31, ob = rr * 64 + cc * 2; return st * 1024 + (ob ^ (((ob >> 9) & 1) << 5)); }
__host__ __device__ __forceinline__ void stage_rc(int b, int& R, int& C) { const int st = b / 1024, sb = b % 1024, swz = sb ^ (((sb >> 9) & 1) << 5); R = (st >> 1) * 16 + swz / 64; C = (st & 1) * 32 + (swz % 64) / 2; }
__host__ __device__ __forceinline__ int perm32(int rho) { const int n = rho >> 4, i = rho & 15; return 8 * (i >> 2) + 4 * n + (i & 3); }

struct Unit { int pm, pn; };
struct Gemm { const bf16_t* A; const bf16_t* Bt; int M, N, K; };

struct StaticOrder {
    int nM, nN, nwg, G, c;
    __host__ __device__ void init(int M, int N, int G_, int c_) { nM = M / BM; nN = N / BM; nwg = nM * nN; G = G_; c = c_; }
    __host__ __device__ bool next(int i, Unit& u) const {
        const long L = (long)i * G + c; if (L >= nwg) return false;
        int wgid = (int)L; { const int q = nwg / NXCD, r = nwg % NXCD, xcd = wgid % NXCD, off = wgid / NXCD; wgid = (xcd < r ? xcd * (q + 1) : r * (q + 1) + (xcd - r) * q) + off; }
        const int nig = WGM * nN, gid = wgid / nig, fm = gid * WGM, gsz = (nM - fm) < WGM ? (nM - fm) : WGM;
        u.pm = fm + ((wgid % nig) % gsz); u.pn = (wgid % nig) / gsz; return true;
    }
    __device__ __forceinline__ void a_ready(const Unit&) const {}
    __device__ __forceinline__ void done(const Unit&) const {}
};

__device__ __forceinline__ unsigned cvt_pk_bf16(float lo, float hi) { unsigned r; asm volatile("v_cvt_pk_bf16_f32 %0, %1, %2" : "=v"(r) : "v"(lo), "v"(hi)); return r; }
typedef float f32x2 __attribute__((ext_vector_type(2)));
template <class Epi, class Sched, bool ALIGN_EPI = false, bool SP2 = false>
__device__ __forceinline__ void gemm_phase(PG8_LAS unsigned char* lds, const Gemm g, const Sched& S, const Epi& E) {
    int tid_o = threadIdx.x; asm volatile("" : "+v"(tid_o));
    const int tid = tid_o, wid = __builtin_amdgcn_readfirstlane(tid >> 6), lane = tid & 63, wr = wid >> 2, wc = wid & 3, fr = lane & 15, fq = lane >> 4;
    const int K = g.K, nt = K / BK;
    unsigned voffA[2], voffB[2];
#pragma unroll
    for (int i = 0; i < 2; ++i) { int R, C; stage_rc(tid * 16 + i * 8192, R, C); const int Rb = Epi::PERM ? ((R & ~31) + perm32(R & 31)) : R;
        voffA[i] = (unsigned)(R * K + C) * 2u; voffB[i] = (unsigned)(Rb * K + C) * 2u; }
    const size_t kstep = (size_t)(BK * 2);
    const size_t hstep = (size_t)HALF * K * 2;
    const size_t tstep = 2 * hstep;
    const unsigned ldsw = (unsigned)wid * 1024u;
    const int aoff = lds_byte(wr * 64 + fr, fq * 8), boff = lds_byte(wc * 32 + fr, fq * 8);
#define PG8_SA(b, h) (((b) * 2 + (h)) * HTB)
#define PG8_SB(b, h) ((4 + (b) * 2 + (h)) * HTB)
#define PG8_STAGE(bufoff, gbase, voff) do { _Pragma("unroll") for (int _i = 0; _i < 2; ++_i) \
        __builtin_amdgcn_global_load_lds((const unsigned*)((const char*)(gbase) + (voff)[_i]), (PG8_LAS unsigned*)(lds + (bufoff) + ldsw + _i * 8192), 16, 0, 0); } while (0)
#define PG8_LDA(dst, b, h) do { _Pragma("unroll") for (int m = 0; m < 4; ++m) _Pragma("unroll") for (int k = 0; k < 2; ++k) dst[m][k] = *(const PG8_LAS bf16x8*)(lds + PG8_SA(b, h) + aoff + m * 2048 + k * 1024); } while (0)
#define PG8_LDB(dst, b, h) do { _Pragma("unroll") for (int n = 0; n < 2; ++n) _Pragma("unroll") for (int k = 0; k < 2; ++k) dst[n][k] = *(const PG8_LAS bf16x8*)(lds + PG8_SB(b, h) + boff + n * 2048 + k * 1024); } while (0)
#define PG8_MMA(ai, bj, At, Bt) do { __builtin_amdgcn_s_setprio(1); _Pragma("unroll") for (int m = 0; m < 4; ++m) _Pragma("unroll") for (int n = 0; n < 2; ++n) _Pragma("unroll") for (int k = 0; k < 2; ++k) \
        acc[ai][bj][m][n] = __builtin_amdgcn_mfma_f32_16x16x32_bf16(Bt[n][k], At[m][k], acc[ai][bj][m][n], 0, 0, 0); __builtin_amdgcn_s_setprio(0); } while (0)
#define PG8_WAIT_V(n) asm volatile("s_waitcnt vmcnt(" #n ")" ::: "memory")
#define PG8_WAIT_L(n) asm volatile("s_waitcnt lgkmcnt(" #n ")" ::: "memory")
#define PG8_BAR __builtin_amdgcn_s_barrier()
#define PG8_SCHED __builtin_amdgcn_sched_barrier(0)
    Unit cur, nxt; int ui = 0;
    if (!S.next(0, cur)) return;
    f32x4 acc[2][2][4][2];
#pragma unroll
    for (int a = 0; a < 2; ++a)
#pragma unroll
        for (int b = 0; b < 2; ++b)
#pragma unroll
            for (int m = 0; m < 4; ++m)
#pragma unroll
                for (int n = 0; n < 2; ++n) acc[a][b][m][n] = (f32x4){0.f, 0.f, 0.f, 0.f};
    bf16x8 At[4][2], B0[2][2], B1[2][2];
    const char* cA = (const char*)g.A + (size_t)cur.pm * tstep; const char* cB = (const char*)g.Bt + (size_t)cur.pn * tstep;
    S.a_ready(cur);
    if constexpr (SP2) {
        PG8_STAGE(PG8_SB(0, 0), cB, voffB); PG8_STAGE(PG8_SB(0, 1), cB + hstep, voffB); PG8_STAGE(PG8_SA(0, 0), cA, voffA); PG8_STAGE(PG8_SA(0, 1), cA + hstep, voffA);
        if (wr == 1) PG8_BAR;
        PG8_WAIT_V(2); PG8_BAR;
        PG8_STAGE(PG8_SB(1, 0), cB + kstep, voffB); PG8_STAGE(PG8_SA(1, 0), cA + kstep, voffA); PG8_STAGE(PG8_SB(1, 1), cB + hstep + kstep, voffB);
        PG8_WAIT_V(6); PG8_BAR;
    } else {
        PG8_STAGE(PG8_SB(0, 0), cB, voffB); PG8_STAGE(PG8_SA(0, 0), cA, voffA); PG8_STAGE(PG8_SB(0, 1), cB + hstep, voffB); PG8_STAGE(PG8_SA(0, 1), cA + hstep, voffA);
        if (wr == 1) PG8_BAR;
        PG8_WAIT_V(4); PG8_BAR;
        PG8_STAGE(PG8_SB(1, 0), cB + kstep, voffB); PG8_STAGE(PG8_SA(1, 0), cA + kstep, voffA); PG8_STAGE(PG8_SB(1, 1), cB + hstep + kstep, voffB);
        PG8_WAIT_V(6); PG8_BAR;
    }
    for (;;) {
        const bool has_next = S.next(ui + 1, nxt);
        const char* nA = has_next ? (const char*)g.A + (size_t)nxt.pm * tstep : cA; const char* nB = has_next ? (const char*)g.Bt + (size_t)nxt.pn * tstep : cB;
        for (int t = 0; t < nt; t += 2) {
            const bool last = (t == nt - 2);
            const char* a1 = cA + (size_t)(t + 1) * kstep;
            const char* a2 = last ? nA : cA + (size_t)(t + 2) * kstep; const char* b2 = last ? nB : cB + (size_t)(t + 2) * kstep;
            const char* a3 = a2 + kstep; const char* b3 = b2 + kstep;
            if (last && has_next) S.a_ready(nxt);
            if constexpr (SP2) {
            PG8_LDB(B0, 0, 0); PG8_LDB(B1, 0, 1); PG8_SCHED; PG8_LDA(At, 0, 0); PG8_STAGE(PG8_SA(1, 1), a1 + hstep, voffA);
            PG8_WAIT_V(8); PG8_WAIT_L(0); PG8_BAR; PG8_MMA(0, 0, At, B0); PG8_MMA(0, 1, At, B1); PG8_BAR; PG8_SCHED;
            PG8_LDA(At, 0, 1); PG8_STAGE(PG8_SB(0, 0), b2, voffB); PG8_STAGE(PG8_SB(0, 1), b2 + hstep, voffB); PG8_STAGE(PG8_SA(0, 0), a2, voffA);
            PG8_WAIT_V(8); PG8_WAIT_L(0); PG8_BAR; PG8_MMA(1, 0, At, B0); PG8_MMA(1, 1, At, B1); PG8_BAR; PG8_SCHED;
            PG8_LDB(B0, 1, 0); PG8_LDB(B1, 1, 1); PG8_SCHED; PG8_LDA(At, 1, 0); PG8_STAGE(PG8_SA(0, 1), a2 + hstep, voffA);
            PG8_WAIT_V(8); PG8_WAIT_L(0); PG8_BAR; PG8_MMA(0, 0, At, B0); PG8_MMA(0, 1, At, B1); PG8_BAR; PG8_SCHED;
            PG8_LDA(At, 1, 1); PG8_STAGE(PG8_SB(1, 0), b3, voffB); PG8_STAGE(PG8_SB(1, 1), b3 + hstep, voffB); PG8_STAGE(PG8_SA(1, 0), a3, voffA);
            PG8_WAIT_V(8); PG8_WAIT_L(0); PG8_BAR; PG8_MMA(1, 0, At, B0); PG8_MMA(1, 1, At, B1); PG8_BAR; PG8_SCHED;
            } else {
            PG8_LDB(B0, 0, 0); PG8_SCHED; PG8_LDA(At, 0, 0); PG8_STAGE(PG8_SA(1, 1), a1 + hstep, voffA);
            PG8_WAIT_L(8); PG8_BAR; PG8_WAIT_L(0); PG8_MMA(0, 0, At, B0); PG8_BAR; PG8_SCHED;
            PG8_LDB(B1, 0, 1); PG8_STAGE(PG8_SB(0, 0), b2, voffB);
            PG8_BAR; PG8_WAIT_L(0); PG8_MMA(0, 1, At, B1); PG8_BAR;
            PG8_LDA(At, 0, 1); PG8_STAGE(PG8_SA(0, 0), a2, voffA);
            PG8_BAR; PG8_WAIT_L(0); PG8_MMA(1, 0, At, B0); PG8_BAR; PG8_SCHED;
            PG8_STAGE(PG8_SB(0, 1), b2 + hstep, voffB);
            PG8_WAIT_V(6); PG8_BAR; PG8_MMA(1, 1, At, B1); PG8_BAR;
            PG8_LDB(B0, 1, 0); PG8_SCHED; PG8_LDA(At, 1, 0); PG8_STAGE(PG8_SA(0, 1), a2 + hstep, voffA);
            PG8_WAIT_L(8); PG8_BAR; PG8_WAIT_L(0); PG8_MMA(0, 0, At, B0); PG8_BAR; PG8_SCHED;
            PG8_LDB(B1, 1, 1); PG8_STAGE(PG8_SB(1, 0), b3, voffB);
            PG8_BAR; PG8_WAIT_L(0); PG8_MMA(0, 1, At, B1); PG8_BAR;
            PG8_LDA(At, 1, 1); PG8_STAGE(PG8_SA(1, 0), a3, voffA);
            PG8_BAR; PG8_WAIT_L(0); PG8_MMA(1, 0, At, B0); PG8_BAR; PG8_SCHED;
            PG8_STAGE(PG8_SB(1, 1), b3 + hstep, voffB);
            PG8_WAIT_V(6); PG8_BAR; PG8_MMA(1, 1, At, B1); PG8_BAR;
            }
        }
        if constexpr (ALIGN_EPI) { if (wr == 0) PG8_BAR; }
        if constexpr (!Epi::AFTER_DRAIN) { E(acc, cur, wr, wc, fr, fq); S.done(cur); }
        if (!has_next) break;
#pragma unroll
        for (int a = 0; a < 2; ++a)
#pragma unroll
            for (int b = 0; b < 2; ++b)
#pragma unroll
                for (int m = 0; m < 4; ++m)
#pragma unroll
                    for (int n = 0; n < 2; ++n) acc[a][b][m][n] = (f32x4){0.f, 0.f, 0.f, 0.f};
        cur = nxt; cA = nA; cB = nB; ++ui;
        if constexpr (ALIGN_EPI) { if (wr == 1) PG8_BAR; }
    }
    PG8_WAIT_V(0);
    if constexpr (!ALIGN_EPI) { if (wr == 0) PG8_BAR; }
    PG8_BAR;
    if constexpr (Epi::AFTER_DRAIN) { E.fused(acc, cur, wr, wc, fr, fq, lds, wid, lane); S.done(cur); }
#undef PG8_SA
#undef PG8_SB
#undef PG8_STAGE
#undef PG8_LDA
#undef PG8_LDB
#undef PG8_MMA
#undef PG8_WAIT_V
#undef PG8_WAIT_L
#undef PG8_BAR
#undef PG8_SCHED
}
}

#define DI __device__ __forceinline__
#define LAS __attribute__((address_space(3)))
typedef unsigned short bf16_t;
typedef short bf16x8 __attribute__((ext_vector_type(8)));
typedef short s16x4 __attribute__((ext_vector_type(4)));
typedef short v4i16_t __attribute__((ext_vector_type(4)));
typedef float f32x4 __attribute__((ext_vector_type(4)));
typedef float f32x16 __attribute__((ext_vector_type(16)));
typedef unsigned u32x4 __attribute__((ext_vector_type(4)));
typedef unsigned u32x2 __attribute__((ext_vector_type(2)));
typedef float f32x2_t __attribute__((ext_vector_type(2)));
typedef __bf16 bf16x2_t __attribute__((ext_vector_type(2)));

constexpr int NWAVES = 8, NTHREADS = 512;
constexpr int SEQ = 8192, DMODEL = 1024, NMETA = 16, LTOK = SEQ + NMETA  , LP = 8256  , NCHUNK = 129;
constexpr int MTOK = 2 * SEQ;
constexpr int MROWS = 16640;
constexpr int NPROJ = 3840;
constexpr int NKT = 129;
constexpr float EPS = 1e-6f;
constexpr float C2Q = 0.125f * 1.4426950408889634f;
constexpr int XS_ROWS = 41216;

constexpr size_t MiB = 1u << 20;
constexpr size_t WS_CTL = 0, CTL_BYTES = 1 * MiB;
constexpr size_t WS_RS1 = 1 * MiB;
constexpr size_t WS_RS2 = WS_RS1 + 128 * 1024;
constexpr size_t WS_TOKE = WS_RS2 + 128 * 1024;
constexpr size_t WS_TOKW = WS_TOKE + 128 * 1024;
constexpr size_t WS_TOKP = WS_TOKW + 128 * 1024;
constexpr size_t WS_SLOTW = WS_TOKP + 128 * 1024;
constexpr size_t WS_WR = WS_SLOTW + 192 * 1024;
constexpr size_t WS_GL = WS_WR + 160 * 1024;
constexpr size_t WS_COS = 2 * MiB;
constexpr size_t WS_SIN = WS_COS + 1280 * 1024;
constexpr size_t WS_GB = WS_SIN + 1280 * 1024;
constexpr size_t WS_WOUT = 6 * MiB;
constexpr size_t WS_WINT = 8 * MiB;
constexpr size_t WS_XB = WS_WINT + (size_t)NPROJ * 1024 * 2;
constexpr size_t WS_MIX = 8 * MiB;
constexpr size_t WS_QKVB = 48 * MiB;
constexpr size_t WS_QB = WS_QKVB + (size_t)2 * LP * 1536 * 2 + 128 * 1024;
constexpr size_t WS_KT = WS_QB + 16 * MiB;
constexpr size_t WS_VT = WS_KT + (size_t)16 * NKT * 4096 * 2;
constexpr size_t WS_ZB = WS_VT + (size_t)8 * NKT * 8192 * 2;
constexpr size_t WS_GP = WS_ZB + (size_t)2 * LP * 512 * 2;
constexpr size_t GP_ARR = (size_t)2064 * 4096 * 2;
constexpr size_t WS_GP_END = WS_GP + 5 * GP_ARR;
constexpr size_t WS_WGU = 48 * MiB;
constexpr size_t WS_WD = 80 * MiB;
constexpr size_t WS_XS = 96 * MiB;
constexpr size_t WS_YO = 96 * MiB;
constexpr size_t WS_YS = WS_XS + (size_t)XS_ROWS * 1024 * 2;
constexpr size_t WS_END = 256 * MiB;
static_assert(WS_GB + (size_t)2 * LP * 16 * 4 <= WS_WOUT, "small region");
static_assert(WS_XB + (size_t)MROWS * 1024 * 2 <= WS_QKVB, "XB");
static_assert(WS_GP_END <= WS_END, "GDN prep arrays");
static_assert(WS_YS + (size_t)XS_ROWS * 256 * 2 <= WS_END, "YS");
static_assert(WS_WD + (size_t)32 * 1024 * 256 * 2 <= WS_XS, "WD");
constexpr int CW_ATTQ = 0;
constexpr int CW_CNT = 64;
constexpr int CW_BAR = 4096;

constexpr int LDS_BYTES = 147456;

struct Params { const float* in[23]; float* out; unsigned char* ws; };

DI unsigned f2bf(float f) { unsigned u = __float_as_uint(f); return (u + 0x7fffu + ((u >> 16) & 1u)) >> 16; }
DI unsigned pk2(float lo, float hi) { f32x2_t v = {lo, hi}; bf16x2_t b = __builtin_convertvector(v, bf16x2_t); return __builtin_bit_cast(unsigned, b); }
DI float bf2f(unsigned short h) { return __uint_as_float(((unsigned)h) << 16); }
DI float rlane(float v, int l) { return __int_as_float(__builtin_amdgcn_readlane(__float_as_int(v), l)); }
#define DPP_ADD(v, ctrl) ((v) + __int_as_float(__builtin_amdgcn_update_dpp(0, __float_as_int(v), (ctrl), 0xF, 0xF, true)))
DI float wave_sum_dpp(float v) {
    v = DPP_ADD(v, 0xB1);
    v = DPP_ADD(v, 0x4E);
    v = DPP_ADD(v, 0x141);
    v = DPP_ADD(v, 0x140);
    return (rlane(v, 0) + rlane(v, 16)) + (rlane(v, 32) + rlane(v, 48));
}
DI float wave_sum(float v) { return wave_sum_dpp(v); }
DI float swz_xor16(float v) { return __int_as_float(__builtin_amdgcn_ds_swizzle(__float_as_int(v), 0x401F)); }
DI float row_sum16(float v) { v = DPP_ADD(v, 0xB1); v = DPP_ADD(v, 0x4E); v = DPP_ADD(v, 0x141); v = DPP_ADD(v, 0x140); return v; }
DI float half_sum32(float v) { v = row_sum16(v); return v + swz_xor16(v); }
DI float swap32_add(float v) { auto rr = __builtin_amdgcn_permlane32_swap(__float_as_uint(v), __float_as_uint(v), false, false); return __uint_as_float(rr[0]) + __uint_as_float(rr[1]); }
DI float swap32_max(float v) { auto rr = __builtin_amdgcn_permlane32_swap(__float_as_uint(v), __float_as_uint(v), false, false); return fmaxf(__uint_as_float(rr[0]), __uint_as_float(rr[1])); }
#define LDS_WAIT() asm volatile("s_waitcnt lgkmcnt(0)" ::: "memory")
#define BAR_LDS() do { asm volatile("s_waitcnt lgkmcnt(0)" ::: "memory"); __builtin_amdgcn_s_barrier(); asm volatile("" ::: "memory"); } while (0)
#define MFMA32(a, b, c) __builtin_amdgcn_mfma_f32_32x32x16_bf16((a), (b), (c), 0, 0, 0)
DI int crow(int r, int hi) { return (r & 3) + 8 * (r >> 2) + 4 * hi; }
DI int perm16(int x) { return (x & ~12) | ((x & 4) << 1) | ((x & 8) >> 1); }
DI bf16x8 pack8(const f32x16& x, int s) {
    u32x4 p; p.x = pk2(x[8 * s], x[8 * s + 1]); p.y = pk2(x[8 * s + 2], x[8 * s + 3]); p.z = pk2(x[8 * s + 4], x[8 * s + 5]); p.w = pk2(x[8 * s + 6], x[8 * s + 7]);
    return __builtin_bit_cast(bf16x8, p);
}
DI int orig_col(int n) {
    if (n >= 1024) return n;
    const int hh = n >> 6, c2 = n & 63, g8 = c2 >> 3, i = c2 & 7;
    return (hh << 6) + ((i < 4) ? 4 * g8 + i : 32 + 4 * g8 + (i - 4));
}
DI size_t kt_off(int b, int hh, int p, int d) {
    const int tile = p < 16 ? 0 : 1 + ((p - 16) >> 6), kv = p < 16 ? p : ((p - 16) & 63);
    return ((size_t)((b * 8 + hh) * NKT + tile) << 12) + ((d >> 3) << 9) + (kv << 3) + (d & 7);
}
DI size_t vt_off(int b, int h, int p, int d) {
    const int tile = p < 16 ? 0 : 1 + ((p - 16) >> 6), kv = p < 16 ? p : ((p - 16) & 63);
    return ((size_t)((b * 4 + h) * NKT + tile) << 13) + ((d >> 5) << 11) + ((kv >> 4) << 9) + ((kv & 15) << 5) + (d & 31);
}

template <class Src> DI void transpose_item(const Src& src, bf16_t* WT, size_t ldk, int k0, int n0, LAS float* scr, int lane) {
#pragma unroll 8
    for (int i = 0; i < 32; ++i) { const int kk = 2 * i + (lane >> 5); scr[kk * 33 + (lane & 31)] = src(k0 + kk, n0 + (lane & 31)); }
    LDS_WAIT();
    const int c = lane & 7;
#pragma unroll
    for (int j = 0; j < 4; ++j) { const int n = (lane >> 3) + 8 * j; const LAS float* s = scr + (8 * c) * 33 + n;
        u32x4 o; o.x = pk2(s[0 * 33], s[1 * 33]); o.y = pk2(s[2 * 33], s[3 * 33]); o.z = pk2(s[4 * 33], s[5 * 33]); o.w = pk2(s[6 * 33], s[7 * 33]);
        *(u32x4*)(WT + (size_t)(n0 + n) * ldk + k0 + 8 * c) = o; }
    LDS_WAIT();
}
struct SrcWin { const float* w; const float* g; DI float operator()(int k, int n) const { return n >= 3600 ? 0.f : w[(size_t)k * 3600 + orig_col(n)] * g[k]; } };
struct SrcPlain { const float* w; int N; DI float operator()(int k, int n) const { return w[(size_t)k * N + n]; } };
struct SrcGU { const float* w; const float* g; int fadj; DI float operator()(int k, int n) const { return w[(size_t)k * 256 + n + fadj] * g[k]; } };

DI void phase0(const Params& P, LAS unsigned char* lds, int gw, int NGW, int gtid, int NGT, int wave, int lane) {
    LAS float* scr = (LAS float*)(lds + wave * 16384);
    bf16_t* WINT = (bf16_t*)(P.ws + WS_WINT); bf16_t* WOUT = (bf16_t*)(P.ws + WS_WOUT); bf16_t* XB = (bf16_t*)(P.ws + WS_XB);
    float* RS1 = (float*)(P.ws + WS_RS1);
    constexpr int I_IN = 16 * (NPROJ / 32), I_OUT = 16 * 32;
    const SrcWin sw{P.in[3], P.in[2]}; const SrcPlain so{P.in[13], 1024};
    for (int it = gw; it < I_IN + I_OUT; it += NGW) {
        if (it < I_IN) transpose_item(sw, WINT, 1024, (it / (NPROJ / 32)) * 64, (it % (NPROJ / 32)) * 32, scr, lane);
        else { const int r = it - I_IN; transpose_item(so, WOUT, 1024, (r >> 5) * 64, (r & 31) * 32, scr, lane); }
    }
    const float* x = P.in[0]; const float* meta = P.in[1];
    for (int m = gw; m < MROWS; m += NGW) {
        u32x2* orow = (u32x2*)(XB + (size_t)m * 1024);
        if (m >= MTOK + NMETA) {
#pragma unroll
            for (int j = 0; j < 4; ++j) orow[64 * j + lane] = (u32x2){0u, 0u};
            if (lane == 0) RS1[m] = 0.f;
            continue;
        }
        const f32x4* xr = (const f32x4*)((m < MTOK) ? x + (size_t)m * 1024 : meta + (size_t)(m - MTOK) * 1024);
        f32x4 v[4]; float s = 0.f;
#pragma unroll
        for (int j = 0; j < 4; ++j) { v[j] = xr[64 * j + lane]; s += (v[j].x * v[j].x + v[j].y * v[j].y) + (v[j].z * v[j].z + v[j].w * v[j].w); }
        s = wave_sum(s);
        if (lane == 0) RS1[m] = 1.0f / sqrtf(s * (1.0f / 1024.0f) + EPS);
#pragma unroll
        for (int j = 0; j < 4; ++j) orow[64 * j + lane] = (u32x2){pk2(v[j].x, v[j].y), pk2(v[j].z, v[j].w)};
    }
    float* COS = (float*)(P.ws + WS_COS); float* SIN = (float*)(P.ws + WS_SIN);
    for (int i = gtid; i < LTOK * 32; i += NGT) {
        const int p = i >> 5, f = i & 31;
        const float inv = exp2f(-(float)f * (13.287712379549449f / 32.0f));
        const float ang = (float)p * inv;
        COS[i] = cosf(ang); SIN[i] = sinf(ang);
    }
    float* WR = (float*)(P.ws + WS_WR); const float* gf = P.in[14]; const float* wgrp = P.in[15]; const float* wrt = P.in[17];
    for (int i = gtid; i < 36 * 1024; i += NGT) { const int j = i >> 10, k = i & 1023; WR[i] = gf[k] * (j < 4 ? wgrp[k * 4 + j] : wrt[k * 32 + (j - 4)]); }
}

struct EpiInProj {
    static constexpr bool PERM = true, AFTER_DRAIN = false;
    const float* RS1; const float* COS; const float* SIN; const float* a_log; const float* dt_bias;
    bf16_t* QB; bf16_t* KT; bf16_t* VT; bf16_t* QKVB; bf16_t* ZB; float* GB;
    DI void operator()(const pg8::f32x4 (&acc)[2][2][4][2], const pg8::Unit& u, int wr, int wc, int fr, int fq) const {
        const int pn = u.pn;
#pragma unroll
        for (int ai = 0; ai < 2; ++ai)
#pragma unroll
            for (int m = 0; m < 4; ++m) {
                const int row = u.pm * 256 + ai * 128 + wr * 64 + m * 16 + fr;
                if (row < MTOK + NMETA) {
                    const float rs = RS1[row];
                    const bool meta = row >= MTOK;
                    const int p = meta ? row - MTOK : (row & 8191) + NMETA;
                    const int b0 = meta ? 0 : (row >> 13), nb = meta ? 2 : 1;
#pragma unroll
                    for (int bj = 0; bj < 2; ++bj) {
                        float xv[8];
#pragma unroll
                        for (int i = 0; i < 4; ++i) { xv[i] = acc[ai][bj][m][0][i] * rs; xv[4 + i] = acc[ai][bj][m][1][i] * rs; }
                        if (pn < 4) {
                            const int hh = (pn & 1) * 4 + bj * 2 + (wc >> 1), d0 = 4 * (4 * (wc & 1) + fq);
                            const f32x4 cs = *(const f32x4*)(COS + p * 32 + d0), sn = *(const f32x4*)(SIN + p * 32 + d0);
                            float lo[4], hi[4];
#pragma unroll
                            for (int i = 0; i < 4; ++i) { lo[i] = xv[i] * cs[i] - xv[4 + i] * sn[i]; hi[i] = xv[4 + i] * cs[i] + xv[i] * sn[i]; }
                            if (pn < 2) {
                                if (!meta) {
                                    bf16_t* q = QB + ((size_t)((b0 * 8 + hh) * SEQ + (p - NMETA)) << 6) + d0;
                                    *(u32x2*)q = (u32x2){pk2(lo[0] * C2Q, lo[1] * C2Q), pk2(lo[2] * C2Q, lo[3] * C2Q)};
                                    *(u32x2*)(q + 32) = (u32x2){pk2(hi[0] * C2Q, hi[1] * C2Q), pk2(hi[2] * C2Q, hi[3] * C2Q)};
                                }
                            } else {
                                for (int bb = b0; bb < b0 + nb; ++bb) {
                                    *(u32x2*)(KT + kt_off(bb, hh, p, d0)) = (u32x2){pk2(lo[0], lo[1]), pk2(lo[2], lo[3])};
                                    *(u32x2*)(KT + kt_off(bb, hh, p, d0 + 32)) = (u32x2){pk2(hi[0], hi[1]), pk2(hi[2], hi[3])};
                                }
                            }
                        } else {
                            const u32x4 w = (u32x4){pk2(xv[0], xv[1]), pk2(xv[2], xv[3]), pk2(xv[4], xv[5]), pk2(xv[6], xv[7])};
                            const int cl = bj * 128 + wc * 32 + fq * 8;
                            if (pn < 6) {
                                const int h = (pn - 4) * 2 + bj, d = wc * 32 + fq * 8;
                                for (int bb = b0; bb < b0 + nb; ++bb) *(u32x4*)(VT + vt_off(bb, h, p, d)) = w;
                            } else if (pn < 12) {
                                for (int bb = b0; bb < b0 + nb; ++bb) *(u32x4*)(QKVB + (size_t)(bb * LP + p) * 1536 + (pn - 6) * 256 + cl) = w;
                            } else if (pn < 14) {
                                float sz[8];
#pragma unroll
                                for (int i = 0; i < 8; ++i) sz[i] = xv[i] * __builtin_amdgcn_rcpf(1.0f + __expf(-xv[i]));
                                const u32x4 wz = (u32x4){pk2(sz[0], sz[1]), pk2(sz[2], sz[3]), pk2(sz[4], sz[5]), pk2(sz[6], sz[7])};
                                for (int bb = b0; bb < b0 + nb; ++bb) *(u32x4*)(ZB + (size_t)(bb * LP + p) * 512 + (pn - 12) * 256 + cl) = wz;
                            } else if (cl < 16) {
                                float o[8];
                                if (cl == 0) {
#pragma unroll
                                    for (int i = 0; i < 8; ++i) { const float t = xv[i] + dt_bias[i]; const float sp = t > 20.f ? t : log1pf(expf(t)); o[i] = -expf(a_log[i]) * sp; }
                                } else {
#pragma unroll
                                    for (int i = 0; i < 8; ++i) o[i] = 1.0f / (1.0f + expf(-xv[i]));
                                }
                                for (int bb = b0; bb < b0 + nb; ++bb) { float* g = GB + ((size_t)(bb * LP + p) << 4) + cl;
                                    *(f32x4*)g = (f32x4){o[0], o[1], o[2], o[3]}; *(f32x4*)(g + 4) = (f32x4){o[4], o[5], o[6], o[7]}; }
                            }
                        }
                    }
                }
            }
    }
};

DI bf16x8 lds_frag(LAS const bf16_t* M, int row, int ch) { return *(LAS const bf16x8*)((LAS const unsigned char*)M + row * 128 + ((ch ^ (row & 7)) << 4)); }
DI bf16x8 lds_frag_plain(LAS const bf16_t* M, int row, int ch) { return *(LAS const bf16x8*)((LAS const unsigned char*)M + row * 128 + (ch << 4)); }
DI int swz_idx(int row, int d) { return row * 64 + ((((d >> 3) ^ (row & 7)) << 3) | (d & 7)); }

constexpr int PREP_PAIR = 35840;

template <int MAT> DI void prep_rows(const bf16_t* QKVB, const float* cw, int b, int h, int n, int lane, LAS const float* egS,
                                     LAS bf16_t* DS  , bf16_t* QG) {
    const int col = MAT * 512 + h * 64 + lane, p0 = n * 64;
    const float c0 = cw[col], c1 = cw[1536 + col], c2 = cw[3072 + col], c3 = cw[4608 + col];
    const bf16_t* rp = QKVB + (size_t)(b * LP + p0) * 1536 + col;
    float x0 = 0.f, x1 = 0.f, x2 = 0.f;
    if (n > 0) { x0 = bf2f(rp[-3 * 1536]); x1 = bf2f(rp[-2 * 1536]); x2 = bf2f(rp[-1 * 1536]); }
    const int nvalid = (LTOK - p0) < 64 ? (LTOK - p0) : 64;
#pragma unroll 4
    for (int c = 0; c < 64; ++c) {
        const bool valid = c < nvalid;
        const float x3 = valid ? bf2f(*rp) : 0.f;
        rp += 1536;
        float y = c0 * x0 + c1 * x1 + c2 * x2 + c3 * x3;
        y = y * __builtin_amdgcn_rcpf(1.0f + __expf(-y));
        if (!valid) y = 0.f;
        x0 = x1; x1 = x2; x2 = x3;
        if (MAT == 2) { DS[c * 64 + lane] = (bf16_t)f2bf(y); }
        else {
            const float ss = wave_sum(y * y);
            const float yn = y * __builtin_amdgcn_rsqf(ss + EPS);
            if (MAT == 0) {
                const float qn = yn * 0.125f;
                DS[c * 64 + lane] = (bf16_t)f2bf(qn);
                QG[c * 64 + perm16(lane)] = (bf16_t)f2bf(qn * egS[c]);
            } else {
                DS[c * 64 + lane] = (bf16_t)f2bf(yn);
            }
        }
    }
}

DI void solve_blocked(LAS const float* AST, LAS bf16_t* XB, LAS const float* scl, int lane, float sgn, bf16_t* out, int ocol) {
    for (int b = 0; b < 4; ++b) {
        float s[16];
#pragma unroll
        for (int r = 0; r < 16; ++r) s[r] = bf2f(XB[(16 * b + r) * 64 + lane]) * scl[16 * b + r];
        for (int j = 0; j < 16 * b; ++j) {
            const float xj = bf2f(XB[j * 64 + lane]);
            LAS const f32x4* ap = (LAS const f32x4*)(AST + j * 68 + 16 * b);
            const f32x4 a0 = ap[0], a1 = ap[1], a2 = ap[2], a3 = ap[3];
#pragma unroll
            for (int r = 0; r < 4; ++r) { s[r] -= a0[r] * xj; s[4 + r] -= a1[r] * xj; s[8 + r] -= a2[r] * xj; s[12 + r] -= a3[r] * xj; }
        }
#pragma unroll
        for (int jj = 0; jj < 15; ++jj) {
            const float xj = s[jj];
            LAS const float* ap = AST + (16 * b + jj) * 68 + 16 * b;
#pragma unroll
            for (int r = jj + 1; r < 16; ++r) s[r] -= ap[r] * xj;
        }
#pragma unroll
        for (int r = 0; r < 16; ++r) { XB[(16 * b + r) * 64 + lane] = (bf16_t)f2bf(s[r]); out[(16 * b + r) * 64 + ocol] = (bf16_t)f2bf(sgn * s[r]); }
    }
}

DI void gdn_prep_phase(const Params& P, LAS unsigned char* lds, int blk, int G, int wave, int lane_in) {
    const int pair = wave >> 1, role = wave & 1;
    LAS unsigned char* pb = lds + pair * PREP_PAIR;
    LAS bf16_t* QS = (LAS bf16_t*)pb; LAS bf16_t* KS = (LAS bf16_t*)(pb + 8192); LAS float* AS = (LAS float*)(pb + 16384);
    LAS float* gcS = (LAS float*)(pb + 16384 + 17408 + role * 1024); LAS float* betaS = gcS + 64; LAS float* egS = gcS + 128; LAS float* ekS = gcS + 192;
    const bf16_t* QKVB = (const bf16_t*)(P.ws + WS_QKVB); const float* GB = (const float*)(P.ws + WS_GB); const float* cw = P.in[9];
    const int NP = G * 4, NTASK = 2 * 8 * NCHUNK;
    for (int it = 0; it * NP < NTASK; ++it) {
        int lane = lane_in; asm volatile("" : "+v"(lane));
        const int r32 = lane & 31, hi = lane >> 5;
        const int task = it * NP + blk * 4 + pair;
        const bool active = task < NTASK;
        const int b = task / (8 * NCHUNK), h = (task / NCHUNK) & 7, n = task % NCHUNK;
        bf16_t* GPW = (bf16_t*)(P.ws + WS_GP) + (size_t)task * 4096; bf16_t* GPQG = GPW + GP_ARR / 2; bf16_t* GPAQK = GPQG + GP_ARR / 2; bf16_t* GPKGT = GPAQK + GP_ARR / 2; bf16_t* GPU = GPKGT + GP_ARR / 2;
        float gc = 0.f, beta = 0.f;
        if (active) {
            const int pl = n * 64 + lane;
            float g = 0.f;
            if (pl < LTOK) { const float* gb = GB + ((size_t)(b * LP + pl) << 4); g = gb[h]; beta = gb[8 + h]; }
            gcS[lane] = g; LDS_WAIT();
            gc = 0.f;
#pragma unroll
            for (int j4 = 0; j4 < 16; ++j4) { const f32x4 t = *(LAS const f32x4*)(gcS + 4 * j4);
                gc += (4 * j4 <= lane ? t[0] : 0.f) + (4 * j4 + 1 <= lane ? t[1] : 0.f) + (4 * j4 + 2 <= lane ? t[2] : 0.f) + (4 * j4 + 3 <= lane ? t[3] : 0.f); }
            const float glast = rlane(gc, 63);
            LDS_WAIT();
            gcS[lane] = gc; betaS[lane] = beta; egS[lane] = (role == 0) ? __expf(gc) : beta * __expf(gc); ekS[lane] = __expf(glast - gc);
            if (role == 0 && lane == 0) ((float*)(P.ws + WS_GL))[task] = __expf(glast);
            LDS_WAIT();
            if (role == 0) prep_rows<0>(QKVB, cw, b, h, n, lane, egS, QS, GPQG);
            else prep_rows<1>(QKVB, cw, b, h, n, lane, egS, KS, GPQG);
        }
        LDS_WAIT();
        __syncthreads();
        if (active) {
#pragma unroll
            for (int t4 = 0; t4 < 4; ++t4) {
                const int ct = t4 >> 1, st = t4 & 1;
                f32x16 acc = {};
                if (!(ct == 0 && st == 1)) {
#pragma unroll
                    for (int ks = 0; ks < 4; ++ks) {
                        const bf16x8 fa = lds_frag_plain(role == 0 ? QS : KS, 32 * ct + r32, 2 * ks + hi), fb = lds_frag_plain(KS, 32 * st + r32, 2 * ks + hi);
                        acc = MFMA32(fa, fb, acc);
                    }
                }
                const float gcs = gcS[32 * st + r32];
                bf16_t* aqb = GPAQK + hi * 256 + perm16(r32); LAS float* asb = AS + r32 * 68 + hi * 4;        LAS const float* gcb = gcS + hi * 4; LAS const float* beb = betaS + hi * 4;
                asm volatile("" : "+v"(aqb), "+v"(asb), "+v"(gcb), "+v"(beb));
#pragma unroll
                for (int i = 0; i < 16; ++i) {
                    const int cr = 32 * ct + (i & 3) + 8 * (i >> 2);
                    const int cmp = (32 * st + r32) - 4 * hi;
                    const float dec = __expf(gcb[cr] - gcs);
                    if (role == 0) aqb[cr * 64 + 32 * st] = (bf16_t)f2bf((cmp <= cr) ? acc[i] * dec : 0.f);
                    else asb[32 * st * 68 + cr] = (cmp < cr) ? acc[i] * beb[cr] * dec : 0.f;
                }
            }
        }
        LDS_WAIT();
        __syncthreads();
        if (active) {
            if (role == 0) {
                prep_rows<2>(QKVB, cw, b, h, n, lane, egS, QS  , GPQG);
                LDS_WAIT();
                solve_blocked(AS, QS, betaS, lane, 1.0f, GPU, lane);
            } else {
#pragma unroll
                for (int gq = 0; gq < 8; ++gq) {
                    float t[8];
#pragma unroll
                    for (int j = 0; j < 8; ++j) { const int c = perm16(8 * gq + j); t[j] = bf2f(KS[c * 64 + lane]) * ekS[c]; }
                    *(u32x4*)(GPKGT + lane * 64 + 8 * gq) = (u32x4){pk2(t[0], t[1]), pk2(t[2], t[3]), pk2(t[4], t[5]), pk2(t[6], t[7])};
                }
                solve_blocked(AS, KS, egS, lane, -1.0f, GPW, perm16(lane));
            }
        }
        LDS_WAIT();
    }
}

constexpr int GS_STAGE = 40960 + 256;
constexpr int GS_OBUF = 2 * GS_STAGE;
static_assert(GS_OBUF + 32768 <= 131072, "gdn scan LDS");

#define GS_STEP(n, HW, HGW, STGW) do { \
        if (wave < 2) { \
            if (n < NCHUNK) { \
                LAS const unsigned char* sg = lds + (n & 1) * GS_STAGE; \
                LAS const bf16_t* Wm = (LAS const bf16_t*)sg; LAS const bf16_t* QGm = (LAS const bf16_t*)(sg + 8192); LAS const bf16_t* AQm = (LAS const bf16_t*)(sg + 16384); \
                LAS const bf16_t* KGm = (LAS const bf16_t*)(sg + 24576); LAS const bf16_t* Um = (LAS const bf16_t*)(sg + 32768); \
                const float gl = *(LAS const float*)(sg + 40960); \
                bf16x8 Sb[2][2]; Sb[0][0] = pack8(S0, 0); Sb[0][1] = pack8(S0, 1); Sb[1][0] = pack8(S1, 0); Sb[1][1] = pack8(S1, 1); \
                f32x16 vn[2], o[2]; \
        _Pragma("unroll") \
                for (int ct = 0; ct < 2; ++ct) { \
                    f32x16 acc; \
        _Pragma("unroll") \
                    for (int i = 0; i < 16; ++i) acc[i] = bf2f(Um[(32 * ct + crow(i, hi)) * 64 + vbase + r32]); \
                    f32x16 oo = {}; \
        _Pragma("unroll") \
                    for (int kt = 0; kt < 2; ++kt) \
        _Pragma("unroll") \
                        for (int s2 = 0; s2 < 2; ++s2) { \
                            acc = MFMA32(lds_frag(Wm, 32 * ct + r32, (2 * kt + s2) * 2 + hi), Sb[kt][s2], acc); \
                            oo = MFMA32(lds_frag(QGm, 32 * ct + r32, (2 * kt + s2) * 2 + hi), Sb[kt][s2], oo); \
                        } \
                    vn[ct] = acc; o[ct] = oo; \
                } \
                bf16x8 Vb[2][2]; Vb[0][0] = pack8(vn[0], 0); Vb[0][1] = pack8(vn[0], 1); Vb[1][0] = pack8(vn[1], 0); Vb[1][1] = pack8(vn[1], 1); \
        _Pragma("unroll") \
                for (int i = 0; i < 16; ++i) { S0[i] *= gl; S1[i] *= gl; } \
        _Pragma("unroll") \
                for (int ct = 0; ct < 2; ++ct) \
        _Pragma("unroll") \
                    for (int s2 = 0; s2 < 2; ++s2) { \
                        const int ch = (2 * ct + s2) * 2 + hi; \
                        o[0] = MFMA32(lds_frag(AQm, r32, ch), Vb[ct][s2], o[0]); \
                        o[1] = MFMA32(lds_frag(AQm, 32 + r32, ch), Vb[ct][s2], o[1]); \
                        S0 = MFMA32(lds_frag(KGm, r32, ch), Vb[ct][s2], S0); \
                        S1 = MFMA32(lds_frag(KGm, 32 + r32, ch), Vb[ct][s2], S1); \
                    } \
                LAS float* ob = (LAS float*)(lds + GS_OBUF + (n & 1) * 16384); \
        _Pragma("unroll") \
                for (int ct = 0; ct < 2; ++ct) \
        _Pragma("unroll") \
                    for (int i = 0; i < 16; ++i) ob[(32 * ct + crow(i, hi)) * 64 + vbase + r32] = o[ct][i]; \
            } \
        } else if (wave < 4) { \
            if (n > 0) { \
                LAS const float* ob = (LAS const float*)(lds + GS_OBUF + ((n - 1) & 1) * 16384); \
                const f32x4 gn = *(const f32x4*)(gnorm + 4 * vq); \
        _Pragma("unroll") \
                for (int it = 0; it < 8; ++it) { \
                    const int c = (wave - 2) * 32 + 4 * it + rg, p = (n - 1) * 64 + c; \
                    const f32x4 v = *(LAS const f32x4*)(ob + c * 64 + 4 * vq); \
                    const float ss = row_sum16((v[0] * v[0] + v[1] * v[1]) + (v[2] * v[2] + v[3] * v[3])); \
                    const float rn = __builtin_amdgcn_rsqf(ss * (1.0f / 64.0f) + EPS); \
                    const u32x2 zz = zq[it]; \
                    const float z0 = __uint_as_float(zz.x << 16), z1 = __uint_as_float(zz.x & 0xffff0000u), z2 = __uint_as_float(zz.y << 16), z3 = __uint_as_float(zz.y & 0xffff0000u); \
                    const float y0 = v[0] * rn * gn[0] * z0, y1 = v[1] * rn * gn[1] * z1, y2 = v[2] * rn * gn[2] * z2, y3 = v[3] * rn * gn[3] * z3; \
                    if ((p >= NMETA) && (p < LTOK)) *(u32x2*)(MIX + (size_t)(b * SEQ + p - NMETA) * 1024 + 512 + h * 64 + 4 * vq) = (u32x2){pk2(y0, y1), pk2(y2, y3)}; \
                } \
            } \
            if (n < NCHUNK) { GS_ZLOAD(n); } \
        } else { \
            if (n + 1 < NCHUNK) { GS_WRITE(HW, HGW, STGW); if (n + 2 < NCHUNK) GS_ISSUE(HW, HGW, n + 2); } \
        } \
        BAR_LDS(); } while (0)
DI void gdn_scan(const Params& P, LAS unsigned char* lds, int bh, int tid, int wave, int lane) {
    const int b = bh >> 3, h = bh & 7, r32 = lane & 31, hi = lane >> 5;
    const int task0 = (b * 8 + h) * NCHUNK;
    const bf16_t* GP0 = (const bf16_t*)(P.ws + WS_GP);
    const float* GLg = (const float*)(P.ws + WS_GL);
    const bf16_t* ZB = (const bf16_t*)(P.ws + WS_ZB); bf16_t* MIX = (bf16_t*)(P.ws + WS_MIX); const float* gnorm = P.in[12];
    const int lt = tid - 256;
    u32x4 holdA[10]; float hglA = 0.f;
#define GS_ISSUE(H, HG, n_) do { _Pragma("unroll") for (int i = 0; i < 10; ++i) { const int a_ = i >> 1, e_ = lt + 256 * (i & 1); \
            H[i] = *(const u32x4*)(GP0 + (size_t)a_ * (GP_ARR / 2) + (size_t)(task0 + (n_)) * 4096 + e_ * 8); } \
        if (lt == 0) HG = GLg[task0 + (n_)]; } while (0)
#define GS_WRITE(H, HG, stg_) do { LAS unsigned char* sg_ = lds + (stg_) * GS_STAGE; \
        _Pragma("unroll") for (int i = 0; i < 10; ++i) { const int a_ = i >> 1, e_ = lt + 256 * (i & 1), row_ = e_ >> 3, ch_ = e_ & 7; \
            *(LAS u32x4*)(sg_ + a_ * 8192 + row_ * 128 + (((a_ < 4) ? (ch_ ^ (row_ & 7)) : ch_) << 4)) = H[i]; } \
        if (lt == 0) *(LAS float*)(sg_ + 40960) = HG; } while (0)
    const int vq = lane & 15, rg = lane >> 4;
    u32x2 zq[8];
#define GS_ZLOAD(n_) do { _Pragma("unroll") for (int it = 0; it < 8; ++it) { int p_ = (n_) * 64 + (wave - 2) * 32 + 4 * it + rg; p_ = p_ < LTOK ? p_ : LTOK - 1; \
            zq[it] = *(const u32x2*)(ZB + (size_t)(b * LP + p_) * 512 + h * 64 + 4 * vq); } } while (0)
    if (wave >= 4) { GS_ISSUE(holdA, hglA, 0); GS_WRITE(holdA, hglA, 0); GS_ISSUE(holdA, hglA, 1); }
    if (wave == 2 || wave == 3) { GS_ZLOAD(0); }
    __syncthreads();
    f32x16 S0 = {}, S1 = {};
    const int vbase = 32 * wave;
    for (int n2 = 0; n2 <= NCHUNK; n2 += 2) { GS_STEP((n2), holdA, hglA, 1); GS_STEP((n2 + 1), holdA, hglA, 0); }
}

constexpr int AT_STAGE = 32768;
constexpr int AT_XBUF = 2 * AT_STAGE;
constexpr int AT_WSF = AT_XBUF + 65536;
constexpr int AT_UNIT = AT_WSF + 2048;
constexpr float AT_THR = 8.0f;

DI s16x4 tr_read(LAS const unsigned char* p) { return __builtin_bit_cast(s16x4, __builtin_amdgcn_ds_read_tr16_b64_v4i16((LAS v4i16_t*)p)); }

DI void attn_unit(const Params& P, LAS unsigned char* lds, int bh, int qi, int tid, int wave, int lane, float lam) {
    const int b = bh >> 2, h = bh & 3, r32 = lane & 31, hi = lane >> 5, qsub = wave >> 1, map = wave & 1, hh = 2 * h + map;
    const bf16_t* QB = (const bf16_t*)(P.ws + WS_QB); const bf16_t* KT = (const bf16_t*)(P.ws + WS_KT); const bf16_t* VT = (const bf16_t*)(P.ws + WS_VT);
    const int ntiles = 2 * qi + 3, my_nt = (qsub < 2) ? ntiles - 1 : ntiles;
    const bf16_t* k1 = KT + ((size_t)((b * 8 + 2 * h) * NKT) << 12) + tid * 8;
    const bf16_t* k2 = KT + ((size_t)((b * 8 + 2 * h + 1) * NKT) << 12) + tid * 8;
    const bf16_t* vv = VT + ((size_t)((b * 4 + h) * NKT) << 13) + tid * 8;
    u32x4 st[4];
#define AT_LOAD(t) do { st[0] = *(const u32x4*)(k1 + ((size_t)(t) << 12)); st[1] = *(const u32x4*)(k2 + ((size_t)(t) << 12)); \
                        st[2] = *(const u32x4*)(vv + ((size_t)(t) << 13)); st[3] = *(const u32x4*)(vv + ((size_t)(t) << 13) + 4096); } while (0)
#define AT_STORE(sb) do { LAS unsigned char* d_ = lds + (sb) * AT_STAGE + tid * 16; *(LAS u32x4*)d_ = st[0]; *(LAS u32x4*)(d_ + 8192) = st[1]; \
                          *(LAS u32x4*)(d_ + 16384) = st[2]; *(LAS u32x4*)(d_ + 24576) = st[3]; } while (0)
    AT_LOAD(0);
    bf16x8 qr[4];
    { const bf16_t* q = QB + ((size_t)((b * 8 + hh) * SEQ + qi * 128 + qsub * 32 + r32) << 6) + hi * 8;
#pragma unroll
      for (int d0 = 0; d0 < 4; ++d0) qr[d0] = *(const bf16x8*)(q + d0 * 16); }
    AT_STORE(0);
    __syncthreads();
    LAS float* wsf = (LAS float*)(lds + AT_WSF) + wave * 64;
    float m_run = -1e30f, l_run = 0.f;
    f32x16 o[4]; o[0] = f32x16{}; o[1] = f32x16{}; o[2] = f32x16{}; o[3] = f32x16{};
    for (int t = 0; t < ntiles; ++t) {
        if (t + 1 < ntiles) AT_LOAD(t + 1);
        if (t < my_nt) {
            LAS const unsigned char* sg = lds + (t & 1) * AT_STAGE;
            LAS const unsigned char* kb = sg + map * 8192 + hi * 1024 + r32 * 16;
            f32x16 p0 = {}, p1 = {};
#pragma unroll
            for (int d0 = 0; d0 < 4; ++d0) {
                const bf16x8 a0 = *(LAS const bf16x8*)(kb + d0 * 2048), a1 = *(LAS const bf16x8*)(kb + d0 * 2048 + 512);
                p0 = MFMA32(a0, qr[d0], p0); p1 = MFMA32(a1, qr[d0], p1);
            }
            if (t == 0) {
#pragma unroll
                for (int r = 0; r < 16; ++r) { if (crow(r, hi) >= NMETA) p0[r] = -INFINITY; p1[r] = -INFINITY; }
            }
            float rm = fmaxf(p0[0], p1[0]);
#pragma unroll
            for (int r = 1; r < 16; ++r) rm = fmaxf(rm, fmaxf(p0[r], p1[r]));
            rm = swap32_max(rm);
            if (__any(rm > m_run + AT_THR)) {
                const float mn = fmaxf(m_run, rm), alpha = exp2f(m_run - mn);
                l_run *= alpha; m_run = mn;
                if (hi == 0) wsf[r32] = alpha;
                LDS_WAIT();
#pragma unroll
                for (int r = 0; r < 16; ++r) { const float a = wsf[crow(r, hi)];
#pragma unroll
                    for (int d0 = 0; d0 < 4; ++d0) o[d0][r] *= a; }
                LDS_WAIT();
            }
            float ls = 0.f;
#pragma unroll
            for (int r = 0; r < 16; ++r) { p0[r] = exp2f(p0[r] - m_run); p1[r] = exp2f(p1[r] - m_run); ls += p0[r] + p1[r]; }
            l_run += ls;
            const bf16x8 pa0 = pack8(p0, 0), pa1 = pack8(p0, 1), pa2 = pack8(p1, 0), pa3 = pack8(p1, 1);
            LAS const unsigned char* vb = sg + 16384 + ((lane >> 4) & 1) * 32 + (lane & 3) * 8 + (4 * hi + ((lane & 15) >> 2)) * 64;
#pragma unroll
            for (int d0 = 0; d0 < 4; ++d0) {
#define AT_VF(ks) ({ const s16x4 lo_ = tr_read(vb + d0 * 4096 + (ks) * 1024), hi_ = tr_read(vb + d0 * 4096 + (ks) * 1024 + 512); \
                     (bf16x8){lo_[0], lo_[1], lo_[2], lo_[3], hi_[0], hi_[1], hi_[2], hi_[3]}; })
                o[d0] = MFMA32(pa0, AT_VF(0), o[d0]); o[d0] = MFMA32(pa1, AT_VF(1), o[d0]);
                o[d0] = MFMA32(pa2, AT_VF(2), o[d0]); o[d0] = MFMA32(pa3, AT_VF(3), o[d0]);
#undef AT_VF
            }
        }
        if (t + 1 < ntiles) AT_STORE((t + 1) & 1);
        __syncthreads();
    }
    l_run = swap32_add(l_run);
    const float sc = (map ? lam : 1.0f) / l_run;
    if (hi == 0) wsf[r32] = sc;
    LDS_WAIT();
#pragma unroll
    for (int r = 0; r < 16; ++r) { const float a = wsf[crow(r, hi)];
#pragma unroll
        for (int d0 = 0; d0 < 4; ++d0) o[d0][r] *= a; }
    LAS float* xb = (LAS float*)(lds + AT_XBUF + qsub * 16384);
    if (map) {
#pragma unroll
        for (int d0 = 0; d0 < 4; ++d0)
#pragma unroll
            for (int r = 0; r < 16; ++r) xb[(d0 * 16 + r) * 64 + lane] = o[d0][r];
    }
    __syncthreads();
    if (!map) {
        const float* dn = P.in[8];
        bf16_t* MIX = (bf16_t*)(P.ws + WS_MIX);
        float ss[16];
#pragma unroll
        for (int r = 0; r < 16; ++r) { ss[r] = 0.f;
#pragma unroll
            for (int d0 = 0; d0 < 4; ++d0) { o[d0][r] -= xb[(d0 * 16 + r) * 64 + lane]; ss[r] += o[d0][r] * o[d0][r]; } }
#pragma unroll
        for (int r = 0; r < 16; ++r) {
            ss[r] = half_sum32(ss[r]);
            ss[r] = 0.8f / sqrtf(ss[r] * (1.0f / 128.0f) + EPS);
        }
        float dg[4];
#pragma unroll
        for (int d0 = 0; d0 < 4; ++d0) dg[d0] = dn[32 * d0 + r32];
#pragma unroll
        for (int r = 0; r < 16; ++r) {
            bf16_t* orow = MIX + (size_t)(b * SEQ + qi * 128 + qsub * 32 + crow(r, hi)) * 1024 + h * 128 + r32;
#pragma unroll
            for (int d0 = 0; d0 < 4; ++d0) orow[32 * d0] = (bf16_t)f2bf(o[d0][r] * ss[r] * dg[d0]);
        }
    }
    __syncthreads();
#undef AT_LOAD
#undef AT_STORE
}

DI void attn_phase(const Params& P, LAS unsigned char* lds, int tid, int wave, int lane) {
    unsigned* ctl = (unsigned*)(P.ws + WS_CTL);
    const float* lq1 = P.in[4]; const float* lk1 = P.in[5]; const float* lq2 = P.in[6]; const float* lk2 = P.in[7];
    const float lam = __expf(wave_sum(lq1[lane] * lk1[lane])) - __expf(wave_sum(lq2[lane] * lk2[lane])) + 0.2f;
    LAS volatile int* ub = (LAS volatile int*)(lds + AT_UNIT);
    for (;;) {
        if (tid == 0) *ub = (int)__hip_atomic_fetch_add(ctl + CW_ATTQ, 1u, __ATOMIC_RELAXED, __HIP_MEMORY_SCOPE_AGENT);
        __syncthreads();
        const int u = *ub;
        __syncthreads();
        if (u >= 512) break;
        attn_unit(P, lds, u & 7, 63 - (u >> 3), tid, wave, lane, lam);
    }
}

struct EpiOutProj {
    static constexpr bool PERM = false, AFTER_DRAIN = false;
    const float* x; float* out;
    DI void operator()(const pg8::f32x4 (&acc)[2][2][4][2], const pg8::Unit& u, int wr, int wc, int fr, int fq) const {
        const int row0 = u.pm * 256 + wr * 64 + fr, col0 = u.pn * 256 + wc * 32 + 4 * fq;
#pragma unroll
        for (int ai = 0; ai < 2; ++ai)
#pragma unroll
            for (int m = 0; m < 4; ++m) { const size_t off = (size_t)(row0 + ai * 128 + m * 16) * 1024 + col0;
#pragma unroll
                for (int bj = 0; bj < 2; ++bj)
#pragma unroll
                    for (int n = 0; n < 2; ++n) { const f32x4 xv = *(const f32x4*)(x + off + bj * 128 + n * 16); *(f32x4*)(out + off + bj * 128 + n * 16) = acc[ai][bj][m][n] + xv; } }
    }
};

typedef float f32x4v __attribute__((ext_vector_type(4)));
DI void route_tile(const Params& P, int tile, LAS float* lg  , int lane) {
    const float* h2 = P.out; const float* WR = (const float*)(P.ws + WS_WR);
    const int r16 = lane & 15, kq = lane >> 4;
    const float* arow = h2 + (size_t)(tile * 16 + r16) * 1024 + kq * 256;
    const float* b0 = WR + (size_t)r16 * 1024 + kq * 256; const float* b1 = b0 + 16 * 1024; const float* b2 = WR + (size_t)(32 + (r16 & 3)) * 1024 + kq * 256;
    const float z2 = (r16 < 4) ? 1.0f : 0.0f;
    f32x4v c0 = {}, c1 = {}, c2 = {};
    float ss = 0.f;
    for (int t4 = 0; t4 < 64; ++t4) {
        const f32x4 a = *(const f32x4*)(arow + 4 * t4), w0 = *(const f32x4*)(b0 + 4 * t4), w1 = *(const f32x4*)(b1 + 4 * t4), w2 = *(const f32x4*)(b2 + 4 * t4);
        ss += (a.x * a.x + a.y * a.y) + (a.z * a.z + a.w * a.w);
#pragma unroll
        for (int i = 0; i < 4; ++i) {
            c0 = __builtin_amdgcn_mfma_f32_16x16x4f32(a[i], w0[i], c0, 0, 0, 0);
            c1 = __builtin_amdgcn_mfma_f32_16x16x4f32(a[i], w1[i], c1, 0, 0, 0);
            c2 = __builtin_amdgcn_mfma_f32_16x16x4f32(a[i], w2[i] * z2, c2, 0, 0, 0);
        }
    }
    ss += swz_xor16(ss); ss = swap32_add(ss);
    const float rs = 1.0f / sqrtf(ss * (1.0f / 1024.0f) + EPS);
#pragma unroll
    for (int r = 0; r < 4; ++r) { const int row = 4 * kq + r; lg[row * 48 + r16] = c0[r]; lg[row * 48 + 16 + r16] = c1[r]; lg[row * 48 + 32 + r16] = c2[r]; }
    LDS_WAIT();
    if (lane < 16) {
        const int t = tile * 16 + lane;
        const float* bg = P.in[16]; const float* br = P.in[18];
        LAS const float* l = lg + lane * 48;
        float gl[4]; int gs = 0; float gm;
#pragma unroll
        for (int j = 0; j < 4; ++j) gl[j] = l[j] * rs + bg[j];
        gm = gl[0];
#pragma unroll
        for (int j = 1; j < 4; ++j) if (gl[j] > gm) { gm = gl[j]; gs = j; }
        float gsum = 0.f;
#pragma unroll
        for (int j = 0; j < 4; ++j) gsum += __expf(gl[j] - gm);
        const float psel = 1.0f / gsum;
        float e1 = -INFINITY, e2 = -INFINITY; int i1 = 0, i2 = 0;
#pragma unroll
        for (int j = 0; j < 8; ++j) {
            const float v = l[4 + gs * 8 + j] * rs + br[gs * 8 + j];
            if (v > e1) { e2 = e1; i2 = i1; e1 = v; i1 = j; } else if (v > e2) { e2 = v; i2 = j; }
        }
        const float x2 = __expf(e2 - e1), w1 = psel / (1.0f + x2), w2 = psel * x2 / (1.0f + x2);
        const int ea = gs * 8 + i1, eb = gs * 8 + i2;
        unsigned* cnt = (unsigned*)(P.ws + WS_CTL) + CW_CNT;
        const int pa = (int)atomicAdd(cnt + ea, 1u), pb = (int)atomicAdd(cnt + eb, 1u);
        ((int*)(P.ws + WS_TOKE))[2 * t] = ea; ((int*)(P.ws + WS_TOKE))[2 * t + 1] = eb;
        ((float*)(P.ws + WS_TOKW))[2 * t] = w1; ((float*)(P.ws + WS_TOKW))[2 * t + 1] = w2;
        ((int*)(P.ws + WS_TOKP))[2 * t] = pa; ((int*)(P.ws + WS_TOKP))[2 * t + 1] = pb;
        ((float*)(P.ws + WS_RS2))[t] = rs;
    }
    LDS_WAIT();
}

DI void phase4a(const Params& P, LAS unsigned char* lds, int gw, int NGW, int wave, int lane) {
    LAS float* scr = (LAS float*)(lds + wave * 16384);
    for (int tile = gw; tile < MTOK / 16; tile += NGW) route_tile(P, tile, scr, lane);
    bf16_t* WGU = (bf16_t*)(P.ws + WS_WGU); bf16_t* WD = (bf16_t*)(P.ws + WS_WD);
    const float* wg = P.in[19]; const float* wu = P.in[20]; const float* wd = P.in[21]; const float* gf = P.in[14];
    constexpr int I_GU = 16 * 16, I_D = 4 * 32;
    for (int it = gw; it < 32 * (I_GU + I_D); it += NGW) {
        const int e = it / (I_GU + I_D), r = it % (I_GU + I_D);
        if (r < I_GU) { const int n0 = (r & 15) * 32, j = n0 >> 8, up = (n0 >> 7) & 1;
            const float* wsrc = (up ? wu : wg) + (size_t)e * 1024 * 256;
            const SrcGU s{wsrc, gf, 128 * j + (n0 & 127) - n0};
            transpose_item(s, WGU + (size_t)e * 512 * 1024, 1024, (r >> 4) * 64, n0, scr, lane); }
        else { const int r2 = r - I_GU; const SrcPlain s{wd + (size_t)e * 256 * 1024, 1024};
            transpose_item(s, WD + (size_t)e * 1024 * 256, 256, (r2 >> 5) * 64, (r2 & 31) * 32, scr, lane); }
    }
}

DI void expert_layout(const Params& P, int lane, int& cnt, int& base, int& tend) {
    const unsigned* c = (const unsigned*)(P.ws + WS_CTL) + CW_CNT;
    cnt = (lane < 32) ? (int)__hip_atomic_load(c + lane, __ATOMIC_RELAXED, __HIP_MEMORY_SCOPE_AGENT) : 0;
    const int tiles = (cnt + 255) >> 8;
    int inc = 0;
#pragma unroll
    for (int i = 0; i < 32; ++i) { const int ti = __builtin_amdgcn_readlane(tiles, i); inc += (i <= lane) ? ti : 0; }
    tend = inc; base = (inc - tiles) << 8;
}

DI void phase4b(const Params& P, int gw, int NGW, int lane) {
    int cnt, base, tend; expert_layout(P, lane, cnt, base, tend);
    bf16_t* XS = (bf16_t*)(P.ws + WS_XS); float* SLOTW = (float*)(P.ws + WS_SLOTW);
    const int* TOKE = (const int*)(P.ws + WS_TOKE); const float* TOKW = (const float*)(P.ws + WS_TOKW); int* TOKP = (int*)(P.ws + WS_TOKP); const float* RS2 = (const float*)(P.ws + WS_RS2);
    for (int t = gw; t < MTOK; t += NGW) {
        const f32x4* hr = (const f32x4*)(P.out + (size_t)t * 1024);
        const float rs = RS2[t];
        u32x2 w[4];
#pragma unroll
        for (int j = 0; j < 4; ++j) { const f32x4 v = hr[64 * j + lane]; w[j] = (u32x2){pk2(v.x * rs, v.y * rs), pk2(v.z * rs, v.w * rs)}; }
#pragma unroll
        for (int k = 0; k < 2; ++k) {
            const int e = __builtin_amdgcn_readfirstlane(TOKE[2 * t + k]), slot = __builtin_amdgcn_readlane(base, e) + TOKP[2 * t + k];
            u32x2* orow = (u32x2*)(XS + (size_t)slot * 1024);
#pragma unroll
            for (int j = 0; j < 4; ++j) orow[64 * j + lane] = w[j];
            if (lane == 0) { SLOTW[slot] = TOKW[2 * t + k]; TOKP[2 * t + k] = slot; }
        }
    }
    for (int e = 0; e < 32; ++e) {
        const int ce = __builtin_amdgcn_readlane(cnt, e), be = __builtin_amdgcn_readlane(base, e), end = be + (((ce + 255) >> 8) << 8);
        for (int r = be + ce + gw; r < end; r += NGW) { u32x2* orow = (u32x2*)(XS + (size_t)r * 1024);
#pragma unroll
            for (int j = 0; j < 4; ++j) orow[64 * j + lane] = (u32x2){0u, 0u};
            if (lane == 0) SLOTW[r] = 0.f; }
    }
}

struct GroupedOrder {
    int tend; int total; int G, c, NS;
    DI bool next(int i, pg8::Unit& u) const {
        const int L = i * G + c; if (L >= (total << NS)) return false;
        const int mt = L >> NS, j = L & ((1 << NS) - 1);
        const int e = __builtin_popcountll(__ballot(((int)(threadIdx.x & 63) < 32) && tend <= mt));
        u.pm = mt; u.pn = (e << NS) + j; return true;
    }
    DI void a_ready(const pg8::Unit&) const {}
    DI void done(const pg8::Unit&) const {}
};
struct EpiGateUp {
    static constexpr bool PERM = true, AFTER_DRAIN = false;
    const float* SLOTW; bf16_t* YS;
    DI void operator()(const pg8::f32x4 (&acc)[2][2][4][2], const pg8::Unit& u, int wr, int wc, int fr, int fq) const {
        const int f0 = (u.pn & 1) * 128 + wc * 32 + fq * 8;
#pragma unroll
        for (int ai = 0; ai < 2; ++ai)
#pragma unroll
            for (int m = 0; m < 4; ++m) {
                const int row = u.pm * 256 + ai * 128 + wr * 64 + m * 16 + fr;
                const float cw = SLOTW[row];
                float a[8];
#pragma unroll
                for (int i = 0; i < 4; ++i) {
                    const float g0 = acc[ai][0][m][0][i], g1 = acc[ai][0][m][1][i];
                    a[i] = g0 / (1.0f + __expf(-g0)) * acc[ai][1][m][0][i] * cw; a[4 + i] = g1 / (1.0f + __expf(-g1)) * acc[ai][1][m][1][i] * cw;
                }
                *(u32x4*)(YS + (size_t)row * 256 + f0) = (u32x4){pk2(a[0], a[1]), pk2(a[2], a[3]), pk2(a[4], a[5]), pk2(a[6], a[7])};
            }
    }
};
struct EpiDown {
    static constexpr bool PERM = true, AFTER_DRAIN = false;
    bf16_t* YO;
    DI void operator()(const pg8::f32x4 (&acc)[2][2][4][2], const pg8::Unit& u, int wr, int wc, int fr, int fq) const {
        const int c0 = (u.pn & 3) * 256 + wc * 32 + fq * 8;
#pragma unroll
        for (int ai = 0; ai < 2; ++ai)
#pragma unroll
            for (int m = 0; m < 4; ++m) {
                bf16_t* rowp = YO + (size_t)(u.pm * 256 + ai * 128 + wr * 64 + m * 16 + fr) * 1024 + c0;
#pragma unroll
                for (int bj = 0; bj < 2; ++bj) { const pg8::f32x4 v0 = acc[ai][bj][m][0], v1 = acc[ai][bj][m][1];
                    *(u32x4*)(rowp + bj * 128) = (u32x4){pk2(v0[0], v0[1]), pk2(v0[2], v0[3]), pk2(v1[0], v1[1]), pk2(v1[2], v1[3])}; }
            }
    }
};

DI void phase7(const Params& P, int gw, int NGW, int lane) {
    const bf16_t* YO = (const bf16_t*)(P.ws + WS_YO); const int* TOKP = (const int*)(P.ws + WS_TOKP); const f32x4* nf = (const f32x4*)P.in[22];
    for (int t = gw; t < MTOK; t += NGW) {
        f32x4* hr = (f32x4*)(P.out + (size_t)t * 1024);
        const u32x2* y0 = (const u32x2*)(YO + (size_t)TOKP[2 * t] * 1024); const u32x2* y1 = (const u32x2*)(YO + (size_t)TOKP[2 * t + 1] * 1024);
        f32x4 v[4]; float s = 0.f;
#pragma unroll
        for (int j = 0; j < 4; ++j) {
            v[j] = hr[64 * j + lane]; const u32x2 a = y0[64 * j + lane], c = y1[64 * j + lane];
            v[j].x += __uint_as_float(a.x << 16) + __uint_as_float(c.x << 16); v[j].y += __uint_as_float(a.x & 0xffff0000u) + __uint_as_float(c.x & 0xffff0000u);
            v[j].z += __uint_as_float(a.y << 16) + __uint_as_float(c.y << 16); v[j].w += __uint_as_float(a.y & 0xffff0000u) + __uint_as_float(c.y & 0xffff0000u);
            s += (v[j].x * v[j].x + v[j].y * v[j].y) + (v[j].z * v[j].z + v[j].w * v[j].w);
        }
        s = wave_sum(s);
        const float rs = 1.0f / sqrtf(s * (1.0f / 1024.0f) + EPS);
#pragma unroll
        for (int j = 0; j < 4; ++j) hr[64 * j + lane] = v[j] * rs * nf[64 * j + lane];
    }
}

#define XB_TMO      128
#define XB_XCNT(j)  (256  + 64 * (j))
#define XB_XSUB(j)  (1280 + 64 * (j))
#define XB_XGEN(j)  (2304 + 64 * (j))
#define XB_TOP      3328
#define XB_TOPGEN   3392
#define XCD_BAR_WORDS 3456
#define XB_SPIN_CAP (1u << 18)

__device__ __forceinline__ unsigned xb_ld(unsigned* p)              { return __hip_atomic_load(p, __ATOMIC_RELAXED, __HIP_MEMORY_SCOPE_AGENT); }
__device__ __forceinline__ unsigned xb_add(unsigned* p, unsigned v) { return __hip_atomic_fetch_add(p, v, __ATOMIC_RELAXED, __HIP_MEMORY_SCOPE_AGENT); }
__device__ __forceinline__ unsigned xb_xcc_id() { return (unsigned)__builtin_amdgcn_s_getreg((3 << 11) | 20) & 0xFu; }
#define XB_SPIN(cond, bar) do { unsigned _sp = 0; while (cond) { __builtin_amdgcn_s_sleep(1); \
    if ((++_sp & 255u) == 0u) { if (xb_ld(&(bar)[XB_TMO])) break; if (_sp > XB_SPIN_CAP) { atomicAdd(&(bar)[XB_TMO], 1u); break; } } } } while (0)

struct XcdBarrier {
    unsigned* bar; unsigned x;
    volatile LAS unsigned* st;
};

__device__ __forceinline__ XcdBarrier xcd_barrier_post(unsigned* bar, volatile LAS unsigned* st) {
    XcdBarrier b; b.bar = bar; b.x = xb_xcc_id(); b.st = st;
    if (threadIdx.x == 0) (void)xb_add(&bar[XB_XCNT(b.x)], 1u);
    return b;
}
__device__ __forceinline__ void xcd_barrier_complete(unsigned* bar, unsigned x, unsigned& nloc, unsigned& nx) {
    const unsigned G = gridDim.x * gridDim.y * gridDim.z;
    unsigned sum, cnt, mine, sp = 0u;
    for (;;) {
        sum = 0u; cnt = 0u; mine = 0u;
#pragma unroll
        for (unsigned j = 0; j < 16; ++j) { const unsigned c = xb_ld(&bar[XB_XCNT(j)]); sum += c; cnt += (c > 0u) ? 1u : 0u; mine = (j == x) ? c : mine; }
        if (sum == G) break;
        __builtin_amdgcn_s_sleep(1);
        if ((++sp & 255u) == 0u) { if (xb_ld(&bar[XB_TMO])) break; if (sp > XB_SPIN_CAP) { atomicAdd(&bar[XB_TMO], 1u); break; } }
    }
    nloc = mine > 0u ? mine : 1u; nx = cnt > 0u ? cnt : 1u;
}

__device__ __forceinline__ void xcd_barrier(const XcdBarrier& b) {
    asm volatile("s_waitcnt vmcnt(0)" ::: "memory");
    __syncthreads();
    if (threadIdx.x == 0) {
        unsigned* bar = b.bar;
        __builtin_amdgcn_s_waitcnt(0);
        unsigned nloc = b.st[0], nx = b.st[1];
        if (nloc == 0u) { xcd_barrier_complete(bar, b.x, nloc, nx); b.st[0] = nloc; b.st[1] = nx; }
        const unsigned old = xb_add(&bar[XB_XSUB(b.x)], 1u);
        const unsigned gen = old / nloc;
        if (old + 1u == (gen + 1u) * nloc) {
            __builtin_amdgcn_fence(__ATOMIC_RELEASE, "agent");
            asm volatile("s_waitcnt vmcnt(0)" ::: "memory");
            const unsigned og = xb_add(&bar[XB_TOP], 1u);
            const unsigned tg = og / nx;
            if (og + 1u == (tg + 1u) * nx) xb_add(&bar[XB_TOPGEN], 1u);
            else XB_SPIN(xb_ld(&bar[XB_TOPGEN]) == tg, bar);
            __builtin_amdgcn_fence(__ATOMIC_ACQUIRE, "agent");
            xb_add(&bar[XB_XGEN(b.x)], 1u);
            asm volatile("s_waitcnt vmcnt(0)" ::: "memory");
        } else {
            XB_SPIN(xb_ld(&bar[XB_XGEN(b.x)]) == gen, bar);
            __builtin_amdgcn_fence(__ATOMIC_ACQUIRE, "agent");
            asm volatile("s_waitcnt vmcnt(0)" ::: "memory");
        }
    }
    __syncthreads();
}

#ifndef PHMASK
#define PHMASK 2047
#endif
#ifndef REPMASK
#define REPMASK 0
#endif
#define REP(bit) for (int rep_ = 0; rep_ < ((REPMASK & (bit)) ? 2 : 1); ++rep_)
#define REPSYNC(bit) if ((REPMASK & (bit)) && rep_ == 0) GRID_BAR()
typedef const __attribute__((address_space(4))) Params* KParams;
DI Params load_params(KParams kp) { Params p;
#pragma unroll
    for (int i = 0; i < 23; ++i) p.in[i] = kp->in[i];
    p.out = kp->out; p.ws = kp->ws; return p; }
__global__ void __launch_bounds__(NTHREADS, 2) hymba_fwd(Params Pin) {
    extern __shared__ __attribute__((aligned(16))) unsigned char lds_raw[];
    LAS unsigned char* lds = (LAS unsigned char*)lds_raw;
    cg::grid_group grid = cg::this_grid();
    volatile LAS unsigned* bst = (volatile LAS unsigned*)(lds + LDS_BYTES - 64);
    if (threadIdx.x < 2) bst[threadIdx.x] = 0u;
    __syncthreads();
    const XcdBarrier xbar = xcd_barrier_post((unsigned*)(Pin.ws + WS_CTL) + CW_BAR, bst);
#define GRID_BAR() xcd_barrier(xbar)
    const int G = gridDim.x, blk = blockIdx.x, NGW = G * NWAVES, NGT = G * NTHREADS;
#define PHASE_IDS() KParams kp_ = (KParams)__builtin_amdgcn_kernarg_segment_ptr(); asm volatile("" : "+s"(kp_)); const Params P = load_params(kp_); int tid = threadIdx.x; asm volatile("" : "+v"(tid)); const int lane = tid & 63, wave = __builtin_amdgcn_readfirstlane(tid >> 6), gw = blk * NWAVES + wave, gtid = blk * NTHREADS + tid; (void)lane; (void)gw; (void)gtid; (void)wave

    REP(1) { if (PHMASK & 1) { PHASE_IDS(); phase0(P, lds, gw, NGW, gtid, NGT, wave, lane); } REPSYNC(1); }
    grid.sync();
    REP(2) { if (PHMASK & 2) { PHASE_IDS();
        pg8::Gemm g{(const bf16_t*)(P.ws + WS_XB), (const bf16_t*)(P.ws + WS_WINT), MROWS, NPROJ, 1024};
        pg8::StaticOrder S; S.init(MROWS, NPROJ, G, blk);
        EpiInProj E{(const float*)(P.ws + WS_RS1), (const float*)(P.ws + WS_COS), (const float*)(P.ws + WS_SIN), P.in[10], P.in[11],
                    (bf16_t*)(P.ws + WS_QB), (bf16_t*)(P.ws + WS_KT), (bf16_t*)(P.ws + WS_VT), (bf16_t*)(P.ws + WS_QKVB), (bf16_t*)(P.ws + WS_ZB), (float*)(P.ws + WS_GB)};
        pg8::gemm_phase<EpiInProj, pg8::StaticOrder, true, true>(lds, g, S, E);
    } REPSYNC(2); }
    GRID_BAR();
    REP(4) { if (PHMASK & 4) { PHASE_IDS(); gdn_prep_phase(P, lds, blk, G, wave, lane); } REPSYNC(4); }
    GRID_BAR();
    REP(8) { if ((PHMASK & 8) && blk < 16) { PHASE_IDS(); gdn_scan(P, lds, blk, tid, wave, lane); } }
    REP(16) {
    if (PHMASK & 16) { PHASE_IDS(); attn_phase(P, lds, tid, wave, lane); }
    if ((REPMASK & 16) && rep_ == 0) { GRID_BAR(); if (blk == 0 && threadIdx.x == 0) { PHASE_IDS(); __hip_atomic_store((unsigned*)(P.ws + WS_CTL) + CW_ATTQ, 0u, __ATOMIC_RELAXED, __HIP_MEMORY_SCOPE_AGENT); } GRID_BAR(); }
    }
    GRID_BAR();
    REP(32) { if (PHMASK & 32) { PHASE_IDS();
        pg8::Gemm g{(const bf16_t*)(P.ws + WS_MIX), (const bf16_t*)(P.ws + WS_WOUT), MTOK, 1024, 1024};
        pg8::StaticOrder S; S.init(MTOK, 1024, G, blk);
        EpiOutProj E{P.in[0], P.out};
        pg8::gemm_phase<EpiOutProj, pg8::StaticOrder, true, true>(lds, g, S, E);
    } REPSYNC(32); }
    GRID_BAR();
    if (PHMASK & 64) { PHASE_IDS(); phase4a(P, lds, gw, NGW, wave, lane); }
    GRID_BAR();
    if (PHMASK & 128) { PHASE_IDS(); phase4b(P, gw, NGW, lane); }
    GRID_BAR();
    int cnt, base, tend, total; { PHASE_IDS(); expert_layout(P, lane, cnt, base, tend); total = __builtin_amdgcn_readlane(tend, 31); }
    REP(256) { if (PHMASK & 256) { PHASE_IDS();
        pg8::Gemm g{(const bf16_t*)(P.ws + WS_XS), (const bf16_t*)(P.ws + WS_WGU), XS_ROWS, 32 * 512, 1024};
        GroupedOrder S{tend, total, G, blk, 1};
        EpiGateUp E{(const float*)(P.ws + WS_SLOTW), (bf16_t*)(P.ws + WS_YS)};
        pg8::gemm_phase<EpiGateUp, GroupedOrder, true, true>(lds, g, S, E);
    } REPSYNC(256); }
    GRID_BAR();
    REP(512) { if (PHMASK & 512) { PHASE_IDS();
        int kd = 256; asm volatile("" : "+s"(kd));
        pg8::Gemm g{(const bf16_t*)(P.ws + WS_YS), (const bf16_t*)(P.ws + WS_WD), XS_ROWS, 32 * 1024, kd};
        GroupedOrder S{tend, total, G, blk, 2};
        EpiDown E{(bf16_t*)(P.ws + WS_YO)};
        pg8::gemm_phase<EpiDown, GroupedOrder, true, true>(lds, g, S, E);
    } REPSYNC(512); }
    GRID_BAR();
    if (PHMASK & 1024) { PHASE_IDS(); phase7(P, gw, NGW, lane); }
}

extern "C" void kernel_launch(void* const* d_in, const int* in_sizes, int n_in, void* d_out, int out_size, void* d_ws, size_t ws_size, hipStream_t stream) {
    static int grid_blocks = 0;
    if (grid_blocks == 0) {
        if (n_in != 23 || out_size != MTOK * DMODEL || ws_size < WS_END) { fprintf(stderr, "kernel_launch: unexpected shapes (n_in %d out %d ws %zu)\n", n_in, out_size, ws_size); grid_blocks = -1; return; }
        int dev = 0, cus = 0, per_cu = 0;
        hipGetDevice(&dev);
        hipDeviceGetAttribute(&cus, hipDeviceAttributeMultiprocessorCount, dev);
        hipFuncSetAttribute((const void*)hymba_fwd, hipFuncAttributeMaxDynamicSharedMemorySize, LDS_BYTES);
        hipOccupancyMaxActiveBlocksPerMultiprocessor(&per_cu, (const void*)hymba_fwd, NTHREADS, LDS_BYTES);
        if (per_cu < 1) { fprintf(stderr, "kernel_launch: occupancy query says %d blocks/CU\n", per_cu); per_cu = 1; }
        grid_blocks = cus;
        (void)hipGetLastError();
    }
    if (grid_blocks < 0) return;
    hipMemsetAsync((char*)d_ws + WS_CTL, 0, CTL_BYTES, stream);
    Params p{};
    for (int i = 0; i < 23; ++i) p.in[i] = (const float*)d_in[i];
    p.out = (float*)d_out; p.ws = (unsigned char*)d_ws;
    void* args[] = {&p};
    hipError_t e = hipLaunchCooperativeKernel((const void*)hymba_fwd, dim3(grid_blocks), dim3(NTHREADS), args, LDS_BYTES, stream);
    if (e != hipSuccess) fprintf(stderr, "cooperative launch failed: %s (grid %d)\n", hipGetErrorString(e), grid_blocks);
}
```

```cpp
#include <hip/hip_runtime.h>
#include <hip/hip_cooperative_groups.h>
#include <cstdio>
#include <cstdint>
namespace cg = cooperative_groups;
namespace pg8 {
#define PG8_LAS __attribute__((address_space(3)))
typedef unsigned short bf16_t;
typedef short bf16x8 __attribute__((ext_vector_type(8)));
typedef float f32x4 __attribute__((ext_vector_type(4)));
typedef unsigned u32x4 __attribute__((ext_vector_type(4)));
constexpr int BM = 256, BK = 64, HALF = 128, HTB = HALF * BK * 2  , STAGE_BYTES = 8 * HTB, NXCD = 8, WGM = 8;

__host__ __device__ __forceinline__ int lds_byte(int r, int c) { const int st = (r >> 4) * 2 + (c >> 5), rr = r & 15, cc = c & 31, ob = rr * 64 + cc * 2; return st * 1024 + (ob ^ (((ob >> 9) & 1) << 5)); }
__host__ __device__ __forceinline__ void stage_rc(int b, int& R, int& C) { const int st = b / 1024, sb = b % 1024, swz = sb ^ (((sb >> 9) & 1) << 5); R = (st >> 1) * 16 + swz / 64; C = (st & 1) * 32 + (swz % 64) / 2; }
__host__ __device__ __forceinline__ int perm32(int rho) { const int n = rho >> 4, i = rho & 15; return 8 * (i >> 2) + 4 * n + (i & 3); }

struct Unit { int pm, pn; };
struct Gemm { const bf16_t* A; const bf16_t* Bt; int M, N, K; };

struct StaticOrder {
    int nM, nN, nwg, G, c;
    __host__ __device__ void init(int M, int N, int G_, int c_) { nM = M / BM; nN = N / BM; nwg = nM * nN; G = G_; c = c_; }
    __host__ __device__ bool next(int i, Unit& u) const {
        const long L = (long)i * G + c; if (L >= nwg) return false;
        int wgid = (int)L; { const int q = nwg / NXCD, r = nwg % NXCD, xcd = wgid % NXCD, off = wgid / NXCD; wgid = (xcd < r ? xcd * (q + 1) : r * (q + 1) + (xcd - r) * q) + off; }
        const int nig = WGM * nN, gid = wgid / nig, fm = gid * WGM, gsz = (nM - fm) < WGM ? (nM - fm) : WGM;
        u.pm = fm + ((wgid % nig) % gsz); u.pn = (wgid % nig) / gsz; return true;
    }
    __device__ __forceinline__ void a_ready(const Unit&) const {}
    __device__ __forceinline__ void done(const Unit&) const {}
};

__device__ __forceinline__ unsigned cvt_pk_bf16(float lo, float hi) { unsigned r; asm volatile("v_cvt_pk_bf16_f32 %0, %1, %2" : "=v"(r) : "v"(lo), "v"(hi)); return r; }
typedef float f32x2 __attribute__((ext_vector_type(2)));
template <class Epi, class Sched, bool ALIGN_EPI = false, bool SP2 = false>
__device__ __forceinline__ void gemm_phase(PG8_LAS unsigned char* lds, const Gemm g, const Sched& S, const Epi& E) {
    int tid_o = threadIdx.x; asm volatile("" : "+v"(tid_o));
    const int tid = tid_o, wid = __builtin_amdgcn_readfirstlane(tid >> 6), lane = tid & 63, wr = wid >> 2, wc = wid & 3, fr = lane & 15, fq = lane >> 4;
    const int K = g.K, nt = K / BK;
    unsigned voffA[2], voffB[2];
#pragma unroll
    for (int i = 0; i < 2; ++i) { int R, C; stage_rc(tid * 16 + i * 8192, R, C); const int Rb = Epi::PERM ? ((R & ~31) + perm32(R & 31)) : R;
        voffA[i] = (unsigned)(R * K + C) * 2u; voffB[i] = (unsigned)(Rb * K + C) * 2u; }
    const size_t kstep = (size_t)(BK * 2);
    const size_t hstep = (size_t)HALF * K * 2;
    const size_t tstep = 2 * hstep;
    const unsigned ldsw = (unsigned)wid * 1024u;
    const int aoff = lds_byte(wr * 64 + fr, fq * 8), boff = lds_byte(wc * 32 + fr, fq * 8);
#define PG8_SA(b, h) (((b) * 2 + (h)) * HTB)
#define PG8_SB(b, h) ((4 + (b) * 2 + (h)) * HTB)
#define PG8_STAGE(bufoff, gbase, voff) do { _Pragma("unroll") for (int _i = 0; _i < 2; ++_i) \
        __builtin_amdgcn_global_load_lds((const unsigned*)((const char*)(gbase) + (voff)[_i]), (PG8_LAS unsigned*)(lds + (bufoff) + ldsw + _i * 8192), 16, 0, 0); } while (0)
#define PG8_LDA(dst, b, h) do { _Pragma("unroll") for (int m = 0; m < 4; ++m) _Pragma("unroll") for (int k = 0; k < 2; ++k) dst[m][k] = *(const PG8_LAS bf16x8*)(lds + PG8_SA(b, h) + aoff + m * 2048 + k * 1024); } while (0)
#define PG8_LDB(dst, b, h) do { _Pragma("unroll") for (int n = 0; n < 2; ++n) _Pragma("unroll") for (int k = 0; k < 2; ++k) dst[n][k] = *(const PG8_LAS bf16x8*)(lds + PG8_SB(b, h) + boff + n * 2048 + k * 1024); } while (0)
#define PG8_MMA(ai, bj, At, Bt) do { __builtin_amdgcn_s_setprio(1); _Pragma("unroll") for (int m = 0; m < 4; ++m) _Pragma("unroll") for (int n = 0; n < 2; ++n) _Pragma("unroll") for (int k = 0; k < 2; ++k) \
        acc[ai][bj][m][n] = __builtin_amdgcn_mfma_f32_16x16x32_bf16(Bt[n][k], At[m][k], acc[ai][bj][m][n], 0, 0, 0); __builtin_amdgcn_s_setprio(0); } while (0)
#define PG8_WAIT_V(n) asm volatile("s_waitcnt vmcnt(" #n ")" ::: "memory")
#define PG8_WAIT_L(n) asm volatile("s_waitcnt lgkmcnt(" #n ")" ::: "memory")
#define PG8_BAR __builtin_amdgcn_s_barrier()
#define PG8_SCHED __builtin_amdgcn_sched_barrier(0)
    Unit cur, nxt; int ui = 0;
    if (!S.next(0, cur)) return;
    f32x4 acc[2][2][4][2];
#pragma unroll
    for (int a = 0; a < 2; ++a)
#pragma unroll
        for (int b = 0; b < 2; ++b)
#pragma unroll
            for (int m = 0; m < 4; ++m)
#pragma unroll
                for (int n = 0; n < 2; ++n) acc[a][b][m][n] = (f32x4){0.f, 0.f, 0.f, 0.f};
    bf16x8 At[4][2], B0[2][2], B1[2][2];
    const char* cA = (const char*)g.A + (size_t)cur.pm * tstep; const char* cB = (const char*)g.Bt + (size_t)cur.pn * tstep;
    S.a_ready(cur);
    if constexpr (SP2) {
        PG8_STAGE(PG8_SB(0, 0), cB, voffB); PG8_STAGE(PG8_SB(0, 1), cB + hstep, voffB); PG8_STAGE(PG8_SA(0, 0), cA, voffA); PG8_STAGE(PG8_SA(0, 1), cA + hstep, voffA);
        if (wr == 1) PG8_BAR;
        PG8_WAIT_V(2); PG8_BAR;
        PG8_STAGE(PG8_SB(1, 0), cB + kstep, voffB); PG8_STAGE(PG8_SA(1, 0), cA + kstep, voffA); PG8_STAGE(PG8_SB(1, 1), cB + hstep + kstep, voffB);
        PG8_WAIT_V(6); PG8_BAR;
    } else {
        PG8_STAGE(PG8_SB(0, 0), cB, voffB); PG8_STAGE(PG8_SA(0, 0), cA, voffA); PG8_STAGE(PG8_SB(0, 1), cB + hstep, voffB); PG8_STAGE(PG8_SA(0, 1), cA + hstep, voffA);
        if (wr == 1) PG8_BAR;
        PG8_WAIT_V(4); PG8_BAR;
        PG8_STAGE(PG8_SB(1, 0), cB + kstep, voffB); PG8_STAGE(PG8_SA(1, 0), cA + kstep, voffA); PG8_STAGE(PG8_SB(1, 1), cB + hstep + kstep, voffB);
        PG8_WAIT_V(6); PG8_BAR;
    }
    for (;;) {
        const bool has_next = S.next(ui + 1, nxt);
        const char* nA = has_next ? (const char*)g.A + (size_t)nxt.pm * tstep : cA; const char* nB = has_next ? (const char*)g.Bt + (size_t)nxt.pn * tstep : cB;
        for (int t = 0; t < nt; t += 2) {
            const bool last = (t == nt - 2);
            const char* a1 = cA + (size_t)(t + 1) * kstep;
            const char* a2 = last ? nA : cA + (size_t)(t + 2) * kstep; const char* b2 = last ? nB : cB + (size_t)(t + 2) * kstep;
            const char* a3 = a2 + kstep; const char* b3 = b2 + kstep;
            if (last && has_next) S.a_ready(nxt);
            if constexpr (SP2) {
            PG8_LDB(B0, 0, 0); PG8_LDB(B1, 0, 1); PG8_SCHED; PG8_LDA(At, 0, 0); PG8_STAGE(PG8_SA(1, 1), a1 + hstep, voffA);
            PG8_WAIT_V(8); PG8_WAIT_L(0); PG8_BAR; PG8_MMA(0, 0, At, B0); PG8_MMA(0, 1, At, B1); PG8_BAR; PG8_SCHED;
            PG8_LDA(At, 0, 1); PG8_STAGE(PG8_SB(0, 0), b2, voffB); PG8_STAGE(PG8_SB(0, 1), b2 + hstep, voffB); PG8_STAGE(PG8_SA(0, 0), a2, voffA);
            PG8_WAIT_V(8); PG8_WAIT_L(0); PG8_BAR; PG8_MMA(1, 0, At, B0); PG8_MMA(1, 1, At, B1); PG8_BAR; PG8_SCHED;
            PG8_LDB(B0, 1, 0); PG8_LDB(B1, 1, 1); PG8_SCHED; PG8_LDA(At, 1, 0); PG8_STAGE(PG8_SA(0, 1), a2 + hstep, voffA);
            PG8_WAIT_V(8); PG8_WAIT_L(0); PG8_BAR; PG8_MMA(0, 0, At, B0); PG8_MMA(0, 1, At, B1); PG8_BAR; PG8_SCHED;
            PG8_LDA(At, 1, 1); PG8_STAGE(PG8_SB(1, 0), b3, voffB); PG8_STAGE(PG8_SB(1, 1), b3 + hstep, voffB); PG8_STAGE(PG8_SA(1, 0), a3, voffA);
            PG8_WAIT_V(8); PG8_WAIT_L(0); PG8_BAR; PG8_MMA(1, 0, At, B0); PG8_MMA(1, 1, At, B1); PG8_BAR; PG8_SCHED;
            } else {
            PG8_LDB(B0, 0, 0); PG8_SCHED; PG8_LDA(At, 0, 0); PG8_STAGE(PG8_SA(1, 1), a1 + hstep, voffA);
            PG8_WAIT_L(8); PG8_BAR; PG8_WAIT_L(0); PG8_MMA(0, 0, At, B0); PG8_BAR; PG8_SCHED;
            PG8_LDB(B1, 0, 1); PG8_STAGE(PG8_SB(0, 0), b2, voffB);
            PG8_BAR; PG8_WAIT_L(0); PG8_MMA(0, 1, At, B1); PG8_BAR;
            PG8_LDA(At, 0, 1); PG8_STAGE(PG8_SA(0, 0), a2, voffA);
            PG8_BAR; PG8_WAIT_L(0); PG8_MMA(1, 0, At, B0); PG8_BAR; PG8_SCHED;
            PG8_STAGE(PG8_SB(0, 1), b2 + hstep, voffB);
            PG8_WAIT_V(6); PG8_BAR; PG8_MMA(1, 1, At, B1); PG8_BAR;
            PG8_LDB(B0, 1, 0); PG8_SCHED; PG8_LDA(At, 1, 0); PG8_STAGE(PG8_SA(0, 1), a2 + hstep, voffA);
            PG8_WAIT_L(8); PG8_BAR; PG8_WAIT_L(0); PG8_MMA(0, 0, At, B0); PG8_BAR; PG8_SCHED;
            PG8_LDB(B1, 1, 1); PG8_STAGE(PG8_SB(1, 0), b3, voffB);
            PG8_BAR; PG8_WAIT_L(0); PG8_MMA(0, 1, At, B1); PG8_BAR;
            PG8_LDA(At, 1, 1); PG8_STAGE(PG8_SA(1, 0), a3, voffA);
            PG8_BAR; PG8_WAIT_L(0); PG8_MMA(1, 0, At, B0); PG8_BAR; PG8_SCHED;
            PG8_STAGE(PG8_SB(1, 1), b3 + hstep, voffB);
            PG8_WAIT_V(6); PG8_BAR; PG8_MMA(1, 1, At, B1); PG8_BAR;
            }
        }
        if constexpr (ALIGN_EPI) { if (wr == 0) PG8_BAR; }
        if constexpr (!Epi::AFTER_DRAIN) { E(acc, cur, wr, wc, fr, fq); S.done(cur); }
        if (!has_next) break;
#pragma unroll
        for (int a = 0; a < 2; ++a)
#pragma unroll
            for (int b = 0; b < 2; ++b)
#pragma unroll
                for (int m = 0; m < 4; ++m)
#pragma unroll
                    for (int n = 0; n < 2; ++n) acc[a][b][m][n] = (f32x4){0.f, 0.f, 0.f, 0.f};
        cur = nxt; cA = nA; cB = nB; ++ui;
        if constexpr (ALIGN_EPI) { if (wr == 1) PG8_BAR; }
    }
    PG8_WAIT_V(0);
    if constexpr (!ALIGN_EPI) { if (wr == 0) PG8_BAR; }
    PG8_BAR;
    if constexpr (Epi::AFTER_DRAIN) { E.fused(acc, cur, wr, wc, fr, fq, lds, wid, lane); S.done(cur); }
#undef PG8_SA
#undef PG8_SB
#undef PG8_STAGE
#undef PG8_LDA
#undef PG8_LDB
#undef PG8_MMA
#undef PG8_WAIT_V
#undef PG8_WAIT_L
#undef PG8_BAR
#undef PG8_SCHED
}
}

#define DI __device__ __forceinline__
#define LAS __attribute__((address_space(3)))
typedef unsigned short bf16_t;
typedef short bf16x8 __attribute__((ext_vector_type(8)));
typedef short s16x4 __attribute__((ext_vector_type(4)));
typedef short v4i16_t __attribute__((ext_vector_type(4)));
typedef float f32x4 __attribute__((ext_vector_type(4)));
typedef float f32x16 __attribute__((ext_vector_type(16)));
typedef unsigned u32x4 __attribute__((ext_vector_type(4)));
typedef unsigned u32x2 __attribute__((ext_vector_type(2)));
typedef float f32x2_t __attribute__((ext_vector_type(2)));
typedef __bf16 bf16x2_t __attribute__((ext_vector_type(2)));

constexpr int NWAVES = 8, NTHREADS = 512;
constexpr int SEQ = 8192, DMODEL = 1024, NMETA = 16, LTOK = SEQ + NMETA  , LP = 8256  , NCHUNK = 129;
constexpr int MTOK = 2 * SEQ;
constexpr int MROWS = 16640;
constexpr int NPROJ = 3840;
constexpr int NKT = 129;
constexpr float EPS = 1e-6f;
constexpr float C2Q = 0.125f * 1.4426950408889634f;
constexpr int XS_ROWS = 41216;

constexpr size_t MiB = 1u << 20;
constexpr size_t WS_CTL = 0, CTL_BYTES = 1 * MiB;
constexpr size_t WS_RS1 = 1 * MiB;
constexpr size_t WS_RS2 = WS_RS1 + 128 * 1024;
constexpr size_t WS_TOKE = WS_RS2 + 128 * 1024;
constexpr size_t WS_TOKW = WS_TOKE + 128 * 1024;
constexpr size_t WS_TOKP = WS_TOKW + 128 * 1024;
constexpr size_t WS_SLOTW = WS_TOKP + 128 * 1024;
constexpr size_t WS_WR = WS_SLOTW + 192 * 1024;
constexpr size_t WS_GL = WS_WR + 160 * 1024;
constexpr size_t WS_COS = 2 * MiB;
constexpr size_t WS_SIN = WS_COS + 1280 * 1024;
constexpr size_t WS_GB = WS_SIN + 1280 * 1024;
constexpr size_t WS_WOUT = 6 * MiB;
constexpr size_t WS_WINT = 8 * MiB;
constexpr size_t WS_XB = WS_WINT + (size_t)NPROJ * 1024 * 2;
constexpr size_t WS_MIX = 8 * MiB;
constexpr size_t WS_QKVB = 48 * MiB;
constexpr size_t WS_QB = WS_QKVB + (size_t)2 * LP * 1536 * 2 + 128 * 1024;
constexpr size_t WS_KT = WS_QB + 16 * MiB;
constexpr size_t WS_VT = WS_KT + (size_t)16 * NKT * 4096 * 2;
constexpr size_t WS_ZB = WS_VT + (size_t)8 * NKT * 8192 * 2;
constexpr size_t WS_GP = WS_ZB + (size_t)2 * LP * 512 * 2;
constexpr size_t GP_ARR = (size_t)2064 * 4096 * 2;
constexpr size_t WS_GP_END = WS_GP + 5 * GP_ARR;
constexpr size_t WS_WGU = 48 * MiB;
constexpr size_t WS_WD = 80 * MiB;
constexpr size_t WS_XS = 96 * MiB;
constexpr size_t WS_YO = 96 * MiB;
constexpr size_t WS_YS = WS_XS + (size_t)XS_ROWS * 1024 * 2;
constexpr size_t WS_END = 256 * MiB;
static_assert(WS_GB + (size_t)2 * LP * 16 * 4 <= WS_WOUT, "small region");
static_assert(WS_XB + (size_t)MROWS * 1024 * 2 <= WS_QKVB, "XB");
static_assert(WS_GP_END <= WS_END, "GDN prep arrays");
static_assert(WS_YS + (size_t)XS_ROWS * 256 * 2 <= WS_END, "YS");
static_assert(WS_WD + (size_t)32 * 1024 * 256 * 2 <= WS_XS, "WD");
constexpr int CW_ATTQ = 0;
constexpr int CW_CNT = 64;
constexpr int CW_BAR = 4096;

constexpr int LDS_BYTES = 147456;

struct Params { const float* in[23]; float* out; unsigned char* ws; };

DI unsigned f2bf(float f) { unsigned u = __float_as_uint(f); return (u + 0x7fffu + ((u >> 16) & 1u)) >> 16; }
DI unsigned pk2(float lo, float hi) { f32x2_t v = {lo, hi}; bf16x2_t b = __builtin_convertvector(v, bf16x2_t); return __builtin_bit_cast(unsigned, b); }
DI float bf2f(unsigned short h) { return __uint_as_float(((unsigned)h) << 16); }
DI float rlane(float v, int l) { return __int_as_float(__builtin_amdgcn_readlane(__float_as_int(v), l)); }
#define DPP_ADD(v, ctrl) ((v) + __int_as_float(__builtin_amdgcn_update_dpp(0, __float_as_int(v), (ctrl), 0xF, 0xF, true)))
DI float wave_sum_dpp(float v) {
    v = DPP_ADD(v, 0xB1);
    v = DPP_ADD(v, 0x4E);
    v = DPP_ADD(v, 0x141);
    v = DPP_ADD(v, 0x140);
    return (rlane(v, 0) + rlane(v, 16)) + (rlane(v, 32) + rlane(v, 48));
}
DI float wave_sum(float v) { return wave_sum_dpp(v); }
DI float swz_xor16(float v) { return __int_as_float(__builtin_amdgcn_ds_swizzle(__float_as_int(v), 0x401F)); }
DI float row_sum16(float v) { v = DPP_ADD(v, 0xB1); v = DPP_ADD(v, 0x4E); v = DPP_ADD(v, 0x141); v = DPP_ADD(v, 0x140); return v; }
DI float half_sum32(float v) { v = row_sum16(v); return v + swz_xor16(v); }
DI float swap32_add(float v) { auto rr = __builtin_amdgcn_permlane32_swap(__float_as_uint(v), __float_as_uint(v), false, false); return __uint_as_float(rr[0]) + __uint_as_float(rr[1]); }
DI float swap32_max(float v) { auto rr = __builtin_amdgcn_permlane32_swap(__float_as_uint(v), __float_as_uint(v), false, false); return fmaxf(__uint_as_float(rr[0]), __uint_as_float(rr[1])); }
#define LDS_WAIT() asm volatile("s_waitcnt lgkmcnt(0)" ::: "memory")
#define BAR_LDS() do { asm volatile("s_waitcnt lgkmcnt(0)" ::: "memory"); __builtin_amdgcn_s_barrier(); asm volatile("" ::: "memory"); } while (0)
#define MFMA32(a, b, c) __builtin_amdgcn_mfma_f32_32x32x16_bf16((a), (b), (c), 0, 0, 0)
DI int crow(int r, int hi) { return (r & 3) + 8 * (r >> 2) + 4 * hi; }
DI int perm16(int x) { return (x & ~12) | ((x & 4) << 1) | ((x & 8) >> 1); }
DI bf16x8 pack8(const f32x16& x, int s) {
    u32x4 p; p.x = pk2(x[8 * s], x[8 * s + 1]); p.y = pk2(x[8 * s + 2], x[8 * s + 3]); p.z = pk2(x[8 * s + 4], x[8 * s + 5]); p.w = pk2(x[8 * s + 6], x[8 * s + 7]);
    return __builtin_bit_cast(bf16x8, p);
}
DI int orig_col(int n) {
    if (n >= 1024) return n;
    const int hh = n >> 6, c2 = n & 63, g8 = c2 >> 3, i = c2 & 7;
    return (hh << 6) + ((i < 4) ? 4 * g8 + i : 32 + 4 * g8 + (i - 4));
}
DI size_t kt_off(int b, int hh, int p, int d) {
    const int tile = p < 16 ? 0 : 1 + ((p - 16) >> 6), kv = p < 16 ? p : ((p - 16) & 63);
    return ((size_t)((b * 8 + hh) * NKT + tile) << 12) + ((d >> 3) << 9) + (kv << 3) + (d & 7);
}
DI size_t vt_off(int b, int h, int p, int d) {
    const int tile = p < 16 ? 0 : 1 + ((p - 16) >> 6), kv = p < 16 ? p : ((p - 16) & 63);
    return ((size_t)((b * 4 + h) * NKT + tile) << 13) + ((d >> 5) << 11) + ((kv >> 4) << 9) + ((kv & 15) << 5) + (d & 31);
}

template <class Src> DI void transpose_item(const Src& src, bf16_t* WT, size_t ldk, int k0, int n0, LAS float* scr, int lane) {
    float v[32];
#pragma unroll
    for (int i = 0; i < 32; ++i) v[i] = src(k0 + 2 * i + (lane >> 5), n0 + (lane & 31));
#pragma unroll
    for (int i = 0; i < 32; ++i) scr[(2 * i + (lane >> 5)) * 33 + (lane & 31)] = v[i];
    LDS_WAIT();
    const int c = lane & 7;
#pragma unroll
    for (int j = 0; j < 4; ++j) { const int n = (lane >> 3) + 8 * j; const LAS float* s = scr + (8 * c) * 33 + n;
        u32x4 o; o.x = pk2(s[0 * 33], s[1 * 33]); o.y = pk2(s[2 * 33], s[3 * 33]); o.z = pk2(s[4 * 33], s[5 * 33]); o.w = pk2(s[6 * 33], s[7 * 33]);
        *(u32x4*)(WT + (size_t)(n0 + n) * ldk + k0 + 8 * c) = o; }
    LDS_WAIT();
}
struct SrcWin { const float* w; const float* g; DI float operator()(int k, int n) const { return n >= 3600 ? 0.f : w[(size_t)k * 3600 + orig_col(n)] * g[k]; } };
struct SrcPlain { const float* w; int N; DI float operator()(int k, int n) const { return w[(size_t)k * N + n]; } };
struct SrcGU { const float* w; const float* g; int fadj; DI float operator()(int k, int n) const { return w[(size_t)k * 256 + n + fadj] * g[k]; } };

DI void phase0(const Params& P, LAS unsigned char* lds, int gw, int NGW, int gtid, int NGT, int wave, int lane) {
    LAS float* scr = (LAS float*)(lds + wave * 16384);
    bf16_t* WINT = (bf16_t*)(P.ws + WS_WINT); bf16_t* WOUT = (bf16_t*)(P.ws + WS_WOUT); bf16_t* XB = (bf16_t*)(P.ws + WS_XB);
    float* RS1 = (float*)(P.ws + WS_RS1);
    constexpr int I_IN = 16 * (NPROJ / 32), I_OUT = 16 * 32;
    const SrcWin sw{P.in[3], P.in[2]}; const SrcPlain so{P.in[13], 1024};
    for (int it = gw; it < I_IN + I_OUT; it += NGW) {
        if (it < I_IN) transpose_item(sw, WINT, 1024, (it / (NPROJ / 32)) * 64, (it % (NPROJ / 32)) * 32, scr, lane);
        else { const int r = it - I_IN; transpose_item(so, WOUT, 1024, (r >> 5) * 64, (r & 31) * 32, scr, lane); }
    }
    const float* x = P.in[0]; const float* meta = P.in[1];
    for (int m0 = gw; m0 < MROWS; m0 += 4 * NGW) {
        f32x4 v[4][4];
#pragma unroll
        for (int r = 0; r < 4; ++r) { const int m = m0 + r * NGW;
            const bool real = m < MTOK + NMETA;
            const f32x4* xr = (const f32x4*)((m < MTOK) ? x + (size_t)m * 1024 : meta + (size_t)((real ? m : MTOK) - MTOK) * 1024);
#pragma unroll
            for (int j = 0; j < 4; ++j) v[r][j] = (m < MROWS) ? xr[64 * j + lane] : (f32x4){0.f, 0.f, 0.f, 0.f}; }
#pragma unroll
        for (int r = 0; r < 4; ++r) { const int m = m0 + r * NGW;
            if (m < MROWS) {
                const bool real = m < MTOK + NMETA;
                float s = 0.f;
#pragma unroll
                for (int j = 0; j < 4; ++j) { if (!real) v[r][j] = (f32x4){0.f, 0.f, 0.f, 0.f}; s += (v[r][j].x * v[r][j].x + v[r][j].y * v[r][j].y) + (v[r][j].z * v[r][j].z + v[r][j].w * v[r][j].w); }
                s = wave_sum(s);
                if (lane == 0) RS1[m] = real ? __builtin_amdgcn_rsqf(s * (1.0f / 1024.0f) + EPS) : 0.f;
                u32x2* orow = (u32x2*)(XB + (size_t)m * 1024);
#pragma unroll
                for (int j = 0; j < 4; ++j) orow[64 * j + lane] = (u32x2){pk2(v[r][j].x, v[r][j].y), pk2(v[r][j].z, v[r][j].w)};
            } }
    }
    float* COS = (float*)(P.ws + WS_COS); float* SIN = (float*)(P.ws + WS_SIN);
    for (int i = gtid; i < LTOK * 32; i += NGT) {
        const int p = i >> 5, f = i & 31;
        const double rev = (double)p * exp2(-(double)f * (13.287712379549449 / 32.0)) * 0.15915494309189535;
        const float fr = (float)(rev - floor(rev));
        COS[i] = __builtin_amdgcn_cosf(fr); SIN[i] = __builtin_amdgcn_sinf(fr);
    }
    float* WR = (float*)(P.ws + WS_WR); const float* gf = P.in[14]; const float* wgrp = P.in[15]; const float* wrt = P.in[17];
    for (int i = gtid; i < 36 * 1024; i += NGT) { const int j = i >> 10, k = i & 1023; WR[i] = gf[k] * (j < 4 ? wgrp[k * 4 + j] : wrt[k * 32 + (j - 4)]); }
}

struct EpiInProj {
    static constexpr bool PERM = true, AFTER_DRAIN = false;
    const float* RS1; const float* COS; const float* SIN; const float* a_log; const float* dt_bias;
    bf16_t* QB; bf16_t* KT; bf16_t* VT; bf16_t* QKVB; bf16_t* ZB; float* GB;
    DI void operator()(const pg8::f32x4 (&acc)[2][2][4][2], const pg8::Unit& u, int wr, int wc, int fr, int fq) const {
        const int pn = u.pn;
#pragma unroll
        for (int ai = 0; ai < 2; ++ai)
#pragma unroll
            for (int m = 0; m < 4; ++m) {
                const int row = u.pm * 256 + ai * 128 + wr * 64 + m * 16 + fr;
                if (row < MTOK + NMETA) {
                    const float rs = RS1[row];
                    const bool meta = row >= MTOK;
                    const int p = meta ? row - MTOK : (row & 8191) + NMETA;
                    const int b0 = meta ? 0 : (row >> 13), nb = meta ? 2 : 1;
#pragma unroll
                    for (int bj = 0; bj < 2; ++bj) {
                        float xv[8];
#pragma unroll
                        for (int i = 0; i < 4; ++i) { xv[i] = acc[ai][bj][m][0][i] * rs; xv[4 + i] = acc[ai][bj][m][1][i] * rs; }
                        if (pn < 4) {
                            const int hh = (pn & 1) * 4 + bj * 2 + (wc >> 1), d0 = 4 * (4 * (wc & 1) + fq);
                            const f32x4 cs = *(const f32x4*)(COS + p * 32 + d0), sn = *(const f32x4*)(SIN + p * 32 + d0);
                            float lo[4], hi[4];
#pragma unroll
                            for (int i = 0; i < 4; ++i) { lo[i] = xv[i] * cs[i] - xv[4 + i] * sn[i]; hi[i] = xv[4 + i] * cs[i] + xv[i] * sn[i]; }
                            if (pn < 2) {
                                if (!meta) {
                                    bf16_t* q = QB + ((size_t)((b0 * 8 + hh) * SEQ + (p - NMETA)) << 6) + d0;
                                    *(u32x2*)q = (u32x2){pk2(lo[0] * C2Q, lo[1] * C2Q), pk2(lo[2] * C2Q, lo[3] * C2Q)};
                                    *(u32x2*)(q + 32) = (u32x2){pk2(hi[0] * C2Q, hi[1] * C2Q), pk2(hi[2] * C2Q, hi[3] * C2Q)};
                                }
                            } else {
                                for (int bb = b0; bb < b0 + nb; ++bb) {
                                    *(u32x2*)(KT + kt_off(bb, hh, p, d0)) = (u32x2){pk2(lo[0], lo[1]), pk2(lo[2], lo[3])};
                                    *(u32x2*)(KT + kt_off(bb, hh, p, d0 + 32)) = (u32x2){pk2(hi[0], hi[1]), pk2(hi[2], hi[3])};
                                }
                            }
                        } else {
                            const u32x4 w = (u32x4){pk2(xv[0], xv[1]), pk2(xv[2], xv[3]), pk2(xv[4], xv[5]), pk2(xv[6], xv[7])};
                            const int cl = bj * 128 + wc * 32 + fq * 8;
                            if (pn < 6) {
                                const int h = (pn - 4) * 2 + bj, d = wc * 32 + fq * 8;
                                for (int bb = b0; bb < b0 + nb; ++bb) *(u32x4*)(VT + vt_off(bb, h, p, d)) = w;
                            } else if (pn < 12) {
                                for (int bb = b0; bb < b0 + nb; ++bb) *(u32x4*)(QKVB + (size_t)(bb * LP + p) * 1536 + (pn - 6) * 256 + cl) = w;
                            } else if (pn < 14) {
                                float sz[8];
#pragma unroll
                                for (int i = 0; i < 8; ++i) sz[i] = xv[i] * __builtin_amdgcn_rcpf(1.0f + __expf(-xv[i]));
                                const u32x4 wz = (u32x4){pk2(sz[0], sz[1]), pk2(sz[2], sz[3]), pk2(sz[4], sz[5]), pk2(sz[6], sz[7])};
                                for (int bb = b0; bb < b0 + nb; ++bb) *(u32x4*)(ZB + (size_t)(bb * LP + p) * 512 + (pn - 12) * 256 + cl) = wz;
                            } else if (cl < 16) {
                                float o[8];
                                if (cl == 0) {
#pragma unroll
                                    for (int i = 0; i < 8; ++i) { const float t = xv[i] + dt_bias[i]; const float sp = t > 20.f ? t : log1pf(expf(t)); o[i] = -expf(a_log[i]) * sp; }
                                } else {
#pragma unroll
                                    for (int i = 0; i < 8; ++i) o[i] = 1.0f / (1.0f + expf(-xv[i]));
                                }
                                for (int bb = b0; bb < b0 + nb; ++bb) { float* g = GB + ((size_t)(bb * LP + p) << 4) + cl;
                                    *(f32x4*)g = (f32x4){o[0], o[1], o[2], o[3]}; *(f32x4*)(g + 4) = (f32x4){o[4], o[5], o[6], o[7]}; }
                            }
                        }
                    }
                }
            }
    }
};

DI bf16x8 lds_frag(LAS const bf16_t* M, int row, int ch) { return *(LAS const bf16x8*)((LAS const unsigned char*)M + row * 128 + ((ch ^ (row & 7)) << 4)); }
DI bf16x8 lds_frag_plain(LAS const bf16_t* M, int row, int ch) { return *(LAS const bf16x8*)((LAS const unsigned char*)M + row * 128 + (ch << 4)); }
DI int swz_idx(int row, int d) { return row * 64 + ((((d >> 3) ^ (row & 7)) << 3) | (d & 7)); }

constexpr int PREP_PAIR = 35840;

template <int MAT> DI void prep_rows(const bf16_t* QKVB, const float* cw, int b, int h, int n, int lane, LAS const float* egS,
                                     LAS bf16_t* DS  , bf16_t* QG) {
    const int colb = MAT * 512 + h * 64, col = colb + lane, p0 = n * 64;
    const float c0 = cw[col], c1 = cw[1536 + col], c2 = cw[3072 + col], c3 = cw[4608 + col];
    const bf16_t* blk = QKVB + (size_t)(b * LP + p0) * 1536 + colb;
    float x0 = 0.f, x1 = 0.f, x2 = 0.f;
    if (n > 0) { x0 = bf2f(blk[lane - 3 * 1536]); x1 = bf2f(blk[lane - 2 * 1536]); x2 = bf2f(blk[lane - 1 * 1536]); }
    u32x4 stg[8];
#pragma unroll
    for (int i = 0; i < 8; ++i) stg[i] = *(const u32x4*)(blk + (size_t)(8 * i + (lane >> 3)) * 1536 + (lane & 7) * 8);
#pragma unroll
    for (int i = 0; i < 8; ++i) *(LAS u32x4*)(DS + (8 * i + (lane >> 3)) * 64 + (lane & 7) * 8) = stg[i];
    LDS_WAIT();
    const int nvalid = (LTOK - p0) < 64 ? (LTOK - p0) : 64;
#pragma unroll 4
    for (int c = 0; c < 64; ++c) {
        const bool valid = c < nvalid;
        const float x3 = valid ? bf2f(DS[c * 64 + lane]) : 0.f;
        float y = c0 * x0 + c1 * x1 + c2 * x2 + c3 * x3;
        y = y * __builtin_amdgcn_rcpf(1.0f + __expf(-y));
        if (!valid) y = 0.f;
        x0 = x1; x1 = x2; x2 = x3;
        if (MAT == 2) { DS[c * 64 + lane] = (bf16_t)f2bf(y); }
        else {
            const float ss = wave_sum(y * y);
            const float yn = y * __builtin_amdgcn_rsqf(ss + EPS);
            if (MAT == 0) {
                const float qn = yn * 0.125f;
                DS[c * 64 + lane] = (bf16_t)f2bf(qn);
                QG[c * 64 + perm16(lane)] = (bf16_t)f2bf(qn * egS[c]);
            } else {
                DS[c * 64 + lane] = (bf16_t)f2bf(yn);
            }
        }
    }
}

DI void solve_blocked(LAS const float* AST, LAS bf16_t* XB, LAS const float* scl, int lane, float sgn, bf16_t* out, int ocol) {
    for (int b = 0; b < 4; ++b) {
        float s[16];
#pragma unroll
        for (int r = 0; r < 16; ++r) s[r] = bf2f(XB[(16 * b + r) * 64 + lane]) * scl[16 * b + r];
        for (int j = 0; j < 16 * b; ++j) {
            const float xj = bf2f(XB[j * 64 + lane]);
            LAS const f32x4* ap = (LAS const f32x4*)(AST + j * 68 + 16 * b);
            const f32x4 a0 = ap[0], a1 = ap[1], a2 = ap[2], a3 = ap[3];
#pragma unroll
            for (int r = 0; r < 4; ++r) { s[r] -= a0[r] * xj; s[4 + r] -= a1[r] * xj; s[8 + r] -= a2[r] * xj; s[12 + r] -= a3[r] * xj; }
        }
#pragma unroll
        for (int jj = 0; jj < 15; ++jj) {
            const float xj = s[jj];
            LAS const float* ap = AST + (16 * b + jj) * 68 + 16 * b;
#pragma unroll
            for (int r = jj + 1; r < 16; ++r) s[r] -= ap[r] * xj;
        }
#pragma unroll
        for (int r = 0; r < 16; ++r) { XB[(16 * b + r) * 64 + lane] = (bf16_t)f2bf(s[r]); out[(16 * b + r) * 64 + ocol] = (bf16_t)f2bf(sgn * s[r]); }
    }
}

DI void gdn_prep_phase(const Params& P, LAS unsigned char* lds, int blk, int G, int wave, int lane_in) {
    const int pair = wave >> 1, role = wave & 1;
    LAS unsigned char* pb = lds + pair * PREP_PAIR;
    LAS bf16_t* QS = (LAS bf16_t*)pb; LAS bf16_t* KS = (LAS bf16_t*)(pb + 8192); LAS float* AS = (LAS float*)(pb + 16384);
    LAS float* gcS = (LAS float*)(pb + 16384 + 17408 + role * 1024); LAS float* betaS = gcS + 64; LAS float* egS = gcS + 128; LAS float* ekS = gcS + 192;
    const bf16_t* QKVB = (const bf16_t*)(P.ws + WS_QKVB); const float* GB = (const float*)(P.ws + WS_GB); const float* cw = P.in[9];
    const int NP = G * 4, NTASK = 2 * 8 * NCHUNK;
    for (int it = 0; it * NP < NTASK; ++it) {
        int lane = lane_in; asm volatile("" : "+v"(lane));
        const int r32 = lane & 31, hi = lane >> 5;
        const int task = it * NP + blk * 4 + pair;
        const bool active = task < NTASK;
        const int b = task / (8 * NCHUNK), h = (task / NCHUNK) & 7, n = task % NCHUNK;
        bf16_t* GPW = (bf16_t*)(P.ws + WS_GP) + (size_t)task * 4096; bf16_t* GPQG = GPW + GP_ARR / 2; bf16_t* GPAQK = GPQG + GP_ARR / 2; bf16_t* GPKGT = GPAQK + GP_ARR / 2; bf16_t* GPU = GPKGT + GP_ARR / 2;
        float gc = 0.f, beta = 0.f;
        if (active) {
            const int pl = n * 64 + lane;
            float g = 0.f;
            if (pl < LTOK) { const float* gb = GB + ((size_t)(b * LP + pl) << 4); g = gb[h]; beta = gb[8 + h]; }
            gcS[lane] = g; LDS_WAIT();
            gc = 0.f;
#pragma unroll
            for (int j4 = 0; j4 < 16; ++j4) { const f32x4 t = *(LAS const f32x4*)(gcS + 4 * j4);
                gc += (4 * j4 <= lane ? t[0] : 0.f) + (4 * j4 + 1 <= lane ? t[1] : 0.f) + (4 * j4 + 2 <= lane ? t[2] : 0.f) + (4 * j4 + 3 <= lane ? t[3] : 0.f); }
            const float glast = rlane(gc, 63);
            LDS_WAIT();
            gcS[lane] = gc; betaS[lane] = beta; egS[lane] = (role == 0) ? __expf(gc) : beta * __expf(gc); ekS[lane] = __expf(glast - gc);
            if (role == 0 && lane == 0) ((float*)(P.ws + WS_GL))[task] = __expf(glast);
            LDS_WAIT();
            if (role == 0) prep_rows<0>(QKVB, cw, b, h, n, lane, egS, QS, GPQG);
            else prep_rows<1>(QKVB, cw, b, h, n, lane, egS, KS, GPQG);
        }
        LDS_WAIT();
        __syncthreads();
        if (active) {
#pragma unroll
            for (int t4 = 0; t4 < 4; ++t4) {
                const int ct = t4 >> 1, st = t4 & 1;
                f32x16 acc = {};
                if (!(ct == 0 && st == 1)) {
#pragma unroll
                    for (int ks = 0; ks < 4; ++ks) {
                        const bf16x8 fa = lds_frag_plain(role == 0 ? QS : KS, 32 * ct + r32, 2 * ks + hi), fb = lds_frag_plain(KS, 32 * st + r32, 2 * ks + hi);
                        acc = MFMA32(fa, fb, acc);
                    }
                }
                const float gcs = gcS[32 * st + r32];
                bf16_t* aqb = GPAQK + hi * 256 + perm16(r32); LAS float* asb = AS + r32 * 68 + hi * 4;        LAS const float* gcb = gcS + hi * 4; LAS const float* beb = betaS + hi * 4;
                asm volatile("" : "+v"(aqb), "+v"(asb), "+v"(gcb), "+v"(beb));
#pragma unroll
                for (int i = 0; i < 16; ++i) {
                    const int cr = 32 * ct + (i & 3) + 8 * (i >> 2);
                    const int cmp = (32 * st + r32) - 4 * hi;
                    const float dec = __expf(gcb[cr] - gcs);
                    if (role == 0) aqb[cr * 64 + 32 * st] = (bf16_t)f2bf((cmp <= cr) ? acc[i] * dec : 0.f);
                    else asb[32 * st * 68 + cr] = (cmp < cr) ? acc[i] * beb[cr] * dec : 0.f;
                }
            }
        }
        LDS_WAIT();
        __syncthreads();
        if (active) {
            if (role == 0) {
                prep_rows<2>(QKVB, cw, b, h, n, lane, egS, QS  , GPQG);
                LDS_WAIT();
                solve_blocked(AS, QS, betaS, lane, 1.0f, GPU, lane);
            } else {
#pragma unroll
                for (int gq = 0; gq < 8; ++gq) {
                    float t[8];
#pragma unroll
                    for (int j = 0; j < 8; ++j) { const int c = perm16(8 * gq + j); t[j] = bf2f(KS[c * 64 + lane]) * ekS[c]; }
                    *(u32x4*)(GPKGT + lane * 64 + 8 * gq) = (u32x4){pk2(t[0], t[1]), pk2(t[2], t[3]), pk2(t[4], t[5]), pk2(t[6], t[7])};
                }
                solve_blocked(AS, KS, egS, lane, -1.0f, GPW, perm16(lane));
            }
        }
        LDS_WAIT();
    }
}

constexpr int GS_STAGE = 40960 + 256;
constexpr int GS_OBUF = 2 * GS_STAGE;
static_assert(GS_OBUF + 32768 <= 131072, "gdn scan LDS");

#define GS_STEP(n, HW, HGW, STGW) do { \
        if (wave < 2) { \
            if (n < NCHUNK) { \
                LAS const unsigned char* sg = lds + (n & 1) * GS_STAGE; \
                LAS const bf16_t* Wm = (LAS const bf16_t*)sg; LAS const bf16_t* QGm = (LAS const bf16_t*)(sg + 8192); LAS const bf16_t* AQm = (LAS const bf16_t*)(sg + 16384); \
                LAS const bf16_t* KGm = (LAS const bf16_t*)(sg + 24576); LAS const bf16_t* Um = (LAS const bf16_t*)(sg + 32768); \
                const float gl = *(LAS const float*)(sg + 40960); \
                bf16x8 Sb[2][2]; Sb[0][0] = pack8(S0, 0); Sb[0][1] = pack8(S0, 1); Sb[1][0] = pack8(S1, 0); Sb[1][1] = pack8(S1, 1); \
                f32x16 vn[2], o[2]; \
        _Pragma("unroll") \
                for (int ct = 0; ct < 2; ++ct) { \
                    f32x16 acc; \
        _Pragma("unroll") \
                    for (int i = 0; i < 16; ++i) acc[i] = bf2f(Um[(32 * ct + crow(i, hi)) * 64 + vbase + r32]); \
                    f32x16 oo = {}; \
        _Pragma("unroll") \
                    for (int kt = 0; kt < 2; ++kt) \
        _Pragma("unroll") \
                        for (int s2 = 0; s2 < 2; ++s2) { \
                            acc = MFMA32(lds_frag(Wm, 32 * ct + r32, (2 * kt + s2) * 2 + hi), Sb[kt][s2], acc); \
                            oo = MFMA32(lds_frag(QGm, 32 * ct + r32, (2 * kt + s2) * 2 + hi), Sb[kt][s2], oo); \
                        } \
                    vn[ct] = acc; o[ct] = oo; \
                } \
                bf16x8 Vb[2][2]; Vb[0][0] = pack8(vn[0], 0); Vb[0][1] = pack8(vn[0], 1); Vb[1][0] = pack8(vn[1], 0); Vb[1][1] = pack8(vn[1], 1); \
        _Pragma("unroll") \
                for (int i = 0; i < 16; ++i) { S0[i] *= gl; S1[i] *= gl; } \
        _Pragma("unroll") \
                for (int ct = 0; ct < 2; ++ct) \
        _Pragma("unroll") \
                    for (int s2 = 0; s2 < 2; ++s2) { \
                        const int ch = (2 * ct + s2) * 2 + hi; \
                        o[0] = MFMA32(lds_frag(AQm, r32, ch), Vb[ct][s2], o[0]); \
                        o[1] = MFMA32(lds_frag(AQm, 32 + r32, ch), Vb[ct][s2], o[1]); \
                        S0 = MFMA32(lds_frag(KGm, r32, ch), Vb[ct][s2], S0); \
                        S1 = MFMA32(lds_frag(KGm, 32 + r32, ch), Vb[ct][s2], S1); \
                    } \
                LAS float* ob = (LAS float*)(lds + GS_OBUF + (n & 1) * 16384); \
        _Pragma("unroll") \
                for (int ct = 0; ct < 2; ++ct) \
        _Pragma("unroll") \
                    for (int i = 0; i < 16; ++i) ob[(32 * ct + crow(i, hi)) * 64 + vbase + r32] = o[ct][i]; \
            } \
        } else if (wave < 4) { \
            if (n > 0) { \
                LAS const float* ob = (LAS const float*)(lds + GS_OBUF + ((n - 1) & 1) * 16384); \
                const f32x4 gn = *(const f32x4*)(gnorm + 4 * vq); \
        _Pragma("unroll") \
                for (int it = 0; it < 8; ++it) { \
                    const int c = (wave - 2) * 32 + 4 * it + rg, p = (n - 1) * 64 + c; \
                    const f32x4 v = *(LAS const f32x4*)(ob + c * 64 + 4 * vq); \
                    const float ss = row_sum16((v[0] * v[0] + v[1] * v[1]) + (v[2] * v[2] + v[3] * v[3])); \
                    const float rn = __builtin_amdgcn_rsqf(ss * (1.0f / 64.0f) + EPS); \
                    const u32x2 zz = zq[it]; \
                    const float z0 = __uint_as_float(zz.x << 16), z1 = __uint_as_float(zz.x & 0xffff0000u), z2 = __uint_as_float(zz.y << 16), z3 = __uint_as_float(zz.y & 0xffff0000u); \
                    const float y0 = v[0] * rn * gn[0] * z0, y1 = v[1] * rn * gn[1] * z1, y2 = v[2] * rn * gn[2] * z2, y3 = v[3] * rn * gn[3] * z3; \
                    if ((p >= NMETA) && (p < LTOK)) *(u32x2*)(MIX + (size_t)(b * SEQ + p - NMETA) * 1024 + 512 + h * 64 + 4 * vq) = (u32x2){pk2(y0, y1), pk2(y2, y3)}; \
                } \
            } \
            if (n < NCHUNK) { GS_ZLOAD(n); } \
        } else { \
            if (n + 1 < NCHUNK) { GS_WRITE(HW, HGW, STGW); if (n + 2 < NCHUNK) GS_ISSUE(HW, HGW, n + 2); } \
        } \
        BAR_LDS(); } while (0)
DI void gdn_scan(const Params& P, LAS unsigned char* lds, int bh, int tid, int wave, int lane) {
    const int b = bh >> 3, h = bh & 7, r32 = lane & 31, hi = lane >> 5;
    const int task0 = (b * 8 + h) * NCHUNK;
    const bf16_t* GP0 = (const bf16_t*)(P.ws + WS_GP);
    const float* GLg = (const float*)(P.ws + WS_GL);
    const bf16_t* ZB = (const bf16_t*)(P.ws + WS_ZB); bf16_t* MIX = (bf16_t*)(P.ws + WS_MIX); const float* gnorm = P.in[12];
    const int lt = tid - 256;
    u32x4 holdA[10]; float hglA = 0.f;
#define GS_ISSUE(H, HG, n_) do { _Pragma("unroll") for (int i = 0; i < 10; ++i) { const int a_ = i >> 1, e_ = lt + 256 * (i & 1); \
            H[i] = *(const u32x4*)(GP0 + (size_t)a_ * (GP_ARR / 2) + (size_t)(task0 + (n_)) * 4096 + e_ * 8); } \
        if (lt == 0) HG = GLg[task0 + (n_)]; } while (0)
#define GS_WRITE(H, HG, stg_) do { LAS unsigned char* sg_ = lds + (stg_) * GS_STAGE; \
        _Pragma("unroll") for (int i = 0; i < 10; ++i) { const int a_ = i >> 1, e_ = lt + 256 * (i & 1), row_ = e_ >> 3, ch_ = e_ & 7; \
            *(LAS u32x4*)(sg_ + a_ * 8192 + row_ * 128 + (((a_ < 4) ? (ch_ ^ (row_ & 7)) : ch_) << 4)) = H[i]; } \
        if (lt == 0) *(LAS float*)(sg_ + 40960) = HG; } while (0)
    const int vq = lane & 15, rg = lane >> 4;
    u32x2 zq[8];
#define GS_ZLOAD(n_) do { _Pragma("unroll") for (int it = 0; it < 8; ++it) { int p_ = (n_) * 64 + (wave - 2) * 32 + 4 * it + rg; p_ = p_ < LTOK ? p_ : LTOK - 1; \
            zq[it] = *(const u32x2*)(ZB + (size_t)(b * LP + p_) * 512 + h * 64 + 4 * vq); } } while (0)
    if (wave >= 4) { GS_ISSUE(holdA, hglA, 0); GS_WRITE(holdA, hglA, 0); GS_ISSUE(holdA, hglA, 1); }
    if (wave == 2 || wave == 3) { GS_ZLOAD(0); }
    __syncthreads();
    f32x16 S0 = {}, S1 = {};
    const int vbase = 32 * wave;
    for (int n2 = 0; n2 <= NCHUNK; n2 += 2) { GS_STEP((n2), holdA, hglA, 1); GS_STEP((n2 + 1), holdA, hglA, 0); }
}

constexpr int AT_STAGE = 32768;
constexpr int AT_XBUF = 2 * AT_STAGE;
constexpr int AT_WSF = AT_XBUF + 65536;
constexpr int AT_UNIT = AT_WSF + 2048;
constexpr float AT_THR = 8.0f;

DI s16x4 tr_read(LAS const unsigned char* p) { return __builtin_bit_cast(s16x4, __builtin_amdgcn_ds_read_tr16_b64_v4i16((LAS v4i16_t*)p)); }

DI void attn_unit(const Params& P, LAS unsigned char* lds, int bh, int qi, int tid, int wave, int lane, float lam) {
    const int b = bh >> 2, h = bh & 3, r32 = lane & 31, hi = lane >> 5, qsub = wave >> 1, map = wave & 1, hh = 2 * h + map;
    const bf16_t* QB = (const bf16_t*)(P.ws + WS_QB); const bf16_t* KT = (const bf16_t*)(P.ws + WS_KT); const bf16_t* VT = (const bf16_t*)(P.ws + WS_VT);
    const int ntiles = 2 * qi + 3, my_nt = (qsub < 2) ? ntiles - 1 : ntiles;
    const bf16_t* k1 = KT + ((size_t)((b * 8 + 2 * h) * NKT) << 12) + tid * 8;
    const bf16_t* k2 = KT + ((size_t)((b * 8 + 2 * h + 1) * NKT) << 12) + tid * 8;
    const bf16_t* vv = VT + ((size_t)((b * 4 + h) * NKT) << 13) + tid * 8;
    u32x4 st[4];
#define AT_LOAD(t) do { st[0] = *(const u32x4*)(k1 + ((size_t)(t) << 12)); st[1] = *(const u32x4*)(k2 + ((size_t)(t) << 12)); \
                        st[2] = *(const u32x4*)(vv + ((size_t)(t) << 13)); st[3] = *(const u32x4*)(vv + ((size_t)(t) << 13) + 4096); } while (0)
#define AT_STORE(sb) do { LAS unsigned char* d_ = lds + (sb) * AT_STAGE + tid * 16; *(LAS u32x4*)d_ = st[0]; *(LAS u32x4*)(d_ + 8192) = st[1]; \
                          *(LAS u32x4*)(d_ + 16384) = st[2]; *(LAS u32x4*)(d_ + 24576) = st[3]; } while (0)
    AT_LOAD(0);
    bf16x8 qr[4];
    { const bf16_t* q = QB + ((size_t)((b * 8 + hh) * SEQ + qi * 128 + qsub * 32 + r32) << 6) + hi * 8;
#pragma unroll
      for (int d0 = 0; d0 < 4; ++d0) qr[d0] = *(const bf16x8*)(q + d0 * 16); }
    AT_STORE(0);
    __syncthreads();
    LAS float* wsf = (LAS float*)(lds + AT_WSF) + wave * 64;
    float m_run = -1e30f, l_run = 0.f;
    f32x16 o[4]; o[0] = f32x16{}; o[1] = f32x16{}; o[2] = f32x16{}; o[3] = f32x16{};
    for (int t = 0; t < ntiles; ++t) {
        if (t + 1 < ntiles) AT_LOAD(t + 1);
        if (t < my_nt) {
            LAS const unsigned char* sg = lds + (t & 1) * AT_STAGE;
            LAS const unsigned char* kb = sg + map * 8192 + hi * 1024 + r32 * 16;
            f32x16 p0 = {}, p1 = {};
#pragma unroll
            for (int d0 = 0; d0 < 4; ++d0) {
                const bf16x8 a0 = *(LAS const bf16x8*)(kb + d0 * 2048), a1 = *(LAS const bf16x8*)(kb + d0 * 2048 + 512);
                p0 = MFMA32(a0, qr[d0], p0); p1 = MFMA32(a1, qr[d0], p1);
            }
            if (t == 0) {
#pragma unroll
                for (int r = 0; r < 16; ++r) { if (crow(r, hi) >= NMETA) p0[r] = -INFINITY; p1[r] = -INFINITY; }
            }
            float rm = fmaxf(p0[0], p1[0]);
#pragma unroll
            for (int r = 1; r < 16; ++r) rm = fmaxf(rm, fmaxf(p0[r], p1[r]));
            rm = swap32_max(rm);
            if (__any(rm > m_run + AT_THR)) {
                const float mn = fmaxf(m_run, rm), alpha = exp2f(m_run - mn);
                l_run *= alpha; m_run = mn;
                if (hi == 0) wsf[r32] = alpha;
                LDS_WAIT();
#pragma unroll
                for (int r = 0; r < 16; ++r) { const float a = wsf[crow(r, hi)];
#pragma unroll
                    for (int d0 = 0; d0 < 4; ++d0) o[d0][r] *= a; }
                LDS_WAIT();
            }
            float ls = 0.f;
#pragma unroll
            for (int r = 0; r < 16; ++r) { p0[r] = exp2f(p0[r] - m_run); p1[r] = exp2f(p1[r] - m_run); ls += p0[r] + p1[r]; }
            l_run += ls;
            const bf16x8 pa0 = pack8(p0, 0), pa1 = pack8(p0, 1), pa2 = pack8(p1, 0), pa3 = pack8(p1, 1);
            LAS const unsigned char* vb = sg + 16384 + ((lane >> 4) & 1) * 32 + (lane & 3) * 8 + (4 * hi + ((lane & 15) >> 2)) * 64;
#pragma unroll
            for (int d0 = 0; d0 < 4; ++d0) {
#define AT_VF(ks) ({ const s16x4 lo_ = tr_read(vb + d0 * 4096 + (ks) * 1024), hi_ = tr_read(vb + d0 * 4096 + (ks) * 1024 + 512); \
                     (bf16x8){lo_[0], lo_[1], lo_[2], lo_[3], hi_[0], hi_[1], hi_[2], hi_[3]}; })
                o[d0] = MFMA32(pa0, AT_VF(0), o[d0]); o[d0] = MFMA32(pa1, AT_VF(1), o[d0]);
                o[d0] = MFMA32(pa2, AT_VF(2), o[d0]); o[d0] = MFMA32(pa3, AT_VF(3), o[d0]);
#undef AT_VF
            }
        }
        if (t + 1 < ntiles) AT_STORE((t + 1) & 1);
        __syncthreads();
    }
    l_run = swap32_add(l_run);
    const float sc = (map ? lam : 1.0f) / l_run;
    if (hi == 0) wsf[r32] = sc;
    LDS_WAIT();
#pragma unroll
    for (int r = 0; r < 16; ++r) { const float a = wsf[crow(r, hi)];
#pragma unroll
        for (int d0 = 0; d0 < 4; ++d0) o[d0][r] *= a; }
    LAS float* xb = (LAS float*)(lds + AT_XBUF + qsub * 16384);
    if (map) {
#pragma unroll
        for (int d0 = 0; d0 < 4; ++d0)
#pragma unroll
            for (int r = 0; r < 16; ++r) xb[(d0 * 16 + r) * 64 + lane] = o[d0][r];
    }
    __syncthreads();
    if (!map) {
        const float* dn = P.in[8];
        bf16_t* MIX = (bf16_t*)(P.ws + WS_MIX);
        float ss[16];
#pragma unroll
        for (int r = 0; r < 16; ++r) { ss[r] = 0.f;
#pragma unroll
            for (int d0 = 0; d0 < 4; ++d0) { o[d0][r] -= xb[(d0 * 16 + r) * 64 + lane]; ss[r] += o[d0][r] * o[d0][r]; } }
#pragma unroll
        for (int r = 0; r < 16; ++r) {
            ss[r] = half_sum32(ss[r]);
            ss[r] = 0.8f / sqrtf(ss[r] * (1.0f / 128.0f) + EPS);
        }
        float dg[4];
#pragma unroll
        for (int d0 = 0; d0 < 4; ++d0) dg[d0] = dn[32 * d0 + r32];
#pragma unroll
        for (int r = 0; r < 16; ++r) {
            bf16_t* orow = MIX + (size_t)(b * SEQ + qi * 128 + qsub * 32 + crow(r, hi)) * 1024 + h * 128 + r32;
#pragma unroll
            for (int d0 = 0; d0 < 4; ++d0) orow[32 * d0] = (bf16_t)f2bf(o[d0][r] * ss[r] * dg[d0]);
        }
    }
    __syncthreads();
#undef AT_LOAD
#undef AT_STORE
}

DI void attn_phase(const Params& P, LAS unsigned char* lds, int tid, int wave, int lane) {
    unsigned* ctl = (unsigned*)(P.ws + WS_CTL);
    const float* lq1 = P.in[4]; const float* lk1 = P.in[5]; const float* lq2 = P.in[6]; const float* lk2 = P.in[7];
    const float lam = __expf(wave_sum(lq1[lane] * lk1[lane])) - __expf(wave_sum(lq2[lane] * lk2[lane])) + 0.2f;
    LAS volatile int* ub = (LAS volatile int*)(lds + AT_UNIT);
    for (;;) {
        if (tid == 0) *ub = (int)__hip_atomic_fetch_add(ctl + CW_ATTQ, 1u, __ATOMIC_RELAXED, __HIP_MEMORY_SCOPE_AGENT);
        __syncthreads();
        const int u = *ub;
        __syncthreads();
        if (u >= 512) break;
        attn_unit(P, lds, u & 7, 63 - (u >> 3), tid, wave, lane, lam);
    }
}

struct EpiOutProj {
    static constexpr bool PERM = false, AFTER_DRAIN = false;
    const float* x; float* out;
    DI void operator()(const pg8::f32x4 (&acc)[2][2][4][2], const pg8::Unit& u, int wr, int wc, int fr, int fq) const {
        const int row0 = u.pm * 256 + wr * 64 + fr, col0 = u.pn * 256 + wc * 32 + 4 * fq;
#pragma unroll
        for (int ai = 0; ai < 2; ++ai)
#pragma unroll
            for (int m = 0; m < 4; ++m) { const size_t off = (size_t)(row0 + ai * 128 + m * 16) * 1024 + col0;
#pragma unroll
                for (int bj = 0; bj < 2; ++bj)
#pragma unroll
                    for (int n = 0; n < 2; ++n) { const f32x4 xv = *(const f32x4*)(x + off + bj * 128 + n * 16); *(f32x4*)(out + off + bj * 128 + n * 16) = acc[ai][bj][m][n] + xv; } }
    }
};

typedef float f32x4v __attribute__((ext_vector_type(4)));
DI void route_tile(const Params& P, int tile, LAS float* lg  , int lane) {
    const float* h2 = P.out; const float* WR = (const float*)(P.ws + WS_WR);
    const int r16 = lane & 15, kq = lane >> 4;
    const float* arow = h2 + (size_t)(tile * 16 + r16) * 1024 + kq * 256;
    const float* b0 = WR + (size_t)r16 * 1024 + kq * 256; const float* b1 = b0 + 16 * 1024; const float* b2 = WR + (size_t)(32 + (r16 & 3)) * 1024 + kq * 256;
    const float z2 = (r16 < 4) ? 1.0f : 0.0f;
    f32x4v c0 = {}, c1 = {}, c2 = {};
    float ss = 0.f;
    for (int t4 = 0; t4 < 64; ++t4) {
        const f32x4 a = *(const f32x4*)(arow + 4 * t4), w0 = *(const f32x4*)(b0 + 4 * t4), w1 = *(const f32x4*)(b1 + 4 * t4), w2 = *(const f32x4*)(b2 + 4 * t4);
        ss += (a.x * a.x + a.y * a.y) + (a.z * a.z + a.w * a.w);
#pragma unroll
        for (int i = 0; i < 4; ++i) {
            c0 = __builtin_amdgcn_mfma_f32_16x16x4f32(a[i], w0[i], c0, 0, 0, 0);
            c1 = __builtin_amdgcn_mfma_f32_16x16x4f32(a[i], w1[i], c1, 0, 0, 0);
            c2 = __builtin_amdgcn_mfma_f32_16x16x4f32(a[i], w2[i] * z2, c2, 0, 0, 0);
        }
    }
    ss += swz_xor16(ss); ss = swap32_add(ss);
    const float rs = 1.0f / sqrtf(ss * (1.0f / 1024.0f) + EPS);
#pragma unroll
    for (int r = 0; r < 4; ++r) { const int row = 4 * kq + r; lg[row * 48 + r16] = c0[r]; lg[row * 48 + 16 + r16] = c1[r]; lg[row * 48 + 32 + r16] = c2[r]; }
    LDS_WAIT();
    if (lane < 16) {
        const int t = tile * 16 + lane;
        const float* bg = P.in[16]; const float* br = P.in[18];
        LAS const float* l = lg + lane * 48;
        float gl[4]; int gs = 0; float gm;
#pragma unroll
        for (int j = 0; j < 4; ++j) gl[j] = l[j] * rs + bg[j];
        gm = gl[0];
#pragma unroll
        for (int j = 1; j < 4; ++j) if (gl[j] > gm) { gm = gl[j]; gs = j; }
        float gsum = 0.f;
#pragma unroll
        for (int j = 0; j < 4; ++j) gsum += __expf(gl[j] - gm);
        const float psel = 1.0f / gsum;
        float e1 = -INFINITY, e2 = -INFINITY; int i1 = 0, i2 = 0;
#pragma unroll
        for (int j = 0; j < 8; ++j) {
            const float v = l[4 + gs * 8 + j] * rs + br[gs * 8 + j];
            if (v > e1) { e2 = e1; i2 = i1; e1 = v; i1 = j; } else if (v > e2) { e2 = v; i2 = j; }
        }
        const float x2 = __expf(e2 - e1), w1 = psel / (1.0f + x2), w2 = psel * x2 / (1.0f + x2);
        const int ea = gs * 8 + i1, eb = gs * 8 + i2;
        unsigned* cnt = (unsigned*)(P.ws + WS_CTL) + CW_CNT;
        const int pa = (int)atomicAdd(cnt + ea, 1u), pb = (int)atomicAdd(cnt + eb, 1u);
        ((int*)(P.ws + WS_TOKE))[2 * t] = ea; ((int*)(P.ws + WS_TOKE))[2 * t + 1] = eb;
        ((float*)(P.ws + WS_TOKW))[2 * t] = w1; ((float*)(P.ws + WS_TOKW))[2 * t + 1] = w2;
        ((int*)(P.ws + WS_TOKP))[2 * t] = pa; ((int*)(P.ws + WS_TOKP))[2 * t + 1] = pb;
        ((float*)(P.ws + WS_RS2))[t] = rs;
    }
    LDS_WAIT();
}

DI void phase4a(const Params& P, LAS unsigned char* lds, int gw, int NGW, int wave, int lane) {
    LAS float* scr = (LAS float*)(lds + wave * 16384);
    for (int tile = gw; tile < MTOK / 16; tile += NGW) route_tile(P, tile, scr, lane);
    bf16_t* WGU = (bf16_t*)(P.ws + WS_WGU); bf16_t* WD = (bf16_t*)(P.ws + WS_WD);
    const float* wg = P.in[19]; const float* wu = P.in[20]; const float* wd = P.in[21]; const float* gf = P.in[14];
    constexpr int I_GU = 16 * 16, I_D = 4 * 32;
    for (int it = gw; it < 32 * (I_GU + I_D); it += NGW) {
        const int e = it / (I_GU + I_D), r = it % (I_GU + I_D);
        if (r < I_GU) { const int n0 = (r & 15) * 32, j = n0 >> 8, up = (n0 >> 7) & 1;
            const float* wsrc = (up ? wu : wg) + (size_t)e * 1024 * 256;
            const SrcGU s{wsrc, gf, 128 * j + (n0 & 127) - n0};
            transpose_item(s, WGU + (size_t)e * 512 * 1024, 1024, (r >> 4) * 64, n0, scr, lane); }
        else { const int r2 = r - I_GU; const SrcPlain s{wd + (size_t)e * 256 * 1024, 1024};
            transpose_item(s, WD + (size_t)e * 1024 * 256, 256, (r2 >> 5) * 64, (r2 & 31) * 32, scr, lane); }
    }
}

DI void expert_layout(const Params& P, int lane, int& cnt, int& base, int& tend) {
    const unsigned* c = (const unsigned*)(P.ws + WS_CTL) + CW_CNT;
    cnt = (lane < 32) ? (int)__hip_atomic_load(c + lane, __ATOMIC_RELAXED, __HIP_MEMORY_SCOPE_AGENT) : 0;
    const int tiles = (cnt + 255) >> 8;
    int inc = 0;
#pragma unroll
    for (int i = 0; i < 32; ++i) { const int ti = __builtin_amdgcn_readlane(tiles, i); inc += (i <= lane) ? ti : 0; }
    tend = inc; base = (inc - tiles) << 8;
}

DI void phase4b(const Params& P, int gw, int NGW, int lane) {
    int cnt, base, tend; expert_layout(P, lane, cnt, base, tend);
    bf16_t* XS = (bf16_t*)(P.ws + WS_XS); float* SLOTW = (float*)(P.ws + WS_SLOTW);
    const int* TOKE = (const int*)(P.ws + WS_TOKE); const float* TOKW = (const float*)(P.ws + WS_TOKW); int* TOKP = (int*)(P.ws + WS_TOKP); const float* RS2 = (const float*)(P.ws + WS_RS2);
    for (int t = gw; t < MTOK; t += NGW) {
        const f32x4* hr = (const f32x4*)(P.out + (size_t)t * 1024);
        const float rs = RS2[t];
        u32x2 w[4];
#pragma unroll
        for (int j = 0; j < 4; ++j) { const f32x4 v = hr[64 * j + lane]; w[j] = (u32x2){pk2(v.x * rs, v.y * rs), pk2(v.z * rs, v.w * rs)}; }
#pragma unroll
        for (int k = 0; k < 2; ++k) {
            const int e = __builtin_amdgcn_readfirstlane(TOKE[2 * t + k]), slot = __builtin_amdgcn_readlane(base, e) + TOKP[2 * t + k];
            u32x2* orow = (u32x2*)(XS + (size_t)slot * 1024);
#pragma unroll
            for (int j = 0; j < 4; ++j) orow[64 * j + lane] = w[j];
            if (lane == 0) { SLOTW[slot] = TOKW[2 * t + k]; TOKP[2 * t + k] = slot; }
        }
    }
    for (int e = 0; e < 32; ++e) {
        const int ce = __builtin_amdgcn_readlane(cnt, e), be = __builtin_amdgcn_readlane(base, e), end = be + (((ce + 255) >> 8) << 8);
        for (int r = be + ce + gw; r < end; r += NGW) { u32x2* orow = (u32x2*)(XS + (size_t)r * 1024);
#pragma unroll
            for (int j = 0; j < 4; ++j) orow[64 * j + lane] = (u32x2){0u, 0u};
            if (lane == 0) SLOTW[r] = 0.f; }
    }
}

struct GroupedOrder {
    int tend; int total; int G, c, NS;
    DI bool next(int i, pg8::Unit& u) const {
        const int L = i * G + c; if (L >= (total << NS)) return false;
        const int mt = L >> NS, j = L & ((1 << NS) - 1);
        const int e = __builtin_popcountll(__ballot(((int)(threadIdx.x & 63) < 32) && tend <= mt));
        u.pm = mt; u.pn = (e << NS) + j; return true;
    }
    DI void a_ready(const pg8::Unit&) const {}
    DI void done(const pg8::Unit&) const {}
};
struct EpiGateUp {
    static constexpr bool PERM = true, AFTER_DRAIN = false;
    const float* SLOTW; bf16_t* YS;
    DI void operator()(const pg8::f32x4 (&acc)[2][2][4][2], const pg8::Unit& u, int wr, int wc, int fr, int fq) const {
        const int f0 = (u.pn & 1) * 128 + wc * 32 + fq * 8;
#pragma unroll
        for (int ai = 0; ai < 2; ++ai)
#pragma unroll
            for (int m = 0; m < 4; ++m) {
                const int row = u.pm * 256 + ai * 128 + wr * 64 + m * 16 + fr;
                const float cw = SLOTW[row];
                float a[8];
#pragma unroll
                for (int i = 0; i < 4; ++i) {
                    const float g0 = acc[ai][0][m][0][i], g1 = acc[ai][0][m][1][i];
                    a[i] = g0 / (1.0f + __expf(-g0)) * acc[ai][1][m][0][i] * cw; a[4 + i] = g1 / (1.0f + __expf(-g1)) * acc[ai][1][m][1][i] * cw;
                }
                *(u32x4*)(YS + (size_t)row * 256 + f0) = (u32x4){pk2(a[0], a[1]), pk2(a[2], a[3]), pk2(a[4], a[5]), pk2(a[6], a[7])};
            }
    }
};
struct EpiDown {
    static constexpr bool PERM = true, AFTER_DRAIN = false;
    bf16_t* YO;
    DI void operator()(const pg8::f32x4 (&acc)[2][2][4][2], const pg8::Unit& u, int wr, int wc, int fr, int fq) const {
        const int c0 = (u.pn & 3) * 256 + wc * 32 + fq * 8;
#pragma unroll
        for (int ai = 0; ai < 2; ++ai)
#pragma unroll
            for (int m = 0; m < 4; ++m) {
                bf16_t* rowp = YO + (size_t)(u.pm * 256 + ai * 128 + wr * 64 + m * 16 + fr) * 1024 + c0;
#pragma unroll
                for (int bj = 0; bj < 2; ++bj) { const pg8::f32x4 v0 = acc[ai][bj][m][0], v1 = acc[ai][bj][m][1];
                    *(u32x4*)(rowp + bj * 128) = (u32x4){pk2(v0[0], v0[1]), pk2(v0[2], v0[3]), pk2(v1[0], v1[1]), pk2(v1[2], v1[3])}; }
            }
    }
};

DI void phase7(const Params& P, int gw, int NGW, int lane) {
    const bf16_t* YO = (const bf16_t*)(P.ws + WS_YO); const int* TOKP = (const int*)(P.ws + WS_TOKP); const f32x4* nf = (const f32x4*)P.in[22];
    for (int t = gw; t < MTOK; t += NGW) {
        f32x4* hr = (f32x4*)(P.out + (size_t)t * 1024);
        const u32x2* y0 = (const u32x2*)(YO + (size_t)TOKP[2 * t] * 1024); const u32x2* y1 = (const u32x2*)(YO + (size_t)TOKP[2 * t + 1] * 1024);
        f32x4 v[4]; float s = 0.f;
#pragma unroll
        for (int j = 0; j < 4; ++j) {
            v[j] = hr[64 * j + lane]; const u32x2 a = y0[64 * j + lane], c = y1[64 * j + lane];
            v[j].x += __uint_as_float(a.x << 16) + __uint_as_float(c.x << 16); v[j].y += __uint_as_float(a.x & 0xffff0000u) + __uint_as_float(c.x & 0xffff0000u);
            v[j].z += __uint_as_float(a.y << 16) + __uint_as_float(c.y << 16); v[j].w += __uint_as_float(a.y & 0xffff0000u) + __uint_as_float(c.y & 0xffff0000u);
            s += (v[j].x * v[j].x + v[j].y * v[j].y) + (v[j].z * v[j].z + v[j].w * v[j].w);
        }
        s = wave_sum(s);
        const float rs = 1.0f / sqrtf(s * (1.0f / 1024.0f) + EPS);
#pragma unroll
        for (int j = 0; j < 4; ++j) hr[64 * j + lane] = v[j] * rs * nf[64 * j + lane];
    }
}

#define XB_TMO      128
#define XB_XCNT(j)  (256  + 64 * (j))
#define XB_XSUB(j)  (1280 + 64 * (j))
#define XB_XGEN(j)  (2304 + 64 * (j))
#define XB_TOP      3328
#define XB_TOPGEN   3392
#define XCD_BAR_WORDS 3456
#define XB_SPIN_CAP (1u << 18)

__device__ __forceinline__ unsigned xb_ld(unsigned* p)              { return __hip_atomic_load(p, __ATOMIC_RELAXED, __HIP_MEMORY_SCOPE_AGENT); }
__device__ __forceinline__ unsigned xb_add(unsigned* p, unsigned v) { return __hip_atomic_fetch_add(p, v, __ATOMIC_RELAXED, __HIP_MEMORY_SCOPE_AGENT); }
__device__ __forceinline__ unsigned xb_xcc_id() { return (unsigned)__builtin_amdgcn_s_getreg((3 << 11) | 20) & 0xFu; }
#define XB_SPIN(cond, bar) do { unsigned _sp = 0; while (cond) { __builtin_amdgcn_s_sleep(1); \
    if ((++_sp & 255u) == 0u) { if (xb_ld(&(bar)[XB_TMO])) break; if (_sp > XB_SPIN_CAP) { atomicAdd(&(bar)[XB_TMO], 1u); break; } } } } while (0)

struct XcdBarrier {
    unsigned* bar; unsigned x;
    volatile LAS unsigned* st;
};

__device__ __forceinline__ XcdBarrier xcd_barrier_post(unsigned* bar, volatile LAS unsigned* st) {
    XcdBarrier b; b.bar = bar; b.x = xb_xcc_id(); b.st = st;
    if (threadIdx.x == 0) (void)xb_add(&bar[XB_XCNT(b.x)], 1u);
    return b;
}
__device__ __forceinline__ void xcd_barrier_complete(unsigned* bar, unsigned x, unsigned& nloc, unsigned& nx) {
    const unsigned G = gridDim.x * gridDim.y * gridDim.z;
    unsigned sum, cnt, mine, sp = 0u;
    for (;;) {
        sum = 0u; cnt = 0u; mine = 0u;
#pragma unroll
        for (unsigned j = 0; j < 16; ++j) { const unsigned c = xb_ld(&bar[XB_XCNT(j)]); sum += c; cnt += (c > 0u) ? 1u : 0u; mine = (j == x) ? c : mine; }
        if (sum == G) break;
        __builtin_amdgcn_s_sleep(1);
        if ((++sp & 255u) == 0u) { if (xb_ld(&bar[XB_TMO])) break; if (sp > XB_SPIN_CAP) { atomicAdd(&bar[XB_TMO], 1u); break; } }
    }
    nloc = mine > 0u ? mine : 1u; nx = cnt > 0u ? cnt : 1u;
}

__device__ __forceinline__ void xcd_barrier(const XcdBarrier& b) {
    asm volatile("s_waitcnt vmcnt(0)" ::: "memory");
    __syncthreads();
    if (threadIdx.x == 0) {
        unsigned* bar = b.bar;
        __builtin_amdgcn_s_waitcnt(0);
        unsigned nloc = b.st[0], nx = b.st[1];
        if (nloc == 0u) { xcd_barrier_complete(bar, b.x, nloc, nx); b.st[0] = nloc; b.st[1] = nx; }
        const unsigned old = xb_add(&bar[XB_XSUB(b.x)], 1u);
        const unsigned gen = old / nloc;
        if (old + 1u == (gen + 1u) * nloc) {
            __builtin_amdgcn_fence(__ATOMIC_RELEASE, "agent");
            asm volatile("s_waitcnt vmcnt(0)" ::: "memory");
            const unsigned og = xb_add(&bar[XB_TOP], 1u);
            const unsigned tg = og / nx;
            if (og + 1u == (tg + 1u) * nx) xb_add(&bar[XB_TOPGEN], 1u);
            else XB_SPIN(xb_ld(&bar[XB_TOPGEN]) == tg, bar);
            __builtin_amdgcn_fence(__ATOMIC_ACQUIRE, "agent");
            xb_add(&bar[XB_XGEN(b.x)], 1u);
            asm volatile("s_waitcnt vmcnt(0)" ::: "memory");
        } else {
            XB_SPIN(xb_ld(&bar[XB_XGEN(b.x)]) == gen, bar);
            __builtin_amdgcn_fence(__ATOMIC_ACQUIRE, "agent");
            asm volatile("s_waitcnt vmcnt(0)" ::: "memory");
        }
    }
    __syncthreads();
}

#ifndef PHMASK
#define PHMASK 2047
#endif
#ifndef REPMASK
#define REPMASK 0
#endif
#define REP(bit) for (int rep_ = 0; rep_ < ((REPMASK & (bit)) ? 2 : 1); ++rep_)
#define REPSYNC(bit) if ((REPMASK & (bit)) && rep_ == 0) GRID_BAR()
typedef const __attribute__((address_space(4))) Params* KParams;
DI Params load_params(KParams kp) { Params p;
#pragma unroll
    for (int i = 0; i < 23; ++i) p.in[i] = kp->in[i];
    p.out = kp->out; p.ws = kp->ws; return p; }
__global__ void __launch_bounds__(NTHREADS, 2) hymba_fwd(Params Pin) {
    extern __shared__ __attribute__((aligned(16))) unsigned char lds_raw[];
    LAS unsigned char* lds = (LAS unsigned char*)lds_raw;
    cg::grid_group grid = cg::this_grid();
    volatile LAS unsigned* bst = (volatile LAS unsigned*)(lds + LDS_BYTES - 64);
    if (threadIdx.x < 2) bst[threadIdx.x] = 0u;
    __syncthreads();
    const XcdBarrier xbar = xcd_barrier_post((unsigned*)(Pin.ws + WS_CTL) + CW_BAR, bst);
#define GRID_BAR() xcd_barrier(xbar)
    const int G = gridDim.x, blk = blockIdx.x, NGW = G * NWAVES, NGT = G * NTHREADS;
#define PHASE_IDS() KParams kp_ = (KParams)__builtin_amdgcn_kernarg_segment_ptr(); asm volatile("" : "+s"(kp_)); const Params P = load_params(kp_); int tid = threadIdx.x; asm volatile("" : "+v"(tid)); const int lane = tid & 63, wave = __builtin_amdgcn_readfirstlane(tid >> 6), gw = blk * NWAVES + wave, gtid = blk * NTHREADS + tid; (void)lane; (void)gw; (void)gtid; (void)wave

    REP(1) { if (PHMASK & 1) { PHASE_IDS(); phase0(P, lds, gw, NGW, gtid, NGT, wave, lane); } REPSYNC(1); }
    grid.sync();
    REP(2) { if (PHMASK & 2) { PHASE_IDS();
        pg8::Gemm g{(const bf16_t*)(P.ws + WS_XB), (const bf16_t*)(P.ws + WS_WINT), MROWS, NPROJ, 1024};
        pg8::StaticOrder S; S.init(MROWS, NPROJ, G, blk);
        EpiInProj E{(const float*)(P.ws + WS_RS1), (const float*)(P.ws + WS_COS), (const float*)(P.ws + WS_SIN), P.in[10], P.in[11],
                    (bf16_t*)(P.ws + WS_QB), (bf16_t*)(P.ws + WS_KT), (bf16_t*)(P.ws + WS_VT), (bf16_t*)(P.ws + WS_QKVB), (bf16_t*)(P.ws + WS_ZB), (float*)(P.ws + WS_GB)};
        pg8::gemm_phase<EpiInProj, pg8::StaticOrder, true, true>(lds, g, S, E);
    } REPSYNC(2); }
    GRID_BAR();
    REP(4) { if (PHMASK & 4) { PHASE_IDS(); gdn_prep_phase(P, lds, blk, G, wave, lane); } REPSYNC(4); }
    GRID_BAR();
    REP(8) { if ((PHMASK & 8) && blk < 16) { PHASE_IDS(); gdn_scan(P, lds, blk, tid, wave, lane); } }
    REP(16) {
    if (PHMASK & 16) { PHASE_IDS(); attn_phase(P, lds, tid, wave, lane); }
    if ((REPMASK & 16) && rep_ == 0) { GRID_BAR(); if (blk == 0 && threadIdx.x == 0) { PHASE_IDS(); __hip_atomic_store((unsigned*)(P.ws + WS_CTL) + CW_ATTQ, 0u, __ATOMIC_RELAXED, __HIP_MEMORY_SCOPE_AGENT); } GRID_BAR(); }
    }
    GRID_BAR();
    REP(32) { if (PHMASK & 32) { PHASE_IDS();
        pg8::Gemm g{(const bf16_t*)(P.ws + WS_MIX), (const bf16_t*)(P.ws + WS_WOUT), MTOK, 1024, 1024};
        pg8::StaticOrder S; S.init(MTOK, 1024, G, blk);
        EpiOutProj E{P.in[0], P.out};
        pg8::gemm_phase<EpiOutProj, pg8::StaticOrder, true, true>(lds, g, S, E);
    } REPSYNC(32); }
    GRID_BAR();
    if (PHMASK & 64) { PHASE_IDS(); phase4a(P, lds, gw, NGW, wave, lane); }
    GRID_BAR();
    if (PHMASK & 128) { PHASE_IDS(); phase4b(P, gw, NGW, lane); }
    GRID_BAR();
    int cnt, base, tend, total; { PHASE_IDS(); expert_layout(P, lane, cnt, base, tend); total = __builtin_amdgcn_readlane(tend, 31); }
    REP(256) { if (PHMASK & 256) { PHASE_IDS();
        pg8::Gemm g{(const bf16_t*)(P.ws + WS_XS), (const bf16_t*)(P.ws + WS_WGU), XS_ROWS, 32 * 512, 1024};
        GroupedOrder S{tend, total, G, blk, 1};
        EpiGateUp E{(const float*)(P.ws + WS_SLOTW), (bf16_t*)(P.ws + WS_YS)};
        pg8::gemm_phase<EpiGateUp, GroupedOrder, true, true>(lds, g, S, E);
    } REPSYNC(256); }
    GRID_BAR();
    REP(512) { if (PHMASK & 512) { PHASE_IDS();
        int kd = 256; asm volatile("" : "+s"(kd));
        pg8::Gemm g{(const bf16_t*)(P.ws + WS_YS), (const bf16_t*)(P.ws + WS_WD), XS_ROWS, 32 * 1024, kd};
        GroupedOrder S{tend, total, G, blk, 2};
        EpiDown E{(bf16_t*)(P.ws + WS_YO)};
        pg8::gemm_phase<EpiDown, GroupedOrder, true, true>(lds, g, S, E);
    } REPSYNC(512); }
    GRID_BAR();
    if (PHMASK & 1024) { PHASE_IDS(); phase7(P, gw, NGW, lane); }
}

extern "C" void kernel_launch(void* const* d_in, const int* in_sizes, int n_in, void* d_out, int out_size, void* d_ws, size_t ws_size, hipStream_t stream) {
    static int grid_blocks = 0;
    if (grid_blocks == 0) {
        if (n_in != 23 || out_size != MTOK * DMODEL || ws_size < WS_END) { fprintf(stderr, "kernel_launch: unexpected shapes (n_in %d out %d ws %zu)\n", n_in, out_size, ws_size); grid_blocks = -1; return; }
        int dev = 0, cus = 0, per_cu = 0;
        hipGetDevice(&dev);
        hipDeviceGetAttribute(&cus, hipDeviceAttributeMultiprocessorCount, dev);
        hipFuncSetAttribute((const void*)hymba_fwd, hipFuncAttributeMaxDynamicSharedMemorySize, LDS_BYTES);
        hipOccupancyMaxActiveBlocksPerMultiprocessor(&per_cu, (const void*)hymba_fwd, NTHREADS, LDS_BYTES);
        if (per_cu < 1) { fprintf(stderr, "kernel_launch: occupancy query says %d blocks/CU\n", per_cu); per_cu = 1; }
        grid_blocks = cus;
        (void)hipGetLastError();
    }
    if (grid_blocks < 0) return;
    hipMemsetAsync((char*)d_ws + WS_CTL, 0, CTL_BYTES, stream);
    Params p{};
    for (int i = 0; i < 23; ++i) p.in[i] = (const float*)d_in[i];
    p.out = (float*)d_out; p.ws = (unsigned char*)d_ws;
    void* args[] = {&p};
    hipError_t e = hipLaunchCooperativeKernel((const void*)hymba_fwd, dim3(grid_blocks), dim3(NTHREADS), args, LDS_BYTES, stream);
    if (e != hipSuccess) fprintf(stderr, "cooperative launch failed: %s (grid %d)\n", hipGetErrorString(e), grid_blocks);
}
```

```cpp
#include <hip/hip_runtime.h>
#include <hip/hip_cooperative_groups.h>
#include <cstdio>
#include <cstdint>
namespace cg = cooperative_groups;
namespace pg8 {
#define PG8_LAS __attribute__((address_space(3)))
typedef unsigned short bf16_t;
typedef short bf16x8 __attribute__((ext_vector_type(8)));
typedef float f32x4 __attribute__((ext_vector_type(4)));
typedef unsigned u32x4 __attribute__((ext_vector_type(4)));
constexpr int BM = 256, BK = 64, HALF = 128, HTB = HALF * BK * 2  , STAGE_BYTES = 8 * HTB, NXCD = 8, WGM = 8;

__host__ __device__ __forceinline__ int lds_byte(int r, int c) { const int st = (r >> 4) * 2 + (c >> 5), rr = r & 15, cc = c & 31, ob = rr * 64 + cc * 2; return st * 1024 + (ob ^ (((ob >> 9) & 1) << 5)); }
__host__ __device__ __forceinline__ void stage_rc(int b, int& R, int& C) { const int st = b / 1024, sb = b % 1024, swz = sb ^ (((sb >> 9) & 1) << 5); R = (st >> 1) * 16 + swz / 64; C = (st & 1) * 32 + (swz % 64) / 2; }
__host__ __device__ __forceinline__ int perm32(int rho) { const int n = rho >> 4, i = rho & 15; return 8 * (i >> 2) + 4 * n + (i & 3); }

struct Unit { int pm, pn; };
struct Gemm { const bf16_t* A; const bf16_t* Bt; int M, N, K; };

struct StaticOrder {
    int nM, nN, nwg, G, c;
    __host__ __device__ void init(int M, int N, int G_, int c_) { nM = M / BM; nN = N / BM; nwg = nM * nN; G = G_; c = c_; }
    __host__ __device__ bool next(int i, Unit& u) const {
        const long L = (long)i * G + c; if (L >= nwg) return false;
        int wgid = (int)L; { const int q = nwg / NXCD, r = nwg % NXCD, xcd = wgid % NXCD, off = wgid / NXCD; wgid = (xcd < r ? xcd * (q + 1) : r * (q + 1) + (xcd - r) * q) + off; }
        const int nig = WGM * nN, gid = wgid / nig, fm = gid * WGM, gsz = (nM - fm) < WGM ? (nM - fm) : WGM;
        u.pm = fm + ((wgid % nig) % gsz); u.pn = (wgid % nig) / gsz; return true;
    }
    __device__ __forceinline__ void a_ready(const Unit&) const {}
    __device__ __forceinline__ void done(const Unit&) const {}
};

__device__ __forceinline__ unsigned cvt_pk_bf16(float lo, float hi) { unsigned r; asm volatile("v_cvt_pk_bf16_f32 %0, %1, %2" : "=v"(r) : "v"(lo), "v"(hi)); return r; }
typedef float f32x2 __attribute__((ext_vector_type(2)));
template <class Epi, class Sched, bool ALIGN_EPI = false, bool SP2 = false>
__device__ __forceinline__ void gemm_phase(PG8_LAS unsigned char* lds, const Gemm g, const Sched& S, const Epi& E) {
    int tid_o = threadIdx.x; asm volatile("" : "+v"(tid_o));
    const int tid = tid_o, wid = __builtin_amdgcn_readfirstlane(tid >> 6), lane = tid & 63, wr = wid >> 2, wc = wid & 3, fr = lane & 15, fq = lane >> 4;
    const int K = g.K, nt = K / BK;
    unsigned voffA[2], voffB[2];
#pragma unroll
    for (int i = 0; i < 2; ++i) { int R, C; stage_rc(tid * 16 + i * 8192, R, C); const int Rb = Epi::PERM ? ((R & ~31) + perm32(R & 31)) : R;
        voffA[i] = (unsigned)(R * K + C) * 2u; voffB[i] = (unsigned)(Rb * K + C) * 2u; }
    const size_t kstep = (size_t)(BK * 2);
    const size_t hstep = (size_t)HALF * K * 2;
    const size_t tstep = 2 * hstep;
    const unsigned ldsw = (unsigned)wid * 1024u;
    const int aoff = lds_byte(wr * 64 + fr, fq * 8), boff = lds_byte(wc * 32 + fr, fq * 8);
#define PG8_SA(b, h) (((b) * 2 + (h)) * HTB)
#define PG8_SB(b, h) ((4 + (b) * 2 + (h)) * HTB)
#define PG8_STAGE(bufoff, gbase, voff) do { _Pragma("unroll") for (int _i = 0; _i < 2; ++_i) \
        __builtin_amdgcn_global_load_lds((const unsigned*)((const char*)(gbase) + (voff)[_i]), (PG8_LAS unsigned*)(lds + (bufoff) + ldsw + _i * 8192), 16, 0, 0); } while (0)
#define PG8_LDA(dst, b, h) do { _Pragma("unroll") for (int m = 0; m < 4; ++m) _Pragma("unroll") for (int k = 0; k < 2; ++k) dst[m][k] = *(const PG8_LAS bf16x8*)(lds + PG8_SA(b, h) + aoff + m * 2048 + k * 1024); } while (0)
#define PG8_LDB(dst, b, h) do { _Pragma("unroll") for (int n = 0; n < 2; ++n) _Pragma("unroll") for (int k = 0; k < 2; ++k) dst[n][k] = *(const PG8_LAS bf16x8*)(lds + PG8_SB(b, h) + boff + n * 2048 + k * 1024); } while (0)
#define PG8_MMA(ai, bj, At, Bt) do { __builtin_amdgcn_s_setprio(1); _Pragma("unroll") for (int m = 0; m < 4; ++m) _Pragma("unroll") for (int n = 0; n < 2; ++n) _Pragma("unroll") for (int k = 0; k < 2; ++k) \
        acc[ai][bj][m][n] = __builtin_amdgcn_mfma_f32_16x16x32_bf16(Bt[n][k], At[m][k], acc[ai][bj][m][n], 0, 0, 0); __builtin_amdgcn_s_setprio(0); } while (0)
#define PG8_WAIT_V(n) asm volatile("s_waitcnt vmcnt(" #n ")" ::: "memory")
#define PG8_WAIT_L(n) asm volatile("s_waitcnt lgkmcnt(" #n ")" ::: "memory")
#define PG8_BAR __builtin_amdgcn_s_barrier()
#define PG8_SCHED __builtin_amdgcn_sched_barrier(0)
    Unit cur, nxt; int ui = 0;
    if (!S.next(0, cur)) return;
    f32x4 acc[2][2][4][2];
#pragma unroll
    for (int a = 0; a < 2; ++a)
#pragma unroll
        for (int b = 0; b < 2; ++b)
#pragma unroll
            for (int m = 0; m < 4; ++m)
#pragma unroll
                for (int n = 0; n < 2; ++n) acc[a][b][m][n] = (f32x4){0.f, 0.f, 0.f, 0.f};
    bf16x8 At[4][2], B0[2][2], B1[2][2];
    const char* cA = (const char*)g.A + (size_t)cur.pm * tstep; const char* cB = (const char*)g.Bt + (size_t)cur.pn * tstep;
    S.a_ready(cur);
    if constexpr (SP2) {
        PG8_STAGE(PG8_SB(0, 0), cB, voffB); PG8_STAGE(PG8_SB(0, 1), cB + hstep, voffB); PG8_STAGE(PG8_SA(0, 0), cA, voffA); PG8_STAGE(PG8_SA(0, 1), cA + hstep, voffA);
        if (wr == 1) PG8_BAR;
        PG8_WAIT_V(2); PG8_BAR;
        PG8_STAGE(PG8_SB(1, 0), cB + kstep, voffB); PG8_STAGE(PG8_SA(1, 0), cA + kstep, voffA); PG8_STAGE(PG8_SB(1, 1), cB + hstep + kstep, voffB);
        PG8_WAIT_V(6); PG8_BAR;
    } else {
        PG8_STAGE(PG8_SB(0, 0), cB, voffB); PG8_STAGE(PG8_SA(0, 0), cA, voffA); PG8_STAGE(PG8_SB(0, 1), cB + hstep, voffB); PG8_STAGE(PG8_SA(0, 1), cA + hstep, voffA);
        if (wr == 1) PG8_BAR;
        PG8_WAIT_V(4); PG8_BAR;
        PG8_STAGE(PG8_SB(1, 0), cB + kstep, voffB); PG8_STAGE(PG8_SA(1, 0), cA + kstep, voffA); PG8_STAGE(PG8_SB(1, 1), cB + hstep + kstep, voffB);
        PG8_WAIT_V(6); PG8_BAR;
    }
    for (;;) {
        const bool has_next = S.next(ui + 1, nxt);
        const char* nA = has_next ? (const char*)g.A + (size_t)nxt.pm * tstep : cA; const char* nB = has_next ? (const char*)g.Bt + (size_t)nxt.pn * tstep : cB;
        for (int t = 0; t < nt; t += 2) {
            const bool last = (t == nt - 2);
            const char* a1 = cA + (size_t)(t + 1) * kstep;
            const char* a2 = last ? nA : cA + (size_t)(t + 2) * kstep; const char* b2 = last ? nB : cB + (size_t)(t + 2) * kstep;
            const char* a3 = a2 + kstep; const char* b3 = b2 + kstep;
            if (last && has_next) S.a_ready(nxt);
            if constexpr (SP2) {
            PG8_LDB(B0, 0, 0); PG8_LDB(B1, 0, 1); PG8_SCHED; PG8_LDA(At, 0, 0); PG8_STAGE(PG8_SA(1, 1), a1 + hstep, voffA);
            PG8_WAIT_V(8); PG8_WAIT_L(0); PG8_BAR; PG8_MMA(0, 0, At, B0); PG8_MMA(0, 1, At, B1); PG8_BAR; PG8_SCHED;
            PG8_LDA(At, 0, 1); PG8_STAGE(PG8_SB(0, 0), b2, voffB); PG8_STAGE(PG8_SB(0, 1), b2 + hstep, voffB); PG8_STAGE(PG8_SA(0, 0), a2, voffA);
            PG8_WAIT_V(8); PG8_WAIT_L(0); PG8_BAR; PG8_MMA(1, 0, At, B0); PG8_MMA(1, 1, At, B1); PG8_BAR; PG8_SCHED;
            PG8_LDB(B0, 1, 0); PG8_LDB(B1, 1, 1); PG8_SCHED; PG8_LDA(At, 1, 0); PG8_STAGE(PG8_SA(0, 1), a2 + hstep, voffA);
            PG8_WAIT_V(8); PG8_WAIT_L(0); PG8_BAR; PG8_MMA(0, 0, At, B0); PG8_MMA(0, 1, At, B1); PG8_BAR; PG8_SCHED;
            PG8_LDA(At, 1, 1); PG8_STAGE(PG8_SB(1, 0), b3, voffB); PG8_STAGE(PG8_SB(1, 1), b3 + hstep, voffB); PG8_STAGE(PG8_SA(1, 0), a3, voffA);
            PG8_WAIT_V(8); PG8_WAIT_L(0); PG8_BAR; PG8_MMA(1, 0, At, B0); PG8_MMA(1, 1, At, B1); PG8_BAR; PG8_SCHED;
            } else {
            PG8_LDB(B0, 0, 0); PG8_SCHED; PG8_LDA(At, 0, 0); PG8_STAGE(PG8_SA(1, 1), a1 + hstep, voffA);
            PG8_WAIT_L(8); PG8_BAR; PG8_WAIT_L(0); PG8_MMA(0, 0, At, B0); PG8_BAR; PG8_SCHED;
            PG8_LDB(B1, 0, 1); PG8_STAGE(PG8_SB(0, 0), b2, voffB);
            PG8_BAR; PG8_WAIT_L(0); PG8_MMA(0, 1, At, B1); PG8_BAR;
            PG8_LDA(At, 0, 1); PG8_STAGE(PG8_SA(0, 0), a2, voffA);
            PG8_BAR; PG8_WAIT_L(0); PG8_MMA(1, 0, At, B0); PG8_BAR; PG8_SCHED;
            PG8_STAGE(PG8_SB(0, 1), b2 + hstep, voffB);
            PG8_WAIT_V(6); PG8_BAR; PG8_MMA(1, 1, At, B1); PG8_BAR;
            PG8_LDB(B0, 1, 0); PG8_SCHED; PG8_LDA(At, 1, 0); PG8_STAGE(PG8_SA(0, 1), a2 + hstep, voffA);
            PG8_WAIT_L(8); PG8_BAR; PG8_WAIT_L(0); PG8_MMA(0, 0, At, B0); PG8_BAR; PG8_SCHED;
            PG8_LDB(B1, 1, 1); PG8_STAGE(PG8_SB(1, 0), b3, voffB);
            PG8_BAR; PG8_WAIT_L(0); PG8_MMA(0, 1, At, B1); PG8_BAR;
            PG8_LDA(At, 1, 1); PG8_STAGE(PG8_SA(1, 0), a3, voffA);
            PG8_BAR; PG8_WAIT_L(0); PG8_MMA(1, 0, At, B0); PG8_BAR; PG8_SCHED;
            PG8_STAGE(PG8_SB(1, 1), b3 + hstep, voffB);
            PG8_WAIT_V(6); PG8_BAR; PG8_MMA(1, 1, At, B1); PG8_BAR;
            }
        }
        if constexpr (ALIGN_EPI) { if (wr == 0) PG8_BAR; }
        if constexpr (!Epi::AFTER_DRAIN) { E(acc, cur, wr, wc, fr, fq); S.done(cur); }
        if (!has_next) break;
#pragma unroll
        for (int a = 0; a < 2; ++a)
#pragma unroll
            for (int b = 0; b < 2; ++b)
#pragma unroll
                for (int m = 0; m < 4; ++m)
#pragma unroll
                    for (int n = 0; n < 2; ++n) acc[a][b][m][n] = (f32x4){0.f, 0.f, 0.f, 0.f};
        cur = nxt; cA = nA; cB = nB; ++ui;
        if constexpr (ALIGN_EPI) { if (wr == 1) PG8_BAR; }
    }
    PG8_WAIT_V(0);
    if constexpr (!ALIGN_EPI) { if (wr == 0) PG8_BAR; }
    PG8_BAR;
    if constexpr (Epi::AFTER_DRAIN) { E.fused(acc, cur, wr, wc, fr, fq, lds, wid, lane); S.done(cur); }
#undef PG8_SA
#undef PG8_SB
#undef PG8_STAGE
#undef PG8_LDA
#undef PG8_LDB
#undef PG8_MMA
#undef PG8_WAIT_V
#undef PG8_WAIT_L
#undef PG8_BAR
#undef PG8_SCHED
}
}

#define DI __device__ __forceinline__
#define LAS __attribute__((address_space(3)))
typedef unsigned short bf16_t;
typedef short bf16x8 __attribute__((ext_vector_type(8)));
typedef short s16x4 __attribute__((ext_vector_type(4)));
typedef short v4i16_t __attribute__((ext_vector_type(4)));
typedef float f32x4 __attribute__((ext_vector_type(4)));
typedef float f32x16 __attribute__((ext_vector_type(16)));
typedef unsigned u32x4 __attribute__((ext_vector_type(4)));
typedef unsigned u32x2 __attribute__((ext_vector_type(2)));
typedef float f32x2_t __attribute__((ext_vector_type(2)));
typedef __bf16 bf16x2_t __attribute__((ext_vector_type(2)));

constexpr int NWAVES = 8, NTHREADS = 512;
constexpr int SEQ = 8192, DMODEL = 1024, NMETA = 16, LTOK = SEQ + NMETA  , LP = 8256  , NCHUNK = 129;
constexpr int MTOK = 2 * SEQ;
constexpr int MROWS = 16640;
constexpr int NPROJ = 3840;
constexpr int NKT = 129;
constexpr float EPS = 1e-6f;
constexpr float C2Q = 0.125f * 1.4426950408889634f;
constexpr int XS_ROWS = 41216;

constexpr size_t MiB = 1u << 20;
constexpr size_t WS_CTL = 0, CTL_BYTES = 1 * MiB;
constexpr size_t WS_RS1 = 1 * MiB;
constexpr size_t WS_RS2 = WS_RS1 + 128 * 1024;
constexpr size_t WS_TOKE = WS_RS2 + 128 * 1024;
constexpr size_t WS_TOKW = WS_TOKE + 128 * 1024;
constexpr size_t WS_TOKP = WS_TOKW + 128 * 1024;
constexpr size_t WS_SLOTW = WS_TOKP + 128 * 1024;
constexpr size_t WS_WR = WS_SLOTW + 192 * 1024;
constexpr size_t WS_GL = WS_WR + 160 * 1024;
constexpr size_t WS_COS = 2 * MiB;
constexpr size_t WS_SIN = WS_COS + 1280 * 1024;
constexpr size_t WS_GB = WS_SIN + 1280 * 1024;
constexpr size_t WS_WOUT = 6 * MiB;
constexpr size_t WS_WINT = 8 * MiB;
constexpr size_t WS_XB = WS_WINT + (size_t)NPROJ * 1024 * 2;
constexpr size_t WS_MIX = 8 * MiB;
constexpr size_t WS_QKVB = 48 * MiB;
constexpr size_t WS_QB = WS_QKVB + (size_t)2 * LP * 1536 * 2 + 128 * 1024;
constexpr size_t WS_KT = WS_QB + 16 * MiB;
constexpr size_t WS_VT = WS_KT + (size_t)16 * NKT * 4096 * 2;
constexpr size_t WS_ZB = WS_VT + (size_t)8 * NKT * 8192 * 2;
constexpr size_t WS_GP = WS_ZB + (size_t)2 * LP * 512 * 2;
constexpr size_t GP_ARR = (size_t)2064 * 4096 * 2;
constexpr size_t WS_GP_END = WS_GP + 5 * GP_ARR;
constexpr size_t WS_WGU = 48 * MiB;
constexpr size_t WS_WD = 80 * MiB;
constexpr size_t WS_XS = 96 * MiB;
constexpr size_t WS_YO = 96 * MiB;
constexpr size_t WS_YS = WS_XS + (size_t)XS_ROWS * 1024 * 2;
constexpr size_t WS_END = 256 * MiB;
static_assert(WS_GB + (size_t)2 * LP * 16 * 4 <= WS_WOUT, "small region");
static_assert(WS_XB + (size_t)MROWS * 1024 * 2 <= WS_QKVB, "XB");
static_assert(WS_GP_END <= WS_END, "GDN prep arrays");
static_assert(WS_YS + (size_t)XS_ROWS * 256 * 2 <= WS_END, "YS");
static_assert(WS_WD + (size_t)32 * 1024 * 256 * 2 <= WS_XS, "WD");
constexpr int CW_ATTQ = 0;
constexpr int CW_CNT = 64;
constexpr int CW_BAR = 4096;

constexpr int LDS_BYTES = 147456;

struct Params { const float* in[23]; float* out; unsigned char* ws; };

DI unsigned f2bf(float f) { unsigned u = __float_as_uint(f); return (u + 0x7fffu + ((u >> 16) & 1u)) >> 16; }
DI unsigned pk2(float lo, float hi) { f32x2_t v = {lo, hi}; bf16x2_t b = __builtin_convertvector(v, bf16x2_t); return __builtin_bit_cast(unsigned, b); }
DI float bf2f(unsigned short h) { return __uint_as_float(((unsigned)h) << 16); }
DI float rlane(float v, int l) { return __int_as_float(__builtin_amdgcn_readlane(__float_as_int(v), l)); }
#define DPP_ADD(v, ctrl) ((v) + __int_as_float(__builtin_amdgcn_update_dpp(0, __float_as_int(v), (ctrl), 0xF, 0xF, true)))
DI float wave_sum_dpp(float v) {
    v = DPP_ADD(v, 0xB1);
    v = DPP_ADD(v, 0x4E);
    v = DPP_ADD(v, 0x141);
    v = DPP_ADD(v, 0x140);
    return (rlane(v, 0) + rlane(v, 16)) + (rlane(v, 32) + rlane(v, 48));
}
DI float wave_sum(float v) { return wave_sum_dpp(v); }
DI float swz_xor16(float v) { return __int_as_float(__builtin_amdgcn_ds_swizzle(__float_as_int(v), 0x401F)); }
DI float row_sum16(float v) { v = DPP_ADD(v, 0xB1); v = DPP_ADD(v, 0x4E); v = DPP_ADD(v, 0x141); v = DPP_ADD(v, 0x140); return v; }
DI float half_sum32(float v) { v = row_sum16(v); return v + swz_xor16(v); }
DI float swap32_add(float v) { auto rr = __builtin_amdgcn_permlane32_swap(__float_as_uint(v), __float_as_uint(v), false, false); return __uint_as_float(rr[0]) + __uint_as_float(rr[1]); }
DI float swap32_max(float v) { auto rr = __builtin_amdgcn_permlane32_swap(__float_as_uint(v), __float_as_uint(v), false, false); return fmaxf(__uint_as_float(rr[0]), __uint_as_float(rr[1])); }
#define LDS_WAIT() asm volatile("s_waitcnt lgkmcnt(0)" ::: "memory")
#define BAR_LDS() do { asm volatile("s_waitcnt lgkmcnt(0)" ::: "memory"); __builtin_amdgcn_s_barrier(); asm volatile("" ::: "memory"); } while (0)
#define MFMA32(a, b, c) __builtin_amdgcn_mfma_f32_32x32x16_bf16((a), (b), (c), 0, 0, 0)
DI int crow(int r, int hi) { return (r & 3) + 8 * (r >> 2) + 4 * hi; }
DI int perm16(int x) { return (x & ~12) | ((x & 4) << 1) | ((x & 8) >> 1); }
DI bf16x8 pack8(const f32x16& x, int s) {
    u32x4 p; p.x = pk2(x[8 * s], x[8 * s + 1]); p.y = pk2(x[8 * s + 2], x[8 * s + 3]); p.z = pk2(x[8 * s + 4], x[8 * s + 5]); p.w = pk2(x[8 * s + 6], x[8 * s + 7]);
    return __builtin_bit_cast(bf16x8, p);
}
DI int orig_col(int n) {
    if (n >= 1024) return n;
    const int hh = n >> 6, c2 = n & 63, g8 = c2 >> 3, i = c2 & 7;
    return (hh << 6) + ((i < 4) ? 4 * g8 + i : 32 + 4 * g8 + (i - 4));
}
DI size_t kt_off(int b, int hh, int p, int d) {
    const int tile = p < 16 ? 0 : 1 + ((p - 16) >> 6), kv = p < 16 ? p : ((p - 16) & 63);
    return ((size_t)((b * 8 + hh) * NKT + tile) << 12) + ((d >> 3) << 9) + (kv << 3) + (d & 7);
}
DI size_t vt_off(int b, int h, int p, int d) {
    const int tile = p < 16 ? 0 : 1 + ((p - 16) >> 6), kv = p < 16 ? p : ((p - 16) & 63);
    return ((size_t)((b * 4 + h) * NKT + tile) << 13) + ((d >> 5) << 11) + ((kv >> 4) << 9) + ((kv & 15) << 5) + (d & 31);
}

template <class Src> DI void transpose_item(const Src& src, bf16_t* WT, size_t ldk, int k0, int n0, LAS float* scr, int lane) {
    float v[32];
#pragma unroll
    for (int i = 0; i < 32; ++i) v[i] = src(k0 + 2 * i + (lane >> 5), n0 + (lane & 31));
#pragma unroll
    for (int i = 0; i < 32; ++i) scr[(2 * i + (lane >> 5)) * 33 + (lane & 31)] = v[i];
    LDS_WAIT();
    const int c = lane & 7;
#pragma unroll
    for (int j = 0; j < 4; ++j) { const int n = (lane >> 3) + 8 * j; const LAS float* s = scr + (8 * c) * 33 + n;
        u32x4 o; o.x = pk2(s[0 * 33], s[1 * 33]); o.y = pk2(s[2 * 33], s[3 * 33]); o.z = pk2(s[4 * 33], s[5 * 33]); o.w = pk2(s[6 * 33], s[7 * 33]);
        *(u32x4*)(WT + (size_t)(n0 + n) * ldk + k0 + 8 * c) = o; }
    LDS_WAIT();
}
struct SrcWin { const float* w; const float* g; DI float operator()(int k, int n) const { return n >= 3600 ? 0.f : w[(size_t)k * 3600 + orig_col(n)] * g[k]; } };
struct SrcPlain { const float* w; int N; DI float operator()(int k, int n) const { return w[(size_t)k * N + n]; } };
struct SrcGU { const float* w; const float* g; int fadj; DI float operator()(int k, int n) const { return w[(size_t)k * 256 + n + fadj] * g[k]; } };

DI void phase0(const Params& P, LAS unsigned char* lds, int gw, int NGW, int gtid, int NGT, int wave, int lane) {
    LAS float* scr = (LAS float*)(lds + wave * 16384);
    bf16_t* WINT = (bf16_t*)(P.ws + WS_WINT); bf16_t* WOUT = (bf16_t*)(P.ws + WS_WOUT); bf16_t* XB = (bf16_t*)(P.ws + WS_XB);
    float* RS1 = (float*)(P.ws + WS_RS1);
    constexpr int I_IN = 16 * (NPROJ / 32), I_OUT = 16 * 32;
    const SrcWin sw{P.in[3], P.in[2]}; const SrcPlain so{P.in[13], 1024};
    for (int it = gw; it < I_IN + I_OUT; it += NGW) {
        if (it < I_IN) transpose_item(sw, WINT, 1024, (it / (NPROJ / 32)) * 64, (it % (NPROJ / 32)) * 32, scr, lane);
        else { const int r = it - I_IN; transpose_item(so, WOUT, 1024, (r >> 5) * 64, (r & 31) * 32, scr, lane); }
    }
    const float* x = P.in[0]; const float* meta = P.in[1];
    for (int m0 = gw; m0 < MROWS; m0 += 4 * NGW) {
        f32x4 v[4][4];
#pragma unroll
        for (int r = 0; r < 4; ++r) { const int m = m0 + r * NGW;
            const bool real = m < MTOK + NMETA;
            const f32x4* xr = (const f32x4*)((m < MTOK) ? x + (size_t)m * 1024 : meta + (size_t)((real ? m : MTOK) - MTOK) * 1024);
#pragma unroll
            for (int j = 0; j < 4; ++j) v[r][j] = (m < MROWS) ? xr[64 * j + lane] : (f32x4){0.f, 0.f, 0.f, 0.f}; }
#pragma unroll
        for (int r = 0; r < 4; ++r) { const int m = m0 + r * NGW;
            if (m < MROWS) {
                const bool real = m < MTOK + NMETA;
                float s = 0.f;
#pragma unroll
                for (int j = 0; j < 4; ++j) { if (!real) v[r][j] = (f32x4){0.f, 0.f, 0.f, 0.f}; s += (v[r][j].x * v[r][j].x + v[r][j].y * v[r][j].y) + (v[r][j].z * v[r][j].z + v[r][j].w * v[r][j].w); }
                s = wave_sum(s);
                if (lane == 0) RS1[m] = real ? __builtin_amdgcn_rsqf(s * (1.0f / 1024.0f) + EPS) : 0.f;
                u32x2* orow = (u32x2*)(XB + (size_t)m * 1024);
#pragma unroll
                for (int j = 0; j < 4; ++j) orow[64 * j + lane] = (u32x2){pk2(v[r][j].x, v[r][j].y), pk2(v[r][j].z, v[r][j].w)};
            } }
    }
    float* COS = (float*)(P.ws + WS_COS); float* SIN = (float*)(P.ws + WS_SIN);
    for (int i = gtid; i < LTOK * 32; i += NGT) {
        const int p = i >> 5, f = i & 31;
        const double rev = (double)p * exp2(-(double)f * (13.287712379549449 / 32.0)) * 0.15915494309189535;
        const float fr = (float)(rev - floor(rev));
        COS[i] = __builtin_amdgcn_cosf(fr); SIN[i] = __builtin_amdgcn_sinf(fr);
    }
    float* WR = (float*)(P.ws + WS_WR); const float* gf = P.in[14]; const float* wgrp = P.in[15]; const float* wrt = P.in[17];
    for (int i = gtid; i < 36 * 1024; i += NGT) { const int j = i >> 10, k = i & 1023; WR[i] = gf[k] * (j < 4 ? wgrp[k * 4 + j] : wrt[k * 32 + (j - 4)]); }
}

struct EpiInProj {
    static constexpr bool PERM = true, AFTER_DRAIN = false;
    const float* RS1; const float* COS; const float* SIN; const float* a_log; const float* dt_bias;
    bf16_t* QB; bf16_t* KT; bf16_t* VT; bf16_t* QKVB; bf16_t* ZB; float* GB;
    DI void operator()(const pg8::f32x4 (&acc)[2][2][4][2], const pg8::Unit& u, int wr, int wc, int fr, int fq) const {
        const int pn = u.pn;
#pragma unroll
        for (int ai = 0; ai < 2; ++ai)
#pragma unroll
            for (int m = 0; m < 4; ++m) {
                const int row = u.pm * 256 + ai * 128 + wr * 64 + m * 16 + fr;
                if (row < MTOK + NMETA) {
                    const float rs = RS1[row];
                    const bool meta = row >= MTOK;
                    const int p = meta ? row - MTOK : (row & 8191) + NMETA;
                    const int b0 = meta ? 0 : (row >> 13), nb = meta ? 2 : 1;
#pragma unroll
                    for (int bj = 0; bj < 2; ++bj) {
                        float xv[8];
#pragma unroll
                        for (int i = 0; i < 4; ++i) { xv[i] = acc[ai][bj][m][0][i] * rs; xv[4 + i] = acc[ai][bj][m][1][i] * rs; }
                        if (pn < 4) {
                            const int hh = (pn & 1) * 4 + bj * 2 + (wc >> 1), d0 = 4 * (4 * (wc & 1) + fq);
                            const f32x4 cs = *(const f32x4*)(COS + p * 32 + d0), sn = *(const f32x4*)(SIN + p * 32 + d0);
                            float lo[4], hi[4];
#pragma unroll
                            for (int i = 0; i < 4; ++i) { lo[i] = xv[i] * cs[i] - xv[4 + i] * sn[i]; hi[i] = xv[4 + i] * cs[i] + xv[i] * sn[i]; }
                            if (pn < 2) {
                                if (!meta) {
                                    bf16_t* q = QB + ((size_t)((b0 * 8 + hh) * SEQ + (p - NMETA)) << 6) + d0;
                                    *(u32x2*)q = (u32x2){pk2(lo[0] * C2Q, lo[1] * C2Q), pk2(lo[2] * C2Q, lo[3] * C2Q)};
                                    *(u32x2*)(q + 32) = (u32x2){pk2(hi[0] * C2Q, hi[1] * C2Q), pk2(hi[2] * C2Q, hi[3] * C2Q)};
                                }
                            } else {
                                for (int bb = b0; bb < b0 + nb; ++bb) {
                                    *(u32x2*)(KT + kt_off(bb, hh, p, d0)) = (u32x2){pk2(lo[0], lo[1]), pk2(lo[2], lo[3])};
                                    *(u32x2*)(KT + kt_off(bb, hh, p, d0 + 32)) = (u32x2){pk2(hi[0], hi[1]), pk2(hi[2], hi[3])};
                                }
                            }
                        } else {
                            const u32x4 w = (u32x4){pk2(xv[0], xv[1]), pk2(xv[2], xv[3]), pk2(xv[4], xv[5]), pk2(xv[6], xv[7])};
                            const int cl = bj * 128 + wc * 32 + fq * 8;
                            if (pn < 6) {
                                const int h = (pn - 4) * 2 + bj, d = wc * 32 + fq * 8;
                                for (int bb = b0; bb < b0 + nb; ++bb) *(u32x4*)(VT + vt_off(bb, h, p, d)) = w;
                            } else if (pn < 12) {
                                for (int bb = b0; bb < b0 + nb; ++bb) *(u32x4*)(QKVB + (size_t)(bb * LP + p) * 1536 + (pn - 6) * 256 + cl) = w;
                            } else if (pn < 14) {
                                float sz[8];
#pragma unroll
                                for (int i = 0; i < 8; ++i) sz[i] = xv[i] * __builtin_amdgcn_rcpf(1.0f + __expf(-xv[i]));
                                const u32x4 wz = (u32x4){pk2(sz[0], sz[1]), pk2(sz[2], sz[3]), pk2(sz[4], sz[5]), pk2(sz[6], sz[7])};
                                for (int bb = b0; bb < b0 + nb; ++bb) *(u32x4*)(ZB + (size_t)(bb * LP + p) * 512 + (pn - 12) * 256 + cl) = wz;
                            } else if (cl < 16) {
                                float o[8];
                                if (cl == 0) {
#pragma unroll
                                    for (int i = 0; i < 8; ++i) { const float t = xv[i] + dt_bias[i]; const float sp = t > 20.f ? t : log1pf(expf(t)); o[i] = -expf(a_log[i]) * sp; }
                                } else {
#pragma unroll
                                    for (int i = 0; i < 8; ++i) o[i] = 1.0f / (1.0f + expf(-xv[i]));
                                }
                                for (int bb = b0; bb < b0 + nb; ++bb) { float* g = GB + ((size_t)(bb * LP + p) << 4) + cl;
                                    *(f32x4*)g = (f32x4){o[0], o[1], o[2], o[3]}; *(f32x4*)(g + 4) = (f32x4){o[4], o[5], o[6], o[7]}; }
                            }
                        }
                    }
                }
            }
    }
};

DI bf16x8 lds_frag(LAS const bf16_t* M, int row, int ch) { return *(LAS const bf16x8*)((LAS const unsigned char*)M + row * 128 + ((ch ^ (row & 7)) << 4)); }
DI bf16x8 lds_frag_plain(LAS const bf16_t* M, int row, int ch) { return *(LAS const bf16x8*)((LAS const unsigned char*)M + row * 128 + (ch << 4)); }
DI int swz_idx(int row, int d) { return row * 64 + ((((d >> 3) ^ (row & 7)) << 3) | (d & 7)); }

constexpr int PREP_PAIR = 35840;

template <int MAT> DI void prep_rows(const bf16_t* QKVB, const float* cw, int b, int h, int n, int lane, LAS const float* egS,
                                     LAS bf16_t* DS  , bf16_t* QG) {
    const int colb = MAT * 512 + h * 64, col = colb + lane, p0 = n * 64;
    const float c0 = cw[col], c1 = cw[1536 + col], c2 = cw[3072 + col], c3 = cw[4608 + col];
    const bf16_t* blk = QKVB + (size_t)(b * LP + p0) * 1536 + colb;
    float x0 = 0.f, x1 = 0.f, x2 = 0.f;
    if (n > 0) { x0 = bf2f(blk[lane - 3 * 1536]); x1 = bf2f(blk[lane - 2 * 1536]); x2 = bf2f(blk[lane - 1 * 1536]); }
    u32x4 stg[8];
#pragma unroll
    for (int i = 0; i < 8; ++i) stg[i] = *(const u32x4*)(blk + (size_t)(8 * i + (lane >> 3)) * 1536 + (lane & 7) * 8);
#pragma unroll
    for (int i = 0; i < 8; ++i) *(LAS u32x4*)(DS + (8 * i + (lane >> 3)) * 64 + (lane & 7) * 8) = stg[i];
    LDS_WAIT();
    const int nvalid = (LTOK - p0) < 64 ? (LTOK - p0) : 64;
#pragma unroll 4
    for (int c = 0; c < 64; ++c) {
        if (c >= nvalid) { DS[c * 64 + lane] = 0; if (MAT == 0) QG[c * 64 + perm16(lane)] = 0; continue; }
        const bool valid = true;
        const float x3 = bf2f(DS[c * 64 + lane]);
        float y = c0 * x0 + c1 * x1 + c2 * x2 + c3 * x3;
        y = y * __builtin_amdgcn_rcpf(1.0f + __expf(-y));
        if (!valid) y = 0.f;
        x0 = x1; x1 = x2; x2 = x3;
        if (MAT == 2) { DS[c * 64 + lane] = (bf16_t)f2bf(y); }
        else {
            const float ss = wave_sum(y * y);
            const float yn = y * __builtin_amdgcn_rsqf(ss + EPS);
            if (MAT == 0) {
                const float qn = yn * 0.125f;
                DS[c * 64 + lane] = (bf16_t)f2bf(qn);
                QG[c * 64 + perm16(lane)] = (bf16_t)f2bf(qn * egS[c]);
            } else {
                DS[c * 64 + lane] = (bf16_t)f2bf(yn);
            }
        }
    }
}

DI void solve_blocked(LAS const float* AST, LAS bf16_t* XB, LAS const float* scl, int lane, float sgn, bf16_t* out, int ocol, int nvalid) {
    for (int b = 0; b < 4; ++b) {
        if (16 * b >= nvalid) {
#pragma unroll
            for (int r = 0; r < 16; ++r) out[(16 * b + r) * 64 + ocol] = 0;
            continue;
        }
        float s[16];
#pragma unroll
        for (int r = 0; r < 16; ++r) s[r] = bf2f(XB[(16 * b + r) * 64 + lane]) * scl[16 * b + r];
        for (int j = 0; j < 16 * b; ++j) {
            const float xj = bf2f(XB[j * 64 + lane]);
            LAS const f32x4* ap = (LAS const f32x4*)(AST + j * 68 + 16 * b);
            const f32x4 a0 = ap[0], a1 = ap[1], a2 = ap[2], a3 = ap[3];
#pragma unroll
            for (int r = 0; r < 4; ++r) { s[r] -= a0[r] * xj; s[4 + r] -= a1[r] * xj; s[8 + r] -= a2[r] * xj; s[12 + r] -= a3[r] * xj; }
        }
#pragma unroll
        for (int jj = 0; jj < 15; ++jj) {
            const float xj = s[jj];
            LAS const float* ap = AST + (16 * b + jj) * 68 + 16 * b;
#pragma unroll
            for (int r = jj + 1; r < 16; ++r) s[r] -= ap[r] * xj;
        }
#pragma unroll
        for (int r = 0; r < 16; ++r) { XB[(16 * b + r) * 64 + lane] = (bf16_t)f2bf(s[r]); out[(16 * b + r) * 64 + ocol] = (bf16_t)f2bf(sgn * s[r]); }
    }
}

DI void gdn_prep_phase(const Params& P, LAS unsigned char* lds, int blk, int G, int wave, int lane_in) {
    const int pair = wave >> 1, role = wave & 1;
    LAS unsigned char* pb = lds + pair * PREP_PAIR;
    LAS bf16_t* QS = (LAS bf16_t*)pb; LAS bf16_t* KS = (LAS bf16_t*)(pb + 8192); LAS float* AS = (LAS float*)(pb + 16384);
    LAS float* gcS = (LAS float*)(pb + 16384 + 17408 + role * 1024); LAS float* betaS = gcS + 64; LAS float* egS = gcS + 128; LAS float* ekS = gcS + 192;
    const bf16_t* QKVB = (const bf16_t*)(P.ws + WS_QKVB); const float* GB = (const float*)(P.ws + WS_GB); const float* cw = P.in[9];
    const int NP = G * 4, NTASK = 2 * 8 * NCHUNK;
    for (int it = 0; it * NP < NTASK; ++it) {
        int lane = lane_in; asm volatile("" : "+v"(lane));
        const int r32 = lane & 31, hi = lane >> 5;
        const int task = it * NP + blk * 4 + pair;
        const bool active = task < NTASK;
        const int bh = task < 2048 ? (task >> 7) : (task - 2048), n = task < 2048 ? (task & 127) : 128, b = bh >> 3, h = bh & 7;
        const int sidx = bh * NCHUNK + n;
        bf16_t* GPW = (bf16_t*)(P.ws + WS_GP) + (size_t)sidx * 4096; bf16_t* GPQG = GPW + GP_ARR / 2; bf16_t* GPAQK = GPQG + GP_ARR / 2; bf16_t* GPKGT = GPAQK + GP_ARR / 2; bf16_t* GPU = GPKGT + GP_ARR / 2;
        float gc = 0.f, beta = 0.f;
        if (active) {
            const int pl = n * 64 + lane;
            float g = 0.f;
            if (pl < LTOK) { const float* gb = GB + ((size_t)(b * LP + pl) << 4); g = gb[h]; beta = gb[8 + h]; }
            gcS[lane] = g; LDS_WAIT();
            gc = 0.f;
#pragma unroll
            for (int j4 = 0; j4 < 16; ++j4) { const f32x4 t = *(LAS const f32x4*)(gcS + 4 * j4);
                gc += (4 * j4 <= lane ? t[0] : 0.f) + (4 * j4 + 1 <= lane ? t[1] : 0.f) + (4 * j4 + 2 <= lane ? t[2] : 0.f) + (4 * j4 + 3 <= lane ? t[3] : 0.f); }
            const float glast = rlane(gc, 63);
            LDS_WAIT();
            gcS[lane] = gc; betaS[lane] = beta; egS[lane] = (role == 0) ? __expf(gc) : beta * __expf(gc); ekS[lane] = __expf(glast - gc);
            if (role == 0 && lane == 0) ((float*)(P.ws + WS_GL))[sidx] = __expf(glast);
            LDS_WAIT();
            if (role == 0) prep_rows<0>(QKVB, cw, b, h, n, lane, egS, QS, GPQG);
            else prep_rows<1>(QKVB, cw, b, h, n, lane, egS, KS, GPQG);
        }
        LDS_WAIT();
        __syncthreads();
        if (active) {
#pragma unroll
            for (int t4 = 0; t4 < 4; ++t4) {
                const int ct = t4 >> 1, st = t4 & 1;
                f32x16 acc = {};
                if (!(ct == 0 && st == 1)) {
#pragma unroll
                    for (int ks = 0; ks < 4; ++ks) {
                        const bf16x8 fa = lds_frag_plain(role == 0 ? QS : KS, 32 * ct + r32, 2 * ks + hi), fb = lds_frag_plain(KS, 32 * st + r32, 2 * ks + hi);
                        acc = MFMA32(fa, fb, acc);
                    }
                }
                const float gcs = gcS[32 * st + r32];
                bf16_t* aqb = GPAQK + hi * 256 + perm16(r32); LAS float* asb = AS + r32 * 68 + hi * 4;        LAS const float* gcb = gcS + hi * 4; LAS const float* beb = betaS + hi * 4;
                asm volatile("" : "+v"(aqb), "+v"(asb), "+v"(gcb), "+v"(beb));
#pragma unroll
                for (int i = 0; i < 16; ++i) {
                    const int cr = 32 * ct + (i & 3) + 8 * (i >> 2);
                    const int cmp = (32 * st + r32) - 4 * hi;
                    const float dec = __expf(gcb[cr] - gcs);
                    if (role == 0) aqb[cr * 64 + 32 * st] = (bf16_t)f2bf((cmp <= cr) ? acc[i] * dec : 0.f);
                    else asb[32 * st * 68 + cr] = (cmp < cr) ? acc[i] * beb[cr] * dec : 0.f;
                }
            }
        }
        LDS_WAIT();
        __syncthreads();
        if (active) {
            if (role == 0) {
                prep_rows<2>(QKVB, cw, b, h, n, lane, egS, QS  , GPQG);
                LDS_WAIT();
                solve_blocked(AS, QS, betaS, lane, 1.0f, GPU, lane, (LTOK - n * 64) < 64 ? (LTOK - n * 64) : 64);
            } else {
#pragma unroll
                for (int gq = 0; gq < 8; ++gq) {
                    float t[8];
#pragma unroll
                    for (int j = 0; j < 8; ++j) { const int c = perm16(8 * gq + j); t[j] = bf2f(KS[c * 64 + lane]) * ekS[c]; }
                    *(u32x4*)(GPKGT + lane * 64 + 8 * gq) = (u32x4){pk2(t[0], t[1]), pk2(t[2], t[3]), pk2(t[4], t[5]), pk2(t[6], t[7])};
                }
                solve_blocked(AS, KS, egS, lane, -1.0f, GPW, perm16(lane), (LTOK - n * 64) < 64 ? (LTOK - n * 64) : 64);
            }
        }
        LDS_WAIT();
    }
}

constexpr int GS_STAGE = 40960 + 256;
constexpr int GS_OBUF = 2 * GS_STAGE;
static_assert(GS_OBUF + 32768 <= 131072, "gdn scan LDS");

#define GS_STEP(n, HW, HGW, STGW) do { \
        if (wave < 2) { \
            if (n < NCHUNK) { \
                LAS const unsigned char* sg = lds + (n & 1) * GS_STAGE; \
                LAS const bf16_t* Wm = (LAS const bf16_t*)sg; LAS const bf16_t* QGm = (LAS const bf16_t*)(sg + 8192); LAS const bf16_t* AQm = (LAS const bf16_t*)(sg + 16384); \
                LAS const bf16_t* KGm = (LAS const bf16_t*)(sg + 24576); LAS const bf16_t* Um = (LAS const bf16_t*)(sg + 32768); \
                const float gl = *(LAS const float*)(sg + 40960); \
                bf16x8 Sb[2][2]; Sb[0][0] = pack8(S0, 0); Sb[0][1] = pack8(S0, 1); Sb[1][0] = pack8(S1, 0); Sb[1][1] = pack8(S1, 1); \
                f32x16 vn[2], o[2]; \
        _Pragma("unroll") \
                for (int ct = 0; ct < 2; ++ct) { \
                    f32x16 acc; \
        _Pragma("unroll") \
                    for (int i = 0; i < 16; ++i) acc[i] = bf2f(Um[(32 * ct + crow(i, hi)) * 64 + vbase + r32]); \
                    f32x16 oo = {}; \
        _Pragma("unroll") \
                    for (int kt = 0; kt < 2; ++kt) \
        _Pragma("unroll") \
                        for (int s2 = 0; s2 < 2; ++s2) { \
                            acc = MFMA32(lds_frag(Wm, 32 * ct + r32, (2 * kt + s2) * 2 + hi), Sb[kt][s2], acc); \
                            oo = MFMA32(lds_frag(QGm, 32 * ct + r32, (2 * kt + s2) * 2 + hi), Sb[kt][s2], oo); \
                        } \
                    vn[ct] = acc; o[ct] = oo; \
                } \
                bf16x8 Vb[2][2]; Vb[0][0] = pack8(vn[0], 0); Vb[0][1] = pack8(vn[0], 1); Vb[1][0] = pack8(vn[1], 0); Vb[1][1] = pack8(vn[1], 1); \
        _Pragma("unroll") \
                for (int i = 0; i < 16; ++i) { S0[i] *= gl; S1[i] *= gl; } \
        _Pragma("unroll") \
                for (int ct = 0; ct < 2; ++ct) \
        _Pragma("unroll") \
                    for (int s2 = 0; s2 < 2; ++s2) { \
                        const int ch = (2 * ct + s2) * 2 + hi; \
                        o[0] = MFMA32(lds_frag(AQm, r32, ch), Vb[ct][s2], o[0]); \
                        o[1] = MFMA32(lds_frag(AQm, 32 + r32, ch), Vb[ct][s2], o[1]); \
                        S0 = MFMA32(lds_frag(KGm, r32, ch), Vb[ct][s2], S0); \
                        S1 = MFMA32(lds_frag(KGm, 32 + r32, ch), Vb[ct][s2], S1); \
                    } \
                LAS float* ob = (LAS float*)(lds + GS_OBUF + (n & 1) * 16384); \
        _Pragma("unroll") \
                for (int ct = 0; ct < 2; ++ct) \
        _Pragma("unroll") \
                    for (int i = 0; i < 16; ++i) ob[(32 * ct + crow(i, hi)) * 64 + vbase + r32] = o[ct][i]; \
            } \
        } else if (wave < 4) { \
            if (n > 0) { \
                LAS const float* ob = (LAS const float*)(lds + GS_OBUF + ((n - 1) & 1) * 16384); \
                const f32x4 gn = *(const f32x4*)(gnorm + 4 * vq); \
        _Pragma("unroll") \
                for (int it = 0; it < 8; ++it) { \
                    const int c = (wave - 2) * 32 + 4 * it + rg, p = (n - 1) * 64 + c; \
                    const f32x4 v = *(LAS const f32x4*)(ob + c * 64 + 4 * vq); \
                    const float ss = row_sum16((v[0] * v[0] + v[1] * v[1]) + (v[2] * v[2] + v[3] * v[3])); \
                    const float rn = __builtin_amdgcn_rsqf(ss * (1.0f / 64.0f) + EPS); \
                    const u32x2 zz = zq[it]; \
                    const float z0 = __uint_as_float(zz.x << 16), z1 = __uint_as_float(zz.x & 0xffff0000u), z2 = __uint_as_float(zz.y << 16), z3 = __uint_as_float(zz.y & 0xffff0000u); \
                    const float y0 = v[0] * rn * gn[0] * z0, y1 = v[1] * rn * gn[1] * z1, y2 = v[2] * rn * gn[2] * z2, y3 = v[3] * rn * gn[3] * z3; \
                    if ((p >= NMETA) && (p < LTOK)) *(u32x2*)(MIX + (size_t)(b * SEQ + p - NMETA) * 1024 + 512 + h * 64 + 4 * vq) = (u32x2){pk2(y0, y1), pk2(y2, y3)}; \
                } \
            } \
            if (n < NCHUNK) { GS_ZLOAD(n); } \
        } else { \
            if (n + 1 < NCHUNK) { GS_WRITE(HW, HGW, STGW); if (n + 2 < NCHUNK) GS_ISSUE(HW, HGW, n + 2); } \
        } \
        BAR_LDS(); } while (0)
DI void gdn_scan(const Params& P, LAS unsigned char* lds, int bh, int tid, int wave, int lane) {
    const int b = bh >> 3, h = bh & 7, r32 = lane & 31, hi = lane >> 5;
    const int task0 = (b * 8 + h) * NCHUNK;
    const bf16_t* GP0 = (const bf16_t*)(P.ws + WS_GP);
    const float* GLg = (const float*)(P.ws + WS_GL);
    const bf16_t* ZB = (const bf16_t*)(P.ws + WS_ZB); bf16_t* MIX = (bf16_t*)(P.ws + WS_MIX); const float* gnorm = P.in[12];
    const int lt = tid - 256;
    u32x4 holdA[10]; float hglA = 0.f;
#define GS_ISSUE(H, HG, n_) do { _Pragma("unroll") for (int i = 0; i < 10; ++i) { const int a_ = i >> 1, e_ = lt + 256 * (i & 1); \
            H[i] = *(const u32x4*)(GP0 + (size_t)a_ * (GP_ARR / 2) + (size_t)(task0 + (n_)) * 4096 + e_ * 8); } \
        if (lt == 0) HG = GLg[task0 + (n_)]; } while (0)
#define GS_WRITE(H, HG, stg_) do { LAS unsigned char* sg_ = lds + (stg_) * GS_STAGE; \
        _Pragma("unroll") for (int i = 0; i < 10; ++i) { const int a_ = i >> 1, e_ = lt + 256 * (i & 1), row_ = e_ >> 3, ch_ = e_ & 7; \
            *(LAS u32x4*)(sg_ + a_ * 8192 + row_ * 128 + (((a_ < 4) ? (ch_ ^ (row_ & 7)) : ch_) << 4)) = H[i]; } \
        if (lt == 0) *(LAS float*)(sg_ + 40960) = HG; } while (0)
    const int vq = lane & 15, rg = lane >> 4;
    u32x2 zq[8];
#define GS_ZLOAD(n_) do { _Pragma("unroll") for (int it = 0; it < 8; ++it) { int p_ = (n_) * 64 + (wave - 2) * 32 + 4 * it + rg; p_ = p_ < LTOK ? p_ : LTOK - 1; \
            zq[it] = *(const u32x2*)(ZB + (size_t)(b * LP + p_) * 512 + h * 64 + 4 * vq); } } while (0)
    if (wave >= 4) { GS_ISSUE(holdA, hglA, 0); GS_WRITE(holdA, hglA, 0); GS_ISSUE(holdA, hglA, 1); }
    if (wave == 2 || wave == 3) { GS_ZLOAD(0); }
    __syncthreads();
    f32x16 S0 = {}, S1 = {};
    const int vbase = 32 * wave;
    for (int n2 = 0; n2 <= NCHUNK; n2 += 2) { GS_STEP((n2), holdA, hglA, 1); GS_STEP((n2 + 1), holdA, hglA, 0); }
}

constexpr int AT_STAGE = 32768;
constexpr int AT_XBUF = 2 * AT_STAGE;
constexpr int AT_WSF = AT_XBUF + 65536;
constexpr int AT_UNIT = AT_WSF + 2048;
constexpr float AT_THR = 8.0f;

DI s16x4 tr_read(LAS const unsigned char* p) { return __builtin_bit_cast(s16x4, __builtin_amdgcn_ds_read_tr16_b64_v4i16((LAS v4i16_t*)p)); }

DI void attn_unit(const Params& P, LAS unsigned char* lds, int bh, int qi, int tid, int wave, int lane, float lam) {
    const int b = bh >> 2, h = bh & 3, r32 = lane & 31, hi = lane >> 5, qsub = wave >> 1, map = wave & 1, hh = 2 * h + map;
    const bf16_t* QB = (const bf16_t*)(P.ws + WS_QB); const bf16_t* KT = (const bf16_t*)(P.ws + WS_KT); const bf16_t* VT = (const bf16_t*)(P.ws + WS_VT);
    const int ntiles = 2 * qi + 3, my_nt = (qsub < 2) ? ntiles - 1 : ntiles;
    const bf16_t* k1 = KT + ((size_t)((b * 8 + 2 * h) * NKT) << 12) + tid * 8;
    const bf16_t* k2 = KT + ((size_t)((b * 8 + 2 * h + 1) * NKT) << 12) + tid * 8;
    const bf16_t* vv = VT + ((size_t)((b * 4 + h) * NKT) << 13) + tid * 8;
    u32x4 st[4];
#define AT_LOAD(t) do { st[0] = *(const u32x4*)(k1 + ((size_t)(t) << 12)); st[1] = *(const u32x4*)(k2 + ((size_t)(t) << 12)); \
                        st[2] = *(const u32x4*)(vv + ((size_t)(t) << 13)); st[3] = *(const u32x4*)(vv + ((size_t)(t) << 13) + 4096); } while (0)
#define AT_STORE(sb) do { LAS unsigned char* d_ = lds + (sb) * AT_STAGE + tid * 16; *(LAS u32x4*)d_ = st[0]; *(LAS u32x4*)(d_ + 8192) = st[1]; \
                          *(LAS u32x4*)(d_ + 16384) = st[2]; *(LAS u32x4*)(d_ + 24576) = st[3]; } while (0)
    AT_LOAD(0);
    bf16x8 qr[4];
    { const bf16_t* q = QB + ((size_t)((b * 8 + hh) * SEQ + qi * 128 + qsub * 32 + r32) << 6) + hi * 8;
#pragma unroll
      for (int d0 = 0; d0 < 4; ++d0) qr[d0] = *(const bf16x8*)(q + d0 * 16); }
    AT_STORE(0);
    __syncthreads();
    LAS float* wsf = (LAS float*)(lds + AT_WSF) + wave * 64;
    float m_run = -1e30f, l_run = 0.f;
    f32x16 o[4]; o[0] = f32x16{}; o[1] = f32x16{}; o[2] = f32x16{}; o[3] = f32x16{};
    for (int t = 0; t < ntiles; ++t) {
        if (t + 1 < ntiles) AT_LOAD(t + 1);
        if (t < my_nt) {
            LAS const unsigned char* sg = lds + (t & 1) * AT_STAGE;
            LAS const unsigned char* kb = sg + map * 8192 + hi * 1024 + r32 * 16;
            f32x16 p0 = {}, p1 = {};
#pragma unroll
            for (int d0 = 0; d0 < 4; ++d0) {
                const bf16x8 a0 = *(LAS const bf16x8*)(kb + d0 * 2048), a1 = *(LAS const bf16x8*)(kb + d0 * 2048 + 512);
                p0 = MFMA32(a0, qr[d0], p0); p1 = MFMA32(a1, qr[d0], p1);
            }
            if (t == 0) {
#pragma unroll
                for (int r = 0; r < 16; ++r) { if (crow(r, hi) >= NMETA) p0[r] = -INFINITY; p1[r] = -INFINITY; }
            }
            float rm = fmaxf(p0[0], p1[0]);
#pragma unroll
            for (int r = 1; r < 16; ++r) rm = fmaxf(rm, fmaxf(p0[r], p1[r]));
            rm = swap32_max(rm);
            if (__any(rm > m_run + AT_THR)) {
                const float mn = fmaxf(m_run, rm), alpha = exp2f(m_run - mn);
                l_run *= alpha; m_run = mn;
                if (hi == 0) wsf[r32] = alpha;
                LDS_WAIT();
#pragma unroll
                for (int r = 0; r < 16; ++r) { const float a = wsf[crow(r, hi)];
#pragma unroll
                    for (int d0 = 0; d0 < 4; ++d0) o[d0][r] *= a; }
                LDS_WAIT();
            }
            float ls = 0.f;
#pragma unroll
            for (int r = 0; r < 16; ++r) { p0[r] = exp2f(p0[r] - m_run); p1[r] = exp2f(p1[r] - m_run); ls += p0[r] + p1[r]; }
            l_run += ls;
            const bf16x8 pa0 = pack8(p0, 0), pa1 = pack8(p0, 1), pa2 = pack8(p1, 0), pa3 = pack8(p1, 1);
            LAS const unsigned char* vb = sg + 16384 + ((lane >> 4) & 1) * 32 + (lane & 3) * 8 + (4 * hi + ((lane & 15) >> 2)) * 64;
#pragma unroll
            for (int d0 = 0; d0 < 4; ++d0) {
#define AT_VF(ks) ({ const s16x4 lo_ = tr_read(vb + d0 * 4096 + (ks) * 1024), hi_ = tr_read(vb + d0 * 4096 + (ks) * 1024 + 512); \
                     (bf16x8){lo_[0], lo_[1], lo_[2], lo_[3], hi_[0], hi_[1], hi_[2], hi_[3]}; })
                o[d0] = MFMA32(pa0, AT_VF(0), o[d0]); o[d0] = MFMA32(pa1, AT_VF(1), o[d0]);
                o[d0] = MFMA32(pa2, AT_VF(2), o[d0]); o[d0] = MFMA32(pa3, AT_VF(3), o[d0]);
#undef AT_VF
            }
        }
        if (t + 1 < ntiles) AT_STORE((t + 1) & 1);
        __syncthreads();
    }
    l_run = swap32_add(l_run);
    const float sc = (map ? lam : 1.0f) / l_run;
    if (hi == 0) wsf[r32] = sc;
    LDS_WAIT();
#pragma unroll
    for (int r = 0; r < 16; ++r) { const float a = wsf[crow(r, hi)];
#pragma unroll
        for (int d0 = 0; d0 < 4; ++d0) o[d0][r] *= a; }
    LAS float* xb = (LAS float*)(lds + AT_XBUF + qsub * 16384);
    if (map) {
#pragma unroll
        for (int d0 = 0; d0 < 4; ++d0)
#pragma unroll
            for (int r = 0; r < 16; ++r) xb[(d0 * 16 + r) * 64 + lane] = o[d0][r];
    }
    __syncthreads();
    if (!map) {
        const float* dn = P.in[8];
        bf16_t* MIX = (bf16_t*)(P.ws + WS_MIX);
        float ss[16];
#pragma unroll
        for (int r = 0; r < 16; ++r) { ss[r] = 0.f;
#pragma unroll
            for (int d0 = 0; d0 < 4; ++d0) { o[d0][r] -= xb[(d0 * 16 + r) * 64 + lane]; ss[r] += o[d0][r] * o[d0][r]; } }
#pragma unroll
        for (int r = 0; r < 16; ++r) {
            ss[r] = half_sum32(ss[r]);
            ss[r] = 0.8f / sqrtf(ss[r] * (1.0f / 128.0f) + EPS);
        }
        float dg[4];
#pragma unroll
        for (int d0 = 0; d0 < 4; ++d0) dg[d0] = dn[32 * d0 + r32];
#pragma unroll
        for (int r = 0; r < 16; ++r) {
            bf16_t* orow = MIX + (size_t)(b * SEQ + qi * 128 + qsub * 32 + crow(r, hi)) * 1024 + h * 128 + r32;
#pragma unroll
            for (int d0 = 0; d0 < 4; ++d0) orow[32 * d0] = (bf16_t)f2bf(o[d0][r] * ss[r] * dg[d0]);
        }
    }
    __syncthreads();
#undef AT_LOAD
#undef AT_STORE
}

DI void attn_phase(const Params& P, LAS unsigned char* lds, int tid, int wave, int lane) {
    unsigned* ctl = (unsigned*)(P.ws + WS_CTL);
    const float* lq1 = P.in[4]; const float* lk1 = P.in[5]; const float* lq2 = P.in[6]; const float* lk2 = P.in[7];
    const float lam = __expf(wave_sum(lq1[lane] * lk1[lane])) - __expf(wave_sum(lq2[lane] * lk2[lane])) + 0.2f;
    LAS volatile int* ub = (LAS volatile int*)(lds + AT_UNIT);
    for (;;) {
        if (tid == 0) *ub = (int)__hip_atomic_fetch_add(ctl + CW_ATTQ, 1u, __ATOMIC_RELAXED, __HIP_MEMORY_SCOPE_AGENT);
        __syncthreads();
        const int u = *ub;
        __syncthreads();
        if (u >= 512) break;
        attn_unit(P, lds, u & 7, 63 - (u >> 3), tid, wave, lane, lam);
    }
}

struct EpiOutProj {
    static constexpr bool PERM = false, AFTER_DRAIN = false;
    const float* x; float* out;
    DI void operator()(const pg8::f32x4 (&acc)[2][2][4][2], const pg8::Unit& u, int wr, int wc, int fr, int fq) const {
        const int row0 = u.pm * 256 + wr * 64 + fr, col0 = u.pn * 256 + wc * 32 + 4 * fq;
#pragma unroll
        for (int ai = 0; ai < 2; ++ai)
#pragma unroll
            for (int m = 0; m < 4; ++m) { const size_t off = (size_t)(row0 + ai * 128 + m * 16) * 1024 + col0;
#pragma unroll
                for (int bj = 0; bj < 2; ++bj)
#pragma unroll
                    for (int n = 0; n < 2; ++n) { const f32x4 xv = *(const f32x4*)(x + off + bj * 128 + n * 16); *(f32x4*)(out + off + bj * 128 + n * 16) = acc[ai][bj][m][n] + xv; } }
    }
};

typedef float f32x4v __attribute__((ext_vector_type(4)));
DI void route_tile(const Params& P, int tile, LAS float* lg  , int lane) {
    const float* h2 = P.out; const float* WR = (const float*)(P.ws + WS_WR);
    const int r16 = lane & 15, kq = lane >> 4;
    const float* arow = h2 + (size_t)(tile * 16 + r16) * 1024 + kq * 256;
    const float* b0 = WR + (size_t)r16 * 1024 + kq * 256; const float* b1 = b0 + 16 * 1024; const float* b2 = WR + (size_t)(32 + (r16 & 3)) * 1024 + kq * 256;
    const float z2 = (r16 < 4) ? 1.0f : 0.0f;
    f32x4v c0 = {}, c1 = {}, c2 = {};
    float ss = 0.f;
    for (int t4 = 0; t4 < 64; ++t4) {
        const f32x4 a = *(const f32x4*)(arow + 4 * t4), w0 = *(const f32x4*)(b0 + 4 * t4), w1 = *(const f32x4*)(b1 + 4 * t4), w2 = *(const f32x4*)(b2 + 4 * t4);
        ss += (a.x * a.x + a.y * a.y) + (a.z * a.z + a.w * a.w);
#pragma unroll
        for (int i = 0; i < 4; ++i) {
            c0 = __builtin_amdgcn_mfma_f32_16x16x4f32(a[i], w0[i], c0, 0, 0, 0);
            c1 = __builtin_amdgcn_mfma_f32_16x16x4f32(a[i], w1[i], c1, 0, 0, 0);
            c2 = __builtin_amdgcn_mfma_f32_16x16x4f32(a[i], w2[i] * z2, c2, 0, 0, 0);
        }
    }
    ss += swz_xor16(ss); ss = swap32_add(ss);
    const float rs = 1.0f / sqrtf(ss * (1.0f / 1024.0f) + EPS);
#pragma unroll
    for (int r = 0; r < 4; ++r) { const int row = 4 * kq + r; lg[row * 48 + r16] = c0[r]; lg[row * 48 + 16 + r16] = c1[r]; lg[row * 48 + 32 + r16] = c2[r]; }
    LDS_WAIT();
    if (lane < 16) {
        const int t = tile * 16 + lane;
        const float* bg = P.in[16]; const float* br = P.in[18];
        LAS const float* l = lg + lane * 48;
        float gl[4]; int gs = 0; float gm;
#pragma unroll
        for (int j = 0; j < 4; ++j) gl[j] = l[j] * rs + bg[j];
        gm = gl[0];
#pragma unroll
        for (int j = 1; j < 4; ++j) if (gl[j] > gm) { gm = gl[j]; gs = j; }
        float gsum = 0.f;
#pragma unroll
        for (int j = 0; j < 4; ++j) gsum += __expf(gl[j] - gm);
        const float psel = 1.0f / gsum;
        float e1 = -INFINITY, e2 = -INFINITY; int i1 = 0, i2 = 0;
#pragma unroll
        for (int j = 0; j < 8; ++j) {
            const float v = l[4 + gs * 8 + j] * rs + br[gs * 8 + j];
            if (v > e1) { e2 = e1; i2 = i1; e1 = v; i1 = j; } else if (v > e2) { e2 = v; i2 = j; }
        }
        const float x2 = __expf(e2 - e1), w1 = psel / (1.0f + x2), w2 = psel * x2 / (1.0f + x2);
        const int ea = gs * 8 + i1, eb = gs * 8 + i2;
        unsigned* cnt = (unsigned*)(P.ws + WS_CTL) + CW_CNT;
        const int pa = (int)atomicAdd(cnt + ea, 1u), pb = (int)atomicAdd(cnt + eb, 1u);
        ((int*)(P.ws + WS_TOKE))[2 * t] = ea; ((int*)(P.ws + WS_TOKE))[2 * t + 1] = eb;
        ((float*)(P.ws + WS_TOKW))[2 * t] = w1; ((float*)(P.ws + WS_TOKW))[2 * t + 1] = w2;
        ((int*)(P.ws + WS_TOKP))[2 * t] = pa; ((int*)(P.ws + WS_TOKP))[2 * t + 1] = pb;
        ((float*)(P.ws + WS_RS2))[t] = rs;
    }
    LDS_WAIT();
}

DI void phase4a(const Params& P, LAS unsigned char* lds, int gw, int NGW, int wave, int lane) {
    LAS float* scr = (LAS float*)(lds + wave * 16384);
    for (int tile = gw; tile < MTOK / 16; tile += NGW) route_tile(P, tile, scr, lane);
    bf16_t* WGU = (bf16_t*)(P.ws + WS_WGU); bf16_t* WD = (bf16_t*)(P.ws + WS_WD);
    const float* wg = P.in[19]; const float* wu = P.in[20]; const float* wd = P.in[21]; const float* gf = P.in[14];
    constexpr int I_GU = 16 * 16, I_D = 4 * 32;
    for (int it = gw; it < 32 * (I_GU + I_D); it += NGW) {
        const int e = it / (I_GU + I_D), r = it % (I_GU + I_D);
        if (r < I_GU) { const int n0 = (r & 15) * 32, j = n0 >> 8, up = (n0 >> 7) & 1;
            const float* wsrc = (up ? wu : wg) + (size_t)e * 1024 * 256;
            const SrcGU s{wsrc, gf, 128 * j + (n0 & 127) - n0};
            transpose_item(s, WGU + (size_t)e * 512 * 1024, 1024, (r >> 4) * 64, n0, scr, lane); }
        else { const int r2 = r - I_GU; const SrcPlain s{wd + (size_t)e * 256 * 1024, 1024};
            transpose_item(s, WD + (size_t)e * 1024 * 256, 256, (r2 >> 5) * 64, (r2 & 31) * 32, scr, lane); }
    }
}

DI void expert_layout(const Params& P, int lane, int& cnt, int& base, int& tend) {
    const unsigned* c = (const unsigned*)(P.ws + WS_CTL) + CW_CNT;
    cnt = (lane < 32) ? (int)__hip_atomic_load(c + lane, __ATOMIC_RELAXED, __HIP_MEMORY_SCOPE_AGENT) : 0;
    const int tiles = (cnt + 255) >> 8;
    int inc = 0;
#pragma unroll
    for (int i = 0; i < 32; ++i) { const int ti = __builtin_amdgcn_readlane(tiles, i); inc += (i <= lane) ? ti : 0; }
    tend = inc; base = (inc - tiles) << 8;
}

DI void phase4b(const Params& P, int gw, int NGW, int lane) {
    int cnt, base, tend; expert_layout(P, lane, cnt, base, tend);
    bf16_t* XS = (bf16_t*)(P.ws + WS_XS); float* SLOTW = (float*)(P.ws + WS_SLOTW);
    const int* TOKE = (const int*)(P.ws + WS_TOKE); const float* TOKW = (const float*)(P.ws + WS_TOKW); int* TOKP = (int*)(P.ws + WS_TOKP); const float* RS2 = (const float*)(P.ws + WS_RS2);
    for (int t = gw; t < MTOK; t += NGW) {
        const f32x4* hr = (const f32x4*)(P.out + (size_t)t * 1024);
        const float rs = RS2[t];
        u32x2 w[4];
#pragma unroll
        for (int j = 0; j < 4; ++j) { const f32x4 v = hr[64 * j + lane]; w[j] = (u32x2){pk2(v.x * rs, v.y * rs), pk2(v.z * rs, v.w * rs)}; }
#pragma unroll
        for (int k = 0; k < 2; ++k) {
            const int e = __builtin_amdgcn_readfirstlane(TOKE[2 * t + k]), slot = __builtin_amdgcn_readlane(base, e) + TOKP[2 * t + k];
            u32x2* orow = (u32x2*)(XS + (size_t)slot * 1024);
#pragma unroll
            for (int j = 0; j < 4; ++j) orow[64 * j + lane] = w[j];
            if (lane == 0) { SLOTW[slot] = TOKW[2 * t + k]; TOKP[2 * t + k] = slot; }
        }
    }
    for (int e = 0; e < 32; ++e) {
        const int ce = __builtin_amdgcn_readlane(cnt, e), be = __builtin_amdgcn_readlane(base, e), end = be + (((ce + 255) >> 8) << 8);
        for (int r = be + ce + gw; r < end; r += NGW) { u32x2* orow = (u32x2*)(XS + (size_t)r * 1024);
#pragma unroll
            for (int j = 0; j < 4; ++j) orow[64 * j + lane] = (u32x2){0u, 0u};
            if (lane == 0) SLOTW[r] = 0.f; }
    }
}

struct GroupedOrder {
    int tend; int total; int G, c, NS;
    DI bool next(int i, pg8::Unit& u) const {
        const int L = i * G + c; if (L >= (total << NS)) return false;
        const int mt = L >> NS, j = L & ((1 << NS) - 1);
        const int e = __builtin_popcountll(__ballot(((int)(threadIdx.x & 63) < 32) && tend <= mt));
        u.pm = mt; u.pn = (e << NS) + j; return true;
    }
    DI void a_ready(const pg8::Unit&) const {}
    DI void done(const pg8::Unit&) const {}
};
struct EpiGateUp {
    static constexpr bool PERM = true, AFTER_DRAIN = false;
    const float* SLOTW; bf16_t* YS;
    DI void operator()(const pg8::f32x4 (&acc)[2][2][4][2], const pg8::Unit& u, int wr, int wc, int fr, int fq) const {
        const int f0 = (u.pn & 1) * 128 + wc * 32 + fq * 8;
#pragma unroll
        for (int ai = 0; ai < 2; ++ai)
#pragma unroll
            for (int m = 0; m < 4; ++m) {
                const int row = u.pm * 256 + ai * 128 + wr * 64 + m * 16 + fr;
                const float cw = SLOTW[row];
                float a[8];
#pragma unroll
                for (int i = 0; i < 4; ++i) {
                    const float g0 = acc[ai][0][m][0][i], g1 = acc[ai][0][m][1][i];
                    a[i] = g0 / (1.0f + __expf(-g0)) * acc[ai][1][m][0][i] * cw; a[4 + i] = g1 / (1.0f + __expf(-g1)) * acc[ai][1][m][1][i] * cw;
                }
                *(u32x4*)(YS + (size_t)row * 256 + f0) = (u32x4){pk2(a[0], a[1]), pk2(a[2], a[3]), pk2(a[4], a[5]), pk2(a[6], a[7])};
            }
    }
};
struct EpiDown {
    static constexpr bool PERM = true, AFTER_DRAIN = false;
    bf16_t* YO;
    DI void operator()(const pg8::f32x4 (&acc)[2][2][4][2], const pg8::Unit& u, int wr, int wc, int fr, int fq) const {
        const int c0 = (u.pn & 3) * 256 + wc * 32 + fq * 8;
#pragma unroll
        for (int ai = 0; ai < 2; ++ai)
#pragma unroll
            for (int m = 0; m < 4; ++m) {
                bf16_t* rowp = YO + (size_t)(u.pm * 256 + ai * 128 + wr * 64 + m * 16 + fr) * 1024 + c0;
#pragma unroll
                for (int bj = 0; bj < 2; ++bj) { const pg8::f32x4 v0 = acc[ai][bj][m][0], v1 = acc[ai][bj][m][1];
                    *(u32x4*)(rowp + bj * 128) = (u32x4){pk2(v0[0], v0[1]), pk2(v0[2], v0[3]), pk2(v1[0], v1[1]), pk2(v1[2], v1[3])}; }
            }
    }
};

DI void phase7(const Params& P, int gw, int NGW, int lane) {
    const bf16_t* YO = (const bf16_t*)(P.ws + WS_YO); const int* TOKP = (const int*)(P.ws + WS_TOKP); const f32x4* nf = (const f32x4*)P.in[22];
    for (int t = gw; t < MTOK; t += NGW) {
        f32x4* hr = (f32x4*)(P.out + (size_t)t * 1024);
        const u32x2* y0 = (const u32x2*)(YO + (size_t)TOKP[2 * t] * 1024); const u32x2* y1 = (const u32x2*)(YO + (size_t)TOKP[2 * t + 1] * 1024);
        f32x4 v[4]; float s = 0.f;
#pragma unroll
        for (int j = 0; j < 4; ++j) {
            v[j] = hr[64 * j + lane]; const u32x2 a = y0[64 * j + lane], c = y1[64 * j + lane];
            v[j].x += __uint_as_float(a.x << 16) + __uint_as_float(c.x << 16); v[j].y += __uint_as_float(a.x & 0xffff0000u) + __uint_as_float(c.x & 0xffff0000u);
            v[j].z += __uint_as_float(a.y << 16) + __uint_as_float(c.y << 16); v[j].w += __uint_as_float(a.y & 0xffff0000u) + __uint_as_float(c.y & 0xffff0000u);
            s += (v[j].x * v[j].x + v[j].y * v[j].y) + (v[j].z * v[j].z + v[j].w * v[j].w);
        }
        s = wave_sum(s);
        const float rs = 1.0f / sqrtf(s * (1.0f / 1024.0f) + EPS);
#pragma unroll
        for (int j = 0; j < 4; ++j) hr[64 * j + lane] = v[j] * rs * nf[64 * j + lane];
    }
}

#define XB_TMO      128
#define XB_XCNT(j)  (256  + 64 * (j))
#define XB_XSUB(j)  (1280 + 64 * (j))
#define XB_XGEN(j)  (2304 + 64 * (j))
#define XB_TOP      3328
#define XB_TOPGEN   3392
#define XCD_BAR_WORDS 3456
#define XB_SPIN_CAP (1u << 18)

__device__ __forceinline__ unsigned xb_ld(unsigned* p)              { return __hip_atomic_load(p, __ATOMIC_RELAXED, __HIP_MEMORY_SCOPE_AGENT); }
__device__ __forceinline__ unsigned xb_add(unsigned* p, unsigned v) { return __hip_atomic_fetch_add(p, v, __ATOMIC_RELAXED, __HIP_MEMORY_SCOPE_AGENT); }
__device__ __forceinline__ unsigned xb_xcc_id() { return (unsigned)__builtin_amdgcn_s_getreg((3 << 11) | 20) & 0xFu; }
#define XB_SPIN(cond, bar) do { unsigned _sp = 0; while (cond) { __builtin_amdgcn_s_sleep(1); \
    if ((++_sp & 255u) == 0u) { if (xb_ld(&(bar)[XB_TMO])) break; if (_sp > XB_SPIN_CAP) { atomicAdd(&(bar)[XB_TMO], 1u); break; } } } } while (0)

struct XcdBarrier {
    unsigned* bar; unsigned x;
    volatile LAS unsigned* st;
};

__device__ __forceinline__ XcdBarrier xcd_barrier_post(unsigned* bar, volatile LAS unsigned* st) {
    XcdBarrier b; b.bar = bar; b.x = xb_xcc_id(); b.st = st;
    if (threadIdx.x == 0) (void)xb_add(&bar[XB_XCNT(b.x)], 1u);
    return b;
}
__device__ __forceinline__ void xcd_barrier_complete(unsigned* bar, unsigned x, unsigned& nloc, unsigned& nx) {
    const unsigned G = gridDim.x * gridDim.y * gridDim.z;
    unsigned sum, cnt, mine, sp = 0u;
    for (;;) {
        sum = 0u; cnt = 0u; mine = 0u;
#pragma unroll
        for (unsigned j = 0; j < 16; ++j) { const unsigned c = xb_ld(&bar[XB_XCNT(j)]); sum += c; cnt += (c > 0u) ? 1u : 0u; mine = (j == x) ? c : mine; }
        if (sum == G) break;
        __builtin_amdgcn_s_sleep(1);
        if ((++sp & 255u) == 0u) { if (xb_ld(&bar[XB_TMO])) break; if (sp > XB_SPIN_CAP) { atomicAdd(&bar[XB_TMO], 1u); break; } }
    }
    nloc = mine > 0u ? mine : 1u; nx = cnt > 0u ? cnt : 1u;
}

__device__ __forceinline__ void xcd_barrier(const XcdBarrier& b) {
    asm volatile("s_waitcnt vmcnt(0)" ::: "memory");
    __syncthreads();
    if (threadIdx.x == 0) {
        unsigned* bar = b.bar;
        __builtin_amdgcn_s_waitcnt(0);
        unsigned nloc = b.st[0], nx = b.st[1];
        if (nloc == 0u) { xcd_barrier_complete(bar, b.x, nloc, nx); b.st[0] = nloc; b.st[1] = nx; }
        const unsigned old = xb_add(&bar[XB_XSUB(b.x)], 1u);
        const unsigned gen = old / nloc;
        if (old + 1u == (gen + 1u) * nloc) {
            __builtin_amdgcn_fence(__ATOMIC_RELEASE, "agent");
            asm volatile("s_waitcnt vmcnt(0)" ::: "memory");
            const unsigned og = xb_add(&bar[XB_TOP], 1u);
            const unsigned tg = og / nx;
            if (og + 1u == (tg + 1u) * nx) xb_add(&bar[XB_TOPGEN], 1u);
            else XB_SPIN(xb_ld(&bar[XB_TOPGEN]) == tg, bar);
            __builtin_amdgcn_fence(__ATOMIC_ACQUIRE, "agent");
            xb_add(&bar[XB_XGEN(b.x)], 1u);
            asm volatile("s_waitcnt vmcnt(0)" ::: "memory");
        } else {
            XB_SPIN(xb_ld(&bar[XB_XGEN(b.x)]) == gen, bar);
            __builtin_amdgcn_fence(__ATOMIC_ACQUIRE, "agent");
            asm volatile("s_waitcnt vmcnt(0)" ::: "memory");
        }
    }
    __syncthreads();
}

#ifndef PHMASK
#define PHMASK 2047
#endif
#ifndef REPMASK
#define REPMASK 0
#endif
#define REP(bit) for (int rep_ = 0; rep_ < ((REPMASK & (bit)) ? 2 : 1); ++rep_)
#define REPSYNC(bit) if ((REPMASK & (bit)) && rep_ == 0) GRID_BAR()
typedef const __attribute__((address_space(4))) Params* KParams;
DI Params load_params(KParams kp) { Params p;
#pragma unroll
    for (int i = 0; i < 23; ++i) p.in[i] = kp->in[i];
    p.out = kp->out; p.ws = kp->ws; return p; }
__global__ void __launch_bounds__(NTHREADS, 2) hymba_fwd(Params Pin) {
    extern __shared__ __attribute__((aligned(16))) unsigned char lds_raw[];
    LAS unsigned char* lds = (LAS unsigned char*)lds_raw;
    cg::grid_group grid = cg::this_grid();
    volatile LAS unsigned* bst = (volatile LAS unsigned*)(lds + LDS_BYTES - 64);
    if (threadIdx.x < 2) bst[threadIdx.x] = 0u;
    __syncthreads();
    const XcdBarrier xbar = xcd_barrier_post((unsigned*)(Pin.ws + WS_CTL) + CW_BAR, bst);
#define GRID_BAR() xcd_barrier(xbar)
    const int G = gridDim.x, blk = blockIdx.x, NGW = G * NWAVES, NGT = G * NTHREADS;
#define PHASE_IDS() KParams kp_ = (KParams)__builtin_amdgcn_kernarg_segment_ptr(); asm volatile("" : "+s"(kp_)); const Params P = load_params(kp_); int tid = threadIdx.x; asm volatile("" : "+v"(tid)); const int lane = tid & 63, wave = __builtin_amdgcn_readfirstlane(tid >> 6), gw = blk * NWAVES + wave, gtid = blk * NTHREADS + tid; (void)lane; (void)gw; (void)gtid; (void)wave

    REP(1) { if (PHMASK & 1) { PHASE_IDS(); phase0(P, lds, gw, NGW, gtid, NGT, wave, lane); } REPSYNC(1); }
    GRID_BAR();
    REP(2) { if (PHMASK & 2) { PHASE_IDS();
        pg8::Gemm g{(const bf16_t*)(P.ws + WS_XB), (const bf16_t*)(P.ws + WS_WINT), MROWS, NPROJ, 1024};
        pg8::StaticOrder S; S.init(MROWS, NPROJ, G, blk);
        EpiInProj E{(const float*)(P.ws + WS_RS1), (const float*)(P.ws + WS_COS), (const float*)(P.ws + WS_SIN), P.in[10], P.in[11],
                    (bf16_t*)(P.ws + WS_QB), (bf16_t*)(P.ws + WS_KT), (bf16_t*)(P.ws + WS_VT), (bf16_t*)(P.ws + WS_QKVB), (bf16_t*)(P.ws + WS_ZB), (float*)(P.ws + WS_GB)};
        pg8::gemm_phase<EpiInProj, pg8::StaticOrder, true, true>(lds, g, S, E);
    } REPSYNC(2); }
    GRID_BAR();
    REP(4) { if (PHMASK & 4) { PHASE_IDS(); gdn_prep_phase(P, lds, blk, G, wave, lane); } REPSYNC(4); }
    GRID_BAR();
    REP(8) { if ((PHMASK & 8) && blk < 16) { PHASE_IDS(); gdn_scan(P, lds, blk, tid, wave, lane); } }
    REP(16) {
    if (PHMASK & 16) { PHASE_IDS(); attn_phase(P, lds, tid, wave, lane); }
    if ((REPMASK & 16) && rep_ == 0) { GRID_BAR(); if (blk == 0 && threadIdx.x == 0) { PHASE_IDS(); __hip_atomic_store((unsigned*)(P.ws + WS_CTL) + CW_ATTQ, 0u, __ATOMIC_RELAXED, __HIP_MEMORY_SCOPE_AGENT); } GRID_BAR(); }
    }
    GRID_BAR();
    REP(32) { if (PHMASK & 32) { PHASE_IDS();
        pg8::Gemm g{(const bf16_t*)(P.ws + WS_MIX), (const bf16_t*)(P.ws + WS_WOUT), MTOK, 1024, 1024};
        pg8::StaticOrder S; S.init(MTOK, 1024, G, blk);
        EpiOutProj E{P.in[0], P.out};
        pg8::gemm_phase<EpiOutProj, pg8::StaticOrder, true, true>(lds, g, S, E);
    } REPSYNC(32); }
    GRID_BAR();
    if (PHMASK & 64) { PHASE_IDS(); phase4a(P, lds, gw, NGW, wave, lane); }
    GRID_BAR();
    if (PHMASK & 128) { PHASE_IDS(); phase4b(P, gw, NGW, lane); }
    GRID_BAR();
    int cnt, base, tend, total; { PHASE_IDS(); expert_layout(P, lane, cnt, base, tend); total = __builtin_amdgcn_readlane(tend, 31); }
    REP(256) { if (PHMASK & 256) { PHASE_IDS();
        pg8::Gemm g{(const bf16_t*)(P.ws + WS_XS), (const bf16_t*)(P.ws + WS_WGU), XS_ROWS, 32 * 512, 1024};
        GroupedOrder S{tend, total, G, blk, 1};
        EpiGateUp E{(const float*)(P.ws + WS_SLOTW), (bf16_t*)(P.ws + WS_YS)};
        pg8::gemm_phase<EpiGateUp, GroupedOrder, true, true>(lds, g, S, E);
    } REPSYNC(256); }
    GRID_BAR();
    REP(512) { if (PHMASK & 512) { PHASE_IDS();
        int kd = 256; asm volatile("" : "+s"(kd));
        pg8::Gemm g{(const bf16_t*)(P.ws + WS_YS), (const bf16_t*)(P.ws + WS_WD), XS_ROWS, 32 * 1024, kd};
        GroupedOrder S{tend, total, G, blk, 2};
        EpiDown E{(bf16_t*)(P.ws + WS_YO)};
        pg8::gemm_phase<EpiDown, GroupedOrder, true, true>(lds, g, S, E);
    } REPSYNC(512); }
    GRID_BAR();
    if (PHMASK & 1024) { PHASE_IDS(); phase7(P, gw, NGW, lane); }
}

extern "C" void kernel_launch(void* const* d_in, const int* in_sizes, int n_in, void* d_out, int out_size, void* d_ws, size_t ws_size, hipStream_t stream) {
    static int grid_blocks = 0;
    if (grid_blocks == 0) {
        if (n_in != 23 || out_size != MTOK * DMODEL || ws_size < WS_END) { fprintf(stderr, "kernel_launch: unexpected shapes (n_in %d out %d ws %zu)\n", n_in, out_size, ws_size); grid_blocks = -1; return; }
        int dev = 0, cus = 0, per_cu = 0;
        hipGetDevice(&dev);
        hipDeviceGetAttribute(&cus, hipDeviceAttributeMultiprocessorCount, dev);
        hipFuncSetAttribute((const void*)hymba_fwd, hipFuncAttributeMaxDynamicSharedMemorySize, LDS_BYTES);
        hipOccupancyMaxActiveBlocksPerMultiprocessor(&per_cu, (const void*)hymba_fwd, NTHREADS, LDS_BYTES);
        if (per_cu < 1) { fprintf(stderr, "kernel_launch: occupancy query says %d blocks/CU\n", per_cu); per_cu = 1; }
        grid_blocks = cus;
        (void)hipGetLastError();
    }
    if (grid_blocks < 0) return;
    hipMemsetAsync((char*)d_ws + WS_CTL, 0, CTL_BYTES, stream);
    Params p{};
    for (int i = 0; i < 23; ++i) p.in[i] = (const float*)d_in[i];
    p.out = (float*)d_out; p.ws = (unsigned char*)d_ws;
    void* args[] = {&p};
    hipError_t e = hipLaunchCooperativeKernel((const void*)hymba_fwd, dim3(grid_blocks), dim3(NTHREADS), args, LDS_BYTES, stream);
    if (e != hipSuccess) fprintf(stderr, "cooperative launch failed: %s (grid %d)\n", hipGetErrorString(e), grid_blocks);
}
```

```cpp
#include <hip/hip_runtime.h>
#include <hip/hip_cooperative_groups.h>
#include <cstdio>
#include <cstdint>
namespace cg = cooperative_groups;
namespace pg8 {
#define PG8_LAS __attribute__((address_space(3)))
typedef unsigned short bf16_t;
typedef short bf16x8 __attribute__((ext_vector_type(8)));
typedef float f32x4 __attribute__((ext_vector_type(4)));
typedef unsigned u32x4 __attribute__((ext_vector_type(4)));
constexpr int BM = 256, BK = 64, HALF = 128, HTB = HALF * BK * 2  , STAGE_BYTES = 8 * HTB, NXCD = 8, WGM = 8;

__host__ __device__ __forceinline__ int lds_byte(int r, int c) { const int st = (r >> 4) * 2 + (c >> 5), rr = r & 15, cc = c & 31, ob = rr * 64 + cc * 2; return st * 1024 + (ob ^ (((ob >> 9) & 1) << 5)); }
__host__ __device__ __forceinline__ void stage_rc(int b, int& R, int& C) { const int st = b / 1024, sb = b % 1024, swz = sb ^ (((sb >> 9) & 1) << 5); R = (st >> 1) * 16 + swz / 64; C = (st & 1) * 32 + (swz % 64) / 2; }
__host__ __device__ __forceinline__ int perm32(int rho) { const int n = rho >> 4, i = rho & 15; return 8 * (i >> 2) + 4 * n + (i & 3); }

struct Unit { int pm, pn; };
struct Gemm { const bf16_t* A; const bf16_t* Bt; int M, N, K; };

struct StaticOrder {
    int nM, nN, nwg, G, c;
    __host__ __device__ void init(int M, int N, int G_, int c_) { nM = M / BM; nN = N / BM; nwg = nM * nN; G = G_; c = c_; }
    __host__ __device__ bool next(int i, Unit& u) const {
        const long L = (long)i * G + c; if (L >= nwg) return false;
        int wgid = (int)L; { const int q = nwg / NXCD, r = nwg % NXCD, xcd = wgid % NXCD, off = wgid / NXCD; wgid = (xcd < r ? xcd * (q + 1) : r * (q + 1) + (xcd - r) * q) + off; }
        const int nig = WGM * nN, gid = wgid / nig, fm = gid * WGM, gsz = (nM - fm) < WGM ? (nM - fm) : WGM;
        u.pm = fm + ((wgid % nig) % gsz); u.pn = (wgid % nig) / gsz; return true;
    }
    __device__ __forceinline__ void a_ready(const Unit&) const {}
    __device__ __forceinline__ void done(const Unit&) const {}
};

__device__ __forceinline__ unsigned cvt_pk_bf16(float lo, float hi) { unsigned r; asm volatile("v_cvt_pk_bf16_f32 %0, %1, %2" : "=v"(r) : "v"(lo), "v"(hi)); return r; }
typedef float f32x2 __attribute__((ext_vector_type(2)));
template <class Epi, class Sched, bool ALIGN_EPI = false, bool SP2 = false>
__device__ __forceinline__ void gemm_phase(PG8_LAS unsigned char* lds, const Gemm g, const Sched& S, const Epi& E) {
    int tid_o = threadIdx.x; asm volatile("" : "+v"(tid_o));
    const int tid = tid_o, wid = __builtin_amdgcn_readfirstlane(tid >> 6), lane = tid & 63, wr = wid >> 2, wc = wid & 3, fr = lane & 15, fq = lane >> 4;
    const int K = g.K, nt = K / BK;
    unsigned voffA[2], voffB[2];
#pragma unroll
    for (int i = 0; i < 2; ++i) { int R, C; stage_rc(tid * 16 + i * 8192, R, C); const int Rb = Epi::PERM ? ((R & ~31) + perm32(R & 31)) : R;
        voffA[i] = (unsigned)(R * K + C) * 2u; voffB[i] = (unsigned)(Rb * K + C) * 2u; }
    const size_t kstep = (size_t)(BK * 2);
    const size_t hstep = (size_t)HALF * K * 2;
    const size_t tstep = 2 * hstep;
    const unsigned ldsw = (unsigned)wid * 1024u;
    const int aoff = lds_byte(wr * 64 + fr, fq * 8), boff = lds_byte(wc * 32 + fr, fq * 8);
#define PG8_SA(b, h) (((b) * 2 + (h)) * HTB)
#define PG8_SB(b, h) ((4 + (b) * 2 + (h)) * HTB)
#define PG8_STAGE(bufoff, gbase, voff) do { _Pragma("unroll") for (int _i = 0; _i < 2; ++_i) \
        __builtin_amdgcn_global_load_lds((const unsigned*)((const char*)(gbase) + (voff)[_i]), (PG8_LAS unsigned*)(lds + (bufoff) + ldsw + _i * 8192), 16, 0, 0); } while (0)
#define PG8_LDA(dst, b, h) do { _Pragma("unroll") for (int m = 0; m < 4; ++m) _Pragma("unroll") for (int k = 0; k < 2; ++k) dst[m][k] = *(const PG8_LAS bf16x8*)(lds + PG8_SA(b, h) + aoff + m * 2048 + k * 1024); } while (0)
#define PG8_LDB(dst, b, h) do { _Pragma("unroll") for (int n = 0; n < 2; ++n) _Pragma("unroll") for (int k = 0; k < 2; ++k) dst[n][k] = *(const PG8_LAS bf16x8*)(lds + PG8_SB(b, h) + boff + n * 2048 + k * 1024); } while (0)
#define PG8_MMA(ai, bj, At, Bt) do { __builtin_amdgcn_s_setprio(1); _Pragma("unroll") for (int m = 0; m < 4; ++m) _Pragma("unroll") for (int n = 0; n < 2; ++n) _Pragma("unroll") for (int k = 0; k < 2; ++k) \
        acc[ai][bj][m][n] = __builtin_amdgcn_mfma_f32_16x16x32_bf16(Bt[n][k], At[m][k], acc[ai][bj][m][n], 0, 0, 0); __builtin_amdgcn_s_setprio(0); } while (0)
#define PG8_WAIT_V(n) asm volatile("s_waitcnt vmcnt(" #n ")" ::: "memory")
#define PG8_WAIT_L(n) asm volatile("s_waitcnt lgkmcnt(" #n ")" ::: "memory")
#define PG8_BAR __builtin_amdgcn_s_barrier()
#define PG8_SCHED __builtin_amdgcn_sched_barrier(0)
    Unit cur, nxt; int ui = 0;
    if (!S.next(0, cur)) return;
    f32x4 acc[2][2][4][2];
#pragma unroll
    for (int a = 0; a < 2; ++a)
#pragma unroll
        for (int b = 0; b < 2; ++b)
#pragma unroll
            for (int m = 0; m < 4; ++m)
#pragma unroll
                for (int n = 0; n < 2; ++n) acc[a][b][m][n] = (f32x4){0.f, 0.f, 0.f, 0.f};
    bf16x8 At[4][2], B0[2][2], B1[2][2];
    const char* cA = (const char*)g.A + (size_t)cur.pm * tstep; const char* cB = (const char*)g.Bt + (size_t)cur.pn * tstep;
    S.a_ready(cur);
    if constexpr (SP2) {
        PG8_STAGE(PG8_SB(0, 0), cB, voffB); PG8_STAGE(PG8_SB(0, 1), cB + hstep, voffB); PG8_STAGE(PG8_SA(0, 0), cA, voffA); PG8_STAGE(PG8_SA(0, 1), cA + hstep, voffA);
        if (wr == 1) PG8_BAR;
        PG8_WAIT_V(2); PG8_BAR;
        PG8_STAGE(PG8_SB(1, 0), cB + kstep, voffB); PG8_STAGE(PG8_SA(1, 0), cA + kstep, voffA); PG8_STAGE(PG8_SB(1, 1), cB + hstep + kstep, voffB);
        PG8_WAIT_V(6); PG8_BAR;
    } else {
        PG8_STAGE(PG8_SB(0, 0), cB, voffB); PG8_STAGE(PG8_SA(0, 0), cA, voffA); PG8_STAGE(PG8_SB(0, 1), cB + hstep, voffB); PG8_STAGE(PG8_SA(0, 1), cA + hstep, voffA);
        if (wr == 1) PG8_BAR;
        PG8_WAIT_V(4); PG8_BAR;
        PG8_STAGE(PG8_SB(1, 0), cB + kstep, voffB); PG8_STAGE(PG8_SA(1, 0), cA + kstep, voffA); PG8_STAGE(PG8_SB(1, 1), cB + hstep + kstep, voffB);
        PG8_WAIT_V(6); PG8_BAR;
    }
    for (;;) {
        const bool has_next = S.next(ui + 1, nxt);
        const char* nA = has_next ? (const char*)g.A + (size_t)nxt.pm * tstep : cA; const char* nB = has_next ? (const char*)g.Bt + (size_t)nxt.pn * tstep : cB;
        for (int t = 0; t < nt; t += 2) {
            const bool last = (t == nt - 2);
            const char* a1 = cA + (size_t)(t + 1) * kstep;
            const char* a2 = last ? nA : cA + (size_t)(t + 2) * kstep; const char* b2 = last ? nB : cB + (size_t)(t + 2) * kstep;
            const char* a3 = a2 + kstep; const char* b3 = b2 + kstep;
            if (last && has_next) S.a_ready(nxt);
            if constexpr (SP2) {
            PG8_LDB(B0, 0, 0); PG8_LDB(B1, 0, 1); PG8_SCHED; PG8_LDA(At, 0, 0); PG8_STAGE(PG8_SA(1, 1), a1 + hstep, voffA);
            PG8_WAIT_V(8); PG8_WAIT_L(0); PG8_BAR; PG8_MMA(0, 0, At, B0); PG8_MMA(0, 1, At, B1); PG8_BAR; PG8_SCHED;
            PG8_LDA(At, 0, 1); PG8_STAGE(PG8_SB(0, 0), b2, voffB); PG8_STAGE(PG8_SB(0, 1), b2 + hstep, voffB); PG8_STAGE(PG8_SA(0, 0), a2, voffA);
            PG8_WAIT_V(8); PG8_WAIT_L(0); PG8_BAR; PG8_MMA(1, 0, At, B0); PG8_MMA(1, 1, At, B1); PG8_BAR; PG8_SCHED;
            PG8_LDB(B0, 1, 0); PG8_LDB(B1, 1, 1); PG8_SCHED; PG8_LDA(At, 1, 0); PG8_STAGE(PG8_SA(0, 1), a2 + hstep, voffA);
            PG8_WAIT_V(8); PG8_WAIT_L(0); PG8_BAR; PG8_MMA(0, 0, At, B0); PG8_MMA(0, 1, At, B1); PG8_BAR; PG8_SCHED;
            PG8_LDA(At, 1, 1); PG8_STAGE(PG8_SB(1, 0), b3, voffB); PG8_STAGE(PG8_SB(1, 1), b3 + hstep, voffB); PG8_STAGE(PG8_SA(1, 0), a3, voffA);
            PG8_WAIT_V(8); PG8_WAIT_L(0); PG8_BAR; PG8_MMA(1, 0, At, B0); PG8_MMA(1, 1, At, B1); PG8_BAR; PG8_SCHED;
            } else {
            PG8_LDB(B0, 0, 0); PG8_SCHED; PG8_LDA(At, 0, 0); PG8_STAGE(PG8_SA(1, 1), a1 + hstep, voffA);
            PG8_WAIT_L(8); PG8_BAR; PG8_WAIT_L(0); PG8_MMA(0, 0, At, B0); PG8_BAR; PG8_SCHED;
            PG8_LDB(B1, 0, 1); PG8_STAGE(PG8_SB(0, 0), b2, voffB);
            PG8_BAR; PG8_WAIT_L(0); PG8_MMA(0, 1, At, B1); PG8_BAR;
            PG8_LDA(At, 0, 1); PG8_STAGE(PG8_SA(0, 0), a2, voffA);
            PG8_BAR; PG8_WAIT_L(0); PG8_MMA(1, 0, At, B0); PG8_BAR; PG8_SCHED;
            PG8_STAGE(PG8_SB(0, 1), b2 + hstep, voffB);
            PG8_WAIT_V(6); PG8_BAR; PG8_MMA(1, 1, At, B1); PG8_BAR;
            PG8_LDB(B0, 1, 0); PG8_SCHED; PG8_LDA(At, 1, 0); PG8_STAGE(PG8_SA(0, 1), a2 + hstep, voffA);
            PG8_WAIT_L(8); PG8_BAR; PG8_WAIT_L(0); PG8_MMA(0, 0, At, B0); PG8_BAR; PG8_SCHED;
            PG8_LDB(B1, 1, 1); PG8_STAGE(PG8_SB(1, 0), b3, voffB);
            PG8_BAR; PG8_WAIT_L(0); PG8_MMA(0, 1, At, B1); PG8_BAR;
            PG8_LDA(At, 1, 1); PG8_STAGE(PG8_SA(1, 0), a3, voffA);
            PG8_BAR; PG8_WAIT_L(0); PG8_MMA(1, 0, At, B0); PG8_BAR; PG8_SCHED;
            PG8_STAGE(PG8_SB(1, 1), b3 + hstep, voffB);
            PG8_WAIT_V(6); PG8_BAR; PG8_MMA(1, 1, At, B1); PG8_BAR;
            }
        }
        if constexpr (ALIGN_EPI) { if (wr == 0) PG8_BAR; }
        if constexpr (!Epi::AFTER_DRAIN) { E(acc, cur, wr, wc, fr, fq); S.done(cur); }
        if (!has_next) break;
#pragma unroll
        for (int a = 0; a < 2; ++a)
#pragma unroll
            for (int b = 0; b < 2; ++b)
#pragma unroll
                for (int m = 0; m < 4; ++m)
#pragma unroll
                    for (int n = 0; n < 2; ++n) acc[a][b][m][n] = (f32x4){0.f, 0.f, 0.f, 0.f};
        cur = nxt; cA = nA; cB = nB; ++ui;
        if constexpr (ALIGN_EPI) { if (wr == 1) PG8_BAR; }
    }
    PG8_WAIT_V(0);
    if constexpr (!ALIGN_EPI) { if (wr == 0) PG8_BAR; }
    PG8_BAR;
    if constexpr (Epi::AFTER_DRAIN) { E.fused(acc, cur, wr, wc, fr, fq, lds, wid, lane); S.done(cur); }
#undef PG8_SA
#undef PG8_SB
#undef PG8_STAGE
#undef PG8_LDA
#undef PG8_LDB
#undef PG8_MMA
#undef PG8_WAIT_V
#undef PG8_WAIT_L
#undef PG8_BAR
#undef PG8_SCHED
}
}

#define DI __device__ __forceinline__
#define LAS __attribute__((address_space(3)))
typedef unsigned short bf16_t;
typedef short bf16x8 __attribute__((ext_vector_type(8)));
typedef short s16x4 __attribute__((ext_vector_type(4)));
typedef short v4i16_t __attribute__((ext_vector_type(4)));
typedef float f32x4 __attribute__((ext_vector_type(4)));
typedef float f32x16 __attribute__((ext_vector_type(16)));
typedef unsigned u32x4 __attribute__((ext_vector_type(4)));
typedef unsigned u32x2 __attribute__((ext_vector_type(2)));
typedef float f32x2_t __attribute__((ext_vector_type(2)));
typedef __bf16 bf16x2_t __attribute__((ext_vector_type(2)));

constexpr int NWAVES = 8, NTHREADS = 512;
constexpr int SEQ = 8192, DMODEL = 1024, NMETA = 16, LTOK = SEQ + NMETA  , LP = 8256  , NCHUNK = 129;
constexpr int MTOK = 2 * SEQ;
constexpr int MROWS = 16640;
constexpr int NPROJ = 3840;
constexpr int NKT = 129;
constexpr float EPS = 1e-6f;
constexpr float C2Q = 0.125f * 1.4426950408889634f;
constexpr int XS_ROWS = 41216;

constexpr size_t MiB = 1u << 20;
constexpr size_t WS_CTL = 0, CTL_BYTES = 1 * MiB;
constexpr size_t WS_RS1 = 1 * MiB;
constexpr size_t WS_RS2 = WS_RS1 + 128 * 1024;
constexpr size_t WS_TOKE = WS_RS2 + 128 * 1024;
constexpr size_t WS_TOKW = WS_TOKE + 128 * 1024;
constexpr size_t WS_TOKP = WS_TOKW + 128 * 1024;
constexpr size_t WS_SLOTW = WS_TOKP + 128 * 1024;
constexpr size_t WS_WR = WS_SLOTW + 192 * 1024;
constexpr size_t WS_GL = WS_WR + 160 * 1024;
constexpr size_t WS_COS = 2 * MiB;
constexpr size_t WS_SIN = WS_COS + 1280 * 1024;
constexpr size_t WS_GB = WS_SIN + 1280 * 1024;
constexpr size_t WS_WOUT = 6 * MiB;
constexpr size_t WS_WINT = 8 * MiB;
constexpr size_t WS_XB = WS_WINT + (size_t)NPROJ * 1024 * 2;
constexpr size_t WS_MIX = 8 * MiB;
constexpr size_t WS_QKVB = 48 * MiB;
constexpr size_t WS_QB = WS_QKVB + (size_t)2 * LP * 1536 * 2 + 128 * 1024;
constexpr size_t WS_KT = WS_QB + 16 * MiB;
constexpr size_t WS_VT = WS_KT + (size_t)16 * NKT * 4096 * 2;
constexpr size_t WS_ZB = WS_VT + (size_t)8 * NKT * 8192 * 2;
constexpr size_t WS_GP = WS_ZB + (size_t)2 * LP * 512 * 2;
constexpr size_t GP_ARR = (size_t)2064 * 4096 * 2;
constexpr size_t WS_GP_END = WS_GP + 5 * GP_ARR;
constexpr size_t WS_WGU = 48 * MiB;
constexpr size_t WS_WD = 80 * MiB;
constexpr size_t WS_XS = 96 * MiB;
constexpr size_t WS_YO = 96 * MiB;
constexpr size_t WS_YS = WS_XS + (size_t)XS_ROWS * 1024 * 2;
constexpr size_t WS_END = 256 * MiB;
static_assert(WS_GB + (size_t)2 * LP * 16 * 4 <= WS_WOUT, "small region");
static_assert(WS_XB + (size_t)MROWS * 1024 * 2 <= WS_QKVB, "XB");
static_assert(WS_GP_END <= WS_END, "GDN prep arrays");
static_assert(WS_YS + (size_t)XS_ROWS * 256 * 2 <= WS_END, "YS");
static_assert(WS_WD + (size_t)32 * 1024 * 256 * 2 <= WS_XS, "WD");
constexpr int CW_ATTQ = 0;
constexpr int CW_CNT = 64;
constexpr int CW_BAR = 4096;

constexpr int LDS_BYTES = 147456;

struct Params { const float* in[23]; float* out; unsigned char* ws; };

DI unsigned f2bf(float f) { unsigned u = __float_as_uint(f); return (u + 0x7fffu + ((u >> 16) & 1u)) >> 16; }
DI unsigned pk2(float lo, float hi) { f32x2_t v = {lo, hi}; bf16x2_t b = __builtin_convertvector(v, bf16x2_t); return __builtin_bit_cast(unsigned, b); }
DI float bf2f(unsigned short h) { return __uint_as_float(((unsigned)h) << 16); }
DI float rlane(float v, int l) { return __int_as_float(__builtin_amdgcn_readlane(__float_as_int(v), l)); }
#define DPP_ADD(v, ctrl) ((v) + __int_as_float(__builtin_amdgcn_update_dpp(0, __float_as_int(v), (ctrl), 0xF, 0xF, true)))
DI float wave_sum_dpp(float v) {
    v = DPP_ADD(v, 0xB1);
    v = DPP_ADD(v, 0x4E);
    v = DPP_ADD(v, 0x141);
    v = DPP_ADD(v, 0x140);
    return (rlane(v, 0) + rlane(v, 16)) + (rlane(v, 32) + rlane(v, 48));
}
DI float wave_sum(float v) { return wave_sum_dpp(v); }
DI float swz_xor16(float v) { return __int_as_float(__builtin_amdgcn_ds_swizzle(__float_as_int(v), 0x401F)); }
DI float row_sum16(float v) { v = DPP_ADD(v, 0xB1); v = DPP_ADD(v, 0x4E); v = DPP_ADD(v, 0x141); v = DPP_ADD(v, 0x140); return v; }
DI float half_sum32(float v) { v = row_sum16(v); return v + swz_xor16(v); }
DI float swap32_add(float v) { auto rr = __builtin_amdgcn_permlane32_swap(__float_as_uint(v), __float_as_uint(v), false, false); return __uint_as_float(rr[0]) + __uint_as_float(rr[1]); }
DI float swap32_max(float v) { auto rr = __builtin_amdgcn_permlane32_swap(__float_as_uint(v), __float_as_uint(v), false, false); return fmaxf(__uint_as_float(rr[0]), __uint_as_float(rr[1])); }
#define LDS_WAIT() asm volatile("s_waitcnt lgkmcnt(0)" ::: "memory")
#define BAR_LDS() do { asm volatile("s_waitcnt lgkmcnt(0)" ::: "memory"); __builtin_amdgcn_s_barrier(); asm volatile("" ::: "memory"); } while (0)
#define MFMA32(a, b, c) __builtin_amdgcn_mfma_f32_32x32x16_bf16((a), (b), (c), 0, 0, 0)
DI int crow(int r, int hi) { return (r & 3) + 8 * (r >> 2) + 4 * hi; }
DI int perm16(int x) { return (x & ~12) | ((x & 4) << 1) | ((x & 8) >> 1); }
DI bf16x8 pack8(const f32x16& x, int s) {
    u32x4 p; p.x = pk2(x[8 * s], x[8 * s + 1]); p.y = pk2(x[8 * s + 2], x[8 * s + 3]); p.z = pk2(x[8 * s + 4], x[8 * s + 5]); p.w = pk2(x[8 * s + 6], x[8 * s + 7]);
    return __builtin_bit_cast(bf16x8, p);
}
DI int orig_col(int n) {
    if (n >= 1024) return n;
    const int hh = n >> 6, c2 = n & 63, g8 = c2 >> 3, i = c2 & 7;
    return (hh << 6) + ((i < 4) ? 4 * g8 + i : 32 + 4 * g8 + (i - 4));
}
DI size_t kt_off(int b, int hh, int p, int d) {
    const int tile = p < 16 ? 0 : 1 + ((p - 16) >> 6), kv = p < 16 ? p : ((p - 16) & 63);
    return ((size_t)((b * 8 + hh) * NKT + tile) << 12) + ((d >> 3) << 9) + (kv << 3) + (d & 7);
}
DI size_t vt_off(int b, int h, int p, int d) {
    const int tile = p < 16 ? 0 : 1 + ((p - 16) >> 6), kv = p < 16 ? p : ((p - 16) & 63);
    return ((size_t)((b * 4 + h) * NKT + tile) << 13) + ((d >> 5) << 11) + ((kv >> 4) << 9) + ((kv & 15) << 5) + (d & 31);
}

template <class Src> DI void transpose_item(const Src& src, bf16_t* WT, size_t ldk, int k0, int n0, LAS float* scr, int lane) {
    float v[32];
#pragma unroll
    for (int i = 0; i < 32; ++i) v[i] = src(k0 + 2 * i + (lane >> 5), n0 + (lane & 31));
#pragma unroll
    for (int i = 0; i < 32; ++i) scr[(2 * i + (lane >> 5)) * 33 + (lane & 31)] = v[i];
    LDS_WAIT();
    const int c = lane & 7;
#pragma unroll
    for (int j = 0; j < 4; ++j) { const int n = (lane >> 3) + 8 * j; const LAS float* s = scr + (8 * c) * 33 + n;
        u32x4 o; o.x = pk2(s[0 * 33], s[1 * 33]); o.y = pk2(s[2 * 33], s[3 * 33]); o.z = pk2(s[4 * 33], s[5 * 33]); o.w = pk2(s[6 * 33], s[7 * 33]);
        *(u32x4*)(WT + (size_t)(n0 + n) * ldk + k0 + 8 * c) = o; }
    LDS_WAIT();
}
struct SrcWin { const float* w; const float* g; DI float operator()(int k, int n) const { return n >= 3600 ? 0.f : w[(size_t)k * 3600 + orig_col(n)] * g[k]; } };
struct SrcPlain { const float* w; int N; DI float operator()(int k, int n) const { return w[(size_t)k * N + n]; } };
struct SrcGU { const float* w; const float* g; int fadj; DI float operator()(int k, int n) const { return w[(size_t)k * 256 + n + fadj] * g[k]; } };

DI void phase0(const Params& P, LAS unsigned char* lds, int gw, int NGW, int gtid, int NGT, int wave, int lane) {
    LAS float* scr = (LAS float*)(lds + wave * 16384);
    bf16_t* WINT = (bf16_t*)(P.ws + WS_WINT); bf16_t* WOUT = (bf16_t*)(P.ws + WS_WOUT); bf16_t* XB = (bf16_t*)(P.ws + WS_XB);
    float* RS1 = (float*)(P.ws + WS_RS1);
    constexpr int I_IN = 16 * (NPROJ / 32), I_OUT = 16 * 32;
    const SrcWin sw{P.in[3], P.in[2]}; const SrcPlain so{P.in[13], 1024};
    for (int it = gw; it < I_IN + I_OUT; it += NGW) {
        if (it < I_IN) transpose_item(sw, WINT, 1024, (it / (NPROJ / 32)) * 64, (it % (NPROJ / 32)) * 32, scr, lane);
        else { const int r = it - I_IN; transpose_item(so, WOUT, 1024, (r >> 5) * 64, (r & 31) * 32, scr, lane); }
    }
    const float* x = P.in[0]; const float* meta = P.in[1];
    for (int m0 = gw; m0 < MROWS; m0 += 4 * NGW) {
        f32x4 v[4][4];
#pragma unroll
        for (int r = 0; r < 4; ++r) { const int m = m0 + r * NGW;
            const bool real = m < MTOK + NMETA;
            const f32x4* xr = (const f32x4*)((m < MTOK) ? x + (size_t)m * 1024 : meta + (size_t)((real ? m : MTOK) - MTOK) * 1024);
#pragma unroll
            for (int j = 0; j < 4; ++j) v[r][j] = (m < MROWS) ? xr[64 * j + lane] : (f32x4){0.f, 0.f, 0.f, 0.f}; }
#pragma unroll
        for (int r = 0; r < 4; ++r) { const int m = m0 + r * NGW;
            if (m < MROWS) {
                const bool real = m < MTOK + NMETA;
                float s = 0.f;
#pragma unroll
                for (int j = 0; j < 4; ++j) { if (!real) v[r][j] = (f32x4){0.f, 0.f, 0.f, 0.f}; s += (v[r][j].x * v[r][j].x + v[r][j].y * v[r][j].y) + (v[r][j].z * v[r][j].z + v[r][j].w * v[r][j].w); }
                s = wave_sum(s);
                if (lane == 0) RS1[m] = real ? __builtin_amdgcn_rsqf(s * (1.0f / 1024.0f) + EPS) : 0.f;
                u32x2* orow = (u32x2*)(XB + (size_t)m * 1024);
#pragma unroll
                for (int j = 0; j < 4; ++j) orow[64 * j + lane] = (u32x2){pk2(v[r][j].x, v[r][j].y), pk2(v[r][j].z, v[r][j].w)};
            } }
    }
    float* COS = (float*)(P.ws + WS_COS); float* SIN = (float*)(P.ws + WS_SIN);
    for (int i = gtid; i < LTOK * 32; i += NGT) {
        const int p = i >> 5, f = i & 31;
        const double rev = (double)p * exp2(-(double)f * (13.287712379549449 / 32.0)) * 0.15915494309189535;
        const float fr = (float)(rev - floor(rev));
        COS[i] = __builtin_amdgcn_cosf(fr); SIN[i] = __builtin_amdgcn_sinf(fr);
    }
    float* WR = (float*)(P.ws + WS_WR); const float* gf = P.in[14]; const float* wgrp = P.in[15]; const float* wrt = P.in[17];
    for (int i = gtid; i < 36 * 1024; i += NGT) { const int j = i >> 10, k = i & 1023; WR[i] = gf[k] * (j < 4 ? wgrp[k * 4 + j] : wrt[k * 32 + (j - 4)]); }
}

struct EpiInProj {
    static constexpr bool PERM = true, AFTER_DRAIN = false;
    const float* RS1; const float* COS; const float* SIN; const float* a_log; const float* dt_bias;
    bf16_t* QB; bf16_t* KT; bf16_t* VT; bf16_t* QKVB; bf16_t* ZB; float* GB;
    DI void operator()(const pg8::f32x4 (&acc)[2][2][4][2], const pg8::Unit& u, int wr, int wc, int fr, int fq) const {
        const int pn = u.pn;
#pragma unroll
        for (int ai = 0; ai < 2; ++ai)
#pragma unroll
            for (int m = 0; m < 4; ++m) {
                const int row = u.pm * 256 + ai * 128 + wr * 64 + m * 16 + fr;
                if (row < MTOK + NMETA) {
                    const float rs = RS1[row];
                    const bool meta = row >= MTOK;
                    const int p = meta ? row - MTOK : (row & 8191) + NMETA;
                    const int b0 = meta ? 0 : (row >> 13), nb = meta ? 2 : 1;
#pragma unroll
                    for (int bj = 0; bj < 2; ++bj) {
                        float xv[8];
#pragma unroll
                        for (int i = 0; i < 4; ++i) { xv[i] = acc[ai][bj][m][0][i] * rs; xv[4 + i] = acc[ai][bj][m][1][i] * rs; }
                        if (pn < 4) {
                            const int hh = (pn & 1) * 4 + bj * 2 + (wc >> 1), d0 = 4 * (4 * (wc & 1) + fq);
                            const f32x4 cs = *(const f32x4*)(COS + p * 32 + d0), sn = *(const f32x4*)(SIN + p * 32 + d0);
                            float lo[4], hi[4];
#pragma unroll
                            for (int i = 0; i < 4; ++i) { lo[i] = xv[i] * cs[i] - xv[4 + i] * sn[i]; hi[i] = xv[4 + i] * cs[i] + xv[i] * sn[i]; }
                            if (pn < 2) {
                                if (!meta) {
                                    bf16_t* q = QB + ((size_t)((b0 * 8 + hh) * SEQ + (p - NMETA)) << 6) + d0;
                                    *(u32x2*)q = (u32x2){pk2(lo[0] * C2Q, lo[1] * C2Q), pk2(lo[2] * C2Q, lo[3] * C2Q)};
                                    *(u32x2*)(q + 32) = (u32x2){pk2(hi[0] * C2Q, hi[1] * C2Q), pk2(hi[2] * C2Q, hi[3] * C2Q)};
                                }
                            } else {
                                for (int bb = b0; bb < b0 + nb; ++bb) {
                                    *(u32x2*)(KT + kt_off(bb, hh, p, d0)) = (u32x2){pk2(lo[0], lo[1]), pk2(lo[2], lo[3])};
                                    *(u32x2*)(KT + kt_off(bb, hh, p, d0 + 32)) = (u32x2){pk2(hi[0], hi[1]), pk2(hi[2], hi[3])};
                                }
                            }
                        } else {
                            const u32x4 w = (u32x4){pk2(xv[0], xv[1]), pk2(xv[2], xv[3]), pk2(xv[4], xv[5]), pk2(xv[6], xv[7])};
                            const int cl = bj * 128 + wc * 32 + fq * 8;
                            if (pn < 6) {
                                const int h = (pn - 4) * 2 + bj, d = wc * 32 + fq * 8;
                                for (int bb = b0; bb < b0 + nb; ++bb) *(u32x4*)(VT + vt_off(bb, h, p, d)) = w;
                            } else if (pn < 12) {
                                for (int bb = b0; bb < b0 + nb; ++bb) *(u32x4*)(QKVB + (size_t)(bb * LP + p) * 1536 + (pn - 6) * 256 + cl) = w;
                            } else if (pn < 14) {
                                float sz[8];
#pragma unroll
                                for (int i = 0; i < 8; ++i) sz[i] = xv[i] * __builtin_amdgcn_rcpf(1.0f + __expf(-xv[i]));
                                const u32x4 wz = (u32x4){pk2(sz[0], sz[1]), pk2(sz[2], sz[3]), pk2(sz[4], sz[5]), pk2(sz[6], sz[7])};
                                for (int bb = b0; bb < b0 + nb; ++bb) *(u32x4*)(ZB + (size_t)(bb * LP + p) * 512 + (pn - 12) * 256 + cl) = wz;
                            } else if (cl < 16) {
                                float o[8];
                                if (cl == 0) {
#pragma unroll
                                    for (int i = 0; i < 8; ++i) { const float t = xv[i] + dt_bias[i]; const float sp = t > 20.f ? t : log1pf(expf(t)); o[i] = -expf(a_log[i]) * sp; }
                                } else {
#pragma unroll
                                    for (int i = 0; i < 8; ++i) o[i] = 1.0f / (1.0f + expf(-xv[i]));
                                }
                                for (int bb = b0; bb < b0 + nb; ++bb) { float* g = GB + ((size_t)(bb * LP + p) << 4) + cl;
                                    *(f32x4*)g = (f32x4){o[0], o[1], o[2], o[3]}; *(f32x4*)(g + 4) = (f32x4){o[4], o[5], o[6], o[7]}; }
                            }
                        }
                    }
                }
            }
    }
};

DI bf16x8 lds_frag(LAS const bf16_t* M, int row, int ch) { return *(LAS const bf16x8*)((LAS const unsigned char*)M + row * 128 + ((ch ^ (row & 7)) << 4)); }
DI s16x4 tr_read_b64(LAS const unsigned char* p) { return __builtin_bit_cast(s16x4, __builtin_amdgcn_ds_read_tr16_b64_v4i16((LAS v4i16_t*)p)); }
DI bf16x8 lds_frag_plain(LAS const bf16_t* M, int row, int ch) { return *(LAS const bf16x8*)((LAS const unsigned char*)M + row * 128 + (ch << 4)); }
DI int swz_idx(int row, int d) { return row * 64 + ((((d >> 3) ^ (row & 7)) << 3) | (d & 7)); }

constexpr int PREP_PAIR = 35840;

template <int MAT> DI void prep_rows(const bf16_t* QKVB, const float* cw, int b, int h, int n, int lane, LAS const float* egS,
                                     LAS bf16_t* DS  , bf16_t* QG) {
    const int colb = MAT * 512 + h * 64, col = colb + lane, p0 = n * 64;
    const float c0 = cw[col], c1 = cw[1536 + col], c2 = cw[3072 + col], c3 = cw[4608 + col];
    const bf16_t* blk = QKVB + (size_t)(b * LP + p0) * 1536 + colb;
    float x0 = 0.f, x1 = 0.f, x2 = 0.f;
    if (n > 0) { x0 = bf2f(blk[lane - 3 * 1536]); x1 = bf2f(blk[lane - 2 * 1536]); x2 = bf2f(blk[lane - 1 * 1536]); }
    u32x4 stg[8];
#pragma unroll
    for (int i = 0; i < 8; ++i) stg[i] = *(const u32x4*)(blk + (size_t)(8 * i + (lane >> 3)) * 1536 + (lane & 7) * 8);
#pragma unroll
    for (int i = 0; i < 8; ++i) *(LAS u32x4*)(DS + (8 * i + (lane >> 3)) * 64 + (lane & 7) * 8) = stg[i];
    LDS_WAIT();
    const int nvalid = (LTOK - p0) < 64 ? (LTOK - p0) : 64;
#pragma unroll 4
    for (int c = 0; c < 64; ++c) {
        if (c >= nvalid) { DS[c * 64 + lane] = 0; if (MAT == 0) QG[c * 64 + perm16(lane)] = 0; continue; }
        const bool valid = true;
        const float x3 = bf2f(DS[c * 64 + lane]);
        float y = c0 * x0 + c1 * x1 + c2 * x2 + c3 * x3;
        y = y * __builtin_amdgcn_rcpf(1.0f + __expf(-y));
        if (!valid) y = 0.f;
        x0 = x1; x1 = x2; x2 = x3;
        if (MAT == 2) { DS[c * 64 + lane] = (bf16_t)f2bf(y * egS[c]); }
        else {
            const float ss = wave_sum(y * y);
            const float yn = y * __builtin_amdgcn_rsqf(ss + EPS);
            if (MAT == 0) {
                const float qn = yn * 0.125f;
                DS[c * 64 + lane] = (bf16_t)f2bf(qn);
                QG[c * 64 + perm16(lane)] = (bf16_t)f2bf(qn * egS[c]);
            } else {
                DS[c * 64 + lane] = (bf16_t)f2bf(yn);
            }
        }
    }
}

DI void gdn_tinv(LAS const float* AST, LAS bf16_t* TS, int lane) {
    const int hb = lane >> 5, j = lane & 31, r32 = j, hi = hb;
    LAS const float* Ab = AST + (32 * hb) * 68 + 32 * hb;
    float x[32];
#pragma unroll
    for (int r = 0; r < 32; ++r) x[r] = (r == j) ? 1.0f : 0.0f;
#pragma unroll
    for (int jj = 0; jj < 31; ++jj) {
        const float xj = x[jj];
        LAS const float* ap = Ab + jj * 68;
#pragma unroll
        for (int r4 = (jj + 1) / 4; r4 < 8; ++r4) {
            const f32x4 a = *(LAS const f32x4*)(ap + 4 * r4);
#pragma unroll
            for (int e = 0; e < 4; ++e) if (4 * r4 + e > jj) x[4 * r4 + e] -= a[e] * xj;
        }
    }
    bf16x8 a21[2];
#pragma unroll
    for (int s = 0; s < 2; ++s) { float t[8];
#pragma unroll
        for (int jj = 0; jj < 8; ++jj) t[jj] = AST[(16 * s + 8 * hi + jj) * 68 + 32 + r32];
        const u32x4 p = (u32x4){pk2(t[0], t[1]), pk2(t[2], t[3]), pk2(t[4], t[5]), pk2(t[6], t[7])}; a21[s] = __builtin_bit_cast(bf16x8, p); }
    f32x16 M = {};
#pragma unroll
    for (int s = 0; s < 2; ++s) { float t[8];
#pragma unroll
        for (int jj = 0; jj < 8; ++jj) {
            const auto rr = __builtin_amdgcn_permlane32_swap(__float_as_uint(x[16 * s + 8 + jj]), __float_as_uint(x[16 * s + 8 + jj]), false, false);
            t[jj] = hi ? __uint_as_float(rr[0]) : x[16 * s + jj];
        }
        const u32x4 p = (u32x4){pk2(t[0], t[1]), pk2(t[2], t[3]), pk2(t[4], t[5]), pk2(t[6], t[7])};
        M = MFMA32(a21[s], __builtin_bit_cast(bf16x8, p), M);
    }
    asm volatile("s_waitcnt lgkmcnt(0)" ::: "memory");
#pragma unroll
    for (int i = 0; i < 32; ++i) TS[(32 * hb + i) * 64 + 32 * hb + j] = (bf16_t)f2bf(x[i]);
    asm volatile("s_waitcnt lgkmcnt(0)" ::: "memory");
    f32x16 T21 = {};
#pragma unroll
    for (int s = 0; s < 2; ++s) {
        const u32x2 lo = *(LAS const u32x2*)(TS + (32 + r32) * 64 + 32 + 16 * s + 4 * hi), hi8 = *(LAS const u32x2*)(TS + (32 + r32) * 64 + 32 + 16 * s + 8 + 4 * hi);
        const u32x4 p = (u32x4){lo.x, lo.y, hi8.x, hi8.y};
        T21 = MFMA32(__builtin_bit_cast(bf16x8, p), pack8(M, s), T21);
    }
#pragma unroll
    for (int i = 0; i < 16; ++i) TS[(32 + crow(i, hi)) * 64 + r32] = (bf16_t)f2bf(-T21[i]);
    asm volatile("s_waitcnt lgkmcnt(0)" ::: "memory");
}

template <bool PERM> DI void gdn_tmul(LAS const bf16_t* TS, LAS const bf16_t* RS, int lane, float sgn, bf16_t* out) {
    const int r32 = lane & 31, hi = lane >> 5;
    LAS const unsigned char* rb = (LAS const unsigned char*)RS + ((8 * hi + ((lane & 15) >> 2)) * 64 + 16 * ((lane >> 4) & 1) + 4 * (lane & 3)) * 2;
#pragma unroll
    for (int ct = 0; ct < 2; ++ct)
#pragma unroll
        for (int cb = 0; cb < 2; ++cb) {
            f32x16 acc = {};
#pragma unroll
            for (int ks = 0; ks < (ct == 0 ? 2 : 4); ++ks) {
                const bf16x8 fa = lds_frag_plain(TS, 32 * ct + r32, 2 * ks + hi);
                const s16x4 lo = tr_read_b64(rb + (16 * ks * 64 + 32 * cb) * 2), h4 = tr_read_b64(rb + ((16 * ks + 4) * 64 + 32 * cb) * 2);
                const bf16x8 fb = (bf16x8){lo[0], lo[1], lo[2], lo[3], h4[0], h4[1], h4[2], h4[3]};
                acc = MFMA32(fa, fb, acc);
            }
            bf16_t* ob = out + hi * 256 + (PERM ? perm16(32 * cb + r32) : 32 * cb + r32);
            asm volatile("" : "+v"(ob));
#pragma unroll
            for (int i = 0; i < 16; ++i) ob[(32 * ct + (i & 3) + 8 * (i >> 2)) * 64] = (bf16_t)f2bf(sgn * acc[i]);
        }
}

DI void gdn_prep_phase(const Params& P, LAS unsigned char* lds, int blk, int G, int wave, int lane_in) {
    const int pair = wave >> 1, role = wave & 1;
    LAS unsigned char* pb = lds + pair * PREP_PAIR;
    LAS bf16_t* QS = (LAS bf16_t*)pb; LAS bf16_t* KS = (LAS bf16_t*)(pb + 8192); LAS float* AS = (LAS float*)(pb + 16384);
    LAS float* gcS = (LAS float*)(pb + 16384 + 17408 + role * 1024); LAS float* betaS = gcS + 64; LAS float* egS = gcS + 128; LAS float* ekS = gcS + 192;
    const bf16_t* QKVB = (const bf16_t*)(P.ws + WS_QKVB); const float* GB = (const float*)(P.ws + WS_GB); const float* cw = P.in[9];
    const int NP = G * 4, NTASK = 2 * 8 * NCHUNK;
    for (int it = 0; it * NP < NTASK; ++it) {
        int lane = lane_in; asm volatile("" : "+v"(lane));
        const int r32 = lane & 31, hi = lane >> 5;
        const int task = it * NP + blk * 4 + pair;
        const bool active = task < NTASK;
        const int bh = task < 2048 ? (task >> 7) : (task - 2048), n = task < 2048 ? (task & 127) : 128, b = bh >> 3, h = bh & 7;
        const int sidx = bh * NCHUNK + n;
        bf16_t* GPW = (bf16_t*)(P.ws + WS_GP) + (size_t)sidx * 4096; bf16_t* GPQG = GPW + GP_ARR / 2; bf16_t* GPAQK = GPQG + GP_ARR / 2; bf16_t* GPKGT = GPAQK + GP_ARR / 2; bf16_t* GPU = GPKGT + GP_ARR / 2;
        float gc = 0.f, beta = 0.f;
        if (active) {
            const int pl = n * 64 + lane;
            float g = 0.f;
            if (pl < LTOK) { const float* gb = GB + ((size_t)(b * LP + pl) << 4); g = gb[h]; beta = gb[8 + h]; }
            gcS[lane] = g; LDS_WAIT();
            gc = 0.f;
#pragma unroll
            for (int j4 = 0; j4 < 16; ++j4) { const f32x4 t = *(LAS const f32x4*)(gcS + 4 * j4);
                gc += (4 * j4 <= lane ? t[0] : 0.f) + (4 * j4 + 1 <= lane ? t[1] : 0.f) + (4 * j4 + 2 <= lane ? t[2] : 0.f) + (4 * j4 + 3 <= lane ? t[3] : 0.f); }
            const float glast = rlane(gc, 63);
            LDS_WAIT();
            gcS[lane] = gc; betaS[lane] = beta; egS[lane] = (role == 0) ? __expf(gc) : beta * __expf(gc); ekS[lane] = __expf(glast - gc);
            if (role == 0 && lane == 0) ((float*)(P.ws + WS_GL))[sidx] = __expf(glast);
            LDS_WAIT();
            if (role == 0) prep_rows<0>(QKVB, cw, b, h, n, lane, egS, QS, GPQG);
            else prep_rows<1>(QKVB, cw, b, h, n, lane, egS, KS, GPQG);
        }
        LDS_WAIT();
        __syncthreads();
        if (active) {
#pragma unroll
            for (int t4 = 0; t4 < 4; ++t4) {
                const int ct = t4 >> 1, st = t4 & 1;
                f32x16 acc = {};
                if (!(ct == 0 && st == 1)) {
#pragma unroll
                    for (int ks = 0; ks < 4; ++ks) {
                        const bf16x8 fa = lds_frag_plain(role == 0 ? QS : KS, 32 * ct + r32, 2 * ks + hi), fb = lds_frag_plain(KS, 32 * st + r32, 2 * ks + hi);
                        acc = MFMA32(fa, fb, acc);
                    }
                }
                const float gcs = gcS[32 * st + r32];
                bf16_t* aqb = GPAQK + hi * 256 + perm16(r32); LAS float* asb = AS + r32 * 68 + hi * 4;        LAS const float* gcb = gcS + hi * 4; LAS const float* beb = betaS + hi * 4;
                asm volatile("" : "+v"(aqb), "+v"(asb), "+v"(gcb), "+v"(beb));
#pragma unroll
                for (int i = 0; i < 16; ++i) {
                    const int cr = 32 * ct + (i & 3) + 8 * (i >> 2);
                    const int cmp = (32 * st + r32) - 4 * hi;
                    const float dec = __expf(gcb[cr] - gcs);
                    if (role == 0) aqb[cr * 64 + 32 * st] = (bf16_t)f2bf((cmp <= cr) ? acc[i] * dec : 0.f);
                    else asb[32 * st * 68 + cr] = (cmp < cr) ? acc[i] * beb[cr] * dec : 0.f;
                }
            }
        }
        LDS_WAIT();
        __syncthreads();
        LAS bf16_t* TS = (LAS bf16_t*)((LAS unsigned char*)AS + 32 * 68 * 4);
        if (active) {
            if (role == 0) {
                prep_rows<2>(QKVB, cw, b, h, n, lane, betaS, QS  , GPQG);
            } else {
#pragma unroll
                for (int gq = 0; gq < 8; ++gq) {
                    float t[8];
#pragma unroll
                    for (int j = 0; j < 8; ++j) { const int c = perm16(8 * gq + j); t[j] = bf2f(KS[c * 64 + lane]) * ekS[c]; }
                    *(u32x4*)(GPKGT + lane * 64 + 8 * gq) = (u32x4){pk2(t[0], t[1]), pk2(t[2], t[3]), pk2(t[4], t[5]), pk2(t[6], t[7])};
                }
#pragma unroll 8
                for (int c = 0; c < 64; ++c) KS[c * 64 + lane] = (bf16_t)f2bf(bf2f(KS[c * 64 + lane]) * egS[c]);
                gdn_tinv(AS, TS, lane);
            }
        }
        LDS_WAIT();
        __syncthreads();
        if (active) {
            if (role == 0) gdn_tmul<false>(TS, QS, lane, 1.0f, GPU);
            else gdn_tmul<true>(TS, KS, lane, -1.0f, GPW);
        }
        LDS_WAIT();
    }
}

constexpr int GS_STAGE = 40960 + 256;
constexpr int GS_OBUF = 2 * GS_STAGE;
static_assert(GS_OBUF + 32768 <= 131072, "gdn scan LDS");

#define GS_STEP(n, HW, HGW, STGW) do { \
        if (wave < 2) { \
            if (n < NCHUNK) { \
                LAS const unsigned char* sg = lds + (n & 1) * GS_STAGE; \
                LAS const bf16_t* Wm = (LAS const bf16_t*)sg; LAS const bf16_t* QGm = (LAS const bf16_t*)(sg + 8192); LAS const bf16_t* AQm = (LAS const bf16_t*)(sg + 16384); \
                LAS const bf16_t* KGm = (LAS const bf16_t*)(sg + 24576); LAS const bf16_t* Um = (LAS const bf16_t*)(sg + 32768); \
                const float gl = *(LAS const float*)(sg + 40960); \
                bf16x8 Sb[2][2]; Sb[0][0] = pack8(S0, 0); Sb[0][1] = pack8(S0, 1); Sb[1][0] = pack8(S1, 0); Sb[1][1] = pack8(S1, 1); \
                f32x16 vn[2], o[2]; \
        _Pragma("unroll") \
                for (int ct = 0; ct < 2; ++ct) { \
                    f32x16 acc; \
        _Pragma("unroll") \
                    for (int i = 0; i < 16; ++i) acc[i] = bf2f(Um[(32 * ct + crow(i, hi)) * 64 + vbase + r32]); \
                    f32x16 oo = {}; \
        _Pragma("unroll") \
                    for (int kt = 0; kt < 2; ++kt) \
        _Pragma("unroll") \
                        for (int s2 = 0; s2 < 2; ++s2) { \
                            acc = MFMA32(lds_frag(Wm, 32 * ct + r32, (2 * kt + s2) * 2 + hi), Sb[kt][s2], acc); \
                            oo = MFMA32(lds_frag(QGm, 32 * ct + r32, (2 * kt + s2) * 2 + hi), Sb[kt][s2], oo); \
                        } \
                    vn[ct] = acc; o[ct] = oo; \
                } \
                bf16x8 Vb[2][2]; Vb[0][0] = pack8(vn[0], 0); Vb[0][1] = pack8(vn[0], 1); Vb[1][0] = pack8(vn[1], 0); Vb[1][1] = pack8(vn[1], 1); \
        _Pragma("unroll") \
                for (int i = 0; i < 16; ++i) { S0[i] *= gl; S1[i] *= gl; } \
        _Pragma("unroll") \
                for (int ct = 0; ct < 2; ++ct) \
        _Pragma("unroll") \
                    for (int s2 = 0; s2 < 2; ++s2) { \
                        const int ch = (2 * ct + s2) * 2 + hi; \
                        o[0] = MFMA32(lds_frag(AQm, r32, ch), Vb[ct][s2], o[0]); \
                        o[1] = MFMA32(lds_frag(AQm, 32 + r32, ch), Vb[ct][s2], o[1]); \
                        S0 = MFMA32(lds_frag(KGm, r32, ch), Vb[ct][s2], S0); \
                        S1 = MFMA32(lds_frag(KGm, 32 + r32, ch), Vb[ct][s2], S1); \
                    } \
                LAS float* ob = (LAS float*)(lds + GS_OBUF + (n & 1) * 16384); \
        _Pragma("unroll") \
                for (int ct = 0; ct < 2; ++ct) \
        _Pragma("unroll") \
                    for (int i = 0; i < 16; ++i) ob[(32 * ct + crow(i, hi)) * 64 + vbase + r32] = o[ct][i]; \
            } \
        } else if (wave < 4) { \
            if (n > 0) { \
                LAS const float* ob = (LAS const float*)(lds + GS_OBUF + ((n - 1) & 1) * 16384); \
                const f32x4 gn = *(const f32x4*)(gnorm + 4 * vq); \
        _Pragma("unroll") \
                for (int it = 0; it < 8; ++it) { \
                    const int c = (wave - 2) * 32 + 4 * it + rg, p = (n - 1) * 64 + c; \
                    const f32x4 v = *(LAS const f32x4*)(ob + c * 64 + 4 * vq); \
                    const float ss = row_sum16((v[0] * v[0] + v[1] * v[1]) + (v[2] * v[2] + v[3] * v[3])); \
                    const float rn = __builtin_amdgcn_rsqf(ss * (1.0f / 64.0f) + EPS); \
                    const u32x2 zz = zq[it]; \
                    const float z0 = __uint_as_float(zz.x << 16), z1 = __uint_as_float(zz.x & 0xffff0000u), z2 = __uint_as_float(zz.y << 16), z3 = __uint_as_float(zz.y & 0xffff0000u); \
                    const float y0 = v[0] * rn * gn[0] * z0, y1 = v[1] * rn * gn[1] * z1, y2 = v[2] * rn * gn[2] * z2, y3 = v[3] * rn * gn[3] * z3; \
                    if ((p >= NMETA) && (p < LTOK)) *(u32x2*)(MIX + (size_t)(b * SEQ + p - NMETA) * 1024 + 512 + h * 64 + 4 * vq) = (u32x2){pk2(y0, y1), pk2(y2, y3)}; \
                } \
            } \
            if (n < NCHUNK) { GS_ZLOAD(n); } \
        } else { \
            if (n + 1 < NCHUNK) { GS_WRITE(HW, HGW, STGW); if (n + 2 < NCHUNK) GS_ISSUE(HW, HGW, n + 2); } \
        } \
        BAR_LDS(); } while (0)
DI void gdn_scan(const Params& P, LAS unsigned char* lds, int bh, int tid, int wave, int lane) {
    const int b = bh >> 3, h = bh & 7, r32 = lane & 31, hi = lane >> 5;
    const int task0 = (b * 8 + h) * NCHUNK;
    const bf16_t* GP0 = (const bf16_t*)(P.ws + WS_GP);
    const float* GLg = (const float*)(P.ws + WS_GL);
    const bf16_t* ZB = (const bf16_t*)(P.ws + WS_ZB); bf16_t* MIX = (bf16_t*)(P.ws + WS_MIX); const float* gnorm = P.in[12];
    const int lt = tid - 256;
    u32x4 holdA[10]; float hglA = 0.f;
#define GS_ISSUE(H, HG, n_) do { _Pragma("unroll") for (int i = 0; i < 10; ++i) { const int a_ = i >> 1, e_ = lt + 256 * (i & 1); \
            H[i] = *(const u32x4*)(GP0 + (size_t)a_ * (GP_ARR / 2) + (size_t)(task0 + (n_)) * 4096 + e_ * 8); } \
        if (lt == 0) HG = GLg[task0 + (n_)]; } while (0)
#define GS_WRITE(H, HG, stg_) do { LAS unsigned char* sg_ = lds + (stg_) * GS_STAGE; \
        _Pragma("unroll") for (int i = 0; i < 10; ++i) { const int a_ = i >> 1, e_ = lt + 256 * (i & 1), row_ = e_ >> 3, ch_ = e_ & 7; \
            *(LAS u32x4*)(sg_ + a_ * 8192 + row_ * 128 + (((a_ < 4) ? (ch_ ^ (row_ & 7)) : ch_) << 4)) = H[i]; } \
        if (lt == 0) *(LAS float*)(sg_ + 40960) = HG; } while (0)
    const int vq = lane & 15, rg = lane >> 4;
    u32x2 zq[8];
#define GS_ZLOAD(n_) do { _Pragma("unroll") for (int it = 0; it < 8; ++it) { int p_ = (n_) * 64 + (wave - 2) * 32 + 4 * it + rg; p_ = p_ < LTOK ? p_ : LTOK - 1; \
            zq[it] = *(const u32x2*)(ZB + (size_t)(b * LP + p_) * 512 + h * 64 + 4 * vq); } } while (0)
    if (wave >= 4) { GS_ISSUE(holdA, hglA, 0); GS_WRITE(holdA, hglA, 0); GS_ISSUE(holdA, hglA, 1); }
    if (wave == 2 || wave == 3) { GS_ZLOAD(0); }
    __syncthreads();
    f32x16 S0 = {}, S1 = {};
    const int vbase = 32 * wave;
    for (int n2 = 0; n2 <= NCHUNK; n2 += 2) { GS_STEP((n2), holdA, hglA, 1); GS_STEP((n2 + 1), holdA, hglA, 0); }
}

constexpr int AT_STAGE = 32768;
constexpr int AT_XBUF = 2 * AT_STAGE;
constexpr int AT_WSF = AT_XBUF + 65536;
constexpr int AT_UNIT = AT_WSF + 2048;
constexpr float AT_THR = 8.0f;

DI s16x4 tr_read(LAS const unsigned char* p) { return __builtin_bit_cast(s16x4, __builtin_amdgcn_ds_read_tr16_b64_v4i16((LAS v4i16_t*)p)); }

DI void attn_unit(const Params& P, LAS unsigned char* lds, int bh, int qi, int tid, int wave, int lane, float lam) {
    const int b = bh >> 2, h = bh & 3, r32 = lane & 31, hi = lane >> 5, qsub = wave >> 1, map = wave & 1, hh = 2 * h + map;
    const bf16_t* QB = (const bf16_t*)(P.ws + WS_QB); const bf16_t* KT = (const bf16_t*)(P.ws + WS_KT); const bf16_t* VT = (const bf16_t*)(P.ws + WS_VT);
    const int ntiles = 2 * qi + 3, my_nt = (qsub < 2) ? ntiles - 1 : ntiles;
    const bf16_t* k1 = KT + ((size_t)((b * 8 + 2 * h) * NKT) << 12) + tid * 8;
    const bf16_t* k2 = KT + ((size_t)((b * 8 + 2 * h + 1) * NKT) << 12) + tid * 8;
    const bf16_t* vv = VT + ((size_t)((b * 4 + h) * NKT) << 13) + tid * 8;
    u32x4 st[4];
#define AT_LOAD(t) do { st[0] = *(const u32x4*)(k1 + ((size_t)(t) << 12)); st[1] = *(const u32x4*)(k2 + ((size_t)(t) << 12)); \
                        st[2] = *(const u32x4*)(vv + ((size_t)(t) << 13)); st[3] = *(const u32x4*)(vv + ((size_t)(t) << 13) + 4096); } while (0)
#define AT_STORE(sb) do { LAS unsigned char* d_ = lds + (sb) * AT_STAGE + tid * 16; *(LAS u32x4*)d_ = st[0]; *(LAS u32x4*)(d_ + 8192) = st[1]; \
                          *(LAS u32x4*)(d_ + 16384) = st[2]; *(LAS u32x4*)(d_ + 24576) = st[3]; } while (0)
    AT_LOAD(0);
    bf16x8 qr[4];
    { const bf16_t* q = QB + ((size_t)((b * 8 + hh) * SEQ + qi * 128 + qsub * 32 + r32) << 6) + hi * 8;
#pragma unroll
      for (int d0 = 0; d0 < 4; ++d0) qr[d0] = *(const bf16x8*)(q + d0 * 16); }
    AT_STORE(0);
    __syncthreads();
    LAS float* wsf = (LAS float*)(lds + AT_WSF) + wave * 64;
    float m_run = -1e30f, l_run = 0.f;
    f32x16 o[4]; o[0] = f32x16{}; o[1] = f32x16{}; o[2] = f32x16{}; o[3] = f32x16{};
    for (int t = 0; t < ntiles; ++t) {
        if (t + 1 < ntiles) AT_LOAD(t + 1);
        if (t < my_nt) {
            LAS const unsigned char* sg = lds + (t & 1) * AT_STAGE;
            LAS const unsigned char* kb = sg + map * 8192 + hi * 1024 + r32 * 16;
            f32x16 p0 = {}, p1 = {};
#pragma unroll
            for (int d0 = 0; d0 < 4; ++d0) {
                const bf16x8 a0 = *(LAS const bf16x8*)(kb + d0 * 2048), a1 = *(LAS const bf16x8*)(kb + d0 * 2048 + 512);
                p0 = MFMA32(a0, qr[d0], p0); p1 = MFMA32(a1, qr[d0], p1);
            }
            if (t == 0) {
#pragma unroll
                for (int r = 0; r < 16; ++r) { if (crow(r, hi) >= NMETA) p0[r] = -INFINITY; p1[r] = -INFINITY; }
            }
            float rm = fmaxf(p0[0], p1[0]);
#pragma unroll
            for (int r = 1; r < 16; ++r) rm = fmaxf(rm, fmaxf(p0[r], p1[r]));
            rm = swap32_max(rm);
            if (__any(rm > m_run + AT_THR)) {
                const float mn = fmaxf(m_run, rm), alpha = exp2f(m_run - mn);
                l_run *= alpha; m_run = mn;
                if (hi == 0) wsf[r32] = alpha;
                LDS_WAIT();
#pragma unroll
                for (int r = 0; r < 16; ++r) { const float a = wsf[crow(r, hi)];
#pragma unroll
                    for (int d0 = 0; d0 < 4; ++d0) o[d0][r] *= a; }
                LDS_WAIT();
            }
            float ls = 0.f;
#pragma unroll
            for (int r = 0; r < 16; ++r) { p0[r] = exp2f(p0[r] - m_run); p1[r] = exp2f(p1[r] - m_run); ls += p0[r] + p1[r]; }
            l_run += ls;
            const bf16x8 pa0 = pack8(p0, 0), pa1 = pack8(p0, 1), pa2 = pack8(p1, 0), pa3 = pack8(p1, 1);
            LAS const unsigned char* vb = sg + 16384 + ((lane >> 4) & 1) * 32 + (lane & 3) * 8 + (4 * hi + ((lane & 15) >> 2)) * 64;
#pragma unroll
            for (int d0 = 0; d0 < 4; ++d0) {
#define AT_VF(ks) ({ const s16x4 lo_ = tr_read(vb + d0 * 4096 + (ks) * 1024), hi_ = tr_read(vb + d0 * 4096 + (ks) * 1024 + 512); \
                     (bf16x8){lo_[0], lo_[1], lo_[2], lo_[3], hi_[0], hi_[1], hi_[2], hi_[3]}; })
                o[d0] = MFMA32(pa0, AT_VF(0), o[d0]); o[d0] = MFMA32(pa1, AT_VF(1), o[d0]);
                o[d0] = MFMA32(pa2, AT_VF(2), o[d0]); o[d0] = MFMA32(pa3, AT_VF(3), o[d0]);
#undef AT_VF
            }
        }
        if (t + 1 < ntiles) AT_STORE((t + 1) & 1);
        __syncthreads();
    }
    l_run = swap32_add(l_run);
    const float sc = (map ? lam : 1.0f) / l_run;
    if (hi == 0) wsf[r32] = sc;
    LDS_WAIT();
#pragma unroll
    for (int r = 0; r < 16; ++r) { const float a = wsf[crow(r, hi)];
#pragma unroll
        for (int d0 = 0; d0 < 4; ++d0) o[d0][r] *= a; }
    LAS float* xb = (LAS float*)(lds + AT_XBUF + qsub * 16384);
    if (map) {
#pragma unroll
        for (int d0 = 0; d0 < 4; ++d0)
#pragma unroll
            for (int r = 0; r < 16; ++r) xb[(d0 * 16 + r) * 64 + lane] = o[d0][r];
    }
    __syncthreads();
    if (!map) {
        const float* dn = P.in[8];
        bf16_t* MIX = (bf16_t*)(P.ws + WS_MIX);
        float ss[16];
#pragma unroll
        for (int r = 0; r < 16; ++r) { ss[r] = 0.f;
#pragma unroll
            for (int d0 = 0; d0 < 4; ++d0) { o[d0][r] -= xb[(d0 * 16 + r) * 64 + lane]; ss[r] += o[d0][r] * o[d0][r]; } }
#pragma unroll
        for (int r = 0; r < 16; ++r) {
            ss[r] = half_sum32(ss[r]);
            ss[r] = 0.8f / sqrtf(ss[r] * (1.0f / 128.0f) + EPS);
        }
        float dg[4];
#pragma unroll
        for (int d0 = 0; d0 < 4; ++d0) dg[d0] = dn[32 * d0 + r32];
#pragma unroll
        for (int r = 0; r < 16; ++r) {
            bf16_t* orow = MIX + (size_t)(b * SEQ + qi * 128 + qsub * 32 + crow(r, hi)) * 1024 + h * 128 + r32;
#pragma unroll
            for (int d0 = 0; d0 < 4; ++d0) orow[32 * d0] = (bf16_t)f2bf(o[d0][r] * ss[r] * dg[d0]);
        }
    }
    __syncthreads();
#undef AT_LOAD
#undef AT_STORE
}

DI void attn_phase(const Params& P, LAS unsigned char* lds, int tid, int wave, int lane) {
    unsigned* ctl = (unsigned*)(P.ws + WS_CTL);
    const float* lq1 = P.in[4]; const float* lk1 = P.in[5]; const float* lq2 = P.in[6]; const float* lk2 = P.in[7];
    const float lam = __expf(wave_sum(lq1[lane] * lk1[lane])) - __expf(wave_sum(lq2[lane] * lk2[lane])) + 0.2f;
    LAS volatile int* ub = (LAS volatile int*)(lds + AT_UNIT);
    for (;;) {
        if (tid == 0) *ub = (int)__hip_atomic_fetch_add(ctl + CW_ATTQ, 1u, __ATOMIC_RELAXED, __HIP_MEMORY_SCOPE_AGENT);
        __syncthreads();
        const int u = *ub;
        __syncthreads();
        if (u >= 512) break;
        attn_unit(P, lds, u & 7, 63 - (u >> 3), tid, wave, lane, lam);
    }
}

struct EpiOutProj {
    static constexpr bool PERM = false, AFTER_DRAIN = false;
    const float* x; float* out;
    DI void operator()(const pg8::f32x4 (&acc)[2][2][4][2], const pg8::Unit& u, int wr, int wc, int fr, int fq) const {
        const int row0 = u.pm * 256 + wr * 64 + fr, col0 = u.pn * 256 + wc * 32 + 4 * fq;
#pragma unroll
        for (int ai = 0; ai < 2; ++ai)
#pragma unroll
            for (int m = 0; m < 4; ++m) { const size_t off = (size_t)(row0 + ai * 128 + m * 16) * 1024 + col0;
#pragma unroll
                for (int bj = 0; bj < 2; ++bj)
#pragma unroll
                    for (int n = 0; n < 2; ++n) { const f32x4 xv = *(const f32x4*)(x + off + bj * 128 + n * 16); *(f32x4*)(out + off + bj * 128 + n * 16) = acc[ai][bj][m][n] + xv; } }
    }
};

typedef float f32x4v __attribute__((ext_vector_type(4)));
DI void route_tile(const Params& P, int tile, LAS float* lg  , int lane) {
    const float* h2 = P.out; const float* WR = (const float*)(P.ws + WS_WR);
    const int r16 = lane & 15, kq = lane >> 4;
    const float* arow = h2 + (size_t)(tile * 16 + r16) * 1024 + kq * 256;
    const float* b0 = WR + (size_t)r16 * 1024 + kq * 256; const float* b1 = b0 + 16 * 1024; const float* b2 = WR + (size_t)(32 + (r16 & 3)) * 1024 + kq * 256;
    const float z2 = (r16 < 4) ? 1.0f : 0.0f;
    f32x4v c0 = {}, c1 = {}, c2 = {};
    float ss = 0.f;
    for (int t4 = 0; t4 < 64; ++t4) {
        const f32x4 a = *(const f32x4*)(arow + 4 * t4), w0 = *(const f32x4*)(b0 + 4 * t4), w1 = *(const f32x4*)(b1 + 4 * t4), w2 = *(const f32x4*)(b2 + 4 * t4);
        ss += (a.x * a.x + a.y * a.y) + (a.z * a.z + a.w * a.w);
#pragma unroll
        for (int i = 0; i < 4; ++i) {
            c0 = __builtin_amdgcn_mfma_f32_16x16x4f32(a[i], w0[i], c0, 0, 0, 0);
            c1 = __builtin_amdgcn_mfma_f32_16x16x4f32(a[i], w1[i], c1, 0, 0, 0);
            c2 = __builtin_amdgcn_mfma_f32_16x16x4f32(a[i], w2[i] * z2, c2, 0, 0, 0);
        }
    }
    ss += swz_xor16(ss); ss = swap32_add(ss);
    const float rs = 1.0f / sqrtf(ss * (1.0f / 1024.0f) + EPS);
#pragma unroll
    for (int r = 0; r < 4; ++r) { const int row = 4 * kq + r; lg[row * 48 + r16] = c0[r]; lg[row * 48 + 16 + r16] = c1[r]; lg[row * 48 + 32 + r16] = c2[r]; }
    LDS_WAIT();
    if (lane < 16) {
        const int t = tile * 16 + lane;
        const float* bg = P.in[16]; const float* br = P.in[18];
        LAS const float* l = lg + lane * 48;
        float gl[4]; int gs = 0; float gm;
#pragma unroll
        for (int j = 0; j < 4; ++j) gl[j] = l[j] * rs + bg[j];
        gm = gl[0];
#pragma unroll
        for (int j = 1; j < 4; ++j) if (gl[j] > gm) { gm = gl[j]; gs = j; }
        float gsum = 0.f;
#pragma unroll
        for (int j = 0; j < 4; ++j) gsum += __expf(gl[j] - gm);
        const float psel = 1.0f / gsum;
        float e1 = -INFINITY, e2 = -INFINITY; int i1 = 0, i2 = 0;
#pragma unroll
        for (int j = 0; j < 8; ++j) {
            const float v = l[4 + gs * 8 + j] * rs + br[gs * 8 + j];
            if (v > e1) { e2 = e1; i2 = i1; e1 = v; i1 = j; } else if (v > e2) { e2 = v; i2 = j; }
        }
        const float x2 = __expf(e2 - e1), w1 = psel / (1.0f + x2), w2 = psel * x2 / (1.0f + x2);
        const int ea = gs * 8 + i1, eb = gs * 8 + i2;
        unsigned* cnt = (unsigned*)(P.ws + WS_CTL) + CW_CNT;
        const int pa = (int)atomicAdd(cnt + ea, 1u), pb = (int)atomicAdd(cnt + eb, 1u);
        ((int*)(P.ws + WS_TOKE))[2 * t] = ea; ((int*)(P.ws + WS_TOKE))[2 * t + 1] = eb;
        ((float*)(P.ws + WS_TOKW))[2 * t] = w1; ((float*)(P.ws + WS_TOKW))[2 * t + 1] = w2;
        ((int*)(P.ws + WS_TOKP))[2 * t] = pa; ((int*)(P.ws + WS_TOKP))[2 * t + 1] = pb;
        ((float*)(P.ws + WS_RS2))[t] = rs;
    }
    LDS_WAIT();
}

DI void phase4a(const Params& P, LAS unsigned char* lds, int gw, int NGW, int wave, int lane) {
    LAS float* scr = (LAS float*)(lds + wave * 16384);
    for (int tile = gw; tile < MTOK / 16; tile += NGW) route_tile(P, tile, scr, lane);
    bf16_t* WGU = (bf16_t*)(P.ws + WS_WGU); bf16_t* WD = (bf16_t*)(P.ws + WS_WD);
    const float* wg = P.in[19]; const float* wu = P.in[20]; const float* wd = P.in[21]; const float* gf = P.in[14];
    constexpr int I_GU = 16 * 16, I_D = 4 * 32;
    for (int it = gw; it < 32 * (I_GU + I_D); it += NGW) {
        const int e = it / (I_GU + I_D), r = it % (I_GU + I_D);
        if (r < I_GU) { const int n0 = (r & 15) * 32, j = n0 >> 8, up = (n0 >> 7) & 1;
            const float* wsrc = (up ? wu : wg) + (size_t)e * 1024 * 256;
            const SrcGU s{wsrc, gf, 128 * j + (n0 & 127) - n0};
            transpose_item(s, WGU + (size_t)e * 512 * 1024, 1024, (r >> 4) * 64, n0, scr, lane); }
        else { const int r2 = r - I_GU; const SrcPlain s{wd + (size_t)e * 256 * 1024, 1024};
            transpose_item(s, WD + (size_t)e * 1024 * 256, 256, (r2 >> 5) * 64, (r2 & 31) * 32, scr, lane); }
    }
}

DI void expert_layout(const Params& P, int lane, int& cnt, int& base, int& tend) {
    const unsigned* c = (const unsigned*)(P.ws + WS_CTL) + CW_CNT;
    cnt = (lane < 32) ? (int)__hip_atomic_load(c + lane, __ATOMIC_RELAXED, __HIP_MEMORY_SCOPE_AGENT) : 0;
    const int tiles = (cnt + 255) >> 8;
    int inc = 0;
#pragma unroll
    for (int i = 0; i < 32; ++i) { const int ti = __builtin_amdgcn_readlane(tiles, i); inc += (i <= lane) ? ti : 0; }
    tend = inc; base = (inc - tiles) << 8;
}

DI void phase4b(const Params& P, int gw, int NGW, int lane) {
    int cnt, base, tend; expert_layout(P, lane, cnt, base, tend);
    bf16_t* XS = (bf16_t*)(P.ws + WS_XS); float* SLOTW = (float*)(P.ws + WS_SLOTW);
    const int* TOKE = (const int*)(P.ws + WS_TOKE); const float* TOKW = (const float*)(P.ws + WS_TOKW); int* TOKP = (int*)(P.ws + WS_TOKP); const float* RS2 = (const float*)(P.ws + WS_RS2);
    for (int t = gw; t < MTOK; t += NGW) {
        const f32x4* hr = (const f32x4*)(P.out + (size_t)t * 1024);
        const float rs = RS2[t];
        u32x2 w[4];
#pragma unroll
        for (int j = 0; j < 4; ++j) { const f32x4 v = hr[64 * j + lane]; w[j] = (u32x2){pk2(v.x * rs, v.y * rs), pk2(v.z * rs, v.w * rs)}; }
#pragma unroll
        for (int k = 0; k < 2; ++k) {
            const int e = __builtin_amdgcn_readfirstlane(TOKE[2 * t + k]), slot = __builtin_amdgcn_readlane(base, e) + TOKP[2 * t + k];
            u32x2* orow = (u32x2*)(XS + (size_t)slot * 1024);
#pragma unroll
            for (int j = 0; j < 4; ++j) orow[64 * j + lane] = w[j];
            if (lane == 0) { SLOTW[slot] = TOKW[2 * t + k]; TOKP[2 * t + k] = slot; }
        }
    }
    for (int e = 0; e < 32; ++e) {
        const int ce = __builtin_amdgcn_readlane(cnt, e), be = __builtin_amdgcn_readlane(base, e), end = be + (((ce + 255) >> 8) << 8);
        for (int r = be + ce + gw; r < end; r += NGW) { u32x2* orow = (u32x2*)(XS + (size_t)r * 1024);
#pragma unroll
            for (int j = 0; j < 4; ++j) orow[64 * j + lane] = (u32x2){0u, 0u};
            if (lane == 0) SLOTW[r] = 0.f; }
    }
}

struct GroupedOrder {
    int tend; int total; int G, c, NS;
    DI bool next(int i, pg8::Unit& u) const {
        const int L = i * G + c; if (L >= (total << NS)) return false;
        const int mt = L >> NS, j = L & ((1 << NS) - 1);
        const int e = __builtin_popcountll(__ballot(((int)(threadIdx.x & 63) < 32) && tend <= mt));
        u.pm = mt; u.pn = (e << NS) + j; return true;
    }
    DI void a_ready(const pg8::Unit&) const {}
    DI void done(const pg8::Unit&) const {}
};
struct EpiGateUp {
    static constexpr bool PERM = true, AFTER_DRAIN = false;
    const float* SLOTW; bf16_t* YS;
    DI void operator()(const pg8::f32x4 (&acc)[2][2][4][2], const pg8::Unit& u, int wr, int wc, int fr, int fq) const {
        const int f0 = (u.pn & 1) * 128 + wc * 32 + fq * 8;
#pragma unroll
        for (int ai = 0; ai < 2; ++ai)
#pragma unroll
            for (int m = 0; m < 4; ++m) {
                const int row = u.pm * 256 + ai * 128 + wr * 64 + m * 16 + fr;
                const float cw = SLOTW[row];
                float a[8];
#pragma unroll
                for (int i = 0; i < 4; ++i) {
                    const float g0 = acc[ai][0][m][0][i], g1 = acc[ai][0][m][1][i];
                    a[i] = g0 / (1.0f + __expf(-g0)) * acc[ai][1][m][0][i] * cw; a[4 + i] = g1 / (1.0f + __expf(-g1)) * acc[ai][1][m][1][i] * cw;
                }
                *(u32x4*)(YS + (size_t)row * 256 + f0) = (u32x4){pk2(a[0], a[1]), pk2(a[2], a[3]), pk2(a[4], a[5]), pk2(a[6], a[7])};
            }
    }
};
struct EpiDown {
    static constexpr bool PERM = true, AFTER_DRAIN = false;
    bf16_t* YO;
    DI void operator()(const pg8::f32x4 (&acc)[2][2][4][2], const pg8::Unit& u, int wr, int wc, int fr, int fq) const {
        const int c0 = (u.pn & 3) * 256 + wc * 32 + fq * 8;
#pragma unroll
        for (int ai = 0; ai < 2; ++ai)
#pragma unroll
            for (int m = 0; m < 4; ++m) {
                bf16_t* rowp = YO + (size_t)(u.pm * 256 + ai * 128 + wr * 64 + m * 16 + fr) * 1024 + c0;
#pragma unroll
                for (int bj = 0; bj < 2; ++bj) { const pg8::f32x4 v0 = acc[ai][bj][m][0], v1 = acc[ai][bj][m][1];
                    *(u32x4*)(rowp + bj * 128) = (u32x4){pk2(v0[0], v0[1]), pk2(v0[2], v0[3]), pk2(v1[0], v1[1]), pk2(v1[2], v1[3])}; }
            }
    }
};

DI void phase7(const Params& P, int gw, int NGW, int lane) {
    const bf16_t* YO = (const bf16_t*)(P.ws + WS_YO); const int* TOKP = (const int*)(P.ws + WS_TOKP); const f32x4* nf = (const f32x4*)P.in[22];
    for (int t = gw; t < MTOK; t += NGW) {
        f32x4* hr = (f32x4*)(P.out + (size_t)t * 1024);
        const u32x2* y0 = (const u32x2*)(YO + (size_t)TOKP[2 * t] * 1024); const u32x2* y1 = (const u32x2*)(YO + (size_t)TOKP[2 * t + 1] * 1024);
        f32x4 v[4]; float s = 0.f;
#pragma unroll
        for (int j = 0; j < 4; ++j) {
            v[j] = hr[64 * j + lane]; const u32x2 a = y0[64 * j + lane], c = y1[64 * j + lane];
            v[j].x += __uint_as_float(a.x << 16) + __uint_as_float(c.x << 16); v[j].y += __uint_as_float(a.x & 0xffff0000u) + __uint_as_float(c.x & 0xffff0000u);
            v[j].z += __uint_as_float(a.y << 16) + __uint_as_float(c.y << 16); v[j].w += __uint_as_float(a.y & 0xffff0000u) + __uint_as_float(c.y & 0xffff0000u);
            s += (v[j].x * v[j].x + v[j].y * v[j].y) + (v[j].z * v[j].z + v[j].w * v[j].w);
        }
        s = wave_sum(s);
        const float rs = 1.0f / sqrtf(s * (1.0f / 1024.0f) + EPS);
#pragma unroll
        for (int j = 0; j < 4; ++j) hr[64 * j + lane] = v[j] * rs * nf[64 * j + lane];
    }
}

#define XB_TMO      128
#define XB_XCNT(j)  (256  + 64 * (j))
#define XB_XSUB(j)  (1280 + 64 * (j))
#define XB_XGEN(j)  (2304 + 64 * (j))
#define XB_TOP      3328
#define XB_TOPGEN   3392
#define XCD_BAR_WORDS 3456
#define XB_SPIN_CAP (1u << 18)

__device__ __forceinline__ unsigned xb_ld(unsigned* p)              { return __hip_atomic_load(p, __ATOMIC_RELAXED, __HIP_MEMORY_SCOPE_AGENT); }
__device__ __forceinline__ unsigned xb_add(unsigned* p, unsigned v) { return __hip_atomic_fetch_add(p, v, __ATOMIC_RELAXED, __HIP_MEMORY_SCOPE_AGENT); }
__device__ __forceinline__ unsigned xb_xcc_id() { return (unsigned)__builtin_amdgcn_s_getreg((3 << 11) | 20) & 0xFu; }
#define XB_SPIN(cond, bar) do { unsigned _sp = 0; while (cond) { __builtin_amdgcn_s_sleep(1); \
    if ((++_sp & 255u) == 0u) { if (xb_ld(&(bar)[XB_TMO])) break; if (_sp > XB_SPIN_CAP) { atomicAdd(&(bar)[XB_TMO], 1u); break; } } } } while (0)

struct XcdBarrier {
    unsigned* bar; unsigned x;
    volatile LAS unsigned* st;
};

__device__ __forceinline__ XcdBarrier xcd_barrier_post(unsigned* bar, volatile LAS unsigned* st) {
    XcdBarrier b; b.bar = bar; b.x = xb_xcc_id(); b.st = st;
    if (threadIdx.x == 0) (void)xb_add(&bar[XB_XCNT(b.x)], 1u);
    return b;
}
__device__ __forceinline__ void xcd_barrier_complete(unsigned* bar, unsigned x, unsigned& nloc, unsigned& nx) {
    const unsigned G = gridDim.x * gridDim.y * gridDim.z;
    unsigned sum, cnt, mine, sp = 0u;
    for (;;) {
        sum = 0u; cnt = 0u; mine = 0u;
#pragma unroll
        for (unsigned j = 0; j < 16; ++j) { const unsigned c = xb_ld(&bar[XB_XCNT(j)]); sum += c; cnt += (c > 0u) ? 1u : 0u; mine = (j == x) ? c : mine; }
        if (sum == G) break;
        __builtin_amdgcn_s_sleep(1);
        if ((++sp & 255u) == 0u) { if (xb_ld(&bar[XB_TMO])) break; if (sp > XB_SPIN_CAP) { atomicAdd(&bar[XB_TMO], 1u); break; } }
    }
    nloc = mine > 0u ? mine : 1u; nx = cnt > 0u ? cnt : 1u;
}

__device__ __forceinline__ void xcd_barrier(const XcdBarrier& b) {
    asm volatile("s_waitcnt vmcnt(0)" ::: "memory");
    __syncthreads();
    if (threadIdx.x == 0) {
        unsigned* bar = b.bar;
        __builtin_amdgcn_s_waitcnt(0);
        unsigned nloc = b.st[0], nx = b.st[1];
        if (nloc == 0u) { xcd_barrier_complete(bar, b.x, nloc, nx); b.st[0] = nloc; b.st[1] = nx; }
        const unsigned old = xb_add(&bar[XB_XSUB(b.x)], 1u);
        const unsigned gen = old / nloc;
        if (old + 1u == (gen + 1u) * nloc) {
            __builtin_amdgcn_fence(__ATOMIC_RELEASE, "agent");
            asm volatile("s_waitcnt vmcnt(0)" ::: "memory");
            const unsigned og = xb_add(&bar[XB_TOP], 1u);
            const unsigned tg = og / nx;
            if (og + 1u == (tg + 1u) * nx) xb_add(&bar[XB_TOPGEN], 1u);
            else XB_SPIN(xb_ld(&bar[XB_TOPGEN]) == tg, bar);
            __builtin_amdgcn_fence(__ATOMIC_ACQUIRE, "agent");
            xb_add(&bar[XB_XGEN(b.x)], 1u);
            asm volatile("s_waitcnt vmcnt(0)" ::: "memory");
        } else {
            XB_SPIN(xb_ld(&bar[XB_XGEN(b.x)]) == gen, bar);
            __builtin_amdgcn_fence(__ATOMIC_ACQUIRE, "agent");
            asm volatile("s_waitcnt vmcnt(0)" ::: "memory");
        }
    }
    __syncthreads();
}

#ifndef PHMASK
#define PHMASK 2047
#endif
#ifndef REPMASK
#define REPMASK 0
#endif
#define REP(bit) for (int rep_ = 0; rep_ < ((REPMASK & (bit)) ? 2 : 1); ++rep_)
#define REPSYNC(bit) if ((REPMASK & (bit)) && rep_ == 0) GRID_BAR()
typedef const __attribute__((address_space(4))) Params* KParams;
DI Params load_params(KParams kp) { Params p;
#pragma unroll
    for (int i = 0; i < 23; ++i) p.in[i] = kp->in[i];
    p.out = kp->out; p.ws = kp->ws; return p; }
__global__ void __launch_bounds__(NTHREADS, 2) hymba_fwd(Params Pin) {
    extern __shared__ __attribute__((aligned(16))) unsigned char lds_raw[];
    LAS unsigned char* lds = (LAS unsigned char*)lds_raw;
    cg::grid_group grid = cg::this_grid();
    volatile LAS unsigned* bst = (volatile LAS unsigned*)(lds + LDS_BYTES - 64);
    if (threadIdx.x < 2) bst[threadIdx.x] = 0u;
    __syncthreads();
    const XcdBarrier xbar = xcd_barrier_post((unsigned*)(Pin.ws + WS_CTL) + CW_BAR, bst);
#define GRID_BAR() xcd_barrier(xbar)
    const int G = gridDim.x, blk = blockIdx.x, NGW = G * NWAVES, NGT = G * NTHREADS;
#define PHASE_IDS() KParams kp_ = (KParams)__builtin_amdgcn_kernarg_segment_ptr(); asm volatile("" : "+s"(kp_)); const Params P = load_params(kp_); int tid = threadIdx.x; asm volatile("" : "+v"(tid)); const int lane = tid & 63, wave = __builtin_amdgcn_readfirstlane(tid >> 6), gw = blk * NWAVES + wave, gtid = blk * NTHREADS + tid; (void)lane; (void)gw; (void)gtid; (void)wave

    REP(1) { if (PHMASK & 1) { PHASE_IDS(); phase0(P, lds, gw, NGW, gtid, NGT, wave, lane); } REPSYNC(1); }
    GRID_BAR();
    REP(2) { if (PHMASK & 2) { PHASE_IDS();
        pg8::Gemm g{(const bf16_t*)(P.ws + WS_XB), (const bf16_t*)(P.ws + WS_WINT), MROWS, NPROJ, 1024};
        pg8::StaticOrder S; S.init(MROWS, NPROJ, G, blk);
        EpiInProj E{(const float*)(P.ws + WS_RS1), (const float*)(P.ws + WS_COS), (const float*)(P.ws + WS_SIN), P.in[10], P.in[11],
                    (bf16_t*)(P.ws + WS_QB), (bf16_t*)(P.ws + WS_KT), (bf16_t*)(P.ws + WS_VT), (bf16_t*)(P.ws + WS_QKVB), (bf16_t*)(P.ws + WS_ZB), (float*)(P.ws + WS_GB)};
        pg8::gemm_phase<EpiInProj, pg8::StaticOrder, true, true>(lds, g, S, E);
    } REPSYNC(2); }
    GRID_BAR();
    REP(4) { if (PHMASK & 4) { PHASE_IDS(); gdn_prep_phase(P, lds, blk, G, wave, lane); } REPSYNC(4); }
    GRID_BAR();
    REP(8) { if ((PHMASK & 8) && blk < 16) { PHASE_IDS(); gdn_scan(P, lds, blk, tid, wave, lane); } }
    REP(16) {
    if (PHMASK & 16) { PHASE_IDS(); attn_phase(P, lds, tid, wave, lane); }
    if ((REPMASK & 16) && rep_ == 0) { GRID_BAR(); if (blk == 0 && threadIdx.x == 0) { PHASE_IDS(); __hip_atomic_store((unsigned*)(P.ws + WS_CTL) + CW_ATTQ, 0u, __ATOMIC_RELAXED, __HIP_MEMORY_SCOPE_AGENT); } GRID_BAR(); }
    }
    GRID_BAR();
    REP(32) { if (PHMASK & 32) { PHASE_IDS();
        pg8::Gemm g{(const bf16_t*)(P.ws + WS_MIX), (const bf16_t*)(P.ws + WS_WOUT), MTOK, 1024, 1024};
        pg8::StaticOrder S; S.init(MTOK, 1024, G, blk);
        EpiOutProj E{P.in[0], P.out};
        pg8::gemm_phase<EpiOutProj, pg8::StaticOrder, true, true>(lds, g, S, E);
    } REPSYNC(32); }
    GRID_BAR();
    if (PHMASK & 64) { PHASE_IDS(); phase4a(P, lds, gw, NGW, wave, lane); }
    GRID_BAR();
    if (PHMASK & 128) { PHASE_IDS(); phase4b(P, gw, NGW, lane); }
    GRID_BAR();
    int cnt, base, tend, total; { PHASE_IDS(); expert_layout(P, lane, cnt, base, tend); total = __builtin_amdgcn_readlane(tend, 31); }
    REP(256) { if (PHMASK & 256) { PHASE_IDS();
        pg8::Gemm g{(const bf16_t*)(P.ws + WS_XS), (const bf16_t*)(P.ws + WS_WGU), XS_ROWS, 32 * 512, 1024};
        GroupedOrder S{tend, total, G, blk, 1};
        EpiGateUp E{(const float*)(P.ws + WS_SLOTW), (bf16_t*)(P.ws + WS_YS)};
        pg8::gemm_phase<EpiGateUp, GroupedOrder, true, true>(lds, g, S, E);
    } REPSYNC(256); }
    GRID_BAR();
    REP(512) { if (PHMASK & 512) { PHASE_IDS();
        int kd = 256; asm volatile("" : "+s"(kd));
        pg8::Gemm g{(const bf16_t*)(P.ws + WS_YS), (const bf16_t*)(P.ws + WS_WD), XS_ROWS, 32 * 1024, kd};
        GroupedOrder S{tend, total, G, blk, 2};
        EpiDown E{(bf16_t*)(P.ws + WS_YO)};
        pg8::gemm_phase<EpiDown, GroupedOrder, true, true>(lds, g, S, E);
    } REPSYNC(512); }
    GRID_BAR();
    if (PHMASK & 1024) { PHASE_IDS(); phase7(P, gw, NGW, lane); }
}

extern "C" void kernel_launch(void* const* d_in, const int* in_sizes, int n_in, void* d_out, int out_size, void* d_ws, size_t ws_size, hipStream_t stream) {
    static int grid_blocks = 0;
    if (grid_blocks == 0) {
        if (n_in != 23 || out_size != MTOK * DMODEL || ws_size < WS_END) { fprintf(stderr, "kernel_launch: unexpected shapes (n_in %d out %d ws %zu)\n", n_in, out_size, ws_size); grid_blocks = -1; return; }
        int dev = 0, cus = 0, per_cu = 0;
        hipGetDevice(&dev);
        hipDeviceGetAttribute(&cus, hipDeviceAttributeMultiprocessorCount, dev);
        hipFuncSetAttribute((const void*)hymba_fwd, hipFuncAttributeMaxDynamicSharedMemorySize, LDS_BYTES);
        hipOccupancyMaxActiveBlocksPerMultiprocessor(&per_cu, (const void*)hymba_fwd, NTHREADS, LDS_BYTES);
        if (per_cu < 1) { fprintf(stderr, "kernel_launch: occupancy query says %d blocks/CU\n", per_cu); per_cu = 1; }
        grid_blocks = cus;
        (void)hipGetLastError();
    }
    if (grid_blocks < 0) return;
    hipMemsetAsync((char*)d_ws + WS_CTL, 0, CTL_BYTES, stream);
    Params p{};
    for (int i = 0; i < 23; ++i) p.in[i] = (const float*)d_in[i];
    p.out = (float*)d_out; p.ws = (unsigned char*)d_ws;
    void* args[] = {&p};
    hipError_t e = hipLaunchCooperativeKernel((const void*)hymba_fwd, dim3(grid_blocks), dim3(NTHREADS), args, LDS_BYTES, stream);
    if (e != hipSuccess) fprintf(stderr, "cooperative launch failed: %s (grid %d)\n", hipGetErrorString(e), grid_blocks);
}
```

```cpp
#include <hip/hip_runtime.h>
#include <hip/hip_cooperative_groups.h>
#include <cstdio>
#include <cstdint>
namespace cg = cooperative_groups;
namespace pg8 {
#define PG8_LAS __attribute__((address_space(3)))
typedef unsigned short bf16_t;
typedef short bf16x8 __attribute__((ext_vector_type(8)));
typedef float f32x4 __attribute__((ext_vector_type(4)));
typedef unsigned u32x4 __attribute__((ext_vector_type(4)));
constexpr int BM = 256, BK = 64, HALF = 128, HTB = HALF * BK * 2  , STAGE_BYTES = 8 * HTB, NXCD = 8, WGM = 8;

__host__ __device__ __forceinline__ int lds_byte(int r, int c) { const int st = (r >> 4) * 2 + (c >> 5), rr = r & 15, cc = c & 31, ob = rr * 64 + cc * 2; return st * 1024 + (ob ^ (((ob >> 9) & 1) << 5)); }
__host__ __device__ __forceinline__ void stage_rc(int b, int& R, int& C) { const int st = b / 1024, sb = b % 1024, swz = sb ^ (((sb >> 9) & 1) << 5); R = (st >> 1) * 16 + swz / 64; C = (st & 1) * 32 + (swz % 64) / 2; }
__host__ __device__ __forceinline__ int perm32(int rho) { const int n = rho >> 4, i = rho & 15; return 8 * (i >> 2) + 4 * n + (i & 3); }

struct Unit { int pm, pn; };
struct Gemm { const bf16_t* A; const bf16_t* Bt; int M, N, K; };

struct StaticOrder {
    int nM, nN, nwg, G, c;
    __host__ __device__ void init(int M, int N, int G_, int c_) { nM = M / BM; nN = N / BM; nwg = nM * nN; G = G_; c = c_; }
    __host__ __device__ bool next(int i, Unit& u) const {
        const long L = (long)i * G + c; if (L >= nwg) return false;
        int wgid = (int)L; { const int q = nwg / NXCD, r = nwg % NXCD, xcd = wgid % NXCD, off = wgid / NXCD; wgid = (xcd < r ? xcd * (q + 1) : r * (q + 1) + (xcd - r) * q) + off; }
        const int nig = WGM * nN, gid = wgid / nig, fm = gid * WGM, gsz = (nM - fm) < WGM ? (nM - fm) : WGM;
        u.pm = fm + ((wgid % nig) % gsz); u.pn = (wgid % nig) / gsz; return true;
    }
    __device__ __forceinline__ void a_ready(const Unit&) const {}
    __device__ __forceinline__ void done(const Unit&) const {}
};

__device__ __forceinline__ unsigned cvt_pk_bf16(float lo, float hi) { unsigned r; asm volatile("v_cvt_pk_bf16_f32 %0, %1, %2" : "=v"(r) : "v"(lo), "v"(hi)); return r; }
typedef float f32x2 __attribute__((ext_vector_type(2)));
template <class Epi, class Sched, bool ALIGN_EPI = false, bool SP2 = false>
__device__ __forceinline__ void gemm_phase(PG8_LAS unsigned char* lds, const Gemm g, const Sched& S, const Epi& E) {
    int tid_o = threadIdx.x; asm volatile("" : "+v"(tid_o));
    const int tid = tid_o, wid = __builtin_amdgcn_readfirstlane(tid >> 6), lane = tid & 63, wr = wid >> 2, wc = wid & 3, fr = lane & 15, fq = lane >> 4;
    const int K = g.K, nt = K / BK;
    unsigned voffA[2], voffB[2];
#pragma unroll
    for (int i = 0; i < 2; ++i) { int R, C; stage_rc(tid * 16 + i * 8192, R, C); const int Rb = Epi::PERM ? ((R & ~31) + perm32(R & 31)) : R;
        voffA[i] = (unsigned)(R * K + C) * 2u; voffB[i] = (unsigned)(Rb * K + C) * 2u; }
    const size_t kstep = (size_t)(BK * 2);
    const size_t hstep = (size_t)HALF * K * 2;
    const size_t tstep = 2 * hstep;
    const unsigned ldsw = (unsigned)wid * 1024u;
    const int aoff = lds_byte(wr * 64 + fr, fq * 8), boff = lds_byte(wc * 32 + fr, fq * 8);
#define PG8_SA(b, h) (((b) * 2 + (h)) * HTB)
#define PG8_SB(b, h) ((4 + (b) * 2 + (h)) * HTB)
#define PG8_STAGE(bufoff, gbase, voff) do { _Pragma("unroll") for (int _i = 0; _i < 2; ++_i) \
        __builtin_amdgcn_global_load_lds((const unsigned*)((const char*)(gbase) + (voff)[_i]), (PG8_LAS unsigned*)(lds + (bufoff) + ldsw + _i * 8192), 16, 0, 0); } while (0)
#define PG8_LDA(dst, b, h) do { _Pragma("unroll") for (int m = 0; m < 4; ++m) _Pragma("unroll") for (int k = 0; k < 2; ++k) dst[m][k] = *(const PG8_LAS bf16x8*)(lds + PG8_SA(b, h) + aoff + m * 2048 + k * 1024); } while (0)
#define PG8_LDB(dst, b, h) do { _Pragma("unroll") for (int n = 0; n < 2; ++n) _Pragma("unroll") for (int k = 0; k < 2; ++k) dst[n][k] = *(const PG8_LAS bf16x8*)(lds + PG8_SB(b, h) + boff + n * 2048 + k * 1024); } while (0)
#define PG8_MMA(ai, bj, At, Bt) do { __builtin_amdgcn_s_setprio(1); _Pragma("unroll") for (int m = 0; m < 4; ++m) _Pragma("unroll") for (int n = 0; n < 2; ++n) _Pragma("unroll") for (int k = 0; k < 2; ++k) \
        acc[ai][bj][m][n] = __builtin_amdgcn_mfma_f32_16x16x32_bf16(Bt[n][k], At[m][k], acc[ai][bj][m][n], 0, 0, 0); __builtin_amdgcn_s_setprio(0); } while (0)
#define PG8_WAIT_V(n) asm volatile("s_waitcnt vmcnt(" #n ")" ::: "memory")
#define PG8_WAIT_L(n) asm volatile("s_waitcnt lgkmcnt(" #n ")" ::: "memory")
#define PG8_BAR __builtin_amdgcn_s_barrier()
#define PG8_SCHED __builtin_amdgcn_sched_barrier(0)
    Unit cur, nxt; int ui = 0;
    if (!S.next(0, cur)) return;
    f32x4 acc[2][2][4][2];
#pragma unroll
    for (int a = 0; a < 2; ++a)
#pragma unroll
        for (int b = 0; b < 2; ++b)
#pragma unroll
            for (int m = 0; m < 4; ++m)
#pragma unroll
                for (int n = 0; n < 2; ++n) acc[a][b][m][n] = (f32x4){0.f, 0.f, 0.f, 0.f};
    bf16x8 At[4][2], B0[2][2], B1[2][2];
    const char* cA = (const char*)g.A + (size_t)cur.pm * tstep; const char* cB = (const char*)g.Bt + (size_t)cur.pn * tstep;
    S.a_ready(cur);
    if constexpr (SP2) {
        PG8_STAGE(PG8_SB(0, 0), cB, voffB); PG8_STAGE(PG8_SB(0, 1), cB + hstep, voffB); PG8_STAGE(PG8_SA(0, 0), cA, voffA); PG8_STAGE(PG8_SA(0, 1), cA + hstep, voffA);
        if (wr == 1) PG8_BAR;
        PG8_WAIT_V(2); PG8_BAR;
        PG8_STAGE(PG8_SB(1, 0), cB + kstep, voffB); PG8_STAGE(PG8_SA(1, 0), cA + kstep, voffA); PG8_STAGE(PG8_SB(1, 1), cB + hstep + kstep, voffB);
        PG8_WAIT_V(6); PG8_BAR;
    } else {
        PG8_STAGE(PG8_SB(0, 0), cB, voffB); PG8_STAGE(PG8_SA(0, 0), cA, voffA); PG8_STAGE(PG8_SB(0, 1), cB + hstep, voffB); PG8_STAGE(PG8_SA(0, 1), cA + hstep, voffA);
        if (wr == 1) PG8_BAR;
        PG8_WAIT_V(4); PG8_BAR;
        PG8_STAGE(PG8_SB(1, 0), cB + kstep, voffB); PG8_STAGE(PG8_SA(1, 0), cA + kstep, voffA); PG8_STAGE(PG8_SB(1, 1), cB + hstep + kstep, voffB);
        PG8_WAIT_V(6); PG8_BAR;
    }
    for (;;) {
        const bool has_next = S.next(ui + 1, nxt);
        const char* nA = has_next ? (const char*)g.A + (size_t)nxt.pm * tstep : cA; const char* nB = has_next ? (const char*)g.Bt + (size_t)nxt.pn * tstep : cB;
        for (int t = 0; t < nt; t += 2) {
            const bool last = (t == nt - 2);
            const char* a1 = cA + (size_t)(t + 1) * kstep;
            const char* a2 = last ? nA : cA + (size_t)(t + 2) * kstep; const char* b2 = last ? nB : cB + (size_t)(t + 2) * kstep;
            const char* a3 = a2 + kstep; const char* b3 = b2 + kstep;
            if (last && has_next) S.a_ready(nxt);
            if constexpr (SP2) {
            PG8_LDB(B0, 0, 0); PG8_LDB(B1, 0, 1); PG8_SCHED; PG8_LDA(At, 0, 0); PG8_STAGE(PG8_SA(1, 1), a1 + hstep, voffA);
            PG8_WAIT_V(8); PG8_WAIT_L(0); PG8_BAR; PG8_MMA(0, 0, At, B0); PG8_MMA(0, 1, At, B1); PG8_BAR; PG8_SCHED;
            PG8_LDA(At, 0, 1); PG8_STAGE(PG8_SB(0, 0), b2, voffB); PG8_STAGE(PG8_SB(0, 1), b2 + hstep, voffB); PG8_STAGE(PG8_SA(0, 0), a2, voffA);
            PG8_WAIT_V(8); PG8_WAIT_L(0); PG8_BAR; PG8_MMA(1, 0, At, B0); PG8_MMA(1, 1, At, B1); PG8_BAR; PG8_SCHED;
            PG8_LDB(B0, 1, 0); PG8_LDB(B1, 1, 1); PG8_SCHED; PG8_LDA(At, 1, 0); PG8_STAGE(PG8_SA(0, 1), a2 + hstep, voffA);
            PG8_WAIT_V(8); PG8_WAIT_L(0); PG8_BAR; PG8_MMA(0, 0, At, B0); PG8_MMA(0, 1, At, B1); PG8_BAR; PG8_SCHED;
            PG8_LDA(At, 1, 1); PG8_STAGE(PG8_SB(1, 0), b3, voffB); PG8_STAGE(PG8_SB(1, 1), b3 + hstep, voffB); PG8_STAGE(PG8_SA(1, 0), a3, voffA);
            PG8_WAIT_V(8); PG8_WAIT_L(0); PG8_BAR; PG8_MMA(1, 0, At, B0); PG8_MMA(1, 1, At, B1); PG8_BAR; PG8_SCHED;
            } else {
            PG8_LDB(B0, 0, 0); PG8_SCHED; PG8_LDA(At, 0, 0); PG8_STAGE(PG8_SA(1, 1), a1 + hstep, voffA);
            PG8_WAIT_L(8); PG8_BAR; PG8_WAIT_L(0); PG8_MMA(0, 0, At, B0); PG8_BAR; PG8_SCHED;
            PG8_LDB(B1, 0, 1); PG8_STAGE(PG8_SB(0, 0), b2, voffB);
            PG8_BAR; PG8_WAIT_L(0); PG8_MMA(0, 1, At, B1); PG8_BAR;
            PG8_LDA(At, 0, 1); PG8_STAGE(PG8_SA(0, 0), a2, voffA);
            PG8_BAR; PG8_WAIT_L(0); PG8_MMA(1, 0, At, B0); PG8_BAR; PG8_SCHED;
            PG8_STAGE(PG8_SB(0, 1), b2 + hstep, voffB);
            PG8_WAIT_V(6); PG8_BAR; PG8_MMA(1, 1, At, B1); PG8_BAR;
            PG8_LDB(B0, 1, 0); PG8_SCHED; PG8_LDA(At, 1, 0); PG8_STAGE(PG8_SA(0, 1), a2 + hstep, voffA);
            PG8_WAIT_L(8); PG8_BAR; PG8_WAIT_L(0); PG8_MMA(0, 0, At, B0); PG8_BAR; PG8_SCHED;
            PG8_LDB(B1, 1, 1); PG8_STAGE(PG8_SB(1, 0), b3, voffB);
            PG8_BAR; PG8_WAIT_L(0); PG8_MMA(0, 1, At, B1); PG8_BAR;
            PG8_LDA(At, 1, 1); PG8_STAGE(PG8_SA(1, 0), a3, voffA);
            PG8_BAR; PG8_WAIT_L(0); PG8_MMA(1, 0, At, B0); PG8_BAR; PG8_SCHED;
            PG8_STAGE(PG8_SB(1, 1), b3 + hstep, voffB);
            PG8_WAIT_V(6); PG8_BAR; PG8_MMA(1, 1, At, B1); PG8_BAR;
            }
        }
        if constexpr (ALIGN_EPI) { if (wr == 0) PG8_BAR; }
        if constexpr (!Epi::AFTER_DRAIN) { E(acc, cur, wr, wc, fr, fq); S.done(cur); }
        if (!has_next) break;
#pragma unroll
        for (int a = 0; a < 2; ++a)
#pragma unroll
            for (int b = 0; b < 2; ++b)
#pragma unroll
                for (int m = 0; m < 4; ++m)
#pragma unroll
                    for (int n = 0; n < 2; ++n) acc[a][b][m][n] = (f32x4){0.f, 0.f, 0.f, 0.f};
        cur = nxt; cA = nA; cB = nB; ++ui;
        if constexpr (ALIGN_EPI) { if (wr == 1) PG8_BAR; }
    }
    PG8_WAIT_V(0);
    if constexpr (!ALIGN_EPI) { if (wr == 0) PG8_BAR; }
    PG8_BAR;
    if constexpr (Epi::AFTER_DRAIN) { E.fused(acc, cur, wr, wc, fr, fq, lds, wid, lane); S.done(cur); }
#undef PG8_SA
#undef PG8_SB
#undef PG8_STAGE
#undef PG8_LDA
#undef PG8_LDB
#undef PG8_MMA
#undef PG8_WAIT_V
#undef PG8_WAIT_L
#undef PG8_BAR
#undef PG8_SCHED
}
}

#define DI __device__ __forceinline__
#define LAS __attribute__((address_space(3)))
typedef unsigned short bf16_t;
typedef short bf16x8 __attribute__((ext_vector_type(8)));
typedef short s16x4 __attribute__((ext_vector_type(4)));
typedef short v4i16_t __attribute__((ext_vector_type(4)));
typedef float f32x4 __attribute__((ext_vector_type(4)));
typedef float f32x16 __attribute__((ext_vector_type(16)));
typedef unsigned u32x4 __attribute__((ext_vector_type(4)));
typedef unsigned u32x2 __attribute__((ext_vector_type(2)));
typedef float f32x2_t __attribute__((ext_vector_type(2)));
typedef __bf16 bf16x2_t __attribute__((ext_vector_type(2)));

constexpr int NWAVES = 8, NTHREADS = 512;
constexpr int SEQ = 8192, DMODEL = 1024, NMETA = 16, LTOK = SEQ + NMETA  , LP = 8256  , NCHUNK = 129;
constexpr int MTOK = 2 * SEQ;
constexpr int MROWS = 16640;
constexpr int NPROJ = 3840;
constexpr int NKT = 129;
constexpr float EPS = 1e-6f;
constexpr float C2Q = 0.125f * 1.4426950408889634f;
constexpr int XS_ROWS = 41216;

constexpr size_t MiB = 1u << 20;
constexpr size_t WS_CTL = 0, CTL_BYTES = 1 * MiB;
constexpr size_t WS_RS1 = 1 * MiB;
constexpr size_t WS_RS2 = WS_RS1 + 128 * 1024;
constexpr size_t WS_TOKE = WS_RS2 + 128 * 1024;
constexpr size_t WS_TOKW = WS_TOKE + 128 * 1024;
constexpr size_t WS_TOKP = WS_TOKW + 128 * 1024;
constexpr size_t WS_SLOTW = WS_TOKP + 128 * 1024;
constexpr size_t WS_WR = WS_SLOTW + 192 * 1024;
constexpr size_t WS_GL = WS_WR + 160 * 1024;
constexpr size_t WS_COS = 2 * MiB;
constexpr size_t WS_SIN = WS_COS + 1280 * 1024;
constexpr size_t WS_GB = WS_SIN + 1280 * 1024;
constexpr size_t WS_WOUT = 6 * MiB;
constexpr size_t WS_WINT = 8 * MiB;
constexpr size_t WS_XB = WS_WINT + (size_t)NPROJ * 1024 * 2;
constexpr size_t WS_MIX = 8 * MiB;
constexpr size_t WS_QKVB = 48 * MiB;
constexpr size_t WS_QB = WS_QKVB + (size_t)2 * LP * 1536 * 2 + 128 * 1024;
constexpr size_t WS_KT = WS_QB + 16 * MiB;
constexpr size_t WS_VT = WS_KT + (size_t)16 * NKT * 4096 * 2;
constexpr size_t WS_ZB = WS_VT + (size_t)8 * NKT * 8192 * 2;
constexpr size_t WS_GP = WS_ZB + (size_t)2 * LP * 512 * 2;
constexpr size_t GP_ARR = (size_t)2064 * 4096 * 2;
constexpr size_t WS_GP_END = WS_GP + 5 * GP_ARR;
constexpr size_t WS_WGU = 48 * MiB;
constexpr size_t WS_WD = 80 * MiB;
constexpr size_t WS_XS = 96 * MiB;
constexpr size_t WS_YO = 96 * MiB;
constexpr size_t WS_YS = WS_XS + (size_t)XS_ROWS * 1024 * 2;
constexpr size_t WS_END = 256 * MiB;
static_assert(WS_GB + (size_t)2 * LP * 16 * 4 <= WS_WOUT, "small region");
static_assert(WS_XB + (size_t)MROWS * 1024 * 2 <= WS_QKVB, "XB");
static_assert(WS_GP_END <= WS_END, "GDN prep arrays");
static_assert(WS_YS + (size_t)XS_ROWS * 256 * 2 <= WS_END, "YS");
static_assert(WS_WD + (size_t)32 * 1024 * 256 * 2 <= WS_XS, "WD");
constexpr int CW_ATTQ = 0;
constexpr int CW_CNT = 64;
constexpr int CW_BAR = 4096;

constexpr int LDS_BYTES = 147456;

struct Params { const float* in[23]; float* out; unsigned char* ws; };

DI unsigned f2bf(float f) { unsigned u = __float_as_uint(f); return (u + 0x7fffu + ((u >> 16) & 1u)) >> 16; }
DI unsigned pk2(float lo, float hi) { f32x2_t v = {lo, hi}; bf16x2_t b = __builtin_convertvector(v, bf16x2_t); return __builtin_bit_cast(unsigned, b); }
DI float bf2f(unsigned short h) { return __uint_as_float(((unsigned)h) << 16); }
DI float rlane(float v, int l) { return __int_as_float(__builtin_amdgcn_readlane(__float_as_int(v), l)); }
#define DPP_ADD(v, ctrl) ((v) + __int_as_float(__builtin_amdgcn_update_dpp(0, __float_as_int(v), (ctrl), 0xF, 0xF, true)))
DI float wave_sum_dpp(float v) {
    v = DPP_ADD(v, 0xB1);
    v = DPP_ADD(v, 0x4E);
    v = DPP_ADD(v, 0x141);
    v = DPP_ADD(v, 0x140);
    return (rlane(v, 0) + rlane(v, 16)) + (rlane(v, 32) + rlane(v, 48));
}
DI float wave_sum(float v) { return wave_sum_dpp(v); }
DI float swz_xor16(float v) { return __int_as_float(__builtin_amdgcn_ds_swizzle(__float_as_int(v), 0x401F)); }
DI float row_sum16(float v) { v = DPP_ADD(v, 0xB1); v = DPP_ADD(v, 0x4E); v = DPP_ADD(v, 0x141); v = DPP_ADD(v, 0x140); return v; }
DI float half_sum32(float v) { v = row_sum16(v); return v + swz_xor16(v); }
DI float swap32_add(float v) { auto rr = __builtin_amdgcn_permlane32_swap(__float_as_uint(v), __float_as_uint(v), false, false); return __uint_as_float(rr[0]) + __uint_as_float(rr[1]); }
DI float swap32_max(float v) { auto rr = __builtin_amdgcn_permlane32_swap(__float_as_uint(v), __float_as_uint(v), false, false); return fmaxf(__uint_as_float(rr[0]), __uint_as_float(rr[1])); }
#define LDS_WAIT() asm volatile("s_waitcnt lgkmcnt(0)" ::: "memory")
#define BAR_LDS() do { asm volatile("s_waitcnt lgkmcnt(0)" ::: "memory"); __builtin_amdgcn_s_barrier(); asm volatile("" ::: "memory"); } while (0)
#define MFMA32(a, b, c) __builtin_amdgcn_mfma_f32_32x32x16_bf16((a), (b), (c), 0, 0, 0)
DI int crow(int r, int hi) { return (r & 3) + 8 * (r >> 2) + 4 * hi; }
DI int perm16(int x) { return (x & ~12) | ((x & 4) << 1) | ((x & 8) >> 1); }
DI bf16x8 pack8(const f32x16& x, int s) {
    u32x4 p; p.x = pk2(x[8 * s], x[8 * s + 1]); p.y = pk2(x[8 * s + 2], x[8 * s + 3]); p.z = pk2(x[8 * s + 4], x[8 * s + 5]); p.w = pk2(x[8 * s + 6], x[8 * s + 7]);
    return __builtin_bit_cast(bf16x8, p);
}
DI int orig_col(int n) {
    if (n >= 1024) return n;
    const int hh = n >> 6, c2 = n & 63, g8 = c2 >> 3, i = c2 & 7;
    return (hh << 6) + ((i < 4) ? 4 * g8 + i : 32 + 4 * g8 + (i - 4));
}
DI size_t kt_off(int b, int hh, int p, int d) {
    const int tile = p < 16 ? 0 : 1 + ((p - 16) >> 6), kv = p < 16 ? p : ((p - 16) & 63);
    return ((size_t)((b * 8 + hh) * NKT + tile) << 12) + ((d >> 3) << 9) + (kv << 3) + (d & 7);
}
DI size_t vt_off(int b, int h, int p, int d) {
    const int tile = p < 16 ? 0 : 1 + ((p - 16) >> 6), kv = p < 16 ? p : ((p - 16) & 63);
    return ((size_t)((b * 4 + h) * NKT + tile) << 13) + ((d >> 5) << 11) + ((kv >> 4) << 9) + ((kv & 15) << 5) + (d & 31);
}

template <class Src> DI void transpose_item(const Src& src, bf16_t* WT, size_t ldk, int k0, int n0, LAS float* scr, int lane) {
    float v[32];
#pragma unroll
    for (int i = 0; i < 32; ++i) v[i] = src(k0 + 2 * i + (lane >> 5), n0 + (lane & 31));
#pragma unroll
    for (int i = 0; i < 32; ++i) scr[(2 * i + (lane >> 5)) * 33 + (lane & 31)] = v[i];
    LDS_WAIT();
    const int c = lane & 7;
#pragma unroll
    for (int j = 0; j < 4; ++j) { const int n = (lane >> 3) + 8 * j; const LAS float* s = scr + (8 * c) * 33 + n;
        u32x4 o; o.x = pk2(s[0 * 33], s[1 * 33]); o.y = pk2(s[2 * 33], s[3 * 33]); o.z = pk2(s[4 * 33], s[5 * 33]); o.w = pk2(s[6 * 33], s[7 * 33]);
        *(u32x4*)(WT + (size_t)(n0 + n) * ldk + k0 + 8 * c) = o; }
    LDS_WAIT();
}
struct SrcWin { const float* w; const float* g; DI float operator()(int k, int n) const { return n >= 3600 ? 0.f : w[(size_t)k * 3600 + orig_col(n)] * g[k]; } };
struct SrcPlain { const float* w; int N; DI float operator()(int k, int n) const { return w[(size_t)k * N + n]; } };
struct SrcGU { const float* w; const float* g; int fadj; DI float operator()(int k, int n) const { return w[(size_t)k * 256 + n + fadj] * g[k]; } };

#ifndef P0_REP
#define P0_REP 0
#endif
DI void phase0(const Params& P, LAS unsigned char* lds, int gw, int NGW, int gtid, int NGT, int wave, int lane) {
    LAS float* scr = (LAS float*)(lds + wave * 16384);
    bf16_t* WINT = (bf16_t*)(P.ws + WS_WINT); bf16_t* WOUT = (bf16_t*)(P.ws + WS_WOUT); bf16_t* XB = (bf16_t*)(P.ws + WS_XB);
    float* RS1 = (float*)(P.ws + WS_RS1);
    constexpr int I_IN = 16 * (NPROJ / 32), I_OUT = 16 * 32;
    const SrcWin sw{P.in[3], P.in[2]}; const SrcPlain so{P.in[13], 1024};
    for (int rp_ = 0; rp_ < ((P0_REP & 1) ? 2 : 1); ++rp_)
    for (int it = gw; it < I_IN + I_OUT; it += NGW) {
        if (it < I_IN) transpose_item(sw, WINT, 1024, (it / (NPROJ / 32)) * 64, (it % (NPROJ / 32)) * 32, scr, lane);
        else { const int r = it - I_IN; transpose_item(so, WOUT, 1024, (r >> 5) * 64, (r & 31) * 32, scr, lane); }
    }
    const float* x = P.in[0]; const float* meta = P.in[1];
    for (int rp_ = 0; rp_ < ((P0_REP & 2) ? 2 : 1); ++rp_)
    for (int m0 = gw; m0 < MROWS; m0 += 4 * NGW) {
        f32x4 v[4][4];
#pragma unroll
        for (int r = 0; r < 4; ++r) { const int m = m0 + r * NGW;
            const bool real = m < MTOK + NMETA;
            const f32x4* xr = (const f32x4*)((m < MTOK) ? x + (size_t)m * 1024 : meta + (size_t)((real ? m : MTOK) - MTOK) * 1024);
#pragma unroll
            for (int j = 0; j < 4; ++j) v[r][j] = (m < MROWS) ? xr[64 * j + lane] : (f32x4){0.f, 0.f, 0.f, 0.f}; }
#pragma unroll
        for (int r = 0; r < 4; ++r) { const int m = m0 + r * NGW;
            if (m < MROWS) {
                const bool real = m < MTOK + NMETA;
                float s = 0.f;
#pragma unroll
                for (int j = 0; j < 4; ++j) { if (!real) v[r][j] = (f32x4){0.f, 0.f, 0.f, 0.f}; s += (v[r][j].x * v[r][j].x + v[r][j].y * v[r][j].y) + (v[r][j].z * v[r][j].z + v[r][j].w * v[r][j].w); }
                s = wave_sum(s);
                if (lane == 0) RS1[m] = real ? __builtin_amdgcn_rsqf(s * (1.0f / 1024.0f) + EPS) : 0.f;
                u32x2* orow = (u32x2*)(XB + (size_t)m * 1024);
#pragma unroll
                for (int j = 0; j < 4; ++j) orow[64 * j + lane] = (u32x2){pk2(v[r][j].x, v[r][j].y), pk2(v[r][j].z, v[r][j].w)};
            } }
    }
    float* COS = (float*)(P.ws + WS_COS); float* SIN = (float*)(P.ws + WS_SIN);
    for (int rp_ = 0; rp_ < ((P0_REP & 4) ? 2 : 1); ++rp_)
    for (int i = gtid; i < LTOK * 32; i += NGT) {
        const int p = i >> 5, f = i & 31;
        const double rev = (double)p * exp2(-(double)f * (13.287712379549449 / 32.0)) * 0.15915494309189535;
        const float fr = (float)(rev - floor(rev));
        COS[i] = __builtin_amdgcn_cosf(fr); SIN[i] = __builtin_amdgcn_sinf(fr);
    }
    float* WR = (float*)(P.ws + WS_WR); const float* gf = P.in[14]; const float* wgrp = P.in[15]; const float* wrt = P.in[17];
    for (int i = gtid; i < 36 * 1024; i += NGT) { const int j = i >> 10, k = i & 1023; WR[i] = gf[k] * (j < 4 ? wgrp[k * 4 + j] : wrt[k * 32 + (j - 4)]); }
}

struct EpiInProj {
    static constexpr bool PERM = true, AFTER_DRAIN = false;
    const float* RS1; const float* COS; const float* SIN; const float* a_log; const float* dt_bias;
    bf16_t* QB; bf16_t* KT; bf16_t* VT; bf16_t* QKVB; bf16_t* ZB; float* GB;
    DI void operator()(const pg8::f32x4 (&acc)[2][2][4][2], const pg8::Unit& u, int wr, int wc, int fr, int fq) const {
        const int pn = u.pn;
#pragma unroll
        for (int ai = 0; ai < 2; ++ai)
#pragma unroll
            for (int m = 0; m < 4; ++m) {
                const int row = u.pm * 256 + ai * 128 + wr * 64 + m * 16 + fr;
                if (row < MTOK + NMETA) {
                    const float rs = RS1[row];
                    const bool meta = row >= MTOK;
                    const int p = meta ? row - MTOK : (row & 8191) + NMETA;
                    const int b0 = meta ? 0 : (row >> 13), nb = meta ? 2 : 1;
#pragma unroll
                    for (int bj = 0; bj < 2; ++bj) {
                        float xv[8];
#pragma unroll
                        for (int i = 0; i < 4; ++i) { xv[i] = acc[ai][bj][m][0][i] * rs; xv[4 + i] = acc[ai][bj][m][1][i] * rs; }
                        if (pn < 4) {
                            const int hh = (pn & 1) * 4 + bj * 2 + (wc >> 1), d0 = 4 * (4 * (wc & 1) + fq);
                            const f32x4 cs = *(const f32x4*)(COS + p * 32 + d0), sn = *(const f32x4*)(SIN + p * 32 + d0);
                            float lo[4], hi[4];
#pragma unroll
                            for (int i = 0; i < 4; ++i) { lo[i] = xv[i] * cs[i] - xv[4 + i] * sn[i]; hi[i] = xv[4 + i] * cs[i] + xv[i] * sn[i]; }
                            if (pn < 2) {
                                if (!meta) {
                                    bf16_t* q = QB + ((size_t)((b0 * 8 + hh) * SEQ + (p - NMETA)) << 6) + d0;
                                    *(u32x2*)q = (u32x2){pk2(lo[0] * C2Q, lo[1] * C2Q), pk2(lo[2] * C2Q, lo[3] * C2Q)};
                                    *(u32x2*)(q + 32) = (u32x2){pk2(hi[0] * C2Q, hi[1] * C2Q), pk2(hi[2] * C2Q, hi[3] * C2Q)};
                                }
                            } else {
                                for (int bb = b0; bb < b0 + nb; ++bb) {
                                    *(u32x2*)(KT + kt_off(bb, hh, p, d0)) = (u32x2){pk2(lo[0], lo[1]), pk2(lo[2], lo[3])};
                                    *(u32x2*)(KT + kt_off(bb, hh, p, d0 + 32)) = (u32x2){pk2(hi[0], hi[1]), pk2(hi[2], hi[3])};
                                }
                            }
                        } else {
                            const u32x4 w = (u32x4){pk2(xv[0], xv[1]), pk2(xv[2], xv[3]), pk2(xv[4], xv[5]), pk2(xv[6], xv[7])};
                            const int cl = bj * 128 + wc * 32 + fq * 8;
                            if (pn < 6) {
                                const int h = (pn - 4) * 2 + bj, d = wc * 32 + fq * 8;
                                for (int bb = b0; bb < b0 + nb; ++bb) *(u32x4*)(VT + vt_off(bb, h, p, d)) = w;
                            } else if (pn < 12) {
                                for (int bb = b0; bb < b0 + nb; ++bb) *(u32x4*)(QKVB + (size_t)(bb * LP + p) * 1536 + (pn - 6) * 256 + cl) = w;
                            } else if (pn < 14) {
                                float sz[8];
#pragma unroll
                                for (int i = 0; i < 8; ++i) sz[i] = xv[i] * __builtin_amdgcn_rcpf(1.0f + __expf(-xv[i]));
                                const u32x4 wz = (u32x4){pk2(sz[0], sz[1]), pk2(sz[2], sz[3]), pk2(sz[4], sz[5]), pk2(sz[6], sz[7])};
                                for (int bb = b0; bb < b0 + nb; ++bb) *(u32x4*)(ZB + (size_t)(bb * LP + p) * 512 + (pn - 12) * 256 + cl) = wz;
                            } else if (cl < 16) {
                                float o[8];
                                if (cl == 0) {
#pragma unroll
                                    for (int i = 0; i < 8; ++i) { const float t = xv[i] + dt_bias[i]; const float sp = t > 20.f ? t : log1pf(expf(t)); o[i] = -expf(a_log[i]) * sp; }
                                } else {
#pragma unroll
                                    for (int i = 0; i < 8; ++i) o[i] = 1.0f / (1.0f + expf(-xv[i]));
                                }
                                for (int bb = b0; bb < b0 + nb; ++bb) { float* g = GB + ((size_t)(bb * LP + p) << 4) + cl;
                                    *(f32x4*)g = (f32x4){o[0], o[1], o[2], o[3]}; *(f32x4*)(g + 4) = (f32x4){o[4], o[5], o[6], o[7]}; }
                            }
                        }
                    }
                }
            }
    }
};

DI bf16x8 lds_frag(LAS const bf16_t* M, int row, int ch) { return *(LAS const bf16x8*)((LAS const unsigned char*)M + row * 128 + ((ch ^ (row & 7)) << 4)); }
DI s16x4 tr_read_b64(LAS const unsigned char* p) { return __builtin_bit_cast(s16x4, __builtin_amdgcn_ds_read_tr16_b64_v4i16((LAS v4i16_t*)p)); }
DI bf16x8 lds_frag_plain(LAS const bf16_t* M, int row, int ch) { return *(LAS const bf16x8*)((LAS const unsigned char*)M + row * 128 + (ch << 4)); }
DI int swz_idx(int row, int d) { return row * 64 + ((((d >> 3) ^ (row & 7)) << 3) | (d & 7)); }

#ifndef PREP_REP
#define PREP_REP 0
#endif
constexpr int PREP_PAIR = 35840;

template <int MAT> DI void prep_rows(const bf16_t* QKVB, const float* cw, int b, int h, int n, int lane, LAS const float* egS,
                                     LAS bf16_t* DS  , bf16_t* QG) {
    const int colb = MAT * 512 + h * 64, col = colb + lane, p0 = n * 64;
    const float c0 = cw[col], c1 = cw[1536 + col], c2 = cw[3072 + col], c3 = cw[4608 + col];
    const bf16_t* blk = QKVB + (size_t)(b * LP + p0) * 1536 + colb;
    float x0 = 0.f, x1 = 0.f, x2 = 0.f;
    if (n > 0) { x0 = bf2f(blk[lane - 3 * 1536]); x1 = bf2f(blk[lane - 2 * 1536]); x2 = bf2f(blk[lane - 1 * 1536]); }
    u32x4 stg[8];
#pragma unroll
    for (int i = 0; i < 8; ++i) stg[i] = *(const u32x4*)(blk + (size_t)(8 * i + (lane >> 3)) * 1536 + (lane & 7) * 8);
#pragma unroll
    for (int i = 0; i < 8; ++i) *(LAS u32x4*)(DS + (8 * i + (lane >> 3)) * 64 + (lane & 7) * 8) = stg[i];
    LDS_WAIT();
    const int nvalid = (LTOK - p0) < 64 ? (LTOK - p0) : 64;
#pragma unroll 4
    for (int c = 0; c < 64; ++c) {
        if (c >= nvalid) { DS[c * 64 + lane] = 0; if (MAT == 0) QG[c * 64 + perm16(lane)] = 0; continue; }
        const bool valid = true;
        const float x3 = bf2f(DS[c * 64 + lane]);
        float y = c0 * x0 + c1 * x1 + c2 * x2 + c3 * x3;
        y = y * __builtin_amdgcn_rcpf(1.0f + __expf(-y));
        if (!valid) y = 0.f;
        x0 = x1; x1 = x2; x2 = x3;
        if (MAT == 2) { DS[c * 64 + lane] = (bf16_t)f2bf(y * egS[c]); }
        else {
            const float ss = wave_sum(y * y);
            const float yn = y * __builtin_amdgcn_rsqf(ss + EPS);
            if (MAT == 0) {
                const float qn = yn * 0.125f;
                DS[c * 64 + lane] = (bf16_t)f2bf(qn);
                QG[c * 64 + perm16(lane)] = (bf16_t)f2bf(qn * egS[c]);
            } else {
                DS[c * 64 + lane] = (bf16_t)f2bf(yn);
            }
        }
    }
}

DI void gdn_tinv(LAS const float* AST, LAS bf16_t* TS, int lane) {
    const int hb = lane >> 5, j = lane & 31, r32 = j, hi = hb;
    LAS const float* Ab = AST + (32 * hb) * 68 + 32 * hb;
    float x[32];
#pragma unroll
    for (int r = 0; r < 32; ++r) x[r] = (r == j) ? 1.0f : 0.0f;
#pragma unroll
    for (int jj = 0; jj < 31; ++jj) {
        const float xj = x[jj];
        LAS const float* ap = Ab + jj * 68;
#pragma unroll
        for (int r4 = (jj + 1) / 4; r4 < 8; ++r4) {
            const f32x4 a = *(LAS const f32x4*)(ap + 4 * r4);
#pragma unroll
            for (int e = 0; e < 4; ++e) if (4 * r4 + e > jj) x[4 * r4 + e] -= a[e] * xj;
        }
    }
    bf16x8 a21[2];
#pragma unroll
    for (int s = 0; s < 2; ++s) { float t[8];
#pragma unroll
        for (int jj = 0; jj < 8; ++jj) t[jj] = AST[(16 * s + 8 * hi + jj) * 68 + 32 + r32];
        const u32x4 p = (u32x4){pk2(t[0], t[1]), pk2(t[2], t[3]), pk2(t[4], t[5]), pk2(t[6], t[7])}; a21[s] = __builtin_bit_cast(bf16x8, p); }
    f32x16 M = {};
#pragma unroll
    for (int s = 0; s < 2; ++s) { float t[8];
#pragma unroll
        for (int jj = 0; jj < 8; ++jj) {
            const auto rr = __builtin_amdgcn_permlane32_swap(__float_as_uint(x[16 * s + 8 + jj]), __float_as_uint(x[16 * s + 8 + jj]), false, false);
            t[jj] = hi ? __uint_as_float(rr[0]) : x[16 * s + jj];
        }
        const u32x4 p = (u32x4){pk2(t[0], t[1]), pk2(t[2], t[3]), pk2(t[4], t[5]), pk2(t[6], t[7])};
        M = MFMA32(a21[s], __builtin_bit_cast(bf16x8, p), M);
    }
    asm volatile("s_waitcnt lgkmcnt(0)" ::: "memory");
#pragma unroll
    for (int i = 0; i < 32; ++i) TS[(32 * hb + i) * 64 + 32 * hb + j] = (bf16_t)f2bf(x[i]);
    asm volatile("s_waitcnt lgkmcnt(0)" ::: "memory");
    f32x16 T21 = {};
#pragma unroll
    for (int s = 0; s < 2; ++s) {
        const u32x2 lo = *(LAS const u32x2*)(TS + (32 + r32) * 64 + 32 + 16 * s + 4 * hi), hi8 = *(LAS const u32x2*)(TS + (32 + r32) * 64 + 32 + 16 * s + 8 + 4 * hi);
        const u32x4 p = (u32x4){lo.x, lo.y, hi8.x, hi8.y};
        T21 = MFMA32(__builtin_bit_cast(bf16x8, p), pack8(M, s), T21);
    }
#pragma unroll
    for (int i = 0; i < 16; ++i) TS[(32 + crow(i, hi)) * 64 + r32] = (bf16_t)f2bf(-T21[i]);
    asm volatile("s_waitcnt lgkmcnt(0)" ::: "memory");
}

template <bool PERM> DI void gdn_tmul(LAS const bf16_t* TS, LAS const bf16_t* RS, int lane, float sgn, bf16_t* out) {
    const int r32 = lane & 31, hi = lane >> 5;
    LAS const unsigned char* rb = (LAS const unsigned char*)RS + ((8 * hi + ((lane & 15) >> 2)) * 64 + 16 * ((lane >> 4) & 1) + 4 * (lane & 3)) * 2;
#pragma unroll
    for (int ct = 0; ct < 2; ++ct)
#pragma unroll
        for (int cb = 0; cb < 2; ++cb) {
            f32x16 acc = {};
#pragma unroll
            for (int ks = 0; ks < (ct == 0 ? 2 : 4); ++ks) {
                const bf16x8 fa = lds_frag_plain(TS, 32 * ct + r32, 2 * ks + hi);
                const s16x4 lo = tr_read_b64(rb + (16 * ks * 64 + 32 * cb) * 2), h4 = tr_read_b64(rb + ((16 * ks + 4) * 64 + 32 * cb) * 2);
                const bf16x8 fb = (bf16x8){lo[0], lo[1], lo[2], lo[3], h4[0], h4[1], h4[2], h4[3]};
                acc = MFMA32(fa, fb, acc);
            }
            bf16_t* ob = out + hi * 256 + (PERM ? perm16(32 * cb + r32) : 32 * cb + r32);
            asm volatile("" : "+v"(ob));
#pragma unroll
            for (int i = 0; i < 16; ++i) ob[(32 * ct + (i & 3) + 8 * (i >> 2)) * 64] = (bf16_t)f2bf(sgn * acc[i]);
        }
}

DI void gdn_prep_phase(const Params& P, LAS unsigned char* lds, int blk, int G, int wave, int lane_in) {
    const int pair = wave >> 1, role = wave & 1;
    LAS unsigned char* pb = lds + pair * PREP_PAIR;
    LAS bf16_t* QS = (LAS bf16_t*)pb; LAS bf16_t* KS = (LAS bf16_t*)(pb + 8192); LAS float* AS = (LAS float*)(pb + 16384);
    LAS float* gcS = (LAS float*)(pb + 16384 + 17408 + role * 1024); LAS float* betaS = gcS + 64; LAS float* egS = gcS + 128; LAS float* ekS = gcS + 192;
    const bf16_t* QKVB = (const bf16_t*)(P.ws + WS_QKVB); const float* GB = (const float*)(P.ws + WS_GB); const float* cw = P.in[9];
    const int NP = G * 4, NTASK = 2 * 8 * NCHUNK;
    for (int it = 0; it * NP < NTASK; ++it) {
        int lane = lane_in; asm volatile("" : "+v"(lane));
        const int r32 = lane & 31, hi = lane >> 5;
        const int task = it * NP + blk * 4 + pair;
        const bool active = task < NTASK;
        const int bh = task < 2048 ? (task >> 7) : (task - 2048), n = task < 2048 ? (task & 127) : 128, b = bh >> 3, h = bh & 7;
        const int sidx = bh * NCHUNK + n;
        bf16_t* GPW = (bf16_t*)(P.ws + WS_GP) + (size_t)sidx * 4096; bf16_t* GPQG = GPW + GP_ARR / 2; bf16_t* GPAQK = GPQG + GP_ARR / 2; bf16_t* GPKGT = GPAQK + GP_ARR / 2; bf16_t* GPU = GPKGT + GP_ARR / 2;
        float gc = 0.f, beta = 0.f;
        if (active) {
            const int pl = n * 64 + lane;
            float g = 0.f;
            if (pl < LTOK) { const float* gb = GB + ((size_t)(b * LP + pl) << 4); g = gb[h]; beta = gb[8 + h]; }
            gcS[lane] = g; LDS_WAIT();
            gc = 0.f;
#pragma unroll
            for (int j4 = 0; j4 < 16; ++j4) { const f32x4 t = *(LAS const f32x4*)(gcS + 4 * j4);
                gc += (4 * j4 <= lane ? t[0] : 0.f) + (4 * j4 + 1 <= lane ? t[1] : 0.f) + (4 * j4 + 2 <= lane ? t[2] : 0.f) + (4 * j4 + 3 <= lane ? t[3] : 0.f); }
            const float glast = rlane(gc, 63);
            LDS_WAIT();
            gcS[lane] = gc; betaS[lane] = beta; egS[lane] = (role == 0) ? __expf(gc) : beta * __expf(gc); ekS[lane] = __expf(glast - gc);
            if (role == 0 && lane == 0) ((float*)(P.ws + WS_GL))[sidx] = __expf(glast);
            LDS_WAIT();
            for (int rp_ = 0; rp_ < ((PREP_REP & 1) ? 2 : 1); ++rp_) {
            if (role == 0) prep_rows<0>(QKVB, cw, b, h, n, lane, egS, QS, GPQG);
            else prep_rows<1>(QKVB, cw, b, h, n, lane, egS, KS, GPQG);
            }
        }
        LDS_WAIT();
        __syncthreads();
        if (active) {
            for (int rp_ = 0; rp_ < ((PREP_REP & 2) ? 2 : 1); ++rp_)
#pragma unroll
            for (int t4 = 0; t4 < 4; ++t4) {
                const int ct = t4 >> 1, st = t4 & 1;
                f32x16 acc = {};
                if (!(ct == 0 && st == 1)) {
#pragma unroll
                    for (int ks = 0; ks < 4; ++ks) {
                        const bf16x8 fa = lds_frag_plain(role == 0 ? QS : KS, 32 * ct + r32, 2 * ks + hi), fb = lds_frag_plain(KS, 32 * st + r32, 2 * ks + hi);
                        acc = MFMA32(fa, fb, acc);
                    }
                }
                const float gcs = gcS[32 * st + r32];
                bf16_t* aqb = GPAQK + hi * 256 + perm16(r32); LAS float* asb = AS + r32 * 68 + hi * 4;        LAS const float* gcb = gcS + hi * 4; LAS const float* beb = betaS + hi * 4;
                asm volatile("" : "+v"(aqb), "+v"(asb), "+v"(gcb), "+v"(beb));
#pragma unroll
                for (int i = 0; i < 16; ++i) {
                    const int cr = 32 * ct + (i & 3) + 8 * (i >> 2);
                    const int cmp = (32 * st + r32) - 4 * hi;
                    const float dec = __expf(gcb[cr] - gcs);
                    if (role == 0) aqb[cr * 64 + 32 * st] = (bf16_t)f2bf((cmp <= cr) ? acc[i] * dec : 0.f);
                    else asb[32 * st * 68 + cr] = (cmp < cr) ? acc[i] * beb[cr] * dec : 0.f;
                }
            }
        }
        LDS_WAIT();
        __syncthreads();
        LAS bf16_t* TS = (LAS bf16_t*)((LAS unsigned char*)AS + 32 * 68 * 4);
        if (active) {
            if (role == 0) {
                prep_rows<2>(QKVB, cw, b, h, n, lane, betaS, QS  , GPQG);
            } else {
#pragma unroll
                for (int gq = 0; gq < 8; ++gq) {
                    float t[8];
#pragma unroll
                    for (int j = 0; j < 8; ++j) { const int c = perm16(8 * gq + j); t[j] = bf2f(KS[c * 64 + lane]) * ekS[c]; }
                    *(u32x4*)(GPKGT + lane * 64 + 8 * gq) = (u32x4){pk2(t[0], t[1]), pk2(t[2], t[3]), pk2(t[4], t[5]), pk2(t[6], t[7])};
                }
#pragma unroll 8
                for (int c = 0; c < 64; ++c) KS[c * 64 + lane] = (bf16_t)f2bf(bf2f(KS[c * 64 + lane]) * egS[c]);
                gdn_tinv(AS, TS, lane);
            }
        }
        LDS_WAIT();
        __syncthreads();
        if (active) {
            for (int rp_ = 0; rp_ < ((PREP_REP & 8) ? 2 : 1); ++rp_) {
            if (role == 0) gdn_tmul<false>(TS, QS, lane, 1.0f, GPU);
            else gdn_tmul<true>(TS, KS, lane, -1.0f, GPW);
            }
        }
        LDS_WAIT();
    }
}

constexpr int GS_STAGE = 40960 + 256;
constexpr int GS_OBUF = 2 * GS_STAGE;
static_assert(GS_OBUF + 32768 <= 131072, "gdn scan LDS");

#define GS_STEP(n, HW, HGW, STGW) do { \
        if (wave < 2) { \
            if (n < NCHUNK) { \
                LAS const unsigned char* sg = lds + (n & 1) * GS_STAGE; \
                LAS const bf16_t* Wm = (LAS const bf16_t*)sg; LAS const bf16_t* QGm = (LAS const bf16_t*)(sg + 8192); LAS const bf16_t* AQm = (LAS const bf16_t*)(sg + 16384); \
                LAS const bf16_t* KGm = (LAS const bf16_t*)(sg + 24576); LAS const bf16_t* Um = (LAS const bf16_t*)(sg + 32768); \
                const float gl = *(LAS const float*)(sg + 40960); \
                bf16x8 Sb[2][2]; Sb[0][0] = pack8(S0, 0); Sb[0][1] = pack8(S0, 1); Sb[1][0] = pack8(S1, 0); Sb[1][1] = pack8(S1, 1); \
                f32x16 vn[2], o[2]; \
        _Pragma("unroll") \
                for (int ct = 0; ct < 2; ++ct) { \
                    f32x16 acc; \
        _Pragma("unroll") \
                    for (int i = 0; i < 16; ++i) acc[i] = bf2f(Um[(32 * ct + crow(i, hi)) * 64 + vbase + r32]); \
                    f32x16 oo = {}; \
        _Pragma("unroll") \
                    for (int kt = 0; kt < 2; ++kt) \
        _Pragma("unroll") \
                        for (int s2 = 0; s2 < 2; ++s2) { \
                            acc = MFMA32(lds_frag(Wm, 32 * ct + r32, (2 * kt + s2) * 2 + hi), Sb[kt][s2], acc); \
                            oo = MFMA32(lds_frag(QGm, 32 * ct + r32, (2 * kt + s2) * 2 + hi), Sb[kt][s2], oo); \
                        } \
                    vn[ct] = acc; o[ct] = oo; \
                } \
                bf16x8 Vb[2][2]; Vb[0][0] = pack8(vn[0], 0); Vb[0][1] = pack8(vn[0], 1); Vb[1][0] = pack8(vn[1], 0); Vb[1][1] = pack8(vn[1], 1); \
        _Pragma("unroll") \
                for (int i = 0; i < 16; ++i) { S0[i] *= gl; S1[i] *= gl; } \
        _Pragma("unroll") \
                for (int ct = 0; ct < 2; ++ct) \
        _Pragma("unroll") \
                    for (int s2 = 0; s2 < 2; ++s2) { \
                        const int ch = (2 * ct + s2) * 2 + hi; \
                        o[0] = MFMA32(lds_frag(AQm, r32, ch), Vb[ct][s2], o[0]); \
                        o[1] = MFMA32(lds_frag(AQm, 32 + r32, ch), Vb[ct][s2], o[1]); \
                        S0 = MFMA32(lds_frag(KGm, r32, ch), Vb[ct][s2], S0); \
                        S1 = MFMA32(lds_frag(KGm, 32 + r32, ch), Vb[ct][s2], S1); \
                    } \
                LAS float* ob = (LAS float*)(lds + GS_OBUF + (n & 1) * 16384); \
        _Pragma("unroll") \
                for (int ct = 0; ct < 2; ++ct) \
        _Pragma("unroll") \
                    for (int i = 0; i < 16; ++i) ob[(32 * ct + crow(i, hi)) * 64 + vbase + r32] = o[ct][i]; \
            } \
        } else if (wave < 4) { \
            if (n > 0) { \
                LAS const float* ob = (LAS const float*)(lds + GS_OBUF + ((n - 1) & 1) * 16384); \
                const f32x4 gn = *(const f32x4*)(gnorm + 4 * vq); \
        _Pragma("unroll") \
                for (int it = 0; it < 8; ++it) { \
                    const int c = (wave - 2) * 32 + 4 * it + rg, p = (n - 1) * 64 + c; \
                    const f32x4 v = *(LAS const f32x4*)(ob + c * 64 + 4 * vq); \
                    const float ss = row_sum16((v[0] * v[0] + v[1] * v[1]) + (v[2] * v[2] + v[3] * v[3])); \
                    const float rn = __builtin_amdgcn_rsqf(ss * (1.0f / 64.0f) + EPS); \
                    const u32x2 zz = zq[it]; \
                    const float z0 = __uint_as_float(zz.x << 16), z1 = __uint_as_float(zz.x & 0xffff0000u), z2 = __uint_as_float(zz.y << 16), z3 = __uint_as_float(zz.y & 0xffff0000u); \
                    const float y0 = v[0] * rn * gn[0] * z0, y1 = v[1] * rn * gn[1] * z1, y2 = v[2] * rn * gn[2] * z2, y3 = v[3] * rn * gn[3] * z3; \
                    if ((p >= NMETA) && (p < LTOK)) *(u32x2*)(MIX + (size_t)(b * SEQ + p - NMETA) * 1024 + 512 + h * 64 + 4 * vq) = (u32x2){pk2(y0, y1), pk2(y2, y3)}; \
                } \
            } \
            if (n < NCHUNK) { GS_ZLOAD(n); } \
        } else { \
            if (n + 1 < NCHUNK) { GS_WRITE(HW, HGW, STGW); if (n + 2 < NCHUNK) GS_ISSUE(HW, HGW, n + 2); } \
        } \
        BAR_LDS(); } while (0)
DI void gdn_scan(const Params& P, LAS unsigned char* lds, int bh, int tid, int wave, int lane) {
    const int b = bh >> 3, h = bh & 7, r32 = lane & 31, hi = lane >> 5;
    const int task0 = (b * 8 + h) * NCHUNK;
    const bf16_t* GP0 = (const bf16_t*)(P.ws + WS_GP);
    const float* GLg = (const float*)(P.ws + WS_GL);
    const bf16_t* ZB = (const bf16_t*)(P.ws + WS_ZB); bf16_t* MIX = (bf16_t*)(P.ws + WS_MIX); const float* gnorm = P.in[12];
    const int lt = tid - 256;
    u32x4 holdA[10]; float hglA = 0.f;
#define GS_ISSUE(H, HG, n_) do { _Pragma("unroll") for (int i = 0; i < 10; ++i) { const int a_ = i >> 1, e_ = lt + 256 * (i & 1); \
            H[i] = *(const u32x4*)(GP0 + (size_t)a_ * (GP_ARR / 2) + (size_t)(task0 + (n_)) * 4096 + e_ * 8); } \
        if (lt == 0) HG = GLg[task0 + (n_)]; } while (0)
#define GS_WRITE(H, HG, stg_) do { LAS unsigned char* sg_ = lds + (stg_) * GS_STAGE; \
        _Pragma("unroll") for (int i = 0; i < 10; ++i) { const int a_ = i >> 1, e_ = lt + 256 * (i & 1), row_ = e_ >> 3, ch_ = e_ & 7; \
            *(LAS u32x4*)(sg_ + a_ * 8192 + row_ * 128 + (((a_ < 4) ? (ch_ ^ (row_ & 7)) : ch_) << 4)) = H[i]; } \
        if (lt == 0) *(LAS float*)(sg_ + 40960) = HG; } while (0)
    const int vq = lane & 15, rg = lane >> 4;
    u32x2 zq[8];
#define GS_ZLOAD(n_) do { _Pragma("unroll") for (int it = 0; it < 8; ++it) { int p_ = (n_) * 64 + (wave - 2) * 32 + 4 * it + rg; p_ = p_ < LTOK ? p_ : LTOK - 1; \
            zq[it] = *(const u32x2*)(ZB + (size_t)(b * LP + p_) * 512 + h * 64 + 4 * vq); } } while (0)
    if (wave >= 4) { GS_ISSUE(holdA, hglA, 0); GS_WRITE(holdA, hglA, 0); GS_ISSUE(holdA, hglA, 1); }
    if (wave == 2 || wave == 3) { GS_ZLOAD(0); }
    __syncthreads();
    f32x16 S0 = {}, S1 = {};
    const int vbase = 32 * wave;
    for (int n2 = 0; n2 <= NCHUNK; n2 += 2) { GS_STEP((n2), holdA, hglA, 1); GS_STEP((n2 + 1), holdA, hglA, 0); }
}

constexpr int AT_STAGE = 32768;
constexpr int AT_XBUF = 2 * AT_STAGE;
constexpr int AT_WSF = AT_XBUF + 65536;
constexpr int AT_UNIT = AT_WSF + 2048;
constexpr float AT_THR = 8.0f;

DI float max3f(float a, float b, float c) { return __builtin_fmaxf(__builtin_fmaxf(a, b), c); }
DI s16x4 tr_read(LAS const unsigned char* p) { return __builtin_bit_cast(s16x4, __builtin_amdgcn_ds_read_tr16_b64_v4i16((LAS v4i16_t*)p)); }

DI void attn_unit(const Params& P, LAS unsigned char* lds, int bh, int qi, int tid, int wave, int lane, float lam) {
    const int b = bh >> 2, h = bh & 3, r32 = lane & 31, hi = lane >> 5, qsub = wave >> 1, map = wave & 1, hh = 2 * h + map;
    const bf16_t* QB = (const bf16_t*)(P.ws + WS_QB); const bf16_t* KT = (const bf16_t*)(P.ws + WS_KT); const bf16_t* VT = (const bf16_t*)(P.ws + WS_VT);
    const int ntiles = 2 * qi + 3, my_nt = (qsub < 2) ? ntiles - 1 : ntiles;
    const bf16_t* k1 = KT + ((size_t)((b * 8 + 2 * h) * NKT) << 12) + tid * 8;
    const bf16_t* k2 = KT + ((size_t)((b * 8 + 2 * h + 1) * NKT) << 12) + tid * 8;
    const bf16_t* vv = VT + ((size_t)((b * 4 + h) * NKT) << 13) + tid * 8;
    u32x4 st[4];
#define AT_LOAD(t) do { st[0] = *(const u32x4*)(k1 + ((size_t)(t) << 12)); st[1] = *(const u32x4*)(k2 + ((size_t)(t) << 12)); \
                        st[2] = *(const u32x4*)(vv + ((size_t)(t) << 13)); st[3] = *(const u32x4*)(vv + ((size_t)(t) << 13) + 4096); } while (0)
#define AT_STORE(sb) do { LAS unsigned char* d_ = lds + (sb) * AT_STAGE + tid * 16; *(LAS u32x4*)d_ = st[0]; *(LAS u32x4*)(d_ + 8192) = st[1]; \
                          *(LAS u32x4*)(d_ + 16384) = st[2]; *(LAS u32x4*)(d_ + 24576) = st[3]; } while (0)
    AT_LOAD(0);
    bf16x8 qr[4];
    { const bf16_t* q = QB + ((size_t)((b * 8 + hh) * SEQ + qi * 128 + qsub * 32 + r32) << 6) + hi * 8;
#pragma unroll
      for (int d0 = 0; d0 < 4; ++d0) qr[d0] = *(const bf16x8*)(q + d0 * 16); }
    AT_STORE(0);
    __syncthreads();
    LAS float* wsf = (LAS float*)(lds + AT_WSF) + wave * 64;
    float m_run = 0.f, l_run = 0.f;
    f32x16 negm = {};
    f32x16 o[4]; o[0] = f32x16{}; o[1] = f32x16{}; o[2] = f32x16{}; o[3] = f32x16{};
    for (int t = 0; t < ntiles; ++t) {
        if (t + 1 < ntiles) AT_LOAD(t + 1);
        if (t < my_nt) {
            LAS const unsigned char* sg = lds + (t & 1) * AT_STAGE;
            LAS const unsigned char* kb = sg + map * 8192 + hi * 1024 + r32 * 16;
            f32x16 p0 = negm, p1 = negm;
#pragma unroll
            for (int d0 = 0; d0 < 4; ++d0) {
                const bf16x8 a0 = *(LAS const bf16x8*)(kb + d0 * 2048), a1 = *(LAS const bf16x8*)(kb + d0 * 2048 + 512);
                p0 = MFMA32(a0, qr[d0], p0); p1 = MFMA32(a1, qr[d0], p1);
            }
            const bool first = (t == 0);
            if (first) {
#pragma unroll
                for (int r = 0; r < 16; ++r) { if (crow(r, hi) >= NMETA) p0[r] = -INFINITY; p1[r] = -INFINITY; }
            }
            float ma = max3f(p0[0], p0[1], p1[0]), mb = max3f(p0[2], p0[3], p1[1]); ma = max3f(ma, p1[2], p1[3]);
#pragma unroll
            for (int r = 4; r < 16; r += 4) { ma = max3f(ma, p0[r], p0[r + 1]); mb = max3f(mb, p0[r + 2], p0[r + 3]); ma = max3f(ma, p1[r], p1[r + 1]); mb = max3f(mb, p1[r + 2], p1[r + 3]); }
            const float rm = swap32_max(max3f(ma, mb, mb));
            if (first || __any(rm > AT_THR)) {
                const float dl = first ? rm : fmaxf(rm, 0.f);
                m_run += dl;
#pragma unroll
                for (int r = 0; r < 16; ++r) { p0[r] -= dl; p1[r] -= dl; negm[r] = -m_run; }
                const float alpha = __builtin_amdgcn_exp2f(-dl);
                l_run *= alpha;
                if (!first) {
                    if (hi == 0) wsf[r32] = alpha;
                    LDS_WAIT();
#pragma unroll
                    for (int r = 0; r < 16; ++r) { const float a = wsf[crow(r, hi)];
#pragma unroll
                        for (int d0 = 0; d0 < 4; ++d0) o[d0][r] *= a; }
                    LDS_WAIT();
                }
            }
            float ls0 = 0.f, ls1 = 0.f;
#pragma unroll
            for (int r = 0; r < 16; ++r) { p0[r] = __builtin_amdgcn_exp2f(p0[r]); p1[r] = __builtin_amdgcn_exp2f(p1[r]); ls0 += p0[r]; ls1 += p1[r]; }
            l_run += ls0 + ls1;
            const bf16x8 pa0 = pack8(p0, 0), pa1 = pack8(p0, 1), pa2 = pack8(p1, 0), pa3 = pack8(p1, 1);
            LAS const unsigned char* vb = sg + 16384 + ((lane >> 4) & 1) * 32 + (lane & 3) * 8 + (4 * hi + ((lane & 15) >> 2)) * 64;
            bf16x8 vfa[4], vfb[4];
#define AT_VLD(V, d0_) do { _Pragma("unroll") for (int ks = 0; ks < 4; ++ks) { const s16x4 lo_ = tr_read(vb + (d0_) * 4096 + ks * 1024), hi_ = tr_read(vb + (d0_) * 4096 + ks * 1024 + 512); \
                V[ks] = (bf16x8){lo_[0], lo_[1], lo_[2], lo_[3], hi_[0], hi_[1], hi_[2], hi_[3]}; } } while (0)
#define AT_PV(V, d0_) do { o[d0_] = MFMA32(pa0, V[0], o[d0_]); o[d0_] = MFMA32(pa1, V[1], o[d0_]); o[d0_] = MFMA32(pa2, V[2], o[d0_]); o[d0_] = MFMA32(pa3, V[3], o[d0_]); } while (0)
            AT_VLD(vfa, 0); AT_VLD(vfb, 1);
            AT_PV(vfa, 0); AT_VLD(vfa, 2);
            AT_PV(vfb, 1); AT_VLD(vfb, 3);
            AT_PV(vfa, 2);
            AT_PV(vfb, 3);
#undef AT_VLD
#undef AT_PV
        }
        if (t + 1 < ntiles) AT_STORE((t + 1) & 1);
        __syncthreads();
    }
    l_run = swap32_add(l_run);
    const float sc = (map ? lam : 1.0f) / l_run;
    if (hi == 0) wsf[r32] = sc;
    LDS_WAIT();
#pragma unroll
    for (int r = 0; r < 16; ++r) { const float a = wsf[crow(r, hi)];
#pragma unroll
        for (int d0 = 0; d0 < 4; ++d0) o[d0][r] *= a; }
    LAS float* xb = (LAS float*)(lds + AT_XBUF + qsub * 16384);
    if (map) {
#pragma unroll
        for (int d0 = 0; d0 < 4; ++d0)
#pragma unroll
            for (int r = 0; r < 16; ++r) xb[(d0 * 16 + r) * 64 + lane] = o[d0][r];
    }
    __syncthreads();
    if (!map) {
        const float* dn = P.in[8];
        bf16_t* MIX = (bf16_t*)(P.ws + WS_MIX);
        float ss[16];
#pragma unroll
        for (int r = 0; r < 16; ++r) { ss[r] = 0.f;
#pragma unroll
            for (int d0 = 0; d0 < 4; ++d0) { o[d0][r] -= xb[(d0 * 16 + r) * 64 + lane]; ss[r] += o[d0][r] * o[d0][r]; } }
#pragma unroll
        for (int r = 0; r < 16; ++r) {
            ss[r] = half_sum32(ss[r]);
            ss[r] = 0.8f / sqrtf(ss[r] * (1.0f / 128.0f) + EPS);
        }
        float dg[4];
#pragma unroll
        for (int d0 = 0; d0 < 4; ++d0) dg[d0] = dn[32 * d0 + r32];
#pragma unroll
        for (int r = 0; r < 16; ++r) {
            bf16_t* orow = MIX + (size_t)(b * SEQ + qi * 128 + qsub * 32 + crow(r, hi)) * 1024 + h * 128 + r32;
#pragma unroll
            for (int d0 = 0; d0 < 4; ++d0) orow[32 * d0] = (bf16_t)f2bf(o[d0][r] * ss[r] * dg[d0]);
        }
    }
    __syncthreads();
#undef AT_LOAD
#undef AT_STORE
}

DI void attn_phase(const Params& P, LAS unsigned char* lds, int tid, int wave, int lane) {
    unsigned* ctl = (unsigned*)(P.ws + WS_CTL);
    const float* lq1 = P.in[4]; const float* lk1 = P.in[5]; const float* lq2 = P.in[6]; const float* lk2 = P.in[7];
    const float lam = __expf(wave_sum(lq1[lane] * lk1[lane])) - __expf(wave_sum(lq2[lane] * lk2[lane])) + 0.2f;
    LAS volatile int* ub = (LAS volatile int*)(lds + AT_UNIT);
    for (;;) {
        if (tid == 0) *ub = (int)__hip_atomic_fetch_add(ctl + CW_ATTQ, 1u, __ATOMIC_RELAXED, __HIP_MEMORY_SCOPE_AGENT);
        __syncthreads();
        const int u = *ub;
        __syncthreads();
        if (u >= 512) break;
        attn_unit(P, lds, u & 7, 63 - (u >> 3), tid, wave, lane, lam);
    }
}

struct EpiOutProj {
    static constexpr bool PERM = false, AFTER_DRAIN = false;
    const float* x; float* out;
    DI void operator()(const pg8::f32x4 (&acc)[2][2][4][2], const pg8::Unit& u, int wr, int wc, int fr, int fq) const {
        const int row0 = u.pm * 256 + wr * 64 + fr, col0 = u.pn * 256 + wc * 32 + 4 * fq;
#pragma unroll
        for (int ai = 0; ai < 2; ++ai)
#pragma unroll
            for (int m = 0; m < 4; ++m) { const size_t off = (size_t)(row0 + ai * 128 + m * 16) * 1024 + col0;
#pragma unroll
                for (int bj = 0; bj < 2; ++bj)
#pragma unroll
                    for (int n = 0; n < 2; ++n) { const f32x4 xv = *(const f32x4*)(x + off + bj * 128 + n * 16); *(f32x4*)(out + off + bj * 128 + n * 16) = acc[ai][bj][m][n] + xv; } }
    }
};

typedef float f32x4v __attribute__((ext_vector_type(4)));
DI void route_tile(const Params& P, int tile, LAS float* lg  , int lane) {
    const float* h2 = P.out; const float* WR = (const float*)(P.ws + WS_WR);
    const int r16 = lane & 15, kq = lane >> 4;
    const float* arow = h2 + (size_t)(tile * 16 + r16) * 1024 + kq * 256;
    const float* b0 = WR + (size_t)r16 * 1024 + kq * 256; const float* b1 = b0 + 16 * 1024; const float* b2 = WR + (size_t)(32 + (r16 & 3)) * 1024 + kq * 256;
    const float z2 = (r16 < 4) ? 1.0f : 0.0f;
    f32x4v c0 = {}, c1 = {}, c2 = {};
    float ss = 0.f;
    for (int t4 = 0; t4 < 64; ++t4) {
        const f32x4 a = *(const f32x4*)(arow + 4 * t4), w0 = *(const f32x4*)(b0 + 4 * t4), w1 = *(const f32x4*)(b1 + 4 * t4), w2 = *(const f32x4*)(b2 + 4 * t4);
        ss += (a.x * a.x + a.y * a.y) + (a.z * a.z + a.w * a.w);
#pragma unroll
        for (int i = 0; i < 4; ++i) {
            c0 = __builtin_amdgcn_mfma_f32_16x16x4f32(a[i], w0[i], c0, 0, 0, 0);
            c1 = __builtin_amdgcn_mfma_f32_16x16x4f32(a[i], w1[i], c1, 0, 0, 0);
            c2 = __builtin_amdgcn_mfma_f32_16x16x4f32(a[i], w2[i] * z2, c2, 0, 0, 0);
        }
    }
    ss += swz_xor16(ss); ss = swap32_add(ss);
    const float rs = 1.0f / sqrtf(ss * (1.0f / 1024.0f) + EPS);
#pragma unroll
    for (int r = 0; r < 4; ++r) { const int row = 4 * kq + r; lg[row * 48 + r16] = c0[r]; lg[row * 48 + 16 + r16] = c1[r]; lg[row * 48 + 32 + r16] = c2[r]; }
    LDS_WAIT();
    if (lane < 16) {
        const int t = tile * 16 + lane;
        const float* bg = P.in[16]; const float* br = P.in[18];
        LAS const float* l = lg + lane * 48;
        float gl[4]; int gs = 0; float gm;
#pragma unroll
        for (int j = 0; j < 4; ++j) gl[j] = l[j] * rs + bg[j];
        gm = gl[0];
#pragma unroll
        for (int j = 1; j < 4; ++j) if (gl[j] > gm) { gm = gl[j]; gs = j; }
        float gsum = 0.f;
#pragma unroll
        for (int j = 0; j < 4; ++j) gsum += __expf(gl[j] - gm);
        const float psel = 1.0f / gsum;
        float e1 = -INFINITY, e2 = -INFINITY; int i1 = 0, i2 = 0;
#pragma unroll
        for (int j = 0; j < 8; ++j) {
            const float v = l[4 + gs * 8 + j] * rs + br[gs * 8 + j];
            if (v > e1) { e2 = e1; i2 = i1; e1 = v; i1 = j; } else if (v > e2) { e2 = v; i2 = j; }
        }
        const float x2 = __expf(e2 - e1), w1 = psel / (1.0f + x2), w2 = psel * x2 / (1.0f + x2);
        const int ea = gs * 8 + i1, eb = gs * 8 + i2;
        unsigned* cnt = (unsigned*)(P.ws + WS_CTL) + CW_CNT;
        const int pa = (int)atomicAdd(cnt + ea, 1u), pb = (int)atomicAdd(cnt + eb, 1u);
        ((int*)(P.ws + WS_TOKE))[2 * t] = ea; ((int*)(P.ws + WS_TOKE))[2 * t + 1] = eb;
        ((float*)(P.ws + WS_TOKW))[2 * t] = w1; ((float*)(P.ws + WS_TOKW))[2 * t + 1] = w2;
        ((int*)(P.ws + WS_TOKP))[2 * t] = pa; ((int*)(P.ws + WS_TOKP))[2 * t + 1] = pb;
        ((float*)(P.ws + WS_RS2))[t] = rs;
    }
    LDS_WAIT();
}

#ifndef P4A_REP
#define P4A_REP 0
#endif
DI void phase4a(const Params& P, LAS unsigned char* lds, int gw, int NGW, int wave, int lane) {
    LAS float* scr = (LAS float*)(lds + wave * 16384);
    for (int tile = gw; tile < MTOK / 16; tile += NGW) route_tile(P, tile, scr, lane);
    bf16_t* WGU = (bf16_t*)(P.ws + WS_WGU); bf16_t* WD = (bf16_t*)(P.ws + WS_WD);
    const float* wg = P.in[19]; const float* wu = P.in[20]; const float* wd = P.in[21]; const float* gf = P.in[14];
    constexpr int I_GU = 16 * 16, I_D = 4 * 32;
    for (int rp_ = 0; rp_ < (P4A_REP ? 2 : 1); ++rp_)
    for (int it = gw; it < 32 * (I_GU + I_D); it += NGW) {
        const int e = it / (I_GU + I_D), r = it % (I_GU + I_D);
        if (r < I_GU) { const int n0 = (r & 15) * 32, j = n0 >> 8, up = (n0 >> 7) & 1;
            const float* wsrc = (up ? wu : wg) + (size_t)e * 1024 * 256;
            const SrcGU s{wsrc, gf, 128 * j + (n0 & 127) - n0};
            transpose_item(s, WGU + (size_t)e * 512 * 1024, 1024, (r >> 4) * 64, n0, scr, lane); }
        else { const int r2 = r - I_GU; const SrcPlain s{wd + (size_t)e * 256 * 1024, 1024};
            transpose_item(s, WD + (size_t)e * 1024 * 256, 256, (r2 >> 5) * 64, (r2 & 31) * 32, scr, lane); }
    }
}

DI void expert_layout(const Params& P, int lane, int& cnt, int& base, int& tend) {
    const unsigned* c = (const unsigned*)(P.ws + WS_CTL) + CW_CNT;
    cnt = (lane < 32) ? (int)__hip_atomic_load(c + lane, __ATOMIC_RELAXED, __HIP_MEMORY_SCOPE_AGENT) : 0;
    const int tiles = (cnt + 255) >> 8;
    int inc = 0;
#pragma unroll
    for (int i = 0; i < 32; ++i) { const int ti = __builtin_amdgcn_readlane(tiles, i); inc += (i <= lane) ? ti : 0; }
    tend = inc; base = (inc - tiles) << 8;
}

DI void phase4b(const Params& P, int gw, int NGW, int lane) {
    int cnt, base, tend; expert_layout(P, lane, cnt, base, tend);
    bf16_t* XS = (bf16_t*)(P.ws + WS_XS); float* SLOTW = (float*)(P.ws + WS_SLOTW);
    const int* TOKE = (const int*)(P.ws + WS_TOKE); const float* TOKW = (const float*)(P.ws + WS_TOKW); int* TOKP = (int*)(P.ws + WS_TOKP); const float* RS2 = (const float*)(P.ws + WS_RS2);
    for (int t = gw; t < MTOK; t += NGW) {
        const f32x4* hr = (const f32x4*)(P.out + (size_t)t * 1024);
        const float rs = RS2[t];
        u32x2 w[4];
#pragma unroll
        for (int j = 0; j < 4; ++j) { const f32x4 v = hr[64 * j + lane]; w[j] = (u32x2){pk2(v.x * rs, v.y * rs), pk2(v.z * rs, v.w * rs)}; }
#pragma unroll
        for (int k = 0; k < 2; ++k) {
            const int e = __builtin_amdgcn_readfirstlane(TOKE[2 * t + k]), slot = __builtin_amdgcn_readlane(base, e) + TOKP[2 * t + k];
            u32x2* orow = (u32x2*)(XS + (size_t)slot * 1024);
#pragma unroll
            for (int j = 0; j < 4; ++j) orow[64 * j + lane] = w[j];
            if (lane == 0) { SLOTW[slot] = TOKW[2 * t + k]; TOKP[2 * t + k] = slot; }
        }
    }
    for (int e = 0; e < 32; ++e) {
        const int ce = __builtin_amdgcn_readlane(cnt, e), be = __builtin_amdgcn_readlane(base, e), end = be + (((ce + 255) >> 8) << 8);
        for (int r = be + ce + gw; r < end; r += NGW) { u32x2* orow = (u32x2*)(XS + (size_t)r * 1024);
#pragma unroll
            for (int j = 0; j < 4; ++j) orow[64 * j + lane] = (u32x2){0u, 0u};
            if (lane == 0) SLOTW[r] = 0.f; }
    }
}

struct GroupedOrder {
    int tend; int total; int G, c, NS;
    DI bool next(int i, pg8::Unit& u) const {
        const int L = i * G + c; if (L >= (total << NS)) return false;
        const int mt = L >> NS, j = L & ((1 << NS) - 1);
        const int e = __builtin_popcountll(__ballot(((int)(threadIdx.x & 63) < 32) && tend <= mt));
        u.pm = mt; u.pn = (e << NS) + j; return true;
    }
    DI void a_ready(const pg8::Unit&) const {}
    DI void done(const pg8::Unit&) const {}
};
struct EpiGateUp {
    static constexpr bool PERM = true, AFTER_DRAIN = false;
    const float* SLOTW; bf16_t* YS;
    DI void operator()(const pg8::f32x4 (&acc)[2][2][4][2], const pg8::Unit& u, int wr, int wc, int fr, int fq) const {
        const int f0 = (u.pn & 1) * 128 + wc * 32 + fq * 8;
#pragma unroll
        for (int ai = 0; ai < 2; ++ai)
#pragma unroll
            for (int m = 0; m < 4; ++m) {
                const int row = u.pm * 256 + ai * 128 + wr * 64 + m * 16 + fr;
                const float cw = SLOTW[row];
                float a[8];
#pragma unroll
                for (int i = 0; i < 4; ++i) {
                    const float g0 = acc[ai][0][m][0][i], g1 = acc[ai][0][m][1][i];
                    a[i] = g0 / (1.0f + __expf(-g0)) * acc[ai][1][m][0][i] * cw; a[4 + i] = g1 / (1.0f + __expf(-g1)) * acc[ai][1][m][1][i] * cw;
                }
                *(u32x4*)(YS + (size_t)row * 256 + f0) = (u32x4){pk2(a[0], a[1]), pk2(a[2], a[3]), pk2(a[4], a[5]), pk2(a[6], a[7])};
            }
    }
};
struct EpiDown {
    static constexpr bool PERM = true, AFTER_DRAIN = false;
    bf16_t* YO;
    DI void operator()(const pg8::f32x4 (&acc)[2][2][4][2], const pg8::Unit& u, int wr, int wc, int fr, int fq) const {
        const int c0 = (u.pn & 3) * 256 + wc * 32 + fq * 8;
#pragma unroll
        for (int ai = 0; ai < 2; ++ai)
#pragma unroll
            for (int m = 0; m < 4; ++m) {
                bf16_t* rowp = YO + (size_t)(u.pm * 256 + ai * 128 + wr * 64 + m * 16 + fr) * 1024 + c0;
#pragma unroll
                for (int bj = 0; bj < 2; ++bj) { const pg8::f32x4 v0 = acc[ai][bj][m][0], v1 = acc[ai][bj][m][1];
                    *(u32x4*)(rowp + bj * 128) = (u32x4){pk2(v0[0], v0[1]), pk2(v0[2], v0[3]), pk2(v1[0], v1[1]), pk2(v1[2], v1[3])}; }
            }
    }
};

DI void phase7(const Params& P, int gw, int NGW, int lane) {
    const bf16_t* YO = (const bf16_t*)(P.ws + WS_YO); const int* TOKP = (const int*)(P.ws + WS_TOKP); const f32x4* nf = (const f32x4*)P.in[22];
    for (int t = gw; t < MTOK; t += NGW) {
        f32x4* hr = (f32x4*)(P.out + (size_t)t * 1024);
        const u32x2* y0 = (const u32x2*)(YO + (size_t)TOKP[2 * t] * 1024); const u32x2* y1 = (const u32x2*)(YO + (size_t)TOKP[2 * t + 1] * 1024);
        f32x4 v[4]; float s = 0.f;
#pragma unroll
        for (int j = 0; j < 4; ++j) {
            v[j] = hr[64 * j + lane]; const u32x2 a = y0[64 * j + lane], c = y1[64 * j + lane];
            v[j].x += __uint_as_float(a.x << 16) + __uint_as_float(c.x << 16); v[j].y += __uint_as_float(a.x & 0xffff0000u) + __uint_as_float(c.x & 0xffff0000u);
            v[j].z += __uint_as_float(a.y << 16) + __uint_as_float(c.y << 16); v[j].w += __uint_as_float(a.y & 0xffff0000u) + __uint_as_float(c.y & 0xffff0000u);
            s += (v[j].x * v[j].x + v[j].y * v[j].y) + (v[j].z * v[j].z + v[j].w * v[j].w);
        }
        s = wave_sum(s);
        const float rs = 1.0f / sqrtf(s * (1.0f / 1024.0f) + EPS);
#pragma unroll
        for (int j = 0; j < 4; ++j) hr[64 * j + lane] = v[j] * rs * nf[64 * j + lane];
    }
}

#define XB_TMO      128
#define XB_XCNT(j)  (256  + 64 * (j))
#define XB_XSUB(j)  (1280 + 64 * (j))
#define XB_XGEN(j)  (2304 + 64 * (j))
#define XB_TOP      3328
#define XB_TOPGEN   3392
#define XCD_BAR_WORDS 3456
#define XB_SPIN_CAP (1u << 18)

__device__ __forceinline__ unsigned xb_ld(unsigned* p)              { return __hip_atomic_load(p, __ATOMIC_RELAXED, __HIP_MEMORY_SCOPE_AGENT); }
__device__ __forceinline__ unsigned xb_add(unsigned* p, unsigned v) { return __hip_atomic_fetch_add(p, v, __ATOMIC_RELAXED, __HIP_MEMORY_SCOPE_AGENT); }
__device__ __forceinline__ unsigned xb_xcc_id() { return (unsigned)__builtin_amdgcn_s_getreg((3 << 11) | 20) & 0xFu; }
#define XB_SPIN(cond, bar) do { unsigned _sp = 0; while (cond) { __builtin_amdgcn_s_sleep(1); \
    if ((++_sp & 255u) == 0u) { if (xb_ld(&(bar)[XB_TMO])) break; if (_sp > XB_SPIN_CAP) { atomicAdd(&(bar)[XB_TMO], 1u); break; } } } } while (0)

struct XcdBarrier {
    unsigned* bar; unsigned x;
    volatile LAS unsigned* st;
};

__device__ __forceinline__ XcdBarrier xcd_barrier_post(unsigned* bar, volatile LAS unsigned* st) {
    XcdBarrier b; b.bar = bar; b.x = xb_xcc_id(); b.st = st;
    if (threadIdx.x == 0) (void)xb_add(&bar[XB_XCNT(b.x)], 1u);
    return b;
}
__device__ __forceinline__ void xcd_barrier_complete(unsigned* bar, unsigned x, unsigned& nloc, unsigned& nx) {
    const unsigned G = gridDim.x * gridDim.y * gridDim.z;
    unsigned sum, cnt, mine, sp = 0u;
    for (;;) {
        sum = 0u; cnt = 0u; mine = 0u;
#pragma unroll
        for (unsigned j = 0; j < 16; ++j) { const unsigned c = xb_ld(&bar[XB_XCNT(j)]); sum += c; cnt += (c > 0u) ? 1u : 0u; mine = (j == x) ? c : mine; }
        if (sum == G) break;
        __builtin_amdgcn_s_sleep(1);
        if ((++sp & 255u) == 0u) { if (xb_ld(&bar[XB_TMO])) break; if (sp > XB_SPIN_CAP) { atomicAdd(&bar[XB_TMO], 1u); break; } }
    }
    nloc = mine > 0u ? mine : 1u; nx = cnt > 0u ? cnt : 1u;
}

__device__ __forceinline__ void xcd_barrier(const XcdBarrier& b) {
    asm volatile("s_waitcnt vmcnt(0)" ::: "memory");
    __syncthreads();
    if (threadIdx.x == 0) {
        unsigned* bar = b.bar;
        __builtin_amdgcn_s_waitcnt(0);
        unsigned nloc = b.st[0], nx = b.st[1];
        if (nloc == 0u) { xcd_barrier_complete(bar, b.x, nloc, nx); b.st[0] = nloc; b.st[1] = nx; }
        const unsigned old = xb_add(&bar[XB_XSUB(b.x)], 1u);
        const unsigned gen = old / nloc;
        if (old + 1u == (gen + 1u) * nloc) {
            __builtin_amdgcn_fence(__ATOMIC_RELEASE, "agent");
            asm volatile("s_waitcnt vmcnt(0)" ::: "memory");
            const unsigned og = xb_add(&bar[XB_TOP], 1u);
            const unsigned tg = og / nx;
            if (og + 1u == (tg + 1u) * nx) xb_add(&bar[XB_TOPGEN], 1u);
            else XB_SPIN(xb_ld(&bar[XB_TOPGEN]) == tg, bar);
            __builtin_amdgcn_fence(__ATOMIC_ACQUIRE, "agent");
            xb_add(&bar[XB_XGEN(b.x)], 1u);
            asm volatile("s_waitcnt vmcnt(0)" ::: "memory");
        } else {
            XB_SPIN(xb_ld(&bar[XB_XGEN(b.x)]) == gen, bar);
            __builtin_amdgcn_fence(__ATOMIC_ACQUIRE, "agent");
            asm volatile("s_waitcnt vmcnt(0)" ::: "memory");
        }
    }
    __syncthreads();
}

#ifndef PHMASK
#define PHMASK 2047
#endif
#ifndef REPMASK
#define REPMASK 0
#endif
#define REP(bit) for (int rep_ = 0; rep_ < ((REPMASK & (bit)) ? 2 : 1); ++rep_)
#define REPSYNC(bit) if ((REPMASK & (bit)) && rep_ == 0) GRID_BAR()
typedef const __attribute__((address_space(4))) Params* KParams;
DI Params load_params(KParams kp) { Params p;
#pragma unroll
    for (int i = 0; i < 23; ++i) p.in[i] = kp->in[i];
    p.out = kp->out; p.ws = kp->ws; return p; }
__global__ void __launch_bounds__(NTHREADS, 2) hymba_fwd(Params Pin) {
    extern __shared__ __attribute__((aligned(16))) unsigned char lds_raw[];
    LAS unsigned char* lds = (LAS unsigned char*)lds_raw;
    cg::grid_group grid = cg::this_grid();
    volatile LAS unsigned* bst = (volatile LAS unsigned*)(lds + LDS_BYTES - 64);
    if (threadIdx.x < 2) bst[threadIdx.x] = 0u;
    __syncthreads();
    const XcdBarrier xbar = xcd_barrier_post((unsigned*)(Pin.ws + WS_CTL) + CW_BAR, bst);
#define GRID_BAR() xcd_barrier(xbar)
    const int G = gridDim.x, blk = blockIdx.x, NGW = G * NWAVES, NGT = G * NTHREADS;
#define PHASE_IDS() KParams kp_ = (KParams)__builtin_amdgcn_kernarg_segment_ptr(); asm volatile("" : "+s"(kp_)); const Params P = load_params(kp_); int tid = threadIdx.x; asm volatile("" : "+v"(tid)); const int lane = tid & 63, wave = __builtin_amdgcn_readfirstlane(tid >> 6), gw = blk * NWAVES + wave, gtid = blk * NTHREADS + tid; (void)lane; (void)gw; (void)gtid; (void)wave

    REP(1) { if (PHMASK & 1) { PHASE_IDS(); phase0(P, lds, gw, NGW, gtid, NGT, wave, lane); } REPSYNC(1); }
    GRID_BAR();
    REP(2) { if (PHMASK & 2) { PHASE_IDS();
        pg8::Gemm g{(const bf16_t*)(P.ws + WS_XB), (const bf16_t*)(P.ws + WS_WINT), MROWS, NPROJ, 1024};
        pg8::StaticOrder S; S.init(MROWS, NPROJ, G, blk);
        EpiInProj E{(const float*)(P.ws + WS_RS1), (const float*)(P.ws + WS_COS), (const float*)(P.ws + WS_SIN), P.in[10], P.in[11],
                    (bf16_t*)(P.ws + WS_QB), (bf16_t*)(P.ws + WS_KT), (bf16_t*)(P.ws + WS_VT), (bf16_t*)(P.ws + WS_QKVB), (bf16_t*)(P.ws + WS_ZB), (float*)(P.ws + WS_GB)};
        pg8::gemm_phase<EpiInProj, pg8::StaticOrder, true, true>(lds, g, S, E);
    } REPSYNC(2); }
    GRID_BAR();
    REP(4) { if (PHMASK & 4) { PHASE_IDS(); gdn_prep_phase(P, lds, blk, G, wave, lane); } REPSYNC(4); }
    GRID_BAR();
    REP(8) { if ((PHMASK & 8) && blk < 16) { PHASE_IDS(); gdn_scan(P, lds, blk, tid, wave, lane); } }
    REP(16) {
    if (PHMASK & 16) { PHASE_IDS(); attn_phase(P, lds, tid, wave, lane); }
    if ((REPMASK & 16) && rep_ == 0) { GRID_BAR(); if (blk == 0 && threadIdx.x == 0) { PHASE_IDS(); __hip_atomic_store((unsigned*)(P.ws + WS_CTL) + CW_ATTQ, 0u, __ATOMIC_RELAXED, __HIP_MEMORY_SCOPE_AGENT); } GRID_BAR(); }
    }
    GRID_BAR();
    REP(32) { if (PHMASK & 32) { PHASE_IDS();
        pg8::Gemm g{(const bf16_t*)(P.ws + WS_MIX), (const bf16_t*)(P.ws + WS_WOUT), MTOK, 1024, 1024};
        pg8::StaticOrder S; S.init(MTOK, 1024, G, blk);
        EpiOutProj E{P.in[0], P.out};
        pg8::gemm_phase<EpiOutProj, pg8::StaticOrder, true, true>(lds, g, S, E);
    } REPSYNC(32); }
    GRID_BAR();
    if (PHMASK & 64) { PHASE_IDS(); phase4a(P, lds, gw, NGW, wave, lane); }
    GRID_BAR();
    if (PHMASK & 128) { PHASE_IDS(); phase4b(P, gw, NGW, lane); }
    GRID_BAR();
    int cnt, base, tend, total; { PHASE_IDS(); expert_layout(P, lane, cnt, base, tend); total = __builtin_amdgcn_readlane(tend, 31); }
    REP(256) { if (PHMASK & 256) { PHASE_IDS();
        pg8::Gemm g{(const bf16_t*)(P.ws + WS_XS), (const bf16_t*)(P.ws + WS_WGU), XS_ROWS, 32 * 512, 1024};
        GroupedOrder S{tend, total, G, blk, 1};
        EpiGateUp E{(const float*)(P.ws + WS_SLOTW), (bf16_t*)(P.ws + WS_YS)};
        pg8::gemm_phase<EpiGateUp, GroupedOrder, true, true>(lds, g, S, E);
    } REPSYNC(256); }
    GRID_BAR();
    REP(512) { if (PHMASK & 512) { PHASE_IDS();
        int kd = 256; asm volatile("" : "+s"(kd));
        pg8::Gemm g{(const bf16_t*)(P.ws + WS_YS), (const bf16_t*)(P.ws + WS_WD), XS_ROWS, 32 * 1024, kd};
        GroupedOrder S{tend, total, G, blk, 2};
        EpiDown E{(bf16_t*)(P.ws + WS_YO)};
        pg8::gemm_phase<EpiDown, GroupedOrder, true, true>(lds, g, S, E);
    } REPSYNC(512); }
    GRID_BAR();
    if (PHMASK & 1024) { PHASE_IDS(); phase7(P, gw, NGW, lane); }
}

extern "C" void kernel_launch(void* const* d_in, const int* in_sizes, int n_in, void* d_out, int out_size, void* d_ws, size_t ws_size, hipStream_t stream) {
    static int grid_blocks = 0;
    if (grid_blocks == 0) {
        if (n_in != 23 || out_size != MTOK * DMODEL || ws_size < WS_END) { fprintf(stderr, "kernel_launch: unexpected shapes (n_in %d out %d ws %zu)\n", n_in, out_size, ws_size); grid_blocks = -1; return; }
        int dev = 0, cus = 0, per_cu = 0;
        hipGetDevice(&dev);
        hipDeviceGetAttribute(&cus, hipDeviceAttributeMultiprocessorCount, dev);
        hipFuncSetAttribute((const void*)hymba_fwd, hipFuncAttributeMaxDynamicSharedMemorySize, LDS_BYTES);
        hipOccupancyMaxActiveBlocksPerMultiprocessor(&per_cu, (const void*)hymba_fwd, NTHREADS, LDS_BYTES);
        if (per_cu < 1) { fprintf(stderr, "kernel_launch: occupancy query says %d blocks/CU\n", per_cu); per_cu = 1; }
        grid_blocks = cus;
        (void)hipGetLastError();
    }
    if (grid_blocks < 0) return;
    hipMemsetAsync((char*)d_ws + WS_CTL, 0, CTL_BYTES, stream);
    Params p{};
    for (int i = 0; i < 23; ++i) p.in[i] = (const float*)d_in[i];
    p.out = (float*)d_out; p.ws = (unsigned char*)d_ws;
    void* args[] = {&p};
    hipError_t e = hipLaunchCooperativeKernel((const void*)hymba_fwd, dim3(grid_blocks), dim3(NTHREADS), args, LDS_BYTES, stream);
    if (e != hipSuccess) fprintf(stderr, "cooperative launch failed: %s (grid %d)\n", hipGetErrorString(e), grid_blocks);
}
```

```cpp
#include <hip/hip_runtime.h>
#include <hip/hip_cooperative_groups.h>
#include <cstdio>
#include <cstdint>
namespace cg = cooperative_groups;
#ifndef PG8_EPI_AGAIN
#define PG8_EPI_AGAIN(x) do {} while (0)
#endif
namespace pg8 {
#define PG8_LAS __attribute__((address_space(3)))
typedef unsigned short bf16_t;
typedef short bf16x8 __attribute__((ext_vector_type(8)));
typedef float f32x4 __attribute__((ext_vector_type(4)));
typedef unsigned u32x4 __attribute__((ext_vector_type(4)));
constexpr int BM = 256, BK = 64, HALF = 128, HTB = HALF * BK * 2  , STAGE_BYTES = 8 * HTB, NXCD = 8, WGM = 8;

__host__ __device__ __forceinline__ int lds_byte(int r, int c) { const int st = (r >> 4) * 2 + (c >> 5), rr = r & 15, cc = c & 31, ob = rr * 64 + cc * 2; return st * 1024 + (ob ^ (((ob >> 9) & 1) << 5)); }
__host__ __device__ __forceinline__ void stage_rc(int b, int& R, int& C) { const int st = b / 1024, sb = b % 1024, swz = sb ^ (((sb >> 9) & 1) << 5); R = (st >> 1) * 16 + swz / 64; C = (st & 1) * 32 + (swz % 64) / 2; }
__host__ __device__ __forceinline__ int perm32(int rho) { const int n = rho >> 4, i = rho & 15; return 8 * (i >> 2) + 4 * n + (i & 3); }

struct Unit { int pm, pn; };
struct Gemm { const bf16_t* A; const bf16_t* Bt; int M, N, K; };

struct StaticOrder {
    int nM, nN, nwg, G, c;
    __host__ __device__ void init(int M, int N, int G_, int c_) { nM = M / BM; nN = N / BM; nwg = nM * nN; G = G_; c = c_; }
    __host__ __device__ bool next(int i, Unit& u) const {
        const long L = (long)i * G + c; if (L >= nwg) return false;
        int wgid = (int)L; { const int q = nwg / NXCD, r = nwg % NXCD, xcd = wgid % NXCD, off = wgid / NXCD; wgid = (xcd < r ? xcd * (q + 1) : r * (q + 1) + (xcd - r) * q) + off; }
        const int nig = WGM * nN, gid = wgid / nig, fm = gid * WGM, gsz = (nM - fm) < WGM ? (nM - fm) : WGM;
        u.pm = fm + ((wgid % nig) % gsz); u.pn = (wgid % nig) / gsz; return true;
    }
    __device__ __forceinline__ void a_ready(const Unit&) const {}
    __device__ __forceinline__ void done(const Unit&) const {}
};

__device__ __forceinline__ unsigned cvt_pk_bf16(float lo, float hi) { unsigned r; asm volatile("v_cvt_pk_bf16_f32 %0, %1, %2" : "=v"(r) : "v"(lo), "v"(hi)); return r; }
typedef float f32x2 __attribute__((ext_vector_type(2)));
template <class Epi, class Sched, bool ALIGN_EPI = false, bool SP2 = false>
__device__ __forceinline__ void gemm_phase(PG8_LAS unsigned char* lds, const Gemm g, const Sched& S, const Epi& E) {
    int tid_o = threadIdx.x; asm volatile("" : "+v"(tid_o));
    const int tid = tid_o, wid = __builtin_amdgcn_readfirstlane(tid >> 6), lane = tid & 63, wr = wid >> 2, wc = wid & 3, fr = lane & 15, fq = lane >> 4;
    const int K = g.K, nt = K / BK;
    unsigned voffA[2], voffB[2];
#pragma unroll
    for (int i = 0; i < 2; ++i) { int R, C; stage_rc(tid * 16 + i * 8192, R, C); const int Rb = Epi::PERM ? ((R & ~31) + perm32(R & 31)) : R;
        voffA[i] = (unsigned)(R * K + C) * 2u; voffB[i] = (unsigned)(Rb * K + C) * 2u; }
    const size_t kstep = (size_t)(BK * 2);
    const size_t hstep = (size_t)HALF * K * 2;
    const size_t tstep = 2 * hstep;
    const unsigned ldsw = (unsigned)wid * 1024u;
    const int aoff = lds_byte(wr * 64 + fr, fq * 8), boff = lds_byte(wc * 32 + fr, fq * 8);
#define PG8_SA(b, h) (((b) * 2 + (h)) * HTB)
#define PG8_SB(b, h) ((4 + (b) * 2 + (h)) * HTB)
#define PG8_STAGE(bufoff, gbase, voff) do { _Pragma("unroll") for (int _i = 0; _i < 2; ++_i) \
        __builtin_amdgcn_global_load_lds((const unsigned*)((const char*)(gbase) + (voff)[_i]), (PG8_LAS unsigned*)(lds + (bufoff) + ldsw + _i * 8192), 16, 0, 0); } while (0)
#define PG8_LDA(dst, b, h) do { _Pragma("unroll") for (int m = 0; m < 4; ++m) _Pragma("unroll") for (int k = 0; k < 2; ++k) dst[m][k] = *(const PG8_LAS bf16x8*)(lds + PG8_SA(b, h) + aoff + m * 2048 + k * 1024); } while (0)
#define PG8_LDB(dst, b, h) do { _Pragma("unroll") for (int n = 0; n < 2; ++n) _Pragma("unroll") for (int k = 0; k < 2; ++k) dst[n][k] = *(const PG8_LAS bf16x8*)(lds + PG8_SB(b, h) + boff + n * 2048 + k * 1024); } while (0)
#define PG8_MMA(ai, bj, At, Bt) do { __builtin_amdgcn_s_setprio(1); _Pragma("unroll") for (int m = 0; m < 4; ++m) _Pragma("unroll") for (int n = 0; n < 2; ++n) _Pragma("unroll") for (int k = 0; k < 2; ++k) \
        acc[ai][bj][m][n] = __builtin_amdgcn_mfma_f32_16x16x32_bf16(Bt[n][k], At[m][k], acc[ai][bj][m][n], 0, 0, 0); __builtin_amdgcn_s_setprio(0); } while (0)
#define PG8_WAIT_V(n) asm volatile("s_waitcnt vmcnt(" #n ")" ::: "memory")
#define PG8_WAIT_L(n) asm volatile("s_waitcnt lgkmcnt(" #n ")" ::: "memory")
#define PG8_BAR __builtin_amdgcn_s_barrier()
#define PG8_SCHED __builtin_amdgcn_sched_barrier(0)
    Unit cur, nxt; int ui = 0;
    if (!S.next(0, cur)) return;
    f32x4 acc[2][2][4][2];
#pragma unroll
    for (int a = 0; a < 2; ++a)
#pragma unroll
        for (int b = 0; b < 2; ++b)
#pragma unroll
            for (int m = 0; m < 4; ++m)
#pragma unroll
                for (int n = 0; n < 2; ++n) acc[a][b][m][n] = (f32x4){0.f, 0.f, 0.f, 0.f};
    bf16x8 At[4][2], B0[2][2], B1[2][2];
    const char* cA = (const char*)g.A + (size_t)cur.pm * tstep; const char* cB = (const char*)g.Bt + (size_t)cur.pn * tstep;
    S.a_ready(cur);
    if constexpr (SP2) {
        PG8_STAGE(PG8_SB(0, 0), cB, voffB); PG8_STAGE(PG8_SB(0, 1), cB + hstep, voffB); PG8_STAGE(PG8_SA(0, 0), cA, voffA); PG8_STAGE(PG8_SA(0, 1), cA + hstep, voffA);
        if (wr == 1) PG8_BAR;
        PG8_WAIT_V(2); PG8_BAR;
        PG8_STAGE(PG8_SB(1, 0), cB + kstep, voffB); PG8_STAGE(PG8_SA(1, 0), cA + kstep, voffA); PG8_STAGE(PG8_SB(1, 1), cB + hstep + kstep, voffB);
        PG8_WAIT_V(6); PG8_BAR;
    } else {
        PG8_STAGE(PG8_SB(0, 0), cB, voffB); PG8_STAGE(PG8_SA(0, 0), cA, voffA); PG8_STAGE(PG8_SB(0, 1), cB + hstep, voffB); PG8_STAGE(PG8_SA(0, 1), cA + hstep, voffA);
        if (wr == 1) PG8_BAR;
        PG8_WAIT_V(4); PG8_BAR;
        PG8_STAGE(PG8_SB(1, 0), cB + kstep, voffB); PG8_STAGE(PG8_SA(1, 0), cA + kstep, voffA); PG8_STAGE(PG8_SB(1, 1), cB + hstep + kstep, voffB);
        PG8_WAIT_V(6); PG8_BAR;
    }
    for (;;) {
        const bool has_next = S.next(ui + 1, nxt);
        const char* nA = has_next ? (const char*)g.A + (size_t)nxt.pm * tstep : cA; const char* nB = has_next ? (const char*)g.Bt + (size_t)nxt.pn * tstep : cB;
        for (int t = 0; t < nt; t += 2) {
            const bool last = (t == nt - 2);
            const char* a1 = cA + (size_t)(t + 1) * kstep;
            const char* a2 = last ? nA : cA + (size_t)(t + 2) * kstep; const char* b2 = last ? nB : cB + (size_t)(t + 2) * kstep;
            const char* a3 = a2 + kstep; const char* b3 = b2 + kstep;
            if (last && has_next) S.a_ready(nxt);
            if constexpr (SP2) {
            PG8_LDB(B0, 0, 0); PG8_LDB(B1, 0, 1); PG8_SCHED; PG8_LDA(At, 0, 0); PG8_STAGE(PG8_SA(1, 1), a1 + hstep, voffA);
            PG8_WAIT_V(8); PG8_WAIT_L(0); PG8_BAR; PG8_MMA(0, 0, At, B0); PG8_MMA(0, 1, At, B1); PG8_BAR; PG8_SCHED;
            PG8_LDA(At, 0, 1); PG8_STAGE(PG8_SB(0, 0), b2, voffB); PG8_STAGE(PG8_SB(0, 1), b2 + hstep, voffB); PG8_STAGE(PG8_SA(0, 0), a2, voffA);
            PG8_WAIT_V(8); PG8_WAIT_L(0); PG8_BAR; PG8_MMA(1, 0, At, B0); PG8_MMA(1, 1, At, B1); PG8_BAR; PG8_SCHED;
            PG8_LDB(B0, 1, 0); PG8_LDB(B1, 1, 1); PG8_SCHED; PG8_LDA(At, 1, 0); PG8_STAGE(PG8_SA(0, 1), a2 + hstep, voffA);
            PG8_WAIT_V(8); PG8_WAIT_L(0); PG8_BAR; PG8_MMA(0, 0, At, B0); PG8_MMA(0, 1, At, B1); PG8_BAR; PG8_SCHED;
            PG8_LDA(At, 1, 1); PG8_STAGE(PG8_SB(1, 0), b3, voffB); PG8_STAGE(PG8_SB(1, 1), b3 + hstep, voffB); PG8_STAGE(PG8_SA(1, 0), a3, voffA);
            PG8_WAIT_V(8); PG8_WAIT_L(0); PG8_BAR; PG8_MMA(1, 0, At, B0); PG8_MMA(1, 1, At, B1); PG8_BAR; PG8_SCHED;
            } else {
            PG8_LDB(B0, 0, 0); PG8_SCHED; PG8_LDA(At, 0, 0); PG8_STAGE(PG8_SA(1, 1), a1 + hstep, voffA);
            PG8_WAIT_L(8); PG8_BAR; PG8_WAIT_L(0); PG8_MMA(0, 0, At, B0); PG8_BAR; PG8_SCHED;
            PG8_LDB(B1, 0, 1); PG8_STAGE(PG8_SB(0, 0), b2, voffB);
            PG8_BAR; PG8_WAIT_L(0); PG8_MMA(0, 1, At, B1); PG8_BAR;
            PG8_LDA(At, 0, 1); PG8_STAGE(PG8_SA(0, 0), a2, voffA);
            PG8_BAR; PG8_WAIT_L(0); PG8_MMA(1, 0, At, B0); PG8_BAR; PG8_SCHED;
            PG8_STAGE(PG8_SB(0, 1), b2 + hstep, voffB);
            PG8_WAIT_V(6); PG8_BAR; PG8_MMA(1, 1, At, B1); PG8_BAR;
            PG8_LDB(B0, 1, 0); PG8_SCHED; PG8_LDA(At, 1, 0); PG8_STAGE(PG8_SA(0, 1), a2 + hstep, voffA);
            PG8_WAIT_L(8); PG8_BAR; PG8_WAIT_L(0); PG8_MMA(0, 0, At, B0); PG8_BAR; PG8_SCHED;
            PG8_LDB(B1, 1, 1); PG8_STAGE(PG8_SB(1, 0), b3, voffB);
            PG8_BAR; PG8_WAIT_L(0); PG8_MMA(0, 1, At, B1); PG8_BAR;
            PG8_LDA(At, 1, 1); PG8_STAGE(PG8_SA(1, 0), a3, voffA);
            PG8_BAR; PG8_WAIT_L(0); PG8_MMA(1, 0, At, B0); PG8_BAR; PG8_SCHED;
            PG8_STAGE(PG8_SB(1, 1), b3 + hstep, voffB);
            PG8_WAIT_V(6); PG8_BAR; PG8_MMA(1, 1, At, B1); PG8_BAR;
            }
        }
        if constexpr (ALIGN_EPI) { if (wr == 0) PG8_BAR; }
        if constexpr (!Epi::AFTER_DRAIN) { E(acc, cur, wr, wc, fr, fq); PG8_EPI_AGAIN(E(acc, cur, wr, wc, fr, fq)); S.done(cur); }
        if (!has_next) break;
#pragma unroll
        for (int a = 0; a < 2; ++a)
#pragma unroll
            for (int b = 0; b < 2; ++b)
#pragma unroll
                for (int m = 0; m < 4; ++m)
#pragma unroll
                    for (int n = 0; n < 2; ++n) acc[a][b][m][n] = (f32x4){0.f, 0.f, 0.f, 0.f};
        cur = nxt; cA = nA; cB = nB; ++ui;
        if constexpr (ALIGN_EPI) { if (wr == 1) PG8_BAR; }
    }
    PG8_WAIT_V(0);
    if constexpr (!ALIGN_EPI) { if (wr == 0) PG8_BAR; }
    PG8_BAR;
    if constexpr (Epi::AFTER_DRAIN) { E.fused(acc, cur, wr, wc, fr, fq, lds, wid, lane); S.done(cur); }
#undef PG8_SA
#undef PG8_SB
#undef PG8_STAGE
#undef PG8_LDA
#undef PG8_LDB
#undef PG8_MMA
#undef PG8_WAIT_V
#undef PG8_WAIT_L
#undef PG8_BAR
#undef PG8_SCHED
}
static_assert(true, "gather variant of gemm_phase (SP2 = true only): identical schedule, the A operand's rows are gathered through Sched::rowoff");
template <class Epi, class Sched, bool ALIGN_EPI = false, bool SP2 = false>
__device__ __forceinline__ void gemm_phase_g(PG8_LAS unsigned char* lds, const Gemm g, const Sched& S, const Epi& E) {
    int tid_o = threadIdx.x; asm volatile("" : "+v"(tid_o));
    const int tid = tid_o, wid = __builtin_amdgcn_readfirstlane(tid >> 6), lane = tid & 63, wr = wid >> 2, wc = wid & 3, fr = lane & 15, fq = lane >> 4;
    const int K = g.K, nt = K / BK;
    unsigned voffA[2], voffB[2]; int RA_[2]; unsigned CA_[2];
#pragma unroll
    for (int i = 0; i < 2; ++i) { int R, C; stage_rc(tid * 16 + i * 8192, R, C); const int Rb = Epi::PERM ? ((R & ~31) + perm32(R & 31)) : R;
        voffA[i] = (unsigned)(R * K + C) * 2u; voffB[i] = (unsigned)(Rb * K + C) * 2u; RA_[i] = R; CA_[i] = (unsigned)C * 2u; }
    const size_t kstep = (size_t)(BK * 2);
    const size_t hstep = (size_t)HALF * K * 2;
    const size_t tstep = 2 * hstep;
    const unsigned ldsw = (unsigned)wid * 1024u;
    const int aoff = lds_byte(wr * 64 + fr, fq * 8), boff = lds_byte(wc * 32 + fr, fq * 8);
#define PG8_SA(b, h) (((b) * 2 + (h)) * HTB)
#define PG8_SB(b, h) ((4 + (b) * 2 + (h)) * HTB)
#define PG8_STAGE(bufoff, gbase, voff) do { _Pragma("unroll") for (int _i = 0; _i < 2; ++_i) \
        __builtin_amdgcn_global_load_lds((const unsigned*)((const char*)(gbase) + (voff)[_i]), (PG8_LAS unsigned*)(lds + (bufoff) + ldsw + _i * 8192), 16, 0, 0); } while (0)
#define PG8_LDA(dst, b, h) do { _Pragma("unroll") for (int m = 0; m < 4; ++m) _Pragma("unroll") for (int k = 0; k < 2; ++k) dst[m][k] = *(const PG8_LAS bf16x8*)(lds + PG8_SA(b, h) + aoff + m * 2048 + k * 1024); } while (0)
#define PG8_LDB(dst, b, h) do { _Pragma("unroll") for (int n = 0; n < 2; ++n) _Pragma("unroll") for (int k = 0; k < 2; ++k) dst[n][k] = *(const PG8_LAS bf16x8*)(lds + PG8_SB(b, h) + boff + n * 2048 + k * 1024); } while (0)
#define PG8_MMA(ai, bj, At, Bt) do { __builtin_amdgcn_s_setprio(1); _Pragma("unroll") for (int m = 0; m < 4; ++m) _Pragma("unroll") for (int n = 0; n < 2; ++n) _Pragma("unroll") for (int k = 0; k < 2; ++k) \
        acc[ai][bj][m][n] = __builtin_amdgcn_mfma_f32_16x16x32_bf16(Bt[n][k], At[m][k], acc[ai][bj][m][n], 0, 0, 0); __builtin_amdgcn_s_setprio(0); } while (0)
#define PG8_WAIT_V(n) asm volatile("s_waitcnt vmcnt(" #n ")" ::: "memory")
#define PG8_WAIT_L(n) asm volatile("s_waitcnt lgkmcnt(" #n ")" ::: "memory")
#define PG8_BAR __builtin_amdgcn_s_barrier()
#define PG8_SCHED __builtin_amdgcn_sched_barrier(0)
    Unit cur, nxt; int ui = 0;
    if (!S.next(0, cur)) return;
    f32x4 acc[2][2][4][2];
#pragma unroll
    for (int a = 0; a < 2; ++a)
#pragma unroll
        for (int b = 0; b < 2; ++b)
#pragma unroll
            for (int m = 0; m < 4; ++m)
#pragma unroll
                for (int n = 0; n < 2; ++n) acc[a][b][m][n] = (f32x4){0.f, 0.f, 0.f, 0.f};
    bf16x8 At[4][2], B0[2][2], B1[2][2];
    const char* cA = (const char*)g.A; const char* cB = (const char*)g.Bt + (size_t)cur.pn * tstep;
    unsigned cA0[2], cA1[2], nA0[2], nA1[2];
#pragma unroll
    for (int i = 0; i < 2; ++i) { cA0[i] = S.rowoff(cur, RA_[i]) + CA_[i]; cA1[i] = S.rowoff(cur, 128 + RA_[i]) + CA_[i]; }
    S.a_ready(cur);
    if constexpr (SP2) {
        PG8_STAGE(PG8_SB(0, 0), cB, voffB); PG8_STAGE(PG8_SB(0, 1), cB + hstep, voffB); PG8_STAGE(PG8_SA(0, 0), cA, cA0); PG8_STAGE(PG8_SA(0, 1), cA, cA1);
        if (wr == 1) PG8_BAR;
        PG8_WAIT_V(2); PG8_BAR;
        PG8_STAGE(PG8_SB(1, 0), cB + kstep, voffB); PG8_STAGE(PG8_SA(1, 0), cA + kstep, cA0); PG8_STAGE(PG8_SB(1, 1), cB + hstep + kstep, voffB);
        PG8_WAIT_V(6); PG8_BAR;
    } else {
        PG8_STAGE(PG8_SB(0, 0), cB, voffB); PG8_STAGE(PG8_SA(0, 0), cA, voffA); PG8_STAGE(PG8_SB(0, 1), cB + hstep, voffB); PG8_STAGE(PG8_SA(0, 1), cA + hstep, voffA);
        if (wr == 1) PG8_BAR;
        PG8_WAIT_V(4); PG8_BAR;
        PG8_STAGE(PG8_SB(1, 0), cB + kstep, voffB); PG8_STAGE(PG8_SA(1, 0), cA + kstep, voffA); PG8_STAGE(PG8_SB(1, 1), cB + hstep + kstep, voffB);
        PG8_WAIT_V(6); PG8_BAR;
    }
    for (;;) {
        const bool has_next = S.next(ui + 1, nxt);
        const char* nA = cA; const char* nB = has_next ? (const char*)g.Bt + (size_t)nxt.pn * tstep : cB;
#pragma unroll
        for (int i = 0; i < 2; ++i) { nA0[i] = has_next ? S.rowoff(nxt, RA_[i]) + CA_[i] : cA0[i]; nA1[i] = has_next ? S.rowoff(nxt, 128 + RA_[i]) + CA_[i] : cA1[i]; }
        for (int t = 0; t < nt; t += 2) {
            const bool last = (t == nt - 2);
            const char* a1 = cA + (size_t)(t + 1) * kstep;
            const char* a2 = last ? nA : cA + (size_t)(t + 2) * kstep; const char* b2 = last ? nB : cB + (size_t)(t + 2) * kstep;
            const char* a3 = a2 + kstep; const char* b3 = b2 + kstep;
            unsigned sA0[2], sA1[2];
#pragma unroll
            for (int i = 0; i < 2; ++i) { sA0[i] = last ? nA0[i] : cA0[i]; sA1[i] = last ? nA1[i] : cA1[i]; }
            if (last && has_next) S.a_ready(nxt);
            if constexpr (SP2) {
            PG8_LDB(B0, 0, 0); PG8_LDB(B1, 0, 1); PG8_SCHED; PG8_LDA(At, 0, 0); PG8_STAGE(PG8_SA(1, 1), a1, cA1);
            PG8_WAIT_V(8); PG8_WAIT_L(0); PG8_BAR; PG8_MMA(0, 0, At, B0); PG8_MMA(0, 1, At, B1); PG8_BAR; PG8_SCHED;
            PG8_LDA(At, 0, 1); PG8_STAGE(PG8_SB(0, 0), b2, voffB); PG8_STAGE(PG8_SB(0, 1), b2 + hstep, voffB); PG8_STAGE(PG8_SA(0, 0), a2, sA0);
            PG8_WAIT_V(8); PG8_WAIT_L(0); PG8_BAR; PG8_MMA(1, 0, At, B0); PG8_MMA(1, 1, At, B1); PG8_BAR; PG8_SCHED;
            PG8_LDB(B0, 1, 0); PG8_LDB(B1, 1, 1); PG8_SCHED; PG8_LDA(At, 1, 0); PG8_STAGE(PG8_SA(0, 1), a2, sA1);
            PG8_WAIT_V(8); PG8_WAIT_L(0); PG8_BAR; PG8_MMA(0, 0, At, B0); PG8_MMA(0, 1, At, B1); PG8_BAR; PG8_SCHED;
            PG8_LDA(At, 1, 1); PG8_STAGE(PG8_SB(1, 0), b3, voffB); PG8_STAGE(PG8_SB(1, 1), b3 + hstep, voffB); PG8_STAGE(PG8_SA(1, 0), a3, sA0);
            PG8_WAIT_V(8); PG8_WAIT_L(0); PG8_BAR; PG8_MMA(1, 0, At, B0); PG8_MMA(1, 1, At, B1); PG8_BAR; PG8_SCHED;
            } else {
            PG8_LDB(B0, 0, 0); PG8_SCHED; PG8_LDA(At, 0, 0); PG8_STAGE(PG8_SA(1, 1), a1 + hstep, voffA);
            PG8_WAIT_L(8); PG8_BAR; PG8_WAIT_L(0); PG8_MMA(0, 0, At, B0); PG8_BAR; PG8_SCHED;
            PG8_LDB(B1, 0, 1); PG8_STAGE(PG8_SB(0, 0), b2, voffB);
            PG8_BAR; PG8_WAIT_L(0); PG8_MMA(0, 1, At, B1); PG8_BAR;
            PG8_LDA(At, 0, 1); PG8_STAGE(PG8_SA(0, 0), a2, voffA);
            PG8_BAR; PG8_WAIT_L(0); PG8_MMA(1, 0, At, B0); PG8_BAR; PG8_SCHED;
            PG8_STAGE(PG8_SB(0, 1), b2 + hstep, voffB);
            PG8_WAIT_V(6); PG8_BAR; PG8_MMA(1, 1, At, B1); PG8_BAR;
            PG8_LDB(B0, 1, 0); PG8_SCHED; PG8_LDA(At, 1, 0); PG8_STAGE(PG8_SA(0, 1), a2 + hstep, voffA);
            PG8_WAIT_L(8); PG8_BAR; PG8_WAIT_L(0); PG8_MMA(0, 0, At, B0); PG8_BAR; PG8_SCHED;
            PG8_LDB(B1, 1, 1); PG8_STAGE(PG8_SB(1, 0), b3, voffB);
            PG8_BAR; PG8_WAIT_L(0); PG8_MMA(0, 1, At, B1); PG8_BAR;
            PG8_LDA(At, 1, 1); PG8_STAGE(PG8_SA(1, 0), a3, voffA);
            PG8_BAR; PG8_WAIT_L(0); PG8_MMA(1, 0, At, B0); PG8_BAR; PG8_SCHED;
            PG8_STAGE(PG8_SB(1, 1), b3 + hstep, voffB);
            PG8_WAIT_V(6); PG8_BAR; PG8_MMA(1, 1, At, B1); PG8_BAR;
            }
        }
        if constexpr (ALIGN_EPI) { if (wr == 0) PG8_BAR; }
        if constexpr (!Epi::AFTER_DRAIN) { E(acc, cur, wr, wc, fr, fq); PG8_EPI_AGAIN(E(acc, cur, wr, wc, fr, fq)); S.done(cur); }
        if (!has_next) break;
#pragma unroll
        for (int a = 0; a < 2; ++a)
#pragma unroll
            for (int b = 0; b < 2; ++b)
#pragma unroll
                for (int m = 0; m < 4; ++m)
#pragma unroll
                    for (int n = 0; n < 2; ++n) acc[a][b][m][n] = (f32x4){0.f, 0.f, 0.f, 0.f};
        cur = nxt; cA = nA; cB = nB; ++ui;
#pragma unroll
        for (int i = 0; i < 2; ++i) { cA0[i] = nA0[i]; cA1[i] = nA1[i]; }
        if constexpr (ALIGN_EPI) { if (wr == 1) PG8_BAR; }
    }
    PG8_WAIT_V(0);
    if constexpr (!ALIGN_EPI) { if (wr == 0) PG8_BAR; }
    PG8_BAR;
    if constexpr (Epi::AFTER_DRAIN) { E.fused(acc, cur, wr, wc, fr, fq, lds, wid, lane); S.done(cur); }
#undef PG8_SA
#undef PG8_SB
#undef PG8_STAGE
#undef PG8_LDA
#undef PG8_LDB
#undef PG8_MMA
#undef PG8_WAIT_V
#undef PG8_WAIT_L
#undef PG8_BAR
#undef PG8_SCHED
}
}

#define DI __device__ __forceinline__
#define LAS __attribute__((address_space(3)))
typedef unsigned short bf16_t;
typedef short bf16x8 __attribute__((ext_vector_type(8)));
typedef short s16x4 __attribute__((ext_vector_type(4)));
typedef short v4i16_t __attribute__((ext_vector_type(4)));
typedef float f32x4 __attribute__((ext_vector_type(4)));
typedef float f32x16 __attribute__((ext_vector_type(16)));
typedef unsigned u32x4 __attribute__((ext_vector_type(4)));
typedef unsigned u32x2 __attribute__((ext_vector_type(2)));
typedef float f32x2_t __attribute__((ext_vector_type(2)));
typedef __bf16 bf16x2_t __attribute__((ext_vector_type(2)));

constexpr int NWAVES = 8, NTHREADS = 512;
constexpr int SEQ = 8192, DMODEL = 1024, NMETA = 16, LTOK = SEQ + NMETA  , LP = 8256  , NCHUNK = 129;
constexpr int MTOK = 2 * SEQ;
constexpr int MROWS = 16640;
constexpr int NPROJ = 3840;
constexpr int NKT = 129;
constexpr float EPS = 1e-6f;
constexpr float C2Q = 0.125f * 1.4426950408889634f;
constexpr int XS_ROWS = 41216;

constexpr size_t MiB = 1u << 20;
constexpr size_t WS_CTL = 0, CTL_BYTES = 1 * MiB;
constexpr size_t WS_RS1 = 1 * MiB;
constexpr size_t WS_RS2 = WS_RS1 + 128 * 1024;
constexpr size_t WS_TOKE = WS_RS2 + 128 * 1024;
constexpr size_t WS_TOKW = WS_TOKE + 128 * 1024;
constexpr size_t WS_TOKP = WS_TOKW + 128 * 1024;
constexpr size_t WS_SLOTW = WS_TOKP + 128 * 1024;
constexpr size_t WS_WR = WS_SLOTW + 192 * 1024;
constexpr size_t WS_GL = WS_WR + 160 * 1024;
constexpr size_t WS_DUMP = 2 * MiB;
constexpr size_t WS_COS = 2 * MiB;
constexpr size_t WS_SIN = WS_COS + 1280 * 1024;
constexpr size_t WS_GB = WS_SIN + 1280 * 1024;
constexpr size_t WS_WOUT = 6 * MiB;
constexpr size_t WS_WINT = 8 * MiB;
constexpr size_t WS_XB = WS_WINT + (size_t)NPROJ * 1024 * 2;
constexpr size_t WS_MIX = 8 * MiB;
constexpr size_t WS_QKVB = 48 * MiB;
constexpr size_t WS_QB = WS_QKVB + (size_t)2 * LP * 1536 * 2 + 128 * 1024;
constexpr size_t WS_KT = WS_QB + 16 * MiB;
constexpr size_t WS_VT = WS_KT + (size_t)16 * NKT * 4096 * 2;
constexpr size_t WS_ZB = WS_VT + (size_t)8 * NKT * 8192 * 2;
constexpr size_t WS_GP = WS_ZB + (size_t)2 * LP * 512 * 2;
constexpr size_t GP_ARR = (size_t)2064 * 4096 * 2;
constexpr size_t WS_GP_END = WS_GP + 5 * GP_ARR;
constexpr size_t WS_WGU = 48 * MiB;
constexpr size_t WS_WD = 80 * MiB;
constexpr size_t WS_U2 = 96 * MiB;
constexpr size_t WS_LIST = 240 * MiB;
constexpr size_t WS_LISTW = 242 * MiB;
constexpr size_t WS_LISTRS = 244 * MiB;
constexpr size_t WS_XS = 96 * MiB;
constexpr size_t WS_YO = 96 * MiB;
constexpr size_t WS_YS = WS_XS + (size_t)XS_ROWS * 1024 * 2;
constexpr size_t WS_END = 256 * MiB;
static_assert(WS_GB + (size_t)2 * LP * 16 * 4 <= WS_WOUT, "small region");
static_assert(WS_XB + (size_t)MROWS * 1024 * 2 <= WS_QKVB, "XB");
static_assert(WS_GP_END <= WS_END, "GDN prep arrays");
static_assert(WS_YS + (size_t)XS_ROWS * 256 * 2 <= WS_END, "YS");
static_assert(WS_WD + (size_t)32 * 1024 * 256 * 2 <= WS_XS, "WD");
constexpr int CW_ATTQ = 2112;
constexpr int CW_PREP = 2688;
constexpr int CW_CNT = 64;
constexpr int CW_TILE = 8192;
constexpr int CW_BAR = 4096;

constexpr int LDS_BYTES = 147456;

struct Params { const float* in[23]; float* out; unsigned char* ws; };

DI unsigned f2bf(float f) { unsigned u = __float_as_uint(f); return (u + 0x7fffu + ((u >> 16) & 1u)) >> 16; }
DI unsigned pk2(float lo, float hi) { f32x2_t v = {lo, hi}; bf16x2_t b = __builtin_convertvector(v, bf16x2_t); return __builtin_bit_cast(unsigned, b); }
DI float bf2f(unsigned short h) { return __uint_as_float(((unsigned)h) << 16); }
DI float rlane(float v, int l) { return __int_as_float(__builtin_amdgcn_readlane(__float_as_int(v), l)); }
#define DPP_ADD(v, ctrl) ((v) + __int_as_float(__builtin_amdgcn_update_dpp(0, __float_as_int(v), (ctrl), 0xF, 0xF, true)))
DI u32x2 pack_quad_bf16(float v) {
    const float v1 = __int_as_float(__builtin_amdgcn_update_dpp(0, __float_as_int(v), 0xB1, 0xF, 0xF, true));
    const unsigned p = pk2(v, v1);
    const unsigned q = (unsigned)__builtin_amdgcn_update_dpp(0, (int)p, 0x4E, 0xF, 0xF, true);
    return (u32x2){p, q};
}
typedef __attribute__((address_space(1))) u32x2 g_u32x2;
DI void store_quad_bf16(bf16_t* dst  , float v, int lane) {
    const float v1 = __int_as_float(__builtin_amdgcn_update_dpp(0, __float_as_int(v), 0xB1, 0xF, 0xF, true));
    const unsigned p = pk2(v, v1);
    const unsigned q = (unsigned)__builtin_amdgcn_update_dpp(0, (int)p, 0x4E, 0xF, 0xF, true);
    if ((lane & 3) == 0) *(u32x2*)dst = (u32x2){p, q};
}
DI float wave_sum_dpp(float v) {
    v = DPP_ADD(v, 0xB1);
    v = DPP_ADD(v, 0x4E);
    v = DPP_ADD(v, 0x141);
    v = DPP_ADD(v, 0x140);
    return (rlane(v, 0) + rlane(v, 16)) + (rlane(v, 32) + rlane(v, 48));
}
DI float wave_sum(float v) { return wave_sum_dpp(v); }
DI float swz_xor16(float v) { return __int_as_float(__builtin_amdgcn_ds_swizzle(__float_as_int(v), 0x401F)); }
DI float row_sum16(float v) { v = DPP_ADD(v, 0xB1); v = DPP_ADD(v, 0x4E); v = DPP_ADD(v, 0x141); v = DPP_ADD(v, 0x140); return v; }
DI float half_sum32(float v) { v = row_sum16(v); return v + swz_xor16(v); }
DI float swap32_add(float v) { auto rr = __builtin_amdgcn_permlane32_swap(__float_as_uint(v), __float_as_uint(v), false, false); return __uint_as_float(rr[0]) + __uint_as_float(rr[1]); }
DI float swap32_max(float v) { auto rr = __builtin_amdgcn_permlane32_swap(__float_as_uint(v), __float_as_uint(v), false, false); return fmaxf(__uint_as_float(rr[0]), __uint_as_float(rr[1])); }
#define LDS_WAIT() asm volatile("s_waitcnt lgkmcnt(0)" ::: "memory")
#define BAR_LDS() do { asm volatile("s_waitcnt lgkmcnt(0)" ::: "memory"); __builtin_amdgcn_s_barrier(); asm volatile("" ::: "memory"); } while (0)
#define MFMA32(a, b, c) __builtin_amdgcn_mfma_f32_32x32x16_bf16((a), (b), (c), 0, 0, 0)
DI int crow(int r, int hi) { return (r & 3) + 8 * (r >> 2) + 4 * hi; }
DI int perm16(int x) { return (x & ~12) | ((x & 4) << 1) | ((x & 8) >> 1); }
DI bf16x8 pack8(const f32x16& x, int s) {
    u32x4 p; p.x = pk2(x[8 * s], x[8 * s + 1]); p.y = pk2(x[8 * s + 2], x[8 * s + 3]); p.z = pk2(x[8 * s + 4], x[8 * s + 5]); p.w = pk2(x[8 * s + 6], x[8 * s + 7]);
    return __builtin_bit_cast(bf16x8, p);
}
DI int orig_col(int n) {
    if (n >= 1024) return n;
    const int hh = n >> 6, c2 = n & 63, g8 = c2 >> 3, i = c2 & 7;
    return (hh << 6) + ((i < 4) ? 4 * g8 + i : 32 + 4 * g8 + (i - 4));
}
DI size_t kt_off(int b, int hh, int p, int d) {
    const int tile = p < 16 ? 0 : 1 + ((p - 16) >> 6), kv = p < 16 ? p : ((p - 16) & 63);
    return ((size_t)((b * 8 + hh) * NKT + tile) << 12) + ((d >> 3) << 9) + (kv << 3) + (d & 7);
}
DI size_t vt_off(int b, int h, int p, int d) {
    const int tile = p < 16 ? 0 : 1 + ((p - 16) >> 6), kv = p < 16 ? p : ((p - 16) & 63);
    return ((size_t)((b * 4 + h) * NKT + tile) << 13) + ((d >> 5) << 11) + ((kv >> 4) << 9) + ((kv & 15) << 5) + (d & 31);
}

template <class Src> DI void transpose_item(const Src& src, bf16_t* WT, size_t ldk, int k0, int n0, LAS float* scr, int lane) {
    float v[32];
#pragma unroll
    for (int i = 0; i < 32; ++i) v[i] = src(k0 + 2 * i + (lane >> 5), n0 + (lane & 31));
#pragma unroll
    for (int i = 0; i < 32; ++i) scr[(2 * i + (lane >> 5)) * 33 + (lane & 31)] = v[i];
    LDS_WAIT();
    const int c = lane & 7;
#pragma unroll
    for (int j = 0; j < 4; ++j) { const int n = (lane >> 3) + 8 * j; const LAS float* s = scr + (8 * c) * 33 + n;
        u32x4 o; o.x = pk2(s[0 * 33], s[1 * 33]); o.y = pk2(s[2 * 33], s[3 * 33]); o.z = pk2(s[4 * 33], s[5 * 33]); o.w = pk2(s[6 * 33], s[7 * 33]);
        *(u32x4*)(WT + (size_t)(n0 + n) * ldk + k0 + 8 * c) = o; }
    LDS_WAIT();
}
struct SrcWin { const float* w; const float* g; DI float operator()(int k, int n) const { return n >= 3600 ? 0.f : w[(size_t)k * 3600 + orig_col(n)] * g[k]; } };
struct SrcPlain { const float* w; int N; DI float operator()(int k, int n) const { return w[(size_t)k * N + n]; } };
struct SrcGU { const float* w; const float* g; int fadj; DI float operator()(int k, int n) const { return w[(size_t)k * 256 + n + fadj] * g[k]; } };

#ifndef P0_REP
#define P0_REP 0
#endif
DI void phase0(const Params& P, LAS unsigned char* lds, int gw, int NGW, int gtid, int NGT, int wave, int lane) {
    LAS float* scr = (LAS float*)(lds + wave * 16384);
    bf16_t* WINT = (bf16_t*)(P.ws + WS_WINT); bf16_t* WOUT = (bf16_t*)(P.ws + WS_WOUT); bf16_t* XB = (bf16_t*)(P.ws + WS_XB);
    float* RS1 = (float*)(P.ws + WS_RS1);
    constexpr int I_IN = 16 * (NPROJ / 32), I_OUT = 16 * 32;
    const SrcWin sw{P.in[3], P.in[2]}; const SrcPlain so{P.in[13], 1024};
    for (int rp_ = 0; rp_ < ((P0_REP & 1) ? 2 : 1); ++rp_)
    for (int it = gw; it < I_IN + I_OUT; it += NGW) {
        if (it < I_IN) transpose_item(sw, WINT, 1024, (it / (NPROJ / 32)) * 64, (it % (NPROJ / 32)) * 32, scr, lane);
        else { const int r = it - I_IN; transpose_item(so, WOUT, 1024, (r >> 5) * 64, (r & 31) * 32, scr, lane); }
    }
    const float* x = P.in[0]; const float* meta = P.in[1];
    for (int rp_ = 0; rp_ < ((P0_REP & 2) ? 2 : 1); ++rp_)
    for (int m0 = gw; m0 < MROWS; m0 += 4 * NGW) {
        f32x4 v[4][4];
#pragma unroll
        for (int r = 0; r < 4; ++r) { const int m = m0 + r * NGW;
            const bool real = m < MTOK + NMETA;
            const f32x4* xr = (const f32x4*)((m < MTOK) ? x + (size_t)m * 1024 : meta + (size_t)((real ? m : MTOK) - MTOK) * 1024);
#pragma unroll
            for (int j = 0; j < 4; ++j) v[r][j] = (m < MROWS) ? xr[64 * j + lane] : (f32x4){0.f, 0.f, 0.f, 0.f}; }
#pragma unroll
        for (int r = 0; r < 4; ++r) { const int m = m0 + r * NGW;
            if (m < MROWS) {
                const bool real = m < MTOK + NMETA;
                float s = 0.f;
#pragma unroll
                for (int j = 0; j < 4; ++j) { if (!real) v[r][j] = (f32x4){0.f, 0.f, 0.f, 0.f}; s += (v[r][j].x * v[r][j].x + v[r][j].y * v[r][j].y) + (v[r][j].z * v[r][j].z + v[r][j].w * v[r][j].w); }
                s = wave_sum(s);
                if (lane == 0) RS1[m] = real ? __builtin_amdgcn_rsqf(s * (1.0f / 1024.0f) + EPS) : 0.f;
                u32x2* orow = (u32x2*)(XB + (size_t)m * 1024);
#pragma unroll
                for (int j = 0; j < 4; ++j) orow[64 * j + lane] = (u32x2){pk2(v[r][j].x, v[r][j].y), pk2(v[r][j].z, v[r][j].w)};
            } }
    }
    float* COS = (float*)(P.ws + WS_COS); float* SIN = (float*)(P.ws + WS_SIN);
    for (int rp_ = 0; rp_ < ((P0_REP & 4) ? 2 : 1); ++rp_)
    for (int i = gtid; i < LTOK * 32; i += NGT) {
        const int p = i >> 5, f = i & 31;
        const double rev = (double)p * exp2(-(double)f * (13.287712379549449 / 32.0)) * 0.15915494309189535;
        const float fr = (float)(rev - floor(rev));
        COS[i] = __builtin_amdgcn_cosf(fr); SIN[i] = __builtin_amdgcn_sinf(fr);
    }
    float* WR = (float*)(P.ws + WS_WR); const float* gf = P.in[14]; const float* wgrp = P.in[15]; const float* wrt = P.in[17];
    for (int i = gtid; i < 36 * 1024; i += NGT) { const int j = i >> 10, k = i & 1023; WR[i] = gf[k] * (j < 4 ? wgrp[k * 4 + j] : wrt[k * 32 + (j - 4)]); }
}

struct EpiInProj {
    static constexpr bool PERM = true, AFTER_DRAIN = false;
    const float* RS1; const float* COS; const float* SIN; const float* a_log; const float* dt_bias;
    bf16_t* QB; bf16_t* KT; bf16_t* VT; bf16_t* QKVB; bf16_t* ZB; float* GB;
    DI void tail(const pg8::f32x4 (&acc)[2][2][4][2], const pg8::Unit& u, int wr, int wc, int fr, int fq) const {
        const int pn = u.pn;
#pragma unroll
        for (int ai = 0; ai < 2; ++ai)
#pragma unroll
            for (int m = 0; m < 4; ++m) {
                const int row = u.pm * 256 + ai * 128 + wr * 64 + m * 16 + fr;
                if (row < MTOK + NMETA) {
                    const float rs = RS1[row];
                    const bool meta = row >= MTOK;
                    const int p = meta ? row - MTOK : (row & 8191) + NMETA;
                    const int b0 = meta ? 0 : (row >> 13), nb = meta ? 2 : 1;
#pragma unroll
                    for (int bj = 0; bj < 2; ++bj) {
                        float xv[8];
#pragma unroll
                        for (int i = 0; i < 4; ++i) { xv[i] = acc[ai][bj][m][0][i] * rs; xv[4 + i] = acc[ai][bj][m][1][i] * rs; }
                        if (pn < 4) {
                            const int hh = (pn & 1) * 4 + bj * 2 + (wc >> 1), d0 = 4 * (4 * (wc & 1) + fq);
                            const f32x4 cs = *(const f32x4*)(COS + p * 32 + d0), sn = *(const f32x4*)(SIN + p * 32 + d0);
                            float lo[4], hi[4];
#pragma unroll
                            for (int i = 0; i < 4; ++i) { lo[i] = xv[i] * cs[i] - xv[4 + i] * sn[i]; hi[i] = xv[4 + i] * cs[i] + xv[i] * sn[i]; }
                            if (pn < 2) {
                                if (!meta) {
                                    bf16_t* q = QB + ((size_t)((b0 * 8 + hh) * SEQ + (p - NMETA)) << 6) + d0;
                                    *(u32x2*)q = (u32x2){pk2(lo[0] * C2Q, lo[1] * C2Q), pk2(lo[2] * C2Q, lo[3] * C2Q)};
                                    *(u32x2*)(q + 32) = (u32x2){pk2(hi[0] * C2Q, hi[1] * C2Q), pk2(hi[2] * C2Q, hi[3] * C2Q)};
                                }
                            } else {
                                for (int bb = b0; bb < b0 + nb; ++bb) {
                                    *(u32x2*)(KT + kt_off(bb, hh, p, d0)) = (u32x2){pk2(lo[0], lo[1]), pk2(lo[2], lo[3])};
                                    *(u32x2*)(KT + kt_off(bb, hh, p, d0 + 32)) = (u32x2){pk2(hi[0], hi[1]), pk2(hi[2], hi[3])};
                                }
                            }
                        } else {
                            const u32x4 w = (u32x4){pk2(xv[0], xv[1]), pk2(xv[2], xv[3]), pk2(xv[4], xv[5]), pk2(xv[6], xv[7])};
                            const int cl = bj * 128 + wc * 32 + fq * 8;
                            if (pn < 6) {
                                const int h = (pn - 4) * 2 + bj, d = wc * 32 + fq * 8;
                                for (int bb = b0; bb < b0 + nb; ++bb) *(u32x4*)(VT + vt_off(bb, h, p, d)) = w;
                            } else if (pn < 12) {
                                for (int bb = b0; bb < b0 + nb; ++bb) *(u32x4*)(QKVB + (size_t)(bb * LP + p) * 1536 + (pn - 6) * 256 + cl) = w;
                            } else if (pn < 14) {
                                float sz[8];
#pragma unroll
                                for (int i = 0; i < 8; ++i) sz[i] = xv[i] * __builtin_amdgcn_rcpf(1.0f + __expf(-xv[i]));
                                const u32x4 wz = (u32x4){pk2(sz[0], sz[1]), pk2(sz[2], sz[3]), pk2(sz[4], sz[5]), pk2(sz[6], sz[7])};
                                for (int bb = b0; bb < b0 + nb; ++bb) *(u32x4*)(ZB + (size_t)(bb * LP + p) * 512 + (pn - 12) * 256 + cl) = wz;
                            } else if (cl < 16) {
                                float o[8];
                                if (cl == 0) {
#pragma unroll
                                    for (int i = 0; i < 8; ++i) { const float t = xv[i] + dt_bias[i]; const float sp = t > 20.f ? t : log1pf(expf(t)); o[i] = -expf(a_log[i]) * sp; }
                                } else {
#pragma unroll
                                    for (int i = 0; i < 8; ++i) o[i] = 1.0f / (1.0f + expf(-xv[i]));
                                }
                                for (int bb = b0; bb < b0 + nb; ++bb) { float* g = GB + ((size_t)(bb * LP + p) << 4) + cl;
                                    *(f32x4*)g = (f32x4){o[0], o[1], o[2], o[3]}; *(f32x4*)(g + 4) = (f32x4){o[4], o[5], o[6], o[7]}; }
                            }
                        }
                    }
                }
            }
    }

    DI void operator()(const pg8::f32x4 (&acc)[2][2][4][2], const pg8::Unit& u, int wr, int wc, int fr, int fq) const {
        if (u.pm >= MTOK / 256) { tail(acc, u, wr, wc, fr, fq); return; }
        const int pn = u.pn, rowb = u.pm * 256 + wr * 64 + fr;
        float rs[2][4];
#pragma unroll
        for (int ai = 0; ai < 2; ++ai)
#pragma unroll
            for (int m = 0; m < 4; ++m) rs[ai][m] = RS1[rowb + ai * 128 + m * 16];
        __builtin_amdgcn_sched_barrier(0);
        const int b = rowb >> 13, s0 = rowb & 8191;
        if (pn < 4) {
            const int d0 = 4 * (4 * (wc & 1) + fq);
#pragma unroll
            for (int ai = 0; ai < 2; ++ai) {
                f32x4 cs[4], sn[4];
#pragma unroll
                for (int m = 0; m < 4; ++m) { const int p = s0 + ai * 128 + m * 16 + NMETA; cs[m] = *(const f32x4*)(COS + p * 32 + d0); sn[m] = *(const f32x4*)(SIN + p * 32 + d0); }
                __builtin_amdgcn_sched_barrier(0);
#pragma unroll
                for (int m = 0; m < 4; ++m)
#pragma unroll
                    for (int bj = 0; bj < 2; ++bj) {
                        const int hh = (pn & 1) * 4 + bj * 2 + (wc >> 1), s = s0 + ai * 128 + m * 16;
                        float lo[4], hi[4];
#pragma unroll
                        for (int i = 0; i < 4; ++i) { const float x1 = acc[ai][bj][m][0][i] * rs[ai][m], x2 = acc[ai][bj][m][1][i] * rs[ai][m];
                            lo[i] = x1 * cs[m][i] - x2 * sn[m][i]; hi[i] = x2 * cs[m][i] + x1 * sn[m][i]; }
                        if (pn < 2) { bf16_t* q = QB + ((size_t)((b * 8 + hh) * SEQ + s) << 6) + d0;
                            *(u32x2*)q = (u32x2){pk2(lo[0] * C2Q, lo[1] * C2Q), pk2(lo[2] * C2Q, lo[3] * C2Q)};
                            *(u32x2*)(q + 32) = (u32x2){pk2(hi[0] * C2Q, hi[1] * C2Q), pk2(hi[2] * C2Q, hi[3] * C2Q)};
                        } else { bf16_t* k = KT + ((size_t)((b * 8 + hh) * NKT + 1 + (s >> 6)) << 12) + ((d0 >> 3) << 9) + ((s & 63) << 3) + (d0 & 7);
                            *(u32x2*)k = (u32x2){pk2(lo[0], lo[1]), pk2(lo[2], lo[3])};
                            *(u32x2*)(k + 4 * 512) = (u32x2){pk2(hi[0], hi[1]), pk2(hi[2], hi[3])}; }
                    }
            }
            return;
        }
        const int cl = wc * 32 + fq * 8;
#pragma unroll
        for (int ai = 0; ai < 2; ++ai)
#pragma unroll
            for (int m = 0; m < 4; ++m)
#pragma unroll
                for (int bj = 0; bj < 2; ++bj) {
                    const int s = s0 + ai * 128 + m * 16, p = s + NMETA;
                    float xv[8];
#pragma unroll
                    for (int i = 0; i < 4; ++i) { xv[i] = acc[ai][bj][m][0][i] * rs[ai][m]; xv[4 + i] = acc[ai][bj][m][1][i] * rs[ai][m]; }
                    if (pn < 6) {
                        const int h = (pn - 4) * 2 + bj;
                        *(u32x4*)(VT + ((size_t)((b * 4 + h) * NKT + 1 + (s >> 6)) << 13) + ((cl >> 5) << 11) + (((s & 63) >> 4) << 9) + ((s & 15) << 5) + (cl & 31)) =
                            (u32x4){pk2(xv[0], xv[1]), pk2(xv[2], xv[3]), pk2(xv[4], xv[5]), pk2(xv[6], xv[7])};
                    } else if (pn < 12) {
                        *(u32x4*)(QKVB + (size_t)(b * LP + p) * 1536 + (pn - 6) * 256 + bj * 128 + cl) = (u32x4){pk2(xv[0], xv[1]), pk2(xv[2], xv[3]), pk2(xv[4], xv[5]), pk2(xv[6], xv[7])};
                    } else if (pn < 14) {
#pragma unroll
                        for (int i = 0; i < 8; ++i) xv[i] = xv[i] * __builtin_amdgcn_rcpf(1.0f + __expf(-xv[i]));
                        *(u32x4*)(ZB + (size_t)(b * LP + p) * 512 + (pn - 12) * 256 + bj * 128 + cl) = (u32x4){pk2(xv[0], xv[1]), pk2(xv[2], xv[3]), pk2(xv[4], xv[5]), pk2(xv[6], xv[7])};
                    } else if (bj == 0 && cl < 16) {
                        float o[8];
                        if (cl == 0) {
#pragma unroll
                            for (int i = 0; i < 8; ++i) { const float t = xv[i] + dt_bias[i]; const float sp = t > 20.f ? t : log1pf(expf(t)); o[i] = -expf(a_log[i]) * sp; }
                        } else {
#pragma unroll
                            for (int i = 0; i < 8; ++i) o[i] = 1.0f / (1.0f + expf(-xv[i]));
                        }
                        float* g = GB + ((size_t)(b * LP + p) << 4) + cl;
                        *(f32x4*)g = (f32x4){o[0], o[1], o[2], o[3]}; *(f32x4*)(g + 4) = (f32x4){o[4], o[5], o[6], o[7]};
                    }
                }
    }
};

DI bf16x8 lds_frag(LAS const bf16_t* M, int row, int ch) { return *(LAS const bf16x8*)((LAS const unsigned char*)M + row * 128 + ((ch ^ (row & 7)) << 4)); }
DI s16x4 tr_read_b64(LAS const unsigned char* p) { return __builtin_bit_cast(s16x4, __builtin_amdgcn_ds_read_tr16_b64_v4i16((LAS v4i16_t*)p)); }
DI bf16x8 lds_frag_plain(LAS const bf16_t* M, int row, int ch) { return *(LAS const bf16x8*)((LAS const unsigned char*)M + row * 128 + (ch << 4)); }
DI int swz_idx(int row, int d) { return row * 64 + ((((d >> 3) ^ (row & 7)) << 3) | (d & 7)); }

#ifndef PREP_REP
#define PREP_REP 0
#endif
constexpr int PREP_PAIR = 35840;

template <int MAT> DI void prep_rows(const bf16_t* QKVB, const float* cw, int b, int h, int n, int lane, LAS const float* egS,
                                     LAS bf16_t* DS  , bf16_t* QG) {
    const int colb = MAT * 512 + h * 64, col = colb + lane, p0 = n * 64;
    const float c0 = cw[col], c1 = cw[1536 + col], c2 = cw[3072 + col], c3 = cw[4608 + col];
    const bf16_t* blk = QKVB + (size_t)(b * LP + p0) * 1536 + colb;
    float x0 = 0.f, x1 = 0.f, x2 = 0.f;
    if (n > 0) { x0 = bf2f(blk[lane - 3 * 1536]); x1 = bf2f(blk[lane - 2 * 1536]); x2 = bf2f(blk[lane - 1 * 1536]); }
    u32x4 stg[8];
#pragma unroll
    for (int i = 0; i < 8; ++i) stg[i] = *(const u32x4*)(blk + (size_t)(8 * i + (lane >> 3)) * 1536 + (lane & 7) * 8);
#pragma unroll
    for (int i = 0; i < 8; ++i) *(LAS u32x4*)(DS + (8 * i + (lane >> 3)) * 64 + (lane & 7) * 8) = stg[i];
    LDS_WAIT();
    const int nvalid = (LTOK - p0) < 64 ? (LTOK - p0) : 64;
#pragma unroll 4
    for (int c = 0; c < 64; ++c) {
        if (c >= nvalid) { DS[c * 64 + lane] = 0; if (MAT == 0) store_quad_bf16(QG + c * 64 + perm16(lane), 0.f, lane); continue; }
        const bool valid = true;
        const float x3 = bf2f(DS[c * 64 + lane]);
        float y = c0 * x0 + c1 * x1 + c2 * x2 + c3 * x3;
        y = y * __builtin_amdgcn_rcpf(1.0f + __expf(-y));
        if (!valid) y = 0.f;
        x0 = x1; x1 = x2; x2 = x3;
        if (MAT == 2) { DS[c * 64 + lane] = (bf16_t)f2bf(y * egS[c]); }
        else {
            const float ss = wave_sum(y * y);
            const float yn = y * __builtin_amdgcn_rsqf(ss + EPS);
            if (MAT == 0) {
                const float qn = yn * 0.125f;
                DS[c * 64 + lane] = (bf16_t)f2bf(qn);
                store_quad_bf16(QG + c * 64 + perm16(lane), qn * egS[c], lane);
            } else {
                DS[c * 64 + lane] = (bf16_t)f2bf(yn);
            }
        }
    }
}

DI void gdn_tinv(LAS const float* AST, LAS bf16_t* TS, int lane) {
    const int hb = lane >> 5, j = lane & 31, r32 = j, hi = hb;
    LAS const float* Ab = AST + (32 * hb) * 68 + 32 * hb;
    float x[32];
#pragma unroll
    for (int r = 0; r < 32; ++r) x[r] = (r == j) ? 1.0f : 0.0f;
#pragma unroll
    for (int jj = 0; jj < 31; ++jj) {
        const float xj = x[jj];
        LAS const float* ap = Ab + jj * 68;
#pragma unroll
        for (int r4 = (jj + 1) / 4; r4 < 8; ++r4) {
            const f32x4 a = *(LAS const f32x4*)(ap + 4 * r4);
#pragma unroll
            for (int e = 0; e < 4; ++e) if (4 * r4 + e > jj) x[4 * r4 + e] -= a[e] * xj;
        }
    }
    bf16x8 a21[2];
#pragma unroll
    for (int s = 0; s < 2; ++s) { float t[8];
#pragma unroll
        for (int jj = 0; jj < 8; ++jj) t[jj] = AST[(16 * s + 8 * hi + jj) * 68 + 32 + r32];
        const u32x4 p = (u32x4){pk2(t[0], t[1]), pk2(t[2], t[3]), pk2(t[4], t[5]), pk2(t[6], t[7])}; a21[s] = __builtin_bit_cast(bf16x8, p); }
    f32x16 M = {};
#pragma unroll
    for (int s = 0; s < 2; ++s) { float t[8];
#pragma unroll
        for (int jj = 0; jj < 8; ++jj) {
            const auto rr = __builtin_amdgcn_permlane32_swap(__float_as_uint(x[16 * s + 8 + jj]), __float_as_uint(x[16 * s + 8 + jj]), false, false);
            t[jj] = hi ? __uint_as_float(rr[0]) : x[16 * s + jj];
        }
        const u32x4 p = (u32x4){pk2(t[0], t[1]), pk2(t[2], t[3]), pk2(t[4], t[5]), pk2(t[6], t[7])};
        M = MFMA32(a21[s], __builtin_bit_cast(bf16x8, p), M);
    }
    asm volatile("s_waitcnt lgkmcnt(0)" ::: "memory");
#pragma unroll
    for (int i = 0; i < 32; ++i) TS[(32 * hb + i) * 64 + 32 * hb + j] = (bf16_t)f2bf(x[i]);
    asm volatile("s_waitcnt lgkmcnt(0)" ::: "memory");
    f32x16 T21 = {};
#pragma unroll
    for (int s = 0; s < 2; ++s) {
        const u32x2 lo = *(LAS const u32x2*)(TS + (32 + r32) * 64 + 32 + 16 * s + 4 * hi), hi8 = *(LAS const u32x2*)(TS + (32 + r32) * 64 + 32 + 16 * s + 8 + 4 * hi);
        const u32x4 p = (u32x4){lo.x, lo.y, hi8.x, hi8.y};
        T21 = MFMA32(__builtin_bit_cast(bf16x8, p), pack8(M, s), T21);
    }
#pragma unroll
    for (int i = 0; i < 16; ++i) TS[(32 + crow(i, hi)) * 64 + r32] = (bf16_t)f2bf(-T21[i]);
    asm volatile("s_waitcnt lgkmcnt(0)" ::: "memory");
}

template <bool PERM> DI void gdn_tmul(LAS const bf16_t* TS, LAS const bf16_t* RS, int lane, float sgn, bf16_t* out) {
    const int r32 = lane & 31, hi = lane >> 5;
    LAS const unsigned char* rb = (LAS const unsigned char*)RS + ((8 * hi + ((lane & 15) >> 2)) * 64 + 16 * ((lane >> 4) & 1) + 4 * (lane & 3)) * 2;
#pragma unroll
    for (int ct = 0; ct < 2; ++ct)
#pragma unroll
        for (int cb = 0; cb < 2; ++cb) {
            f32x16 acc = {};
#pragma unroll
            for (int ks = 0; ks < (ct == 0 ? 2 : 4); ++ks) {
                const bf16x8 fa = lds_frag_plain(TS, 32 * ct + r32, 2 * ks + hi);
                const s16x4 lo = tr_read_b64(rb + (16 * ks * 64 + 32 * cb) * 2), h4 = tr_read_b64(rb + ((16 * ks + 4) * 64 + 32 * cb) * 2);
                const bf16x8 fb = (bf16x8){lo[0], lo[1], lo[2], lo[3], h4[0], h4[1], h4[2], h4[3]};
                acc = MFMA32(fa, fb, acc);
            }
            u32x2 pk[16];
#pragma unroll
            for (int i = 0; i < 16; ++i) pk[i] = pack_quad_bf16(sgn * acc[i]);
            if ((lane & 3) == 0) {
                unsigned long long ob_ = (unsigned long long)(out + hi * 256 + (PERM ? perm16(32 * cb + r32) : 32 * cb + r32)); asm volatile("" : "+v"(ob_));
                g_u32x2* ob = (g_u32x2*)ob_;
#pragma unroll
                for (int i = 0; i < 16; ++i) ob[(32 * ct + (i & 3) + 8 * (i >> 2)) * 16] = pk[i];
            }
        }
}

DI void gdn_prep_phase(const Params& P, LAS unsigned char* lds, int blk, int G, int wave, int lane_in) {
    const int pair = wave >> 1, role = wave & 1;
    LAS unsigned char* pb = lds + pair * PREP_PAIR;
    LAS bf16_t* QS = (LAS bf16_t*)pb; LAS bf16_t* KS = (LAS bf16_t*)(pb + 8192); LAS float* AS = (LAS float*)(pb + 16384);
    LAS float* gcS = (LAS float*)(pb + 16384 + 17408 + role * 1024); LAS float* betaS = gcS + 64; LAS float* egS = gcS + 128; LAS float* ekS = gcS + 192;
    const bf16_t* QKVB = (const bf16_t*)(P.ws + WS_QKVB); const float* GB = (const float*)(P.ws + WS_GB); const float* cw = P.in[9];
    const int NP = G * 4, NTASK = 2 * 8 * NCHUNK;
    for (int it = 0; it * NP < NTASK; ++it) {
        int lane = lane_in; asm volatile("" : "+v"(lane));
        const int r32 = lane & 31, hi = lane >> 5;
        const int task = it * NP + blk * 4 + pair;
        const bool active = task < NTASK;
        const int bh = task < 2048 ? (task >> 7) : (task - 2048), n = task < 2048 ? (task & 127) : 128, b = bh >> 3, h = bh & 7;
        const int sidx = bh * NCHUNK + n;
        bf16_t* GPW = (bf16_t*)(P.ws + WS_GP) + (size_t)sidx * 4096; bf16_t* GPQG = GPW + GP_ARR / 2; bf16_t* GPAQK = GPQG + GP_ARR / 2; bf16_t* GPKGT = GPAQK + GP_ARR / 2; bf16_t* GPU = GPKGT + GP_ARR / 2;
        float gc = 0.f, beta = 0.f;
        if (active) {
            const int pl = n * 64 + lane;
            float g = 0.f;
            if (pl < LTOK) { const float* gb = GB + ((size_t)(b * LP + pl) << 4); g = gb[h]; beta = gb[8 + h]; }
            gcS[lane] = g; LDS_WAIT();
            gc = 0.f;
#pragma unroll
            for (int j4 = 0; j4 < 16; ++j4) { const f32x4 t = *(LAS const f32x4*)(gcS + 4 * j4);
                gc += (4 * j4 <= lane ? t[0] : 0.f) + (4 * j4 + 1 <= lane ? t[1] : 0.f) + (4 * j4 + 2 <= lane ? t[2] : 0.f) + (4 * j4 + 3 <= lane ? t[3] : 0.f); }
            const float glast = rlane(gc, 63);
            LDS_WAIT();
            gcS[lane] = gc; betaS[lane] = beta; egS[lane] = (role == 0) ? __expf(gc) : beta * __expf(gc); ekS[lane] = __expf(glast - gc);
            if (role == 0 && lane == 0) ((float*)(P.ws + WS_GL))[sidx] = __expf(glast);
            LDS_WAIT();
            for (int rp_ = 0; rp_ < ((PREP_REP & 1) ? 2 : 1); ++rp_) {
            if (role == 0) prep_rows<0>(QKVB, cw, b, h, n, lane, egS, QS, GPQG);
            else prep_rows<1>(QKVB, cw, b, h, n, lane, egS, KS, GPQG);
            }
        }
        LDS_WAIT();
        __syncthreads();
        if (active) {
            for (int rp_ = 0; rp_ < ((PREP_REP & 2) ? 2 : 1); ++rp_)
#pragma unroll
            for (int t4 = 0; t4 < 4; ++t4) {
                const int ct = t4 >> 1, st = t4 & 1;
                f32x16 acc = {};
                if (!(ct == 0 && st == 1)) {
#pragma unroll
                    for (int ks = 0; ks < 4; ++ks) {
                        const bf16x8 fa = lds_frag_plain(role == 0 ? QS : KS, 32 * ct + r32, 2 * ks + hi), fb = lds_frag_plain(KS, 32 * st + r32, 2 * ks + hi);
                        acc = MFMA32(fa, fb, acc);
                    }
                }
                const float gcs = gcS[32 * st + r32];
                LAS const float* gcb = gcS + hi * 4; LAS const float* beb = betaS + hi * 4;
                asm volatile("" : "+v"(gcb), "+v"(beb));
                const int cmp = (32 * st + r32) - 4 * hi;
                if (role == 0) {
                    u32x2 pk[16];
#pragma unroll
                    for (int i = 0; i < 16; ++i) { const int cr = 32 * ct + (i & 3) + 8 * (i >> 2);
                        pk[i] = pack_quad_bf16((cmp <= cr) ? acc[i] * __expf(gcb[cr] - gcs) : 0.f); }
                    if ((lane & 3) == 0) {
                        unsigned long long aq_ = (unsigned long long)(GPAQK + hi * 256 + perm16(r32) + 32 * st); asm volatile("" : "+v"(aq_));
                        g_u32x2* aqb = (g_u32x2*)aq_;
#pragma unroll
                        for (int i = 0; i < 16; ++i) { const int cr = 32 * ct + (i & 3) + 8 * (i >> 2); aqb[cr * 16] = pk[i]; }
                    }
                } else {
                    LAS float* asb = AS + r32 * 68 + hi * 4;
                    asm volatile("" : "+v"(asb));
#pragma unroll
                    for (int i = 0; i < 16; ++i) { const int cr = 32 * ct + (i & 3) + 8 * (i >> 2);
                        asb[32 * st * 68 + cr] = (cmp < cr) ? acc[i] * beb[cr] * __expf(gcb[cr] - gcs) : 0.f; }
                }
            }
        }
        LDS_WAIT();
        __syncthreads();
        LAS bf16_t* TS = (LAS bf16_t*)((LAS unsigned char*)AS + 32 * 68 * 4);
        if (active) {
            if (role == 0) {
                prep_rows<2>(QKVB, cw, b, h, n, lane, betaS, QS  , GPQG);
            } else {
#pragma unroll
                for (int gq = 0; gq < 8; ++gq) {
                    float t[8];
#pragma unroll
                    for (int j = 0; j < 8; ++j) { const int c = perm16(8 * gq + j); t[j] = bf2f(KS[c * 64 + lane]) * ekS[c]; }
                    *(u32x4*)(GPKGT + lane * 64 + 8 * gq) = (u32x4){pk2(t[0], t[1]), pk2(t[2], t[3]), pk2(t[4], t[5]), pk2(t[6], t[7])};
                }
#pragma unroll 8
                for (int c = 0; c < 64; ++c) KS[c * 64 + lane] = (bf16_t)f2bf(bf2f(KS[c * 64 + lane]) * egS[c]);
                gdn_tinv(AS, TS, lane);
            }
        }
        LDS_WAIT();
        __syncthreads();
        if (active) {
            for (int rp_ = 0; rp_ < ((PREP_REP & 8) ? 2 : 1); ++rp_) {
            if (role == 0) gdn_tmul<false>(TS, QS, lane, 1.0f, GPU);
            else gdn_tmul<true>(TS, KS, lane, -1.0f, GPW);
            }
        }
        LDS_WAIT();
    }
}

constexpr int GS_STAGE = 40960 + 1024;
constexpr int GS_NSTAGE = 3;
constexpr int GS_OBUF = GS_NSTAGE * GS_STAGE;
static_assert(GS_OBUF + 16384 <= LDS_BYTES - 64, "gdn scan LDS");

#define GS_POST(n, ZQ) do { \
            if (n > 0) {         \
                LAS const bf16_t* ob = (LAS const bf16_t*)(lds + GS_OBUF + ((n - 1) & 1) * 8192); \
                const f32x4 gn = *(const f32x4*)(gnorm + 4 * vq); \
            _Pragma("unroll") \
                for (int it = 0; it < 8; ++it) { \
                    const int c = (wave - 2) * 32 + 4 * it + rg, p = (n - 1) * 64 + c; \
                    const u32x2 ov = *(LAS const u32x2*)(ob + c * 64 + 4 * vq); \
                    const float v0 = __uint_as_float(ov.x << 16), v1 = __uint_as_float(ov.x & 0xffff0000u), v2 = __uint_as_float(ov.y << 16), v3 = __uint_as_float(ov.y & 0xffff0000u); \
                    const float ss = row_sum16((v0 * v0 + v1 * v1) + (v2 * v2 + v3 * v3)); \
                    const float rn = __builtin_amdgcn_rsqf(ss * (1.0f / 64.0f) + EPS); \
                    const u32x2 zz = ZQ[it]; \
                    const float z0 = __uint_as_float(zz.x << 16), z1 = __uint_as_float(zz.x & 0xffff0000u), z2 = __uint_as_float(zz.y << 16), z3 = __uint_as_float(zz.y & 0xffff0000u); \
                    const float y0 = v0 * rn * gn[0] * z0, y1 = v1 * rn * gn[1] * z1, y2 = v2 * rn * gn[2] * z2, y3 = v3 * rn * gn[3] * z3;       \
                    { bf16_t* dst_ = ((p >= NMETA) && (p < LTOK)) ? MIX + (size_t)(b * SEQ + p - NMETA) * 1024 + 512 + h * 64 + 4 * vq : DUMP + lane * 4;       \
                      *(u32x2*)dst_ = (u32x2){pk2(y0, y1), pk2(y2, y3)}; } \
                } \
            } \
        } while (0)
DI void gdn_scan(const Params& P, LAS unsigned char* lds, int bh, int tid, int wave, int lane) {
    const int b = bh >> 3, h = bh & 7, r32 = lane & 31, hi = lane >> 5;
    const int task0 = (b * 8 + h) * NCHUNK;
    const bf16_t* GP0 = (const bf16_t*)(P.ws + WS_GP);
    const float* GLg = (const float*)(P.ws + WS_GL);
    const bf16_t* ZB = (const bf16_t*)(P.ws + WS_ZB); bf16_t* MIX = (bf16_t*)(P.ws + WS_MIX); const float* gnorm = P.in[12];
    bf16_t* DUMP = (bf16_t*)(P.ws + WS_DUMP) + bh * 4096 + wave * 512;
    const int lw = wave - 4;
    const int prow = lane >> 3, pch = lane & 7;
#define GS_DMA(n_, stg_) do { LAS unsigned char* sg_ = lds + (stg_) * GS_STAGE; \
        _Pragma("unroll") for (int i = 0; i < 10; ++i) { const int a_ = i >> 1, pi_ = lw * 2 + (i & 1), row_ = 8 * pi_ + prow; \
            const int sch_ = (a_ < 4) ? (pch ^ (row_ & 7)) : pch; \
            __builtin_amdgcn_global_load_lds((const unsigned*)(GP0 + (size_t)a_ * (GP_ARR / 2) + (size_t)(task0 + (n_)) * 4096 + row_ * 64 + sch_ * 8), \
                                             (LAS unsigned*)(sg_ + a_ * 8192 + pi_ * 1024), 16, 0, 0); } \
        __builtin_amdgcn_global_load_lds((const unsigned*)(GLg + task0 + (n_)), (LAS unsigned*)(sg_ + 40960 + lw * 256), 4, 0, 0); } while (0)
    if (wave >= 4) { GS_DMA(0, 0); GS_DMA(1, 1); asm volatile("s_waitcnt vmcnt(11)" ::: "memory"); }
    const int vq = lane & 15, rg = lane >> 4;
    u32x2 zqA[8], zqB[8];
#define GS_ZLOADX(ZQ, n_) do { _Pragma("unroll") for (int it = 0; it < 8; ++it) { int p_ = (n_) * 64 + (wave - 2) * 32 + 4 * it + rg; p_ = p_ < LTOK ? p_ : LTOK - 1; \
            ZQ[it] = *(const u32x2*)(ZB + (size_t)(b * LP + p_) * 512 + h * 64 + 4 * vq); } } while (0)
    if (wave == 2 || wave == 3) { GS_ZLOADX(zqB, 0); }
    BAR_LDS();
    f32x16 S0 = {}, S1 = {};
    const int vbase = 32 * wave;
    if (wave < 2) {
    int stg = 0;
    for (int n = 0; n <= NCHUNK; ++n) {
        {
            if (n < NCHUNK) {
                LAS const unsigned char* sg = lds + stg * GS_STAGE;
                LAS const bf16_t* Wm = (LAS const bf16_t*)sg; LAS const bf16_t* QGm = (LAS const bf16_t*)(sg + 8192); LAS const bf16_t* AQm = (LAS const bf16_t*)(sg + 16384);
                LAS const bf16_t* KGm = (LAS const bf16_t*)(sg + 24576); LAS const bf16_t* Um = (LAS const bf16_t*)(sg + 32768);
                const float gl = *(LAS const float*)(sg + 40960);
                bf16x8 Sb[2][2]; Sb[0][0] = pack8(S0, 0); Sb[0][1] = pack8(S0, 1); Sb[1][0] = pack8(S1, 0); Sb[1][1] = pack8(S1, 1);
                bf16x8 fw[2][4], fq[2][4];
                f32x16 vn[2], o[2];
#pragma unroll
                for (int ct = 0; ct < 2; ++ct)
#pragma unroll
                    for (int k4 = 0; k4 < 4; ++k4) { fw[ct][k4] = lds_frag(Wm, 32 * ct + r32, k4 * 2 + hi); fq[ct][k4] = lds_frag(QGm, 32 * ct + r32, k4 * 2 + hi); }
#pragma unroll
                for (int ct = 0; ct < 2; ++ct)
#pragma unroll
                    for (int i = 0; i < 16; ++i) vn[ct][i] = bf2f(Um[(32 * ct + crow(i, hi)) * 64 + vbase + r32]);
                o[0] = f32x16{}; o[1] = f32x16{};
                __builtin_amdgcn_sched_barrier(0);
#pragma unroll
                for (int k4 = 0; k4 < 4; ++k4) {
                    vn[0] = MFMA32(fw[0][k4], Sb[k4 >> 1][k4 & 1], vn[0]); o[0] = MFMA32(fq[0][k4], Sb[k4 >> 1][k4 & 1], o[0]);
                    vn[1] = MFMA32(fw[1][k4], Sb[k4 >> 1][k4 & 1], vn[1]); o[1] = MFMA32(fq[1][k4], Sb[k4 >> 1][k4 & 1], o[1]);
                }
                __builtin_amdgcn_sched_barrier(0);
                bf16x8 fa[2][4], fk[2][4];
#pragma unroll
                for (int g = 0; g < 4; ++g) { fa[0][g] = lds_frag(AQm, r32, g * 2 + hi); fa[1][g] = lds_frag(AQm, 32 + r32, g * 2 + hi);
                                              fk[0][g] = lds_frag(KGm, r32, g * 2 + hi); fk[1][g] = lds_frag(KGm, 32 + r32, g * 2 + hi); }
#pragma unroll
                for (int i = 0; i < 16; ++i) { S0[i] *= gl; S1[i] *= gl; }
                __builtin_amdgcn_sched_barrier(0);
                bf16x8 Vb[2][2]; Vb[0][0] = pack8(vn[0], 0); Vb[0][1] = pack8(vn[0], 1); Vb[1][0] = pack8(vn[1], 0); Vb[1][1] = pack8(vn[1], 1);
#pragma unroll
                for (int g = 0; g < 4; ++g) {
                    o[0] = MFMA32(fa[0][g], Vb[g >> 1][g & 1], o[0]); S0 = MFMA32(fk[0][g], Vb[g >> 1][g & 1], S0);
                    o[1] = MFMA32(fa[1][g], Vb[g >> 1][g & 1], o[1]); S1 = MFMA32(fk[1][g], Vb[g >> 1][g & 1], S1);
                }
                LAS bf16_t* ob = (LAS bf16_t*)(lds + GS_OBUF + (n & 1) * 8192);
#pragma unroll
                for (int ct = 0; ct < 2; ++ct)
#pragma unroll
                    for (int i = 0; i < 16; ++i) ob[(32 * ct + crow(i, hi)) * 64 + vbase + r32] = (bf16_t)f2bf(o[ct][i]);
            }
        }
        BAR_LDS();
        stg = stg + 1 >= GS_NSTAGE ? 0 : stg + 1;
    }
    } else if (wave < 4) {
    for (int n = 0; n <= NCHUNK; n += 2) {
        GS_POST(n, zqA);     if (n + 1 < NCHUNK) { GS_ZLOADX(zqA, n + 1); } BAR_LDS();
        GS_POST((n + 1), zqB); if (n + 2 < NCHUNK) { GS_ZLOADX(zqB, n + 2); } BAR_LDS();
    }
    } else {
    int stg = 0;
    for (int n = 0; n <= NCHUNK; ++n) {
        {
            if (n + 2 < NCHUNK) { const int s2_ = stg + 2 >= GS_NSTAGE ? stg + 2 - GS_NSTAGE : stg + 2; GS_DMA(n + 2, s2_); asm volatile("s_waitcnt vmcnt(11)" ::: "memory"); }
            else asm volatile("s_waitcnt vmcnt(0)" ::: "memory");
        }
        BAR_LDS();
        stg = stg + 1 >= GS_NSTAGE ? 0 : stg + 1;
    }
    }
#undef GS_DMA
#undef GS_ZLOADX
}
#define XB_TMO      128
#define XB_XCNT(j)  (256  + 64 * (j))
#define XB_XSUB(j)  (1280 + 64 * (j))
#define XB_XGEN(j)  (2304 + 64 * (j))
#define XB_TOP      3328
#define XB_TOPGEN   3392
#define XCD_BAR_WORDS 3456
#define XB_SPIN_CAP (1u << 18)

__device__ __forceinline__ unsigned xb_ld(unsigned* p)              { return __hip_atomic_load(p, __ATOMIC_RELAXED, __HIP_MEMORY_SCOPE_AGENT); }
__device__ __forceinline__ unsigned xb_add(unsigned* p, unsigned v) { return __hip_atomic_fetch_add(p, v, __ATOMIC_RELAXED, __HIP_MEMORY_SCOPE_AGENT); }
__device__ __forceinline__ unsigned xb_xcc_id() { return (unsigned)__builtin_amdgcn_s_getreg((3 << 11) | 20) & 0xFu; }
#define XB_SPIN(cond, bar) do { unsigned _sp = 0; while (cond) { __builtin_amdgcn_s_sleep(1); \
    if ((++_sp & 255u) == 0u) { if (xb_ld(&(bar)[XB_TMO])) break; if (_sp > XB_SPIN_CAP) { atomicAdd(&(bar)[XB_TMO], 1u); break; } } } } while (0)

struct XcdBarrier {
    unsigned* bar; unsigned x;
    volatile LAS unsigned* st;
};

__device__ __forceinline__ XcdBarrier xcd_barrier_post(unsigned* bar, volatile LAS unsigned* st) {
    XcdBarrier b; b.bar = bar; b.x = xb_xcc_id(); b.st = st;
    if (threadIdx.x == 0) (void)xb_add(&bar[XB_XCNT(b.x)], 1u);
    return b;
}
__device__ __forceinline__ void xcd_barrier_complete(unsigned* bar, unsigned x, unsigned& nloc, unsigned& nx) {
    const unsigned G = gridDim.x * gridDim.y * gridDim.z;
    unsigned sum, cnt, mine, sp = 0u;
    for (;;) {
        sum = 0u; cnt = 0u; mine = 0u;
#pragma unroll
        for (unsigned j = 0; j < 16; ++j) { const unsigned c = xb_ld(&bar[XB_XCNT(j)]); sum += c; cnt += (c > 0u) ? 1u : 0u; mine = (j == x) ? c : mine; }
        if (sum == G) break;
        __builtin_amdgcn_s_sleep(1);
        if ((++sp & 255u) == 0u) { if (xb_ld(&bar[XB_TMO])) break; if (sp > XB_SPIN_CAP) { atomicAdd(&bar[XB_TMO], 1u); break; } }
    }
    nloc = mine > 0u ? mine : 1u; nx = cnt > 0u ? cnt : 1u;
}

__device__ __forceinline__ void xcd_barrier(const XcdBarrier& b) {
    asm volatile("s_waitcnt vmcnt(0)" ::: "memory");
    __syncthreads();
    if (threadIdx.x == 0) {
        unsigned* bar = b.bar;
        __builtin_amdgcn_s_waitcnt(0);
        unsigned nloc = b.st[0], nx = b.st[1];
        if (nloc == 0u) { xcd_barrier_complete(bar, b.x, nloc, nx); b.st[0] = nloc; b.st[1] = nx; }
        const unsigned old = xb_add(&bar[XB_XSUB(b.x)], 1u);
        const unsigned gen = old / nloc;
        if (old + 1u == (gen + 1u) * nloc) {
            __builtin_amdgcn_fence(__ATOMIC_RELEASE, "agent");
            asm volatile("s_waitcnt vmcnt(0)" ::: "memory");
            const unsigned og = xb_add(&bar[XB_TOP], 1u);
            const unsigned tg = og / nx;
            if (og + 1u == (tg + 1u) * nx) xb_add(&bar[XB_TOPGEN], 1u);
            else XB_SPIN(xb_ld(&bar[XB_TOPGEN]) == tg, bar);
            __builtin_amdgcn_fence(__ATOMIC_ACQUIRE, "agent");
            xb_add(&bar[XB_XGEN(b.x)], 1u);
            asm volatile("s_waitcnt vmcnt(0)" ::: "memory");
        } else {
            XB_SPIN(xb_ld(&bar[XB_XGEN(b.x)]) == gen, bar);
            __builtin_amdgcn_fence(__ATOMIC_ACQUIRE, "agent");
            asm volatile("s_waitcnt vmcnt(0)" ::: "memory");
        }
    }
    __syncthreads();
}


constexpr int AT_STAGE = 32768;
constexpr int AT_NSTAGE = 4;
constexpr int AT_XBUF = 0;
constexpr int AT_WSF = AT_NSTAGE * AT_STAGE;
constexpr int AT_UNIT = AT_WSF + 2048;
constexpr float AT_THR = 8.0f;

DI float max3f(float a, float b, float c) { return __builtin_fmaxf(__builtin_fmaxf(a, b), c); }
DI s16x4 tr_read(LAS const unsigned char* p) { return __builtin_bit_cast(s16x4, __builtin_amdgcn_ds_read_tr16_b64_v4i16((LAS v4i16_t*)p)); }

template <int VAR> DI void attn_unit(const Params& P, LAS unsigned char* lds, int bh, int qi, int tid, int wave, int lane, float lam) {
    const int b = bh >> 2, h = bh & 3, r32 = lane & 31, hi = lane >> 5, qsub = wave >> 1, map = wave & 1, hh = 2 * h + map;
    const bf16_t* QB = (const bf16_t*)(P.ws + WS_QB); const bf16_t* KT = (const bf16_t*)(P.ws + WS_KT); const bf16_t* VT = (const bf16_t*)(P.ws + WS_VT);
    const int ntiles = 2 * qi + 3, my_nt = (qsub < 2) ? ntiles - 1 : ntiles;
    const bf16_t* k1 = KT + ((size_t)((b * 8 + 2 * h) * NKT) << 12);
    const bf16_t* k2 = KT + ((size_t)((b * 8 + 2 * h + 1) * NKT) << 12);
    const bf16_t* vv = VT + ((size_t)((b * 4 + h) * NKT) << 13);
#define AT_DMA(t, sb) do { LAS unsigned char* d_ = lds + (sb) * AT_STAGE + wave * 1024; unsigned lo_ = (unsigned)tid * 8u; asm volatile("" : "+v"(lo_)); \
        __builtin_amdgcn_global_load_lds((const unsigned*)(k1 + ((size_t)(t) << 12) + lo_), (LAS unsigned*)d_, 16, 0, 0); \
        __builtin_amdgcn_global_load_lds((const unsigned*)(k2 + ((size_t)(t) << 12) + lo_), (LAS unsigned*)(d_ + 8192), 16, 0, 0); \
        __builtin_amdgcn_global_load_lds((const unsigned*)(vv + ((size_t)(t) << 13) + lo_), (LAS unsigned*)(d_ + 16384), 16, 0, 0); \
        __builtin_amdgcn_global_load_lds((const unsigned*)(vv + ((size_t)(t) << 13) + 4096 + lo_), (LAS unsigned*)(d_ + 24576), 16, 0, 0); } while (0)
    bf16x8 qr[4];
    { const bf16_t* q = QB + ((size_t)((b * 8 + hh) * SEQ + qi * 128 + qsub * 32 + r32) << 6) + hi * 8;
#pragma unroll
      for (int d0 = 0; d0 < 4; ++d0) qr[d0] = *(const bf16x8*)(q + d0 * 16); }
    asm volatile("s_waitcnt vmcnt(0)" : "+v"(qr[0]), "+v"(qr[1]), "+v"(qr[2]), "+v"(qr[3]) :: "memory");
    AT_DMA(0, 0); AT_DMA(1, 1); AT_DMA(2, 2);
    asm volatile("s_waitcnt vmcnt(4)" ::: "memory");
    BAR_LDS();
    LAS float* wsf = (LAS float*)(lds + AT_WSF) + wave * 64;
    float m_run = 0.f, l_run = 0.f;
    f32x16 o[4]; o[0] = f32x16{}; o[1] = f32x16{}; o[2] = f32x16{}; o[3] = f32x16{};
    const unsigned voff = ((lane >> 4) & 1) * 32 + (lane & 3) * 8 + (4 * hi + ((lane & 15) >> 2)) * 64;
    const unsigned lbase = (unsigned)(uintptr_t)lds;
#define AT_QK(P0, P1, sl) do { LAS const unsigned char* kb_ = lds + (sl) * AT_STAGE + map * 8192 + hi * 1024 + r32 * 16; bf16x8 kf[8]; \
        _Pragma("unroll") for (int d0 = 0; d0 < 4; ++d0) { kf[2 * d0] = *(LAS const bf16x8*)(kb_ + d0 * 2048); kf[2 * d0 + 1] = *(LAS const bf16x8*)(kb_ + d0 * 2048 + 512); } \
        __builtin_amdgcn_sched_barrier(0); P0 = f32x16{}; P1 = f32x16{}; __builtin_amdgcn_s_setprio(1); \
        _Pragma("unroll") for (int d0 = 0; d0 < 4; ++d0) { P0 = MFMA32(kf[2 * d0], qr[d0], P0); P1 = MFMA32(kf[2 * d0 + 1], qr[d0], P1); } \
        __builtin_amdgcn_s_setprio(0); } while (0)
#define AT_ROWMAX(RM, P0, P1) do { float ma_ = max3f(P0[0], P0[1], P1[0]), mb_ = max3f(P0[2], P0[3], P1[1]); ma_ = max3f(ma_, P1[2], P1[3]); \
        _Pragma("unroll") for (int r = 4; r < 16; r += 4) { ma_ = max3f(ma_, P0[r], P0[r + 1]); mb_ = max3f(mb_, P0[r + 2], P0[r + 3]); ma_ = max3f(ma_, P1[r], P1[r + 1]); mb_ = max3f(mb_, P1[r + 2], P1[r + 3]); } \
        RM = swap32_max(max3f(ma_, mb_, mb_)); } while (0)
#define AT_EXPG(g) do { _Pragma("unroll") for (int r = 4 * (g); r < 4 * (g) + 4; ++r) { q0[r] = __builtin_amdgcn_exp2f(q0[r] - m_run); q1[r] = __builtin_amdgcn_exp2f(q1[r] - m_run); } } while (0)
#define AT_VLD(V, d0_) do { _Pragma("unroll") for (int ks = 0; ks < 4; ++ks) { \
        asm volatile("ds_read_b64_tr_b16 %0, %1 offset:%c2" : "=v"(V[2 * ks]) : "v"(vba), "i"((d0_) * 4096 + ks * 1024)); \
        asm volatile("ds_read_b64_tr_b16 %0, %1 offset:%c2" : "=v"(V[2 * ks + 1]) : "v"(vba), "i"((d0_) * 4096 + ks * 1024 + 512)); } } while (0)
#define AT_VF(V, ks) ((bf16x8){V[2 * (ks)][0], V[2 * (ks)][1], V[2 * (ks)][2], V[2 * (ks)][3], V[2 * (ks) + 1][0], V[2 * (ks) + 1][1], V[2 * (ks) + 1][2], V[2 * (ks) + 1][3]})
#define AT_WAITL(n, V) do { asm volatile("s_waitcnt lgkmcnt(" #n ")" : "+v"(V[0]), "+v"(V[1]), "+v"(V[2]), "+v"(V[3]), "+v"(V[4]), "+v"(V[5]), "+v"(V[6]), "+v"(V[7])); __builtin_amdgcn_sched_barrier(0); } while (0)
#define AT_PV(V, d0_) do { __builtin_amdgcn_s_setprio(1); o[d0_] = MFMA32(pa0, AT_VF(V, 0), o[d0_]); o[d0_] = MFMA32(pa1, AT_VF(V, 1), o[d0_]); o[d0_] = MFMA32(pa2, AT_VF(V, 2), o[d0_]); o[d0_] = MFMA32(pa3, AT_VF(V, 3), o[d0_]); __builtin_amdgcn_s_setprio(0); } while (0)
    f32x16 q0, q1;
    bf16x8 pa0, pa1, pa2, pa3;
    {
        AT_QK(q0, q1, 0);
#pragma unroll
        for (int r = 0; r < 16; ++r) { if (crow(r, hi) >= NMETA) q0[r] = -INFINITY; q1[r] = -INFINITY; }
        float rm; AT_ROWMAX(rm, q0, q1);
        m_run = rm;
        AT_EXPG(0); AT_EXPG(1); AT_EXPG(2); AT_EXPG(3);
        float ls0 = 0.f, ls1 = 0.f;
#pragma unroll
        for (int r = 0; r < 16; ++r) { ls0 += q0[r]; ls1 += q1[r]; }
        l_run = ls0 + ls1;
        pa0 = pack8(q0, 0); pa1 = pack8(q0, 1); pa2 = pack8(q1, 0); pa3 = pack8(q1, 1);
    }
    for (int t = 0; t < ntiles; ++t) {
        if (t + 3 < ntiles) AT_DMA(t + 3, (t + 3) & 3);
        const bool have_cur = t < my_nt, have_next = t + 1 < my_nt;
        float rm = 0.f;
        if (have_next) { AT_QK(q0, q1, (t + 1) & 3); AT_ROWMAX(rm, q0, q1); }
        const bool need = have_next && __any(rm - m_run > AT_THR);
        if (have_cur) {
            s16x4 va_[8], vb_[8];
            const unsigned vba = lbase + (t & 3) * AT_STAGE + 16384 + voff;
            asm volatile("s_waitcnt lgkmcnt(0)" ::: "memory"); __builtin_amdgcn_sched_barrier(0);
            if (have_next && !need) {
                AT_VLD(va_, 0); AT_VLD(vb_, 1);
                AT_WAITL(8, va_); AT_PV(va_, 0); AT_EXPG(0); __builtin_amdgcn_sched_barrier(0); AT_VLD(va_, 2);
                AT_WAITL(8, vb_); AT_PV(vb_, 1); AT_EXPG(1); __builtin_amdgcn_sched_barrier(0); AT_VLD(vb_, 3);
                AT_WAITL(8, va_); AT_PV(va_, 2); AT_EXPG(2); __builtin_amdgcn_sched_barrier(0);
                AT_WAITL(0, vb_); AT_PV(vb_, 3); AT_EXPG(3);
            } else {
                AT_VLD(va_, 0); AT_VLD(vb_, 1);
                AT_WAITL(8, va_); AT_PV(va_, 0); __builtin_amdgcn_sched_barrier(0); AT_VLD(va_, 2);
                AT_WAITL(8, vb_); AT_PV(vb_, 1); __builtin_amdgcn_sched_barrier(0); AT_VLD(vb_, 3);
                AT_WAITL(8, va_); AT_PV(va_, 2); __builtin_amdgcn_sched_barrier(0);
                AT_WAITL(0, vb_); AT_PV(vb_, 3);
            }
        }
        if (have_next) {
            if (need) {
                const float dl = fmaxf(rm - m_run, 0.f);
                m_run += dl;
                const float alpha = __builtin_amdgcn_exp2f(-dl);
                l_run *= alpha;
                if (hi == 0) wsf[r32] = alpha;
                LDS_WAIT();
#pragma unroll
                for (int r = 0; r < 16; ++r) { const float a = wsf[crow(r, hi)];
#pragma unroll
                    for (int d0 = 0; d0 < 4; ++d0) o[d0][r] *= a; }
                LDS_WAIT();
                AT_EXPG(0); AT_EXPG(1); AT_EXPG(2); AT_EXPG(3);
            }
            float ls0 = 0.f, ls1 = 0.f;
#pragma unroll
            for (int r = 0; r < 16; ++r) { ls0 += q0[r]; ls1 += q1[r]; }
            l_run += ls0 + ls1;
            pa0 = pack8(q0, 0); pa1 = pack8(q0, 1); pa2 = pack8(q1, 0); pa3 = pack8(q1, 1);
        }
        if (t + 3 < ntiles) asm volatile("s_waitcnt vmcnt(4)" ::: "memory"); else asm volatile("s_waitcnt vmcnt(0)" ::: "memory");
        BAR_LDS();
    }
#undef AT_QK
#undef AT_ROWMAX
#undef AT_EXPG
#undef AT_VLD
#undef AT_VF
#undef AT_WAITL
#undef AT_PV
    if (VAR != 0) { if (o[0][0] + o[1][1] + o[2][2] + o[3][3] + l_run == 123.456f) ((float*)(P.ws + WS_DUMP))[tid] = 1.f; __syncthreads(); return; }
    l_run = swap32_add(l_run);
    const float sc = (map ? lam : 1.0f) / l_run;
    if (hi == 0) wsf[r32] = sc;
    LDS_WAIT();
#pragma unroll
    for (int r = 0; r < 16; ++r) { const float a = wsf[crow(r, hi)];
#pragma unroll
        for (int d0 = 0; d0 < 4; ++d0) o[d0][r] *= a; }
    LAS float* xb = (LAS float*)(lds + AT_XBUF + qsub * 16384);
    if (map) {
#pragma unroll
        for (int d0 = 0; d0 < 4; ++d0)
#pragma unroll
            for (int r = 0; r < 16; ++r) xb[(d0 * 16 + r) * 64 + lane] = o[d0][r];
    }
    __syncthreads();
    if (!map) {
        const float* dn = P.in[8];
        bf16_t* MIX = (bf16_t*)(P.ws + WS_MIX);
        float ss[16];
#pragma unroll
        for (int r = 0; r < 16; ++r) { ss[r] = 0.f;
#pragma unroll
            for (int d0 = 0; d0 < 4; ++d0) { o[d0][r] -= xb[(d0 * 16 + r) * 64 + lane]; ss[r] += o[d0][r] * o[d0][r]; } }
#pragma unroll
        for (int r = 0; r < 16; ++r) {
            ss[r] = half_sum32(ss[r]);
            ss[r] = 0.8f / sqrtf(ss[r] * (1.0f / 128.0f) + EPS);
        }
        float dg[4];
#pragma unroll
        for (int d0 = 0; d0 < 4; ++d0) dg[d0] = dn[32 * d0 + r32];
#pragma unroll
        for (int r = 0; r < 16; ++r) {
            bf16_t* orow = MIX + (size_t)(b * SEQ + qi * 128 + qsub * 32 + crow(r, hi)) * 1024 + h * 128 + r32;
#pragma unroll
            for (int d0 = 0; d0 < 4; ++d0) orow[32 * d0] = (bf16_t)f2bf(o[d0][r] * ss[r] * dg[d0]);
        }
    }
    __syncthreads();
#undef AT_DMA
}

template <int VAR> DI void attn_phase(const Params& P, LAS unsigned char* lds, int tid, int wave, int lane) {
    unsigned* ctl = (unsigned*)(P.ws + WS_CTL);
    const float* lq1 = P.in[4]; const float* lk1 = P.in[5]; const float* lq2 = P.in[6]; const float* lk2 = P.in[7];
    const float lam = __expf(wave_sum(lq1[lane] * lk1[lane])) - __expf(wave_sum(lq2[lane] * lk2[lane])) + 0.2f;
    LAS volatile int* ub = (LAS volatile int*)(lds + AT_UNIT);
    const unsigned x0 = xb_xcc_id() & 7u;
    for (;;) {
        if (tid == 0) {
            int u = -1;
            for (unsigned j = 0; j < 8u && u < 0; ++j) { const unsigned x = (x0 + j) & 7u;
                if (__hip_atomic_load(ctl + CW_ATTQ + 64 * x, __ATOMIC_RELAXED, __HIP_MEMORY_SCOPE_AGENT) >= 64u) continue;
                const unsigned i = __hip_atomic_fetch_add(ctl + CW_ATTQ + 64 * x, 1u, __ATOMIC_RELAXED, __HIP_MEMORY_SCOPE_AGENT);
                if (i < 64u) u = (int)(x * 64u + i); }
            *ub = u;
        }
        __syncthreads();
        const int u = *ub;
        __syncthreads();
        if (u < 0) break;
        int tid_u = tid; asm volatile("" : "+v"(tid_u));
        attn_unit<VAR>(P, lds, u >> 6, 63 - (u & 63), tid_u, wave, tid_u & 63, lam);
    }
}

struct EpiOutProj {
    static constexpr bool PERM = false, AFTER_DRAIN = false;
    const float* x; float* out; bf16_t* u2;
    DI void operator()(const pg8::f32x4 (&acc)[2][2][4][2], const pg8::Unit& u, int wr, int wc, int fr, int fq) const {
        const int row0 = u.pm * 256 + wr * 64 + fr, col0 = u.pn * 256 + wc * 32 + 4 * fq;
#pragma unroll
        for (int ai = 0; ai < 2; ++ai) {
            f32x4 xv[4][2][2];
#pragma unroll
            for (int m = 0; m < 4; ++m) { const size_t off = (size_t)(row0 + ai * 128 + m * 16) * 1024 + col0;
#pragma unroll
                for (int bj = 0; bj < 2; ++bj)
#pragma unroll
                    for (int n = 0; n < 2; ++n) xv[m][bj][n] = *(const f32x4*)(x + off + bj * 128 + n * 16); }
#pragma unroll
            for (int m = 0; m < 4; ++m) { const size_t off = (size_t)(row0 + ai * 128 + m * 16) * 1024 + col0;
#pragma unroll
                for (int bj = 0; bj < 2; ++bj)
#pragma unroll
                    for (int n = 0; n < 2; ++n) { const f32x4 hv = acc[ai][bj][m][n] + xv[m][bj][n]; *(f32x4*)(out + off + bj * 128 + n * 16) = hv;
                        *(u32x2*)(u2 + off + bj * 128 + n * 16) = (u32x2){pk2(hv[0], hv[1]), pk2(hv[2], hv[3])}; } }
        }
    }
};

typedef float f32x4v __attribute__((ext_vector_type(4)));
#ifdef ROUTE_PROBE
#define ROUTE_MID_HOOK() do { XcdBarrier xb2; xb2.bar = (unsigned*)(P.ws + WS_CTL) + CW_BAR; xb2.x = xb_xcc_id(); xb2.st = (volatile LAS unsigned*)(ldsb + LDS_BYTES - 64); xcd_barrier(xb2); \
    if (blockIdx.x == 0 && threadIdx.x == 0) __hip_atomic_store((unsigned long long*)(P.ws + WS_CTL + 65536) + 20, (unsigned long long)__builtin_amdgcn_s_memrealtime(), __ATOMIC_RELAXED, __HIP_MEMORY_SCOPE_AGENT); } while (0)
#else
#define ROUTE_MID_HOOK() do {} while (0)
#endif
DI void route_tile(const Params& P, int tile, int par, LAS float* sc  , int lane, LAS unsigned char* ldsb) {
    const float* h2 = P.out; const float* WR = (const float*)(P.ws + WS_WR);
    const int r16 = lane & 15, kq = lane >> 4;
    const float* arow = h2 + (size_t)(tile * 16 + r16) * 1024 + par * 512 + kq * 8;
    const float* b0 = WR + (size_t)r16 * 1024 + par * 512 + kq * 8; const float* b1 = b0 + 16 * 1024; const float* b2 = WR + (size_t)(32 + (r16 & 3)) * 1024 + par * 512 + kq * 8;
    const float z2 = (r16 < 4) ? 1.0f : 0.0f;
    f32x4v c0 = {}, c1 = {}, c2 = {};
    float ss = 0.f;
    f32x4 bA[4][4], bB[4][4];
#define RT_LOAD(B, tb) do { _Pragma("unroll") for (int j = 0; j < 4; ++j) { const int o_ = 32 * ((tb) + (j >> 1)) + 4 * (j & 1); \
        B[j][0] = *(const f32x4*)(arow + o_); B[j][1] = *(const f32x4*)(b0 + o_); B[j][2] = *(const f32x4*)(b1 + o_); B[j][3] = *(const f32x4*)(b2 + o_); } } while (0)
#define RT_COMP(B) do { _Pragma("unroll") for (int j = 0; j < 4; ++j) { const f32x4 a = B[j][0]; ss += (a.x * a.x + a.y * a.y) + (a.z * a.z + a.w * a.w); \
        _Pragma("unroll") for (int i = 0; i < 4; ++i) { c0 = __builtin_amdgcn_mfma_f32_16x16x4f32(a[i], B[j][1][i], c0, 0, 0, 0); \
            c1 = __builtin_amdgcn_mfma_f32_16x16x4f32(a[i], B[j][2][i], c1, 0, 0, 0); c2 = __builtin_amdgcn_mfma_f32_16x16x4f32(a[i], B[j][3][i] * z2, c2, 0, 0, 0); } } } while (0)
    RT_LOAD(bA, 0);
#pragma unroll 1
    for (int tb = 0; tb < 16; tb += 4) { RT_LOAD(bB, tb + 2); RT_COMP(bA); if (tb + 4 < 16) RT_LOAD(bA, tb + 4); RT_COMP(bB); }
#undef RT_LOAD
#undef RT_COMP
    ss += swz_xor16(ss); ss = swap32_add(ss);
    LAS float* my = sc + par * 800;
#pragma unroll
    for (int r = 0; r < 4; ++r) { const int row = 4 * kq + r; my[row * 48 + r16] = c0[r]; my[row * 48 + 16 + r16] = c1[r]; my[row * 48 + 32 + r16] = c2[r]; }
    if (lane < 16) my[768 + lane] = ss;
    LAS int* lcnt = (LAS int*)(ldsb + 4 * 32768 + 1024);
    if (threadIdx.x < 32) lcnt[threadIdx.x] = 0;
    int pa = 0, pb = 0, ea_ = 0, eb_ = 0; float w1_ = 0.f, w2_ = 0.f, rs_ = 0.f;
    LDS_WAIT();
    __syncthreads();
    ROUTE_MID_HOOK();
    if (par == 0 && lane < 16) {
        LAS const float* l0 = sc + lane * 48; LAS const float* l1 = sc + 800 + lane * 48;
        const float rs = __builtin_amdgcn_rsqf((sc[768 + lane] + sc[800 + 768 + lane]) * (1.0f / 1024.0f) + EPS);
#define LG(j) (l0[j] + l1[j])
        const int t = tile * 16 + lane;
        const float* bg = P.in[16]; const float* br = P.in[18];
        float gl[4]; int gs = 0; float gm;
#pragma unroll
        for (int j = 0; j < 4; ++j) gl[j] = LG(j) * rs + bg[j];
        gm = gl[0];
#pragma unroll
        for (int j = 1; j < 4; ++j) if (gl[j] > gm) { gm = gl[j]; gs = j; }
        float gsum = 0.f;
#pragma unroll
        for (int j = 0; j < 4; ++j) gsum += __expf(gl[j] - gm);
        const float psel = 1.0f / gsum;
        float e1 = -INFINITY, e2 = -INFINITY; int i1 = 0, i2 = 0;
#pragma unroll
        for (int j = 0; j < 8; ++j) {
            const float v = LG(4 + gs * 8 + j) * rs + br[gs * 8 + j];
            if (v > e1) { e2 = e1; i2 = i1; e1 = v; i1 = j; } else if (v > e2) { e2 = v; i2 = j; }
        }
        const float x2 = __expf(e2 - e1), w1 = psel / (1.0f + x2), w2 = psel * x2 / (1.0f + x2);
        const int ea = gs * 8 + i1, eb = gs * 8 + i2;
        pa = (int)__hip_atomic_fetch_add(lcnt + ea, 1, __ATOMIC_RELAXED, __HIP_MEMORY_SCOPE_WORKGROUP); pb = (int)__hip_atomic_fetch_add(lcnt + eb, 1, __ATOMIC_RELAXED, __HIP_MEMORY_SCOPE_WORKGROUP);
        ea_ = ea; eb_ = eb; w1_ = w1; w2_ = w2; rs_ = rs;
        ((int*)(P.ws + WS_TOKE))[2 * t] = ea; ((int*)(P.ws + WS_TOKE))[2 * t + 1] = eb;
        ((float*)(P.ws + WS_TOKW))[2 * t] = w1; ((float*)(P.ws + WS_TOKW))[2 * t + 1] = w2;
        ((float*)(P.ws + WS_RS2))[t] = rs;
#undef LG
    }
    LDS_WAIT();
    __syncthreads();
    if (threadIdx.x < 32) { const int c = lcnt[threadIdx.x];
        lcnt[32 + threadIdx.x] = c ? (int)atomicAdd((unsigned*)(P.ws + WS_CTL) + CW_CNT + 64 * threadIdx.x, (unsigned)c) : 0; }
    LDS_WAIT();
    __syncthreads();
    if (par == 0 && lane < 16) { const int t = tile * 16 + lane;
        const int qa = lcnt[32 + ea_] + pa, qb = lcnt[32 + eb_] + pb;
        ((int*)(P.ws + WS_TOKP))[2 * t] = qa; ((int*)(P.ws + WS_TOKP))[2 * t + 1] = qb;
        ((int*)(P.ws + WS_LIST))[ea_ * 16384 + qa] = t; ((int*)(P.ws + WS_LIST))[eb_ * 16384 + qb] = t;
        ((float*)(P.ws + WS_LISTW))[ea_ * 16384 + qa] = w1_; ((float*)(P.ws + WS_LISTW))[eb_ * 16384 + qb] = w2_;
        ((float*)(P.ws + WS_LISTRS))[ea_ * 16384 + qa] = rs_; ((float*)(P.ws + WS_LISTRS))[eb_ * 16384 + qb] = rs_; }
    LDS_WAIT();
    __syncthreads();
}

#ifndef P4A_REP
#define P4A_REP 0
#endif
template <int P4A_PART> DI void phase4a(const Params& P, LAS unsigned char* lds, int gw, int NGW, int wave, int lane) {
    LAS float* scr = (LAS float*)(lds + wave * 16384);
    if (P4A_PART & 1) for (int tile = (gw >> 1); tile < MTOK / 16; tile += (NGW >> 1)) route_tile(P, tile, wave & 1, (LAS float*)(lds + (wave >> 1) * 32768), lane, lds);
    if (!(P4A_PART & 2)) return;
    bf16_t* WGU = (bf16_t*)(P.ws + WS_WGU); bf16_t* WD = (bf16_t*)(P.ws + WS_WD);
    const float* wg = P.in[19]; const float* wu = P.in[20]; const float* wd = P.in[21]; const float* gf = P.in[14];
    constexpr int I_GU = 16 * 16, I_D = 4 * 32, NIT = 32 * (I_GU + I_D);
    struct TItem { const float* src; const float* gn; bf16_t* dst; int stride, ldk; };
    auto mk = [&](int it) { TItem d; const int e = it / (I_GU + I_D), r = it % (I_GU + I_D);
        if (r < I_GU) { const int n0 = (r & 15) * 32, j = n0 >> 8, up = (n0 >> 7) & 1, k0 = (r >> 4) * 64;
            d.src = (up ? wu : wg) + (size_t)e * 1024 * 256 + (size_t)k0 * 256 + 128 * j + (n0 & 127); d.gn = gf + k0; d.stride = 256; d.ldk = 1024;
            d.dst = WGU + (size_t)e * 512 * 1024 + (size_t)n0 * 1024 + k0; }
        else { const int r2 = r - I_GU, k0 = (r2 >> 5) * 64, n0 = (r2 & 31) * 32;
            d.src = wd + (size_t)e * 256 * 1024 + (size_t)k0 * 1024 + n0; d.gn = nullptr; d.stride = 1024; d.ldk = 256;
            d.dst = WD + (size_t)e * 1024 * 256 + (size_t)n0 * 256 + k0; }
        return d; };
#define TI_LOAD(D, V) do { _Pragma("unroll") for (int i = 0; i < 32; ++i) { const int kk = 2 * i + (lane >> 5); \
        V[i] = D.src[(size_t)kk * D.stride + (lane & 31)] * (D.gn ? D.gn[kk] : 1.0f); } } while (0)
#define TI_FIN(D, V) do { _Pragma("unroll") for (int i = 0; i < 32; ++i) scr[(2 * i + (lane >> 5)) * 33 + (lane & 31)] = V[i]; \
        LDS_WAIT(); const int c_ = lane & 7; \
        _Pragma("unroll") for (int j = 0; j < 4; ++j) { const int n_ = (lane >> 3) + 8 * j; const LAS float* s_ = scr + (8 * c_) * 33 + n_; \
            u32x4 o_; o_.x = pk2(s_[0 * 33], s_[1 * 33]); o_.y = pk2(s_[2 * 33], s_[3 * 33]); o_.z = pk2(s_[4 * 33], s_[5 * 33]); o_.w = pk2(s_[6 * 33], s_[7 * 33]); \
            *(u32x4*)(D.dst + (size_t)n_ * D.ldk + 8 * c_) = o_; } \
        LDS_WAIT(); } while (0)
    for (int rp_ = 0; rp_ < (P4A_REP ? 2 : 1); ++rp_) {
        float va[32], vb[32];
        int it = gw;
        if (it < NIT) { TItem da = mk(it); TI_LOAD(da, va);
            for (;;) {
                const int itb = it + NGW; TItem db = da; const bool hb = itb < NIT;
                if (hb) { db = mk(itb); TI_LOAD(db, vb); }
                TI_FIN(da, va);
                if (!hb) break;
                it = itb + NGW; const bool ha = it < NIT;
                if (ha) { da = mk(it); TI_LOAD(da, va); }
                TI_FIN(db, vb);
                if (!ha) break;
            }
        }
    }
#undef TI_LOAD
#undef TI_FIN
}

DI void expert_layout(const Params& P, int lane, int& cnt, int& base, int& tend) {
    const unsigned* c = (const unsigned*)(P.ws + WS_CTL) + CW_CNT;
    cnt = (lane < 32) ? (int)__hip_atomic_load(c + 64 * lane, __ATOMIC_RELAXED, __HIP_MEMORY_SCOPE_AGENT) : 0;
    const int tiles = (cnt + 255) >> 8;
    int inc = 0;
#pragma unroll
    for (int i = 0; i < 32; ++i) { const int ti = __builtin_amdgcn_readlane(tiles, i); inc += (i <= lane) ? ti : 0; }
    tend = inc; base = (inc - tiles) << 8;
}

DI void phase4b(const Params& P, int gw, int NGW, int lane) {
    int cnt, base, tend; expert_layout(P, lane, cnt, base, tend);
    bf16_t* XS = (bf16_t*)(P.ws + WS_XS); float* SLOTW = (float*)(P.ws + WS_SLOTW);
    const int* TOKE = (const int*)(P.ws + WS_TOKE); const float* TOKW = (const float*)(P.ws + WS_TOKW); int* TOKP = (int*)(P.ws + WS_TOKP); const float* RS2 = (const float*)(P.ws + WS_RS2);
    for (int t = gw; t < MTOK; t += NGW) {
        const f32x4* hr = (const f32x4*)(P.out + (size_t)t * 1024);
        const float rs = RS2[t];
        u32x2 w[4];
#pragma unroll
        for (int j = 0; j < 4; ++j) { const f32x4 v = hr[64 * j + lane]; w[j] = (u32x2){pk2(v.x * rs, v.y * rs), pk2(v.z * rs, v.w * rs)}; }
#pragma unroll
        for (int k = 0; k < 2; ++k) {
            const int e = __builtin_amdgcn_readfirstlane(TOKE[2 * t + k]), slot = __builtin_amdgcn_readlane(base, e) + TOKP[2 * t + k];
            u32x2* orow = (u32x2*)(XS + (size_t)slot * 1024);
#pragma unroll
            for (int j = 0; j < 4; ++j) orow[64 * j + lane] = w[j];
            if (lane == 0) { SLOTW[slot] = TOKW[2 * t + k]; TOKP[2 * t + k] = slot; }
        }
    }
    for (int e = 0; e < 32; ++e) {
        const int ce = __builtin_amdgcn_readlane(cnt, e), be = __builtin_amdgcn_readlane(base, e), end = be + (((ce + 255) >> 8) << 8);
        for (int r = be + ce + gw; r < end; r += NGW) { u32x2* orow = (u32x2*)(XS + (size_t)r * 1024);
#pragma unroll
            for (int j = 0; j < 4; ++j) orow[64 * j + lane] = (u32x2){0u, 0u};
            if (lane == 0) SLOTW[r] = 0.f; }
    }
}

struct GroupedOrder {
    int tend; int total; int G, c, NS; int cnt, base; const int* LIST;
    DI unsigned rowoff(const pg8::Unit& u, int r) const {
        const int e = __builtin_amdgcn_readfirstlane(u.pn >> NS), ce = __builtin_amdgcn_readlane(cnt, e), t0 = __builtin_amdgcn_readlane(base, e) >> 8;
        const int pos = (u.pm - t0) * 256 + r;
        const int tok = pos < ce ? LIST[e * 16384 + pos] : 0;
        return (unsigned)tok * 2048u;
    }
    DI bool next(int i, pg8::Unit& u) const {
        const int L = i * G + c; if (L >= (total << NS)) return false;
        const int mt = L >> NS, j = L & ((1 << NS) - 1);
        const int e = __builtin_popcountll(__ballot(((int)(threadIdx.x & 63) < 32) && tend <= mt));
        u.pm = mt; u.pn = (e << NS) + j; return true;
    }
    DI void a_ready(const pg8::Unit&) const {}
    DI void done(const pg8::Unit&) const {}
};
struct EpiGateUp {
    static constexpr bool PERM = true, AFTER_DRAIN = false;
    const float* LISTW; const float* LISTRS; bf16_t* YS; int cnt, base;
    DI void operator()(const pg8::f32x4 (&acc)[2][2][4][2], const pg8::Unit& u, int wr, int wc, int fr, int fq) const {
        const int f0 = (u.pn & 1) * 128 + wc * 32 + fq * 8;
        const int e = __builtin_amdgcn_readfirstlane(u.pn >> 1), ce = __builtin_amdgcn_readlane(cnt, e), t0 = __builtin_amdgcn_readlane(base, e) >> 8;
#pragma unroll
        for (int ai = 0; ai < 2; ++ai)
#pragma unroll
            for (int m = 0; m < 4; ++m) {
                const int r = ai * 128 + wr * 64 + m * 16 + fr, row = u.pm * 256 + r, pos = (u.pm - t0) * 256 + r;
                const bool ok = pos < ce;
                const float cw = ok ? LISTW[e * 16384 + pos] : 0.f, rs = ok ? LISTRS[e * 16384 + pos] : 0.f, cr = cw * rs;
                float a[8];
#pragma unroll
                for (int i = 0; i < 4; ++i) {
                    const float g0 = acc[ai][0][m][0][i] * rs, g1 = acc[ai][0][m][1][i] * rs;
                    a[i] = g0 * __builtin_amdgcn_rcpf(1.0f + __expf(-g0)) * acc[ai][1][m][0][i] * cr; a[4 + i] = g1 * __builtin_amdgcn_rcpf(1.0f + __expf(-g1)) * acc[ai][1][m][1][i] * cr;
                }
                *(u32x4*)(YS + (size_t)row * 256 + f0) = (u32x4){pk2(a[0], a[1]), pk2(a[2], a[3]), pk2(a[4], a[5]), pk2(a[6], a[7])};
            }
    }
};
struct EpiDown {
    static constexpr bool PERM = true, AFTER_DRAIN = false;
    bf16_t* YO;
    DI void operator()(const pg8::f32x4 (&acc)[2][2][4][2], const pg8::Unit& u, int wr, int wc, int fr, int fq) const {
        const int c0 = (u.pn & 3) * 256 + wc * 32 + fq * 8;
#pragma unroll
        for (int ai = 0; ai < 2; ++ai)
#pragma unroll
            for (int m = 0; m < 4; ++m) {
                bf16_t* rowp = YO + (size_t)(u.pm * 256 + ai * 128 + wr * 64 + m * 16 + fr) * 1024 + c0;
#pragma unroll
                for (int bj = 0; bj < 2; ++bj) { const pg8::f32x4 v0 = acc[ai][bj][m][0], v1 = acc[ai][bj][m][1];
                    *(u32x4*)(rowp + bj * 128) = (u32x4){pk2(v0[0], v0[1]), pk2(v0[2], v0[3]), pk2(v1[0], v1[1]), pk2(v1[2], v1[3])}; }
            }
    }
};

DI void phase7(const Params& P, int gw, int NGW, int lane) {
    int cnt_, base_, tend_; expert_layout(P, lane, cnt_, base_, tend_);
    const bf16_t* YO = (const bf16_t*)(P.ws + WS_YO); const int* TOKP = (const int*)(P.ws + WS_TOKP); const int* TOKE = (const int*)(P.ws + WS_TOKE); const f32x4* nf = (const f32x4*)P.in[22];
    f32x4 nfv[4];
#pragma unroll
    for (int j = 0; j < 4; ++j) nfv[j] = nf[64 * j + lane];
    for (int t0 = gw; t0 < MTOK; t0 += 2 * NGW) {
        f32x4 v[2][4]; u32x2 ya[2][4], yb[2][4];
#pragma unroll
        for (int r = 0; r < 2; ++r) { const int t = (t0 + r * NGW) < MTOK ? (t0 + r * NGW) : t0;
            const f32x4* hr = (const f32x4*)(P.out + (size_t)t * 1024);
            const int e0 = __builtin_amdgcn_readfirstlane(TOKE[2 * t]), e1 = __builtin_amdgcn_readfirstlane(TOKE[2 * t + 1]);
            const int s0 = __builtin_amdgcn_readlane(base_, e0) + TOKP[2 * t], s1 = __builtin_amdgcn_readlane(base_, e1) + TOKP[2 * t + 1];
            const u32x2* y0 = (const u32x2*)(YO + (size_t)s0 * 1024); const u32x2* y1 = (const u32x2*)(YO + (size_t)s1 * 1024);
#pragma unroll
            for (int j = 0; j < 4; ++j) { v[r][j] = hr[64 * j + lane]; ya[r][j] = y0[64 * j + lane]; yb[r][j] = y1[64 * j + lane]; } }
#pragma unroll
        for (int r = 0; r < 2; ++r) { const int t = t0 + r * NGW;
            if (t < MTOK) {
                float s = 0.f;
#pragma unroll
                for (int j = 0; j < 4; ++j) { const u32x2 a = ya[r][j], c = yb[r][j];
                    v[r][j].x += __uint_as_float(a.x << 16) + __uint_as_float(c.x << 16); v[r][j].y += __uint_as_float(a.x & 0xffff0000u) + __uint_as_float(c.x & 0xffff0000u);
                    v[r][j].z += __uint_as_float(a.y << 16) + __uint_as_float(c.y << 16); v[r][j].w += __uint_as_float(a.y & 0xffff0000u) + __uint_as_float(c.y & 0xffff0000u);
                    s += (v[r][j].x * v[r][j].x + v[r][j].y * v[r][j].y) + (v[r][j].z * v[r][j].z + v[r][j].w * v[r][j].w); }
                s = wave_sum(s);
                const float rs = __builtin_amdgcn_rsqf(s * (1.0f / 1024.0f) + EPS);
                f32x4* hw = (f32x4*)(P.out + (size_t)t * 1024);
#pragma unroll
                for (int j = 0; j < 4; ++j) hw[64 * j + lane] = v[r][j] * rs * nfv[j];
            } }
    }
}

struct EpiNull { static constexpr bool PERM = true, AFTER_DRAIN = false; float* d;
    DI void operator()(const pg8::f32x4 (&acc)[2][2][4][2], const pg8::Unit& u, int wr, int wc, int fr, int fq) const {
        pg8::f32x4 s = acc[0][0][0][0];
#pragma unroll
        for (int ai = 0; ai < 2; ++ai)
#pragma unroll
            for (int bj = 0; bj < 2; ++bj)
#pragma unroll
                for (int m = 0; m < 4; ++m)
#pragma unroll
                    for (int n = 0; n < 2; ++n) s += acc[ai][bj][m][n];
        if (s[0] == 12345.678f) d[threadIdx.x] = s[1] + s[2] + s[3]; } };
#ifndef PHMASK
#define PHMASK 2047
#endif
#ifndef P1_STAGGER_TICKS
#define P1_STAGGER_TICKS 0
#endif
#ifndef ATT_VAR
#define ATT_VAR 0
#endif
#ifndef REPMASK
#define REPMASK 0
#endif
#define REP(bit) for (int rep_ = 0; rep_ < ((REPMASK & (bit)) ? 2 : 1); ++rep_)
#define REPSYNC(bit) if ((REPMASK & (bit)) && rep_ == 0) GRID_BAR()
typedef const __attribute__((address_space(4))) Params* KParams;
DI Params load_params(KParams kp) { Params p;
#pragma unroll
    for (int i = 0; i < 23; ++i) p.in[i] = kp->in[i];
    p.out = kp->out; p.ws = kp->ws; return p; }
__global__ void __launch_bounds__(NTHREADS, 2) hymba_fwd(Params Pin) {
    extern __shared__ __attribute__((aligned(16))) unsigned char lds_raw[];
    LAS unsigned char* lds = (LAS unsigned char*)lds_raw;
    cg::grid_group grid = cg::this_grid();
    volatile LAS unsigned* bst = (volatile LAS unsigned*)(lds + LDS_BYTES - 64);
    if (threadIdx.x < 2) bst[threadIdx.x] = 0u;
    __syncthreads();
    const XcdBarrier xbar = xcd_barrier_post((unsigned*)(Pin.ws + WS_CTL) + CW_BAR, bst);
#ifndef TPROBE
#define TPROBE (-1)
#endif
#ifndef TPROBE_A
#define TPROBE_A TPROBE
#define TPROBE_B (TPROBE + 1)
#endif
    int nstamp_ = 0;
#define STAMP() do { if (TPROBE >= 0) { if (blockIdx.x == 0 && threadIdx.x == 0) __hip_atomic_store((unsigned long long*)(Pin.ws + WS_CTL + 65536) + nstamp_, (unsigned long long)__builtin_amdgcn_s_memrealtime(), __ATOMIC_RELAXED, __HIP_MEMORY_SCOPE_AGENT); ++nstamp_; } } while (0)
#define GRID_BAR() do { xcd_barrier(xbar); STAMP(); } while (0)
    STAMP();
    const int G = gridDim.x, blk = blockIdx.x, NGW = G * NWAVES, NGT = G * NTHREADS;
#define PHASE_IDS() KParams kp_ = (KParams)__builtin_amdgcn_kernarg_segment_ptr(); asm volatile("" : "+s"(kp_)); const Params P = load_params(kp_); int tid = threadIdx.x; asm volatile("" : "+v"(tid)); const int lane = tid & 63, wave = __builtin_amdgcn_readfirstlane(tid >> 6), gw = blk * NWAVES + wave, gtid = blk * NTHREADS + tid; (void)lane; (void)gw; (void)gtid; (void)wave

    REP(1) { if (PHMASK & 1) { PHASE_IDS(); phase0(P, lds, gw, NGW, gtid, NGT, wave, lane); } REPSYNC(1); }
    GRID_BAR();
    REP(2) { if (PHMASK & 2) { PHASE_IDS();
        pg8::Gemm g{(const bf16_t*)(P.ws + WS_XB), (const bf16_t*)(P.ws + WS_WINT), MROWS, NPROJ, 1024};
        if (P1_STAGGER_TICKS > 0 && (blk & 1)) { const unsigned long long s0_ = __builtin_amdgcn_s_memrealtime(); while (__builtin_amdgcn_s_memrealtime() - s0_ < (unsigned long long)P1_STAGGER_TICKS) __builtin_amdgcn_s_sleep(8); }
        pg8::StaticOrder S; S.init(MROWS, NPROJ, G, blk);
        EpiInProj E{(const float*)(P.ws + WS_RS1), (const float*)(P.ws + WS_COS), (const float*)(P.ws + WS_SIN), P.in[10], P.in[11],
                    (bf16_t*)(P.ws + WS_QB), (bf16_t*)(P.ws + WS_KT), (bf16_t*)(P.ws + WS_VT), (bf16_t*)(P.ws + WS_QKVB), (bf16_t*)(P.ws + WS_ZB), (float*)(P.ws + WS_GB)};
        if (rep_ == 0) pg8::gemm_phase<EpiInProj, pg8::StaticOrder, true, true>(lds, g, S, E);
        else { EpiNull EN{(float*)(P.ws + WS_DUMP)}; pg8::gemm_phase<EpiNull, pg8::StaticOrder, true, true>(lds, g, S, EN); }
    } REPSYNC(2); }
    GRID_BAR();
    REP(4) { if (PHMASK & 4) { PHASE_IDS(); gdn_prep_phase(P, lds, blk, G, wave, lane); } REPSYNC(4); }
    {
        unsigned* prep = (unsigned*)(Pin.ws + WS_CTL) + CW_PREP;
        asm volatile("s_waitcnt vmcnt(0)" ::: "memory");
        __syncthreads();
        if (threadIdx.x == 0) { __builtin_amdgcn_fence(__ATOMIC_RELEASE, "agent"); asm volatile("s_waitcnt vmcnt(0)" ::: "memory");
            __hip_atomic_fetch_add(prep, 1u, __ATOMIC_RELAXED, __HIP_MEMORY_SCOPE_AGENT); }
        if (blk < 16) {
            if (threadIdx.x == 0) { unsigned sp = 0;
                while (__hip_atomic_load(prep, __ATOMIC_RELAXED, __HIP_MEMORY_SCOPE_AGENT) < (unsigned)G) { __builtin_amdgcn_s_sleep(2); if (++sp > (1u << 22)) break; }
                __builtin_amdgcn_fence(__ATOMIC_ACQUIRE, "agent"); asm volatile("s_waitcnt vmcnt(0)" ::: "memory"); }
            __syncthreads();
        }
    }
    REP(8) { if ((PHMASK & 8) && blk < 16) { PHASE_IDS(); gdn_scan(P, lds, blk, tid, wave, lane); } }
    REP(16) {
    if (PHMASK & 16) { PHASE_IDS(); if (rep_ == 0) attn_phase<0>(P, lds, tid, wave, lane); else attn_phase<ATT_VAR>(P, lds, tid, wave, lane); }
    if ((REPMASK & 16) && rep_ == 0) { GRID_BAR(); if (blk == 0 && threadIdx.x < 8) { PHASE_IDS(); __hip_atomic_store((unsigned*)(P.ws + WS_CTL) + CW_ATTQ + 64 * threadIdx.x, 0u, __ATOMIC_RELAXED, __HIP_MEMORY_SCOPE_AGENT); } GRID_BAR(); }
    }
    GRID_BAR();
    REP(32) { if (PHMASK & 32) { PHASE_IDS();
        pg8::Gemm g{(const bf16_t*)(P.ws + WS_MIX), (const bf16_t*)(P.ws + WS_WOUT), MTOK, 1024, 1024};
        pg8::StaticOrder S; S.init(MTOK, 1024, G, blk);
        EpiOutProj E{P.in[0], P.out, (bf16_t*)(P.ws + WS_U2)};
        pg8::gemm_phase<EpiOutProj, pg8::StaticOrder, true, true>(lds, g, S, E);
    } REPSYNC(32); }
    GRID_BAR();
#ifdef P4A_SPLIT
    if (PHMASK & 64) { PHASE_IDS(); phase4a<1>(P, lds, gw, NGW, wave, lane); }
    GRID_BAR();
    if (PHMASK & 64) { PHASE_IDS(); phase4a<2>(P, lds, gw, NGW, wave, lane); }
#else
    if (PHMASK & 64) { PHASE_IDS(); phase4a<3>(P, lds, gw, NGW, wave, lane); }
#endif
    GRID_BAR();
    int cnt, base, tend, total; { PHASE_IDS(); expert_layout(P, lane, cnt, base, tend); total = __builtin_amdgcn_readlane(tend, 31); }
    REP(256) { if (PHMASK & 256) { PHASE_IDS();
        pg8::Gemm g{(const bf16_t*)(P.ws + WS_U2), (const bf16_t*)(P.ws + WS_WGU), XS_ROWS, 32 * 512, 1024};
        GroupedOrder S{tend, total, G, blk, 1, cnt, base, (const int*)(P.ws + WS_LIST)};
        EpiGateUp E{(const float*)(P.ws + WS_LISTW), (const float*)(P.ws + WS_LISTRS), (bf16_t*)(P.ws + WS_YS), cnt, base};
        pg8::gemm_phase_g<EpiGateUp, GroupedOrder, true, true>(lds, g, S, E);
    } REPSYNC(256); }
    GRID_BAR();
    REP(512) { if (PHMASK & 512) { PHASE_IDS();
        int kd = 256; asm volatile("" : "+s"(kd));
        pg8::Gemm g{(const bf16_t*)(P.ws + WS_YS), (const bf16_t*)(P.ws + WS_WD), XS_ROWS, 32 * 1024, kd};
        GroupedOrder S{tend, total, G, blk, 2, cnt, base, (const int*)(P.ws + WS_LIST)};
        EpiDown E{(bf16_t*)(P.ws + WS_YO)};
        pg8::gemm_phase<EpiDown, GroupedOrder, true, true>(lds, g, S, E);
    } REPSYNC(512); }
    GRID_BAR();
    if (PHMASK & 1024) { PHASE_IDS(); phase7(P, gw, NGW, lane); }
    if (TPROBE >= 0) {
        GRID_BAR();
        const unsigned long long* st = (const unsigned long long*)(Pin.ws + WS_CTL + 65536);
        const unsigned long long t0 = __hip_atomic_load(st + TPROBE_A, __ATOMIC_RELAXED, __HIP_MEMORY_SCOPE_AGENT), t1 = __hip_atomic_load(st + TPROBE_B, __ATOMIC_RELAXED, __HIP_MEMORY_SCOPE_AGENT);
        const unsigned long long dt = (t1 - t0) * 4ull, s0 = __builtin_amdgcn_s_memrealtime();
        while (__builtin_amdgcn_s_memrealtime() - s0 < dt) __builtin_amdgcn_s_sleep(8);
    }
}

extern "C" void kernel_launch(void* const* d_in, const int* in_sizes, int n_in, void* d_out, int out_size, void* d_ws, size_t ws_size, hipStream_t stream) {
    static int grid_blocks = 0;
    if (grid_blocks == 0) {
        if (n_in != 23 || out_size != MTOK * DMODEL || ws_size < WS_END) { fprintf(stderr, "kernel_launch: unexpected shapes (n_in %d out %d ws %zu)\n", n_in, out_size, ws_size); grid_blocks = -1; return; }
        int dev = 0, cus = 0, per_cu = 0;
        hipGetDevice(&dev);
        hipDeviceGetAttribute(&cus, hipDeviceAttributeMultiprocessorCount, dev);
        hipFuncSetAttribute((const void*)hymba_fwd, hipFuncAttributeMaxDynamicSharedMemorySize, LDS_BYTES);
        hipOccupancyMaxActiveBlocksPerMultiprocessor(&per_cu, (const void*)hymba_fwd, NTHREADS, LDS_BYTES);
        if (per_cu < 1) { fprintf(stderr, "kernel_launch: occupancy query says %d blocks/CU\n", per_cu); per_cu = 1; }
        grid_blocks = cus;
        (void)hipGetLastError();
    }
    if (grid_blocks < 0) return;
    hipMemsetAsync((char*)d_ws + WS_CTL, 0, CTL_BYTES, stream);
    Params p{};
    for (int i = 0; i < 23; ++i) p.in[i] = (const float*)d_in[i];
    p.out = (float*)d_out; p.ws = (unsigned char*)d_ws;
    void* args[] = {&p};
    hipError_t e = hipLaunchCooperativeKernel((const void*)hymba_fwd, dim3(grid_blocks), dim3(NTHREADS), args, LDS_BYTES, stream);
    if (e != hipSuccess) fprintf(stderr, "cooperative launch failed: %s (grid %d)\n", hipGetErrorString(e), grid_blocks);
}
```

```cpp
#include <hip/hip_runtime.h>
#include <hip/hip_cooperative_groups.h>
#include <cstdio>
#include <cstdint>
namespace cg = cooperative_groups;
#ifndef PG8_EPI_AGAIN
#define PG8_EPI_AGAIN(x) do {} while (0)
#endif
namespace pg8 {
#define PG8_LAS __attribute__((address_space(3)))
typedef unsigned short bf16_t;
typedef short bf16x8 __attribute__((ext_vector_type(8)));
typedef float f32x4 __attribute__((ext_vector_type(4)));
typedef unsigned u32x4 __attribute__((ext_vector_type(4)));
constexpr int BM = 256, BK = 64, HALF = 128, HTB = HALF * BK * 2  , STAGE_BYTES = 8 * HTB, NXCD = 8, WGM = 8;

__host__ __device__ __forceinline__ int lds_byte(int r, int c) { const int st = (r >> 4) * 2 + (c >> 5), rr = r & 15, cc = c & 31, ob = rr * 64 + cc * 2; return st * 1024 + (ob ^ (((ob >> 9) & 1) << 5)); }
__host__ __device__ __forceinline__ void stage_rc(int b, int& R, int& C) { const int st = b / 1024, sb = b % 1024, swz = sb ^ (((sb >> 9) & 1) << 5); R = (st >> 1) * 16 + swz / 64; C = (st & 1) * 32 + (swz % 64) / 2; }
__host__ __device__ __forceinline__ int perm32(int rho) { const int n = rho >> 4, i = rho & 15; return 8 * (i >> 2) + 4 * n + (i & 3); }

struct Unit { int pm, pn; };
struct Gemm { const bf16_t* A; const bf16_t* Bt; int M, N, K; };

struct StaticOrder {
    int nM, nN, nwg, G, c;
    __host__ __device__ void init(int M, int N, int G_, int c_) { nM = M / BM; nN = N / BM; nwg = nM * nN; G = G_; c = c_; }
    __host__ __device__ bool next(int i, Unit& u) const {
        const long L = (long)i * G + c; if (L >= nwg) return false;
        int wgid = (int)L; { const int q = nwg / NXCD, r = nwg % NXCD, xcd = wgid % NXCD, off = wgid / NXCD; wgid = (xcd < r ? xcd * (q + 1) : r * (q + 1) + (xcd - r) * q) + off; }
        const int nig = WGM * nN, gid = wgid / nig, fm = gid * WGM, gsz = (nM - fm) < WGM ? (nM - fm) : WGM;
        u.pm = fm + ((wgid % nig) % gsz); u.pn = (wgid % nig) / gsz; return true;
    }
    __device__ __forceinline__ void a_ready(const Unit&) const {}
    __device__ __forceinline__ void done(const Unit&) const {}
};

__device__ __forceinline__ unsigned cvt_pk_bf16(float lo, float hi) { unsigned r; asm volatile("v_cvt_pk_bf16_f32 %0, %1, %2" : "=v"(r) : "v"(lo), "v"(hi)); return r; }
typedef float f32x2 __attribute__((ext_vector_type(2)));
template <class Epi, class Sched, bool ALIGN_EPI = false, bool SP2 = false>
__device__ __forceinline__ void gemm_phase(PG8_LAS unsigned char* lds, const Gemm g, const Sched& S, const Epi& E) {
    int tid_o = threadIdx.x; asm volatile("" : "+v"(tid_o));
    const int tid = tid_o, wid = __builtin_amdgcn_readfirstlane(tid >> 6), lane = tid & 63, wr = wid >> 2, wc = wid & 3, fr = lane & 15, fq = lane >> 4;
    const int K = g.K, nt = K / BK;
    unsigned voffA[2], voffB[2];
#pragma unroll
    for (int i = 0; i < 2; ++i) { int R, C; stage_rc(tid * 16 + i * 8192, R, C); const int Rb = Epi::PERM ? ((R & ~31) + perm32(R & 31)) : R;
        voffA[i] = (unsigned)(R * K + C) * 2u; voffB[i] = (unsigned)(Rb * K + C) * 2u; }
    const size_t kstep = (size_t)(BK * 2);
    const size_t hstep = (size_t)HALF * K * 2;
    const size_t tstep = 2 * hstep;
    const unsigned ldsw = (unsigned)wid * 1024u;
    const int aoff = lds_byte(wr * 64 + fr, fq * 8), boff = lds_byte(wc * 32 + fr, fq * 8);
#define PG8_SA(b, h) (((b) * 2 + (h)) * HTB)
#define PG8_SB(b, h) ((4 + (b) * 2 + (h)) * HTB)
#define PG8_STAGE(bufoff, gbase, voff) do { _Pragma("unroll") for (int _i = 0; _i < 2; ++_i) \
        __builtin_amdgcn_global_load_lds((const unsigned*)((const char*)(gbase) + (voff)[_i]), (PG8_LAS unsigned*)(lds + (bufoff) + ldsw + _i * 8192), 16, 0, 0); } while (0)
#define PG8_LDA(dst, b, h) do { _Pragma("unroll") for (int m = 0; m < 4; ++m) _Pragma("unroll") for (int k = 0; k < 2; ++k) dst[m][k] = *(const PG8_LAS bf16x8*)(lds + PG8_SA(b, h) + aoff + m * 2048 + k * 1024); } while (0)
#define PG8_LDB(dst, b, h) do { _Pragma("unroll") for (int n = 0; n < 2; ++n) _Pragma("unroll") for (int k = 0; k < 2; ++k) dst[n][k] = *(const PG8_LAS bf16x8*)(lds + PG8_SB(b, h) + boff + n * 2048 + k * 1024); } while (0)
#define PG8_MMA(ai, bj, At, Bt) do { __builtin_amdgcn_s_setprio(1); _Pragma("unroll") for (int m = 0; m < 4; ++m) _Pragma("unroll") for (int n = 0; n < 2; ++n) _Pragma("unroll") for (int k = 0; k < 2; ++k) \
        acc[ai][bj][m][n] = __builtin_amdgcn_mfma_f32_16x16x32_bf16(Bt[n][k], At[m][k], acc[ai][bj][m][n], 0, 0, 0); __builtin_amdgcn_s_setprio(0); } while (0)
#define PG8_WAIT_V(n) asm volatile("s_waitcnt vmcnt(" #n ")" ::: "memory")
#define PG8_WAIT_L(n) asm volatile("s_waitcnt lgkmcnt(" #n ")" ::: "memory")
#define PG8_BAR __builtin_amdgcn_s_barrier()
#define PG8_SCHED __builtin_amdgcn_sched_barrier(0)
    Unit cur, nxt; int ui = 0;
    if (!S.next(0, cur)) return;
    f32x4 acc[2][2][4][2];
#pragma unroll
    for (int a = 0; a < 2; ++a)
#pragma unroll
        for (int b = 0; b < 2; ++b)
#pragma unroll
            for (int m = 0; m < 4; ++m)
#pragma unroll
                for (int n = 0; n < 2; ++n) acc[a][b][m][n] = (f32x4){0.f, 0.f, 0.f, 0.f};
    bf16x8 At[4][2], B0[2][2], B1[2][2];
    const char* cA = (const char*)g.A + (size_t)cur.pm * tstep; const char* cB = (const char*)g.Bt + (size_t)cur.pn * tstep;
    S.a_ready(cur);
    if constexpr (SP2) {
        PG8_STAGE(PG8_SB(0, 0), cB, voffB); PG8_STAGE(PG8_SB(0, 1), cB + hstep, voffB); PG8_STAGE(PG8_SA(0, 0), cA, voffA); PG8_STAGE(PG8_SA(0, 1), cA + hstep, voffA);
        if (wr == 1) PG8_BAR;
        PG8_WAIT_V(2); PG8_BAR;
        PG8_STAGE(PG8_SB(1, 0), cB + kstep, voffB); PG8_STAGE(PG8_SA(1, 0), cA + kstep, voffA); PG8_STAGE(PG8_SB(1, 1), cB + hstep + kstep, voffB);
        PG8_WAIT_V(6); PG8_BAR;
    } else {
        PG8_STAGE(PG8_SB(0, 0), cB, voffB); PG8_STAGE(PG8_SA(0, 0), cA, voffA); PG8_STAGE(PG8_SB(0, 1), cB + hstep, voffB); PG8_STAGE(PG8_SA(0, 1), cA + hstep, voffA);
        if (wr == 1) PG8_BAR;
        PG8_WAIT_V(4); PG8_BAR;
        PG8_STAGE(PG8_SB(1, 0), cB + kstep, voffB); PG8_STAGE(PG8_SA(1, 0), cA + kstep, voffA); PG8_STAGE(PG8_SB(1, 1), cB + hstep + kstep, voffB);
        PG8_WAIT_V(6); PG8_BAR;
    }
    for (;;) {
        const bool has_next = S.next(ui + 1, nxt);
        const char* nA = has_next ? (const char*)g.A + (size_t)nxt.pm * tstep : cA; const char* nB = has_next ? (const char*)g.Bt + (size_t)nxt.pn * tstep : cB;
        for (int t = 0; t < nt; t += 2) {
            const bool last = (t == nt - 2);
            const char* a1 = cA + (size_t)(t + 1) * kstep;
            const char* a2 = last ? nA : cA + (size_t)(t + 2) * kstep; const char* b2 = last ? nB : cB + (size_t)(t + 2) * kstep;
            const char* a3 = a2 + kstep; const char* b3 = b2 + kstep;
            if (last && has_next) S.a_ready(nxt);
            if constexpr (SP2) {
            PG8_LDB(B0, 0, 0); PG8_LDB(B1, 0, 1); PG8_SCHED; PG8_LDA(At, 0, 0); PG8_STAGE(PG8_SA(1, 1), a1 + hstep, voffA);
            PG8_WAIT_V(8); PG8_WAIT_L(0); PG8_BAR; PG8_MMA(0, 0, At, B0); PG8_MMA(0, 1, At, B1); PG8_BAR; PG8_SCHED;
            PG8_LDA(At, 0, 1); PG8_STAGE(PG8_SB(0, 0), b2, voffB); PG8_STAGE(PG8_SB(0, 1), b2 + hstep, voffB); PG8_STAGE(PG8_SA(0, 0), a2, voffA);
            PG8_WAIT_V(8); PG8_WAIT_L(0); PG8_BAR; PG8_MMA(1, 0, At, B0); PG8_MMA(1, 1, At, B1); PG8_BAR; PG8_SCHED;
            PG8_LDB(B0, 1, 0); PG8_LDB(B1, 1, 1); PG8_SCHED; PG8_LDA(At, 1, 0); PG8_STAGE(PG8_SA(0, 1), a2 + hstep, voffA);
            PG8_WAIT_V(8); PG8_WAIT_L(0); PG8_BAR; PG8_MMA(0, 0, At, B0); PG8_MMA(0, 1, At, B1); PG8_BAR; PG8_SCHED;
            PG8_LDA(At, 1, 1); PG8_STAGE(PG8_SB(1, 0), b3, voffB); PG8_STAGE(PG8_SB(1, 1), b3 + hstep, voffB); PG8_STAGE(PG8_SA(1, 0), a3, voffA);
            PG8_WAIT_V(8); PG8_WAIT_L(0); PG8_BAR; PG8_MMA(1, 0, At, B0); PG8_MMA(1, 1, At, B1); PG8_BAR; PG8_SCHED;
            } else {
            PG8_LDB(B0, 0, 0); PG8_SCHED; PG8_LDA(At, 0, 0); PG8_STAGE(PG8_SA(1, 1), a1 + hstep, voffA);
            PG8_WAIT_L(8); PG8_BAR; PG8_WAIT_L(0); PG8_MMA(0, 0, At, B0); PG8_BAR; PG8_SCHED;
            PG8_LDB(B1, 0, 1); PG8_STAGE(PG8_SB(0, 0), b2, voffB);
            PG8_BAR; PG8_WAIT_L(0); PG8_MMA(0, 1, At, B1); PG8_BAR;
            PG8_LDA(At, 0, 1); PG8_STAGE(PG8_SA(0, 0), a2, voffA);
            PG8_BAR; PG8_WAIT_L(0); PG8_MMA(1, 0, At, B0); PG8_BAR; PG8_SCHED;
            PG8_STAGE(PG8_SB(0, 1), b2 + hstep, voffB);
            PG8_WAIT_V(6); PG8_BAR; PG8_MMA(1, 1, At, B1); PG8_BAR;
            PG8_LDB(B0, 1, 0); PG8_SCHED; PG8_LDA(At, 1, 0); PG8_STAGE(PG8_SA(0, 1), a2 + hstep, voffA);
            PG8_WAIT_L(8); PG8_BAR; PG8_WAIT_L(0); PG8_MMA(0, 0, At, B0); PG8_BAR; PG8_SCHED;
            PG8_LDB(B1, 1, 1); PG8_STAGE(PG8_SB(1, 0), b3, voffB);
            PG8_BAR; PG8_WAIT_L(0); PG8_MMA(0, 1, At, B1); PG8_BAR;
            PG8_LDA(At, 1, 1); PG8_STAGE(PG8_SA(1, 0), a3, voffA);
            PG8_BAR; PG8_WAIT_L(0); PG8_MMA(1, 0, At, B0); PG8_BAR; PG8_SCHED;
            PG8_STAGE(PG8_SB(1, 1), b3 + hstep, voffB);
            PG8_WAIT_V(6); PG8_BAR; PG8_MMA(1, 1, At, B1); PG8_BAR;
            }
        }
        if constexpr (ALIGN_EPI) { if (wr == 0) PG8_BAR; }
        if constexpr (!Epi::AFTER_DRAIN) { E(acc, cur, wr, wc, fr, fq); PG8_EPI_AGAIN(E(acc, cur, wr, wc, fr, fq)); S.done(cur); }
        if (!has_next) break;
#pragma unroll
        for (int a = 0; a < 2; ++a)
#pragma unroll
            for (int b = 0; b < 2; ++b)
#pragma unroll
                for (int m = 0; m < 4; ++m)
#pragma unroll
                    for (int n = 0; n < 2; ++n) acc[a][b][m][n] = (f32x4){0.f, 0.f, 0.f, 0.f};
        cur = nxt; cA = nA; cB = nB; ++ui;
        if constexpr (ALIGN_EPI) { if (wr == 1) PG8_BAR; }
    }
    PG8_WAIT_V(0);
    if constexpr (!ALIGN_EPI) { if (wr == 0) PG8_BAR; }
    PG8_BAR;
    if constexpr (Epi::AFTER_DRAIN) { E.fused(acc, cur, wr, wc, fr, fq, lds, wid, lane); S.done(cur); }
#undef PG8_SA
#undef PG8_SB
#undef PG8_STAGE
#undef PG8_LDA
#undef PG8_LDB
#undef PG8_MMA
#undef PG8_WAIT_V
#undef PG8_WAIT_L
#undef PG8_BAR
#undef PG8_SCHED
}
static_assert(true, "gather variant of gemm_phase (SP2 = true only): identical schedule, the A operand's rows are gathered through Sched::rowoff");
template <class Epi, class Sched, bool ALIGN_EPI = false, bool SP2 = false>
__device__ __forceinline__ void gemm_phase_g(PG8_LAS unsigned char* lds, const Gemm g, const Sched& S, const Epi& E) {
    int tid_o = threadIdx.x; asm volatile("" : "+v"(tid_o));
    const int tid = tid_o, wid = __builtin_amdgcn_readfirstlane(tid >> 6), lane = tid & 63, wr = wid >> 2, wc = wid & 3, fr = lane & 15, fq = lane >> 4;
    const int K = g.K, nt = K / BK;
    unsigned voffA[2], voffB[2]; int RA_[2]; unsigned CA_[2];
#pragma unroll
    for (int i = 0; i < 2; ++i) { int R, C; stage_rc(tid * 16 + i * 8192, R, C); const int Rb = Epi::PERM ? ((R & ~31) + perm32(R & 31)) : R;
        voffA[i] = (unsigned)(R * K + C) * 2u; voffB[i] = (unsigned)(Rb * K + C) * 2u; RA_[i] = R; CA_[i] = (unsigned)C * 2u; }
    const size_t kstep = (size_t)(BK * 2);
    const size_t hstep = (size_t)HALF * K * 2;
    const size_t tstep = 2 * hstep;
    const unsigned ldsw = (unsigned)wid * 1024u;
    const int aoff = lds_byte(wr * 64 + fr, fq * 8), boff = lds_byte(wc * 32 + fr, fq * 8);
#define PG8_SA(b, h) (((b) * 2 + (h)) * HTB)
#define PG8_SB(b, h) ((4 + (b) * 2 + (h)) * HTB)
#define PG8_STAGE(bufoff, gbase, voff) do { _Pragma("unroll") for (int _i = 0; _i < 2; ++_i) \
        __builtin_amdgcn_global_load_lds((const unsigned*)((const char*)(gbase) + (voff)[_i]), (PG8_LAS unsigned*)(lds + (bufoff) + ldsw + _i * 8192), 16, 0, 0); } while (0)
#define PG8_LDA(dst, b, h) do { _Pragma("unroll") for (int m = 0; m < 4; ++m) _Pragma("unroll") for (int k = 0; k < 2; ++k) dst[m][k] = *(const PG8_LAS bf16x8*)(lds + PG8_SA(b, h) + aoff + m * 2048 + k * 1024); } while (0)
#define PG8_LDB(dst, b, h) do { _Pragma("unroll") for (int n = 0; n < 2; ++n) _Pragma("unroll") for (int k = 0; k < 2; ++k) dst[n][k] = *(const PG8_LAS bf16x8*)(lds + PG8_SB(b, h) + boff + n * 2048 + k * 1024); } while (0)
#define PG8_MMA(ai, bj, At, Bt) do { __builtin_amdgcn_s_setprio(1); _Pragma("unroll") for (int m = 0; m < 4; ++m) _Pragma("unroll") for (int n = 0; n < 2; ++n) _Pragma("unroll") for (int k = 0; k < 2; ++k) \
        acc[ai][bj][m][n] = __builtin_amdgcn_mfma_f32_16x16x32_bf16(Bt[n][k], At[m][k], acc[ai][bj][m][n], 0, 0, 0); __builtin_amdgcn_s_setprio(0); } while (0)
#define PG8_WAIT_V(n) asm volatile("s_waitcnt vmcnt(" #n ")" ::: "memory")
#define PG8_WAIT_L(n) asm volatile("s_waitcnt lgkmcnt(" #n ")" ::: "memory")
#define PG8_BAR __builtin_amdgcn_s_barrier()
#define PG8_SCHED __builtin_amdgcn_sched_barrier(0)
    Unit cur, nxt; int ui = 0;
    if (!S.next(0, cur)) return;
    f32x4 acc[2][2][4][2];
#pragma unroll
    for (int a = 0; a < 2; ++a)
#pragma unroll
        for (int b = 0; b < 2; ++b)
#pragma unroll
            for (int m = 0; m < 4; ++m)
#pragma unroll
                for (int n = 0; n < 2; ++n) acc[a][b][m][n] = (f32x4){0.f, 0.f, 0.f, 0.f};
    bf16x8 At[4][2], B0[2][2], B1[2][2];
    const char* cA = (const char*)g.A; const char* cB = (const char*)g.Bt + (size_t)cur.pn * tstep;
    unsigned cA0[2], cA1[2], nA0[2], nA1[2];
#pragma unroll
    for (int i = 0; i < 2; ++i) { cA0[i] = S.rowoff(cur, RA_[i]) + CA_[i]; cA1[i] = S.rowoff(cur, 128 + RA_[i]) + CA_[i]; }
    S.a_ready(cur);
    if constexpr (SP2) {
        PG8_STAGE(PG8_SB(0, 0), cB, voffB); PG8_STAGE(PG8_SB(0, 1), cB + hstep, voffB); PG8_STAGE(PG8_SA(0, 0), cA, cA0); PG8_STAGE(PG8_SA(0, 1), cA, cA1);
        if (wr == 1) PG8_BAR;
        PG8_WAIT_V(2); PG8_BAR;
        PG8_STAGE(PG8_SB(1, 0), cB + kstep, voffB); PG8_STAGE(PG8_SA(1, 0), cA + kstep, cA0); PG8_STAGE(PG8_SB(1, 1), cB + hstep + kstep, voffB);
        PG8_WAIT_V(6); PG8_BAR;
    } else {
        PG8_STAGE(PG8_SB(0, 0), cB, voffB); PG8_STAGE(PG8_SA(0, 0), cA, voffA); PG8_STAGE(PG8_SB(0, 1), cB + hstep, voffB); PG8_STAGE(PG8_SA(0, 1), cA + hstep, voffA);
        if (wr == 1) PG8_BAR;
        PG8_WAIT_V(4); PG8_BAR;
        PG8_STAGE(PG8_SB(1, 0), cB + kstep, voffB); PG8_STAGE(PG8_SA(1, 0), cA + kstep, voffA); PG8_STAGE(PG8_SB(1, 1), cB + hstep + kstep, voffB);
        PG8_WAIT_V(6); PG8_BAR;
    }
    for (;;) {
        const bool has_next = S.next(ui + 1, nxt);
        const char* nA = cA; const char* nB = has_next ? (const char*)g.Bt + (size_t)nxt.pn * tstep : cB;
#pragma unroll
        for (int i = 0; i < 2; ++i) { nA0[i] = has_next ? S.rowoff(nxt, RA_[i]) + CA_[i] : cA0[i]; nA1[i] = has_next ? S.rowoff(nxt, 128 + RA_[i]) + CA_[i] : cA1[i]; }
        for (int t = 0; t < nt; t += 2) {
            const bool last = (t == nt - 2);
            const char* a1 = cA + (size_t)(t + 1) * kstep;
            const char* a2 = last ? nA : cA + (size_t)(t + 2) * kstep; const char* b2 = last ? nB : cB + (size_t)(t + 2) * kstep;
            const char* a3 = a2 + kstep; const char* b3 = b2 + kstep;
            unsigned sA0[2], sA1[2];
#pragma unroll
            for (int i = 0; i < 2; ++i) { sA0[i] = last ? nA0[i] : cA0[i]; sA1[i] = last ? nA1[i] : cA1[i]; }
            if (last && has_next) S.a_ready(nxt);
            if constexpr (SP2) {
            PG8_LDB(B0, 0, 0); PG8_LDB(B1, 0, 1); PG8_SCHED; PG8_LDA(At, 0, 0); PG8_STAGE(PG8_SA(1, 1), a1, cA1);
            PG8_WAIT_V(8); PG8_WAIT_L(0); PG8_BAR; PG8_MMA(0, 0, At, B0); PG8_MMA(0, 1, At, B1); PG8_BAR; PG8_SCHED;
            PG8_LDA(At, 0, 1); PG8_STAGE(PG8_SB(0, 0), b2, voffB); PG8_STAGE(PG8_SB(0, 1), b2 + hstep, voffB); PG8_STAGE(PG8_SA(0, 0), a2, sA0);
            PG8_WAIT_V(8); PG8_WAIT_L(0); PG8_BAR; PG8_MMA(1, 0, At, B0); PG8_MMA(1, 1, At, B1); PG8_BAR; PG8_SCHED;
            PG8_LDB(B0, 1, 0); PG8_LDB(B1, 1, 1); PG8_SCHED; PG8_LDA(At, 1, 0); PG8_STAGE(PG8_SA(0, 1), a2, sA1);
            PG8_WAIT_V(8); PG8_WAIT_L(0); PG8_BAR; PG8_MMA(0, 0, At, B0); PG8_MMA(0, 1, At, B1); PG8_BAR; PG8_SCHED;
            PG8_LDA(At, 1, 1); PG8_STAGE(PG8_SB(1, 0), b3, voffB); PG8_STAGE(PG8_SB(1, 1), b3 + hstep, voffB); PG8_STAGE(PG8_SA(1, 0), a3, sA0);
            PG8_WAIT_V(8); PG8_WAIT_L(0); PG8_BAR; PG8_MMA(1, 0, At, B0); PG8_MMA(1, 1, At, B1); PG8_BAR; PG8_SCHED;
            } else {
            PG8_LDB(B0, 0, 0); PG8_SCHED; PG8_LDA(At, 0, 0); PG8_STAGE(PG8_SA(1, 1), a1 + hstep, voffA);
            PG8_WAIT_L(8); PG8_BAR; PG8_WAIT_L(0); PG8_MMA(0, 0, At, B0); PG8_BAR; PG8_SCHED;
            PG8_LDB(B1, 0, 1); PG8_STAGE(PG8_SB(0, 0), b2, voffB);
            PG8_BAR; PG8_WAIT_L(0); PG8_MMA(0, 1, At, B1); PG8_BAR;
            PG8_LDA(At, 0, 1); PG8_STAGE(PG8_SA(0, 0), a2, voffA);
            PG8_BAR; PG8_WAIT_L(0); PG8_MMA(1, 0, At, B0); PG8_BAR; PG8_SCHED;
            PG8_STAGE(PG8_SB(0, 1), b2 + hstep, voffB);
            PG8_WAIT_V(6); PG8_BAR; PG8_MMA(1, 1, At, B1); PG8_BAR;
            PG8_LDB(B0, 1, 0); PG8_SCHED; PG8_LDA(At, 1, 0); PG8_STAGE(PG8_SA(0, 1), a2 + hstep, voffA);
            PG8_WAIT_L(8); PG8_BAR; PG8_WAIT_L(0); PG8_MMA(0, 0, At, B0); PG8_BAR; PG8_SCHED;
            PG8_LDB(B1, 1, 1); PG8_STAGE(PG8_SB(1, 0), b3, voffB);
            PG8_BAR; PG8_WAIT_L(0); PG8_MMA(0, 1, At, B1); PG8_BAR;
            PG8_LDA(At, 1, 1); PG8_STAGE(PG8_SA(1, 0), a3, voffA);
            PG8_BAR; PG8_WAIT_L(0); PG8_MMA(1, 0, At, B0); PG8_BAR; PG8_SCHED;
            PG8_STAGE(PG8_SB(1, 1), b3 + hstep, voffB);
            PG8_WAIT_V(6); PG8_BAR; PG8_MMA(1, 1, At, B1); PG8_BAR;
            }
        }
        if constexpr (ALIGN_EPI) { if (wr == 0) PG8_BAR; }
        if constexpr (!Epi::AFTER_DRAIN) { E(acc, cur, wr, wc, fr, fq); PG8_EPI_AGAIN(E(acc, cur, wr, wc, fr, fq)); S.done(cur); }
        if (!has_next) break;
#pragma unroll
        for (int a = 0; a < 2; ++a)
#pragma unroll
            for (int b = 0; b < 2; ++b)
#pragma unroll
                for (int m = 0; m < 4; ++m)
#pragma unroll
                    for (int n = 0; n < 2; ++n) acc[a][b][m][n] = (f32x4){0.f, 0.f, 0.f, 0.f};
        cur = nxt; cA = nA; cB = nB; ++ui;
#pragma unroll
        for (int i = 0; i < 2; ++i) { cA0[i] = nA0[i]; cA1[i] = nA1[i]; }
        if constexpr (ALIGN_EPI) { if (wr == 1) PG8_BAR; }
    }
    PG8_WAIT_V(0);
    if constexpr (!ALIGN_EPI) { if (wr == 0) PG8_BAR; }
    PG8_BAR;
    if constexpr (Epi::AFTER_DRAIN) { E.fused(acc, cur, wr, wc, fr, fq, lds, wid, lane); S.done(cur); }
#undef PG8_SA
#undef PG8_SB
#undef PG8_STAGE
#undef PG8_LDA
#undef PG8_LDB
#undef PG8_MMA
#undef PG8_WAIT_V
#undef PG8_WAIT_L
#undef PG8_BAR
#undef PG8_SCHED
}
}

#define DI __device__ __forceinline__
#define LAS __attribute__((address_space(3)))
typedef unsigned short bf16_t;
typedef short bf16x8 __attribute__((ext_vector_type(8)));
typedef short s16x4 __attribute__((ext_vector_type(4)));
typedef short v4i16_t __attribute__((ext_vector_type(4)));
typedef float f32x4 __attribute__((ext_vector_type(4)));
typedef float f32x16 __attribute__((ext_vector_type(16)));
typedef unsigned u32x4 __attribute__((ext_vector_type(4)));
typedef unsigned u32x2 __attribute__((ext_vector_type(2)));
typedef float f32x2_t __attribute__((ext_vector_type(2)));
typedef __bf16 bf16x2_t __attribute__((ext_vector_type(2)));

constexpr int NWAVES = 8, NTHREADS = 512;
constexpr int SEQ = 8192, DMODEL = 1024, NMETA = 16, LTOK = SEQ + NMETA  , LP = 8256  , NCHUNK = 129;
constexpr int MTOK = 2 * SEQ;
constexpr int MROWS = 16640;
constexpr int NPROJ = 3840;
constexpr int NKT = 129;
constexpr float EPS = 1e-6f;
constexpr float C2Q = 0.125f * 1.4426950408889634f;
constexpr int XS_ROWS = 41216;

constexpr size_t MiB = 1u << 20;
constexpr size_t WS_CTL = 0, CTL_BYTES = 1 * MiB;
constexpr size_t WS_RS1 = 1 * MiB;
constexpr size_t WS_RS2 = WS_RS1 + 128 * 1024;
constexpr size_t WS_TOKE = WS_RS2 + 128 * 1024;
constexpr size_t WS_TOKW = WS_TOKE + 128 * 1024;
constexpr size_t WS_TOKP = WS_TOKW + 128 * 1024;
constexpr size_t WS_SLOTW = WS_TOKP + 128 * 1024;
constexpr size_t WS_WR = WS_SLOTW + 192 * 1024;
constexpr size_t WS_GL = WS_WR + 160 * 1024;
constexpr size_t WS_DUMP = 2 * MiB;
constexpr size_t WS_COS = 2 * MiB;
constexpr size_t WS_SIN = WS_COS + 1280 * 1024;
constexpr size_t WS_GB = WS_SIN + 1280 * 1024;
constexpr size_t WS_WOUT = 6 * MiB;
constexpr size_t WS_WINT = 8 * MiB;
constexpr size_t WS_XB = WS_WINT + (size_t)NPROJ * 1024 * 2;
constexpr size_t WS_MIX = 8 * MiB;
constexpr size_t WS_QKVB = 48 * MiB;
constexpr size_t WS_QB = WS_QKVB + (size_t)2 * LP * 1536 * 2 + 128 * 1024;
constexpr size_t WS_KT = WS_QB + 16 * MiB;
constexpr size_t WS_VT = WS_KT + (size_t)16 * NKT * 4096 * 2;
constexpr size_t WS_ZB = WS_VT + (size_t)8 * NKT * 8192 * 2;
constexpr size_t WS_GP = WS_ZB + (size_t)2 * LP * 512 * 2;
constexpr size_t GP_ARR = (size_t)2064 * 4096 * 2;
constexpr size_t WS_GP_END = WS_GP + 5 * GP_ARR;
constexpr size_t WS_WGU = 48 * MiB;
constexpr size_t WS_WD = 80 * MiB;
constexpr size_t WS_U2 = 96 * MiB;
constexpr size_t WS_LIST = 240 * MiB;
constexpr size_t WS_LISTW = 242 * MiB;
constexpr size_t WS_LISTRS = 244 * MiB;
constexpr size_t WS_XS = 96 * MiB;
constexpr size_t WS_YO = 96 * MiB;
constexpr size_t WS_YS = WS_XS + (size_t)XS_ROWS * 1024 * 2;
constexpr size_t WS_END = 256 * MiB;
static_assert(WS_GB + (size_t)2 * LP * 16 * 4 <= WS_WOUT, "small region");
static_assert(WS_XB + (size_t)MROWS * 1024 * 2 <= WS_QKVB, "XB");
static_assert(WS_GP_END <= WS_END, "GDN prep arrays");
static_assert(WS_YS + (size_t)XS_ROWS * 256 * 2 <= WS_END, "YS");
static_assert(WS_WD + (size_t)32 * 1024 * 256 * 2 <= WS_XS, "WD");
constexpr int CW_ATTQ = 2112;
constexpr int CW_PREP = 2688;
constexpr int CW_CNT = 64;
constexpr int CW_TILE = 8192;
constexpr int CW_BAR = 4096;

constexpr int LDS_BYTES = 147456;

struct Params { const float* in[23]; float* out; unsigned char* ws; };

DI unsigned f2bf(float f) { unsigned u = __float_as_uint(f); return (u + 0x7fffu + ((u >> 16) & 1u)) >> 16; }
DI unsigned pk2(float lo, float hi) { f32x2_t v = {lo, hi}; bf16x2_t b = __builtin_convertvector(v, bf16x2_t); return __builtin_bit_cast(unsigned, b); }
DI float bf2f(unsigned short h) { return __uint_as_float(((unsigned)h) << 16); }
DI float rlane(float v, int l) { return __int_as_float(__builtin_amdgcn_readlane(__float_as_int(v), l)); }
#define DPP_ADD(v, ctrl) ((v) + __int_as_float(__builtin_amdgcn_update_dpp(0, __float_as_int(v), (ctrl), 0xF, 0xF, true)))
DI u32x2 pack_quad_bf16(float v) {
    const float v1 = __int_as_float(__builtin_amdgcn_update_dpp(0, __float_as_int(v), 0xB1, 0xF, 0xF, true));
    const unsigned p = pk2(v, v1);
    const unsigned q = (unsigned)__builtin_amdgcn_update_dpp(0, (int)p, 0x4E, 0xF, 0xF, true);
    return (u32x2){p, q};
}
typedef __attribute__((address_space(1))) u32x2 g_u32x2;
DI void store_quad_bf16(bf16_t* dst  , float v, int lane) {
    const float v1 = __int_as_float(__builtin_amdgcn_update_dpp(0, __float_as_int(v), 0xB1, 0xF, 0xF, true));
    const unsigned p = pk2(v, v1);
    const unsigned q = (unsigned)__builtin_amdgcn_update_dpp(0, (int)p, 0x4E, 0xF, 0xF, true);
    if ((lane & 3) == 0) *(u32x2*)dst = (u32x2){p, q};
}
DI float wave_sum_dpp(float v) {
    v = DPP_ADD(v, 0xB1);
    v = DPP_ADD(v, 0x4E);
    v = DPP_ADD(v, 0x141);
    v = DPP_ADD(v, 0x140);
    return (rlane(v, 0) + rlane(v, 16)) + (rlane(v, 32) + rlane(v, 48));
}
DI float wave_sum(float v) { return wave_sum_dpp(v); }
DI float swz_xor16(float v) { return __int_as_float(__builtin_amdgcn_ds_swizzle(__float_as_int(v), 0x401F)); }
DI float row_sum16(float v) { v = DPP_ADD(v, 0xB1); v = DPP_ADD(v, 0x4E); v = DPP_ADD(v, 0x141); v = DPP_ADD(v, 0x140); return v; }
DI float half_sum32(float v) { v = row_sum16(v); return v + swz_xor16(v); }
DI float swap32_add(float v) { auto rr = __builtin_amdgcn_permlane32_swap(__float_as_uint(v), __float_as_uint(v), false, false); return __uint_as_float(rr[0]) + __uint_as_float(rr[1]); }
DI float swap32_max(float v) { auto rr = __builtin_amdgcn_permlane32_swap(__float_as_uint(v), __float_as_uint(v), false, false); return fmaxf(__uint_as_float(rr[0]), __uint_as_float(rr[1])); }
#define LDS_WAIT() asm volatile("s_waitcnt lgkmcnt(0)" ::: "memory")
#define BAR_LDS() do { asm volatile("s_waitcnt lgkmcnt(0)" ::: "memory"); __builtin_amdgcn_s_barrier(); asm volatile("" ::: "memory"); } while (0)
#define MFMA32(a, b, c) __builtin_amdgcn_mfma_f32_32x32x16_bf16((a), (b), (c), 0, 0, 0)
DI int crow(int r, int hi) { return (r & 3) + 8 * (r >> 2) + 4 * hi; }
DI int perm16(int x) { return (x & ~12) | ((x & 4) << 1) | ((x & 8) >> 1); }
DI bf16x8 pack8(const f32x16& x, int s) {
    u32x4 p; p.x = pk2(x[8 * s], x[8 * s + 1]); p.y = pk2(x[8 * s + 2], x[8 * s + 3]); p.z = pk2(x[8 * s + 4], x[8 * s + 5]); p.w = pk2(x[8 * s + 6], x[8 * s + 7]);
    return __builtin_bit_cast(bf16x8, p);
}
DI int orig_col(int n) {
    if (n >= 1024) return n;
    const int hh = n >> 6, c2 = n & 63, g8 = c2 >> 3, i = c2 & 7;
    return (hh << 6) + ((i < 4) ? 4 * g8 + i : 32 + 4 * g8 + (i - 4));
}
DI size_t kt_off(int b, int hh, int p, int d) {
    const int tile = p < 16 ? 0 : 1 + ((p - 16) >> 6), kv = p < 16 ? p : ((p - 16) & 63);
    return ((size_t)((b * 8 + hh) * NKT + tile) << 12) + ((d >> 3) << 9) + (kv << 3) + (d & 7);
}
DI size_t vt_off(int b, int h, int p, int d) {
    const int tile = p < 16 ? 0 : 1 + ((p - 16) >> 6), kv = p < 16 ? p : ((p - 16) & 63);
    return ((size_t)((b * 4 + h) * NKT + tile) << 13) + ((d >> 5) << 11) + ((kv >> 4) << 9) + ((kv & 15) << 5) + (d & 31);
}

template <class Src> DI void transpose_item(const Src& src, bf16_t* WT, size_t ldk, int k0, int n0, LAS float* scr, int lane) {
    float v[32];
#pragma unroll
    for (int i = 0; i < 32; ++i) v[i] = src(k0 + 2 * i + (lane >> 5), n0 + (lane & 31));
#pragma unroll
    for (int i = 0; i < 32; ++i) scr[(2 * i + (lane >> 5)) * 33 + (lane & 31)] = v[i];
    LDS_WAIT();
    const int c = lane & 7;
#pragma unroll
    for (int j = 0; j < 4; ++j) { const int n = (lane >> 3) + 8 * j; const LAS float* s = scr + (8 * c) * 33 + n;
        u32x4 o; o.x = pk2(s[0 * 33], s[1 * 33]); o.y = pk2(s[2 * 33], s[3 * 33]); o.z = pk2(s[4 * 33], s[5 * 33]); o.w = pk2(s[6 * 33], s[7 * 33]);
        *(u32x4*)(WT + (size_t)(n0 + n) * ldk + k0 + 8 * c) = o; }
    LDS_WAIT();
}
struct SrcWin { const float* w; const float* g; DI float operator()(int k, int n) const { return n >= 3600 ? 0.f : w[(size_t)k * 3600 + orig_col(n)] * g[k]; } };
struct SrcPlain { const float* w; int N; DI float operator()(int k, int n) const { return w[(size_t)k * N + n]; } };
struct SrcGU { const float* w; const float* g; int fadj; DI float operator()(int k, int n) const { return w[(size_t)k * 256 + n + fadj] * g[k]; } };

#ifndef P0_REP
#define P0_REP 0
#endif
DI void phase0(const Params& P, LAS unsigned char* lds, int gw, int NGW, int gtid, int NGT, int wave, int lane) {
    LAS float* scr = (LAS float*)(lds + wave * 16384);
    bf16_t* WINT = (bf16_t*)(P.ws + WS_WINT); bf16_t* WOUT = (bf16_t*)(P.ws + WS_WOUT); bf16_t* XB = (bf16_t*)(P.ws + WS_XB);
    float* RS1 = (float*)(P.ws + WS_RS1);
    constexpr int I_IN = 16 * (NPROJ / 32), I_OUT = 16 * 32;
    const SrcWin sw{P.in[3], P.in[2]}; const SrcPlain so{P.in[13], 1024};
    for (int rp_ = 0; rp_ < ((P0_REP & 1) ? 2 : 1); ++rp_)
    for (int it = gw; it < I_IN + I_OUT; it += NGW) {
        if (it < I_IN) transpose_item(sw, WINT, 1024, (it / (NPROJ / 32)) * 64, (it % (NPROJ / 32)) * 32, scr, lane);
        else { const int r = it - I_IN; transpose_item(so, WOUT, 1024, (r >> 5) * 64, (r & 31) * 32, scr, lane); }
    }
    const float* x = P.in[0]; const float* meta = P.in[1];
    for (int rp_ = 0; rp_ < ((P0_REP & 2) ? 2 : 1); ++rp_)
    for (int m0 = gw; m0 < MROWS; m0 += 4 * NGW) {
        f32x4 v[4][4];
#pragma unroll
        for (int r = 0; r < 4; ++r) { const int m = m0 + r * NGW;
            const bool real = m < MTOK + NMETA;
            const f32x4* xr = (const f32x4*)((m < MTOK) ? x + (size_t)m * 1024 : meta + (size_t)((real ? m : MTOK) - MTOK) * 1024);
#pragma unroll
            for (int j = 0; j < 4; ++j) v[r][j] = (m < MROWS) ? xr[64 * j + lane] : (f32x4){0.f, 0.f, 0.f, 0.f}; }
#pragma unroll
        for (int r = 0; r < 4; ++r) { const int m = m0 + r * NGW;
            if (m < MROWS) {
                const bool real = m < MTOK + NMETA;
                float s = 0.f;
#pragma unroll
                for (int j = 0; j < 4; ++j) { if (!real) v[r][j] = (f32x4){0.f, 0.f, 0.f, 0.f}; s += (v[r][j].x * v[r][j].x + v[r][j].y * v[r][j].y) + (v[r][j].z * v[r][j].z + v[r][j].w * v[r][j].w); }
                s = wave_sum(s);
                if (lane == 0) RS1[m] = real ? __builtin_amdgcn_rsqf(s * (1.0f / 1024.0f) + EPS) : 0.f;
                u32x2* orow = (u32x2*)(XB + (size_t)m * 1024);
#pragma unroll
                for (int j = 0; j < 4; ++j) orow[64 * j + lane] = (u32x2){pk2(v[r][j].x, v[r][j].y), pk2(v[r][j].z, v[r][j].w)};
            } }
    }
    float* COS = (float*)(P.ws + WS_COS); float* SIN = (float*)(P.ws + WS_SIN);
    for (int rp_ = 0; rp_ < ((P0_REP & 4) ? 2 : 1); ++rp_)
    for (int i = gtid; i < LTOK * 32; i += NGT) {
        const int p = i >> 5, f = i & 31;
        const double rev = (double)p * exp2(-(double)f * (13.287712379549449 / 32.0)) * 0.15915494309189535;
        const float fr = (float)(rev - floor(rev));
        COS[i] = __builtin_amdgcn_cosf(fr); SIN[i] = __builtin_amdgcn_sinf(fr);
    }
    float* WR = (float*)(P.ws + WS_WR); const float* gf = P.in[14]; const float* wgrp = P.in[15]; const float* wrt = P.in[17];
    for (int i = gtid; i < 36 * 1024; i += NGT) { const int j = i >> 10, k = i & 1023; WR[i] = gf[k] * (j < 4 ? wgrp[k * 4 + j] : wrt[k * 32 + (j - 4)]); }
}

struct EpiInProj {
    static constexpr bool PERM = true, AFTER_DRAIN = false;
    const float* RS1; const float* COS; const float* SIN; const float* a_log; const float* dt_bias;
    bf16_t* QB; bf16_t* KT; bf16_t* VT; bf16_t* QKVB; bf16_t* ZB; float* GB;
    DI void tail(const pg8::f32x4 (&acc)[2][2][4][2], const pg8::Unit& u, int wr, int wc, int fr, int fq) const {
        const int pn = u.pn;
#pragma unroll
        for (int ai = 0; ai < 2; ++ai)
#pragma unroll
            for (int m = 0; m < 4; ++m) {
                const int row = u.pm * 256 + ai * 128 + wr * 64 + m * 16 + fr;
                if (row < MTOK + NMETA) {
                    const float rs = RS1[row];
                    const bool meta = row >= MTOK;
                    const int p = meta ? row - MTOK : (row & 8191) + NMETA;
                    const int b0 = meta ? 0 : (row >> 13), nb = meta ? 2 : 1;
#pragma unroll
                    for (int bj = 0; bj < 2; ++bj) {
                        float xv[8];
#pragma unroll
                        for (int i = 0; i < 4; ++i) { xv[i] = acc[ai][bj][m][0][i] * rs; xv[4 + i] = acc[ai][bj][m][1][i] * rs; }
                        if (pn < 4) {
                            const int hh = (pn & 1) * 4 + bj * 2 + (wc >> 1), d0 = 4 * (4 * (wc & 1) + fq);
                            const f32x4 cs = *(const f32x4*)(COS + p * 32 + d0), sn = *(const f32x4*)(SIN + p * 32 + d0);
                            float lo[4], hi[4];
#pragma unroll
                            for (int i = 0; i < 4; ++i) { lo[i] = xv[i] * cs[i] - xv[4 + i] * sn[i]; hi[i] = xv[4 + i] * cs[i] + xv[i] * sn[i]; }
                            if (pn < 2) {
                                if (!meta) {
                                    bf16_t* q = QB + ((size_t)((b0 * 8 + hh) * SEQ + (p - NMETA)) << 6) + d0;
                                    *(u32x2*)q = (u32x2){pk2(lo[0] * C2Q, lo[1] * C2Q), pk2(lo[2] * C2Q, lo[3] * C2Q)};
                                    *(u32x2*)(q + 32) = (u32x2){pk2(hi[0] * C2Q, hi[1] * C2Q), pk2(hi[2] * C2Q, hi[3] * C2Q)};
                                }
                            } else {
                                for (int bb = b0; bb < b0 + nb; ++bb) {
                                    *(u32x2*)(KT + kt_off(bb, hh, p, d0)) = (u32x2){pk2(lo[0], lo[1]), pk2(lo[2], lo[3])};
                                    *(u32x2*)(KT + kt_off(bb, hh, p, d0 + 32)) = (u32x2){pk2(hi[0], hi[1]), pk2(hi[2], hi[3])};
                                }
                            }
                        } else {
                            const u32x4 w = (u32x4){pk2(xv[0], xv[1]), pk2(xv[2], xv[3]), pk2(xv[4], xv[5]), pk2(xv[6], xv[7])};
                            const int cl = bj * 128 + wc * 32 + fq * 8;
                            if (pn < 6) {
                                const int h = (pn - 4) * 2 + bj, d = wc * 32 + fq * 8;
                                for (int bb = b0; bb < b0 + nb; ++bb) *(u32x4*)(VT + vt_off(bb, h, p, d)) = w;
                            } else if (pn < 12) {
                                for (int bb = b0; bb < b0 + nb; ++bb) *(u32x4*)(QKVB + (size_t)(bb * LP + p) * 1536 + (pn - 6) * 256 + cl) = w;
                            } else if (pn < 14) {
                                float sz[8];
#pragma unroll
                                for (int i = 0; i < 8; ++i) sz[i] = xv[i] * __builtin_amdgcn_rcpf(1.0f + __expf(-xv[i]));
                                const u32x4 wz = (u32x4){pk2(sz[0], sz[1]), pk2(sz[2], sz[3]), pk2(sz[4], sz[5]), pk2(sz[6], sz[7])};
                                for (int bb = b0; bb < b0 + nb; ++bb) *(u32x4*)(ZB + (size_t)(bb * LP + p) * 512 + (pn - 12) * 256 + cl) = wz;
                            } else if (cl < 16) {
                                float o[8];
                                if (cl == 0) {
#pragma unroll
                                    for (int i = 0; i < 8; ++i) { const float t = xv[i] + dt_bias[i]; const float sp = t > 20.f ? t : log1pf(expf(t)); o[i] = -expf(a_log[i]) * sp; }
                                } else {
#pragma unroll
                                    for (int i = 0; i < 8; ++i) o[i] = 1.0f / (1.0f + expf(-xv[i]));
                                }
                                for (int bb = b0; bb < b0 + nb; ++bb) { float* g = GB + ((size_t)(bb * LP + p) << 4) + cl;
                                    *(f32x4*)g = (f32x4){o[0], o[1], o[2], o[3]}; *(f32x4*)(g + 4) = (f32x4){o[4], o[5], o[6], o[7]}; }
                            }
                        }
                    }
                }
            }
    }

    DI void operator()(const pg8::f32x4 (&acc)[2][2][4][2], const pg8::Unit& u, int wr, int wc, int fr, int fq) const {
        if (u.pm >= MTOK / 256) { tail(acc, u, wr, wc, fr, fq); return; }
        const int pn = u.pn, rowb = u.pm * 256 + wr * 64 + fr;
        float rs[2][4];
#pragma unroll
        for (int ai = 0; ai < 2; ++ai)
#pragma unroll
            for (int m = 0; m < 4; ++m) rs[ai][m] = RS1[rowb + ai * 128 + m * 16];
        __builtin_amdgcn_sched_barrier(0);
        const int b = rowb >> 13, s0 = rowb & 8191;
        if (pn < 4) {
            const int d0 = 4 * (4 * (wc & 1) + fq);
#pragma unroll
            for (int ai = 0; ai < 2; ++ai) {
                f32x4 cs[4], sn[4];
#pragma unroll
                for (int m = 0; m < 4; ++m) { const int p = s0 + ai * 128 + m * 16 + NMETA; cs[m] = *(const f32x4*)(COS + p * 32 + d0); sn[m] = *(const f32x4*)(SIN + p * 32 + d0); }
                __builtin_amdgcn_sched_barrier(0);
#pragma unroll
                for (int m = 0; m < 4; ++m)
#pragma unroll
                    for (int bj = 0; bj < 2; ++bj) {
                        const int hh = (pn & 1) * 4 + bj * 2 + (wc >> 1), s = s0 + ai * 128 + m * 16;
                        float lo[4], hi[4];
#pragma unroll
                        for (int i = 0; i < 4; ++i) { const float x1 = acc[ai][bj][m][0][i] * rs[ai][m], x2 = acc[ai][bj][m][1][i] * rs[ai][m];
                            lo[i] = x1 * cs[m][i] - x2 * sn[m][i]; hi[i] = x2 * cs[m][i] + x1 * sn[m][i]; }
                        if (pn < 2) { bf16_t* q = QB + ((size_t)((b * 8 + hh) * SEQ + s) << 6) + d0;
                            *(u32x2*)q = (u32x2){pk2(lo[0] * C2Q, lo[1] * C2Q), pk2(lo[2] * C2Q, lo[3] * C2Q)};
                            *(u32x2*)(q + 32) = (u32x2){pk2(hi[0] * C2Q, hi[1] * C2Q), pk2(hi[2] * C2Q, hi[3] * C2Q)};
                        } else { bf16_t* k = KT + ((size_t)((b * 8 + hh) * NKT + 1 + (s >> 6)) << 12) + ((d0 >> 3) << 9) + ((s & 63) << 3) + (d0 & 7);
                            *(u32x2*)k = (u32x2){pk2(lo[0], lo[1]), pk2(lo[2], lo[3])};
                            *(u32x2*)(k + 4 * 512) = (u32x2){pk2(hi[0], hi[1]), pk2(hi[2], hi[3])}; }
                    }
            }
            return;
        }
        const int cl = wc * 32 + fq * 8;
#pragma unroll
        for (int ai = 0; ai < 2; ++ai)
#pragma unroll
            for (int m = 0; m < 4; ++m)
#pragma unroll
                for (int bj = 0; bj < 2; ++bj) {
                    const int s = s0 + ai * 128 + m * 16, p = s + NMETA;
                    float xv[8];
#pragma unroll
                    for (int i = 0; i < 4; ++i) { xv[i] = acc[ai][bj][m][0][i] * rs[ai][m]; xv[4 + i] = acc[ai][bj][m][1][i] * rs[ai][m]; }
                    if (pn < 6) {
                        const int h = (pn - 4) * 2 + bj;
                        *(u32x4*)(VT + ((size_t)((b * 4 + h) * NKT + 1 + (s >> 6)) << 13) + ((cl >> 5) << 11) + (((s & 63) >> 4) << 9) + ((s & 15) << 5) + (cl & 31)) =
                            (u32x4){pk2(xv[0], xv[1]), pk2(xv[2], xv[3]), pk2(xv[4], xv[5]), pk2(xv[6], xv[7])};
                    } else if (pn < 12) {
                        *(u32x4*)(QKVB + (size_t)(b * LP + p) * 1536 + (pn - 6) * 256 + bj * 128 + cl) = (u32x4){pk2(xv[0], xv[1]), pk2(xv[2], xv[3]), pk2(xv[4], xv[5]), pk2(xv[6], xv[7])};
                    } else if (pn < 14) {
#pragma unroll
                        for (int i = 0; i < 8; ++i) xv[i] = xv[i] * __builtin_amdgcn_rcpf(1.0f + __expf(-xv[i]));
                        *(u32x4*)(ZB + (size_t)(b * LP + p) * 512 + (pn - 12) * 256 + bj * 128 + cl) = (u32x4){pk2(xv[0], xv[1]), pk2(xv[2], xv[3]), pk2(xv[4], xv[5]), pk2(xv[6], xv[7])};
                    } else if (bj == 0 && cl < 16) {
                        float o[8];
                        if (cl == 0) {
#pragma unroll
                            for (int i = 0; i < 8; ++i) { const float t = xv[i] + dt_bias[i]; const float sp = t > 20.f ? t : log1pf(expf(t)); o[i] = -expf(a_log[i]) * sp; }
                        } else {
#pragma unroll
                            for (int i = 0; i < 8; ++i) o[i] = 1.0f / (1.0f + expf(-xv[i]));
                        }
                        float* g = GB + ((size_t)(b * LP + p) << 4) + cl;
                        *(f32x4*)g = (f32x4){o[0], o[1], o[2], o[3]}; *(f32x4*)(g + 4) = (f32x4){o[4], o[5], o[6], o[7]};
                    }
                }
    }
};

DI bf16x8 lds_frag(LAS const bf16_t* M, int row, int ch) { return *(LAS const bf16x8*)((LAS const unsigned char*)M + row * 128 + ((ch ^ (row & 7)) << 4)); }
DI s16x4 tr_read_b64(LAS const unsigned char* p) { return __builtin_bit_cast(s16x4, __builtin_amdgcn_ds_read_tr16_b64_v4i16((LAS v4i16_t*)p)); }
DI bf16x8 lds_frag_plain(LAS const bf16_t* M, int row, int ch) { return *(LAS const bf16x8*)((LAS const unsigned char*)M + row * 128 + (ch << 4)); }
DI int swz_idx(int row, int d) { return row * 64 + ((((d >> 3) ^ (row & 7)) << 3) | (d & 7)); }

#ifndef PREP_REP
#define PREP_REP 0
#endif
constexpr int PREP_PAIR = 35840;

template <int MAT> DI void prep_rows(const bf16_t* QKVB, const float* cw, int b, int h, int n, int lane, LAS const float* egS,
                                     LAS bf16_t* DS  , bf16_t* QG) {
    const int colb = MAT * 512 + h * 64, col = colb + lane, p0 = n * 64;
    const float c0 = cw[col], c1 = cw[1536 + col], c2 = cw[3072 + col], c3 = cw[4608 + col];
    const bf16_t* blk = QKVB + (size_t)(b * LP + p0) * 1536 + colb;
    float x0 = 0.f, x1 = 0.f, x2 = 0.f;
    if (n > 0) { x0 = bf2f(blk[lane - 3 * 1536]); x1 = bf2f(blk[lane - 2 * 1536]); x2 = bf2f(blk[lane - 1 * 1536]); }
    u32x4 stg[8];
#pragma unroll
    for (int i = 0; i < 8; ++i) stg[i] = *(const u32x4*)(blk + (size_t)(8 * i + (lane >> 3)) * 1536 + (lane & 7) * 8);
#pragma unroll
    for (int i = 0; i < 8; ++i) *(LAS u32x4*)(DS + (8 * i + (lane >> 3)) * 64 + (lane & 7) * 8) = stg[i];
    LDS_WAIT();
    const int nvalid = (LTOK - p0) < 64 ? (LTOK - p0) : 64;
#pragma unroll 4
    for (int c = 0; c < 64; ++c) {
        if (c >= nvalid) { DS[c * 64 + lane] = 0; if (MAT == 0) store_quad_bf16(QG + c * 64 + perm16(lane), 0.f, lane); continue; }
        const bool valid = true;
        const float x3 = bf2f(DS[c * 64 + lane]);
        float y = c0 * x0 + c1 * x1 + c2 * x2 + c3 * x3;
        y = y * __builtin_amdgcn_rcpf(1.0f + __expf(-y));
        if (!valid) y = 0.f;
        x0 = x1; x1 = x2; x2 = x3;
        if (MAT == 2) { DS[c * 64 + lane] = (bf16_t)f2bf(y * egS[c]); }
        else {
            const float ss = wave_sum(y * y);
            const float yn = y * __builtin_amdgcn_rsqf(ss + EPS);
            if (MAT == 0) {
                const float qn = yn * 0.125f;
                DS[c * 64 + lane] = (bf16_t)f2bf(qn);
                store_quad_bf16(QG + c * 64 + perm16(lane), qn * egS[c], lane);
            } else {
                DS[c * 64 + lane] = (bf16_t)f2bf(yn);
            }
        }
    }
}

DI void gdn_tinv(LAS const float* AST, LAS bf16_t* TS, int lane) {
    const int hb = lane >> 5, j = lane & 31, r32 = j, hi = hb;
    LAS const float* Ab = AST + (32 * hb) * 68 + 32 * hb;
    float x[32];
#pragma unroll
    for (int r = 0; r < 32; ++r) x[r] = (r == j) ? 1.0f : 0.0f;
#pragma unroll
    for (int jj = 0; jj < 31; ++jj) {
        const float xj = x[jj];
        LAS const float* ap = Ab + jj * 68;
#pragma unroll
        for (int r4 = (jj + 1) / 4; r4 < 8; ++r4) {
            const f32x4 a = *(LAS const f32x4*)(ap + 4 * r4);
#pragma unroll
            for (int e = 0; e < 4; ++e) if (4 * r4 + e > jj) x[4 * r4 + e] -= a[e] * xj;
        }
    }
    bf16x8 a21[2];
#pragma unroll
    for (int s = 0; s < 2; ++s) { float t[8];
#pragma unroll
        for (int jj = 0; jj < 8; ++jj) t[jj] = AST[(16 * s + 8 * hi + jj) * 68 + 32 + r32];
        const u32x4 p = (u32x4){pk2(t[0], t[1]), pk2(t[2], t[3]), pk2(t[4], t[5]), pk2(t[6], t[7])}; a21[s] = __builtin_bit_cast(bf16x8, p); }
    f32x16 M = {};
#pragma unroll
    for (int s = 0; s < 2; ++s) { float t[8];
#pragma unroll
        for (int jj = 0; jj < 8; ++jj) {
            const auto rr = __builtin_amdgcn_permlane32_swap(__float_as_uint(x[16 * s + 8 + jj]), __float_as_uint(x[16 * s + 8 + jj]), false, false);
            t[jj] = hi ? __uint_as_float(rr[0]) : x[16 * s + jj];
        }
        const u32x4 p = (u32x4){pk2(t[0], t[1]), pk2(t[2], t[3]), pk2(t[4], t[5]), pk2(t[6], t[7])};
        M = MFMA32(a21[s], __builtin_bit_cast(bf16x8, p), M);
    }
    asm volatile("s_waitcnt lgkmcnt(0)" ::: "memory");
#pragma unroll
    for (int i = 0; i < 32; ++i) TS[(32 * hb + i) * 64 + 32 * hb + j] = (bf16_t)f2bf(x[i]);
    asm volatile("s_waitcnt lgkmcnt(0)" ::: "memory");
    f32x16 T21 = {};
#pragma unroll
    for (int s = 0; s < 2; ++s) {
        const u32x2 lo = *(LAS const u32x2*)(TS + (32 + r32) * 64 + 32 + 16 * s + 4 * hi), hi8 = *(LAS const u32x2*)(TS + (32 + r32) * 64 + 32 + 16 * s + 8 + 4 * hi);
        const u32x4 p = (u32x4){lo.x, lo.y, hi8.x, hi8.y};
        T21 = MFMA32(__builtin_bit_cast(bf16x8, p), pack8(M, s), T21);
    }
#pragma unroll
    for (int i = 0; i < 16; ++i) TS[(32 + crow(i, hi)) * 64 + r32] = (bf16_t)f2bf(-T21[i]);
    asm volatile("s_waitcnt lgkmcnt(0)" ::: "memory");
}

template <bool PERM> DI void gdn_tmul(LAS const bf16_t* TS, LAS const bf16_t* RS, int lane, float sgn, bf16_t* out) {
    const int r32 = lane & 31, hi = lane >> 5;
    LAS const unsigned char* rb = (LAS const unsigned char*)RS + ((8 * hi + ((lane & 15) >> 2)) * 64 + 16 * ((lane >> 4) & 1) + 4 * (lane & 3)) * 2;
#pragma unroll
    for (int ct = 0; ct < 2; ++ct)
#pragma unroll
        for (int cb = 0; cb < 2; ++cb) {
            f32x16 acc = {};
#pragma unroll
            for (int ks = 0; ks < (ct == 0 ? 2 : 4); ++ks) {
                const bf16x8 fa = lds_frag_plain(TS, 32 * ct + r32, 2 * ks + hi);
                const s16x4 lo = tr_read_b64(rb + (16 * ks * 64 + 32 * cb) * 2), h4 = tr_read_b64(rb + ((16 * ks + 4) * 64 + 32 * cb) * 2);
                const bf16x8 fb = (bf16x8){lo[0], lo[1], lo[2], lo[3], h4[0], h4[1], h4[2], h4[3]};
                acc = MFMA32(fa, fb, acc);
            }
            u32x2 pk[16];
#pragma unroll
            for (int i = 0; i < 16; ++i) pk[i] = pack_quad_bf16(sgn * acc[i]);
            if ((lane & 3) == 0) {
                unsigned long long ob_ = (unsigned long long)(out + hi * 256 + (PERM ? perm16(32 * cb + r32) : 32 * cb + r32)); asm volatile("" : "+v"(ob_));
                g_u32x2* ob = (g_u32x2*)ob_;
#pragma unroll
                for (int i = 0; i < 16; ++i) ob[(32 * ct + (i & 3) + 8 * (i >> 2)) * 16] = pk[i];
            }
        }
}

DI void gdn_prep_phase(const Params& P, LAS unsigned char* lds, int blk, int G, int wave, int lane_in) {
    const int pair = wave >> 1, role = wave & 1;
    LAS unsigned char* pb = lds + pair * PREP_PAIR;
    LAS bf16_t* QS = (LAS bf16_t*)pb; LAS bf16_t* KS = (LAS bf16_t*)(pb + 8192); LAS float* AS = (LAS float*)(pb + 16384);
    LAS float* gcS = (LAS float*)(pb + 16384 + 17408 + role * 1024); LAS float* betaS = gcS + 64; LAS float* egS = gcS + 128; LAS float* ekS = gcS + 192;
    const bf16_t* QKVB = (const bf16_t*)(P.ws + WS_QKVB); const float* GB = (const float*)(P.ws + WS_GB); const float* cw = P.in[9];
    const int NP = G * 4, NTASK = 2 * 8 * NCHUNK;
    for (int it = 0; it * NP < NTASK; ++it) {
        int lane = lane_in; asm volatile("" : "+v"(lane));
        const int r32 = lane & 31, hi = lane >> 5;
        const int task = it * NP + blk * 4 + pair;
        const bool active = task < NTASK;
        const int bh = task < 2048 ? (task >> 7) : (task - 2048), n = task < 2048 ? (task & 127) : 128, b = bh >> 3, h = bh & 7;
        const int sidx = bh * NCHUNK + n;
        bf16_t* GPW = (bf16_t*)(P.ws + WS_GP) + (size_t)sidx * 4096; bf16_t* GPQG = GPW + GP_ARR / 2; bf16_t* GPAQK = GPQG + GP_ARR / 2; bf16_t* GPKGT = GPAQK + GP_ARR / 2; bf16_t* GPU = GPKGT + GP_ARR / 2;
        float gc = 0.f, beta = 0.f;
        if (active) {
            const int pl = n * 64 + lane;
            float g = 0.f;
            if (pl < LTOK) { const float* gb = GB + ((size_t)(b * LP + pl) << 4); g = gb[h]; beta = gb[8 + h]; }
            gcS[lane] = g; LDS_WAIT();
            gc = 0.f;
#pragma unroll
            for (int j4 = 0; j4 < 16; ++j4) { const f32x4 t = *(LAS const f32x4*)(gcS + 4 * j4);
                gc += (4 * j4 <= lane ? t[0] : 0.f) + (4 * j4 + 1 <= lane ? t[1] : 0.f) + (4 * j4 + 2 <= lane ? t[2] : 0.f) + (4 * j4 + 3 <= lane ? t[3] : 0.f); }
            const float glast = rlane(gc, 63);
            LDS_WAIT();
            gcS[lane] = gc; betaS[lane] = beta; egS[lane] = (role == 0) ? __expf(gc) : beta * __expf(gc); ekS[lane] = __expf(glast - gc);
            if (role == 0 && lane == 0) ((float*)(P.ws + WS_GL))[sidx] = __expf(glast);
            LDS_WAIT();
            for (int rp_ = 0; rp_ < ((PREP_REP & 1) ? 2 : 1); ++rp_) {
            if (role == 0) prep_rows<0>(QKVB, cw, b, h, n, lane, egS, QS, GPQG);
            else prep_rows<1>(QKVB, cw, b, h, n, lane, egS, KS, GPQG);
            }
        }
        LDS_WAIT();
        __syncthreads();
        if (active) {
            for (int rp_ = 0; rp_ < ((PREP_REP & 2) ? 2 : 1); ++rp_)
#pragma unroll
            for (int t4 = 0; t4 < 4; ++t4) {
                const int ct = t4 >> 1, st = t4 & 1;
                f32x16 acc = {};
                if (!(ct == 0 && st == 1)) {
#pragma unroll
                    for (int ks = 0; ks < 4; ++ks) {
                        const bf16x8 fa = lds_frag_plain(role == 0 ? QS : KS, 32 * ct + r32, 2 * ks + hi), fb = lds_frag_plain(KS, 32 * st + r32, 2 * ks + hi);
                        acc = MFMA32(fa, fb, acc);
                    }
                }
                const float gcs = gcS[32 * st + r32];
                LAS const float* gcb = gcS + hi * 4; LAS const float* beb = betaS + hi * 4;
                asm volatile("" : "+v"(gcb), "+v"(beb));
                const int cmp = (32 * st + r32) - 4 * hi;
                if (role == 0) {
                    u32x2 pk[16];
#pragma unroll
                    for (int i = 0; i < 16; ++i) { const int cr = 32 * ct + (i & 3) + 8 * (i >> 2);
                        pk[i] = pack_quad_bf16((cmp <= cr) ? acc[i] * __expf(gcb[cr] - gcs) : 0.f); }
                    if ((lane & 3) == 0) {
                        unsigned long long aq_ = (unsigned long long)(GPAQK + hi * 256 + perm16(r32) + 32 * st); asm volatile("" : "+v"(aq_));
                        g_u32x2* aqb = (g_u32x2*)aq_;
#pragma unroll
                        for (int i = 0; i < 16; ++i) { const int cr = 32 * ct + (i & 3) + 8 * (i >> 2); aqb[cr * 16] = pk[i]; }
                    }
                } else {
                    LAS float* asb = AS + r32 * 68 + hi * 4;
                    asm volatile("" : "+v"(asb));
#pragma unroll
                    for (int i = 0; i < 16; ++i) { const int cr = 32 * ct + (i & 3) + 8 * (i >> 2);
                        asb[32 * st * 68 + cr] = (cmp < cr) ? acc[i] * beb[cr] * __expf(gcb[cr] - gcs) : 0.f; }
                }
            }
        }
        LDS_WAIT();
        __syncthreads();
        LAS bf16_t* TS = (LAS bf16_t*)((LAS unsigned char*)AS + 32 * 68 * 4);
        if (active) {
            if (role == 0) {
                prep_rows<2>(QKVB, cw, b, h, n, lane, betaS, QS  , GPQG);
            } else {
#pragma unroll
                for (int gq = 0; gq < 8; ++gq) {
                    float t[8];
#pragma unroll
                    for (int j = 0; j < 8; ++j) { const int c = perm16(8 * gq + j); t[j] = bf2f(KS[c * 64 + lane]) * ekS[c]; }
                    *(u32x4*)(GPKGT + lane * 64 + 8 * gq) = (u32x4){pk2(t[0], t[1]), pk2(t[2], t[3]), pk2(t[4], t[5]), pk2(t[6], t[7])};
                }
#pragma unroll 8
                for (int c = 0; c < 64; ++c) KS[c * 64 + lane] = (bf16_t)f2bf(bf2f(KS[c * 64 + lane]) * egS[c]);
                gdn_tinv(AS, TS, lane);
            }
        }
        LDS_WAIT();
        __syncthreads();
        if (active) {
            for (int rp_ = 0; rp_ < ((PREP_REP & 8) ? 2 : 1); ++rp_) {
            if (role == 0) gdn_tmul<false>(TS, QS, lane, 1.0f, GPU);
            else gdn_tmul<true>(TS, KS, lane, -1.0f, GPW);
            }
        }
        LDS_WAIT();
    }
}

constexpr int GS_STAGE = 40960 + 1024;
constexpr int GS_NSTAGE = 3;
constexpr int GS_OBUF = GS_NSTAGE * GS_STAGE;
static_assert(GS_OBUF + 16384 <= LDS_BYTES - 64, "gdn scan LDS");

#define GS_POST(n, ZQ) do { \
            if (n > 0) {         \
                LAS const bf16_t* ob = (LAS const bf16_t*)(lds + GS_OBUF + ((n - 1) & 1) * 8192); \
                const f32x4 gn = *(const f32x4*)(gnorm + 4 * vq); \
            _Pragma("unroll") \
                for (int it = 0; it < 8; ++it) { \
                    const int c = (wave - 2) * 32 + 4 * it + rg, p = (n - 1) * 64 + c; \
                    const u32x2 ov = *(LAS const u32x2*)(ob + c * 64 + 4 * vq); \
                    const float v0 = __uint_as_float(ov.x << 16), v1 = __uint_as_float(ov.x & 0xffff0000u), v2 = __uint_as_float(ov.y << 16), v3 = __uint_as_float(ov.y & 0xffff0000u); \
                    const float ss = row_sum16((v0 * v0 + v1 * v1) + (v2 * v2 + v3 * v3)); \
                    const float rn = __builtin_amdgcn_rsqf(ss * (1.0f / 64.0f) + EPS); \
                    const u32x2 zz = ZQ[it]; \
                    const float z0 = __uint_as_float(zz.x << 16), z1 = __uint_as_float(zz.x & 0xffff0000u), z2 = __uint_as_float(zz.y << 16), z3 = __uint_as_float(zz.y & 0xffff0000u); \
                    const float y0 = v0 * rn * gn[0] * z0, y1 = v1 * rn * gn[1] * z1, y2 = v2 * rn * gn[2] * z2, y3 = v3 * rn * gn[3] * z3;       \
                    { bf16_t* dst_ = ((p >= NMETA) && (p < LTOK)) ? MIX + (size_t)(b * SEQ + p - NMETA) * 1024 + 512 + h * 64 + 4 * vq : DUMP + lane * 4;       \
                      *(u32x2*)dst_ = (u32x2){pk2(y0, y1), pk2(y2, y3)}; } \
                } \
            } \
        } while (0)
DI void gdn_scan(const Params& P, LAS unsigned char* lds, int bh, int tid, int wave, int lane) {
    const int b = bh >> 3, h = bh & 7, r32 = lane & 31, hi = lane >> 5;
    const int task0 = (b * 8 + h) * NCHUNK;
    const bf16_t* GP0 = (const bf16_t*)(P.ws + WS_GP);
    const float* GLg = (const float*)(P.ws + WS_GL);
    const bf16_t* ZB = (const bf16_t*)(P.ws + WS_ZB); bf16_t* MIX = (bf16_t*)(P.ws + WS_MIX); const float* gnorm = P.in[12];
    bf16_t* DUMP = (bf16_t*)(P.ws + WS_DUMP) + bh * 4096 + wave * 512;
    const int lw = wave - 4;
    const int prow = lane >> 3, pch = lane & 7;
#define GS_DMA(n_, stg_) do { LAS unsigned char* sg_ = lds + (stg_) * GS_STAGE; \
        _Pragma("unroll") for (int i = 0; i < 10; ++i) { const int a_ = i >> 1, pi_ = lw * 2 + (i & 1), row_ = 8 * pi_ + prow; \
            const int sch_ = (a_ < 4) ? (pch ^ (row_ & 7)) : pch; \
            __builtin_amdgcn_global_load_lds((const unsigned*)(GP0 + (size_t)a_ * (GP_ARR / 2) + (size_t)(task0 + (n_)) * 4096 + row_ * 64 + sch_ * 8), \
                                             (LAS unsigned*)(sg_ + a_ * 8192 + pi_ * 1024), 16, 0, 0); } \
        __builtin_amdgcn_global_load_lds((const unsigned*)(GLg + task0 + (n_)), (LAS unsigned*)(sg_ + 40960 + lw * 256), 4, 0, 0); } while (0)
    if (wave >= 4) { GS_DMA(0, 0); GS_DMA(1, 1); asm volatile("s_waitcnt vmcnt(11)" ::: "memory"); }
    const int vq = lane & 15, rg = lane >> 4;
    u32x2 zqA[8], zqB[8];
#define GS_ZLOADX(ZQ, n_) do { _Pragma("unroll") for (int it = 0; it < 8; ++it) { int p_ = (n_) * 64 + (wave - 2) * 32 + 4 * it + rg; p_ = p_ < LTOK ? p_ : LTOK - 1; \
            ZQ[it] = *(const u32x2*)(ZB + (size_t)(b * LP + p_) * 512 + h * 64 + 4 * vq); } } while (0)
    if (wave == 2 || wave == 3) { GS_ZLOADX(zqB, 0); }
    BAR_LDS();
    f32x16 S0 = {}, S1 = {};
    const int vbase = 32 * wave;
    if (wave < 2) {
    int stg = 0;
    for (int n = 0; n <= NCHUNK; ++n) {
        {
            if (n < NCHUNK) {
                LAS const unsigned char* sg = lds + stg * GS_STAGE;
                LAS const bf16_t* Wm = (LAS const bf16_t*)sg; LAS const bf16_t* QGm = (LAS const bf16_t*)(sg + 8192); LAS const bf16_t* AQm = (LAS const bf16_t*)(sg + 16384);
                LAS const bf16_t* KGm = (LAS const bf16_t*)(sg + 24576); LAS const bf16_t* Um = (LAS const bf16_t*)(sg + 32768);
                const float gl = *(LAS const float*)(sg + 40960);
                bf16x8 Sb[2][2]; Sb[0][0] = pack8(S0, 0); Sb[0][1] = pack8(S0, 1); Sb[1][0] = pack8(S1, 0); Sb[1][1] = pack8(S1, 1);
                bf16x8 fw[2][4], fq[2][4];
                f32x16 vn[2], o[2];
#pragma unroll
                for (int ct = 0; ct < 2; ++ct)
#pragma unroll
                    for (int k4 = 0; k4 < 4; ++k4) { fw[ct][k4] = lds_frag(Wm, 32 * ct + r32, k4 * 2 + hi); fq[ct][k4] = lds_frag(QGm, 32 * ct + r32, k4 * 2 + hi); }
#pragma unroll
                for (int ct = 0; ct < 2; ++ct)
#pragma unroll
                    for (int i = 0; i < 16; ++i) vn[ct][i] = bf2f(Um[(32 * ct + crow(i, hi)) * 64 + vbase + r32]);
                o[0] = f32x16{}; o[1] = f32x16{};
                __builtin_amdgcn_sched_barrier(0);
#pragma unroll
                for (int k4 = 0; k4 < 4; ++k4) {
                    vn[0] = MFMA32(fw[0][k4], Sb[k4 >> 1][k4 & 1], vn[0]); o[0] = MFMA32(fq[0][k4], Sb[k4 >> 1][k4 & 1], o[0]);
                    vn[1] = MFMA32(fw[1][k4], Sb[k4 >> 1][k4 & 1], vn[1]); o[1] = MFMA32(fq[1][k4], Sb[k4 >> 1][k4 & 1], o[1]);
                }
                __builtin_amdgcn_sched_barrier(0);
                bf16x8 fa[2][4], fk[2][4];
#pragma unroll
                for (int g = 0; g < 4; ++g) { fa[0][g] = lds_frag(AQm, r32, g * 2 + hi); fa[1][g] = lds_frag(AQm, 32 + r32, g * 2 + hi);
                                              fk[0][g] = lds_frag(KGm, r32, g * 2 + hi); fk[1][g] = lds_frag(KGm, 32 + r32, g * 2 + hi); }
#pragma unroll
                for (int i = 0; i < 16; ++i) { S0[i] *= gl; S1[i] *= gl; }
                __builtin_amdgcn_sched_barrier(0);
                bf16x8 Vb[2][2]; Vb[0][0] = pack8(vn[0], 0); Vb[0][1] = pack8(vn[0], 1); Vb[1][0] = pack8(vn[1], 0); Vb[1][1] = pack8(vn[1], 1);
#pragma unroll
                for (int g = 0; g < 4; ++g) {
                    o[0] = MFMA32(fa[0][g], Vb[g >> 1][g & 1], o[0]); S0 = MFMA32(fk[0][g], Vb[g >> 1][g & 1], S0);
                    o[1] = MFMA32(fa[1][g], Vb[g >> 1][g & 1], o[1]); S1 = MFMA32(fk[1][g], Vb[g >> 1][g & 1], S1);
                }
                LAS bf16_t* ob = (LAS bf16_t*)(lds + GS_OBUF + (n & 1) * 8192);
#pragma unroll
                for (int ct = 0; ct < 2; ++ct)
#pragma unroll
                    for (int i = 0; i < 16; ++i) ob[(32 * ct + crow(i, hi)) * 64 + vbase + r32] = (bf16_t)f2bf(o[ct][i]);
            }
        }
        BAR_LDS();
        stg = stg + 1 >= GS_NSTAGE ? 0 : stg + 1;
    }
    } else if (wave < 4) {
    for (int n = 0; n <= NCHUNK; n += 2) {
        GS_POST(n, zqA);     if (n + 1 < NCHUNK) { GS_ZLOADX(zqA, n + 1); } BAR_LDS();
        GS_POST((n + 1), zqB); if (n + 2 < NCHUNK) { GS_ZLOADX(zqB, n + 2); } BAR_LDS();
    }
    } else {
    int stg = 0;
    for (int n = 0; n <= NCHUNK; ++n) {
        {
            if (n + 2 < NCHUNK) { const int s2_ = stg + 2 >= GS_NSTAGE ? stg + 2 - GS_NSTAGE : stg + 2; GS_DMA(n + 2, s2_); asm volatile("s_waitcnt vmcnt(11)" ::: "memory"); }
            else asm volatile("s_waitcnt vmcnt(0)" ::: "memory");
        }
        BAR_LDS();
        stg = stg + 1 >= GS_NSTAGE ? 0 : stg + 1;
    }
    }
#undef GS_DMA
#undef GS_ZLOADX
}
#define XB_TMO      128
#define XB_XCNT(j)  (256  + 64 * (j))
#define XB_XSUB(j)  (1280 + 64 * (j))
#define XB_XGEN(j)  (2304 + 64 * (j))
#define XB_TOP      3328
#define XB_TOPGEN   3392
#define XCD_BAR_WORDS 3456
#define XB_SPIN_CAP (1u << 18)

__device__ __forceinline__ unsigned xb_ld(unsigned* p)              { return __hip_atomic_load(p, __ATOMIC_RELAXED, __HIP_MEMORY_SCOPE_AGENT); }
__device__ __forceinline__ unsigned xb_add(unsigned* p, unsigned v) { return __hip_atomic_fetch_add(p, v, __ATOMIC_RELAXED, __HIP_MEMORY_SCOPE_AGENT); }
__device__ __forceinline__ unsigned xb_xcc_id() { return (unsigned)__builtin_amdgcn_s_getreg((3 << 11) | 20) & 0xFu; }
#define XB_SPIN(cond, bar) do { unsigned _sp = 0; while (cond) { __builtin_amdgcn_s_sleep(1); \
    if ((++_sp & 255u) == 0u) { if (xb_ld(&(bar)[XB_TMO])) break; if (_sp > XB_SPIN_CAP) { atomicAdd(&(bar)[XB_TMO], 1u); break; } } } } while (0)

struct XcdBarrier {
    unsigned* bar; unsigned x;
    volatile LAS unsigned* st;
};

__device__ __forceinline__ XcdBarrier xcd_barrier_post(unsigned* bar, volatile LAS unsigned* st) {
    XcdBarrier b; b.bar = bar; b.x = xb_xcc_id(); b.st = st;
    if (threadIdx.x == 0) (void)xb_add(&bar[XB_XCNT(b.x)], 1u);
    return b;
}
__device__ __forceinline__ void xcd_barrier_complete(unsigned* bar, unsigned x, unsigned& nloc, unsigned& nx) {
    const unsigned G = gridDim.x * gridDim.y * gridDim.z;
    unsigned sum, cnt, mine, sp = 0u;
    for (;;) {
        sum = 0u; cnt = 0u; mine = 0u;
#pragma unroll
        for (unsigned j = 0; j < 16; ++j) { const unsigned c = xb_ld(&bar[XB_XCNT(j)]); sum += c; cnt += (c > 0u) ? 1u : 0u; mine = (j == x) ? c : mine; }
        if (sum == G) break;
        __builtin_amdgcn_s_sleep(1);
        if ((++sp & 255u) == 0u) { if (xb_ld(&bar[XB_TMO])) break; if (sp > XB_SPIN_CAP) { atomicAdd(&bar[XB_TMO], 1u); break; } }
    }
    nloc = mine > 0u ? mine : 1u; nx = cnt > 0u ? cnt : 1u;
}

__device__ __forceinline__ void xcd_barrier(const XcdBarrier& b) {
    asm volatile("s_waitcnt vmcnt(0)" ::: "memory");
    __syncthreads();
    if (threadIdx.x == 0) {
        unsigned* bar = b.bar;
        __builtin_amdgcn_s_waitcnt(0);
        unsigned nloc = b.st[0], nx = b.st[1];
        if (nloc == 0u) { xcd_barrier_complete(bar, b.x, nloc, nx); b.st[0] = nloc; b.st[1] = nx; }
        const unsigned old = xb_add(&bar[XB_XSUB(b.x)], 1u);
        const unsigned gen = old / nloc;
        if (old + 1u == (gen + 1u) * nloc) {
            __builtin_amdgcn_fence(__ATOMIC_RELEASE, "agent");
            asm volatile("s_waitcnt vmcnt(0)" ::: "memory");
            const unsigned og = xb_add(&bar[XB_TOP], 1u);
            const unsigned tg = og / nx;
            if (og + 1u == (tg + 1u) * nx) xb_add(&bar[XB_TOPGEN], 1u);
            else XB_SPIN(xb_ld(&bar[XB_TOPGEN]) == tg, bar);
            __builtin_amdgcn_fence(__ATOMIC_ACQUIRE, "agent");
            xb_add(&bar[XB_XGEN(b.x)], 1u);
            asm volatile("s_waitcnt vmcnt(0)" ::: "memory");
        } else {
            XB_SPIN(xb_ld(&bar[XB_XGEN(b.x)]) == gen, bar);
            __builtin_amdgcn_fence(__ATOMIC_ACQUIRE, "agent");
            asm volatile("s_waitcnt vmcnt(0)" ::: "memory");
        }
    }
    __syncthreads();
}


constexpr int AT_STAGE = 32768;
constexpr int AT_NSTAGE = 3;
constexpr int AT_XBUF = 0;
constexpr int AT_WSF = AT_NSTAGE * AT_STAGE;
constexpr int AT_UNIT = AT_WSF + 2048;
constexpr float AT_THR = 8.0f;

DI float max3f(float a, float b, float c) { return __builtin_fmaxf(__builtin_fmaxf(a, b), c); }
DI s16x4 tr_read(LAS const unsigned char* p) { return __builtin_bit_cast(s16x4, __builtin_amdgcn_ds_read_tr16_b64_v4i16((LAS v4i16_t*)p)); }

template <int VAR> DI void attn_unit(const Params& P, LAS unsigned char* lds, int bh, int qi, int tid, int wave, int lane, float lam) {
    const int b = bh >> 2, h = bh & 3, r32 = lane & 31, hi = lane >> 5, qsub = wave >> 1, map = wave & 1, hh = 2 * h + map;
    const bf16_t* QB = (const bf16_t*)(P.ws + WS_QB); const bf16_t* KT = (const bf16_t*)(P.ws + WS_KT); const bf16_t* VT = (const bf16_t*)(P.ws + WS_VT);
    const int ntiles = 2 * qi + 3, my_nt = (qsub < 2) ? ntiles - 1 : ntiles;
    const bf16_t* k1 = KT + ((size_t)((b * 8 + 2 * h) * NKT) << 12) + tid * 8;
    const bf16_t* k2 = KT + ((size_t)((b * 8 + 2 * h + 1) * NKT) << 12) + tid * 8;
    const bf16_t* vv = VT + ((size_t)((b * 4 + h) * NKT) << 13) + tid * 8;
#define AT_DMA(t, sb) do { LAS unsigned char* d_ = lds + (sb) * AT_STAGE + wave * 1024; \
        __builtin_amdgcn_global_load_lds((const unsigned*)(k1 + ((size_t)(t) << 12)), (LAS unsigned*)d_, 16, 0, 0); \
        __builtin_amdgcn_global_load_lds((const unsigned*)(k2 + ((size_t)(t) << 12)), (LAS unsigned*)(d_ + 8192), 16, 0, 0); \
        __builtin_amdgcn_global_load_lds((const unsigned*)(vv + ((size_t)(t) << 13)), (LAS unsigned*)(d_ + 16384), 16, 0, 0); \
        __builtin_amdgcn_global_load_lds((const unsigned*)(vv + ((size_t)(t) << 13) + 4096), (LAS unsigned*)(d_ + 24576), 16, 0, 0); } while (0)
    bf16x8 qr[4];
    { const bf16_t* q = QB + ((size_t)((b * 8 + hh) * SEQ + qi * 128 + qsub * 32 + r32) << 6) + hi * 8;
#pragma unroll
      for (int d0 = 0; d0 < 4; ++d0) qr[d0] = *(const bf16x8*)(q + d0 * 16); }
    asm volatile("s_waitcnt vmcnt(0)" : "+v"(qr[0]), "+v"(qr[1]), "+v"(qr[2]), "+v"(qr[3]) :: "memory");
    AT_DMA(0, 0);
    if (ntiles > 1) AT_DMA(1, 1);
    if (ntiles > 1) asm volatile("s_waitcnt vmcnt(4)" ::: "memory"); else asm volatile("s_waitcnt vmcnt(0)" ::: "memory");
    BAR_LDS();
    LAS float* wsf = (LAS float*)(lds + AT_WSF) + wave * 64;
    float m_run = 0.f, l_run = 0.f;
    f32x16 negm = {};
    f32x16 o[4]; o[0] = f32x16{}; o[1] = f32x16{}; o[2] = f32x16{}; o[3] = f32x16{};
    for (int t = 0; t < ntiles; ++t) {
        if (t + 2 < ntiles) AT_DMA(t + 2, (t + 2) % AT_NSTAGE);
        if (t < my_nt) {
            LAS const unsigned char* sg = lds + (t % AT_NSTAGE) * AT_STAGE;
            LAS const unsigned char* kb = sg + map * 8192 + hi * 1024 + r32 * 16;
            f32x16 p0 = negm, p1 = negm;
            bf16x8 kf[8];
#pragma unroll
            for (int d0 = 0; d0 < 4; ++d0) { kf[2 * d0] = *(LAS const bf16x8*)(kb + d0 * 2048); kf[2 * d0 + 1] = *(LAS const bf16x8*)(kb + d0 * 2048 + 512); }
            __builtin_amdgcn_sched_barrier(0);
            __builtin_amdgcn_s_setprio(1);
#pragma unroll
            for (int d0 = 0; d0 < 4; ++d0) { p0 = MFMA32(kf[2 * d0], qr[d0], p0); p1 = MFMA32(kf[2 * d0 + 1], qr[d0], p1); }
            __builtin_amdgcn_s_setprio(0);
            const bool first = (t == 0);
            if (first) {
#pragma unroll
                for (int r = 0; r < 16; ++r) { if (crow(r, hi) >= NMETA) p0[r] = -INFINITY; p1[r] = -INFINITY; }
            }
            float ma = max3f(p0[0], p0[1], p1[0]), mb = max3f(p0[2], p0[3], p1[1]); ma = max3f(ma, p1[2], p1[3]);
#pragma unroll
            for (int r = 4; r < 16; r += 4) { ma = max3f(ma, p0[r], p0[r + 1]); mb = max3f(mb, p0[r + 2], p0[r + 3]); ma = max3f(ma, p1[r], p1[r + 1]); mb = max3f(mb, p1[r + 2], p1[r + 3]); }
            const float rm = swap32_max(max3f(ma, mb, mb));
            if (first || __any(rm > AT_THR)) {
                const float dl = first ? rm : fmaxf(rm, 0.f);
                m_run += dl;
#pragma unroll
                for (int r = 0; r < 16; ++r) { p0[r] -= dl; p1[r] -= dl; negm[r] = -m_run; }
                const float alpha = __builtin_amdgcn_exp2f(-dl);
                l_run *= alpha;
                if (!first) {
                    if (hi == 0) wsf[r32] = alpha;
                    LDS_WAIT();
#pragma unroll
                    for (int r = 0; r < 16; ++r) { const float a = wsf[crow(r, hi)];
#pragma unroll
                        for (int d0 = 0; d0 < 4; ++d0) o[d0][r] *= a; }
                    LDS_WAIT();
                }
            }
            float ls0 = 0.f, ls1 = 0.f;
#pragma unroll
            for (int r = 0; r < 16; ++r) { if (VAR != 2) { p0[r] = __builtin_amdgcn_exp2f(p0[r]); p1[r] = __builtin_amdgcn_exp2f(p1[r]); } ls0 += p0[r]; ls1 += p1[r]; }
            l_run += ls0 + ls1;
            const bf16x8 pa0 = pack8(p0, 0), pa1 = pack8(p0, 1), pa2 = pack8(p1, 0), pa3 = pack8(p1, 1);
            LAS const unsigned char* vb = sg + 16384 + ((lane >> 4) & 1) * 32 + (lane & 3) * 8 + (4 * hi + ((lane & 15) >> 2)) * 64;
            s16x4 va_[8], vb_[8];
            const unsigned vba = (unsigned)(uintptr_t)vb;
#define AT_VLD(V, d0_) do { _Pragma("unroll") for (int ks = 0; ks < 4; ++ks) { \
                asm volatile("ds_read_b64_tr_b16 %0, %1 offset:%c2" : "=v"(V[2 * ks]) : "v"(vba), "i"((d0_) * 4096 + ks * 1024)); \
                asm volatile("ds_read_b64_tr_b16 %0, %1 offset:%c2" : "=v"(V[2 * ks + 1]) : "v"(vba), "i"((d0_) * 4096 + ks * 1024 + 512)); } } while (0)
#define AT_VF(V, ks) ((bf16x8){V[2 * (ks)][0], V[2 * (ks)][1], V[2 * (ks)][2], V[2 * (ks)][3], V[2 * (ks) + 1][0], V[2 * (ks) + 1][1], V[2 * (ks) + 1][2], V[2 * (ks) + 1][3]})
#define AT_WAITL(n, V) do { asm volatile("s_waitcnt lgkmcnt(" #n ")" : "+v"(V[0]), "+v"(V[1]), "+v"(V[2]), "+v"(V[3]), "+v"(V[4]), "+v"(V[5]), "+v"(V[6]), "+v"(V[7])); __builtin_amdgcn_sched_barrier(0); } while (0)
#define AT_PV(V, d0_) do { __builtin_amdgcn_s_setprio(1); o[d0_] = MFMA32(pa0, AT_VF(V, 0), o[d0_]); o[d0_] = MFMA32(pa1, AT_VF(V, 1), o[d0_]); o[d0_] = MFMA32(pa2, AT_VF(V, 2), o[d0_]); o[d0_] = MFMA32(pa3, AT_VF(V, 3), o[d0_]); __builtin_amdgcn_s_setprio(0); } while (0)
            if (VAR != 1) {
            asm volatile("s_waitcnt lgkmcnt(0)" ::: "memory"); __builtin_amdgcn_sched_barrier(0);
            AT_VLD(va_, 0); AT_VLD(vb_, 1);
            AT_WAITL(8, va_); AT_PV(va_, 0); __builtin_amdgcn_sched_barrier(0); AT_VLD(va_, 2);
            AT_WAITL(8, vb_); AT_PV(vb_, 1); __builtin_amdgcn_sched_barrier(0); AT_VLD(vb_, 3);
            AT_WAITL(8, va_); AT_PV(va_, 2); __builtin_amdgcn_sched_barrier(0);
            AT_WAITL(0, vb_); AT_PV(vb_, 3);
            } else { o[0][0] += (float)pa0[0] + (float)pa1[1] + (float)pa2[2] + (float)pa3[3]; }
#undef AT_VF
#undef AT_WAITL
#undef AT_VLD
#undef AT_PV
        }
        if (t + 2 < ntiles) asm volatile("s_waitcnt vmcnt(4)" ::: "memory"); else asm volatile("s_waitcnt vmcnt(0)" ::: "memory");
        BAR_LDS();
    }
    if (VAR != 0) { if (o[0][0] + o[1][1] + o[2][2] + o[3][3] + l_run == 123.456f) ((float*)(P.ws + WS_DUMP))[tid] = 1.f; __syncthreads(); return; }
    l_run = swap32_add(l_run);
    const float sc = (map ? lam : 1.0f) / l_run;
    if (hi == 0) wsf[r32] = sc;
    LDS_WAIT();
#pragma unroll
    for (int r = 0; r < 16; ++r) { const float a = wsf[crow(r, hi)];
#pragma unroll
        for (int d0 = 0; d0 < 4; ++d0) o[d0][r] *= a; }
    LAS float* xb = (LAS float*)(lds + AT_XBUF + qsub * 16384);
    if (map) {
#pragma unroll
        for (int d0 = 0; d0 < 4; ++d0)
#pragma unroll
            for (int r = 0; r < 16; ++r) xb[(d0 * 16 + r) * 64 + lane] = o[d0][r];
    }
    __syncthreads();
    if (!map) {
        const float* dn = P.in[8];
        bf16_t* MIX = (bf16_t*)(P.ws + WS_MIX);
        float ss[16];
#pragma unroll
        for (int r = 0; r < 16; ++r) { ss[r] = 0.f;
#pragma unroll
            for (int d0 = 0; d0 < 4; ++d0) { o[d0][r] -= xb[(d0 * 16 + r) * 64 + lane]; ss[r] += o[d0][r] * o[d0][r]; } }
#pragma unroll
        for (int r = 0; r < 16; ++r) {
            ss[r] = half_sum32(ss[r]);
            ss[r] = 0.8f / sqrtf(ss[r] * (1.0f / 128.0f) + EPS);
        }
        float dg[4];
#pragma unroll
        for (int d0 = 0; d0 < 4; ++d0) dg[d0] = dn[32 * d0 + r32];
#pragma unroll
        for (int r = 0; r < 16; ++r) {
            bf16_t* orow = MIX + (size_t)(b * SEQ + qi * 128 + qsub * 32 + crow(r, hi)) * 1024 + h * 128 + r32;
#pragma unroll
            for (int d0 = 0; d0 < 4; ++d0) orow[32 * d0] = (bf16_t)f2bf(o[d0][r] * ss[r] * dg[d0]);
        }
    }
    __syncthreads();
#undef AT_DMA
}

template <int VAR> DI void attn_phase(const Params& P, LAS unsigned char* lds, int tid, int wave, int lane) {
    unsigned* ctl = (unsigned*)(P.ws + WS_CTL);
    const float* lq1 = P.in[4]; const float* lk1 = P.in[5]; const float* lq2 = P.in[6]; const float* lk2 = P.in[7];
    const float lam = __expf(wave_sum(lq1[lane] * lk1[lane])) - __expf(wave_sum(lq2[lane] * lk2[lane])) + 0.2f;
    LAS volatile int* ub = (LAS volatile int*)(lds + AT_UNIT);
    const unsigned x0 = xb_xcc_id() & 7u;
    for (;;) {
        if (tid == 0) {
            int u = -1;
            for (unsigned j = 0; j < 8u && u < 0; ++j) { const unsigned x = (x0 + j) & 7u;
                if (__hip_atomic_load(ctl + CW_ATTQ + 64 * x, __ATOMIC_RELAXED, __HIP_MEMORY_SCOPE_AGENT) >= 64u) continue;
                const unsigned i = __hip_atomic_fetch_add(ctl + CW_ATTQ + 64 * x, 1u, __ATOMIC_RELAXED, __HIP_MEMORY_SCOPE_AGENT);
                if (i < 64u) u = (int)(x * 64u + i); }
            *ub = u;
        }
        __syncthreads();
        const int u = *ub;
        __syncthreads();
        if (u < 0) break;
        attn_unit<VAR>(P, lds, u >> 6, 63 - (u & 63), tid, wave, lane, lam);
    }
}

struct EpiOutProj {
    static constexpr bool PERM = false, AFTER_DRAIN = false;
    const float* x; float* out; bf16_t* u2;
    DI void operator()(const pg8::f32x4 (&acc)[2][2][4][2], const pg8::Unit& u, int wr, int wc, int fr, int fq) const {
        const int row0 = u.pm * 256 + wr * 64 + fr, col0 = u.pn * 256 + wc * 32 + 4 * fq;
#pragma unroll
        for (int ai = 0; ai < 2; ++ai) {
            f32x4 xv[4][2][2];
#pragma unroll
            for (int m = 0; m < 4; ++m) { const size_t off = (size_t)(row0 + ai * 128 + m * 16) * 1024 + col0;
#pragma unroll
                for (int bj = 0; bj < 2; ++bj)
#pragma unroll
                    for (int n = 0; n < 2; ++n) xv[m][bj][n] = *(const f32x4*)(x + off + bj * 128 + n * 16); }
#pragma unroll
            for (int m = 0; m < 4; ++m) { const size_t off = (size_t)(row0 + ai * 128 + m * 16) * 1024 + col0;
#pragma unroll
                for (int bj = 0; bj < 2; ++bj)
#pragma unroll
                    for (int n = 0; n < 2; ++n) { const f32x4 hv = acc[ai][bj][m][n] + xv[m][bj][n]; *(f32x4*)(out + off + bj * 128 + n * 16) = hv;
                        *(u32x2*)(u2 + off + bj * 128 + n * 16) = (u32x2){pk2(hv[0], hv[1]), pk2(hv[2], hv[3])}; } }
        }
    }
};

typedef float f32x4v __attribute__((ext_vector_type(4)));
#ifdef ROUTE_PROBE
#define ROUTE_MID_HOOK() do { XcdBarrier xb2; xb2.bar = (unsigned*)(P.ws + WS_CTL) + CW_BAR; xb2.x = xb_xcc_id(); xb2.st = (volatile LAS unsigned*)(ldsb + LDS_BYTES - 64); xcd_barrier(xb2); \
    if (blockIdx.x == 0 && threadIdx.x == 0) __hip_atomic_store((unsigned long long*)(P.ws + WS_CTL + 65536) + 20, (unsigned long long)__builtin_amdgcn_s_memrealtime(), __ATOMIC_RELAXED, __HIP_MEMORY_SCOPE_AGENT); } while (0)
#else
#define ROUTE_MID_HOOK() do {} while (0)
#endif
DI void route_tile(const Params& P, int tile, int par, LAS float* sc  , int lane, LAS unsigned char* ldsb) {
    const float* h2 = P.out; const float* WR = (const float*)(P.ws + WS_WR);
    const int r16 = lane & 15, kq = lane >> 4;
    const float* arow = h2 + (size_t)(tile * 16 + r16) * 1024 + par * 512 + kq * 8;
    const float* b0 = WR + (size_t)r16 * 1024 + par * 512 + kq * 8; const float* b1 = b0 + 16 * 1024; const float* b2 = WR + (size_t)(32 + (r16 & 3)) * 1024 + par * 512 + kq * 8;
    const float z2 = (r16 < 4) ? 1.0f : 0.0f;
    f32x4v c0 = {}, c1 = {}, c2 = {};
    float ss = 0.f;
    f32x4 bA[4][4], bB[4][4];
#define RT_LOAD(B, tb) do { _Pragma("unroll") for (int j = 0; j < 4; ++j) { const int o_ = 32 * ((tb) + (j >> 1)) + 4 * (j & 1); \
        B[j][0] = *(const f32x4*)(arow + o_); B[j][1] = *(const f32x4*)(b0 + o_); B[j][2] = *(const f32x4*)(b1 + o_); B[j][3] = *(const f32x4*)(b2 + o_); } } while (0)
#define RT_COMP(B) do { _Pragma("unroll") for (int j = 0; j < 4; ++j) { const f32x4 a = B[j][0]; ss += (a.x * a.x + a.y * a.y) + (a.z * a.z + a.w * a.w); \
        _Pragma("unroll") for (int i = 0; i < 4; ++i) { c0 = __builtin_amdgcn_mfma_f32_16x16x4f32(a[i], B[j][1][i], c0, 0, 0, 0); \
            c1 = __builtin_amdgcn_mfma_f32_16x16x4f32(a[i], B[j][2][i], c1, 0, 0, 0); c2 = __builtin_amdgcn_mfma_f32_16x16x4f32(a[i], B[j][3][i] * z2, c2, 0, 0, 0); } } } while (0)
    RT_LOAD(bA, 0);
#pragma unroll
    for (int tb = 0; tb < 16; tb += 4) {
        RT_LOAD(bB, tb + 2); __builtin_amdgcn_sched_barrier(0); RT_COMP(bA); __builtin_amdgcn_sched_barrier(0);
        if (tb + 4 < 16) { RT_LOAD(bA, tb + 4); } __builtin_amdgcn_sched_barrier(0); RT_COMP(bB); __builtin_amdgcn_sched_barrier(0); }
#undef RT_LOAD
#undef RT_COMP
    ss += swz_xor16(ss); ss = swap32_add(ss);
    LAS float* my = sc + par * 800;
#pragma unroll
    for (int r = 0; r < 4; ++r) { const int row = 4 * kq + r; my[row * 48 + r16] = c0[r]; my[row * 48 + 16 + r16] = c1[r]; my[row * 48 + 32 + r16] = c2[r]; }
    if (lane < 16) my[768 + lane] = ss;
    LAS int* lcnt = (LAS int*)(ldsb + 4 * 32768 + 1024);
    if (threadIdx.x < 32) lcnt[threadIdx.x] = 0;
    int pa = 0, pb = 0, ea_ = 0, eb_ = 0; float w1_ = 0.f, w2_ = 0.f, rs_ = 0.f;
    LDS_WAIT();
    __syncthreads();
    ROUTE_MID_HOOK();
    if (par == 0 && lane < 16) {
        LAS const float* l0 = sc + lane * 48; LAS const float* l1 = sc + 800 + lane * 48;
        const float rs = __builtin_amdgcn_rsqf((sc[768 + lane] + sc[800 + 768 + lane]) * (1.0f / 1024.0f) + EPS);
#define LG(j) (l0[j] + l1[j])
        const int t = tile * 16 + lane;
        const float* bg = P.in[16]; const float* br = P.in[18];
        float gl[4]; int gs = 0; float gm;
#pragma unroll
        for (int j = 0; j < 4; ++j) gl[j] = LG(j) * rs + bg[j];
        gm = gl[0];
#pragma unroll
        for (int j = 1; j < 4; ++j) if (gl[j] > gm) { gm = gl[j]; gs = j; }
        float gsum = 0.f;
#pragma unroll
        for (int j = 0; j < 4; ++j) gsum += __expf(gl[j] - gm);
        const float psel = 1.0f / gsum;
        float e1 = -INFINITY, e2 = -INFINITY; int i1 = 0, i2 = 0;
#pragma unroll
        for (int j = 0; j < 8; ++j) {
            const float v = LG(4 + gs * 8 + j) * rs + br[gs * 8 + j];
            if (v > e1) { e2 = e1; i2 = i1; e1 = v; i1 = j; } else if (v > e2) { e2 = v; i2 = j; }
        }
        const float x2 = __expf(e2 - e1), w1 = psel / (1.0f + x2), w2 = psel * x2 / (1.0f + x2);
        const int ea = gs * 8 + i1, eb = gs * 8 + i2;
        pa = (int)__hip_atomic_fetch_add(lcnt + ea, 1, __ATOMIC_RELAXED, __HIP_MEMORY_SCOPE_WORKGROUP); pb = (int)__hip_atomic_fetch_add(lcnt + eb, 1, __ATOMIC_RELAXED, __HIP_MEMORY_SCOPE_WORKGROUP);
        ea_ = ea; eb_ = eb; w1_ = w1; w2_ = w2; rs_ = rs;
        ((int*)(P.ws + WS_TOKE))[2 * t] = ea; ((int*)(P.ws + WS_TOKE))[2 * t + 1] = eb;
        ((float*)(P.ws + WS_TOKW))[2 * t] = w1; ((float*)(P.ws + WS_TOKW))[2 * t + 1] = w2;
        ((float*)(P.ws + WS_RS2))[t] = rs;
#undef LG
    }
    LDS_WAIT();
    __syncthreads();
    if (threadIdx.x < 32) { const int c = lcnt[threadIdx.x];
        lcnt[32 + threadIdx.x] = c ? (int)atomicAdd((unsigned*)(P.ws + WS_CTL) + CW_CNT + 64 * threadIdx.x, (unsigned)c) : 0; }
    LDS_WAIT();
    __syncthreads();
    if (par == 0 && lane < 16) { const int t = tile * 16 + lane;
        const int qa = lcnt[32 + ea_] + pa, qb = lcnt[32 + eb_] + pb;
        ((int*)(P.ws + WS_TOKP))[2 * t] = qa; ((int*)(P.ws + WS_TOKP))[2 * t + 1] = qb;
        ((int*)(P.ws + WS_LIST))[ea_ * 16384 + qa] = t; ((int*)(P.ws + WS_LIST))[eb_ * 16384 + qb] = t;
        ((float*)(P.ws + WS_LISTW))[ea_ * 16384 + qa] = w1_; ((float*)(P.ws + WS_LISTW))[eb_ * 16384 + qb] = w2_;
        ((float*)(P.ws + WS_LISTRS))[ea_ * 16384 + qa] = rs_; ((float*)(P.ws + WS_LISTRS))[eb_ * 16384 + qb] = rs_; }
    LDS_WAIT();
    __syncthreads();
}

#ifndef P4A_REP
#define P4A_REP 0
#endif
template <int P4A_PART> DI void phase4a(const Params& P, LAS unsigned char* lds, int gw, int NGW, int wave, int lane) {
    LAS float* scr = (LAS float*)(lds + wave * 16384);
    if (P4A_PART & 1) for (int tile = (gw >> 1); tile < MTOK / 16; tile += (NGW >> 1)) route_tile(P, tile, wave & 1, (LAS float*)(lds + (wave >> 1) * 32768), lane, lds);
    if (!(P4A_PART & 2)) return;
    bf16_t* WGU = (bf16_t*)(P.ws + WS_WGU); bf16_t* WD = (bf16_t*)(P.ws + WS_WD);
    const float* wg = P.in[19]; const float* wu = P.in[20]; const float* wd = P.in[21]; const float* gf = P.in[14];
    constexpr int I_GU = 16 * 16, I_D = 4 * 32, NIT = 32 * (I_GU + I_D);
    struct TItem { const float* src; const float* gn; bf16_t* dst; int stride, ldk; };
    auto mk = [&](int it) { TItem d; const int e = it / (I_GU + I_D), r = it % (I_GU + I_D);
        if (r < I_GU) { const int n0 = (r & 15) * 32, j = n0 >> 8, up = (n0 >> 7) & 1, k0 = (r >> 4) * 64;
            d.src = (up ? wu : wg) + (size_t)e * 1024 * 256 + (size_t)k0 * 256 + 128 * j + (n0 & 127); d.gn = gf + k0; d.stride = 256; d.ldk = 1024;
            d.dst = WGU + (size_t)e * 512 * 1024 + (size_t)n0 * 1024 + k0; }
        else { const int r2 = r - I_GU, k0 = (r2 >> 5) * 64, n0 = (r2 & 31) * 32;
            d.src = wd + (size_t)e * 256 * 1024 + (size_t)k0 * 1024 + n0; d.gn = nullptr; d.stride = 1024; d.ldk = 256;
            d.dst = WD + (size_t)e * 1024 * 256 + (size_t)n0 * 256 + k0; }
        return d; };
#define TI_LOAD(D, V) do { _Pragma("unroll") for (int i = 0; i < 32; ++i) { const int kk = 2 * i + (lane >> 5); \
        V[i] = D.src[(size_t)kk * D.stride + (lane & 31)] * (D.gn ? D.gn[kk] : 1.0f); } } while (0)
#define TI_FIN(D, V) do { _Pragma("unroll") for (int i = 0; i < 32; ++i) scr[(2 * i + (lane >> 5)) * 33 + (lane & 31)] = V[i]; \
        LDS_WAIT(); const int c_ = lane & 7; \
        _Pragma("unroll") for (int j = 0; j < 4; ++j) { const int n_ = (lane >> 3) + 8 * j; const LAS float* s_ = scr + (8 * c_) * 33 + n_; \
            u32x4 o_; o_.x = pk2(s_[0 * 33], s_[1 * 33]); o_.y = pk2(s_[2 * 33], s_[3 * 33]); o_.z = pk2(s_[4 * 33], s_[5 * 33]); o_.w = pk2(s_[6 * 33], s_[7 * 33]); \
            *(u32x4*)(D.dst + (size_t)n_ * D.ldk + 8 * c_) = o_; } \
        LDS_WAIT(); } while (0)
    for (int rp_ = 0; rp_ < (P4A_REP ? 2 : 1); ++rp_) {
        float va[32], vb[32];
        int it = gw;
        if (it < NIT) { TItem da = mk(it); TI_LOAD(da, va);
            for (;;) {
                const int itb = it + NGW; TItem db = da; const bool hb = itb < NIT;
                if (hb) { db = mk(itb); TI_LOAD(db, vb); }
                TI_FIN(da, va);
                if (!hb) break;
                it = itb + NGW; const bool ha = it < NIT;
                if (ha) { da = mk(it); TI_LOAD(da, va); }
                TI_FIN(db, vb);
                if (!ha) break;
            }
        }
    }
#undef TI_LOAD
#undef TI_FIN
}

DI void expert_layout(const Params& P, int lane, int& cnt, int& base, int& tend) {
    const unsigned* c = (const unsigned*)(P.ws + WS_CTL) + CW_CNT;
    cnt = (lane < 32) ? (int)__hip_atomic_load(c + 64 * lane, __ATOMIC_RELAXED, __HIP_MEMORY_SCOPE_AGENT) : 0;
    const int tiles = (cnt + 255) >> 8;
    int inc = 0;
#pragma unroll
    for (int i = 0; i < 32; ++i) { const int ti = __builtin_amdgcn_readlane(tiles, i); inc += (i <= lane) ? ti : 0; }
    tend = inc; base = (inc - tiles) << 8;
}

DI void phase4b(const Params& P, int gw, int NGW, int lane) {
    int cnt, base, tend; expert_layout(P, lane, cnt, base, tend);
    bf16_t* XS = (bf16_t*)(P.ws + WS_XS); float* SLOTW = (float*)(P.ws + WS_SLOTW);
    const int* TOKE = (const int*)(P.ws + WS_TOKE); const float* TOKW = (const float*)(P.ws + WS_TOKW); int* TOKP = (int*)(P.ws + WS_TOKP); const float* RS2 = (const float*)(P.ws + WS_RS2);
    for (int t = gw; t < MTOK; t += NGW) {
        const f32x4* hr = (const f32x4*)(P.out + (size_t)t * 1024);
        const float rs = RS2[t];
        u32x2 w[4];
#pragma unroll
        for (int j = 0; j < 4; ++j) { const f32x4 v = hr[64 * j + lane]; w[j] = (u32x2){pk2(v.x * rs, v.y * rs), pk2(v.z * rs, v.w * rs)}; }
#pragma unroll
        for (int k = 0; k < 2; ++k) {
            const int e = __builtin_amdgcn_readfirstlane(TOKE[2 * t + k]), slot = __builtin_amdgcn_readlane(base, e) + TOKP[2 * t + k];
            u32x2* orow = (u32x2*)(XS + (size_t)slot * 1024);
#pragma unroll
            for (int j = 0; j < 4; ++j) orow[64 * j + lane] = w[j];
            if (lane == 0) { SLOTW[slot] = TOKW[2 * t + k]; TOKP[2 * t + k] = slot; }
        }
    }
    for (int e = 0; e < 32; ++e) {
        const int ce = __builtin_amdgcn_readlane(cnt, e), be = __builtin_amdgcn_readlane(base, e), end = be + (((ce + 255) >> 8) << 8);
        for (int r = be + ce + gw; r < end; r += NGW) { u32x2* orow = (u32x2*)(XS + (size_t)r * 1024);
#pragma unroll
            for (int j = 0; j < 4; ++j) orow[64 * j + lane] = (u32x2){0u, 0u};
            if (lane == 0) SLOTW[r] = 0.f; }
    }
}

struct GroupedOrder {
    int tend; int total; int G, c, NS; int cnt, base; const int* LIST;
    DI unsigned rowoff(const pg8::Unit& u, int r) const {
        const int e = __builtin_amdgcn_readfirstlane(u.pn >> NS), ce = __builtin_amdgcn_readlane(cnt, e), t0 = __builtin_amdgcn_readlane(base, e) >> 8;
        const int pos = (u.pm - t0) * 256 + r;
        const int tok = pos < ce ? LIST[e * 16384 + pos] : 0;
        return (unsigned)tok * 2048u;
    }
    DI bool next(int i, pg8::Unit& u) const {
        const int L = i * G + c; if (L >= (total << NS)) return false;
        const int mt = L >> NS, j = L & ((1 << NS) - 1);
        const int e = __builtin_popcountll(__ballot(((int)(threadIdx.x & 63) < 32) && tend <= mt));
        u.pm = mt; u.pn = (e << NS) + j; return true;
    }
    DI void a_ready(const pg8::Unit&) const {}
    DI void done(const pg8::Unit&) const {}
};
struct EpiGateUp {
    static constexpr bool PERM = true, AFTER_DRAIN = false;
    const float* LISTW; const float* LISTRS; bf16_t* YS; int cnt, base;
    DI void operator()(const pg8::f32x4 (&acc)[2][2][4][2], const pg8::Unit& u, int wr, int wc, int fr, int fq) const {
        const int f0 = (u.pn & 1) * 128 + wc * 32 + fq * 8;
        const int e = __builtin_amdgcn_readfirstlane(u.pn >> 1), ce = __builtin_amdgcn_readlane(cnt, e), t0 = __builtin_amdgcn_readlane(base, e) >> 8;
#pragma unroll
        for (int ai = 0; ai < 2; ++ai)
#pragma unroll
            for (int m = 0; m < 4; ++m) {
                const int r = ai * 128 + wr * 64 + m * 16 + fr, row = u.pm * 256 + r, pos = (u.pm - t0) * 256 + r;
                const bool ok = pos < ce;
                const float cw = ok ? LISTW[e * 16384 + pos] : 0.f, rs = ok ? LISTRS[e * 16384 + pos] : 0.f, cr = cw * rs;
                float a[8];
#pragma unroll
                for (int i = 0; i < 4; ++i) {
                    const float g0 = acc[ai][0][m][0][i] * rs, g1 = acc[ai][0][m][1][i] * rs;
                    a[i] = g0 * __builtin_amdgcn_rcpf(1.0f + __expf(-g0)) * acc[ai][1][m][0][i] * cr; a[4 + i] = g1 * __builtin_amdgcn_rcpf(1.0f + __expf(-g1)) * acc[ai][1][m][1][i] * cr;
                }
                *(u32x4*)(YS + (size_t)row * 256 + f0) = (u32x4){pk2(a[0], a[1]), pk2(a[2], a[3]), pk2(a[4], a[5]), pk2(a[6], a[7])};
            }
    }
};
struct EpiDown {
    static constexpr bool PERM = true, AFTER_DRAIN = false;
    bf16_t* YO;
    DI void operator()(const pg8::f32x4 (&acc)[2][2][4][2], const pg8::Unit& u, int wr, int wc, int fr, int fq) const {
        const int c0 = (u.pn & 3) * 256 + wc * 32 + fq * 8;
#pragma unroll
        for (int ai = 0; ai < 2; ++ai)
#pragma unroll
            for (int m = 0; m < 4; ++m) {
                bf16_t* rowp = YO + (size_t)(u.pm * 256 + ai * 128 + wr * 64 + m * 16 + fr) * 1024 + c0;
#pragma unroll
                for (int bj = 0; bj < 2; ++bj) { const pg8::f32x4 v0 = acc[ai][bj][m][0], v1 = acc[ai][bj][m][1];
                    *(u32x4*)(rowp + bj * 128) = (u32x4){pk2(v0[0], v0[1]), pk2(v0[2], v0[3]), pk2(v1[0], v1[1]), pk2(v1[2], v1[3])}; }
            }
    }
};

DI void phase7(const Params& P, int gw, int NGW, int lane) {
    int cnt_, base_, tend_; expert_layout(P, lane, cnt_, base_, tend_);
    const bf16_t* YO = (const bf16_t*)(P.ws + WS_YO); const int* TOKP = (const int*)(P.ws + WS_TOKP); const int* TOKE = (const int*)(P.ws + WS_TOKE); const f32x4* nf = (const f32x4*)P.in[22];
    f32x4 nfv[4];
#pragma unroll
    for (int j = 0; j < 4; ++j) nfv[j] = nf[64 * j + lane];
    for (int t0 = gw; t0 < MTOK; t0 += 2 * NGW) {
        f32x4 v[2][4]; u32x2 ya[2][4], yb[2][4];
#pragma unroll
        for (int r = 0; r < 2; ++r) { const int t = (t0 + r * NGW) < MTOK ? (t0 + r * NGW) : t0;
            const f32x4* hr = (const f32x4*)(P.out + (size_t)t * 1024);
            const int e0 = __builtin_amdgcn_readfirstlane(TOKE[2 * t]), e1 = __builtin_amdgcn_readfirstlane(TOKE[2 * t + 1]);
            const int s0 = __builtin_amdgcn_readlane(base_, e0) + TOKP[2 * t], s1 = __builtin_amdgcn_readlane(base_, e1) + TOKP[2 * t + 1];
            const u32x2* y0 = (const u32x2*)(YO + (size_t)s0 * 1024); const u32x2* y1 = (const u32x2*)(YO + (size_t)s1 * 1024);
#pragma unroll
            for (int j = 0; j < 4; ++j) { v[r][j] = hr[64 * j + lane]; ya[r][j] = y0[64 * j + lane]; yb[r][j] = y1[64 * j + lane]; } }
#pragma unroll
        for (int r = 0; r < 2; ++r) { const int t = t0 + r * NGW;
            if (t < MTOK) {
                float s = 0.f;
#pragma unroll
                for (int j = 0; j < 4; ++j) { const u32x2 a = ya[r][j], c = yb[r][j];
                    v[r][j].x += __uint_as_float(a.x << 16) + __uint_as_float(c.x << 16); v[r][j].y += __uint_as_float(a.x & 0xffff0000u) + __uint_as_float(c.x & 0xffff0000u);
                    v[r][j].z += __uint_as_float(a.y << 16) + __uint_as_float(c.y << 16); v[r][j].w += __uint_as_float(a.y & 0xffff0000u) + __uint_as_float(c.y & 0xffff0000u);
                    s += (v[r][j].x * v[r][j].x + v[r][j].y * v[r][j].y) + (v[r][j].z * v[r][j].z + v[r][j].w * v[r][j].w); }
                s = wave_sum(s);
                const float rs = __builtin_amdgcn_rsqf(s * (1.0f / 1024.0f) + EPS);
                f32x4* hw = (f32x4*)(P.out + (size_t)t * 1024);
#pragma unroll
                for (int j = 0; j < 4; ++j) hw[64 * j + lane] = v[r][j] * rs * nfv[j];
            } }
    }
}

struct EpiNull { static constexpr bool PERM = true, AFTER_DRAIN = false; float* d;
    DI void operator()(const pg8::f32x4 (&acc)[2][2][4][2], const pg8::Unit& u, int wr, int wc, int fr, int fq) const {
        pg8::f32x4 s = acc[0][0][0][0];
#pragma unroll
        for (int ai = 0; ai < 2; ++ai)
#pragma unroll
            for (int bj = 0; bj < 2; ++bj)
#pragma unroll
                for (int m = 0; m < 4; ++m)
#pragma unroll
                    for (int n = 0; n < 2; ++n) s += acc[ai][bj][m][n];
        if (s[0] == 12345.678f) d[threadIdx.x] = s[1] + s[2] + s[3]; } };
#ifndef PHMASK
#define PHMASK 2047
#endif
#ifndef P1_STAGGER_TICKS
#define P1_STAGGER_TICKS 0
#endif
#ifndef ATT_VAR
#define ATT_VAR 0
#endif
#ifndef REPMASK
#define REPMASK 0
#endif
#define REP(bit) for (int rep_ = 0; rep_ < ((REPMASK & (bit)) ? 2 : 1); ++rep_)
#define REPSYNC(bit) if ((REPMASK & (bit)) && rep_ == 0) GRID_BAR()
typedef const __attribute__((address_space(4))) Params* KParams;
DI Params load_params(KParams kp) { Params p;
#pragma unroll
    for (int i = 0; i < 23; ++i) p.in[i] = kp->in[i];
    p.out = kp->out; p.ws = kp->ws; return p; }
__global__ void __launch_bounds__(NTHREADS, 2) hymba_fwd(Params Pin) {
    extern __shared__ __attribute__((aligned(16))) unsigned char lds_raw[];
    LAS unsigned char* lds = (LAS unsigned char*)lds_raw;
    cg::grid_group grid = cg::this_grid();
    volatile LAS unsigned* bst = (volatile LAS unsigned*)(lds + LDS_BYTES - 64);
    if (threadIdx.x < 2) bst[threadIdx.x] = 0u;
    __syncthreads();
    const XcdBarrier xbar = xcd_barrier_post((unsigned*)(Pin.ws + WS_CTL) + CW_BAR, bst);
#ifndef TPROBE
#define TPROBE (-1)
#endif
#ifndef TPROBE_A
#define TPROBE_A TPROBE
#define TPROBE_B (TPROBE + 1)
#endif
    int nstamp_ = 0;
#define STAMP() do { if (TPROBE >= 0) { if (blockIdx.x == 0 && threadIdx.x == 0) __hip_atomic_store((unsigned long long*)(Pin.ws + WS_CTL + 65536) + nstamp_, (unsigned long long)__builtin_amdgcn_s_memrealtime(), __ATOMIC_RELAXED, __HIP_MEMORY_SCOPE_AGENT); ++nstamp_; } } while (0)
#define GRID_BAR() do { xcd_barrier(xbar); STAMP(); } while (0)
    STAMP();
    const int G = gridDim.x, blk = blockIdx.x, NGW = G * NWAVES, NGT = G * NTHREADS;
#define PHASE_IDS() KParams kp_ = (KParams)__builtin_amdgcn_kernarg_segment_ptr(); asm volatile("" : "+s"(kp_)); const Params P = load_params(kp_); int tid = threadIdx.x; asm volatile("" : "+v"(tid)); const int lane = tid & 63, wave = __builtin_amdgcn_readfirstlane(tid >> 6), gw = blk * NWAVES + wave, gtid = blk * NTHREADS + tid; (void)lane; (void)gw; (void)gtid; (void)wave

    REP(1) { if (PHMASK & 1) { PHASE_IDS(); phase0(P, lds, gw, NGW, gtid, NGT, wave, lane); } REPSYNC(1); }
    GRID_BAR();
    REP(2) { if (PHMASK & 2) { PHASE_IDS();
        pg8::Gemm g{(const bf16_t*)(P.ws + WS_XB), (const bf16_t*)(P.ws + WS_WINT), MROWS, NPROJ, 1024};
        if (P1_STAGGER_TICKS > 0 && (blk & 1)) { const unsigned long long s0_ = __builtin_amdgcn_s_memrealtime(); while (__builtin_amdgcn_s_memrealtime() - s0_ < (unsigned long long)P1_STAGGER_TICKS) __builtin_amdgcn_s_sleep(8); }
        pg8::StaticOrder S; S.init(MROWS, NPROJ, G, blk);
        EpiInProj E{(const float*)(P.ws + WS_RS1), (const float*)(P.ws + WS_COS), (const float*)(P.ws + WS_SIN), P.in[10], P.in[11],
                    (bf16_t*)(P.ws + WS_QB), (bf16_t*)(P.ws + WS_KT), (bf16_t*)(P.ws + WS_VT), (bf16_t*)(P.ws + WS_QKVB), (bf16_t*)(P.ws + WS_ZB), (float*)(P.ws + WS_GB)};
        if (rep_ == 0) pg8::gemm_phase<EpiInProj, pg8::StaticOrder, true, true>(lds, g, S, E);
        else { EpiNull EN{(float*)(P.ws + WS_DUMP)}; pg8::gemm_phase<EpiNull, pg8::StaticOrder, true, true>(lds, g, S, EN); }
    } REPSYNC(2); }
    GRID_BAR();
    REP(4) { if (PHMASK & 4) { PHASE_IDS(); gdn_prep_phase(P, lds, blk, G, wave, lane); } REPSYNC(4); }
    {
        unsigned* prep = (unsigned*)(Pin.ws + WS_CTL) + CW_PREP;
        asm volatile("s_waitcnt vmcnt(0)" ::: "memory");
        __syncthreads();
        if (threadIdx.x == 0) { __builtin_amdgcn_fence(__ATOMIC_RELEASE, "agent"); asm volatile("s_waitcnt vmcnt(0)" ::: "memory");
            __hip_atomic_fetch_add(prep, 1u, __ATOMIC_RELAXED, __HIP_MEMORY_SCOPE_AGENT); }
        if (blk < 16) {
            if (threadIdx.x == 0) { unsigned sp = 0;
                while (__hip_atomic_load(prep, __ATOMIC_RELAXED, __HIP_MEMORY_SCOPE_AGENT) < (unsigned)G) { __builtin_amdgcn_s_sleep(2); if (++sp > (1u << 22)) break; }
                __builtin_amdgcn_fence(__ATOMIC_ACQUIRE, "agent"); asm volatile("s_waitcnt vmcnt(0)" ::: "memory"); }
            __syncthreads();
        }
    }
    REP(8) { if ((PHMASK & 8) && blk < 16) { PHASE_IDS(); gdn_scan(P, lds, blk, tid, wave, lane); } }
    REP(16) {
    if (PHMASK & 16) { PHASE_IDS(); if (rep_ == 0) attn_phase<0>(P, lds, tid, wave, lane); else attn_phase<ATT_VAR>(P, lds, tid, wave, lane); }
    if ((REPMASK & 16) && rep_ == 0) { GRID_BAR(); if (blk == 0 && threadIdx.x < 8) { PHASE_IDS(); __hip_atomic_store((unsigned*)(P.ws + WS_CTL) + CW_ATTQ + 64 * threadIdx.x, 0u, __ATOMIC_RELAXED, __HIP_MEMORY_SCOPE_AGENT); } GRID_BAR(); }
    }
    GRID_BAR();
    REP(32) { if (PHMASK & 32) { PHASE_IDS();
        pg8::Gemm g{(const bf16_t*)(P.ws + WS_MIX), (const bf16_t*)(P.ws + WS_WOUT), MTOK, 1024, 1024};
        pg8::StaticOrder S; S.init(MTOK, 1024, G, blk);
        EpiOutProj E{P.in[0], P.out, (bf16_t*)(P.ws + WS_U2)};
        pg8::gemm_phase<EpiOutProj, pg8::StaticOrder, true, true>(lds, g, S, E);
    } REPSYNC(32); }
    GRID_BAR();
#ifdef P4A_SPLIT
    if (PHMASK & 64) { PHASE_IDS(); phase4a<1>(P, lds, gw, NGW, wave, lane); }
    GRID_BAR();
    if (PHMASK & 64) { PHASE_IDS(); phase4a<2>(P, lds, gw, NGW, wave, lane); }
#else
    if (PHMASK & 64) { PHASE_IDS(); phase4a<3>(P, lds, gw, NGW, wave, lane); }
#endif
    GRID_BAR();
    int cnt, base, tend, total; { PHASE_IDS(); expert_layout(P, lane, cnt, base, tend); total = __builtin_amdgcn_readlane(tend, 31); }
    REP(256) { if (PHMASK & 256) { PHASE_IDS();
        pg8::Gemm g{(const bf16_t*)(P.ws + WS_U2), (const bf16_t*)(P.ws + WS_WGU), XS_ROWS, 32 * 512, 1024};
        GroupedOrder S{tend, total, G, blk, 1, cnt, base, (const int*)(P.ws + WS_LIST)};
        EpiGateUp E{(const float*)(P.ws + WS_LISTW), (const float*)(P.ws + WS_LISTRS), (bf16_t*)(P.ws + WS_YS), cnt, base};
        pg8::gemm_phase_g<EpiGateUp, GroupedOrder, true, true>(lds, g, S, E);
    } REPSYNC(256); }
    GRID_BAR();
    REP(512) { if (PHMASK & 512) { PHASE_IDS();
        int kd = 256; asm volatile("" : "+s"(kd));
        pg8::Gemm g{(const bf16_t*)(P.ws + WS_YS), (const bf16_t*)(P.ws + WS_WD), XS_ROWS, 32 * 1024, kd};
        GroupedOrder S{tend, total, G, blk, 2, cnt, base, (const int*)(P.ws + WS_LIST)};
        EpiDown E{(bf16_t*)(P.ws + WS_YO)};
        pg8::gemm_phase<EpiDown, GroupedOrder, true, true>(lds, g, S, E);
    } REPSYNC(512); }
    GRID_BAR();
    if (PHMASK & 1024) { PHASE_IDS(); phase7(P, gw, NGW, lane); }
    if (TPROBE >= 0) {
        GRID_BAR();
        const unsigned long long* st = (const unsigned long long*)(Pin.ws + WS_CTL + 65536);
        const unsigned long long t0 = __hip_atomic_load(st + TPROBE_A, __ATOMIC_RELAXED, __HIP_MEMORY_SCOPE_AGENT), t1 = __hip_atomic_load(st + TPROBE_B, __ATOMIC_RELAXED, __HIP_MEMORY_SCOPE_AGENT);
        const unsigned long long dt = (t1 - t0) * 4ull, s0 = __builtin_amdgcn_s_memrealtime();
        while (__builtin_amdgcn_s_memrealtime() - s0 < dt) __builtin_amdgcn_s_sleep(8);
    }
}

extern "C" void kernel_launch(void* const* d_in, const int* in_sizes, int n_in, void* d_out, int out_size, void* d_ws, size_t ws_size, hipStream_t stream) {
    static int grid_blocks = 0;
    if (grid_blocks == 0) {
        if (n_in != 23 || out_size != MTOK * DMODEL || ws_size < WS_END) { fprintf(stderr, "kernel_launch: unexpected shapes (n_in %d out %d ws %zu)\n", n_in, out_size, ws_size); grid_blocks = -1; return; }
        int dev = 0, cus = 0, per_cu = 0;
        hipGetDevice(&dev);
        hipDeviceGetAttribute(&cus, hipDeviceAttributeMultiprocessorCount, dev);
        hipFuncSetAttribute((const void*)hymba_fwd, hipFuncAttributeMaxDynamicSharedMemorySize, LDS_BYTES);
        hipOccupancyMaxActiveBlocksPerMultiprocessor(&per_cu, (const void*)hymba_fwd, NTHREADS, LDS_BYTES);
        if (per_cu < 1) { fprintf(stderr, "kernel_launch: occupancy query says %d blocks/CU\n", per_cu); per_cu = 1; }
        grid_blocks = cus;
        (void)hipGetLastError();
    }
    if (grid_blocks < 0) return;
    hipMemsetAsync((char*)d_ws + WS_CTL, 0, CTL_BYTES, stream);
    Params p{};
    for (int i = 0; i < 23; ++i) p.in[i] = (const float*)d_in[i];
    p.out = (float*)d_out; p.ws = (unsigned char*)d_ws;
    void* args[] = {&p};
    hipError_t e = hipLaunchCooperativeKernel((const void*)hymba_fwd, dim3(grid_blocks), dim3(NTHREADS), args, LDS_BYTES, stream);
    if (e != hipSuccess) fprintf(stderr, "cooperative launch failed: %s (grid %d)\n", hipGetErrorString(e), grid_blocks);
}
```

```cpp
#include <hip/hip_runtime.h>
#include <hip/hip_cooperative_groups.h>
#include <cstdio>
#include <cstdint>
namespace cg = cooperative_groups;
#ifndef PG8_EPI_AGAIN
#define PG8_EPI_AGAIN(x) do {} while (0)
#endif
namespace pg8 {
#define PG8_LAS __attribute__((address_space(3)))
typedef unsigned short bf16_t;
typedef short bf16x8 __attribute__((ext_vector_type(8)));
typedef float f32x4 __attribute__((ext_vector_type(4)));
typedef unsigned u32x4 __attribute__((ext_vector_type(4)));
constexpr int BM = 256, BK = 64, HALF = 128, HTB = HALF * BK * 2  , STAGE_BYTES = 8 * HTB, NXCD = 8, WGM = 8;

__host__ __device__ __forceinline__ int lds_byte(int r, int c) { const int st = (r >> 4) * 2 + (c >> 5), rr = r & 15, cc = c & 31, ob = rr * 64 + cc * 2; return st * 1024 + (ob ^ (((ob >> 9) & 1) << 5)); }
__host__ __device__ __forceinline__ void stage_rc(int b, int& R, int& C) { const int st = b / 1024, sb = b % 1024, swz = sb ^ (((sb >> 9) & 1) << 5); R = (st >> 1) * 16 + swz / 64; C = (st & 1) * 32 + (swz % 64) / 2; }
__host__ __device__ __forceinline__ int perm32(int rho) { const int n = rho >> 4, i = rho & 15; return 8 * (i >> 2) + 4 * n + (i & 3); }

struct Unit { int pm, pn; };
struct Gemm { const bf16_t* A; const bf16_t* Bt; int M, N, K; };

struct StaticOrder {
    int nM, nN, nwg, G, c;
    __host__ __device__ void init(int M, int N, int G_, int c_) { nM = M / BM; nN = N / BM; nwg = nM * nN; G = G_; c = c_; }
    __host__ __device__ bool next(int i, Unit& u) const {
        const long L = (long)i * G + c; if (L >= nwg) return false;
        int wgid = (int)L; { const int q = nwg / NXCD, r = nwg % NXCD, xcd = wgid % NXCD, off = wgid / NXCD; wgid = (xcd < r ? xcd * (q + 1) : r * (q + 1) + (xcd - r) * q) + off; }
        const int nig = WGM * nN, gid = wgid / nig, fm = gid * WGM, gsz = (nM - fm) < WGM ? (nM - fm) : WGM;
        u.pm = fm + ((wgid % nig) % gsz); u.pn = (wgid % nig) / gsz; return true;
    }
    __device__ __forceinline__ void a_ready(const Unit&) const {}
    __device__ __forceinline__ void done(const Unit&) const {}
};

__device__ __forceinline__ unsigned cvt_pk_bf16(float lo, float hi) { unsigned r; asm volatile("v_cvt_pk_bf16_f32 %0, %1, %2" : "=v"(r) : "v"(lo), "v"(hi)); return r; }
typedef float f32x2 __attribute__((ext_vector_type(2)));
template <class Epi, class Sched, bool ALIGN_EPI = false, bool SP2 = false>
__device__ __forceinline__ void gemm_phase(PG8_LAS unsigned char* lds, const Gemm g, const Sched& S, const Epi& E) {
    int tid_o = threadIdx.x; asm volatile("" : "+v"(tid_o));
    const int tid = tid_o, wid = __builtin_amdgcn_readfirstlane(tid >> 6), lane = tid & 63, wr = wid >> 2, wc = wid & 3, fr = lane & 15, fq = lane >> 4;
    const int K = g.K, nt = K / BK;
    unsigned voffA[2], voffB[2];
#pragma unroll
    for (int i = 0; i < 2; ++i) { int R, C; stage_rc(tid * 16 + i * 8192, R, C); const int Rb = Epi::PERM ? ((R & ~31) + perm32(R & 31)) : R;
        voffA[i] = (unsigned)(R * K + C) * 2u; voffB[i] = (unsigned)(Rb * K + C) * 2u; }
    const size_t kstep = (size_t)(BK * 2);
    const size_t hstep = (size_t)HALF * K * 2;
    const size_t tstep = 2 * hstep;
    const unsigned ldsw = (unsigned)wid * 1024u;
    const int aoff = lds_byte(wr * 64 + fr, fq * 8), boff = lds_byte(wc * 32 + fr, fq * 8);
#define PG8_SA(b, h) (((b) * 2 + (h)) * HTB)
#define PG8_SB(b, h) ((4 + (b) * 2 + (h)) * HTB)
#define PG8_STAGE(bufoff, gbase, voff) do { _Pragma("unroll") for (int _i = 0; _i < 2; ++_i) \
        __builtin_amdgcn_global_load_lds((const unsigned*)((const char*)(gbase) + (voff)[_i]), (PG8_LAS unsigned*)(lds + (bufoff) + ldsw + _i * 8192), 16, 0, 0); } while (0)
#define PG8_LDA(dst, b, h) do { _Pragma("unroll") for (int m = 0; m < 4; ++m) _Pragma("unroll") for (int k = 0; k < 2; ++k) dst[m][k] = *(const PG8_LAS bf16x8*)(lds + PG8_SA(b, h) + aoff + m * 2048 + k * 1024); } while (0)
#define PG8_LDB(dst, b, h) do { _Pragma("unroll") for (int n = 0; n < 2; ++n) _Pragma("unroll") for (int k = 0; k < 2; ++k) dst[n][k] = *(const PG8_LAS bf16x8*)(lds + PG8_SB(b, h) + boff + n * 2048 + k * 1024); } while (0)
#define PG8_MMA(ai, bj, At, Bt) do { __builtin_amdgcn_s_setprio(1); _Pragma("unroll") for (int m = 0; m < 4; ++m) _Pragma("unroll") for (int n = 0; n < 2; ++n) _Pragma("unroll") for (int k = 0; k < 2; ++k) \
        acc[ai][bj][m][n] = __builtin_amdgcn_mfma_f32_16x16x32_bf16(Bt[n][k], At[m][k], acc[ai][bj][m][n], 0, 0, 0); __builtin_amdgcn_s_setprio(0); } while (0)
#define PG8_WAIT_V(n) asm volatile("s_waitcnt vmcnt(" #n ")" ::: "memory")
#define PG8_WAIT_L(n) asm volatile("s_waitcnt lgkmcnt(" #n ")" ::: "memory")
#define PG8_BAR __builtin_amdgcn_s_barrier()
#define PG8_SCHED __builtin_amdgcn_sched_barrier(0)
    Unit cur, nxt; int ui = 0;
    if (!S.next(0, cur)) return;
    f32x4 acc[2][2][4][2];
#pragma unroll
    for (int a = 0; a < 2; ++a)
#pragma unroll
        for (int b = 0; b < 2; ++b)
#pragma unroll
            for (int m = 0; m < 4; ++m)
#pragma unroll
                for (int n = 0; n < 2; ++n) acc[a][b][m][n] = (f32x4){0.f, 0.f, 0.f, 0.f};
    bf16x8 At[4][2], B0[2][2], B1[2][2];
    const char* cA = (const char*)g.A + (size_t)cur.pm * tstep; const char* cB = (const char*)g.Bt + (size_t)cur.pn * tstep;
    S.a_ready(cur);
    if constexpr (SP2) {
        PG8_STAGE(PG8_SB(0, 0), cB, voffB); PG8_STAGE(PG8_SB(0, 1), cB + hstep, voffB); PG8_STAGE(PG8_SA(0, 0), cA, voffA); PG8_STAGE(PG8_SA(0, 1), cA + hstep, voffA);
        if (wr == 1) PG8_BAR;
        PG8_WAIT_V(2); PG8_BAR;
        PG8_STAGE(PG8_SB(1, 0), cB + kstep, voffB); PG8_STAGE(PG8_SA(1, 0), cA + kstep, voffA); PG8_STAGE(PG8_SB(1, 1), cB + hstep + kstep, voffB);
        PG8_WAIT_V(6); PG8_BAR;
    } else {
        PG8_STAGE(PG8_SB(0, 0), cB, voffB); PG8_STAGE(PG8_SA(0, 0), cA, voffA); PG8_STAGE(PG8_SB(0, 1), cB + hstep, voffB); PG8_STAGE(PG8_SA(0, 1), cA + hstep, voffA);
        if (wr == 1) PG8_BAR;
        PG8_WAIT_V(4); PG8_BAR;
        PG8_STAGE(PG8_SB(1, 0), cB + kstep, voffB); PG8_STAGE(PG8_SA(1, 0), cA + kstep, voffA); PG8_STAGE(PG8_SB(1, 1), cB + hstep + kstep, voffB);
        PG8_WAIT_V(6); PG8_BAR;
    }
    for (;;) {
        const bool has_next = S.next(ui + 1, nxt);
        const char* nA = has_next ? (const char*)g.A + (size_t)nxt.pm * tstep : cA; const char* nB = has_next ? (const char*)g.Bt + (size_t)nxt.pn * tstep : cB;
        for (int t = 0; t < nt; t += 2) {
            const bool last = (t == nt - 2);
            const char* a1 = cA + (size_t)(t + 1) * kstep;
            const char* a2 = last ? nA : cA + (size_t)(t + 2) * kstep; const char* b2 = last ? nB : cB + (size_t)(t + 2) * kstep;
            const char* a3 = a2 + kstep; const char* b3 = b2 + kstep;
            if (last && has_next) S.a_ready(nxt);
            if constexpr (SP2) {
            PG8_LDB(B0, 0, 0); PG8_LDB(B1, 0, 1); PG8_SCHED; PG8_LDA(At, 0, 0); PG8_STAGE(PG8_SA(1, 1), a1 + hstep, voffA);
            PG8_WAIT_V(8); PG8_WAIT_L(0); PG8_BAR; PG8_MMA(0, 0, At, B0); PG8_MMA(0, 1, At, B1); PG8_BAR; PG8_SCHED;
            PG8_LDA(At, 0, 1); PG8_STAGE(PG8_SB(0, 0), b2, voffB); PG8_STAGE(PG8_SB(0, 1), b2 + hstep, voffB); PG8_STAGE(PG8_SA(0, 0), a2, voffA);
            PG8_WAIT_V(8); PG8_WAIT_L(0); PG8_BAR; PG8_MMA(1, 0, At, B0); PG8_MMA(1, 1, At, B1); PG8_BAR; PG8_SCHED;
            PG8_LDB(B0, 1, 0); PG8_LDB(B1, 1, 1); PG8_SCHED; PG8_LDA(At, 1, 0); PG8_STAGE(PG8_SA(0, 1), a2 + hstep, voffA);
            PG8_WAIT_V(8); PG8_WAIT_L(0); PG8_BAR; PG8_MMA(0, 0, At, B0); PG8_MMA(0, 1, At, B1); PG8_BAR; PG8_SCHED;
            PG8_LDA(At, 1, 1); PG8_STAGE(PG8_SB(1, 0), b3, voffB); PG8_STAGE(PG8_SB(1, 1), b3 + hstep, voffB); PG8_STAGE(PG8_SA(1, 0), a3, voffA);
            PG8_WAIT_V(8); PG8_WAIT_L(0); PG8_BAR; PG8_MMA(1, 0, At, B0); PG8_MMA(1, 1, At, B1); PG8_BAR; PG8_SCHED;
            } else {
            PG8_LDB(B0, 0, 0); PG8_SCHED; PG8_LDA(At, 0, 0); PG8_STAGE(PG8_SA(1, 1), a1 + hstep, voffA);
            PG8_WAIT_L(8); PG8_BAR; PG8_WAIT_L(0); PG8_MMA(0, 0, At, B0); PG8_BAR; PG8_SCHED;
            PG8_LDB(B1, 0, 1); PG8_STAGE(PG8_SB(0, 0), b2, voffB);
            PG8_BAR; PG8_WAIT_L(0); PG8_MMA(0, 1, At, B1); PG8_BAR;
            PG8_LDA(At, 0, 1); PG8_STAGE(PG8_SA(0, 0), a2, voffA);
            PG8_BAR; PG8_WAIT_L(0); PG8_MMA(1, 0, At, B0); PG8_BAR; PG8_SCHED;
            PG8_STAGE(PG8_SB(0, 1), b2 + hstep, voffB);
            PG8_WAIT_V(6); PG8_BAR; PG8_MMA(1, 1, At, B1); PG8_BAR;
            PG8_LDB(B0, 1, 0); PG8_SCHED; PG8_LDA(At, 1, 0); PG8_STAGE(PG8_SA(0, 1), a2 + hstep, voffA);
            PG8_WAIT_L(8); PG8_BAR; PG8_WAIT_L(0); PG8_MMA(0, 0, At, B0); PG8_BAR; PG8_SCHED;
            PG8_LDB(B1, 1, 1); PG8_STAGE(PG8_SB(1, 0), b3, voffB);
            PG8_BAR; PG8_WAIT_L(0); PG8_MMA(0, 1, At, B1); PG8_BAR;
            PG8_LDA(At, 1, 1); PG8_STAGE(PG8_SA(1, 0), a3, voffA);
            PG8_BAR; PG8_WAIT_L(0); PG8_MMA(1, 0, At, B0); PG8_BAR; PG8_SCHED;
            PG8_STAGE(PG8_SB(1, 1), b3 + hstep, voffB);
            PG8_WAIT_V(6); PG8_BAR; PG8_MMA(1, 1, At, B1); PG8_BAR;
            }
        }
        if constexpr (ALIGN_EPI) { if (wr == 0) PG8_BAR; }
        if constexpr (!Epi::AFTER_DRAIN) { E(acc, cur, wr, wc, fr, fq); PG8_EPI_AGAIN(E(acc, cur, wr, wc, fr, fq)); S.done(cur); }
        if (!has_next) break;
#pragma unroll
        for (int a = 0; a < 2; ++a)
#pragma unroll
            for (int b = 0; b < 2; ++b)
#pragma unroll
                for (int m = 0; m < 4; ++m)
#pragma unroll
                    for (int n = 0; n < 2; ++n) acc[a][b][m][n] = (f32x4){0.f, 0.f, 0.f, 0.f};
        cur = nxt; cA = nA; cB = nB; ++ui;
        if constexpr (ALIGN_EPI) { if (wr == 1) PG8_BAR; }
    }
    PG8_WAIT_V(0);
    if constexpr (!ALIGN_EPI) { if (wr == 0) PG8_BAR; }
    PG8_BAR;
    if constexpr (Epi::AFTER_DRAIN) { E.fused(acc, cur, wr, wc, fr, fq, lds, wid, lane); S.done(cur); }
#undef PG8_SA
#undef PG8_SB
#undef PG8_STAGE
#undef PG8_LDA
#undef PG8_LDB
#undef PG8_MMA
#undef PG8_WAIT_V
#undef PG8_WAIT_L
#undef PG8_BAR
#undef PG8_SCHED
}
static_assert(true, "gather variant of gemm_phase (SP2 = true only): identical schedule, the A operand's rows are gathered through Sched::rowoff");
template <class Epi, class Sched, bool ALIGN_EPI = false, bool SP2 = false>
__device__ __forceinline__ void gemm_phase_g(PG8_LAS unsigned char* lds, const Gemm g, const Sched& S, const Epi& E) {
    int tid_o = threadIdx.x; asm volatile("" : "+v"(tid_o));
    const int tid = tid_o, wid = __builtin_amdgcn_readfirstlane(tid >> 6), lane = tid & 63, wr = wid >> 2, wc = wid & 3, fr = lane & 15, fq = lane >> 4;
    const int K = g.K, nt = K / BK;
    unsigned voffA[2], voffB[2]; int RA_[2]; unsigned CA_[2];
#pragma unroll
    for (int i = 0; i < 2; ++i) { int R, C; stage_rc(tid * 16 + i * 8192, R, C); const int Rb = Epi::PERM ? ((R & ~31) + perm32(R & 31)) : R;
        voffA[i] = (unsigned)(R * K + C) * 2u; voffB[i] = (unsigned)(Rb * K + C) * 2u; RA_[i] = R; CA_[i] = (unsigned)C * 2u; }
    const size_t kstep = (size_t)(BK * 2);
    const size_t hstep = (size_t)HALF * K * 2;
    const size_t tstep = 2 * hstep;
    const unsigned ldsw = (unsigned)wid * 1024u;
    const int aoff = lds_byte(wr * 64 + fr, fq * 8), boff = lds_byte(wc * 32 + fr, fq * 8);
#define PG8_SA(b, h) (((b) * 2 + (h)) * HTB)
#define PG8_SB(b, h) ((4 + (b) * 2 + (h)) * HTB)
#define PG8_STAGE(bufoff, gbase, voff) do { _Pragma("unroll") for (int _i = 0; _i < 2; ++_i) \
        __builtin_amdgcn_global_load_lds((const unsigned*)((const char*)(gbase) + (voff)[_i]), (PG8_LAS unsigned*)(lds + (bufoff) + ldsw + _i * 8192), 16, 0, 0); } while (0)
#define PG8_LDA(dst, b, h) do { _Pragma("unroll") for (int m = 0; m < 4; ++m) _Pragma("unroll") for (int k = 0; k < 2; ++k) dst[m][k] = *(const PG8_LAS bf16x8*)(lds + PG8_SA(b, h) + aoff + m * 2048 + k * 1024); } while (0)
#define PG8_LDB(dst, b, h) do { _Pragma("unroll") for (int n = 0; n < 2; ++n) _Pragma("unroll") for (int k = 0; k < 2; ++k) dst[n][k] = *(const PG8_LAS bf16x8*)(lds + PG8_SB(b, h) + boff + n * 2048 + k * 1024); } while (0)
#define PG8_MMA(ai, bj, At, Bt) do { __builtin_amdgcn_s_setprio(1); _Pragma("unroll") for (int m = 0; m < 4; ++m) _Pragma("unroll") for (int n = 0; n < 2; ++n) _Pragma("unroll") for (int k = 0; k < 2; ++k) \
        acc[ai][bj][m][n] = __builtin_amdgcn_mfma_f32_16x16x32_bf16(Bt[n][k], At[m][k], acc[ai][bj][m][n], 0, 0, 0); __builtin_amdgcn_s_setprio(0); } while (0)
#define PG8_WAIT_V(n) asm volatile("s_waitcnt vmcnt(" #n ")" ::: "memory")
#define PG8_WAIT_L(n) asm volatile("s_waitcnt lgkmcnt(" #n ")" ::: "memory")
#define PG8_BAR __builtin_amdgcn_s_barrier()
#define PG8_SCHED __builtin_amdgcn_sched_barrier(0)
    Unit cur, nxt; int ui = 0;
    if (!S.next(0, cur)) return;
    f32x4 acc[2][2][4][2];
#pragma unroll
    for (int a = 0; a < 2; ++a)
#pragma unroll
        for (int b = 0; b < 2; ++b)
#pragma unroll
            for (int m = 0; m < 4; ++m)
#pragma unroll
                for (int n = 0; n < 2; ++n) acc[a][b][m][n] = (f32x4){0.f, 0.f, 0.f, 0.f};
    bf16x8 At[4][2], B0[2][2], B1[2][2];
    const char* cA = (const char*)g.A; const char* cB = (const char*)g.Bt + (size_t)cur.pn * tstep;
    unsigned cA0[2], cA1[2], nA0[2], nA1[2];
#pragma unroll
    for (int i = 0; i < 2; ++i) { cA0[i] = S.rowoff(cur, RA_[i]) + CA_[i]; cA1[i] = S.rowoff(cur, 128 + RA_[i]) + CA_[i]; }
    S.a_ready(cur);
    if constexpr (SP2) {
        PG8_STAGE(PG8_SB(0, 0), cB, voffB); PG8_STAGE(PG8_SB(0, 1), cB + hstep, voffB); PG8_STAGE(PG8_SA(0, 0), cA, cA0); PG8_STAGE(PG8_SA(0, 1), cA, cA1);
        if (wr == 1) PG8_BAR;
        PG8_WAIT_V(2); PG8_BAR;
        PG8_STAGE(PG8_SB(1, 0), cB + kstep, voffB); PG8_STAGE(PG8_SA(1, 0), cA + kstep, cA0); PG8_STAGE(PG8_SB(1, 1), cB + hstep + kstep, voffB);
        PG8_WAIT_V(6); PG8_BAR;
    } else {
        PG8_STAGE(PG8_SB(0, 0), cB, voffB); PG8_STAGE(PG8_SA(0, 0), cA, voffA); PG8_STAGE(PG8_SB(0, 1), cB + hstep, voffB); PG8_STAGE(PG8_SA(0, 1), cA + hstep, voffA);
        if (wr == 1) PG8_BAR;
        PG8_WAIT_V(4); PG8_BAR;
        PG8_STAGE(PG8_SB(1, 0), cB + kstep, voffB); PG8_STAGE(PG8_SA(1, 0), cA + kstep, voffA); PG8_STAGE(PG8_SB(1, 1), cB + hstep + kstep, voffB);
        PG8_WAIT_V(6); PG8_BAR;
    }
    for (;;) {
        const bool has_next = S.next(ui + 1, nxt);
        const char* nA = cA; const char* nB = has_next ? (const char*)g.Bt + (size_t)nxt.pn * tstep : cB;
#pragma unroll
        for (int i = 0; i < 2; ++i) { nA0[i] = has_next ? S.rowoff(nxt, RA_[i]) + CA_[i] : cA0[i]; nA1[i] = has_next ? S.rowoff(nxt, 128 + RA_[i]) + CA_[i] : cA1[i]; }
        for (int t = 0; t < nt; t += 2) {
            const bool last = (t == nt - 2);
            const char* a1 = cA + (size_t)(t + 1) * kstep;
            const char* a2 = last ? nA : cA + (size_t)(t + 2) * kstep; const char* b2 = last ? nB : cB + (size_t)(t + 2) * kstep;
            const char* a3 = a2 + kstep; const char* b3 = b2 + kstep;
            unsigned sA0[2], sA1[2];
#pragma unroll
            for (int i = 0; i < 2; ++i) { sA0[i] = last ? nA0[i] : cA0[i]; sA1[i] = last ? nA1[i] : cA1[i]; }
            if (last && has_next) S.a_ready(nxt);
            if constexpr (SP2) {
            PG8_LDB(B0, 0, 0); PG8_LDB(B1, 0, 1); PG8_SCHED; PG8_LDA(At, 0, 0); PG8_STAGE(PG8_SA(1, 1), a1, cA1);
            PG8_WAIT_V(8); PG8_WAIT_L(0); PG8_BAR; PG8_MMA(0, 0, At, B0); PG8_MMA(0, 1, At, B1); PG8_BAR; PG8_SCHED;
            PG8_LDA(At, 0, 1); PG8_STAGE(PG8_SB(0, 0), b2, voffB); PG8_STAGE(PG8_SB(0, 1), b2 + hstep, voffB); PG8_STAGE(PG8_SA(0, 0), a2, sA0);
            PG8_WAIT_V(8); PG8_WAIT_L(0); PG8_BAR; PG8_MMA(1, 0, At, B0); PG8_MMA(1, 1, At, B1); PG8_BAR; PG8_SCHED;
            PG8_LDB(B0, 1, 0); PG8_LDB(B1, 1, 1); PG8_SCHED; PG8_LDA(At, 1, 0); PG8_STAGE(PG8_SA(0, 1), a2, sA1);
            PG8_WAIT_V(8); PG8_WAIT_L(0); PG8_BAR; PG8_MMA(0, 0, At, B0); PG8_MMA(0, 1, At, B1); PG8_BAR; PG8_SCHED;
            PG8_LDA(At, 1, 1); PG8_STAGE(PG8_SB(1, 0), b3, voffB); PG8_STAGE(PG8_SB(1, 1), b3 + hstep, voffB); PG8_STAGE(PG8_SA(1, 0), a3, sA0);
            PG8_WAIT_V(8); PG8_WAIT_L(0); PG8_BAR; PG8_MMA(1, 0, At, B0); PG8_MMA(1, 1, At, B1); PG8_BAR; PG8_SCHED;
            } else {
            PG8_LDB(B0, 0, 0); PG8_SCHED; PG8_LDA(At, 0, 0); PG8_STAGE(PG8_SA(1, 1), a1 + hstep, voffA);
            PG8_WAIT_L(8); PG8_BAR; PG8_WAIT_L(0); PG8_MMA(0, 0, At, B0); PG8_BAR; PG8_SCHED;
            PG8_LDB(B1, 0, 1); PG8_STAGE(PG8_SB(0, 0), b2, voffB);
            PG8_BAR; PG8_WAIT_L(0); PG8_MMA(0, 1, At, B1); PG8_BAR;
            PG8_LDA(At, 0, 1); PG8_STAGE(PG8_SA(0, 0), a2, voffA);
            PG8_BAR; PG8_WAIT_L(0); PG8_MMA(1, 0, At, B0); PG8_BAR; PG8_SCHED;
            PG8_STAGE(PG8_SB(0, 1), b2 + hstep, voffB);
            PG8_WAIT_V(6); PG8_BAR; PG8_MMA(1, 1, At, B1); PG8_BAR;
            PG8_LDB(B0, 1, 0); PG8_SCHED; PG8_LDA(At, 1, 0); PG8_STAGE(PG8_SA(0, 1), a2 + hstep, voffA);
            PG8_WAIT_L(8); PG8_BAR; PG8_WAIT_L(0); PG8_MMA(0, 0, At, B0); PG8_BAR; PG8_SCHED;
            PG8_LDB(B1, 1, 1); PG8_STAGE(PG8_SB(1, 0), b3, voffB);
            PG8_BAR; PG8_WAIT_L(0); PG8_MMA(0, 1, At, B1); PG8_BAR;
            PG8_LDA(At, 1, 1); PG8_STAGE(PG8_SA(1, 0), a3, voffA);
            PG8_BAR; PG8_WAIT_L(0); PG8_MMA(1, 0, At, B0); PG8_BAR; PG8_SCHED;
            PG8_STAGE(PG8_SB(1, 1), b3 + hstep, voffB);
            PG8_WAIT_V(6); PG8_BAR; PG8_MMA(1, 1, At, B1); PG8_BAR;
            }
        }
        if constexpr (ALIGN_EPI) { if (wr == 0) PG8_BAR; }
        if constexpr (!Epi::AFTER_DRAIN) { E(acc, cur, wr, wc, fr, fq); PG8_EPI_AGAIN(E(acc, cur, wr, wc, fr, fq)); S.done(cur); }
        if (!has_next) break;
#pragma unroll
        for (int a = 0; a < 2; ++a)
#pragma unroll
            for (int b = 0; b < 2; ++b)
#pragma unroll
                for (int m = 0; m < 4; ++m)
#pragma unroll
                    for (int n = 0; n < 2; ++n) acc[a][b][m][n] = (f32x4){0.f, 0.f, 0.f, 0.f};
        cur = nxt; cA = nA; cB = nB; ++ui;
#pragma unroll
        for (int i = 0; i < 2; ++i) { cA0[i] = nA0[i]; cA1[i] = nA1[i]; }
        if constexpr (ALIGN_EPI) { if (wr == 1) PG8_BAR; }
    }
    PG8_WAIT_V(0);
    if constexpr (!ALIGN_EPI) { if (wr == 0) PG8_BAR; }
    PG8_BAR;
    if constexpr (Epi::AFTER_DRAIN) { E.fused(acc, cur, wr, wc, fr, fq, lds, wid, lane); S.done(cur); }
#undef PG8_SA
#undef PG8_SB
#undef PG8_STAGE
#undef PG8_LDA
#undef PG8_LDB
#undef PG8_MMA
#undef PG8_WAIT_V
#undef PG8_WAIT_L
#undef PG8_BAR
#undef PG8_SCHED
}
}

#define DI __device__ __forceinline__
#define LAS __attribute__((address_space(3)))
typedef unsigned short bf16_t;
typedef short bf16x8 __attribute__((ext_vector_type(8)));
typedef short s16x4 __attribute__((ext_vector_type(4)));
typedef short v4i16_t __attribute__((ext_vector_type(4)));
typedef float f32x4 __attribute__((ext_vector_type(4)));
typedef float f32x16 __attribute__((ext_vector_type(16)));
typedef unsigned u32x4 __attribute__((ext_vector_type(4)));
typedef unsigned u32x2 __attribute__((ext_vector_type(2)));
typedef float f32x2_t __attribute__((ext_vector_type(2)));
typedef __bf16 bf16x2_t __attribute__((ext_vector_type(2)));

constexpr int NWAVES = 8, NTHREADS = 512;
constexpr int SEQ = 8192, DMODEL = 1024, NMETA = 16, LTOK = SEQ + NMETA  , LP = 8256  , NCHUNK = 129;
constexpr int MTOK = 2 * SEQ;
constexpr int MROWS = 16640;
constexpr int NPROJ = 3840;
constexpr int NKT = 129;
constexpr float EPS = 1e-6f;
constexpr float C2Q = 0.125f * 1.4426950408889634f;
constexpr int XS_ROWS = 41216;

constexpr size_t MiB = 1u << 20;
constexpr size_t WS_CTL = 0, CTL_BYTES = 1 * MiB;
constexpr size_t WS_RS1 = 1 * MiB;
constexpr size_t WS_RS2 = WS_RS1 + 128 * 1024;
constexpr size_t WS_TOKE = WS_RS2 + 128 * 1024;
constexpr size_t WS_TOKW = WS_TOKE + 128 * 1024;
constexpr size_t WS_TOKP = WS_TOKW + 128 * 1024;
constexpr size_t WS_SLOTW = WS_TOKP + 128 * 1024;
constexpr size_t WS_WR = WS_SLOTW + 192 * 1024;
constexpr size_t WS_GL = WS_WR + 160 * 1024;
constexpr size_t WS_DUMP = 2 * MiB;
constexpr size_t WS_COS = 2 * MiB;
constexpr size_t WS_SIN = WS_COS + 1280 * 1024;
constexpr size_t WS_GB = WS_SIN + 1280 * 1024;
constexpr size_t WS_WOUT = 6 * MiB;
constexpr size_t WS_WINT = 8 * MiB;
constexpr size_t WS_XB = WS_WINT + (size_t)NPROJ * 1024 * 2;
constexpr size_t WS_MIX = 8 * MiB;
constexpr size_t WS_QKVB = 48 * MiB;
constexpr size_t WS_QB = WS_QKVB + (size_t)2 * LP * 1536 * 2 + 128 * 1024;
constexpr size_t WS_KT = WS_QB + 16 * MiB;
constexpr size_t WS_VT = WS_KT + (size_t)16 * NKT * 4096 * 2;
constexpr size_t WS_ZB = WS_VT + (size_t)8 * NKT * 8192 * 2;
constexpr size_t WS_GP = WS_ZB + (size_t)2 * LP * 512 * 2;
constexpr size_t GP_ARR = (size_t)2064 * 4096 * 2;
constexpr size_t WS_GP_END = WS_GP + 5 * GP_ARR;
constexpr size_t WS_WGU = 48 * MiB;
constexpr size_t WS_WD = 80 * MiB;
constexpr size_t WS_U2 = 96 * MiB;
constexpr size_t WS_LIST = 240 * MiB;
constexpr size_t WS_LISTW = 242 * MiB;
constexpr size_t WS_LISTRS = 244 * MiB;
constexpr size_t WS_XS = 96 * MiB;
constexpr size_t WS_YO = 96 * MiB;
constexpr size_t WS_YS = WS_XS + (size_t)XS_ROWS * 1024 * 2;
constexpr size_t WS_END = 256 * MiB;
static_assert(WS_GB + (size_t)2 * LP * 16 * 4 <= WS_WOUT, "small region");
static_assert(WS_XB + (size_t)MROWS * 1024 * 2 <= WS_QKVB, "XB");
static_assert(WS_GP_END <= WS_END, "GDN prep arrays");
static_assert(WS_YS + (size_t)XS_ROWS * 256 * 2 <= WS_END, "YS");
static_assert(WS_WD + (size_t)32 * 1024 * 256 * 2 <= WS_XS, "WD");
constexpr int CW_ATTQ = 2112;
constexpr int CW_PREP = 2688;
constexpr int CW_CNT = 64;
constexpr int CW_TILE = 8192;
constexpr int CW_BAR = 4096;

constexpr int LDS_BYTES = 147456;

struct Params { const float* in[23]; float* out; unsigned char* ws; };

DI unsigned f2bf(float f) { unsigned u = __float_as_uint(f); return (u + 0x7fffu + ((u >> 16) & 1u)) >> 16; }
DI unsigned pk2(float lo, float hi) { f32x2_t v = {lo, hi}; bf16x2_t b = __builtin_convertvector(v, bf16x2_t); return __builtin_bit_cast(unsigned, b); }
DI float bf2f(unsigned short h) { return __uint_as_float(((unsigned)h) << 16); }
DI float rlane(float v, int l) { return __int_as_float(__builtin_amdgcn_readlane(__float_as_int(v), l)); }
#define DPP_ADD(v, ctrl) ((v) + __int_as_float(__builtin_amdgcn_update_dpp(0, __float_as_int(v), (ctrl), 0xF, 0xF, true)))
DI u32x2 pack_quad_bf16(float v) {
    const float v1 = __int_as_float(__builtin_amdgcn_update_dpp(0, __float_as_int(v), 0xB1, 0xF, 0xF, true));
    const unsigned p = pk2(v, v1);
    const unsigned q = (unsigned)__builtin_amdgcn_update_dpp(0, (int)p, 0x4E, 0xF, 0xF, true);
    return (u32x2){p, q};
}
typedef __attribute__((address_space(1))) u32x2 g_u32x2;
DI void store_quad_bf16(bf16_t* dst  , float v, int lane) {
    const float v1 = __int_as_float(__builtin_amdgcn_update_dpp(0, __float_as_int(v), 0xB1, 0xF, 0xF, true));
    const unsigned p = pk2(v, v1);
    const unsigned q = (unsigned)__builtin_amdgcn_update_dpp(0, (int)p, 0x4E, 0xF, 0xF, true);
    if ((lane & 3) == 0) *(u32x2*)dst = (u32x2){p, q};
}
DI float wave_sum_dpp(float v) {
    v = DPP_ADD(v, 0xB1);
    v = DPP_ADD(v, 0x4E);
    v = DPP_ADD(v, 0x141);
    v = DPP_ADD(v, 0x140);
    return (rlane(v, 0) + rlane(v, 16)) + (rlane(v, 32) + rlane(v, 48));
}
DI float wave_sum(float v) { return wave_sum_dpp(v); }
DI float swz_xor16(float v) { return __int_as_float(__builtin_amdgcn_ds_swizzle(__float_as_int(v), 0x401F)); }
DI float row_sum16(float v) { v = DPP_ADD(v, 0xB1); v = DPP_ADD(v, 0x4E); v = DPP_ADD(v, 0x141); v = DPP_ADD(v, 0x140); return v; }
DI float half_sum32(float v) { v = row_sum16(v); return v + swz_xor16(v); }
DI float swap32_add(float v) { auto rr = __builtin_amdgcn_permlane32_swap(__float_as_uint(v), __float_as_uint(v), false, false); return __uint_as_float(rr[0]) + __uint_as_float(rr[1]); }
DI float swap32_max(float v) { auto rr = __builtin_amdgcn_permlane32_swap(__float_as_uint(v), __float_as_uint(v), false, false); return fmaxf(__uint_as_float(rr[0]), __uint_as_float(rr[1])); }
#define LDS_WAIT() asm volatile("s_waitcnt lgkmcnt(0)" ::: "memory")
#define BAR_LDS() do { asm volatile("s_waitcnt lgkmcnt(0)" ::: "memory"); __builtin_amdgcn_s_barrier(); asm volatile("" ::: "memory"); } while (0)
#define MFMA32(a, b, c) __builtin_amdgcn_mfma_f32_32x32x16_bf16((a), (b), (c), 0, 0, 0)
DI int crow(int r, int hi) { return (r & 3) + 8 * (r >> 2) + 4 * hi; }
DI int perm16(int x) { return (x & ~12) | ((x & 4) << 1) | ((x & 8) >> 1); }
DI bf16x8 pack8(const f32x16& x, int s) {
    u32x4 p; p.x = pk2(x[8 * s], x[8 * s + 1]); p.y = pk2(x[8 * s + 2], x[8 * s + 3]); p.z = pk2(x[8 * s + 4], x[8 * s + 5]); p.w = pk2(x[8 * s + 6], x[8 * s + 7]);
    return __builtin_bit_cast(bf16x8, p);
}
DI int orig_col(int n) {
    if (n >= 1024) return n;
    const int hh = n >> 6, c2 = n & 63, g8 = c2 >> 3, i = c2 & 7;
    return (hh << 6) + ((i < 4) ? 4 * g8 + i : 32 + 4 * g8 + (i - 4));
}
DI size_t kt_off(int b, int hh, int p, int d) {
    const int tile = p < 16 ? 0 : 1 + ((p - 16) >> 6), kv = p < 16 ? p : ((p - 16) & 63);
    return ((size_t)((b * 8 + hh) * NKT + tile) << 12) + ((d >> 3) << 9) + (kv << 3) + (d & 7);
}
DI size_t vt_off(int b, int h, int p, int d) {
    const int tile = p < 16 ? 0 : 1 + ((p - 16) >> 6), kv = p < 16 ? p : ((p - 16) & 63);
    return ((size_t)((b * 4 + h) * NKT + tile) << 13) + ((d >> 5) << 11) + ((kv >> 4) << 9) + ((kv & 15) << 5) + (d & 31);
}

template <class Src> DI void transpose_item(const Src& src, bf16_t* WT, size_t ldk, int k0, int n0, LAS float* scr, int lane) {
    float v[32];
#pragma unroll
    for (int i = 0; i < 32; ++i) v[i] = src(k0 + 2 * i + (lane >> 5), n0 + (lane & 31));
#pragma unroll
    for (int i = 0; i < 32; ++i) scr[(2 * i + (lane >> 5)) * 33 + (lane & 31)] = v[i];
    LDS_WAIT();
    const int c = lane & 7;
#pragma unroll
    for (int j = 0; j < 4; ++j) { const int n = (lane >> 3) + 8 * j; const LAS float* s = scr + (8 * c) * 33 + n;
        u32x4 o; o.x = pk2(s[0 * 33], s[1 * 33]); o.y = pk2(s[2 * 33], s[3 * 33]); o.z = pk2(s[4 * 33], s[5 * 33]); o.w = pk2(s[6 * 33], s[7 * 33]);
        *(u32x4*)(WT + (size_t)(n0 + n) * ldk + k0 + 8 * c) = o; }
    LDS_WAIT();
}
struct SrcWin { const float* w; const float* g; DI float operator()(int k, int n) const { return n >= 3600 ? 0.f : w[(size_t)k * 3600 + orig_col(n)] * g[k]; } };
struct SrcPlain { const float* w; int N; DI float operator()(int k, int n) const { return w[(size_t)k * N + n]; } };
struct SrcGU { const float* w; const float* g; int fadj; DI float operator()(int k, int n) const { return w[(size_t)k * 256 + n + fadj] * g[k]; } };

#ifndef P0_REP
#define P0_REP 0
#endif
DI void phase0(const Params& P, LAS unsigned char* lds, int gw, int NGW, int gtid, int NGT, int wave, int lane) {
    LAS float* scr = (LAS float*)(lds + wave * 16384);
    bf16_t* WINT = (bf16_t*)(P.ws + WS_WINT); bf16_t* WOUT = (bf16_t*)(P.ws + WS_WOUT); bf16_t* XB = (bf16_t*)(P.ws + WS_XB);
    float* RS1 = (float*)(P.ws + WS_RS1);
    constexpr int I_IN = 16 * (NPROJ / 32), I_OUT = 16 * 32;
    const SrcWin sw{P.in[3], P.in[2]}; const SrcPlain so{P.in[13], 1024};
    for (int rp_ = 0; rp_ < ((P0_REP & 1) ? 2 : 1); ++rp_)
    for (int it = gw; it < I_IN + I_OUT; it += NGW) {
        if (it < I_IN) transpose_item(sw, WINT, 1024, (it / (NPROJ / 32)) * 64, (it % (NPROJ / 32)) * 32, scr, lane);
        else { const int r = it - I_IN; transpose_item(so, WOUT, 1024, (r >> 5) * 64, (r & 31) * 32, scr, lane); }
    }
    const float* x = P.in[0]; const float* meta = P.in[1];
    for (int rp_ = 0; rp_ < ((P0_REP & 2) ? 2 : 1); ++rp_)
    for (int m0 = gw; m0 < MROWS; m0 += 4 * NGW) {
        f32x4 v[4][4];
#pragma unroll
        for (int r = 0; r < 4; ++r) { const int m = m0 + r * NGW;
            const bool real = m < MTOK + NMETA;
            const f32x4* xr = (const f32x4*)((m < MTOK) ? x + (size_t)m * 1024 : meta + (size_t)((real ? m : MTOK) - MTOK) * 1024);
#pragma unroll
            for (int j = 0; j < 4; ++j) v[r][j] = (m < MROWS) ? xr[64 * j + lane] : (f32x4){0.f, 0.f, 0.f, 0.f}; }
#pragma unroll
        for (int r = 0; r < 4; ++r) { const int m = m0 + r * NGW;
            if (m < MROWS) {
                const bool real = m < MTOK + NMETA;
                float s = 0.f;
#pragma unroll
                for (int j = 0; j < 4; ++j) { if (!real) v[r][j] = (f32x4){0.f, 0.f, 0.f, 0.f}; s += (v[r][j].x * v[r][j].x + v[r][j].y * v[r][j].y) + (v[r][j].z * v[r][j].z + v[r][j].w * v[r][j].w); }
                s = wave_sum(s);
                if (lane == 0) RS1[m] = real ? __builtin_amdgcn_rsqf(s * (1.0f / 1024.0f) + EPS) : 0.f;
                u32x2* orow = (u32x2*)(XB + (size_t)m * 1024);
#pragma unroll
                for (int j = 0; j < 4; ++j) orow[64 * j + lane] = (u32x2){pk2(v[r][j].x, v[r][j].y), pk2(v[r][j].z, v[r][j].w)};
            } }
    }
    float* COS = (float*)(P.ws + WS_COS); float* SIN = (float*)(P.ws + WS_SIN);
    for (int rp_ = 0; rp_ < ((P0_REP & 4) ? 2 : 1); ++rp_)
    for (int i = gtid; i < LTOK * 32; i += NGT) {
        const int p = i >> 5, f = i & 31;
        const double rev = (double)p * exp2(-(double)f * (13.287712379549449 / 32.0)) * 0.15915494309189535;
        const float fr = (float)(rev - floor(rev));
        COS[i] = __builtin_amdgcn_cosf(fr); SIN[i] = __builtin_amdgcn_sinf(fr);
    }
    float* WR = (float*)(P.ws + WS_WR); const float* gf = P.in[14]; const float* wgrp = P.in[15]; const float* wrt = P.in[17];
    for (int i = gtid; i < 36 * 1024; i += NGT) { const int j = i >> 10, k = i & 1023; WR[i] = gf[k] * (j < 4 ? wgrp[k * 4 + j] : wrt[k * 32 + (j - 4)]); }
}

struct EpiInProj {
    static constexpr bool PERM = true, AFTER_DRAIN = false;
    const float* RS1; const float* COS; const float* SIN; const float* a_log; const float* dt_bias;
    bf16_t* QB; bf16_t* KT; bf16_t* VT; bf16_t* QKVB; bf16_t* ZB; float* GB;
    DI void tail(const pg8::f32x4 (&acc)[2][2][4][2], const pg8::Unit& u, int wr, int wc, int fr, int fq) const {
        const int pn = u.pn;
#pragma unroll
        for (int ai = 0; ai < 2; ++ai)
#pragma unroll
            for (int m = 0; m < 4; ++m) {
                const int row = u.pm * 256 + ai * 128 + wr * 64 + m * 16 + fr;
                if (row < MTOK + NMETA) {
                    const float rs = RS1[row];
                    const bool meta = row >= MTOK;
                    const int p = meta ? row - MTOK : (row & 8191) + NMETA;
                    const int b0 = meta ? 0 : (row >> 13), nb = meta ? 2 : 1;
#pragma unroll
                    for (int bj = 0; bj < 2; ++bj) {
                        float xv[8];
#pragma unroll
                        for (int i = 0; i < 4; ++i) { xv[i] = acc[ai][bj][m][0][i] * rs; xv[4 + i] = acc[ai][bj][m][1][i] * rs; }
                        if (pn < 4) {
                            const int hh = (pn & 1) * 4 + bj * 2 + (wc >> 1), d0 = 4 * (4 * (wc & 1) + fq);
                            const f32x4 cs = *(const f32x4*)(COS + p * 32 + d0), sn = *(const f32x4*)(SIN + p * 32 + d0);
                            float lo[4], hi[4];
#pragma unroll
                            for (int i = 0; i < 4; ++i) { lo[i] = xv[i] * cs[i] - xv[4 + i] * sn[i]; hi[i] = xv[4 + i] * cs[i] + xv[i] * sn[i]; }
                            if (pn < 2) {
                                if (!meta) {
                                    bf16_t* q = QB + ((size_t)((b0 * 8 + hh) * SEQ + (p - NMETA)) << 6) + d0;
                                    *(u32x2*)q = (u32x2){pk2(lo[0] * C2Q, lo[1] * C2Q), pk2(lo[2] * C2Q, lo[3] * C2Q)};
                                    *(u32x2*)(q + 32) = (u32x2){pk2(hi[0] * C2Q, hi[1] * C2Q), pk2(hi[2] * C2Q, hi[3] * C2Q)};
                                }
                            } else {
                                for (int bb = b0; bb < b0 + nb; ++bb) {
                                    *(u32x2*)(KT + kt_off(bb, hh, p, d0)) = (u32x2){pk2(lo[0], lo[1]), pk2(lo[2], lo[3])};
                                    *(u32x2*)(KT + kt_off(bb, hh, p, d0 + 32)) = (u32x2){pk2(hi[0], hi[1]), pk2(hi[2], hi[3])};
                                }
                            }
                        } else {
                            const u32x4 w = (u32x4){pk2(xv[0], xv[1]), pk2(xv[2], xv[3]), pk2(xv[4], xv[5]), pk2(xv[6], xv[7])};
                            const int cl = bj * 128 + wc * 32 + fq * 8;
                            if (pn < 6) {
                                const int h = (pn - 4) * 2 + bj, d = wc * 32 + fq * 8;
                                for (int bb = b0; bb < b0 + nb; ++bb) *(u32x4*)(VT + vt_off(bb, h, p, d)) = w;
                            } else if (pn < 12) {
                                for (int bb = b0; bb < b0 + nb; ++bb) *(u32x4*)(QKVB + (size_t)(bb * LP + p) * 1536 + (pn - 6) * 256 + cl) = w;
                            } else if (pn < 14) {
                                float sz[8];
#pragma unroll
                                for (int i = 0; i < 8; ++i) sz[i] = xv[i] * __builtin_amdgcn_rcpf(1.0f + __expf(-xv[i]));
                                const u32x4 wz = (u32x4){pk2(sz[0], sz[1]), pk2(sz[2], sz[3]), pk2(sz[4], sz[5]), pk2(sz[6], sz[7])};
                                for (int bb = b0; bb < b0 + nb; ++bb) *(u32x4*)(ZB + (size_t)(bb * LP + p) * 512 + (pn - 12) * 256 + cl) = wz;
                            } else if (cl < 16) {
                                float o[8];
                                if (cl == 0) {
#pragma unroll
                                    for (int i = 0; i < 8; ++i) { const float t = xv[i] + dt_bias[i]; const float sp = t > 20.f ? t : log1pf(expf(t)); o[i] = -expf(a_log[i]) * sp; }
                                } else {
#pragma unroll
                                    for (int i = 0; i < 8; ++i) o[i] = 1.0f / (1.0f + expf(-xv[i]));
                                }
                                for (int bb = b0; bb < b0 + nb; ++bb) { float* g = GB + ((size_t)(bb * LP + p) << 4) + cl;
                                    *(f32x4*)g = (f32x4){o[0], o[1], o[2], o[3]}; *(f32x4*)(g + 4) = (f32x4){o[4], o[5], o[6], o[7]}; }
                            }
                        }
                    }
                }
            }
    }

    DI void operator()(const pg8::f32x4 (&acc)[2][2][4][2], const pg8::Unit& u, int wr, int wc, int fr, int fq) const {
        if (u.pm >= MTOK / 256) { tail(acc, u, wr, wc, fr, fq); return; }
        const int pn = u.pn, rowb = u.pm * 256 + wr * 64 + fr;
        float rs[2][4];
#pragma unroll
        for (int ai = 0; ai < 2; ++ai)
#pragma unroll
            for (int m = 0; m < 4; ++m) rs[ai][m] = RS1[rowb + ai * 128 + m * 16];
        __builtin_amdgcn_sched_barrier(0);
        const int b = rowb >> 13, s0 = rowb & 8191;
        if (pn < 4) {
            const int d0 = 4 * (4 * (wc & 1) + fq);
#pragma unroll
            for (int ai = 0; ai < 2; ++ai) {
                f32x4 cs[4], sn[4];
#pragma unroll
                for (int m = 0; m < 4; ++m) { const int p = s0 + ai * 128 + m * 16 + NMETA; cs[m] = *(const f32x4*)(COS + p * 32 + d0); sn[m] = *(const f32x4*)(SIN + p * 32 + d0); }
                __builtin_amdgcn_sched_barrier(0);
#pragma unroll
                for (int m = 0; m < 4; ++m)
#pragma unroll
                    for (int bj = 0; bj < 2; ++bj) {
                        const int hh = (pn & 1) * 4 + bj * 2 + (wc >> 1), s = s0 + ai * 128 + m * 16;
                        float lo[4], hi[4];
#pragma unroll
                        for (int i = 0; i < 4; ++i) { const float x1 = acc[ai][bj][m][0][i] * rs[ai][m], x2 = acc[ai][bj][m][1][i] * rs[ai][m];
                            lo[i] = x1 * cs[m][i] - x2 * sn[m][i]; hi[i] = x2 * cs[m][i] + x1 * sn[m][i]; }
                        if (pn < 2) { bf16_t* q = QB + ((size_t)((b * 8 + hh) * SEQ + s) << 6) + d0;
                            *(u32x2*)q = (u32x2){pk2(lo[0] * C2Q, lo[1] * C2Q), pk2(lo[2] * C2Q, lo[3] * C2Q)};
                            *(u32x2*)(q + 32) = (u32x2){pk2(hi[0] * C2Q, hi[1] * C2Q), pk2(hi[2] * C2Q, hi[3] * C2Q)};
                        } else { bf16_t* k = KT + ((size_t)((b * 8 + hh) * NKT + 1 + (s >> 6)) << 12) + ((d0 >> 3) << 9) + ((s & 63) << 3) + (d0 & 7);
                            *(u32x2*)k = (u32x2){pk2(lo[0], lo[1]), pk2(lo[2], lo[3])};
                            *(u32x2*)(k + 4 * 512) = (u32x2){pk2(hi[0], hi[1]), pk2(hi[2], hi[3])}; }
                    }
            }
            return;
        }
        const int cl = wc * 32 + fq * 8;
#pragma unroll
        for (int ai = 0; ai < 2; ++ai)
#pragma unroll
            for (int m = 0; m < 4; ++m)
#pragma unroll
                for (int bj = 0; bj < 2; ++bj) {
                    const int s = s0 + ai * 128 + m * 16, p = s + NMETA;
                    float xv[8];
#pragma unroll
                    for (int i = 0; i < 4; ++i) { xv[i] = acc[ai][bj][m][0][i] * rs[ai][m]; xv[4 + i] = acc[ai][bj][m][1][i] * rs[ai][m]; }
                    if (pn < 6) {
                        const int h = (pn - 4) * 2 + bj;
                        *(u32x4*)(VT + ((size_t)((b * 4 + h) * NKT + 1 + (s >> 6)) << 13) + ((cl >> 5) << 11) + (((s & 63) >> 4) << 9) + ((s & 15) << 5) + (cl & 31)) =
                            (u32x4){pk2(xv[0], xv[1]), pk2(xv[2], xv[3]), pk2(xv[4], xv[5]), pk2(xv[6], xv[7])};
                    } else if (pn < 12) {
                        *(u32x4*)(QKVB + (size_t)(b * LP + p) * 1536 + (pn - 6) * 256 + bj * 128 + cl) = (u32x4){pk2(xv[0], xv[1]), pk2(xv[2], xv[3]), pk2(xv[4], xv[5]), pk2(xv[6], xv[7])};
                    } else if (pn < 14) {
#pragma unroll
                        for (int i = 0; i < 8; ++i) xv[i] = xv[i] * __builtin_amdgcn_rcpf(1.0f + __expf(-xv[i]));
                        *(u32x4*)(ZB + (size_t)(b * LP + p) * 512 + (pn - 12) * 256 + bj * 128 + cl) = (u32x4){pk2(xv[0], xv[1]), pk2(xv[2], xv[3]), pk2(xv[4], xv[5]), pk2(xv[6], xv[7])};
                    } else if (bj == 0 && cl < 16) {
                        float o[8];
                        if (cl == 0) {
#pragma unroll
                            for (int i = 0; i < 8; ++i) { const float t = xv[i] + dt_bias[i]; const float sp = t > 20.f ? t : log1pf(expf(t)); o[i] = -expf(a_log[i]) * sp; }
                        } else {
#pragma unroll
                            for (int i = 0; i < 8; ++i) o[i] = 1.0f / (1.0f + expf(-xv[i]));
                        }
                        float* g = GB + ((size_t)(b * LP + p) << 4) + cl;
                        *(f32x4*)g = (f32x4){o[0], o[1], o[2], o[3]}; *(f32x4*)(g + 4) = (f32x4){o[4], o[5], o[6], o[7]};
                    }
                }
    }
};

DI bf16x8 lds_frag(LAS const bf16_t* M, int row, int ch) { return *(LAS const bf16x8*)((LAS const unsigned char*)M + row * 128 + ((ch ^ (row & 7)) << 4)); }
DI s16x4 tr_read_b64(LAS const unsigned char* p) { return __builtin_bit_cast(s16x4, __builtin_amdgcn_ds_read_tr16_b64_v4i16((LAS v4i16_t*)p)); }
DI bf16x8 lds_frag_plain(LAS const bf16_t* M, int row, int ch) { return *(LAS const bf16x8*)((LAS const unsigned char*)M + row * 128 + (ch << 4)); }
DI int swz_idx(int row, int d) { return row * 64 + ((((d >> 3) ^ (row & 7)) << 3) | (d & 7)); }

#ifndef PREP_REP
#define PREP_REP 0
#endif
constexpr int PREP_PAIR = 35840;

template <int MAT> DI void prep_rows(const bf16_t* QKVB, const float* cw, int b, int h, int n, int lane, LAS const float* egS,
                                     LAS bf16_t* DS  , bf16_t* QG) {
    const int colb = MAT * 512 + h * 64, col = colb + lane, p0 = n * 64;
    const float c0 = cw[col], c1 = cw[1536 + col], c2 = cw[3072 + col], c3 = cw[4608 + col];
    const bf16_t* blk = QKVB + (size_t)(b * LP + p0) * 1536 + colb;
    float x0 = 0.f, x1 = 0.f, x2 = 0.f;
    if (n > 0) { x0 = bf2f(blk[lane - 3 * 1536]); x1 = bf2f(blk[lane - 2 * 1536]); x2 = bf2f(blk[lane - 1 * 1536]); }
    u32x4 stg[8];
#pragma unroll
    for (int i = 0; i < 8; ++i) stg[i] = *(const u32x4*)(blk + (size_t)(8 * i + (lane >> 3)) * 1536 + (lane & 7) * 8);
#pragma unroll
    for (int i = 0; i < 8; ++i) *(LAS u32x4*)(DS + (8 * i + (lane >> 3)) * 64 + (lane & 7) * 8) = stg[i];
    LDS_WAIT();
    const int nvalid = (LTOK - p0) < 64 ? (LTOK - p0) : 64;
#pragma unroll 4
    for (int c = 0; c < nvalid; ++c) {
        const float x3 = bf2f(DS[c * 64 + lane]);
        float y = c0 * x0 + c1 * x1 + c2 * x2 + c3 * x3;
        y = y * __builtin_amdgcn_rcpf(1.0f + __expf(-y));
        x0 = x1; x1 = x2; x2 = x3;
        if (MAT == 2) { DS[c * 64 + lane] = (bf16_t)f2bf(y * egS[c]); }
        else {
            const float ss = wave_sum(y * y);
            const float yn = y * __builtin_amdgcn_rsqf(ss + EPS);
            if (MAT == 0) {
                const float qn = yn * 0.125f;
                DS[c * 64 + lane] = (bf16_t)f2bf(qn);
                QG[c * 64 + perm16(lane)] = (bf16_t)f2bf(qn * egS[c]);
            } else {
                DS[c * 64 + lane] = (bf16_t)f2bf(yn);
            }
        }
    }
    for (int c = nvalid; c < 64; ++c) { DS[c * 64 + lane] = 0; if (MAT == 0) QG[c * 64 + perm16(lane)] = 0; }
}

DI void gdn_tinv(LAS const float* AST, LAS bf16_t* TS, int lane) {
    const int hb = lane >> 5, j = lane & 31, r32 = j, hi = hb;
    LAS const float* Ab = AST + (32 * hb) * 68 + 32 * hb;
    float x[32];
#pragma unroll
    for (int r = 0; r < 32; ++r) x[r] = (r == j) ? 1.0f : 0.0f;
#pragma unroll
    for (int jj = 0; jj < 31; ++jj) {
        const float xj = x[jj];
        LAS const float* ap = Ab + jj * 68;
#pragma unroll
        for (int r4 = (jj + 1) / 4; r4 < 8; ++r4) {
            const f32x4 a = *(LAS const f32x4*)(ap + 4 * r4);
#pragma unroll
            for (int e = 0; e < 4; ++e) if (4 * r4 + e > jj) x[4 * r4 + e] -= a[e] * xj;
        }
    }
    bf16x8 a21[2];
#pragma unroll
    for (int s = 0; s < 2; ++s) { float t[8];
#pragma unroll
        for (int jj = 0; jj < 8; ++jj) t[jj] = AST[(16 * s + 8 * hi + jj) * 68 + 32 + r32];
        const u32x4 p = (u32x4){pk2(t[0], t[1]), pk2(t[2], t[3]), pk2(t[4], t[5]), pk2(t[6], t[7])}; a21[s] = __builtin_bit_cast(bf16x8, p); }
    f32x16 M = {};
#pragma unroll
    for (int s = 0; s < 2; ++s) { float t[8];
#pragma unroll
        for (int jj = 0; jj < 8; ++jj) {
            const auto rr = __builtin_amdgcn_permlane32_swap(__float_as_uint(x[16 * s + 8 + jj]), __float_as_uint(x[16 * s + 8 + jj]), false, false);
            t[jj] = hi ? __uint_as_float(rr[0]) : x[16 * s + jj];
        }
        const u32x4 p = (u32x4){pk2(t[0], t[1]), pk2(t[2], t[3]), pk2(t[4], t[5]), pk2(t[6], t[7])};
        M = MFMA32(a21[s], __builtin_bit_cast(bf16x8, p), M);
    }
    asm volatile("s_waitcnt lgkmcnt(0)" ::: "memory");
#pragma unroll
    for (int i = 0; i < 32; ++i) TS[(32 * hb + i) * 64 + 32 * hb + j] = (bf16_t)f2bf(x[i]);
    asm volatile("s_waitcnt lgkmcnt(0)" ::: "memory");
    f32x16 T21 = {};
#pragma unroll
    for (int s = 0; s < 2; ++s) {
        const u32x2 lo = *(LAS const u32x2*)(TS + (32 + r32) * 64 + 32 + 16 * s + 4 * hi), hi8 = *(LAS const u32x2*)(TS + (32 + r32) * 64 + 32 + 16 * s + 8 + 4 * hi);
        const u32x4 p = (u32x4){lo.x, lo.y, hi8.x, hi8.y};
        T21 = MFMA32(__builtin_bit_cast(bf16x8, p), pack8(M, s), T21);
    }
#pragma unroll
    for (int i = 0; i < 16; ++i) TS[(32 + crow(i, hi)) * 64 + r32] = (bf16_t)f2bf(-T21[i]);
    asm volatile("s_waitcnt lgkmcnt(0)" ::: "memory");
}

template <bool PERM> DI void gdn_tmul(LAS const bf16_t* TS, LAS const bf16_t* RS, int lane, float sgn, bf16_t* out) {
    const int r32 = lane & 31, hi = lane >> 5;
    LAS const unsigned char* rb = (LAS const unsigned char*)RS + ((8 * hi + ((lane & 15) >> 2)) * 64 + 16 * ((lane >> 4) & 1) + 4 * (lane & 3)) * 2;
#pragma unroll
    for (int ct = 0; ct < 2; ++ct)
#pragma unroll
        for (int cb = 0; cb < 2; ++cb) {
            f32x16 acc = {};
#pragma unroll
            for (int ks = 0; ks < (ct == 0 ? 2 : 4); ++ks) {
                const bf16x8 fa = lds_frag_plain(TS, 32 * ct + r32, 2 * ks + hi);
                const s16x4 lo = tr_read_b64(rb + (16 * ks * 64 + 32 * cb) * 2), h4 = tr_read_b64(rb + ((16 * ks + 4) * 64 + 32 * cb) * 2);
                const bf16x8 fb = (bf16x8){lo[0], lo[1], lo[2], lo[3], h4[0], h4[1], h4[2], h4[3]};
                acc = MFMA32(fa, fb, acc);
            }
            u32x2 pk[16];
#pragma unroll
            for (int i = 0; i < 16; ++i) pk[i] = pack_quad_bf16(sgn * acc[i]);
            if ((lane & 3) == 0) {
                unsigned long long ob_ = (unsigned long long)(out + hi * 256 + (PERM ? perm16(32 * cb + r32) : 32 * cb + r32)); asm volatile("" : "+v"(ob_));
                g_u32x2* ob = (g_u32x2*)ob_;
#pragma unroll
                for (int i = 0; i < 16; ++i) ob[(32 * ct + (i & 3) + 8 * (i >> 2)) * 16] = pk[i];
            }
        }
}

DI void gdn_prep_phase(const Params& P, LAS unsigned char* lds, int blk, int G, int wave, int lane_in) {
    const int pair = wave >> 1, role = wave & 1;
    LAS unsigned char* pb = lds + pair * PREP_PAIR;
    LAS bf16_t* QS = (LAS bf16_t*)pb; LAS bf16_t* KS = (LAS bf16_t*)(pb + 8192); LAS float* AS = (LAS float*)(pb + 16384);
    LAS float* gcS = (LAS float*)(pb + 16384 + 17408 + role * 1024); LAS float* betaS = gcS + 64; LAS float* egS = gcS + 128; LAS float* ekS = gcS + 192;
    const bf16_t* QKVB = (const bf16_t*)(P.ws + WS_QKVB); const float* GB = (const float*)(P.ws + WS_GB); const float* cw = P.in[9];
    const int NP = G * 4, NTASK = 2 * 8 * NCHUNK;
    for (int it = 0; it * NP < NTASK; ++it) {
        int lane = lane_in; asm volatile("" : "+v"(lane));
        const int r32 = lane & 31, hi = lane >> 5;
        const int task = it * NP + blk * 4 + pair;
        const bool active = task < NTASK;
        const int bh = task < 2048 ? (task >> 7) : (task - 2048), n = task < 2048 ? (task & 127) : 128, b = bh >> 3, h = bh & 7;
        const int sidx = bh * NCHUNK + n;
        bf16_t* GPW = (bf16_t*)(P.ws + WS_GP) + (size_t)sidx * 4096; bf16_t* GPQG = GPW + GP_ARR / 2; bf16_t* GPAQK = GPQG + GP_ARR / 2; bf16_t* GPKGT = GPAQK + GP_ARR / 2; bf16_t* GPU = GPKGT + GP_ARR / 2;
        float gc = 0.f, beta = 0.f;
        if (active) {
            const int pl = n * 64 + lane;
            float g = 0.f;
            if (pl < LTOK) { const float* gb = GB + ((size_t)(b * LP + pl) << 4); g = gb[h]; beta = gb[8 + h]; }
            gcS[lane] = g; LDS_WAIT();
            gc = 0.f;
#pragma unroll
            for (int j4 = 0; j4 < 16; ++j4) { const f32x4 t = *(LAS const f32x4*)(gcS + 4 * j4);
                gc += (4 * j4 <= lane ? t[0] : 0.f) + (4 * j4 + 1 <= lane ? t[1] : 0.f) + (4 * j4 + 2 <= lane ? t[2] : 0.f) + (4 * j4 + 3 <= lane ? t[3] : 0.f); }
            const float glast = rlane(gc, 63);
            LDS_WAIT();
            gcS[lane] = gc; betaS[lane] = beta; egS[lane] = (role == 0) ? __expf(gc) : beta * __expf(gc); ekS[lane] = __expf(glast - gc);
            if (role == 0 && lane == 0) ((float*)(P.ws + WS_GL))[sidx] = __expf(glast);
            LDS_WAIT();
            for (int rp_ = 0; rp_ < ((PREP_REP & 1) ? 2 : 1); ++rp_) {
            if (role == 0) prep_rows<0>(QKVB, cw, b, h, n, lane, egS, QS, GPQG);
            else prep_rows<1>(QKVB, cw, b, h, n, lane, egS, KS, GPQG);
            }
        }
        LDS_WAIT();
        __syncthreads();
        if (active) {
            for (int rp_ = 0; rp_ < ((PREP_REP & 2) ? 2 : 1); ++rp_)
#pragma unroll
            for (int t4 = 0; t4 < 4; ++t4) {
                const int ct = t4 >> 1, st = t4 & 1;
                f32x16 acc = {};
                if (!(ct == 0 && st == 1)) {
#pragma unroll
                    for (int ks = 0; ks < 4; ++ks) {
                        const bf16x8 fa = lds_frag_plain(role == 0 ? QS : KS, 32 * ct + r32, 2 * ks + hi), fb = lds_frag_plain(KS, 32 * st + r32, 2 * ks + hi);
                        acc = MFMA32(fa, fb, acc);
                    }
                }
                const float gcs = gcS[32 * st + r32];
                LAS const float* gcb = gcS + hi * 4; LAS const float* beb = betaS + hi * 4;
                asm volatile("" : "+v"(gcb), "+v"(beb));
                const int cmp = (32 * st + r32) - 4 * hi;
                if (role == 0) {
                    u32x2 pk[16];
#pragma unroll
                    for (int i = 0; i < 16; ++i) { const int cr = 32 * ct + (i & 3) + 8 * (i >> 2);
                        pk[i] = pack_quad_bf16((cmp <= cr) ? acc[i] * __expf(gcb[cr] - gcs) : 0.f); }
                    if ((lane & 3) == 0) {
                        unsigned long long aq_ = (unsigned long long)(GPAQK + hi * 256 + perm16(r32) + 32 * st); asm volatile("" : "+v"(aq_));
                        g_u32x2* aqb = (g_u32x2*)aq_;
#pragma unroll
                        for (int i = 0; i < 16; ++i) { const int cr = 32 * ct + (i & 3) + 8 * (i >> 2); aqb[cr * 16] = pk[i]; }
                    }
                } else {
                    LAS float* asb = AS + r32 * 68 + hi * 4;
                    asm volatile("" : "+v"(asb));
#pragma unroll
                    for (int i = 0; i < 16; ++i) { const int cr = 32 * ct + (i & 3) + 8 * (i >> 2);
                        asb[32 * st * 68 + cr] = (cmp < cr) ? acc[i] * beb[cr] * __expf(gcb[cr] - gcs) : 0.f; }
                }
            }
        }
        LDS_WAIT();
        __syncthreads();
        LAS bf16_t* TS = (LAS bf16_t*)((LAS unsigned char*)AS + 32 * 68 * 4);
        if (active) {
            if (role == 0) {
                prep_rows<2>(QKVB, cw, b, h, n, lane, betaS, QS  , GPQG);
            } else {
#pragma unroll
                for (int gq = 0; gq < 8; ++gq) {
                    float t[8];
#pragma unroll
                    for (int j = 0; j < 8; ++j) { const int c = perm16(8 * gq + j); t[j] = bf2f(KS[c * 64 + lane]) * ekS[c]; }
                    *(u32x4*)(GPKGT + lane * 64 + 8 * gq) = (u32x4){pk2(t[0], t[1]), pk2(t[2], t[3]), pk2(t[4], t[5]), pk2(t[6], t[7])};
                }
#pragma unroll 8
                for (int c = 0; c < 64; ++c) KS[c * 64 + lane] = (bf16_t)f2bf(bf2f(KS[c * 64 + lane]) * egS[c]);
                gdn_tinv(AS, TS, lane);
            }
        }
        LDS_WAIT();
        __syncthreads();
        if (active) {
            for (int rp_ = 0; rp_ < ((PREP_REP & 8) ? 2 : 1); ++rp_) {
            if (role == 0) gdn_tmul<false>(TS, QS, lane, 1.0f, GPU);
            else gdn_tmul<true>(TS, KS, lane, -1.0f, GPW);
            }
        }
        LDS_WAIT();
    }
}

constexpr int GS_STAGE = 40960 + 1024;
constexpr int GS_NSTAGE = 3;
constexpr int GS_OBUF = GS_NSTAGE * GS_STAGE;
static_assert(GS_OBUF + 16384 <= LDS_BYTES - 64, "gdn scan LDS");

#define GS_POST(n, ZQ) do { \
            if (n > 0) {         \
                LAS const bf16_t* ob = (LAS const bf16_t*)(lds + GS_OBUF + ((n - 1) & 1) * 8192); \
                const f32x4 gn = *(const f32x4*)(gnorm + 4 * vq); \
            _Pragma("unroll") \
                for (int it = 0; it < 8; ++it) { \
                    const int c = (wave - 2) * 32 + 4 * it + rg, p = (n - 1) * 64 + c; \
                    const u32x2 ov = *(LAS const u32x2*)(ob + c * 64 + 4 * vq); \
                    const float v0 = __uint_as_float(ov.x << 16), v1 = __uint_as_float(ov.x & 0xffff0000u), v2 = __uint_as_float(ov.y << 16), v3 = __uint_as_float(ov.y & 0xffff0000u); \
                    const float ss = row_sum16((v0 * v0 + v1 * v1) + (v2 * v2 + v3 * v3)); \
                    const float rn = __builtin_amdgcn_rsqf(ss * (1.0f / 64.0f) + EPS); \
                    const u32x2 zz = ZQ[it]; \
                    const float z0 = __uint_as_float(zz.x << 16), z1 = __uint_as_float(zz.x & 0xffff0000u), z2 = __uint_as_float(zz.y << 16), z3 = __uint_as_float(zz.y & 0xffff0000u); \
                    const float y0 = v0 * rn * gn[0] * z0, y1 = v1 * rn * gn[1] * z1, y2 = v2 * rn * gn[2] * z2, y3 = v3 * rn * gn[3] * z3;       \
                    { bf16_t* dst_ = ((p >= NMETA) && (p < LTOK)) ? MIX + (size_t)(b * SEQ + p - NMETA) * 1024 + 512 + h * 64 + 4 * vq : DUMP + lane * 4;       \
                      *(u32x2*)dst_ = (u32x2){pk2(y0, y1), pk2(y2, y3)}; } \
                } \
            } \
        } while (0)
DI void gdn_scan(const Params& P, LAS unsigned char* lds, int bh, int tid, int wave, int lane) {
    const int b = bh >> 3, h = bh & 7, r32 = lane & 31, hi = lane >> 5;
    const int task0 = (b * 8 + h) * NCHUNK;
    const bf16_t* GP0 = (const bf16_t*)(P.ws + WS_GP);
    const float* GLg = (const float*)(P.ws + WS_GL);
    const bf16_t* ZB = (const bf16_t*)(P.ws + WS_ZB); bf16_t* MIX = (bf16_t*)(P.ws + WS_MIX); const float* gnorm = P.in[12];
    bf16_t* DUMP = (bf16_t*)(P.ws + WS_DUMP) + bh * 4096 + wave * 512;
    const int lw = wave - 4;
    const int prow = lane >> 3, pch = lane & 7;
#define GS_DMA(n_, stg_) do { LAS unsigned char* sg_ = lds + (stg_) * GS_STAGE; \
        _Pragma("unroll") for (int i = 0; i < 10; ++i) { const int a_ = i >> 1, pi_ = lw * 2 + (i & 1), row_ = 8 * pi_ + prow; \
            const int sch_ = (a_ < 4) ? (pch ^ (row_ & 7)) : pch; \
            __builtin_amdgcn_global_load_lds((const unsigned*)(GP0 + (size_t)a_ * (GP_ARR / 2) + (size_t)(task0 + (n_)) * 4096 + row_ * 64 + sch_ * 8), \
                                             (LAS unsigned*)(sg_ + a_ * 8192 + pi_ * 1024), 16, 0, 0); } \
        __builtin_amdgcn_global_load_lds((const unsigned*)(GLg + task0 + (n_)), (LAS unsigned*)(sg_ + 40960 + lw * 256), 4, 0, 0); } while (0)
    if (wave >= 4) { GS_DMA(0, 0); GS_DMA(1, 1); asm volatile("s_waitcnt vmcnt(11)" ::: "memory"); }
    const int vq = lane & 15, rg = lane >> 4;
    u32x2 zqA[8], zqB[8];
#define GS_ZLOADX(ZQ, n_) do { _Pragma("unroll") for (int it = 0; it < 8; ++it) { int p_ = (n_) * 64 + (wave - 2) * 32 + 4 * it + rg; p_ = p_ < LTOK ? p_ : LTOK - 1; \
            ZQ[it] = *(const u32x2*)(ZB + (size_t)(b * LP + p_) * 512 + h * 64 + 4 * vq); } } while (0)
    if (wave == 2 || wave == 3) { GS_ZLOADX(zqB, 0); }
    BAR_LDS();
    f32x16 S0 = {}, S1 = {};
    const int vbase = 32 * wave;
    if (wave < 2) {
    int stg = 0;
    for (int n = 0; n <= NCHUNK; ++n) {
        {
            if (n < NCHUNK) {
                LAS const unsigned char* sg = lds + stg * GS_STAGE;
                LAS const bf16_t* Wm = (LAS const bf16_t*)sg; LAS const bf16_t* QGm = (LAS const bf16_t*)(sg + 8192); LAS const bf16_t* AQm = (LAS const bf16_t*)(sg + 16384);
                LAS const bf16_t* KGm = (LAS const bf16_t*)(sg + 24576); LAS const bf16_t* Um = (LAS const bf16_t*)(sg + 32768);
                const float gl = *(LAS const float*)(sg + 40960);
                bf16x8 Sb[2][2]; Sb[0][0] = pack8(S0, 0); Sb[0][1] = pack8(S0, 1); Sb[1][0] = pack8(S1, 0); Sb[1][1] = pack8(S1, 1);
                bf16x8 fw[2][4], fq[2][4];
                f32x16 vn[2], o[2];
#pragma unroll
                for (int ct = 0; ct < 2; ++ct)
#pragma unroll
                    for (int k4 = 0; k4 < 4; ++k4) { fw[ct][k4] = lds_frag(Wm, 32 * ct + r32, k4 * 2 + hi); fq[ct][k4] = lds_frag(QGm, 32 * ct + r32, k4 * 2 + hi); }
#pragma unroll
                for (int ct = 0; ct < 2; ++ct)
#pragma unroll
                    for (int i = 0; i < 16; ++i) vn[ct][i] = bf2f(Um[(32 * ct + crow(i, hi)) * 64 + vbase + r32]);
                o[0] = f32x16{}; o[1] = f32x16{};
                __builtin_amdgcn_sched_barrier(0);
#pragma unroll
                for (int k4 = 0; k4 < 4; ++k4) {
                    vn[0] = MFMA32(fw[0][k4], Sb[k4 >> 1][k4 & 1], vn[0]); o[0] = MFMA32(fq[0][k4], Sb[k4 >> 1][k4 & 1], o[0]);
                    vn[1] = MFMA32(fw[1][k4], Sb[k4 >> 1][k4 & 1], vn[1]); o[1] = MFMA32(fq[1][k4], Sb[k4 >> 1][k4 & 1], o[1]);
                }
                __builtin_amdgcn_sched_barrier(0);
                bf16x8 fa[2][4], fk[2][4];
#pragma unroll
                for (int g = 0; g < 4; ++g) { fa[0][g] = lds_frag(AQm, r32, g * 2 + hi); fa[1][g] = lds_frag(AQm, 32 + r32, g * 2 + hi);
                                              fk[0][g] = lds_frag(KGm, r32, g * 2 + hi); fk[1][g] = lds_frag(KGm, 32 + r32, g * 2 + hi); }
#pragma unroll
                for (int i = 0; i < 16; ++i) { S0[i] *= gl; S1[i] *= gl; }
                __builtin_amdgcn_sched_barrier(0);
                bf16x8 Vb[2][2]; Vb[0][0] = pack8(vn[0], 0); Vb[0][1] = pack8(vn[0], 1); Vb[1][0] = pack8(vn[1], 0); Vb[1][1] = pack8(vn[1], 1);
#pragma unroll
                for (int g = 0; g < 4; ++g) {
                    o[0] = MFMA32(fa[0][g], Vb[g >> 1][g & 1], o[0]); S0 = MFMA32(fk[0][g], Vb[g >> 1][g & 1], S0);
                    o[1] = MFMA32(fa[1][g], Vb[g >> 1][g & 1], o[1]); S1 = MFMA32(fk[1][g], Vb[g >> 1][g & 1], S1);
                }
                LAS bf16_t* ob = (LAS bf16_t*)(lds + GS_OBUF + (n & 1) * 8192);
#pragma unroll
                for (int ct = 0; ct < 2; ++ct)
#pragma unroll
                    for (int i = 0; i < 16; ++i) ob[(32 * ct + crow(i, hi)) * 64 + vbase + r32] = (bf16_t)f2bf(o[ct][i]);
            }
        }
        BAR_LDS();
        stg = stg + 1 >= GS_NSTAGE ? 0 : stg + 1;
    }
    } else if (wave < 4) {
    for (int n = 0; n <= NCHUNK; n += 2) {
        GS_POST(n, zqA);     if (n + 1 < NCHUNK) { GS_ZLOADX(zqA, n + 1); } BAR_LDS();
        GS_POST((n + 1), zqB); if (n + 2 < NCHUNK) { GS_ZLOADX(zqB, n + 2); } BAR_LDS();
    }
    } else {
    int stg = 0;
    for (int n = 0; n <= NCHUNK; ++n) {
        {
            if (n + 2 < NCHUNK) { const int s2_ = stg + 2 >= GS_NSTAGE ? stg + 2 - GS_NSTAGE : stg + 2; GS_DMA(n + 2, s2_); asm volatile("s_waitcnt vmcnt(11)" ::: "memory"); }
            else asm volatile("s_waitcnt vmcnt(0)" ::: "memory");
        }
        BAR_LDS();
        stg = stg + 1 >= GS_NSTAGE ? 0 : stg + 1;
    }
    }
#undef GS_DMA
#undef GS_ZLOADX
}
#define XB_TMO      128
#define XB_XCNT(j)  (256  + 64 * (j))
#define XB_XSUB(j)  (1280 + 64 * (j))
#define XB_XGEN(j)  (2304 + 64 * (j))
#define XB_TOP      3328
#define XB_TOPGEN   3392
#define XCD_BAR_WORDS 3456
#define XB_SPIN_CAP (1u << 18)

__device__ __forceinline__ unsigned xb_ld(unsigned* p)              { return __hip_atomic_load(p, __ATOMIC_RELAXED, __HIP_MEMORY_SCOPE_AGENT); }
__device__ __forceinline__ unsigned xb_add(unsigned* p, unsigned v) { return __hip_atomic_fetch_add(p, v, __ATOMIC_RELAXED, __HIP_MEMORY_SCOPE_AGENT); }
__device__ __forceinline__ unsigned xb_xcc_id() { return (unsigned)__builtin_amdgcn_s_getreg((3 << 11) | 20) & 0xFu; }
#define XB_SPIN(cond, bar) do { unsigned _sp = 0; while (cond) { __builtin_amdgcn_s_sleep(1); \
    if ((++_sp & 255u) == 0u) { if (xb_ld(&(bar)[XB_TMO])) break; if (_sp > XB_SPIN_CAP) { atomicAdd(&(bar)[XB_TMO], 1u); break; } } } } while (0)

struct XcdBarrier {
    unsigned* bar; unsigned x;
    volatile LAS unsigned* st;
};

__device__ __forceinline__ XcdBarrier xcd_barrier_post(unsigned* bar, volatile LAS unsigned* st) {
    XcdBarrier b; b.bar = bar; b.x = xb_xcc_id(); b.st = st;
    if (threadIdx.x == 0) (void)xb_add(&bar[XB_XCNT(b.x)], 1u);
    return b;
}
__device__ __forceinline__ void xcd_barrier_complete(unsigned* bar, unsigned x, unsigned& nloc, unsigned& nx) {
    const unsigned G = gridDim.x * gridDim.y * gridDim.z;
    unsigned sum, cnt, mine, sp = 0u;
    for (;;) {
        sum = 0u; cnt = 0u; mine = 0u;
#pragma unroll
        for (unsigned j = 0; j < 16; ++j) { const unsigned c = xb_ld(&bar[XB_XCNT(j)]); sum += c; cnt += (c > 0u) ? 1u : 0u; mine = (j == x) ? c : mine; }
        if (sum == G) break;
        __builtin_amdgcn_s_sleep(1);
        if ((++sp & 255u) == 0u) { if (xb_ld(&bar[XB_TMO])) break; if (sp > XB_SPIN_CAP) { atomicAdd(&bar[XB_TMO], 1u); break; } }
    }
    nloc = mine > 0u ? mine : 1u; nx = cnt > 0u ? cnt : 1u;
}

__device__ __forceinline__ void xcd_barrier(const XcdBarrier& b) {
    asm volatile("s_waitcnt vmcnt(0)" ::: "memory");
    __syncthreads();
    if (threadIdx.x == 0) {
        unsigned* bar = b.bar;
        __builtin_amdgcn_s_waitcnt(0);
        unsigned nloc = b.st[0], nx = b.st[1];
        if (nloc == 0u) { xcd_barrier_complete(bar, b.x, nloc, nx); b.st[0] = nloc; b.st[1] = nx; }
        const unsigned old = xb_add(&bar[XB_XSUB(b.x)], 1u);
        const unsigned gen = old / nloc;
        if (old + 1u == (gen + 1u) * nloc) {
            __builtin_amdgcn_fence(__ATOMIC_RELEASE, "agent");
            asm volatile("s_waitcnt vmcnt(0)" ::: "memory");
            const unsigned og = xb_add(&bar[XB_TOP], 1u);
            const unsigned tg = og / nx;
            if (og + 1u == (tg + 1u) * nx) xb_add(&bar[XB_TOPGEN], 1u);
            else XB_SPIN(xb_ld(&bar[XB_TOPGEN]) == tg, bar);
            __builtin_amdgcn_fence(__ATOMIC_ACQUIRE, "agent");
            xb_add(&bar[XB_XGEN(b.x)], 1u);
            asm volatile("s_waitcnt vmcnt(0)" ::: "memory");
        } else {
            XB_SPIN(xb_ld(&bar[XB_XGEN(b.x)]) == gen, bar);
            __builtin_amdgcn_fence(__ATOMIC_ACQUIRE, "agent");
            asm volatile("s_waitcnt vmcnt(0)" ::: "memory");
        }
    }
    __syncthreads();
}


constexpr int AT_STAGE = 32768;
constexpr int AT_NSTAGE = 3;
constexpr int AT_XBUF = 0;
constexpr int AT_WSF = AT_NSTAGE * AT_STAGE;
constexpr int AT_UNIT = AT_WSF + 2048;
constexpr float AT_THR = 8.0f;

DI float max3f(float a, float b, float c) { return __builtin_fmaxf(__builtin_fmaxf(a, b), c); }
DI s16x4 tr_read(LAS const unsigned char* p) { return __builtin_bit_cast(s16x4, __builtin_amdgcn_ds_read_tr16_b64_v4i16((LAS v4i16_t*)p)); }

template <int VAR> DI void attn_unit(const Params& P, LAS unsigned char* lds, int bh, int qi, int tid, int wave, int lane, float lam) {
    const int b = bh >> 2, h = bh & 3, r32 = lane & 31, hi = lane >> 5, qsub = wave >> 1, map = wave & 1, hh = 2 * h + map;
    const bf16_t* QB = (const bf16_t*)(P.ws + WS_QB); const bf16_t* KT = (const bf16_t*)(P.ws + WS_KT); const bf16_t* VT = (const bf16_t*)(P.ws + WS_VT);
    const int ntiles = 2 * qi + 3, my_nt = (qsub < 2) ? ntiles - 1 : ntiles;
    const bf16_t* k1 = KT + ((size_t)((b * 8 + 2 * h) * NKT) << 12) + tid * 8;
    const bf16_t* k2 = KT + ((size_t)((b * 8 + 2 * h + 1) * NKT) << 12) + tid * 8;
    const bf16_t* vv = VT + ((size_t)((b * 4 + h) * NKT) << 13) + tid * 8;
#define AT_DMA(t, sb) do { LAS unsigned char* d_ = lds + (sb) * AT_STAGE + wave * 1024; \
        __builtin_amdgcn_global_load_lds((const unsigned*)(k1 + ((size_t)(t) << 12)), (LAS unsigned*)d_, 16, 0, 0); \
        __builtin_amdgcn_global_load_lds((const unsigned*)(k2 + ((size_t)(t) << 12)), (LAS unsigned*)(d_ + 8192), 16, 0, 0); \
        __builtin_amdgcn_global_load_lds((const unsigned*)(vv + ((size_t)(t) << 13)), (LAS unsigned*)(d_ + 16384), 16, 0, 0); \
        __builtin_amdgcn_global_load_lds((const unsigned*)(vv + ((size_t)(t) << 13) + 4096), (LAS unsigned*)(d_ + 24576), 16, 0, 0); } while (0)
    bf16x8 qr[4];
    { const bf16_t* q = QB + ((size_t)((b * 8 + hh) * SEQ + qi * 128 + qsub * 32 + r32) << 6) + hi * 8;
#pragma unroll
      for (int d0 = 0; d0 < 4; ++d0) qr[d0] = *(const bf16x8*)(q + d0 * 16); }
    asm volatile("s_waitcnt vmcnt(0)" : "+v"(qr[0]), "+v"(qr[1]), "+v"(qr[2]), "+v"(qr[3]) :: "memory");
    AT_DMA(0, 0);
    if (ntiles > 1) AT_DMA(1, 1);
    if (ntiles > 1) asm volatile("s_waitcnt vmcnt(4)" ::: "memory"); else asm volatile("s_waitcnt vmcnt(0)" ::: "memory");
    BAR_LDS();
    LAS float* wsf = (LAS float*)(lds + AT_WSF) + wave * 64;
    float m_run = 0.f, l_run = 0.f;
    f32x16 negm = {};
    f32x16 o[4]; o[0] = f32x16{}; o[1] = f32x16{}; o[2] = f32x16{}; o[3] = f32x16{};
    for (int t = 0; t < ntiles; ++t) {
        if (t + 2 < ntiles) AT_DMA(t + 2, (t + 2) % AT_NSTAGE);
        if (t < my_nt) {
            LAS const unsigned char* sg = lds + (t % AT_NSTAGE) * AT_STAGE;
            LAS const unsigned char* kb = sg + map * 8192 + hi * 1024 + r32 * 16;
            f32x16 p0 = negm, p1 = negm;
            bf16x8 kf[8];
#pragma unroll
            for (int d0 = 0; d0 < 4; ++d0) { kf[2 * d0] = *(LAS const bf16x8*)(kb + d0 * 2048); kf[2 * d0 + 1] = *(LAS const bf16x8*)(kb + d0 * 2048 + 512); }
            __builtin_amdgcn_sched_barrier(0);
            __builtin_amdgcn_s_setprio(1);
#pragma unroll
            for (int d0 = 0; d0 < 4; ++d0) { p0 = MFMA32(kf[2 * d0], qr[d0], p0); p1 = MFMA32(kf[2 * d0 + 1], qr[d0], p1); }
            __builtin_amdgcn_s_setprio(0);
            const bool first = (t == 0);
            if (first) {
#pragma unroll
                for (int r = 0; r < 16; ++r) { if (crow(r, hi) >= NMETA) p0[r] = -INFINITY; p1[r] = -INFINITY; }
            }
            float ma = max3f(p0[0], p0[1], p1[0]), mb = max3f(p0[2], p0[3], p1[1]); ma = max3f(ma, p1[2], p1[3]);
#pragma unroll
            for (int r = 4; r < 16; r += 4) { ma = max3f(ma, p0[r], p0[r + 1]); mb = max3f(mb, p0[r + 2], p0[r + 3]); ma = max3f(ma, p1[r], p1[r + 1]); mb = max3f(mb, p1[r + 2], p1[r + 3]); }
            const float rm = swap32_max(max3f(ma, mb, mb));
            if (first || __any(rm > AT_THR)) {
                const float dl = first ? rm : fmaxf(rm, 0.f);
                m_run += dl;
#pragma unroll
                for (int r = 0; r < 16; ++r) { p0[r] -= dl; p1[r] -= dl; negm[r] = -m_run; }
                const float alpha = __builtin_amdgcn_exp2f(-dl);
                l_run *= alpha;
                if (!first) {
                    if (hi == 0) wsf[r32] = alpha;
                    LDS_WAIT();
#pragma unroll
                    for (int r = 0; r < 16; ++r) { const float a = wsf[crow(r, hi)];
#pragma unroll
                        for (int d0 = 0; d0 < 4; ++d0) o[d0][r] *= a; }
                    LDS_WAIT();
                }
            }
            float ls0 = 0.f, ls1 = 0.f;
#pragma unroll
            for (int r = 0; r < 16; ++r) { if (VAR != 2) { p0[r] = __builtin_amdgcn_exp2f(p0[r]); p1[r] = __builtin_amdgcn_exp2f(p1[r]); } ls0 += p0[r]; ls1 += p1[r]; }
            l_run += ls0 + ls1;
            const bf16x8 pa0 = pack8(p0, 0), pa1 = pack8(p0, 1), pa2 = pack8(p1, 0), pa3 = pack8(p1, 1);
            LAS const unsigned char* vb = sg + 16384 + ((lane >> 4) & 1) * 32 + (lane & 3) * 8 + (4 * hi + ((lane & 15) >> 2)) * 64;
            s16x4 va_[8], vb_[8];
            const unsigned vba = (unsigned)(uintptr_t)vb;
#define AT_VLD(V, d0_) do { _Pragma("unroll") for (int ks = 0; ks < 4; ++ks) { \
                asm volatile("ds_read_b64_tr_b16 %0, %1 offset:%c2" : "=v"(V[2 * ks]) : "v"(vba), "i"((d0_) * 4096 + ks * 1024)); \
                asm volatile("ds_read_b64_tr_b16 %0, %1 offset:%c2" : "=v"(V[2 * ks + 1]) : "v"(vba), "i"((d0_) * 4096 + ks * 1024 + 512)); } } while (0)
#define AT_VF(V, ks) ((bf16x8){V[2 * (ks)][0], V[2 * (ks)][1], V[2 * (ks)][2], V[2 * (ks)][3], V[2 * (ks) + 1][0], V[2 * (ks) + 1][1], V[2 * (ks) + 1][2], V[2 * (ks) + 1][3]})
#define AT_WAITL(n, V) do { asm volatile("s_waitcnt lgkmcnt(" #n ")" : "+v"(V[0]), "+v"(V[1]), "+v"(V[2]), "+v"(V[3]), "+v"(V[4]), "+v"(V[5]), "+v"(V[6]), "+v"(V[7])); __builtin_amdgcn_sched_barrier(0); } while (0)
#define AT_PV(V, d0_) do { __builtin_amdgcn_s_setprio(1); o[d0_] = MFMA32(pa0, AT_VF(V, 0), o[d0_]); o[d0_] = MFMA32(pa1, AT_VF(V, 1), o[d0_]); o[d0_] = MFMA32(pa2, AT_VF(V, 2), o[d0_]); o[d0_] = MFMA32(pa3, AT_VF(V, 3), o[d0_]); __builtin_amdgcn_s_setprio(0); } while (0)
            if (VAR != 1) {
            asm volatile("s_waitcnt lgkmcnt(0)" ::: "memory"); __builtin_amdgcn_sched_barrier(0);
            AT_VLD(va_, 0); AT_VLD(vb_, 1);
            AT_WAITL(8, va_); AT_PV(va_, 0); __builtin_amdgcn_sched_barrier(0); AT_VLD(va_, 2);
            AT_WAITL(8, vb_); AT_PV(vb_, 1); __builtin_amdgcn_sched_barrier(0); AT_VLD(vb_, 3);
            AT_WAITL(8, va_); AT_PV(va_, 2); __builtin_amdgcn_sched_barrier(0);
            AT_WAITL(0, vb_); AT_PV(vb_, 3);
            } else { o[0][0] += (float)pa0[0] + (float)pa1[1] + (float)pa2[2] + (float)pa3[3]; }
#undef AT_VF
#undef AT_WAITL
#undef AT_VLD
#undef AT_PV
        }
        if (t + 2 < ntiles) asm volatile("s_waitcnt vmcnt(4)" ::: "memory"); else asm volatile("s_waitcnt vmcnt(0)" ::: "memory");
        BAR_LDS();
    }
    if (VAR != 0) { if (o[0][0] + o[1][1] + o[2][2] + o[3][3] + l_run == 123.456f) ((float*)(P.ws + WS_DUMP))[tid] = 1.f; __syncthreads(); return; }
    l_run = swap32_add(l_run);
    const float sc = (map ? lam : 1.0f) / l_run;
    if (hi == 0) wsf[r32] = sc;
    LDS_WAIT();
#pragma unroll
    for (int r = 0; r < 16; ++r) { const float a = wsf[crow(r, hi)];
#pragma unroll
        for (int d0 = 0; d0 < 4; ++d0) o[d0][r] *= a; }
    LAS float* xb = (LAS float*)(lds + AT_XBUF + qsub * 16384);
    if (map) {
#pragma unroll
        for (int d0 = 0; d0 < 4; ++d0)
#pragma unroll
            for (int r = 0; r < 16; ++r) xb[(d0 * 16 + r) * 64 + lane] = o[d0][r];
    }
    __syncthreads();
    if (!map) {
        const float* dn = P.in[8];
        bf16_t* MIX = (bf16_t*)(P.ws + WS_MIX);
        float ss[16];
#pragma unroll
        for (int r = 0; r < 16; ++r) { ss[r] = 0.f;
#pragma unroll
            for (int d0 = 0; d0 < 4; ++d0) { o[d0][r] -= xb[(d0 * 16 + r) * 64 + lane]; ss[r] += o[d0][r] * o[d0][r]; } }
#pragma unroll
        for (int r = 0; r < 16; ++r) {
            ss[r] = half_sum32(ss[r]);
            ss[r] = 0.8f / sqrtf(ss[r] * (1.0f / 128.0f) + EPS);
        }
        float dg[4];
#pragma unroll
        for (int d0 = 0; d0 < 4; ++d0) dg[d0] = dn[32 * d0 + r32];
#pragma unroll
        for (int r = 0; r < 16; ++r) {
            bf16_t* orow = MIX + (size_t)(b * SEQ + qi * 128 + qsub * 32 + crow(r, hi)) * 1024 + h * 128 + r32;
#pragma unroll
            for (int d0 = 0; d0 < 4; ++d0) orow[32 * d0] = (bf16_t)f2bf(o[d0][r] * ss[r] * dg[d0]);
        }
    }
    __syncthreads();
#undef AT_DMA
}

template <int VAR> DI void attn_phase(const Params& P, LAS unsigned char* lds, int tid, int wave, int lane) {
    unsigned* ctl = (unsigned*)(P.ws + WS_CTL);
    const float* lq1 = P.in[4]; const float* lk1 = P.in[5]; const float* lq2 = P.in[6]; const float* lk2 = P.in[7];
    const float lam = __expf(wave_sum(lq1[lane] * lk1[lane])) - __expf(wave_sum(lq2[lane] * lk2[lane])) + 0.2f;
    LAS volatile int* ub = (LAS volatile int*)(lds + AT_UNIT);
    const unsigned x0 = xb_xcc_id() & 7u;
    for (;;) {
        if (tid == 0) {
            int u = -1;
            for (unsigned j = 0; j < 8u && u < 0; ++j) { const unsigned x = (x0 + j) & 7u;
                if (__hip_atomic_load(ctl + CW_ATTQ + 64 * x, __ATOMIC_RELAXED, __HIP_MEMORY_SCOPE_AGENT) >= 64u) continue;
                const unsigned i = __hip_atomic_fetch_add(ctl + CW_ATTQ + 64 * x, 1u, __ATOMIC_RELAXED, __HIP_MEMORY_SCOPE_AGENT);
                if (i < 64u) u = (int)(x * 64u + i); }
            *ub = u;
        }
        __syncthreads();
        const int u = *ub;
        __syncthreads();
        if (u < 0) break;
        attn_unit<VAR>(P, lds, u >> 6, 63 - (u & 63), tid, wave, lane, lam);
    }
}

struct EpiOutProj {
    static constexpr bool PERM = false, AFTER_DRAIN = false;
    const float* x; float* out; bf16_t* u2;
    DI void operator()(const pg8::f32x4 (&acc)[2][2][4][2], const pg8::Unit& u, int wr, int wc, int fr, int fq) const {
        const int row0 = u.pm * 256 + wr * 64 + fr, col0 = u.pn * 256 + wc * 32 + 4 * fq;
#pragma unroll
        for (int ai = 0; ai < 2; ++ai) {
            f32x4 xv[4][2][2];
#pragma unroll
            for (int m = 0; m < 4; ++m) { const size_t off = (size_t)(row0 + ai * 128 + m * 16) * 1024 + col0;
#pragma unroll
                for (int bj = 0; bj < 2; ++bj)
#pragma unroll
                    for (int n = 0; n < 2; ++n) xv[m][bj][n] = *(const f32x4*)(x + off + bj * 128 + n * 16); }
#pragma unroll
            for (int m = 0; m < 4; ++m) { const size_t off = (size_t)(row0 + ai * 128 + m * 16) * 1024 + col0;
#pragma unroll
                for (int bj = 0; bj < 2; ++bj)
#pragma unroll
                    for (int n = 0; n < 2; ++n) { const f32x4 hv = acc[ai][bj][m][n] + xv[m][bj][n]; *(f32x4*)(out + off + bj * 128 + n * 16) = hv;
                        *(u32x2*)(u2 + off + bj * 128 + n * 16) = (u32x2){pk2(hv[0], hv[1]), pk2(hv[2], hv[3])}; } }
        }
    }
};

typedef float f32x4v __attribute__((ext_vector_type(4)));
#ifdef ROUTE_PROBE
#define ROUTE_MID_HOOK() do { XcdBarrier xb2; xb2.bar = (unsigned*)(P.ws + WS_CTL) + CW_BAR; xb2.x = xb_xcc_id(); xb2.st = (volatile LAS unsigned*)(ldsb + LDS_BYTES - 64); xcd_barrier(xb2); \
    if (blockIdx.x == 0 && threadIdx.x == 0) __hip_atomic_store((unsigned long long*)(P.ws + WS_CTL + 65536) + 20, (unsigned long long)__builtin_amdgcn_s_memrealtime(), __ATOMIC_RELAXED, __HIP_MEMORY_SCOPE_AGENT); } while (0)
#else
#define ROUTE_MID_HOOK() do {} while (0)
#endif
DI void route_tile(const Params& P, int tile, int par, LAS float* sc  , int lane, LAS unsigned char* ldsb) {
    const float* h2 = P.out; const float* WR = (const float*)(P.ws + WS_WR);
    const int r16 = lane & 15, kq = lane >> 4;
    const float* arow = h2 + (size_t)(tile * 16 + r16) * 1024 + par * 512 + kq * 8;
    const float* b0 = WR + (size_t)r16 * 1024 + par * 512 + kq * 8; const float* b1 = b0 + 16 * 1024; const float* b2 = WR + (size_t)(32 + (r16 & 3)) * 1024 + par * 512 + kq * 8;
    const float z2 = (r16 < 4) ? 1.0f : 0.0f;
    f32x4v c0 = {}, c1 = {}, c2 = {};
    float ss = 0.f;
    f32x4 bA[4][4], bB[4][4];
#define RT_LOAD(B, tb) do { _Pragma("unroll") for (int j = 0; j < 4; ++j) { const int o_ = 32 * ((tb) + (j >> 1)) + 4 * (j & 1); \
        B[j][0] = *(const f32x4*)(arow + o_); B[j][1] = *(const f32x4*)(b0 + o_); B[j][2] = *(const f32x4*)(b1 + o_); B[j][3] = *(const f32x4*)(b2 + o_); } } while (0)
#define RT_COMP(B) do { _Pragma("unroll") for (int j = 0; j < 4; ++j) { const f32x4 a = B[j][0]; ss += (a.x * a.x + a.y * a.y) + (a.z * a.z + a.w * a.w); \
        _Pragma("unroll") for (int i = 0; i < 4; ++i) { c0 = __builtin_amdgcn_mfma_f32_16x16x4f32(a[i], B[j][1][i], c0, 0, 0, 0); \
            c1 = __builtin_amdgcn_mfma_f32_16x16x4f32(a[i], B[j][2][i], c1, 0, 0, 0); c2 = __builtin_amdgcn_mfma_f32_16x16x4f32(a[i], B[j][3][i] * z2, c2, 0, 0, 0); } } } while (0)
    RT_LOAD(bA, 0);
#pragma unroll
    for (int tb = 0; tb < 16; tb += 4) {
        RT_LOAD(bB, tb + 2); __builtin_amdgcn_sched_barrier(0); RT_COMP(bA); __builtin_amdgcn_sched_barrier(0);
        if (tb + 4 < 16) { RT_LOAD(bA, tb + 4); } __builtin_amdgcn_sched_barrier(0); RT_COMP(bB); __builtin_amdgcn_sched_barrier(0); }
#undef RT_LOAD
#undef RT_COMP
    ss += swz_xor16(ss); ss = swap32_add(ss);
    LAS float* my = sc + par * 800;
#pragma unroll
    for (int r = 0; r < 4; ++r) { const int row = 4 * kq + r; my[row * 48 + r16] = c0[r]; my[row * 48 + 16 + r16] = c1[r]; my[row * 48 + 32 + r16] = c2[r]; }
    if (lane < 16) my[768 + lane] = ss;
    LAS int* lcnt = (LAS int*)(ldsb + 4 * 32768 + 1024);
    if (threadIdx.x < 32) lcnt[threadIdx.x] = 0;
    int pa = 0, pb = 0, ea_ = 0, eb_ = 0; float w1_ = 0.f, w2_ = 0.f, rs_ = 0.f;
    LDS_WAIT();
    __syncthreads();
    ROUTE_MID_HOOK();
    if (par == 0 && lane < 16) {
        LAS const float* l0 = sc + lane * 48; LAS const float* l1 = sc + 800 + lane * 48;
        const float rs = __builtin_amdgcn_rsqf((sc[768 + lane] + sc[800 + 768 + lane]) * (1.0f / 1024.0f) + EPS);
#define LG(j) (l0[j] + l1[j])
        const int t = tile * 16 + lane;
        const float* bg = P.in[16]; const float* br = P.in[18];
        float gl[4]; int gs = 0; float gm;
#pragma unroll
        for (int j = 0; j < 4; ++j) gl[j] = LG(j) * rs + bg[j];
        gm = gl[0];
#pragma unroll
        for (int j = 1; j < 4; ++j) if (gl[j] > gm) { gm = gl[j]; gs = j; }
        float gsum = 0.f;
#pragma unroll
        for (int j = 0; j < 4; ++j) gsum += __expf(gl[j] - gm);
        const float psel = 1.0f / gsum;
        float e1 = -INFINITY, e2 = -INFINITY; int i1 = 0, i2 = 0;
#pragma unroll
        for (int j = 0; j < 8; ++j) {
            const float v = LG(4 + gs * 8 + j) * rs + br[gs * 8 + j];
            if (v > e1) { e2 = e1; i2 = i1; e1 = v; i1 = j; } else if (v > e2) { e2 = v; i2 = j; }
        }
        const float x2 = __expf(e2 - e1), w1 = psel / (1.0f + x2), w2 = psel * x2 / (1.0f + x2);
        const int ea = gs * 8 + i1, eb = gs * 8 + i2;
        pa = (int)__hip_atomic_fetch_add(lcnt + ea, 1, __ATOMIC_RELAXED, __HIP_MEMORY_SCOPE_WORKGROUP); pb = (int)__hip_atomic_fetch_add(lcnt + eb, 1, __ATOMIC_RELAXED, __HIP_MEMORY_SCOPE_WORKGROUP);
        ea_ = ea; eb_ = eb; w1_ = w1; w2_ = w2; rs_ = rs;
        ((int*)(P.ws + WS_TOKE))[2 * t] = ea; ((int*)(P.ws + WS_TOKE))[2 * t + 1] = eb;
        ((float*)(P.ws + WS_TOKW))[2 * t] = w1; ((float*)(P.ws + WS_TOKW))[2 * t + 1] = w2;
        ((float*)(P.ws + WS_RS2))[t] = rs;
#undef LG
    }
    LDS_WAIT();
    __syncthreads();
    if (threadIdx.x < 32) { const int c = lcnt[threadIdx.x];
        lcnt[32 + threadIdx.x] = c ? (int)atomicAdd((unsigned*)(P.ws + WS_CTL) + CW_CNT + 64 * threadIdx.x, (unsigned)c) : 0; }
    LDS_WAIT();
    __syncthreads();
    if (par == 0 && lane < 16) { const int t = tile * 16 + lane;
        const int qa = lcnt[32 + ea_] + pa, qb = lcnt[32 + eb_] + pb;
        ((int*)(P.ws + WS_TOKP))[2 * t] = qa; ((int*)(P.ws + WS_TOKP))[2 * t + 1] = qb;
        ((int*)(P.ws + WS_LIST))[ea_ * 16384 + qa] = t; ((int*)(P.ws + WS_LIST))[eb_ * 16384 + qb] = t;
        ((float*)(P.ws + WS_LISTW))[ea_ * 16384 + qa] = w1_; ((float*)(P.ws + WS_LISTW))[eb_ * 16384 + qb] = w2_;
        ((float*)(P.ws + WS_LISTRS))[ea_ * 16384 + qa] = rs_; ((float*)(P.ws + WS_LISTRS))[eb_ * 16384 + qb] = rs_; }
    LDS_WAIT();
    __syncthreads();
}

#ifndef P4A_REP
#define P4A_REP 0
#endif
template <int P4A_PART> DI void phase4a(const Params& P, LAS unsigned char* lds, int gw, int NGW, int wave, int lane) {
    LAS float* scr = (LAS float*)(lds + wave * 16384);
    if (P4A_PART & 1) for (int tile = (gw >> 1); tile < MTOK / 16; tile += (NGW >> 1)) route_tile(P, tile, wave & 1, (LAS float*)(lds + (wave >> 1) * 32768), lane, lds);
    if (!(P4A_PART & 2)) return;
    bf16_t* WGU = (bf16_t*)(P.ws + WS_WGU); bf16_t* WD = (bf16_t*)(P.ws + WS_WD);
    const float* wg = P.in[19]; const float* wu = P.in[20]; const float* wd = P.in[21]; const float* gf = P.in[14];
    constexpr int I_GU = 16 * 16, I_D = 4 * 32, NIT = 32 * (I_GU + I_D);
    struct TItem { const float* src; const float* gn; bf16_t* dst; int stride, ldk; };
    auto mk = [&](int it) { TItem d; const int e = it / (I_GU + I_D), r = it % (I_GU + I_D);
        if (r < I_GU) { const int n0 = (r & 15) * 32, j = n0 >> 8, up = (n0 >> 7) & 1, k0 = (r >> 4) * 64;
            d.src = (up ? wu : wg) + (size_t)e * 1024 * 256 + (size_t)k0 * 256 + 128 * j + (n0 & 127); d.gn = gf + k0; d.stride = 256; d.ldk = 1024;
            d.dst = WGU + (size_t)e * 512 * 1024 + (size_t)n0 * 1024 + k0; }
        else { const int r2 = r - I_GU, k0 = (r2 >> 5) * 64, n0 = (r2 & 31) * 32;
            d.src = wd + (size_t)e * 256 * 1024 + (size_t)k0 * 1024 + n0; d.gn = nullptr; d.stride = 1024; d.ldk = 256;
            d.dst = WD + (size_t)e * 1024 * 256 + (size_t)n0 * 256 + k0; }
        return d; };
#define TI_LOAD(D, V) do { _Pragma("unroll") for (int i = 0; i < 32; ++i) { const int kk = 2 * i + (lane >> 5); \
        V[i] = D.src[(size_t)kk * D.stride + (lane & 31)] * (D.gn ? D.gn[kk] : 1.0f); } } while (0)
#define TI_FIN(D, V) do { _Pragma("unroll") for (int i = 0; i < 32; ++i) scr[(2 * i + (lane >> 5)) * 33 + (lane & 31)] = V[i]; \
        LDS_WAIT(); const int c_ = lane & 7; \
        _Pragma("unroll") for (int j = 0; j < 4; ++j) { const int n_ = (lane >> 3) + 8 * j; const LAS float* s_ = scr + (8 * c_) * 33 + n_; \
            u32x4 o_; o_.x = pk2(s_[0 * 33], s_[1 * 33]); o_.y = pk2(s_[2 * 33], s_[3 * 33]); o_.z = pk2(s_[4 * 33], s_[5 * 33]); o_.w = pk2(s_[6 * 33], s_[7 * 33]); \
            *(u32x4*)(D.dst + (size_t)n_ * D.ldk + 8 * c_) = o_; } \
        LDS_WAIT(); } while (0)
    for (int rp_ = 0; rp_ < (P4A_REP ? 2 : 1); ++rp_) {
        float va[32], vb[32];
        int it = gw;
        if (it < NIT) { TItem da = mk(it); TI_LOAD(da, va);
            for (;;) {
                const int itb = it + NGW; TItem db = da; const bool hb = itb < NIT;
                if (hb) { db = mk(itb); TI_LOAD(db, vb); }
                TI_FIN(da, va);
                if (!hb) break;
                it = itb + NGW; const bool ha = it < NIT;
                if (ha) { da = mk(it); TI_LOAD(da, va); }
                TI_FIN(db, vb);
                if (!ha) break;
            }
        }
    }
#undef TI_LOAD
#undef TI_FIN
}

DI void expert_layout(const Params& P, int lane, int& cnt, int& base, int& tend) {
    const unsigned* c = (const unsigned*)(P.ws + WS_CTL) + CW_CNT;
    cnt = (lane < 32) ? (int)__hip_atomic_load(c + 64 * lane, __ATOMIC_RELAXED, __HIP_MEMORY_SCOPE_AGENT) : 0;
    const int tiles = (cnt + 255) >> 8;
    int inc = 0;
#pragma unroll
    for (int i = 0; i < 32; ++i) { const int ti = __builtin_amdgcn_readlane(tiles, i); inc += (i <= lane) ? ti : 0; }
    tend = inc; base = (inc - tiles) << 8;
}

DI void phase4b(const Params& P, int gw, int NGW, int lane) {
    int cnt, base, tend; expert_layout(P, lane, cnt, base, tend);
    bf16_t* XS = (bf16_t*)(P.ws + WS_XS); float* SLOTW = (float*)(P.ws + WS_SLOTW);
    const int* TOKE = (const int*)(P.ws + WS_TOKE); const float* TOKW = (const float*)(P.ws + WS_TOKW); int* TOKP = (int*)(P.ws + WS_TOKP); const float* RS2 = (const float*)(P.ws + WS_RS2);
    for (int t = gw; t < MTOK; t += NGW) {
        const f32x4* hr = (const f32x4*)(P.out + (size_t)t * 1024);
        const float rs = RS2[t];
        u32x2 w[4];
#pragma unroll
        for (int j = 0; j < 4; ++j) { const f32x4 v = hr[64 * j + lane]; w[j] = (u32x2){pk2(v.x * rs, v.y * rs), pk2(v.z * rs, v.w * rs)}; }
#pragma unroll
        for (int k = 0; k < 2; ++k) {
            const int e = __builtin_amdgcn_readfirstlane(TOKE[2 * t + k]), slot = __builtin_amdgcn_readlane(base, e) + TOKP[2 * t + k];
            u32x2* orow = (u32x2*)(XS + (size_t)slot * 1024);
#pragma unroll
            for (int j = 0; j < 4; ++j) orow[64 * j + lane] = w[j];
            if (lane == 0) { SLOTW[slot] = TOKW[2 * t + k]; TOKP[2 * t + k] = slot; }
        }
    }
    for (int e = 0; e < 32; ++e) {
        const int ce = __builtin_amdgcn_readlane(cnt, e), be = __builtin_amdgcn_readlane(base, e), end = be + (((ce + 255) >> 8) << 8);
        for (int r = be + ce + gw; r < end; r += NGW) { u32x2* orow = (u32x2*)(XS + (size_t)r * 1024);
#pragma unroll
            for (int j = 0; j < 4; ++j) orow[64 * j + lane] = (u32x2){0u, 0u};
            if (lane == 0) SLOTW[r] = 0.f; }
    }
}

struct GroupedOrder {
    int tend; int total; int G, c, NS; int cnt, base; const int* LIST;
    DI unsigned rowoff(const pg8::Unit& u, int r) const {
        const int e = __builtin_amdgcn_readfirstlane(u.pn >> NS), ce = __builtin_amdgcn_readlane(cnt, e), t0 = __builtin_amdgcn_readlane(base, e) >> 8;
        const int pos = (u.pm - t0) * 256 + r;
        const int tok = pos < ce ? LIST[e * 16384 + pos] : 0;
        return (unsigned)tok * 2048u;
    }
    DI bool next(int i, pg8::Unit& u) const {
        const int L = i * G + c; if (L >= (total << NS)) return false;
        const int mt = L >> NS, j = L & ((1 << NS) - 1);
        const int e = __builtin_popcountll(__ballot(((int)(threadIdx.x & 63) < 32) && tend <= mt));
        u.pm = mt; u.pn = (e << NS) + j; return true;
    }
    DI void a_ready(const pg8::Unit&) const {}
    DI void done(const pg8::Unit&) const {}
};
struct EpiGateUp {
    static constexpr bool PERM = true, AFTER_DRAIN = false;
    const float* LISTW; const float* LISTRS; bf16_t* YS; int cnt, base;
    DI void operator()(const pg8::f32x4 (&acc)[2][2][4][2], const pg8::Unit& u, int wr, int wc, int fr, int fq) const {
        const int f0 = (u.pn & 1) * 128 + wc * 32 + fq * 8;
        const int e = __builtin_amdgcn_readfirstlane(u.pn >> 1), ce = __builtin_amdgcn_readlane(cnt, e), t0 = __builtin_amdgcn_readlane(base, e) >> 8;
#pragma unroll
        for (int ai = 0; ai < 2; ++ai)
#pragma unroll
            for (int m = 0; m < 4; ++m) {
                const int r = ai * 128 + wr * 64 + m * 16 + fr, row = u.pm * 256 + r, pos = (u.pm - t0) * 256 + r;
                const bool ok = pos < ce;
                const float cw = ok ? LISTW[e * 16384 + pos] : 0.f, rs = ok ? LISTRS[e * 16384 + pos] : 0.f, cr = cw * rs;
                float a[8];
#pragma unroll
                for (int i = 0; i < 4; ++i) {
                    const float g0 = acc[ai][0][m][0][i] * rs, g1 = acc[ai][0][m][1][i] * rs;
                    a[i] = g0 * __builtin_amdgcn_rcpf(1.0f + __expf(-g0)) * acc[ai][1][m][0][i] * cr; a[4 + i] = g1 * __builtin_amdgcn_rcpf(1.0f + __expf(-g1)) * acc[ai][1][m][1][i] * cr;
                }
                *(u32x4*)(YS + (size_t)row * 256 + f0) = (u32x4){pk2(a[0], a[1]), pk2(a[2], a[3]), pk2(a[4], a[5]), pk2(a[6], a[7])};
            }
    }
};
struct EpiDown {
    static constexpr bool PERM = true, AFTER_DRAIN = false;
    bf16_t* YO;
    DI void operator()(const pg8::f32x4 (&acc)[2][2][4][2], const pg8::Unit& u, int wr, int wc, int fr, int fq) const {
        const int c0 = (u.pn & 3) * 256 + wc * 32 + fq * 8;
#pragma unroll
        for (int ai = 0; ai < 2; ++ai)
#pragma unroll
            for (int m = 0; m < 4; ++m) {
                bf16_t* rowp = YO + (size_t)(u.pm * 256 + ai * 128 + wr * 64 + m * 16 + fr) * 1024 + c0;
#pragma unroll
                for (int bj = 0; bj < 2; ++bj) { const pg8::f32x4 v0 = acc[ai][bj][m][0], v1 = acc[ai][bj][m][1];
                    *(u32x4*)(rowp + bj * 128) = (u32x4){pk2(v0[0], v0[1]), pk2(v0[2], v0[3]), pk2(v1[0], v1[1]), pk2(v1[2], v1[3])}; }
            }
    }
};

DI void phase7(const Params& P, int gw, int NGW, int lane) {
    int cnt_, base_, tend_; expert_layout(P, lane, cnt_, base_, tend_);
    const bf16_t* YO = (const bf16_t*)(P.ws + WS_YO); const int* TOKP = (const int*)(P.ws + WS_TOKP); const int* TOKE = (const int*)(P.ws + WS_TOKE); const f32x4* nf = (const f32x4*)P.in[22];
    f32x4 nfv[4];
#pragma unroll
    for (int j = 0; j < 4; ++j) nfv[j] = nf[64 * j + lane];
    for (int t0 = gw; t0 < MTOK; t0 += 2 * NGW) {
        f32x4 v[2][4]; u32x2 ya[2][4], yb[2][4];
#pragma unroll
        for (int r = 0; r < 2; ++r) { const int t = (t0 + r * NGW) < MTOK ? (t0 + r * NGW) : t0;
            const f32x4* hr = (const f32x4*)(P.out + (size_t)t * 1024);
            const int e0 = __builtin_amdgcn_readfirstlane(TOKE[2 * t]), e1 = __builtin_amdgcn_readfirstlane(TOKE[2 * t + 1]);
            const int s0 = __builtin_amdgcn_readlane(base_, e0) + TOKP[2 * t], s1 = __builtin_amdgcn_readlane(base_, e1) + TOKP[2 * t + 1];
            const u32x2* y0 = (const u32x2*)(YO + (size_t)s0 * 1024); const u32x2* y1 = (const u32x2*)(YO + (size_t)s1 * 1024);
#pragma unroll
            for (int j = 0; j < 4; ++j) { v[r][j] = hr[64 * j + lane]; ya[r][j] = y0[64 * j + lane]; yb[r][j] = y1[64 * j + lane]; } }
#pragma unroll
        for (int r = 0; r < 2; ++r) { const int t = t0 + r * NGW;
            if (t < MTOK) {
                float s = 0.f;
#pragma unroll
                for (int j = 0; j < 4; ++j) { const u32x2 a = ya[r][j], c = yb[r][j];
                    v[r][j].x += __uint_as_float(a.x << 16) + __uint_as_float(c.x << 16); v[r][j].y += __uint_as_float(a.x & 0xffff0000u) + __uint_as_float(c.x & 0xffff0000u);
                    v[r][j].z += __uint_as_float(a.y << 16) + __uint_as_float(c.y << 16); v[r][j].w += __uint_as_float(a.y & 0xffff0000u) + __uint_as_float(c.y & 0xffff0000u);
                    s += (v[r][j].x * v[r][j].x + v[r][j].y * v[r][j].y) + (v[r][j].z * v[r][j].z + v[r][j].w * v[r][j].w); }
                s = wave_sum(s);
                const float rs = __builtin_amdgcn_rsqf(s * (1.0f / 1024.0f) + EPS);
                f32x4* hw = (f32x4*)(P.out + (size_t)t * 1024);
#pragma unroll
                for (int j = 0; j < 4; ++j) hw[64 * j + lane] = v[r][j] * rs * nfv[j];
            } }
    }
}

struct EpiNull { static constexpr bool PERM = true, AFTER_DRAIN = false; float* d;
    DI void operator()(const pg8::f32x4 (&acc)[2][2][4][2], const pg8::Unit& u, int wr, int wc, int fr, int fq) const {
        pg8::f32x4 s = acc[0][0][0][0];
#pragma unroll
        for (int ai = 0; ai < 2; ++ai)
#pragma unroll
            for (int bj = 0; bj < 2; ++bj)
#pragma unroll
                for (int m = 0; m < 4; ++m)
#pragma unroll
                    for (int n = 0; n < 2; ++n) s += acc[ai][bj][m][n];
        if (s[0] == 12345.678f) d[threadIdx.x] = s[1] + s[2] + s[3]; } };
#ifndef PHMASK
#define PHMASK 2047
#endif
#ifndef P1_STAGGER_TICKS
#define P1_STAGGER_TICKS 0
#endif
#ifndef ATT_VAR
#define ATT_VAR 0
#endif
#ifndef REPMASK
#define REPMASK 0
#endif
#define REP(bit) for (int rep_ = 0; rep_ < ((REPMASK & (bit)) ? 2 : 1); ++rep_)
#define REPSYNC(bit) if ((REPMASK & (bit)) && rep_ == 0) GRID_BAR()
typedef const __attribute__((address_space(4))) Params* KParams;
DI Params load_params(KParams kp) { Params p;
#pragma unroll
    for (int i = 0; i < 23; ++i) p.in[i] = kp->in[i];
    p.out = kp->out; p.ws = kp->ws; return p; }
__global__ void __launch_bounds__(NTHREADS, 2) hymba_fwd(Params Pin) {
    extern __shared__ __attribute__((aligned(16))) unsigned char lds_raw[];
    LAS unsigned char* lds = (LAS unsigned char*)lds_raw;
    cg::grid_group grid = cg::this_grid();
    volatile LAS unsigned* bst = (volatile LAS unsigned*)(lds + LDS_BYTES - 64);
    if (threadIdx.x < 2) bst[threadIdx.x] = 0u;
    __syncthreads();
    const XcdBarrier xbar = xcd_barrier_post((unsigned*)(Pin.ws + WS_CTL) + CW_BAR, bst);
#ifndef TPROBE
#define TPROBE (-1)
#endif
#ifndef TPROBE_A
#define TPROBE_A TPROBE
#define TPROBE_B (TPROBE + 1)
#endif
    int nstamp_ = 0;
#define STAMP() do { if (TPROBE >= 0) { if (blockIdx.x == 0 && threadIdx.x == 0) __hip_atomic_store((unsigned long long*)(Pin.ws + WS_CTL + 65536) + nstamp_, (unsigned long long)__builtin_amdgcn_s_memrealtime(), __ATOMIC_RELAXED, __HIP_MEMORY_SCOPE_AGENT); ++nstamp_; } } while (0)
#define GRID_BAR() do { xcd_barrier(xbar); STAMP(); } while (0)
    STAMP();
    const int G = gridDim.x, blk = blockIdx.x, NGW = G * NWAVES, NGT = G * NTHREADS;
#define PHASE_IDS() KParams kp_ = (KParams)__builtin_amdgcn_kernarg_segment_ptr(); asm volatile("" : "+s"(kp_)); const Params P = load_params(kp_); int tid = threadIdx.x; asm volatile("" : "+v"(tid)); const int lane = tid & 63, wave = __builtin_amdgcn_readfirstlane(tid >> 6), gw = blk * NWAVES + wave, gtid = blk * NTHREADS + tid; (void)lane; (void)gw; (void)gtid; (void)wave

    REP(1) { if (PHMASK & 1) { PHASE_IDS(); phase0(P, lds, gw, NGW, gtid, NGT, wave, lane); } REPSYNC(1); }
    GRID_BAR();
    REP(2) { if (PHMASK & 2) { PHASE_IDS();
        pg8::Gemm g{(const bf16_t*)(P.ws + WS_XB), (const bf16_t*)(P.ws + WS_WINT), MROWS, NPROJ, 1024};
        if (P1_STAGGER_TICKS > 0 && (blk & 1)) { const unsigned long long s0_ = __builtin_amdgcn_s_memrealtime(); while (__builtin_amdgcn_s_memrealtime() - s0_ < (unsigned long long)P1_STAGGER_TICKS) __builtin_amdgcn_s_sleep(8); }
        pg8::StaticOrder S; S.init(MROWS, NPROJ, G, blk);
        EpiInProj E{(const float*)(P.ws + WS_RS1), (const float*)(P.ws + WS_COS), (const float*)(P.ws + WS_SIN), P.in[10], P.in[11],
                    (bf16_t*)(P.ws + WS_QB), (bf16_t*)(P.ws + WS_KT), (bf16_t*)(P.ws + WS_VT), (bf16_t*)(P.ws + WS_QKVB), (bf16_t*)(P.ws + WS_ZB), (float*)(P.ws + WS_GB)};
        if (rep_ == 0) pg8::gemm_phase<EpiInProj, pg8::StaticOrder, true, true>(lds, g, S, E);
        else { EpiNull EN{(float*)(P.ws + WS_DUMP)}; pg8::gemm_phase<EpiNull, pg8::StaticOrder, true, true>(lds, g, S, EN); }
    } REPSYNC(2); }
    GRID_BAR();
    REP(4) { if (PHMASK & 4) { PHASE_IDS(); gdn_prep_phase(P, lds, blk, G, wave, lane); } REPSYNC(4); }
    {
        unsigned* prep = (unsigned*)(Pin.ws + WS_CTL) + CW_PREP;
        asm volatile("s_waitcnt vmcnt(0)" ::: "memory");
        __syncthreads();
        if (threadIdx.x == 0) { __builtin_amdgcn_fence(__ATOMIC_RELEASE, "agent"); asm volatile("s_waitcnt vmcnt(0)" ::: "memory");
            __hip_atomic_fetch_add(prep, 1u, __ATOMIC_RELAXED, __HIP_MEMORY_SCOPE_AGENT); }
        if (blk < 16) {
            if (threadIdx.x == 0) { unsigned sp = 0;
                while (__hip_atomic_load(prep, __ATOMIC_RELAXED, __HIP_MEMORY_SCOPE_AGENT) < (unsigned)G) { __builtin_amdgcn_s_sleep(2); if (++sp > (1u << 22)) break; }
                __builtin_amdgcn_fence(__ATOMIC_ACQUIRE, "agent"); asm volatile("s_waitcnt vmcnt(0)" ::: "memory"); }
            __syncthreads();
        }
    }
    REP(8) { if ((PHMASK & 8) && blk < 16) { PHASE_IDS(); gdn_scan(P, lds, blk, tid, wave, lane); } }
    REP(16) {
    if (PHMASK & 16) { PHASE_IDS(); if (rep_ == 0) attn_phase<0>(P, lds, tid, wave, lane); else attn_phase<ATT_VAR>(P, lds, tid, wave, lane); }
    if ((REPMASK & 16) && rep_ == 0) { GRID_BAR(); if (blk == 0 && threadIdx.x < 8) { PHASE_IDS(); __hip_atomic_store((unsigned*)(P.ws + WS_CTL) + CW_ATTQ + 64 * threadIdx.x, 0u, __ATOMIC_RELAXED, __HIP_MEMORY_SCOPE_AGENT); } GRID_BAR(); }
    }
    GRID_BAR();
    REP(32) { if (PHMASK & 32) { PHASE_IDS();
        pg8::Gemm g{(const bf16_t*)(P.ws + WS_MIX), (const bf16_t*)(P.ws + WS_WOUT), MTOK, 1024, 1024};
        pg8::StaticOrder S; S.init(MTOK, 1024, G, blk);
        EpiOutProj E{P.in[0], P.out, (bf16_t*)(P.ws + WS_U2)};
        pg8::gemm_phase<EpiOutProj, pg8::StaticOrder, true, true>(lds, g, S, E);
    } REPSYNC(32); }
    GRID_BAR();
#ifdef P4A_SPLIT
    if (PHMASK & 64) { PHASE_IDS(); phase4a<1>(P, lds, gw, NGW, wave, lane); }
    GRID_BAR();
    if (PHMASK & 64) { PHASE_IDS(); phase4a<2>(P, lds, gw, NGW, wave, lane); }
#else
    if (PHMASK & 64) { PHASE_IDS(); phase4a<3>(P, lds, gw, NGW, wave, lane); }
#endif
    GRID_BAR();
    int cnt, base, tend, total; { PHASE_IDS(); expert_layout(P, lane, cnt, base, tend); total = __builtin_amdgcn_readlane(tend, 31); }
    REP(256) { if (PHMASK & 256) { PHASE_IDS();
        pg8::Gemm g{(const bf16_t*)(P.ws + WS_U2), (const bf16_t*)(P.ws + WS_WGU), XS_ROWS, 32 * 512, 1024};
        GroupedOrder S{tend, total, G, blk, 1, cnt, base, (const int*)(P.ws + WS_LIST)};
        EpiGateUp E{(const float*)(P.ws + WS_LISTW), (const float*)(P.ws + WS_LISTRS), (bf16_t*)(P.ws + WS_YS), cnt, base};
        pg8::gemm_phase_g<EpiGateUp, GroupedOrder, true, true>(lds, g, S, E);
    } REPSYNC(256); }
    GRID_BAR();
    REP(512) { if (PHMASK & 512) { PHASE_IDS();
        int kd = 256; asm volatile("" : "+s"(kd));
        pg8::Gemm g{(const bf16_t*)(P.ws + WS_YS), (const bf16_t*)(P.ws + WS_WD), XS_ROWS, 32 * 1024, kd};
        GroupedOrder S{tend, total, G, blk, 2, cnt, base, (const int*)(P.ws + WS_LIST)};
        EpiDown E{(bf16_t*)(P.ws + WS_YO)};
        pg8::gemm_phase<EpiDown, GroupedOrder, true, true>(lds, g, S, E);
    } REPSYNC(512); }
    GRID_BAR();
    if (PHMASK & 1024) { PHASE_IDS(); phase7(P, gw, NGW, lane); }
    if (TPROBE >= 0) {
        GRID_BAR();
        const unsigned long long* st = (const unsigned long long*)(Pin.ws + WS_CTL + 65536);
        const unsigned long long t0 = __hip_atomic_load(st + TPROBE_A, __ATOMIC_RELAXED, __HIP_MEMORY_SCOPE_AGENT), t1 = __hip_atomic_load(st + TPROBE_B, __ATOMIC_RELAXED, __HIP_MEMORY_SCOPE_AGENT);
        const unsigned long long dt = (t1 - t0) * 4ull, s0 = __builtin_amdgcn_s_memrealtime();
        while (__builtin_amdgcn_s_memrealtime() - s0 < dt) __builtin_amdgcn_s_sleep(8);
    }
}

extern "C" void kernel_launch(void* const* d_in, const int* in_sizes, int n_in, void* d_out, int out_size, void* d_ws, size_t ws_size, hipStream_t stream) {
    static int grid_blocks = 0;
    if (grid_blocks == 0) {
        if (n_in != 23 || out_size != MTOK * DMODEL || ws_size < WS_END) { fprintf(stderr, "kernel_launch: unexpected shapes (n_in %d out %d ws %zu)\n", n_in, out_size, ws_size); grid_blocks = -1; return; }
        int dev = 0, cus = 0, per_cu = 0;
        hipGetDevice(&dev);
        hipDeviceGetAttribute(&cus, hipDeviceAttributeMultiprocessorCount, dev);
        hipFuncSetAttribute((const void*)hymba_fwd, hipFuncAttributeMaxDynamicSharedMemorySize, LDS_BYTES);
        hipOccupancyMaxActiveBlocksPerMultiprocessor(&per_cu, (const void*)hymba_fwd, NTHREADS, LDS_BYTES);
        if (per_cu < 1) { fprintf(stderr, "kernel_launch: occupancy query says %d blocks/CU\n", per_cu); per_cu = 1; }
        grid_blocks = cus;
        (void)hipGetLastError();
    }
    if (grid_blocks < 0) return;
    hipMemsetAsync((char*)d_ws + WS_CTL, 0, CTL_BYTES, stream);
    Params p{};
    for (int i = 0; i < 23; ++i) p.in[i] = (const float*)d_in[i];
    p.out = (float*)d_out; p.ws = (unsigned char*)d_ws;
    void* args[] = {&p};
    hipError_t e = hipLaunchCooperativeKernel((const void*)hymba_fwd, dim3(grid_blocks), dim3(NTHREADS), args, LDS_BYTES, stream);
    if (e != hipSuccess) fprintf(stderr, "cooperative launch failed: %s (grid %d)\n", hipGetErrorString(e), grid_blocks);
}
```

```cpp
#include <hip/hip_runtime.h>
#include <hip/hip_cooperative_groups.h>
#include <cstdio>
#include <cstdint>
namespace cg = cooperative_groups;
#ifndef PG8_EPI_AGAIN
#define PG8_EPI_AGAIN(x) do {} while (0)
#endif
namespace pg8 {
#define PG8_LAS __attribute__((address_space(3)))
typedef unsigned short bf16_t;
typedef short bf16x8 __attribute__((ext_vector_type(8)));
typedef float f32x4 __attribute__((ext_vector_type(4)));
typedef unsigned u32x4 __attribute__((ext_vector_type(4)));
constexpr int BM = 256, BK = 64, HALF = 128, HTB = HALF * BK * 2  , STAGE_BYTES = 8 * HTB, NXCD = 8, WGM = 8;

__host__ __device__ __forceinline__ int lds_byte(int r, int c) { const int st = (r >> 4) * 2 + (c >> 5), rr = r & 15, cc = c & 31, ob = rr * 64 + cc * 2; return st * 1024 + (ob ^ (((ob >> 9) & 1) << 5)); }
__host__ __device__ __forceinline__ void stage_rc(int b, int& R, int& C) { const int st = b / 1024, sb = b % 1024, swz = sb ^ (((sb >> 9) & 1) << 5); R = (st >> 1) * 16 + swz / 64; C = (st & 1) * 32 + (swz % 64) / 2; }
__host__ __device__ __forceinline__ int perm32(int rho) { const int n = rho >> 4, i = rho & 15; return 8 * (i >> 2) + 4 * n + (i & 3); }

struct Unit { int pm, pn; };
struct Gemm { const bf16_t* A; const bf16_t* Bt; int M, N, K; };

struct StaticOrder {
    int nM, nN, nwg, G, c;
    __host__ __device__ void init(int M, int N, int G_, int c_) { nM = M / BM; nN = N / BM; nwg = nM * nN; G = G_; c = c_; }
    __host__ __device__ bool next(int i, Unit& u) const {
        const long L = (long)i * G + c; if (L >= nwg) return false;
        int wgid = (int)L; { const int q = nwg / NXCD, r = nwg % NXCD, xcd = wgid % NXCD, off = wgid / NXCD; wgid = (xcd < r ? xcd * (q + 1) : r * (q + 1) + (xcd - r) * q) + off; }
        const int nig = WGM * nN, gid = wgid / nig, fm = gid * WGM, gsz = (nM - fm) < WGM ? (nM - fm) : WGM;
        u.pm = fm + ((wgid % nig) % gsz); u.pn = (wgid % nig) / gsz; return true;
    }
    __device__ __forceinline__ void a_ready(const Unit&) const {}
    __device__ __forceinline__ void done(const Unit&) const {}
};

__device__ __forceinline__ unsigned cvt_pk_bf16(float lo, float hi) { unsigned r; asm volatile("v_cvt_pk_bf16_f32 %0, %1, %2" : "=v"(r) : "v"(lo), "v"(hi)); return r; }
typedef float f32x2 __attribute__((ext_vector_type(2)));
template <class Epi, class Sched, bool ALIGN_EPI = false, bool SP2 = false>
__device__ __forceinline__ void gemm_phase(PG8_LAS unsigned char* lds, const Gemm g, const Sched& S, const Epi& E) {
    int tid_o = threadIdx.x; asm volatile("" : "+v"(tid_o));
    const int tid = tid_o, wid = __builtin_amdgcn_readfirstlane(tid >> 6), lane = tid & 63, wr = wid >> 2, wc = wid & 3, fr = lane & 15, fq = lane >> 4;
    const int K = g.K, nt = K / BK;
    unsigned voffA[2], voffB[2];
#pragma unroll
    for (int i = 0; i < 2; ++i) { int R, C; stage_rc(tid * 16 + i * 8192, R, C); const int Rb = Epi::PERM ? ((R & ~31) + perm32(R & 31)) : R;
        voffA[i] = (unsigned)(R * K + C) * 2u; voffB[i] = (unsigned)(Rb * K + C) * 2u; }
    const size_t kstep = (size_t)(BK * 2);
    const size_t hstep = (size_t)HALF * K * 2;
    const size_t tstep = 2 * hstep;
    const unsigned ldsw = (unsigned)wid * 1024u;
    const int aoff = lds_byte(wr * 64 + fr, fq * 8), boff = lds_byte(wc * 32 + fr, fq * 8);
#define PG8_SA(b, h) (((b) * 2 + (h)) * HTB)
#define PG8_SB(b, h) ((4 + (b) * 2 + (h)) * HTB)
#define PG8_STAGE(bufoff, gbase, voff) do { _Pragma("unroll") for (int _i = 0; _i < 2; ++_i) \
        __builtin_amdgcn_global_load_lds((const unsigned*)((const char*)(gbase) + (voff)[_i]), (PG8_LAS unsigned*)(lds + (bufoff) + ldsw + _i * 8192), 16, 0, 0); } while (0)
#define PG8_LDA(dst, b, h) do { _Pragma("unroll") for (int m = 0; m < 4; ++m) _Pragma("unroll") for (int k = 0; k < 2; ++k) dst[m][k] = *(const PG8_LAS bf16x8*)(lds + PG8_SA(b, h) + aoff + m * 2048 + k * 1024); } while (0)
#define PG8_LDB(dst, b, h) do { _Pragma("unroll") for (int n = 0; n < 2; ++n) _Pragma("unroll") for (int k = 0; k < 2; ++k) dst[n][k] = *(const PG8_LAS bf16x8*)(lds + PG8_SB(b, h) + boff + n * 2048 + k * 1024); } while (0)
#define PG8_MMA(ai, bj, At, Bt) do { __builtin_amdgcn_s_setprio(1); _Pragma("unroll") for (int m = 0; m < 4; ++m) _Pragma("unroll") for (int n = 0; n < 2; ++n) _Pragma("unroll") for (int k = 0; k < 2; ++k) \
        acc[ai][bj][m][n] = __builtin_amdgcn_mfma_f32_16x16x32_bf16(Bt[n][k], At[m][k], acc[ai][bj][m][n], 0, 0, 0); __builtin_amdgcn_s_setprio(0); } while (0)
#define PG8_WAIT_V(n) asm volatile("s_waitcnt vmcnt(" #n ")" ::: "memory")
#define PG8_WAIT_L(n) asm volatile("s_waitcnt lgkmcnt(" #n ")" ::: "memory")
#define PG8_BAR __builtin_amdgcn_s_barrier()
#define PG8_SCHED __builtin_amdgcn_sched_barrier(0)
    Unit cur, nxt; int ui = 0;
    if (!S.next(0, cur)) return;
    f32x4 acc[2][2][4][2];
#pragma unroll
    for (int a = 0; a < 2; ++a)
#pragma unroll
        for (int b = 0; b < 2; ++b)
#pragma unroll
            for (int m = 0; m < 4; ++m)
#pragma unroll
                for (int n = 0; n < 2; ++n) acc[a][b][m][n] = (f32x4){0.f, 0.f, 0.f, 0.f};
    bf16x8 At[4][2], B0[2][2], B1[2][2];
    const char* cA = (const char*)g.A + (size_t)cur.pm * tstep; const char* cB = (const char*)g.Bt + (size_t)cur.pn * tstep;
    S.a_ready(cur);
    if constexpr (SP2) {
        PG8_STAGE(PG8_SB(0, 0), cB, voffB); PG8_STAGE(PG8_SB(0, 1), cB + hstep, voffB); PG8_STAGE(PG8_SA(0, 0), cA, voffA); PG8_STAGE(PG8_SA(0, 1), cA + hstep, voffA);
        if (wr == 1) PG8_BAR;
        PG8_WAIT_V(2); PG8_BAR;
        PG8_STAGE(PG8_SB(1, 0), cB + kstep, voffB); PG8_STAGE(PG8_SA(1, 0), cA + kstep, voffA); PG8_STAGE(PG8_SB(1, 1), cB + hstep + kstep, voffB);
        PG8_WAIT_V(6); PG8_BAR;
    } else {
        PG8_STAGE(PG8_SB(0, 0), cB, voffB); PG8_STAGE(PG8_SA(0, 0), cA, voffA); PG8_STAGE(PG8_SB(0, 1), cB + hstep, voffB); PG8_STAGE(PG8_SA(0, 1), cA + hstep, voffA);
        if (wr == 1) PG8_BAR;
        PG8_WAIT_V(4); PG8_BAR;
        PG8_STAGE(PG8_SB(1, 0), cB + kstep, voffB); PG8_STAGE(PG8_SA(1, 0), cA + kstep, voffA); PG8_STAGE(PG8_SB(1, 1), cB + hstep + kstep, voffB);
        PG8_WAIT_V(6); PG8_BAR;
    }
    for (;;) {
        const bool has_next = S.next(ui + 1, nxt);
        const char* nA = has_next ? (const char*)g.A + (size_t)nxt.pm * tstep : cA; const char* nB = has_next ? (const char*)g.Bt + (size_t)nxt.pn * tstep : cB;
        for (int t = 0; t < nt; t += 2) {
            const bool last = (t == nt - 2);
            const char* a1 = cA + (size_t)(t + 1) * kstep;
            const char* a2 = last ? nA : cA + (size_t)(t + 2) * kstep; const char* b2 = last ? nB : cB + (size_t)(t + 2) * kstep;
            const char* a3 = a2 + kstep; const char* b3 = b2 + kstep;
            if (last && has_next) S.a_ready(nxt);
            if constexpr (SP2) {
            PG8_LDB(B0, 0, 0); PG8_LDB(B1, 0, 1); PG8_SCHED; PG8_LDA(At, 0, 0); PG8_STAGE(PG8_SA(1, 1), a1 + hstep, voffA);
            PG8_WAIT_V(8); PG8_WAIT_L(0); PG8_BAR; PG8_MMA(0, 0, At, B0); PG8_MMA(0, 1, At, B1); PG8_BAR; PG8_SCHED;
            PG8_LDA(At, 0, 1); PG8_STAGE(PG8_SB(0, 0), b2, voffB); PG8_STAGE(PG8_SB(0, 1), b2 + hstep, voffB); PG8_STAGE(PG8_SA(0, 0), a2, voffA);
            PG8_WAIT_V(8); PG8_WAIT_L(0); PG8_BAR; PG8_MMA(1, 0, At, B0); PG8_MMA(1, 1, At, B1); PG8_BAR; PG8_SCHED;
            PG8_LDB(B0, 1, 0); PG8_LDB(B1, 1, 1); PG8_SCHED; PG8_LDA(At, 1, 0); PG8_STAGE(PG8_SA(0, 1), a2 + hstep, voffA);
            PG8_WAIT_V(8); PG8_WAIT_L(0); PG8_BAR; PG8_MMA(0, 0, At, B0); PG8_MMA(0, 1, At, B1); PG8_BAR; PG8_SCHED;
            PG8_LDA(At, 1, 1); PG8_STAGE(PG8_SB(1, 0), b3, voffB); PG8_STAGE(PG8_SB(1, 1), b3 + hstep, voffB); PG8_STAGE(PG8_SA(1, 0), a3, voffA);
            PG8_WAIT_V(8); PG8_WAIT_L(0); PG8_BAR; PG8_MMA(1, 0, At, B0); PG8_MMA(1, 1, At, B1); PG8_BAR; PG8_SCHED;
            } else {
            PG8_LDB(B0, 0, 0); PG8_SCHED; PG8_LDA(At, 0, 0); PG8_STAGE(PG8_SA(1, 1), a1 + hstep, voffA);
            PG8_WAIT_L(8); PG8_BAR; PG8_WAIT_L(0); PG8_MMA(0, 0, At, B0); PG8_BAR; PG8_SCHED;
            PG8_LDB(B1, 0, 1); PG8_STAGE(PG8_SB(0, 0), b2, voffB);
            PG8_BAR; PG8_WAIT_L(0); PG8_MMA(0, 1, At, B1); PG8_BAR;
            PG8_LDA(At, 0, 1); PG8_STAGE(PG8_SA(0, 0), a2, voffA);
            PG8_BAR; PG8_WAIT_L(0); PG8_MMA(1, 0, At, B0); PG8_BAR; PG8_SCHED;
            PG8_STAGE(PG8_SB(0, 1), b2 + hstep, voffB);
            PG8_WAIT_V(6); PG8_BAR; PG8_MMA(1, 1, At, B1); PG8_BAR;
            PG8_LDB(B0, 1, 0); PG8_SCHED; PG8_LDA(At, 1, 0); PG8_STAGE(PG8_SA(0, 1), a2 + hstep, voffA);
            PG8_WAIT_L(8); PG8_BAR; PG8_WAIT_L(0); PG8_MMA(0, 0, At, B0); PG8_BAR; PG8_SCHED;
            PG8_LDB(B1, 1, 1); PG8_STAGE(PG8_SB(1, 0), b3, voffB);
            PG8_BAR; PG8_WAIT_L(0); PG8_MMA(0, 1, At, B1); PG8_BAR;
            PG8_LDA(At, 1, 1); PG8_STAGE(PG8_SA(1, 0), a3, voffA);
            PG8_BAR; PG8_WAIT_L(0); PG8_MMA(1, 0, At, B0); PG8_BAR; PG8_SCHED;
            PG8_STAGE(PG8_SB(1, 1), b3 + hstep, voffB);
            PG8_WAIT_V(6); PG8_BAR; PG8_MMA(1, 1, At, B1); PG8_BAR;
            }
        }
        if constexpr (ALIGN_EPI) { if (wr == 0) PG8_BAR; }
        if constexpr (!Epi::AFTER_DRAIN) { E(acc, cur, wr, wc, fr, fq); PG8_EPI_AGAIN(E(acc, cur, wr, wc, fr, fq)); S.done(cur); }
        if (!has_next) break;
#pragma unroll
        for (int a = 0; a < 2; ++a)
#pragma unroll
            for (int b = 0; b < 2; ++b)
#pragma unroll
                for (int m = 0; m < 4; ++m)
#pragma unroll
                    for (int n = 0; n < 2; ++n) acc[a][b][m][n] = (f32x4){0.f, 0.f, 0.f, 0.f};
        cur = nxt; cA = nA; cB = nB; ++ui;
        if constexpr (ALIGN_EPI) { if (wr == 1) PG8_BAR; }
    }
    PG8_WAIT_V(0);
    if constexpr (!ALIGN_EPI) { if (wr == 0) PG8_BAR; }
    PG8_BAR;
    if constexpr (Epi::AFTER_DRAIN) { E.fused(acc, cur, wr, wc, fr, fq, lds, wid, lane); S.done(cur); }
#undef PG8_SA
#undef PG8_SB
#undef PG8_STAGE
#undef PG8_LDA
#undef PG8_LDB
#undef PG8_MMA
#undef PG8_WAIT_V
#undef PG8_WAIT_L
#undef PG8_BAR
#undef PG8_SCHED
}
static_assert(true, "gather variant of gemm_phase (SP2 = true only): identical schedule, the A operand's rows are gathered through Sched::rowoff");
template <class Epi, class Sched, bool ALIGN_EPI = false, bool SP2 = false>
__device__ __forceinline__ void gemm_phase_g(PG8_LAS unsigned char* lds, const Gemm g, const Sched& S, const Epi& E) {
    int tid_o = threadIdx.x; asm volatile("" : "+v"(tid_o));
    const int tid = tid_o, wid = __builtin_amdgcn_readfirstlane(tid >> 6), lane = tid & 63, wr = wid >> 2, wc = wid & 3, fr = lane & 15, fq = lane >> 4;
    const int K = g.K, nt = K / BK;
    unsigned voffA[2], voffB[2]; int RA_[2]; unsigned CA_[2];
#pragma unroll
    for (int i = 0; i < 2; ++i) { int R, C; stage_rc(tid * 16 + i * 8192, R, C); const int Rb = Epi::PERM ? ((R & ~31) + perm32(R & 31)) : R;
        voffA[i] = (unsigned)(R * K + C) * 2u; voffB[i] = (unsigned)(Rb * K + C) * 2u; RA_[i] = R; CA_[i] = (unsigned)C * 2u; }
    const size_t kstep = (size_t)(BK * 2);
    const size_t hstep = (size_t)HALF * K * 2;
    const size_t tstep = 2 * hstep;
    const unsigned ldsw = (unsigned)wid * 1024u;
    const int aoff = lds_byte(wr * 64 + fr, fq * 8), boff = lds_byte(wc * 32 + fr, fq * 8);
#define PG8_SA(b, h) (((b) * 2 + (h)) * HTB)
#define PG8_SB(b, h) ((4 + (b) * 2 + (h)) * HTB)
#define PG8_STAGE(bufoff, gbase, voff) do { _Pragma("unroll") for (int _i = 0; _i < 2; ++_i) \
        __builtin_amdgcn_global_load_lds((const unsigned*)((const char*)(gbase) + (voff)[_i]), (PG8_LAS unsigned*)(lds + (bufoff) + ldsw + _i * 8192), 16, 0, 0); } while (0)
#define PG8_LDA(dst, b, h) do { _Pragma("unroll") for (int m = 0; m < 4; ++m) _Pragma("unroll") for (int k = 0; k < 2; ++k) dst[m][k] = *(const PG8_LAS bf16x8*)(lds + PG8_SA(b, h) + aoff + m * 2048 + k * 1024); } while (0)
#define PG8_LDB(dst, b, h) do { _Pragma("unroll") for (int n = 0; n < 2; ++n) _Pragma("unroll") for (int k = 0; k < 2; ++k) dst[n][k] = *(const PG8_LAS bf16x8*)(lds + PG8_SB(b, h) + boff + n * 2048 + k * 1024); } while (0)
#define PG8_MMA(ai, bj, At, Bt) do { __builtin_amdgcn_s_setprio(1); _Pragma("unroll") for (int m = 0; m < 4; ++m) _Pragma("unroll") for (int n = 0; n < 2; ++n) _Pragma("unroll") for (int k = 0; k < 2; ++k) \
        acc[ai][bj][m][n] = __builtin_amdgcn_mfma_f32_16x16x32_bf16(Bt[n][k], At[m][k], acc[ai][bj][m][n], 0, 0, 0); __builtin_amdgcn_s_setprio(0); } while (0)
#define PG8_WAIT_V(n) asm volatile("s_waitcnt vmcnt(" #n ")" ::: "memory")
#define PG8_WAIT_L(n) asm volatile("s_waitcnt lgkmcnt(" #n ")" ::: "memory")
#define PG8_BAR __builtin_amdgcn_s_barrier()
#define PG8_SCHED __builtin_amdgcn_sched_barrier(0)
    Unit cur, nxt; int ui = 0;
    if (!S.next(0, cur)) return;
    f32x4 acc[2][2][4][2];
#pragma unroll
    for (int a = 0; a < 2; ++a)
#pragma unroll
        for (int b = 0; b < 2; ++b)
#pragma unroll
            for (int m = 0; m < 4; ++m)
#pragma unroll
                for (int n = 0; n < 2; ++n) acc[a][b][m][n] = (f32x4){0.f, 0.f, 0.f, 0.f};
    bf16x8 At[4][2], B0[2][2], B1[2][2];
    const char* cA = (const char*)g.A; const char* cB = (const char*)g.Bt + (size_t)cur.pn * tstep;
    unsigned cA0[2], cA1[2], nA0[2], nA1[2];
#pragma unroll
    for (int i = 0; i < 2; ++i) { cA0[i] = S.rowoff(cur, RA_[i]) + CA_[i]; cA1[i] = S.rowoff(cur, 128 + RA_[i]) + CA_[i]; }
    S.a_ready(cur);
    if constexpr (SP2) {
        PG8_STAGE(PG8_SB(0, 0), cB, voffB); PG8_STAGE(PG8_SB(0, 1), cB + hstep, voffB); PG8_STAGE(PG8_SA(0, 0), cA, cA0); PG8_STAGE(PG8_SA(0, 1), cA, cA1);
        if (wr == 1) PG8_BAR;
        PG8_WAIT_V(2); PG8_BAR;
        PG8_STAGE(PG8_SB(1, 0), cB + kstep, voffB); PG8_STAGE(PG8_SA(1, 0), cA + kstep, cA0); PG8_STAGE(PG8_SB(1, 1), cB + hstep + kstep, voffB);
        PG8_WAIT_V(6); PG8_BAR;
    } else {
        PG8_STAGE(PG8_SB(0, 0), cB, voffB); PG8_STAGE(PG8_SA(0, 0), cA, voffA); PG8_STAGE(PG8_SB(0, 1), cB + hstep, voffB); PG8_STAGE(PG8_SA(0, 1), cA + hstep, voffA);
        if (wr == 1) PG8_BAR;
        PG8_WAIT_V(4); PG8_BAR;
        PG8_STAGE(PG8_SB(1, 0), cB + kstep, voffB); PG8_STAGE(PG8_SA(1, 0), cA + kstep, voffA); PG8_STAGE(PG8_SB(1, 1), cB + hstep + kstep, voffB);
        PG8_WAIT_V(6); PG8_BAR;
    }
    for (;;) {
        const bool has_next = S.next(ui + 1, nxt);
        const char* nA = cA; const char* nB = has_next ? (const char*)g.Bt + (size_t)nxt.pn * tstep : cB;
#pragma unroll
        for (int i = 0; i < 2; ++i) { nA0[i] = has_next ? S.rowoff(nxt, RA_[i]) + CA_[i] : cA0[i]; nA1[i] = has_next ? S.rowoff(nxt, 128 + RA_[i]) + CA_[i] : cA1[i]; }
        for (int t = 0; t < nt; t += 2) {
            const bool last = (t == nt - 2);
            const char* a1 = cA + (size_t)(t + 1) * kstep;
            const char* a2 = last ? nA : cA + (size_t)(t + 2) * kstep; const char* b2 = last ? nB : cB + (size_t)(t + 2) * kstep;
            const char* a3 = a2 + kstep; const char* b3 = b2 + kstep;
            unsigned sA0[2], sA1[2];
#pragma unroll
            for (int i = 0; i < 2; ++i) { sA0[i] = last ? nA0[i] : cA0[i]; sA1[i] = last ? nA1[i] : cA1[i]; }
            if (last && has_next) S.a_ready(nxt);
            if constexpr (SP2) {
            PG8_LDB(B0, 0, 0); PG8_LDB(B1, 0, 1); PG8_SCHED; PG8_LDA(At, 0, 0); PG8_STAGE(PG8_SA(1, 1), a1, cA1);
            PG8_WAIT_V(8); PG8_WAIT_L(0); PG8_BAR; PG8_MMA(0, 0, At, B0); PG8_MMA(0, 1, At, B1); PG8_BAR; PG8_SCHED;
            PG8_LDA(At, 0, 1); PG8_STAGE(PG8_SB(0, 0), b2, voffB); PG8_STAGE(PG8_SB(0, 1), b2 + hstep, voffB); PG8_STAGE(PG8_SA(0, 0), a2, sA0);
            PG8_WAIT_V(8); PG8_WAIT_L(0); PG8_BAR; PG8_MMA(1, 0, At, B0); PG8_MMA(1, 1, At, B1); PG8_BAR; PG8_SCHED;
            PG8_LDB(B0, 1, 0); PG8_LDB(B1, 1, 1); PG8_SCHED; PG8_LDA(At, 1, 0); PG8_STAGE(PG8_SA(0, 1), a2, sA1);
            PG8_WAIT_V(8); PG8_WAIT_L(0); PG8_BAR; PG8_MMA(0, 0, At, B0); PG8_MMA(0, 1, At, B1); PG8_BAR; PG8_SCHED;
            PG8_LDA(At, 1, 1); PG8_STAGE(PG8_SB(1, 0), b3, voffB); PG8_STAGE(PG8_SB(1, 1), b3 + hstep, voffB); PG8_STAGE(PG8_SA(1, 0), a3, sA0);
            PG8_WAIT_V(8); PG8_WAIT_L(0); PG8_BAR; PG8_MMA(1, 0, At, B0); PG8_MMA(1, 1, At, B1); PG8_BAR; PG8_SCHED;
            } else {
            PG8_LDB(B0, 0, 0); PG8_SCHED; PG8_LDA(At, 0, 0); PG8_STAGE(PG8_SA(1, 1), a1 + hstep, voffA);
            PG8_WAIT_L(8); PG8_BAR; PG8_WAIT_L(0); PG8_MMA(0, 0, At, B0); PG8_BAR; PG8_SCHED;
            PG8_LDB(B1, 0, 1); PG8_STAGE(PG8_SB(0, 0), b2, voffB);
            PG8_BAR; PG8_WAIT_L(0); PG8_MMA(0, 1, At, B1); PG8_BAR;
            PG8_LDA(At, 0, 1); PG8_STAGE(PG8_SA(0, 0), a2, voffA);
            PG8_BAR; PG8_WAIT_L(0); PG8_MMA(1, 0, At, B0); PG8_BAR; PG8_SCHED;
            PG8_STAGE(PG8_SB(0, 1), b2 + hstep, voffB);
            PG8_WAIT_V(6); PG8_BAR; PG8_MMA(1, 1, At, B1); PG8_BAR;
            PG8_LDB(B0, 1, 0); PG8_SCHED; PG8_LDA(At, 1, 0); PG8_STAGE(PG8_SA(0, 1), a2 + hstep, voffA);
            PG8_WAIT_L(8); PG8_BAR; PG8_WAIT_L(0); PG8_MMA(0, 0, At, B0); PG8_BAR; PG8_SCHED;
            PG8_LDB(B1, 1, 1); PG8_STAGE(PG8_SB(1, 0), b3, voffB);
            PG8_BAR; PG8_WAIT_L(0); PG8_MMA(0, 1, At, B1); PG8_BAR;
            PG8_LDA(At, 1, 1); PG8_STAGE(PG8_SA(1, 0), a3, voffA);
            PG8_BAR; PG8_WAIT_L(0); PG8_MMA(1, 0, At, B0); PG8_BAR; PG8_SCHED;
            PG8_STAGE(PG8_SB(1, 1), b3 + hstep, voffB);
            PG8_WAIT_V(6); PG8_BAR; PG8_MMA(1, 1, At, B1); PG8_BAR;
            }
        }
        if constexpr (ALIGN_EPI) { if (wr == 0) PG8_BAR; }
        if constexpr (!Epi::AFTER_DRAIN) { E(acc, cur, wr, wc, fr, fq); PG8_EPI_AGAIN(E(acc, cur, wr, wc, fr, fq)); S.done(cur); }
        if (!has_next) break;
#pragma unroll
        for (int a = 0; a < 2; ++a)
#pragma unroll
            for (int b = 0; b < 2; ++b)
#pragma unroll
                for (int m = 0; m < 4; ++m)
#pragma unroll
                    for (int n = 0; n < 2; ++n) acc[a][b][m][n] = (f32x4){0.f, 0.f, 0.f, 0.f};
        cur = nxt; cA = nA; cB = nB; ++ui;
#pragma unroll
        for (int i = 0; i < 2; ++i) { cA0[i] = nA0[i]; cA1[i] = nA1[i]; }
        if constexpr (ALIGN_EPI) { if (wr == 1) PG8_BAR; }
    }
    PG8_WAIT_V(0);
    if constexpr (!ALIGN_EPI) { if (wr == 0) PG8_BAR; }
    PG8_BAR;
    if constexpr (Epi::AFTER_DRAIN) { E.fused(acc, cur, wr, wc, fr, fq, lds, wid, lane); S.done(cur); }
#undef PG8_SA
#undef PG8_SB
#undef PG8_STAGE
#undef PG8_LDA
#undef PG8_LDB
#undef PG8_MMA
#undef PG8_WAIT_V
#undef PG8_WAIT_L
#undef PG8_BAR
#undef PG8_SCHED
}
}

#define DI __device__ __forceinline__
#define LAS __attribute__((address_space(3)))
typedef unsigned short bf16_t;
typedef short bf16x8 __attribute__((ext_vector_type(8)));
typedef short s16x4 __attribute__((ext_vector_type(4)));
typedef short v4i16_t __attribute__((ext_vector_type(4)));
typedef float f32x4 __attribute__((ext_vector_type(4)));
typedef float f32x16 __attribute__((ext_vector_type(16)));
typedef unsigned u32x4 __attribute__((ext_vector_type(4)));
typedef unsigned u32x2 __attribute__((ext_vector_type(2)));
typedef float f32x2_t __attribute__((ext_vector_type(2)));
typedef __bf16 bf16x2_t __attribute__((ext_vector_type(2)));

constexpr int NWAVES = 8, NTHREADS = 512;
constexpr int SEQ = 8192, DMODEL = 1024, NMETA = 16, LTOK = SEQ + NMETA  , LP = 8256  , NCHUNK = 129;
constexpr int MTOK = 2 * SEQ;
constexpr int MROWS = 16640;
constexpr int NPROJ = 3840;
constexpr int NKT = 129;
constexpr float EPS = 1e-6f;
constexpr float C2Q = 0.125f * 1.4426950408889634f;
constexpr int XS_ROWS = 41216;

constexpr size_t MiB = 1u << 20;
constexpr size_t WS_CTL = 0, CTL_BYTES = 1 * MiB;
constexpr size_t WS_RS1 = 1 * MiB;
constexpr size_t WS_RS2 = WS_RS1 + 128 * 1024;
constexpr size_t WS_TOKE = WS_RS2 + 128 * 1024;
constexpr size_t WS_TOKW = WS_TOKE + 128 * 1024;
constexpr size_t WS_TOKP = WS_TOKW + 128 * 1024;
constexpr size_t WS_SLOTW = WS_TOKP + 128 * 1024;
constexpr size_t WS_WR = WS_SLOTW + 192 * 1024;
constexpr size_t WS_GL = WS_WR + 160 * 1024;
constexpr size_t WS_DUMP = 2 * MiB;
constexpr size_t WS_COS = 2 * MiB;
constexpr size_t WS_SIN = WS_COS + 1280 * 1024;
constexpr size_t WS_GB = WS_SIN + 1280 * 1024;
constexpr size_t WS_WOUT = 6 * MiB;
constexpr size_t WS_WINT = 8 * MiB;
constexpr size_t WS_XB = WS_WINT + (size_t)NPROJ * 1024 * 2;
constexpr size_t WS_MIX = 8 * MiB;
constexpr size_t WS_QKVB = 48 * MiB;
constexpr size_t WS_QB = WS_QKVB + (size_t)2 * LP * 1536 * 2 + 128 * 1024;
constexpr size_t WS_KT = WS_QB + 16 * MiB;
constexpr size_t WS_VT = WS_KT + (size_t)16 * NKT * 4096 * 2;
constexpr size_t WS_ZB = WS_VT + (size_t)8 * NKT * 8192 * 2;
constexpr size_t WS_GP = WS_ZB + (size_t)2 * LP * 512 * 2;
constexpr size_t GP_ARR = (size_t)2064 * 4096 * 2;
constexpr size_t WS_GP_END = WS_GP + 5 * GP_ARR;
constexpr size_t WS_WGU = 48 * MiB;
constexpr size_t WS_WD = 80 * MiB;
constexpr size_t WS_U2 = 96 * MiB;
constexpr size_t WS_LIST = 240 * MiB;
constexpr size_t WS_LISTW = 242 * MiB;
constexpr size_t WS_LISTRS = 244 * MiB;
constexpr size_t WS_XS = 96 * MiB;
constexpr size_t WS_YO = 128 * MiB;
constexpr size_t WS_YS = 8 * MiB;
constexpr size_t WS_END = 256 * MiB;
static_assert(WS_GB + (size_t)2 * LP * 16 * 4 <= WS_WOUT, "small region");
static_assert(WS_XB + (size_t)MROWS * 1024 * 2 <= WS_QKVB, "XB");
static_assert(WS_GP_END <= WS_END, "GDN prep arrays");
static_assert(WS_YS + (size_t)XS_ROWS * 256 * 2 <= WS_END, "YS");
static_assert(WS_WD + (size_t)32 * 1024 * 256 * 2 <= WS_XS, "WD");
constexpr int CW_ATTQ = 2112;
constexpr int CW_PREP = 2688;
constexpr int CW_CNT = 64;
constexpr int CW_TILE = 8192;
constexpr int CW_BAR = 4096;

constexpr int LDS_BYTES = 147456;

struct Params { const float* in[23]; float* out; unsigned char* ws; };

DI unsigned f2bf(float f) { unsigned u = __float_as_uint(f); return (u + 0x7fffu + ((u >> 16) & 1u)) >> 16; }
DI unsigned pk2(float lo, float hi) { f32x2_t v = {lo, hi}; bf16x2_t b = __builtin_convertvector(v, bf16x2_t); return __builtin_bit_cast(unsigned, b); }
DI float bf2f(unsigned short h) { return __uint_as_float(((unsigned)h) << 16); }
DI float rlane(float v, int l) { return __int_as_float(__builtin_amdgcn_readlane(__float_as_int(v), l)); }
#define DPP_ADD(v, ctrl) ((v) + __int_as_float(__builtin_amdgcn_update_dpp(0, __float_as_int(v), (ctrl), 0xF, 0xF, true)))
DI u32x2 pack_quad_bf16(float v) {
    const float v1 = __int_as_float(__builtin_amdgcn_update_dpp(0, __float_as_int(v), 0xB1, 0xF, 0xF, true));
    const unsigned p = pk2(v, v1);
    const unsigned q = (unsigned)__builtin_amdgcn_update_dpp(0, (int)p, 0x4E, 0xF, 0xF, true);
    return (u32x2){p, q};
}
typedef __attribute__((address_space(1))) u32x2 g_u32x2;
DI void store_quad_bf16(bf16_t* dst  , float v, int lane) {
    const float v1 = __int_as_float(__builtin_amdgcn_update_dpp(0, __float_as_int(v), 0xB1, 0xF, 0xF, true));
    const unsigned p = pk2(v, v1);
    const unsigned q = (unsigned)__builtin_amdgcn_update_dpp(0, (int)p, 0x4E, 0xF, 0xF, true);
    if ((lane & 3) == 0) *(u32x2*)dst = (u32x2){p, q};
}
DI float wave_sum_dpp(float v) {
    v = DPP_ADD(v, 0xB1);
    v = DPP_ADD(v, 0x4E);
    v = DPP_ADD(v, 0x141);
    v = DPP_ADD(v, 0x140);
    return (rlane(v, 0) + rlane(v, 16)) + (rlane(v, 32) + rlane(v, 48));
}
DI float wave_sum(float v) { return wave_sum_dpp(v); }
DI float swz_xor16(float v) { return __int_as_float(__builtin_amdgcn_ds_swizzle(__float_as_int(v), 0x401F)); }
DI float row_sum16(float v) { v = DPP_ADD(v, 0xB1); v = DPP_ADD(v, 0x4E); v = DPP_ADD(v, 0x141); v = DPP_ADD(v, 0x140); return v; }
DI float half_sum32(float v) { v = row_sum16(v); return v + swz_xor16(v); }
DI float swap32_add(float v) { auto rr = __builtin_amdgcn_permlane32_swap(__float_as_uint(v), __float_as_uint(v), false, false); return __uint_as_float(rr[0]) + __uint_as_float(rr[1]); }
DI float swap32_max(float v) { auto rr = __builtin_amdgcn_permlane32_swap(__float_as_uint(v), __float_as_uint(v), false, false); return fmaxf(__uint_as_float(rr[0]), __uint_as_float(rr[1])); }
#define LDS_WAIT() asm volatile("s_waitcnt lgkmcnt(0)" ::: "memory")
#define BAR_LDS() do { asm volatile("s_waitcnt lgkmcnt(0)" ::: "memory"); __builtin_amdgcn_s_barrier(); asm volatile("" ::: "memory"); } while (0)
#define MFMA32(a, b, c) __builtin_amdgcn_mfma_f32_32x32x16_bf16((a), (b), (c), 0, 0, 0)
DI int crow(int r, int hi) { return (r & 3) + 8 * (r >> 2) + 4 * hi; }
DI int perm16(int x) { return (x & ~12) | ((x & 4) << 1) | ((x & 8) >> 1); }
DI bf16x8 pack8(const f32x16& x, int s) {
    u32x4 p; p.x = pk2(x[8 * s], x[8 * s + 1]); p.y = pk2(x[8 * s + 2], x[8 * s + 3]); p.z = pk2(x[8 * s + 4], x[8 * s + 5]); p.w = pk2(x[8 * s + 6], x[8 * s + 7]);
    return __builtin_bit_cast(bf16x8, p);
}
DI int orig_col(int n) {
    if (n >= 1024) return n;
    const int hh = n >> 6, c2 = n & 63, g8 = c2 >> 3, i = c2 & 7;
    return (hh << 6) + ((i < 4) ? 4 * g8 + i : 32 + 4 * g8 + (i - 4));
}
DI size_t kt_off(int b, int hh, int p, int d) {
    const int tile = p < 16 ? 0 : 1 + ((p - 16) >> 6), kv = p < 16 ? p : ((p - 16) & 63);
    return ((size_t)((b * 8 + hh) * NKT + tile) << 12) + ((d >> 3) << 9) + (kv << 3) + (d & 7);
}
DI size_t vt_off(int b, int h, int p, int d) {
    const int tile = p < 16 ? 0 : 1 + ((p - 16) >> 6), kv = p < 16 ? p : ((p - 16) & 63);
    return ((size_t)((b * 4 + h) * NKT + tile) << 13) + ((d >> 5) << 11) + ((kv >> 4) << 9) + ((kv & 15) << 5) + (d & 31);
}

template <class Src> DI void transpose_item(const Src& src, bf16_t* WT, size_t ldk, int k0, int n0, LAS float* scr, int lane) {
    float v[32];
#pragma unroll
    for (int i = 0; i < 32; ++i) v[i] = src(k0 + 2 * i + (lane >> 5), n0 + (lane & 31));
#pragma unroll
    for (int i = 0; i < 32; ++i) scr[(2 * i + (lane >> 5)) * 33 + (lane & 31)] = v[i];
    LDS_WAIT();
    const int c = lane & 7;
#pragma unroll
    for (int j = 0; j < 4; ++j) { const int n = (lane >> 3) + 8 * j; const LAS float* s = scr + (8 * c) * 33 + n;
        u32x4 o; o.x = pk2(s[0 * 33], s[1 * 33]); o.y = pk2(s[2 * 33], s[3 * 33]); o.z = pk2(s[4 * 33], s[5 * 33]); o.w = pk2(s[6 * 33], s[7 * 33]);
        *(u32x4*)(WT + (size_t)(n0 + n) * ldk + k0 + 8 * c) = o; }
    LDS_WAIT();
}
struct SrcWin { const float* w; const float* g; DI float operator()(int k, int n) const { return n >= 3600 ? 0.f : w[(size_t)k * 3600 + orig_col(n)] * g[k]; } };
struct SrcPlain { const float* w; int N; DI float operator()(int k, int n) const { return w[(size_t)k * N + n]; } };
struct SrcGU { const float* w; const float* g; int fadj; DI float operator()(int k, int n) const { return w[(size_t)k * 256 + n + fadj] * g[k]; } };

#ifndef P0_REP
#define P0_REP 0
#endif
DI void phase0(const Params& P, LAS unsigned char* lds, int gw, int NGW, int gtid, int NGT, int wave, int lane) {
    LAS float* scr = (LAS float*)(lds + wave * 16384);
    bf16_t* WINT = (bf16_t*)(P.ws + WS_WINT); bf16_t* WOUT = (bf16_t*)(P.ws + WS_WOUT); bf16_t* XB = (bf16_t*)(P.ws + WS_XB);
    float* RS1 = (float*)(P.ws + WS_RS1);
    constexpr int I_IN = 16 * (NPROJ / 32), I_OUT = 16 * 32;
    const SrcWin sw{P.in[3], P.in[2]}; const SrcPlain so{P.in[13], 1024};
    for (int rp_ = 0; rp_ < ((P0_REP & 1) ? 2 : 1); ++rp_)
    for (int it = gw; it < I_IN + I_OUT; it += NGW) {
        if (it < I_IN) transpose_item(sw, WINT, 1024, (it / (NPROJ / 32)) * 64, (it % (NPROJ / 32)) * 32, scr, lane);
        else { const int r = it - I_IN; transpose_item(so, WOUT, 1024, (r >> 5) * 64, (r & 31) * 32, scr, lane); }
    }
    const float* x = P.in[0]; const float* meta = P.in[1];
    for (int rp_ = 0; rp_ < ((P0_REP & 2) ? 2 : 1); ++rp_)
    for (int m0 = gw; m0 < MROWS; m0 += 4 * NGW) {
        f32x4 v[4][4];
#pragma unroll
        for (int r = 0; r < 4; ++r) { const int m = m0 + r * NGW;
            const bool real = m < MTOK + NMETA;
            const f32x4* xr = (const f32x4*)((m < MTOK) ? x + (size_t)m * 1024 : meta + (size_t)((real ? m : MTOK) - MTOK) * 1024);
#pragma unroll
            for (int j = 0; j < 4; ++j) v[r][j] = (m < MROWS) ? xr[64 * j + lane] : (f32x4){0.f, 0.f, 0.f, 0.f}; }
#pragma unroll
        for (int r = 0; r < 4; ++r) { const int m = m0 + r * NGW;
            if (m < MROWS) {
                const bool real = m < MTOK + NMETA;
                float s = 0.f;
#pragma unroll
                for (int j = 0; j < 4; ++j) { if (!real) v[r][j] = (f32x4){0.f, 0.f, 0.f, 0.f}; s += (v[r][j].x * v[r][j].x + v[r][j].y * v[r][j].y) + (v[r][j].z * v[r][j].z + v[r][j].w * v[r][j].w); }
                s = wave_sum(s);
                if (lane == 0) RS1[m] = real ? __builtin_amdgcn_rsqf(s * (1.0f / 1024.0f) + EPS) : 0.f;
                u32x2* orow = (u32x2*)(XB + (size_t)m * 1024);
#pragma unroll
                for (int j = 0; j < 4; ++j) orow[64 * j + lane] = (u32x2){pk2(v[r][j].x, v[r][j].y), pk2(v[r][j].z, v[r][j].w)};
            } }
    }
    float* COS = (float*)(P.ws + WS_COS); float* SIN = (float*)(P.ws + WS_SIN);
    for (int rp_ = 0; rp_ < ((P0_REP & 4) ? 2 : 1); ++rp_)
    for (int i = gtid; i < LTOK * 32; i += NGT) {
        const int p = i >> 5, f = i & 31;
        const double rev = (double)p * exp2(-(double)f * (13.287712379549449 / 32.0)) * 0.15915494309189535;
        const float fr = (float)(rev - floor(rev));
        COS[i] = __builtin_amdgcn_cosf(fr); SIN[i] = __builtin_amdgcn_sinf(fr);
    }
    float* WR = (float*)(P.ws + WS_WR); const float* gf = P.in[14]; const float* wgrp = P.in[15]; const float* wrt = P.in[17];
    for (int i = gtid; i < 36 * 1024; i += NGT) { const int j = i >> 10, k = i & 1023; WR[i] = gf[k] * (j < 4 ? wgrp[k * 4 + j] : wrt[k * 32 + (j - 4)]); }
}

#ifndef EPI_NT
#define EPI_NT 0
#endif
#if EPI_NT
#define NT_ST(p, v) __builtin_nontemporal_store((v), (p))
#else
#define NT_ST(p, v) (*(p) = (v))
#endif
struct EpiInProj {
    static constexpr bool PERM = true, AFTER_DRAIN = false;
    const float* RS1; const float* COS; const float* SIN; const float* a_log; const float* dt_bias;
    bf16_t* QB; bf16_t* KT; bf16_t* VT; bf16_t* QKVB; bf16_t* ZB; float* GB;
    DI void tail(const pg8::f32x4 (&acc)[2][2][4][2], const pg8::Unit& u, int wr, int wc, int fr, int fq) const {
        const int pn = u.pn;
#pragma unroll
        for (int ai = 0; ai < 2; ++ai)
#pragma unroll
            for (int m = 0; m < 4; ++m) {
                const int row = u.pm * 256 + ai * 128 + wr * 64 + m * 16 + fr;
                if (row < MTOK + NMETA) {
                    const float rs = RS1[row];
                    const bool meta = row >= MTOK;
                    const int p = meta ? row - MTOK : (row & 8191) + NMETA;
                    const int b0 = meta ? 0 : (row >> 13), nb = meta ? 2 : 1;
#pragma unroll
                    for (int bj = 0; bj < 2; ++bj) {
                        float xv[8];
#pragma unroll
                        for (int i = 0; i < 4; ++i) { xv[i] = acc[ai][bj][m][0][i] * rs; xv[4 + i] = acc[ai][bj][m][1][i] * rs; }
                        if (pn < 4) {
                            const int hh = (pn & 1) * 4 + bj * 2 + (wc >> 1), d0 = 4 * (4 * (wc & 1) + fq);
                            const f32x4 cs = *(const f32x4*)(COS + p * 32 + d0), sn = *(const f32x4*)(SIN + p * 32 + d0);
                            float lo[4], hi[4];
#pragma unroll
                            for (int i = 0; i < 4; ++i) { lo[i] = xv[i] * cs[i] - xv[4 + i] * sn[i]; hi[i] = xv[4 + i] * cs[i] + xv[i] * sn[i]; }
                            if (pn < 2) {
                                if (!meta) {
                                    bf16_t* q = QB + ((size_t)((b0 * 8 + hh) * SEQ + (p - NMETA)) << 6) + d0;
                                    *(u32x2*)q = (u32x2){pk2(lo[0] * C2Q, lo[1] * C2Q), pk2(lo[2] * C2Q, lo[3] * C2Q)};
                                    *(u32x2*)(q + 32) = (u32x2){pk2(hi[0] * C2Q, hi[1] * C2Q), pk2(hi[2] * C2Q, hi[3] * C2Q)};
                                }
                            } else {
                                for (int bb = b0; bb < b0 + nb; ++bb) {
                                    *(u32x2*)(KT + kt_off(bb, hh, p, d0)) = (u32x2){pk2(lo[0], lo[1]), pk2(lo[2], lo[3])};
                                    *(u32x2*)(KT + kt_off(bb, hh, p, d0 + 32)) = (u32x2){pk2(hi[0], hi[1]), pk2(hi[2], hi[3])};
                                }
                            }
                        } else {
                            const u32x4 w = (u32x4){pk2(xv[0], xv[1]), pk2(xv[2], xv[3]), pk2(xv[4], xv[5]), pk2(xv[6], xv[7])};
                            const int cl = bj * 128 + wc * 32 + fq * 8;
                            if (pn < 6) {
                                const int h = (pn - 4) * 2 + bj, d = wc * 32 + fq * 8;
                                for (int bb = b0; bb < b0 + nb; ++bb) *(u32x4*)(VT + vt_off(bb, h, p, d)) = w;
                            } else if (pn < 12) {
                                for (int bb = b0; bb < b0 + nb; ++bb) *(u32x4*)(QKVB + (size_t)(bb * LP + p) * 1536 + (pn - 6) * 256 + cl) = w;
                            } else if (pn < 14) {
                                float sz[8];
#pragma unroll
                                for (int i = 0; i < 8; ++i) sz[i] = xv[i] * __builtin_amdgcn_rcpf(1.0f + __expf(-xv[i]));
                                const u32x4 wz = (u32x4){pk2(sz[0], sz[1]), pk2(sz[2], sz[3]), pk2(sz[4], sz[5]), pk2(sz[6], sz[7])};
                                for (int bb = b0; bb < b0 + nb; ++bb) *(u32x4*)(ZB + (size_t)(bb * LP + p) * 512 + (pn - 12) * 256 + cl) = wz;
                            } else if (cl < 16) {
                                float o[8];
                                if (cl == 0) {
#pragma unroll
                                    for (int i = 0; i < 8; ++i) { const float t = xv[i] + dt_bias[i]; const float sp = t > 20.f ? t : log1pf(expf(t)); o[i] = -expf(a_log[i]) * sp; }
                                } else {
#pragma unroll
                                    for (int i = 0; i < 8; ++i) o[i] = 1.0f / (1.0f + expf(-xv[i]));
                                }
                                for (int bb = b0; bb < b0 + nb; ++bb) { float* g = GB + ((size_t)(bb * LP + p) << 4) + cl;
                                    *(f32x4*)g = (f32x4){o[0], o[1], o[2], o[3]}; *(f32x4*)(g + 4) = (f32x4){o[4], o[5], o[6], o[7]}; }
                            }
                        }
                    }
                }
            }
    }

    DI void operator()(const pg8::f32x4 (&acc)[2][2][4][2], const pg8::Unit& u, int wr, int wc, int fr, int fq) const {
        if (u.pm >= MTOK / 256) { tail(acc, u, wr, wc, fr, fq); return; }
        const int pn = u.pn, rowb = u.pm * 256 + wr * 64 + fr;
        float rs[2][4];
#pragma unroll
        for (int ai = 0; ai < 2; ++ai)
#pragma unroll
            for (int m = 0; m < 4; ++m) rs[ai][m] = RS1[rowb + ai * 128 + m * 16];
        __builtin_amdgcn_sched_barrier(0);
        const int b = rowb >> 13, s0 = rowb & 8191;
        if (pn < 4) {
            const int d0 = 4 * (4 * (wc & 1) + fq);
#pragma unroll
            for (int ai = 0; ai < 2; ++ai) {
                f32x4 cs[4], sn[4];
#pragma unroll
                for (int m = 0; m < 4; ++m) { const int p = s0 + ai * 128 + m * 16 + NMETA; cs[m] = *(const f32x4*)(COS + p * 32 + d0); sn[m] = *(const f32x4*)(SIN + p * 32 + d0); }
                __builtin_amdgcn_sched_barrier(0);
#pragma unroll
                for (int m = 0; m < 4; ++m)
#pragma unroll
                    for (int bj = 0; bj < 2; ++bj) {
                        const int hh = (pn & 1) * 4 + bj * 2 + (wc >> 1), s = s0 + ai * 128 + m * 16;
                        float lo[4], hi[4];
#pragma unroll
                        for (int i = 0; i < 4; ++i) { const float x1 = acc[ai][bj][m][0][i] * rs[ai][m], x2 = acc[ai][bj][m][1][i] * rs[ai][m];
                            lo[i] = x1 * cs[m][i] - x2 * sn[m][i]; hi[i] = x2 * cs[m][i] + x1 * sn[m][i]; }
                        if (pn < 2) { bf16_t* q = QB + ((size_t)((b * 8 + hh) * SEQ + s) << 6) + d0;
                            NT_ST((u32x2*)q, ((u32x2){pk2(lo[0] * C2Q, lo[1] * C2Q), pk2(lo[2] * C2Q, lo[3] * C2Q)}));
                            NT_ST((u32x2*)(q + 32), ((u32x2){pk2(hi[0] * C2Q, hi[1] * C2Q), pk2(hi[2] * C2Q, hi[3] * C2Q)}));
                        } else { bf16_t* k = KT + ((size_t)((b * 8 + hh) * NKT + 1 + (s >> 6)) << 12) + ((d0 >> 3) << 9) + ((s & 63) << 3) + (d0 & 7);
                            NT_ST((u32x2*)k, ((u32x2){pk2(lo[0], lo[1]), pk2(lo[2], lo[3])}));
                            NT_ST((u32x2*)(k + 4 * 512), ((u32x2){pk2(hi[0], hi[1]), pk2(hi[2], hi[3])})); }
                    }
            }
            return;
        }
        const int cl = wc * 32 + fq * 8;
#pragma unroll
        for (int ai = 0; ai < 2; ++ai)
#pragma unroll
            for (int m = 0; m < 4; ++m)
#pragma unroll
                for (int bj = 0; bj < 2; ++bj) {
                    const int s = s0 + ai * 128 + m * 16, p = s + NMETA;
                    float xv[8];
#pragma unroll
                    for (int i = 0; i < 4; ++i) { xv[i] = acc[ai][bj][m][0][i] * rs[ai][m]; xv[4 + i] = acc[ai][bj][m][1][i] * rs[ai][m]; }
                    if (pn < 6) {
                        const int h = (pn - 4) * 2 + bj;
                        NT_ST((u32x4*)(VT + ((size_t)((b * 4 + h) * NKT + 1 + (s >> 6)) << 13) + ((cl >> 5) << 11) + (((s & 63) >> 4) << 9) + ((s & 15) << 5) + (cl & 31)),
                            ((u32x4){pk2(xv[0], xv[1]), pk2(xv[2], xv[3]), pk2(xv[4], xv[5]), pk2(xv[6], xv[7])}));
                    } else if (pn < 12) {
                        NT_ST((u32x4*)(QKVB + (size_t)(b * LP + p) * 1536 + (pn - 6) * 256 + bj * 128 + cl), ((u32x4){pk2(xv[0], xv[1]), pk2(xv[2], xv[3]), pk2(xv[4], xv[5]), pk2(xv[6], xv[7])}));
                    } else if (pn < 14) {
#pragma unroll
                        for (int i = 0; i < 8; ++i) xv[i] = xv[i] * __builtin_amdgcn_rcpf(1.0f + __expf(-xv[i]));
                        NT_ST((u32x4*)(ZB + (size_t)(b * LP + p) * 512 + (pn - 12) * 256 + bj * 128 + cl), ((u32x4){pk2(xv[0], xv[1]), pk2(xv[2], xv[3]), pk2(xv[4], xv[5]), pk2(xv[6], xv[7])}));
                    } else if (bj == 0 && cl < 16) {
                        float o[8];
                        if (cl == 0) {
#pragma unroll
                            for (int i = 0; i < 8; ++i) { const float t = xv[i] + dt_bias[i]; const float sp = t > 20.f ? t : log1pf(expf(t)); o[i] = -expf(a_log[i]) * sp; }
                        } else {
#pragma unroll
                            for (int i = 0; i < 8; ++i) o[i] = 1.0f / (1.0f + expf(-xv[i]));
                        }
                        float* g = GB + ((size_t)(b * LP + p) << 4) + cl;
                        *(f32x4*)g = (f32x4){o[0], o[1], o[2], o[3]}; *(f32x4*)(g + 4) = (f32x4){o[4], o[5], o[6], o[7]};
                    }
                }
    }
};

DI bf16x8 lds_frag(LAS const bf16_t* M, int row, int ch) { return *(LAS const bf16x8*)((LAS const unsigned char*)M + row * 128 + ((ch ^ (row & 7)) << 4)); }
DI s16x4 tr_read_b64(LAS const unsigned char* p) { return __builtin_bit_cast(s16x4, __builtin_amdgcn_ds_read_tr16_b64_v4i16((LAS v4i16_t*)p)); }
DI bf16x8 lds_frag_plain(LAS const bf16_t* M, int row, int ch) { return *(LAS const bf16x8*)((LAS const unsigned char*)M + row * 128 + (ch << 4)); }
DI int swz_idx(int row, int d) { return row * 64 + ((((d >> 3) ^ (row & 7)) << 3) | (d & 7)); }

#ifndef PREP_REP
#define PREP_REP 0
#endif
constexpr int PREP_PAIR = 35840;

template <int MAT> DI void prep_rows(const bf16_t* QKVB, const float* cw, int b, int h, int n, int lane, LAS const float* egS,
                                     LAS bf16_t* DS  , bf16_t* QG) {
    const int colb = MAT * 512 + h * 64, col = colb + lane, p0 = n * 64;
    const float c0 = cw[col], c1 = cw[1536 + col], c2 = cw[3072 + col], c3 = cw[4608 + col];
    const bf16_t* blk = QKVB + (size_t)(b * LP + p0) * 1536 + colb;
    float x0 = 0.f, x1 = 0.f, x2 = 0.f;
    if (n > 0) { x0 = bf2f(blk[lane - 3 * 1536]); x1 = bf2f(blk[lane - 2 * 1536]); x2 = bf2f(blk[lane - 1 * 1536]); }
    u32x4 stg[8];
#pragma unroll
    for (int i = 0; i < 8; ++i) stg[i] = *(const u32x4*)(blk + (size_t)(8 * i + (lane >> 3)) * 1536 + (lane & 7) * 8);
#pragma unroll
    for (int i = 0; i < 8; ++i) *(LAS u32x4*)(DS + (8 * i + (lane >> 3)) * 64 + (lane & 7) * 8) = stg[i];
    LDS_WAIT();
    const int nvalid = (LTOK - p0) < 64 ? (LTOK - p0) : 64;
#pragma unroll 4
    for (int c = 0; c < nvalid; ++c) {
        const float x3 = bf2f(DS[c * 64 + lane]);
        float y = c0 * x0 + c1 * x1 + c2 * x2 + c3 * x3;
        y = y * __builtin_amdgcn_rcpf(1.0f + __expf(-y));
        x0 = x1; x1 = x2; x2 = x3;
        if (MAT == 2) { DS[c * 64 + lane] = (bf16_t)f2bf(y * egS[c]); }
        else {
            const float ss = wave_sum(y * y);
            const float yn = y * __builtin_amdgcn_rsqf(ss + EPS);
            if (MAT == 0) {
                const float qn = yn * 0.125f;
                DS[c * 64 + lane] = (bf16_t)f2bf(qn);
                QG[c * 64 + perm16(lane)] = (bf16_t)f2bf(qn * egS[c]);
            } else {
                DS[c * 64 + lane] = (bf16_t)f2bf(yn);
            }
        }
    }
    for (int c = nvalid; c < 64; ++c) { DS[c * 64 + lane] = 0; if (MAT == 0) QG[c * 64 + perm16(lane)] = 0; }
}

DI void gdn_tinv(LAS const float* AST, LAS bf16_t* TS, int lane) {
    const int hb = lane >> 5, j = lane & 31, r32 = j, hi = hb;
    LAS const float* Ab = AST + (32 * hb) * 68 + 32 * hb;
    float x[32];
#pragma unroll
    for (int r = 0; r < 32; ++r) x[r] = (r == j) ? 1.0f : 0.0f;
#pragma unroll
    for (int jj = 0; jj < 31; ++jj) {
        const float xj = x[jj];
        LAS const float* ap = Ab + jj * 68;
#pragma unroll
        for (int r4 = (jj + 1) / 4; r4 < 8; ++r4) {
            const f32x4 a = *(LAS const f32x4*)(ap + 4 * r4);
#pragma unroll
            for (int e = 0; e < 4; ++e) if (4 * r4 + e > jj) x[4 * r4 + e] -= a[e] * xj;
        }
    }
    bf16x8 a21[2];
#pragma unroll
    for (int s = 0; s < 2; ++s) { float t[8];
#pragma unroll
        for (int jj = 0; jj < 8; ++jj) t[jj] = AST[(16 * s + 8 * hi + jj) * 68 + 32 + r32];
        const u32x4 p = (u32x4){pk2(t[0], t[1]), pk2(t[2], t[3]), pk2(t[4], t[5]), pk2(t[6], t[7])}; a21[s] = __builtin_bit_cast(bf16x8, p); }
    f32x16 M = {};
#pragma unroll
    for (int s = 0; s < 2; ++s) { float t[8];
#pragma unroll
        for (int jj = 0; jj < 8; ++jj) {
            const auto rr = __builtin_amdgcn_permlane32_swap(__float_as_uint(x[16 * s + 8 + jj]), __float_as_uint(x[16 * s + 8 + jj]), false, false);
            t[jj] = hi ? __uint_as_float(rr[0]) : x[16 * s + jj];
        }
        const u32x4 p = (u32x4){pk2(t[0], t[1]), pk2(t[2], t[3]), pk2(t[4], t[5]), pk2(t[6], t[7])};
        M = MFMA32(a21[s], __builtin_bit_cast(bf16x8, p), M);
    }
    asm volatile("s_waitcnt lgkmcnt(0)" ::: "memory");
#pragma unroll
    for (int i = 0; i < 32; ++i) TS[(32 * hb + i) * 64 + 32 * hb + j] = (bf16_t)f2bf(x[i]);
    asm volatile("s_waitcnt lgkmcnt(0)" ::: "memory");
    f32x16 T21 = {};
#pragma unroll
    for (int s = 0; s < 2; ++s) {
        const u32x2 lo = *(LAS const u32x2*)(TS + (32 + r32) * 64 + 32 + 16 * s + 4 * hi), hi8 = *(LAS const u32x2*)(TS + (32 + r32) * 64 + 32 + 16 * s + 8 + 4 * hi);
        const u32x4 p = (u32x4){lo.x, lo.y, hi8.x, hi8.y};
        T21 = MFMA32(__builtin_bit_cast(bf16x8, p), pack8(M, s), T21);
    }
#pragma unroll
    for (int i = 0; i < 16; ++i) TS[(32 + crow(i, hi)) * 64 + r32] = (bf16_t)f2bf(-T21[i]);
    asm volatile("s_waitcnt lgkmcnt(0)" ::: "memory");
}

template <bool PERM> DI void gdn_tmul(LAS const bf16_t* TS, LAS const bf16_t* RS, int lane, float sgn, bf16_t* out) {
    const int r32 = lane & 31, hi = lane >> 5;
    LAS const unsigned char* rb = (LAS const unsigned char*)RS + ((8 * hi + ((lane & 15) >> 2)) * 64 + 16 * ((lane >> 4) & 1) + 4 * (lane & 3)) * 2;
#pragma unroll
    for (int ct = 0; ct < 2; ++ct)
#pragma unroll
        for (int cb = 0; cb < 2; ++cb) {
            f32x16 acc = {};
#pragma unroll
            for (int ks = 0; ks < (ct == 0 ? 2 : 4); ++ks) {
                const bf16x8 fa = lds_frag_plain(TS, 32 * ct + r32, 2 * ks + hi);
                const s16x4 lo = tr_read_b64(rb + (16 * ks * 64 + 32 * cb) * 2), h4 = tr_read_b64(rb + ((16 * ks + 4) * 64 + 32 * cb) * 2);
                const bf16x8 fb = (bf16x8){lo[0], lo[1], lo[2], lo[3], h4[0], h4[1], h4[2], h4[3]};
                acc = MFMA32(fa, fb, acc);
            }
            u32x2 pk[16];
#pragma unroll
            for (int i = 0; i < 16; ++i) pk[i] = pack_quad_bf16(sgn * acc[i]);
            if ((lane & 3) == 0) {
                unsigned long long ob_ = (unsigned long long)(out + hi * 256 + (PERM ? perm16(32 * cb + r32) : 32 * cb + r32)); asm volatile("" : "+v"(ob_));
                g_u32x2* ob = (g_u32x2*)ob_;
#pragma unroll
                for (int i = 0; i < 16; ++i) ob[(32 * ct + (i & 3) + 8 * (i >> 2)) * 16] = pk[i];
            }
        }
}

DI void gdn_prep_phase(const Params& P, LAS unsigned char* lds, int blk, int G, int wave, int lane_in) {
    const int pair = wave >> 1, role = wave & 1;
    LAS unsigned char* pb = lds + pair * PREP_PAIR;
    LAS bf16_t* QS = (LAS bf16_t*)pb; LAS bf16_t* KS = (LAS bf16_t*)(pb + 8192); LAS float* AS = (LAS float*)(pb + 16384);
    LAS float* gcS = (LAS float*)(pb + 16384 + 17408 + role * 1024); LAS float* betaS = gcS + 64; LAS float* egS = gcS + 128; LAS float* ekS = gcS + 192;
    const bf16_t* QKVB = (const bf16_t*)(P.ws + WS_QKVB); const float* GB = (const float*)(P.ws + WS_GB); const float* cw = P.in[9];
    const int NP = G * 4, NTASK = 2 * 8 * NCHUNK;
    for (int it = 0; it * NP < NTASK; ++it) {
        int lane = lane_in; asm volatile("" : "+v"(lane));
        const int r32 = lane & 31, hi = lane >> 5;
        const int task = it * NP + blk * 4 + pair;
        const bool active = task < NTASK;
        const int bh = task < 2048 ? (task >> 7) : (task - 2048), n = task < 2048 ? (task & 127) : 128, b = bh >> 3, h = bh & 7;
        const int sidx = bh * NCHUNK + n;
        bf16_t* GPW = (bf16_t*)(P.ws + WS_GP) + (size_t)sidx * 4096; bf16_t* GPQG = GPW + GP_ARR / 2; bf16_t* GPAQK = GPQG + GP_ARR / 2; bf16_t* GPKGT = GPAQK + GP_ARR / 2; bf16_t* GPU = GPKGT + GP_ARR / 2;
        float gc = 0.f, beta = 0.f;
        if (active) {
            const int pl = n * 64 + lane;
            float g = 0.f;
            if (pl < LTOK) { const float* gb = GB + ((size_t)(b * LP + pl) << 4); g = gb[h]; beta = gb[8 + h]; }
            gcS[lane] = g; LDS_WAIT();
            gc = 0.f;
#pragma unroll
            for (int j4 = 0; j4 < 16; ++j4) { const f32x4 t = *(LAS const f32x4*)(gcS + 4 * j4);
                gc += (4 * j4 <= lane ? t[0] : 0.f) + (4 * j4 + 1 <= lane ? t[1] : 0.f) + (4 * j4 + 2 <= lane ? t[2] : 0.f) + (4 * j4 + 3 <= lane ? t[3] : 0.f); }
            const float glast = rlane(gc, 63);
            LDS_WAIT();
            gcS[lane] = gc; betaS[lane] = beta; egS[lane] = (role == 0) ? __expf(gc) : beta * __expf(gc); ekS[lane] = __expf(glast - gc);
            if (role == 0 && lane == 0) ((float*)(P.ws + WS_GL))[sidx] = __expf(glast);
            LDS_WAIT();
            for (int rp_ = 0; rp_ < ((PREP_REP & 1) ? 2 : 1); ++rp_) {
            if (role == 0) prep_rows<0>(QKVB, cw, b, h, n, lane, egS, QS, GPQG);
            else prep_rows<1>(QKVB, cw, b, h, n, lane, egS, KS, GPQG);
            }
        }
        LDS_WAIT();
        __syncthreads();
        if (active) {
            for (int rp_ = 0; rp_ < ((PREP_REP & 2) ? 2 : 1); ++rp_)
#pragma unroll
            for (int t4 = 0; t4 < 4; ++t4) {
                const int ct = t4 >> 1, st = t4 & 1;
                f32x16 acc = {};
                if (!(ct == 0 && st == 1)) {
#pragma unroll
                    for (int ks = 0; ks < 4; ++ks) {
                        const bf16x8 fa = lds_frag_plain(role == 0 ? QS : KS, 32 * ct + r32, 2 * ks + hi), fb = lds_frag_plain(KS, 32 * st + r32, 2 * ks + hi);
                        acc = MFMA32(fa, fb, acc);
                    }
                }
                const float gcs = gcS[32 * st + r32];
                LAS const float* gcb = gcS + hi * 4; LAS const float* beb = betaS + hi * 4;
                asm volatile("" : "+v"(gcb), "+v"(beb));
                const int cmp = (32 * st + r32) - 4 * hi;
                if (role == 0) {
                    u32x2 pk[16];
#pragma unroll
                    for (int i = 0; i < 16; ++i) { const int cr = 32 * ct + (i & 3) + 8 * (i >> 2);
                        pk[i] = pack_quad_bf16((cmp <= cr) ? acc[i] * __expf(gcb[cr] - gcs) : 0.f); }
                    if ((lane & 3) == 0) {
                        unsigned long long aq_ = (unsigned long long)(GPAQK + hi * 256 + perm16(r32) + 32 * st); asm volatile("" : "+v"(aq_));
                        g_u32x2* aqb = (g_u32x2*)aq_;
#pragma unroll
                        for (int i = 0; i < 16; ++i) { const int cr = 32 * ct + (i & 3) + 8 * (i >> 2); aqb[cr * 16] = pk[i]; }
                    }
                } else {
                    LAS float* asb = AS + r32 * 68 + hi * 4;
                    asm volatile("" : "+v"(asb));
#pragma unroll
                    for (int i = 0; i < 16; ++i) { const int cr = 32 * ct + (i & 3) + 8 * (i >> 2);
                        asb[32 * st * 68 + cr] = (cmp < cr) ? acc[i] * beb[cr] * __expf(gcb[cr] - gcs) : 0.f; }
                }
            }
        }
        LDS_WAIT();
        __syncthreads();
        LAS bf16_t* TS = (LAS bf16_t*)((LAS unsigned char*)AS + 32 * 68 * 4);
        if (active) {
            if (role == 0) {
                prep_rows<2>(QKVB, cw, b, h, n, lane, betaS, QS  , GPQG);
            } else {
#pragma unroll
                for (int gq = 0; gq < 8; ++gq) {
                    float t[8];
#pragma unroll
                    for (int j = 0; j < 8; ++j) { const int c = perm16(8 * gq + j); t[j] = bf2f(KS[c * 64 + lane]) * ekS[c]; }
                    *(u32x4*)(GPKGT + lane * 64 + 8 * gq) = (u32x4){pk2(t[0], t[1]), pk2(t[2], t[3]), pk2(t[4], t[5]), pk2(t[6], t[7])};
                }
#pragma unroll 8
                for (int c = 0; c < 64; ++c) KS[c * 64 + lane] = (bf16_t)f2bf(bf2f(KS[c * 64 + lane]) * egS[c]);
                gdn_tinv(AS, TS, lane);
            }
        }
        LDS_WAIT();
        __syncthreads();
        if (active) {
            for (int rp_ = 0; rp_ < ((PREP_REP & 8) ? 2 : 1); ++rp_) {
            if (role == 0) gdn_tmul<false>(TS, QS, lane, 1.0f, GPU);
            else gdn_tmul<true>(TS, KS, lane, -1.0f, GPW);
            }
        }
        LDS_WAIT();
    }
}

constexpr int GS_STAGE = 40960 + 1024;
constexpr int GS_NSTAGE = 3;
constexpr int GS_OBUF = GS_NSTAGE * GS_STAGE;
static_assert(GS_OBUF + 16384 <= LDS_BYTES - 64, "gdn scan LDS");

#define GS_POST(n, ZQ) do { \
            if (n > 0) {         \
                LAS const bf16_t* ob = (LAS const bf16_t*)(lds + GS_OBUF + ((n - 1) & 1) * 8192); \
                const f32x4 gn = *(const f32x4*)(gnorm + 4 * vq); \
            _Pragma("unroll") \
                for (int it = 0; it < 8; ++it) { \
                    const int c = (wave - 2) * 32 + 4 * it + rg, p = (n - 1) * 64 + c; \
                    const u32x2 ov = *(LAS const u32x2*)(ob + c * 64 + 4 * vq); \
                    const float v0 = __uint_as_float(ov.x << 16), v1 = __uint_as_float(ov.x & 0xffff0000u), v2 = __uint_as_float(ov.y << 16), v3 = __uint_as_float(ov.y & 0xffff0000u); \
                    const float ss = row_sum16((v0 * v0 + v1 * v1) + (v2 * v2 + v3 * v3)); \
                    const float rn = __builtin_amdgcn_rsqf(ss * (1.0f / 64.0f) + EPS); \
                    const u32x2 zz = ZQ[it]; \
                    const float z0 = __uint_as_float(zz.x << 16), z1 = __uint_as_float(zz.x & 0xffff0000u), z2 = __uint_as_float(zz.y << 16), z3 = __uint_as_float(zz.y & 0xffff0000u); \
                    const float y0 = v0 * rn * gn[0] * z0, y1 = v1 * rn * gn[1] * z1, y2 = v2 * rn * gn[2] * z2, y3 = v3 * rn * gn[3] * z3;       \
                    { bf16_t* dst_ = ((p >= NMETA) && (p < LTOK)) ? MIX + (size_t)(b * SEQ + p - NMETA) * 1024 + 512 + h * 64 + 4 * vq : DUMP + lane * 4;       \
                      *(u32x2*)dst_ = (u32x2){pk2(y0, y1), pk2(y2, y3)}; } \
                } \
            } \
        } while (0)
DI void gdn_scan(const Params& P, LAS unsigned char* lds, int bh, int tid, int wave, int lane) {
    const int b = bh >> 3, h = bh & 7, r32 = lane & 31, hi = lane >> 5;
    const int task0 = (b * 8 + h) * NCHUNK;
    const bf16_t* GP0 = (const bf16_t*)(P.ws + WS_GP);
    const float* GLg = (const float*)(P.ws + WS_GL);
    const bf16_t* ZB = (const bf16_t*)(P.ws + WS_ZB); bf16_t* MIX = (bf16_t*)(P.ws + WS_MIX); const float* gnorm = P.in[12];
    bf16_t* DUMP = (bf16_t*)(P.ws + WS_DUMP) + bh * 4096 + wave * 512;
    const int lw = wave - 4;
    const int prow = lane >> 3, pch = lane & 7;
#define GS_DMA(n_, stg_) do { LAS unsigned char* sg_ = lds + (stg_) * GS_STAGE; \
        _Pragma("unroll") for (int i = 0; i < 10; ++i) { const int a_ = i >> 1, pi_ = lw * 2 + (i & 1), row_ = 8 * pi_ + prow; \
            const int sch_ = (a_ < 4) ? (pch ^ (row_ & 7)) : pch; \
            __builtin_amdgcn_global_load_lds((const unsigned*)(GP0 + (size_t)a_ * (GP_ARR / 2) + (size_t)(task0 + (n_)) * 4096 + row_ * 64 + sch_ * 8), \
                                             (LAS unsigned*)(sg_ + a_ * 8192 + pi_ * 1024), 16, 0, 0); } \
        __builtin_amdgcn_global_load_lds((const unsigned*)(GLg + task0 + (n_)), (LAS unsigned*)(sg_ + 40960 + lw * 256), 4, 0, 0); } while (0)
    if (wave >= 4) { GS_DMA(0, 0); GS_DMA(1, 1); asm volatile("s_waitcnt vmcnt(11)" ::: "memory"); }
    const int vq = lane & 15, rg = lane >> 4;
    u32x2 zqA[8], zqB[8];
#define GS_ZLOADX(ZQ, n_) do { _Pragma("unroll") for (int it = 0; it < 8; ++it) { int p_ = (n_) * 64 + (wave - 2) * 32 + 4 * it + rg; p_ = p_ < LTOK ? p_ : LTOK - 1; \
            ZQ[it] = *(const u32x2*)(ZB + (size_t)(b * LP + p_) * 512 + h * 64 + 4 * vq); } } while (0)
    if (wave == 2 || wave == 3) { GS_ZLOADX(zqB, 0); }
    BAR_LDS();
    f32x16 S0 = {}, S1 = {};
    const int vbase = 32 * wave;
    if (wave < 2) {
    int stg = 0;
    for (int n = 0; n <= NCHUNK; ++n) {
        {
            if (n < NCHUNK) {
                LAS const unsigned char* sg = lds + stg * GS_STAGE;
                LAS const bf16_t* Wm = (LAS const bf16_t*)sg; LAS const bf16_t* QGm = (LAS const bf16_t*)(sg + 8192); LAS const bf16_t* AQm = (LAS const bf16_t*)(sg + 16384);
                LAS const bf16_t* KGm = (LAS const bf16_t*)(sg + 24576); LAS const bf16_t* Um = (LAS const bf16_t*)(sg + 32768);
                const float gl = *(LAS const float*)(sg + 40960);
                bf16x8 Sb[2][2]; Sb[0][0] = pack8(S0, 0); Sb[0][1] = pack8(S0, 1); Sb[1][0] = pack8(S1, 0); Sb[1][1] = pack8(S1, 1);
                bf16x8 fw[2][4], fq[2][4];
                f32x16 vn[2], o[2];
#pragma unroll
                for (int ct = 0; ct < 2; ++ct)
#pragma unroll
                    for (int k4 = 0; k4 < 4; ++k4) { fw[ct][k4] = lds_frag(Wm, 32 * ct + r32, k4 * 2 + hi); fq[ct][k4] = lds_frag(QGm, 32 * ct + r32, k4 * 2 + hi); }
#pragma unroll
                for (int ct = 0; ct < 2; ++ct)
#pragma unroll
                    for (int i = 0; i < 16; ++i) vn[ct][i] = bf2f(Um[(32 * ct + crow(i, hi)) * 64 + vbase + r32]);
                o[0] = f32x16{}; o[1] = f32x16{};
                __builtin_amdgcn_sched_barrier(0);
#pragma unroll
                for (int k4 = 0; k4 < 4; ++k4) {
                    vn[0] = MFMA32(fw[0][k4], Sb[k4 >> 1][k4 & 1], vn[0]); o[0] = MFMA32(fq[0][k4], Sb[k4 >> 1][k4 & 1], o[0]);
                    vn[1] = MFMA32(fw[1][k4], Sb[k4 >> 1][k4 & 1], vn[1]); o[1] = MFMA32(fq[1][k4], Sb[k4 >> 1][k4 & 1], o[1]);
                }
                __builtin_amdgcn_sched_barrier(0);
                bf16x8 fa[2][4], fk[2][4];
#pragma unroll
                for (int g = 0; g < 4; ++g) { fa[0][g] = lds_frag(AQm, r32, g * 2 + hi); fa[1][g] = lds_frag(AQm, 32 + r32, g * 2 + hi);
                                              fk[0][g] = lds_frag(KGm, r32, g * 2 + hi); fk[1][g] = lds_frag(KGm, 32 + r32, g * 2 + hi); }
#pragma unroll
                for (int i = 0; i < 16; ++i) { S0[i] *= gl; S1[i] *= gl; }
                __builtin_amdgcn_sched_barrier(0);
                bf16x8 Vb[2][2]; Vb[0][0] = pack8(vn[0], 0); Vb[0][1] = pack8(vn[0], 1); Vb[1][0] = pack8(vn[1], 0); Vb[1][1] = pack8(vn[1], 1);
#pragma unroll
                for (int g = 0; g < 4; ++g) {
                    o[0] = MFMA32(fa[0][g], Vb[g >> 1][g & 1], o[0]); S0 = MFMA32(fk[0][g], Vb[g >> 1][g & 1], S0);
                    o[1] = MFMA32(fa[1][g], Vb[g >> 1][g & 1], o[1]); S1 = MFMA32(fk[1][g], Vb[g >> 1][g & 1], S1);
                }
                LAS bf16_t* ob = (LAS bf16_t*)(lds + GS_OBUF + (n & 1) * 8192);
#pragma unroll
                for (int ct = 0; ct < 2; ++ct)
#pragma unroll
                    for (int i = 0; i < 16; ++i) ob[(32 * ct + crow(i, hi)) * 64 + vbase + r32] = (bf16_t)f2bf(o[ct][i]);
            }
        }
        BAR_LDS();
        stg = stg + 1 >= GS_NSTAGE ? 0 : stg + 1;
    }
    } else if (wave < 4) {
    for (int n = 0; n <= NCHUNK; n += 2) {
        GS_POST(n, zqA);     if (n + 1 < NCHUNK) { GS_ZLOADX(zqA, n + 1); } BAR_LDS();
        GS_POST((n + 1), zqB); if (n + 2 < NCHUNK) { GS_ZLOADX(zqB, n + 2); } BAR_LDS();
    }
    } else {
    int stg = 0;
    for (int n = 0; n <= NCHUNK; ++n) {
        {
            if (n + 2 < NCHUNK) { const int s2_ = stg + 2 >= GS_NSTAGE ? stg + 2 - GS_NSTAGE : stg + 2; GS_DMA(n + 2, s2_); asm volatile("s_waitcnt vmcnt(11)" ::: "memory"); }
            else asm volatile("s_waitcnt vmcnt(0)" ::: "memory");
        }
        BAR_LDS();
        stg = stg + 1 >= GS_NSTAGE ? 0 : stg + 1;
    }
    }
#undef GS_DMA
#undef GS_ZLOADX
}
#define XB_TMO      128
#define XB_XCNT(j)  (256  + 64 * (j))
#define XB_XSUB(j)  (1280 + 64 * (j))
#define XB_XGEN(j)  (2304 + 64 * (j))
#define XB_TOP      3328
#define XB_TOPGEN   3392
#define XCD_BAR_WORDS 3456
#define XB_SPIN_CAP (1u << 18)

__device__ __forceinline__ unsigned xb_ld(unsigned* p)              { return __hip_atomic_load(p, __ATOMIC_RELAXED, __HIP_MEMORY_SCOPE_AGENT); }
__device__ __forceinline__ unsigned xb_add(unsigned* p, unsigned v) { return __hip_atomic_fetch_add(p, v, __ATOMIC_RELAXED, __HIP_MEMORY_SCOPE_AGENT); }
__device__ __forceinline__ unsigned xb_xcc_id() { return (unsigned)__builtin_amdgcn_s_getreg((3 << 11) | 20) & 0xFu; }
#define XB_SPIN(cond, bar) do { unsigned _sp = 0; while (cond) { __builtin_amdgcn_s_sleep(1); \
    if ((++_sp & 255u) == 0u) { if (xb_ld(&(bar)[XB_TMO])) break; if (_sp > XB_SPIN_CAP) { atomicAdd(&(bar)[XB_TMO], 1u); break; } } } } while (0)

struct XcdBarrier {
    unsigned* bar; unsigned x;
    volatile LAS unsigned* st;
};

__device__ __forceinline__ XcdBarrier xcd_barrier_post(unsigned* bar, volatile LAS unsigned* st) {
    XcdBarrier b; b.bar = bar; b.x = xb_xcc_id(); b.st = st;
    if (threadIdx.x == 0) (void)xb_add(&bar[XB_XCNT(b.x)], 1u);
    return b;
}
__device__ __forceinline__ void xcd_barrier_complete(unsigned* bar, unsigned x, unsigned& nloc, unsigned& nx) {
    const unsigned G = gridDim.x * gridDim.y * gridDim.z;
    unsigned sum, cnt, mine, sp = 0u;
    for (;;) {
        sum = 0u; cnt = 0u; mine = 0u;
#pragma unroll
        for (unsigned j = 0; j < 16; ++j) { const unsigned c = xb_ld(&bar[XB_XCNT(j)]); sum += c; cnt += (c > 0u) ? 1u : 0u; mine = (j == x) ? c : mine; }
        if (sum == G) break;
        __builtin_amdgcn_s_sleep(1);
        if ((++sp & 255u) == 0u) { if (xb_ld(&bar[XB_TMO])) break; if (sp > XB_SPIN_CAP) { atomicAdd(&bar[XB_TMO], 1u); break; } }
    }
    nloc = mine > 0u ? mine : 1u; nx = cnt > 0u ? cnt : 1u;
}

__device__ __forceinline__ void xcd_barrier(const XcdBarrier& b) {
    asm volatile("s_waitcnt vmcnt(0)" ::: "memory");
    __syncthreads();
    if (threadIdx.x == 0) {
        unsigned* bar = b.bar;
        __builtin_amdgcn_s_waitcnt(0);
        unsigned nloc = b.st[0], nx = b.st[1];
        if (nloc == 0u) { xcd_barrier_complete(bar, b.x, nloc, nx); b.st[0] = nloc; b.st[1] = nx; }
        const unsigned old = xb_add(&bar[XB_XSUB(b.x)], 1u);
        const unsigned gen = old / nloc;
        if (old + 1u == (gen + 1u) * nloc) {
            __builtin_amdgcn_fence(__ATOMIC_RELEASE, "agent");
            asm volatile("s_waitcnt vmcnt(0)" ::: "memory");
            const unsigned og = xb_add(&bar[XB_TOP], 1u);
            const unsigned tg = og / nx;
            if (og + 1u == (tg + 1u) * nx) xb_add(&bar[XB_TOPGEN], 1u);
            else XB_SPIN(xb_ld(&bar[XB_TOPGEN]) == tg, bar);
            __builtin_amdgcn_fence(__ATOMIC_ACQUIRE, "agent");
            xb_add(&bar[XB_XGEN(b.x)], 1u);
            asm volatile("s_waitcnt vmcnt(0)" ::: "memory");
        } else {
            XB_SPIN(xb_ld(&bar[XB_XGEN(b.x)]) == gen, bar);
            __builtin_amdgcn_fence(__ATOMIC_ACQUIRE, "agent");
            asm volatile("s_waitcnt vmcnt(0)" ::: "memory");
        }
    }
    __syncthreads();
}


constexpr int AT_STAGE = 32768;
constexpr int AT_NSTAGE = 3;
constexpr int AT_XBUF = 0;
constexpr int AT_WSF = AT_NSTAGE * AT_STAGE;
constexpr int AT_UNIT = AT_WSF + 2048;
constexpr float AT_THR = 8.0f;

DI float max3f(float a, float b, float c) { return __builtin_fmaxf(__builtin_fmaxf(a, b), c); }
DI s16x4 tr_read(LAS const unsigned char* p) { return __builtin_bit_cast(s16x4, __builtin_amdgcn_ds_read_tr16_b64_v4i16((LAS v4i16_t*)p)); }

template <int VAR> DI void attn_unit(const Params& P, LAS unsigned char* lds, int bh, int qi, int tid, int wave, int lane, float lam) {
    const int b = bh >> 2, h = bh & 3, r32 = lane & 31, hi = lane >> 5, qsub = wave >> 1, map = wave & 1, hh = 2 * h + map;
    const bf16_t* QB = (const bf16_t*)(P.ws + WS_QB); const bf16_t* KT = (const bf16_t*)(P.ws + WS_KT); const bf16_t* VT = (const bf16_t*)(P.ws + WS_VT);
    const int ntiles = 2 * qi + 3, my_nt = (qsub < 2) ? ntiles - 1 : ntiles;
    const bf16_t* k1 = KT + ((size_t)((b * 8 + 2 * h) * NKT) << 12) + tid * 8;
    const bf16_t* k2 = KT + ((size_t)((b * 8 + 2 * h + 1) * NKT) << 12) + tid * 8;
    const bf16_t* vv = VT + ((size_t)((b * 4 + h) * NKT) << 13) + tid * 8;
#define AT_DMA(t, sb) do { LAS unsigned char* d_ = lds + (sb) * AT_STAGE + wave * 1024; \
        __builtin_amdgcn_global_load_lds((const unsigned*)(k1 + ((size_t)(t) << 12)), (LAS unsigned*)d_, 16, 0, 0); \
        __builtin_amdgcn_global_load_lds((const unsigned*)(k2 + ((size_t)(t) << 12)), (LAS unsigned*)(d_ + 8192), 16, 0, 0); \
        __builtin_amdgcn_global_load_lds((const unsigned*)(vv + ((size_t)(t) << 13)), (LAS unsigned*)(d_ + 16384), 16, 0, 0); \
        __builtin_amdgcn_global_load_lds((const unsigned*)(vv + ((size_t)(t) << 13) + 4096), (LAS unsigned*)(d_ + 24576), 16, 0, 0); } while (0)
    bf16x8 qr[4];
    { const bf16_t* q = QB + ((size_t)((b * 8 + hh) * SEQ + qi * 128 + qsub * 32 + r32) << 6) + hi * 8;
#pragma unroll
      for (int d0 = 0; d0 < 4; ++d0) qr[d0] = *(const bf16x8*)(q + d0 * 16); }
    asm volatile("s_waitcnt vmcnt(0)" : "+v"(qr[0]), "+v"(qr[1]), "+v"(qr[2]), "+v"(qr[3]) :: "memory");
    AT_DMA(0, 0);
    if (ntiles > 1) AT_DMA(1, 1);
    if (ntiles > 1) asm volatile("s_waitcnt vmcnt(4)" ::: "memory"); else asm volatile("s_waitcnt vmcnt(0)" ::: "memory");
    BAR_LDS();
    LAS float* wsf = (LAS float*)(lds + AT_WSF) + wave * 64;
    float m_run = 0.f, l_run = 0.f;
    f32x16 negm = {};
    f32x16 o[4]; o[0] = f32x16{}; o[1] = f32x16{}; o[2] = f32x16{}; o[3] = f32x16{};
    for (int t = 0; t < ntiles; ++t) {
        if (t + 2 < ntiles) AT_DMA(t + 2, (t + 2) % AT_NSTAGE);
        if (t < my_nt) {
            LAS const unsigned char* sg = lds + (t % AT_NSTAGE) * AT_STAGE;
            LAS const unsigned char* kb = sg + map * 8192 + hi * 1024 + r32 * 16;
            f32x16 p0 = negm, p1 = negm;
            bf16x8 kf[8];
#pragma unroll
            for (int d0 = 0; d0 < 4; ++d0) { kf[2 * d0] = *(LAS const bf16x8*)(kb + d0 * 2048); kf[2 * d0 + 1] = *(LAS const bf16x8*)(kb + d0 * 2048 + 512); }
            __builtin_amdgcn_sched_barrier(0);
            __builtin_amdgcn_s_setprio(1);
#pragma unroll
            for (int d0 = 0; d0 < 4; ++d0) { p0 = MFMA32(kf[2 * d0], qr[d0], p0); p1 = MFMA32(kf[2 * d0 + 1], qr[d0], p1); }
            __builtin_amdgcn_s_setprio(0);
            const bool first = (t == 0);
            if (first) {
#pragma unroll
                for (int r = 0; r < 16; ++r) { if (crow(r, hi) >= NMETA) p0[r] = -INFINITY; p1[r] = -INFINITY; }
            }
            float ma = max3f(p0[0], p0[1], p1[0]), mb = max3f(p0[2], p0[3], p1[1]); ma = max3f(ma, p1[2], p1[3]);
#pragma unroll
            for (int r = 4; r < 16; r += 4) { ma = max3f(ma, p0[r], p0[r + 1]); mb = max3f(mb, p0[r + 2], p0[r + 3]); ma = max3f(ma, p1[r], p1[r + 1]); mb = max3f(mb, p1[r + 2], p1[r + 3]); }
            const float rm = swap32_max(max3f(ma, mb, mb));
            if (first || __any(rm > AT_THR)) {
                const float dl = first ? rm : fmaxf(rm, 0.f);
                m_run += dl;
#pragma unroll
                for (int r = 0; r < 16; ++r) { p0[r] -= dl; p1[r] -= dl; negm[r] = -m_run; }
                const float alpha = __builtin_amdgcn_exp2f(-dl);
                l_run *= alpha;
                if (!first) {
                    if (hi == 0) wsf[r32] = alpha;
                    LDS_WAIT();
#pragma unroll
                    for (int r = 0; r < 16; ++r) { const float a = wsf[crow(r, hi)];
#pragma unroll
                        for (int d0 = 0; d0 < 4; ++d0) o[d0][r] *= a; }
                    LDS_WAIT();
                }
            }
            float ls0 = 0.f, ls1 = 0.f;
#pragma unroll
            for (int r = 0; r < 16; ++r) { if (VAR != 2) { p0[r] = __builtin_amdgcn_exp2f(p0[r]); p1[r] = __builtin_amdgcn_exp2f(p1[r]); } ls0 += p0[r]; ls1 += p1[r]; }
            l_run += ls0 + ls1;
            const bf16x8 pa0 = pack8(p0, 0), pa1 = pack8(p0, 1), pa2 = pack8(p1, 0), pa3 = pack8(p1, 1);
            LAS const unsigned char* vb = sg + 16384 + ((lane >> 4) & 1) * 32 + (lane & 3) * 8 + (4 * hi + ((lane & 15) >> 2)) * 64;
            s16x4 va_[8], vb_[8];
            const unsigned vba = (unsigned)(uintptr_t)vb;
#define AT_VLD(V, d0_) do { _Pragma("unroll") for (int ks = 0; ks < 4; ++ks) { \
                asm volatile("ds_read_b64_tr_b16 %0, %1 offset:%c2" : "=v"(V[2 * ks]) : "v"(vba), "i"((d0_) * 4096 + ks * 1024)); \
                asm volatile("ds_read_b64_tr_b16 %0, %1 offset:%c2" : "=v"(V[2 * ks + 1]) : "v"(vba), "i"((d0_) * 4096 + ks * 1024 + 512)); } } while (0)
#define AT_VF(V, ks) ((bf16x8){V[2 * (ks)][0], V[2 * (ks)][1], V[2 * (ks)][2], V[2 * (ks)][3], V[2 * (ks) + 1][0], V[2 * (ks) + 1][1], V[2 * (ks) + 1][2], V[2 * (ks) + 1][3]})
#define AT_WAITL(n, V) do { asm volatile("s_waitcnt lgkmcnt(" #n ")" : "+v"(V[0]), "+v"(V[1]), "+v"(V[2]), "+v"(V[3]), "+v"(V[4]), "+v"(V[5]), "+v"(V[6]), "+v"(V[7])); __builtin_amdgcn_sched_barrier(0); } while (0)
#define AT_PV(V, d0_) do { __builtin_amdgcn_s_setprio(1); o[d0_] = MFMA32(pa0, AT_VF(V, 0), o[d0_]); o[d0_] = MFMA32(pa1, AT_VF(V, 1), o[d0_]); o[d0_] = MFMA32(pa2, AT_VF(V, 2), o[d0_]); o[d0_] = MFMA32(pa3, AT_VF(V, 3), o[d0_]); __builtin_amdgcn_s_setprio(0); } while (0)
            if (VAR != 1) {
            asm volatile("s_waitcnt lgkmcnt(0)" ::: "memory"); __builtin_amdgcn_sched_barrier(0);
            AT_VLD(va_, 0); AT_VLD(vb_, 1);
            AT_WAITL(8, va_); AT_PV(va_, 0); __builtin_amdgcn_sched_barrier(0); AT_VLD(va_, 2);
            AT_WAITL(8, vb_); AT_PV(vb_, 1); __builtin_amdgcn_sched_barrier(0); AT_VLD(vb_, 3);
            AT_WAITL(8, va_); AT_PV(va_, 2); __builtin_amdgcn_sched_barrier(0);
            AT_WAITL(0, vb_); AT_PV(vb_, 3);
            } else { o[0][0] += (float)pa0[0] + (float)pa1[1] + (float)pa2[2] + (float)pa3[3]; }
#undef AT_VF
#undef AT_WAITL
#undef AT_VLD
#undef AT_PV
        }
        if (t + 2 < ntiles) asm volatile("s_waitcnt vmcnt(4)" ::: "memory"); else asm volatile("s_waitcnt vmcnt(0)" ::: "memory");
        BAR_LDS();
    }
    if (VAR != 0) { if (o[0][0] + o[1][1] + o[2][2] + o[3][3] + l_run == 123.456f) ((float*)(P.ws + WS_DUMP))[tid] = 1.f; __syncthreads(); return; }
    l_run = swap32_add(l_run);
    const float sc = (map ? lam : 1.0f) / l_run;
    if (hi == 0) wsf[r32] = sc;
    LDS_WAIT();
#pragma unroll
    for (int r = 0; r < 16; ++r) { const float a = wsf[crow(r, hi)];
#pragma unroll
        for (int d0 = 0; d0 < 4; ++d0) o[d0][r] *= a; }
    LAS float* xb = (LAS float*)(lds + AT_XBUF + qsub * 16384);
    if (map) {
#pragma unroll
        for (int d0 = 0; d0 < 4; ++d0)
#pragma unroll
            for (int r = 0; r < 16; ++r) xb[(d0 * 16 + r) * 64 + lane] = o[d0][r];
    }
    __syncthreads();
    if (!map) {
        const float* dn = P.in[8];
        bf16_t* MIX = (bf16_t*)(P.ws + WS_MIX);
        float ss[16];
#pragma unroll
        for (int r = 0; r < 16; ++r) { ss[r] = 0.f;
#pragma unroll
            for (int d0 = 0; d0 < 4; ++d0) { o[d0][r] -= xb[(d0 * 16 + r) * 64 + lane]; ss[r] += o[d0][r] * o[d0][r]; } }
#pragma unroll
        for (int r = 0; r < 16; ++r) {
            ss[r] = half_sum32(ss[r]);
            ss[r] = 0.8f / sqrtf(ss[r] * (1.0f / 128.0f) + EPS);
        }
        float dg[4];
#pragma unroll
        for (int d0 = 0; d0 < 4; ++d0) dg[d0] = dn[32 * d0 + r32];
#pragma unroll
        for (int r = 0; r < 16; ++r) {
            bf16_t* orow = MIX + (size_t)(b * SEQ + qi * 128 + qsub * 32 + crow(r, hi)) * 1024 + h * 128 + r32;
#pragma unroll
            for (int d0 = 0; d0 < 4; ++d0) orow[32 * d0] = (bf16_t)f2bf(o[d0][r] * ss[r] * dg[d0]);
        }
    }
    __syncthreads();
#undef AT_DMA
}

template <int VAR> DI void attn_phase(const Params& P, LAS unsigned char* lds, int tid, int wave, int lane) {
    unsigned* ctl = (unsigned*)(P.ws + WS_CTL);
    const float* lq1 = P.in[4]; const float* lk1 = P.in[5]; const float* lq2 = P.in[6]; const float* lk2 = P.in[7];
    const float lam = __expf(wave_sum(lq1[lane] * lk1[lane])) - __expf(wave_sum(lq2[lane] * lk2[lane])) + 0.2f;
    LAS volatile int* ub = (LAS volatile int*)(lds + AT_UNIT);
    const unsigned x0 = xb_xcc_id() & 7u;
    for (;;) {
        if (tid == 0) {
            int u = -1;
            for (unsigned j = 0; j < 8u && u < 0; ++j) { const unsigned x = (x0 + j) & 7u;
                if (__hip_atomic_load(ctl + CW_ATTQ + 64 * x, __ATOMIC_RELAXED, __HIP_MEMORY_SCOPE_AGENT) >= 64u) continue;
                const unsigned i = __hip_atomic_fetch_add(ctl + CW_ATTQ + 64 * x, 1u, __ATOMIC_RELAXED, __HIP_MEMORY_SCOPE_AGENT);
                if (i < 64u) u = (int)(x * 64u + i); }
            *ub = u;
        }
        __syncthreads();
        const int u = *ub;
        __syncthreads();
        if (u < 0) break;
        attn_unit<VAR>(P, lds, u >> 6, 63 - (u & 63), tid, wave, lane, lam);
    }
}

struct EpiOutProj {
    static constexpr bool PERM = false, AFTER_DRAIN = false;
    const float* x; float* out; bf16_t* u2;
    DI void operator()(const pg8::f32x4 (&acc)[2][2][4][2], const pg8::Unit& u, int wr, int wc, int fr, int fq) const {
        const int row0 = u.pm * 256 + wr * 64 + fr, col0 = u.pn * 256 + wc * 32 + 4 * fq;
#pragma unroll
        for (int ai = 0; ai < 2; ++ai) {
            f32x4 xv[4][2][2];
#pragma unroll
            for (int m = 0; m < 4; ++m) { const size_t off = (size_t)(row0 + ai * 128 + m * 16) * 1024 + col0;
#pragma unroll
                for (int bj = 0; bj < 2; ++bj)
#pragma unroll
                    for (int n = 0; n < 2; ++n) xv[m][bj][n] = *(const f32x4*)(x + off + bj * 128 + n * 16); }
#pragma unroll
            for (int m = 0; m < 4; ++m) { const size_t off = (size_t)(row0 + ai * 128 + m * 16) * 1024 + col0;
#pragma unroll
                for (int bj = 0; bj < 2; ++bj)
#pragma unroll
                    for (int n = 0; n < 2; ++n) { const f32x4 hv = acc[ai][bj][m][n] + xv[m][bj][n]; *(f32x4*)(out + off + bj * 128 + n * 16) = hv;
                        *(u32x2*)(u2 + off + bj * 128 + n * 16) = (u32x2){pk2(hv[0], hv[1]), pk2(hv[2], hv[3])}; } }
        }
    }
};

typedef float f32x4v __attribute__((ext_vector_type(4)));
#ifdef ROUTE_PROBE
#define ROUTE_MID_HOOK() do { XcdBarrier xb2; xb2.bar = (unsigned*)(P.ws + WS_CTL) + CW_BAR; xb2.x = xb_xcc_id(); xb2.st = (volatile LAS unsigned*)(ldsb + LDS_BYTES - 64); xcd_barrier(xb2); \
    if (blockIdx.x == 0 && threadIdx.x == 0) __hip_atomic_store((unsigned long long*)(P.ws + WS_CTL + 65536) + 20, (unsigned long long)__builtin_amdgcn_s_memrealtime(), __ATOMIC_RELAXED, __HIP_MEMORY_SCOPE_AGENT); } while (0)
#else
#define ROUTE_MID_HOOK() do {} while (0)
#endif
DI void route_tile(const Params& P, int tile, int par, LAS float* sc  , int lane, LAS unsigned char* ldsb) {
    const float* h2 = P.out; const float* WR = (const float*)(P.ws + WS_WR);
    const int r16 = lane & 15, kq = lane >> 4;
    const float* arow = h2 + (size_t)(tile * 16 + r16) * 1024 + par * 512 + kq * 8;
    const float* b0 = WR + (size_t)r16 * 1024 + par * 512 + kq * 8; const float* b1 = b0 + 16 * 1024; const float* b2 = WR + (size_t)(32 + (r16 & 3)) * 1024 + par * 512 + kq * 8;
    const float z2 = (r16 < 4) ? 1.0f : 0.0f;
    f32x4v c0 = {}, c1 = {}, c2 = {};
    float ss = 0.f;
    f32x4 bA[4][4], bB[4][4];
#define RT_LOAD(B, tb) do { _Pragma("unroll") for (int j = 0; j < 4; ++j) { const int o_ = 32 * ((tb) + (j >> 1)) + 4 * (j & 1); \
        B[j][0] = *(const f32x4*)(arow + o_); B[j][1] = *(const f32x4*)(b0 + o_); B[j][2] = *(const f32x4*)(b1 + o_); B[j][3] = *(const f32x4*)(b2 + o_); } } while (0)
#define RT_COMP(B) do { _Pragma("unroll") for (int j = 0; j < 4; ++j) { const f32x4 a = B[j][0]; ss += (a.x * a.x + a.y * a.y) + (a.z * a.z + a.w * a.w); \
        _Pragma("unroll") for (int i = 0; i < 4; ++i) { c0 = __builtin_amdgcn_mfma_f32_16x16x4f32(a[i], B[j][1][i], c0, 0, 0, 0); \
            c1 = __builtin_amdgcn_mfma_f32_16x16x4f32(a[i], B[j][2][i], c1, 0, 0, 0); c2 = __builtin_amdgcn_mfma_f32_16x16x4f32(a[i], B[j][3][i] * z2, c2, 0, 0, 0); } } } while (0)
    RT_LOAD(bA, 0);
#pragma unroll
    for (int tb = 0; tb < 16; tb += 4) {
        RT_LOAD(bB, tb + 2); __builtin_amdgcn_sched_barrier(0); RT_COMP(bA); __builtin_amdgcn_sched_barrier(0);
        if (tb + 4 < 16) { RT_LOAD(bA, tb + 4); } __builtin_amdgcn_sched_barrier(0); RT_COMP(bB); __builtin_amdgcn_sched_barrier(0); }
#undef RT_LOAD
#undef RT_COMP
    ss += swz_xor16(ss); ss = swap32_add(ss);
    LAS float* my = sc + par * 800;
#pragma unroll
    for (int r = 0; r < 4; ++r) { const int row = 4 * kq + r; my[row * 48 + r16] = c0[r]; my[row * 48 + 16 + r16] = c1[r]; my[row * 48 + 32 + r16] = c2[r]; }
    if (lane < 16) my[768 + lane] = ss;
    LAS int* lcnt = (LAS int*)(ldsb + 4 * 32768 + 1024);
    if (threadIdx.x < 32) lcnt[threadIdx.x] = 0;
    int pa = 0, pb = 0, ea_ = 0, eb_ = 0; float w1_ = 0.f, w2_ = 0.f, rs_ = 0.f;
    LDS_WAIT();
    __syncthreads();
    ROUTE_MID_HOOK();
    if (par == 0 && lane < 16) {
        LAS const float* l0 = sc + lane * 48; LAS const float* l1 = sc + 800 + lane * 48;
        const float rs = __builtin_amdgcn_rsqf((sc[768 + lane] + sc[800 + 768 + lane]) * (1.0f / 1024.0f) + EPS);
#define LG(j) (l0[j] + l1[j])
        const int t = tile * 16 + lane;
        const float* bg = P.in[16]; const float* br = P.in[18];
        float gl[4]; int gs = 0; float gm;
#pragma unroll
        for (int j = 0; j < 4; ++j) gl[j] = LG(j) * rs + bg[j];
        gm = gl[0];
#pragma unroll
        for (int j = 1; j < 4; ++j) if (gl[j] > gm) { gm = gl[j]; gs = j; }
        float gsum = 0.f;
#pragma unroll
        for (int j = 0; j < 4; ++j) gsum += __expf(gl[j] - gm);
        const float psel = 1.0f / gsum;
        float e1 = -INFINITY, e2 = -INFINITY; int i1 = 0, i2 = 0;
#pragma unroll
        for (int j = 0; j < 8; ++j) {
            const float v = LG(4 + gs * 8 + j) * rs + br[gs * 8 + j];
            if (v > e1) { e2 = e1; i2 = i1; e1 = v; i1 = j; } else if (v > e2) { e2 = v; i2 = j; }
        }
        const float x2 = __expf(e2 - e1), w1 = psel / (1.0f + x2), w2 = psel * x2 / (1.0f + x2);
        const int ea = gs * 8 + i1, eb = gs * 8 + i2;
        pa = (int)__hip_atomic_fetch_add(lcnt + ea, 1, __ATOMIC_RELAXED, __HIP_MEMORY_SCOPE_WORKGROUP); pb = (int)__hip_atomic_fetch_add(lcnt + eb, 1, __ATOMIC_RELAXED, __HIP_MEMORY_SCOPE_WORKGROUP);
        ea_ = ea; eb_ = eb; w1_ = w1; w2_ = w2; rs_ = rs;
        ((int*)(P.ws + WS_TOKE))[2 * t] = ea; ((int*)(P.ws + WS_TOKE))[2 * t + 1] = eb;
        ((float*)(P.ws + WS_TOKW))[2 * t] = w1; ((float*)(P.ws + WS_TOKW))[2 * t + 1] = w2;
        ((float*)(P.ws + WS_RS2))[t] = rs;
#undef LG
    }
    LDS_WAIT();
    __syncthreads();
    if (threadIdx.x < 32) { const int c = lcnt[threadIdx.x];
        lcnt[32 + threadIdx.x] = c ? (int)atomicAdd((unsigned*)(P.ws + WS_CTL) + CW_CNT + 64 * threadIdx.x, (unsigned)c) : 0; }
    LDS_WAIT();
    __syncthreads();
    if (par == 0 && lane < 16) { const int t = tile * 16 + lane;
        const int qa = lcnt[32 + ea_] + pa, qb = lcnt[32 + eb_] + pb;
        ((int*)(P.ws + WS_TOKP))[2 * t] = qa; ((int*)(P.ws + WS_TOKP))[2 * t + 1] = qb;
        ((int*)(P.ws + WS_LIST))[ea_ * 16384 + qa] = t; ((int*)(P.ws + WS_LIST))[eb_ * 16384 + qb] = t;
        ((float*)(P.ws + WS_LISTW))[ea_ * 16384 + qa] = w1_; ((float*)(P.ws + WS_LISTW))[eb_ * 16384 + qb] = w2_;
        ((float*)(P.ws + WS_LISTRS))[ea_ * 16384 + qa] = rs_; ((float*)(P.ws + WS_LISTRS))[eb_ * 16384 + qb] = rs_; }
    LDS_WAIT();
    __syncthreads();
}

#ifndef P4A_REP
#define P4A_REP 0
#endif
template <int P4A_PART> DI void phase4a(const Params& P, LAS unsigned char* lds, int gw, int NGW, int wave, int lane) {
    LAS float* scr = (LAS float*)(lds + wave * 16384);
    if (P4A_PART & 1) for (int tile = (gw >> 1); tile < MTOK / 16; tile += (NGW >> 1)) route_tile(P, tile, wave & 1, (LAS float*)(lds + (wave >> 1) * 32768), lane, lds);
    if (!(P4A_PART & 2)) return;
    bf16_t* WGU = (bf16_t*)(P.ws + WS_WGU); bf16_t* WD = (bf16_t*)(P.ws + WS_WD);
    const float* wg = P.in[19]; const float* wu = P.in[20]; const float* wd = P.in[21]; const float* gf = P.in[14];
    constexpr int I_GU = 16 * 16, I_D = 4 * 32, NIT = 32 * (I_GU + I_D);
    struct TItem { const float* src; const float* gn; bf16_t* dst; int stride, ldk; };
    auto mk = [&](int it) { TItem d; const int e = it / (I_GU + I_D), r = it % (I_GU + I_D);
        if (r < I_GU) { const int n0 = (r & 15) * 32, j = n0 >> 8, up = (n0 >> 7) & 1, k0 = (r >> 4) * 64;
            d.src = (up ? wu : wg) + (size_t)e * 1024 * 256 + (size_t)k0 * 256 + 128 * j + (n0 & 127); d.gn = gf + k0; d.stride = 256; d.ldk = 1024;
            d.dst = WGU + (size_t)e * 512 * 1024 + (size_t)n0 * 1024 + k0; }
        else { const int r2 = r - I_GU, k0 = (r2 >> 5) * 64, n0 = (r2 & 31) * 32;
            d.src = wd + (size_t)e * 256 * 1024 + (size_t)k0 * 1024 + n0; d.gn = nullptr; d.stride = 1024; d.ldk = 256;
            d.dst = WD + (size_t)e * 1024 * 256 + (size_t)n0 * 256 + k0; }
        return d; };
#define TI_LOAD(D, V) do { _Pragma("unroll") for (int i = 0; i < 32; ++i) { const int kk = 2 * i + (lane >> 5); \
        V[i] = D.src[(size_t)kk * D.stride + (lane & 31)] * (D.gn ? D.gn[kk] : 1.0f); } } while (0)
#define TI_FIN(D, V) do { _Pragma("unroll") for (int i = 0; i < 32; ++i) scr[(2 * i + (lane >> 5)) * 33 + (lane & 31)] = V[i]; \
        LDS_WAIT(); const int c_ = lane & 7; \
        _Pragma("unroll") for (int j = 0; j < 4; ++j) { const int n_ = (lane >> 3) + 8 * j; const LAS float* s_ = scr + (8 * c_) * 33 + n_; \
            u32x4 o_; o_.x = pk2(s_[0 * 33], s_[1 * 33]); o_.y = pk2(s_[2 * 33], s_[3 * 33]); o_.z = pk2(s_[4 * 33], s_[5 * 33]); o_.w = pk2(s_[6 * 33], s_[7 * 33]); \
            *(u32x4*)(D.dst + (size_t)n_ * D.ldk + 8 * c_) = o_; } \
        LDS_WAIT(); } while (0)
    for (int rp_ = 0; rp_ < (P4A_REP ? 2 : 1); ++rp_) {
        float va[32], vb[32];
        int it = gw;
        if (it < NIT) { TItem da = mk(it); TI_LOAD(da, va);
            for (;;) {
                const int itb = it + NGW; TItem db = da; const bool hb = itb < NIT;
                if (hb) { db = mk(itb); TI_LOAD(db, vb); }
                TI_FIN(da, va);
                if (!hb) break;
                it = itb + NGW; const bool ha = it < NIT;
                if (ha) { da = mk(it); TI_LOAD(da, va); }
                TI_FIN(db, vb);
                if (!ha) break;
            }
        }
    }
#undef TI_LOAD
#undef TI_FIN
}

DI void expert_layout(const Params& P, int lane, int& cnt, int& base, int& tend) {
    const unsigned* c = (const unsigned*)(P.ws + WS_CTL) + CW_CNT;
    cnt = (lane < 32) ? (int)__hip_atomic_load(c + 64 * lane, __ATOMIC_RELAXED, __HIP_MEMORY_SCOPE_AGENT) : 0;
    const int tiles = (cnt + 255) >> 8;
    int inc = 0;
#pragma unroll
    for (int i = 0; i < 32; ++i) { const int ti = __builtin_amdgcn_readlane(tiles, i); inc += (i <= lane) ? ti : 0; }
    tend = inc; base = (inc - tiles) << 8;
}

DI void phase4b(const Params& P, int gw, int NGW, int lane) {
    int cnt, base, tend; expert_layout(P, lane, cnt, base, tend);
    bf16_t* XS = (bf16_t*)(P.ws + WS_XS); float* SLOTW = (float*)(P.ws + WS_SLOTW);
    const int* TOKE = (const int*)(P.ws + WS_TOKE); const float* TOKW = (const float*)(P.ws + WS_TOKW); int* TOKP = (int*)(P.ws + WS_TOKP); const float* RS2 = (const float*)(P.ws + WS_RS2);
    for (int t = gw; t < MTOK; t += NGW) {
        const f32x4* hr = (const f32x4*)(P.out + (size_t)t * 1024);
        const float rs = RS2[t];
        u32x2 w[4];
#pragma unroll
        for (int j = 0; j < 4; ++j) { const f32x4 v = hr[64 * j + lane]; w[j] = (u32x2){pk2(v.x * rs, v.y * rs), pk2(v.z * rs, v.w * rs)}; }
#pragma unroll
        for (int k = 0; k < 2; ++k) {
            const int e = __builtin_amdgcn_readfirstlane(TOKE[2 * t + k]), slot = __builtin_amdgcn_readlane(base, e) + TOKP[2 * t + k];
            u32x2* orow = (u32x2*)(XS + (size_t)slot * 1024);
#pragma unroll
            for (int j = 0; j < 4; ++j) orow[64 * j + lane] = w[j];
            if (lane == 0) { SLOTW[slot] = TOKW[2 * t + k]; TOKP[2 * t + k] = slot; }
        }
    }
    for (int e = 0; e < 32; ++e) {
        const int ce = __builtin_amdgcn_readlane(cnt, e), be = __builtin_amdgcn_readlane(base, e), end = be + (((ce + 255) >> 8) << 8);
        for (int r = be + ce + gw; r < end; r += NGW) { u32x2* orow = (u32x2*)(XS + (size_t)r * 1024);
#pragma unroll
            for (int j = 0; j < 4; ++j) orow[64 * j + lane] = (u32x2){0u, 0u};
            if (lane == 0) SLOTW[r] = 0.f; }
    }
}

struct GroupedOrder {
    int tend; int total; int G, c, NS; int cnt, base; const int* LIST;
    DI unsigned rowoff(const pg8::Unit& u, int r) const {
        const int e = __builtin_amdgcn_readfirstlane(u.pn >> NS), ce = __builtin_amdgcn_readlane(cnt, e), t0 = __builtin_amdgcn_readlane(base, e) >> 8;
        const int pos = (u.pm - t0) * 256 + r;
        const int tok = pos < ce ? LIST[e * 16384 + pos] : 0;
        return (unsigned)tok * 2048u;
    }
    DI bool next(int i, pg8::Unit& u) const {
        const int L = i * G + c; if (L >= (total << NS)) return false;
        const int mt = L >> NS, j = L & ((1 << NS) - 1);
        const int e = __builtin_popcountll(__ballot(((int)(threadIdx.x & 63) < 32) && tend <= mt));
        u.pm = mt; u.pn = (e << NS) + j; return true;
    }
    DI void a_ready(const pg8::Unit&) const {}
    DI void done(const pg8::Unit&) const {}
};
struct EpiGateUp {
    static constexpr bool PERM = true, AFTER_DRAIN = false;
    const float* LISTW; const float* LISTRS; bf16_t* YS; int cnt, base;
    DI void operator()(const pg8::f32x4 (&acc)[2][2][4][2], const pg8::Unit& u, int wr, int wc, int fr, int fq) const {
        const int f0 = (u.pn & 1) * 128 + wc * 32 + fq * 8;
        const int e = __builtin_amdgcn_readfirstlane(u.pn >> 1), ce = __builtin_amdgcn_readlane(cnt, e), t0 = __builtin_amdgcn_readlane(base, e) >> 8;
#pragma unroll
        for (int ai = 0; ai < 2; ++ai)
#pragma unroll
            for (int m = 0; m < 4; ++m) {
                const int r = ai * 128 + wr * 64 + m * 16 + fr, row = u.pm * 256 + r, pos = (u.pm - t0) * 256 + r;
                const bool ok = pos < ce;
                const float cw = ok ? LISTW[e * 16384 + pos] : 0.f, rs = ok ? LISTRS[e * 16384 + pos] : 0.f, cr = cw * rs;
                float a[8];
#pragma unroll
                for (int i = 0; i < 4; ++i) {
                    const float g0 = acc[ai][0][m][0][i] * rs, g1 = acc[ai][0][m][1][i] * rs;
                    a[i] = g0 * __builtin_amdgcn_rcpf(1.0f + __expf(-g0)) * acc[ai][1][m][0][i] * cr; a[4 + i] = g1 * __builtin_amdgcn_rcpf(1.0f + __expf(-g1)) * acc[ai][1][m][1][i] * cr;
                }
                *(u32x4*)(YS + (size_t)row * 256 + f0) = (u32x4){pk2(a[0], a[1]), pk2(a[2], a[3]), pk2(a[4], a[5]), pk2(a[6], a[7])};
            }
    }
};
struct EpiDown {
    static constexpr bool PERM = true, AFTER_DRAIN = false;
    bf16_t* YO;
    DI void operator()(const pg8::f32x4 (&acc)[2][2][4][2], const pg8::Unit& u, int wr, int wc, int fr, int fq) const {
        const int c0 = (u.pn & 3) * 256 + wc * 32 + fq * 8;
#pragma unroll
        for (int ai = 0; ai < 2; ++ai)
#pragma unroll
            for (int m = 0; m < 4; ++m) {
                bf16_t* rowp = YO + (size_t)(u.pm * 256 + ai * 128 + wr * 64 + m * 16 + fr) * 1024 + c0;
#pragma unroll
                for (int bj = 0; bj < 2; ++bj) { const pg8::f32x4 v0 = acc[ai][bj][m][0], v1 = acc[ai][bj][m][1];
                    *(u32x4*)(rowp + bj * 128) = (u32x4){pk2(v0[0], v0[1]), pk2(v0[2], v0[3]), pk2(v1[0], v1[1]), pk2(v1[2], v1[3])}; }
            }
    }
};

DI void phase7(const Params& P, int gw, int NGW, int lane) {
    int cnt_, base_, tend_; expert_layout(P, lane, cnt_, base_, tend_);
    const bf16_t* YO = (const bf16_t*)(P.ws + WS_YO); const int* TOKP = (const int*)(P.ws + WS_TOKP); const int* TOKE = (const int*)(P.ws + WS_TOKE); const f32x4* nf = (const f32x4*)P.in[22];
    f32x4 nfv[4];
#pragma unroll
    for (int j = 0; j < 4; ++j) nfv[j] = nf[64 * j + lane];
    for (int t0 = gw; t0 < MTOK; t0 += 2 * NGW) {
        f32x4 v[2][4]; u32x2 hv[2][4], ya[2][4], yb[2][4];
#pragma unroll
        for (int r = 0; r < 2; ++r) { const int t = (t0 + r * NGW) < MTOK ? (t0 + r * NGW) : t0;
            const u32x2* hr = (const u32x2*)((const bf16_t*)(P.ws + WS_U2) + (size_t)t * 1024);
            const int e0 = __builtin_amdgcn_readfirstlane(TOKE[2 * t]), e1 = __builtin_amdgcn_readfirstlane(TOKE[2 * t + 1]);
            const int s0 = __builtin_amdgcn_readlane(base_, e0) + TOKP[2 * t], s1 = __builtin_amdgcn_readlane(base_, e1) + TOKP[2 * t + 1];
            const u32x2* y0 = (const u32x2*)(YO + (size_t)s0 * 1024); const u32x2* y1 = (const u32x2*)(YO + (size_t)s1 * 1024);
#pragma unroll
            for (int j = 0; j < 4; ++j) { hv[r][j] = hr[64 * j + lane]; ya[r][j] = y0[64 * j + lane]; yb[r][j] = y1[64 * j + lane]; } }
#pragma unroll
        for (int r = 0; r < 2; ++r) { const int t = t0 + r * NGW;
            if (t < MTOK) {
                float s = 0.f;
#pragma unroll
                for (int j = 0; j < 4; ++j) { const u32x2 a = ya[r][j], c = yb[r][j], hq = hv[r][j];
                    v[r][j] = (f32x4){__uint_as_float(hq.x << 16), __uint_as_float(hq.x & 0xffff0000u), __uint_as_float(hq.y << 16), __uint_as_float(hq.y & 0xffff0000u)};
                    v[r][j].x += __uint_as_float(a.x << 16) + __uint_as_float(c.x << 16); v[r][j].y += __uint_as_float(a.x & 0xffff0000u) + __uint_as_float(c.x & 0xffff0000u);
                    v[r][j].z += __uint_as_float(a.y << 16) + __uint_as_float(c.y << 16); v[r][j].w += __uint_as_float(a.y & 0xffff0000u) + __uint_as_float(c.y & 0xffff0000u);
                    s += (v[r][j].x * v[r][j].x + v[r][j].y * v[r][j].y) + (v[r][j].z * v[r][j].z + v[r][j].w * v[r][j].w); }
                s = wave_sum(s);
                const float rs = __builtin_amdgcn_rsqf(s * (1.0f / 1024.0f) + EPS);
                f32x4* hw = (f32x4*)(P.out + (size_t)t * 1024);
#pragma unroll
                for (int j = 0; j < 4; ++j) hw[64 * j + lane] = v[r][j] * rs * nfv[j];
            } }
    }
}

struct EpiNull { static constexpr bool PERM = true, AFTER_DRAIN = false; float* d;
    DI void operator()(const pg8::f32x4 (&acc)[2][2][4][2], const pg8::Unit& u, int wr, int wc, int fr, int fq) const {
        pg8::f32x4 s = acc[0][0][0][0];
#pragma unroll
        for (int ai = 0; ai < 2; ++ai)
#pragma unroll
            for (int bj = 0; bj < 2; ++bj)
#pragma unroll
                for (int m = 0; m < 4; ++m)
#pragma unroll
                    for (int n = 0; n < 2; ++n) s += acc[ai][bj][m][n];
        if (s[0] == 12345.678f) d[threadIdx.x] = s[1] + s[2] + s[3]; } };
#ifndef PHMASK
#define PHMASK 2047
#endif
#ifndef P1_STAGGER_TICKS
#define P1_STAGGER_TICKS 0
#endif
#ifndef ATT_VAR
#define ATT_VAR 0
#endif
#ifndef REPMASK
#define REPMASK 0
#endif
#define REP(bit) for (int rep_ = 0; rep_ < ((REPMASK & (bit)) ? 2 : 1); ++rep_)
#define REPSYNC(bit) if ((REPMASK & (bit)) && rep_ == 0) GRID_BAR()
typedef const __attribute__((address_space(4))) Params* KParams;
DI Params load_params(KParams kp) { Params p;
#pragma unroll
    for (int i = 0; i < 23; ++i) p.in[i] = kp->in[i];
    p.out = kp->out; p.ws = kp->ws; return p; }
__global__ void __launch_bounds__(NTHREADS, 2) hymba_fwd(Params Pin) {
    extern __shared__ __attribute__((aligned(16))) unsigned char lds_raw[];
    LAS unsigned char* lds = (LAS unsigned char*)lds_raw;
    cg::grid_group grid = cg::this_grid();
    volatile LAS unsigned* bst = (volatile LAS unsigned*)(lds + LDS_BYTES - 64);
    if (threadIdx.x < 2) bst[threadIdx.x] = 0u;
    __syncthreads();
    const XcdBarrier xbar = xcd_barrier_post((unsigned*)(Pin.ws + WS_CTL) + CW_BAR, bst);
#ifndef TPROBE
#define TPROBE (-1)
#endif
#ifndef TPROBE_A
#define TPROBE_A TPROBE
#define TPROBE_B (TPROBE + 1)
#endif
    int nstamp_ = 0;
#define STAMP() do { if (TPROBE >= 0) { if (blockIdx.x == 0 && threadIdx.x == 0) __hip_atomic_store((unsigned long long*)(Pin.ws + WS_CTL + 65536) + nstamp_, (unsigned long long)__builtin_amdgcn_s_memrealtime(), __ATOMIC_RELAXED, __HIP_MEMORY_SCOPE_AGENT); ++nstamp_; } } while (0)
#define GRID_BAR() do { xcd_barrier(xbar); STAMP(); } while (0)
    STAMP();
    const int G = gridDim.x, blk = blockIdx.x, NGW = G * NWAVES, NGT = G * NTHREADS;
#define PHASE_IDS() KParams kp_ = (KParams)__builtin_amdgcn_kernarg_segment_ptr(); asm volatile("" : "+s"(kp_)); const Params P = load_params(kp_); int tid = threadIdx.x; asm volatile("" : "+v"(tid)); const int lane = tid & 63, wave = __builtin_amdgcn_readfirstlane(tid >> 6), gw = blk * NWAVES + wave, gtid = blk * NTHREADS + tid; (void)lane; (void)gw; (void)gtid; (void)wave

    REP(1) { if (PHMASK & 1) { PHASE_IDS(); phase0(P, lds, gw, NGW, gtid, NGT, wave, lane); } REPSYNC(1); }
    GRID_BAR();
    REP(2) { if (PHMASK & 2) { PHASE_IDS();
        pg8::Gemm g{(const bf16_t*)(P.ws + WS_XB), (const bf16_t*)(P.ws + WS_WINT), MROWS, NPROJ, 1024};
        if (P1_STAGGER_TICKS > 0 && (blk & 1)) { const unsigned long long s0_ = __builtin_amdgcn_s_memrealtime(); while (__builtin_amdgcn_s_memrealtime() - s0_ < (unsigned long long)P1_STAGGER_TICKS) __builtin_amdgcn_s_sleep(8); }
        pg8::StaticOrder S; S.init(MROWS, NPROJ, G, blk);
        EpiInProj E{(const float*)(P.ws + WS_RS1), (const float*)(P.ws + WS_COS), (const float*)(P.ws + WS_SIN), P.in[10], P.in[11],
                    (bf16_t*)(P.ws + WS_QB), (bf16_t*)(P.ws + WS_KT), (bf16_t*)(P.ws + WS_VT), (bf16_t*)(P.ws + WS_QKVB), (bf16_t*)(P.ws + WS_ZB), (float*)(P.ws + WS_GB)};
        if (rep_ == 0) pg8::gemm_phase<EpiInProj, pg8::StaticOrder, true, true>(lds, g, S, E);
        else { EpiNull EN{(float*)(P.ws + WS_DUMP)}; pg8::gemm_phase<EpiNull, pg8::StaticOrder, true, true>(lds, g, S, EN); }
    } REPSYNC(2); }
    GRID_BAR();
    REP(4) { if (PHMASK & 4) { PHASE_IDS(); gdn_prep_phase(P, lds, blk, G, wave, lane); } REPSYNC(4); }
    {
        unsigned* prep = (unsigned*)(Pin.ws + WS_CTL) + CW_PREP;
        asm volatile("s_waitcnt vmcnt(0)" ::: "memory");
        __syncthreads();
        if (threadIdx.x == 0) { __builtin_amdgcn_fence(__ATOMIC_RELEASE, "agent"); asm volatile("s_waitcnt vmcnt(0)" ::: "memory");
            __hip_atomic_fetch_add(prep, 1u, __ATOMIC_RELAXED, __HIP_MEMORY_SCOPE_AGENT); }
        if (blk < 16) {
            if (threadIdx.x == 0) { unsigned sp = 0;
                while (__hip_atomic_load(prep, __ATOMIC_RELAXED, __HIP_MEMORY_SCOPE_AGENT) < (unsigned)G) { __builtin_amdgcn_s_sleep(2); if (++sp > (1u << 22)) break; }
                __builtin_amdgcn_fence(__ATOMIC_ACQUIRE, "agent"); asm volatile("s_waitcnt vmcnt(0)" ::: "memory"); }
            __syncthreads();
        }
    }
    REP(8) { if ((PHMASK & 8) && blk < 16) { PHASE_IDS(); gdn_scan(P, lds, blk, tid, wave, lane); } }
    REP(16) {
    if (PHMASK & 16) { PHASE_IDS(); if (rep_ == 0) attn_phase<0>(P, lds, tid, wave, lane); else attn_phase<ATT_VAR>(P, lds, tid, wave, lane); }
    if ((REPMASK & 16) && rep_ == 0) { GRID_BAR(); if (blk == 0 && threadIdx.x < 8) { PHASE_IDS(); __hip_atomic_store((unsigned*)(P.ws + WS_CTL) + CW_ATTQ + 64 * threadIdx.x, 0u, __ATOMIC_RELAXED, __HIP_MEMORY_SCOPE_AGENT); } GRID_BAR(); }
    }
    GRID_BAR();
    REP(32) { if (PHMASK & 32) { PHASE_IDS();
        pg8::Gemm g{(const bf16_t*)(P.ws + WS_MIX), (const bf16_t*)(P.ws + WS_WOUT), MTOK, 1024, 1024};
        pg8::StaticOrder S; S.init(MTOK, 1024, G, blk);
        EpiOutProj E{P.in[0], P.out, (bf16_t*)(P.ws + WS_U2)};
        pg8::gemm_phase<EpiOutProj, pg8::StaticOrder, true, true>(lds, g, S, E);
    } REPSYNC(32); }
    GRID_BAR();
#ifdef P4A_SPLIT
    if (PHMASK & 64) { PHASE_IDS(); phase4a<1>(P, lds, gw, NGW, wave, lane); }
    GRID_BAR();
    if (PHMASK & 64) { PHASE_IDS(); phase4a<2>(P, lds, gw, NGW, wave, lane); }
#else
    if (PHMASK & 64) { PHASE_IDS(); phase4a<3>(P, lds, gw, NGW, wave, lane); }
#endif
    GRID_BAR();
    int cnt, base, tend, total; { PHASE_IDS(); expert_layout(P, lane, cnt, base, tend); total = __builtin_amdgcn_readlane(tend, 31); }
    REP(256) { if (PHMASK & 256) { PHASE_IDS();
        pg8::Gemm g{(const bf16_t*)(P.ws + WS_U2), (const bf16_t*)(P.ws + WS_WGU), XS_ROWS, 32 * 512, 1024};
        GroupedOrder S{tend, total, G, blk, 1, cnt, base, (const int*)(P.ws + WS_LIST)};
        EpiGateUp E{(const float*)(P.ws + WS_LISTW), (const float*)(P.ws + WS_LISTRS), (bf16_t*)(P.ws + WS_YS), cnt, base};
        pg8::gemm_phase_g<EpiGateUp, GroupedOrder, true, true>(lds, g, S, E);
    } REPSYNC(256); }
    GRID_BAR();
    REP(512) { if (PHMASK & 512) { PHASE_IDS();
        int kd = 256; asm volatile("" : "+s"(kd));
        pg8::Gemm g{(const bf16_t*)(P.ws + WS_YS), (const bf16_t*)(P.ws + WS_WD), XS_ROWS, 32 * 1024, kd};
        GroupedOrder S{tend, total, G, blk, 2, cnt, base, (const int*)(P.ws + WS_LIST)};
        EpiDown E{(bf16_t*)(P.ws + WS_YO)};
        pg8::gemm_phase<EpiDown, GroupedOrder, true, true>(lds, g, S, E);
    } REPSYNC(512); }
    GRID_BAR();
    if (PHMASK & 1024) { PHASE_IDS(); phase7(P, gw, NGW, lane); }
    if (TPROBE >= 0) {
        GRID_BAR();
        const unsigned long long* st = (const unsigned long long*)(Pin.ws + WS_CTL + 65536);
        const unsigned long long t0 = __hip_atomic_load(st + TPROBE_A, __ATOMIC_RELAXED, __HIP_MEMORY_SCOPE_AGENT), t1 = __hip_atomic_load(st + TPROBE_B, __ATOMIC_RELAXED, __HIP_MEMORY_SCOPE_AGENT);
        const unsigned long long dt = (t1 - t0) * 4ull, s0 = __builtin_amdgcn_s_memrealtime();
        while (__builtin_amdgcn_s_memrealtime() - s0 < dt) __builtin_amdgcn_s_sleep(8);
    }
}

extern "C" void kernel_launch(void* const* d_in, const int* in_sizes, int n_in, void* d_out, int out_size, void* d_ws, size_t ws_size, hipStream_t stream) {
    static int grid_blocks = 0;
    if (grid_blocks == 0) {
        if (n_in != 23 || out_size != MTOK * DMODEL || ws_size < WS_END) { fprintf(stderr, "kernel_launch: unexpected shapes (n_in %d out %d ws %zu)\n", n_in, out_size, ws_size); grid_blocks = -1; return; }
        int dev = 0, cus = 0, per_cu = 0;
        hipGetDevice(&dev);
        hipDeviceGetAttribute(&cus, hipDeviceAttributeMultiprocessorCount, dev);
        hipFuncSetAttribute((const void*)hymba_fwd, hipFuncAttributeMaxDynamicSharedMemorySize, LDS_BYTES);
        hipOccupancyMaxActiveBlocksPerMultiprocessor(&per_cu, (const void*)hymba_fwd, NTHREADS, LDS_BYTES);
        if (per_cu < 1) { fprintf(stderr, "kernel_launch: occupancy query says %d blocks/CU\n", per_cu); per_cu = 1; }
        grid_blocks = cus;
        (void)hipGetLastError();
    }
    if (grid_blocks < 0) return;
    hipMemsetAsync((char*)d_ws + WS_CTL, 0, CTL_BYTES, stream);
    Params p{};
    for (int i = 0; i < 23; ++i) p.in[i] = (const float*)d_in[i];
    p.out = (float*)d_out; p.ws = (unsigned char*)d_ws;
    void* args[] = {&p};
    hipError_t e = hipLaunchCooperativeKernel((const void*)hymba_fwd, dim3(grid_blocks), dim3(NTHREADS), args, LDS_BYTES, stream);
    if (e != hipSuccess) fprintf(stderr, "cooperative launch failed: %s (grid %d)\n", hipGetErrorString(e), grid_blocks);
}
```

```cpp
#include <hip/hip_runtime.h>
#include <hip/hip_cooperative_groups.h>
#include <cstdio>
#include <cstdint>
namespace cg = cooperative_groups;
#ifndef PG8_EPI_AGAIN
#define PG8_EPI_AGAIN(x) do {} while (0)
#endif
namespace pg8 {
#define PG8_LAS __attribute__((address_space(3)))
typedef unsigned short bf16_t;
typedef short bf16x8 __attribute__((ext_vector_type(8)));
typedef float f32x4 __attribute__((ext_vector_type(4)));
typedef unsigned u32x4 __attribute__((ext_vector_type(4)));
constexpr int BM = 256, BK = 64, HALF = 128, HTB = HALF * BK * 2  , STAGE_BYTES = 8 * HTB, NXCD = 8, WGM = 8;

__host__ __device__ __forceinline__ int lds_byte(int r, int c) { const int st = (r >> 4) * 2 + (c >> 5), rr = r & 15, cc = c & 31, ob = rr * 64 + cc * 2; return st * 1024 + (ob ^ (((ob >> 9) & 1) << 5)); }
__host__ __device__ __forceinline__ void stage_rc(int b, int& R, int& C) { const int st = b / 1024, sb = b % 1024, swz = sb ^ (((sb >> 9) & 1) << 5); R = (st >> 1) * 16 + swz / 64; C = (st & 1) * 32 + (swz % 64) / 2; }
__host__ __device__ __forceinline__ int perm32(int rho) { const int n = rho >> 4, i = rho & 15; return 8 * (i >> 2) + 4 * n + (i & 3); }

template <class T, class = void> struct epi_timed { static constexpr bool v = false; };
template <class T> struct epi_timed<T, decltype((void)T::TIMED)> { static constexpr bool v = true; };
#ifndef PG8_TBLK
#define PG8_TBLK 0
#define PG8_TTID 0
#endif
struct Unit { int pm, pn; };
struct Gemm { const bf16_t* A; const bf16_t* Bt; int M, N, K; };

struct StaticOrder {
    int nM, nN, nwg, G, c;
    __host__ __device__ void init(int M, int N, int G_, int c_) { nM = M / BM; nN = N / BM; nwg = nM * nN; G = G_; c = c_; }
    __host__ __device__ bool next(int i, Unit& u) const {
        const long L = (long)i * G + c; if (L >= nwg) return false;
        int wgid = (int)L; { const int q = nwg / NXCD, r = nwg % NXCD, xcd = wgid % NXCD, off = wgid / NXCD; wgid = (xcd < r ? xcd * (q + 1) : r * (q + 1) + (xcd - r) * q) + off; }
        const int nig = WGM * nN, gid = wgid / nig, fm = gid * WGM, gsz = (nM - fm) < WGM ? (nM - fm) : WGM;
        u.pm = fm + ((wgid % nig) % gsz); u.pn = (wgid % nig) / gsz; return true;
    }
    __device__ __forceinline__ void a_ready(const Unit&) const {}
    __device__ __forceinline__ void done(const Unit&) const {}
};

__device__ __forceinline__ unsigned cvt_pk_bf16(float lo, float hi) { unsigned r; asm volatile("v_cvt_pk_bf16_f32 %0, %1, %2" : "=v"(r) : "v"(lo), "v"(hi)); return r; }
typedef float f32x2 __attribute__((ext_vector_type(2)));
template <class Epi, class Sched, bool ALIGN_EPI = false, bool SP2 = false>
__device__ __forceinline__ void gemm_phase(PG8_LAS unsigned char* lds, const Gemm g, const Sched& S, const Epi& E) {
    int tid_o = threadIdx.x; asm volatile("" : "+v"(tid_o));
    const int tid = tid_o, wid = __builtin_amdgcn_readfirstlane(tid >> 6), lane = tid & 63, wr = wid >> 2, wc = wid & 3, fr = lane & 15, fq = lane >> 4;
    const int K = g.K, nt = K / BK;
    unsigned voffA[2], voffB[2];
#pragma unroll
    for (int i = 0; i < 2; ++i) { int R, C; stage_rc(tid * 16 + i * 8192, R, C); const int Rb = Epi::PERM ? ((R & ~31) + perm32(R & 31)) : R;
        voffA[i] = (unsigned)(R * K + C) * 2u; voffB[i] = (unsigned)(Rb * K + C) * 2u; }
    const size_t kstep = (size_t)(BK * 2);
    const size_t hstep = (size_t)HALF * K * 2;
    const size_t tstep = 2 * hstep;
    const unsigned ldsw = (unsigned)wid * 1024u;
    const int aoff = lds_byte(wr * 64 + fr, fq * 8), boff = lds_byte(wc * 32 + fr, fq * 8);
#define PG8_SA(b, h) (((b) * 2 + (h)) * HTB)
#define PG8_SB(b, h) ((4 + (b) * 2 + (h)) * HTB)
#define PG8_STAGE(bufoff, gbase, voff) do { _Pragma("unroll") for (int _i = 0; _i < 2; ++_i) \
        __builtin_amdgcn_global_load_lds((const unsigned*)((const char*)(gbase) + (voff)[_i]), (PG8_LAS unsigned*)(lds + (bufoff) + ldsw + _i * 8192), 16, 0, 0); } while (0)
#define PG8_LDA(dst, b, h) do { _Pragma("unroll") for (int m = 0; m < 4; ++m) _Pragma("unroll") for (int k = 0; k < 2; ++k) dst[m][k] = *(const PG8_LAS bf16x8*)(lds + PG8_SA(b, h) + aoff + m * 2048 + k * 1024); } while (0)
#define PG8_LDB(dst, b, h) do { _Pragma("unroll") for (int n = 0; n < 2; ++n) _Pragma("unroll") for (int k = 0; k < 2; ++k) dst[n][k] = *(const PG8_LAS bf16x8*)(lds + PG8_SB(b, h) + boff + n * 2048 + k * 1024); } while (0)
#define PG8_MMA(ai, bj, At, Bt) do { __builtin_amdgcn_s_setprio(1); _Pragma("unroll") for (int m = 0; m < 4; ++m) _Pragma("unroll") for (int n = 0; n < 2; ++n) _Pragma("unroll") for (int k = 0; k < 2; ++k) \
        acc[ai][bj][m][n] = __builtin_amdgcn_mfma_f32_16x16x32_bf16(Bt[n][k], At[m][k], acc[ai][bj][m][n], 0, 0, 0); __builtin_amdgcn_s_setprio(0); } while (0)
#define PG8_WAIT_V(n) asm volatile("s_waitcnt vmcnt(" #n ")" ::: "memory")
#define PG8_WAIT_L(n) asm volatile("s_waitcnt lgkmcnt(" #n ")" ::: "memory")
#define PG8_BAR __builtin_amdgcn_s_barrier()
#define PG8_SCHED __builtin_amdgcn_sched_barrier(0)
    Unit cur, nxt; int ui = 0;
    if (!S.next(0, cur)) return;
    f32x4 acc[2][2][4][2];
#pragma unroll
    for (int a = 0; a < 2; ++a)
#pragma unroll
        for (int b = 0; b < 2; ++b)
#pragma unroll
            for (int m = 0; m < 4; ++m)
#pragma unroll
                for (int n = 0; n < 2; ++n) acc[a][b][m][n] = (f32x4){0.f, 0.f, 0.f, 0.f};
    bf16x8 At[4][2], B0[2][2], B1[2][2];
    const char* cA = (const char*)g.A + (size_t)cur.pm * tstep; const char* cB = (const char*)g.Bt + (size_t)cur.pn * tstep;
    S.a_ready(cur);
    if constexpr (SP2) {
        PG8_STAGE(PG8_SB(0, 0), cB, voffB); PG8_STAGE(PG8_SB(0, 1), cB + hstep, voffB); PG8_STAGE(PG8_SA(0, 0), cA, voffA); PG8_STAGE(PG8_SA(0, 1), cA + hstep, voffA);
        if (wr == 1) PG8_BAR;
        PG8_WAIT_V(2); PG8_BAR;
        PG8_STAGE(PG8_SB(1, 0), cB + kstep, voffB); PG8_STAGE(PG8_SA(1, 0), cA + kstep, voffA); PG8_STAGE(PG8_SB(1, 1), cB + hstep + kstep, voffB);
        PG8_WAIT_V(6); PG8_BAR;
    } else {
        PG8_STAGE(PG8_SB(0, 0), cB, voffB); PG8_STAGE(PG8_SA(0, 0), cA, voffA); PG8_STAGE(PG8_SB(0, 1), cB + hstep, voffB); PG8_STAGE(PG8_SA(0, 1), cA + hstep, voffA);
        if (wr == 1) PG8_BAR;
        PG8_WAIT_V(4); PG8_BAR;
        PG8_STAGE(PG8_SB(1, 0), cB + kstep, voffB); PG8_STAGE(PG8_SA(1, 0), cA + kstep, voffA); PG8_STAGE(PG8_SB(1, 1), cB + hstep + kstep, voffB);
        PG8_WAIT_V(6); PG8_BAR;
    }
#ifdef PG8_TSEL
    unsigned long long tsum_ = 0;
#endif
    for (;;) {
        const bool has_next = S.next(ui + 1, nxt);
        const char* nA = has_next ? (const char*)g.A + (size_t)nxt.pm * tstep : cA; const char* nB = has_next ? (const char*)g.Bt + (size_t)nxt.pn * tstep : cB;
        for (int t = 0; t < nt; t += 2) {
            const bool last = (t == nt - 2);
            const char* a1 = cA + (size_t)(t + 1) * kstep;
            const char* a2 = last ? nA : cA + (size_t)(t + 2) * kstep; const char* b2 = last ? nB : cB + (size_t)(t + 2) * kstep;
            const char* a3 = a2 + kstep; const char* b3 = b2 + kstep;
            if (last && has_next) S.a_ready(nxt);
            if constexpr (SP2) {
            PG8_LDB(B0, 0, 0); PG8_LDB(B1, 0, 1); PG8_SCHED; PG8_LDA(At, 0, 0); PG8_STAGE(PG8_SA(1, 1), a1 + hstep, voffA);
            PG8_WAIT_V(8); PG8_WAIT_L(0); PG8_BAR; PG8_MMA(0, 0, At, B0); PG8_MMA(0, 1, At, B1); PG8_BAR; PG8_SCHED;
            PG8_LDA(At, 0, 1); PG8_STAGE(PG8_SB(0, 0), b2, voffB); PG8_STAGE(PG8_SB(0, 1), b2 + hstep, voffB); PG8_STAGE(PG8_SA(0, 0), a2, voffA);
            PG8_WAIT_V(8); PG8_WAIT_L(0); PG8_BAR; PG8_MMA(1, 0, At, B0); PG8_MMA(1, 1, At, B1); PG8_BAR; PG8_SCHED;
            PG8_LDB(B0, 1, 0); PG8_LDB(B1, 1, 1); PG8_SCHED; PG8_LDA(At, 1, 0); PG8_STAGE(PG8_SA(0, 1), a2 + hstep, voffA);
            PG8_WAIT_V(8); PG8_WAIT_L(0); PG8_BAR; PG8_MMA(0, 0, At, B0); PG8_MMA(0, 1, At, B1); PG8_BAR; PG8_SCHED;
            PG8_LDA(At, 1, 1); PG8_STAGE(PG8_SB(1, 0), b3, voffB); PG8_STAGE(PG8_SB(1, 1), b3 + hstep, voffB); PG8_STAGE(PG8_SA(1, 0), a3, voffA);
            PG8_WAIT_V(8); PG8_WAIT_L(0); PG8_BAR; PG8_MMA(1, 0, At, B0); PG8_MMA(1, 1, At, B1); PG8_BAR; PG8_SCHED;
            } else {
            PG8_LDB(B0, 0, 0); PG8_SCHED; PG8_LDA(At, 0, 0); PG8_STAGE(PG8_SA(1, 1), a1 + hstep, voffA);
            PG8_WAIT_L(8); PG8_BAR; PG8_WAIT_L(0); PG8_MMA(0, 0, At, B0); PG8_BAR; PG8_SCHED;
            PG8_LDB(B1, 0, 1); PG8_STAGE(PG8_SB(0, 0), b2, voffB);
            PG8_BAR; PG8_WAIT_L(0); PG8_MMA(0, 1, At, B1); PG8_BAR;
            PG8_LDA(At, 0, 1); PG8_STAGE(PG8_SA(0, 0), a2, voffA);
            PG8_BAR; PG8_WAIT_L(0); PG8_MMA(1, 0, At, B0); PG8_BAR; PG8_SCHED;
            PG8_STAGE(PG8_SB(0, 1), b2 + hstep, voffB);
            PG8_WAIT_V(6); PG8_BAR; PG8_MMA(1, 1, At, B1); PG8_BAR;
            PG8_LDB(B0, 1, 0); PG8_SCHED; PG8_LDA(At, 1, 0); PG8_STAGE(PG8_SA(0, 1), a2 + hstep, voffA);
            PG8_WAIT_L(8); PG8_BAR; PG8_WAIT_L(0); PG8_MMA(0, 0, At, B0); PG8_BAR; PG8_SCHED;
            PG8_LDB(B1, 1, 1); PG8_STAGE(PG8_SB(1, 0), b3, voffB);
            PG8_BAR; PG8_WAIT_L(0); PG8_MMA(0, 1, At, B1); PG8_BAR;
            PG8_LDA(At, 1, 1); PG8_STAGE(PG8_SA(1, 0), a3, voffA);
            PG8_BAR; PG8_WAIT_L(0); PG8_MMA(1, 0, At, B0); PG8_BAR; PG8_SCHED;
            PG8_STAGE(PG8_SB(1, 1), b3 + hstep, voffB);
            PG8_WAIT_V(6); PG8_BAR; PG8_MMA(1, 1, At, B1); PG8_BAR;
            }
        }
#ifdef PG8_TSEL
        unsigned long long tA_ = 0, tb2_ = 0;
        if constexpr (epi_timed<Epi>::v) tA_ = __builtin_amdgcn_s_memrealtime();
#endif
        if constexpr (ALIGN_EPI) { if (wr == 0) PG8_BAR; }
#ifdef PG8_TSEL
        if constexpr (epi_timed<Epi>::v) tb2_ = __builtin_amdgcn_s_memrealtime();
#endif
#ifdef PG8_TSEL
        unsigned long long tb_ = 0;
        if constexpr (epi_timed<Epi>::v) { if (PG8_TSEL == 2) tb_ = tA_; else tb_ = __builtin_amdgcn_s_memrealtime(); }
#endif
        if constexpr (!Epi::AFTER_DRAIN) { E(acc, cur, wr, wc, fr, fq); PG8_EPI_AGAIN(E(acc, cur, wr, wc, fr, fq)); S.done(cur); }
#ifdef PG8_TSEL
        if constexpr (epi_timed<Epi>::v) { if (PG8_TSEL == 1) asm volatile("s_waitcnt vmcnt(0)" ::: "memory");
            if (PG8_TSEL == 2) tsum_ += tb2_ - tb_; else tsum_ += __builtin_amdgcn_s_memrealtime() - tb_; }
#endif
        if (!has_next) break;
#pragma unroll
        for (int a = 0; a < 2; ++a)
#pragma unroll
            for (int b = 0; b < 2; ++b)
#pragma unroll
                for (int m = 0; m < 4; ++m)
#pragma unroll
                    for (int n = 0; n < 2; ++n) acc[a][b][m][n] = (f32x4){0.f, 0.f, 0.f, 0.f};
        cur = nxt; cA = nA; cB = nB; ++ui;
        if constexpr (ALIGN_EPI) { if (wr == 1) PG8_BAR; }
    }
    PG8_WAIT_V(0);
    if constexpr (!ALIGN_EPI) { if (wr == 0) PG8_BAR; }
    PG8_BAR;
    if constexpr (Epi::AFTER_DRAIN) { E.fused(acc, cur, wr, wc, fr, fq, lds, wid, lane); S.done(cur); }
#ifdef PG8_TSEL
    if constexpr (epi_timed<Epi>::v) { if (blockIdx.x == PG8_TBLK && tid == PG8_TTID) __hip_atomic_store(E.tslot, tsum_, __ATOMIC_RELAXED, __HIP_MEMORY_SCOPE_AGENT); }
#endif
#undef PG8_SA
#undef PG8_SB
#undef PG8_STAGE
#undef PG8_LDA
#undef PG8_LDB
#undef PG8_MMA
#undef PG8_WAIT_V
#undef PG8_WAIT_L
#undef PG8_BAR
#undef PG8_SCHED
}
static_assert(true, "gather variant of gemm_phase (SP2 = true only): identical schedule, the A operand's rows are gathered through Sched::rowoff");
template <class Epi, class Sched, bool ALIGN_EPI = false, bool SP2 = false>
__device__ __forceinline__ void gemm_phase_g(PG8_LAS unsigned char* lds, const Gemm g, const Sched& S, const Epi& E) {
    int tid_o = threadIdx.x; asm volatile("" : "+v"(tid_o));
    const int tid = tid_o, wid = __builtin_amdgcn_readfirstlane(tid >> 6), lane = tid & 63, wr = wid >> 2, wc = wid & 3, fr = lane & 15, fq = lane >> 4;
    const int K = g.K, nt = K / BK;
    unsigned voffA[2], voffB[2]; int RA_[2]; unsigned CA_[2];
#pragma unroll
    for (int i = 0; i < 2; ++i) { int R, C; stage_rc(tid * 16 + i * 8192, R, C); const int Rb = Epi::PERM ? ((R & ~31) + perm32(R & 31)) : R;
        voffA[i] = (unsigned)(R * K + C) * 2u; voffB[i] = (unsigned)(Rb * K + C) * 2u; RA_[i] = R; CA_[i] = (unsigned)C * 2u; }
    const size_t kstep = (size_t)(BK * 2);
    const size_t hstep = (size_t)HALF * K * 2;
    const size_t tstep = 2 * hstep;
    const unsigned ldsw = (unsigned)wid * 1024u;
    const int aoff = lds_byte(wr * 64 + fr, fq * 8), boff = lds_byte(wc * 32 + fr, fq * 8);
#define PG8_SA(b, h) (((b) * 2 + (h)) * HTB)
#define PG8_SB(b, h) ((4 + (b) * 2 + (h)) * HTB)
#define PG8_STAGE(bufoff, gbase, voff) do { _Pragma("unroll") for (int _i = 0; _i < 2; ++_i) \
        __builtin_amdgcn_global_load_lds((const unsigned*)((const char*)(gbase) + (voff)[_i]), (PG8_LAS unsigned*)(lds + (bufoff) + ldsw + _i * 8192), 16, 0, 0); } while (0)
#define PG8_LDA(dst, b, h) do { _Pragma("unroll") for (int m = 0; m < 4; ++m) _Pragma("unroll") for (int k = 0; k < 2; ++k) dst[m][k] = *(const PG8_LAS bf16x8*)(lds + PG8_SA(b, h) + aoff + m * 2048 + k * 1024); } while (0)
#define PG8_LDB(dst, b, h) do { _Pragma("unroll") for (int n = 0; n < 2; ++n) _Pragma("unroll") for (int k = 0; k < 2; ++k) dst[n][k] = *(const PG8_LAS bf16x8*)(lds + PG8_SB(b, h) + boff + n * 2048 + k * 1024); } while (0)
#define PG8_MMA(ai, bj, At, Bt) do { __builtin_amdgcn_s_setprio(1); _Pragma("unroll") for (int m = 0; m < 4; ++m) _Pragma("unroll") for (int n = 0; n < 2; ++n) _Pragma("unroll") for (int k = 0; k < 2; ++k) \
        acc[ai][bj][m][n] = __builtin_amdgcn_mfma_f32_16x16x32_bf16(Bt[n][k], At[m][k], acc[ai][bj][m][n], 0, 0, 0); __builtin_amdgcn_s_setprio(0); } while (0)
#define PG8_WAIT_V(n) asm volatile("s_waitcnt vmcnt(" #n ")" ::: "memory")
#define PG8_WAIT_L(n) asm volatile("s_waitcnt lgkmcnt(" #n ")" ::: "memory")
#define PG8_BAR __builtin_amdgcn_s_barrier()
#define PG8_SCHED __builtin_amdgcn_sched_barrier(0)
    Unit cur, nxt; int ui = 0;
    if (!S.next(0, cur)) return;
    f32x4 acc[2][2][4][2];
#pragma unroll
    for (int a = 0; a < 2; ++a)
#pragma unroll
        for (int b = 0; b < 2; ++b)
#pragma unroll
            for (int m = 0; m < 4; ++m)
#pragma unroll
                for (int n = 0; n < 2; ++n) acc[a][b][m][n] = (f32x4){0.f, 0.f, 0.f, 0.f};
    bf16x8 At[4][2], B0[2][2], B1[2][2];
    const char* cA = (const char*)g.A; const char* cB = (const char*)g.Bt + (size_t)cur.pn * tstep;
    unsigned cA0[2], cA1[2], nA0[2], nA1[2];
#pragma unroll
    for (int i = 0; i < 2; ++i) { cA0[i] = S.rowoff(cur, RA_[i]) + CA_[i]; cA1[i] = S.rowoff(cur, 128 + RA_[i]) + CA_[i]; }
    S.a_ready(cur);
    if constexpr (SP2) {
        PG8_STAGE(PG8_SB(0, 0), cB, voffB); PG8_STAGE(PG8_SB(0, 1), cB + hstep, voffB); PG8_STAGE(PG8_SA(0, 0), cA, cA0); PG8_STAGE(PG8_SA(0, 1), cA, cA1);
        if (wr == 1) PG8_BAR;
        PG8_WAIT_V(2); PG8_BAR;
        PG8_STAGE(PG8_SB(1, 0), cB + kstep, voffB); PG8_STAGE(PG8_SA(1, 0), cA + kstep, cA0); PG8_STAGE(PG8_SB(1, 1), cB + hstep + kstep, voffB);
        PG8_WAIT_V(6); PG8_BAR;
    } else {
        PG8_STAGE(PG8_SB(0, 0), cB, voffB); PG8_STAGE(PG8_SA(0, 0), cA, voffA); PG8_STAGE(PG8_SB(0, 1), cB + hstep, voffB); PG8_STAGE(PG8_SA(0, 1), cA + hstep, voffA);
        if (wr == 1) PG8_BAR;
        PG8_WAIT_V(4); PG8_BAR;
        PG8_STAGE(PG8_SB(1, 0), cB + kstep, voffB); PG8_STAGE(PG8_SA(1, 0), cA + kstep, voffA); PG8_STAGE(PG8_SB(1, 1), cB + hstep + kstep, voffB);
        PG8_WAIT_V(6); PG8_BAR;
    }
    for (;;) {
        const bool has_next = S.next(ui + 1, nxt);
        const char* nA = cA; const char* nB = has_next ? (const char*)g.Bt + (size_t)nxt.pn * tstep : cB;
#pragma unroll
        for (int i = 0; i < 2; ++i) { nA0[i] = has_next ? S.rowoff(nxt, RA_[i]) + CA_[i] : cA0[i]; nA1[i] = has_next ? S.rowoff(nxt, 128 + RA_[i]) + CA_[i] : cA1[i]; }
        for (int t = 0; t < nt; t += 2) {
            const bool last = (t == nt - 2);
            const char* a1 = cA + (size_t)(t + 1) * kstep;
            const char* a2 = last ? nA : cA + (size_t)(t + 2) * kstep; const char* b2 = last ? nB : cB + (size_t)(t + 2) * kstep;
            const char* a3 = a2 + kstep; const char* b3 = b2 + kstep;
            unsigned sA0[2], sA1[2];
#pragma unroll
            for (int i = 0; i < 2; ++i) { sA0[i] = last ? nA0[i] : cA0[i]; sA1[i] = last ? nA1[i] : cA1[i]; }
            if (last && has_next) S.a_ready(nxt);
            if constexpr (SP2) {
            PG8_LDB(B0, 0, 0); PG8_LDB(B1, 0, 1); PG8_SCHED; PG8_LDA(At, 0, 0); PG8_STAGE(PG8_SA(1, 1), a1, cA1);
            PG8_WAIT_V(8); PG8_WAIT_L(0); PG8_BAR; PG8_MMA(0, 0, At, B0); PG8_MMA(0, 1, At, B1); PG8_BAR; PG8_SCHED;
            PG8_LDA(At, 0, 1); PG8_STAGE(PG8_SB(0, 0), b2, voffB); PG8_STAGE(PG8_SB(0, 1), b2 + hstep, voffB); PG8_STAGE(PG8_SA(0, 0), a2, sA0);
            PG8_WAIT_V(8); PG8_WAIT_L(0); PG8_BAR; PG8_MMA(1, 0, At, B0); PG8_MMA(1, 1, At, B1); PG8_BAR; PG8_SCHED;
            PG8_LDB(B0, 1, 0); PG8_LDB(B1, 1, 1); PG8_SCHED; PG8_LDA(At, 1, 0); PG8_STAGE(PG8_SA(0, 1), a2, sA1);
            PG8_WAIT_V(8); PG8_WAIT_L(0); PG8_BAR; PG8_MMA(0, 0, At, B0); PG8_MMA(0, 1, At, B1); PG8_BAR; PG8_SCHED;
            PG8_LDA(At, 1, 1); PG8_STAGE(PG8_SB(1, 0), b3, voffB); PG8_STAGE(PG8_SB(1, 1), b3 + hstep, voffB); PG8_STAGE(PG8_SA(1, 0), a3, sA0);
            PG8_WAIT_V(8); PG8_WAIT_L(0); PG8_BAR; PG8_MMA(1, 0, At, B0); PG8_MMA(1, 1, At, B1); PG8_BAR; PG8_SCHED;
            } else {
            PG8_LDB(B0, 0, 0); PG8_SCHED; PG8_LDA(At, 0, 0); PG8_STAGE(PG8_SA(1, 1), a1 + hstep, voffA);
            PG8_WAIT_L(8); PG8_BAR; PG8_WAIT_L(0); PG8_MMA(0, 0, At, B0); PG8_BAR; PG8_SCHED;
            PG8_LDB(B1, 0, 1); PG8_STAGE(PG8_SB(0, 0), b2, voffB);
            PG8_BAR; PG8_WAIT_L(0); PG8_MMA(0, 1, At, B1); PG8_BAR;
            PG8_LDA(At, 0, 1); PG8_STAGE(PG8_SA(0, 0), a2, voffA);
            PG8_BAR; PG8_WAIT_L(0); PG8_MMA(1, 0, At, B0); PG8_BAR; PG8_SCHED;
            PG8_STAGE(PG8_SB(0, 1), b2 + hstep, voffB);
            PG8_WAIT_V(6); PG8_BAR; PG8_MMA(1, 1, At, B1); PG8_BAR;
            PG8_LDB(B0, 1, 0); PG8_SCHED; PG8_LDA(At, 1, 0); PG8_STAGE(PG8_SA(0, 1), a2 + hstep, voffA);
            PG8_WAIT_L(8); PG8_BAR; PG8_WAIT_L(0); PG8_MMA(0, 0, At, B0); PG8_BAR; PG8_SCHED;
            PG8_LDB(B1, 1, 1); PG8_STAGE(PG8_SB(1, 0), b3, voffB);
            PG8_BAR; PG8_WAIT_L(0); PG8_MMA(0, 1, At, B1); PG8_BAR;
            PG8_LDA(At, 1, 1); PG8_STAGE(PG8_SA(1, 0), a3, voffA);
            PG8_BAR; PG8_WAIT_L(0); PG8_MMA(1, 0, At, B0); PG8_BAR; PG8_SCHED;
            PG8_STAGE(PG8_SB(1, 1), b3 + hstep, voffB);
            PG8_WAIT_V(6); PG8_BAR; PG8_MMA(1, 1, At, B1); PG8_BAR;
            }
        }
        if constexpr (ALIGN_EPI) { if (wr == 0) PG8_BAR; }
        if constexpr (!Epi::AFTER_DRAIN) { E(acc, cur, wr, wc, fr, fq); PG8_EPI_AGAIN(E(acc, cur, wr, wc, fr, fq)); S.done(cur); }
        if (!has_next) break;
#pragma unroll
        for (int a = 0; a < 2; ++a)
#pragma unroll
            for (int b = 0; b < 2; ++b)
#pragma unroll
                for (int m = 0; m < 4; ++m)
#pragma unroll
                    for (int n = 0; n < 2; ++n) acc[a][b][m][n] = (f32x4){0.f, 0.f, 0.f, 0.f};
        cur = nxt; cA = nA; cB = nB; ++ui;
#pragma unroll
        for (int i = 0; i < 2; ++i) { cA0[i] = nA0[i]; cA1[i] = nA1[i]; }
        if constexpr (ALIGN_EPI) { if (wr == 1) PG8_BAR; }
    }
    PG8_WAIT_V(0);
    if constexpr (!ALIGN_EPI) { if (wr == 0) PG8_BAR; }
    PG8_BAR;
    if constexpr (Epi::AFTER_DRAIN) { E.fused(acc, cur, wr, wc, fr, fq, lds, wid, lane); S.done(cur); }
#undef PG8_SA
#undef PG8_SB
#undef PG8_STAGE
#undef PG8_LDA
#undef PG8_LDB
#undef PG8_MMA
#undef PG8_WAIT_V
#undef PG8_WAIT_L
#undef PG8_BAR
#undef PG8_SCHED
}
}

#define DI __device__ __forceinline__
#define LAS __attribute__((address_space(3)))
typedef unsigned short bf16_t;
typedef short bf16x8 __attribute__((ext_vector_type(8)));
typedef short s16x4 __attribute__((ext_vector_type(4)));
typedef short v4i16_t __attribute__((ext_vector_type(4)));
typedef float f32x4 __attribute__((ext_vector_type(4)));
typedef float f32x16 __attribute__((ext_vector_type(16)));
typedef unsigned u32x4 __attribute__((ext_vector_type(4)));
typedef unsigned u32x2 __attribute__((ext_vector_type(2)));
typedef float f32x2_t __attribute__((ext_vector_type(2)));
typedef __bf16 bf16x2_t __attribute__((ext_vector_type(2)));

constexpr int NWAVES = 8, NTHREADS = 512;
constexpr int SEQ = 8192, DMODEL = 1024, NMETA = 16, LTOK = SEQ + NMETA  , LP = 8256  , NCHUNK = 129;
constexpr int MTOK = 2 * SEQ;
constexpr int MROWS = 16640;
constexpr int NPROJ = 3840;
constexpr int NKT = 129;
constexpr float EPS = 1e-6f;
constexpr float C2Q = 0.125f * 1.4426950408889634f;
constexpr int XS_ROWS = 41216;

constexpr size_t MiB = 1u << 20;
constexpr size_t WS_CTL = 0, CTL_BYTES = 1 * MiB;
constexpr size_t WS_RS1 = 1 * MiB;
constexpr size_t WS_RS2 = WS_RS1 + 128 * 1024;
constexpr size_t WS_TOKE = WS_RS2 + 128 * 1024;
constexpr size_t WS_TOKW = WS_TOKE + 128 * 1024;
constexpr size_t WS_TOKP = WS_TOKW + 128 * 1024;
constexpr size_t WS_SLOTW = WS_TOKP + 128 * 1024;
constexpr size_t WS_WR = WS_SLOTW + 192 * 1024;
constexpr size_t WS_GL = WS_WR + 160 * 1024;
constexpr size_t WS_DUMP = 2 * MiB;
constexpr size_t WS_COS = 2 * MiB;
constexpr size_t WS_SIN = WS_COS + 1280 * 1024;
constexpr size_t WS_GB = WS_SIN + 1280 * 1024;
constexpr size_t WS_WOUT = 6 * MiB;
constexpr size_t WS_WINT = 8 * MiB;
constexpr size_t WS_XB = WS_WINT + (size_t)NPROJ * 1024 * 2;
constexpr size_t WS_MIX = 8 * MiB;
constexpr size_t WS_QKVB = 48 * MiB;
constexpr size_t WS_QB = WS_QKVB + (size_t)2 * LP * 1536 * 2 + 128 * 1024;
constexpr size_t WS_KT = WS_QB + 16 * MiB;
constexpr size_t WS_VT = WS_KT + (size_t)16 * NKT * 4096 * 2;
constexpr size_t WS_ZB = WS_VT + (size_t)8 * NKT * 8192 * 2;
constexpr size_t WS_GP = WS_ZB + (size_t)2 * LP * 512 * 2;
constexpr size_t GP_ARR = (size_t)2064 * 4096 * 2;
constexpr size_t WS_GP_END = WS_GP + 5 * GP_ARR;
constexpr size_t WS_WGU = 48 * MiB;
constexpr size_t WS_WD = 80 * MiB;
constexpr size_t WS_U2 = 96 * MiB;
constexpr size_t WS_LIST = 240 * MiB;
constexpr size_t WS_LISTW = 242 * MiB;
constexpr size_t WS_LISTRS = 244 * MiB;
constexpr size_t WS_XS = 96 * MiB;
constexpr size_t WS_YO = 128 * MiB;
constexpr size_t WS_YS = 8 * MiB;
constexpr size_t WS_END = 256 * MiB;
static_assert(WS_GB + (size_t)2 * LP * 16 * 4 <= WS_WOUT, "small region");
static_assert(WS_XB + (size_t)MROWS * 1024 * 2 <= WS_QKVB, "XB");
static_assert(WS_GP_END <= WS_END, "GDN prep arrays");
static_assert(WS_YS + (size_t)XS_ROWS * 256 * 2 <= WS_END, "YS");
static_assert(WS_WD + (size_t)32 * 1024 * 256 * 2 <= WS_XS, "WD");
constexpr int CW_ATTQ = 2112;
constexpr int CW_PREP = 2688;
constexpr int CW_CNT = 64;
constexpr int CW_TILE = 8192;
constexpr int CW_BAR = 4096;

constexpr int LDS_BYTES = 147456;

struct Params { const float* in[23]; float* out; unsigned char* ws; };

DI unsigned f2bf(float f) { unsigned u = __float_as_uint(f); return (u + 0x7fffu + ((u >> 16) & 1u)) >> 16; }
DI unsigned pk2(float lo, float hi) { f32x2_t v = {lo, hi}; bf16x2_t b = __builtin_convertvector(v, bf16x2_t); return __builtin_bit_cast(unsigned, b); }
DI float bf2f(unsigned short h) { return __uint_as_float(((unsigned)h) << 16); }
DI float rlane(float v, int l) { return __int_as_float(__builtin_amdgcn_readlane(__float_as_int(v), l)); }
#define DPP_ADD(v, ctrl) ((v) + __int_as_float(__builtin_amdgcn_update_dpp(0, __float_as_int(v), (ctrl), 0xF, 0xF, true)))
DI u32x2 pack_quad_bf16(float v) {
    const float v1 = __int_as_float(__builtin_amdgcn_update_dpp(0, __float_as_int(v), 0xB1, 0xF, 0xF, true));
    const unsigned p = pk2(v, v1);
    const unsigned q = (unsigned)__builtin_amdgcn_update_dpp(0, (int)p, 0x4E, 0xF, 0xF, true);
    return (u32x2){p, q};
}
typedef __attribute__((address_space(1))) u32x2 g_u32x2;
DI void store_quad_bf16(bf16_t* dst  , float v, int lane) {
    const float v1 = __int_as_float(__builtin_amdgcn_update_dpp(0, __float_as_int(v), 0xB1, 0xF, 0xF, true));
    const unsigned p = pk2(v, v1);
    const unsigned q = (unsigned)__builtin_amdgcn_update_dpp(0, (int)p, 0x4E, 0xF, 0xF, true);
    if ((lane & 3) == 0) *(u32x2*)dst = (u32x2){p, q};
}
DI float wave_sum_dpp(float v) {
    v = DPP_ADD(v, 0xB1);
    v = DPP_ADD(v, 0x4E);
    v = DPP_ADD(v, 0x141);
    v = DPP_ADD(v, 0x140);
    return (rlane(v, 0) + rlane(v, 16)) + (rlane(v, 32) + rlane(v, 48));
}
DI float wave_sum(float v) { return wave_sum_dpp(v); }
DI float swz_xor16(float v) { return __int_as_float(__builtin_amdgcn_ds_swizzle(__float_as_int(v), 0x401F)); }
DI float row_sum16(float v) { v = DPP_ADD(v, 0xB1); v = DPP_ADD(v, 0x4E); v = DPP_ADD(v, 0x141); v = DPP_ADD(v, 0x140); return v; }
DI float half_sum32(float v) { v = row_sum16(v); return v + swz_xor16(v); }
DI float swap32_add(float v) { auto rr = __builtin_amdgcn_permlane32_swap(__float_as_uint(v), __float_as_uint(v), false, false); return __uint_as_float(rr[0]) + __uint_as_float(rr[1]); }
DI float swap32_max(float v) { auto rr = __builtin_amdgcn_permlane32_swap(__float_as_uint(v), __float_as_uint(v), false, false); return fmaxf(__uint_as_float(rr[0]), __uint_as_float(rr[1])); }
#define LDS_WAIT() asm volatile("s_waitcnt lgkmcnt(0)" ::: "memory")
#define BAR_LDS() do { asm volatile("s_waitcnt lgkmcnt(0)" ::: "memory"); __builtin_amdgcn_s_barrier(); asm volatile("" ::: "memory"); } while (0)
#define MFMA32(a, b, c) __builtin_amdgcn_mfma_f32_32x32x16_bf16((a), (b), (c), 0, 0, 0)
DI int crow(int r, int hi) { return (r & 3) + 8 * (r >> 2) + 4 * hi; }
DI int perm16(int x) { return (x & ~12) | ((x & 4) << 1) | ((x & 8) >> 1); }
DI bf16x8 pack8(const f32x16& x, int s) {
    u32x4 p; p.x = pk2(x[8 * s], x[8 * s + 1]); p.y = pk2(x[8 * s + 2], x[8 * s + 3]); p.z = pk2(x[8 * s + 4], x[8 * s + 5]); p.w = pk2(x[8 * s + 6], x[8 * s + 7]);
    return __builtin_bit_cast(bf16x8, p);
}
DI int orig_col(int n) {
    if (n >= 1024) return n;
    const int hh = n >> 6, c2 = n & 63, g8 = c2 >> 3, i = c2 & 7;
    return (hh << 6) + ((i < 4) ? 4 * g8 + i : 32 + 4 * g8 + (i - 4));
}
DI size_t kt_off(int b, int hh, int p, int d) {
    const int tile = p < 16 ? 0 : 1 + ((p - 16) >> 6), kv = p < 16 ? p : ((p - 16) & 63);
    return ((size_t)((b * 8 + hh) * NKT + tile) << 12) + ((d >> 3) << 9) + (kv << 3) + (d & 7);
}
DI size_t vt_off(int b, int h, int p, int d) {
    const int tile = p < 16 ? 0 : 1 + ((p - 16) >> 6), kv = p < 16 ? p : ((p - 16) & 63);
    return ((size_t)((b * 4 + h) * NKT + tile) << 13) + ((d >> 5) << 11) + ((kv >> 4) << 9) + ((kv & 15) << 5) + (d & 31);
}

template <class Src> DI void transpose_item(const Src& src, bf16_t* WT, size_t ldk, int k0, int n0, LAS float* scr, int lane) {
    float v[32];
#pragma unroll
    for (int i = 0; i < 32; ++i) v[i] = src(k0 + 2 * i + (lane >> 5), n0 + (lane & 31));
#pragma unroll
    for (int i = 0; i < 32; ++i) scr[(2 * i + (lane >> 5)) * 33 + (lane & 31)] = v[i];
    LDS_WAIT();
    const int c = lane & 7;
#pragma unroll
    for (int j = 0; j < 4; ++j) { const int n = (lane >> 3) + 8 * j; const LAS float* s = scr + (8 * c) * 33 + n;
        u32x4 o; o.x = pk2(s[0 * 33], s[1 * 33]); o.y = pk2(s[2 * 33], s[3 * 33]); o.z = pk2(s[4 * 33], s[5 * 33]); o.w = pk2(s[6 * 33], s[7 * 33]);
        *(u32x4*)(WT + (size_t)(n0 + n) * ldk + k0 + 8 * c) = o; }
    LDS_WAIT();
}
struct SrcWin { const float* w; const float* g; DI float operator()(int k, int n) const { return n >= 3600 ? 0.f : w[(size_t)k * 3600 + orig_col(n)] * g[k]; } };
struct SrcPlain { const float* w; int N; DI float operator()(int k, int n) const { return w[(size_t)k * N + n]; } };
struct SrcGU { const float* w; const float* g; int fadj; DI float operator()(int k, int n) const { return w[(size_t)k * 256 + n + fadj] * g[k]; } };

#ifndef P0_REP
#define P0_REP 0
#endif
DI void phase0(const Params& P, LAS unsigned char* lds, int gw, int NGW, int gtid, int NGT, int wave, int lane) {
    LAS float* scr = (LAS float*)(lds + wave * 16384);
    bf16_t* WINT = (bf16_t*)(P.ws + WS_WINT); bf16_t* WOUT = (bf16_t*)(P.ws + WS_WOUT); bf16_t* XB = (bf16_t*)(P.ws + WS_XB);
    float* RS1 = (float*)(P.ws + WS_RS1);
    constexpr int I_IN = 16 * (NPROJ / 32), I_OUT = 16 * 32;
    const SrcWin sw{P.in[3], P.in[2]}; const SrcPlain so{P.in[13], 1024};
    for (int rp_ = 0; rp_ < ((P0_REP & 1) ? 2 : 1); ++rp_)
    for (int it = gw; it < I_IN + I_OUT; it += NGW) {
        if (it < I_IN) transpose_item(sw, WINT, 1024, (it / (NPROJ / 32)) * 64, (it % (NPROJ / 32)) * 32, scr, lane);
        else { const int r = it - I_IN; transpose_item(so, WOUT, 1024, (r >> 5) * 64, (r & 31) * 32, scr, lane); }
    }
    const float* x = P.in[0]; const float* meta = P.in[1];
    for (int rp_ = 0; rp_ < ((P0_REP & 2) ? 2 : 1); ++rp_)
    for (int m0 = gw; m0 < MROWS; m0 += 4 * NGW) {
        f32x4 v[4][4];
#pragma unroll
        for (int r = 0; r < 4; ++r) { const int m = m0 + r * NGW;
            const bool real = m < MTOK + NMETA;
            const f32x4* xr = (const f32x4*)((m < MTOK) ? x + (size_t)m * 1024 : meta + (size_t)((real ? m : MTOK) - MTOK) * 1024);
#pragma unroll
            for (int j = 0; j < 4; ++j) v[r][j] = (m < MROWS) ? xr[64 * j + lane] : (f32x4){0.f, 0.f, 0.f, 0.f}; }
#pragma unroll
        for (int r = 0; r < 4; ++r) { const int m = m0 + r * NGW;
            if (m < MROWS) {
                const bool real = m < MTOK + NMETA;
                float s = 0.f;
#pragma unroll
                for (int j = 0; j < 4; ++j) { if (!real) v[r][j] = (f32x4){0.f, 0.f, 0.f, 0.f}; s += (v[r][j].x * v[r][j].x + v[r][j].y * v[r][j].y) + (v[r][j].z * v[r][j].z + v[r][j].w * v[r][j].w); }
                s = wave_sum(s);
                if (lane == 0) RS1[m] = real ? __builtin_amdgcn_rsqf(s * (1.0f / 1024.0f) + EPS) : 0.f;
                u32x2* orow = (u32x2*)(XB + (size_t)m * 1024);
#pragma unroll
                for (int j = 0; j < 4; ++j) orow[64 * j + lane] = (u32x2){pk2(v[r][j].x, v[r][j].y), pk2(v[r][j].z, v[r][j].w)};
            } }
    }
    float* COS = (float*)(P.ws + WS_COS); float* SIN = (float*)(P.ws + WS_SIN);
    for (int rp_ = 0; rp_ < ((P0_REP & 4) ? 2 : 1); ++rp_)
    for (int i = gtid; i < LTOK * 32; i += NGT) {
        const int p = i >> 5, f = i & 31;
        const double rev = (double)p * exp2(-(double)f * (13.287712379549449 / 32.0)) * 0.15915494309189535;
        const float fr = (float)(rev - floor(rev));
        COS[i] = __builtin_amdgcn_cosf(fr); SIN[i] = __builtin_amdgcn_sinf(fr);
    }
    float* WR = (float*)(P.ws + WS_WR); const float* gf = P.in[14]; const float* wgrp = P.in[15]; const float* wrt = P.in[17];
    for (int i = gtid; i < 36 * 1024; i += NGT) { const int j = i >> 10, k = i & 1023; WR[i] = gf[k] * (j < 4 ? wgrp[k * 4 + j] : wrt[k * 32 + (j - 4)]); }
}

#ifndef EPI_NT
#define EPI_NT 0
#endif
#if EPI_NT
#define NT_ST(p, v) __builtin_nontemporal_store((v), (p))
#else
#define NT_ST(p, v) do { if (EV == 1) { auto p_ = (p); *(decltype(p_))(dmask ? dumpb + ((unsigned long long)p_ & 0xFFFF0ull) : (unsigned char*)p_) = (v); } else *(p) = (v); } while (0)
#endif
template <int EV> struct EpiInProjT {
    static constexpr bool PERM = true, AFTER_DRAIN = false, TIMED = true;
    const float* RS1; const float* COS; const float* SIN; const float* a_log; const float* dt_bias;
    bf16_t* QB; bf16_t* KT; bf16_t* VT; bf16_t* QKVB; bf16_t* ZB; float* GB; unsigned char* dumpb; int dmask; unsigned long long* tslot;
    DI void tail(const pg8::f32x4 (&acc)[2][2][4][2], const pg8::Unit& u, int wr, int wc, int fr, int fq) const {
        const int pn = u.pn;
#pragma unroll
        for (int ai = 0; ai < 2; ++ai)
#pragma unroll
            for (int m = 0; m < 4; ++m) {
                const int row = u.pm * 256 + ai * 128 + wr * 64 + m * 16 + fr;
                if (row < MTOK + NMETA) {
                    const float rs = RS1[row];
                    const bool meta = row >= MTOK;
                    const int p = meta ? row - MTOK : (row & 8191) + NMETA;
                    const int b0 = meta ? 0 : (row >> 13), nb = meta ? 2 : 1;
#pragma unroll
                    for (int bj = 0; bj < 2; ++bj) {
                        float xv[8];
#pragma unroll
                        for (int i = 0; i < 4; ++i) { xv[i] = acc[ai][bj][m][0][i] * rs; xv[4 + i] = acc[ai][bj][m][1][i] * rs; }
                        if (pn < 4) {
                            const int hh = (pn & 1) * 4 + bj * 2 + (wc >> 1), d0 = 4 * (4 * (wc & 1) + fq);
                            const f32x4 cs = *(const f32x4*)(COS + p * 32 + d0), sn = *(const f32x4*)(SIN + p * 32 + d0);
                            float lo[4], hi[4];
#pragma unroll
                            for (int i = 0; i < 4; ++i) { lo[i] = xv[i] * cs[i] - xv[4 + i] * sn[i]; hi[i] = xv[4 + i] * cs[i] + xv[i] * sn[i]; }
                            if (pn < 2) {
                                if (!meta) {
                                    bf16_t* q = QB + ((size_t)((b0 * 8 + hh) * SEQ + (p - NMETA)) << 6) + d0;
                                    *(u32x2*)q = (u32x2){pk2(lo[0] * C2Q, lo[1] * C2Q), pk2(lo[2] * C2Q, lo[3] * C2Q)};
                                    *(u32x2*)(q + 32) = (u32x2){pk2(hi[0] * C2Q, hi[1] * C2Q), pk2(hi[2] * C2Q, hi[3] * C2Q)};
                                }
                            } else {
                                for (int bb = b0; bb < b0 + nb; ++bb) {
                                    *(u32x2*)(KT + kt_off(bb, hh, p, d0)) = (u32x2){pk2(lo[0], lo[1]), pk2(lo[2], lo[3])};
                                    *(u32x2*)(KT + kt_off(bb, hh, p, d0 + 32)) = (u32x2){pk2(hi[0], hi[1]), pk2(hi[2], hi[3])};
                                }
                            }
                        } else {
                            const u32x4 w = (u32x4){pk2(xv[0], xv[1]), pk2(xv[2], xv[3]), pk2(xv[4], xv[5]), pk2(xv[6], xv[7])};
                            const int cl = bj * 128 + wc * 32 + fq * 8;
                            if (pn < 6) {
                                const int h = (pn - 4) * 2 + bj, d = wc * 32 + fq * 8;
                                for (int bb = b0; bb < b0 + nb; ++bb) *(u32x4*)(VT + vt_off(bb, h, p, d)) = w;
                            } else if (pn < 12) {
                                for (int bb = b0; bb < b0 + nb; ++bb) *(u32x4*)(QKVB + (size_t)(bb * LP + p) * 1536 + (pn - 6) * 256 + cl) = w;
                            } else if (pn < 14) {
                                float sz[8];
#pragma unroll
                                for (int i = 0; i < 8; ++i) sz[i] = xv[i] * __builtin_amdgcn_rcpf(1.0f + __expf(-xv[i]));
                                const u32x4 wz = (u32x4){pk2(sz[0], sz[1]), pk2(sz[2], sz[3]), pk2(sz[4], sz[5]), pk2(sz[6], sz[7])};
                                for (int bb = b0; bb < b0 + nb; ++bb) *(u32x4*)(ZB + (size_t)(bb * LP + p) * 512 + (pn - 12) * 256 + cl) = wz;
                            } else if (cl < 16) {
                                float o[8];
                                if (cl == 0) {
#pragma unroll
                                    for (int i = 0; i < 8; ++i) { const float t = xv[i] + dt_bias[i]; const float sp = fmaxf(t, 0.f) + __logf(1.0f + __expf(-fabsf(t))); o[i] = -__expf(a_log[i]) * sp; }
                                } else {
#pragma unroll
                                    for (int i = 0; i < 8; ++i) o[i] = __builtin_amdgcn_rcpf(1.0f + __expf(-xv[i]));
                                }
                                for (int bb = b0; bb < b0 + nb; ++bb) { float* g = GB + ((size_t)(bb * LP + p) << 4) + cl;
                                    *(f32x4*)g = (f32x4){o[0], o[1], o[2], o[3]}; *(f32x4*)(g + 4) = (f32x4){o[4], o[5], o[6], o[7]}; }
                            }
                        }
                    }
                }
            }
    }

    DI void operator()(const pg8::f32x4 (&acc)[2][2][4][2], const pg8::Unit& u, int wr, int wc, int fr, int fq) const {
        if (u.pm >= MTOK / 256) { tail(acc, u, wr, wc, fr, fq); return; }
        const int pn = u.pn, rowb = u.pm * 256 + wr * 64 + fr;
        float rs[2][4];
#pragma unroll
        for (int ai = 0; ai < 2; ++ai)
#pragma unroll
            for (int m = 0; m < 4; ++m) rs[ai][m] = (EV == 2) ? 1.0f : RS1[rowb + ai * 128 + m * 16];
        __builtin_amdgcn_sched_barrier(0);
        const int b = rowb >> 13, s0 = rowb & 8191;
        if (pn < 4) {
            const int d0 = 4 * (4 * (wc & 1) + fq);
#pragma unroll
            for (int ai = 0; ai < 2; ++ai) {
                f32x4 cs[4], sn[4];
#pragma unroll
                for (int m = 0; m < 4; ++m) { const int p = s0 + ai * 128 + m * 16 + NMETA; if (EV == 2) { cs[m] = (f32x4){1.f, 1.f, 1.f, 1.f}; sn[m] = (f32x4){0.f, 0.f, 0.f, 0.f}; } else { cs[m] = *(const f32x4*)(COS + p * 32 + d0); sn[m] = *(const f32x4*)(SIN + p * 32 + d0); } }
                __builtin_amdgcn_sched_barrier(0);
#pragma unroll
                for (int m = 0; m < 4; ++m)
#pragma unroll
                    for (int bj = 0; bj < 2; ++bj) {
                        const int hh = (pn & 1) * 4 + bj * 2 + (wc >> 1), s = s0 + ai * 128 + m * 16;
                        float lo[4], hi[4];
#pragma unroll
                        for (int i = 0; i < 4; ++i) { const float x1 = acc[ai][bj][m][0][i] * rs[ai][m], x2 = acc[ai][bj][m][1][i] * rs[ai][m];
                            lo[i] = x1 * cs[m][i] - x2 * sn[m][i]; hi[i] = x2 * cs[m][i] + x1 * sn[m][i]; }
                        if (pn < 2) { bf16_t* q = QB + ((size_t)((b * 8 + hh) * SEQ + s) << 6) + d0;
                            NT_ST((u32x2*)q, ((u32x2){pk2(lo[0] * C2Q, lo[1] * C2Q), pk2(lo[2] * C2Q, lo[3] * C2Q)}));
                            NT_ST((u32x2*)(q + 32), ((u32x2){pk2(hi[0] * C2Q, hi[1] * C2Q), pk2(hi[2] * C2Q, hi[3] * C2Q)}));
                        } else { bf16_t* k = KT + ((size_t)((b * 8 + hh) * NKT + 1 + (s >> 6)) << 12) + ((d0 >> 3) << 9) + ((s & 63) << 3) + (d0 & 7);
                            NT_ST((u32x2*)k, ((u32x2){pk2(lo[0], lo[1]), pk2(lo[2], lo[3])}));
                            NT_ST((u32x2*)(k + 4 * 512), ((u32x2){pk2(hi[0], hi[1]), pk2(hi[2], hi[3])})); }
                    }
            }
            return;
        }
        const int cl = wc * 32 + fq * 8;
#pragma unroll
        for (int ai = 0; ai < 2; ++ai)
#pragma unroll
            for (int m = 0; m < 4; ++m)
#pragma unroll
                for (int bj = 0; bj < 2; ++bj) {
                    const int s = s0 + ai * 128 + m * 16, p = s + NMETA;
                    float xv[8];
#pragma unroll
                    for (int i = 0; i < 4; ++i) { xv[i] = acc[ai][bj][m][0][i] * rs[ai][m]; xv[4 + i] = acc[ai][bj][m][1][i] * rs[ai][m]; }
                    if (pn < 6) {
                        const int h = (pn - 4) * 2 + bj;
                        NT_ST((u32x4*)(VT + ((size_t)((b * 4 + h) * NKT + 1 + (s >> 6)) << 13) + ((cl >> 5) << 11) + (((s & 63) >> 4) << 9) + ((s & 15) << 5) + (cl & 31)),
                            ((u32x4){pk2(xv[0], xv[1]), pk2(xv[2], xv[3]), pk2(xv[4], xv[5]), pk2(xv[6], xv[7])}));
                    } else if (pn < 12) {
                        NT_ST((u32x4*)(QKVB + (size_t)(b * LP + p) * 1536 + (pn - 6) * 256 + bj * 128 + cl), ((u32x4){pk2(xv[0], xv[1]), pk2(xv[2], xv[3]), pk2(xv[4], xv[5]), pk2(xv[6], xv[7])}));
                    } else if (pn < 14) {
#pragma unroll
                        for (int i = 0; i < 8; ++i) xv[i] = xv[i] * __builtin_amdgcn_rcpf(1.0f + __expf(-xv[i]));
                        NT_ST((u32x4*)(ZB + (size_t)(b * LP + p) * 512 + (pn - 12) * 256 + bj * 128 + cl), ((u32x4){pk2(xv[0], xv[1]), pk2(xv[2], xv[3]), pk2(xv[4], xv[5]), pk2(xv[6], xv[7])}));
                    } else if (bj == 0 && cl < 16) {
                        float o[8];
                        if (cl == 0) {
#pragma unroll
                            for (int i = 0; i < 8; ++i) { const float t = xv[i] + dt_bias[i]; const float sp = fmaxf(t, 0.f) + __logf(1.0f + __expf(-fabsf(t))); o[i] = -__expf(a_log[i]) * sp; }
                        } else {
#pragma unroll
                            for (int i = 0; i < 8; ++i) o[i] = __builtin_amdgcn_rcpf(1.0f + __expf(-xv[i]));
                        }
                        float* g = GB + ((size_t)(b * LP + p) << 4) + cl;
                        *(f32x4*)g = (f32x4){o[0], o[1], o[2], o[3]}; *(f32x4*)(g + 4) = (f32x4){o[4], o[5], o[6], o[7]};
                    }
                }
    }
};
typedef EpiInProjT<0> EpiInProj;

DI bf16x8 lds_frag(LAS const bf16_t* M, int row, int ch) { return *(LAS const bf16x8*)((LAS const unsigned char*)M + row * 128 + ((ch ^ (row & 7)) << 4)); }
DI s16x4 tr_read_b64(LAS const unsigned char* p) { return __builtin_bit_cast(s16x4, __builtin_amdgcn_ds_read_tr16_b64_v4i16((LAS v4i16_t*)p)); }
DI bf16x8 lds_frag_plain(LAS const bf16_t* M, int row, int ch) { return *(LAS const bf16x8*)((LAS const unsigned char*)M + row * 128 + (ch << 4)); }
DI int swz_idx(int row, int d) { return row * 64 + ((((d >> 3) ^ (row & 7)) << 3) | (d & 7)); }

#ifndef PREP_REP
#define PREP_REP 0
#endif
constexpr int PREP_PAIR = 35840;

template <int MAT> DI void prep_rows(const bf16_t* QKVB, const float* cw, int b, int h, int n, int lane, LAS const float* egS,
                                     LAS bf16_t* DS  , bf16_t* QG) {
    const int colb = MAT * 512 + h * 64, col = colb + lane, p0 = n * 64;
    const float c0 = cw[col], c1 = cw[1536 + col], c2 = cw[3072 + col], c3 = cw[4608 + col];
    const bf16_t* blk = QKVB + (size_t)(b * LP + p0) * 1536 + colb;
    float x0 = 0.f, x1 = 0.f, x2 = 0.f;
    if (n > 0) { x0 = bf2f(blk[lane - 3 * 1536]); x1 = bf2f(blk[lane - 2 * 1536]); x2 = bf2f(blk[lane - 1 * 1536]); }
    u32x4 stg[8];
#pragma unroll
    for (int i = 0; i < 8; ++i) stg[i] = *(const u32x4*)(blk + (size_t)(8 * i + (lane >> 3)) * 1536 + (lane & 7) * 8);
#pragma unroll
    for (int i = 0; i < 8; ++i) *(LAS u32x4*)(DS + (8 * i + (lane >> 3)) * 64 + (lane & 7) * 8) = stg[i];
    LDS_WAIT();
    const int nvalid = (LTOK - p0) < 64 ? (LTOK - p0) : 64;
#pragma unroll 4
    for (int c = 0; c < nvalid; ++c) {
        const float x3 = bf2f(DS[c * 64 + lane]);
        float y = c0 * x0 + c1 * x1 + c2 * x2 + c3 * x3;
        y = y * __builtin_amdgcn_rcpf(1.0f + __expf(-y));
        x0 = x1; x1 = x2; x2 = x3;
        if (MAT == 2) { DS[c * 64 + lane] = (bf16_t)f2bf(y * egS[c]); }
        else {
            const float ss = wave_sum(y * y);
            const float yn = y * __builtin_amdgcn_rsqf(ss + EPS);
            if (MAT == 0) {
                const float qn = yn * 0.125f;
                DS[c * 64 + lane] = (bf16_t)f2bf(qn);
                QG[c * 64 + perm16(lane)] = (bf16_t)f2bf(qn * egS[c]);
            } else {
                DS[c * 64 + lane] = (bf16_t)f2bf(yn);
            }
        }
    }
    for (int c = nvalid; c < 64; ++c) { DS[c * 64 + lane] = 0; if (MAT == 0) QG[c * 64 + perm16(lane)] = 0; }
}

DI void gdn_tinv(LAS const float* AST, LAS bf16_t* TS, int lane) {
    const int hb = lane >> 5, j = lane & 31, r32 = j, hi = hb;
    LAS const float* Ab = AST + (32 * hb) * 68 + 32 * hb;
    float x[32];
#pragma unroll
    for (int r = 0; r < 32; ++r) x[r] = (r == j) ? 1.0f : 0.0f;
#pragma unroll
    for (int jj = 0; jj < 31; ++jj) {
        const float xj = x[jj];
        LAS const float* ap = Ab + jj * 68;
#pragma unroll
        for (int r4 = (jj + 1) / 4; r4 < 8; ++r4) {
            const f32x4 a = *(LAS const f32x4*)(ap + 4 * r4);
#pragma unroll
            for (int e = 0; e < 4; ++e) if (4 * r4 + e > jj) x[4 * r4 + e] -= a[e] * xj;
        }
    }
    bf16x8 a21[2];
#pragma unroll
    for (int s = 0; s < 2; ++s) { float t[8];
#pragma unroll
        for (int jj = 0; jj < 8; ++jj) t[jj] = AST[(16 * s + 8 * hi + jj) * 68 + 32 + r32];
        const u32x4 p = (u32x4){pk2(t[0], t[1]), pk2(t[2], t[3]), pk2(t[4], t[5]), pk2(t[6], t[7])}; a21[s] = __builtin_bit_cast(bf16x8, p); }
    f32x16 M = {};
#pragma unroll
    for (int s = 0; s < 2; ++s) { float t[8];
#pragma unroll
        for (int jj = 0; jj < 8; ++jj) {
            const auto rr = __builtin_amdgcn_permlane32_swap(__float_as_uint(x[16 * s + 8 + jj]), __float_as_uint(x[16 * s + 8 + jj]), false, false);
            t[jj] = hi ? __uint_as_float(rr[0]) : x[16 * s + jj];
        }
        const u32x4 p = (u32x4){pk2(t[0], t[1]), pk2(t[2], t[3]), pk2(t[4], t[5]), pk2(t[6], t[7])};
        M = MFMA32(a21[s], __builtin_bit_cast(bf16x8, p), M);
    }
    asm volatile("s_waitcnt lgkmcnt(0)" ::: "memory");
#pragma unroll
    for (int i = 0; i < 32; ++i) TS[(32 * hb + i) * 64 + 32 * hb + j] = (bf16_t)f2bf(x[i]);
    asm volatile("s_waitcnt lgkmcnt(0)" ::: "memory");
    f32x16 T21 = {};
#pragma unroll
    for (int s = 0; s < 2; ++s) {
        const u32x2 lo = *(LAS const u32x2*)(TS + (32 + r32) * 64 + 32 + 16 * s + 4 * hi), hi8 = *(LAS const u32x2*)(TS + (32 + r32) * 64 + 32 + 16 * s + 8 + 4 * hi);
        const u32x4 p = (u32x4){lo.x, lo.y, hi8.x, hi8.y};
        T21 = MFMA32(__builtin_bit_cast(bf16x8, p), pack8(M, s), T21);
    }
#pragma unroll
    for (int i = 0; i < 16; ++i) TS[(32 + crow(i, hi)) * 64 + r32] = (bf16_t)f2bf(-T21[i]);
    asm volatile("s_waitcnt lgkmcnt(0)" ::: "memory");
}

template <bool PERM> DI void gdn_tmul(LAS const bf16_t* TS, LAS const bf16_t* RS, int lane, float sgn, bf16_t* out) {
    const int r32 = lane & 31, hi = lane >> 5;
    LAS const unsigned char* rb = (LAS const unsigned char*)RS + ((8 * hi + ((lane & 15) >> 2)) * 64 + 16 * ((lane >> 4) & 1) + 4 * (lane & 3)) * 2;
#pragma unroll
    for (int ct = 0; ct < 2; ++ct)
#pragma unroll
        for (int cb = 0; cb < 2; ++cb) {
            f32x16 acc = {};
#pragma unroll
            for (int ks = 0; ks < (ct == 0 ? 2 : 4); ++ks) {
                const bf16x8 fa = lds_frag_plain(TS, 32 * ct + r32, 2 * ks + hi);
                const s16x4 lo = tr_read_b64(rb + (16 * ks * 64 + 32 * cb) * 2), h4 = tr_read_b64(rb + ((16 * ks + 4) * 64 + 32 * cb) * 2);
                const bf16x8 fb = (bf16x8){lo[0], lo[1], lo[2], lo[3], h4[0], h4[1], h4[2], h4[3]};
                acc = MFMA32(fa, fb, acc);
            }
            u32x2 pk[16];
#pragma unroll
            for (int i = 0; i < 16; ++i) pk[i] = pack_quad_bf16(sgn * acc[i]);
            if ((lane & 3) == 0) {
                unsigned long long ob_ = (unsigned long long)(out + hi * 256 + (PERM ? perm16(32 * cb + r32) : 32 * cb + r32)); asm volatile("" : "+v"(ob_));
                g_u32x2* ob = (g_u32x2*)ob_;
#pragma unroll
                for (int i = 0; i < 16; ++i) ob[(32 * ct + (i & 3) + 8 * (i >> 2)) * 16] = pk[i];
            }
        }
}

DI void gdn_prep_phase(const Params& P, LAS unsigned char* lds, int blk, int G, int wave, int lane_in) {
    const int pair = wave >> 1, role = wave & 1;
    LAS unsigned char* pb = lds + pair * PREP_PAIR;
    LAS bf16_t* QS = (LAS bf16_t*)pb; LAS bf16_t* KS = (LAS bf16_t*)(pb + 8192); LAS float* AS = (LAS float*)(pb + 16384);
    LAS float* gcS = (LAS float*)(pb + 16384 + 17408 + role * 1024); LAS float* betaS = gcS + 64; LAS float* egS = gcS + 128; LAS float* ekS = gcS + 192;
    const bf16_t* QKVB = (const bf16_t*)(P.ws + WS_QKVB); const float* GB = (const float*)(P.ws + WS_GB); const float* cw = P.in[9];
    const int NP = G * 4, NTASK = 2 * 8 * NCHUNK;
    for (int it = 0; it * NP < NTASK; ++it) {
        int lane = lane_in; asm volatile("" : "+v"(lane));
        const int r32 = lane & 31, hi = lane >> 5;
        const int task = it * NP + blk * 4 + pair;
        const bool active = task < NTASK;
        const int bh = task < 2048 ? (task >> 7) : (task - 2048), n = task < 2048 ? (task & 127) : 128, b = bh >> 3, h = bh & 7;
        const int sidx = bh * NCHUNK + n;
        bf16_t* GPW = (bf16_t*)(P.ws + WS_GP) + (size_t)sidx * 4096; bf16_t* GPQG = GPW + GP_ARR / 2; bf16_t* GPAQK = GPQG + GP_ARR / 2; bf16_t* GPKGT = GPAQK + GP_ARR / 2; bf16_t* GPU = GPKGT + GP_ARR / 2;
        float gc = 0.f, beta = 0.f;
        if (active) {
            const int pl = n * 64 + lane;
            float g = 0.f;
            if (pl < LTOK) { const float* gb = GB + ((size_t)(b * LP + pl) << 4); g = gb[h]; beta = gb[8 + h]; }
            gcS[lane] = g; LDS_WAIT();
            gc = 0.f;
#pragma unroll
            for (int j4 = 0; j4 < 16; ++j4) { const f32x4 t = *(LAS const f32x4*)(gcS + 4 * j4);
                gc += (4 * j4 <= lane ? t[0] : 0.f) + (4 * j4 + 1 <= lane ? t[1] : 0.f) + (4 * j4 + 2 <= lane ? t[2] : 0.f) + (4 * j4 + 3 <= lane ? t[3] : 0.f); }
            const float glast = rlane(gc, 63);
            LDS_WAIT();
            gcS[lane] = gc; betaS[lane] = beta; egS[lane] = (role == 0) ? __expf(gc) : beta * __expf(gc); ekS[lane] = __expf(glast - gc);
            if (role == 0 && lane == 0) ((float*)(P.ws + WS_GL))[sidx] = __expf(glast);
            LDS_WAIT();
            for (int rp_ = 0; rp_ < ((PREP_REP & 1) ? 2 : 1); ++rp_) {
            if (role == 0) prep_rows<0>(QKVB, cw, b, h, n, lane, egS, QS, GPQG);
            else prep_rows<1>(QKVB, cw, b, h, n, lane, egS, KS, GPQG);
            }
        }
        LDS_WAIT();
        __syncthreads();
        if (active) {
            for (int rp_ = 0; rp_ < ((PREP_REP & 2) ? 2 : 1); ++rp_)
#pragma unroll
            for (int t4 = 0; t4 < 4; ++t4) {
                const int ct = t4 >> 1, st = t4 & 1;
                f32x16 acc = {};
                if (!(ct == 0 && st == 1)) {
#pragma unroll
                    for (int ks = 0; ks < 4; ++ks) {
                        const bf16x8 fa = lds_frag_plain(role == 0 ? QS : KS, 32 * ct + r32, 2 * ks + hi), fb = lds_frag_plain(KS, 32 * st + r32, 2 * ks + hi);
                        acc = MFMA32(fa, fb, acc);
                    }
                }
                const float gcs = gcS[32 * st + r32];
                LAS const float* gcb = gcS + hi * 4; LAS const float* beb = betaS + hi * 4;
                asm volatile("" : "+v"(gcb), "+v"(beb));
                const int cmp = (32 * st + r32) - 4 * hi;
                if (role == 0) {
                    u32x2 pk[16];
#pragma unroll
                    for (int i = 0; i < 16; ++i) { const int cr = 32 * ct + (i & 3) + 8 * (i >> 2);
                        pk[i] = pack_quad_bf16((cmp <= cr) ? acc[i] * __expf(gcb[cr] - gcs) : 0.f); }
                    if ((lane & 3) == 0) {
                        unsigned long long aq_ = (unsigned long long)(GPAQK + hi * 256 + perm16(r32) + 32 * st); asm volatile("" : "+v"(aq_));
                        g_u32x2* aqb = (g_u32x2*)aq_;
#pragma unroll
                        for (int i = 0; i < 16; ++i) { const int cr = 32 * ct + (i & 3) + 8 * (i >> 2); aqb[cr * 16] = pk[i]; }
                    }
                } else {
                    LAS float* asb = AS + r32 * 68 + hi * 4;
                    asm volatile("" : "+v"(asb));
#pragma unroll
                    for (int i = 0; i < 16; ++i) { const int cr = 32 * ct + (i & 3) + 8 * (i >> 2);
                        asb[32 * st * 68 + cr] = (cmp < cr) ? acc[i] * beb[cr] * __expf(gcb[cr] - gcs) : 0.f; }
                }
            }
        }
        LDS_WAIT();
        __syncthreads();
        LAS bf16_t* TS = (LAS bf16_t*)((LAS unsigned char*)AS + 32 * 68 * 4);
        if (active) {
            if (role == 0) {
                prep_rows<2>(QKVB, cw, b, h, n, lane, betaS, QS  , GPQG);
            } else {
#pragma unroll
                for (int gq = 0; gq < 8; ++gq) {
                    float t[8];
#pragma unroll
                    for (int j = 0; j < 8; ++j) { const int c = perm16(8 * gq + j); t[j] = bf2f(KS[c * 64 + lane]) * ekS[c]; }
                    *(u32x4*)(GPKGT + lane * 64 + 8 * gq) = (u32x4){pk2(t[0], t[1]), pk2(t[2], t[3]), pk2(t[4], t[5]), pk2(t[6], t[7])};
                }
#pragma unroll 8
                for (int c = 0; c < 64; ++c) KS[c * 64 + lane] = (bf16_t)f2bf(bf2f(KS[c * 64 + lane]) * egS[c]);
                gdn_tinv(AS, TS, lane);
            }
        }
        LDS_WAIT();
        __syncthreads();
        if (active) {
            for (int rp_ = 0; rp_ < ((PREP_REP & 8) ? 2 : 1); ++rp_) {
            if (role == 0) gdn_tmul<false>(TS, QS, lane, 1.0f, GPU);
            else gdn_tmul<true>(TS, KS, lane, -1.0f, GPW);
            }
        }
        LDS_WAIT();
    }
}

constexpr int GS_STAGE = 40960 + 1024;
constexpr int GS_NSTAGE = 3;
constexpr int GS_OBUF = GS_NSTAGE * GS_STAGE;
static_assert(GS_OBUF + 16384 <= LDS_BYTES - 64, "gdn scan LDS");

#define GS_POST(n, ZQ) do { \
            if (n > 0) {         \
                LAS const bf16_t* ob = (LAS const bf16_t*)(lds + GS_OBUF + ((n - 1) & 1) * 8192); \
                const f32x4 gn = *(const f32x4*)(gnorm + 4 * vq); \
            _Pragma("unroll") \
                for (int it = 0; it < 8; ++it) { \
                    const int c = (wave - 2) * 32 + 4 * it + rg, p = (n - 1) * 64 + c; \
                    const u32x2 ov = *(LAS const u32x2*)(ob + c * 64 + 4 * vq); \
                    const float v0 = __uint_as_float(ov.x << 16), v1 = __uint_as_float(ov.x & 0xffff0000u), v2 = __uint_as_float(ov.y << 16), v3 = __uint_as_float(ov.y & 0xffff0000u); \
                    const float ss = row_sum16((v0 * v0 + v1 * v1) + (v2 * v2 + v3 * v3)); \
                    const float rn = __builtin_amdgcn_rsqf(ss * (1.0f / 64.0f) + EPS); \
                    const u32x2 zz = ZQ[it]; \
                    const float z0 = __uint_as_float(zz.x << 16), z1 = __uint_as_float(zz.x & 0xffff0000u), z2 = __uint_as_float(zz.y << 16), z3 = __uint_as_float(zz.y & 0xffff0000u); \
                    const float y0 = v0 * rn * gn[0] * z0, y1 = v1 * rn * gn[1] * z1, y2 = v2 * rn * gn[2] * z2, y3 = v3 * rn * gn[3] * z3;       \
                    { bf16_t* dst_ = ((p >= NMETA) && (p < LTOK)) ? MIX + (size_t)(b * SEQ + p - NMETA) * 1024 + 512 + h * 64 + 4 * vq : DUMP + lane * 4;       \
                      *(u32x2*)dst_ = (u32x2){pk2(y0, y1), pk2(y2, y3)}; } \
                } \
            } \
        } while (0)
DI void gdn_scan(const Params& P, LAS unsigned char* lds, int bh, int tid, int wave, int lane) {
    const int b = bh >> 3, h = bh & 7, r32 = lane & 31, hi = lane >> 5;
    const int task0 = (b * 8 + h) * NCHUNK;
    const bf16_t* GP0 = (const bf16_t*)(P.ws + WS_GP);
    const float* GLg = (const float*)(P.ws + WS_GL);
    const bf16_t* ZB = (const bf16_t*)(P.ws + WS_ZB); bf16_t* MIX = (bf16_t*)(P.ws + WS_MIX); const float* gnorm = P.in[12];
    bf16_t* DUMP = (bf16_t*)(P.ws + WS_DUMP) + bh * 4096 + wave * 512;
    const int lw = wave - 4;
    const int prow = lane >> 3, pch = lane & 7;
#define GS_DMA(n_, stg_) do { LAS unsigned char* sg_ = lds + (stg_) * GS_STAGE; \
        _Pragma("unroll") for (int i = 0; i < 10; ++i) { const int a_ = i >> 1, pi_ = lw * 2 + (i & 1), row_ = 8 * pi_ + prow; \
            const int sch_ = (a_ < 4) ? (pch ^ (row_ & 7)) : pch; \
            __builtin_amdgcn_global_load_lds((const unsigned*)(GP0 + (size_t)a_ * (GP_ARR / 2) + (size_t)(task0 + (n_)) * 4096 + row_ * 64 + sch_ * 8), \
                                             (LAS unsigned*)(sg_ + a_ * 8192 + pi_ * 1024), 16, 0, 0); } \
        __builtin_amdgcn_global_load_lds((const unsigned*)(GLg + task0 + (n_)), (LAS unsigned*)(sg_ + 40960 + lw * 256), 4, 0, 0); } while (0)
    if (wave >= 4) { GS_DMA(0, 0); GS_DMA(1, 1); asm volatile("s_waitcnt vmcnt(11)" ::: "memory"); }
    const int vq = lane & 15, rg = lane >> 4;
    u32x2 zqA[8], zqB[8];
#define GS_ZLOADX(ZQ, n_) do { _Pragma("unroll") for (int it = 0; it < 8; ++it) { int p_ = (n_) * 64 + (wave - 2) * 32 + 4 * it + rg; p_ = p_ < LTOK ? p_ : LTOK - 1; \
            ZQ[it] = *(const u32x2*)(ZB + (size_t)(b * LP + p_) * 512 + h * 64 + 4 * vq); } } while (0)
    if (wave == 2 || wave == 3) { GS_ZLOADX(zqB, 0); }
    BAR_LDS();
    f32x16 S0 = {}, S1 = {};
    const int vbase = 32 * wave;
    if (wave < 2) {
    int stg = 0;
    for (int n = 0; n <= NCHUNK; ++n) {
        {
            if (n < NCHUNK) {
                LAS const unsigned char* sg = lds + stg * GS_STAGE;
                LAS const bf16_t* Wm = (LAS const bf16_t*)sg; LAS const bf16_t* QGm = (LAS const bf16_t*)(sg + 8192); LAS const bf16_t* AQm = (LAS const bf16_t*)(sg + 16384);
                LAS const bf16_t* KGm = (LAS const bf16_t*)(sg + 24576); LAS const bf16_t* Um = (LAS const bf16_t*)(sg + 32768);
                const float gl = *(LAS const float*)(sg + 40960);
                bf16x8 Sb[2][2]; Sb[0][0] = pack8(S0, 0); Sb[0][1] = pack8(S0, 1); Sb[1][0] = pack8(S1, 0); Sb[1][1] = pack8(S1, 1);
                bf16x8 fw[2][4], fq[2][4];
                f32x16 vn[2], o[2];
#pragma unroll
                for (int ct = 0; ct < 2; ++ct)
#pragma unroll
                    for (int k4 = 0; k4 < 4; ++k4) { fw[ct][k4] = lds_frag(Wm, 32 * ct + r32, k4 * 2 + hi); fq[ct][k4] = lds_frag(QGm, 32 * ct + r32, k4 * 2 + hi); }
#pragma unroll
                for (int ct = 0; ct < 2; ++ct)
#pragma unroll
                    for (int i = 0; i < 16; ++i) vn[ct][i] = bf2f(Um[(32 * ct + crow(i, hi)) * 64 + vbase + r32]);
                o[0] = f32x16{}; o[1] = f32x16{};
                __builtin_amdgcn_sched_barrier(0);
#pragma unroll
                for (int k4 = 0; k4 < 4; ++k4) {
                    vn[0] = MFMA32(fw[0][k4], Sb[k4 >> 1][k4 & 1], vn[0]); o[0] = MFMA32(fq[0][k4], Sb[k4 >> 1][k4 & 1], o[0]);
                    vn[1] = MFMA32(fw[1][k4], Sb[k4 >> 1][k4 & 1], vn[1]); o[1] = MFMA32(fq[1][k4], Sb[k4 >> 1][k4 & 1], o[1]);
                }
                __builtin_amdgcn_sched_barrier(0);
                bf16x8 fa[2][4], fk[2][4];
#pragma unroll
                for (int g = 0; g < 4; ++g) { fa[0][g] = lds_frag(AQm, r32, g * 2 + hi); fa[1][g] = lds_frag(AQm, 32 + r32, g * 2 + hi);
                                              fk[0][g] = lds_frag(KGm, r32, g * 2 + hi); fk[1][g] = lds_frag(KGm, 32 + r32, g * 2 + hi); }
#pragma unroll
                for (int i = 0; i < 16; ++i) { S0[i] *= gl; S1[i] *= gl; }
                __builtin_amdgcn_sched_barrier(0);
                bf16x8 Vb[2][2]; Vb[0][0] = pack8(vn[0], 0); Vb[0][1] = pack8(vn[0], 1); Vb[1][0] = pack8(vn[1], 0); Vb[1][1] = pack8(vn[1], 1);
#pragma unroll
                for (int g = 0; g < 4; ++g) {
                    o[0] = MFMA32(fa[0][g], Vb[g >> 1][g & 1], o[0]); S0 = MFMA32(fk[0][g], Vb[g >> 1][g & 1], S0);
                    o[1] = MFMA32(fa[1][g], Vb[g >> 1][g & 1], o[1]); S1 = MFMA32(fk[1][g], Vb[g >> 1][g & 1], S1);
                }
                LAS bf16_t* ob = (LAS bf16_t*)(lds + GS_OBUF + (n & 1) * 8192);
#pragma unroll
                for (int ct = 0; ct < 2; ++ct)
#pragma unroll
                    for (int i = 0; i < 16; ++i) ob[(32 * ct + crow(i, hi)) * 64 + vbase + r32] = (bf16_t)f2bf(o[ct][i]);
            }
        }
        BAR_LDS();
        stg = stg + 1 >= GS_NSTAGE ? 0 : stg + 1;
    }
    } else if (wave < 4) {
    for (int n = 0; n <= NCHUNK; n += 2) {
        GS_POST(n, zqA);     if (n + 1 < NCHUNK) { GS_ZLOADX(zqA, n + 1); } BAR_LDS();
        GS_POST((n + 1), zqB); if (n + 2 < NCHUNK) { GS_ZLOADX(zqB, n + 2); } BAR_LDS();
    }
    } else {
    int stg = 0;
    for (int n = 0; n <= NCHUNK; ++n) {
        {
            if (n + 2 < NCHUNK) { const int s2_ = stg + 2 >= GS_NSTAGE ? stg + 2 - GS_NSTAGE : stg + 2; GS_DMA(n + 2, s2_); asm volatile("s_waitcnt vmcnt(11)" ::: "memory"); }
            else asm volatile("s_waitcnt vmcnt(0)" ::: "memory");
        }
        BAR_LDS();
        stg = stg + 1 >= GS_NSTAGE ? 0 : stg + 1;
    }
    }
#undef GS_DMA
#undef GS_ZLOADX
}
#define XB_TMO      128
#define XB_XCNT(j)  (256  + 64 * (j))
#define XB_XSUB(j)  (1280 + 64 * (j))
#define XB_XGEN(j)  (2304 + 64 * (j))
#define XB_TOP      3328
#define XB_TOPGEN   3392
#define XCD_BAR_WORDS 3456
#define XB_SPIN_CAP (1u << 18)

__device__ __forceinline__ unsigned xb_ld(unsigned* p)              { return __hip_atomic_load(p, __ATOMIC_RELAXED, __HIP_MEMORY_SCOPE_AGENT); }
__device__ __forceinline__ unsigned xb_add(unsigned* p, unsigned v) { return __hip_atomic_fetch_add(p, v, __ATOMIC_RELAXED, __HIP_MEMORY_SCOPE_AGENT); }
__device__ __forceinline__ unsigned xb_xcc_id() { return (unsigned)__builtin_amdgcn_s_getreg((3 << 11) | 20) & 0xFu; }
#define XB_SPIN(cond, bar) do { unsigned _sp = 0; while (cond) { __builtin_amdgcn_s_sleep(1); \
    if ((++_sp & 255u) == 0u) { if (xb_ld(&(bar)[XB_TMO])) break; if (_sp > XB_SPIN_CAP) { atomicAdd(&(bar)[XB_TMO], 1u); break; } } } } while (0)

struct XcdBarrier {
    unsigned* bar; unsigned x;
    volatile LAS unsigned* st;
};

__device__ __forceinline__ XcdBarrier xcd_barrier_post(unsigned* bar, volatile LAS unsigned* st) {
    XcdBarrier b; b.bar = bar; b.x = xb_xcc_id(); b.st = st;
    if (threadIdx.x == 0) (void)xb_add(&bar[XB_XCNT(b.x)], 1u);
    return b;
}
__device__ __forceinline__ void xcd_barrier_complete(unsigned* bar, unsigned x, unsigned& nloc, unsigned& nx) {
    const unsigned G = gridDim.x * gridDim.y * gridDim.z;
    unsigned sum, cnt, mine, sp = 0u;
    for (;;) {
        sum = 0u; cnt = 0u; mine = 0u;
#pragma unroll
        for (unsigned j = 0; j < 16; ++j) { const unsigned c = xb_ld(&bar[XB_XCNT(j)]); sum += c; cnt += (c > 0u) ? 1u : 0u; mine = (j == x) ? c : mine; }
        if (sum == G) break;
        __builtin_amdgcn_s_sleep(1);
        if ((++sp & 255u) == 0u) { if (xb_ld(&bar[XB_TMO])) break; if (sp > XB_SPIN_CAP) { atomicAdd(&bar[XB_TMO], 1u); break; } }
    }
    nloc = mine > 0u ? mine : 1u; nx = cnt > 0u ? cnt : 1u;
}

__device__ __forceinline__ void xcd_barrier(const XcdBarrier& b) {
    asm volatile("s_waitcnt vmcnt(0)" ::: "memory");
    __syncthreads();
    if (threadIdx.x == 0) {
        unsigned* bar = b.bar;
        __builtin_amdgcn_s_waitcnt(0);
        unsigned nloc = b.st[0], nx = b.st[1];
        if (nloc == 0u) { xcd_barrier_complete(bar, b.x, nloc, nx); b.st[0] = nloc; b.st[1] = nx; }
        const unsigned old = xb_add(&bar[XB_XSUB(b.x)], 1u);
        const unsigned gen = old / nloc;
        if (old + 1u == (gen + 1u) * nloc) {
            __builtin_amdgcn_fence(__ATOMIC_RELEASE, "agent");
            asm volatile("s_waitcnt vmcnt(0)" ::: "memory");
            const unsigned og = xb_add(&bar[XB_TOP], 1u);
            const unsigned tg = og / nx;
            if (og + 1u == (tg + 1u) * nx) xb_add(&bar[XB_TOPGEN], 1u);
            else XB_SPIN(xb_ld(&bar[XB_TOPGEN]) == tg, bar);
            __builtin_amdgcn_fence(__ATOMIC_ACQUIRE, "agent");
            xb_add(&bar[XB_XGEN(b.x)], 1u);
            asm volatile("s_waitcnt vmcnt(0)" ::: "memory");
        } else {
            XB_SPIN(xb_ld(&bar[XB_XGEN(b.x)]) == gen, bar);
            __builtin_amdgcn_fence(__ATOMIC_ACQUIRE, "agent");
            asm volatile("s_waitcnt vmcnt(0)" ::: "memory");
        }
    }
    __syncthreads();
}


constexpr int AT_STAGE = 32768;
constexpr int AT_NSTAGE = 3;
constexpr int AT_XBUF = 0;
constexpr int AT_WSF = AT_NSTAGE * AT_STAGE;
constexpr int AT_UNIT = AT_WSF + 2048;
constexpr float AT_THR = 8.0f;

DI float max3f(float a, float b, float c) { return __builtin_fmaxf(__builtin_fmaxf(a, b), c); }
DI s16x4 tr_read(LAS const unsigned char* p) { return __builtin_bit_cast(s16x4, __builtin_amdgcn_ds_read_tr16_b64_v4i16((LAS v4i16_t*)p)); }

template <int VAR> DI void attn_unit(const Params& P, LAS unsigned char* lds, int bh, int qi, int tid, int wave, int lane, float lam) {
    const int b = bh >> 2, h = bh & 3, r32 = lane & 31, hi = lane >> 5, qsub = wave >> 1, map = wave & 1, hh = 2 * h + map;
    const bf16_t* QB = (const bf16_t*)(P.ws + WS_QB); const bf16_t* KT = (const bf16_t*)(P.ws + WS_KT); const bf16_t* VT = (const bf16_t*)(P.ws + WS_VT);
    const int ntiles = 2 * qi + 3, my_nt = (qsub < 2) ? ntiles - 1 : ntiles;
    const bf16_t* k1 = KT + ((size_t)((b * 8 + 2 * h) * NKT) << 12) + tid * 8;
    const bf16_t* k2 = KT + ((size_t)((b * 8 + 2 * h + 1) * NKT) << 12) + tid * 8;
    const bf16_t* vv = VT + ((size_t)((b * 4 + h) * NKT) << 13) + tid * 8;
#define AT_DMA(t, sb) do { LAS unsigned char* d_ = lds + (sb) * AT_STAGE + wave * 1024; \
        __builtin_amdgcn_global_load_lds((const unsigned*)(k1 + ((size_t)(t) << 12)), (LAS unsigned*)d_, 16, 0, 0); \
        __builtin_amdgcn_global_load_lds((const unsigned*)(k2 + ((size_t)(t) << 12)), (LAS unsigned*)(d_ + 8192), 16, 0, 0); \
        __builtin_amdgcn_global_load_lds((const unsigned*)(vv + ((size_t)(t) << 13)), (LAS unsigned*)(d_ + 16384), 16, 0, 0); \
        __builtin_amdgcn_global_load_lds((const unsigned*)(vv + ((size_t)(t) << 13) + 4096), (LAS unsigned*)(d_ + 24576), 16, 0, 0); } while (0)
    bf16x8 qr[4];
    { const bf16_t* q = QB + ((size_t)((b * 8 + hh) * SEQ + qi * 128 + qsub * 32 + r32) << 6) + hi * 8;
#pragma unroll
      for (int d0 = 0; d0 < 4; ++d0) qr[d0] = *(const bf16x8*)(q + d0 * 16); }
    asm volatile("s_waitcnt vmcnt(0)" : "+v"(qr[0]), "+v"(qr[1]), "+v"(qr[2]), "+v"(qr[3]) :: "memory");
    AT_DMA(0, 0);
    if (ntiles > 1) AT_DMA(1, 1);
    if (ntiles > 1) asm volatile("s_waitcnt vmcnt(4)" ::: "memory"); else asm volatile("s_waitcnt vmcnt(0)" ::: "memory");
    BAR_LDS();
    LAS float* wsf = (LAS float*)(lds + AT_WSF) + wave * 64;
    float m_run = 0.f, l_run = 0.f;
    f32x16 negm = {};
    f32x16 o[4]; o[0] = f32x16{}; o[1] = f32x16{}; o[2] = f32x16{}; o[3] = f32x16{};
    for (int t = 0; t < ntiles; ++t) {
        if (t + 2 < ntiles) AT_DMA(t + 2, (t + 2) % AT_NSTAGE);
        if (t < my_nt) {
            LAS const unsigned char* sg = lds + (t % AT_NSTAGE) * AT_STAGE;
            LAS const unsigned char* kb = sg + map * 8192 + hi * 1024 + r32 * 16;
            f32x16 p0 = negm, p1 = negm;
            bf16x8 kf[8];
#pragma unroll
            for (int d0 = 0; d0 < 4; ++d0) { kf[2 * d0] = *(LAS const bf16x8*)(kb + d0 * 2048); kf[2 * d0 + 1] = *(LAS const bf16x8*)(kb + d0 * 2048 + 512); }
            __builtin_amdgcn_sched_barrier(0);
            __builtin_amdgcn_s_setprio(1);
#pragma unroll
            for (int d0 = 0; d0 < 4; ++d0) { p0 = MFMA32(kf[2 * d0], qr[d0], p0); p1 = MFMA32(kf[2 * d0 + 1], qr[d0], p1); }
            __builtin_amdgcn_s_setprio(0);
            const bool first = (t == 0);
            if (first) {
#pragma unroll
                for (int r = 0; r < 16; ++r) { if (crow(r, hi) >= NMETA) p0[r] = -INFINITY; p1[r] = -INFINITY; }
            }
            float ma = max3f(p0[0], p0[1], p1[0]), mb = max3f(p0[2], p0[3], p1[1]); ma = max3f(ma, p1[2], p1[3]);
#pragma unroll
            for (int r = 4; r < 16; r += 4) { ma = max3f(ma, p0[r], p0[r + 1]); mb = max3f(mb, p0[r + 2], p0[r + 3]); ma = max3f(ma, p1[r], p1[r + 1]); mb = max3f(mb, p1[r + 2], p1[r + 3]); }
            const float rm = swap32_max(max3f(ma, mb, mb));
            if (first || __any(rm > AT_THR)) {
                const float dl = first ? rm : fmaxf(rm, 0.f);
                m_run += dl;
#pragma unroll
                for (int r = 0; r < 16; ++r) { p0[r] -= dl; p1[r] -= dl; negm[r] = -m_run; }
                const float alpha = __builtin_amdgcn_exp2f(-dl);
                l_run *= alpha;
                if (!first) {
                    if (hi == 0) wsf[r32] = alpha;
                    LDS_WAIT();
#pragma unroll
                    for (int r = 0; r < 16; ++r) { const float a = wsf[crow(r, hi)];
#pragma unroll
                        for (int d0 = 0; d0 < 4; ++d0) o[d0][r] *= a; }
                    LDS_WAIT();
                }
            }
            float ls0 = 0.f, ls1 = 0.f;
#pragma unroll
            for (int r = 0; r < 16; ++r) { if (VAR != 2) { p0[r] = __builtin_amdgcn_exp2f(p0[r]); p1[r] = __builtin_amdgcn_exp2f(p1[r]); } ls0 += p0[r]; ls1 += p1[r]; }
            l_run += ls0 + ls1;
            const bf16x8 pa0 = pack8(p0, 0), pa1 = pack8(p0, 1), pa2 = pack8(p1, 0), pa3 = pack8(p1, 1);
            LAS const unsigned char* vb = sg + 16384 + ((lane >> 4) & 1) * 32 + (lane & 3) * 8 + (4 * hi + ((lane & 15) >> 2)) * 64;
            s16x4 va_[8], vb_[8];
            const unsigned vba = (unsigned)(uintptr_t)vb;
#define AT_VLD(V, d0_) do { _Pragma("unroll") for (int ks = 0; ks < 4; ++ks) { \
                asm volatile("ds_read_b64_tr_b16 %0, %1 offset:%c2" : "=v"(V[2 * ks]) : "v"(vba), "i"((d0_) * 4096 + ks * 1024)); \
                asm volatile("ds_read_b64_tr_b16 %0, %1 offset:%c2" : "=v"(V[2 * ks + 1]) : "v"(vba), "i"((d0_) * 4096 + ks * 1024 + 512)); } } while (0)
#define AT_VF(V, ks) ((bf16x8){V[2 * (ks)][0], V[2 * (ks)][1], V[2 * (ks)][2], V[2 * (ks)][3], V[2 * (ks) + 1][0], V[2 * (ks) + 1][1], V[2 * (ks) + 1][2], V[2 * (ks) + 1][3]})
#define AT_WAITL(n, V) do { asm volatile("s_waitcnt lgkmcnt(" #n ")" : "+v"(V[0]), "+v"(V[1]), "+v"(V[2]), "+v"(V[3]), "+v"(V[4]), "+v"(V[5]), "+v"(V[6]), "+v"(V[7])); __builtin_amdgcn_sched_barrier(0); } while (0)
#define AT_PV(V, d0_) do { __builtin_amdgcn_s_setprio(1); o[d0_] = MFMA32(pa0, AT_VF(V, 0), o[d0_]); o[d0_] = MFMA32(pa1, AT_VF(V, 1), o[d0_]); o[d0_] = MFMA32(pa2, AT_VF(V, 2), o[d0_]); o[d0_] = MFMA32(pa3, AT_VF(V, 3), o[d0_]); __builtin_amdgcn_s_setprio(0); } while (0)
            if (VAR != 1) {
            asm volatile("s_waitcnt lgkmcnt(0)" ::: "memory"); __builtin_amdgcn_sched_barrier(0);
            AT_VLD(va_, 0); AT_VLD(vb_, 1);
            AT_WAITL(8, va_); AT_PV(va_, 0); __builtin_amdgcn_sched_barrier(0); AT_VLD(va_, 2);
            AT_WAITL(8, vb_); AT_PV(vb_, 1); __builtin_amdgcn_sched_barrier(0); AT_VLD(vb_, 3);
            AT_WAITL(8, va_); AT_PV(va_, 2); __builtin_amdgcn_sched_barrier(0);
            AT_WAITL(0, vb_); AT_PV(vb_, 3);
            } else { o[0][0] += (float)pa0[0] + (float)pa1[1] + (float)pa2[2] + (float)pa3[3]; }
#undef AT_VF
#undef AT_WAITL
#undef AT_VLD
#undef AT_PV
        }
        if (t + 2 < ntiles) asm volatile("s_waitcnt vmcnt(4)" ::: "memory"); else asm volatile("s_waitcnt vmcnt(0)" ::: "memory");
        BAR_LDS();
    }
    if (VAR != 0) { if (o[0][0] + o[1][1] + o[2][2] + o[3][3] + l_run == 123.456f) ((float*)(P.ws + WS_DUMP))[tid] = 1.f; __syncthreads(); return; }
    l_run = swap32_add(l_run);
    const float sc = (map ? lam : 1.0f) / l_run;
    if (hi == 0) wsf[r32] = sc;
    LDS_WAIT();
#pragma unroll
    for (int r = 0; r < 16; ++r) { const float a = wsf[crow(r, hi)];
#pragma unroll
        for (int d0 = 0; d0 < 4; ++d0) o[d0][r] *= a; }
    LAS float* xb = (LAS float*)(lds + AT_XBUF + qsub * 16384);
    if (map) {
#pragma unroll
        for (int d0 = 0; d0 < 4; ++d0)
#pragma unroll
            for (int r = 0; r < 16; ++r) xb[(d0 * 16 + r) * 64 + lane] = o[d0][r];
    }
    __syncthreads();
    if (!map) {
        const float* dn = P.in[8];
        bf16_t* MIX = (bf16_t*)(P.ws + WS_MIX);
        float ss[16];
#pragma unroll
        for (int r = 0; r < 16; ++r) { ss[r] = 0.f;
#pragma unroll
            for (int d0 = 0; d0 < 4; ++d0) { o[d0][r] -= xb[(d0 * 16 + r) * 64 + lane]; ss[r] += o[d0][r] * o[d0][r]; } }
#pragma unroll
        for (int r = 0; r < 16; ++r) {
            ss[r] = half_sum32(ss[r]);
            ss[r] = 0.8f / sqrtf(ss[r] * (1.0f / 128.0f) + EPS);
        }
        float dg[4];
#pragma unroll
        for (int d0 = 0; d0 < 4; ++d0) dg[d0] = dn[32 * d0 + r32];
#pragma unroll
        for (int r = 0; r < 16; ++r) {
            bf16_t* orow = MIX + (size_t)(b * SEQ + qi * 128 + qsub * 32 + crow(r, hi)) * 1024 + h * 128 + r32;
#pragma unroll
            for (int d0 = 0; d0 < 4; ++d0) orow[32 * d0] = (bf16_t)f2bf(o[d0][r] * ss[r] * dg[d0]);
        }
    }
    __syncthreads();
#undef AT_DMA
}

template <int VAR> DI void attn_phase(const Params& P, LAS unsigned char* lds, int tid, int wave, int lane) {
    unsigned* ctl = (unsigned*)(P.ws + WS_CTL);
    const float* lq1 = P.in[4]; const float* lk1 = P.in[5]; const float* lq2 = P.in[6]; const float* lk2 = P.in[7];
    const float lam = __expf(wave_sum(lq1[lane] * lk1[lane])) - __expf(wave_sum(lq2[lane] * lk2[lane])) + 0.2f;
    LAS volatile int* ub = (LAS volatile int*)(lds + AT_UNIT);
    const unsigned x0 = xb_xcc_id() & 7u;
    for (;;) {
        if (tid == 0) {
            int u = -1;
            for (unsigned j = 0; j < 8u && u < 0; ++j) { const unsigned x = (x0 + j) & 7u;
                if (__hip_atomic_load(ctl + CW_ATTQ + 64 * x, __ATOMIC_RELAXED, __HIP_MEMORY_SCOPE_AGENT) >= 64u) continue;
                const unsigned i = __hip_atomic_fetch_add(ctl + CW_ATTQ + 64 * x, 1u, __ATOMIC_RELAXED, __HIP_MEMORY_SCOPE_AGENT);
                if (i < 64u) u = (int)(x * 64u + i); }
            *ub = u;
        }
        __syncthreads();
        const int u = *ub;
        __syncthreads();
        if (u < 0) break;
        attn_unit<VAR>(P, lds, u >> 6, 63 - (u & 63), tid, wave, lane, lam);
    }
}

struct EpiOutProj {
    static constexpr bool PERM = false, AFTER_DRAIN = false;
    const float* x; float* out; bf16_t* u2;
    DI void operator()(const pg8::f32x4 (&acc)[2][2][4][2], const pg8::Unit& u, int wr, int wc, int fr, int fq) const {
        const int row0 = u.pm * 256 + wr * 64 + fr, col0 = u.pn * 256 + wc * 32 + 4 * fq;
#pragma unroll
        for (int ai = 0; ai < 2; ++ai) {
            f32x4 xv[4][2][2];
#pragma unroll
            for (int m = 0; m < 4; ++m) { const size_t off = (size_t)(row0 + ai * 128 + m * 16) * 1024 + col0;
#pragma unroll
                for (int bj = 0; bj < 2; ++bj)
#pragma unroll
                    for (int n = 0; n < 2; ++n) xv[m][bj][n] = *(const f32x4*)(x + off + bj * 128 + n * 16); }
#pragma unroll
            for (int m = 0; m < 4; ++m) { const size_t off = (size_t)(row0 + ai * 128 + m * 16) * 1024 + col0;
#pragma unroll
                for (int bj = 0; bj < 2; ++bj)
#pragma unroll
                    for (int n = 0; n < 2; ++n) { const f32x4 hv = acc[ai][bj][m][n] + xv[m][bj][n]; *(f32x4*)(out + off + bj * 128 + n * 16) = hv;
                        *(u32x2*)(u2 + off + bj * 128 + n * 16) = (u32x2){pk2(hv[0], hv[1]), pk2(hv[2], hv[3])}; } }
        }
    }
};

typedef float f32x4v __attribute__((ext_vector_type(4)));
#ifdef ROUTE_PROBE
#define ROUTE_MID_HOOK() do { XcdBarrier xb2; xb2.bar = (unsigned*)(P.ws + WS_CTL) + CW_BAR; xb2.x = xb_xcc_id(); xb2.st = (volatile LAS unsigned*)(ldsb + LDS_BYTES - 64); xcd_barrier(xb2); \
    if (blockIdx.x == 0 && threadIdx.x == 0) __hip_atomic_store((unsigned long long*)(P.ws + WS_CTL + 65536) + 20, (unsigned long long)__builtin_amdgcn_s_memrealtime(), __ATOMIC_RELAXED, __HIP_MEMORY_SCOPE_AGENT); } while (0)
#else
#define ROUTE_MID_HOOK() do {} while (0)
#endif
DI void route_tile(const Params& P, int tile, int par, LAS float* sc  , int lane, LAS unsigned char* ldsb) {
    const float* h2 = P.out; const float* WR = (const float*)(P.ws + WS_WR);
    const int r16 = lane & 15, kq = lane >> 4;
    const float* arow = h2 + (size_t)(tile * 16 + r16) * 1024 + par * 512 + kq * 8;
    const float* b0 = WR + (size_t)r16 * 1024 + par * 512 + kq * 8; const float* b1 = b0 + 16 * 1024; const float* b2 = WR + (size_t)(32 + (r16 & 3)) * 1024 + par * 512 + kq * 8;
    const float z2 = (r16 < 4) ? 1.0f : 0.0f;
    f32x4v c0 = {}, c1 = {}, c2 = {};
    float ss = 0.f;
    f32x4 bA[4][4], bB[4][4];
#define RT_LOAD(B, tb) do { _Pragma("unroll") for (int j = 0; j < 4; ++j) { const int o_ = 32 * ((tb) + (j >> 1)) + 4 * (j & 1); \
        B[j][0] = *(const f32x4*)(arow + o_); B[j][1] = *(const f32x4*)(b0 + o_); B[j][2] = *(const f32x4*)(b1 + o_); B[j][3] = *(const f32x4*)(b2 + o_); } } while (0)
#define RT_COMP(B) do { _Pragma("unroll") for (int j = 0; j < 4; ++j) { const f32x4 a = B[j][0]; ss += (a.x * a.x + a.y * a.y) + (a.z * a.z + a.w * a.w); \
        _Pragma("unroll") for (int i = 0; i < 4; ++i) { c0 = __builtin_amdgcn_mfma_f32_16x16x4f32(a[i], B[j][1][i], c0, 0, 0, 0); \
            c1 = __builtin_amdgcn_mfma_f32_16x16x4f32(a[i], B[j][2][i], c1, 0, 0, 0); c2 = __builtin_amdgcn_mfma_f32_16x16x4f32(a[i], B[j][3][i] * z2, c2, 0, 0, 0); } } } while (0)
    RT_LOAD(bA, 0);
#pragma unroll
    for (int tb = 0; tb < 16; tb += 4) {
        RT_LOAD(bB, tb + 2); __builtin_amdgcn_sched_barrier(0); RT_COMP(bA); __builtin_amdgcn_sched_barrier(0);
        if (tb + 4 < 16) { RT_LOAD(bA, tb + 4); } __builtin_amdgcn_sched_barrier(0); RT_COMP(bB); __builtin_amdgcn_sched_barrier(0); }
#undef RT_LOAD
#undef RT_COMP
    ss += swz_xor16(ss); ss = swap32_add(ss);
    LAS float* my = sc + par * 800;
#pragma unroll
    for (int r = 0; r < 4; ++r) { const int row = 4 * kq + r; my[row * 48 + r16] = c0[r]; my[row * 48 + 16 + r16] = c1[r]; my[row * 48 + 32 + r16] = c2[r]; }
    if (lane < 16) my[768 + lane] = ss;
    LAS int* lcnt = (LAS int*)(ldsb + 4 * 32768 + 1024);
    if (threadIdx.x < 32) lcnt[threadIdx.x] = 0;
    int pa = 0, pb = 0, ea_ = 0, eb_ = 0; float w1_ = 0.f, w2_ = 0.f, rs_ = 0.f;
    LDS_WAIT();
    __syncthreads();
    ROUTE_MID_HOOK();
    if (par == 0 && lane < 16) {
        LAS const float* l0 = sc + lane * 48; LAS const float* l1 = sc + 800 + lane * 48;
        const float rs = __builtin_amdgcn_rsqf((sc[768 + lane] + sc[800 + 768 + lane]) * (1.0f / 1024.0f) + EPS);
#define LG(j) (l0[j] + l1[j])
        const int t = tile * 16 + lane;
        const float* bg = P.in[16]; const float* br = P.in[18];
        float gl[4]; int gs = 0; float gm;
#pragma unroll
        for (int j = 0; j < 4; ++j) gl[j] = LG(j) * rs + bg[j];
        gm = gl[0];
#pragma unroll
        for (int j = 1; j < 4; ++j) if (gl[j] > gm) { gm = gl[j]; gs = j; }
        float gsum = 0.f;
#pragma unroll
        for (int j = 0; j < 4; ++j) gsum += __expf(gl[j] - gm);
        const float psel = 1.0f / gsum;
        float e1 = -INFINITY, e2 = -INFINITY; int i1 = 0, i2 = 0;
#pragma unroll
        for (int j = 0; j < 8; ++j) {
            const float v = LG(4 + gs * 8 + j) * rs + br[gs * 8 + j];
            if (v > e1) { e2 = e1; i2 = i1; e1 = v; i1 = j; } else if (v > e2) { e2 = v; i2 = j; }
        }
        const float x2 = __expf(e2 - e1), w1 = psel / (1.0f + x2), w2 = psel * x2 / (1.0f + x2);
        const int ea = gs * 8 + i1, eb = gs * 8 + i2;
        pa = (int)__hip_atomic_fetch_add(lcnt + ea, 1, __ATOMIC_RELAXED, __HIP_MEMORY_SCOPE_WORKGROUP); pb = (int)__hip_atomic_fetch_add(lcnt + eb, 1, __ATOMIC_RELAXED, __HIP_MEMORY_SCOPE_WORKGROUP);
        ea_ = ea; eb_ = eb; w1_ = w1; w2_ = w2; rs_ = rs;
        ((int*)(P.ws + WS_TOKE))[2 * t] = ea; ((int*)(P.ws + WS_TOKE))[2 * t + 1] = eb;
        ((float*)(P.ws + WS_TOKW))[2 * t] = w1; ((float*)(P.ws + WS_TOKW))[2 * t + 1] = w2;
        ((float*)(P.ws + WS_RS2))[t] = rs;
#undef LG
    }
    LDS_WAIT();
    __syncthreads();
    if (threadIdx.x < 32) { const int c = lcnt[threadIdx.x];
        lcnt[32 + threadIdx.x] = c ? (int)atomicAdd((unsigned*)(P.ws + WS_CTL) + CW_CNT + 64 * threadIdx.x, (unsigned)c) : 0; }
    LDS_WAIT();
    __syncthreads();
    if (par == 0 && lane < 16) { const int t = tile * 16 + lane;
        const int qa = lcnt[32 + ea_] + pa, qb = lcnt[32 + eb_] + pb;
        ((int*)(P.ws + WS_TOKP))[2 * t] = qa; ((int*)(P.ws + WS_TOKP))[2 * t + 1] = qb;
        ((int*)(P.ws + WS_LIST))[ea_ * 16384 + qa] = t; ((int*)(P.ws + WS_LIST))[eb_ * 16384 + qb] = t;
        ((float*)(P.ws + WS_LISTW))[ea_ * 16384 + qa] = w1_; ((float*)(P.ws + WS_LISTW))[eb_ * 16384 + qb] = w2_;
        ((float*)(P.ws + WS_LISTRS))[ea_ * 16384 + qa] = rs_; ((float*)(P.ws + WS_LISTRS))[eb_ * 16384 + qb] = rs_; }
    LDS_WAIT();
    __syncthreads();
}

#ifndef P4A_REP
#define P4A_REP 0
#endif
template <int P4A_PART> DI void phase4a(const Params& P, LAS unsigned char* lds, int gw, int NGW, int wave, int lane) {
    LAS float* scr = (LAS float*)(lds + wave * 16384);
    if (P4A_PART & 1) for (int tile = (gw >> 1); tile < MTOK / 16; tile += (NGW >> 1)) route_tile(P, tile, wave & 1, (LAS float*)(lds + (wave >> 1) * 32768), lane, lds);
    if (!(P4A_PART & 2)) return;
    bf16_t* WGU = (bf16_t*)(P.ws + WS_WGU); bf16_t* WD = (bf16_t*)(P.ws + WS_WD);
    const float* wg = P.in[19]; const float* wu = P.in[20]; const float* wd = P.in[21]; const float* gf = P.in[14];
    constexpr int I_GU = 16 * 16, I_D = 4 * 32, NIT = 32 * (I_GU + I_D);
    struct TItem { const float* src; const float* gn; bf16_t* dst; int stride, ldk; };
    auto mk = [&](int it) { TItem d; const int e = it / (I_GU + I_D), r = it % (I_GU + I_D);
        if (r < I_GU) { const int n0 = (r & 15) * 32, j = n0 >> 8, up = (n0 >> 7) & 1, k0 = (r >> 4) * 64;
            d.src = (up ? wu : wg) + (size_t)e * 1024 * 256 + (size_t)k0 * 256 + 128 * j + (n0 & 127); d.gn = gf + k0; d.stride = 256; d.ldk = 1024;
            d.dst = WGU + (size_t)e * 512 * 1024 + (size_t)n0 * 1024 + k0; }
        else { const int r2 = r - I_GU, k0 = (r2 >> 5) * 64, n0 = (r2 & 31) * 32;
            d.src = wd + (size_t)e * 256 * 1024 + (size_t)k0 * 1024 + n0; d.gn = nullptr; d.stride = 1024; d.ldk = 256;
            d.dst = WD + (size_t)e * 1024 * 256 + (size_t)n0 * 256 + k0; }
        return d; };
#define TI_LOAD(D, V) do { _Pragma("unroll") for (int i = 0; i < 32; ++i) { const int kk = 2 * i + (lane >> 5); \
        V[i] = D.src[(size_t)kk * D.stride + (lane & 31)] * (D.gn ? D.gn[kk] : 1.0f); } } while (0)
#define TI_FIN(D, V) do { _Pragma("unroll") for (int i = 0; i < 32; ++i) scr[(2 * i + (lane >> 5)) * 33 + (lane & 31)] = V[i]; \
        LDS_WAIT(); const int c_ = lane & 7; \
        _Pragma("unroll") for (int j = 0; j < 4; ++j) { const int n_ = (lane >> 3) + 8 * j; const LAS float* s_ = scr + (8 * c_) * 33 + n_; \
            u32x4 o_; o_.x = pk2(s_[0 * 33], s_[1 * 33]); o_.y = pk2(s_[2 * 33], s_[3 * 33]); o_.z = pk2(s_[4 * 33], s_[5 * 33]); o_.w = pk2(s_[6 * 33], s_[7 * 33]); \
            *(u32x4*)(D.dst + (size_t)n_ * D.ldk + 8 * c_) = o_; } \
        LDS_WAIT(); } while (0)
    for (int rp_ = 0; rp_ < (P4A_REP ? 2 : 1); ++rp_) {
        float va[32], vb[32];
        int it = gw;
        if (it < NIT) { TItem da = mk(it); TI_LOAD(da, va);
            for (;;) {
                const int itb = it + NGW; TItem db = da; const bool hb = itb < NIT;
                if (hb) { db = mk(itb); TI_LOAD(db, vb); }
                TI_FIN(da, va);
                if (!hb) break;
                it = itb + NGW; const bool ha = it < NIT;
                if (ha) { da = mk(it); TI_LOAD(da, va); }
                TI_FIN(db, vb);
                if (!ha) break;
            }
        }
    }
#undef TI_LOAD
#undef TI_FIN
}

DI void expert_layout(const Params& P, int lane, int& cnt, int& base, int& tend) {
    const unsigned* c = (const unsigned*)(P.ws + WS_CTL) + CW_CNT;
    cnt = (lane < 32) ? (int)__hip_atomic_load(c + 64 * lane, __ATOMIC_RELAXED, __HIP_MEMORY_SCOPE_AGENT) : 0;
    const int tiles = (cnt + 255) >> 8;
    int inc = 0;
#pragma unroll
    for (int i = 0; i < 32; ++i) { const int ti = __builtin_amdgcn_readlane(tiles, i); inc += (i <= lane) ? ti : 0; }
    tend = inc; base = (inc - tiles) << 8;
}

DI void phase4b(const Params& P, int gw, int NGW, int lane) {
    int cnt, base, tend; expert_layout(P, lane, cnt, base, tend);
    bf16_t* XS = (bf16_t*)(P.ws + WS_XS); float* SLOTW = (float*)(P.ws + WS_SLOTW);
    const int* TOKE = (const int*)(P.ws + WS_TOKE); const float* TOKW = (const float*)(P.ws + WS_TOKW); int* TOKP = (int*)(P.ws + WS_TOKP); const float* RS2 = (const float*)(P.ws + WS_RS2);
    for (int t = gw; t < MTOK; t += NGW) {
        const f32x4* hr = (const f32x4*)(P.out + (size_t)t * 1024);
        const float rs = RS2[t];
        u32x2 w[4];
#pragma unroll
        for (int j = 0; j < 4; ++j) { const f32x4 v = hr[64 * j + lane]; w[j] = (u32x2){pk2(v.x * rs, v.y * rs), pk2(v.z * rs, v.w * rs)}; }
#pragma unroll
        for (int k = 0; k < 2; ++k) {
            const int e = __builtin_amdgcn_readfirstlane(TOKE[2 * t + k]), slot = __builtin_amdgcn_readlane(base, e) + TOKP[2 * t + k];
            u32x2* orow = (u32x2*)(XS + (size_t)slot * 1024);
#pragma unroll
            for (int j = 0; j < 4; ++j) orow[64 * j + lane] = w[j];
            if (lane == 0) { SLOTW[slot] = TOKW[2 * t + k]; TOKP[2 * t + k] = slot; }
        }
    }
    for (int e = 0; e < 32; ++e) {
        const int ce = __builtin_amdgcn_readlane(cnt, e), be = __builtin_amdgcn_readlane(base, e), end = be + (((ce + 255) >> 8) << 8);
        for (int r = be + ce + gw; r < end; r += NGW) { u32x2* orow = (u32x2*)(XS + (size_t)r * 1024);
#pragma unroll
            for (int j = 0; j < 4; ++j) orow[64 * j + lane] = (u32x2){0u, 0u};
            if (lane == 0) SLOTW[r] = 0.f; }
    }
}

struct GroupedOrder {
    int tend; int total; int G, c, NS; int cnt, base; const int* LIST;
    DI unsigned rowoff(const pg8::Unit& u, int r) const {
        const int e = __builtin_amdgcn_readfirstlane(u.pn >> NS), ce = __builtin_amdgcn_readlane(cnt, e), t0 = __builtin_amdgcn_readlane(base, e) >> 8;
        const int pos = (u.pm - t0) * 256 + r;
        const int tok = pos < ce ? LIST[e * 16384 + pos] : 0;
        return (unsigned)tok * 2048u;
    }
    DI bool next(int i, pg8::Unit& u) const {
        const int L = i * G + c; if (L >= (total << NS)) return false;
        const int mt = L >> NS, j = L & ((1 << NS) - 1);
        const int e = __builtin_popcountll(__ballot(((int)(threadIdx.x & 63) < 32) && tend <= mt));
        u.pm = mt; u.pn = (e << NS) + j; return true;
    }
    DI void a_ready(const pg8::Unit&) const {}
    DI void done(const pg8::Unit&) const {}
};
struct EpiGateUp {
    static constexpr bool PERM = true, AFTER_DRAIN = false;
    const float* LISTW; const float* LISTRS; bf16_t* YS; int cnt, base;
    DI void operator()(const pg8::f32x4 (&acc)[2][2][4][2], const pg8::Unit& u, int wr, int wc, int fr, int fq) const {
        const int f0 = (u.pn & 1) * 128 + wc * 32 + fq * 8;
        const int e = __builtin_amdgcn_readfirstlane(u.pn >> 1), ce = __builtin_amdgcn_readlane(cnt, e), t0 = __builtin_amdgcn_readlane(base, e) >> 8;
#pragma unroll
        for (int ai = 0; ai < 2; ++ai)
#pragma unroll
            for (int m = 0; m < 4; ++m) {
                const int r = ai * 128 + wr * 64 + m * 16 + fr, row = u.pm * 256 + r, pos = (u.pm - t0) * 256 + r;
                const bool ok = pos < ce;
                const float cw = ok ? LISTW[e * 16384 + pos] : 0.f, rs = ok ? LISTRS[e * 16384 + pos] : 0.f, cr = cw * rs;
                float a[8];
#pragma unroll
                for (int i = 0; i < 4; ++i) {
                    const float g0 = acc[ai][0][m][0][i] * rs, g1 = acc[ai][0][m][1][i] * rs;
                    a[i] = g0 * __builtin_amdgcn_rcpf(1.0f + __expf(-g0)) * acc[ai][1][m][0][i] * cr; a[4 + i] = g1 * __builtin_amdgcn_rcpf(1.0f + __expf(-g1)) * acc[ai][1][m][1][i] * cr;
                }
                *(u32x4*)(YS + (size_t)row * 256 + f0) = (u32x4){pk2(a[0], a[1]), pk2(a[2], a[3]), pk2(a[4], a[5]), pk2(a[6], a[7])};
            }
    }
};
struct EpiDown {
    static constexpr bool PERM = true, AFTER_DRAIN = false;
    bf16_t* YO;
    DI void operator()(const pg8::f32x4 (&acc)[2][2][4][2], const pg8::Unit& u, int wr, int wc, int fr, int fq) const {
        const int c0 = (u.pn & 3) * 256 + wc * 32 + fq * 8;
#pragma unroll
        for (int ai = 0; ai < 2; ++ai)
#pragma unroll
            for (int m = 0; m < 4; ++m) {
                bf16_t* rowp = YO + (size_t)(u.pm * 256 + ai * 128 + wr * 64 + m * 16 + fr) * 1024 + c0;
#pragma unroll
                for (int bj = 0; bj < 2; ++bj) { const pg8::f32x4 v0 = acc[ai][bj][m][0], v1 = acc[ai][bj][m][1];
                    *(u32x4*)(rowp + bj * 128) = (u32x4){pk2(v0[0], v0[1]), pk2(v0[2], v0[3]), pk2(v1[0], v1[1]), pk2(v1[2], v1[3])}; }
            }
    }
};

DI void phase7(const Params& P, int gw, int NGW, int lane) {
    int cnt_, base_, tend_; expert_layout(P, lane, cnt_, base_, tend_);
    const bf16_t* YO = (const bf16_t*)(P.ws + WS_YO); const int* TOKP = (const int*)(P.ws + WS_TOKP); const int* TOKE = (const int*)(P.ws + WS_TOKE); const f32x4* nf = (const f32x4*)P.in[22];
    f32x4 nfv[4];
#pragma unroll
    for (int j = 0; j < 4; ++j) nfv[j] = nf[64 * j + lane];
    for (int t0 = gw; t0 < MTOK; t0 += 2 * NGW) {
        f32x4 v[2][4]; u32x2 hv[2][4], ya[2][4], yb[2][4];
#pragma unroll
        for (int r = 0; r < 2; ++r) { const int t = (t0 + r * NGW) < MTOK ? (t0 + r * NGW) : t0;
            const u32x2* hr = (const u32x2*)((const bf16_t*)(P.ws + WS_U2) + (size_t)t * 1024);
            const int e0 = __builtin_amdgcn_readfirstlane(TOKE[2 * t]), e1 = __builtin_amdgcn_readfirstlane(TOKE[2 * t + 1]);
            const int s0 = __builtin_amdgcn_readlane(base_, e0) + TOKP[2 * t], s1 = __builtin_amdgcn_readlane(base_, e1) + TOKP[2 * t + 1];
            const u32x2* y0 = (const u32x2*)(YO + (size_t)s0 * 1024); const u32x2* y1 = (const u32x2*)(YO + (size_t)s1 * 1024);
#pragma unroll
            for (int j = 0; j < 4; ++j) { hv[r][j] = hr[64 * j + lane]; ya[r][j] = y0[64 * j + lane]; yb[r][j] = y1[64 * j + lane]; } }
#pragma unroll
        for (int r = 0; r < 2; ++r) { const int t = t0 + r * NGW;
            if (t < MTOK) {
                float s = 0.f;
#pragma unroll
                for (int j = 0; j < 4; ++j) { const u32x2 a = ya[r][j], c = yb[r][j], hq = hv[r][j];
                    v[r][j] = (f32x4){__uint_as_float(hq.x << 16), __uint_as_float(hq.x & 0xffff0000u), __uint_as_float(hq.y << 16), __uint_as_float(hq.y & 0xffff0000u)};
                    v[r][j].x += __uint_as_float(a.x << 16) + __uint_as_float(c.x << 16); v[r][j].y += __uint_as_float(a.x & 0xffff0000u) + __uint_as_float(c.x & 0xffff0000u);
                    v[r][j].z += __uint_as_float(a.y << 16) + __uint_as_float(c.y << 16); v[r][j].w += __uint_as_float(a.y & 0xffff0000u) + __uint_as_float(c.y & 0xffff0000u);
                    s += (v[r][j].x * v[r][j].x + v[r][j].y * v[r][j].y) + (v[r][j].z * v[r][j].z + v[r][j].w * v[r][j].w); }
                s = wave_sum(s);
                const float rs = __builtin_amdgcn_rsqf(s * (1.0f / 1024.0f) + EPS);
                f32x4* hw = (f32x4*)(P.out + (size_t)t * 1024);
#pragma unroll
                for (int j = 0; j < 4; ++j) hw[64 * j + lane] = v[r][j] * rs * nfv[j];
            } }
    }
}

struct EpiNull { static constexpr bool PERM = true, AFTER_DRAIN = false; float* d;
    DI void operator()(const pg8::f32x4 (&acc)[2][2][4][2], const pg8::Unit& u, int wr, int wc, int fr, int fq) const {
        pg8::f32x4 s = acc[0][0][0][0];
#pragma unroll
        for (int ai = 0; ai < 2; ++ai)
#pragma unroll
            for (int bj = 0; bj < 2; ++bj)
#pragma unroll
                for (int m = 0; m < 4; ++m)
#pragma unroll
                    for (int n = 0; n < 2; ++n) s += acc[ai][bj][m][n];
        if (s[0] == 12345.678f) d[threadIdx.x] = s[1] + s[2] + s[3]; } };
#ifndef PHMASK
#define PHMASK 2047
#endif
#ifndef P1_STAGGER_TICKS
#define P1_STAGGER_TICKS 0
#endif
#ifndef ATT_VAR
#define ATT_VAR 0
#endif
#ifndef REPMASK
#define REPMASK 0
#endif
#define REP(bit) for (int rep_ = 0; rep_ < ((REPMASK & (bit)) ? 2 : 1); ++rep_)
#define REPSYNC(bit) if ((REPMASK & (bit)) && rep_ == 0) GRID_BAR()
typedef const __attribute__((address_space(4))) Params* KParams;
DI Params load_params(KParams kp) { Params p;
#pragma unroll
    for (int i = 0; i < 23; ++i) p.in[i] = kp->in[i];
    p.out = kp->out; p.ws = kp->ws; return p; }
__global__ void __launch_bounds__(NTHREADS, 2) hymba_fwd(Params Pin) {
    extern __shared__ __attribute__((aligned(16))) unsigned char lds_raw[];
    LAS unsigned char* lds = (LAS unsigned char*)lds_raw;
    cg::grid_group grid = cg::this_grid();
    volatile LAS unsigned* bst = (volatile LAS unsigned*)(lds + LDS_BYTES - 64);
    if (threadIdx.x < 2) bst[threadIdx.x] = 0u;
    __syncthreads();
    const XcdBarrier xbar = xcd_barrier_post((unsigned*)(Pin.ws + WS_CTL) + CW_BAR, bst);
#ifndef TPROBE
#define TPROBE (-1)
#endif
#ifndef TPROBE_A
#define TPROBE_A TPROBE
#define TPROBE_B (TPROBE + 1)
#endif
    int nstamp_ = 0;
#define STAMP() do { if (TPROBE >= 0) { if (blockIdx.x == 0 && threadIdx.x == 0) __hip_atomic_store((unsigned long long*)(Pin.ws + WS_CTL + 65536) + nstamp_, (unsigned long long)__builtin_amdgcn_s_memrealtime(), __ATOMIC_RELAXED, __HIP_MEMORY_SCOPE_AGENT); ++nstamp_; } } while (0)
#define GRID_BAR() do { xcd_barrier(xbar); STAMP(); } while (0)
    STAMP();
    const int G = gridDim.x, blk = blockIdx.x, NGW = G * NWAVES, NGT = G * NTHREADS;
#define PHASE_IDS() KParams kp_ = (KParams)__builtin_amdgcn_kernarg_segment_ptr(); asm volatile("" : "+s"(kp_)); const Params P = load_params(kp_); int tid = threadIdx.x; asm volatile("" : "+v"(tid)); const int lane = tid & 63, wave = __builtin_amdgcn_readfirstlane(tid >> 6), gw = blk * NWAVES + wave, gtid = blk * NTHREADS + tid; (void)lane; (void)gw; (void)gtid; (void)wave

    REP(1) { if (PHMASK & 1) { PHASE_IDS(); phase0(P, lds, gw, NGW, gtid, NGT, wave, lane); } REPSYNC(1); }
    GRID_BAR();
#ifdef P1_EV
#define P1_PASS(DM) { PHASE_IDS(); \
        pg8::Gemm g{(const bf16_t*)(P.ws + WS_XB), (const bf16_t*)(P.ws + WS_WINT), MROWS, NPROJ, 1024}; \
        pg8::StaticOrder S; S.init(MROWS, NPROJ, G, blk); \
        EpiInProjT<P1_EV> E{(const float*)(P.ws + WS_RS1), (const float*)(P.ws + WS_COS), (const float*)(P.ws + WS_SIN), P.in[10], P.in[11], \
                    (bf16_t*)(P.ws + WS_QB), (bf16_t*)(P.ws + WS_KT), (bf16_t*)(P.ws + WS_VT), (bf16_t*)(P.ws + WS_QKVB), (bf16_t*)(P.ws + WS_ZB), (float*)(P.ws + WS_GB), P.ws + 248 * MiB, DM, (unsigned long long*)(P.ws + WS_CTL + 65536) + 40}; \
        pg8::gemm_phase<EpiInProjT<P1_EV>, pg8::StaticOrder, true, true>(lds, g, S, E); } GRID_BAR();
    P1_PASS(0)
    P1_PASS(1)
#else
    REP(2) { if (PHMASK & 2) { PHASE_IDS();
        pg8::Gemm g{(const bf16_t*)(P.ws + WS_XB), (const bf16_t*)(P.ws + WS_WINT), MROWS, NPROJ, 1024};
        if (P1_STAGGER_TICKS > 0 && (blk & 1)) { const unsigned long long s0_ = __builtin_amdgcn_s_memrealtime(); while (__builtin_amdgcn_s_memrealtime() - s0_ < (unsigned long long)P1_STAGGER_TICKS) __builtin_amdgcn_s_sleep(8); }
        pg8::StaticOrder S; S.init(MROWS, NPROJ, G, blk);
#ifdef P1_EV
        EpiInProjT<P1_EV> E{(const float*)(P.ws + WS_RS1), (const float*)(P.ws + WS_COS), (const float*)(P.ws + WS_SIN), P.in[10], P.in[11],
                    (bf16_t*)(P.ws + WS_QB), (bf16_t*)(P.ws + WS_KT), (bf16_t*)(P.ws + WS_VT), (bf16_t*)(P.ws + WS_QKVB), (bf16_t*)(P.ws + WS_ZB), (float*)(P.ws + WS_GB), P.ws + 248 * MiB, rep_, (unsigned long long*)(P.ws + WS_CTL + 65536) + 40};
        pg8::gemm_phase<EpiInProjT<P1_EV>, pg8::StaticOrder, true, true>(lds, g, S, E);
#else
        EpiInProj E{(const float*)(P.ws + WS_RS1), (const float*)(P.ws + WS_COS), (const float*)(P.ws + WS_SIN), P.in[10], P.in[11],
                    (bf16_t*)(P.ws + WS_QB), (bf16_t*)(P.ws + WS_KT), (bf16_t*)(P.ws + WS_VT), (bf16_t*)(P.ws + WS_QKVB), (bf16_t*)(P.ws + WS_ZB), (float*)(P.ws + WS_GB), P.ws + 248 * MiB, 0, (unsigned long long*)(P.ws + WS_CTL + 65536) + 40};
        if (rep_ == 0) pg8::gemm_phase<EpiInProj, pg8::StaticOrder, true, true>(lds, g, S, E);
        else { EpiNull EN{(float*)(P.ws + WS_DUMP)}; pg8::gemm_phase<EpiNull, pg8::StaticOrder, true, true>(lds, g, S, EN); }
#endif
    } REPSYNC(2); }
    GRID_BAR();
#endif
    REP(4) { if (PHMASK & 4) { PHASE_IDS(); gdn_prep_phase(P, lds, blk, G, wave, lane); } REPSYNC(4); }
    {
        unsigned* prep = (unsigned*)(Pin.ws + WS_CTL) + CW_PREP;
        asm volatile("s_waitcnt vmcnt(0)" ::: "memory");
        __syncthreads();
        if (threadIdx.x == 0) { __builtin_amdgcn_fence(__ATOMIC_RELEASE, "agent"); asm volatile("s_waitcnt vmcnt(0)" ::: "memory");
            __hip_atomic_fetch_add(prep, 1u, __ATOMIC_RELAXED, __HIP_MEMORY_SCOPE_AGENT); }
        if (blk < 16) {
            if (threadIdx.x == 0) { unsigned sp = 0;
                while (__hip_atomic_load(prep, __ATOMIC_RELAXED, __HIP_MEMORY_SCOPE_AGENT) < (unsigned)G) { __builtin_amdgcn_s_sleep(2); if (++sp > (1u << 22)) break; }
                __builtin_amdgcn_fence(__ATOMIC_ACQUIRE, "agent"); asm volatile("s_waitcnt vmcnt(0)" ::: "memory"); }
            __syncthreads();
        }
    }
    REP(8) { if ((PHMASK & 8) && blk < 16) { PHASE_IDS(); gdn_scan(P, lds, blk, tid, wave, lane); } }
    REP(16) {
    if (PHMASK & 16) { PHASE_IDS(); if (rep_ == 0) attn_phase<0>(P, lds, tid, wave, lane); else attn_phase<ATT_VAR>(P, lds, tid, wave, lane); }
    if ((REPMASK & 16) && rep_ == 0) { GRID_BAR(); if (blk == 0 && threadIdx.x < 8) { PHASE_IDS(); __hip_atomic_store((unsigned*)(P.ws + WS_CTL) + CW_ATTQ + 64 * threadIdx.x, 0u, __ATOMIC_RELAXED, __HIP_MEMORY_SCOPE_AGENT); } GRID_BAR(); }
    }
    GRID_BAR();
    REP(32) { if (PHMASK & 32) { PHASE_IDS();
        pg8::Gemm g{(const bf16_t*)(P.ws + WS_MIX), (const bf16_t*)(P.ws + WS_WOUT), MTOK, 1024, 1024};
        pg8::StaticOrder S; S.init(MTOK, 1024, G, blk);
        EpiOutProj E{P.in[0], P.out, (bf16_t*)(P.ws + WS_U2)};
        pg8::gemm_phase<EpiOutProj, pg8::StaticOrder, true, true>(lds, g, S, E);
    } REPSYNC(32); }
    GRID_BAR();
#ifdef P4A_SPLIT
    if (PHMASK & 64) { PHASE_IDS(); phase4a<1>(P, lds, gw, NGW, wave, lane); }
    GRID_BAR();
    if (PHMASK & 64) { PHASE_IDS(); phase4a<2>(P, lds, gw, NGW, wave, lane); }
#else
    if (PHMASK & 64) { PHASE_IDS(); phase4a<3>(P, lds, gw, NGW, wave, lane); }
#endif
    GRID_BAR();
    int cnt, base, tend, total; { PHASE_IDS(); expert_layout(P, lane, cnt, base, tend); total = __builtin_amdgcn_readlane(tend, 31); }
    REP(256) { if (PHMASK & 256) { PHASE_IDS();
        pg8::Gemm g{(const bf16_t*)(P.ws + WS_U2), (const bf16_t*)(P.ws + WS_WGU), XS_ROWS, 32 * 512, 1024};
        GroupedOrder S{tend, total, G, blk, 1, cnt, base, (const int*)(P.ws + WS_LIST)};
        EpiGateUp E{(const float*)(P.ws + WS_LISTW), (const float*)(P.ws + WS_LISTRS), (bf16_t*)(P.ws + WS_YS), cnt, base};
        pg8::gemm_phase_g<EpiGateUp, GroupedOrder, true, true>(lds, g, S, E);
    } REPSYNC(256); }
    GRID_BAR();
    REP(512) { if (PHMASK & 512) { PHASE_IDS();
        int kd = 256; asm volatile("" : "+s"(kd));
        pg8::Gemm g{(const bf16_t*)(P.ws + WS_YS), (const bf16_t*)(P.ws + WS_WD), XS_ROWS, 32 * 1024, kd};
        GroupedOrder S{tend, total, G, blk, 2, cnt, base, (const int*)(P.ws + WS_LIST)};
        EpiDown E{(bf16_t*)(P.ws + WS_YO)};
        pg8::gemm_phase<EpiDown, GroupedOrder, true, true>(lds, g, S, E);
    } REPSYNC(512); }
    GRID_BAR();
    if (PHMASK & 1024) { PHASE_IDS(); phase7(P, gw, NGW, lane); }
    if (TPROBE >= 0) {
        GRID_BAR();
        const unsigned long long* st = (const unsigned long long*)(Pin.ws + WS_CTL + 65536);
        const unsigned long long t0 = __hip_atomic_load(st + TPROBE_A, __ATOMIC_RELAXED, __HIP_MEMORY_SCOPE_AGENT), t1 = __hip_atomic_load(st + TPROBE_B, __ATOMIC_RELAXED, __HIP_MEMORY_SCOPE_AGENT);
        const unsigned long long dt = (t1 - t0) * 4ull, s0 = __builtin_amdgcn_s_memrealtime();
        while (__builtin_amdgcn_s_memrealtime() - s0 < dt) __builtin_amdgcn_s_sleep(8);
    }
}

extern "C" void kernel_launch(void* const* d_in, const int* in_sizes, int n_in, void* d_out, int out_size, void* d_ws, size_t ws_size, hipStream_t stream) {
    static int grid_blocks = 0;
    if (grid_blocks == 0) {
        if (n_in != 23 || out_size != MTOK * DMODEL || ws_size < WS_END) { fprintf(stderr, "kernel_launch: unexpected shapes (n_in %d out %d ws %zu)\n", n_in, out_size, ws_size); grid_blocks = -1; return; }
        int dev = 0, cus = 0, per_cu = 0;
        hipGetDevice(&dev);
        hipDeviceGetAttribute(&cus, hipDeviceAttributeMultiprocessorCount, dev);
        hipFuncSetAttribute((const void*)hymba_fwd, hipFuncAttributeMaxDynamicSharedMemorySize, LDS_BYTES);
        hipOccupancyMaxActiveBlocksPerMultiprocessor(&per_cu, (const void*)hymba_fwd, NTHREADS, LDS_BYTES);
        if (per_cu < 1) { fprintf(stderr, "kernel_launch: occupancy query says %d blocks/CU\n", per_cu); per_cu = 1; }
        grid_blocks = cus;
        (void)hipGetLastError();
    }
    if (grid_blocks < 0) return;
    hipMemsetAsync((char*)d_ws + WS_CTL, 0, CTL_BYTES, stream);
    Params p{};
    for (int i = 0; i < 23; ++i) p.in[i] = (const float*)d_in[i];
    p.out = (float*)d_out; p.ws = (unsigned char*)d_ws;
    void* args[] = {&p};
    hipError_t e = hipLaunchCooperativeKernel((const void*)hymba_fwd, dim3(grid_blocks), dim3(NTHREADS), args, LDS_BYTES, stream);
    if (e != hipSuccess) fprintf(stderr, "cooperative launch failed: %s (grid %d)\n", hipGetErrorString(e), grid_blocks);
}
```

```cpp
#include <hip/hip_runtime.h>
#include <hip/hip_cooperative_groups.h>
#include <cstdio>
#include <cstdint>
namespace cg = cooperative_groups;
#ifndef PG8_EPI_AGAIN
#define PG8_EPI_AGAIN(x) do {} while (0)
#endif
namespace pg8 {
#define PG8_LAS __attribute__((address_space(3)))
typedef unsigned short bf16_t;
typedef short bf16x8 __attribute__((ext_vector_type(8)));
typedef float f32x4 __attribute__((ext_vector_type(4)));
typedef unsigned u32x4 __attribute__((ext_vector_type(4)));
constexpr int BM = 256, BK = 64, HALF = 128, HTB = HALF * BK * 2  , STAGE_BYTES = 8 * HTB, NXCD = 8, WGM = 8;

__host__ __device__ __forceinline__ int lds_byte(int r, int c) { const int st = (r >> 4) * 2 + (c >> 5), rr = r & 15, cc = c & 31, ob = rr * 64 + cc * 2; return st * 1024 + (ob ^ (((ob >> 9) & 1) << 5)); }
__host__ __device__ __forceinline__ void stage_rc(int b, int& R, int& C) { const int st = b / 1024, sb = b % 1024, swz = sb ^ (((sb >> 9) & 1) << 5); R = (st >> 1) * 16 + swz / 64; C = (st & 1) * 32 + (swz % 64) / 2; }
__host__ __device__ __forceinline__ int perm32(int rho) { const int n = rho >> 4, i = rho & 15; return 8 * (i >> 2) + 4 * n + (i & 3); }

template <class T, class = void> struct epi_timed { static constexpr bool v = false; };
template <class T> struct epi_timed<T, decltype((void)T::TIMED)> { static constexpr bool v = true; };
#ifndef PG8_TBLK
#define PG8_TBLK 0
#define PG8_TTID 0
#endif
struct Unit { int pm, pn; };
struct Gemm { const bf16_t* A; const bf16_t* Bt; int M, N, K; };

struct StaticOrder {
    int nM, nN, nwg, G, c;
    __host__ __device__ void init(int M, int N, int G_, int c_) { nM = M / BM; nN = N / BM; nwg = nM * nN; G = G_; c = c_; }
    __host__ __device__ bool next(int i, Unit& u) const {
        const long L = (long)i * G + c; if (L >= nwg) return false;
        int wgid = (int)L; { const int q = nwg / NXCD, r = nwg % NXCD, xcd = wgid % NXCD, off = wgid / NXCD; wgid = (xcd < r ? xcd * (q + 1) : r * (q + 1) + (xcd - r) * q) + off; }
        const int nig = WGM * nN, gid = wgid / nig, fm = gid * WGM, gsz = (nM - fm) < WGM ? (nM - fm) : WGM;
        u.pm = fm + ((wgid % nig) % gsz); u.pn = (wgid % nig) / gsz; return true;
    }
    __device__ __forceinline__ void a_ready(const Unit&) const {}
    __device__ __forceinline__ void done(const Unit&) const {}
};

__device__ __forceinline__ unsigned cvt_pk_bf16(float lo, float hi) { unsigned r; asm volatile("v_cvt_pk_bf16_f32 %0, %1, %2" : "=v"(r) : "v"(lo), "v"(hi)); return r; }
typedef float f32x2 __attribute__((ext_vector_type(2)));
template <class Epi, class Sched, bool ALIGN_EPI = false, bool SP2 = false>
__device__ __forceinline__ void gemm_phase(PG8_LAS unsigned char* lds, const Gemm g, const Sched& S, const Epi& E) {
    int tid_o = threadIdx.x; asm volatile("" : "+v"(tid_o));
    const int tid = tid_o, wid = __builtin_amdgcn_readfirstlane(tid >> 6), lane = tid & 63, wr = wid >> 2, wc = wid & 3, fr = lane & 15, fq = lane >> 4;
    const int K = g.K, nt = K / BK;
    unsigned voffA[2], voffB[2];
#pragma unroll
    for (int i = 0; i < 2; ++i) { int R, C; stage_rc(tid * 16 + i * 8192, R, C); const int Rb = Epi::PERM ? ((R & ~31) + perm32(R & 31)) : R;
        voffA[i] = (unsigned)(R * K + C) * 2u; voffB[i] = (unsigned)(Rb * K + C) * 2u; }
    const size_t kstep = (size_t)(BK * 2);
    const size_t hstep = (size_t)HALF * K * 2;
    const size_t tstep = 2 * hstep;
    const unsigned ldsw = (unsigned)wid * 1024u;
    const int aoff = lds_byte(wr * 64 + fr, fq * 8), boff = lds_byte(wc * 32 + fr, fq * 8);
#define PG8_SA(b, h) (((b) * 2 + (h)) * HTB)
#define PG8_SB(b, h) ((4 + (b) * 2 + (h)) * HTB)
#define PG8_STAGE(bufoff, gbase, voff) do { _Pragma("unroll") for (int _i = 0; _i < 2; ++_i) \
        __builtin_amdgcn_global_load_lds((const unsigned*)((const char*)(gbase) + (voff)[_i]), (PG8_LAS unsigned*)(lds + (bufoff) + ldsw + _i * 8192), 16, 0, 0); } while (0)
#define PG8_LDA(dst, b, h) do { _Pragma("unroll") for (int m = 0; m < 4; ++m) _Pragma("unroll") for (int k = 0; k < 2; ++k) dst[m][k] = *(const PG8_LAS bf16x8*)(lds + PG8_SA(b, h) + aoff + m * 2048 + k * 1024); } while (0)
#define PG8_LDB(dst, b, h) do { _Pragma("unroll") for (int n = 0; n < 2; ++n) _Pragma("unroll") for (int k = 0; k < 2; ++k) dst[n][k] = *(const PG8_LAS bf16x8*)(lds + PG8_SB(b, h) + boff + n * 2048 + k * 1024); } while (0)
#define PG8_MMA(ai, bj, At, Bt) do { __builtin_amdgcn_s_setprio(1); _Pragma("unroll") for (int m = 0; m < 4; ++m) _Pragma("unroll") for (int n = 0; n < 2; ++n) _Pragma("unroll") for (int k = 0; k < 2; ++k) \
        acc[ai][bj][m][n] = __builtin_amdgcn_mfma_f32_16x16x32_bf16(Bt[n][k], At[m][k], acc[ai][bj][m][n], 0, 0, 0); __builtin_amdgcn_s_setprio(0); } while (0)
#define PG8_WAIT_V(n) asm volatile("s_waitcnt vmcnt(" #n ")" ::: "memory")
#define PG8_WAIT_L(n) asm volatile("s_waitcnt lgkmcnt(" #n ")" ::: "memory")
#define PG8_BAR __builtin_amdgcn_s_barrier()
#define PG8_SCHED __builtin_amdgcn_sched_barrier(0)
    Unit cur, nxt; int ui = 0;
    if (!S.next(0, cur)) return;
    f32x4 acc[2][2][4][2];
#pragma unroll
    for (int a = 0; a < 2; ++a)
#pragma unroll
        for (int b = 0; b < 2; ++b)
#pragma unroll
            for (int m = 0; m < 4; ++m)
#pragma unroll
                for (int n = 0; n < 2; ++n) acc[a][b][m][n] = (f32x4){0.f, 0.f, 0.f, 0.f};
    bf16x8 At[4][2], B0[2][2], B1[2][2];
    const char* cA = (const char*)g.A + (size_t)cur.pm * tstep; const char* cB = (const char*)g.Bt + (size_t)cur.pn * tstep;
    S.a_ready(cur);
    if constexpr (SP2) {
        PG8_STAGE(PG8_SB(0, 0), cB, voffB); PG8_STAGE(PG8_SB(0, 1), cB + hstep, voffB); PG8_STAGE(PG8_SA(0, 0), cA, voffA); PG8_STAGE(PG8_SA(0, 1), cA + hstep, voffA);
        if (wr == 1) PG8_BAR;
        PG8_WAIT_V(2); PG8_BAR;
        PG8_STAGE(PG8_SB(1, 0), cB + kstep, voffB); PG8_STAGE(PG8_SA(1, 0), cA + kstep, voffA); PG8_STAGE(PG8_SB(1, 1), cB + hstep + kstep, voffB);
        PG8_WAIT_V(6); PG8_BAR;
    } else {
        PG8_STAGE(PG8_SB(0, 0), cB, voffB); PG8_STAGE(PG8_SA(0, 0), cA, voffA); PG8_STAGE(PG8_SB(0, 1), cB + hstep, voffB); PG8_STAGE(PG8_SA(0, 1), cA + hstep, voffA);
        if (wr == 1) PG8_BAR;
        PG8_WAIT_V(4); PG8_BAR;
        PG8_STAGE(PG8_SB(1, 0), cB + kstep, voffB); PG8_STAGE(PG8_SA(1, 0), cA + kstep, voffA); PG8_STAGE(PG8_SB(1, 1), cB + hstep + kstep, voffB);
        PG8_WAIT_V(6); PG8_BAR;
    }
#ifdef PG8_TSEL
    unsigned long long tsum_ = 0;
#endif
    for (;;) {
        const bool has_next = S.next(ui + 1, nxt);
        const char* nA = has_next ? (const char*)g.A + (size_t)nxt.pm * tstep : cA; const char* nB = has_next ? (const char*)g.Bt + (size_t)nxt.pn * tstep : cB;
        for (int t = 0; t < nt; t += 2) {
            const bool last = (t == nt - 2);
            const char* a1 = cA + (size_t)(t + 1) * kstep;
            const char* a2 = last ? nA : cA + (size_t)(t + 2) * kstep; const char* b2 = last ? nB : cB + (size_t)(t + 2) * kstep;
            const char* a3 = a2 + kstep; const char* b3 = b2 + kstep;
            if (last && has_next) S.a_ready(nxt);
            if constexpr (SP2) {
            PG8_LDB(B0, 0, 0); PG8_LDB(B1, 0, 1); PG8_SCHED; PG8_LDA(At, 0, 0); PG8_STAGE(PG8_SA(1, 1), a1 + hstep, voffA);
            PG8_WAIT_V(8); PG8_WAIT_L(0); PG8_BAR; PG8_MMA(0, 0, At, B0); PG8_MMA(0, 1, At, B1); PG8_BAR; PG8_SCHED;
            PG8_LDA(At, 0, 1); PG8_STAGE(PG8_SB(0, 0), b2, voffB); PG8_STAGE(PG8_SB(0, 1), b2 + hstep, voffB); PG8_STAGE(PG8_SA(0, 0), a2, voffA);
            PG8_WAIT_V(8); PG8_WAIT_L(0); PG8_BAR; PG8_MMA(1, 0, At, B0); PG8_MMA(1, 1, At, B1); PG8_BAR; PG8_SCHED;
            PG8_LDB(B0, 1, 0); PG8_LDB(B1, 1, 1); PG8_SCHED; PG8_LDA(At, 1, 0); PG8_STAGE(PG8_SA(0, 1), a2 + hstep, voffA);
            PG8_WAIT_V(8); PG8_WAIT_L(0); PG8_BAR; PG8_MMA(0, 0, At, B0); PG8_MMA(0, 1, At, B1); PG8_BAR; PG8_SCHED;
            PG8_LDA(At, 1, 1); PG8_STAGE(PG8_SB(1, 0), b3, voffB); PG8_STAGE(PG8_SB(1, 1), b3 + hstep, voffB); PG8_STAGE(PG8_SA(1, 0), a3, voffA);
            PG8_WAIT_V(8); PG8_WAIT_L(0); PG8_BAR; PG8_MMA(1, 0, At, B0); PG8_MMA(1, 1, At, B1); PG8_BAR; PG8_SCHED;
            } else {
            PG8_LDB(B0, 0, 0); PG8_SCHED; PG8_LDA(At, 0, 0); PG8_STAGE(PG8_SA(1, 1), a1 + hstep, voffA);
            PG8_WAIT_L(8); PG8_BAR; PG8_WAIT_L(0); PG8_MMA(0, 0, At, B0); PG8_BAR; PG8_SCHED;
            PG8_LDB(B1, 0, 1); PG8_STAGE(PG8_SB(0, 0), b2, voffB);
            PG8_BAR; PG8_WAIT_L(0); PG8_MMA(0, 1, At, B1); PG8_BAR;
            PG8_LDA(At, 0, 1); PG8_STAGE(PG8_SA(0, 0), a2, voffA);
            PG8_BAR; PG8_WAIT_L(0); PG8_MMA(1, 0, At, B0); PG8_BAR; PG8_SCHED;
            PG8_STAGE(PG8_SB(0, 1), b2 + hstep, voffB);
            PG8_WAIT_V(6); PG8_BAR; PG8_MMA(1, 1, At, B1); PG8_BAR;
            PG8_LDB(B0, 1, 0); PG8_SCHED; PG8_LDA(At, 1, 0); PG8_STAGE(PG8_SA(0, 1), a2 + hstep, voffA);
            PG8_WAIT_L(8); PG8_BAR; PG8_WAIT_L(0); PG8_MMA(0, 0, At, B0); PG8_BAR; PG8_SCHED;
            PG8_LDB(B1, 1, 1); PG8_STAGE(PG8_SB(1, 0), b3, voffB);
            PG8_BAR; PG8_WAIT_L(0); PG8_MMA(0, 1, At, B1); PG8_BAR;
            PG8_LDA(At, 1, 1); PG8_STAGE(PG8_SA(1, 0), a3, voffA);
            PG8_BAR; PG8_WAIT_L(0); PG8_MMA(1, 0, At, B0); PG8_BAR; PG8_SCHED;
            PG8_STAGE(PG8_SB(1, 1), b3 + hstep, voffB);
            PG8_WAIT_V(6); PG8_BAR; PG8_MMA(1, 1, At, B1); PG8_BAR;
            }
        }
#ifdef PG8_TSEL
        unsigned long long tA_ = 0, tb2_ = 0;
        if constexpr (epi_timed<Epi>::v) tA_ = __builtin_amdgcn_s_memrealtime();
#endif
        if constexpr (ALIGN_EPI) { if (wr == 0) PG8_BAR; }
#ifdef PG8_TSEL
        if constexpr (epi_timed<Epi>::v) tb2_ = __builtin_amdgcn_s_memrealtime();
#endif
#ifdef PG8_TSEL
        unsigned long long tb_ = 0;
        if constexpr (epi_timed<Epi>::v) { if (PG8_TSEL == 2) tb_ = tA_; else tb_ = __builtin_amdgcn_s_memrealtime(); }
#endif
        if constexpr (!Epi::AFTER_DRAIN) { E(acc, cur, wr, wc, fr, fq); PG8_EPI_AGAIN(E(acc, cur, wr, wc, fr, fq)); S.done(cur); }
#ifdef PG8_TSEL
        if constexpr (epi_timed<Epi>::v) { if (PG8_TSEL == 1) asm volatile("s_waitcnt vmcnt(0)" ::: "memory");
            if (PG8_TSEL == 2) tsum_ += tb2_ - tb_; else tsum_ += __builtin_amdgcn_s_memrealtime() - tb_; }
#endif
        if (!has_next) break;
#pragma unroll
        for (int a = 0; a < 2; ++a)
#pragma unroll
            for (int b = 0; b < 2; ++b)
#pragma unroll
                for (int m = 0; m < 4; ++m)
#pragma unroll
                    for (int n = 0; n < 2; ++n) acc[a][b][m][n] = (f32x4){0.f, 0.f, 0.f, 0.f};
        cur = nxt; cA = nA; cB = nB; ++ui;
        if constexpr (ALIGN_EPI) { if (wr == 1) PG8_BAR; }
    }
    PG8_WAIT_V(0);
    if constexpr (!ALIGN_EPI) { if (wr == 0) PG8_BAR; }
    PG8_BAR;
    if constexpr (Epi::AFTER_DRAIN) { E.fused(acc, cur, wr, wc, fr, fq, lds, wid, lane); S.done(cur); }
#ifdef PG8_TSEL
    if constexpr (epi_timed<Epi>::v) { if (blockIdx.x == PG8_TBLK && tid == PG8_TTID) __hip_atomic_store(E.tslot, tsum_, __ATOMIC_RELAXED, __HIP_MEMORY_SCOPE_AGENT); }
#endif
#undef PG8_SA
#undef PG8_SB
#undef PG8_STAGE
#undef PG8_LDA
#undef PG8_LDB
#undef PG8_MMA
#undef PG8_WAIT_V
#undef PG8_WAIT_L
#undef PG8_BAR
#undef PG8_SCHED
}
static_assert(true, "gather variant of gemm_phase (SP2 = true only): identical schedule, the A operand's rows are gathered through Sched::rowoff");
template <class Epi, class Sched, bool ALIGN_EPI = false, bool SP2 = false>
__device__ __forceinline__ void gemm_phase_g(PG8_LAS unsigned char* lds, const Gemm g, const Sched& S, const Epi& E) {
    int tid_o = threadIdx.x; asm volatile("" : "+v"(tid_o));
    const int tid = tid_o, wid = __builtin_amdgcn_readfirstlane(tid >> 6), lane = tid & 63, wr = wid >> 2, wc = wid & 3, fr = lane & 15, fq = lane >> 4;
    const int K = g.K, nt = K / BK;
    unsigned voffA[2], voffB[2]; int RA_[2]; unsigned CA_[2];
#pragma unroll
    for (int i = 0; i < 2; ++i) { int R, C; stage_rc(tid * 16 + i * 8192, R, C); const int Rb = Epi::PERM ? ((R & ~31) + perm32(R & 31)) : R;
        voffA[i] = (unsigned)(R * K + C) * 2u; voffB[i] = (unsigned)(Rb * K + C) * 2u; RA_[i] = R; CA_[i] = (unsigned)C * 2u; }
    const size_t kstep = (size_t)(BK * 2);
    const size_t hstep = (size_t)HALF * K * 2;
    const size_t tstep = 2 * hstep;
    const unsigned ldsw = (unsigned)wid * 1024u;
    const int aoff = lds_byte(wr * 64 + fr, fq * 8), boff = lds_byte(wc * 32 + fr, fq * 8);
#define PG8_SA(b, h) (((b) * 2 + (h)) * HTB)
#define PG8_SB(b, h) ((4 + (b) * 2 + (h)) * HTB)
#define PG8_STAGE(bufoff, gbase, voff) do { _Pragma("unroll") for (int _i = 0; _i < 2; ++_i) \
        __builtin_amdgcn_global_load_lds((const unsigned*)((const char*)(gbase) + (voff)[_i]), (PG8_LAS unsigned*)(lds + (bufoff) + ldsw + _i * 8192), 16, 0, 0); } while (0)
#define PG8_LDA(dst, b, h) do { _Pragma("unroll") for (int m = 0; m < 4; ++m) _Pragma("unroll") for (int k = 0; k < 2; ++k) dst[m][k] = *(const PG8_LAS bf16x8*)(lds + PG8_SA(b, h) + aoff + m * 2048 + k * 1024); } while (0)
#define PG8_LDB(dst, b, h) do { _Pragma("unroll") for (int n = 0; n < 2; ++n) _Pragma("unroll") for (int k = 0; k < 2; ++k) dst[n][k] = *(const PG8_LAS bf16x8*)(lds + PG8_SB(b, h) + boff + n * 2048 + k * 1024); } while (0)
#define PG8_MMA(ai, bj, At, Bt) do { __builtin_amdgcn_s_setprio(1); _Pragma("unroll") for (int m = 0; m < 4; ++m) _Pragma("unroll") for (int n = 0; n < 2; ++n) _Pragma("unroll") for (int k = 0; k < 2; ++k) \
        acc[ai][bj][m][n] = __builtin_amdgcn_mfma_f32_16x16x32_bf16(Bt[n][k], At[m][k], acc[ai][bj][m][n], 0, 0, 0); __builtin_amdgcn_s_setprio(0); } while (0)
#define PG8_WAIT_V(n) asm volatile("s_waitcnt vmcnt(" #n ")" ::: "memory")
#define PG8_WAIT_L(n) asm volatile("s_waitcnt lgkmcnt(" #n ")" ::: "memory")
#define PG8_BAR __builtin_amdgcn_s_barrier()
#define PG8_SCHED __builtin_amdgcn_sched_barrier(0)
    Unit cur, nxt; int ui = 0;
    if (!S.next(0, cur)) return;
    f32x4 acc[2][2][4][2];
#pragma unroll
    for (int a = 0; a < 2; ++a)
#pragma unroll
        for (int b = 0; b < 2; ++b)
#pragma unroll
            for (int m = 0; m < 4; ++m)
#pragma unroll
                for (int n = 0; n < 2; ++n) acc[a][b][m][n] = (f32x4){0.f, 0.f, 0.f, 0.f};
    bf16x8 At[4][2], B0[2][2], B1[2][2];
    const char* cA = (const char*)g.A; const char* cB = (const char*)g.Bt + (size_t)cur.pn * tstep;
    unsigned cA0[2], cA1[2], nA0[2], nA1[2];
#pragma unroll
    for (int i = 0; i < 2; ++i) { cA0[i] = S.rowoff(cur, RA_[i]) + CA_[i]; cA1[i] = S.rowoff(cur, 128 + RA_[i]) + CA_[i]; }
    S.a_ready(cur);
    if constexpr (SP2) {
        PG8_STAGE(PG8_SB(0, 0), cB, voffB); PG8_STAGE(PG8_SB(0, 1), cB + hstep, voffB); PG8_STAGE(PG8_SA(0, 0), cA, cA0); PG8_STAGE(PG8_SA(0, 1), cA, cA1);
        if (wr == 1) PG8_BAR;
        PG8_WAIT_V(2); PG8_BAR;
        PG8_STAGE(PG8_SB(1, 0), cB + kstep, voffB); PG8_STAGE(PG8_SA(1, 0), cA + kstep, cA0); PG8_STAGE(PG8_SB(1, 1), cB + hstep + kstep, voffB);
        PG8_WAIT_V(6); PG8_BAR;
    } else {
        PG8_STAGE(PG8_SB(0, 0), cB, voffB); PG8_STAGE(PG8_SA(0, 0), cA, voffA); PG8_STAGE(PG8_SB(0, 1), cB + hstep, voffB); PG8_STAGE(PG8_SA(0, 1), cA + hstep, voffA);
        if (wr == 1) PG8_BAR;
        PG8_WAIT_V(4); PG8_BAR;
        PG8_STAGE(PG8_SB(1, 0), cB + kstep, voffB); PG8_STAGE(PG8_SA(1, 0), cA + kstep, voffA); PG8_STAGE(PG8_SB(1, 1), cB + hstep + kstep, voffB);
        PG8_WAIT_V(6); PG8_BAR;
    }
    for (;;) {
        const bool has_next = S.next(ui + 1, nxt);
        const char* nA = cA; const char* nB = has_next ? (const char*)g.Bt + (size_t)nxt.pn * tstep : cB;
#pragma unroll
        for (int i = 0; i < 2; ++i) { nA0[i] = has_next ? S.rowoff(nxt, RA_[i]) + CA_[i] : cA0[i]; nA1[i] = has_next ? S.rowoff(nxt, 128 + RA_[i]) + CA_[i] : cA1[i]; }
        for (int t = 0; t < nt; t += 2) {
            const bool last = (t == nt - 2);
            const char* a1 = cA + (size_t)(t + 1) * kstep;
            const char* a2 = last ? nA : cA + (size_t)(t + 2) * kstep; const char* b2 = last ? nB : cB + (size_t)(t + 2) * kstep;
            const char* a3 = a2 + kstep; const char* b3 = b2 + kstep;
            unsigned sA0[2], sA1[2];
#pragma unroll
            for (int i = 0; i < 2; ++i) { sA0[i] = last ? nA0[i] : cA0[i]; sA1[i] = last ? nA1[i] : cA1[i]; }
            if (last && has_next) S.a_ready(nxt);
            if constexpr (SP2) {
            PG8_LDB(B0, 0, 0); PG8_LDB(B1, 0, 1); PG8_SCHED; PG8_LDA(At, 0, 0); PG8_STAGE(PG8_SA(1, 1), a1, cA1);
            PG8_WAIT_V(8); PG8_WAIT_L(0); PG8_BAR; PG8_MMA(0, 0, At, B0); PG8_MMA(0, 1, At, B1); PG8_BAR; PG8_SCHED;
            PG8_LDA(At, 0, 1); PG8_STAGE(PG8_SB(0, 0), b2, voffB); PG8_STAGE(PG8_SB(0, 1), b2 + hstep, voffB); PG8_STAGE(PG8_SA(0, 0), a2, sA0);
            PG8_WAIT_V(8); PG8_WAIT_L(0); PG8_BAR; PG8_MMA(1, 0, At, B0); PG8_MMA(1, 1, At, B1); PG8_BAR; PG8_SCHED;
            PG8_LDB(B0, 1, 0); PG8_LDB(B1, 1, 1); PG8_SCHED; PG8_LDA(At, 1, 0); PG8_STAGE(PG8_SA(0, 1), a2, sA1);
            PG8_WAIT_V(8); PG8_WAIT_L(0); PG8_BAR; PG8_MMA(0, 0, At, B0); PG8_MMA(0, 1, At, B1); PG8_BAR; PG8_SCHED;
            PG8_LDA(At, 1, 1); PG8_STAGE(PG8_SB(1, 0), b3, voffB); PG8_STAGE(PG8_SB(1, 1), b3 + hstep, voffB); PG8_STAGE(PG8_SA(1, 0), a3, sA0);
            PG8_WAIT_V(8); PG8_WAIT_L(0); PG8_BAR; PG8_MMA(1, 0, At, B0); PG8_MMA(1, 1, At, B1); PG8_BAR; PG8_SCHED;
            } else {
            PG8_LDB(B0, 0, 0); PG8_SCHED; PG8_LDA(At, 0, 0); PG8_STAGE(PG8_SA(1, 1), a1 + hstep, voffA);
            PG8_WAIT_L(8); PG8_BAR; PG8_WAIT_L(0); PG8_MMA(0, 0, At, B0); PG8_BAR; PG8_SCHED;
            PG8_LDB(B1, 0, 1); PG8_STAGE(PG8_SB(0, 0), b2, voffB);
            PG8_BAR; PG8_WAIT_L(0); PG8_MMA(0, 1, At, B1); PG8_BAR;
            PG8_LDA(At, 0, 1); PG8_STAGE(PG8_SA(0, 0), a2, voffA);
            PG8_BAR; PG8_WAIT_L(0); PG8_MMA(1, 0, At, B0); PG8_BAR; PG8_SCHED;
            PG8_STAGE(PG8_SB(0, 1), b2 + hstep, voffB);
            PG8_WAIT_V(6); PG8_BAR; PG8_MMA(1, 1, At, B1); PG8_BAR;
            PG8_LDB(B0, 1, 0); PG8_SCHED; PG8_LDA(At, 1, 0); PG8_STAGE(PG8_SA(0, 1), a2 + hstep, voffA);
            PG8_WAIT_L(8); PG8_BAR; PG8_WAIT_L(0); PG8_MMA(0, 0, At, B0); PG8_BAR; PG8_SCHED;
            PG8_LDB(B1, 1, 1); PG8_STAGE(PG8_SB(1, 0), b3, voffB);
            PG8_BAR; PG8_WAIT_L(0); PG8_MMA(0, 1, At, B1); PG8_BAR;
            PG8_LDA(At, 1, 1); PG8_STAGE(PG8_SA(1, 0), a3, voffA);
            PG8_BAR; PG8_WAIT_L(0); PG8_MMA(1, 0, At, B0); PG8_BAR; PG8_SCHED;
            PG8_STAGE(PG8_SB(1, 1), b3 + hstep, voffB);
            PG8_WAIT_V(6); PG8_BAR; PG8_MMA(1, 1, At, B1); PG8_BAR;
            }
        }
        if constexpr (ALIGN_EPI) { if (wr == 0) PG8_BAR; }
        if constexpr (!Epi::AFTER_DRAIN) { E(acc, cur, wr, wc, fr, fq); PG8_EPI_AGAIN(E(acc, cur, wr, wc, fr, fq)); S.done(cur); }
        if (!has_next) break;
#pragma unroll
        for (int a = 0; a < 2; ++a)
#pragma unroll
            for (int b = 0; b < 2; ++b)
#pragma unroll
                for (int m = 0; m < 4; ++m)
#pragma unroll
                    for (int n = 0; n < 2; ++n) acc[a][b][m][n] = (f32x4){0.f, 0.f, 0.f, 0.f};
        cur = nxt; cA = nA; cB = nB; ++ui;
#pragma unroll
        for (int i = 0; i < 2; ++i) { cA0[i] = nA0[i]; cA1[i] = nA1[i]; }
        if constexpr (ALIGN_EPI) { if (wr == 1) PG8_BAR; }
    }
    PG8_WAIT_V(0);
    if constexpr (!ALIGN_EPI) { if (wr == 0) PG8_BAR; }
    PG8_BAR;
    if constexpr (Epi::AFTER_DRAIN) { E.fused(acc, cur, wr, wc, fr, fq, lds, wid, lane); S.done(cur); }
#undef PG8_SA
#undef PG8_SB
#undef PG8_STAGE
#undef PG8_LDA
#undef PG8_LDB
#undef PG8_MMA
#undef PG8_WAIT_V
#undef PG8_WAIT_L
#undef PG8_BAR
#undef PG8_SCHED
}
}

#define DI __device__ __forceinline__
#define LAS __attribute__((address_space(3)))
typedef unsigned short bf16_t;
typedef short bf16x8 __attribute__((ext_vector_type(8)));
typedef short s16x4 __attribute__((ext_vector_type(4)));
typedef short v4i16_t __attribute__((ext_vector_type(4)));
typedef float f32x4 __attribute__((ext_vector_type(4)));
typedef float f32x16 __attribute__((ext_vector_type(16)));
typedef unsigned u32x4 __attribute__((ext_vector_type(4)));
typedef unsigned u32x2 __attribute__((ext_vector_type(2)));
typedef float f32x2_t __attribute__((ext_vector_type(2)));
typedef __bf16 bf16x2_t __attribute__((ext_vector_type(2)));

constexpr int NWAVES = 8, NTHREADS = 512;
constexpr int SEQ = 8192, DMODEL = 1024, NMETA = 16, LTOK = SEQ + NMETA  , LP = 8256  , NCHUNK = 129;
constexpr int MTOK = 2 * SEQ;
constexpr int MROWS = 16640;
constexpr int NPROJ = 3840;
constexpr int NKT = 129;
constexpr float EPS = 1e-6f;
constexpr float C2Q = 0.125f * 1.4426950408889634f;
constexpr int XS_ROWS = 41216;

constexpr size_t MiB = 1u << 20;
constexpr size_t WS_CTL = 0, CTL_BYTES = 1 * MiB;
constexpr size_t WS_RS1 = 1 * MiB;
constexpr size_t WS_RS2 = WS_RS1 + 128 * 1024;
constexpr size_t WS_TOKE = WS_RS2 + 128 * 1024;
constexpr size_t WS_TOKW = WS_TOKE + 128 * 1024;
constexpr size_t WS_TOKP = WS_TOKW + 128 * 1024;
constexpr size_t WS_SLOTW = WS_TOKP + 128 * 1024;
constexpr size_t WS_WR = WS_SLOTW + 192 * 1024;
constexpr size_t WS_GL = WS_WR + 160 * 1024;
constexpr size_t WS_DUMP = 2 * MiB;
constexpr size_t WS_COS = 2 * MiB;
constexpr size_t WS_SIN = WS_COS + 1280 * 1024;
constexpr size_t WS_GB = WS_SIN + 1280 * 1024;
constexpr size_t WS_WOUT = 6 * MiB;
constexpr size_t WS_WINT = 8 * MiB;
constexpr size_t WS_XB = WS_WINT + (size_t)NPROJ * 1024 * 2;
constexpr size_t WS_MIX = 8 * MiB;
constexpr size_t WS_QKVB = 48 * MiB;
constexpr size_t WS_QB = WS_QKVB + (size_t)2 * LP * 1536 * 2 + 128 * 1024;
constexpr size_t WS_KT = WS_QB + 16 * MiB;
constexpr size_t WS_VT = WS_KT + (size_t)16 * NKT * 4096 * 2;
constexpr size_t WS_ZB = WS_VT + (size_t)8 * NKT * 8192 * 2;
constexpr size_t WS_GP = WS_ZB + (size_t)2 * LP * 512 * 2;
constexpr size_t GP_ARR = (size_t)2064 * 4096 * 2;
constexpr size_t WS_GP_END = WS_GP + 5 * GP_ARR;
constexpr size_t WS_WGU = 48 * MiB;
constexpr size_t WS_WD = 80 * MiB;
constexpr size_t WS_U2 = 96 * MiB;
constexpr size_t WS_LIST = 240 * MiB;
constexpr size_t WS_LISTW = 242 * MiB;
constexpr size_t WS_LISTRS = 244 * MiB;
constexpr size_t WS_XS = 96 * MiB;
constexpr size_t WS_YO = 128 * MiB;
constexpr size_t WS_YS = 8 * MiB;
constexpr size_t WS_END = 256 * MiB;
static_assert(WS_GB + (size_t)2 * LP * 16 * 4 <= WS_WOUT, "small region");
static_assert(WS_XB + (size_t)MROWS * 1024 * 2 <= WS_QKVB, "XB");
static_assert(WS_GP_END <= WS_END, "GDN prep arrays");
static_assert(WS_YS + (size_t)XS_ROWS * 256 * 2 <= WS_END, "YS");
static_assert(WS_WD + (size_t)32 * 1024 * 256 * 2 <= WS_XS, "WD");
constexpr int CW_ATTQ = 2112;
constexpr int CW_PREP = 2688;
constexpr int CW_CNT = 64;
constexpr int CW_TILE = 8192;
constexpr int CW_BAR = 4096;

constexpr int LDS_BYTES = 147456;

struct Params { const float* in[23]; float* out; unsigned char* ws; };

DI unsigned f2bf(float f) { unsigned u = __float_as_uint(f); return (u + 0x7fffu + ((u >> 16) & 1u)) >> 16; }
DI unsigned pk2(float lo, float hi) { f32x2_t v = {lo, hi}; bf16x2_t b = __builtin_convertvector(v, bf16x2_t); return __builtin_bit_cast(unsigned, b); }
DI float bf2f(unsigned short h) { return __uint_as_float(((unsigned)h) << 16); }
DI float rlane(float v, int l) { return __int_as_float(__builtin_amdgcn_readlane(__float_as_int(v), l)); }
#define DPP_ADD(v, ctrl) ((v) + __int_as_float(__builtin_amdgcn_update_dpp(0, __float_as_int(v), (ctrl), 0xF, 0xF, true)))
DI u32x2 pack_quad_bf16(float v) {
    const float v1 = __int_as_float(__builtin_amdgcn_update_dpp(0, __float_as_int(v), 0xB1, 0xF, 0xF, true));
    const unsigned p = pk2(v, v1);
    const unsigned q = (unsigned)__builtin_amdgcn_update_dpp(0, (int)p, 0x4E, 0xF, 0xF, true);
    return (u32x2){p, q};
}
typedef __attribute__((address_space(1))) u32x2 g_u32x2;
DI void store_quad_bf16(bf16_t* dst  , float v, int lane) {
    const float v1 = __int_as_float(__builtin_amdgcn_update_dpp(0, __float_as_int(v), 0xB1, 0xF, 0xF, true));
    const unsigned p = pk2(v, v1);
    const unsigned q = (unsigned)__builtin_amdgcn_update_dpp(0, (int)p, 0x4E, 0xF, 0xF, true);
    if ((lane & 3) == 0) *(u32x2*)dst = (u32x2){p, q};
}
DI float wave_sum_dpp(float v) {
    v = DPP_ADD(v, 0xB1);
    v = DPP_ADD(v, 0x4E);
    v = DPP_ADD(v, 0x141);
    v = DPP_ADD(v, 0x140);
    return (rlane(v, 0) + rlane(v, 16)) + (rlane(v, 32) + rlane(v, 48));
}
DI float wave_sum(float v) { return wave_sum_dpp(v); }
DI float swz_xor16(float v) { return __int_as_float(__builtin_amdgcn_ds_swizzle(__float_as_int(v), 0x401F)); }
DI float row_sum16(float v) { v = DPP_ADD(v, 0xB1); v = DPP_ADD(v, 0x4E); v = DPP_ADD(v, 0x141); v = DPP_ADD(v, 0x140); return v; }
DI float half_sum32(float v) { v = row_sum16(v); return v + swz_xor16(v); }
DI float swap32_add(float v) { auto rr = __builtin_amdgcn_permlane32_swap(__float_as_uint(v), __float_as_uint(v), false, false); return __uint_as_float(rr[0]) + __uint_as_float(rr[1]); }
DI float swap32_max(float v) { auto rr = __builtin_amdgcn_permlane32_swap(__float_as_uint(v), __float_as_uint(v), false, false); return fmaxf(__uint_as_float(rr[0]), __uint_as_float(rr[1])); }
#define LDS_WAIT() asm volatile("s_waitcnt lgkmcnt(0)" ::: "memory")
#define BAR_LDS() do { asm volatile("s_waitcnt lgkmcnt(0)" ::: "memory"); __builtin_amdgcn_s_barrier(); asm volatile("" ::: "memory"); } while (0)
#define MFMA32(a, b, c) __builtin_amdgcn_mfma_f32_32x32x16_bf16((a), (b), (c), 0, 0, 0)
DI int crow(int r, int hi) { return (r & 3) + 8 * (r >> 2) + 4 * hi; }
DI int perm16(int x) { return (x & ~12) | ((x & 4) << 1) | ((x & 8) >> 1); }
DI bf16x8 pack8(const f32x16& x, int s) {
    u32x4 p; p.x = pk2(x[8 * s], x[8 * s + 1]); p.y = pk2(x[8 * s + 2], x[8 * s + 3]); p.z = pk2(x[8 * s + 4], x[8 * s + 5]); p.w = pk2(x[8 * s + 6], x[8 * s + 7]);
    return __builtin_bit_cast(bf16x8, p);
}
DI int orig_col(int n) {
    if (n >= 1024) return n;
    const int hh = n >> 6, c2 = n & 63, g8 = c2 >> 3, i = c2 & 7;
    return (hh << 6) + ((i < 4) ? 4 * g8 + i : 32 + 4 * g8 + (i - 4));
}
DI size_t kt_off(int b, int hh, int p, int d) {
    const int tile = p < 16 ? 0 : 1 + ((p - 16) >> 6), kv = p < 16 ? p : ((p - 16) & 63);
    return ((size_t)((b * 8 + hh) * NKT + tile) << 12) + ((d >> 3) << 9) + (kv << 3) + (d & 7);
}
DI size_t vt_off(int b, int h, int p, int d) {
    const int tile = p < 16 ? 0 : 1 + ((p - 16) >> 6), kv = p < 16 ? p : ((p - 16) & 63);
    return ((size_t)((b * 4 + h) * NKT + tile) << 13) + ((d >> 5) << 11) + ((kv >> 4) << 9) + ((kv & 15) << 5) + (d & 31);
}

template <class Src> DI void transpose_item(const Src& src, bf16_t* WT, size_t ldk, int k0, int n0, LAS float* scr, int lane) {
    float v[32];
#pragma unroll
    for (int i = 0; i < 32; ++i) v[i] = src(k0 + 2 * i + (lane >> 5), n0 + (lane & 31));
#pragma unroll
    for (int i = 0; i < 32; ++i) scr[(2 * i + (lane >> 5)) * 33 + (lane & 31)] = v[i];
    LDS_WAIT();
    const int c = lane & 7;
#pragma unroll
    for (int j = 0; j < 4; ++j) { const int n = (lane >> 3) + 8 * j; const LAS float* s = scr + (8 * c) * 33 + n;
        u32x4 o; o.x = pk2(s[0 * 33], s[1 * 33]); o.y = pk2(s[2 * 33], s[3 * 33]); o.z = pk2(s[4 * 33], s[5 * 33]); o.w = pk2(s[6 * 33], s[7 * 33]);
        *(u32x4*)(WT + (size_t)(n0 + n) * ldk + k0 + 8 * c) = o; }
    LDS_WAIT();
}
struct SrcWin { const float* w; const float* g; DI float operator()(int k, int n) const { return n >= 3600 ? 0.f : w[(size_t)k * 3600 + orig_col(n)] * g[k]; } };
struct SrcPlain { const float* w; int N; DI float operator()(int k, int n) const { return w[(size_t)k * N + n]; } };
struct SrcGU { const float* w; const float* g; int fadj; DI float operator()(int k, int n) const { return w[(size_t)k * 256 + n + fadj] * g[k]; } };

#ifndef P0_REP
#define P0_REP 0
#endif
DI void phase0(const Params& P, LAS unsigned char* lds, int gw, int NGW, int gtid, int NGT, int wave, int lane) {
    LAS float* scr = (LAS float*)(lds + wave * 16384);
    bf16_t* WINT = (bf16_t*)(P.ws + WS_WINT); bf16_t* WOUT = (bf16_t*)(P.ws + WS_WOUT); bf16_t* XB = (bf16_t*)(P.ws + WS_XB);
    float* RS1 = (float*)(P.ws + WS_RS1);
    constexpr int I_IN = 16 * (NPROJ / 32), I_OUT = 16 * 32;
    const SrcWin sw{P.in[3], P.in[2]}; const SrcPlain so{P.in[13], 1024};
    for (int rp_ = 0; rp_ < ((P0_REP & 1) ? 2 : 1); ++rp_)
    for (int it = gw; it < I_IN + I_OUT; it += NGW) {
        if (it < I_IN) transpose_item(sw, WINT, 1024, (it / (NPROJ / 32)) * 64, (it % (NPROJ / 32)) * 32, scr, lane);
        else { const int r = it - I_IN; transpose_item(so, WOUT, 1024, (r >> 5) * 64, (r & 31) * 32, scr, lane); }
    }
    const float* x = P.in[0]; const float* meta = P.in[1];
    for (int rp_ = 0; rp_ < ((P0_REP & 2) ? 2 : 1); ++rp_)
    for (int m0 = gw; m0 < MROWS; m0 += 4 * NGW) {
        f32x4 v[4][4];
#pragma unroll
        for (int r = 0; r < 4; ++r) { const int m = m0 + r * NGW;
            const bool real = m < MTOK + NMETA;
            const f32x4* xr = (const f32x4*)((m < MTOK) ? x + (size_t)m * 1024 : meta + (size_t)((real ? m : MTOK) - MTOK) * 1024);
#pragma unroll
            for (int j = 0; j < 4; ++j) v[r][j] = (m < MROWS) ? xr[64 * j + lane] : (f32x4){0.f, 0.f, 0.f, 0.f}; }
#pragma unroll
        for (int r = 0; r < 4; ++r) { const int m = m0 + r * NGW;
            if (m < MROWS) {
                const bool real = m < MTOK + NMETA;
                float s = 0.f;
#pragma unroll
                for (int j = 0; j < 4; ++j) { if (!real) v[r][j] = (f32x4){0.f, 0.f, 0.f, 0.f}; s += (v[r][j].x * v[r][j].x + v[r][j].y * v[r][j].y) + (v[r][j].z * v[r][j].z + v[r][j].w * v[r][j].w); }
                s = wave_sum(s);
                if (lane == 0) RS1[m] = real ? __builtin_amdgcn_rsqf(s * (1.0f / 1024.0f) + EPS) : 0.f;
                u32x2* orow = (u32x2*)(XB + (size_t)m * 1024);
#pragma unroll
                for (int j = 0; j < 4; ++j) orow[64 * j + lane] = (u32x2){pk2(v[r][j].x, v[r][j].y), pk2(v[r][j].z, v[r][j].w)};
            } }
    }
    float* COS = (float*)(P.ws + WS_COS); float* SIN = (float*)(P.ws + WS_SIN);
    for (int rp_ = 0; rp_ < ((P0_REP & 4) ? 2 : 1); ++rp_)
    for (int i = gtid; i < LTOK * 32; i += NGT) {
        const int p = i >> 5, f = i & 31;
        const double rev = (double)p * exp2(-(double)f * (13.287712379549449 / 32.0)) * 0.15915494309189535;
        const float fr = (float)(rev - floor(rev));
        COS[i] = __builtin_amdgcn_cosf(fr); SIN[i] = __builtin_amdgcn_sinf(fr);
    }
    float* WR = (float*)(P.ws + WS_WR); const float* gf = P.in[14]; const float* wgrp = P.in[15]; const float* wrt = P.in[17];
    for (int i = gtid; i < 36 * 1024; i += NGT) { const int j = i >> 10, k = i & 1023; WR[i] = gf[k] * (j < 4 ? wgrp[k * 4 + j] : wrt[k * 32 + (j - 4)]); }
}

#ifndef EPI_NT
#define EPI_NT 0
#endif
#if EPI_NT
#define NT_ST(p, v) __builtin_nontemporal_store((v), (p))
#else
#define NT_ST(p, v) do { if (EV == 1) { auto p_ = (p); *(decltype(p_))(dmask ? dumpb + ((unsigned long long)p_ & 0xFFFF0ull) : (unsigned char*)p_) = (v); } else *(p) = (v); } while (0)
#endif
template <int EV> struct EpiInProjT {
    static constexpr bool PERM = true, AFTER_DRAIN = false, TIMED = true;
    const float* RS1; const float* COS; const float* SIN; const float* a_log; const float* dt_bias;
    bf16_t* QB; bf16_t* KT; bf16_t* VT; bf16_t* QKVB; bf16_t* ZB; float* GB; unsigned char* dumpb; int dmask; unsigned long long* tslot;
    DI void tail(const pg8::f32x4 (&acc)[2][2][4][2], const pg8::Unit& u, int wr, int wc, int fr, int fq) const {
        const int pn = u.pn;
#pragma unroll
        for (int ai = 0; ai < 2; ++ai)
#pragma unroll
            for (int m = 0; m < 4; ++m) {
                const int row = u.pm * 256 + ai * 128 + wr * 64 + m * 16 + fr;
                if (row < MTOK + NMETA) {
                    const float rs = RS1[row];
                    const bool meta = row >= MTOK;
                    const int p = meta ? row - MTOK : (row & 8191) + NMETA;
                    const int b0 = meta ? 0 : (row >> 13), nb = meta ? 2 : 1;
#pragma unroll
                    for (int bj = 0; bj < 2; ++bj) {
                        float xv[8];
#pragma unroll
                        for (int i = 0; i < 4; ++i) { xv[i] = acc[ai][bj][m][0][i] * rs; xv[4 + i] = acc[ai][bj][m][1][i] * rs; }
                        if (pn < 4) {
                            const int hh = (pn & 1) * 4 + bj * 2 + (wc >> 1), d0 = 4 * (4 * (wc & 1) + fq);
                            const f32x4 cs = *(const f32x4*)(COS + p * 32 + d0), sn = *(const f32x4*)(SIN + p * 32 + d0);
                            float lo[4], hi[4];
#pragma unroll
                            for (int i = 0; i < 4; ++i) { lo[i] = xv[i] * cs[i] - xv[4 + i] * sn[i]; hi[i] = xv[4 + i] * cs[i] + xv[i] * sn[i]; }
                            if (pn < 2) {
                                if (!meta) {
                                    bf16_t* q = QB + ((size_t)((b0 * 8 + hh) * SEQ + (p - NMETA)) << 6) + d0;
                                    *(u32x2*)q = (u32x2){pk2(lo[0] * C2Q, lo[1] * C2Q), pk2(lo[2] * C2Q, lo[3] * C2Q)};
                                    *(u32x2*)(q + 32) = (u32x2){pk2(hi[0] * C2Q, hi[1] * C2Q), pk2(hi[2] * C2Q, hi[3] * C2Q)};
                                }
                            } else {
                                for (int bb = b0; bb < b0 + nb; ++bb) {
                                    *(u32x2*)(KT + kt_off(bb, hh, p, d0)) = (u32x2){pk2(lo[0], lo[1]), pk2(lo[2], lo[3])};
                                    *(u32x2*)(KT + kt_off(bb, hh, p, d0 + 32)) = (u32x2){pk2(hi[0], hi[1]), pk2(hi[2], hi[3])};
                                }
                            }
                        } else {
                            const u32x4 w = (u32x4){pk2(xv[0], xv[1]), pk2(xv[2], xv[3]), pk2(xv[4], xv[5]), pk2(xv[6], xv[7])};
                            const int cl = bj * 128 + wc * 32 + fq * 8;
                            if (pn < 6) {
                                const int h = (pn - 4) * 2 + bj, d = wc * 32 + fq * 8;
                                for (int bb = b0; bb < b0 + nb; ++bb) *(u32x4*)(VT + vt_off(bb, h, p, d)) = w;
                            } else if (pn < 12) {
                                for (int bb = b0; bb < b0 + nb; ++bb) *(u32x4*)(QKVB + (size_t)(bb * LP + p) * 1536 + (pn - 6) * 256 + cl) = w;
                            } else if (pn < 14) {
                                float sz[8];
#pragma unroll
                                for (int i = 0; i < 8; ++i) sz[i] = xv[i] * __builtin_amdgcn_rcpf(1.0f + __expf(-xv[i]));
                                const u32x4 wz = (u32x4){pk2(sz[0], sz[1]), pk2(sz[2], sz[3]), pk2(sz[4], sz[5]), pk2(sz[6], sz[7])};
                                for (int bb = b0; bb < b0 + nb; ++bb) *(u32x4*)(ZB + (size_t)(bb * LP + p) * 512 + (pn - 12) * 256 + cl) = wz;
                            } else if (cl < 16) {
                                float o[8];
                                if (cl == 0) {
#pragma unroll
                                    for (int i = 0; i < 8; ++i) { const float t = xv[i] + dt_bias[i]; const float sp = fmaxf(t, 0.f) + __logf(1.0f + __expf(-fabsf(t))); o[i] = -__expf(a_log[i]) * sp; }
                                } else {
#pragma unroll
                                    for (int i = 0; i < 8; ++i) o[i] = __builtin_amdgcn_rcpf(1.0f + __expf(-xv[i]));
                                }
                                for (int bb = b0; bb < b0 + nb; ++bb) { float* g = GB + ((size_t)(bb * LP + p) << 4) + cl;
                                    *(f32x4*)g = (f32x4){o[0], o[1], o[2], o[3]}; *(f32x4*)(g + 4) = (f32x4){o[4], o[5], o[6], o[7]}; }
                            }
                        }
                    }
                }
            }
    }

    DI void operator()(const pg8::f32x4 (&acc)[2][2][4][2], const pg8::Unit& u, int wr, int wc, int fr, int fq) const {
        if (u.pm >= MTOK / 256) { tail(acc, u, wr, wc, fr, fq); return; }
        const int pn = u.pn, rowb = u.pm * 256 + wr * 64 + fr;
        float rs[2][4];
#pragma unroll
        for (int ai = 0; ai < 2; ++ai)
#pragma unroll
            for (int m = 0; m < 4; ++m) rs[ai][m] = (EV == 2) ? 1.0f : RS1[rowb + ai * 128 + m * 16];
        __builtin_amdgcn_sched_barrier(0);
        const int b = rowb >> 13, s0 = rowb & 8191;
        if (pn < 4) {
            const int d0 = 4 * (4 * (wc & 1) + fq);
#pragma unroll
            for (int ai = 0; ai < 2; ++ai) {
                f32x4 cs[4], sn[4];
#pragma unroll
                for (int m = 0; m < 4; ++m) { const int p = s0 + ai * 128 + m * 16 + NMETA; if (EV == 2) { cs[m] = (f32x4){1.f, 1.f, 1.f, 1.f}; sn[m] = (f32x4){0.f, 0.f, 0.f, 0.f}; } else { cs[m] = *(const f32x4*)(COS + p * 32 + d0); sn[m] = *(const f32x4*)(SIN + p * 32 + d0); } }
                __builtin_amdgcn_sched_barrier(0);
#pragma unroll
                for (int m = 0; m < 4; ++m)
#pragma unroll
                    for (int bj = 0; bj < 2; ++bj) {
                        const int hh = (pn & 1) * 4 + bj * 2 + (wc >> 1), s = s0 + ai * 128 + m * 16;
                        float lo[4], hi[4];
#pragma unroll
                        for (int i = 0; i < 4; ++i) { const float x1 = acc[ai][bj][m][0][i] * rs[ai][m], x2 = acc[ai][bj][m][1][i] * rs[ai][m];
                            lo[i] = x1 * cs[m][i] - x2 * sn[m][i]; hi[i] = x2 * cs[m][i] + x1 * sn[m][i]; }
                        if (pn < 2) { bf16_t* q = QB + ((size_t)((b * 8 + hh) * SEQ + s) << 6) + d0;
                            NT_ST((u32x2*)q, ((u32x2){pk2(lo[0] * C2Q, lo[1] * C2Q), pk2(lo[2] * C2Q, lo[3] * C2Q)}));
                            NT_ST((u32x2*)(q + 32), ((u32x2){pk2(hi[0] * C2Q, hi[1] * C2Q), pk2(hi[2] * C2Q, hi[3] * C2Q)}));
                        } else { bf16_t* k = KT + ((size_t)((b * 8 + hh) * NKT + 1 + (s >> 6)) << 12) + ((d0 >> 3) << 9) + ((s & 63) << 3) + (d0 & 7);
                            NT_ST((u32x2*)k, ((u32x2){pk2(lo[0], lo[1]), pk2(lo[2], lo[3])}));
                            NT_ST((u32x2*)(k + 4 * 512), ((u32x2){pk2(hi[0], hi[1]), pk2(hi[2], hi[3])})); }
                    }
            }
            return;
        }
        const int cl = wc * 32 + fq * 8;
#pragma unroll
        for (int ai = 0; ai < 2; ++ai)
#pragma unroll
            for (int m = 0; m < 4; ++m)
#pragma unroll
                for (int bj = 0; bj < 2; ++bj) {
                    const int s = s0 + ai * 128 + m * 16, p = s + NMETA;
                    float xv[8];
#pragma unroll
                    for (int i = 0; i < 4; ++i) { xv[i] = acc[ai][bj][m][0][i] * rs[ai][m]; xv[4 + i] = acc[ai][bj][m][1][i] * rs[ai][m]; }
                    if (pn < 6) {
                        const int h = (pn - 4) * 2 + bj;
                        NT_ST((u32x4*)(VT + ((size_t)((b * 4 + h) * NKT + 1 + (s >> 6)) << 13) + ((cl >> 5) << 11) + (((s & 63) >> 4) << 9) + ((s & 15) << 5) + (cl & 31)),
                            ((u32x4){pk2(xv[0], xv[1]), pk2(xv[2], xv[3]), pk2(xv[4], xv[5]), pk2(xv[6], xv[7])}));
                    } else if (pn < 12) {
                        NT_ST((u32x4*)(QKVB + (size_t)(b * LP + p) * 1536 + (pn - 6) * 256 + bj * 128 + cl), ((u32x4){pk2(xv[0], xv[1]), pk2(xv[2], xv[3]), pk2(xv[4], xv[5]), pk2(xv[6], xv[7])}));
                    } else if (pn < 14) {
#pragma unroll
                        for (int i = 0; i < 8; ++i) xv[i] = xv[i] * __builtin_amdgcn_rcpf(1.0f + __expf(-xv[i]));
                        NT_ST((u32x4*)(ZB + (size_t)(b * LP + p) * 512 + (pn - 12) * 256 + bj * 128 + cl), ((u32x4){pk2(xv[0], xv[1]), pk2(xv[2], xv[3]), pk2(xv[4], xv[5]), pk2(xv[6], xv[7])}));
                    } else if (bj == 0 && cl < 16) {
                        float o[8];
                        if (cl == 0) {
#pragma unroll
                            for (int i = 0; i < 8; ++i) { const float t = xv[i] + dt_bias[i]; const float sp = fmaxf(t, 0.f) + __logf(1.0f + __expf(-fabsf(t))); o[i] = -__expf(a_log[i]) * sp; }
                        } else {
#pragma unroll
                            for (int i = 0; i < 8; ++i) o[i] = __builtin_amdgcn_rcpf(1.0f + __expf(-xv[i]));
                        }
                        float* g = GB + ((size_t)(b * LP + p) << 4) + cl;
                        *(f32x4*)g = (f32x4){o[0], o[1], o[2], o[3]}; *(f32x4*)(g + 4) = (f32x4){o[4], o[5], o[6], o[7]};
                    }
                }
    }
};
typedef EpiInProjT<0> EpiInProj;

DI bf16x8 lds_frag(LAS const bf16_t* M, int row, int ch) { return *(LAS const bf16x8*)((LAS const unsigned char*)M + row * 128 + ((ch ^ (row & 7)) << 4)); }
DI s16x4 tr_read_b64(LAS const unsigned char* p) { return __builtin_bit_cast(s16x4, __builtin_amdgcn_ds_read_tr16_b64_v4i16((LAS v4i16_t*)p)); }
DI bf16x8 lds_frag_plain(LAS const bf16_t* M, int row, int ch) { return *(LAS const bf16x8*)((LAS const unsigned char*)M + row * 128 + (ch << 4)); }
DI int swz_idx(int row, int d) { return row * 64 + ((((d >> 3) ^ (row & 7)) << 3) | (d & 7)); }

#ifndef PREP_REP
#define PREP_REP 0
#endif
constexpr int PREP_PAIR = 35840;

template <int MAT> DI void prep_rows(const bf16_t* QKVB, const float* cw, int b, int h, int n, int lane, LAS const float* egS,
                                     LAS bf16_t* DS  , bf16_t* QG) {
    const int colb = MAT * 512 + h * 64, col = colb + lane, p0 = n * 64;
    const float c0 = cw[col], c1 = cw[1536 + col], c2 = cw[3072 + col], c3 = cw[4608 + col];
    const bf16_t* blk = QKVB + (size_t)(b * LP + p0) * 1536 + colb;
    float x0 = 0.f, x1 = 0.f, x2 = 0.f;
    if (n > 0) { x0 = bf2f(blk[lane - 3 * 1536]); x1 = bf2f(blk[lane - 2 * 1536]); x2 = bf2f(blk[lane - 1 * 1536]); }
    u32x4 stg[8];
#pragma unroll
    for (int i = 0; i < 8; ++i) stg[i] = *(const u32x4*)(blk + (size_t)(8 * i + (lane >> 3)) * 1536 + (lane & 7) * 8);
#pragma unroll
    for (int i = 0; i < 8; ++i) *(LAS u32x4*)(DS + (8 * i + (lane >> 3)) * 64 + (lane & 7) * 8) = stg[i];
    LDS_WAIT();
    const int nvalid = (LTOK - p0) < 64 ? (LTOK - p0) : 64;
#pragma unroll 4
    for (int c = 0; c < nvalid; ++c) {
        const float x3 = bf2f(DS[c * 64 + lane]);
        float y = c0 * x0 + c1 * x1 + c2 * x2 + c3 * x3;
        y = y * __builtin_amdgcn_rcpf(1.0f + __expf(-y));
        x0 = x1; x1 = x2; x2 = x3;
        if (MAT == 2) { DS[c * 64 + lane] = (bf16_t)f2bf(y * egS[c]); }
        else {
            const float ss = wave_sum(y * y);
            const float yn = y * __builtin_amdgcn_rsqf(ss + EPS);
            if (MAT == 0) {
                const float qn = yn * 0.125f;
                DS[c * 64 + lane] = (bf16_t)f2bf(qn);
                QG[c * 64 + perm16(lane)] = (bf16_t)f2bf(qn * egS[c]);
            } else {
                DS[c * 64 + lane] = (bf16_t)f2bf(yn);
            }
        }
    }
    for (int c = nvalid; c < 64; ++c) { DS[c * 64 + lane] = 0; if (MAT == 0) QG[c * 64 + perm16(lane)] = 0; }
}

DI void gdn_tinv(LAS const float* AST, LAS bf16_t* TS, int lane) {
    const int hb = lane >> 5, j = lane & 31, r32 = j, hi = hb;
    LAS const float* Ab = AST + (32 * hb) * 68 + 32 * hb;
    float x[32];
#pragma unroll
    for (int r = 0; r < 32; ++r) x[r] = (r == j) ? 1.0f : 0.0f;
#pragma unroll
    for (int jj = 0; jj < 31; ++jj) {
        const float xj = x[jj];
        LAS const float* ap = Ab + jj * 68;
#pragma unroll
        for (int r4 = (jj + 1) / 4; r4 < 8; ++r4) {
            const f32x4 a = *(LAS const f32x4*)(ap + 4 * r4);
#pragma unroll
            for (int e = 0; e < 4; ++e) if (4 * r4 + e > jj) x[4 * r4 + e] -= a[e] * xj;
        }
    }
    bf16x8 a21[2];
#pragma unroll
    for (int s = 0; s < 2; ++s) { float t[8];
#pragma unroll
        for (int jj = 0; jj < 8; ++jj) t[jj] = AST[(16 * s + 8 * hi + jj) * 68 + 32 + r32];
        const u32x4 p = (u32x4){pk2(t[0], t[1]), pk2(t[2], t[3]), pk2(t[4], t[5]), pk2(t[6], t[7])}; a21[s] = __builtin_bit_cast(bf16x8, p); }
    f32x16 M = {};
#pragma unroll
    for (int s = 0; s < 2; ++s) { float t[8];
#pragma unroll
        for (int jj = 0; jj < 8; ++jj) {
            const auto rr = __builtin_amdgcn_permlane32_swap(__float_as_uint(x[16 * s + 8 + jj]), __float_as_uint(x[16 * s + 8 + jj]), false, false);
            t[jj] = hi ? __uint_as_float(rr[0]) : x[16 * s + jj];
        }
        const u32x4 p = (u32x4){pk2(t[0], t[1]), pk2(t[2], t[3]), pk2(t[4], t[5]), pk2(t[6], t[7])};
        M = MFMA32(a21[s], __builtin_bit_cast(bf16x8, p), M);
    }
    asm volatile("s_waitcnt lgkmcnt(0)" ::: "memory");
#pragma unroll
    for (int i = 0; i < 32; ++i) TS[(32 * hb + i) * 64 + 32 * hb + j] = (bf16_t)f2bf(x[i]);
    asm volatile("s_waitcnt lgkmcnt(0)" ::: "memory");
    f32x16 T21 = {};
#pragma unroll
    for (int s = 0; s < 2; ++s) {
        const u32x2 lo = *(LAS const u32x2*)(TS + (32 + r32) * 64 + 32 + 16 * s + 4 * hi), hi8 = *(LAS const u32x2*)(TS + (32 + r32) * 64 + 32 + 16 * s + 8 + 4 * hi);
        const u32x4 p = (u32x4){lo.x, lo.y, hi8.x, hi8.y};
        T21 = MFMA32(__builtin_bit_cast(bf16x8, p), pack8(M, s), T21);
    }
#pragma unroll
    for (int i = 0; i < 16; ++i) TS[(32 + crow(i, hi)) * 64 + r32] = (bf16_t)f2bf(-T21[i]);
    asm volatile("s_waitcnt lgkmcnt(0)" ::: "memory");
}

template <bool PERM> DI void gdn_tmul(LAS const bf16_t* TS, LAS const bf16_t* RS, int lane, float sgn, bf16_t* out) {
    const int r32 = lane & 31, hi = lane >> 5;
    LAS const unsigned char* rb = (LAS const unsigned char*)RS + ((8 * hi + ((lane & 15) >> 2)) * 64 + 16 * ((lane >> 4) & 1) + 4 * (lane & 3)) * 2;
#pragma unroll
    for (int ct = 0; ct < 2; ++ct)
#pragma unroll
        for (int cb = 0; cb < 2; ++cb) {
            f32x16 acc = {};
#pragma unroll
            for (int ks = 0; ks < (ct == 0 ? 2 : 4); ++ks) {
                const bf16x8 fa = lds_frag_plain(TS, 32 * ct + r32, 2 * ks + hi);
                const s16x4 lo = tr_read_b64(rb + (16 * ks * 64 + 32 * cb) * 2), h4 = tr_read_b64(rb + ((16 * ks + 4) * 64 + 32 * cb) * 2);
                const bf16x8 fb = (bf16x8){lo[0], lo[1], lo[2], lo[3], h4[0], h4[1], h4[2], h4[3]};
                acc = MFMA32(fa, fb, acc);
            }
            u32x2 pk[16];
#pragma unroll
            for (int i = 0; i < 16; ++i) pk[i] = pack_quad_bf16(sgn * acc[i]);
            if ((lane & 3) == 0) {
                unsigned long long ob_ = (unsigned long long)(out + hi * 256 + (PERM ? perm16(32 * cb + r32) : 32 * cb + r32)); asm volatile("" : "+v"(ob_));
                g_u32x2* ob = (g_u32x2*)ob_;
#pragma unroll
                for (int i = 0; i < 16; ++i) ob[(32 * ct + (i & 3) + 8 * (i >> 2)) * 16] = pk[i];
            }
        }
}

DI void gdn_prep_phase(const Params& P, LAS unsigned char* lds, int blk, int G, int wave, int lane_in) {
    const int pair = wave >> 1, role = wave & 1;
    LAS unsigned char* pb = lds + pair * PREP_PAIR;
    LAS bf16_t* QS = (LAS bf16_t*)pb; LAS bf16_t* KS = (LAS bf16_t*)(pb + 8192); LAS float* AS = (LAS float*)(pb + 16384);
    LAS float* gcS = (LAS float*)(pb + 16384 + 17408 + role * 1024); LAS float* betaS = gcS + 64; LAS float* egS = gcS + 128; LAS float* ekS = gcS + 192;
    const bf16_t* QKVB = (const bf16_t*)(P.ws + WS_QKVB); const float* GB = (const float*)(P.ws + WS_GB); const float* cw = P.in[9];
    const int NP = G * 4, NTASK = 2 * 8 * NCHUNK;
    for (int it = 0; it * NP < NTASK; ++it) {
        int lane = lane_in; asm volatile("" : "+v"(lane));
        const int r32 = lane & 31, hi = lane >> 5;
        const int task = it * NP + blk * 4 + pair;
        const bool active = task < NTASK;
        const int bh = task < 2048 ? (task >> 7) : (task - 2048), n = task < 2048 ? (task & 127) : 128, b = bh >> 3, h = bh & 7;
        const int sidx = bh * NCHUNK + n;
        bf16_t* GPW = (bf16_t*)(P.ws + WS_GP) + (size_t)sidx * 4096; bf16_t* GPQG = GPW + GP_ARR / 2; bf16_t* GPAQK = GPQG + GP_ARR / 2; bf16_t* GPKGT = GPAQK + GP_ARR / 2; bf16_t* GPU = GPKGT + GP_ARR / 2;
        float gc = 0.f, beta = 0.f;
        if (active) {
            const int pl = n * 64 + lane;
            float g = 0.f;
            if (pl < LTOK) { const float* gb = GB + ((size_t)(b * LP + pl) << 4); g = gb[h]; beta = gb[8 + h]; }
            gcS[lane] = g; LDS_WAIT();
            gc = 0.f;
#pragma unroll
            for (int j4 = 0; j4 < 16; ++j4) { const f32x4 t = *(LAS const f32x4*)(gcS + 4 * j4);
                gc += (4 * j4 <= lane ? t[0] : 0.f) + (4 * j4 + 1 <= lane ? t[1] : 0.f) + (4 * j4 + 2 <= lane ? t[2] : 0.f) + (4 * j4 + 3 <= lane ? t[3] : 0.f); }
            const float glast = rlane(gc, 63);
            LDS_WAIT();
            gcS[lane] = gc; betaS[lane] = beta; egS[lane] = (role == 0) ? __expf(gc) : beta * __expf(gc); ekS[lane] = __expf(glast - gc);
            if (role == 0 && lane == 0) ((float*)(P.ws + WS_GL))[sidx] = __expf(glast);
            LDS_WAIT();
            for (int rp_ = 0; rp_ < ((PREP_REP & 1) ? 2 : 1); ++rp_) {
            if (role == 0) prep_rows<0>(QKVB, cw, b, h, n, lane, egS, QS, GPQG);
            else prep_rows<1>(QKVB, cw, b, h, n, lane, egS, KS, GPQG);
            }
        }
        LDS_WAIT();
        __syncthreads();
        if (active) {
            for (int rp_ = 0; rp_ < ((PREP_REP & 2) ? 2 : 1); ++rp_)
#pragma unroll
            for (int t4 = 0; t4 < 4; ++t4) {
                const int ct = t4 >> 1, st = t4 & 1;
                f32x16 acc = {};
                if (!(ct == 0 && st == 1)) {
#pragma unroll
                    for (int ks = 0; ks < 4; ++ks) {
                        const bf16x8 fa = lds_frag_plain(role == 0 ? QS : KS, 32 * ct + r32, 2 * ks + hi), fb = lds_frag_plain(KS, 32 * st + r32, 2 * ks + hi);
                        acc = MFMA32(fa, fb, acc);
                    }
                }
                const float gcs = gcS[32 * st + r32];
                LAS const float* gcb = gcS + hi * 4; LAS const float* beb = betaS + hi * 4;
                asm volatile("" : "+v"(gcb), "+v"(beb));
                const int cmp = (32 * st + r32) - 4 * hi;
                if (role == 0) {
                    u32x2 pk[16];
#pragma unroll
                    for (int i = 0; i < 16; ++i) { const int cr = 32 * ct + (i & 3) + 8 * (i >> 2);
                        pk[i] = pack_quad_bf16((cmp <= cr) ? acc[i] * __expf(gcb[cr] - gcs) : 0.f); }
                    if ((lane & 3) == 0) {
                        unsigned long long aq_ = (unsigned long long)(GPAQK + hi * 256 + perm16(r32) + 32 * st); asm volatile("" : "+v"(aq_));
                        g_u32x2* aqb = (g_u32x2*)aq_;
#pragma unroll
                        for (int i = 0; i < 16; ++i) { const int cr = 32 * ct + (i & 3) + 8 * (i >> 2); aqb[cr * 16] = pk[i]; }
                    }
                } else {
                    LAS float* asb = AS + r32 * 68 + hi * 4;
                    asm volatile("" : "+v"(asb));
#pragma unroll
                    for (int i = 0; i < 16; ++i) { const int cr = 32 * ct + (i & 3) + 8 * (i >> 2);
                        asb[32 * st * 68 + cr] = (cmp < cr) ? acc[i] * beb[cr] * __expf(gcb[cr] - gcs) : 0.f; }
                }
            }
        }
        LDS_WAIT();
        __syncthreads();
        LAS bf16_t* TS = (LAS bf16_t*)((LAS unsigned char*)AS + 32 * 68 * 4);
        if (active) {
            if (role == 0) {
                prep_rows<2>(QKVB, cw, b, h, n, lane, betaS, QS  , GPQG);
            } else {
#pragma unroll
                for (int gq = 0; gq < 8; ++gq) {
                    float t[8];
#pragma unroll
                    for (int j = 0; j < 8; ++j) { const int c = perm16(8 * gq + j); t[j] = bf2f(KS[c * 64 + lane]) * ekS[c]; }
                    *(u32x4*)(GPKGT + lane * 64 + 8 * gq) = (u32x4){pk2(t[0], t[1]), pk2(t[2], t[3]), pk2(t[4], t[5]), pk2(t[6], t[7])};
                }
#pragma unroll 8
                for (int c = 0; c < 64; ++c) KS[c * 64 + lane] = (bf16_t)f2bf(bf2f(KS[c * 64 + lane]) * egS[c]);
                gdn_tinv(AS, TS, lane);
            }
        }
        LDS_WAIT();
        __syncthreads();
        if (active) {
            for (int rp_ = 0; rp_ < ((PREP_REP & 8) ? 2 : 1); ++rp_) {
            if (role == 0) gdn_tmul<false>(TS, QS, lane, 1.0f, GPU);
            else gdn_tmul<true>(TS, KS, lane, -1.0f, GPW);
            }
        }
        LDS_WAIT();
    }
}

constexpr int GS_STAGE = 40960 + 1024;
constexpr int GS_NSTAGE = 3;
constexpr int GS_OBUF = GS_NSTAGE * GS_STAGE;
static_assert(GS_OBUF + 16384 <= LDS_BYTES - 64, "gdn scan LDS");

#define GS_POST(n, ZQ) do { \
            if (n > 0) {         \
                LAS const bf16_t* ob = (LAS const bf16_t*)(lds + GS_OBUF + ((n - 1) & 1) * 8192); \
                const f32x4 gn = *(const f32x4*)(gnorm + 4 * vq); \
            _Pragma("unroll") \
                for (int it = 0; it < 8; ++it) { \
                    const int c = (wave - 2) * 32 + 4 * it + rg, p = (n - 1) * 64 + c; \
                    const u32x2 ov = *(LAS const u32x2*)(ob + c * 64 + 4 * vq); \
                    const float v0 = __uint_as_float(ov.x << 16), v1 = __uint_as_float(ov.x & 0xffff0000u), v2 = __uint_as_float(ov.y << 16), v3 = __uint_as_float(ov.y & 0xffff0000u); \
                    const float ss = row_sum16((v0 * v0 + v1 * v1) + (v2 * v2 + v3 * v3)); \
                    const float rn = __builtin_amdgcn_rsqf(ss * (1.0f / 64.0f) + EPS); \
                    const u32x2 zz = ZQ[it]; \
                    const float z0 = __uint_as_float(zz.x << 16), z1 = __uint_as_float(zz.x & 0xffff0000u), z2 = __uint_as_float(zz.y << 16), z3 = __uint_as_float(zz.y & 0xffff0000u); \
                    const float y0 = v0 * rn * gn[0] * z0, y1 = v1 * rn * gn[1] * z1, y2 = v2 * rn * gn[2] * z2, y3 = v3 * rn * gn[3] * z3;       \
                    { bf16_t* dst_ = ((p >= NMETA) && (p < LTOK)) ? MIX + (size_t)(b * SEQ + p - NMETA) * 1024 + 512 + h * 64 + 4 * vq : DUMP + lane * 4;       \
                      *(u32x2*)dst_ = (u32x2){pk2(y0, y1), pk2(y2, y3)}; } \
                } \
            } \
        } while (0)
DI void gdn_scan(const Params& P, LAS unsigned char* lds, int bh, int tid, int wave, int lane) {
    const int b = bh >> 3, h = bh & 7, r32 = lane & 31, hi = lane >> 5;
    const int task0 = (b * 8 + h) * NCHUNK;
    const bf16_t* GP0 = (const bf16_t*)(P.ws + WS_GP);
    const float* GLg = (const float*)(P.ws + WS_GL);
    const bf16_t* ZB = (const bf16_t*)(P.ws + WS_ZB); bf16_t* MIX = (bf16_t*)(P.ws + WS_MIX); const float* gnorm = P.in[12];
    bf16_t* DUMP = (bf16_t*)(P.ws + WS_DUMP) + bh * 4096 + wave * 512;
    const int lw = wave - 4;
    const int prow = lane >> 3, pch = lane & 7;
#define GS_DMA(n_, stg_) do { LAS unsigned char* sg_ = lds + (stg_) * GS_STAGE; \
        _Pragma("unroll") for (int i = 0; i < 10; ++i) { const int a_ = i >> 1, pi_ = lw * 2 + (i & 1), row_ = 8 * pi_ + prow; \
            const int sch_ = (a_ < 4) ? (pch ^ (row_ & 7)) : pch; \
            __builtin_amdgcn_global_load_lds((const unsigned*)(GP0 + (size_t)a_ * (GP_ARR / 2) + (size_t)(task0 + (n_)) * 4096 + row_ * 64 + sch_ * 8), \
                                             (LAS unsigned*)(sg_ + a_ * 8192 + pi_ * 1024), 16, 0, 0); } \
        __builtin_amdgcn_global_load_lds((const unsigned*)(GLg + task0 + (n_)), (LAS unsigned*)(sg_ + 40960 + lw * 256), 4, 0, 0); } while (0)
    if (wave >= 4) { GS_DMA(0, 0); GS_DMA(1, 1); asm volatile("s_waitcnt vmcnt(11)" ::: "memory"); }
    const int vq = lane & 15, rg = lane >> 4;
    u32x2 zqA[8], zqB[8];
#define GS_ZLOADX(ZQ, n_) do { _Pragma("unroll") for (int it = 0; it < 8; ++it) { int p_ = (n_) * 64 + (wave - 2) * 32 + 4 * it + rg; p_ = p_ < LTOK ? p_ : LTOK - 1; \
            ZQ[it] = *(const u32x2*)(ZB + (size_t)(b * LP + p_) * 512 + h * 64 + 4 * vq); } } while (0)
    if (wave == 2 || wave == 3) { GS_ZLOADX(zqB, 0); }
    BAR_LDS();
    f32x16 S0 = {}, S1 = {};
    const int vbase = 32 * wave;
    if (wave < 2) {
    int stg = 0;
    for (int n = 0; n <= NCHUNK; ++n) {
        {
            if (n < NCHUNK) {
                LAS const unsigned char* sg = lds + stg * GS_STAGE;
                LAS const bf16_t* Wm = (LAS const bf16_t*)sg; LAS const bf16_t* QGm = (LAS const bf16_t*)(sg + 8192); LAS const bf16_t* AQm = (LAS const bf16_t*)(sg + 16384);
                LAS const bf16_t* KGm = (LAS const bf16_t*)(sg + 24576); LAS const bf16_t* Um = (LAS const bf16_t*)(sg + 32768);
                const float gl = *(LAS const float*)(sg + 40960);
                bf16x8 Sb[2][2]; Sb[0][0] = pack8(S0, 0); Sb[0][1] = pack8(S0, 1); Sb[1][0] = pack8(S1, 0); Sb[1][1] = pack8(S1, 1);
                bf16x8 fw[2][4], fq[2][4];
                f32x16 vn[2], o[2];
#pragma unroll
                for (int ct = 0; ct < 2; ++ct)
#pragma unroll
                    for (int k4 = 0; k4 < 4; ++k4) { fw[ct][k4] = lds_frag(Wm, 32 * ct + r32, k4 * 2 + hi); fq[ct][k4] = lds_frag(QGm, 32 * ct + r32, k4 * 2 + hi); }
#pragma unroll
                for (int ct = 0; ct < 2; ++ct)
#pragma unroll
                    for (int i = 0; i < 16; ++i) vn[ct][i] = bf2f(Um[(32 * ct + crow(i, hi)) * 64 + vbase + r32]);
                o[0] = f32x16{}; o[1] = f32x16{};
                __builtin_amdgcn_sched_barrier(0);
#pragma unroll
                for (int k4 = 0; k4 < 4; ++k4) {
                    vn[0] = MFMA32(fw[0][k4], Sb[k4 >> 1][k4 & 1], vn[0]); o[0] = MFMA32(fq[0][k4], Sb[k4 >> 1][k4 & 1], o[0]);
                    vn[1] = MFMA32(fw[1][k4], Sb[k4 >> 1][k4 & 1], vn[1]); o[1] = MFMA32(fq[1][k4], Sb[k4 >> 1][k4 & 1], o[1]);
                }
                __builtin_amdgcn_sched_barrier(0);
                bf16x8 fa[2][4], fk[2][4];
#pragma unroll
                for (int g = 0; g < 4; ++g) { fa[0][g] = lds_frag(AQm, r32, g * 2 + hi); fa[1][g] = lds_frag(AQm, 32 + r32, g * 2 + hi);
                                              fk[0][g] = lds_frag(KGm, r32, g * 2 + hi); fk[1][g] = lds_frag(KGm, 32 + r32, g * 2 + hi); }
#pragma unroll
                for (int i = 0; i < 16; ++i) { S0[i] *= gl; S1[i] *= gl; }
                __builtin_amdgcn_sched_barrier(0);
                bf16x8 Vb[2][2]; Vb[0][0] = pack8(vn[0], 0); Vb[0][1] = pack8(vn[0], 1); Vb[1][0] = pack8(vn[1], 0); Vb[1][1] = pack8(vn[1], 1);
#pragma unroll
                for (int g = 0; g < 4; ++g) {
                    o[0] = MFMA32(fa[0][g], Vb[g >> 1][g & 1], o[0]); S0 = MFMA32(fk[0][g], Vb[g >> 1][g & 1], S0);
                    o[1] = MFMA32(fa[1][g], Vb[g >> 1][g & 1], o[1]); S1 = MFMA32(fk[1][g], Vb[g >> 1][g & 1], S1);
                }
                LAS bf16_t* ob = (LAS bf16_t*)(lds + GS_OBUF + (n & 1) * 8192);
#pragma unroll
                for (int ct = 0; ct < 2; ++ct)
#pragma unroll
                    for (int i = 0; i < 16; ++i) ob[(32 * ct + crow(i, hi)) * 64 + vbase + r32] = (bf16_t)f2bf(o[ct][i]);
            }
        }
        BAR_LDS();
        stg = stg + 1 >= GS_NSTAGE ? 0 : stg + 1;
    }
    } else if (wave < 4) {
    for (int n = 0; n <= NCHUNK; n += 2) {
        GS_POST(n, zqA);     if (n + 1 < NCHUNK) { GS_ZLOADX(zqA, n + 1); } BAR_LDS();
        GS_POST((n + 1), zqB); if (n + 2 < NCHUNK) { GS_ZLOADX(zqB, n + 2); } BAR_LDS();
    }
    } else {
    int stg = 0;
    for (int n = 0; n <= NCHUNK; ++n) {
        {
            if (n + 2 < NCHUNK) { const int s2_ = stg + 2 >= GS_NSTAGE ? stg + 2 - GS_NSTAGE : stg + 2; GS_DMA(n + 2, s2_); asm volatile("s_waitcnt vmcnt(11)" ::: "memory"); }
            else asm volatile("s_waitcnt vmcnt(0)" ::: "memory");
        }
        BAR_LDS();
        stg = stg + 1 >= GS_NSTAGE ? 0 : stg + 1;
    }
    }
#undef GS_DMA
#undef GS_ZLOADX
}
#define XB_TMO      128
#define XB_XCNT(j)  (256  + 64 * (j))
#define XB_XSUB(j)  (1280 + 64 * (j))
#define XB_XGEN(j)  (2304 + 64 * (j))
#define XB_TOP      3328
#define XB_TOPGEN   3392
#define XCD_BAR_WORDS 3456
#define XB_SPIN_CAP (1u << 18)

__device__ __forceinline__ unsigned xb_ld(unsigned* p)              { return __hip_atomic_load(p, __ATOMIC_RELAXED, __HIP_MEMORY_SCOPE_AGENT); }
__device__ __forceinline__ unsigned xb_add(unsigned* p, unsigned v) { return __hip_atomic_fetch_add(p, v, __ATOMIC_RELAXED, __HIP_MEMORY_SCOPE_AGENT); }
__device__ __forceinline__ unsigned xb_xcc_id() { return (unsigned)__builtin_amdgcn_s_getreg((3 << 11) | 20) & 0xFu; }
#define XB_SPIN(cond, bar) do { unsigned _sp = 0; while (cond) { __builtin_amdgcn_s_sleep(1); \
    if ((++_sp & 255u) == 0u) { if (xb_ld(&(bar)[XB_TMO])) break; if (_sp > XB_SPIN_CAP) { atomicAdd(&(bar)[XB_TMO], 1u); break; } } } } while (0)

struct XcdBarrier {
    unsigned* bar; unsigned x;
    volatile LAS unsigned* st;
};

__device__ __forceinline__ XcdBarrier xcd_barrier_post(unsigned* bar, volatile LAS unsigned* st) {
    XcdBarrier b; b.bar = bar; b.x = xb_xcc_id(); b.st = st;
    if (threadIdx.x == 0) (void)xb_add(&bar[XB_XCNT(b.x)], 1u);
    return b;
}
__device__ __forceinline__ void xcd_barrier_complete(unsigned* bar, unsigned x, unsigned& nloc, unsigned& nx) {
    const unsigned G = gridDim.x * gridDim.y * gridDim.z;
    unsigned sum, cnt, mine, sp = 0u;
    for (;;) {
        sum = 0u; cnt = 0u; mine = 0u;
#pragma unroll
        for (unsigned j = 0; j < 16; ++j) { const unsigned c = xb_ld(&bar[XB_XCNT(j)]); sum += c; cnt += (c > 0u) ? 1u : 0u; mine = (j == x) ? c : mine; }
        if (sum == G) break;
        __builtin_amdgcn_s_sleep(1);
        if ((++sp & 255u) == 0u) { if (xb_ld(&bar[XB_TMO])) break; if (sp > XB_SPIN_CAP) { atomicAdd(&bar[XB_TMO], 1u); break; } }
    }
    nloc = mine > 0u ? mine : 1u; nx = cnt > 0u ? cnt : 1u;
}

__device__ __forceinline__ void xcd_barrier(const XcdBarrier& b) {
    asm volatile("s_waitcnt vmcnt(0)" ::: "memory");
    __syncthreads();
    if (threadIdx.x == 0) {
        unsigned* bar = b.bar;
        __builtin_amdgcn_s_waitcnt(0);
        unsigned nloc = b.st[0], nx = b.st[1];
        if (nloc == 0u) { xcd_barrier_complete(bar, b.x, nloc, nx); b.st[0] = nloc; b.st[1] = nx; }
        const unsigned old = xb_add(&bar[XB_XSUB(b.x)], 1u);
        const unsigned gen = old / nloc;
        if (old + 1u == (gen + 1u) * nloc) {
            __builtin_amdgcn_fence(__ATOMIC_RELEASE, "agent");
            asm volatile("s_waitcnt vmcnt(0)" ::: "memory");
            const unsigned og = xb_add(&bar[XB_TOP], 1u);
            const unsigned tg = og / nx;
            if (og + 1u == (tg + 1u) * nx) xb_add(&bar[XB_TOPGEN], 1u);
            else XB_SPIN(xb_ld(&bar[XB_TOPGEN]) == tg, bar);
            __builtin_amdgcn_fence(__ATOMIC_ACQUIRE, "agent");
            xb_add(&bar[XB_XGEN(b.x)], 1u);
            asm volatile("s_waitcnt vmcnt(0)" ::: "memory");
        } else {
            XB_SPIN(xb_ld(&bar[XB_XGEN(b.x)]) == gen, bar);
            __builtin_amdgcn_fence(__ATOMIC_ACQUIRE, "agent");
            asm volatile("s_waitcnt vmcnt(0)" ::: "memory");
        }
    }
    __syncthreads();
}


constexpr int AT_STAGE = 32768;
constexpr int AT_NSTAGE = 3;
constexpr int AT_XBUF = 0;
constexpr int AT_WSF = AT_NSTAGE * AT_STAGE;
constexpr int AT_UNIT = AT_WSF + 2048;
constexpr float AT_THR = 8.0f;

DI float max3f(float a, float b, float c) { return __builtin_fmaxf(__builtin_fmaxf(a, b), c); }
DI s16x4 tr_read(LAS const unsigned char* p) { return __builtin_bit_cast(s16x4, __builtin_amdgcn_ds_read_tr16_b64_v4i16((LAS v4i16_t*)p)); }

template <int VAR> DI void attn_unit(const Params& P, LAS unsigned char* lds, int bh, int qi, int tid, int wave, int lane, float lam) {
    const int b = bh >> 2, h = bh & 3, r32 = lane & 31, hi = lane >> 5, qsub = wave >> 1, map = wave & 1, hh = 2 * h + map;
    const bf16_t* QB = (const bf16_t*)(P.ws + WS_QB); const bf16_t* KT = (const bf16_t*)(P.ws + WS_KT); const bf16_t* VT = (const bf16_t*)(P.ws + WS_VT);
    const int ntiles = 2 * qi + 3, my_nt = (qsub < 2) ? ntiles - 1 : ntiles;
    const bf16_t* k1 = KT + ((size_t)((b * 8 + 2 * h) * NKT) << 12) + tid * 8;
    const bf16_t* k2 = KT + ((size_t)((b * 8 + 2 * h + 1) * NKT) << 12) + tid * 8;
    const bf16_t* vv = VT + ((size_t)((b * 4 + h) * NKT) << 13) + tid * 8;
#define AT_DMA(t, sb) do { LAS unsigned char* d_ = lds + (sb) * AT_STAGE + wave * 1024; \
        __builtin_amdgcn_global_load_lds((const unsigned*)(k1 + ((size_t)(t) << 12)), (LAS unsigned*)d_, 16, 0, 0); \
        __builtin_amdgcn_global_load_lds((const unsigned*)(k2 + ((size_t)(t) << 12)), (LAS unsigned*)(d_ + 8192), 16, 0, 0); \
        __builtin_amdgcn_global_load_lds((const unsigned*)(vv + ((size_t)(t) << 13)), (LAS unsigned*)(d_ + 16384), 16, 0, 0); \
        __builtin_amdgcn_global_load_lds((const unsigned*)(vv + ((size_t)(t) << 13) + 4096), (LAS unsigned*)(d_ + 24576), 16, 0, 0); } while (0)
    bf16x8 qr[4];
    { const bf16_t* q = QB + ((size_t)((b * 8 + hh) * SEQ + qi * 128 + qsub * 32 + r32) << 6) + hi * 8;
#pragma unroll
      for (int d0 = 0; d0 < 4; ++d0) qr[d0] = *(const bf16x8*)(q + d0 * 16); }
    asm volatile("s_waitcnt vmcnt(0)" : "+v"(qr[0]), "+v"(qr[1]), "+v"(qr[2]), "+v"(qr[3]) :: "memory");
    AT_DMA(0, 0);
    if (ntiles > 1) AT_DMA(1, 1);
    if (ntiles > 1) asm volatile("s_waitcnt vmcnt(4)" ::: "memory"); else asm volatile("s_waitcnt vmcnt(0)" ::: "memory");
    BAR_LDS();
    LAS float* wsf = (LAS float*)(lds + AT_WSF) + wave * 64;
    float m_run = 0.f, l_run = 0.f;
    f32x16 negm = {};
    f32x16 o[4]; o[0] = f32x16{}; o[1] = f32x16{}; o[2] = f32x16{}; o[3] = f32x16{};
    for (int t = 0; t < ntiles; ++t) {
        if (t + 2 < ntiles) AT_DMA(t + 2, (t + 2) % AT_NSTAGE);
        if (t < my_nt) {
            LAS const unsigned char* sg = lds + (t % AT_NSTAGE) * AT_STAGE;
            LAS const unsigned char* kb = sg + map * 8192 + hi * 1024 + r32 * 16;
            f32x16 p0 = negm, p1 = negm;
            bf16x8 kf[8];
#pragma unroll
            for (int d0 = 0; d0 < 4; ++d0) { kf[2 * d0] = *(LAS const bf16x8*)(kb + d0 * 2048); kf[2 * d0 + 1] = *(LAS const bf16x8*)(kb + d0 * 2048 + 512); }
            __builtin_amdgcn_sched_barrier(0);
            __builtin_amdgcn_s_setprio(1);
#pragma unroll
            for (int d0 = 0; d0 < 4; ++d0) { p0 = MFMA32(kf[2 * d0], qr[d0], p0); p1 = MFMA32(kf[2 * d0 + 1], qr[d0], p1); }
            __builtin_amdgcn_s_setprio(0);
            const bool first = (t == 0);
            if (first) {
#pragma unroll
                for (int r = 0; r < 16; ++r) { if (crow(r, hi) >= NMETA) p0[r] = -INFINITY; p1[r] = -INFINITY; }
            }
            float ma = max3f(p0[0], p0[1], p1[0]), mb = max3f(p0[2], p0[3], p1[1]); ma = max3f(ma, p1[2], p1[3]);
#pragma unroll
            for (int r = 4; r < 16; r += 4) { ma = max3f(ma, p0[r], p0[r + 1]); mb = max3f(mb, p0[r + 2], p0[r + 3]); ma = max3f(ma, p1[r], p1[r + 1]); mb = max3f(mb, p1[r + 2], p1[r + 3]); }
            const float rm = swap32_max(max3f(ma, mb, mb));
            if (first || __any(rm > AT_THR)) {
                const float dl = first ? rm : fmaxf(rm, 0.f);
                m_run += dl;
#pragma unroll
                for (int r = 0; r < 16; ++r) { p0[r] -= dl; p1[r] -= dl; negm[r] = -m_run; }
                const float alpha = __builtin_amdgcn_exp2f(-dl);
                l_run *= alpha;
                if (!first) {
                    if (hi == 0) wsf[r32] = alpha;
                    LDS_WAIT();
#pragma unroll
                    for (int r = 0; r < 16; ++r) { const float a = wsf[crow(r, hi)];
#pragma unroll
                        for (int d0 = 0; d0 < 4; ++d0) o[d0][r] *= a; }
                    LDS_WAIT();
                }
            }
            float ls0 = 0.f, ls1 = 0.f;
#pragma unroll
            for (int r = 0; r < 16; ++r) { if (VAR != 2) { p0[r] = __builtin_amdgcn_exp2f(p0[r]); p1[r] = __builtin_amdgcn_exp2f(p1[r]); } ls0 += p0[r]; ls1 += p1[r]; }
            l_run += ls0 + ls1;
            const bf16x8 pa0 = pack8(p0, 0), pa1 = pack8(p0, 1), pa2 = pack8(p1, 0), pa3 = pack8(p1, 1);
            LAS const unsigned char* vb = sg + 16384 + ((lane >> 4) & 1) * 32 + (lane & 3) * 8 + (4 * hi + ((lane & 15) >> 2)) * 64;
            s16x4 va_[8], vb_[8];
            const unsigned vba = (unsigned)(uintptr_t)vb;
#define AT_VLD(V, d0_) do { _Pragma("unroll") for (int ks = 0; ks < 4; ++ks) { \
                asm volatile("ds_read_b64_tr_b16 %0, %1 offset:%c2" : "=v"(V[2 * ks]) : "v"(vba), "i"((d0_) * 4096 + ks * 1024)); \
                asm volatile("ds_read_b64_tr_b16 %0, %1 offset:%c2" : "=v"(V[2 * ks + 1]) : "v"(vba), "i"((d0_) * 4096 + ks * 1024 + 512)); } } while (0)
#define AT_VF(V, ks) ((bf16x8){V[2 * (ks)][0], V[2 * (ks)][1], V[2 * (ks)][2], V[2 * (ks)][3], V[2 * (ks) + 1][0], V[2 * (ks) + 1][1], V[2 * (ks) + 1][2], V[2 * (ks) + 1][3]})
#define AT_WAITL(n, V) do { asm volatile("s_waitcnt lgkmcnt(" #n ")" : "+v"(V[0]), "+v"(V[1]), "+v"(V[2]), "+v"(V[3]), "+v"(V[4]), "+v"(V[5]), "+v"(V[6]), "+v"(V[7])); __builtin_amdgcn_sched_barrier(0); } while (0)
#define AT_PV(V, d0_) do { __builtin_amdgcn_s_setprio(1); o[d0_] = MFMA32(pa0, AT_VF(V, 0), o[d0_]); o[d0_] = MFMA32(pa1, AT_VF(V, 1), o[d0_]); o[d0_] = MFMA32(pa2, AT_VF(V, 2), o[d0_]); o[d0_] = MFMA32(pa3, AT_VF(V, 3), o[d0_]); __builtin_amdgcn_s_setprio(0); } while (0)
            if (VAR != 1) {
            asm volatile("s_waitcnt lgkmcnt(0)" ::: "memory"); __builtin_amdgcn_sched_barrier(0);
            AT_VLD(va_, 0); AT_VLD(vb_, 1);
            AT_WAITL(8, va_); AT_PV(va_, 0); __builtin_amdgcn_sched_barrier(0); AT_VLD(va_, 2);
            AT_WAITL(8, vb_); AT_PV(vb_, 1); __builtin_amdgcn_sched_barrier(0); AT_VLD(vb_, 3);
            AT_WAITL(8, va_); AT_PV(va_, 2); __builtin_amdgcn_sched_barrier(0);
            AT_WAITL(0, vb_); AT_PV(vb_, 3);
            } else { o[0][0] += (float)pa0[0] + (float)pa1[1] + (float)pa2[2] + (float)pa3[3]; }
#undef AT_VF
#undef AT_WAITL
#undef AT_VLD
#undef AT_PV
        }
        if (t + 2 < ntiles) asm volatile("s_waitcnt vmcnt(4)" ::: "memory"); else asm volatile("s_waitcnt vmcnt(0)" ::: "memory");
        BAR_LDS();
    }
    if (VAR != 0) { if (o[0][0] + o[1][1] + o[2][2] + o[3][3] + l_run == 123.456f) ((float*)(P.ws + WS_DUMP))[tid] = 1.f; __syncthreads(); return; }
    l_run = swap32_add(l_run);
    const float sc = (map ? lam : 1.0f) / l_run;
    if (hi == 0) wsf[r32] = sc;
    LDS_WAIT();
#pragma unroll
    for (int r = 0; r < 16; ++r) { const float a = wsf[crow(r, hi)];
#pragma unroll
        for (int d0 = 0; d0 < 4; ++d0) o[d0][r] *= a; }
    LAS float* xb = (LAS float*)(lds + AT_XBUF + qsub * 16384);
    if (map) {
#pragma unroll
        for (int d0 = 0; d0 < 4; ++d0)
#pragma unroll
            for (int r = 0; r < 16; ++r) xb[(d0 * 16 + r) * 64 + lane] = o[d0][r];
    }
    __syncthreads();
    if (!map) {
        const float* dn = P.in[8];
        bf16_t* MIX = (bf16_t*)(P.ws + WS_MIX);
        float ss[16];
#pragma unroll
        for (int r = 0; r < 16; ++r) { ss[r] = 0.f;
#pragma unroll
            for (int d0 = 0; d0 < 4; ++d0) { o[d0][r] -= xb[(d0 * 16 + r) * 64 + lane]; ss[r] += o[d0][r] * o[d0][r]; } }
#pragma unroll
        for (int r = 0; r < 16; ++r) {
            ss[r] = half_sum32(ss[r]);
            ss[r] = 0.8f / sqrtf(ss[r] * (1.0f / 128.0f) + EPS);
        }
        float dg[4];
#pragma unroll
        for (int d0 = 0; d0 < 4; ++d0) dg[d0] = dn[32 * d0 + r32];
#pragma unroll
        for (int r = 0; r < 16; ++r) {
            bf16_t* orow = MIX + (size_t)(b * SEQ + qi * 128 + qsub * 32 + crow(r, hi)) * 1024 + h * 128 + r32;
#pragma unroll
            for (int d0 = 0; d0 < 4; ++d0) orow[32 * d0] = (bf16_t)f2bf(o[d0][r] * ss[r] * dg[d0]);
        }
    }
    __syncthreads();
#undef AT_DMA
}

template <int VAR> DI void attn_phase(const Params& P, LAS unsigned char* lds, int tid, int wave, int lane) {
    unsigned* ctl = (unsigned*)(P.ws + WS_CTL);
    const float* lq1 = P.in[4]; const float* lk1 = P.in[5]; const float* lq2 = P.in[6]; const float* lk2 = P.in[7];
    const float lam = __expf(wave_sum(lq1[lane] * lk1[lane])) - __expf(wave_sum(lq2[lane] * lk2[lane])) + 0.2f;
    LAS volatile int* ub = (LAS volatile int*)(lds + AT_UNIT);
    const unsigned x0 = xb_xcc_id() & 7u;
    for (;;) {
        if (tid == 0) {
            int u = -1;
            for (unsigned j = 0; j < 8u && u < 0; ++j) { const unsigned x = (x0 + j) & 7u;
                if (__hip_atomic_load(ctl + CW_ATTQ + 64 * x, __ATOMIC_RELAXED, __HIP_MEMORY_SCOPE_AGENT) >= 64u) continue;
                const unsigned i = __hip_atomic_fetch_add(ctl + CW_ATTQ + 64 * x, 1u, __ATOMIC_RELAXED, __HIP_MEMORY_SCOPE_AGENT);
                if (i < 64u) u = (int)(x * 64u + i); }
            *ub = u;
        }
        __syncthreads();
        const int u = *ub;
        __syncthreads();
        if (u < 0) break;
        attn_unit<VAR>(P, lds, u >> 6, 63 - (u & 63), tid, wave, lane, lam);
    }
}

struct EpiOutProj {
    static constexpr bool PERM = false, AFTER_DRAIN = false;
    const float* x; float* out; bf16_t* u2;
    DI void operator()(const pg8::f32x4 (&acc)[2][2][4][2], const pg8::Unit& u, int wr, int wc, int fr, int fq) const {
        const int row0 = u.pm * 256 + wr * 64 + fr, col0 = u.pn * 256 + wc * 32 + 4 * fq;
#pragma unroll
        for (int ai = 0; ai < 2; ++ai) {
            f32x4 xv[4][2][2];
#pragma unroll
            for (int m = 0; m < 4; ++m) { const size_t off = (size_t)(row0 + ai * 128 + m * 16) * 1024 + col0;
#pragma unroll
                for (int bj = 0; bj < 2; ++bj)
#pragma unroll
                    for (int n = 0; n < 2; ++n) xv[m][bj][n] = *(const f32x4*)(x + off + bj * 128 + n * 16); }
#pragma unroll
            for (int m = 0; m < 4; ++m) { const size_t off = (size_t)(row0 + ai * 128 + m * 16) * 1024 + col0;
#pragma unroll
                for (int bj = 0; bj < 2; ++bj)
#pragma unroll
                    for (int n = 0; n < 2; ++n) { const f32x4 hv = acc[ai][bj][m][n] + xv[m][bj][n]; *(f32x4*)(out + off + bj * 128 + n * 16) = hv;
                        *(u32x2*)(u2 + off + bj * 128 + n * 16) = (u32x2){pk2(hv[0], hv[1]), pk2(hv[2], hv[3])}; } }
        }
    }
};

typedef float f32x4v __attribute__((ext_vector_type(4)));
#ifdef ROUTE_PROBE
#define ROUTE_MID_HOOK() do { XcdBarrier xb2; xb2.bar = (unsigned*)(P.ws + WS_CTL) + CW_BAR; xb2.x = xb_xcc_id(); xb2.st = (volatile LAS unsigned*)(ldsb + LDS_BYTES - 64); xcd_barrier(xb2); \
    if (blockIdx.x == 0 && threadIdx.x == 0) __hip_atomic_store((unsigned long long*)(P.ws + WS_CTL + 65536) + 20, (unsigned long long)__builtin_amdgcn_s_memrealtime(), __ATOMIC_RELAXED, __HIP_MEMORY_SCOPE_AGENT); } while (0)
#else
#define ROUTE_MID_HOOK() do {} while (0)
#endif
DI void route_tile(const Params& P, int tile, int par, LAS float* sc  , int lane, LAS unsigned char* ldsb) {
    const float* h2 = P.out; const float* WR = (const float*)(P.ws + WS_WR);
    const int r16 = lane & 15, kq = lane >> 4;
    const float* arow = h2 + (size_t)(tile * 16 + r16) * 1024 + par * 512 + kq * 8;
    const float* b0 = WR + (size_t)r16 * 1024 + par * 512 + kq * 8; const float* b1 = b0 + 16 * 1024; const float* b2 = WR + (size_t)(32 + (r16 & 3)) * 1024 + par * 512 + kq * 8;
    const float z2 = (r16 < 4) ? 1.0f : 0.0f;
    f32x4v c0 = {}, c1 = {}, c2 = {};
    float ss = 0.f;
    f32x4 bA[4][4], bB[4][4];
#define RT_LOAD(B, tb) do { _Pragma("unroll") for (int j = 0; j < 4; ++j) { const int o_ = 32 * ((tb) + (j >> 1)) + 4 * (j & 1); \
        B[j][0] = *(const f32x4*)(arow + o_); B[j][1] = *(const f32x4*)(b0 + o_); B[j][2] = *(const f32x4*)(b1 + o_); B[j][3] = *(const f32x4*)(b2 + o_); } } while (0)
#define RT_COMP(B) do { _Pragma("unroll") for (int j = 0; j < 4; ++j) { const f32x4 a = B[j][0]; ss += (a.x * a.x + a.y * a.y) + (a.z * a.z + a.w * a.w); \
        _Pragma("unroll") for (int i = 0; i < 4; ++i) { c0 = __builtin_amdgcn_mfma_f32_16x16x4f32(a[i], B[j][1][i], c0, 0, 0, 0); \
            c1 = __builtin_amdgcn_mfma_f32_16x16x4f32(a[i], B[j][2][i], c1, 0, 0, 0); c2 = __builtin_amdgcn_mfma_f32_16x16x4f32(a[i], B[j][3][i] * z2, c2, 0, 0, 0); } } } while (0)
    RT_LOAD(bA, 0);
#pragma unroll
    for (int tb = 0; tb < 16; tb += 4) {
        RT_LOAD(bB, tb + 2); __builtin_amdgcn_sched_barrier(0); RT_COMP(bA); __builtin_amdgcn_sched_barrier(0);
        if (tb + 4 < 16) { RT_LOAD(bA, tb + 4); } __builtin_amdgcn_sched_barrier(0); RT_COMP(bB); __builtin_amdgcn_sched_barrier(0); }
#undef RT_LOAD
#undef RT_COMP
    ss += swz_xor16(ss); ss = swap32_add(ss);
    LAS float* my = sc + par * 800;
#pragma unroll
    for (int r = 0; r < 4; ++r) { const int row = 4 * kq + r; my[row * 48 + r16] = c0[r]; my[row * 48 + 16 + r16] = c1[r]; my[row * 48 + 32 + r16] = c2[r]; }
    if (lane < 16) my[768 + lane] = ss;
    LAS int* lcnt = (LAS int*)(ldsb + 4 * 32768 + 1024);
    if (threadIdx.x < 32) lcnt[threadIdx.x] = 0;
    int pa = 0, pb = 0, ea_ = 0, eb_ = 0; float w1_ = 0.f, w2_ = 0.f, rs_ = 0.f;
    LDS_WAIT();
    __syncthreads();
    ROUTE_MID_HOOK();
    if (par == 0 && lane < 16) {
        LAS const float* l0 = sc + lane * 48; LAS const float* l1 = sc + 800 + lane * 48;
        const float rs = __builtin_amdgcn_rsqf((sc[768 + lane] + sc[800 + 768 + lane]) * (1.0f / 1024.0f) + EPS);
#define LG(j) (l0[j] + l1[j])
        const int t = tile * 16 + lane;
        const float* bg = P.in[16]; const float* br = P.in[18];
        float gl[4]; int gs = 0; float gm;
#pragma unroll
        for (int j = 0; j < 4; ++j) gl[j] = LG(j) * rs + bg[j];
        gm = gl[0];
#pragma unroll
        for (int j = 1; j < 4; ++j) if (gl[j] > gm) { gm = gl[j]; gs = j; }
        float gsum = 0.f;
#pragma unroll
        for (int j = 0; j < 4; ++j) gsum += __expf(gl[j] - gm);
        const float psel = 1.0f / gsum;
        float e1 = -INFINITY, e2 = -INFINITY; int i1 = 0, i2 = 0;
#pragma unroll
        for (int j = 0; j < 8; ++j) {
            const float v = LG(4 + gs * 8 + j) * rs + br[gs * 8 + j];
            if (v > e1) { e2 = e1; i2 = i1; e1 = v; i1 = j; } else if (v > e2) { e2 = v; i2 = j; }
        }
        const float x2 = __expf(e2 - e1), w1 = psel / (1.0f + x2), w2 = psel * x2 / (1.0f + x2);
        const int ea = gs * 8 + i1, eb = gs * 8 + i2;
        pa = (int)__hip_atomic_fetch_add(lcnt + ea, 1, __ATOMIC_RELAXED, __HIP_MEMORY_SCOPE_WORKGROUP); pb = (int)__hip_atomic_fetch_add(lcnt + eb, 1, __ATOMIC_RELAXED, __HIP_MEMORY_SCOPE_WORKGROUP);
        ea_ = ea; eb_ = eb; w1_ = w1; w2_ = w2; rs_ = rs;
        ((int*)(P.ws + WS_TOKE))[2 * t] = ea; ((int*)(P.ws + WS_TOKE))[2 * t + 1] = eb;
        ((float*)(P.ws + WS_TOKW))[2 * t] = w1; ((float*)(P.ws + WS_TOKW))[2 * t + 1] = w2;
        ((float*)(P.ws + WS_RS2))[t] = rs;
#undef LG
    }
    LDS_WAIT();
    __syncthreads();
    if (threadIdx.x < 32) { const int c = lcnt[threadIdx.x];
        lcnt[32 + threadIdx.x] = c ? (int)atomicAdd((unsigned*)(P.ws + WS_CTL) + CW_CNT + 64 * threadIdx.x, (unsigned)c) : 0; }
    LDS_WAIT();
    __syncthreads();
    if (par == 0 && lane < 16) { const int t = tile * 16 + lane;
        const int qa = lcnt[32 + ea_] + pa, qb = lcnt[32 + eb_] + pb;
        ((int*)(P.ws + WS_TOKP))[2 * t] = qa; ((int*)(P.ws + WS_TOKP))[2 * t + 1] = qb;
        ((int*)(P.ws + WS_LIST))[ea_ * 16384 + qa] = t; ((int*)(P.ws + WS_LIST))[eb_ * 16384 + qb] = t;
        ((float*)(P.ws + WS_LISTW))[ea_ * 16384 + qa] = w1_; ((float*)(P.ws + WS_LISTW))[eb_ * 16384 + qb] = w2_;
        ((float*)(P.ws + WS_LISTRS))[ea_ * 16384 + qa] = rs_; ((float*)(P.ws + WS_LISTRS))[eb_ * 16384 + qb] = rs_; }
    LDS_WAIT();
    __syncthreads();
}

#ifndef P4A_REP
#define P4A_REP 0
#endif
template <int P4A_PART> DI void phase4a(const Params& P, LAS unsigned char* lds, int gw, int NGW, int wave, int lane) {
    LAS float* scr = (LAS float*)(lds + wave * 16384);
    if (P4A_PART & 1) for (int tile = (gw >> 1); tile < MTOK / 16; tile += (NGW >> 1)) route_tile(P, tile, wave & 1, (LAS float*)(lds + (wave >> 1) * 32768), lane, lds);
    if (!(P4A_PART & 2)) return;
    bf16_t* WGU = (bf16_t*)(P.ws + WS_WGU); bf16_t* WD = (bf16_t*)(P.ws + WS_WD);
    const float* wg = P.in[19]; const float* wu = P.in[20]; const float* wd = P.in[21]; const float* gf = P.in[14];
    constexpr int I_GU = 16 * 16, I_D = 4 * 32, NIT = 32 * (I_GU + I_D);
    struct TItem { const float* src; const float* gn; bf16_t* dst; int stride, ldk; };
    auto mk = [&](int it) { TItem d; const int e = it / (I_GU + I_D), r = it % (I_GU + I_D);
        if (r < I_GU) { const int n0 = (r & 15) * 32, j = n0 >> 8, up = (n0 >> 7) & 1, k0 = (r >> 4) * 64;
            d.src = (up ? wu : wg) + (size_t)e * 1024 * 256 + (size_t)k0 * 256 + 128 * j + (n0 & 127); d.gn = gf + k0; d.stride = 256; d.ldk = 1024;
            d.dst = WGU + (size_t)e * 512 * 1024 + (size_t)n0 * 1024 + k0; }
        else { const int r2 = r - I_GU, k0 = (r2 >> 5) * 64, n0 = (r2 & 31) * 32;
            d.src = wd + (size_t)e * 256 * 1024 + (size_t)k0 * 1024 + n0; d.gn = nullptr; d.stride = 1024; d.ldk = 256;
            d.dst = WD + (size_t)e * 1024 * 256 + (size_t)n0 * 256 + k0; }
        return d; };
#define TI_LOAD(D, V) do { _Pragma("unroll") for (int i = 0; i < 32; ++i) { const int kk = 2 * i + (lane >> 5); \
        V[i] = D.src[(size_t)kk * D.stride + (lane & 31)] * (D.gn ? D.gn[kk] : 1.0f); } } while (0)
#define TI_FIN(D, V) do { _Pragma("unroll") for (int i = 0; i < 32; ++i) scr[(2 * i + (lane >> 5)) * 33 + (lane & 31)] = V[i]; \
        LDS_WAIT(); const int c_ = lane & 7; \
        _Pragma("unroll") for (int j = 0; j < 4; ++j) { const int n_ = (lane >> 3) + 8 * j; const LAS float* s_ = scr + (8 * c_) * 33 + n_; \
            u32x4 o_; o_.x = pk2(s_[0 * 33], s_[1 * 33]); o_.y = pk2(s_[2 * 33], s_[3 * 33]); o_.z = pk2(s_[4 * 33], s_[5 * 33]); o_.w = pk2(s_[6 * 33], s_[7 * 33]); \
            *(u32x4*)(D.dst + (size_t)n_ * D.ldk + 8 * c_) = o_; } \
        LDS_WAIT(); } while (0)
    for (int rp_ = 0; rp_ < (P4A_REP ? 2 : 1); ++rp_) {
        float va[32], vb[32];
        int it = gw;
        if (it < NIT) { TItem da = mk(it); TI_LOAD(da, va);
            for (;;) {
                const int itb = it + NGW; TItem db = da; const bool hb = itb < NIT;
                if (hb) { db = mk(itb); TI_LOAD(db, vb); }
                TI_FIN(da, va);
                if (!hb) break;
                it = itb + NGW; const bool ha = it < NIT;
                if (ha) { da = mk(it); TI_LOAD(da, va); }
                TI_FIN(db, vb);
                if (!ha) break;
            }
        }
    }
#undef TI_LOAD
#undef TI_FIN
}

DI void expert_layout(const Params& P, int lane, int& cnt, int& base, int& tend) {
    const unsigned* c = (const unsigned*)(P.ws + WS_CTL) + CW_CNT;
    cnt = (lane < 32) ? (int)__hip_atomic_load(c + 64 * lane, __ATOMIC_RELAXED, __HIP_MEMORY_SCOPE_AGENT) : 0;
    const int tiles = (cnt + 255) >> 8;
    int inc = 0;
#pragma unroll
    for (int i = 0; i < 32; ++i) { const int ti = __builtin_amdgcn_readlane(tiles, i); inc += (i <= lane) ? ti : 0; }
    tend = inc; base = (inc - tiles) << 8;
}

DI void phase4b(const Params& P, int gw, int NGW, int lane) {
    int cnt, base, tend; expert_layout(P, lane, cnt, base, tend);
    bf16_t* XS = (bf16_t*)(P.ws + WS_XS); float* SLOTW = (float*)(P.ws + WS_SLOTW);
    const int* TOKE = (const int*)(P.ws + WS_TOKE); const float* TOKW = (const float*)(P.ws + WS_TOKW); int* TOKP = (int*)(P.ws + WS_TOKP); const float* RS2 = (const float*)(P.ws + WS_RS2);
    for (int t = gw; t < MTOK; t += NGW) {
        const f32x4* hr = (const f32x4*)(P.out + (size_t)t * 1024);
        const float rs = RS2[t];
        u32x2 w[4];
#pragma unroll
        for (int j = 0; j < 4; ++j) { const f32x4 v = hr[64 * j + lane]; w[j] = (u32x2){pk2(v.x * rs, v.y * rs), pk2(v.z * rs, v.w * rs)}; }
#pragma unroll
        for (int k = 0; k < 2; ++k) {
            const int e = __builtin_amdgcn_readfirstlane(TOKE[2 * t + k]), slot = __builtin_amdgcn_readlane(base, e) + TOKP[2 * t + k];
            u32x2* orow = (u32x2*)(XS + (size_t)slot * 1024);
#pragma unroll
            for (int j = 0; j < 4; ++j) orow[64 * j + lane] = w[j];
            if (lane == 0) { SLOTW[slot] = TOKW[2 * t + k]; TOKP[2 * t + k] = slot; }
        }
    }
    for (int e = 0; e < 32; ++e) {
        const int ce = __builtin_amdgcn_readlane(cnt, e), be = __builtin_amdgcn_readlane(base, e), end = be + (((ce + 255) >> 8) << 8);
        for (int r = be + ce + gw; r < end; r += NGW) { u32x2* orow = (u32x2*)(XS + (size_t)r * 1024);
#pragma unroll
            for (int j = 0; j < 4; ++j) orow[64 * j + lane] = (u32x2){0u, 0u};
            if (lane == 0) SLOTW[r] = 0.f; }
    }
}

#define XCD_ORDER(blk_, G_) ((((G_) & 7) == 0) ? ((blk_) & 7) * ((G_) >> 3) + ((blk_) >> 3) : (blk_))
struct GroupedOrder {
    int tend; int total; int G, c, NS; int cnt, base; const int* LIST;
    DI unsigned rowoff(const pg8::Unit& u, int r) const {
        const int e = __builtin_amdgcn_readfirstlane(u.pn >> NS), ce = __builtin_amdgcn_readlane(cnt, e), t0 = __builtin_amdgcn_readlane(base, e) >> 8;
        const int pos = (u.pm - t0) * 256 + r;
        const int tok = pos < ce ? LIST[e * 16384 + pos] : 0;
        return (unsigned)tok * 2048u;
    }
    DI bool next(int i, pg8::Unit& u) const {
        const int L = i * G + c; if (L >= (total << NS)) return false;
        const int mt = L >> NS, j = L & ((1 << NS) - 1);
        const int e = __builtin_popcountll(__ballot(((int)(threadIdx.x & 63) < 32) && tend <= mt));
        u.pm = mt; u.pn = (e << NS) + j; return true;
    }
    DI void a_ready(const pg8::Unit&) const {}
    DI void done(const pg8::Unit&) const {}
};
struct EpiGateUp {
    static constexpr bool PERM = true, AFTER_DRAIN = false;
    const float* LISTW; const float* LISTRS; bf16_t* YS; int cnt, base;
    DI void operator()(const pg8::f32x4 (&acc)[2][2][4][2], const pg8::Unit& u, int wr, int wc, int fr, int fq) const {
        const int f0 = (u.pn & 1) * 128 + wc * 32 + fq * 8;
        const int e = __builtin_amdgcn_readfirstlane(u.pn >> 1), ce = __builtin_amdgcn_readlane(cnt, e), t0 = __builtin_amdgcn_readlane(base, e) >> 8;
#pragma unroll
        for (int ai = 0; ai < 2; ++ai)
#pragma unroll
            for (int m = 0; m < 4; ++m) {
                const int r = ai * 128 + wr * 64 + m * 16 + fr, row = u.pm * 256 + r, pos = (u.pm - t0) * 256 + r;
                const bool ok = pos < ce;
                const float cw = ok ? LISTW[e * 16384 + pos] : 0.f, rs = ok ? LISTRS[e * 16384 + pos] : 0.f, cr = cw * rs;
                float a[8];
#pragma unroll
                for (int i = 0; i < 4; ++i) {
                    const float g0 = acc[ai][0][m][0][i] * rs, g1 = acc[ai][0][m][1][i] * rs;
                    a[i] = g0 * __builtin_amdgcn_rcpf(1.0f + __expf(-g0)) * acc[ai][1][m][0][i] * cr; a[4 + i] = g1 * __builtin_amdgcn_rcpf(1.0f + __expf(-g1)) * acc[ai][1][m][1][i] * cr;
                }
                *(u32x4*)(YS + (size_t)row * 256 + f0) = (u32x4){pk2(a[0], a[1]), pk2(a[2], a[3]), pk2(a[4], a[5]), pk2(a[6], a[7])};
            }
    }
};
struct EpiDown {
    static constexpr bool PERM = true, AFTER_DRAIN = false;
    bf16_t* YO;
    DI void operator()(const pg8::f32x4 (&acc)[2][2][4][2], const pg8::Unit& u, int wr, int wc, int fr, int fq) const {
        const int c0 = (u.pn & 3) * 256 + wc * 32 + fq * 8;
#pragma unroll
        for (int ai = 0; ai < 2; ++ai)
#pragma unroll
            for (int m = 0; m < 4; ++m) {
                bf16_t* rowp = YO + (size_t)(u.pm * 256 + ai * 128 + wr * 64 + m * 16 + fr) * 1024 + c0;
#pragma unroll
                for (int bj = 0; bj < 2; ++bj) { const pg8::f32x4 v0 = acc[ai][bj][m][0], v1 = acc[ai][bj][m][1];
                    *(u32x4*)(rowp + bj * 128) = (u32x4){pk2(v0[0], v0[1]), pk2(v0[2], v0[3]), pk2(v1[0], v1[1]), pk2(v1[2], v1[3])}; }
            }
    }
};

DI void phase7(const Params& P, int gw, int NGW, int lane) {
    int cnt_, base_, tend_; expert_layout(P, lane, cnt_, base_, tend_);
    const bf16_t* YO = (const bf16_t*)(P.ws + WS_YO); const int* TOKP = (const int*)(P.ws + WS_TOKP); const int* TOKE = (const int*)(P.ws + WS_TOKE); const f32x4* nf = (const f32x4*)P.in[22];
    f32x4 nfv[4];
#pragma unroll
    for (int j = 0; j < 4; ++j) nfv[j] = nf[64 * j + lane];
    for (int t0 = gw; t0 < MTOK; t0 += 2 * NGW) {
        f32x4 v[2][4]; u32x2 hv[2][4], ya[2][4], yb[2][4];
#pragma unroll
        for (int r = 0; r < 2; ++r) { const int t = (t0 + r * NGW) < MTOK ? (t0 + r * NGW) : t0;
            const u32x2* hr = (const u32x2*)((const bf16_t*)(P.ws + WS_U2) + (size_t)t * 1024);
            const int e0 = __builtin_amdgcn_readfirstlane(TOKE[2 * t]), e1 = __builtin_amdgcn_readfirstlane(TOKE[2 * t + 1]);
            const int s0 = __builtin_amdgcn_readlane(base_, e0) + TOKP[2 * t], s1 = __builtin_amdgcn_readlane(base_, e1) + TOKP[2 * t + 1];
            const u32x2* y0 = (const u32x2*)(YO + (size_t)s0 * 1024); const u32x2* y1 = (const u32x2*)(YO + (size_t)s1 * 1024);
#pragma unroll
            for (int j = 0; j < 4; ++j) { hv[r][j] = hr[64 * j + lane]; ya[r][j] = y0[64 * j + lane]; yb[r][j] = y1[64 * j + lane]; } }
#pragma unroll
        for (int r = 0; r < 2; ++r) { const int t = t0 + r * NGW;
            if (t < MTOK) {
                float s = 0.f;
#pragma unroll
                for (int j = 0; j < 4; ++j) { const u32x2 a = ya[r][j], c = yb[r][j], hq = hv[r][j];
                    v[r][j] = (f32x4){__uint_as_float(hq.x << 16), __uint_as_float(hq.x & 0xffff0000u), __uint_as_float(hq.y << 16), __uint_as_float(hq.y & 0xffff0000u)};
                    v[r][j].x += __uint_as_float(a.x << 16) + __uint_as_float(c.x << 16); v[r][j].y += __uint_as_float(a.x & 0xffff0000u) + __uint_as_float(c.x & 0xffff0000u);
                    v[r][j].z += __uint_as_float(a.y << 16) + __uint_as_float(c.y << 16); v[r][j].w += __uint_as_float(a.y & 0xffff0000u) + __uint_as_float(c.y & 0xffff0000u);
                    s += (v[r][j].x * v[r][j].x + v[r][j].y * v[r][j].y) + (v[r][j].z * v[r][j].z + v[r][j].w * v[r][j].w); }
                s = wave_sum(s);
                const float rs = __builtin_amdgcn_rsqf(s * (1.0f / 1024.0f) + EPS);
                f32x4* hw = (f32x4*)(P.out + (size_t)t * 1024);
#pragma unroll
                for (int j = 0; j < 4; ++j) hw[64 * j + lane] = v[r][j] * rs * nfv[j];
            } }
    }
}

struct EpiNull { static constexpr bool PERM = true, AFTER_DRAIN = false; float* d;
    DI void operator()(const pg8::f32x4 (&acc)[2][2][4][2], const pg8::Unit& u, int wr, int wc, int fr, int fq) const {
        pg8::f32x4 s = acc[0][0][0][0];
#pragma unroll
        for (int ai = 0; ai < 2; ++ai)
#pragma unroll
            for (int bj = 0; bj < 2; ++bj)
#pragma unroll
                for (int m = 0; m < 4; ++m)
#pragma unroll
                    for (int n = 0; n < 2; ++n) s += acc[ai][bj][m][n];
        if (s[0] == 12345.678f) d[threadIdx.x] = s[1] + s[2] + s[3]; } };
#ifndef PHMASK
#define PHMASK 2047
#endif
#ifndef P1_STAGGER_TICKS
#define P1_STAGGER_TICKS 0
#endif
#ifndef ATT_VAR
#define ATT_VAR 0
#endif
#ifndef REPMASK
#define REPMASK 0
#endif
#define REP(bit) for (int rep_ = 0; rep_ < ((REPMASK & (bit)) ? 2 : 1); ++rep_)
#define REPSYNC(bit) if ((REPMASK & (bit)) && rep_ == 0) GRID_BAR()
typedef const __attribute__((address_space(4))) Params* KParams;
DI Params load_params(KParams kp) { Params p;
#pragma unroll
    for (int i = 0; i < 23; ++i) p.in[i] = kp->in[i];
    p.out = kp->out; p.ws = kp->ws; return p; }
__global__ void __launch_bounds__(NTHREADS, 2) hymba_fwd(Params Pin) {
    extern __shared__ __attribute__((aligned(16))) unsigned char lds_raw[];
    LAS unsigned char* lds = (LAS unsigned char*)lds_raw;
    cg::grid_group grid = cg::this_grid();
    volatile LAS unsigned* bst = (volatile LAS unsigned*)(lds + LDS_BYTES - 64);
    if (threadIdx.x < 2) bst[threadIdx.x] = 0u;
    __syncthreads();
    const XcdBarrier xbar = xcd_barrier_post((unsigned*)(Pin.ws + WS_CTL) + CW_BAR, bst);
#ifndef TPROBE
#define TPROBE (-1)
#endif
#ifndef TPROBE_A
#define TPROBE_A TPROBE
#define TPROBE_B (TPROBE + 1)
#endif
    int nstamp_ = 0;
#define STAMP() do { if (TPROBE >= 0) { if (blockIdx.x == 0 && threadIdx.x == 0) __hip_atomic_store((unsigned long long*)(Pin.ws + WS_CTL + 65536) + nstamp_, (unsigned long long)__builtin_amdgcn_s_memrealtime(), __ATOMIC_RELAXED, __HIP_MEMORY_SCOPE_AGENT); ++nstamp_; } } while (0)
#define GRID_BAR() do { xcd_barrier(xbar); STAMP(); } while (0)
    STAMP();
    const int G = gridDim.x, blk = blockIdx.x, NGW = G * NWAVES, NGT = G * NTHREADS;
#define PHASE_IDS() KParams kp_ = (KParams)__builtin_amdgcn_kernarg_segment_ptr(); asm volatile("" : "+s"(kp_)); const Params P = load_params(kp_); int tid = threadIdx.x; asm volatile("" : "+v"(tid)); const int lane = tid & 63, wave = __builtin_amdgcn_readfirstlane(tid >> 6), gw = blk * NWAVES + wave, gtid = blk * NTHREADS + tid; (void)lane; (void)gw; (void)gtid; (void)wave

    REP(1) { if (PHMASK & 1) { PHASE_IDS(); phase0(P, lds, gw, NGW, gtid, NGT, wave, lane); } REPSYNC(1); }
    GRID_BAR();
#ifdef P1_EV
#define P1_PASS(DM) { PHASE_IDS(); \
        pg8::Gemm g{(const bf16_t*)(P.ws + WS_XB), (const bf16_t*)(P.ws + WS_WINT), MROWS, NPROJ, 1024}; \
        pg8::StaticOrder S; S.init(MROWS, NPROJ, G, blk); \
        EpiInProjT<P1_EV> E{(const float*)(P.ws + WS_RS1), (const float*)(P.ws + WS_COS), (const float*)(P.ws + WS_SIN), P.in[10], P.in[11], \
                    (bf16_t*)(P.ws + WS_QB), (bf16_t*)(P.ws + WS_KT), (bf16_t*)(P.ws + WS_VT), (bf16_t*)(P.ws + WS_QKVB), (bf16_t*)(P.ws + WS_ZB), (float*)(P.ws + WS_GB), P.ws + 248 * MiB, DM, (unsigned long long*)(P.ws + WS_CTL + 65536) + 40}; \
        pg8::gemm_phase<EpiInProjT<P1_EV>, pg8::StaticOrder, true, true>(lds, g, S, E); } GRID_BAR();
    P1_PASS(0)
    P1_PASS(1)
#else
    REP(2) { if (PHMASK & 2) { PHASE_IDS();
        pg8::Gemm g{(const bf16_t*)(P.ws + WS_XB), (const bf16_t*)(P.ws + WS_WINT), MROWS, NPROJ, 1024};
        if (P1_STAGGER_TICKS > 0 && (blk & 1)) { const unsigned long long s0_ = __builtin_amdgcn_s_memrealtime(); while (__builtin_amdgcn_s_memrealtime() - s0_ < (unsigned long long)P1_STAGGER_TICKS) __builtin_amdgcn_s_sleep(8); }
        pg8::StaticOrder S; S.init(MROWS, NPROJ, G, blk);
#ifdef P1_EV
        EpiInProjT<P1_EV> E{(const float*)(P.ws + WS_RS1), (const float*)(P.ws + WS_COS), (const float*)(P.ws + WS_SIN), P.in[10], P.in[11],
                    (bf16_t*)(P.ws + WS_QB), (bf16_t*)(P.ws + WS_KT), (bf16_t*)(P.ws + WS_VT), (bf16_t*)(P.ws + WS_QKVB), (bf16_t*)(P.ws + WS_ZB), (float*)(P.ws + WS_GB), P.ws + 248 * MiB, rep_, (unsigned long long*)(P.ws + WS_CTL + 65536) + 40};
        pg8::gemm_phase<EpiInProjT<P1_EV>, pg8::StaticOrder, true, true>(lds, g, S, E);
#else
        EpiInProj E{(const float*)(P.ws + WS_RS1), (const float*)(P.ws + WS_COS), (const float*)(P.ws + WS_SIN), P.in[10], P.in[11],
                    (bf16_t*)(P.ws + WS_QB), (bf16_t*)(P.ws + WS_KT), (bf16_t*)(P.ws + WS_VT), (bf16_t*)(P.ws + WS_QKVB), (bf16_t*)(P.ws + WS_ZB), (float*)(P.ws + WS_GB), P.ws + 248 * MiB, 0, (unsigned long long*)(P.ws + WS_CTL + 65536) + 40};
        if (rep_ == 0) pg8::gemm_phase<EpiInProj, pg8::StaticOrder, true, true>(lds, g, S, E);
        else { EpiNull EN{(float*)(P.ws + WS_DUMP)}; pg8::gemm_phase<EpiNull, pg8::StaticOrder, true, true>(lds, g, S, EN); }
#endif
    } REPSYNC(2); }
    GRID_BAR();
#endif
    REP(4) { if (PHMASK & 4) { PHASE_IDS(); gdn_prep_phase(P, lds, blk, G, wave, lane); } REPSYNC(4); }
    {
        unsigned* prep = (unsigned*)(Pin.ws + WS_CTL) + CW_PREP;
        asm volatile("s_waitcnt vmcnt(0)" ::: "memory");
        __syncthreads();
        if (threadIdx.x == 0) { __builtin_amdgcn_fence(__ATOMIC_RELEASE, "agent"); asm volatile("s_waitcnt vmcnt(0)" ::: "memory");
            __hip_atomic_fetch_add(prep, 1u, __ATOMIC_RELAXED, __HIP_MEMORY_SCOPE_AGENT); }
        if (blk < 16) {
            if (threadIdx.x == 0) { unsigned sp = 0;
                while (__hip_atomic_load(prep, __ATOMIC_RELAXED, __HIP_MEMORY_SCOPE_AGENT) < (unsigned)G) { __builtin_amdgcn_s_sleep(2); if (++sp > (1u << 22)) break; }
                __builtin_amdgcn_fence(__ATOMIC_ACQUIRE, "agent"); asm volatile("s_waitcnt vmcnt(0)" ::: "memory"); }
            __syncthreads();
        }
    }
    REP(8) { if ((PHMASK & 8) && blk < 16) { PHASE_IDS(); gdn_scan(P, lds, blk, tid, wave, lane); } }
    REP(16) {
    if (PHMASK & 16) { PHASE_IDS(); if (rep_ == 0) attn_phase<0>(P, lds, tid, wave, lane); else attn_phase<ATT_VAR>(P, lds, tid, wave, lane); }
    if ((REPMASK & 16) && rep_ == 0) { GRID_BAR(); if (blk == 0 && threadIdx.x < 8) { PHASE_IDS(); __hip_atomic_store((unsigned*)(P.ws + WS_CTL) + CW_ATTQ + 64 * threadIdx.x, 0u, __ATOMIC_RELAXED, __HIP_MEMORY_SCOPE_AGENT); } GRID_BAR(); }
    }
    GRID_BAR();
    REP(32) { if (PHMASK & 32) { PHASE_IDS();
        pg8::Gemm g{(const bf16_t*)(P.ws + WS_MIX), (const bf16_t*)(P.ws + WS_WOUT), MTOK, 1024, 1024};
        pg8::StaticOrder S; S.init(MTOK, 1024, G, blk);
        EpiOutProj E{P.in[0], P.out, (bf16_t*)(P.ws + WS_U2)};
        pg8::gemm_phase<EpiOutProj, pg8::StaticOrder, true, true>(lds, g, S, E);
    } REPSYNC(32); }
    GRID_BAR();
#ifdef P4A_SPLIT
    if (PHMASK & 64) { PHASE_IDS(); phase4a<1>(P, lds, gw, NGW, wave, lane); }
    GRID_BAR();
    if (PHMASK & 64) { PHASE_IDS(); phase4a<2>(P, lds, gw, NGW, wave, lane); }
#else
    if (PHMASK & 64) { PHASE_IDS(); phase4a<3>(P, lds, gw, NGW, wave, lane); }
#endif
    GRID_BAR();
    int cnt, base, tend, total; { PHASE_IDS(); expert_layout(P, lane, cnt, base, tend); total = __builtin_amdgcn_readlane(tend, 31); }
    REP(256) { if (PHMASK & 256) { PHASE_IDS();
        pg8::Gemm g{(const bf16_t*)(P.ws + WS_U2), (const bf16_t*)(P.ws + WS_WGU), XS_ROWS, 32 * 512, 1024};
        GroupedOrder S{tend, total, G, XCD_ORDER(blk, G), 1, cnt, base, (const int*)(P.ws + WS_LIST)};
        EpiGateUp E{(const float*)(P.ws + WS_LISTW), (const float*)(P.ws + WS_LISTRS), (bf16_t*)(P.ws + WS_YS), cnt, base};
        pg8::gemm_phase_g<EpiGateUp, GroupedOrder, true, true>(lds, g, S, E);
    } REPSYNC(256); }
    GRID_BAR();
    REP(512) { if (PHMASK & 512) { PHASE_IDS();
        int kd = 256; asm volatile("" : "+s"(kd));
        pg8::Gemm g{(const bf16_t*)(P.ws + WS_YS), (const bf16_t*)(P.ws + WS_WD), XS_ROWS, 32 * 1024, kd};
        GroupedOrder S{tend, total, G, XCD_ORDER(blk, G), 2, cnt, base, (const int*)(P.ws + WS_LIST)};
        EpiDown E{(bf16_t*)(P.ws + WS_YO)};
        pg8::gemm_phase<EpiDown, GroupedOrder, true, true>(lds, g, S, E);
    } REPSYNC(512); }
    GRID_BAR();
    if (PHMASK & 1024) { PHASE_IDS(); phase7(P, gw, NGW, lane); }
    if (TPROBE >= 0) {
        GRID_BAR();
        const unsigned long long* st = (const unsigned long long*)(Pin.ws + WS_CTL + 65536);
        const unsigned long long t0 = __hip_atomic_load(st + TPROBE_A, __ATOMIC_RELAXED, __HIP_MEMORY_SCOPE_AGENT), t1 = __hip_atomic_load(st + TPROBE_B, __ATOMIC_RELAXED, __HIP_MEMORY_SCOPE_AGENT);
        const unsigned long long dt = (t1 - t0) * 4ull, s0 = __builtin_amdgcn_s_memrealtime();
        while (__builtin_amdgcn_s_memrealtime() - s0 < dt) __builtin_amdgcn_s_sleep(8);
    }
}

extern "C" void kernel_launch(void* const* d_in, const int* in_sizes, int n_in, void* d_out, int out_size, void* d_ws, size_t ws_size, hipStream_t stream) {
    static int grid_blocks = 0;
    if (grid_blocks == 0) {
        if (n_in != 23 || out_size != MTOK * DMODEL || ws_size < WS_END) { fprintf(stderr, "kernel_launch: unexpected shapes (n_in %d out %d ws %zu)\n", n_in, out_size, ws_size); grid_blocks = -1; return; }
        int dev = 0, cus = 0, per_cu = 0;
        hipGetDevice(&dev);
        hipDeviceGetAttribute(&cus, hipDeviceAttributeMultiprocessorCount, dev);
        hipFuncSetAttribute((const void*)hymba_fwd, hipFuncAttributeMaxDynamicSharedMemorySize, LDS_BYTES);
        hipOccupancyMaxActiveBlocksPerMultiprocessor(&per_cu, (const void*)hymba_fwd, NTHREADS, LDS_BYTES);
        if (per_cu < 1) { fprintf(stderr, "kernel_launch: occupancy query says %d blocks/CU\n", per_cu); per_cu = 1; }
        grid_blocks = cus;
        (void)hipGetLastError();
    }
    if (grid_blocks < 0) return;
    hipMemsetAsync((char*)d_ws + WS_CTL, 0, CTL_BYTES, stream);
    Params p{};
    for (int i = 0; i < 23; ++i) p.in[i] = (const float*)d_in[i];
    p.out = (float*)d_out; p.ws = (unsigned char*)d_ws;
    void* args[] = {&p};
    hipError_t e = hipLaunchCooperativeKernel((const void*)hymba_fwd, dim3(grid_blocks), dim3(NTHREADS), args, LDS_BYTES, stream);
    if (e != hipSuccess) fprintf(stderr, "cooperative launch failed: %s (grid %d)\n", hipGetErrorString(e), grid_blocks);
}
```

```cpp
#include <hip/hip_runtime.h>
#include <hip/hip_cooperative_groups.h>
#include <cstdio>
#include <cstdint>
namespace cg = cooperative_groups;
#ifndef PG8_EPI_AGAIN
#define PG8_EPI_AGAIN(x) do {} while (0)
#endif
namespace pg8 {
#define PG8_LAS __attribute__((address_space(3)))
typedef unsigned short bf16_t;
typedef short bf16x8 __attribute__((ext_vector_type(8)));
typedef float f32x4 __attribute__((ext_vector_type(4)));
typedef unsigned u32x4 __attribute__((ext_vector_type(4)));
constexpr int BM = 256, BK = 64, HALF = 128, HTB = HALF * BK * 2  , STAGE_BYTES = 8 * HTB, NXCD = 8, WGM = 8;

__host__ __device__ __forceinline__ int lds_byte(int r, int c) { const int st = (r >> 4) * 2 + (c >> 5), rr = r & 15, cc = c & 31, ob = rr * 64 + cc * 2; return st * 1024 + (ob ^ (((ob >> 9) & 1) << 5)); }
__host__ __device__ __forceinline__ void stage_rc(int b, int& R, int& C) { const int st = b / 1024, sb = b % 1024, swz = sb ^ (((sb >> 9) & 1) << 5); R = (st >> 1) * 16 + swz / 64; C = (st & 1) * 32 + (swz % 64) / 2; }
__host__ __device__ __forceinline__ int perm32(int rho) { const int n = rho >> 4, i = rho & 15; return 8 * (i >> 2) + 4 * n + (i & 3); }

template <class T, class = void> struct epi_timed { static constexpr bool v = false; };
template <class T> struct epi_timed<T, decltype((void)T::TIMED)> { static constexpr bool v = true; };
#ifndef PG8_TBLK
#define PG8_TBLK 0
#define PG8_TTID 0
#endif
struct Unit { int pm, pn; };
struct Gemm { const bf16_t* A; const bf16_t* Bt; int M, N, K; };

struct StaticOrder {
    int nM, nN, nwg, G, c;
    __host__ __device__ void init(int M, int N, int G_, int c_) { nM = M / BM; nN = N / BM; nwg = nM * nN; G = G_; c = c_; }
    __host__ __device__ bool next(int i, Unit& u) const {
        const long L = (long)i * G + c; if (L >= nwg) return false;
        int wgid = (int)L; { const int q = nwg / NXCD, r = nwg % NXCD, xcd = wgid % NXCD, off = wgid / NXCD; wgid = (xcd < r ? xcd * (q + 1) : r * (q + 1) + (xcd - r) * q) + off; }
        const int nig = WGM * nN, gid = wgid / nig, fm = gid * WGM, gsz = (nM - fm) < WGM ? (nM - fm) : WGM;
        u.pm = fm + ((wgid % nig) % gsz); u.pn = (wgid % nig) / gsz; return true;
    }
    __device__ __forceinline__ void a_ready(const Unit&) const {}
    __device__ __forceinline__ void done(const Unit&) const {}
};

__device__ __forceinline__ unsigned cvt_pk_bf16(float lo, float hi) { unsigned r; asm volatile("v_cvt_pk_bf16_f32 %0, %1, %2" : "=v"(r) : "v"(lo), "v"(hi)); return r; }
typedef float f32x2 __attribute__((ext_vector_type(2)));
template <class Epi, class Sched, bool ALIGN_EPI = false, bool SP2 = false>
__device__ __forceinline__ void gemm_phase(PG8_LAS unsigned char* lds, const Gemm g, const Sched& S, const Epi& E) {
    int tid_o = threadIdx.x; asm volatile("" : "+v"(tid_o));
    const int tid = tid_o, wid = __builtin_amdgcn_readfirstlane(tid >> 6), lane = tid & 63, wr = wid >> 2, wc = wid & 3, fr = lane & 15, fq = lane >> 4;
    const int K = g.K, nt = K / BK;
    unsigned voffA[2], voffB[2];
#pragma unroll
    for (int i = 0; i < 2; ++i) { int R, C; stage_rc(tid * 16 + i * 8192, R, C); const int Rb = Epi::PERM ? ((R & ~31) + perm32(R & 31)) : R;
        voffA[i] = (unsigned)(R * K + C) * 2u; voffB[i] = (unsigned)(Rb * K + C) * 2u; }
    const size_t kstep = (size_t)(BK * 2);
    const size_t hstep = (size_t)HALF * K * 2;
    const size_t tstep = 2 * hstep;
    const unsigned ldsw = (unsigned)wid * 1024u;
    const int aoff = lds_byte(wr * 64 + fr, fq * 8), boff = lds_byte(wc * 32 + fr, fq * 8);
#define PG8_SA(b, h) (((b) * 2 + (h)) * HTB)
#define PG8_SB(b, h) ((4 + (b) * 2 + (h)) * HTB)
#define PG8_STAGE(bufoff, gbase, voff) do { _Pragma("unroll") for (int _i = 0; _i < 2; ++_i) \
        __builtin_amdgcn_global_load_lds((const unsigned*)((const char*)(gbase) + (voff)[_i]), (PG8_LAS unsigned*)(lds + (bufoff) + ldsw + _i * 8192), 16, 0, 0); } while (0)
#define PG8_LDA(dst, b, h) do { _Pragma("unroll") for (int m = 0; m < 4; ++m) _Pragma("unroll") for (int k = 0; k < 2; ++k) dst[m][k] = *(const PG8_LAS bf16x8*)(lds + PG8_SA(b, h) + aoff + m * 2048 + k * 1024); } while (0)
#define PG8_LDB(dst, b, h) do { _Pragma("unroll") for (int n = 0; n < 2; ++n) _Pragma("unroll") for (int k = 0; k < 2; ++k) dst[n][k] = *(const PG8_LAS bf16x8*)(lds + PG8_SB(b, h) + boff + n * 2048 + k * 1024); } while (0)
#define PG8_MMA(ai, bj, At, Bt) do { __builtin_amdgcn_s_setprio(1); _Pragma("unroll") for (int m = 0; m < 4; ++m) _Pragma("unroll") for (int n = 0; n < 2; ++n) _Pragma("unroll") for (int k = 0; k < 2; ++k) \
        acc[ai][bj][m][n] = __builtin_amdgcn_mfma_f32_16x16x32_bf16(Bt[n][k], At[m][k], acc[ai][bj][m][n], 0, 0, 0); __builtin_amdgcn_s_setprio(0); } while (0)
#define PG8_WAIT_V(n) asm volatile("s_waitcnt vmcnt(" #n ")" ::: "memory")
#define PG8_WAIT_L(n) asm volatile("s_waitcnt lgkmcnt(" #n ")" ::: "memory")
#define PG8_BAR __builtin_amdgcn_s_barrier()
#define PG8_SCHED __builtin_amdgcn_sched_barrier(0)
    Unit cur, nxt; int ui = 0;
    if (!S.next(0, cur)) return;
    f32x4 acc[2][2][4][2];
#pragma unroll
    for (int a = 0; a < 2; ++a)
#pragma unroll
        for (int b = 0; b < 2; ++b)
#pragma unroll
            for (int m = 0; m < 4; ++m)
#pragma unroll
                for (int n = 0; n < 2; ++n) acc[a][b][m][n] = (f32x4){0.f, 0.f, 0.f, 0.f};
    bf16x8 At[4][2], B0[2][2], B1[2][2];
    const char* cA = (const char*)g.A + (size_t)cur.pm * tstep; const char* cB = (const char*)g.Bt + (size_t)cur.pn * tstep;
    S.a_ready(cur);
    if constexpr (SP2) {
        PG8_STAGE(PG8_SB(0, 0), cB, voffB); PG8_STAGE(PG8_SB(0, 1), cB + hstep, voffB); PG8_STAGE(PG8_SA(0, 0), cA, voffA); PG8_STAGE(PG8_SA(0, 1), cA + hstep, voffA);
        if (wr == 1) PG8_BAR;
        PG8_WAIT_V(2); PG8_BAR;
        PG8_STAGE(PG8_SB(1, 0), cB + kstep, voffB); PG8_STAGE(PG8_SA(1, 0), cA + kstep, voffA); PG8_STAGE(PG8_SB(1, 1), cB + hstep + kstep, voffB);
        PG8_WAIT_V(6); PG8_BAR;
    } else {
        PG8_STAGE(PG8_SB(0, 0), cB, voffB); PG8_STAGE(PG8_SA(0, 0), cA, voffA); PG8_STAGE(PG8_SB(0, 1), cB + hstep, voffB); PG8_STAGE(PG8_SA(0, 1), cA + hstep, voffA);
        if (wr == 1) PG8_BAR;
        PG8_WAIT_V(4); PG8_BAR;
        PG8_STAGE(PG8_SB(1, 0), cB + kstep, voffB); PG8_STAGE(PG8_SA(1, 0), cA + kstep, voffA); PG8_STAGE(PG8_SB(1, 1), cB + hstep + kstep, voffB);
        PG8_WAIT_V(6); PG8_BAR;
    }
#ifdef PG8_TSEL
    unsigned long long tsum_ = 0;
#endif
    for (;;) {
        const bool has_next = S.next(ui + 1, nxt);
        const char* nA = has_next ? (const char*)g.A + (size_t)nxt.pm * tstep : cA; const char* nB = has_next ? (const char*)g.Bt + (size_t)nxt.pn * tstep : cB;
        for (int t = 0; t < nt; t += 2) {
            const bool last = (t == nt - 2);
            const char* a1 = cA + (size_t)(t + 1) * kstep;
            const char* a2 = last ? nA : cA + (size_t)(t + 2) * kstep; const char* b2 = last ? nB : cB + (size_t)(t + 2) * kstep;
            const char* a3 = a2 + kstep; const char* b3 = b2 + kstep;
            if (last && has_next) S.a_ready(nxt);
            if constexpr (SP2) {
            PG8_LDB(B0, 0, 0); PG8_LDB(B1, 0, 1); PG8_SCHED; PG8_LDA(At, 0, 0); PG8_STAGE(PG8_SA(1, 1), a1 + hstep, voffA);
            PG8_WAIT_V(8); PG8_WAIT_L(0); PG8_BAR; PG8_MMA(0, 0, At, B0); PG8_MMA(0, 1, At, B1); PG8_BAR; PG8_SCHED;
            PG8_LDA(At, 0, 1); PG8_STAGE(PG8_SB(0, 0), b2, voffB); PG8_STAGE(PG8_SB(0, 1), b2 + hstep, voffB); PG8_STAGE(PG8_SA(0, 0), a2, voffA);
            PG8_WAIT_V(8); PG8_WAIT_L(0); PG8_BAR; PG8_MMA(1, 0, At, B0); PG8_MMA(1, 1, At, B1); PG8_BAR; PG8_SCHED;
            PG8_LDB(B0, 1, 0); PG8_LDB(B1, 1, 1); PG8_SCHED; PG8_LDA(At, 1, 0); PG8_STAGE(PG8_SA(0, 1), a2 + hstep, voffA);
            PG8_WAIT_V(8); PG8_WAIT_L(0); PG8_BAR; PG8_MMA(0, 0, At, B0); PG8_MMA(0, 1, At, B1); PG8_BAR; PG8_SCHED;
            PG8_LDA(At, 1, 1); PG8_STAGE(PG8_SB(1, 0), b3, voffB); PG8_STAGE(PG8_SB(1, 1), b3 + hstep, voffB); PG8_STAGE(PG8_SA(1, 0), a3, voffA);
            PG8_WAIT_V(8); PG8_WAIT_L(0); PG8_BAR; PG8_MMA(1, 0, At, B0); PG8_MMA(1, 1, At, B1); PG8_BAR; PG8_SCHED;
            } else {
            PG8_LDB(B0, 0, 0); PG8_SCHED; PG8_LDA(At, 0, 0); PG8_STAGE(PG8_SA(1, 1), a1 + hstep, voffA);
            PG8_WAIT_L(8); PG8_BAR; PG8_WAIT_L(0); PG8_MMA(0, 0, At, B0); PG8_BAR; PG8_SCHED;
            PG8_LDB(B1, 0, 1); PG8_STAGE(PG8_SB(0, 0), b2, voffB);
            PG8_BAR; PG8_WAIT_L(0); PG8_MMA(0, 1, At, B1); PG8_BAR;
            PG8_LDA(At, 0, 1); PG8_STAGE(PG8_SA(0, 0), a2, voffA);
            PG8_BAR; PG8_WAIT_L(0); PG8_MMA(1, 0, At, B0); PG8_BAR; PG8_SCHED;
            PG8_STAGE(PG8_SB(0, 1), b2 + hstep, voffB);
            PG8_WAIT_V(6); PG8_BAR; PG8_MMA(1, 1, At, B1); PG8_BAR;
            PG8_LDB(B0, 1, 0); PG8_SCHED; PG8_LDA(At, 1, 0); PG8_STAGE(PG8_SA(0, 1), a2 + hstep, voffA);
            PG8_WAIT_L(8); PG8_BAR; PG8_WAIT_L(0); PG8_MMA(0, 0, At, B0); PG8_BAR; PG8_SCHED;
            PG8_LDB(B1, 1, 1); PG8_STAGE(PG8_SB(1, 0), b3, voffB);
            PG8_BAR; PG8_WAIT_L(0); PG8_MMA(0, 1, At, B1); PG8_BAR;
            PG8_LDA(At, 1, 1); PG8_STAGE(PG8_SA(1, 0), a3, voffA);
            PG8_BAR; PG8_WAIT_L(0); PG8_MMA(1, 0, At, B0); PG8_BAR; PG8_SCHED;
            PG8_STAGE(PG8_SB(1, 1), b3 + hstep, voffB);
            PG8_WAIT_V(6); PG8_BAR; PG8_MMA(1, 1, At, B1); PG8_BAR;
            }
        }
#ifdef PG8_TSEL
        unsigned long long tA_ = 0, tb2_ = 0;
        if constexpr (epi_timed<Epi>::v) tA_ = __builtin_amdgcn_s_memrealtime();
#endif
        if constexpr (ALIGN_EPI) { if (wr == 0) PG8_BAR; }
#ifdef PG8_TSEL
        if constexpr (epi_timed<Epi>::v) tb2_ = __builtin_amdgcn_s_memrealtime();
#endif
#ifdef PG8_TSEL
        unsigned long long tb_ = 0;
        if constexpr (epi_timed<Epi>::v) { if (PG8_TSEL == 2) tb_ = tA_; else tb_ = __builtin_amdgcn_s_memrealtime(); }
#endif
        if constexpr (!Epi::AFTER_DRAIN) { E(acc, cur, wr, wc, fr, fq); PG8_EPI_AGAIN(E(acc, cur, wr, wc, fr, fq)); S.done(cur); }
#ifdef PG8_TSEL
        if constexpr (epi_timed<Epi>::v) { if (PG8_TSEL == 1) asm volatile("s_waitcnt vmcnt(0)" ::: "memory");
            if (PG8_TSEL == 2) tsum_ += tb2_ - tb_; else tsum_ += __builtin_amdgcn_s_memrealtime() - tb_; }
#endif
        if (!has_next) break;
#pragma unroll
        for (int a = 0; a < 2; ++a)
#pragma unroll
            for (int b = 0; b < 2; ++b)
#pragma unroll
                for (int m = 0; m < 4; ++m)
#pragma unroll
                    for (int n = 0; n < 2; ++n) acc[a][b][m][n] = (f32x4){0.f, 0.f, 0.f, 0.f};
        cur = nxt; cA = nA; cB = nB; ++ui;
        if constexpr (ALIGN_EPI) { if (wr == 1) PG8_BAR; }
    }
    PG8_WAIT_V(0);
    if constexpr (!ALIGN_EPI) { if (wr == 0) PG8_BAR; }
    PG8_BAR;
    if constexpr (Epi::AFTER_DRAIN) { E.fused(acc, cur, wr, wc, fr, fq, lds, wid, lane); S.done(cur); }
#ifdef PG8_TSEL
    if constexpr (epi_timed<Epi>::v) { if (blockIdx.x == PG8_TBLK && tid == PG8_TTID) __hip_atomic_store(E.tslot, tsum_, __ATOMIC_RELAXED, __HIP_MEMORY_SCOPE_AGENT); }
#endif
#undef PG8_SA
#undef PG8_SB
#undef PG8_STAGE
#undef PG8_LDA
#undef PG8_LDB
#undef PG8_MMA
#undef PG8_WAIT_V
#undef PG8_WAIT_L
#undef PG8_BAR
#undef PG8_SCHED
}
static_assert(true, "gather variant of gemm_phase (SP2 = true only): identical schedule, the A operand's rows are gathered through Sched::rowoff");
template <class Epi, class Sched, bool ALIGN_EPI = false, bool SP2 = false>
__device__ __forceinline__ void gemm_phase_g(PG8_LAS unsigned char* lds, const Gemm g, const Sched& S, const Epi& E) {
    int tid_o = threadIdx.x; asm volatile("" : "+v"(tid_o));
    const int tid = tid_o, wid = __builtin_amdgcn_readfirstlane(tid >> 6), lane = tid & 63, wr = wid >> 2, wc = wid & 3, fr = lane & 15, fq = lane >> 4;
    const int K = g.K, nt = K / BK;
    unsigned voffA[2], voffB[2]; int RA_[2]; unsigned CA_[2];
#pragma unroll
    for (int i = 0; i < 2; ++i) { int R, C; stage_rc(tid * 16 + i * 8192, R, C); const int Rb = Epi::PERM ? ((R & ~31) + perm32(R & 31)) : R;
        voffA[i] = (unsigned)(R * K + C) * 2u; voffB[i] = (unsigned)(Rb * K + C) * 2u; RA_[i] = R; CA_[i] = (unsigned)C * 2u; }
    const size_t kstep = (size_t)(BK * 2);
    const size_t hstep = (size_t)HALF * K * 2;
    const size_t tstep = 2 * hstep;
    const unsigned ldsw = (unsigned)wid * 1024u;
    const int aoff = lds_byte(wr * 64 + fr, fq * 8), boff = lds_byte(wc * 32 + fr, fq * 8);
#define PG8_SA(b, h) (((b) * 2 + (h)) * HTB)
#define PG8_SB(b, h) ((4 + (b) * 2 + (h)) * HTB)
#define PG8_STAGE(bufoff, gbase, voff) do { _Pragma("unroll") for (int _i = 0; _i < 2; ++_i) \
        __builtin_amdgcn_global_load_lds((const unsigned*)((const char*)(gbase) + (voff)[_i]), (PG8_LAS unsigned*)(lds + (bufoff) + ldsw + _i * 8192), 16, 0, 0); } while (0)
#define PG8_LDA(dst, b, h) do { _Pragma("unroll") for (int m = 0; m < 4; ++m) _Pragma("unroll") for (int k = 0; k < 2; ++k) dst[m][k] = *(const PG8_LAS bf16x8*)(lds + PG8_SA(b, h) + aoff + m * 2048 + k * 1024); } while (0)
#define PG8_LDB(dst, b, h) do { _Pragma("unroll") for (int n = 0; n < 2; ++n) _Pragma("unroll") for (int k = 0; k < 2; ++k) dst[n][k] = *(const PG8_LAS bf16x8*)(lds + PG8_SB(b, h) + boff + n * 2048 + k * 1024); } while (0)
#define PG8_MMA(ai, bj, At, Bt) do { __builtin_amdgcn_s_setprio(1); _Pragma("unroll") for (int m = 0; m < 4; ++m) _Pragma("unroll") for (int n = 0; n < 2; ++n) _Pragma("unroll") for (int k = 0; k < 2; ++k) \
        acc[ai][bj][m][n] = __builtin_amdgcn_mfma_f32_16x16x32_bf16(Bt[n][k], At[m][k], acc[ai][bj][m][n], 0, 0, 0); __builtin_amdgcn_s_setprio(0); } while (0)
#define PG8_WAIT_V(n) asm volatile("s_waitcnt vmcnt(" #n ")" ::: "memory")
#define PG8_WAIT_L(n) asm volatile("s_waitcnt lgkmcnt(" #n ")" ::: "memory")
#define PG8_BAR __builtin_amdgcn_s_barrier()
#define PG8_SCHED __builtin_amdgcn_sched_barrier(0)
    Unit cur, nxt; int ui = 0;
    if (!S.next(0, cur)) return;
    f32x4 acc[2][2][4][2];
#pragma unroll
    for (int a = 0; a < 2; ++a)
#pragma unroll
        for (int b = 0; b < 2; ++b)
#pragma unroll
            for (int m = 0; m < 4; ++m)
#pragma unroll
                for (int n = 0; n < 2; ++n) acc[a][b][m][n] = (f32x4){0.f, 0.f, 0.f, 0.f};
    bf16x8 At[4][2], B0[2][2], B1[2][2];
    const char* cA = (const char*)g.A; const char* cB = (const char*)g.Bt + (size_t)cur.pn * tstep;
    unsigned cA0[2], cA1[2], nA0[2], nA1[2];
#pragma unroll
    for (int i = 0; i < 2; ++i) { cA0[i] = S.rowoff(cur, RA_[i]) + CA_[i]; cA1[i] = S.rowoff(cur, 128 + RA_[i]) + CA_[i]; }
    S.a_ready(cur);
    if constexpr (SP2) {
        PG8_STAGE(PG8_SB(0, 0), cB, voffB); PG8_STAGE(PG8_SB(0, 1), cB + hstep, voffB); PG8_STAGE(PG8_SA(0, 0), cA, cA0); PG8_STAGE(PG8_SA(0, 1), cA, cA1);
        if (wr == 1) PG8_BAR;
        PG8_WAIT_V(2); PG8_BAR;
        PG8_STAGE(PG8_SB(1, 0), cB + kstep, voffB); PG8_STAGE(PG8_SA(1, 0), cA + kstep, cA0); PG8_STAGE(PG8_SB(1, 1), cB + hstep + kstep, voffB);
        PG8_WAIT_V(6); PG8_BAR;
    } else {
        PG8_STAGE(PG8_SB(0, 0), cB, voffB); PG8_STAGE(PG8_SA(0, 0), cA, voffA); PG8_STAGE(PG8_SB(0, 1), cB + hstep, voffB); PG8_STAGE(PG8_SA(0, 1), cA + hstep, voffA);
        if (wr == 1) PG8_BAR;
        PG8_WAIT_V(4); PG8_BAR;
        PG8_STAGE(PG8_SB(1, 0), cB + kstep, voffB); PG8_STAGE(PG8_SA(1, 0), cA + kstep, voffA); PG8_STAGE(PG8_SB(1, 1), cB + hstep + kstep, voffB);
        PG8_WAIT_V(6); PG8_BAR;
    }
    for (;;) {
        const bool has_next = S.next(ui + 1, nxt);
        const char* nA = cA; const char* nB = has_next ? (const char*)g.Bt + (size_t)nxt.pn * tstep : cB;
#pragma unroll
        for (int i = 0; i < 2; ++i) { nA0[i] = has_next ? S.rowoff(nxt, RA_[i]) + CA_[i] : cA0[i]; nA1[i] = has_next ? S.rowoff(nxt, 128 + RA_[i]) + CA_[i] : cA1[i]; }
        for (int t = 0; t < nt; t += 2) {
            const bool last = (t == nt - 2);
            const char* a1 = cA + (size_t)(t + 1) * kstep;
            const char* a2 = last ? nA : cA + (size_t)(t + 2) * kstep; const char* b2 = last ? nB : cB + (size_t)(t + 2) * kstep;
            const char* a3 = a2 + kstep; const char* b3 = b2 + kstep;
            unsigned sA0[2], sA1[2];
#pragma unroll
            for (int i = 0; i < 2; ++i) { sA0[i] = last ? nA0[i] : cA0[i]; sA1[i] = last ? nA1[i] : cA1[i]; }
            if (last && has_next) S.a_ready(nxt);
            if constexpr (SP2) {
            PG8_LDB(B0, 0, 0); PG8_LDB(B1, 0, 1); PG8_SCHED; PG8_LDA(At, 0, 0); PG8_STAGE(PG8_SA(1, 1), a1, cA1);
            PG8_WAIT_V(8); PG8_WAIT_L(0); PG8_BAR; PG8_MMA(0, 0, At, B0); PG8_MMA(0, 1, At, B1); PG8_BAR; PG8_SCHED;
            PG8_LDA(At, 0, 1); PG8_STAGE(PG8_SB(0, 0), b2, voffB); PG8_STAGE(PG8_SB(0, 1), b2 + hstep, voffB); PG8_STAGE(PG8_SA(0, 0), a2, sA0);
            PG8_WAIT_V(8); PG8_WAIT_L(0); PG8_BAR; PG8_MMA(1, 0, At, B0); PG8_MMA(1, 1, At, B1); PG8_BAR; PG8_SCHED;
            PG8_LDB(B0, 1, 0); PG8_LDB(B1, 1, 1); PG8_SCHED; PG8_LDA(At, 1, 0); PG8_STAGE(PG8_SA(0, 1), a2, sA1);
            PG8_WAIT_V(8); PG8_WAIT_L(0); PG8_BAR; PG8_MMA(0, 0, At, B0); PG8_MMA(0, 1, At, B1); PG8_BAR; PG8_SCHED;
            PG8_LDA(At, 1, 1); PG8_STAGE(PG8_SB(1, 0), b3, voffB); PG8_STAGE(PG8_SB(1, 1), b3 + hstep, voffB); PG8_STAGE(PG8_SA(1, 0), a3, sA0);
            PG8_WAIT_V(8); PG8_WAIT_L(0); PG8_BAR; PG8_MMA(1, 0, At, B0); PG8_MMA(1, 1, At, B1); PG8_BAR; PG8_SCHED;
            } else {
            PG8_LDB(B0, 0, 0); PG8_SCHED; PG8_LDA(At, 0, 0); PG8_STAGE(PG8_SA(1, 1), a1 + hstep, voffA);
            PG8_WAIT_L(8); PG8_BAR; PG8_WAIT_L(0); PG8_MMA(0, 0, At, B0); PG8_BAR; PG8_SCHED;
            PG8_LDB(B1, 0, 1); PG8_STAGE(PG8_SB(0, 0), b2, voffB);
            PG8_BAR; PG8_WAIT_L(0); PG8_MMA(0, 1, At, B1); PG8_BAR;
            PG8_LDA(At, 0, 1); PG8_STAGE(PG8_SA(0, 0), a2, voffA);
            PG8_BAR; PG8_WAIT_L(0); PG8_MMA(1, 0, At, B0); PG8_BAR; PG8_SCHED;
            PG8_STAGE(PG8_SB(0, 1), b2 + hstep, voffB);
            PG8_WAIT_V(6); PG8_BAR; PG8_MMA(1, 1, At, B1); PG8_BAR;
            PG8_LDB(B0, 1, 0); PG8_SCHED; PG8_LDA(At, 1, 0); PG8_STAGE(PG8_SA(0, 1), a2 + hstep, voffA);
            PG8_WAIT_L(8); PG8_BAR; PG8_WAIT_L(0); PG8_MMA(0, 0, At, B0); PG8_BAR; PG8_SCHED;
            PG8_LDB(B1, 1, 1); PG8_STAGE(PG8_SB(1, 0), b3, voffB);
            PG8_BAR; PG8_WAIT_L(0); PG8_MMA(0, 1, At, B1); PG8_BAR;
            PG8_LDA(At, 1, 1); PG8_STAGE(PG8_SA(1, 0), a3, voffA);
            PG8_BAR; PG8_WAIT_L(0); PG8_MMA(1, 0, At, B0); PG8_BAR; PG8_SCHED;
            PG8_STAGE(PG8_SB(1, 1), b3 + hstep, voffB);
            PG8_WAIT_V(6); PG8_BAR; PG8_MMA(1, 1, At, B1); PG8_BAR;
            }
        }
        if constexpr (ALIGN_EPI) { if (wr == 0) PG8_BAR; }
        if constexpr (!Epi::AFTER_DRAIN) { E(acc, cur, wr, wc, fr, fq); PG8_EPI_AGAIN(E(acc, cur, wr, wc, fr, fq)); S.done(cur); }
        if (!has_next) break;
#pragma unroll
        for (int a = 0; a < 2; ++a)
#pragma unroll
            for (int b = 0; b < 2; ++b)
#pragma unroll
                for (int m = 0; m < 4; ++m)
#pragma unroll
                    for (int n = 0; n < 2; ++n) acc[a][b][m][n] = (f32x4){0.f, 0.f, 0.f, 0.f};
        cur = nxt; cA = nA; cB = nB; ++ui;
#pragma unroll
        for (int i = 0; i < 2; ++i) { cA0[i] = nA0[i]; cA1[i] = nA1[i]; }
        if constexpr (ALIGN_EPI) { if (wr == 1) PG8_BAR; }
    }
    PG8_WAIT_V(0);
    if constexpr (!ALIGN_EPI) { if (wr == 0) PG8_BAR; }
    PG8_BAR;
    if constexpr (Epi::AFTER_DRAIN) { E.fused(acc, cur, wr, wc, fr, fq, lds, wid, lane); S.done(cur); }
#undef PG8_SA
#undef PG8_SB
#undef PG8_STAGE
#undef PG8_LDA
#undef PG8_LDB
#undef PG8_MMA
#undef PG8_WAIT_V
#undef PG8_WAIT_L
#undef PG8_BAR
#undef PG8_SCHED
}
}

#define DI __device__ __forceinline__
#define LAS __attribute__((address_space(3)))
typedef unsigned short bf16_t;
typedef short bf16x8 __attribute__((ext_vector_type(8)));
typedef short s16x4 __attribute__((ext_vector_type(4)));
typedef short v4i16_t __attribute__((ext_vector_type(4)));
typedef float f32x4 __attribute__((ext_vector_type(4)));
typedef float f32x16 __attribute__((ext_vector_type(16)));
typedef unsigned u32x4 __attribute__((ext_vector_type(4)));
typedef unsigned u32x2 __attribute__((ext_vector_type(2)));
typedef float f32x2_t __attribute__((ext_vector_type(2)));
typedef __bf16 bf16x2_t __attribute__((ext_vector_type(2)));

constexpr int NWAVES = 8, NTHREADS = 512;
constexpr int SEQ = 8192, DMODEL = 1024, NMETA = 16, LTOK = SEQ + NMETA  , LP = 8256  , NCHUNK = 129;
constexpr int MTOK = 2 * SEQ;
constexpr int MROWS = 16640;
constexpr int NPROJ = 3840;
constexpr int NKT = 129;
constexpr float EPS = 1e-6f;
constexpr float C2Q = 0.125f * 1.4426950408889634f;
constexpr int XS_ROWS = 41216;

constexpr size_t MiB = 1u << 20;
constexpr size_t WS_CTL = 0, CTL_BYTES = 1 * MiB;
constexpr size_t WS_RS1 = 1 * MiB;
constexpr size_t WS_RS2 = WS_RS1 + 128 * 1024;
constexpr size_t WS_TOKE = WS_RS2 + 128 * 1024;
constexpr size_t WS_TOKW = WS_TOKE + 128 * 1024;
constexpr size_t WS_TOKP = WS_TOKW + 128 * 1024;
constexpr size_t WS_SLOTW = WS_TOKP + 128 * 1024;
constexpr size_t WS_WR = WS_SLOTW + 192 * 1024;
constexpr size_t WS_GL = WS_WR + 160 * 1024;
constexpr size_t WS_DUMP = 2 * MiB;
constexpr size_t WS_COS = 2 * MiB;
constexpr size_t WS_SIN = WS_COS + 1280 * 1024;
constexpr size_t WS_GB = WS_SIN + 1280 * 1024;
constexpr size_t WS_WOUT = 6 * MiB;
constexpr size_t WS_WINT = 8 * MiB;
constexpr size_t WS_XB = WS_WINT + (size_t)NPROJ * 1024 * 2;
constexpr size_t WS_MIX = 8 * MiB;
constexpr size_t WS_QKVB = 48 * MiB;
constexpr size_t WS_QB = WS_QKVB + (size_t)2 * LP * 1536 * 2 + 128 * 1024;
constexpr size_t WS_KT = WS_QB + 16 * MiB;
constexpr size_t WS_VT = WS_KT + (size_t)16 * NKT * 4096 * 2;
constexpr size_t WS_ZB = WS_VT + (size_t)8 * NKT * 8192 * 2;
constexpr size_t WS_GP = WS_ZB + (size_t)2 * LP * 512 * 2;
constexpr size_t GP_ARR = (size_t)2064 * 4096 * 2;
constexpr size_t WS_GP_END = WS_GP + 5 * GP_ARR;
constexpr size_t WS_WGU = 48 * MiB;
constexpr size_t WS_WD = 80 * MiB;
constexpr size_t WS_U2 = 96 * MiB;
constexpr size_t WS_LIST = 240 * MiB;
constexpr size_t WS_LISTW = 242 * MiB;
constexpr size_t WS_LISTRS = 244 * MiB;
constexpr size_t WS_XS = 96 * MiB;
constexpr size_t WS_YO = 128 * MiB;
constexpr size_t WS_YS = 8 * MiB;
constexpr size_t WS_END = 256 * MiB;
static_assert(WS_GB + (size_t)2 * LP * 16 * 4 <= WS_WOUT, "small region");
static_assert(WS_XB + (size_t)MROWS * 1024 * 2 <= WS_QKVB, "XB");
static_assert(WS_GP_END <= WS_END, "GDN prep arrays");
static_assert(WS_YS + (size_t)XS_ROWS * 256 * 2 <= WS_END, "YS");
static_assert(WS_WD + (size_t)32 * 1024 * 256 * 2 <= WS_XS, "WD");
constexpr int CW_ATTQ = 2112;
constexpr int CW_PREP = 2688;
constexpr int CW_CNT = 64;
constexpr int CW_TILE = 8192;
constexpr int CW_BAR = 4096;

constexpr int LDS_BYTES = 147456;

struct Params { const float* in[23]; float* out; unsigned char* ws; };

DI unsigned f2bf(float f) { unsigned u = __float_as_uint(f); return (u + 0x7fffu + ((u >> 16) & 1u)) >> 16; }
DI unsigned pk2(float lo, float hi) { f32x2_t v = {lo, hi}; bf16x2_t b = __builtin_convertvector(v, bf16x2_t); return __builtin_bit_cast(unsigned, b); }
DI float bf2f(unsigned short h) { return __uint_as_float(((unsigned)h) << 16); }
DI float rlane(float v, int l) { return __int_as_float(__builtin_amdgcn_readlane(__float_as_int(v), l)); }
#define DPP_ADD(v, ctrl) ((v) + __int_as_float(__builtin_amdgcn_update_dpp(0, __float_as_int(v), (ctrl), 0xF, 0xF, true)))
DI u32x2 pack_quad_bf16(float v) {
    const float v1 = __int_as_float(__builtin_amdgcn_update_dpp(0, __float_as_int(v), 0xB1, 0xF, 0xF, true));
    const unsigned p = pk2(v, v1);
    const unsigned q = (unsigned)__builtin_amdgcn_update_dpp(0, (int)p, 0x4E, 0xF, 0xF, true);
    return (u32x2){p, q};
}
typedef __attribute__((address_space(1))) u32x2 g_u32x2;
DI void store_quad_bf16(bf16_t* dst  , float v, int lane) {
    const float v1 = __int_as_float(__builtin_amdgcn_update_dpp(0, __float_as_int(v), 0xB1, 0xF, 0xF, true));
    const unsigned p = pk2(v, v1);
    const unsigned q = (unsigned)__builtin_amdgcn_update_dpp(0, (int)p, 0x4E, 0xF, 0xF, true);
    if ((lane & 3) == 0) *(u32x2*)dst = (u32x2){p, q};
}
DI float wave_sum_dpp(float v) {
    v = DPP_ADD(v, 0xB1);
    v = DPP_ADD(v, 0x4E);
    v = DPP_ADD(v, 0x141);
    v = DPP_ADD(v, 0x140);
    return (rlane(v, 0) + rlane(v, 16)) + (rlane(v, 32) + rlane(v, 48));
}
DI float wave_sum(float v) { return wave_sum_dpp(v); }
DI float swz_xor16(float v) { return __int_as_float(__builtin_amdgcn_ds_swizzle(__float_as_int(v), 0x401F)); }
DI float row_sum16(float v) { v = DPP_ADD(v, 0xB1); v = DPP_ADD(v, 0x4E); v = DPP_ADD(v, 0x141); v = DPP_ADD(v, 0x140); return v; }
DI float half_sum32(float v) { v = row_sum16(v); return v + swz_xor16(v); }
DI float swap32_add(float v) { auto rr = __builtin_amdgcn_permlane32_swap(__float_as_uint(v), __float_as_uint(v), false, false); return __uint_as_float(rr[0]) + __uint_as_float(rr[1]); }
DI float swap32_max(float v) { auto rr = __builtin_amdgcn_permlane32_swap(__float_as_uint(v), __float_as_uint(v), false, false); return fmaxf(__uint_as_float(rr[0]), __uint_as_float(rr[1])); }
#define LDS_WAIT() asm volatile("s_waitcnt lgkmcnt(0)" ::: "memory")
#define BAR_LDS() do { asm volatile("s_waitcnt lgkmcnt(0)" ::: "memory"); __builtin_amdgcn_s_barrier(); asm volatile("" ::: "memory"); } while (0)
#define MFMA32(a, b, c) __builtin_amdgcn_mfma_f32_32x32x16_bf16((a), (b), (c), 0, 0, 0)
DI int crow(int r, int hi) { return (r & 3) + 8 * (r >> 2) + 4 * hi; }
DI int perm16(int x) { return (x & ~12) | ((x & 4) << 1) | ((x & 8) >> 1); }
DI bf16x8 pack8(const f32x16& x, int s) {
    u32x4 p; p.x = pk2(x[8 * s], x[8 * s + 1]); p.y = pk2(x[8 * s + 2], x[8 * s + 3]); p.z = pk2(x[8 * s + 4], x[8 * s + 5]); p.w = pk2(x[8 * s + 6], x[8 * s + 7]);
    return __builtin_bit_cast(bf16x8, p);
}
DI int orig_col(int n) {
    if (n >= 1024) return n;
    const int hh = n >> 6, c2 = n & 63, g8 = c2 >> 3, i = c2 & 7;
    return (hh << 6) + ((i < 4) ? 4 * g8 + i : 32 + 4 * g8 + (i - 4));
}
DI size_t kt_off(int b, int hh, int p, int d) {
    const int tile = p < 16 ? 0 : 1 + ((p - 16) >> 6), kv = p < 16 ? p : ((p - 16) & 63);
    return ((size_t)((b * 8 + hh) * NKT + tile) << 12) + ((d >> 3) << 9) + (kv << 3) + (d & 7);
}
DI size_t vt_off(int b, int h, int p, int d) {
    const int tile = p < 16 ? 0 : 1 + ((p - 16) >> 6), kv = p < 16 ? p : ((p - 16) & 63);
    return ((size_t)((b * 4 + h) * NKT + tile) << 13) + ((d >> 5) << 11) + ((kv >> 4) << 9) + ((kv & 15) << 5) + (d & 31);
}

template <class Src> DI void transpose_item(const Src& src, bf16_t* WT, size_t ldk, int k0, int n0, LAS float* scr, int lane) {
    float v[32];
#pragma unroll
    for (int i = 0; i < 32; ++i) v[i] = src(k0 + 2 * i + (lane >> 5), n0 + (lane & 31));
#pragma unroll
    for (int i = 0; i < 32; ++i) scr[(2 * i + (lane >> 5)) * 33 + (lane & 31)] = v[i];
    LDS_WAIT();
    const int c = lane & 7;
#pragma unroll
    for (int j = 0; j < 4; ++j) { const int n = (lane >> 3) + 8 * j; const LAS float* s = scr + (8 * c) * 33 + n;
        u32x4 o; o.x = pk2(s[0 * 33], s[1 * 33]); o.y = pk2(s[2 * 33], s[3 * 33]); o.z = pk2(s[4 * 33], s[5 * 33]); o.w = pk2(s[6 * 33], s[7 * 33]);
        *(u32x4*)(WT + (size_t)(n0 + n) * ldk + k0 + 8 * c) = o; }
    LDS_WAIT();
}
struct SrcWin { const float* w; const float* g; DI float operator()(int k, int n) const { return n >= 3600 ? 0.f : w[(size_t)k * 3600 + orig_col(n)] * g[k]; } };
struct SrcPlain { const float* w; int N; DI float operator()(int k, int n) const { return w[(size_t)k * N + n]; } };
struct SrcGU { const float* w; const float* g; int fadj; DI float operator()(int k, int n) const { return w[(size_t)k * 256 + n + fadj] * g[k]; } };

#ifndef P0_REP
#define P0_REP 0
#endif
DI void phase0(const Params& P, LAS unsigned char* lds, int gw, int NGW, int gtid, int NGT, int wave, int lane) {
    LAS float* scr = (LAS float*)(lds + wave * 16384);
    bf16_t* WINT = (bf16_t*)(P.ws + WS_WINT); bf16_t* WOUT = (bf16_t*)(P.ws + WS_WOUT); bf16_t* XB = (bf16_t*)(P.ws + WS_XB);
    float* RS1 = (float*)(P.ws + WS_RS1);
    constexpr int I_IN = 16 * (NPROJ / 32), I_OUT = 16 * 32;
    const SrcWin sw{P.in[3], P.in[2]}; const SrcPlain so{P.in[13], 1024};
    for (int rp_ = 0; rp_ < ((P0_REP & 1) ? 2 : 1); ++rp_)
    for (int it = gw; it < I_IN + I_OUT; it += NGW) {
        if (it < I_IN) transpose_item(sw, WINT, 1024, (it / (NPROJ / 32)) * 64, (it % (NPROJ / 32)) * 32, scr, lane);
        else { const int r = it - I_IN; transpose_item(so, WOUT, 1024, (r >> 5) * 64, (r & 31) * 32, scr, lane); }
    }
    const float* x = P.in[0]; const float* meta = P.in[1];
    for (int rp_ = 0; rp_ < ((P0_REP & 2) ? 2 : 1); ++rp_)
    for (int m0 = gw; m0 < MROWS; m0 += 4 * NGW) {
        f32x4 v[4][4];
#pragma unroll
        for (int r = 0; r < 4; ++r) { const int m = m0 + r * NGW;
            const bool real = m < MTOK + NMETA;
            const f32x4* xr = (const f32x4*)((m < MTOK) ? x + (size_t)m * 1024 : meta + (size_t)((real ? m : MTOK) - MTOK) * 1024);
#pragma unroll
            for (int j = 0; j < 4; ++j) v[r][j] = (m < MROWS) ? xr[64 * j + lane] : (f32x4){0.f, 0.f, 0.f, 0.f}; }
#pragma unroll
        for (int r = 0; r < 4; ++r) { const int m = m0 + r * NGW;
            if (m < MROWS) {
                const bool real = m < MTOK + NMETA;
                float s = 0.f;
#pragma unroll
                for (int j = 0; j < 4; ++j) { if (!real) v[r][j] = (f32x4){0.f, 0.f, 0.f, 0.f}; s += (v[r][j].x * v[r][j].x + v[r][j].y * v[r][j].y) + (v[r][j].z * v[r][j].z + v[r][j].w * v[r][j].w); }
                s = wave_sum(s);
                if (lane == 0) RS1[m] = real ? __builtin_amdgcn_rsqf(s * (1.0f / 1024.0f) + EPS) : 0.f;
                u32x2* orow = (u32x2*)(XB + (size_t)m * 1024);
#pragma unroll
                for (int j = 0; j < 4; ++j) orow[64 * j + lane] = (u32x2){pk2(v[r][j].x, v[r][j].y), pk2(v[r][j].z, v[r][j].w)};
            } }
    }
    float* COS = (float*)(P.ws + WS_COS); float* SIN = (float*)(P.ws + WS_SIN);
    for (int rp_ = 0; rp_ < ((P0_REP & 4) ? 2 : 1); ++rp_)
    for (int i = gtid; i < LTOK * 32; i += NGT) {
        const int p = i >> 5, f = i & 31;
        const double rev = (double)p * exp2(-(double)f * (13.287712379549449 / 32.0)) * 0.15915494309189535;
        const float fr = (float)(rev - floor(rev));
        COS[i] = __builtin_amdgcn_cosf(fr); SIN[i] = __builtin_amdgcn_sinf(fr);
    }
    float* WR = (float*)(P.ws + WS_WR); const float* gf = P.in[14]; const float* wgrp = P.in[15]; const float* wrt = P.in[17];
    for (int i = gtid; i < 36 * 1024; i += NGT) { const int j = i >> 10, k = i & 1023; WR[i] = gf[k] * (j < 4 ? wgrp[k * 4 + j] : wrt[k * 32 + (j - 4)]); }
}

#ifndef EPI_NT
#define EPI_NT 0
#endif
#if EPI_NT
#define NT_ST(p, v) __builtin_nontemporal_store((v), (p))
#else
#define NT_ST(p, v) do { if (EV == 1) { auto p_ = (p); *(decltype(p_))(dmask ? dumpb + ((unsigned long long)p_ & 0xFFFF0ull) : (unsigned char*)p_) = (v); } else *(p) = (v); } while (0)
#endif
template <int EV> struct EpiInProjT {
    static constexpr bool PERM = true, AFTER_DRAIN = false, TIMED = true;
    const float* RS1; const float* COS; const float* SIN; const float* a_log; const float* dt_bias;
    bf16_t* QB; bf16_t* KT; bf16_t* VT; bf16_t* QKVB; bf16_t* ZB; float* GB; unsigned char* dumpb; int dmask; unsigned long long* tslot;
    DI void tail(const pg8::f32x4 (&acc)[2][2][4][2], const pg8::Unit& u, int wr, int wc, int fr, int fq) const {
        const int pn = u.pn;
#pragma unroll
        for (int ai = 0; ai < 2; ++ai)
#pragma unroll
            for (int m = 0; m < 4; ++m) {
                const int row = u.pm * 256 + ai * 128 + wr * 64 + m * 16 + fr;
                if (row < MTOK + NMETA) {
                    const float rs = RS1[row];
                    const bool meta = row >= MTOK;
                    const int p = meta ? row - MTOK : (row & 8191) + NMETA;
                    const int b0 = meta ? 0 : (row >> 13), nb = meta ? 2 : 1;
#pragma unroll
                    for (int bj = 0; bj < 2; ++bj) {
                        float xv[8];
#pragma unroll
                        for (int i = 0; i < 4; ++i) { xv[i] = acc[ai][bj][m][0][i] * rs; xv[4 + i] = acc[ai][bj][m][1][i] * rs; }
                        if (pn < 4) {
                            const int hh = (pn & 1) * 4 + bj * 2 + (wc >> 1), d0 = 4 * (4 * (wc & 1) + fq);
                            const f32x4 cs = *(const f32x4*)(COS + p * 32 + d0), sn = *(const f32x4*)(SIN + p * 32 + d0);
                            float lo[4], hi[4];
#pragma unroll
                            for (int i = 0; i < 4; ++i) { lo[i] = xv[i] * cs[i] - xv[4 + i] * sn[i]; hi[i] = xv[4 + i] * cs[i] + xv[i] * sn[i]; }
                            if (pn < 2) {
                                if (!meta) {
                                    bf16_t* q = QB + ((size_t)((b0 * 8 + hh) * SEQ + (p - NMETA)) << 6) + d0;
                                    *(u32x2*)q = (u32x2){pk2(lo[0] * C2Q, lo[1] * C2Q), pk2(lo[2] * C2Q, lo[3] * C2Q)};
                                    *(u32x2*)(q + 32) = (u32x2){pk2(hi[0] * C2Q, hi[1] * C2Q), pk2(hi[2] * C2Q, hi[3] * C2Q)};
                                }
                            } else {
                                for (int bb = b0; bb < b0 + nb; ++bb) {
                                    *(u32x2*)(KT + kt_off(bb, hh, p, d0)) = (u32x2){pk2(lo[0], lo[1]), pk2(lo[2], lo[3])};
                                    *(u32x2*)(KT + kt_off(bb, hh, p, d0 + 32)) = (u32x2){pk2(hi[0], hi[1]), pk2(hi[2], hi[3])};
                                }
                            }
                        } else {
                            const u32x4 w = (u32x4){pk2(xv[0], xv[1]), pk2(xv[2], xv[3]), pk2(xv[4], xv[5]), pk2(xv[6], xv[7])};
                            const int cl = bj * 128 + wc * 32 + fq * 8;
                            if (pn < 6) {
                                const int h = (pn - 4) * 2 + bj, d = wc * 32 + fq * 8;
                                for (int bb = b0; bb < b0 + nb; ++bb) *(u32x4*)(VT + vt_off(bb, h, p, d)) = w;
                            } else if (pn < 12) {
                                for (int bb = b0; bb < b0 + nb; ++bb) *(u32x4*)(QKVB + (size_t)(bb * LP + p) * 1536 + (pn - 6) * 256 + cl) = w;
                            } else if (pn < 14) {
                                float sz[8];
#pragma unroll
                                for (int i = 0; i < 8; ++i) sz[i] = xv[i] * __builtin_amdgcn_rcpf(1.0f + __expf(-xv[i]));
                                const u32x4 wz = (u32x4){pk2(sz[0], sz[1]), pk2(sz[2], sz[3]), pk2(sz[4], sz[5]), pk2(sz[6], sz[7])};
                                for (int bb = b0; bb < b0 + nb; ++bb) *(u32x4*)(ZB + (size_t)(bb * LP + p) * 512 + (pn - 12) * 256 + cl) = wz;
                            } else if (cl < 16) {
                                float o[8];
                                if (cl == 0) {
#pragma unroll
                                    for (int i = 0; i < 8; ++i) { const float t = xv[i] + dt_bias[i]; const float sp = fmaxf(t, 0.f) + __logf(1.0f + __expf(-fabsf(t))); o[i] = -__expf(a_log[i]) * sp; }
                                } else {
#pragma unroll
                                    for (int i = 0; i < 8; ++i) o[i] = __builtin_amdgcn_rcpf(1.0f + __expf(-xv[i]));
                                }
                                for (int bb = b0; bb < b0 + nb; ++bb) { float* g = GB + ((size_t)(bb * LP + p) << 4) + cl;
                                    *(f32x4*)g = (f32x4){o[0], o[1], o[2], o[3]}; *(f32x4*)(g + 4) = (f32x4){o[4], o[5], o[6], o[7]}; }
                            }
                        }
                    }
                }
            }
    }

    DI void operator()(const pg8::f32x4 (&acc)[2][2][4][2], const pg8::Unit& u, int wr, int wc, int fr, int fq) const {
        if (u.pm >= MTOK / 256) { tail(acc, u, wr, wc, fr, fq); return; }
        const int pn = u.pn, rowb = u.pm * 256 + wr * 64 + fr;
        float rs[2][4];
#pragma unroll
        for (int ai = 0; ai < 2; ++ai)
#pragma unroll
            for (int m = 0; m < 4; ++m) rs[ai][m] = (EV == 2) ? 1.0f : RS1[rowb + ai * 128 + m * 16];
        __builtin_amdgcn_sched_barrier(0);
        const int b = rowb >> 13, s0 = rowb & 8191;
        if (pn < 4) {
            const int d0 = 4 * (4 * (wc & 1) + fq);
#pragma unroll
            for (int ai = 0; ai < 2; ++ai) {
                f32x4 cs[4], sn[4];
#pragma unroll
                for (int m = 0; m < 4; ++m) { const int p = s0 + ai * 128 + m * 16 + NMETA; if (EV == 2) { cs[m] = (f32x4){1.f, 1.f, 1.f, 1.f}; sn[m] = (f32x4){0.f, 0.f, 0.f, 0.f}; } else { cs[m] = *(const f32x4*)(COS + p * 32 + d0); sn[m] = *(const f32x4*)(SIN + p * 32 + d0); } }
                __builtin_amdgcn_sched_barrier(0);
#pragma unroll
                for (int m = 0; m < 4; ++m)
#pragma unroll
                    for (int bj = 0; bj < 2; ++bj) {
                        const int hh = (pn & 1) * 4 + bj * 2 + (wc >> 1), s = s0 + ai * 128 + m * 16;
                        float lo[4], hi[4];
#pragma unroll
                        for (int i = 0; i < 4; ++i) { const float x1 = acc[ai][bj][m][0][i] * rs[ai][m], x2 = acc[ai][bj][m][1][i] * rs[ai][m];
                            lo[i] = x1 * cs[m][i] - x2 * sn[m][i]; hi[i] = x2 * cs[m][i] + x1 * sn[m][i]; }
                        if (pn < 2) { bf16_t* q = QB + ((size_t)((b * 8 + hh) * SEQ + s) << 6) + d0;
                            NT_ST((u32x2*)q, ((u32x2){pk2(lo[0] * C2Q, lo[1] * C2Q), pk2(lo[2] * C2Q, lo[3] * C2Q)}));
                            NT_ST((u32x2*)(q + 32), ((u32x2){pk2(hi[0] * C2Q, hi[1] * C2Q), pk2(hi[2] * C2Q, hi[3] * C2Q)}));
                        } else { bf16_t* k = KT + ((size_t)((b * 8 + hh) * NKT + 1 + (s >> 6)) << 12) + ((d0 >> 3) << 9) + ((s & 63) << 3) + (d0 & 7);
                            NT_ST((u32x2*)k, ((u32x2){pk2(lo[0], lo[1]), pk2(lo[2], lo[3])}));
                            NT_ST((u32x2*)(k + 4 * 512), ((u32x2){pk2(hi[0], hi[1]), pk2(hi[2], hi[3])})); }
                    }
            }
            return;
        }
        const int cl = wc * 32 + fq * 8;
#pragma unroll
        for (int ai = 0; ai < 2; ++ai)
#pragma unroll
            for (int m = 0; m < 4; ++m)
#pragma unroll
                for (int bj = 0; bj < 2; ++bj) {
                    const int s = s0 + ai * 128 + m * 16, p = s + NMETA;
                    float xv[8];
#pragma unroll
                    for (int i = 0; i < 4; ++i) { xv[i] = acc[ai][bj][m][0][i] * rs[ai][m]; xv[4 + i] = acc[ai][bj][m][1][i] * rs[ai][m]; }
                    if (pn < 6) {
                        const int h = (pn - 4) * 2 + bj;
                        NT_ST((u32x4*)(VT + ((size_t)((b * 4 + h) * NKT + 1 + (s >> 6)) << 13) + ((cl >> 5) << 11) + (((s & 63) >> 4) << 9) + ((s & 15) << 5) + (cl & 31)),
                            ((u32x4){pk2(xv[0], xv[1]), pk2(xv[2], xv[3]), pk2(xv[4], xv[5]), pk2(xv[6], xv[7])}));
                    } else if (pn < 12) {
                        NT_ST((u32x4*)(QKVB + (size_t)(b * LP + p) * 1536 + (pn - 6) * 256 + bj * 128 + cl), ((u32x4){pk2(xv[0], xv[1]), pk2(xv[2], xv[3]), pk2(xv[4], xv[5]), pk2(xv[6], xv[7])}));
                    } else if (pn < 14) {
#pragma unroll
                        for (int i = 0; i < 8; ++i) xv[i] = xv[i] * __builtin_amdgcn_rcpf(1.0f + __expf(-xv[i]));
                        NT_ST((u32x4*)(ZB + (size_t)(b * LP + p) * 512 + (pn - 12) * 256 + bj * 128 + cl), ((u32x4){pk2(xv[0], xv[1]), pk2(xv[2], xv[3]), pk2(xv[4], xv[5]), pk2(xv[6], xv[7])}));
                    } else if (bj == 0 && cl < 16) {
                        float o[8];
                        if (cl == 0) {
#pragma unroll
                            for (int i = 0; i < 8; ++i) { const float t = xv[i] + dt_bias[i]; const float sp = fmaxf(t, 0.f) + __logf(1.0f + __expf(-fabsf(t))); o[i] = -__expf(a_log[i]) * sp; }
                        } else {
#pragma unroll
                            for (int i = 0; i < 8; ++i) o[i] = __builtin_amdgcn_rcpf(1.0f + __expf(-xv[i]));
                        }
                        float* g = GB + ((size_t)(b * LP + p) << 4) + cl;
                        *(f32x4*)g = (f32x4){o[0], o[1], o[2], o[3]}; *(f32x4*)(g + 4) = (f32x4){o[4], o[5], o[6], o[7]};
                    }
                }
    }
};
typedef EpiInProjT<0> EpiInProj;

DI bf16x8 lds_frag(LAS const bf16_t* M, int row, int ch) { return *(LAS const bf16x8*)((LAS const unsigned char*)M + row * 128 + ((ch ^ (row & 7)) << 4)); }
DI s16x4 tr_read_b64(LAS const unsigned char* p) { return __builtin_bit_cast(s16x4, __builtin_amdgcn_ds_read_tr16_b64_v4i16((LAS v4i16_t*)p)); }
DI bf16x8 lds_frag_plain(LAS const bf16_t* M, int row, int ch) { return *(LAS const bf16x8*)((LAS const unsigned char*)M + row * 128 + (ch << 4)); }
DI int swz_idx(int row, int d) { return row * 64 + ((((d >> 3) ^ (row & 7)) << 3) | (d & 7)); }

#ifndef PREP_REP
#define PREP_REP 0
#endif
constexpr int PREP_PAIR = 35840;

template <int MAT> DI void prep_rows(const bf16_t* QKVB, const float* cw, int b, int h, int n, int lane, LAS const float* egS,
                                     LAS bf16_t* DS  , bf16_t* QG) {
    const int colb = MAT * 512 + h * 64, col = colb + lane, p0 = n * 64;
    const float c0 = cw[col], c1 = cw[1536 + col], c2 = cw[3072 + col], c3 = cw[4608 + col];
    const bf16_t* blk = QKVB + (size_t)(b * LP + p0) * 1536 + colb;
    float x0 = 0.f, x1 = 0.f, x2 = 0.f;
    if (n > 0) { x0 = bf2f(blk[lane - 3 * 1536]); x1 = bf2f(blk[lane - 2 * 1536]); x2 = bf2f(blk[lane - 1 * 1536]); }
    u32x4 stg[8];
#pragma unroll
    for (int i = 0; i < 8; ++i) stg[i] = *(const u32x4*)(blk + (size_t)(8 * i + (lane >> 3)) * 1536 + (lane & 7) * 8);
#pragma unroll
    for (int i = 0; i < 8; ++i) *(LAS u32x4*)(DS + (8 * i + (lane >> 3)) * 64 + (lane & 7) * 8) = stg[i];
    LDS_WAIT();
    const int nvalid = (LTOK - p0) < 64 ? (LTOK - p0) : 64;
#pragma unroll 4
    for (int c = 0; c < nvalid; ++c) {
        const float x3 = bf2f(DS[c * 64 + lane]);
        float y = c0 * x0 + c1 * x1 + c2 * x2 + c3 * x3;
        y = y * __builtin_amdgcn_rcpf(1.0f + __expf(-y));
        x0 = x1; x1 = x2; x2 = x3;
        if (MAT == 2) { DS[c * 64 + lane] = (bf16_t)f2bf(y * egS[c]); }
        else {
            const float ss = wave_sum(y * y);
            const float yn = y * __builtin_amdgcn_rsqf(ss + EPS);
            if (MAT == 0) {
                const float qn = yn * 0.125f;
                DS[c * 64 + lane] = (bf16_t)f2bf(qn);
                QG[c * 64 + perm16(lane)] = (bf16_t)f2bf(qn * egS[c]);
            } else {
                DS[c * 64 + lane] = (bf16_t)f2bf(yn);
            }
        }
    }
    for (int c = nvalid; c < 64; ++c) { DS[c * 64 + lane] = 0; if (MAT == 0) QG[c * 64 + perm16(lane)] = 0; }
}

DI void gdn_tinv(LAS const float* AST, LAS bf16_t* TS, int lane) {
    const int hb = lane >> 5, j = lane & 31, r32 = j, hi = hb;
    LAS const float* Ab = AST + (32 * hb) * 68 + 32 * hb;
    float x[32];
#pragma unroll
    for (int r = 0; r < 32; ++r) x[r] = (r == j) ? 1.0f : 0.0f;
#pragma unroll
    for (int jj = 0; jj < 31; ++jj) {
        const float xj = x[jj];
        LAS const float* ap = Ab + jj * 68;
#pragma unroll
        for (int r4 = (jj + 1) / 4; r4 < 8; ++r4) {
            const f32x4 a = *(LAS const f32x4*)(ap + 4 * r4);
#pragma unroll
            for (int e = 0; e < 4; ++e) if (4 * r4 + e > jj) x[4 * r4 + e] -= a[e] * xj;
        }
    }
    bf16x8 a21[2];
#pragma unroll
    for (int s = 0; s < 2; ++s) { float t[8];
#pragma unroll
        for (int jj = 0; jj < 8; ++jj) t[jj] = AST[(16 * s + 8 * hi + jj) * 68 + 32 + r32];
        const u32x4 p = (u32x4){pk2(t[0], t[1]), pk2(t[2], t[3]), pk2(t[4], t[5]), pk2(t[6], t[7])}; a21[s] = __builtin_bit_cast(bf16x8, p); }
    f32x16 M = {};
#pragma unroll
    for (int s = 0; s < 2; ++s) { float t[8];
#pragma unroll
        for (int jj = 0; jj < 8; ++jj) {
            const auto rr = __builtin_amdgcn_permlane32_swap(__float_as_uint(x[16 * s + 8 + jj]), __float_as_uint(x[16 * s + 8 + jj]), false, false);
            t[jj] = hi ? __uint_as_float(rr[0]) : x[16 * s + jj];
        }
        const u32x4 p = (u32x4){pk2(t[0], t[1]), pk2(t[2], t[3]), pk2(t[4], t[5]), pk2(t[6], t[7])};
        M = MFMA32(a21[s], __builtin_bit_cast(bf16x8, p), M);
    }
    asm volatile("s_waitcnt lgkmcnt(0)" ::: "memory");
#pragma unroll
    for (int i = 0; i < 32; ++i) TS[(32 * hb + i) * 64 + 32 * hb + j] = (bf16_t)f2bf(x[i]);
    asm volatile("s_waitcnt lgkmcnt(0)" ::: "memory");
    f32x16 T21 = {};
#pragma unroll
    for (int s = 0; s < 2; ++s) {
        const u32x2 lo = *(LAS const u32x2*)(TS + (32 + r32) * 64 + 32 + 16 * s + 4 * hi), hi8 = *(LAS const u32x2*)(TS + (32 + r32) * 64 + 32 + 16 * s + 8 + 4 * hi);
        const u32x4 p = (u32x4){lo.x, lo.y, hi8.x, hi8.y};
        T21 = MFMA32(__builtin_bit_cast(bf16x8, p), pack8(M, s), T21);
    }
#pragma unroll
    for (int i = 0; i < 16; ++i) TS[(32 + crow(i, hi)) * 64 + r32] = (bf16_t)f2bf(-T21[i]);
    asm volatile("s_waitcnt lgkmcnt(0)" ::: "memory");
}

template <bool PERM> DI void gdn_tmul(LAS const bf16_t* TS, LAS const bf16_t* RS, int lane, float sgn, bf16_t* out) {
    const int r32 = lane & 31, hi = lane >> 5;
    LAS const unsigned char* rb = (LAS const unsigned char*)RS + ((8 * hi + ((lane & 15) >> 2)) * 64 + 16 * ((lane >> 4) & 1) + 4 * (lane & 3)) * 2;
#pragma unroll
    for (int ct = 0; ct < 2; ++ct)
#pragma unroll
        for (int cb = 0; cb < 2; ++cb) {
            f32x16 acc = {};
#pragma unroll
            for (int ks = 0; ks < (ct == 0 ? 2 : 4); ++ks) {
                const bf16x8 fa = lds_frag_plain(TS, 32 * ct + r32, 2 * ks + hi);
                const s16x4 lo = tr_read_b64(rb + (16 * ks * 64 + 32 * cb) * 2), h4 = tr_read_b64(rb + ((16 * ks + 4) * 64 + 32 * cb) * 2);
                const bf16x8 fb = (bf16x8){lo[0], lo[1], lo[2], lo[3], h4[0], h4[1], h4[2], h4[3]};
                acc = MFMA32(fa, fb, acc);
            }
            u32x2 pk[16];
#pragma unroll
            for (int i = 0; i < 16; ++i) pk[i] = pack_quad_bf16(sgn * acc[i]);
            if ((lane & 3) == 0) {
                unsigned long long ob_ = (unsigned long long)(out + hi * 256 + (PERM ? perm16(32 * cb + r32) : 32 * cb + r32)); asm volatile("" : "+v"(ob_));
                g_u32x2* ob = (g_u32x2*)ob_;
#pragma unroll
                for (int i = 0; i < 16; ++i) ob[(32 * ct + (i & 3) + 8 * (i >> 2)) * 16] = pk[i];
            }
        }
}

DI void gdn_prep_phase(const Params& P, LAS unsigned char* lds, int blk, int G, int wave, int lane_in) {
    const int pair = wave >> 1, role = wave & 1;
    LAS unsigned char* pb = lds + pair * PREP_PAIR;
    LAS bf16_t* QS = (LAS bf16_t*)pb; LAS bf16_t* KS = (LAS bf16_t*)(pb + 8192); LAS float* AS = (LAS float*)(pb + 16384);
    LAS float* gcS = (LAS float*)(pb + 16384 + 17408 + role * 1024); LAS float* betaS = gcS + 64; LAS float* egS = gcS + 128; LAS float* ekS = gcS + 192;
    const bf16_t* QKVB = (const bf16_t*)(P.ws + WS_QKVB); const float* GB = (const float*)(P.ws + WS_GB); const float* cw = P.in[9];
    const int NP = G * 4, NTASK = 2 * 8 * NCHUNK;
    for (int it = 0; it * NP < NTASK; ++it) {
        int lane = lane_in; asm volatile("" : "+v"(lane));
        const int r32 = lane & 31, hi = lane >> 5;
        const int task = it * NP + blk * 4 + pair;
        const bool active = task < NTASK;
        const int bh = task < 2048 ? (task >> 7) : (task - 2048), n = task < 2048 ? (task & 127) : 128, b = bh >> 3, h = bh & 7;
        const int sidx = bh * NCHUNK + n;
        bf16_t* GPW = (bf16_t*)(P.ws + WS_GP) + (size_t)sidx * 4096; bf16_t* GPQG = GPW + GP_ARR / 2; bf16_t* GPAQK = GPQG + GP_ARR / 2; bf16_t* GPKGT = GPAQK + GP_ARR / 2; bf16_t* GPU = GPKGT + GP_ARR / 2;
        float gc = 0.f, beta = 0.f;
        if (active) {
            const int pl = n * 64 + lane;
            float g = 0.f;
            if (pl < LTOK) { const float* gb = GB + ((size_t)(b * LP + pl) << 4); g = gb[h]; beta = gb[8 + h]; }
            gcS[lane] = g; LDS_WAIT();
            gc = 0.f;
#pragma unroll
            for (int j4 = 0; j4 < 16; ++j4) { const f32x4 t = *(LAS const f32x4*)(gcS + 4 * j4);
                gc += (4 * j4 <= lane ? t[0] : 0.f) + (4 * j4 + 1 <= lane ? t[1] : 0.f) + (4 * j4 + 2 <= lane ? t[2] : 0.f) + (4 * j4 + 3 <= lane ? t[3] : 0.f); }
            const float glast = rlane(gc, 63);
            LDS_WAIT();
            gcS[lane] = gc; betaS[lane] = beta; egS[lane] = (role == 0) ? __expf(gc) : beta * __expf(gc); ekS[lane] = __expf(glast - gc);
            if (role == 0 && lane == 0) ((float*)(P.ws + WS_GL))[sidx] = __expf(glast);
            LDS_WAIT();
            for (int rp_ = 0; rp_ < ((PREP_REP & 1) ? 2 : 1); ++rp_) {
            if (role == 0) prep_rows<0>(QKVB, cw, b, h, n, lane, egS, QS, GPQG);
            else prep_rows<1>(QKVB, cw, b, h, n, lane, egS, KS, GPQG);
            }
        }
        LDS_WAIT();
        __syncthreads();
        if (active) {
            for (int rp_ = 0; rp_ < ((PREP_REP & 2) ? 2 : 1); ++rp_)
#pragma unroll
            for (int t4 = 0; t4 < 4; ++t4) {
                const int ct = t4 >> 1, st = t4 & 1;
                f32x16 acc = {};
                if (!(ct == 0 && st == 1)) {
#pragma unroll
                    for (int ks = 0; ks < 4; ++ks) {
                        const bf16x8 fa = lds_frag_plain(role == 0 ? QS : KS, 32 * ct + r32, 2 * ks + hi), fb = lds_frag_plain(KS, 32 * st + r32, 2 * ks + hi);
                        acc = MFMA32(fa, fb, acc);
                    }
                }
                const float gcs = gcS[32 * st + r32];
                LAS const float* gcb = gcS + hi * 4; LAS const float* beb = betaS + hi * 4;
                asm volatile("" : "+v"(gcb), "+v"(beb));
                const int cmp = (32 * st + r32) - 4 * hi;
                if (role == 0) {
                    u32x2 pk[16];
#pragma unroll
                    for (int i = 0; i < 16; ++i) { const int cr = 32 * ct + (i & 3) + 8 * (i >> 2);
                        pk[i] = pack_quad_bf16((cmp <= cr) ? acc[i] * __expf(gcb[cr] - gcs) : 0.f); }
                    if ((lane & 3) == 0) {
                        unsigned long long aq_ = (unsigned long long)(GPAQK + hi * 256 + perm16(r32) + 32 * st); asm volatile("" : "+v"(aq_));
                        g_u32x2* aqb = (g_u32x2*)aq_;
#pragma unroll
                        for (int i = 0; i < 16; ++i) { const int cr = 32 * ct + (i & 3) + 8 * (i >> 2); aqb[cr * 16] = pk[i]; }
                    }
                } else {
                    LAS float* asb = AS + r32 * 68 + hi * 4;
                    asm volatile("" : "+v"(asb));
#pragma unroll
                    for (int i = 0; i < 16; ++i) { const int cr = 32 * ct + (i & 3) + 8 * (i >> 2);
                        asb[32 * st * 68 + cr] = (cmp < cr) ? acc[i] * beb[cr] * __expf(gcb[cr] - gcs) : 0.f; }
                }
            }
        }
        LDS_WAIT();
        __syncthreads();
        LAS bf16_t* TS = (LAS bf16_t*)((LAS unsigned char*)AS + 32 * 68 * 4);
        if (active) {
            if (role == 0) {
                prep_rows<2>(QKVB, cw, b, h, n, lane, betaS, QS  , GPQG);
            } else {
#pragma unroll
                for (int gq = 0; gq < 8; ++gq) {
                    float t[8];
#pragma unroll
                    for (int j = 0; j < 8; ++j) { const int c = perm16(8 * gq + j); t[j] = bf2f(KS[c * 64 + lane]) * ekS[c]; }
                    *(u32x4*)(GPKGT + lane * 64 + 8 * gq) = (u32x4){pk2(t[0], t[1]), pk2(t[2], t[3]), pk2(t[4], t[5]), pk2(t[6], t[7])};
                }
#pragma unroll 8
                for (int c = 0; c < 64; ++c) KS[c * 64 + lane] = (bf16_t)f2bf(bf2f(KS[c * 64 + lane]) * egS[c]);
                gdn_tinv(AS, TS, lane);
            }
        }
        LDS_WAIT();
        __syncthreads();
        if (active) {
            for (int rp_ = 0; rp_ < ((PREP_REP & 8) ? 2 : 1); ++rp_) {
            if (role == 0) gdn_tmul<false>(TS, QS, lane, 1.0f, GPU);
            else gdn_tmul<true>(TS, KS, lane, -1.0f, GPW);
            }
        }
        LDS_WAIT();
    }
}

constexpr int GS_STAGE = 40960 + 1024;
constexpr int GS_NSTAGE = 3;
constexpr int GS_OBUF = GS_NSTAGE * GS_STAGE;
static_assert(GS_OBUF + 16384 <= LDS_BYTES - 64, "gdn scan LDS");

#define GS_POST(n, ZQ) do { \
            if (n > 0) {         \
                LAS const bf16_t* ob = (LAS const bf16_t*)(lds + GS_OBUF + ((n - 1) & 1) * 8192); \
                const f32x4 gn = *(const f32x4*)(gnorm + 4 * vq); \
            _Pragma("unroll") \
                for (int it = 0; it < 8; ++it) { \
                    const int c = (wave - 2) * 32 + 4 * it + rg, p = (n - 1) * 64 + c; \
                    const u32x2 ov = *(LAS const u32x2*)(ob + c * 64 + 4 * vq); \
                    const float v0 = __uint_as_float(ov.x << 16), v1 = __uint_as_float(ov.x & 0xffff0000u), v2 = __uint_as_float(ov.y << 16), v3 = __uint_as_float(ov.y & 0xffff0000u); \
                    const float ss = row_sum16((v0 * v0 + v1 * v1) + (v2 * v2 + v3 * v3)); \
                    const float rn = __builtin_amdgcn_rsqf(ss * (1.0f / 64.0f) + EPS); \
                    const u32x2 zz = ZQ[it]; \
                    const float z0 = __uint_as_float(zz.x << 16), z1 = __uint_as_float(zz.x & 0xffff0000u), z2 = __uint_as_float(zz.y << 16), z3 = __uint_as_float(zz.y & 0xffff0000u); \
                    const float y0 = v0 * rn * gn[0] * z0, y1 = v1 * rn * gn[1] * z1, y2 = v2 * rn * gn[2] * z2, y3 = v3 * rn * gn[3] * z3;       \
                    { bf16_t* dst_ = ((p >= NMETA) && (p < LTOK)) ? MIX + (size_t)(b * SEQ + p - NMETA) * 1024 + 512 + h * 64 + 4 * vq : DUMP + lane * 4;       \
                      *(u32x2*)dst_ = (u32x2){pk2(y0, y1), pk2(y2, y3)}; } \
                } \
            } \
        } while (0)
DI void gdn_scan(const Params& P, LAS unsigned char* lds, int bh, int tid, int wave, int lane) {
    const int b = bh >> 3, h = bh & 7, r32 = lane & 31, hi = lane >> 5;
    const int task0 = (b * 8 + h) * NCHUNK;
    const bf16_t* GP0 = (const bf16_t*)(P.ws + WS_GP);
    const float* GLg = (const float*)(P.ws + WS_GL);
    const bf16_t* ZB = (const bf16_t*)(P.ws + WS_ZB); bf16_t* MIX = (bf16_t*)(P.ws + WS_MIX); const float* gnorm = P.in[12];
    bf16_t* DUMP = (bf16_t*)(P.ws + WS_DUMP) + bh * 4096 + wave * 512;
    const int lw = wave - 4;
    const int prow = lane >> 3, pch = lane & 7;
#define GS_DMA(n_, stg_) do { LAS unsigned char* sg_ = lds + (stg_) * GS_STAGE; \
        _Pragma("unroll") for (int i = 0; i < 10; ++i) { const int a_ = i >> 1, pi_ = lw * 2 + (i & 1), row_ = 8 * pi_ + prow; \
            const int sch_ = (a_ < 4) ? (pch ^ (row_ & 7)) : pch; \
            __builtin_amdgcn_global_load_lds((const unsigned*)(GP0 + (size_t)a_ * (GP_ARR / 2) + (size_t)(task0 + (n_)) * 4096 + row_ * 64 + sch_ * 8), \
                                             (LAS unsigned*)(sg_ + a_ * 8192 + pi_ * 1024), 16, 0, 0); } \
        __builtin_amdgcn_global_load_lds((const unsigned*)(GLg + task0 + (n_)), (LAS unsigned*)(sg_ + 40960 + lw * 256), 4, 0, 0); } while (0)
    if (wave >= 4) { GS_DMA(0, 0); GS_DMA(1, 1); asm volatile("s_waitcnt vmcnt(11)" ::: "memory"); }
    const int vq = lane & 15, rg = lane >> 4;
    u32x2 zqA[8], zqB[8];
#define GS_ZLOADX(ZQ, n_) do { _Pragma("unroll") for (int it = 0; it < 8; ++it) { int p_ = (n_) * 64 + (wave - 2) * 32 + 4 * it + rg; p_ = p_ < LTOK ? p_ : LTOK - 1; \
            ZQ[it] = *(const u32x2*)(ZB + (size_t)(b * LP + p_) * 512 + h * 64 + 4 * vq); } } while (0)
    if (wave == 2 || wave == 3) { GS_ZLOADX(zqB, 0); }
    BAR_LDS();
    f32x16 S0 = {}, S1 = {};
    const int vbase = 32 * wave;
    if (wave < 2) {
    int stg = 0;
    for (int n = 0; n <= NCHUNK; ++n) {
        {
            if (n < NCHUNK) {
                LAS const unsigned char* sg = lds + stg * GS_STAGE;
                LAS const bf16_t* Wm = (LAS const bf16_t*)sg; LAS const bf16_t* QGm = (LAS const bf16_t*)(sg + 8192); LAS const bf16_t* AQm = (LAS const bf16_t*)(sg + 16384);
                LAS const bf16_t* KGm = (LAS const bf16_t*)(sg + 24576); LAS const bf16_t* Um = (LAS const bf16_t*)(sg + 32768);
                const float gl = *(LAS const float*)(sg + 40960);
                bf16x8 Sb[2][2]; Sb[0][0] = pack8(S0, 0); Sb[0][1] = pack8(S0, 1); Sb[1][0] = pack8(S1, 0); Sb[1][1] = pack8(S1, 1);
                bf16x8 fw[2][4], fq[2][4];
                f32x16 vn[2], o[2];
#pragma unroll
                for (int ct = 0; ct < 2; ++ct)
#pragma unroll
                    for (int k4 = 0; k4 < 4; ++k4) { fw[ct][k4] = lds_frag(Wm, 32 * ct + r32, k4 * 2 + hi); fq[ct][k4] = lds_frag(QGm, 32 * ct + r32, k4 * 2 + hi); }
#pragma unroll
                for (int ct = 0; ct < 2; ++ct)
#pragma unroll
                    for (int i = 0; i < 16; ++i) vn[ct][i] = bf2f(Um[(32 * ct + crow(i, hi)) * 64 + vbase + r32]);
                o[0] = f32x16{}; o[1] = f32x16{};
                __builtin_amdgcn_sched_barrier(0);
#pragma unroll
                for (int k4 = 0; k4 < 4; ++k4) {
                    vn[0] = MFMA32(fw[0][k4], Sb[k4 >> 1][k4 & 1], vn[0]); o[0] = MFMA32(fq[0][k4], Sb[k4 >> 1][k4 & 1], o[0]);
                    vn[1] = MFMA32(fw[1][k4], Sb[k4 >> 1][k4 & 1], vn[1]); o[1] = MFMA32(fq[1][k4], Sb[k4 >> 1][k4 & 1], o[1]);
                }
                __builtin_amdgcn_sched_barrier(0);
                bf16x8 fa[2][4], fk[2][4];
#pragma unroll
                for (int g = 0; g < 4; ++g) { fa[0][g] = lds_frag(AQm, r32, g * 2 + hi); fa[1][g] = lds_frag(AQm, 32 + r32, g * 2 + hi);
                                              fk[0][g] = lds_frag(KGm, r32, g * 2 + hi); fk[1][g] = lds_frag(KGm, 32 + r32, g * 2 + hi); }
#pragma unroll
                for (int i = 0; i < 16; ++i) { S0[i] *= gl; S1[i] *= gl; }
                __builtin_amdgcn_sched_barrier(0);
                bf16x8 Vb[2][2]; Vb[0][0] = pack8(vn[0], 0); Vb[0][1] = pack8(vn[0], 1); Vb[1][0] = pack8(vn[1], 0); Vb[1][1] = pack8(vn[1], 1);
#pragma unroll
                for (int g = 0; g < 4; ++g) {
                    o[0] = MFMA32(fa[0][g], Vb[g >> 1][g & 1], o[0]); S0 = MFMA32(fk[0][g], Vb[g >> 1][g & 1], S0);
                    o[1] = MFMA32(fa[1][g], Vb[g >> 1][g & 1], o[1]); S1 = MFMA32(fk[1][g], Vb[g >> 1][g & 1], S1);
                }
                LAS bf16_t* ob = (LAS bf16_t*)(lds + GS_OBUF + (n & 1) * 8192);
#pragma unroll
                for (int ct = 0; ct < 2; ++ct)
#pragma unroll
                    for (int i = 0; i < 16; ++i) ob[(32 * ct + crow(i, hi)) * 64 + vbase + r32] = (bf16_t)f2bf(o[ct][i]);
            }
        }
        BAR_LDS();
        stg = stg + 1 >= GS_NSTAGE ? 0 : stg + 1;
    }
    } else if (wave < 4) {
    for (int n = 0; n <= NCHUNK; n += 2) {
        GS_POST(n, zqA);     if (n + 1 < NCHUNK) { GS_ZLOADX(zqA, n + 1); } BAR_LDS();
        GS_POST((n + 1), zqB); if (n + 2 < NCHUNK) { GS_ZLOADX(zqB, n + 2); } BAR_LDS();
    }
    } else {
    int stg = 0;
    for (int n = 0; n <= NCHUNK; ++n) {
        {
            if (n + 2 < NCHUNK) { const int s2_ = stg + 2 >= GS_NSTAGE ? stg + 2 - GS_NSTAGE : stg + 2; GS_DMA(n + 2, s2_); asm volatile("s_waitcnt vmcnt(11)" ::: "memory"); }
            else asm volatile("s_waitcnt vmcnt(0)" ::: "memory");
        }
        BAR_LDS();
        stg = stg + 1 >= GS_NSTAGE ? 0 : stg + 1;
    }
    }
#undef GS_DMA
#undef GS_ZLOADX
}
#define XB_TMO      128
#define XB_XCNT(j)  (256  + 64 * (j))
#define XB_XSUB(j)  (1280 + 64 * (j))
#define XB_XGEN(j)  (2304 + 64 * (j))
#define XB_TOP      3328
#define XB_TOPGEN   3392
#define XCD_BAR_WORDS 3456
#define XB_SPIN_CAP (1u << 18)

__device__ __forceinline__ unsigned xb_ld(unsigned* p)              { return __hip_atomic_load(p, __ATOMIC_RELAXED, __HIP_MEMORY_SCOPE_AGENT); }
__device__ __forceinline__ unsigned xb_add(unsigned* p, unsigned v) { return __hip_atomic_fetch_add(p, v, __ATOMIC_RELAXED, __HIP_MEMORY_SCOPE_AGENT); }
__device__ __forceinline__ unsigned xb_xcc_id() { return (unsigned)__builtin_amdgcn_s_getreg((3 << 11) | 20) & 0xFu; }
#define XB_SPIN(cond, bar) do { unsigned _sp = 0; while (cond) { __builtin_amdgcn_s_sleep(1); \
    if ((++_sp & 255u) == 0u) { if (xb_ld(&(bar)[XB_TMO])) break; if (_sp > XB_SPIN_CAP) { atomicAdd(&(bar)[XB_TMO], 1u); break; } } } } while (0)

struct XcdBarrier {
    unsigned* bar; unsigned x;
    volatile LAS unsigned* st;
};

__device__ __forceinline__ XcdBarrier xcd_barrier_post(unsigned* bar, volatile LAS unsigned* st) {
    XcdBarrier b; b.bar = bar; b.x = xb_xcc_id(); b.st = st;
    if (threadIdx.x == 0) (void)xb_add(&bar[XB_XCNT(b.x)], 1u);
    return b;
}
__device__ __forceinline__ void xcd_barrier_complete(unsigned* bar, unsigned x, unsigned& nloc, unsigned& nx) {
    const unsigned G = gridDim.x * gridDim.y * gridDim.z;
    unsigned sum, cnt, mine, sp = 0u;
    for (;;) {
        sum = 0u; cnt = 0u; mine = 0u;
#pragma unroll
        for (unsigned j = 0; j < 16; ++j) { const unsigned c = xb_ld(&bar[XB_XCNT(j)]); sum += c; cnt += (c > 0u) ? 1u : 0u; mine = (j == x) ? c : mine; }
        if (sum == G) break;
        __builtin_amdgcn_s_sleep(1);
        if ((++sp & 255u) == 0u) { if (xb_ld(&bar[XB_TMO])) break; if (sp > XB_SPIN_CAP) { atomicAdd(&bar[XB_TMO], 1u); break; } }
    }
    nloc = mine > 0u ? mine : 1u; nx = cnt > 0u ? cnt : 1u;
}

__device__ __forceinline__ void xcd_barrier(const XcdBarrier& b) {
    asm volatile("s_waitcnt vmcnt(0)" ::: "memory");
    __syncthreads();
    if (threadIdx.x == 0) {
        unsigned* bar = b.bar;
        __builtin_amdgcn_s_waitcnt(0);
        unsigned nloc = b.st[0], nx = b.st[1];
        if (nloc == 0u) { xcd_barrier_complete(bar, b.x, nloc, nx); b.st[0] = nloc; b.st[1] = nx; }
        const unsigned old = xb_add(&bar[XB_XSUB(b.x)], 1u);
        const unsigned gen = old / nloc;
        if (old + 1u == (gen + 1u) * nloc) {
            __builtin_amdgcn_fence(__ATOMIC_RELEASE, "agent");
            asm volatile("s_waitcnt vmcnt(0)" ::: "memory");
            const unsigned og = xb_add(&bar[XB_TOP], 1u);
            const unsigned tg = og / nx;
            if (og + 1u == (tg + 1u) * nx) xb_add(&bar[XB_TOPGEN], 1u);
            else XB_SPIN(xb_ld(&bar[XB_TOPGEN]) == tg, bar);
            __builtin_amdgcn_fence(__ATOMIC_ACQUIRE, "agent");
            xb_add(&bar[XB_XGEN(b.x)], 1u);
            asm volatile("s_waitcnt vmcnt(0)" ::: "memory");
        } else {
            XB_SPIN(xb_ld(&bar[XB_XGEN(b.x)]) == gen, bar);
            __builtin_amdgcn_fence(__ATOMIC_ACQUIRE, "agent");
            asm volatile("s_waitcnt vmcnt(0)" ::: "memory");
        }
    }
    __syncthreads();
}


constexpr int AT_STAGE = 32768;
constexpr int AT_NSTAGE = 4;
constexpr int AT_XBUF = 0;
constexpr int AT_WSF = AT_NSTAGE * AT_STAGE;
constexpr int AT_UNIT = AT_WSF + 2048;
constexpr float AT_THR = 8.0f;

DI float max3f(float a, float b, float c) { return __builtin_fmaxf(__builtin_fmaxf(a, b), c); }
DI s16x4 tr_read(LAS const unsigned char* p) { return __builtin_bit_cast(s16x4, __builtin_amdgcn_ds_read_tr16_b64_v4i16((LAS v4i16_t*)p)); }

template <int VAR> DI void attn_unit(const Params& P, LAS unsigned char* lds, int bh, int qi, int tid, int wave, int lane, float lam) {
    const int b = bh >> 2, h = bh & 3, r32 = lane & 31, hi = lane >> 5, qsub = wave >> 1, map = wave & 1, hh = 2 * h + map;
    const bf16_t* QB = (const bf16_t*)(P.ws + WS_QB); const bf16_t* KT = (const bf16_t*)(P.ws + WS_KT); const bf16_t* VT = (const bf16_t*)(P.ws + WS_VT);
    const int ntiles = 2 * qi + 3, my_nt = (qsub < 2) ? ntiles - 1 : ntiles;
    const bf16_t* k1 = KT + ((size_t)((b * 8 + 2 * h) * NKT) << 12) + tid * 8;
    const bf16_t* k2 = KT + ((size_t)((b * 8 + 2 * h + 1) * NKT) << 12) + tid * 8;
    const bf16_t* vv = VT + ((size_t)((b * 4 + h) * NKT) << 13) + tid * 8;
#define AT_DMA(t, sb) do { LAS unsigned char* d_ = lds + (sb) * AT_STAGE + wave * 1024; \
        __builtin_amdgcn_global_load_lds((const unsigned*)(k1 + ((size_t)(t) << 12)), (LAS unsigned*)d_, 16, 0, 0); \
        __builtin_amdgcn_global_load_lds((const unsigned*)(k2 + ((size_t)(t) << 12)), (LAS unsigned*)(d_ + 8192), 16, 0, 0); \
        __builtin_amdgcn_global_load_lds((const unsigned*)(vv + ((size_t)(t) << 13)), (LAS unsigned*)(d_ + 16384), 16, 0, 0); \
        __builtin_amdgcn_global_load_lds((const unsigned*)(vv + ((size_t)(t) << 13) + 4096), (LAS unsigned*)(d_ + 24576), 16, 0, 0); } while (0)
    bf16x8 qr[4];
    { const bf16_t* q = QB + ((size_t)((b * 8 + hh) * SEQ + qi * 128 + qsub * 32 + r32) << 6) + hi * 8;
#pragma unroll
      for (int d0 = 0; d0 < 4; ++d0) qr[d0] = *(const bf16x8*)(q + d0 * 16); }
    asm volatile("s_waitcnt vmcnt(0)" : "+v"(qr[0]), "+v"(qr[1]), "+v"(qr[2]), "+v"(qr[3]) :: "memory");
    AT_DMA(0, 0); AT_DMA(1, 1); AT_DMA(2, 2);
    asm volatile("s_waitcnt vmcnt(8)" ::: "memory");
    BAR_LDS();
    LAS float* wsf = (LAS float*)(lds + AT_WSF) + wave * 64;
    float m_run = 0.f, l_run = 0.f;
    f32x16 negm = {};
    f32x16 o[4]; o[0] = f32x16{}; o[1] = f32x16{}; o[2] = f32x16{}; o[3] = f32x16{};
    for (int t = 0; t < ntiles; ++t) {
        if (t + 3 < ntiles) AT_DMA(t + 3, (t + 3) % AT_NSTAGE);
        if (t < my_nt) {
            LAS const unsigned char* sg = lds + (t % AT_NSTAGE) * AT_STAGE;
            LAS const unsigned char* kb = sg + map * 8192 + hi * 1024 + r32 * 16;
            f32x16 p0 = negm, p1 = negm;
            bf16x8 kf[8];
#pragma unroll
            for (int d0 = 0; d0 < 4; ++d0) { kf[2 * d0] = *(LAS const bf16x8*)(kb + d0 * 2048); kf[2 * d0 + 1] = *(LAS const bf16x8*)(kb + d0 * 2048 + 512); }
            __builtin_amdgcn_sched_barrier(0);
            __builtin_amdgcn_s_setprio(1);
#pragma unroll
            for (int d0 = 0; d0 < 4; ++d0) { p0 = MFMA32(kf[2 * d0], qr[d0], p0); p1 = MFMA32(kf[2 * d0 + 1], qr[d0], p1); }
            __builtin_amdgcn_s_setprio(0);
            const bool first = (t == 0);
            if (first) {
#pragma unroll
                for (int r = 0; r < 16; ++r) { if (crow(r, hi) >= NMETA) p0[r] = -INFINITY; p1[r] = -INFINITY; }
            }
            float ma = max3f(p0[0], p0[1], p1[0]), mb = max3f(p0[2], p0[3], p1[1]); ma = max3f(ma, p1[2], p1[3]);
#pragma unroll
            for (int r = 4; r < 16; r += 4) { ma = max3f(ma, p0[r], p0[r + 1]); mb = max3f(mb, p0[r + 2], p0[r + 3]); ma = max3f(ma, p1[r], p1[r + 1]); mb = max3f(mb, p1[r + 2], p1[r + 3]); }
            const float rm = swap32_max(max3f(ma, mb, mb));
            if (first || __any(rm > AT_THR)) {
                const float dl = first ? rm : fmaxf(rm, 0.f);
                m_run += dl;
#pragma unroll
                for (int r = 0; r < 16; ++r) { p0[r] -= dl; p1[r] -= dl; negm[r] = -m_run; }
                const float alpha = __builtin_amdgcn_exp2f(-dl);
                l_run *= alpha;
                if (!first) {
                    if (hi == 0) wsf[r32] = alpha;
                    LDS_WAIT();
#pragma unroll
                    for (int r = 0; r < 16; ++r) { const float a = wsf[crow(r, hi)];
#pragma unroll
                        for (int d0 = 0; d0 < 4; ++d0) o[d0][r] *= a; }
                    LDS_WAIT();
                }
            }
            float ls0 = 0.f, ls1 = 0.f;
#pragma unroll
            for (int r = 0; r < 16; ++r) { if (VAR != 2) { p0[r] = __builtin_amdgcn_exp2f(p0[r]); p1[r] = __builtin_amdgcn_exp2f(p1[r]); } ls0 += p0[r]; ls1 += p1[r]; }
            l_run += ls0 + ls1;
            const bf16x8 pa0 = pack8(p0, 0), pa1 = pack8(p0, 1), pa2 = pack8(p1, 0), pa3 = pack8(p1, 1);
            LAS const unsigned char* vb = sg + 16384 + ((lane >> 4) & 1) * 32 + (lane & 3) * 8 + (4 * hi + ((lane & 15) >> 2)) * 64;
            s16x4 va_[8], vb_[8];
            const unsigned vba = (unsigned)(uintptr_t)vb;
#define AT_VLD(V, d0_) do { _Pragma("unroll") for (int ks = 0; ks < 4; ++ks) { \
                asm volatile("ds_read_b64_tr_b16 %0, %1 offset:%c2" : "=v"(V[2 * ks]) : "v"(vba), "i"((d0_) * 4096 + ks * 1024)); \
                asm volatile("ds_read_b64_tr_b16 %0, %1 offset:%c2" : "=v"(V[2 * ks + 1]) : "v"(vba), "i"((d0_) * 4096 + ks * 1024 + 512)); } } while (0)
#define AT_VF(V, ks) ((bf16x8){V[2 * (ks)][0], V[2 * (ks)][1], V[2 * (ks)][2], V[2 * (ks)][3], V[2 * (ks) + 1][0], V[2 * (ks) + 1][1], V[2 * (ks) + 1][2], V[2 * (ks) + 1][3]})
#define AT_WAITL(n, V) do { asm volatile("s_waitcnt lgkmcnt(" #n ")" : "+v"(V[0]), "+v"(V[1]), "+v"(V[2]), "+v"(V[3]), "+v"(V[4]), "+v"(V[5]), "+v"(V[6]), "+v"(V[7])); __builtin_amdgcn_sched_barrier(0); } while (0)
#define AT_PV(V, d0_) do { __builtin_amdgcn_s_setprio(1); o[d0_] = MFMA32(pa0, AT_VF(V, 0), o[d0_]); o[d0_] = MFMA32(pa1, AT_VF(V, 1), o[d0_]); o[d0_] = MFMA32(pa2, AT_VF(V, 2), o[d0_]); o[d0_] = MFMA32(pa3, AT_VF(V, 3), o[d0_]); __builtin_amdgcn_s_setprio(0); } while (0)
            if (VAR != 1) {
            asm volatile("s_waitcnt lgkmcnt(0)" ::: "memory"); __builtin_amdgcn_sched_barrier(0);
            AT_VLD(va_, 0); AT_VLD(vb_, 1);
            AT_WAITL(8, va_); AT_PV(va_, 0); __builtin_amdgcn_sched_barrier(0); AT_VLD(va_, 2);
            AT_WAITL(8, vb_); AT_PV(vb_, 1); __builtin_amdgcn_sched_barrier(0); AT_VLD(vb_, 3);
            AT_WAITL(8, va_); AT_PV(va_, 2); __builtin_amdgcn_sched_barrier(0);
            AT_WAITL(0, vb_); AT_PV(vb_, 3);
            } else { o[0][0] += (float)pa0[0] + (float)pa1[1] + (float)pa2[2] + (float)pa3[3]; }
#undef AT_VF
#undef AT_WAITL
#undef AT_VLD
#undef AT_PV
        }
        if (t + 3 < ntiles) asm volatile("s_waitcnt vmcnt(8)" ::: "memory"); else if (t + 2 < ntiles) asm volatile("s_waitcnt vmcnt(4)" ::: "memory"); else asm volatile("s_waitcnt vmcnt(0)" ::: "memory");
        BAR_LDS();
    }
    if (VAR != 0) { if (o[0][0] + o[1][1] + o[2][2] + o[3][3] + l_run == 123.456f) ((float*)(P.ws + WS_DUMP))[tid] = 1.f; __syncthreads(); return; }
    l_run = swap32_add(l_run);
    const float sc = (map ? lam : 1.0f) / l_run;
    if (hi == 0) wsf[r32] = sc;
    LDS_WAIT();
#pragma unroll
    for (int r = 0; r < 16; ++r) { const float a = wsf[crow(r, hi)];
#pragma unroll
        for (int d0 = 0; d0 < 4; ++d0) o[d0][r] *= a; }
    LAS float* xb = (LAS float*)(lds + AT_XBUF + qsub * 16384);
    if (map) {
#pragma unroll
        for (int d0 = 0; d0 < 4; ++d0)
#pragma unroll
            for (int r = 0; r < 16; ++r) xb[(d0 * 16 + r) * 64 + lane] = o[d0][r];
    }
    __syncthreads();
    if (!map) {
        const float* dn = P.in[8];
        bf16_t* MIX = (bf16_t*)(P.ws + WS_MIX);
        float ss[16];
#pragma unroll
        for (int r = 0; r < 16; ++r) { ss[r] = 0.f;
#pragma unroll
            for (int d0 = 0; d0 < 4; ++d0) { o[d0][r] -= xb[(d0 * 16 + r) * 64 + lane]; ss[r] += o[d0][r] * o[d0][r]; } }
#pragma unroll
        for (int r = 0; r < 16; ++r) {
            ss[r] = half_sum32(ss[r]);
            ss[r] = 0.8f / sqrtf(ss[r] * (1.0f / 128.0f) + EPS);
        }
        float dg[4];
#pragma unroll
        for (int d0 = 0; d0 < 4; ++d0) dg[d0] = dn[32 * d0 + r32];
#pragma unroll
        for (int r = 0; r < 16; ++r) {
            bf16_t* orow = MIX + (size_t)(b * SEQ + qi * 128 + qsub * 32 + crow(r, hi)) * 1024 + h * 128 + r32;
#pragma unroll
            for (int d0 = 0; d0 < 4; ++d0) orow[32 * d0] = (bf16_t)f2bf(o[d0][r] * ss[r] * dg[d0]);
        }
    }
    __syncthreads();
#undef AT_DMA
}

template <int VAR> DI void attn_phase(const Params& P, LAS unsigned char* lds, int tid, int wave, int lane) {
    unsigned* ctl = (unsigned*)(P.ws + WS_CTL);
    const float* lq1 = P.in[4]; const float* lk1 = P.in[5]; const float* lq2 = P.in[6]; const float* lk2 = P.in[7];
    const float lam = __expf(wave_sum(lq1[lane] * lk1[lane])) - __expf(wave_sum(lq2[lane] * lk2[lane])) + 0.2f;
    LAS volatile int* ub = (LAS volatile int*)(lds + AT_UNIT);
    const unsigned x0 = xb_xcc_id() & 7u;
    for (;;) {
        if (tid == 0) {
            int u = -1;
            for (unsigned j = 0; j < 8u && u < 0; ++j) { const unsigned x = (x0 + j) & 7u;
                if (__hip_atomic_load(ctl + CW_ATTQ + 64 * x, __ATOMIC_RELAXED, __HIP_MEMORY_SCOPE_AGENT) >= 64u) continue;
                const unsigned i = __hip_atomic_fetch_add(ctl + CW_ATTQ + 64 * x, 1u, __ATOMIC_RELAXED, __HIP_MEMORY_SCOPE_AGENT);
                if (i < 64u) u = (int)(x * 64u + i); }
            *ub = u;
        }
        __syncthreads();
        const int u = *ub;
        __syncthreads();
        if (u < 0) break;
        attn_unit<VAR>(P, lds, u >> 6, 63 - (u & 63), tid, wave, lane, lam);
    }
}

struct EpiOutProj {
    static constexpr bool PERM = false, AFTER_DRAIN = false;
    const float* x; float* out; bf16_t* u2;
    DI void operator()(const pg8::f32x4 (&acc)[2][2][4][2], const pg8::Unit& u, int wr, int wc, int fr, int fq) const {
        const int row0 = u.pm * 256 + wr * 64 + fr, col0 = u.pn * 256 + wc * 32 + 4 * fq;
#pragma unroll
        for (int ai = 0; ai < 2; ++ai) {
            f32x4 xv[4][2][2];
#pragma unroll
            for (int m = 0; m < 4; ++m) { const size_t off = (size_t)(row0 + ai * 128 + m * 16) * 1024 + col0;
#pragma unroll
                for (int bj = 0; bj < 2; ++bj)
#pragma unroll
                    for (int n = 0; n < 2; ++n) xv[m][bj][n] = *(const f32x4*)(x + off + bj * 128 + n * 16); }
#pragma unroll
            for (int m = 0; m < 4; ++m) { const size_t off = (size_t)(row0 + ai * 128 + m * 16) * 1024 + col0;
#pragma unroll
                for (int bj = 0; bj < 2; ++bj)
#pragma unroll
                    for (int n = 0; n < 2; ++n) { const f32x4 hv = acc[ai][bj][m][n] + xv[m][bj][n]; *(f32x4*)(out + off + bj * 128 + n * 16) = hv;
                        *(u32x2*)(u2 + off + bj * 128 + n * 16) = (u32x2){pk2(hv[0], hv[1]), pk2(hv[2], hv[3])}; } }
        }
    }
};

typedef float f32x4v __attribute__((ext_vector_type(4)));
#ifdef ROUTE_PROBE
#define ROUTE_MID_HOOK() do { XcdBarrier xb2; xb2.bar = (unsigned*)(P.ws + WS_CTL) + CW_BAR; xb2.x = xb_xcc_id(); xb2.st = (volatile LAS unsigned*)(ldsb + LDS_BYTES - 64); xcd_barrier(xb2); \
    if (blockIdx.x == 0 && threadIdx.x == 0) __hip_atomic_store((unsigned long long*)(P.ws + WS_CTL + 65536) + 20, (unsigned long long)__builtin_amdgcn_s_memrealtime(), __ATOMIC_RELAXED, __HIP_MEMORY_SCOPE_AGENT); } while (0)
#else
#define ROUTE_MID_HOOK() do {} while (0)
#endif
DI void route_tile(const Params& P, int tile, int par, LAS float* sc  , int lane, LAS unsigned char* ldsb) {
    const float* h2 = P.out; const float* WR = (const float*)(P.ws + WS_WR);
    const int r16 = lane & 15, kq = lane >> 4;
    const float* arow = h2 + (size_t)(tile * 16 + r16) * 1024 + par * 512 + kq * 8;
    const float* b0 = WR + (size_t)r16 * 1024 + par * 512 + kq * 8; const float* b1 = b0 + 16 * 1024; const float* b2 = WR + (size_t)(32 + (r16 & 3)) * 1024 + par * 512 + kq * 8;
    const float z2 = (r16 < 4) ? 1.0f : 0.0f;
    f32x4v c0 = {}, c1 = {}, c2 = {};
    float ss = 0.f;
    f32x4 bA[4][4], bB[4][4];
#define RT_LOAD(B, tb) do { _Pragma("unroll") for (int j = 0; j < 4; ++j) { const int o_ = 32 * ((tb) + (j >> 1)) + 4 * (j & 1); \
        B[j][0] = *(const f32x4*)(arow + o_); B[j][1] = *(const f32x4*)(b0 + o_); B[j][2] = *(const f32x4*)(b1 + o_); B[j][3] = *(const f32x4*)(b2 + o_); } } while (0)
#define RT_COMP(B) do { _Pragma("unroll") for (int j = 0; j < 4; ++j) { const f32x4 a = B[j][0]; ss += (a.x * a.x + a.y * a.y) + (a.z * a.z + a.w * a.w); \
        _Pragma("unroll") for (int i = 0; i < 4; ++i) { c0 = __builtin_amdgcn_mfma_f32_16x16x4f32(a[i], B[j][1][i], c0, 0, 0, 0); \
            c1 = __builtin_amdgcn_mfma_f32_16x16x4f32(a[i], B[j][2][i], c1, 0, 0, 0); c2 = __builtin_amdgcn_mfma_f32_16x16x4f32(a[i], B[j][3][i] * z2, c2, 0, 0, 0); } } } while (0)
    RT_LOAD(bA, 0);
#pragma unroll
    for (int tb = 0; tb < 16; tb += 4) {
        RT_LOAD(bB, tb + 2); __builtin_amdgcn_sched_barrier(0); RT_COMP(bA); __builtin_amdgcn_sched_barrier(0);
        if (tb + 4 < 16) { RT_LOAD(bA, tb + 4); } __builtin_amdgcn_sched_barrier(0); RT_COMP(bB); __builtin_amdgcn_sched_barrier(0); }
#undef RT_LOAD
#undef RT_COMP
    ss += swz_xor16(ss); ss = swap32_add(ss);
    LAS float* my = sc + par * 800;
#pragma unroll
    for (int r = 0; r < 4; ++r) { const int row = 4 * kq + r; my[row * 48 + r16] = c0[r]; my[row * 48 + 16 + r16] = c1[r]; my[row * 48 + 32 + r16] = c2[r]; }
    if (lane < 16) my[768 + lane] = ss;
    LAS int* lcnt = (LAS int*)(ldsb + 4 * 32768 + 1024);
    if (threadIdx.x < 32) lcnt[threadIdx.x] = 0;
    int pa = 0, pb = 0, ea_ = 0, eb_ = 0; float w1_ = 0.f, w2_ = 0.f, rs_ = 0.f;
    LDS_WAIT();
    __syncthreads();
    ROUTE_MID_HOOK();
    if (par == 0 && lane < 16) {
        LAS const float* l0 = sc + lane * 48; LAS const float* l1 = sc + 800 + lane * 48;
        const float rs = __builtin_amdgcn_rsqf((sc[768 + lane] + sc[800 + 768 + lane]) * (1.0f / 1024.0f) + EPS);
#define LG(j) (l0[j] + l1[j])
        const int t = tile * 16 + lane;
        const float* bg = P.in[16]; const float* br = P.in[18];
        float gl[4]; int gs = 0; float gm;
#pragma unroll
        for (int j = 0; j < 4; ++j) gl[j] = LG(j) * rs + bg[j];
        gm = gl[0];
#pragma unroll
        for (int j = 1; j < 4; ++j) if (gl[j] > gm) { gm = gl[j]; gs = j; }
        float gsum = 0.f;
#pragma unroll
        for (int j = 0; j < 4; ++j) gsum += __expf(gl[j] - gm);
        const float psel = 1.0f / gsum;
        float e1 = -INFINITY, e2 = -INFINITY; int i1 = 0, i2 = 0;
#pragma unroll
        for (int j = 0; j < 8; ++j) {
            const float v = LG(4 + gs * 8 + j) * rs + br[gs * 8 + j];
            if (v > e1) { e2 = e1; i2 = i1; e1 = v; i1 = j; } else if (v > e2) { e2 = v; i2 = j; }
        }
        const float x2 = __expf(e2 - e1), w1 = psel / (1.0f + x2), w2 = psel * x2 / (1.0f + x2);
        const int ea = gs * 8 + i1, eb = gs * 8 + i2;
        pa = (int)__hip_atomic_fetch_add(lcnt + ea, 1, __ATOMIC_RELAXED, __HIP_MEMORY_SCOPE_WORKGROUP); pb = (int)__hip_atomic_fetch_add(lcnt + eb, 1, __ATOMIC_RELAXED, __HIP_MEMORY_SCOPE_WORKGROUP);
        ea_ = ea; eb_ = eb; w1_ = w1; w2_ = w2; rs_ = rs;
        ((int*)(P.ws + WS_TOKE))[2 * t] = ea; ((int*)(P.ws + WS_TOKE))[2 * t + 1] = eb;
        ((float*)(P.ws + WS_TOKW))[2 * t] = w1; ((float*)(P.ws + WS_TOKW))[2 * t + 1] = w2;
        ((float*)(P.ws + WS_RS2))[t] = rs;
#undef LG
    }
    LDS_WAIT();
    __syncthreads();
    if (threadIdx.x < 32) { const int c = lcnt[threadIdx.x];
        lcnt[32 + threadIdx.x] = c ? (int)atomicAdd((unsigned*)(P.ws + WS_CTL) + CW_CNT + 64 * threadIdx.x, (unsigned)c) : 0; }
    LDS_WAIT();
    __syncthreads();
    if (par == 0 && lane < 16) { const int t = tile * 16 + lane;
        const int qa = lcnt[32 + ea_] + pa, qb = lcnt[32 + eb_] + pb;
        ((int*)(P.ws + WS_TOKP))[2 * t] = qa; ((int*)(P.ws + WS_TOKP))[2 * t + 1] = qb;
        ((int*)(P.ws + WS_LIST))[ea_ * 16384 + qa] = t; ((int*)(P.ws + WS_LIST))[eb_ * 16384 + qb] = t;
        ((float*)(P.ws + WS_LISTW))[ea_ * 16384 + qa] = w1_; ((float*)(P.ws + WS_LISTW))[eb_ * 16384 + qb] = w2_;
        ((float*)(P.ws + WS_LISTRS))[ea_ * 16384 + qa] = rs_; ((float*)(P.ws + WS_LISTRS))[eb_ * 16384 + qb] = rs_; }
    LDS_WAIT();
    __syncthreads();
}

#ifndef P4A_REP
#define P4A_REP 0
#endif
template <int P4A_PART> DI void phase4a(const Params& P, LAS unsigned char* lds, int gw, int NGW, int wave, int lane) {
    LAS float* scr = (LAS float*)(lds + wave * 16384);
    if (P4A_PART & 1) for (int tile = (gw >> 1); tile < MTOK / 16; tile += (NGW >> 1)) route_tile(P, tile, wave & 1, (LAS float*)(lds + (wave >> 1) * 32768), lane, lds);
    if (!(P4A_PART & 2)) return;
    bf16_t* WGU = (bf16_t*)(P.ws + WS_WGU); bf16_t* WD = (bf16_t*)(P.ws + WS_WD);
    const float* wg = P.in[19]; const float* wu = P.in[20]; const float* wd = P.in[21]; const float* gf = P.in[14];
    constexpr int I_GU = 16 * 16, I_D = 4 * 32, NIT = 32 * (I_GU + I_D);
    struct TItem { const float* src; const float* gn; bf16_t* dst; int stride, ldk; };
    auto mk = [&](int it) { TItem d; const int e = it / (I_GU + I_D), r = it % (I_GU + I_D);
        if (r < I_GU) { const int n0 = (r & 15) * 32, j = n0 >> 8, up = (n0 >> 7) & 1, k0 = (r >> 4) * 64;
            d.src = (up ? wu : wg) + (size_t)e * 1024 * 256 + (size_t)k0 * 256 + 128 * j + (n0 & 127); d.gn = gf + k0; d.stride = 256; d.ldk = 1024;
            d.dst = WGU + (size_t)e * 512 * 1024 + (size_t)n0 * 1024 + k0; }
        else { const int r2 = r - I_GU, k0 = (r2 >> 5) * 64, n0 = (r2 & 31) * 32;
            d.src = wd + (size_t)e * 256 * 1024 + (size_t)k0 * 1024 + n0; d.gn = nullptr; d.stride = 1024; d.ldk = 256;
            d.dst = WD + (size_t)e * 1024 * 256 + (size_t)n0 * 256 + k0; }
        return d; };
#define TI_LOAD(D, V) do { _Pragma("unroll") for (int i = 0; i < 32; ++i) { const int kk = 2 * i + (lane >> 5); \
        V[i] = D.src[(size_t)kk * D.stride + (lane & 31)] * (D.gn ? D.gn[kk] : 1.0f); } } while (0)
#define TI_FIN(D, V) do { _Pragma("unroll") for (int i = 0; i < 32; ++i) scr[(2 * i + (lane >> 5)) * 33 + (lane & 31)] = V[i]; \
        LDS_WAIT(); const int c_ = lane & 7; \
        _Pragma("unroll") for (int j = 0; j < 4; ++j) { const int n_ = (lane >> 3) + 8 * j; const LAS float* s_ = scr + (8 * c_) * 33 + n_; \
            u32x4 o_; o_.x = pk2(s_[0 * 33], s_[1 * 33]); o_.y = pk2(s_[2 * 33], s_[3 * 33]); o_.z = pk2(s_[4 * 33], s_[5 * 33]); o_.w = pk2(s_[6 * 33], s_[7 * 33]); \
            *(u32x4*)(D.dst + (size_t)n_ * D.ldk + 8 * c_) = o_; } \
        LDS_WAIT(); } while (0)
    for (int rp_ = 0; rp_ < (P4A_REP ? 2 : 1); ++rp_) {
        float va[32], vb[32];
        int it = gw;
        if (it < NIT) { TItem da = mk(it); TI_LOAD(da, va);
            for (;;) {
                const int itb = it + NGW; TItem db = da; const bool hb = itb < NIT;
                if (hb) { db = mk(itb); TI_LOAD(db, vb); }
                TI_FIN(da, va);
                if (!hb) break;
                it = itb + NGW; const bool ha = it < NIT;
                if (ha) { da = mk(it); TI_LOAD(da, va); }
                TI_FIN(db, vb);
                if (!ha) break;
            }
        }
    }
#undef TI_LOAD
#undef TI_FIN
}

DI void expert_layout(const Params& P, int lane, int& cnt, int& base, int& tend) {
    const unsigned* c = (const unsigned*)(P.ws + WS_CTL) + CW_CNT;
    cnt = (lane < 32) ? (int)__hip_atomic_load(c + 64 * lane, __ATOMIC_RELAXED, __HIP_MEMORY_SCOPE_AGENT) : 0;
    const int tiles = (cnt + 255) >> 8;
    int inc = 0;
#pragma unroll
    for (int i = 0; i < 32; ++i) { const int ti = __builtin_amdgcn_readlane(tiles, i); inc += (i <= lane) ? ti : 0; }
    tend = inc; base = (inc - tiles) << 8;
}

DI void phase4b(const Params& P, int gw, int NGW, int lane) {
    int cnt, base, tend; expert_layout(P, lane, cnt, base, tend);
    bf16_t* XS = (bf16_t*)(P.ws + WS_XS); float* SLOTW = (float*)(P.ws + WS_SLOTW);
    const int* TOKE = (const int*)(P.ws + WS_TOKE); const float* TOKW = (const float*)(P.ws + WS_TOKW); int* TOKP = (int*)(P.ws + WS_TOKP); const float* RS2 = (const float*)(P.ws + WS_RS2);
    for (int t = gw; t < MTOK; t += NGW) {
        const f32x4* hr = (const f32x4*)(P.out + (size_t)t * 1024);
        const float rs = RS2[t];
        u32x2 w[4];
#pragma unroll
        for (int j = 0; j < 4; ++j) { const f32x4 v = hr[64 * j + lane]; w[j] = (u32x2){pk2(v.x * rs, v.y * rs), pk2(v.z * rs, v.w * rs)}; }
#pragma unroll
        for (int k = 0; k < 2; ++k) {
            const int e = __builtin_amdgcn_readfirstlane(TOKE[2 * t + k]), slot = __builtin_amdgcn_readlane(base, e) + TOKP[2 * t + k];
            u32x2* orow = (u32x2*)(XS + (size_t)slot * 1024);
#pragma unroll
            for (int j = 0; j < 4; ++j) orow[64 * j + lane] = w[j];
            if (lane == 0) { SLOTW[slot] = TOKW[2 * t + k]; TOKP[2 * t + k] = slot; }
        }
    }
    for (int e = 0; e < 32; ++e) {
        const int ce = __builtin_amdgcn_readlane(cnt, e), be = __builtin_amdgcn_readlane(base, e), end = be + (((ce + 255) >> 8) << 8);
        for (int r = be + ce + gw; r < end; r += NGW) { u32x2* orow = (u32x2*)(XS + (size_t)r * 1024);
#pragma unroll
            for (int j = 0; j < 4; ++j) orow[64 * j + lane] = (u32x2){0u, 0u};
            if (lane == 0) SLOTW[r] = 0.f; }
    }
}

#define XCD_ORDER(blk_, G_) ((((G_) & 7) == 0) ? ((blk_) & 7) * ((G_) >> 3) + ((blk_) >> 3) : (blk_))
struct GroupedOrder {
    int tend; int total; int G, c, NS; int cnt, base; const int* LIST;
    DI unsigned rowoff(const pg8::Unit& u, int r) const {
        const int e = __builtin_amdgcn_readfirstlane(u.pn >> NS), ce = __builtin_amdgcn_readlane(cnt, e), t0 = __builtin_amdgcn_readlane(base, e) >> 8;
        const int pos = (u.pm - t0) * 256 + r;
        const int tok = pos < ce ? LIST[e * 16384 + pos] : 0;
        return (unsigned)tok * 2048u;
    }
    DI bool next(int i, pg8::Unit& u) const {
        const int L = i * G + c; if (L >= (total << NS)) return false;
        const int mt = L >> NS, j = L & ((1 << NS) - 1);
        const int e = __builtin_popcountll(__ballot(((int)(threadIdx.x & 63) < 32) && tend <= mt));
        u.pm = mt; u.pn = (e << NS) + j; return true;
    }
    DI void a_ready(const pg8::Unit&) const {}
    DI void done(const pg8::Unit&) const {}
};
struct EpiGateUp {
    static constexpr bool PERM = true, AFTER_DRAIN = false;
    const float* LISTW; const float* LISTRS; bf16_t* YS; int cnt, base;
    DI void operator()(const pg8::f32x4 (&acc)[2][2][4][2], const pg8::Unit& u, int wr, int wc, int fr, int fq) const {
        const int f0 = (u.pn & 1) * 128 + wc * 32 + fq * 8;
        const int e = __builtin_amdgcn_readfirstlane(u.pn >> 1), ce = __builtin_amdgcn_readlane(cnt, e), t0 = __builtin_amdgcn_readlane(base, e) >> 8;
        float cwv[2][4], rsv[2][4];
#pragma unroll
        for (int ai = 0; ai < 2; ++ai)
#pragma unroll
            for (int m = 0; m < 4; ++m) { const int pos = (u.pm - t0) * 256 + ai * 128 + wr * 64 + m * 16 + fr; const bool ok = pos < ce;
                cwv[ai][m] = ok ? LISTW[e * 16384 + pos] : 0.f; rsv[ai][m] = ok ? LISTRS[e * 16384 + pos] : 0.f; }
        __builtin_amdgcn_sched_barrier(0);
#pragma unroll
        for (int ai = 0; ai < 2; ++ai)
#pragma unroll
            for (int m = 0; m < 4; ++m) {
                const int r = ai * 128 + wr * 64 + m * 16 + fr, row = u.pm * 256 + r;
                const float rs = rsv[ai][m], cr = cwv[ai][m] * rs;
                float a[8];
#pragma unroll
                for (int i = 0; i < 4; ++i) {
                    const float g0 = acc[ai][0][m][0][i] * rs, g1 = acc[ai][0][m][1][i] * rs;
                    a[i] = g0 * __builtin_amdgcn_rcpf(1.0f + __expf(-g0)) * acc[ai][1][m][0][i] * cr; a[4 + i] = g1 * __builtin_amdgcn_rcpf(1.0f + __expf(-g1)) * acc[ai][1][m][1][i] * cr;
                }
                *(u32x4*)(YS + (size_t)row * 256 + f0) = (u32x4){pk2(a[0], a[1]), pk2(a[2], a[3]), pk2(a[4], a[5]), pk2(a[6], a[7])};
            }
    }
};
struct EpiDown {
    static constexpr bool PERM = true, AFTER_DRAIN = false;
    bf16_t* YO;
    DI void operator()(const pg8::f32x4 (&acc)[2][2][4][2], const pg8::Unit& u, int wr, int wc, int fr, int fq) const {
        const int c0 = (u.pn & 3) * 256 + wc * 32 + fq * 8;
#pragma unroll
        for (int ai = 0; ai < 2; ++ai)
#pragma unroll
            for (int m = 0; m < 4; ++m) {
                bf16_t* rowp = YO + (size_t)(u.pm * 256 + ai * 128 + wr * 64 + m * 16 + fr) * 1024 + c0;
#pragma unroll
                for (int bj = 0; bj < 2; ++bj) { const pg8::f32x4 v0 = acc[ai][bj][m][0], v1 = acc[ai][bj][m][1];
                    *(u32x4*)(rowp + bj * 128) = (u32x4){pk2(v0[0], v0[1]), pk2(v0[2], v0[3]), pk2(v1[0], v1[1]), pk2(v1[2], v1[3])}; }
            }
    }
};

DI void phase7(const Params& P, int gw, int NGW, int lane) {
    int cnt_, base_, tend_; expert_layout(P, lane, cnt_, base_, tend_);
    const bf16_t* YO = (const bf16_t*)(P.ws + WS_YO); const int* TOKP = (const int*)(P.ws + WS_TOKP); const int* TOKE = (const int*)(P.ws + WS_TOKE); const f32x4* nf = (const f32x4*)P.in[22];
    f32x4 nfv[4];
#pragma unroll
    for (int j = 0; j < 4; ++j) nfv[j] = nf[64 * j + lane];
    for (int t0 = gw; t0 < MTOK; t0 += 2 * NGW) {
        f32x4 v[2][4]; u32x2 hv[2][4], ya[2][4], yb[2][4];
#pragma unroll
        for (int r = 0; r < 2; ++r) { const int t = (t0 + r * NGW) < MTOK ? (t0 + r * NGW) : t0;
            const u32x2* hr = (const u32x2*)((const bf16_t*)(P.ws + WS_U2) + (size_t)t * 1024);
            const int e0 = __builtin_amdgcn_readfirstlane(TOKE[2 * t]), e1 = __builtin_amdgcn_readfirstlane(TOKE[2 * t + 1]);
            const int s0 = __builtin_amdgcn_readlane(base_, e0) + TOKP[2 * t], s1 = __builtin_amdgcn_readlane(base_, e1) + TOKP[2 * t + 1];
            const u32x2* y0 = (const u32x2*)(YO + (size_t)s0 * 1024); const u32x2* y1 = (const u32x2*)(YO + (size_t)s1 * 1024);
#pragma unroll
            for (int j = 0; j < 4; ++j) { hv[r][j] = hr[64 * j + lane]; ya[r][j] = y0[64 * j + lane]; yb[r][j] = y1[64 * j + lane]; } }
#pragma unroll
        for (int r = 0; r < 2; ++r) { const int t = t0 + r * NGW;
            if (t < MTOK) {
                float s = 0.f;
#pragma unroll
                for (int j = 0; j < 4; ++j) { const u32x2 a = ya[r][j], c = yb[r][j], hq = hv[r][j];
                    v[r][j] = (f32x4){__uint_as_float(hq.x << 16), __uint_as_float(hq.x & 0xffff0000u), __uint_as_float(hq.y << 16), __uint_as_float(hq.y & 0xffff0000u)};
                    v[r][j].x += __uint_as_float(a.x << 16) + __uint_as_float(c.x << 16); v[r][j].y += __uint_as_float(a.x & 0xffff0000u) + __uint_as_float(c.x & 0xffff0000u);
                    v[r][j].z += __uint_as_float(a.y << 16) + __uint_as_float(c.y << 16); v[r][j].w += __uint_as_float(a.y & 0xffff0000u) + __uint_as_float(c.y & 0xffff0000u);
                    s += (v[r][j].x * v[r][j].x + v[r][j].y * v[r][j].y) + (v[r][j].z * v[r][j].z + v[r][j].w * v[r][j].w); }
                s = wave_sum(s);
                const float rs = __builtin_amdgcn_rsqf(s * (1.0f / 1024.0f) + EPS);
                f32x4* hw = (f32x4*)(P.out + (size_t)t * 1024);
#pragma unroll
                for (int j = 0; j < 4; ++j) hw[64 * j + lane] = v[r][j] * rs * nfv[j];
            } }
    }
}

struct EpiNull { static constexpr bool PERM = true, AFTER_DRAIN = false; float* d;
    DI void operator()(const pg8::f32x4 (&acc)[2][2][4][2], const pg8::Unit& u, int wr, int wc, int fr, int fq) const {
        pg8::f32x4 s = acc[0][0][0][0];
#pragma unroll
        for (int ai = 0; ai < 2; ++ai)
#pragma unroll
            for (int bj = 0; bj < 2; ++bj)
#pragma unroll
                for (int m = 0; m < 4; ++m)
#pragma unroll
                    for (int n = 0; n < 2; ++n) s += acc[ai][bj][m][n];
        if (s[0] == 12345.678f) d[threadIdx.x] = s[1] + s[2] + s[3]; } };
#ifndef PHMASK
#define PHMASK 2047
#endif
#ifndef P1_STAGGER_TICKS
#define P1_STAGGER_TICKS 0
#endif
#ifndef ATT_VAR
#define ATT_VAR 0
#endif
#ifndef REPMASK
#define REPMASK 0
#endif
#define REP(bit) for (int rep_ = 0; rep_ < ((REPMASK & (bit)) ? 2 : 1); ++rep_)
#define REPSYNC(bit) if ((REPMASK & (bit)) && rep_ == 0) GRID_BAR()
typedef const __attribute__((address_space(4))) Params* KParams;
DI Params load_params(KParams kp) { Params p;
#pragma unroll
    for (int i = 0; i < 23; ++i) p.in[i] = kp->in[i];
    p.out = kp->out; p.ws = kp->ws; return p; }
__global__ void __launch_bounds__(NTHREADS, 2) hymba_fwd(Params Pin) {
    extern __shared__ __attribute__((aligned(16))) unsigned char lds_raw[];
    LAS unsigned char* lds = (LAS unsigned char*)lds_raw;
    cg::grid_group grid = cg::this_grid();
    volatile LAS unsigned* bst = (volatile LAS unsigned*)(lds + LDS_BYTES - 64);
    if (threadIdx.x < 2) bst[threadIdx.x] = 0u;
    __syncthreads();
    const XcdBarrier xbar = xcd_barrier_post((unsigned*)(Pin.ws + WS_CTL) + CW_BAR, bst);
#ifndef TPROBE
#define TPROBE (-1)
#endif
#ifndef TPROBE_A
#define TPROBE_A TPROBE
#define TPROBE_B (TPROBE + 1)
#endif
    int nstamp_ = 0;
#define STAMP() do { if (TPROBE >= 0) { if (blockIdx.x == 0 && threadIdx.x == 0) __hip_atomic_store((unsigned long long*)(Pin.ws + WS_CTL + 65536) + nstamp_, (unsigned long long)__builtin_amdgcn_s_memrealtime(), __ATOMIC_RELAXED, __HIP_MEMORY_SCOPE_AGENT); ++nstamp_; } } while (0)
#define GRID_BAR() do { xcd_barrier(xbar); STAMP(); } while (0)
    STAMP();
    const int G = gridDim.x, blk = blockIdx.x, NGW = G * NWAVES, NGT = G * NTHREADS;
#define PHASE_IDS() KParams kp_ = (KParams)__builtin_amdgcn_kernarg_segment_ptr(); asm volatile("" : "+s"(kp_)); const Params P = load_params(kp_); int tid = threadIdx.x; asm volatile("" : "+v"(tid)); const int lane = tid & 63, wave = __builtin_amdgcn_readfirstlane(tid >> 6), gw = blk * NWAVES + wave, gtid = blk * NTHREADS + tid; (void)lane; (void)gw; (void)gtid; (void)wave

    REP(1) { if (PHMASK & 1) { PHASE_IDS(); phase0(P, lds, gw, NGW, gtid, NGT, wave, lane); } REPSYNC(1); }
    GRID_BAR();
#ifdef P1_EV
#define P1_PASS(DM) { PHASE_IDS(); \
        pg8::Gemm g{(const bf16_t*)(P.ws + WS_XB), (const bf16_t*)(P.ws + WS_WINT), MROWS, NPROJ, 1024}; \
        pg8::StaticOrder S; S.init(MROWS, NPROJ, G, blk); \
        EpiInProjT<P1_EV> E{(const float*)(P.ws + WS_RS1), (const float*)(P.ws + WS_COS), (const float*)(P.ws + WS_SIN), P.in[10], P.in[11], \
                    (bf16_t*)(P.ws + WS_QB), (bf16_t*)(P.ws + WS_KT), (bf16_t*)(P.ws + WS_VT), (bf16_t*)(P.ws + WS_QKVB), (bf16_t*)(P.ws + WS_ZB), (float*)(P.ws + WS_GB), P.ws + 248 * MiB, DM, (unsigned long long*)(P.ws + WS_CTL + 65536) + 40}; \
        pg8::gemm_phase<EpiInProjT<P1_EV>, pg8::StaticOrder, true, true>(lds, g, S, E); } GRID_BAR();
    P1_PASS(0)
    P1_PASS(1)
#else
    REP(2) { if (PHMASK & 2) { PHASE_IDS();
        pg8::Gemm g{(const bf16_t*)(P.ws + WS_XB), (const bf16_t*)(P.ws + WS_WINT), MROWS, NPROJ, 1024};
        if (P1_STAGGER_TICKS > 0 && (blk & 1)) { const unsigned long long s0_ = __builtin_amdgcn_s_memrealtime(); while (__builtin_amdgcn_s_memrealtime() - s0_ < (unsigned long long)P1_STAGGER_TICKS) __builtin_amdgcn_s_sleep(8); }
        pg8::StaticOrder S; S.init(MROWS, NPROJ, G, blk);
#ifdef P1_EV
        EpiInProjT<P1_EV> E{(const float*)(P.ws + WS_RS1), (const float*)(P.ws + WS_COS), (const float*)(P.ws + WS_SIN), P.in[10], P.in[11],
                    (bf16_t*)(P.ws + WS_QB), (bf16_t*)(P.ws + WS_KT), (bf16_t*)(P.ws + WS_VT), (bf16_t*)(P.ws + WS_QKVB), (bf16_t*)(P.ws + WS_ZB), (float*)(P.ws + WS_GB), P.ws + 248 * MiB, rep_, (unsigned long long*)(P.ws + WS_CTL + 65536) + 40};
        pg8::gemm_phase<EpiInProjT<P1_EV>, pg8::StaticOrder, true, true>(lds, g, S, E);
#else
        EpiInProj E{(const float*)(P.ws + WS_RS1), (const float*)(P.ws + WS_COS), (const float*)(P.ws + WS_SIN), P.in[10], P.in[11],
                    (bf16_t*)(P.ws + WS_QB), (bf16_t*)(P.ws + WS_KT), (bf16_t*)(P.ws + WS_VT), (bf16_t*)(P.ws + WS_QKVB), (bf16_t*)(P.ws + WS_ZB), (float*)(P.ws + WS_GB), P.ws + 248 * MiB, 0, (unsigned long long*)(P.ws + WS_CTL + 65536) + 40};
        if (rep_ == 0) pg8::gemm_phase<EpiInProj, pg8::StaticOrder, true, true>(lds, g, S, E);
        else { EpiNull EN{(float*)(P.ws + WS_DUMP)}; pg8::gemm_phase<EpiNull, pg8::StaticOrder, true, true>(lds, g, S, EN); }
#endif
    } REPSYNC(2); }
    GRID_BAR();
#endif
    REP(4) { if (PHMASK & 4) { PHASE_IDS(); gdn_prep_phase(P, lds, blk, G, wave, lane); } REPSYNC(4); }
    {
        unsigned* prep = (unsigned*)(Pin.ws + WS_CTL) + CW_PREP;
        asm volatile("s_waitcnt vmcnt(0)" ::: "memory");
        __syncthreads();
        if (threadIdx.x == 0) { __builtin_amdgcn_fence(__ATOMIC_RELEASE, "agent"); asm volatile("s_waitcnt vmcnt(0)" ::: "memory");
            __hip_atomic_fetch_add(prep, 1u, __ATOMIC_RELAXED, __HIP_MEMORY_SCOPE_AGENT); }
        if (blk < 16) {
            if (threadIdx.x == 0) { unsigned sp = 0;
                while (__hip_atomic_load(prep, __ATOMIC_RELAXED, __HIP_MEMORY_SCOPE_AGENT) < (unsigned)G) { __builtin_amdgcn_s_sleep(2); if (++sp > (1u << 22)) break; }
                __builtin_amdgcn_fence(__ATOMIC_ACQUIRE, "agent"); asm volatile("s_waitcnt vmcnt(0)" ::: "memory"); }
            __syncthreads();
        }
    }
    REP(8) { if ((PHMASK & 8) && blk < 16) { PHASE_IDS(); gdn_scan(P, lds, blk, tid, wave, lane); } }
    REP(16) {
    if (PHMASK & 16) { PHASE_IDS(); if (rep_ == 0) attn_phase<0>(P, lds, tid, wave, lane); else attn_phase<ATT_VAR>(P, lds, tid, wave, lane); }
    if ((REPMASK & 16) && rep_ == 0) { GRID_BAR(); if (blk == 0 && threadIdx.x < 8) { PHASE_IDS(); __hip_atomic_store((unsigned*)(P.ws + WS_CTL) + CW_ATTQ + 64 * threadIdx.x, 0u, __ATOMIC_RELAXED, __HIP_MEMORY_SCOPE_AGENT); } GRID_BAR(); }
    }
    GRID_BAR();
    REP(32) { if (PHMASK & 32) { PHASE_IDS();
        pg8::Gemm g{(const bf16_t*)(P.ws + WS_MIX), (const bf16_t*)(P.ws + WS_WOUT), MTOK, 1024, 1024};
        pg8::StaticOrder S; S.init(MTOK, 1024, G, blk);
        EpiOutProj E{P.in[0], P.out, (bf16_t*)(P.ws + WS_U2)};
        pg8::gemm_phase<EpiOutProj, pg8::StaticOrder, true, true>(lds, g, S, E);
    } REPSYNC(32); }
    GRID_BAR();
#ifdef P4A_SPLIT
    if (PHMASK & 64) { PHASE_IDS(); phase4a<1>(P, lds, gw, NGW, wave, lane); }
    GRID_BAR();
    if (PHMASK & 64) { PHASE_IDS(); phase4a<2>(P, lds, gw, NGW, wave, lane); }
#else
    if (PHMASK & 64) { PHASE_IDS(); phase4a<3>(P, lds, gw, NGW, wave, lane); }
#endif
    GRID_BAR();
    int cnt, base, tend, total; { PHASE_IDS(); expert_layout(P, lane, cnt, base, tend); total = __builtin_amdgcn_readlane(tend, 31); }
    REP(256) { if (PHMASK & 256) { PHASE_IDS();
        pg8::Gemm g{(const bf16_t*)(P.ws + WS_U2), (const bf16_t*)(P.ws + WS_WGU), XS_ROWS, 32 * 512, 1024};
        GroupedOrder S{tend, total, G, XCD_ORDER(blk, G), 1, cnt, base, (const int*)(P.ws + WS_LIST)};
        EpiGateUp E{(const float*)(P.ws + WS_LISTW), (const float*)(P.ws + WS_LISTRS), (bf16_t*)(P.ws + WS_YS), cnt, base};
        pg8::gemm_phase_g<EpiGateUp, GroupedOrder, true, true>(lds, g, S, E);
    } REPSYNC(256); }
    GRID_BAR();
    REP(512) { if (PHMASK & 512) { PHASE_IDS();
        int kd = 256; asm volatile("" : "+s"(kd));
        pg8::Gemm g{(const bf16_t*)(P.ws + WS_YS), (const bf16_t*)(P.ws + WS_WD), XS_ROWS, 32 * 1024, kd};
        GroupedOrder S{tend, total, G, XCD_ORDER(blk, G), 2, cnt, base, (const int*)(P.ws + WS_LIST)};
        EpiDown E{(bf16_t*)(P.ws + WS_YO)};
        pg8::gemm_phase<EpiDown, GroupedOrder, true, true>(lds, g, S, E);
    } REPSYNC(512); }
    GRID_BAR();
    if (PHMASK & 1024) { PHASE_IDS(); phase7(P, gw, NGW, lane); }
    if (TPROBE >= 0) {
        GRID_BAR();
        const unsigned long long* st = (const unsigned long long*)(Pin.ws + WS_CTL + 65536);
        const unsigned long long t0 = __hip_atomic_load(st + TPROBE_A, __ATOMIC_RELAXED, __HIP_MEMORY_SCOPE_AGENT), t1 = __hip_atomic_load(st + TPROBE_B, __ATOMIC_RELAXED, __HIP_MEMORY_SCOPE_AGENT);
        const unsigned long long dt = (t1 - t0) * 4ull, s0 = __builtin_amdgcn_s_memrealtime();
        while (__builtin_amdgcn_s_memrealtime() - s0 < dt) __builtin_amdgcn_s_sleep(8);
    }
}

extern "C" void kernel_launch(void* const* d_in, const int* in_sizes, int n_in, void* d_out, int out_size, void* d_ws, size_t ws_size, hipStream_t stream) {
    static int grid_blocks = 0;
    if (grid_blocks == 0) {
        if (n_in != 23 || out_size != MTOK * DMODEL || ws_size < WS_END) { fprintf(stderr, "kernel_launch: unexpected shapes (n_in %d out %d ws %zu)\n", n_in, out_size, ws_size); grid_blocks = -1; return; }
        int dev = 0, cus = 0, per_cu = 0;
        hipGetDevice(&dev);
        hipDeviceGetAttribute(&cus, hipDeviceAttributeMultiprocessorCount, dev);
        hipFuncSetAttribute((const void*)hymba_fwd, hipFuncAttributeMaxDynamicSharedMemorySize, LDS_BYTES);
        hipOccupancyMaxActiveBlocksPerMultiprocessor(&per_cu, (const void*)hymba_fwd, NTHREADS, LDS_BYTES);
        if (per_cu < 1) { fprintf(stderr, "kernel_launch: occupancy query says %d blocks/CU\n", per_cu); per_cu = 1; }
        grid_blocks = cus;
        (void)hipGetLastError();
    }
    if (grid_blocks < 0) return;
    hipMemsetAsync((char*)d_ws + WS_CTL, 0, CTL_BYTES, stream);
    Params p{};
    for (int i = 0; i < 23; ++i) p.in[i] = (const float*)d_in[i];
    p.out = (float*)d_out; p.ws = (unsigned char*)d_ws;
    void* args[] = {&p};
    hipError_t e = hipLaunchCooperativeKernel((const void*)hymba_fwd, dim3(grid_blocks), dim3(NTHREADS), args, LDS_BYTES, stream);
    if (e != hipSuccess) fprintf(stderr, "cooperative launch failed: %s (grid %d)\n", hipGetErrorString(e), grid_blocks);
}
```

```cpp
#include <hip/hip_runtime.h>
#include <hip/hip_cooperative_groups.h>
#include <cstdio>
#include <cstdint>
namespace cg = cooperative_groups;
#ifndef PG8_EPI_AGAIN
#define PG8_EPI_AGAIN(x) do {} while (0)
#endif
namespace pg8 {
#define PG8_LAS __attribute__((address_space(3)))
typedef unsigned short bf16_t;
typedef short bf16x8 __attribute__((ext_vector_type(8)));
typedef float f32x4 __attribute__((ext_vector_type(4)));
typedef unsigned u32x4 __attribute__((ext_vector_type(4)));
constexpr int BM = 256, BK = 64, HALF = 128, HTB = HALF * BK * 2  , STAGE_BYTES = 8 * HTB, NXCD = 8, WGM = 8;

__host__ __device__ __forceinline__ int lds_byte(int r, int c) { const int st = (r >> 4) * 2 + (c >> 5), rr = r & 15, cc = c & 31, ob = rr * 64 + cc * 2; return st * 1024 + (ob ^ (((ob >> 9) & 1) << 5)); }
__host__ __device__ __forceinline__ void stage_rc(int b, int& R, int& C) { const int st = b / 1024, sb = b % 1024, swz = sb ^ (((sb >> 9) & 1) << 5); R = (st >> 1) * 16 + swz / 64; C = (st & 1) * 32 + (swz % 64) / 2; }
__host__ __device__ __forceinline__ int perm32(int rho) { const int n = rho >> 4, i = rho & 15; return 8 * (i >> 2) + 4 * n + (i & 3); }

template <class T, class = void> struct epi_timed { static constexpr bool v = false; };
template <class T> struct epi_timed<T, decltype((void)T::TIMED)> { static constexpr bool v = true; };
#ifndef PG8_TBLK
#define PG8_TBLK 0
#define PG8_TTID 0
#endif
struct Unit { int pm, pn; };
struct Gemm { const bf16_t* A; const bf16_t* Bt; int M, N, K; };

struct StaticOrder {
    int nM, nN, nwg, G, c;
    __host__ __device__ void init(int M, int N, int G_, int c_) { nM = M / BM; nN = N / BM; nwg = nM * nN; G = G_; c = c_; }
    __host__ __device__ bool next(int i, Unit& u) const {
        const long L = (long)i * G + c; if (L >= nwg) return false;
        int wgid = (int)L; { const int q = nwg / NXCD, r = nwg % NXCD, xcd = wgid % NXCD, off = wgid / NXCD; wgid = (xcd < r ? xcd * (q + 1) : r * (q + 1) + (xcd - r) * q) + off; }
        const int nig = WGM * nN, gid = wgid / nig, fm = gid * WGM, gsz = (nM - fm) < WGM ? (nM - fm) : WGM;
        u.pm = fm + ((wgid % nig) % gsz); u.pn = (wgid % nig) / gsz; return true;
    }
    __device__ __forceinline__ void a_ready(const Unit&) const {}
    __device__ __forceinline__ void done(const Unit&) const {}
};

__device__ __forceinline__ unsigned cvt_pk_bf16(float lo, float hi) { unsigned r; asm volatile("v_cvt_pk_bf16_f32 %0, %1, %2" : "=v"(r) : "v"(lo), "v"(hi)); return r; }
typedef float f32x2 __attribute__((ext_vector_type(2)));
template <class Epi, class Sched, bool ALIGN_EPI = false, bool SP2 = false>
__device__ __forceinline__ void gemm_phase(PG8_LAS unsigned char* lds, const Gemm g, const Sched& S, const Epi& E) {
    int tid_o = threadIdx.x; asm volatile("" : "+v"(tid_o));
    const int tid = tid_o, wid = __builtin_amdgcn_readfirstlane(tid >> 6), lane = tid & 63, wr = wid >> 2, wc = wid & 3, fr = lane & 15, fq = lane >> 4;
    const int K = g.K, nt = K / BK;
    unsigned voffA[2], voffB[2];
#pragma unroll
    for (int i = 0; i < 2; ++i) { int R, C; stage_rc(tid * 16 + i * 8192, R, C); const int Rb = Epi::PERM ? ((R & ~31) + perm32(R & 31)) : R;
        voffA[i] = (unsigned)(R * K + C) * 2u; voffB[i] = (unsigned)(Rb * K + C) * 2u; }
    const size_t kstep = (size_t)(BK * 2);
    const size_t hstep = (size_t)HALF * K * 2;
    const size_t tstep = 2 * hstep;
    const unsigned ldsw = (unsigned)wid * 1024u;
    const int aoff = lds_byte(wr * 64 + fr, fq * 8), boff = lds_byte(wc * 32 + fr, fq * 8);
#define PG8_SA(b, h) (((b) * 2 + (h)) * HTB)
#define PG8_SB(b, h) ((4 + (b) * 2 + (h)) * HTB)
#define PG8_STAGE(bufoff, gbase, voff) do { _Pragma("unroll") for (int _i = 0; _i < 2; ++_i) \
        __builtin_amdgcn_global_load_lds((const unsigned*)((const char*)(gbase) + (voff)[_i]), (PG8_LAS unsigned*)(lds + (bufoff) + ldsw + _i * 8192), 16, 0, 0); } while (0)
#define PG8_LDA(dst, b, h) do { _Pragma("unroll") for (int m = 0; m < 4; ++m) _Pragma("unroll") for (int k = 0; k < 2; ++k) dst[m][k] = *(const PG8_LAS bf16x8*)(lds + PG8_SA(b, h) + aoff + m * 2048 + k * 1024); } while (0)
#define PG8_LDB(dst, b, h) do { _Pragma("unroll") for (int n = 0; n < 2; ++n) _Pragma("unroll") for (int k = 0; k < 2; ++k) dst[n][k] = *(const PG8_LAS bf16x8*)(lds + PG8_SB(b, h) + boff + n * 2048 + k * 1024); } while (0)
#define PG8_MMA(ai, bj, At, Bt) do { __builtin_amdgcn_s_setprio(1); _Pragma("unroll") for (int m = 0; m < 4; ++m) _Pragma("unroll") for (int n = 0; n < 2; ++n) _Pragma("unroll") for (int k = 0; k < 2; ++k) \
        acc[ai][bj][m][n] = __builtin_amdgcn_mfma_f32_16x16x32_bf16(Bt[n][k], At[m][k], acc[ai][bj][m][n], 0, 0, 0); __builtin_amdgcn_s_setprio(0); } while (0)
#define PG8_WAIT_V(n) asm volatile("s_waitcnt vmcnt(" #n ")" ::: "memory")
#define PG8_WAIT_L(n) asm volatile("s_waitcnt lgkmcnt(" #n ")" ::: "memory")
#define PG8_BAR __builtin_amdgcn_s_barrier()
#define PG8_SCHED __builtin_amdgcn_sched_barrier(0)
    Unit cur, nxt; int ui = 0;
    if (!S.next(0, cur)) return;
    f32x4 acc[2][2][4][2];
#pragma unroll
    for (int a = 0; a < 2; ++a)
#pragma unroll
        for (int b = 0; b < 2; ++b)
#pragma unroll
            for (int m = 0; m < 4; ++m)
#pragma unroll
                for (int n = 0; n < 2; ++n) acc[a][b][m][n] = (f32x4){0.f, 0.f, 0.f, 0.f};
    bf16x8 At[4][2], B0[2][2], B1[2][2];
    const char* cA = (const char*)g.A + (size_t)cur.pm * tstep; const char* cB = (const char*)g.Bt + (size_t)cur.pn * tstep;
    S.a_ready(cur);
    if constexpr (SP2) {
        PG8_STAGE(PG8_SB(0, 0), cB, voffB); PG8_STAGE(PG8_SB(0, 1), cB + hstep, voffB); PG8_STAGE(PG8_SA(0, 0), cA, voffA); PG8_STAGE(PG8_SA(0, 1), cA + hstep, voffA);
        if (wr == 1) PG8_BAR;
        PG8_WAIT_V(2); PG8_BAR;
        PG8_STAGE(PG8_SB(1, 0), cB + kstep, voffB); PG8_STAGE(PG8_SA(1, 0), cA + kstep, voffA); PG8_STAGE(PG8_SB(1, 1), cB + hstep + kstep, voffB);
        PG8_WAIT_V(6); PG8_BAR;
    } else {
        PG8_STAGE(PG8_SB(0, 0), cB, voffB); PG8_STAGE(PG8_SA(0, 0), cA, voffA); PG8_STAGE(PG8_SB(0, 1), cB + hstep, voffB); PG8_STAGE(PG8_SA(0, 1), cA + hstep, voffA);
        if (wr == 1) PG8_BAR;
        PG8_WAIT_V(4); PG8_BAR;
        PG8_STAGE(PG8_SB(1, 0), cB + kstep, voffB); PG8_STAGE(PG8_SA(1, 0), cA + kstep, voffA); PG8_STAGE(PG8_SB(1, 1), cB + hstep + kstep, voffB);
        PG8_WAIT_V(6); PG8_BAR;
    }
#ifdef PG8_TSEL
    unsigned long long tsum_ = 0;
#endif
    for (;;) {
        const bool has_next = S.next(ui + 1, nxt);
        const char* nA = has_next ? (const char*)g.A + (size_t)nxt.pm * tstep : cA; const char* nB = has_next ? (const char*)g.Bt + (size_t)nxt.pn * tstep : cB;
        for (int t = 0; t < nt; t += 2) {
            const bool last = (t == nt - 2);
            const char* a1 = cA + (size_t)(t + 1) * kstep;
            const char* a2 = last ? nA : cA + (size_t)(t + 2) * kstep; const char* b2 = last ? nB : cB + (size_t)(t + 2) * kstep;
            const char* a3 = a2 + kstep; const char* b3 = b2 + kstep;
            if (last && has_next) S.a_ready(nxt);
            if constexpr (SP2) {
            PG8_LDB(B0, 0, 0); PG8_LDB(B1, 0, 1); PG8_SCHED; PG8_LDA(At, 0, 0); PG8_STAGE(PG8_SA(1, 1), a1 + hstep, voffA);
            PG8_WAIT_V(8); PG8_WAIT_L(0); PG8_BAR; PG8_MMA(0, 0, At, B0); PG8_MMA(0, 1, At, B1); PG8_BAR; PG8_SCHED;
            PG8_LDA(At, 0, 1); PG8_STAGE(PG8_SB(0, 0), b2, voffB); PG8_STAGE(PG8_SB(0, 1), b2 + hstep, voffB); PG8_STAGE(PG8_SA(0, 0), a2, voffA);
            PG8_WAIT_V(8); PG8_WAIT_L(0); PG8_BAR; PG8_MMA(1, 0, At, B0); PG8_MMA(1, 1, At, B1); PG8_BAR; PG8_SCHED;
            PG8_LDB(B0, 1, 0); PG8_LDB(B1, 1, 1); PG8_SCHED; PG8_LDA(At, 1, 0); PG8_STAGE(PG8_SA(0, 1), a2 + hstep, voffA);
            PG8_WAIT_V(8); PG8_WAIT_L(0); PG8_BAR; PG8_MMA(0, 0, At, B0); PG8_MMA(0, 1, At, B1); PG8_BAR; PG8_SCHED;
            PG8_LDA(At, 1, 1); PG8_STAGE(PG8_SB(1, 0), b3, voffB); PG8_STAGE(PG8_SB(1, 1), b3 + hstep, voffB); PG8_STAGE(PG8_SA(1, 0), a3, voffA);
            PG8_WAIT_V(8); PG8_WAIT_L(0); PG8_BAR; PG8_MMA(1, 0, At, B0); PG8_MMA(1, 1, At, B1); PG8_BAR; PG8_SCHED;
            } else {
            PG8_LDB(B0, 0, 0); PG8_SCHED; PG8_LDA(At, 0, 0); PG8_STAGE(PG8_SA(1, 1), a1 + hstep, voffA);
            PG8_WAIT_L(8); PG8_BAR; PG8_WAIT_L(0); PG8_MMA(0, 0, At, B0); PG8_BAR; PG8_SCHED;
            PG8_LDB(B1, 0, 1); PG8_STAGE(PG8_SB(0, 0), b2, voffB);
            PG8_BAR; PG8_WAIT_L(0); PG8_MMA(0, 1, At, B1); PG8_BAR;
            PG8_LDA(At, 0, 1); PG8_STAGE(PG8_SA(0, 0), a2, voffA);
            PG8_BAR; PG8_WAIT_L(0); PG8_MMA(1, 0, At, B0); PG8_BAR; PG8_SCHED;
            PG8_STAGE(PG8_SB(0, 1), b2 + hstep, voffB);
            PG8_WAIT_V(6); PG8_BAR; PG8_MMA(1, 1, At, B1); PG8_BAR;
            PG8_LDB(B0, 1, 0); PG8_SCHED; PG8_LDA(At, 1, 0); PG8_STAGE(PG8_SA(0, 1), a2 + hstep, voffA);
            PG8_WAIT_L(8); PG8_BAR; PG8_WAIT_L(0); PG8_MMA(0, 0, At, B0); PG8_BAR; PG8_SCHED;
            PG8_LDB(B1, 1, 1); PG8_STAGE(PG8_SB(1, 0), b3, voffB);
            PG8_BAR; PG8_WAIT_L(0); PG8_MMA(0, 1, At, B1); PG8_BAR;
            PG8_LDA(At, 1, 1); PG8_STAGE(PG8_SA(1, 0), a3, voffA);
            PG8_BAR; PG8_WAIT_L(0); PG8_MMA(1, 0, At, B0); PG8_BAR; PG8_SCHED;
            PG8_STAGE(PG8_SB(1, 1), b3 + hstep, voffB);
            PG8_WAIT_V(6); PG8_BAR; PG8_MMA(1, 1, At, B1); PG8_BAR;
            }
        }
#ifdef PG8_TSEL
        unsigned long long tA_ = 0, tb2_ = 0;
        if constexpr (epi_timed<Epi>::v) tA_ = __builtin_amdgcn_s_memrealtime();
#endif
        if constexpr (ALIGN_EPI) { if (wr == 0) PG8_BAR; }
#ifdef PG8_TSEL
        if constexpr (epi_timed<Epi>::v) tb2_ = __builtin_amdgcn_s_memrealtime();
#endif
#ifdef PG8_TSEL
        unsigned long long tb_ = 0;
        if constexpr (epi_timed<Epi>::v) { if (PG8_TSEL == 2) tb_ = tA_; else tb_ = __builtin_amdgcn_s_memrealtime(); }
#endif
        if constexpr (!Epi::AFTER_DRAIN) { E(acc, cur, wr, wc, fr, fq); PG8_EPI_AGAIN(E(acc, cur, wr, wc, fr, fq)); S.done(cur); }
#ifdef PG8_TSEL
        if constexpr (epi_timed<Epi>::v) { if (PG8_TSEL == 1) asm volatile("s_waitcnt vmcnt(0)" ::: "memory");
            if (PG8_TSEL == 2) tsum_ += tb2_ - tb_; else tsum_ += __builtin_amdgcn_s_memrealtime() - tb_; }
#endif
        if (!has_next) break;
#pragma unroll
        for (int a = 0; a < 2; ++a)
#pragma unroll
            for (int b = 0; b < 2; ++b)
#pragma unroll
                for (int m = 0; m < 4; ++m)
#pragma unroll
                    for (int n = 0; n < 2; ++n) acc[a][b][m][n] = (f32x4){0.f, 0.f, 0.f, 0.f};
        cur = nxt; cA = nA; cB = nB; ++ui;
        if constexpr (ALIGN_EPI) { if (wr == 1) PG8_BAR; }
    }
    PG8_WAIT_V(0);
    if constexpr (!ALIGN_EPI) { if (wr == 0) PG8_BAR; }
    PG8_BAR;
    if constexpr (Epi::AFTER_DRAIN) { E.fused(acc, cur, wr, wc, fr, fq, lds, wid, lane); S.done(cur); }
#ifdef PG8_TSEL
    if constexpr (epi_timed<Epi>::v) { if (blockIdx.x == PG8_TBLK && tid == PG8_TTID) __hip_atomic_store(E.tslot, tsum_, __ATOMIC_RELAXED, __HIP_MEMORY_SCOPE_AGENT); }
#endif
#undef PG8_SA
#undef PG8_SB
#undef PG8_STAGE
#undef PG8_LDA
#undef PG8_LDB
#undef PG8_MMA
#undef PG8_WAIT_V
#undef PG8_WAIT_L
#undef PG8_BAR
#undef PG8_SCHED
}
static_assert(true, "gather variant of gemm_phase (SP2 = true only): identical schedule, the A operand's rows are gathered through Sched::rowoff");
template <class Epi, class Sched, bool ALIGN_EPI = false, bool SP2 = false>
__device__ __forceinline__ void gemm_phase_g(PG8_LAS unsigned char* lds, const Gemm g, const Sched& S, const Epi& E) {
    int tid_o = threadIdx.x; asm volatile("" : "+v"(tid_o));
    const int tid = tid_o, wid = __builtin_amdgcn_readfirstlane(tid >> 6), lane = tid & 63, wr = wid >> 2, wc = wid & 3, fr = lane & 15, fq = lane >> 4;
    const int K = g.K, nt = K / BK;
    unsigned voffA[2], voffB[2]; int RA_[2]; unsigned CA_[2];
#pragma unroll
    for (int i = 0; i < 2; ++i) { int R, C; stage_rc(tid * 16 + i * 8192, R, C); const int Rb = Epi::PERM ? ((R & ~31) + perm32(R & 31)) : R;
        voffA[i] = (unsigned)(R * K + C) * 2u; voffB[i] = (unsigned)(Rb * K + C) * 2u; RA_[i] = R; CA_[i] = (unsigned)C * 2u; }
    const size_t kstep = (size_t)(BK * 2);
    const size_t hstep = (size_t)HALF * K * 2;
    const size_t tstep = 2 * hstep;
    const unsigned ldsw = (unsigned)wid * 1024u;
    const int aoff = lds_byte(wr * 64 + fr, fq * 8), boff = lds_byte(wc * 32 + fr, fq * 8);
#define PG8_SA(b, h) (((b) * 2 + (h)) * HTB)
#define PG8_SB(b, h) ((4 + (b) * 2 + (h)) * HTB)
#define PG8_STAGE(bufoff, gbase, voff) do { _Pragma("unroll") for (int _i = 0; _i < 2; ++_i) \
        __builtin_amdgcn_global_load_lds((const unsigned*)((const char*)(gbase) + (voff)[_i]), (PG8_LAS unsigned*)(lds + (bufoff) + ldsw + _i * 8192), 16, 0, 0); } while (0)
#define PG8_LDA(dst, b, h) do { _Pragma("unroll") for (int m = 0; m < 4; ++m) _Pragma("unroll") for (int k = 0; k < 2; ++k) dst[m][k] = *(const PG8_LAS bf16x8*)(lds + PG8_SA(b, h) + aoff + m * 2048 + k * 1024); } while (0)
#define PG8_LDB(dst, b, h) do { _Pragma("unroll") for (int n = 0; n < 2; ++n) _Pragma("unroll") for (int k = 0; k < 2; ++k) dst[n][k] = *(const PG8_LAS bf16x8*)(lds + PG8_SB(b, h) + boff + n * 2048 + k * 1024); } while (0)
#define PG8_MMA(ai, bj, At, Bt) do { __builtin_amdgcn_s_setprio(1); _Pragma("unroll") for (int m = 0; m < 4; ++m) _Pragma("unroll") for (int n = 0; n < 2; ++n) _Pragma("unroll") for (int k = 0; k < 2; ++k) \
        acc[ai][bj][m][n] = __builtin_amdgcn_mfma_f32_16x16x32_bf16(Bt[n][k], At[m][k], acc[ai][bj][m][n], 0, 0, 0); __builtin_amdgcn_s_setprio(0); } while (0)
#define PG8_WAIT_V(n) asm volatile("s_waitcnt vmcnt(" #n ")" ::: "memory")
#define PG8_WAIT_L(n) asm volatile("s_waitcnt lgkmcnt(" #n ")" ::: "memory")
#define PG8_BAR __builtin_amdgcn_s_barrier()
#define PG8_SCHED __builtin_amdgcn_sched_barrier(0)
    Unit cur, nxt; int ui = 0;
    if (!S.next(0, cur)) return;
    f32x4 acc[2][2][4][2];
#pragma unroll
    for (int a = 0; a < 2; ++a)
#pragma unroll
        for (int b = 0; b < 2; ++b)
#pragma unroll
            for (int m = 0; m < 4; ++m)
#pragma unroll
                for (int n = 0; n < 2; ++n) acc[a][b][m][n] = (f32x4){0.f, 0.f, 0.f, 0.f};
    bf16x8 At[4][2], B0[2][2], B1[2][2];
    const char* cA = (const char*)g.A; const char* cB = (const char*)g.Bt + (size_t)cur.pn * tstep;
    unsigned cA0[2], cA1[2], nA0[2], nA1[2];
#pragma unroll
    for (int i = 0; i < 2; ++i) { cA0[i] = S.rowoff(cur, RA_[i]) + CA_[i]; cA1[i] = S.rowoff(cur, 128 + RA_[i]) + CA_[i]; }
    S.a_ready(cur);
    if constexpr (SP2) {
        PG8_STAGE(PG8_SB(0, 0), cB, voffB); PG8_STAGE(PG8_SB(0, 1), cB + hstep, voffB); PG8_STAGE(PG8_SA(0, 0), cA, cA0); PG8_STAGE(PG8_SA(0, 1), cA, cA1);
        if (wr == 1) PG8_BAR;
        PG8_WAIT_V(2); PG8_BAR;
        PG8_STAGE(PG8_SB(1, 0), cB + kstep, voffB); PG8_STAGE(PG8_SA(1, 0), cA + kstep, cA0); PG8_STAGE(PG8_SB(1, 1), cB + hstep + kstep, voffB);
        PG8_WAIT_V(6); PG8_BAR;
    } else {
        PG8_STAGE(PG8_SB(0, 0), cB, voffB); PG8_STAGE(PG8_SA(0, 0), cA, voffA); PG8_STAGE(PG8_SB(0, 1), cB + hstep, voffB); PG8_STAGE(PG8_SA(0, 1), cA + hstep, voffA);
        if (wr == 1) PG8_BAR;
        PG8_WAIT_V(4); PG8_BAR;
        PG8_STAGE(PG8_SB(1, 0), cB + kstep, voffB); PG8_STAGE(PG8_SA(1, 0), cA + kstep, voffA); PG8_STAGE(PG8_SB(1, 1), cB + hstep + kstep, voffB);
        PG8_WAIT_V(6); PG8_BAR;
    }
    for (;;) {
        const bool has_next = S.next(ui + 1, nxt);
        const char* nA = cA; const char* nB = has_next ? (const char*)g.Bt + (size_t)nxt.pn * tstep : cB;
#pragma unroll
        for (int i = 0; i < 2; ++i) { nA0[i] = has_next ? S.rowoff(nxt, RA_[i]) + CA_[i] : cA0[i]; nA1[i] = has_next ? S.rowoff(nxt, 128 + RA_[i]) + CA_[i] : cA1[i]; }
        for (int t = 0; t < nt; t += 2) {
            const bool last = (t == nt - 2);
            const char* a1 = cA + (size_t)(t + 1) * kstep;
            const char* a2 = last ? nA : cA + (size_t)(t + 2) * kstep; const char* b2 = last ? nB : cB + (size_t)(t + 2) * kstep;
            const char* a3 = a2 + kstep; const char* b3 = b2 + kstep;
            unsigned sA0[2], sA1[2];
#pragma unroll
            for (int i = 0; i < 2; ++i) { sA0[i] = last ? nA0[i] : cA0[i]; sA1[i] = last ? nA1[i] : cA1[i]; }
            if (last && has_next) S.a_ready(nxt);
            if constexpr (SP2) {
            PG8_LDB(B0, 0, 0); PG8_LDB(B1, 0, 1); PG8_SCHED; PG8_LDA(At, 0, 0); PG8_STAGE(PG8_SA(1, 1), a1, cA1);
            PG8_WAIT_V(8); PG8_WAIT_L(0); PG8_BAR; PG8_MMA(0, 0, At, B0); PG8_MMA(0, 1, At, B1); PG8_BAR; PG8_SCHED;
            PG8_LDA(At, 0, 1); PG8_STAGE(PG8_SB(0, 0), b2, voffB); PG8_STAGE(PG8_SB(0, 1), b2 + hstep, voffB); PG8_STAGE(PG8_SA(0, 0), a2, sA0);
            PG8_WAIT_V(8); PG8_WAIT_L(0); PG8_BAR; PG8_MMA(1, 0, At, B0); PG8_MMA(1, 1, At, B1); PG8_BAR; PG8_SCHED;
            PG8_LDB(B0, 1, 0); PG8_LDB(B1, 1, 1); PG8_SCHED; PG8_LDA(At, 1, 0); PG8_STAGE(PG8_SA(0, 1), a2, sA1);
            PG8_WAIT_V(8); PG8_WAIT_L(0); PG8_BAR; PG8_MMA(0, 0, At, B0); PG8_MMA(0, 1, At, B1); PG8_BAR; PG8_SCHED;
            PG8_LDA(At, 1, 1); PG8_STAGE(PG8_SB(1, 0), b3, voffB); PG8_STAGE(PG8_SB(1, 1), b3 + hstep, voffB); PG8_STAGE(PG8_SA(1, 0), a3, sA0);
            PG8_WAIT_V(8); PG8_WAIT_L(0); PG8_BAR; PG8_MMA(1, 0, At, B0); PG8_MMA(1, 1, At, B1); PG8_BAR; PG8_SCHED;
            } else {
            PG8_LDB(B0, 0, 0); PG8_SCHED; PG8_LDA(At, 0, 0); PG8_STAGE(PG8_SA(1, 1), a1 + hstep, voffA);
            PG8_WAIT_L(8); PG8_BAR; PG8_WAIT_L(0); PG8_MMA(0, 0, At, B0); PG8_BAR; PG8_SCHED;
            PG8_LDB(B1, 0, 1); PG8_STAGE(PG8_SB(0, 0), b2, voffB);
            PG8_BAR; PG8_WAIT_L(0); PG8_MMA(0, 1, At, B1); PG8_BAR;
            PG8_LDA(At, 0, 1); PG8_STAGE(PG8_SA(0, 0), a2, voffA);
            PG8_BAR; PG8_WAIT_L(0); PG8_MMA(1, 0, At, B0); PG8_BAR; PG8_SCHED;
            PG8_STAGE(PG8_SB(0, 1), b2 + hstep, voffB);
            PG8_WAIT_V(6); PG8_BAR; PG8_MMA(1, 1, At, B1); PG8_BAR;
            PG8_LDB(B0, 1, 0); PG8_SCHED; PG8_LDA(At, 1, 0); PG8_STAGE(PG8_SA(0, 1), a2 + hstep, voffA);
            PG8_WAIT_L(8); PG8_BAR; PG8_WAIT_L(0); PG8_MMA(0, 0, At, B0); PG8_BAR; PG8_SCHED;
            PG8_LDB(B1, 1, 1); PG8_STAGE(PG8_SB(1, 0), b3, voffB);
            PG8_BAR; PG8_WAIT_L(0); PG8_MMA(0, 1, At, B1); PG8_BAR;
            PG8_LDA(At, 1, 1); PG8_STAGE(PG8_SA(1, 0), a3, voffA);
            PG8_BAR; PG8_WAIT_L(0); PG8_MMA(1, 0, At, B0); PG8_BAR; PG8_SCHED;
            PG8_STAGE(PG8_SB(1, 1), b3 + hstep, voffB);
            PG8_WAIT_V(6); PG8_BAR; PG8_MMA(1, 1, At, B1); PG8_BAR;
            }
        }
        if constexpr (ALIGN_EPI) { if (wr == 0) PG8_BAR; }
        if constexpr (!Epi::AFTER_DRAIN) { E(acc, cur, wr, wc, fr, fq); PG8_EPI_AGAIN(E(acc, cur, wr, wc, fr, fq)); S.done(cur); }
        if (!has_next) break;
#pragma unroll
        for (int a = 0; a < 2; ++a)
#pragma unroll
            for (int b = 0; b < 2; ++b)
#pragma unroll
                for (int m = 0; m < 4; ++m)
#pragma unroll
                    for (int n = 0; n < 2; ++n) acc[a][b][m][n] = (f32x4){0.f, 0.f, 0.f, 0.f};
        cur = nxt; cA = nA; cB = nB; ++ui;
#pragma unroll
        for (int i = 0; i < 2; ++i) { cA0[i] = nA0[i]; cA1[i] = nA1[i]; }
        if constexpr (ALIGN_EPI) { if (wr == 1) PG8_BAR; }
    }
    PG8_WAIT_V(0);
    if constexpr (!ALIGN_EPI) { if (wr == 0) PG8_BAR; }
    PG8_BAR;
    if constexpr (Epi::AFTER_DRAIN) { E.fused(acc, cur, wr, wc, fr, fq, lds, wid, lane); S.done(cur); }
#undef PG8_SA
#undef PG8_SB
#undef PG8_STAGE
#undef PG8_LDA
#undef PG8_LDB
#undef PG8_MMA
#undef PG8_WAIT_V
#undef PG8_WAIT_L
#undef PG8_BAR
#undef PG8_SCHED
}
}

#define DI __device__ __forceinline__
#define LAS __attribute__((address_space(3)))
typedef unsigned short bf16_t;
typedef short bf16x8 __attribute__((ext_vector_type(8)));
typedef short s16x4 __attribute__((ext_vector_type(4)));
typedef short v4i16_t __attribute__((ext_vector_type(4)));
typedef float f32x4 __attribute__((ext_vector_type(4)));
typedef float f32x16 __attribute__((ext_vector_type(16)));
typedef unsigned u32x4 __attribute__((ext_vector_type(4)));
typedef unsigned u32x2 __attribute__((ext_vector_type(2)));
typedef float f32x2_t __attribute__((ext_vector_type(2)));
typedef __bf16 bf16x2_t __attribute__((ext_vector_type(2)));

constexpr int NWAVES = 8, NTHREADS = 512;
constexpr int SEQ = 8192, DMODEL = 1024, NMETA = 16, LTOK = SEQ + NMETA  , LP = 8256  , NCHUNK = 129;
constexpr int MTOK = 2 * SEQ;
constexpr int MROWS = 16640;
constexpr int NPROJ = 3840;
constexpr int NKT = 129;
constexpr float EPS = 1e-6f;
constexpr float C2Q = 0.125f * 1.4426950408889634f;
constexpr int XS_ROWS = 41216;

constexpr size_t MiB = 1u << 20;
constexpr size_t WS_CTL = 0, CTL_BYTES = 1 * MiB;
constexpr size_t WS_RS1 = 1 * MiB;
constexpr size_t WS_RS2 = WS_RS1 + 128 * 1024;
constexpr size_t WS_TOKE = WS_RS2 + 128 * 1024;
constexpr size_t WS_TOKW = WS_TOKE + 128 * 1024;
constexpr size_t WS_TOKP = WS_TOKW + 128 * 1024;
constexpr size_t WS_SLOTW = WS_TOKP + 128 * 1024;
constexpr size_t WS_WR = WS_SLOTW + 192 * 1024;
constexpr size_t WS_GL = WS_WR + 160 * 1024;
constexpr size_t WS_DUMP = 2 * MiB;
constexpr size_t WS_COS = 2 * MiB;
constexpr size_t WS_SIN = WS_COS + 1280 * 1024;
constexpr size_t WS_GB = WS_SIN + 1280 * 1024;
constexpr size_t WS_WOUT = 6 * MiB;
constexpr size_t WS_WINT = 8 * MiB;
constexpr size_t WS_XB = WS_WINT + (size_t)NPROJ * 1024 * 2;
constexpr size_t WS_MIX = 8 * MiB;
constexpr size_t WS_QKVB = 48 * MiB;
constexpr size_t WS_QB = WS_QKVB + (size_t)2 * LP * 1536 * 2 + 128 * 1024;
constexpr size_t WS_KT = WS_QB + 16 * MiB;
constexpr size_t WS_VT = WS_KT + (size_t)16 * NKT * 4096 * 2;
constexpr size_t WS_ZB = WS_VT + (size_t)8 * NKT * 8192 * 2;
constexpr size_t WS_GP = WS_ZB + (size_t)2 * LP * 512 * 2;
constexpr size_t GP_ARR = (size_t)2064 * 4096 * 2;
constexpr size_t WS_GP_END = WS_GP + 5 * GP_ARR;
constexpr size_t WS_WGU = 48 * MiB;
constexpr size_t WS_WD = 80 * MiB;
constexpr size_t WS_U2 = 96 * MiB;
constexpr size_t WS_LIST = 240 * MiB;
constexpr size_t WS_LISTW = 242 * MiB;
constexpr size_t WS_LISTRS = 244 * MiB;
constexpr size_t WS_XS = 96 * MiB;
constexpr size_t WS_YO = 128 * MiB;
constexpr size_t WS_YS = 8 * MiB;
constexpr size_t WS_END = 256 * MiB;
static_assert(WS_GB + (size_t)2 * LP * 16 * 4 <= WS_WOUT, "small region");
static_assert(WS_XB + (size_t)MROWS * 1024 * 2 <= WS_QKVB, "XB");
static_assert(WS_GP_END <= WS_END, "GDN prep arrays");
static_assert(WS_YS + (size_t)XS_ROWS * 256 * 2 <= WS_END, "YS");
static_assert(WS_WD + (size_t)32 * 1024 * 256 * 2 <= WS_XS, "WD");
constexpr int CW_ATTQ = 2112;
constexpr int CW_PREP = 2688;
constexpr int CW_CNT = 64;
constexpr int CW_TILE = 8192;
constexpr int CW_BAR = 4096;

constexpr int LDS_BYTES = 147456;

struct Params { const float* in[23]; float* out; unsigned char* ws; };

DI unsigned f2bf(float f) { unsigned u = __float_as_uint(f); return (u + 0x7fffu + ((u >> 16) & 1u)) >> 16; }
DI unsigned pk2(float lo, float hi) { f32x2_t v = {lo, hi}; bf16x2_t b = __builtin_convertvector(v, bf16x2_t); return __builtin_bit_cast(unsigned, b); }
DI float bf2f(unsigned short h) { return __uint_as_float(((unsigned)h) << 16); }
DI float rlane(float v, int l) { return __int_as_float(__builtin_amdgcn_readlane(__float_as_int(v), l)); }
#define DPP_ADD(v, ctrl) ((v) + __int_as_float(__builtin_amdgcn_update_dpp(0, __float_as_int(v), (ctrl), 0xF, 0xF, true)))
DI u32x2 pack_quad_bf16(float v) {
    const float v1 = __int_as_float(__builtin_amdgcn_update_dpp(0, __float_as_int(v), 0xB1, 0xF, 0xF, true));
    const unsigned p = pk2(v, v1);
    const unsigned q = (unsigned)__builtin_amdgcn_update_dpp(0, (int)p, 0x4E, 0xF, 0xF, true);
    return (u32x2){p, q};
}
typedef __attribute__((address_space(1))) u32x2 g_u32x2;
DI void store_quad_bf16(bf16_t* dst  , float v, int lane) {
    const float v1 = __int_as_float(__builtin_amdgcn_update_dpp(0, __float_as_int(v), 0xB1, 0xF, 0xF, true));
    const unsigned p = pk2(v, v1);
    const unsigned q = (unsigned)__builtin_amdgcn_update_dpp(0, (int)p, 0x4E, 0xF, 0xF, true);
    if ((lane & 3) == 0) *(u32x2*)dst = (u32x2){p, q};
}
DI float wave_sum_dpp(float v) {
    v = DPP_ADD(v, 0xB1);
    v = DPP_ADD(v, 0x4E);
    v = DPP_ADD(v, 0x141);
    v = DPP_ADD(v, 0x140);
    return (rlane(v, 0) + rlane(v, 16)) + (rlane(v, 32) + rlane(v, 48));
}
DI float wave_sum(float v) { return wave_sum_dpp(v); }
DI float swz_xor16(float v) { return __int_as_float(__builtin_amdgcn_ds_swizzle(__float_as_int(v), 0x401F)); }
DI float row_sum16(float v) { v = DPP_ADD(v, 0xB1); v = DPP_ADD(v, 0x4E); v = DPP_ADD(v, 0x141); v = DPP_ADD(v, 0x140); return v; }
DI float half_sum32(float v) { v = row_sum16(v); return v + swz_xor16(v); }
DI float swap32_add(float v) { auto rr = __builtin_amdgcn_permlane32_swap(__float_as_uint(v), __float_as_uint(v), false, false); return __uint_as_float(rr[0]) + __uint_as_float(rr[1]); }
DI float swap32_max(float v) { auto rr = __builtin_amdgcn_permlane32_swap(__float_as_uint(v), __float_as_uint(v), false, false); return fmaxf(__uint_as_float(rr[0]), __uint_as_float(rr[1])); }
#define LDS_WAIT() asm volatile("s_waitcnt lgkmcnt(0)" ::: "memory")
#define BAR_LDS() do { asm volatile("s_waitcnt lgkmcnt(0)" ::: "memory"); __builtin_amdgcn_s_barrier(); asm volatile("" ::: "memory"); } while (0)
#define MFMA32(a, b, c) __builtin_amdgcn_mfma_f32_32x32x16_bf16((a), (b), (c), 0, 0, 0)
DI int crow(int r, int hi) { return (r & 3) + 8 * (r >> 2) + 4 * hi; }
DI int perm16(int x) { return (x & ~12) | ((x & 4) << 1) | ((x & 8) >> 1); }
DI bf16x8 pack8(const f32x16& x, int s) {
    u32x4 p; p.x = pk2(x[8 * s], x[8 * s + 1]); p.y = pk2(x[8 * s + 2], x[8 * s + 3]); p.z = pk2(x[8 * s + 4], x[8 * s + 5]); p.w = pk2(x[8 * s + 6], x[8 * s + 7]);
    return __builtin_bit_cast(bf16x8, p);
}
DI int orig_col(int n) {
    if (n >= 1024) return n;
    const int hh = n >> 6, c2 = n & 63, g8 = c2 >> 3, i = c2 & 7;
    return (hh << 6) + ((i < 4) ? 4 * g8 + i : 32 + 4 * g8 + (i - 4));
}
DI size_t kt_off(int b, int hh, int p, int d) {
    const int tile = p < 16 ? 0 : 1 + ((p - 16) >> 6), kv = p < 16 ? p : ((p - 16) & 63);
    return ((size_t)((b * 8 + hh) * NKT + tile) << 12) + ((d >> 3) << 9) + (kv << 3) + (d & 7);
}
DI size_t vt_off(int b, int h, int p, int d) {
    const int tile = p < 16 ? 0 : 1 + ((p - 16) >> 6), kv = p < 16 ? p : ((p - 16) & 63);
    return ((size_t)((b * 4 + h) * NKT + tile) << 13) + ((d >> 5) << 11) + ((kv >> 4) << 9) + ((kv & 15) << 5) + (d & 31);
}

template <class Src> DI void transpose_item(const Src& src, bf16_t* WT, size_t ldk, int k0, int n0, LAS float* scr, int lane) {
    float v[32];
    const int c = lane & 7;
    f32x4 g0, g1; src.gain(k0 + 8 * c, g0, g1);
#pragma unroll
    for (int i = 0; i < 32; ++i) v[i] = src(k0 + 2 * i + (lane >> 5), n0 + (lane & 31));
#pragma unroll
    for (int i = 0; i < 32; ++i) scr[(2 * i + (lane >> 5)) * 33 + (lane & 31)] = v[i];
    LDS_WAIT();
#pragma unroll
    for (int j = 0; j < 4; ++j) { const int n = (lane >> 3) + 8 * j; const LAS float* s = scr + (8 * c) * 33 + n;
        u32x4 o; o.x = pk2(s[0 * 33] * g0[0], s[1 * 33] * g0[1]); o.y = pk2(s[2 * 33] * g0[2], s[3 * 33] * g0[3]); o.z = pk2(s[4 * 33] * g1[0], s[5 * 33] * g1[1]); o.w = pk2(s[6 * 33] * g1[2], s[7 * 33] * g1[3]);
        *(u32x4*)(WT + (size_t)(n0 + n) * ldk + k0 + 8 * c) = o; }
    LDS_WAIT();
}
struct SrcWin { const float* w; const float* g; DI float operator()(int k, int n) const { return n >= 3600 ? 0.f : w[(size_t)k * 3600 + orig_col(n)]; }
    DI void gain(int k, f32x4& a, f32x4& b) const { a = *(const f32x4*)(g + k); b = *(const f32x4*)(g + k + 4); } };
struct SrcPlain { const float* w; int N; DI float operator()(int k, int n) const { return w[(size_t)k * N + n]; }
    DI void gain(int, f32x4& a, f32x4& b) const { a = (f32x4){1.f, 1.f, 1.f, 1.f}; b = a; } };
struct SrcGU { const float* w; const float* g; int fadj; DI float operator()(int k, int n) const { return w[(size_t)k * 256 + n + fadj] * g[k]; } };

#ifndef P0_REP
#define P0_REP 0
#endif
DI void phase0(const Params& P, LAS unsigned char* lds, int gw, int NGW, int gtid, int NGT, int wave, int lane) {
    LAS float* scr = (LAS float*)(lds + wave * 16384);
    bf16_t* WINT = (bf16_t*)(P.ws + WS_WINT); bf16_t* WOUT = (bf16_t*)(P.ws + WS_WOUT); bf16_t* XB = (bf16_t*)(P.ws + WS_XB);
    float* RS1 = (float*)(P.ws + WS_RS1);
    constexpr int I_IN = 16 * (NPROJ / 32), I_OUT = 16 * 32;
    const SrcWin sw{P.in[3], P.in[2]}; const SrcPlain so{P.in[13], 1024};
    for (int rp_ = 0; rp_ < ((P0_REP & 1) ? 2 : 1); ++rp_)
    for (int it = gw; it < I_IN + I_OUT; it += NGW) {
        if (it < I_IN) transpose_item(sw, WINT, 1024, (it / (NPROJ / 32)) * 64, (it % (NPROJ / 32)) * 32, scr, lane);
        else { const int r = it - I_IN; transpose_item(so, WOUT, 1024, (r >> 5) * 64, (r & 31) * 32, scr, lane); }
    }
    const float* x = P.in[0]; const float* meta = P.in[1];
    for (int rp_ = 0; rp_ < ((P0_REP & 2) ? 2 : 1); ++rp_)
    for (int m0 = gw; m0 < MROWS; m0 += 4 * NGW) {
        f32x4 v[4][4];
#pragma unroll
        for (int r = 0; r < 4; ++r) { const int m = m0 + r * NGW;
            const bool real = m < MTOK + NMETA;
            const f32x4* xr = (const f32x4*)((m < MTOK) ? x + (size_t)m * 1024 : meta + (size_t)((real ? m : MTOK) - MTOK) * 1024);
#pragma unroll
            for (int j = 0; j < 4; ++j) v[r][j] = (m < MROWS) ? xr[64 * j + lane] : (f32x4){0.f, 0.f, 0.f, 0.f}; }
#pragma unroll
        for (int r = 0; r < 4; ++r) { const int m = m0 + r * NGW;
            if (m < MROWS) {
                const bool real = m < MTOK + NMETA;
                float s = 0.f;
#pragma unroll
                for (int j = 0; j < 4; ++j) { if (!real) v[r][j] = (f32x4){0.f, 0.f, 0.f, 0.f}; s += (v[r][j].x * v[r][j].x + v[r][j].y * v[r][j].y) + (v[r][j].z * v[r][j].z + v[r][j].w * v[r][j].w); }
                s = wave_sum(s);
                if (lane == 0) RS1[m] = real ? __builtin_amdgcn_rsqf(s * (1.0f / 1024.0f) + EPS) : 0.f;
                u32x2* orow = (u32x2*)(XB + (size_t)m * 1024);
#pragma unroll
                for (int j = 0; j < 4; ++j) orow[64 * j + lane] = (u32x2){pk2(v[r][j].x, v[r][j].y), pk2(v[r][j].z, v[r][j].w)};
            } }
    }
    float* COS = (float*)(P.ws + WS_COS); float* SIN = (float*)(P.ws + WS_SIN);
    for (int rp_ = 0; rp_ < ((P0_REP & 4) ? 2 : 1); ++rp_)
    for (int i = gtid; i < LTOK * 32; i += NGT) {
        const int p = i >> 5, f = i & 31;
        const double rev = (double)p * exp2(-(double)f * (13.287712379549449 / 32.0)) * 0.15915494309189535;
        const float fr = (float)(rev - floor(rev));
        COS[i] = __builtin_amdgcn_cosf(fr); SIN[i] = __builtin_amdgcn_sinf(fr);
    }
    float* WR = (float*)(P.ws + WS_WR); const float* gf = P.in[14]; const float* wgrp = P.in[15]; const float* wrt = P.in[17];
    for (int i = gtid; i < 36 * 1024; i += NGT) { const int j = i >> 10, k = i & 1023; WR[i] = gf[k] * (j < 4 ? wgrp[k * 4 + j] : wrt[k * 32 + (j - 4)]); }
}

#ifndef EPI_NT
#define EPI_NT 0
#endif
#if EPI_NT
#define NT_ST(p, v) __builtin_nontemporal_store((v), (p))
#else
#define NT_ST(p, v) do { if (EV == 1) { auto p_ = (p); *(decltype(p_))(dmask ? dumpb + ((unsigned long long)p_ & 0xFFFF0ull) : (unsigned char*)p_) = (v); } else *(p) = (v); } while (0)
#endif
template <int EV> struct EpiInProjT {
    static constexpr bool PERM = true, AFTER_DRAIN = false, TIMED = true;
    const float* RS1; const float* COS; const float* SIN; const float* a_log; const float* dt_bias;
    bf16_t* QB; bf16_t* KT; bf16_t* VT; bf16_t* QKVB; bf16_t* ZB; float* GB; unsigned char* dumpb; int dmask; unsigned long long* tslot;
    DI void tail(const pg8::f32x4 (&acc)[2][2][4][2], const pg8::Unit& u, int wr, int wc, int fr, int fq) const {
        const int pn = u.pn;
#pragma unroll
        for (int ai = 0; ai < 2; ++ai)
#pragma unroll
            for (int m = 0; m < 4; ++m) {
                const int row = u.pm * 256 + ai * 128 + wr * 64 + m * 16 + fr;
                if (row < MTOK + NMETA) {
                    const float rs = RS1[row];
                    const bool meta = row >= MTOK;
                    const int p = meta ? row - MTOK : (row & 8191) + NMETA;
                    const int b0 = meta ? 0 : (row >> 13), nb = meta ? 2 : 1;
#pragma unroll
                    for (int bj = 0; bj < 2; ++bj) {
                        float xv[8];
#pragma unroll
                        for (int i = 0; i < 4; ++i) { xv[i] = acc[ai][bj][m][0][i] * rs; xv[4 + i] = acc[ai][bj][m][1][i] * rs; }
                        if (pn < 4) {
                            const int hh = (pn & 1) * 4 + bj * 2 + (wc >> 1), d0 = 4 * (4 * (wc & 1) + fq);
                            const f32x4 cs = *(const f32x4*)(COS + p * 32 + d0), sn = *(const f32x4*)(SIN + p * 32 + d0);
                            float lo[4], hi[4];
#pragma unroll
                            for (int i = 0; i < 4; ++i) { lo[i] = xv[i] * cs[i] - xv[4 + i] * sn[i]; hi[i] = xv[4 + i] * cs[i] + xv[i] * sn[i]; }
                            if (pn < 2) {
                                if (!meta) {
                                    bf16_t* q = QB + ((size_t)((b0 * 8 + hh) * SEQ + (p - NMETA)) << 6) + d0;
                                    *(u32x2*)q = (u32x2){pk2(lo[0] * C2Q, lo[1] * C2Q), pk2(lo[2] * C2Q, lo[3] * C2Q)};
                                    *(u32x2*)(q + 32) = (u32x2){pk2(hi[0] * C2Q, hi[1] * C2Q), pk2(hi[2] * C2Q, hi[3] * C2Q)};
                                }
                            } else {
                                for (int bb = b0; bb < b0 + nb; ++bb) {
                                    *(u32x2*)(KT + kt_off(bb, hh, p, d0)) = (u32x2){pk2(lo[0], lo[1]), pk2(lo[2], lo[3])};
                                    *(u32x2*)(KT + kt_off(bb, hh, p, d0 + 32)) = (u32x2){pk2(hi[0], hi[1]), pk2(hi[2], hi[3])};
                                }
                            }
                        } else {
                            const u32x4 w = (u32x4){pk2(xv[0], xv[1]), pk2(xv[2], xv[3]), pk2(xv[4], xv[5]), pk2(xv[6], xv[7])};
                            const int cl = bj * 128 + wc * 32 + fq * 8;
                            if (pn < 6) {
                                const int h = (pn - 4) * 2 + bj, d = wc * 32 + fq * 8;
                                for (int bb = b0; bb < b0 + nb; ++bb) *(u32x4*)(VT + vt_off(bb, h, p, d)) = w;
                            } else if (pn < 12) {
                                for (int bb = b0; bb < b0 + nb; ++bb) *(u32x4*)(QKVB + (size_t)(bb * LP + p) * 1536 + (pn - 6) * 256 + cl) = w;
                            } else if (pn < 14) {
                                float sz[8];
#pragma unroll
                                for (int i = 0; i < 8; ++i) sz[i] = xv[i] * __builtin_amdgcn_rcpf(1.0f + __expf(-xv[i]));
                                const u32x4 wz = (u32x4){pk2(sz[0], sz[1]), pk2(sz[2], sz[3]), pk2(sz[4], sz[5]), pk2(sz[6], sz[7])};
                                for (int bb = b0; bb < b0 + nb; ++bb) *(u32x4*)(ZB + (size_t)(bb * LP + p) * 512 + (pn - 12) * 256 + cl) = wz;
                            } else if (cl < 16) {
                                float o[8];
                                if (cl == 0) {
#pragma unroll
                                    for (int i = 0; i < 8; ++i) { const float t = xv[i] + dt_bias[i]; const float sp = fmaxf(t, 0.f) + __logf(1.0f + __expf(-fabsf(t))); o[i] = -__expf(a_log[i]) * sp; }
                                } else {
#pragma unroll
                                    for (int i = 0; i < 8; ++i) o[i] = __builtin_amdgcn_rcpf(1.0f + __expf(-xv[i]));
                                }
                                for (int bb = b0; bb < b0 + nb; ++bb) { float* g = GB + ((size_t)(bb * LP + p) << 4) + cl;
                                    *(f32x4*)g = (f32x4){o[0], o[1], o[2], o[3]}; *(f32x4*)(g + 4) = (f32x4){o[4], o[5], o[6], o[7]}; }
                            }
                        }
                    }
                }
            }
    }

    DI void operator()(const pg8::f32x4 (&acc)[2][2][4][2], const pg8::Unit& u, int wr, int wc, int fr, int fq) const {
        if (u.pm >= MTOK / 256) { tail(acc, u, wr, wc, fr, fq); return; }
        const int pn = u.pn, rowb = u.pm * 256 + wr * 64 + fr;
        float rs[2][4];
#pragma unroll
        for (int ai = 0; ai < 2; ++ai)
#pragma unroll
            for (int m = 0; m < 4; ++m) rs[ai][m] = (EV == 2) ? 1.0f : RS1[rowb + ai * 128 + m * 16];
        __builtin_amdgcn_sched_barrier(0);
        const int b = rowb >> 13, s0 = rowb & 8191;
        if (pn < 4) {
            const int d0 = 4 * (4 * (wc & 1) + fq);
#pragma unroll
            for (int ai = 0; ai < 2; ++ai) {
                f32x4 cs[4], sn[4];
#pragma unroll
                for (int m = 0; m < 4; ++m) { const int p = s0 + ai * 128 + m * 16 + NMETA; if (EV == 2) { cs[m] = (f32x4){1.f, 1.f, 1.f, 1.f}; sn[m] = (f32x4){0.f, 0.f, 0.f, 0.f}; } else { cs[m] = *(const f32x4*)(COS + p * 32 + d0); sn[m] = *(const f32x4*)(SIN + p * 32 + d0); } }
                __builtin_amdgcn_sched_barrier(0);
#pragma unroll
                for (int m = 0; m < 4; ++m)
#pragma unroll
                    for (int bj = 0; bj < 2; ++bj) {
                        const int hh = (pn & 1) * 4 + bj * 2 + (wc >> 1), s = s0 + ai * 128 + m * 16;
                        float lo[4], hi[4];
#pragma unroll
                        for (int i = 0; i < 4; ++i) { const float x1 = acc[ai][bj][m][0][i] * rs[ai][m], x2 = acc[ai][bj][m][1][i] * rs[ai][m];
                            lo[i] = x1 * cs[m][i] - x2 * sn[m][i]; hi[i] = x2 * cs[m][i] + x1 * sn[m][i]; }
                        if (pn < 2) { bf16_t* q = QB + ((size_t)((b * 8 + hh) * SEQ + s) << 6) + d0;
                            NT_ST((u32x2*)q, ((u32x2){pk2(lo[0] * C2Q, lo[1] * C2Q), pk2(lo[2] * C2Q, lo[3] * C2Q)}));
                            NT_ST((u32x2*)(q + 32), ((u32x2){pk2(hi[0] * C2Q, hi[1] * C2Q), pk2(hi[2] * C2Q, hi[3] * C2Q)}));
                        } else { bf16_t* k = KT + ((size_t)((b * 8 + hh) * NKT + 1 + (s >> 6)) << 12) + ((d0 >> 3) << 9) + ((s & 63) << 3) + (d0 & 7);
                            NT_ST((u32x2*)k, ((u32x2){pk2(lo[0], lo[1]), pk2(lo[2], lo[3])}));
                            NT_ST((u32x2*)(k + 4 * 512), ((u32x2){pk2(hi[0], hi[1]), pk2(hi[2], hi[3])})); }
                    }
            }
            return;
        }
        const int cl = wc * 32 + fq * 8;
#pragma unroll
        for (int ai = 0; ai < 2; ++ai)
#pragma unroll
            for (int m = 0; m < 4; ++m)
#pragma unroll
                for (int bj = 0; bj < 2; ++bj) {
                    const int s = s0 + ai * 128 + m * 16, p = s + NMETA;
                    float xv[8];
#pragma unroll
                    for (int i = 0; i < 4; ++i) { xv[i] = acc[ai][bj][m][0][i] * rs[ai][m]; xv[4 + i] = acc[ai][bj][m][1][i] * rs[ai][m]; }
                    if (pn < 6) {
                        const int h = (pn - 4) * 2 + bj;
                        NT_ST((u32x4*)(VT + ((size_t)((b * 4 + h) * NKT + 1 + (s >> 6)) << 13) + ((cl >> 5) << 11) + (((s & 63) >> 4) << 9) + ((s & 15) << 5) + (cl & 31)),
                            ((u32x4){pk2(xv[0], xv[1]), pk2(xv[2], xv[3]), pk2(xv[4], xv[5]), pk2(xv[6], xv[7])}));
                    } else if (pn < 12) {
                        NT_ST((u32x4*)(QKVB + (size_t)(b * LP + p) * 1536 + (pn - 6) * 256 + bj * 128 + cl), ((u32x4){pk2(xv[0], xv[1]), pk2(xv[2], xv[3]), pk2(xv[4], xv[5]), pk2(xv[6], xv[7])}));
                    } else if (pn < 14) {
#pragma unroll
                        for (int i = 0; i < 8; ++i) xv[i] = xv[i] * __builtin_amdgcn_rcpf(1.0f + __expf(-xv[i]));
                        NT_ST((u32x4*)(ZB + (size_t)(b * LP + p) * 512 + (pn - 12) * 256 + bj * 128 + cl), ((u32x4){pk2(xv[0], xv[1]), pk2(xv[2], xv[3]), pk2(xv[4], xv[5]), pk2(xv[6], xv[7])}));
                    } else if (bj == 0 && cl < 16) {
                        float o[8];
                        if (cl == 0) {
#pragma unroll
                            for (int i = 0; i < 8; ++i) { const float t = xv[i] + dt_bias[i]; const float sp = fmaxf(t, 0.f) + __logf(1.0f + __expf(-fabsf(t))); o[i] = -__expf(a_log[i]) * sp; }
                        } else {
#pragma unroll
                            for (int i = 0; i < 8; ++i) o[i] = __builtin_amdgcn_rcpf(1.0f + __expf(-xv[i]));
                        }
                        float* g = GB + ((size_t)(b * LP + p) << 4) + cl;
                        *(f32x4*)g = (f32x4){o[0], o[1], o[2], o[3]}; *(f32x4*)(g + 4) = (f32x4){o[4], o[5], o[6], o[7]};
                    }
                }
    }
};
typedef EpiInProjT<0> EpiInProj;

DI bf16x8 lds_frag(LAS const bf16_t* M, int row, int ch) { return *(LAS const bf16x8*)((LAS const unsigned char*)M + row * 128 + ((ch ^ (row & 7)) << 4)); }
DI s16x4 tr_read_b64(LAS const unsigned char* p) { return __builtin_bit_cast(s16x4, __builtin_amdgcn_ds_read_tr16_b64_v4i16((LAS v4i16_t*)p)); }
DI bf16x8 lds_frag_plain(LAS const bf16_t* M, int row, int ch) { return *(LAS const bf16x8*)((LAS const unsigned char*)M + row * 128 + (ch << 4)); }
DI int swz_idx(int row, int d) { return row * 64 + ((((d >> 3) ^ (row & 7)) << 3) | (d & 7)); }

#ifndef PREP_REP
#define PREP_REP 0
#endif
constexpr int PREP_PAIR = 35840;

template <int MAT> DI void prep_rows(const bf16_t* QKVB, const float* cw, int b, int h, int n, int lane, LAS const float* egS,
                                     LAS bf16_t* DS  , bf16_t* QG) {
    const int colb = MAT * 512 + h * 64, col = colb + lane, p0 = n * 64;
    const float c0 = cw[col], c1 = cw[1536 + col], c2 = cw[3072 + col], c3 = cw[4608 + col];
    const bf16_t* blk = QKVB + (size_t)(b * LP + p0) * 1536 + colb;
    float x0 = 0.f, x1 = 0.f, x2 = 0.f;
    if (n > 0) { x0 = bf2f(blk[lane - 3 * 1536]); x1 = bf2f(blk[lane - 2 * 1536]); x2 = bf2f(blk[lane - 1 * 1536]); }
    u32x4 stg[8];
#pragma unroll
    for (int i = 0; i < 8; ++i) stg[i] = *(const u32x4*)(blk + (size_t)(8 * i + (lane >> 3)) * 1536 + (lane & 7) * 8);
#pragma unroll
    for (int i = 0; i < 8; ++i) *(LAS u32x4*)(DS + (8 * i + (lane >> 3)) * 64 + (lane & 7) * 8) = stg[i];
    LDS_WAIT();
    const int nvalid = (LTOK - p0) < 64 ? (LTOK - p0) : 64;
#pragma unroll 4
    for (int c = 0; c < nvalid; ++c) {
        const float x3 = bf2f(DS[c * 64 + lane]);
        float y = c0 * x0 + c1 * x1 + c2 * x2 + c3 * x3;
        y = y * __builtin_amdgcn_rcpf(1.0f + __expf(-y));
        x0 = x1; x1 = x2; x2 = x3;
        if (MAT == 2) { DS[c * 64 + lane] = (bf16_t)f2bf(y * egS[c]); }
        else {
            const float ss = wave_sum(y * y);
            const float yn = y * __builtin_amdgcn_rsqf(ss + EPS);
            if (MAT == 0) {
                const float qn = yn * 0.125f;
                DS[c * 64 + lane] = (bf16_t)f2bf(qn);
                QG[c * 64 + perm16(lane)] = (bf16_t)f2bf(qn * egS[c]);
            } else {
                DS[c * 64 + lane] = (bf16_t)f2bf(yn);
            }
        }
    }
    for (int c = nvalid; c < 64; ++c) { DS[c * 64 + lane] = 0; if (MAT == 0) QG[c * 64 + perm16(lane)] = 0; }
}

DI void gdn_tinv(LAS const float* AST, LAS bf16_t* TS, int lane) {
    const int hb = lane >> 5, j = lane & 31, r32 = j, hi = hb;
    LAS const float* Ab = AST + (32 * hb) * 68 + 32 * hb;
    float x[32];
#pragma unroll
    for (int r = 0; r < 32; ++r) x[r] = (r == j) ? 1.0f : 0.0f;
#pragma unroll
    for (int jj = 0; jj < 31; ++jj) {
        const float xj = x[jj];
        LAS const float* ap = Ab + jj * 68;
#pragma unroll
        for (int r4 = (jj + 1) / 4; r4 < 8; ++r4) {
            const f32x4 a = *(LAS const f32x4*)(ap + 4 * r4);
#pragma unroll
            for (int e = 0; e < 4; ++e) if (4 * r4 + e > jj) x[4 * r4 + e] -= a[e] * xj;
        }
    }
    bf16x8 a21[2];
#pragma unroll
    for (int s = 0; s < 2; ++s) { float t[8];
#pragma unroll
        for (int jj = 0; jj < 8; ++jj) t[jj] = AST[(16 * s + 8 * hi + jj) * 68 + 32 + r32];
        const u32x4 p = (u32x4){pk2(t[0], t[1]), pk2(t[2], t[3]), pk2(t[4], t[5]), pk2(t[6], t[7])}; a21[s] = __builtin_bit_cast(bf16x8, p); }
    f32x16 M = {};
#pragma unroll
    for (int s = 0; s < 2; ++s) { float t[8];
#pragma unroll
        for (int jj = 0; jj < 8; ++jj) {
            const auto rr = __builtin_amdgcn_permlane32_swap(__float_as_uint(x[16 * s + 8 + jj]), __float_as_uint(x[16 * s + 8 + jj]), false, false);
            t[jj] = hi ? __uint_as_float(rr[0]) : x[16 * s + jj];
        }
        const u32x4 p = (u32x4){pk2(t[0], t[1]), pk2(t[2], t[3]), pk2(t[4], t[5]), pk2(t[6], t[7])};
        M = MFMA32(a21[s], __builtin_bit_cast(bf16x8, p), M);
    }
    asm volatile("s_waitcnt lgkmcnt(0)" ::: "memory");
#pragma unroll
    for (int i = 0; i < 32; ++i) TS[(32 * hb + i) * 64 + 32 * hb + j] = (bf16_t)f2bf(x[i]);
    asm volatile("s_waitcnt lgkmcnt(0)" ::: "memory");
    f32x16 T21 = {};
#pragma unroll
    for (int s = 0; s < 2; ++s) {
        const u32x2 lo = *(LAS const u32x2*)(TS + (32 + r32) * 64 + 32 + 16 * s + 4 * hi), hi8 = *(LAS const u32x2*)(TS + (32 + r32) * 64 + 32 + 16 * s + 8 + 4 * hi);
        const u32x4 p = (u32x4){lo.x, lo.y, hi8.x, hi8.y};
        T21 = MFMA32(__builtin_bit_cast(bf16x8, p), pack8(M, s), T21);
    }
#pragma unroll
    for (int i = 0; i < 16; ++i) TS[(32 + crow(i, hi)) * 64 + r32] = (bf16_t)f2bf(-T21[i]);
    asm volatile("s_waitcnt lgkmcnt(0)" ::: "memory");
}

template <bool PERM> DI void gdn_tmul(LAS const bf16_t* TS, LAS const bf16_t* RS, int lane, float sgn, bf16_t* out) {
    const int r32 = lane & 31, hi = lane >> 5;
    LAS const unsigned char* rb = (LAS const unsigned char*)RS + ((8 * hi + ((lane & 15) >> 2)) * 64 + 16 * ((lane >> 4) & 1) + 4 * (lane & 3)) * 2;
#pragma unroll
    for (int ct = 0; ct < 2; ++ct)
#pragma unroll
        for (int cb = 0; cb < 2; ++cb) {
            f32x16 acc = {};
#pragma unroll
            for (int ks = 0; ks < (ct == 0 ? 2 : 4); ++ks) {
                const bf16x8 fa = lds_frag_plain(TS, 32 * ct + r32, 2 * ks + hi);
                const s16x4 lo = tr_read_b64(rb + (16 * ks * 64 + 32 * cb) * 2), h4 = tr_read_b64(rb + ((16 * ks + 4) * 64 + 32 * cb) * 2);
                const bf16x8 fb = (bf16x8){lo[0], lo[1], lo[2], lo[3], h4[0], h4[1], h4[2], h4[3]};
                acc = MFMA32(fa, fb, acc);
            }
            u32x2 pk[16];
#pragma unroll
            for (int i = 0; i < 16; ++i) pk[i] = pack_quad_bf16(sgn * acc[i]);
            if ((lane & 3) == 0) {
                unsigned long long ob_ = (unsigned long long)(out + hi * 256 + (PERM ? perm16(32 * cb + r32) : 32 * cb + r32)); asm volatile("" : "+v"(ob_));
                g_u32x2* ob = (g_u32x2*)ob_;
#pragma unroll
                for (int i = 0; i < 16; ++i) ob[(32 * ct + (i & 3) + 8 * (i >> 2)) * 16] = pk[i];
            }
        }
}

DI void gdn_prep_phase(const Params& P, LAS unsigned char* lds, int blk, int G, int wave, int lane_in) {
    const int pair = wave >> 1, role = wave & 1;
    LAS unsigned char* pb = lds + pair * PREP_PAIR;
    LAS bf16_t* QS = (LAS bf16_t*)pb; LAS bf16_t* KS = (LAS bf16_t*)(pb + 8192); LAS float* AS = (LAS float*)(pb + 16384);
    LAS float* gcS = (LAS float*)(pb + 16384 + 17408 + role * 1024); LAS float* betaS = gcS + 64; LAS float* egS = gcS + 128; LAS float* ekS = gcS + 192;
    const bf16_t* QKVB = (const bf16_t*)(P.ws + WS_QKVB); const float* GB = (const float*)(P.ws + WS_GB); const float* cw = P.in[9];
    const int NP = G * 4, NTASK = 2 * 8 * NCHUNK;
    for (int it = 0; it * NP < NTASK; ++it) {
        int lane = lane_in; asm volatile("" : "+v"(lane));
        const int r32 = lane & 31, hi = lane >> 5;
        const int task = it * NP + blk * 4 + pair;
        const bool active = task < NTASK;
        const int bh = task < 2048 ? (task >> 7) : (task - 2048), n = task < 2048 ? (task & 127) : 128, b = bh >> 3, h = bh & 7;
        const int sidx = bh * NCHUNK + n;
        bf16_t* GPW = (bf16_t*)(P.ws + WS_GP) + (size_t)sidx * 4096; bf16_t* GPQG = GPW + GP_ARR / 2; bf16_t* GPAQK = GPQG + GP_ARR / 2; bf16_t* GPKGT = GPAQK + GP_ARR / 2; bf16_t* GPU = GPKGT + GP_ARR / 2;
        float gc = 0.f, beta = 0.f;
        if (active) {
            const int pl = n * 64 + lane;
            float g = 0.f;
            if (pl < LTOK) { const float* gb = GB + ((size_t)(b * LP + pl) << 4); g = gb[h]; beta = gb[8 + h]; }
            gcS[lane] = g; LDS_WAIT();
            gc = 0.f;
#pragma unroll
            for (int j4 = 0; j4 < 16; ++j4) { const f32x4 t = *(LAS const f32x4*)(gcS + 4 * j4);
                gc += (4 * j4 <= lane ? t[0] : 0.f) + (4 * j4 + 1 <= lane ? t[1] : 0.f) + (4 * j4 + 2 <= lane ? t[2] : 0.f) + (4 * j4 + 3 <= lane ? t[3] : 0.f); }
            const float glast = rlane(gc, 63);
            LDS_WAIT();
            gcS[lane] = gc; betaS[lane] = beta; egS[lane] = (role == 0) ? __expf(gc) : beta * __expf(gc); ekS[lane] = __expf(glast - gc);
            if (role == 0 && lane == 0) ((float*)(P.ws + WS_GL))[sidx] = __expf(glast);
            LDS_WAIT();
            for (int rp_ = 0; rp_ < ((PREP_REP & 1) ? 2 : 1); ++rp_) {
            if (role == 0) prep_rows<0>(QKVB, cw, b, h, n, lane, egS, QS, GPQG);
            else prep_rows<1>(QKVB, cw, b, h, n, lane, egS, KS, GPQG);
            }
        }
        LDS_WAIT();
        __syncthreads();
        if (active) {
            for (int rp_ = 0; rp_ < ((PREP_REP & 2) ? 2 : 1); ++rp_)
#pragma unroll
            for (int t4 = 0; t4 < 4; ++t4) {
                const int ct = t4 >> 1, st = t4 & 1;
                f32x16 acc = {};
                if (!(ct == 0 && st == 1)) {
#pragma unroll
                    for (int ks = 0; ks < 4; ++ks) {
                        const bf16x8 fa = lds_frag_plain(role == 0 ? QS : KS, 32 * ct + r32, 2 * ks + hi), fb = lds_frag_plain(KS, 32 * st + r32, 2 * ks + hi);
                        acc = MFMA32(fa, fb, acc);
                    }
                }
                const float gcs = gcS[32 * st + r32];
                LAS const float* gcb = gcS + hi * 4; LAS const float* beb = betaS + hi * 4;
                asm volatile("" : "+v"(gcb), "+v"(beb));
                const int cmp = (32 * st + r32) - 4 * hi;
                if (role == 0) {
                    u32x2 pk[16];
#pragma unroll
                    for (int i = 0; i < 16; ++i) { const int cr = 32 * ct + (i & 3) + 8 * (i >> 2);
                        pk[i] = pack_quad_bf16((cmp <= cr) ? acc[i] * __expf(gcb[cr] - gcs) : 0.f); }
                    if ((lane & 3) == 0) {
                        unsigned long long aq_ = (unsigned long long)(GPAQK + hi * 256 + perm16(r32) + 32 * st); asm volatile("" : "+v"(aq_));
                        g_u32x2* aqb = (g_u32x2*)aq_;
#pragma unroll
                        for (int i = 0; i < 16; ++i) { const int cr = 32 * ct + (i & 3) + 8 * (i >> 2); aqb[cr * 16] = pk[i]; }
                    }
                } else {
                    LAS float* asb = AS + r32 * 68 + hi * 4;
                    asm volatile("" : "+v"(asb));
#pragma unroll
                    for (int i = 0; i < 16; ++i) { const int cr = 32 * ct + (i & 3) + 8 * (i >> 2);
                        asb[32 * st * 68 + cr] = (cmp < cr) ? acc[i] * beb[cr] * __expf(gcb[cr] - gcs) : 0.f; }
                }
            }
        }
        LDS_WAIT();
        __syncthreads();
        LAS bf16_t* TS = (LAS bf16_t*)((LAS unsigned char*)AS + 32 * 68 * 4);
        if (active) {
            if (role == 0) {
                prep_rows<2>(QKVB, cw, b, h, n, lane, betaS, QS  , GPQG);
            } else {
#pragma unroll
                for (int gq = 0; gq < 8; ++gq) {
                    float t[8];
#pragma unroll
                    for (int j = 0; j < 8; ++j) { const int c = perm16(8 * gq + j); t[j] = bf2f(KS[c * 64 + lane]) * ekS[c]; }
                    *(u32x4*)(GPKGT + lane * 64 + 8 * gq) = (u32x4){pk2(t[0], t[1]), pk2(t[2], t[3]), pk2(t[4], t[5]), pk2(t[6], t[7])};
                }
#pragma unroll 8
                for (int c = 0; c < 64; ++c) KS[c * 64 + lane] = (bf16_t)f2bf(bf2f(KS[c * 64 + lane]) * egS[c]);
                gdn_tinv(AS, TS, lane);
            }
        }
        LDS_WAIT();
        __syncthreads();
        if (active) {
            for (int rp_ = 0; rp_ < ((PREP_REP & 8) ? 2 : 1); ++rp_) {
            if (role == 0) gdn_tmul<false>(TS, QS, lane, 1.0f, GPU);
            else gdn_tmul<true>(TS, KS, lane, -1.0f, GPW);
            }
        }
        LDS_WAIT();
    }
}

constexpr int GS_STAGE = 40960 + 1024;
constexpr int GS_NSTAGE = 3;
constexpr int GS_OBUF = GS_NSTAGE * GS_STAGE;
static_assert(GS_OBUF + 16384 <= LDS_BYTES - 64, "gdn scan LDS");

#define GS_POST(n, ZQ) do { \
            if (n > 0) {         \
                LAS const bf16_t* ob = (LAS const bf16_t*)(lds + GS_OBUF + ((n - 1) & 1) * 8192); \
                const f32x4 gn = *(const f32x4*)(gnorm + 4 * vq); \
            _Pragma("unroll") \
                for (int it = 0; it < 8; ++it) { \
                    const int c = (wave - 2) * 32 + 4 * it + rg, p = (n - 1) * 64 + c; \
                    const u32x2 ov = *(LAS const u32x2*)(ob + c * 64 + 4 * vq); \
                    const float v0 = __uint_as_float(ov.x << 16), v1 = __uint_as_float(ov.x & 0xffff0000u), v2 = __uint_as_float(ov.y << 16), v3 = __uint_as_float(ov.y & 0xffff0000u); \
                    const float ss = row_sum16((v0 * v0 + v1 * v1) + (v2 * v2 + v3 * v3)); \
                    const float rn = __builtin_amdgcn_rsqf(ss * (1.0f / 64.0f) + EPS); \
                    const u32x2 zz = ZQ[it]; \
                    const float z0 = __uint_as_float(zz.x << 16), z1 = __uint_as_float(zz.x & 0xffff0000u), z2 = __uint_as_float(zz.y << 16), z3 = __uint_as_float(zz.y & 0xffff0000u); \
                    const float y0 = v0 * rn * gn[0] * z0, y1 = v1 * rn * gn[1] * z1, y2 = v2 * rn * gn[2] * z2, y3 = v3 * rn * gn[3] * z3;       \
                    { bf16_t* dst_ = ((p >= NMETA) && (p < LTOK)) ? MIX + (size_t)(b * SEQ + p - NMETA) * 1024 + 512 + h * 64 + 4 * vq : DUMP + lane * 4;       \
                      *(u32x2*)dst_ = (u32x2){pk2(y0, y1), pk2(y2, y3)}; } \
                } \
            } \
        } while (0)
DI void gdn_scan(const Params& P, LAS unsigned char* lds, int bh, int tid, int wave, int lane) {
    const int b = bh >> 3, h = bh & 7, r32 = lane & 31, hi = lane >> 5;
    const int task0 = (b * 8 + h) * NCHUNK;
    const bf16_t* GP0 = (const bf16_t*)(P.ws + WS_GP);
    const float* GLg = (const float*)(P.ws + WS_GL);
    const bf16_t* ZB = (const bf16_t*)(P.ws + WS_ZB); bf16_t* MIX = (bf16_t*)(P.ws + WS_MIX); const float* gnorm = P.in[12];
    bf16_t* DUMP = (bf16_t*)(P.ws + WS_DUMP) + bh * 4096 + wave * 512;
    const int lw = wave - 4;
    const int prow = lane >> 3, pch = lane & 7;
#define GS_DMA(n_, stg_) do { LAS unsigned char* sg_ = lds + (stg_) * GS_STAGE; \
        _Pragma("unroll") for (int i = 0; i < 10; ++i) { const int a_ = i >> 1, pi_ = lw * 2 + (i & 1), row_ = 8 * pi_ + prow; \
            const int sch_ = (a_ < 4) ? (pch ^ (row_ & 7)) : pch; \
            __builtin_amdgcn_global_load_lds((const unsigned*)(GP0 + (size_t)a_ * (GP_ARR / 2) + (size_t)(task0 + (n_)) * 4096 + row_ * 64 + sch_ * 8), \
                                             (LAS unsigned*)(sg_ + a_ * 8192 + pi_ * 1024), 16, 0, 0); } \
        __builtin_amdgcn_global_load_lds((const unsigned*)(GLg + task0 + (n_)), (LAS unsigned*)(sg_ + 40960 + lw * 256), 4, 0, 0); } while (0)
    if (wave >= 4) { GS_DMA(0, 0); GS_DMA(1, 1); asm volatile("s_waitcnt vmcnt(11)" ::: "memory"); }
    const int vq = lane & 15, rg = lane >> 4;
    u32x2 zqA[8], zqB[8];
#define GS_ZLOADX(ZQ, n_) do { _Pragma("unroll") for (int it = 0; it < 8; ++it) { int p_ = (n_) * 64 + (wave - 2) * 32 + 4 * it + rg; p_ = p_ < LTOK ? p_ : LTOK - 1; \
            ZQ[it] = *(const u32x2*)(ZB + (size_t)(b * LP + p_) * 512 + h * 64 + 4 * vq); } } while (0)
    if (wave == 2 || wave == 3) { GS_ZLOADX(zqB, 0); }
    BAR_LDS();
    f32x16 S0 = {}, S1 = {};
    const int vbase = 32 * wave;
    if (wave < 2) {
    int stg = 0;
    for (int n = 0; n <= NCHUNK; ++n) {
        {
            if (n < NCHUNK) {
                LAS const unsigned char* sg = lds + stg * GS_STAGE;
                LAS const bf16_t* Wm = (LAS const bf16_t*)sg; LAS const bf16_t* QGm = (LAS const bf16_t*)(sg + 8192); LAS const bf16_t* AQm = (LAS const bf16_t*)(sg + 16384);
                LAS const bf16_t* KGm = (LAS const bf16_t*)(sg + 24576); LAS const bf16_t* Um = (LAS const bf16_t*)(sg + 32768);
                const float gl = *(LAS const float*)(sg + 40960);
                bf16x8 Sb[2][2]; Sb[0][0] = pack8(S0, 0); Sb[0][1] = pack8(S0, 1); Sb[1][0] = pack8(S1, 0); Sb[1][1] = pack8(S1, 1);
                bf16x8 fw[2][4], fq[2][4];
                f32x16 vn[2], o[2];
#pragma unroll
                for (int ct = 0; ct < 2; ++ct)
#pragma unroll
                    for (int k4 = 0; k4 < 4; ++k4) { fw[ct][k4] = lds_frag(Wm, 32 * ct + r32, k4 * 2 + hi); fq[ct][k4] = lds_frag(QGm, 32 * ct + r32, k4 * 2 + hi); }
#pragma unroll
                for (int ct = 0; ct < 2; ++ct)
#pragma unroll
                    for (int i = 0; i < 16; ++i) vn[ct][i] = bf2f(Um[(32 * ct + crow(i, hi)) * 64 + vbase + r32]);
                o[0] = f32x16{}; o[1] = f32x16{};
                __builtin_amdgcn_sched_barrier(0);
#pragma unroll
                for (int k4 = 0; k4 < 4; ++k4) {
                    vn[0] = MFMA32(fw[0][k4], Sb[k4 >> 1][k4 & 1], vn[0]); o[0] = MFMA32(fq[0][k4], Sb[k4 >> 1][k4 & 1], o[0]);
                    vn[1] = MFMA32(fw[1][k4], Sb[k4 >> 1][k4 & 1], vn[1]); o[1] = MFMA32(fq[1][k4], Sb[k4 >> 1][k4 & 1], o[1]);
                }
                __builtin_amdgcn_sched_barrier(0);
                bf16x8 fa[2][4], fk[2][4];
#pragma unroll
                for (int g = 0; g < 4; ++g) { fa[0][g] = lds_frag(AQm, r32, g * 2 + hi); fa[1][g] = lds_frag(AQm, 32 + r32, g * 2 + hi);
                                              fk[0][g] = lds_frag(KGm, r32, g * 2 + hi); fk[1][g] = lds_frag(KGm, 32 + r32, g * 2 + hi); }
#pragma unroll
                for (int i = 0; i < 16; ++i) { S0[i] *= gl; S1[i] *= gl; }
                __builtin_amdgcn_sched_barrier(0);
                bf16x8 Vb[2][2]; Vb[0][0] = pack8(vn[0], 0); Vb[0][1] = pack8(vn[0], 1); Vb[1][0] = pack8(vn[1], 0); Vb[1][1] = pack8(vn[1], 1);
#pragma unroll
                for (int g = 0; g < 4; ++g) {
                    o[0] = MFMA32(fa[0][g], Vb[g >> 1][g & 1], o[0]); S0 = MFMA32(fk[0][g], Vb[g >> 1][g & 1], S0);
                    o[1] = MFMA32(fa[1][g], Vb[g >> 1][g & 1], o[1]); S1 = MFMA32(fk[1][g], Vb[g >> 1][g & 1], S1);
                }
                LAS bf16_t* ob = (LAS bf16_t*)(lds + GS_OBUF + (n & 1) * 8192);
#pragma unroll
                for (int ct = 0; ct < 2; ++ct)
#pragma unroll
                    for (int i = 0; i < 16; ++i) ob[(32 * ct + crow(i, hi)) * 64 + vbase + r32] = (bf16_t)f2bf(o[ct][i]);
            }
        }
        BAR_LDS();
        stg = stg + 1 >= GS_NSTAGE ? 0 : stg + 1;
    }
    } else if (wave < 4) {
    for (int n = 0; n <= NCHUNK; n += 2) {
        GS_POST(n, zqA);     if (n + 1 < NCHUNK) { GS_ZLOADX(zqA, n + 1); } BAR_LDS();
        GS_POST((n + 1), zqB); if (n + 2 < NCHUNK) { GS_ZLOADX(zqB, n + 2); } BAR_LDS();
    }
    } else {
    int stg = 0;
    for (int n = 0; n <= NCHUNK; ++n) {
        {
            if (n + 2 < NCHUNK) { const int s2_ = stg + 2 >= GS_NSTAGE ? stg + 2 - GS_NSTAGE : stg + 2; GS_DMA(n + 2, s2_); asm volatile("s_waitcnt vmcnt(11)" ::: "memory"); }
            else asm volatile("s_waitcnt vmcnt(0)" ::: "memory");
        }
        BAR_LDS();
        stg = stg + 1 >= GS_NSTAGE ? 0 : stg + 1;
    }
    }
#undef GS_DMA
#undef GS_ZLOADX
}
#define XB_TMO      128
#define XB_XCNT(j)  (256  + 64 * (j))
#define XB_XSUB(j)  (1280 + 64 * (j))
#define XB_XGEN(j)  (2304 + 64 * (j))
#define XB_TOP      3328
#define XB_TOPGEN   3392
#define XCD_BAR_WORDS 3456
#define XB_SPIN_CAP (1u << 18)

__device__ __forceinline__ unsigned xb_ld(unsigned* p)              { return __hip_atomic_load(p, __ATOMIC_RELAXED, __HIP_MEMORY_SCOPE_AGENT); }
__device__ __forceinline__ unsigned xb_add(unsigned* p, unsigned v) { return __hip_atomic_fetch_add(p, v, __ATOMIC_RELAXED, __HIP_MEMORY_SCOPE_AGENT); }
__device__ __forceinline__ unsigned xb_xcc_id() { return (unsigned)__builtin_amdgcn_s_getreg((3 << 11) | 20) & 0xFu; }
#define XB_SPIN(cond, bar) do { unsigned _sp = 0; while (cond) { __builtin_amdgcn_s_sleep(1); \
    if ((++_sp & 255u) == 0u) { if (xb_ld(&(bar)[XB_TMO])) break; if (_sp > XB_SPIN_CAP) { atomicAdd(&(bar)[XB_TMO], 1u); break; } } } } while (0)

struct XcdBarrier {
    unsigned* bar; unsigned x;
    volatile LAS unsigned* st;
};

__device__ __forceinline__ XcdBarrier xcd_barrier_post(unsigned* bar, volatile LAS unsigned* st) {
    XcdBarrier b; b.bar = bar; b.x = xb_xcc_id(); b.st = st;
    if (threadIdx.x == 0) (void)xb_add(&bar[XB_XCNT(b.x)], 1u);
    return b;
}
__device__ __forceinline__ void xcd_barrier_complete(unsigned* bar, unsigned x, unsigned& nloc, unsigned& nx) {
    const unsigned G = gridDim.x * gridDim.y * gridDim.z;
    unsigned sum, cnt, mine, sp = 0u;
    for (;;) {
        sum = 0u; cnt = 0u; mine = 0u;
#pragma unroll
        for (unsigned j = 0; j < 16; ++j) { const unsigned c = xb_ld(&bar[XB_XCNT(j)]); sum += c; cnt += (c > 0u) ? 1u : 0u; mine = (j == x) ? c : mine; }
        if (sum == G) break;
        __builtin_amdgcn_s_sleep(1);
        if ((++sp & 255u) == 0u) { if (xb_ld(&bar[XB_TMO])) break; if (sp > XB_SPIN_CAP) { atomicAdd(&bar[XB_TMO], 1u); break; } }
    }
    nloc = mine > 0u ? mine : 1u; nx = cnt > 0u ? cnt : 1u;
}

__device__ __forceinline__ void xcd_barrier(const XcdBarrier& b) {
    asm volatile("s_waitcnt vmcnt(0)" ::: "memory");
    __syncthreads();
    if (threadIdx.x == 0) {
        unsigned* bar = b.bar;
        __builtin_amdgcn_s_waitcnt(0);
        unsigned nloc = b.st[0], nx = b.st[1];
        if (nloc == 0u) { xcd_barrier_complete(bar, b.x, nloc, nx); b.st[0] = nloc; b.st[1] = nx; }
        const unsigned old = xb_add(&bar[XB_XSUB(b.x)], 1u);
        const unsigned gen = old / nloc;
        if (old + 1u == (gen + 1u) * nloc) {
            __builtin_amdgcn_fence(__ATOMIC_RELEASE, "agent");
            asm volatile("s_waitcnt vmcnt(0)" ::: "memory");
            const unsigned og = xb_add(&bar[XB_TOP], 1u);
            const unsigned tg = og / nx;
            if (og + 1u == (tg + 1u) * nx) xb_add(&bar[XB_TOPGEN], 1u);
            else XB_SPIN(xb_ld(&bar[XB_TOPGEN]) == tg, bar);
            __builtin_amdgcn_fence(__ATOMIC_ACQUIRE, "agent");
            xb_add(&bar[XB_XGEN(b.x)], 1u);
            asm volatile("s_waitcnt vmcnt(0)" ::: "memory");
        } else {
            XB_SPIN(xb_ld(&bar[XB_XGEN(b.x)]) == gen, bar);
            __builtin_amdgcn_fence(__ATOMIC_ACQUIRE, "agent");
            asm volatile("s_waitcnt vmcnt(0)" ::: "memory");
        }
    }
    __syncthreads();
}


constexpr int AT_STAGE = 32768;
constexpr int AT_NSTAGE = 4;
constexpr int AT_XBUF = 0;
constexpr int AT_WSF = AT_NSTAGE * AT_STAGE;
constexpr int AT_UNIT = AT_WSF + 2048;
constexpr float AT_THR = 8.0f;

DI float max3f(float a, float b, float c) { return __builtin_fmaxf(__builtin_fmaxf(a, b), c); }
DI s16x4 tr_read(LAS const unsigned char* p) { return __builtin_bit_cast(s16x4, __builtin_amdgcn_ds_read_tr16_b64_v4i16((LAS v4i16_t*)p)); }

template <int VAR> DI void attn_unit(const Params& P, LAS unsigned char* lds, int bh, int qi, int tid, int wave, int lane, float lam) {
    const int b = bh >> 2, h = bh & 3, r32 = lane & 31, hi = lane >> 5, qsub = wave >> 1, map = wave & 1, hh = 2 * h + map;
    const bf16_t* QB = (const bf16_t*)(P.ws + WS_QB); const bf16_t* KT = (const bf16_t*)(P.ws + WS_KT); const bf16_t* VT = (const bf16_t*)(P.ws + WS_VT);
    const int ntiles = 2 * qi + 3, my_nt = (qsub < 2) ? ntiles - 1 : ntiles;
    const bf16_t* k1 = KT + ((size_t)((b * 8 + 2 * h) * NKT) << 12) + tid * 8;
    const bf16_t* k2 = KT + ((size_t)((b * 8 + 2 * h + 1) * NKT) << 12) + tid * 8;
    const bf16_t* vv = VT + ((size_t)((b * 4 + h) * NKT) << 13) + tid * 8;
#define AT_DMA(t, sb) do { LAS unsigned char* d_ = lds + (sb) * AT_STAGE + wave * 1024; \
        __builtin_amdgcn_global_load_lds((const unsigned*)(k1 + ((size_t)(t) << 12)), (LAS unsigned*)d_, 16, 0, 0); \
        __builtin_amdgcn_global_load_lds((const unsigned*)(k2 + ((size_t)(t) << 12)), (LAS unsigned*)(d_ + 8192), 16, 0, 0); \
        __builtin_amdgcn_global_load_lds((const unsigned*)(vv + ((size_t)(t) << 13)), (LAS unsigned*)(d_ + 16384), 16, 0, 0); \
        __builtin_amdgcn_global_load_lds((const unsigned*)(vv + ((size_t)(t) << 13) + 4096), (LAS unsigned*)(d_ + 24576), 16, 0, 0); } while (0)
    bf16x8 qr[4];
    { const bf16_t* q = QB + ((size_t)((b * 8 + hh) * SEQ + qi * 128 + qsub * 32 + r32) << 6) + hi * 8;
#pragma unroll
      for (int d0 = 0; d0 < 4; ++d0) qr[d0] = *(const bf16x8*)(q + d0 * 16); }
    asm volatile("s_waitcnt vmcnt(0)" : "+v"(qr[0]), "+v"(qr[1]), "+v"(qr[2]), "+v"(qr[3]) :: "memory");
    AT_DMA(0, 0); AT_DMA(1, 1); AT_DMA(2, 2);
    asm volatile("s_waitcnt vmcnt(8)" ::: "memory");
    BAR_LDS();
    LAS float* wsf = (LAS float*)(lds + AT_WSF) + wave * 64;
    float m_run = 0.f, l_run = 0.f;
    f32x16 negm = {};
    f32x16 o[4]; o[0] = f32x16{}; o[1] = f32x16{}; o[2] = f32x16{}; o[3] = f32x16{};
    for (int t = 0; t < ntiles; ++t) {
        if (t + 3 < ntiles) AT_DMA(t + 3, (t + 3) % AT_NSTAGE);
        if (t < my_nt) {
            LAS const unsigned char* sg = lds + (t % AT_NSTAGE) * AT_STAGE;
            LAS const unsigned char* kb = sg + map * 8192 + hi * 1024 + r32 * 16;
            f32x16 p0 = negm, p1 = negm;
            bf16x8 kf[8];
#pragma unroll
            for (int d0 = 0; d0 < 4; ++d0) { kf[2 * d0] = *(LAS const bf16x8*)(kb + d0 * 2048); kf[2 * d0 + 1] = *(LAS const bf16x8*)(kb + d0 * 2048 + 512); }
            __builtin_amdgcn_sched_barrier(0);
            __builtin_amdgcn_s_setprio(1);
#pragma unroll
            for (int d0 = 0; d0 < 4; ++d0) { p0 = MFMA32(kf[2 * d0], qr[d0], p0); p1 = MFMA32(kf[2 * d0 + 1], qr[d0], p1); }
            __builtin_amdgcn_s_setprio(0);
            const bool first = (t == 0);
            if (first) {
#pragma unroll
                for (int r = 0; r < 16; ++r) { if (crow(r, hi) >= NMETA) p0[r] = -INFINITY; p1[r] = -INFINITY; }
            }
            float ma = max3f(p0[0], p0[1], p1[0]), mb = max3f(p0[2], p0[3], p1[1]); ma = max3f(ma, p1[2], p1[3]);
#pragma unroll
            for (int r = 4; r < 16; r += 4) { ma = max3f(ma, p0[r], p0[r + 1]); mb = max3f(mb, p0[r + 2], p0[r + 3]); ma = max3f(ma, p1[r], p1[r + 1]); mb = max3f(mb, p1[r + 2], p1[r + 3]); }
            const float rm = swap32_max(max3f(ma, mb, mb));
            if (first || __any(rm > AT_THR)) {
                const float dl = first ? rm : fmaxf(rm, 0.f);
                m_run += dl;
#pragma unroll
                for (int r = 0; r < 16; ++r) { p0[r] -= dl; p1[r] -= dl; negm[r] = -m_run; }
                const float alpha = __builtin_amdgcn_exp2f(-dl);
                l_run *= alpha;
                if (!first) {
                    if (hi == 0) wsf[r32] = alpha;
                    LDS_WAIT();
#pragma unroll
                    for (int r = 0; r < 16; ++r) { const float a = wsf[crow(r, hi)];
#pragma unroll
                        for (int d0 = 0; d0 < 4; ++d0) o[d0][r] *= a; }
                    LDS_WAIT();
                }
            }
            float ls0 = 0.f, ls1 = 0.f;
#pragma unroll
            for (int r = 0; r < 16; ++r) { if (VAR != 2) { p0[r] = __builtin_amdgcn_exp2f(p0[r]); p1[r] = __builtin_amdgcn_exp2f(p1[r]); } ls0 += p0[r]; ls1 += p1[r]; }
            l_run += ls0 + ls1;
            const bf16x8 pa0 = pack8(p0, 0), pa1 = pack8(p0, 1), pa2 = pack8(p1, 0), pa3 = pack8(p1, 1);
            LAS const unsigned char* vb = sg + 16384 + ((lane >> 4) & 1) * 32 + (lane & 3) * 8 + (4 * hi + ((lane & 15) >> 2)) * 64;
            s16x4 va_[8], vb_[8];
            const unsigned vba = (unsigned)(uintptr_t)vb;
#define AT_VLD(V, d0_) do { _Pragma("unroll") for (int ks = 0; ks < 4; ++ks) { \
                asm volatile("ds_read_b64_tr_b16 %0, %1 offset:%c2" : "=v"(V[2 * ks]) : "v"(vba), "i"((d0_) * 4096 + ks * 1024)); \
                asm volatile("ds_read_b64_tr_b16 %0, %1 offset:%c2" : "=v"(V[2 * ks + 1]) : "v"(vba), "i"((d0_) * 4096 + ks * 1024 + 512)); } } while (0)
#define AT_VF(V, ks) ((bf16x8){V[2 * (ks)][0], V[2 * (ks)][1], V[2 * (ks)][2], V[2 * (ks)][3], V[2 * (ks) + 1][0], V[2 * (ks) + 1][1], V[2 * (ks) + 1][2], V[2 * (ks) + 1][3]})
#define AT_WAITL(n, V) do { asm volatile("s_waitcnt lgkmcnt(" #n ")" : "+v"(V[0]), "+v"(V[1]), "+v"(V[2]), "+v"(V[3]), "+v"(V[4]), "+v"(V[5]), "+v"(V[6]), "+v"(V[7])); __builtin_amdgcn_sched_barrier(0); } while (0)
#define AT_PV(V, d0_) do { __builtin_amdgcn_s_setprio(1); o[d0_] = MFMA32(pa0, AT_VF(V, 0), o[d0_]); o[d0_] = MFMA32(pa1, AT_VF(V, 1), o[d0_]); o[d0_] = MFMA32(pa2, AT_VF(V, 2), o[d0_]); o[d0_] = MFMA32(pa3, AT_VF(V, 3), o[d0_]); __builtin_amdgcn_s_setprio(0); } while (0)
            if (VAR != 1) {
            asm volatile("s_waitcnt lgkmcnt(0)" ::: "memory"); __builtin_amdgcn_sched_barrier(0);
            AT_VLD(va_, 0); AT_VLD(vb_, 1);
            AT_WAITL(8, va_); AT_PV(va_, 0); __builtin_amdgcn_sched_barrier(0); AT_VLD(va_, 2);
            AT_WAITL(8, vb_); AT_PV(vb_, 1); __builtin_amdgcn_sched_barrier(0); AT_VLD(vb_, 3);
            AT_WAITL(8, va_); AT_PV(va_, 2); __builtin_amdgcn_sched_barrier(0);
            AT_WAITL(0, vb_); AT_PV(vb_, 3);
            } else { o[0][0] += (float)pa0[0] + (float)pa1[1] + (float)pa2[2] + (float)pa3[3]; }
#undef AT_VF
#undef AT_WAITL
#undef AT_VLD
#undef AT_PV
        }
        if (t + 3 < ntiles) asm volatile("s_waitcnt vmcnt(8)" ::: "memory"); else if (t + 2 < ntiles) asm volatile("s_waitcnt vmcnt(4)" ::: "memory"); else asm volatile("s_waitcnt vmcnt(0)" ::: "memory");
        BAR_LDS();
    }
    if (VAR != 0) { if (o[0][0] + o[1][1] + o[2][2] + o[3][3] + l_run == 123.456f) ((float*)(P.ws + WS_DUMP))[tid] = 1.f; __syncthreads(); return; }
    l_run = swap32_add(l_run);
    const float sc = (map ? lam : 1.0f) / l_run;
    if (hi == 0) wsf[r32] = sc;
    LDS_WAIT();
#pragma unroll
    for (int r = 0; r < 16; ++r) { const float a = wsf[crow(r, hi)];
#pragma unroll
        for (int d0 = 0; d0 < 4; ++d0) o[d0][r] *= a; }
    LAS float* xb = (LAS float*)(lds + AT_XBUF + qsub * 16384);
    if (map) {
#pragma unroll
        for (int d0 = 0; d0 < 4; ++d0)
#pragma unroll
            for (int r = 0; r < 16; ++r) xb[(d0 * 16 + r) * 64 + lane] = o[d0][r];
    }
    __syncthreads();
    if (!map) {
        const float* dn = P.in[8];
        bf16_t* MIX = (bf16_t*)(P.ws + WS_MIX);
        float ss[16];
#pragma unroll
        for (int r = 0; r < 16; ++r) { ss[r] = 0.f;
#pragma unroll
            for (int d0 = 0; d0 < 4; ++d0) { o[d0][r] -= xb[(d0 * 16 + r) * 64 + lane]; ss[r] += o[d0][r] * o[d0][r]; } }
#pragma unroll
        for (int r = 0; r < 16; ++r) {
            ss[r] = half_sum32(ss[r]);
            ss[r] = 0.8f / sqrtf(ss[r] * (1.0f / 128.0f) + EPS);
        }
        float dg[4];
#pragma unroll
        for (int d0 = 0; d0 < 4; ++d0) dg[d0] = dn[32 * d0 + r32];
#pragma unroll
        for (int r = 0; r < 16; ++r) {
            bf16_t* orow = MIX + (size_t)(b * SEQ + qi * 128 + qsub * 32 + crow(r, hi)) * 1024 + h * 128 + r32;
#pragma unroll
            for (int d0 = 0; d0 < 4; ++d0) orow[32 * d0] = (bf16_t)f2bf(o[d0][r] * ss[r] * dg[d0]);
        }
    }
    __syncthreads();
#undef AT_DMA
}

template <int VAR> DI void attn_phase(const Params& P, LAS unsigned char* lds, int tid, int wave, int lane) {
    unsigned* ctl = (unsigned*)(P.ws + WS_CTL);
    const float* lq1 = P.in[4]; const float* lk1 = P.in[5]; const float* lq2 = P.in[6]; const float* lk2 = P.in[7];
    const float lam = __expf(wave_sum(lq1[lane] * lk1[lane])) - __expf(wave_sum(lq2[lane] * lk2[lane])) + 0.2f;
    LAS volatile int* ub = (LAS volatile int*)(lds + AT_UNIT);
    const unsigned x0 = xb_xcc_id() & 7u;
    for (;;) {
        if (tid == 0) {
            int u = -1;
            for (unsigned j = 0; j < 8u && u < 0; ++j) { const unsigned x = (x0 + j) & 7u;
                if (__hip_atomic_load(ctl + CW_ATTQ + 64 * x, __ATOMIC_RELAXED, __HIP_MEMORY_SCOPE_AGENT) >= 64u) continue;
                const unsigned i = __hip_atomic_fetch_add(ctl + CW_ATTQ + 64 * x, 1u, __ATOMIC_RELAXED, __HIP_MEMORY_SCOPE_AGENT);
                if (i < 64u) u = (int)(x * 64u + i); }
            *ub = u;
        }
        __syncthreads();
        const int u = *ub;
        __syncthreads();
        if (u < 0) break;
        attn_unit<VAR>(P, lds, u >> 6, 63 - (u & 63), tid, wave, lane, lam);
    }
}

struct EpiOutProj {
    static constexpr bool PERM = false, AFTER_DRAIN = false;
    const float* x; float* out; bf16_t* u2;
    DI void operator()(const pg8::f32x4 (&acc)[2][2][4][2], const pg8::Unit& u, int wr, int wc, int fr, int fq) const {
        const int row0 = u.pm * 256 + wr * 64 + fr, col0 = u.pn * 256 + wc * 32 + 4 * fq;
#pragma unroll
        for (int ai = 0; ai < 2; ++ai) {
            f32x4 xv[4][2][2];
#pragma unroll
            for (int m = 0; m < 4; ++m) { const size_t off = (size_t)(row0 + ai * 128 + m * 16) * 1024 + col0;
#pragma unroll
                for (int bj = 0; bj < 2; ++bj)
#pragma unroll
                    for (int n = 0; n < 2; ++n) xv[m][bj][n] = *(const f32x4*)(x + off + bj * 128 + n * 16); }
#pragma unroll
            for (int m = 0; m < 4; ++m) { const size_t off = (size_t)(row0 + ai * 128 + m * 16) * 1024 + col0;
#pragma unroll
                for (int bj = 0; bj < 2; ++bj)
#pragma unroll
                    for (int n = 0; n < 2; ++n) { const f32x4 hv = acc[ai][bj][m][n] + xv[m][bj][n]; *(f32x4*)(out + off + bj * 128 + n * 16) = hv;
                        *(u32x2*)(u2 + off + bj * 128 + n * 16) = (u32x2){pk2(hv[0], hv[1]), pk2(hv[2], hv[3])}; } }
        }
    }
};

typedef float f32x4v __attribute__((ext_vector_type(4)));
#ifdef ROUTE_PROBE
#define ROUTE_MID_HOOK() do { XcdBarrier xb2; xb2.bar = (unsigned*)(P.ws + WS_CTL) + CW_BAR; xb2.x = xb_xcc_id(); xb2.st = (volatile LAS unsigned*)(ldsb + LDS_BYTES - 64); xcd_barrier(xb2); \
    if (blockIdx.x == 0 && threadIdx.x == 0) __hip_atomic_store((unsigned long long*)(P.ws + WS_CTL + 65536) + 20, (unsigned long long)__builtin_amdgcn_s_memrealtime(), __ATOMIC_RELAXED, __HIP_MEMORY_SCOPE_AGENT); } while (0)
#else
#define ROUTE_MID_HOOK() do {} while (0)
#endif
DI void route_tile(const Params& P, int tile, int par, LAS float* sc  , int lane, LAS unsigned char* ldsb) {
    const float* h2 = P.out; const float* WR = (const float*)(P.ws + WS_WR);
    const int r16 = lane & 15, kq = lane >> 4;
    const float* arow = h2 + (size_t)(tile * 16 + r16) * 1024 + par * 512 + kq * 8;
    const float* b0 = WR + (size_t)r16 * 1024 + par * 512 + kq * 8; const float* b1 = b0 + 16 * 1024; const float* b2 = WR + (size_t)(32 + (r16 & 3)) * 1024 + par * 512 + kq * 8;
    const float z2 = (r16 < 4) ? 1.0f : 0.0f;
    f32x4v c0 = {}, c1 = {}, c2 = {};
    float ss = 0.f;
    f32x4 bA[4][4], bB[4][4];
#define RT_LOAD(B, tb) do { _Pragma("unroll") for (int j = 0; j < 4; ++j) { const int o_ = 32 * ((tb) + (j >> 1)) + 4 * (j & 1); \
        B[j][0] = *(const f32x4*)(arow + o_); B[j][1] = *(const f32x4*)(b0 + o_); B[j][2] = *(const f32x4*)(b1 + o_); B[j][3] = *(const f32x4*)(b2 + o_); } } while (0)
#define RT_COMP(B) do { _Pragma("unroll") for (int j = 0; j < 4; ++j) { const f32x4 a = B[j][0]; ss += (a.x * a.x + a.y * a.y) + (a.z * a.z + a.w * a.w); \
        _Pragma("unroll") for (int i = 0; i < 4; ++i) { c0 = __builtin_amdgcn_mfma_f32_16x16x4f32(a[i], B[j][1][i], c0, 0, 0, 0); \
            c1 = __builtin_amdgcn_mfma_f32_16x16x4f32(a[i], B[j][2][i], c1, 0, 0, 0); c2 = __builtin_amdgcn_mfma_f32_16x16x4f32(a[i], B[j][3][i] * z2, c2, 0, 0, 0); } } } while (0)
    RT_LOAD(bA, 0);
#pragma unroll
    for (int tb = 0; tb < 16; tb += 4) {
        RT_LOAD(bB, tb + 2); __builtin_amdgcn_sched_barrier(0); RT_COMP(bA); __builtin_amdgcn_sched_barrier(0);
        if (tb + 4 < 16) { RT_LOAD(bA, tb + 4); } __builtin_amdgcn_sched_barrier(0); RT_COMP(bB); __builtin_amdgcn_sched_barrier(0); }
#undef RT_LOAD
#undef RT_COMP
    ss += swz_xor16(ss); ss = swap32_add(ss);
    LAS float* my = sc + par * 800;
#pragma unroll
    for (int r = 0; r < 4; ++r) { const int row = 4 * kq + r; my[row * 48 + r16] = c0[r]; my[row * 48 + 16 + r16] = c1[r]; my[row * 48 + 32 + r16] = c2[r]; }
    if (lane < 16) my[768 + lane] = ss;
    LAS int* lcnt = (LAS int*)(ldsb + 4 * 32768 + 1024);
    if (threadIdx.x < 32) lcnt[threadIdx.x] = 0;
    int pa = 0, pb = 0, ea_ = 0, eb_ = 0; float w1_ = 0.f, w2_ = 0.f, rs_ = 0.f;
    LDS_WAIT();
    __syncthreads();
    ROUTE_MID_HOOK();
    if (par == 0 && lane < 16) {
        LAS const float* l0 = sc + lane * 48; LAS const float* l1 = sc + 800 + lane * 48;
        const float rs = __builtin_amdgcn_rsqf((sc[768 + lane] + sc[800 + 768 + lane]) * (1.0f / 1024.0f) + EPS);
#define LG(j) (l0[j] + l1[j])
        const int t = tile * 16 + lane;
        const float* bg = P.in[16]; const float* br = P.in[18];
        float gl[4]; int gs = 0; float gm;
#pragma unroll
        for (int j = 0; j < 4; ++j) gl[j] = LG(j) * rs + bg[j];
        gm = gl[0];
#pragma unroll
        for (int j = 1; j < 4; ++j) if (gl[j] > gm) { gm = gl[j]; gs = j; }
        float gsum = 0.f;
#pragma unroll
        for (int j = 0; j < 4; ++j) gsum += __expf(gl[j] - gm);
        const float psel = 1.0f / gsum;
        float e1 = -INFINITY, e2 = -INFINITY; int i1 = 0, i2 = 0;
#pragma unroll
        for (int j = 0; j < 8; ++j) {
            const float v = LG(4 + gs * 8 + j) * rs + br[gs * 8 + j];
            if (v > e1) { e2 = e1; i2 = i1; e1 = v; i1 = j; } else if (v > e2) { e2 = v; i2 = j; }
        }
        const float x2 = __expf(e2 - e1), w1 = psel / (1.0f + x2), w2 = psel * x2 / (1.0f + x2);
        const int ea = gs * 8 + i1, eb = gs * 8 + i2;
        pa = (int)__hip_atomic_fetch_add(lcnt + ea, 1, __ATOMIC_RELAXED, __HIP_MEMORY_SCOPE_WORKGROUP); pb = (int)__hip_atomic_fetch_add(lcnt + eb, 1, __ATOMIC_RELAXED, __HIP_MEMORY_SCOPE_WORKGROUP);
        ea_ = ea; eb_ = eb; w1_ = w1; w2_ = w2; rs_ = rs;
        ((int*)(P.ws + WS_TOKE))[2 * t] = ea; ((int*)(P.ws + WS_TOKE))[2 * t + 1] = eb;
        ((float*)(P.ws + WS_TOKW))[2 * t] = w1; ((float*)(P.ws + WS_TOKW))[2 * t + 1] = w2;
        ((float*)(P.ws + WS_RS2))[t] = rs;
#undef LG
    }
    LDS_WAIT();
    __syncthreads();
    if (threadIdx.x < 32) { const int c = lcnt[threadIdx.x];
        lcnt[32 + threadIdx.x] = c ? (int)atomicAdd((unsigned*)(P.ws + WS_CTL) + CW_CNT + 64 * threadIdx.x, (unsigned)c) : 0; }
    LDS_WAIT();
    __syncthreads();
    if (par == 0 && lane < 16) { const int t = tile * 16 + lane;
        const int qa = lcnt[32 + ea_] + pa, qb = lcnt[32 + eb_] + pb;
        ((int*)(P.ws + WS_TOKP))[2 * t] = qa; ((int*)(P.ws + WS_TOKP))[2 * t + 1] = qb;
        ((int*)(P.ws + WS_LIST))[ea_ * 16384 + qa] = t; ((int*)(P.ws + WS_LIST))[eb_ * 16384 + qb] = t;
        ((float*)(P.ws + WS_LISTW))[ea_ * 16384 + qa] = w1_; ((float*)(P.ws + WS_LISTW))[eb_ * 16384 + qb] = w2_;
        ((float*)(P.ws + WS_LISTRS))[ea_ * 16384 + qa] = rs_; ((float*)(P.ws + WS_LISTRS))[eb_ * 16384 + qb] = rs_; }
    LDS_WAIT();
    __syncthreads();
}

#ifndef P4A_REP
#define P4A_REP 0
#endif
template <int P4A_PART> DI void phase4a(const Params& P, LAS unsigned char* lds, int gw, int NGW, int wave, int lane) {
    LAS float* scr = (LAS float*)(lds + wave * 16384);
    if (P4A_PART & 1) for (int tile = (gw >> 1); tile < MTOK / 16; tile += (NGW >> 1)) route_tile(P, tile, wave & 1, (LAS float*)(lds + (wave >> 1) * 32768), lane, lds);
    if (!(P4A_PART & 2)) return;
    bf16_t* WGU = (bf16_t*)(P.ws + WS_WGU); bf16_t* WD = (bf16_t*)(P.ws + WS_WD);
    const float* wg = P.in[19]; const float* wu = P.in[20]; const float* wd = P.in[21]; const float* gf = P.in[14];
    constexpr int I_GU = 16 * 16, I_D = 4 * 32, NIT = 32 * (I_GU + I_D);
    struct TItem { const float* src; const float* gn; bf16_t* dst; int stride, ldk; };
    auto mk = [&](int it) { TItem d; const int e = it / (I_GU + I_D), r = it % (I_GU + I_D);
        if (r < I_GU) { const int n0 = (r & 15) * 32, j = n0 >> 8, up = (n0 >> 7) & 1, k0 = (r >> 4) * 64;
            d.src = (up ? wu : wg) + (size_t)e * 1024 * 256 + (size_t)k0 * 256 + 128 * j + (n0 & 127); d.gn = gf + k0; d.stride = 256; d.ldk = 1024;
            d.dst = WGU + (size_t)e * 512 * 1024 + (size_t)n0 * 1024 + k0; }
        else { const int r2 = r - I_GU, k0 = (r2 >> 5) * 64, n0 = (r2 & 31) * 32;
            d.src = wd + (size_t)e * 256 * 1024 + (size_t)k0 * 1024 + n0; d.gn = nullptr; d.stride = 1024; d.ldk = 256;
            d.dst = WD + (size_t)e * 1024 * 256 + (size_t)n0 * 256 + k0; }
        return d; };
#define TI_LOAD(D, V, GV) do { if (D.gn) { GV[0] = *(const f32x4*)(D.gn + 8 * (lane & 7)); GV[1] = *(const f32x4*)(D.gn + 8 * (lane & 7) + 4); } else { GV[0] = (f32x4){1.f, 1.f, 1.f, 1.f}; GV[1] = GV[0]; } \
        _Pragma("unroll") for (int i = 0; i < 32; ++i) { const int kk = 2 * i + (lane >> 5); V[i] = D.src[(size_t)kk * D.stride + (lane & 31)]; } } while (0)
#define TI_FIN(D, V, GV) do { _Pragma("unroll") for (int i = 0; i < 32; ++i) scr[(2 * i + (lane >> 5)) * 33 + (lane & 31)] = V[i]; \
        LDS_WAIT(); const int c_ = lane & 7; \
        _Pragma("unroll") for (int j = 0; j < 4; ++j) { const int n_ = (lane >> 3) + 8 * j; const LAS float* s_ = scr + (8 * c_) * 33 + n_; \
            u32x4 o_; o_.x = pk2(s_[0 * 33] * GV[0][0], s_[1 * 33] * GV[0][1]); o_.y = pk2(s_[2 * 33] * GV[0][2], s_[3 * 33] * GV[0][3]); o_.z = pk2(s_[4 * 33] * GV[1][0], s_[5 * 33] * GV[1][1]); o_.w = pk2(s_[6 * 33] * GV[1][2], s_[7 * 33] * GV[1][3]); \
            *(u32x4*)(D.dst + (size_t)n_ * D.ldk + 8 * c_) = o_; } \
        LDS_WAIT(); } while (0)
    for (int rp_ = 0; rp_ < (P4A_REP ? 2 : 1); ++rp_) {
        float va[32], vb[32]; f32x4 ga[2], gb[2];
        int it = gw;
        if (it < NIT) { TItem da = mk(it); TI_LOAD(da, va, ga);
            for (;;) {
                const int itb = it + NGW; TItem db = da; const bool hb = itb < NIT;
                if (hb) { db = mk(itb); TI_LOAD(db, vb, gb); }
                TI_FIN(da, va, ga);
                if (!hb) break;
                it = itb + NGW; const bool ha = it < NIT;
                if (ha) { da = mk(it); TI_LOAD(da, va, ga); }
                TI_FIN(db, vb, gb);
                if (!ha) break;
            }
        }
    }
#undef TI_LOAD
#undef TI_FIN
}

DI void expert_layout(const Params& P, int lane, int& cnt, int& base, int& tend) {
    const unsigned* c = (const unsigned*)(P.ws + WS_CTL) + CW_CNT;
    cnt = (lane < 32) ? (int)__hip_atomic_load(c + 64 * lane, __ATOMIC_RELAXED, __HIP_MEMORY_SCOPE_AGENT) : 0;
    const int tiles = (cnt + 255) >> 8;
    int inc = 0;
#pragma unroll
    for (int i = 0; i < 32; ++i) { const int ti = __builtin_amdgcn_readlane(tiles, i); inc += (i <= lane) ? ti : 0; }
    tend = inc; base = (inc - tiles) << 8;
}

DI void phase4b(const Params& P, int gw, int NGW, int lane) {
    int cnt, base, tend; expert_layout(P, lane, cnt, base, tend);
    bf16_t* XS = (bf16_t*)(P.ws + WS_XS); float* SLOTW = (float*)(P.ws + WS_SLOTW);
    const int* TOKE = (const int*)(P.ws + WS_TOKE); const float* TOKW = (const float*)(P.ws + WS_TOKW); int* TOKP = (int*)(P.ws + WS_TOKP); const float* RS2 = (const float*)(P.ws + WS_RS2);
    for (int t = gw; t < MTOK; t += NGW) {
        const f32x4* hr = (const f32x4*)(P.out + (size_t)t * 1024);
        const float rs = RS2[t];
        u32x2 w[4];
#pragma unroll
        for (int j = 0; j < 4; ++j) { const f32x4 v = hr[64 * j + lane]; w[j] = (u32x2){pk2(v.x * rs, v.y * rs), pk2(v.z * rs, v.w * rs)}; }
#pragma unroll
        for (int k = 0; k < 2; ++k) {
            const int e = __builtin_amdgcn_readfirstlane(TOKE[2 * t + k]), slot = __builtin_amdgcn_readlane(base, e) + TOKP[2 * t + k];
            u32x2* orow = (u32x2*)(XS + (size_t)slot * 1024);
#pragma unroll
            for (int j = 0; j < 4; ++j) orow[64 * j + lane] = w[j];
            if (lane == 0) { SLOTW[slot] = TOKW[2 * t + k]; TOKP[2 * t + k] = slot; }
        }
    }
    for (int e = 0; e < 32; ++e) {
        const int ce = __builtin_amdgcn_readlane(cnt, e), be = __builtin_amdgcn_readlane(base, e), end = be + (((ce + 255) >> 8) << 8);
        for (int r = be + ce + gw; r < end; r += NGW) { u32x2* orow = (u32x2*)(XS + (size_t)r * 1024);
#pragma unroll
            for (int j = 0; j < 4; ++j) orow[64 * j + lane] = (u32x2){0u, 0u};
            if (lane == 0) SLOTW[r] = 0.f; }
    }
}

#define XCD_ORDER(blk_, G_) ((((G_) & 7) == 0) ? ((blk_) & 7) * ((G_) >> 3) + ((blk_) >> 3) : (blk_))
struct GroupedOrder {
    int tend; int total; int G, c, NS; int cnt, base; const int* LIST;
    DI unsigned rowoff(const pg8::Unit& u, int r) const {
        const int e = __builtin_amdgcn_readfirstlane(u.pn >> NS), ce = __builtin_amdgcn_readlane(cnt, e), t0 = __builtin_amdgcn_readlane(base, e) >> 8;
        const int pos = (u.pm - t0) * 256 + r;
        const int tok = pos < ce ? LIST[e * 16384 + pos] : 0;
        return (unsigned)tok * 2048u;
    }
    DI bool next(int i, pg8::Unit& u) const {
        const int L = i * G + c; if (L >= (total << NS)) return false;
        const int mt = L >> NS, j = L & ((1 << NS) - 1);
        const int e = __builtin_popcountll(__ballot(((int)(threadIdx.x & 63) < 32) && tend <= mt));
        u.pm = mt; u.pn = (e << NS) + j; return true;
    }
    DI void a_ready(const pg8::Unit&) const {}
    DI void done(const pg8::Unit&) const {}
};
struct EpiGateUp {
    static constexpr bool PERM = true, AFTER_DRAIN = false;
    const float* LISTW; const float* LISTRS; bf16_t* YS; int cnt, base;
    DI void operator()(const pg8::f32x4 (&acc)[2][2][4][2], const pg8::Unit& u, int wr, int wc, int fr, int fq) const {
        const int f0 = (u.pn & 1) * 128 + wc * 32 + fq * 8;
        const int e = __builtin_amdgcn_readfirstlane(u.pn >> 1), ce = __builtin_amdgcn_readlane(cnt, e), t0 = __builtin_amdgcn_readlane(base, e) >> 8;
        float cwv[2][4], rsv[2][4];
#pragma unroll
        for (int ai = 0; ai < 2; ++ai)
#pragma unroll
            for (int m = 0; m < 4; ++m) { const int pos = (u.pm - t0) * 256 + ai * 128 + wr * 64 + m * 16 + fr; const bool ok = pos < ce;
                cwv[ai][m] = ok ? LISTW[e * 16384 + pos] : 0.f; rsv[ai][m] = ok ? LISTRS[e * 16384 + pos] : 0.f; }
        __builtin_amdgcn_sched_barrier(0);
#pragma unroll
        for (int ai = 0; ai < 2; ++ai)
#pragma unroll
            for (int m = 0; m < 4; ++m) {
                const int r = ai * 128 + wr * 64 + m * 16 + fr, row = u.pm * 256 + r;
                const float rs = rsv[ai][m], cr = cwv[ai][m] * rs;
                float a[8];
#pragma unroll
                for (int i = 0; i < 4; ++i) {
                    const float g0 = acc[ai][0][m][0][i] * rs, g1 = acc[ai][0][m][1][i] * rs;
                    a[i] = g0 * __builtin_amdgcn_rcpf(1.0f + __expf(-g0)) * acc[ai][1][m][0][i] * cr; a[4 + i] = g1 * __builtin_amdgcn_rcpf(1.0f + __expf(-g1)) * acc[ai][1][m][1][i] * cr;
                }
                *(u32x4*)(YS + (size_t)row * 256 + f0) = (u32x4){pk2(a[0], a[1]), pk2(a[2], a[3]), pk2(a[4], a[5]), pk2(a[6], a[7])};
            }
    }
};
struct EpiDown {
    static constexpr bool PERM = true, AFTER_DRAIN = false;
    bf16_t* YO;
    DI void operator()(const pg8::f32x4 (&acc)[2][2][4][2], const pg8::Unit& u, int wr, int wc, int fr, int fq) const {
        const int c0 = (u.pn & 3) * 256 + wc * 32 + fq * 8;
#pragma unroll
        for (int ai = 0; ai < 2; ++ai)
#pragma unroll
            for (int m = 0; m < 4; ++m) {
                bf16_t* rowp = YO + (size_t)(u.pm * 256 + ai * 128 + wr * 64 + m * 16 + fr) * 1024 + c0;
#pragma unroll
                for (int bj = 0; bj < 2; ++bj) { const pg8::f32x4 v0 = acc[ai][bj][m][0], v1 = acc[ai][bj][m][1];
                    *(u32x4*)(rowp + bj * 128) = (u32x4){pk2(v0[0], v0[1]), pk2(v0[2], v0[3]), pk2(v1[0], v1[1]), pk2(v1[2], v1[3])}; }
            }
    }
};

DI void phase7(const Params& P, int gw, int NGW, int lane) {
    int cnt_, base_, tend_; expert_layout(P, lane, cnt_, base_, tend_);
    const bf16_t* YO = (const bf16_t*)(P.ws + WS_YO); const int* TOKP = (const int*)(P.ws + WS_TOKP); const int* TOKE = (const int*)(P.ws + WS_TOKE); const f32x4* nf = (const f32x4*)P.in[22];
    f32x4 nfv[4];
#pragma unroll
    for (int j = 0; j < 4; ++j) nfv[j] = nf[64 * j + lane];
    for (int t0 = gw; t0 < MTOK; t0 += 2 * NGW) {
        f32x4 v[2][4]; u32x2 hv[2][4], ya[2][4], yb[2][4];
#pragma unroll
        for (int r = 0; r < 2; ++r) { const int t = (t0 + r * NGW) < MTOK ? (t0 + r * NGW) : t0;
            const u32x2* hr = (const u32x2*)((const bf16_t*)(P.ws + WS_U2) + (size_t)t * 1024);
            const int e0 = __builtin_amdgcn_readfirstlane(TOKE[2 * t]), e1 = __builtin_amdgcn_readfirstlane(TOKE[2 * t + 1]);
            const int s0 = __builtin_amdgcn_readlane(base_, e0) + TOKP[2 * t], s1 = __builtin_amdgcn_readlane(base_, e1) + TOKP[2 * t + 1];
            const u32x2* y0 = (const u32x2*)(YO + (size_t)s0 * 1024); const u32x2* y1 = (const u32x2*)(YO + (size_t)s1 * 1024);
#pragma unroll
            for (int j = 0; j < 4; ++j) { hv[r][j] = hr[64 * j + lane]; ya[r][j] = y0[64 * j + lane]; yb[r][j] = y1[64 * j + lane]; } }
#pragma unroll
        for (int r = 0; r < 2; ++r) { const int t = t0 + r * NGW;
            if (t < MTOK) {
                float s = 0.f;
#pragma unroll
                for (int j = 0; j < 4; ++j) { const u32x2 a = ya[r][j], c = yb[r][j], hq = hv[r][j];
                    v[r][j] = (f32x4){__uint_as_float(hq.x << 16), __uint_as_float(hq.x & 0xffff0000u), __uint_as_float(hq.y << 16), __uint_as_float(hq.y & 0xffff0000u)};
                    v[r][j].x += __uint_as_float(a.x << 16) + __uint_as_float(c.x << 16); v[r][j].y += __uint_as_float(a.x & 0xffff0000u) + __uint_as_float(c.x & 0xffff0000u);
                    v[r][j].z += __uint_as_float(a.y << 16) + __uint_as_float(c.y << 16); v[r][j].w += __uint_as_float(a.y & 0xffff0000u) + __uint_as_float(c.y & 0xffff0000u);
                    s += (v[r][j].x * v[r][j].x + v[r][j].y * v[r][j].y) + (v[r][j].z * v[r][j].z + v[r][j].w * v[r][j].w); }
                s = wave_sum(s);
                const float rs = __builtin_amdgcn_rsqf(s * (1.0f / 1024.0f) + EPS);
                f32x4* hw = (f32x4*)(P.out + (size_t)t * 1024);
#pragma unroll
                for (int j = 0; j < 4; ++j) hw[64 * j + lane] = v[r][j] * rs * nfv[j];
            } }
    }
}

struct EpiNull { static constexpr bool PERM = true, AFTER_DRAIN = false; float* d;
    DI void operator()(const pg8::f32x4 (&acc)[2][2][4][2], const pg8::Unit& u, int wr, int wc, int fr, int fq) const {
        pg8::f32x4 s = acc[0][0][0][0];
#pragma unroll
        for (int ai = 0; ai < 2; ++ai)
#pragma unroll
            for (int bj = 0; bj < 2; ++bj)
#pragma unroll
                for (int m = 0; m < 4; ++m)
#pragma unroll
                    for (int n = 0; n < 2; ++n) s += acc[ai][bj][m][n];
        if (s[0] == 12345.678f) d[threadIdx.x] = s[1] + s[2] + s[3]; } };
#ifndef PHMASK
#define PHMASK 2047
#endif
#ifndef P1_STAGGER_TICKS
#define P1_STAGGER_TICKS 0
#endif
#ifndef ATT_VAR
#define ATT_VAR 0
#endif
#ifndef REPMASK
#define REPMASK 0
#endif
#define REP(bit) for (int rep_ = 0; rep_ < ((REPMASK & (bit)) ? 2 : 1); ++rep_)
#define REPSYNC(bit) if ((REPMASK & (bit)) && rep_ == 0) GRID_BAR()
typedef const __attribute__((address_space(4))) Params* KParams;
DI Params load_params(KParams kp) { Params p;
#pragma unroll
    for (int i = 0; i < 23; ++i) p.in[i] = kp->in[i];
    p.out = kp->out; p.ws = kp->ws; return p; }
__global__ void __launch_bounds__(NTHREADS, 2) hymba_fwd(Params Pin) {
    extern __shared__ __attribute__((aligned(16))) unsigned char lds_raw[];
    LAS unsigned char* lds = (LAS unsigned char*)lds_raw;
    cg::grid_group grid = cg::this_grid();
    volatile LAS unsigned* bst = (volatile LAS unsigned*)(lds + LDS_BYTES - 64);
    if (threadIdx.x < 2) bst[threadIdx.x] = 0u;
    __syncthreads();
    const XcdBarrier xbar = xcd_barrier_post((unsigned*)(Pin.ws + WS_CTL) + CW_BAR, bst);
#ifndef TPROBE
#define TPROBE (-1)
#endif
#ifndef TPROBE_A
#define TPROBE_A TPROBE
#define TPROBE_B (TPROBE + 1)
#endif
    int nstamp_ = 0;
#define STAMP() do { if (TPROBE >= 0) { if (blockIdx.x == 0 && threadIdx.x == 0) __hip_atomic_store((unsigned long long*)(Pin.ws + WS_CTL + 65536) + nstamp_, (unsigned long long)__builtin_amdgcn_s_memrealtime(), __ATOMIC_RELAXED, __HIP_MEMORY_SCOPE_AGENT); ++nstamp_; } } while (0)
#define GRID_BAR() do { xcd_barrier(xbar); STAMP(); } while (0)
    STAMP();
    const int G = gridDim.x, blk = blockIdx.x, NGW = G * NWAVES, NGT = G * NTHREADS;
#define PHASE_IDS() KParams kp_ = (KParams)__builtin_amdgcn_kernarg_segment_ptr(); asm volatile("" : "+s"(kp_)); const Params P = load_params(kp_); int tid = threadIdx.x; asm volatile("" : "+v"(tid)); const int lane = tid & 63, wave = __builtin_amdgcn_readfirstlane(tid >> 6), gw = blk * NWAVES + wave, gtid = blk * NTHREADS + tid; (void)lane; (void)gw; (void)gtid; (void)wave

    REP(1) { if (PHMASK & 1) { PHASE_IDS(); phase0(P, lds, gw, NGW, gtid, NGT, wave, lane); } REPSYNC(1); }
    GRID_BAR();
#ifdef P1_EV
#define P1_PASS(DM) { PHASE_IDS(); \
        pg8::Gemm g{(const bf16_t*)(P.ws + WS_XB), (const bf16_t*)(P.ws + WS_WINT), MROWS, NPROJ, 1024}; \
        pg8::StaticOrder S; S.init(MROWS, NPROJ, G, blk); \
        EpiInProjT<P1_EV> E{(const float*)(P.ws + WS_RS1), (const float*)(P.ws + WS_COS), (const float*)(P.ws + WS_SIN), P.in[10], P.in[11], \
                    (bf16_t*)(P.ws + WS_QB), (bf16_t*)(P.ws + WS_KT), (bf16_t*)(P.ws + WS_VT), (bf16_t*)(P.ws + WS_QKVB), (bf16_t*)(P.ws + WS_ZB), (float*)(P.ws + WS_GB), P.ws + 248 * MiB, DM, (unsigned long long*)(P.ws + WS_CTL + 65536) + 40}; \
        pg8::gemm_phase<EpiInProjT<P1_EV>, pg8::StaticOrder, true, true>(lds, g, S, E); } GRID_BAR();
    P1_PASS(0)
    P1_PASS(1)
#else
    REP(2) { if (PHMASK & 2) { PHASE_IDS();
        pg8::Gemm g{(const bf16_t*)(P.ws + WS_XB), (const bf16_t*)(P.ws + WS_WINT), MROWS, NPROJ, 1024};
        if (P1_STAGGER_TICKS > 0 && (blk & 1)) { const unsigned long long s0_ = __builtin_amdgcn_s_memrealtime(); while (__builtin_amdgcn_s_memrealtime() - s0_ < (unsigned long long)P1_STAGGER_TICKS) __builtin_amdgcn_s_sleep(8); }
        pg8::StaticOrder S; S.init(MROWS, NPROJ, G, blk);
#ifdef P1_EV
        EpiInProjT<P1_EV> E{(const float*)(P.ws + WS_RS1), (const float*)(P.ws + WS_COS), (const float*)(P.ws + WS_SIN), P.in[10], P.in[11],
                    (bf16_t*)(P.ws + WS_QB), (bf16_t*)(P.ws + WS_KT), (bf16_t*)(P.ws + WS_VT), (bf16_t*)(P.ws + WS_QKVB), (bf16_t*)(P.ws + WS_ZB), (float*)(P.ws + WS_GB), P.ws + 248 * MiB, rep_, (unsigned long long*)(P.ws + WS_CTL + 65536) + 40};
        pg8::gemm_phase<EpiInProjT<P1_EV>, pg8::StaticOrder, true, true>(lds, g, S, E);
#else
        EpiInProj E{(const float*)(P.ws + WS_RS1), (const float*)(P.ws + WS_COS), (const float*)(P.ws + WS_SIN), P.in[10], P.in[11],
                    (bf16_t*)(P.ws + WS_QB), (bf16_t*)(P.ws + WS_KT), (bf16_t*)(P.ws + WS_VT), (bf16_t*)(P.ws + WS_QKVB), (bf16_t*)(P.ws + WS_ZB), (float*)(P.ws + WS_GB), P.ws + 248 * MiB, 0, (unsigned long long*)(P.ws + WS_CTL + 65536) + 40};
        if (rep_ == 0) pg8::gemm_phase<EpiInProj, pg8::StaticOrder, true, true>(lds, g, S, E);
        else { EpiNull EN{(float*)(P.ws + WS_DUMP)}; pg8::gemm_phase<EpiNull, pg8::StaticOrder, true, true>(lds, g, S, EN); }
#endif
    } REPSYNC(2); }
    GRID_BAR();
#endif
    REP(4) { if (PHMASK & 4) { PHASE_IDS(); gdn_prep_phase(P, lds, blk, G, wave, lane); } REPSYNC(4); }
    {
        unsigned* prep = (unsigned*)(Pin.ws + WS_CTL) + CW_PREP;
        asm volatile("s_waitcnt vmcnt(0)" ::: "memory");
        __syncthreads();
        if (threadIdx.x == 0) { __builtin_amdgcn_fence(__ATOMIC_RELEASE, "agent"); asm volatile("s_waitcnt vmcnt(0)" ::: "memory");
            __hip_atomic_fetch_add(prep, 1u, __ATOMIC_RELAXED, __HIP_MEMORY_SCOPE_AGENT); }
        if (blk < 16) {
            if (threadIdx.x == 0) { unsigned sp = 0;
                while (__hip_atomic_load(prep, __ATOMIC_RELAXED, __HIP_MEMORY_SCOPE_AGENT) < (unsigned)G) { __builtin_amdgcn_s_sleep(2); if (++sp > (1u << 22)) break; }
                __builtin_amdgcn_fence(__ATOMIC_ACQUIRE, "agent"); asm volatile("s_waitcnt vmcnt(0)" ::: "memory"); }
            __syncthreads();
        }
    }
    REP(8) { if ((PHMASK & 8) && blk < 16) { PHASE_IDS(); gdn_scan(P, lds, blk, tid, wave, lane); } }
    REP(16) {
    if (PHMASK & 16) { PHASE_IDS(); if (rep_ == 0) attn_phase<0>(P, lds, tid, wave, lane); else attn_phase<ATT_VAR>(P, lds, tid, wave, lane); }
    if ((REPMASK & 16) && rep_ == 0) { GRID_BAR(); if (blk == 0 && threadIdx.x < 8) { PHASE_IDS(); __hip_atomic_store((unsigned*)(P.ws + WS_CTL) + CW_ATTQ + 64 * threadIdx.x, 0u, __ATOMIC_RELAXED, __HIP_MEMORY_SCOPE_AGENT); } GRID_BAR(); }
    }
    GRID_BAR();
    REP(32) { if (PHMASK & 32) { PHASE_IDS();
        pg8::Gemm g{(const bf16_t*)(P.ws + WS_MIX), (const bf16_t*)(P.ws + WS_WOUT), MTOK, 1024, 1024};
        pg8::StaticOrder S; S.init(MTOK, 1024, G, blk);
        EpiOutProj E{P.in[0], P.out, (bf16_t*)(P.ws + WS_U2)};
        pg8::gemm_phase<EpiOutProj, pg8::StaticOrder, true, true>(lds, g, S, E);
    } REPSYNC(32); }
    GRID_BAR();
#ifdef P4A_SPLIT
    if (PHMASK & 64) { PHASE_IDS(); phase4a<1>(P, lds, gw, NGW, wave, lane); }
    GRID_BAR();
    if (PHMASK & 64) { PHASE_IDS(); phase4a<2>(P, lds, gw, NGW, wave, lane); }
#else
    if (PHMASK & 64) { PHASE_IDS(); phase4a<3>(P, lds, gw, NGW, wave, lane); }
#endif
    GRID_BAR();
    int cnt, base, tend, total; { PHASE_IDS(); expert_layout(P, lane, cnt, base, tend); total = __builtin_amdgcn_readlane(tend, 31); }
    REP(256) { if (PHMASK & 256) { PHASE_IDS();
        pg8::Gemm g{(const bf16_t*)(P.ws + WS_U2), (const bf16_t*)(P.ws + WS_WGU), XS_ROWS, 32 * 512, 1024};
        GroupedOrder S{tend, total, G, XCD_ORDER(blk, G), 1, cnt, base, (const int*)(P.ws + WS_LIST)};
        EpiGateUp E{(const float*)(P.ws + WS_LISTW), (const float*)(P.ws + WS_LISTRS), (bf16_t*)(P.ws + WS_YS), cnt, base};
        pg8::gemm_phase_g<EpiGateUp, GroupedOrder, true, true>(lds, g, S, E);
    } REPSYNC(256); }
    GRID_BAR();
    REP(512) { if (PHMASK & 512) { PHASE_IDS();
        int kd = 256; asm volatile("" : "+s"(kd));
        pg8::Gemm g{(const bf16_t*)(P.ws + WS_YS), (const bf16_t*)(P.ws + WS_WD), XS_ROWS, 32 * 1024, kd};
        GroupedOrder S{tend, total, G, XCD_ORDER(blk, G), 2, cnt, base, (const int*)(P.ws + WS_LIST)};
        EpiDown E{(bf16_t*)(P.ws + WS_YO)};
        pg8::gemm_phase<EpiDown, GroupedOrder, true, true>(lds, g, S, E);
    } REPSYNC(512); }
    GRID_BAR();
    if (PHMASK & 1024) { PHASE_IDS(); phase7(P, gw, NGW, lane); }
    if (TPROBE >= 0) {
        GRID_BAR();
        const unsigned long long* st = (const unsigned long long*)(Pin.ws + WS_CTL + 65536);
        const unsigned long long t0 = __hip_atomic_load(st + TPROBE_A, __ATOMIC_RELAXED, __HIP_MEMORY_SCOPE_AGENT), t1 = __hip_atomic_load(st + TPROBE_B, __ATOMIC_RELAXED, __HIP_MEMORY_SCOPE_AGENT);
        const unsigned long long dt = (t1 - t0) * 4ull, s0 = __builtin_amdgcn_s_memrealtime();
        while (__builtin_amdgcn_s_memrealtime() - s0 < dt) __builtin_amdgcn_s_sleep(8);
    }
}

extern "C" void kernel_launch(void* const* d_in, const int* in_sizes, int n_in, void* d_out, int out_size, void* d_ws, size_t ws_size, hipStream_t stream) {
    static int grid_blocks = 0;
    if (grid_blocks == 0) {
        if (n_in != 23 || out_size != MTOK * DMODEL || ws_size < WS_END) { fprintf(stderr, "kernel_launch: unexpected shapes (n_in %d out %d ws %zu)\n", n_in, out_size, ws_size); grid_blocks = -1; return; }
        int dev = 0, cus = 0, per_cu = 0;
        hipGetDevice(&dev);
        hipDeviceGetAttribute(&cus, hipDeviceAttributeMultiprocessorCount, dev);
        hipFuncSetAttribute((const void*)hymba_fwd, hipFuncAttributeMaxDynamicSharedMemorySize, LDS_BYTES);
        hipOccupancyMaxActiveBlocksPerMultiprocessor(&per_cu, (const void*)hymba_fwd, NTHREADS, LDS_BYTES);
        if (per_cu < 1) { fprintf(stderr, "kernel_launch: occupancy query says %d blocks/CU\n", per_cu); per_cu = 1; }
        grid_blocks = cus;
        (void)hipGetLastError();
    }
    if (grid_blocks < 0) return;
    hipMemsetAsync((char*)d_ws + WS_CTL, 0, CTL_BYTES, stream);
    Params p{};
    for (int i = 0; i < 23; ++i) p.in[i] = (const float*)d_in[i];
    p.out = (float*)d_out; p.ws = (unsigned char*)d_ws;
    void* args[] = {&p};
    hipError_t e = hipLaunchCooperativeKernel((const void*)hymba_fwd, dim3(grid_blocks), dim3(NTHREADS), args, LDS_BYTES, stream);
    if (e != hipSuccess) fprintf(stderr, "cooperative launch failed: %s (grid %d)\n", hipGetErrorString(e), grid_blocks);
}
```

```cpp
#include <hip/hip_runtime.h>
#include <hip/hip_cooperative_groups.h>
#include <cstdio>
#include <cstdint>
namespace cg = cooperative_groups;
#ifndef PG8_EPI_AGAIN
#define PG8_EPI_AGAIN(x) do {} while (0)
#endif
namespace pg8 {
#define PG8_LAS __attribute__((address_space(3)))
typedef unsigned short bf16_t;
typedef short bf16x8 __attribute__((ext_vector_type(8)));
typedef float f32x4 __attribute__((ext_vector_type(4)));
typedef unsigned u32x4 __attribute__((ext_vector_type(4)));
constexpr int BM = 256, BK = 64, HALF = 128, HTB = HALF * BK * 2  , STAGE_BYTES = 8 * HTB, NXCD = 8, WGM = 8;

__host__ __device__ __forceinline__ int lds_byte(int r, int c) { const int st = (r >> 4) * 2 + (c >> 5), rr = r & 15, cc = c & 31, ob = rr * 64 + cc * 2; return st * 1024 + (ob ^ (((ob >> 9) & 1) << 5)); }
__host__ __device__ __forceinline__ void stage_rc(int b, int& R, int& C) { const int st = b / 1024, sb = b % 1024, swz = sb ^ (((sb >> 9) & 1) << 5); R = (st >> 1) * 16 + swz / 64; C = (st & 1) * 32 + (swz % 64) / 2; }
__host__ __device__ __forceinline__ int perm32(int rho) { const int n = rho >> 4, i = rho & 15; return 8 * (i >> 2) + 4 * n + (i & 3); }

template <class T, class = void> struct epi_timed { static constexpr bool v = false; };
template <class T> struct epi_timed<T, decltype((void)T::TIMED)> { static constexpr bool v = true; };
#ifndef PG8_TBLK
#define PG8_TBLK 0
#define PG8_TTID 0
#endif
struct Unit { int pm, pn; };
struct Gemm { const bf16_t* A; const bf16_t* Bt; int M, N, K; };

struct StaticOrder {
    int nM, nN, nwg, G, c;
    __host__ __device__ void init(int M, int N, int G_, int c_) { nM = M / BM; nN = N / BM; nwg = nM * nN; G = G_; c = c_; }
    __host__ __device__ bool next(int i, Unit& u) const {
        const long L = (long)i * G + c; if (L >= nwg) return false;
        int wgid = (int)L; { const int q = nwg / NXCD, r = nwg % NXCD, xcd = wgid % NXCD, off = wgid / NXCD; wgid = (xcd < r ? xcd * (q + 1) : r * (q + 1) + (xcd - r) * q) + off; }
        const int nig = WGM * nN, gid = wgid / nig, fm = gid * WGM, gsz = (nM - fm) < WGM ? (nM - fm) : WGM;
        u.pm = fm + ((wgid % nig) % gsz); u.pn = (wgid % nig) / gsz; return true;
    }
    __device__ __forceinline__ void a_ready(const Unit&) const {}
    __device__ __forceinline__ void done(const Unit&) const {}
};

__device__ __forceinline__ unsigned cvt_pk_bf16(float lo, float hi) { unsigned r; asm volatile("v_cvt_pk_bf16_f32 %0, %1, %2" : "=v"(r) : "v"(lo), "v"(hi)); return r; }
typedef float f32x2 __attribute__((ext_vector_type(2)));
template <class Epi, class Sched, bool ALIGN_EPI = false, bool SP2 = false>
__device__ __forceinline__ void gemm_phase(PG8_LAS unsigned char* lds, const Gemm g, const Sched& S, const Epi& E) {
    int tid_o = threadIdx.x; asm volatile("" : "+v"(tid_o));
    const int tid = tid_o, wid = __builtin_amdgcn_readfirstlane(tid >> 6), lane = tid & 63, wr = wid >> 2, wc = wid & 3, fr = lane & 15, fq = lane >> 4;
    const int K = g.K, nt = K / BK;
    unsigned voffA[2], voffB[2];
#pragma unroll
    for (int i = 0; i < 2; ++i) { int R, C; stage_rc(tid * 16 + i * 8192, R, C); const int Rb = Epi::PERM ? ((R & ~31) + perm32(R & 31)) : R;
        voffA[i] = (unsigned)(R * K + C) * 2u; voffB[i] = (unsigned)(Rb * K + C) * 2u; }
    const size_t kstep = (size_t)(BK * 2);
    const size_t hstep = (size_t)HALF * K * 2;
    const size_t tstep = 2 * hstep;
    const unsigned ldsw = (unsigned)wid * 1024u;
    const int aoff = lds_byte(wr * 64 + fr, fq * 8), boff = lds_byte(wc * 32 + fr, fq * 8);
#define PG8_SA(b, h) (((b) * 2 + (h)) * HTB)
#define PG8_SB(b, h) ((4 + (b) * 2 + (h)) * HTB)
#define PG8_STAGE(bufoff, gbase, voff) do { _Pragma("unroll") for (int _i = 0; _i < 2; ++_i) \
        __builtin_amdgcn_global_load_lds((const unsigned*)((const char*)(gbase) + (voff)[_i]), (PG8_LAS unsigned*)(lds + (bufoff) + ldsw + _i * 8192), 16, 0, 0); } while (0)
#define PG8_LDA(dst, b, h) do { _Pragma("unroll") for (int m = 0; m < 4; ++m) _Pragma("unroll") for (int k = 0; k < 2; ++k) dst[m][k] = *(const PG8_LAS bf16x8*)(lds + PG8_SA(b, h) + aoff + m * 2048 + k * 1024); } while (0)
#define PG8_LDB(dst, b, h) do { _Pragma("unroll") for (int n = 0; n < 2; ++n) _Pragma("unroll") for (int k = 0; k < 2; ++k) dst[n][k] = *(const PG8_LAS bf16x8*)(lds + PG8_SB(b, h) + boff + n * 2048 + k * 1024); } while (0)
#define PG8_MMA(ai, bj, At, Bt) do { __builtin_amdgcn_s_setprio(1); _Pragma("unroll") for (int m = 0; m < 4; ++m) _Pragma("unroll") for (int n = 0; n < 2; ++n) _Pragma("unroll") for (int k = 0; k < 2; ++k) \
        acc[ai][bj][m][n] = __builtin_amdgcn_mfma_f32_16x16x32_bf16(Bt[n][k], At[m][k], acc[ai][bj][m][n], 0, 0, 0); __builtin_amdgcn_s_setprio(0); } while (0)
#define PG8_WAIT_V(n) asm volatile("s_waitcnt vmcnt(" #n ")" ::: "memory")
#define PG8_WAIT_L(n) asm volatile("s_waitcnt lgkmcnt(" #n ")" ::: "memory")
#define PG8_BAR __builtin_amdgcn_s_barrier()
#define PG8_SCHED __builtin_amdgcn_sched_barrier(0)
    Unit cur, nxt; int ui = 0;
    if (!S.next(0, cur)) return;
    f32x4 acc[2][2][4][2];
#pragma unroll
    for (int a = 0; a < 2; ++a)
#pragma unroll
        for (int b = 0; b < 2; ++b)
#pragma unroll
            for (int m = 0; m < 4; ++m)
#pragma unroll
                for (int n = 0; n < 2; ++n) acc[a][b][m][n] = (f32x4){0.f, 0.f, 0.f, 0.f};
    bf16x8 At[4][2], B0[2][2], B1[2][2];
    const char* cA = (const char*)g.A + (size_t)cur.pm * tstep; const char* cB = (const char*)g.Bt + (size_t)cur.pn * tstep;
    S.a_ready(cur);
    if constexpr (SP2) {
        PG8_STAGE(PG8_SB(0, 0), cB, voffB); PG8_STAGE(PG8_SB(0, 1), cB + hstep, voffB); PG8_STAGE(PG8_SA(0, 0), cA, voffA); PG8_STAGE(PG8_SA(0, 1), cA + hstep, voffA);
        if (wr == 1) PG8_BAR;
        PG8_WAIT_V(2); PG8_BAR;
        PG8_STAGE(PG8_SB(1, 0), cB + kstep, voffB); PG8_STAGE(PG8_SA(1, 0), cA + kstep, voffA); PG8_STAGE(PG8_SB(1, 1), cB + hstep + kstep, voffB);
        PG8_WAIT_V(6); PG8_BAR;
    } else {
        PG8_STAGE(PG8_SB(0, 0), cB, voffB); PG8_STAGE(PG8_SA(0, 0), cA, voffA); PG8_STAGE(PG8_SB(0, 1), cB + hstep, voffB); PG8_STAGE(PG8_SA(0, 1), cA + hstep, voffA);
        if (wr == 1) PG8_BAR;
        PG8_WAIT_V(4); PG8_BAR;
        PG8_STAGE(PG8_SB(1, 0), cB + kstep, voffB); PG8_STAGE(PG8_SA(1, 0), cA + kstep, voffA); PG8_STAGE(PG8_SB(1, 1), cB + hstep + kstep, voffB);
        PG8_WAIT_V(6); PG8_BAR;
    }
#ifdef PG8_TSEL
    unsigned long long tsum_ = 0;
#endif
    for (;;) {
        const bool has_next = S.next(ui + 1, nxt);
        const char* nA = has_next ? (const char*)g.A + (size_t)nxt.pm * tstep : cA; const char* nB = has_next ? (const char*)g.Bt + (size_t)nxt.pn * tstep : cB;
        for (int t = 0; t < nt; t += 2) {
            const bool last = (t == nt - 2);
            const char* a1 = cA + (size_t)(t + 1) * kstep;
            const char* a2 = last ? nA : cA + (size_t)(t + 2) * kstep; const char* b2 = last ? nB : cB + (size_t)(t + 2) * kstep;
            const char* a3 = a2 + kstep; const char* b3 = b2 + kstep;
            if (last && has_next) S.a_ready(nxt);
            if constexpr (SP2) {
            PG8_LDB(B0, 0, 0); PG8_LDB(B1, 0, 1); PG8_SCHED; PG8_LDA(At, 0, 0); PG8_STAGE(PG8_SA(1, 1), a1 + hstep, voffA);
            PG8_WAIT_V(8); PG8_WAIT_L(0); PG8_BAR; PG8_MMA(0, 0, At, B0); PG8_MMA(0, 1, At, B1); PG8_BAR; PG8_SCHED;
            PG8_LDA(At, 0, 1); PG8_STAGE(PG8_SB(0, 0), b2, voffB); PG8_STAGE(PG8_SB(0, 1), b2 + hstep, voffB); PG8_STAGE(PG8_SA(0, 0), a2, voffA);
            PG8_WAIT_V(8); PG8_WAIT_L(0); PG8_BAR; PG8_MMA(1, 0, At, B0); PG8_MMA(1, 1, At, B1); PG8_BAR; PG8_SCHED;
            PG8_LDB(B0, 1, 0); PG8_LDB(B1, 1, 1); PG8_SCHED; PG8_LDA(At, 1, 0); PG8_STAGE(PG8_SA(0, 1), a2 + hstep, voffA);
            PG8_WAIT_V(8); PG8_WAIT_L(0); PG8_BAR; PG8_MMA(0, 0, At, B0); PG8_MMA(0, 1, At, B1); PG8_BAR; PG8_SCHED;
            PG8_LDA(At, 1, 1); PG8_STAGE(PG8_SB(1, 0), b3, voffB); PG8_STAGE(PG8_SB(1, 1), b3 + hstep, voffB); PG8_STAGE(PG8_SA(1, 0), a3, voffA);
            PG8_WAIT_V(8); PG8_WAIT_L(0); PG8_BAR; PG8_MMA(1, 0, At, B0); PG8_MMA(1, 1, At, B1); PG8_BAR; PG8_SCHED;
            } else {
            PG8_LDB(B0, 0, 0); PG8_SCHED; PG8_LDA(At, 0, 0); PG8_STAGE(PG8_SA(1, 1), a1 + hstep, voffA);
            PG8_WAIT_L(8); PG8_BAR; PG8_WAIT_L(0); PG8_MMA(0, 0, At, B0); PG8_BAR; PG8_SCHED;
            PG8_LDB(B1, 0, 1); PG8_STAGE(PG8_SB(0, 0), b2, voffB);
            PG8_BAR; PG8_WAIT_L(0); PG8_MMA(0, 1, At, B1); PG8_BAR;
            PG8_LDA(At, 0, 1); PG8_STAGE(PG8_SA(0, 0), a2, voffA);
            PG8_BAR; PG8_WAIT_L(0); PG8_MMA(1, 0, At, B0); PG8_BAR; PG8_SCHED;
            PG8_STAGE(PG8_SB(0, 1), b2 + hstep, voffB);
            PG8_WAIT_V(6); PG8_BAR; PG8_MMA(1, 1, At, B1); PG8_BAR;
            PG8_LDB(B0, 1, 0); PG8_SCHED; PG8_LDA(At, 1, 0); PG8_STAGE(PG8_SA(0, 1), a2 + hstep, voffA);
            PG8_WAIT_L(8); PG8_BAR; PG8_WAIT_L(0); PG8_MMA(0, 0, At, B0); PG8_BAR; PG8_SCHED;
            PG8_LDB(B1, 1, 1); PG8_STAGE(PG8_SB(1, 0), b3, voffB);
            PG8_BAR; PG8_WAIT_L(0); PG8_MMA(0, 1, At, B1); PG8_BAR;
            PG8_LDA(At, 1, 1); PG8_STAGE(PG8_SA(1, 0), a3, voffA);
            PG8_BAR; PG8_WAIT_L(0); PG8_MMA(1, 0, At, B0); PG8_BAR; PG8_SCHED;
            PG8_STAGE(PG8_SB(1, 1), b3 + hstep, voffB);
            PG8_WAIT_V(6); PG8_BAR; PG8_MMA(1, 1, At, B1); PG8_BAR;
            }
        }
#ifdef PG8_TSEL
        unsigned long long tA_ = 0, tb2_ = 0;
        if constexpr (epi_timed<Epi>::v) tA_ = __builtin_amdgcn_s_memrealtime();
#endif
        if constexpr (ALIGN_EPI) { if (wr == 0) PG8_BAR; }
#ifdef PG8_TSEL
        if constexpr (epi_timed<Epi>::v) tb2_ = __builtin_amdgcn_s_memrealtime();
#endif
#ifdef PG8_TSEL
        unsigned long long tb_ = 0;
        if constexpr (epi_timed<Epi>::v) { if (PG8_TSEL == 2) tb_ = tA_; else tb_ = __builtin_amdgcn_s_memrealtime(); }
#endif
        if constexpr (!Epi::AFTER_DRAIN) { E(acc, cur, wr, wc, fr, fq); PG8_EPI_AGAIN(E(acc, cur, wr, wc, fr, fq)); S.done(cur); }
#ifdef PG8_TSEL
        if constexpr (epi_timed<Epi>::v) { if (PG8_TSEL == 1) asm volatile("s_waitcnt vmcnt(0)" ::: "memory");
            if (PG8_TSEL == 2) tsum_ += tb2_ - tb_; else tsum_ += __builtin_amdgcn_s_memrealtime() - tb_; }
#endif
        if (!has_next) break;
#pragma unroll
        for (int a = 0; a < 2; ++a)
#pragma unroll
            for (int b = 0; b < 2; ++b)
#pragma unroll
                for (int m = 0; m < 4; ++m)
#pragma unroll
                    for (int n = 0; n < 2; ++n) acc[a][b][m][n] = (f32x4){0.f, 0.f, 0.f, 0.f};
        cur = nxt; cA = nA; cB = nB; ++ui;
        if constexpr (ALIGN_EPI) { if (wr == 1) PG8_BAR; }
    }
    PG8_WAIT_V(0);
    if constexpr (!ALIGN_EPI) { if (wr == 0) PG8_BAR; }
    PG8_BAR;
    if constexpr (Epi::AFTER_DRAIN) { E.fused(acc, cur, wr, wc, fr, fq, lds, wid, lane); S.done(cur); }
#ifdef PG8_TSEL
    if constexpr (epi_timed<Epi>::v) { if (blockIdx.x == PG8_TBLK && tid == PG8_TTID) __hip_atomic_store(E.tslot, tsum_, __ATOMIC_RELAXED, __HIP_MEMORY_SCOPE_AGENT); }
#endif
#undef PG8_SA
#undef PG8_SB
#undef PG8_STAGE
#undef PG8_LDA
#undef PG8_LDB
#undef PG8_MMA
#undef PG8_WAIT_V
#undef PG8_WAIT_L
#undef PG8_BAR
#undef PG8_SCHED
}
static_assert(true, "gather variant of gemm_phase (SP2 = true only): identical schedule, the A operand's rows are gathered through Sched::rowoff");
template <class Epi, class Sched, bool ALIGN_EPI = false, bool SP2 = false>
__device__ __forceinline__ void gemm_phase_g(PG8_LAS unsigned char* lds, const Gemm g, const Sched& S, const Epi& E) {
    int tid_o = threadIdx.x; asm volatile("" : "+v"(tid_o));
    const int tid = tid_o, wid = __builtin_amdgcn_readfirstlane(tid >> 6), lane = tid & 63, wr = wid >> 2, wc = wid & 3, fr = lane & 15, fq = lane >> 4;
    const int K = g.K, nt = K / BK;
    unsigned voffA[2], voffB[2]; int RA_[2]; unsigned CA_[2];
#pragma unroll
    for (int i = 0; i < 2; ++i) { int R, C; stage_rc(tid * 16 + i * 8192, R, C); const int Rb = Epi::PERM ? ((R & ~31) + perm32(R & 31)) : R;
        voffA[i] = (unsigned)(R * K + C) * 2u; voffB[i] = (unsigned)(Rb * K + C) * 2u; RA_[i] = R; CA_[i] = (unsigned)C * 2u; }
    const size_t kstep = (size_t)(BK * 2);
    const size_t hstep = (size_t)HALF * K * 2;
    const size_t tstep = 2 * hstep;
    const unsigned ldsw = (unsigned)wid * 1024u;
    const int aoff = lds_byte(wr * 64 + fr, fq * 8), boff = lds_byte(wc * 32 + fr, fq * 8);
#define PG8_SA(b, h) (((b) * 2 + (h)) * HTB)
#define PG8_SB(b, h) ((4 + (b) * 2 + (h)) * HTB)
#define PG8_STAGE(bufoff, gbase, voff) do { _Pragma("unroll") for (int _i = 0; _i < 2; ++_i) \
        __builtin_amdgcn_global_load_lds((const unsigned*)((const char*)(gbase) + (voff)[_i]), (PG8_LAS unsigned*)(lds + (bufoff) + ldsw + _i * 8192), 16, 0, 0); } while (0)
#define PG8_LDA(dst, b, h) do { _Pragma("unroll") for (int m = 0; m < 4; ++m) _Pragma("unroll") for (int k = 0; k < 2; ++k) dst[m][k] = *(const PG8_LAS bf16x8*)(lds + PG8_SA(b, h) + aoff + m * 2048 + k * 1024); } while (0)
#define PG8_LDB(dst, b, h) do { _Pragma("unroll") for (int n = 0; n < 2; ++n) _Pragma("unroll") for (int k = 0; k < 2; ++k) dst[n][k] = *(const PG8_LAS bf16x8*)(lds + PG8_SB(b, h) + boff + n * 2048 + k * 1024); } while (0)
#define PG8_MMA(ai, bj, At, Bt) do { __builtin_amdgcn_s_setprio(1); _Pragma("unroll") for (int m = 0; m < 4; ++m) _Pragma("unroll") for (int n = 0; n < 2; ++n) _Pragma("unroll") for (int k = 0; k < 2; ++k) \
        acc[ai][bj][m][n] = __builtin_amdgcn_mfma_f32_16x16x32_bf16(Bt[n][k], At[m][k], acc[ai][bj][m][n], 0, 0, 0); __builtin_amdgcn_s_setprio(0); } while (0)
#define PG8_WAIT_V(n) asm volatile("s_waitcnt vmcnt(" #n ")" ::: "memory")
#define PG8_WAIT_L(n) asm volatile("s_waitcnt lgkmcnt(" #n ")" ::: "memory")
#define PG8_BAR __builtin_amdgcn_s_barrier()
#define PG8_SCHED __builtin_amdgcn_sched_barrier(0)
    Unit cur, nxt; int ui = 0;
    if (!S.next(0, cur)) return;
    f32x4 acc[2][2][4][2];
#pragma unroll
    for (int a = 0; a < 2; ++a)
#pragma unroll
        for (int b = 0; b < 2; ++b)
#pragma unroll
            for (int m = 0; m < 4; ++m)
#pragma unroll
                for (int n = 0; n < 2; ++n) acc[a][b][m][n] = (f32x4){0.f, 0.f, 0.f, 0.f};
    bf16x8 At[4][2], B0[2][2], B1[2][2];
    const char* cA = (const char*)g.A; const char* cB = (const char*)g.Bt + (size_t)cur.pn * tstep;
    unsigned cA0[2], cA1[2], nA0[2], nA1[2];
#pragma unroll
    for (int i = 0; i < 2; ++i) { cA0[i] = S.rowoff(cur, RA_[i]) + CA_[i]; cA1[i] = S.rowoff(cur, 128 + RA_[i]) + CA_[i]; }
    S.a_ready(cur);
    if constexpr (SP2) {
        PG8_STAGE(PG8_SB(0, 0), cB, voffB); PG8_STAGE(PG8_SB(0, 1), cB + hstep, voffB); PG8_STAGE(PG8_SA(0, 0), cA, cA0); PG8_STAGE(PG8_SA(0, 1), cA, cA1);
        if (wr == 1) PG8_BAR;
        PG8_WAIT_V(2); PG8_BAR;
        PG8_STAGE(PG8_SB(1, 0), cB + kstep, voffB); PG8_STAGE(PG8_SA(1, 0), cA + kstep, cA0); PG8_STAGE(PG8_SB(1, 1), cB + hstep + kstep, voffB);
        PG8_WAIT_V(6); PG8_BAR;
    } else {
        PG8_STAGE(PG8_SB(0, 0), cB, voffB); PG8_STAGE(PG8_SA(0, 0), cA, voffA); PG8_STAGE(PG8_SB(0, 1), cB + hstep, voffB); PG8_STAGE(PG8_SA(0, 1), cA + hstep, voffA);
        if (wr == 1) PG8_BAR;
        PG8_WAIT_V(4); PG8_BAR;
        PG8_STAGE(PG8_SB(1, 0), cB + kstep, voffB); PG8_STAGE(PG8_SA(1, 0), cA + kstep, voffA); PG8_STAGE(PG8_SB(1, 1), cB + hstep + kstep, voffB);
        PG8_WAIT_V(6); PG8_BAR;
    }
    for (;;) {
        const bool has_next = S.next(ui + 1, nxt);
        const char* nA = cA; const char* nB = has_next ? (const char*)g.Bt + (size_t)nxt.pn * tstep : cB;
#pragma unroll
        for (int i = 0; i < 2; ++i) { nA0[i] = has_next ? S.rowoff(nxt, RA_[i]) + CA_[i] : cA0[i]; nA1[i] = has_next ? S.rowoff(nxt, 128 + RA_[i]) + CA_[i] : cA1[i]; }
        for (int t = 0; t < nt; t += 2) {
            const bool last = (t == nt - 2);
            const char* a1 = cA + (size_t)(t + 1) * kstep;
            const char* a2 = last ? nA : cA + (size_t)(t + 2) * kstep; const char* b2 = last ? nB : cB + (size_t)(t + 2) * kstep;
            const char* a3 = a2 + kstep; const char* b3 = b2 + kstep;
            unsigned sA0[2], sA1[2];
#pragma unroll
            for (int i = 0; i < 2; ++i) { sA0[i] = last ? nA0[i] : cA0[i]; sA1[i] = last ? nA1[i] : cA1[i]; }
            if (last && has_next) S.a_ready(nxt);
            if constexpr (SP2) {
            PG8_LDB(B0, 0, 0); PG8_LDB(B1, 0, 1); PG8_SCHED; PG8_LDA(At, 0, 0); PG8_STAGE(PG8_SA(1, 1), a1, cA1);
            PG8_WAIT_V(8); PG8_WAIT_L(0); PG8_BAR; PG8_MMA(0, 0, At, B0); PG8_MMA(0, 1, At, B1); PG8_BAR; PG8_SCHED;
            PG8_LDA(At, 0, 1); PG8_STAGE(PG8_SB(0, 0), b2, voffB); PG8_STAGE(PG8_SB(0, 1), b2 + hstep, voffB); PG8_STAGE(PG8_SA(0, 0), a2, sA0);
            PG8_WAIT_V(8); PG8_WAIT_L(0); PG8_BAR; PG8_MMA(1, 0, At, B0); PG8_MMA(1, 1, At, B1); PG8_BAR; PG8_SCHED;
            PG8_LDB(B0, 1, 0); PG8_LDB(B1, 1, 1); PG8_SCHED; PG8_LDA(At, 1, 0); PG8_STAGE(PG8_SA(0, 1), a2, sA1);
            PG8_WAIT_V(8); PG8_WAIT_L(0); PG8_BAR; PG8_MMA(0, 0, At, B0); PG8_MMA(0, 1, At, B1); PG8_BAR; PG8_SCHED;
            PG8_LDA(At, 1, 1); PG8_STAGE(PG8_SB(1, 0), b3, voffB); PG8_STAGE(PG8_SB(1, 1), b3 + hstep, voffB); PG8_STAGE(PG8_SA(1, 0), a3, sA0);
            PG8_WAIT_V(8); PG8_WAIT_L(0); PG8_BAR; PG8_MMA(1, 0, At, B0); PG8_MMA(1, 1, At, B1); PG8_BAR; PG8_SCHED;
            } else {
            PG8_LDB(B0, 0, 0); PG8_SCHED; PG8_LDA(At, 0, 0); PG8_STAGE(PG8_SA(1, 1), a1 + hstep, voffA);
            PG8_WAIT_L(8); PG8_BAR; PG8_WAIT_L(0); PG8_MMA(0, 0, At, B0); PG8_BAR; PG8_SCHED;
            PG8_LDB(B1, 0, 1); PG8_STAGE(PG8_SB(0, 0), b2, voffB);
            PG8_BAR; PG8_WAIT_L(0); PG8_MMA(0, 1, At, B1); PG8_BAR;
            PG8_LDA(At, 0, 1); PG8_STAGE(PG8_SA(0, 0), a2, voffA);
            PG8_BAR; PG8_WAIT_L(0); PG8_MMA(1, 0, At, B0); PG8_BAR; PG8_SCHED;
            PG8_STAGE(PG8_SB(0, 1), b2 + hstep, voffB);
            PG8_WAIT_V(6); PG8_BAR; PG8_MMA(1, 1, At, B1); PG8_BAR;
            PG8_LDB(B0, 1, 0); PG8_SCHED; PG8_LDA(At, 1, 0); PG8_STAGE(PG8_SA(0, 1), a2 + hstep, voffA);
            PG8_WAIT_L(8); PG8_BAR; PG8_WAIT_L(0); PG8_MMA(0, 0, At, B0); PG8_BAR; PG8_SCHED;
            PG8_LDB(B1, 1, 1); PG8_STAGE(PG8_SB(1, 0), b3, voffB);
            PG8_BAR; PG8_WAIT_L(0); PG8_MMA(0, 1, At, B1); PG8_BAR;
            PG8_LDA(At, 1, 1); PG8_STAGE(PG8_SA(1, 0), a3, voffA);
            PG8_BAR; PG8_WAIT_L(0); PG8_MMA(1, 0, At, B0); PG8_BAR; PG8_SCHED;
            PG8_STAGE(PG8_SB(1, 1), b3 + hstep, voffB);
            PG8_WAIT_V(6); PG8_BAR; PG8_MMA(1, 1, At, B1); PG8_BAR;
            }
        }
        if constexpr (ALIGN_EPI) { if (wr == 0) PG8_BAR; }
        if constexpr (!Epi::AFTER_DRAIN) { E(acc, cur, wr, wc, fr, fq); PG8_EPI_AGAIN(E(acc, cur, wr, wc, fr, fq)); S.done(cur); }
        if (!has_next) break;
#pragma unroll
        for (int a = 0; a < 2; ++a)
#pragma unroll
            for (int b = 0; b < 2; ++b)
#pragma unroll
                for (int m = 0; m < 4; ++m)
#pragma unroll
                    for (int n = 0; n < 2; ++n) acc[a][b][m][n] = (f32x4){0.f, 0.f, 0.f, 0.f};
        cur = nxt; cA = nA; cB = nB; ++ui;
#pragma unroll
        for (int i = 0; i < 2; ++i) { cA0[i] = nA0[i]; cA1[i] = nA1[i]; }
        if constexpr (ALIGN_EPI) { if (wr == 1) PG8_BAR; }
    }
    PG8_WAIT_V(0);
    if constexpr (!ALIGN_EPI) { if (wr == 0) PG8_BAR; }
    PG8_BAR;
    if constexpr (Epi::AFTER_DRAIN) { E.fused(acc, cur, wr, wc, fr, fq, lds, wid, lane); S.done(cur); }
#undef PG8_SA
#undef PG8_SB
#undef PG8_STAGE
#undef PG8_LDA
#undef PG8_LDB
#undef PG8_MMA
#undef PG8_WAIT_V
#undef PG8_WAIT_L
#undef PG8_BAR
#undef PG8_SCHED
}
}

#define DI __device__ __forceinline__
#define LAS __attribute__((address_space(3)))
typedef unsigned short bf16_t;
typedef short bf16x8 __attribute__((ext_vector_type(8)));
typedef short s16x4 __attribute__((ext_vector_type(4)));
typedef short v4i16_t __attribute__((ext_vector_type(4)));
typedef float f32x4 __attribute__((ext_vector_type(4)));
typedef float f32x16 __attribute__((ext_vector_type(16)));
typedef unsigned u32x4 __attribute__((ext_vector_type(4)));
typedef unsigned u32x2 __attribute__((ext_vector_type(2)));
typedef float f32x2_t __attribute__((ext_vector_type(2)));
typedef __bf16 bf16x2_t __attribute__((ext_vector_type(2)));

constexpr int NWAVES = 8, NTHREADS = 512;
constexpr int SEQ = 8192, DMODEL = 1024, NMETA = 16, LTOK = SEQ + NMETA  , LP = 8256  , NCHUNK = 129;
constexpr int MTOK = 2 * SEQ;
constexpr int MROWS = 16640;
constexpr int NPROJ = 3840;
constexpr int NKT = 129;
constexpr float EPS = 1e-6f;
constexpr float C2Q = 0.125f * 1.4426950408889634f;
constexpr int XS_ROWS = 41216;

constexpr size_t MiB = 1u << 20;
constexpr size_t WS_CTL = 0, CTL_BYTES = 1 * MiB;
constexpr size_t WS_RS1 = 1 * MiB;
constexpr size_t WS_RS2 = WS_RS1 + 128 * 1024;
constexpr size_t WS_TOKE = WS_RS2 + 128 * 1024;
constexpr size_t WS_TOKW = WS_TOKE + 128 * 1024;
constexpr size_t WS_TOKP = WS_TOKW + 128 * 1024;
constexpr size_t WS_SLOTW = WS_TOKP + 128 * 1024;
constexpr size_t WS_WR = WS_SLOTW + 192 * 1024;
constexpr size_t WS_GL = WS_WR + 160 * 1024;
constexpr size_t WS_DUMP = 2 * MiB;
constexpr size_t WS_COS = 2 * MiB;
constexpr size_t WS_SIN = WS_COS + 1280 * 1024;
constexpr size_t WS_GB = WS_SIN + 1280 * 1024;
constexpr size_t WS_WOUT = 6 * MiB;
constexpr size_t WS_WINT = 8 * MiB;
constexpr size_t WS_XB = WS_WINT + (size_t)NPROJ * 1024 * 2;
constexpr size_t WS_MIX = 8 * MiB;
constexpr size_t WS_QKVB = 48 * MiB;
constexpr size_t WS_QB = WS_QKVB + (size_t)2 * LP * 1536 * 2 + 128 * 1024;
constexpr size_t WS_KT = WS_QB + 16 * MiB;
constexpr size_t WS_VT = WS_KT + (size_t)16 * NKT * 4096 * 2;
constexpr size_t WS_ZB = WS_VT + (size_t)8 * NKT * 8192 * 2;
constexpr size_t WS_GP = WS_ZB + (size_t)2 * LP * 512 * 2;
constexpr size_t GP_ARR = (size_t)2064 * 4096 * 2;
constexpr size_t WS_GP_END = WS_GP + 5 * GP_ARR;
constexpr size_t WS_WGU = 48 * MiB;
constexpr size_t WS_WD = 80 * MiB;
constexpr size_t WS_U2 = 96 * MiB;
constexpr size_t WS_LIST = 240 * MiB;
constexpr size_t WS_LISTW = 242 * MiB;
constexpr size_t WS_LISTRS = 244 * MiB;
constexpr size_t WS_XS = 96 * MiB;
constexpr size_t WS_YO = 128 * MiB;
constexpr size_t WS_YS = 8 * MiB;
constexpr size_t WS_END = 256 * MiB;
static_assert(WS_GB + (size_t)2 * LP * 16 * 4 <= WS_WOUT, "small region");
static_assert(WS_XB + (size_t)MROWS * 1024 * 2 <= WS_QKVB, "XB");
static_assert(WS_GP_END <= WS_END, "GDN prep arrays");
static_assert(WS_YS + (size_t)XS_ROWS * 256 * 2 <= WS_END, "YS");
static_assert(WS_WD + (size_t)32 * 1024 * 256 * 2 <= WS_XS, "WD");
constexpr int CW_ATTQ = 2112;
constexpr int CW_PREP = 2688;
constexpr int CW_CNT = 64;
constexpr int CW_TILE = 8192;
constexpr int CW_BAR = 4096;

constexpr int LDS_BYTES = 147456;

struct Params { const float* in[23]; float* out; unsigned char* ws; };

DI unsigned f2bf(float f) { unsigned u = __float_as_uint(f); return (u + 0x7fffu + ((u >> 16) & 1u)) >> 16; }
DI unsigned pk2(float lo, float hi) { f32x2_t v = {lo, hi}; bf16x2_t b = __builtin_convertvector(v, bf16x2_t); return __builtin_bit_cast(unsigned, b); }
DI float bf2f(unsigned short h) { return __uint_as_float(((unsigned)h) << 16); }
DI float rlane(float v, int l) { return __int_as_float(__builtin_amdgcn_readlane(__float_as_int(v), l)); }
#define DPP_ADD(v, ctrl) ((v) + __int_as_float(__builtin_amdgcn_update_dpp(0, __float_as_int(v), (ctrl), 0xF, 0xF, true)))
DI u32x2 pack_quad_bf16(float v) {
    const float v1 = __int_as_float(__builtin_amdgcn_update_dpp(0, __float_as_int(v), 0xB1, 0xF, 0xF, true));
    const unsigned p = pk2(v, v1);
    const unsigned q = (unsigned)__builtin_amdgcn_update_dpp(0, (int)p, 0x4E, 0xF, 0xF, true);
    return (u32x2){p, q};
}
typedef __attribute__((address_space(1))) u32x2 g_u32x2;
DI void store_quad_bf16(bf16_t* dst  , float v, int lane) {
    const float v1 = __int_as_float(__builtin_amdgcn_update_dpp(0, __float_as_int(v), 0xB1, 0xF, 0xF, true));
    const unsigned p = pk2(v, v1);
    const unsigned q = (unsigned)__builtin_amdgcn_update_dpp(0, (int)p, 0x4E, 0xF, 0xF, true);
    if ((lane & 3) == 0) *(u32x2*)dst = (u32x2){p, q};
}
DI float wave_sum_dpp(float v) {
    v = DPP_ADD(v, 0xB1);
    v = DPP_ADD(v, 0x4E);
    v = DPP_ADD(v, 0x141);
    v = DPP_ADD(v, 0x140);
    return (rlane(v, 0) + rlane(v, 16)) + (rlane(v, 32) + rlane(v, 48));
}
DI float wave_sum(float v) { return wave_sum_dpp(v); }
DI float swz_xor16(float v) { return __int_as_float(__builtin_amdgcn_ds_swizzle(__float_as_int(v), 0x401F)); }
DI float row_sum16(float v) { v = DPP_ADD(v, 0xB1); v = DPP_ADD(v, 0x4E); v = DPP_ADD(v, 0x141); v = DPP_ADD(v, 0x140); return v; }
DI float half_sum32(float v) { v = row_sum16(v); return v + swz_xor16(v); }
DI float swap32_add(float v) { auto rr = __builtin_amdgcn_permlane32_swap(__float_as_uint(v), __float_as_uint(v), false, false); return __uint_as_float(rr[0]) + __uint_as_float(rr[1]); }
DI float swap32_max(float v) { auto rr = __builtin_amdgcn_permlane32_swap(__float_as_uint(v), __float_as_uint(v), false, false); return fmaxf(__uint_as_float(rr[0]), __uint_as_float(rr[1])); }
#define LDS_WAIT() asm volatile("s_waitcnt lgkmcnt(0)" ::: "memory")
#define BAR_LDS() do { asm volatile("s_waitcnt lgkmcnt(0)" ::: "memory"); __builtin_amdgcn_s_barrier(); asm volatile("" ::: "memory"); } while (0)
#define MFMA32(a, b, c) __builtin_amdgcn_mfma_f32_32x32x16_bf16((a), (b), (c), 0, 0, 0)
DI int crow(int r, int hi) { return (r & 3) + 8 * (r >> 2) + 4 * hi; }
DI int perm16(int x) { return (x & ~12) | ((x & 4) << 1) | ((x & 8) >> 1); }
DI bf16x8 pack8(const f32x16& x, int s) {
    u32x4 p; p.x = pk2(x[8 * s], x[8 * s + 1]); p.y = pk2(x[8 * s + 2], x[8 * s + 3]); p.z = pk2(x[8 * s + 4], x[8 * s + 5]); p.w = pk2(x[8 * s + 6], x[8 * s + 7]);
    return __builtin_bit_cast(bf16x8, p);
}
DI int orig_col(int n) {
    if (n >= 1024) return n;
    const int hh = n >> 6, c2 = n & 63, g8 = c2 >> 3, i = c2 & 7;
    return (hh << 6) + ((i < 4) ? 4 * g8 + i : 32 + 4 * g8 + (i - 4));
}
DI size_t kt_off(int b, int hh, int p, int d) {
    const int tile = p < 16 ? 0 : 1 + ((p - 16) >> 6), kv = p < 16 ? p : ((p - 16) & 63);
    return ((size_t)((b * 8 + hh) * NKT + tile) << 12) + ((d >> 3) << 9) + (kv << 3) + (d & 7);
}
DI size_t vt_off(int b, int h, int p, int d) {
    const int tile = p < 16 ? 0 : 1 + ((p - 16) >> 6), kv = p < 16 ? p : ((p - 16) & 63);
    return ((size_t)((b * 4 + h) * NKT + tile) << 13) + ((d >> 5) << 11) + ((kv >> 4) << 9) + ((kv & 15) << 5) + (d & 31);
}

template <class Src> DI void transpose_item(const Src& src, bf16_t* WT, size_t ldk, int k0, int n0, LAS float* scr, int lane) {
    float v[32];
    const int c = lane & 7;
    f32x4 g0, g1; src.gain(k0 + 8 * c, g0, g1);
#pragma unroll
    for (int i = 0; i < 32; ++i) v[i] = src(k0 + 2 * i + (lane >> 5), n0 + (lane & 31));
#pragma unroll
    for (int i = 0; i < 32; ++i) scr[(2 * i + (lane >> 5)) * 33 + (lane & 31)] = v[i];
    LDS_WAIT();
#pragma unroll
    for (int j = 0; j < 4; ++j) { const int n = (lane >> 3) + 8 * j; const LAS float* s = scr + (8 * c) * 33 + n;
        u32x4 o; o.x = pk2(s[0 * 33] * g0[0], s[1 * 33] * g0[1]); o.y = pk2(s[2 * 33] * g0[2], s[3 * 33] * g0[3]); o.z = pk2(s[4 * 33] * g1[0], s[5 * 33] * g1[1]); o.w = pk2(s[6 * 33] * g1[2], s[7 * 33] * g1[3]);
        *(u32x4*)(WT + (size_t)(n0 + n) * ldk + k0 + 8 * c) = o; }
    LDS_WAIT();
}
struct SrcWin { const float* w; const float* g; DI float operator()(int k, int n) const { return n >= 3600 ? 0.f : w[(size_t)k * 3600 + orig_col(n)]; }
    DI void gain(int k, f32x4& a, f32x4& b) const { a = *(const f32x4*)(g + k); b = *(const f32x4*)(g + k + 4); } };
struct SrcPlain { const float* w; int N; DI float operator()(int k, int n) const { return w[(size_t)k * N + n]; }
    DI void gain(int, f32x4& a, f32x4& b) const { a = (f32x4){1.f, 1.f, 1.f, 1.f}; b = a; } };
struct SrcGU { const float* w; const float* g; int fadj; DI float operator()(int k, int n) const { return w[(size_t)k * 256 + n + fadj] * g[k]; } };

#ifndef P0_REP
#define P0_REP 0
#endif
DI void phase0(const Params& P, LAS unsigned char* lds, int gw, int NGW, int gtid, int NGT, int wave, int lane) {
    LAS float* scr = (LAS float*)(lds + wave * 16384);
    bf16_t* WINT = (bf16_t*)(P.ws + WS_WINT); bf16_t* WOUT = (bf16_t*)(P.ws + WS_WOUT); bf16_t* XB = (bf16_t*)(P.ws + WS_XB);
    float* RS1 = (float*)(P.ws + WS_RS1);
    constexpr int I_IN = 16 * (NPROJ / 32), I_OUT = 16 * 32;
    const SrcWin sw{P.in[3], P.in[2]}; const SrcPlain so{P.in[13], 1024};
    for (int rp_ = 0; rp_ < ((P0_REP & 1) ? 2 : 1); ++rp_)
    for (int it = gw; it < I_IN + I_OUT; it += NGW) {
        if (it < I_IN) transpose_item(sw, WINT, 1024, (it / (NPROJ / 32)) * 64, (it % (NPROJ / 32)) * 32, scr, lane);
        else { const int r = it - I_IN; transpose_item(so, WOUT, 1024, (r >> 5) * 64, (r & 31) * 32, scr, lane); }
    }
    const float* x = P.in[0]; const float* meta = P.in[1];
    for (int rp_ = 0; rp_ < ((P0_REP & 2) ? 2 : 1); ++rp_)
    for (int m0 = gw; m0 < MROWS; m0 += 4 * NGW) {
        f32x4 v[4][4];
#pragma unroll
        for (int r = 0; r < 4; ++r) { const int m = m0 + r * NGW;
            const bool real = m < MTOK + NMETA;
            const f32x4* xr = (const f32x4*)((m < MTOK) ? x + (size_t)m * 1024 : meta + (size_t)((real ? m : MTOK) - MTOK) * 1024);
#pragma unroll
            for (int j = 0; j < 4; ++j) v[r][j] = (m < MROWS) ? xr[64 * j + lane] : (f32x4){0.f, 0.f, 0.f, 0.f}; }
#pragma unroll
        for (int r = 0; r < 4; ++r) { const int m = m0 + r * NGW;
            if (m < MROWS) {
                const bool real = m < MTOK + NMETA;
                float s = 0.f;
#pragma unroll
                for (int j = 0; j < 4; ++j) { if (!real) v[r][j] = (f32x4){0.f, 0.f, 0.f, 0.f}; s += (v[r][j].x * v[r][j].x + v[r][j].y * v[r][j].y) + (v[r][j].z * v[r][j].z + v[r][j].w * v[r][j].w); }
                s = wave_sum(s);
                if (lane == 0) RS1[m] = real ? __builtin_amdgcn_rsqf(s * (1.0f / 1024.0f) + EPS) : 0.f;
                u32x2* orow = (u32x2*)(XB + (size_t)m * 1024);
#pragma unroll
                for (int j = 0; j < 4; ++j) orow[64 * j + lane] = (u32x2){pk2(v[r][j].x, v[r][j].y), pk2(v[r][j].z, v[r][j].w)};
            } }
    }
    float* COS = (float*)(P.ws + WS_COS); float* SIN = (float*)(P.ws + WS_SIN);
    for (int rp_ = 0; rp_ < ((P0_REP & 4) ? 2 : 1); ++rp_)
    for (int i = gtid; i < LTOK * 32; i += NGT) {
        const int p = i >> 5, f = i & 31;
        const double rev = (double)p * exp2(-(double)f * (13.287712379549449 / 32.0)) * 0.15915494309189535;
        const float fr = (float)(rev - floor(rev));
        COS[i] = __builtin_amdgcn_cosf(fr); SIN[i] = __builtin_amdgcn_sinf(fr);
    }
    float* WR = (float*)(P.ws + WS_WR); const float* gf = P.in[14]; const float* wgrp = P.in[15]; const float* wrt = P.in[17];
    for (int i = gtid; i < 36 * 1024; i += NGT) { const int j = i >> 10, k = i & 1023; WR[i] = gf[k] * (j < 4 ? wgrp[k * 4 + j] : wrt[k * 32 + (j - 4)]); }
}

#ifndef EPI_NT
#define EPI_NT 0
#endif
#if EPI_NT
#define NT_ST(p, v) __builtin_nontemporal_store((v), (p))
#else
#define NT_ST(p, v) do { if (EV == 1) { auto p_ = (p); *(decltype(p_))(dmask ? dumpb + ((unsigned long long)p_ & 0xFFFF0ull) : (unsigned char*)p_) = (v); } else *(p) = (v); } while (0)
#endif
template <int EV> struct EpiInProjT {
    static constexpr bool PERM = true, AFTER_DRAIN = false, TIMED = true;
    const float* RS1; const float* COS; const float* SIN; const float* a_log; const float* dt_bias;
    bf16_t* QB; bf16_t* KT; bf16_t* VT; bf16_t* QKVB; bf16_t* ZB; float* GB; unsigned char* dumpb; int dmask; unsigned long long* tslot;
    DI void tail(const pg8::f32x4 (&acc)[2][2][4][2], const pg8::Unit& u, int wr, int wc, int fr, int fq) const {
        const int pn = u.pn;
#pragma unroll
        for (int ai = 0; ai < 2; ++ai)
#pragma unroll
            for (int m = 0; m < 4; ++m) {
                const int row = u.pm * 256 + ai * 128 + wr * 64 + m * 16 + fr;
                if (row < MTOK + NMETA) {
                    const float rs = RS1[row];
                    const bool meta = row >= MTOK;
                    const int p = meta ? row - MTOK : (row & 8191) + NMETA;
                    const int b0 = meta ? 0 : (row >> 13), nb = meta ? 2 : 1;
#pragma unroll
                    for (int bj = 0; bj < 2; ++bj) {
                        float xv[8];
#pragma unroll
                        for (int i = 0; i < 4; ++i) { xv[i] = acc[ai][bj][m][0][i] * rs; xv[4 + i] = acc[ai][bj][m][1][i] * rs; }
                        if (pn < 4) {
                            const int hh = (pn & 1) * 4 + bj * 2 + (wc >> 1), d0 = 4 * (4 * (wc & 1) + fq);
                            const f32x4 cs = *(const f32x4*)(COS + p * 32 + d0), sn = *(const f32x4*)(SIN + p * 32 + d0);
                            float lo[4], hi[4];
#pragma unroll
                            for (int i = 0; i < 4; ++i) { lo[i] = xv[i] * cs[i] - xv[4 + i] * sn[i]; hi[i] = xv[4 + i] * cs[i] + xv[i] * sn[i]; }
                            if (pn < 2) {
                                if (!meta) {
                                    bf16_t* q = QB + ((size_t)((b0 * 8 + hh) * SEQ + (p - NMETA)) << 6) + d0;
                                    *(u32x2*)q = (u32x2){pk2(lo[0] * C2Q, lo[1] * C2Q), pk2(lo[2] * C2Q, lo[3] * C2Q)};
                                    *(u32x2*)(q + 32) = (u32x2){pk2(hi[0] * C2Q, hi[1] * C2Q), pk2(hi[2] * C2Q, hi[3] * C2Q)};
                                }
                            } else {
                                for (int bb = b0; bb < b0 + nb; ++bb) {
                                    *(u32x2*)(KT + kt_off(bb, hh, p, d0)) = (u32x2){pk2(lo[0], lo[1]), pk2(lo[2], lo[3])};
                                    *(u32x2*)(KT + kt_off(bb, hh, p, d0 + 32)) = (u32x2){pk2(hi[0], hi[1]), pk2(hi[2], hi[3])};
                                }
                            }
                        } else {
                            const u32x4 w = (u32x4){pk2(xv[0], xv[1]), pk2(xv[2], xv[3]), pk2(xv[4], xv[5]), pk2(xv[6], xv[7])};
                            const int cl = bj * 128 + wc * 32 + fq * 8;
                            if (pn < 6) {
                                const int h = (pn - 4) * 2 + bj, d = wc * 32 + fq * 8;
                                for (int bb = b0; bb < b0 + nb; ++bb) *(u32x4*)(VT + vt_off(bb, h, p, d)) = w;
                            } else if (pn < 12) {
                                for (int bb = b0; bb < b0 + nb; ++bb) *(u32x4*)(QKVB + (size_t)(bb * LP + p) * 1536 + (pn - 6) * 256 + cl) = w;
                            } else if (pn < 14) {
                                float sz[8];
#pragma unroll
                                for (int i = 0; i < 8; ++i) sz[i] = xv[i] * __builtin_amdgcn_rcpf(1.0f + __expf(-xv[i]));
                                const u32x4 wz = (u32x4){pk2(sz[0], sz[1]), pk2(sz[2], sz[3]), pk2(sz[4], sz[5]), pk2(sz[6], sz[7])};
                                for (int bb = b0; bb < b0 + nb; ++bb) *(u32x4*)(ZB + (size_t)(bb * LP + p) * 512 + (pn - 12) * 256 + cl) = wz;
                            } else if (cl < 16) {
                                float o[8];
                                if (cl == 0) {
#pragma unroll
                                    for (int i = 0; i < 8; ++i) { const float t = xv[i] + dt_bias[i]; const float sp = fmaxf(t, 0.f) + __logf(1.0f + __expf(-fabsf(t))); o[i] = -__expf(a_log[i]) * sp; }
                                } else {
#pragma unroll
                                    for (int i = 0; i < 8; ++i) o[i] = __builtin_amdgcn_rcpf(1.0f + __expf(-xv[i]));
                                }
                                for (int bb = b0; bb < b0 + nb; ++bb) { float* g = GB + ((size_t)(bb * LP + p) << 4) + cl;
                                    *(f32x4*)g = (f32x4){o[0], o[1], o[2], o[3]}; *(f32x4*)(g + 4) = (f32x4){o[4], o[5], o[6], o[7]}; }
                            }
                        }
                    }
                }
            }
    }

    DI void operator()(const pg8::f32x4 (&acc)[2][2][4][2], const pg8::Unit& u, int wr, int wc, int fr, int fq) const {
        if (u.pm >= MTOK / 256) { tail(acc, u, wr, wc, fr, fq); return; }
        const int pn = u.pn, rowb = u.pm * 256 + wr * 64 + fr;
        float rs[2][4];
#pragma unroll
        for (int ai = 0; ai < 2; ++ai)
#pragma unroll
            for (int m = 0; m < 4; ++m) rs[ai][m] = (EV == 2) ? 1.0f : RS1[rowb + ai * 128 + m * 16];
        __builtin_amdgcn_sched_barrier(0);
        const int b = rowb >> 13, s0 = rowb & 8191;
        if (pn < 4) {
            const int d0 = 4 * (4 * (wc & 1) + fq);
#pragma unroll
            for (int ai = 0; ai < 2; ++ai) {
                f32x4 cs[4], sn[4];
#pragma unroll
                for (int m = 0; m < 4; ++m) { const int p = s0 + ai * 128 + m * 16 + NMETA; if (EV == 2) { cs[m] = (f32x4){1.f, 1.f, 1.f, 1.f}; sn[m] = (f32x4){0.f, 0.f, 0.f, 0.f}; } else { cs[m] = *(const f32x4*)(COS + p * 32 + d0); sn[m] = *(const f32x4*)(SIN + p * 32 + d0); } }
                __builtin_amdgcn_sched_barrier(0);
#pragma unroll
                for (int m = 0; m < 4; ++m)
#pragma unroll
                    for (int bj = 0; bj < 2; ++bj) {
                        const int hh = (pn & 1) * 4 + bj * 2 + (wc >> 1), s = s0 + ai * 128 + m * 16;
                        float lo[4], hi[4];
#pragma unroll
                        for (int i = 0; i < 4; ++i) { const float x1 = acc[ai][bj][m][0][i] * rs[ai][m], x2 = acc[ai][bj][m][1][i] * rs[ai][m];
                            lo[i] = x1 * cs[m][i] - x2 * sn[m][i]; hi[i] = x2 * cs[m][i] + x1 * sn[m][i]; }
                        if (pn < 2) { bf16_t* q = QB + ((size_t)((b * 8 + hh) * SEQ + s) << 6) + d0;
                            NT_ST((u32x2*)q, ((u32x2){pk2(lo[0] * C2Q, lo[1] * C2Q), pk2(lo[2] * C2Q, lo[3] * C2Q)}));
                            NT_ST((u32x2*)(q + 32), ((u32x2){pk2(hi[0] * C2Q, hi[1] * C2Q), pk2(hi[2] * C2Q, hi[3] * C2Q)}));
                        } else { bf16_t* k = KT + ((size_t)((b * 8 + hh) * NKT + 1 + (s >> 6)) << 12) + ((d0 >> 3) << 9) + ((s & 63) << 3) + (d0 & 7);
                            NT_ST((u32x2*)k, ((u32x2){pk2(lo[0], lo[1]), pk2(lo[2], lo[3])}));
                            NT_ST((u32x2*)(k + 4 * 512), ((u32x2){pk2(hi[0], hi[1]), pk2(hi[2], hi[3])})); }
                    }
            }
            return;
        }
        const int cl = wc * 32 + fq * 8;
#pragma unroll
        for (int ai = 0; ai < 2; ++ai)
#pragma unroll
            for (int m = 0; m < 4; ++m)
#pragma unroll
                for (int bj = 0; bj < 2; ++bj) {
                    const int s = s0 + ai * 128 + m * 16, p = s + NMETA;
                    float xv[8];
#pragma unroll
                    for (int i = 0; i < 4; ++i) { xv[i] = acc[ai][bj][m][0][i] * rs[ai][m]; xv[4 + i] = acc[ai][bj][m][1][i] * rs[ai][m]; }
                    if (pn < 6) {
                        const int h = (pn - 4) * 2 + bj;
                        NT_ST((u32x4*)(VT + ((size_t)((b * 4 + h) * NKT + 1 + (s >> 6)) << 13) + ((cl >> 5) << 11) + (((s & 63) >> 4) << 9) + ((s & 15) << 5) + (cl & 31)),
                            ((u32x4){pk2(xv[0], xv[1]), pk2(xv[2], xv[3]), pk2(xv[4], xv[5]), pk2(xv[6], xv[7])}));
                    } else if (pn < 12) {
                        NT_ST((u32x4*)(QKVB + (size_t)(b * LP + p) * 1536 + (pn - 6) * 256 + bj * 128 + cl), ((u32x4){pk2(xv[0], xv[1]), pk2(xv[2], xv[3]), pk2(xv[4], xv[5]), pk2(xv[6], xv[7])}));
                    } else if (pn < 14) {
#pragma unroll
                        for (int i = 0; i < 8; ++i) xv[i] = xv[i] * __builtin_amdgcn_rcpf(1.0f + __expf(-xv[i]));
                        NT_ST((u32x4*)(ZB + (size_t)(b * LP + p) * 512 + (pn - 12) * 256 + bj * 128 + cl), ((u32x4){pk2(xv[0], xv[1]), pk2(xv[2], xv[3]), pk2(xv[4], xv[5]), pk2(xv[6], xv[7])}));
                    } else if (bj == 0 && cl < 16) {
                        float o[8];
                        if (cl == 0) {
#pragma unroll
                            for (int i = 0; i < 8; ++i) { const float t = xv[i] + dt_bias[i]; const float sp = fmaxf(t, 0.f) + __logf(1.0f + __expf(-fabsf(t))); o[i] = -__expf(a_log[i]) * sp; }
                        } else {
#pragma unroll
                            for (int i = 0; i < 8; ++i) o[i] = __builtin_amdgcn_rcpf(1.0f + __expf(-xv[i]));
                        }
                        float* g = GB + ((size_t)(b * LP + p) << 4) + cl;
                        *(f32x4*)g = (f32x4){o[0], o[1], o[2], o[3]}; *(f32x4*)(g + 4) = (f32x4){o[4], o[5], o[6], o[7]};
                    }
                }
    }
};
typedef EpiInProjT<0> EpiInProj;

DI bf16x8 lds_frag(LAS const bf16_t* M, int row, int ch) { return *(LAS const bf16x8*)((LAS const unsigned char*)M + row * 128 + ((ch ^ (row & 7)) << 4)); }
DI s16x4 tr_read_b64(LAS const unsigned char* p) { return __builtin_bit_cast(s16x4, __builtin_amdgcn_ds_read_tr16_b64_v4i16((LAS v4i16_t*)p)); }
DI bf16x8 lds_frag_plain(LAS const bf16_t* M, int row, int ch) { return *(LAS const bf16x8*)((LAS const unsigned char*)M + row * 128 + (ch << 4)); }
DI int swz_idx(int row, int d) { return row * 64 + ((((d >> 3) ^ (row & 7)) << 3) | (d & 7)); }

#ifndef PREP_REP
#define PREP_REP 0
#endif
constexpr int PREP_PAIR = 35840;

template <int MAT> DI void prep_rows(const bf16_t* QKVB, const float* cw, int b, int h, int n, int lane, LAS const float* egS,
                                     LAS bf16_t* DS  , bf16_t* QG) {
    const int colb = MAT * 512 + h * 64, col = colb + lane, p0 = n * 64;
    const float c0 = cw[col], c1 = cw[1536 + col], c2 = cw[3072 + col], c3 = cw[4608 + col];
    const bf16_t* blk = QKVB + (size_t)(b * LP + p0) * 1536 + colb;
    float x0 = 0.f, x1 = 0.f, x2 = 0.f;
    if (n > 0) { x0 = bf2f(blk[lane - 3 * 1536]); x1 = bf2f(blk[lane - 2 * 1536]); x2 = bf2f(blk[lane - 1 * 1536]); }
    u32x4 stg[8];
#pragma unroll
    for (int i = 0; i < 8; ++i) stg[i] = *(const u32x4*)(blk + (size_t)(8 * i + (lane >> 3)) * 1536 + (lane & 7) * 8);
#pragma unroll
    for (int i = 0; i < 8; ++i) *(LAS u32x4*)(DS + (8 * i + (lane >> 3)) * 64 + (lane & 7) * 8) = stg[i];
    LDS_WAIT();
    const int nvalid = (LTOK - p0) < 64 ? (LTOK - p0) : 64;
#pragma unroll 4
    for (int c = 0; c < nvalid; ++c) {
        const float x3 = bf2f(DS[c * 64 + lane]);
        float y = c0 * x0 + c1 * x1 + c2 * x2 + c3 * x3;
        y = y * __builtin_amdgcn_rcpf(1.0f + __expf(-y));
        x0 = x1; x1 = x2; x2 = x3;
        if (MAT == 2) { DS[c * 64 + lane] = (bf16_t)f2bf(y * egS[c]); }
        else {
            const float ss = wave_sum(y * y);
            const float yn = y * __builtin_amdgcn_rsqf(ss + EPS);
            if (MAT == 0) {
                const float qn = yn * 0.125f;
                DS[c * 64 + lane] = (bf16_t)f2bf(qn);
                QG[c * 64 + perm16(lane)] = (bf16_t)f2bf(qn * egS[c]);
            } else {
                DS[c * 64 + lane] = (bf16_t)f2bf(yn);
            }
        }
    }
    for (int c = nvalid; c < 64; ++c) { DS[c * 64 + lane] = 0; if (MAT == 0) QG[c * 64 + perm16(lane)] = 0; }
}

DI void gdn_tinv(LAS const float* AST, LAS bf16_t* TS, int lane) {
    const int hb = lane >> 5, j = lane & 31, r32 = j, hi = hb;
    LAS const float* Ab = AST + (32 * hb) * 68 + 32 * hb;
    float x[32];
#pragma unroll
    for (int r = 0; r < 32; ++r) x[r] = (r == j) ? 1.0f : 0.0f;
#pragma unroll
    for (int jj = 0; jj < 31; ++jj) {
        const float xj = x[jj];
        LAS const float* ap = Ab + jj * 68;
#pragma unroll
        for (int r4 = (jj + 1) / 4; r4 < 8; ++r4) {
            const f32x4 a = *(LAS const f32x4*)(ap + 4 * r4);
#pragma unroll
            for (int e = 0; e < 4; ++e) if (4 * r4 + e > jj) x[4 * r4 + e] -= a[e] * xj;
        }
    }
    bf16x8 a21[2];
#pragma unroll
    for (int s = 0; s < 2; ++s) { float t[8];
#pragma unroll
        for (int jj = 0; jj < 8; ++jj) t[jj] = AST[(16 * s + 8 * hi + jj) * 68 + 32 + r32];
        const u32x4 p = (u32x4){pk2(t[0], t[1]), pk2(t[2], t[3]), pk2(t[4], t[5]), pk2(t[6], t[7])}; a21[s] = __builtin_bit_cast(bf16x8, p); }
    f32x16 M = {};
#pragma unroll
    for (int s = 0; s < 2; ++s) { float t[8];
#pragma unroll
        for (int jj = 0; jj < 8; ++jj) {
            const auto rr = __builtin_amdgcn_permlane32_swap(__float_as_uint(x[16 * s + 8 + jj]), __float_as_uint(x[16 * s + 8 + jj]), false, false);
            t[jj] = hi ? __uint_as_float(rr[0]) : x[16 * s + jj];
        }
        const u32x4 p = (u32x4){pk2(t[0], t[1]), pk2(t[2], t[3]), pk2(t[4], t[5]), pk2(t[6], t[7])};
        M = MFMA32(a21[s], __builtin_bit_cast(bf16x8, p), M);
    }
    asm volatile("s_waitcnt lgkmcnt(0)" ::: "memory");
#pragma unroll
    for (int i = 0; i < 32; ++i) TS[(32 * hb + i) * 64 + 32 * hb + j] = (bf16_t)f2bf(x[i]);
    asm volatile("s_waitcnt lgkmcnt(0)" ::: "memory");
    f32x16 T21 = {};
#pragma unroll
    for (int s = 0; s < 2; ++s) {
        const u32x2 lo = *(LAS const u32x2*)(TS + (32 + r32) * 64 + 32 + 16 * s + 4 * hi), hi8 = *(LAS const u32x2*)(TS + (32 + r32) * 64 + 32 + 16 * s + 8 + 4 * hi);
        const u32x4 p = (u32x4){lo.x, lo.y, hi8.x, hi8.y};
        T21 = MFMA32(__builtin_bit_cast(bf16x8, p), pack8(M, s), T21);
    }
#pragma unroll
    for (int i = 0; i < 16; ++i) TS[(32 + crow(i, hi)) * 64 + r32] = (bf16_t)f2bf(-T21[i]);
    asm volatile("s_waitcnt lgkmcnt(0)" ::: "memory");
}

template <bool PERM> DI void gdn_tmul(LAS const bf16_t* TS, LAS const bf16_t* RS, int lane, float sgn, bf16_t* out) {
    const int r32 = lane & 31, hi = lane >> 5;
    LAS const unsigned char* rb = (LAS const unsigned char*)RS + ((8 * hi + ((lane & 15) >> 2)) * 64 + 16 * ((lane >> 4) & 1) + 4 * (lane & 3)) * 2;
#pragma unroll
    for (int ct = 0; ct < 2; ++ct)
#pragma unroll
        for (int cb = 0; cb < 2; ++cb) {
            f32x16 acc = {};
#pragma unroll
            for (int ks = 0; ks < (ct == 0 ? 2 : 4); ++ks) {
                const bf16x8 fa = lds_frag_plain(TS, 32 * ct + r32, 2 * ks + hi);
                const s16x4 lo = tr_read_b64(rb + (16 * ks * 64 + 32 * cb) * 2), h4 = tr_read_b64(rb + ((16 * ks + 4) * 64 + 32 * cb) * 2);
                const bf16x8 fb = (bf16x8){lo[0], lo[1], lo[2], lo[3], h4[0], h4[1], h4[2], h4[3]};
                acc = MFMA32(fa, fb, acc);
            }
            u32x2 pk[16];
#pragma unroll
            for (int i = 0; i < 16; ++i) pk[i] = pack_quad_bf16(sgn * acc[i]);
            if ((lane & 3) == 0) {
                unsigned long long ob_ = (unsigned long long)(out + hi * 256 + (PERM ? perm16(32 * cb + r32) : 32 * cb + r32)); asm volatile("" : "+v"(ob_));
                g_u32x2* ob = (g_u32x2*)ob_;
#pragma unroll
                for (int i = 0; i < 16; ++i) ob[(32 * ct + (i & 3) + 8 * (i >> 2)) * 16] = pk[i];
            }
        }
}

DI void gdn_prep_phase(const Params& P, LAS unsigned char* lds, int blk, int G, int wave, int lane_in) {
    const int pair = wave >> 1, role = wave & 1;
    LAS unsigned char* pb = lds + pair * PREP_PAIR;
    LAS bf16_t* QS = (LAS bf16_t*)pb; LAS bf16_t* KS = (LAS bf16_t*)(pb + 8192); LAS float* AS = (LAS float*)(pb + 16384);
    LAS float* gcS = (LAS float*)(pb + 16384 + 17408 + role * 1024); LAS float* betaS = gcS + 64; LAS float* egS = gcS + 128; LAS float* ekS = gcS + 192;
    const bf16_t* QKVB = (const bf16_t*)(P.ws + WS_QKVB); const float* GB = (const float*)(P.ws + WS_GB); const float* cw = P.in[9];
    const int NP = G * 4, NTASK = 2 * 8 * NCHUNK;
    for (int it = 0; it * NP < NTASK; ++it) {
        int lane = lane_in; asm volatile("" : "+v"(lane));
        const int r32 = lane & 31, hi = lane >> 5;
        const int task = it * NP + blk * 4 + pair;
        const bool active = task < NTASK;
        const int bh = task < 2048 ? (task >> 7) : (task - 2048), n = task < 2048 ? (task & 127) : 128, b = bh >> 3, h = bh & 7;
        const int sidx = bh * NCHUNK + n;
        bf16_t* GPW = (bf16_t*)(P.ws + WS_GP) + (size_t)sidx * 4096; bf16_t* GPQG = GPW + GP_ARR / 2; bf16_t* GPAQK = GPQG + GP_ARR / 2; bf16_t* GPKGT = GPAQK + GP_ARR / 2; bf16_t* GPU = GPKGT + GP_ARR / 2;
        float gc = 0.f, beta = 0.f;
        if (active) {
            const int pl = n * 64 + lane;
            float g = 0.f;
            if (pl < LTOK) { const float* gb = GB + ((size_t)(b * LP + pl) << 4); g = gb[h]; beta = gb[8 + h]; }
            gcS[lane] = g; LDS_WAIT();
            gc = 0.f;
#pragma unroll
            for (int j4 = 0; j4 < 16; ++j4) { const f32x4 t = *(LAS const f32x4*)(gcS + 4 * j4);
                gc += (4 * j4 <= lane ? t[0] : 0.f) + (4 * j4 + 1 <= lane ? t[1] : 0.f) + (4 * j4 + 2 <= lane ? t[2] : 0.f) + (4 * j4 + 3 <= lane ? t[3] : 0.f); }
            const float glast = rlane(gc, 63);
            LDS_WAIT();
            gcS[lane] = gc; betaS[lane] = beta; egS[lane] = (role == 0) ? __expf(gc) : beta * __expf(gc); ekS[lane] = __expf(glast - gc);
            if (role == 0 && lane == 0) ((float*)(P.ws + WS_GL))[sidx] = __expf(glast);
            LDS_WAIT();
            for (int rp_ = 0; rp_ < ((PREP_REP & 1) ? 2 : 1); ++rp_) {
            if (role == 0) prep_rows<0>(QKVB, cw, b, h, n, lane, egS, QS, GPQG);
            else prep_rows<1>(QKVB, cw, b, h, n, lane, egS, KS, GPQG);
            }
        }
        LDS_WAIT();
        __syncthreads();
        if (active) {
            for (int rp_ = 0; rp_ < ((PREP_REP & 2) ? 2 : 1); ++rp_)
#pragma unroll
            for (int t4 = 0; t4 < 4; ++t4) {
                const int ct = t4 >> 1, st = t4 & 1;
                f32x16 acc = {};
                if (!(ct == 0 && st == 1)) {
#pragma unroll
                    for (int ks = 0; ks < 4; ++ks) {
                        const bf16x8 fa = lds_frag_plain(role == 0 ? QS : KS, 32 * ct + r32, 2 * ks + hi), fb = lds_frag_plain(KS, 32 * st + r32, 2 * ks + hi);
                        acc = MFMA32(fa, fb, acc);
                    }
                }
                const float gcs = gcS[32 * st + r32];
                LAS const float* gcb = gcS + hi * 4; LAS const float* beb = betaS + hi * 4;
                asm volatile("" : "+v"(gcb), "+v"(beb));
                const int cmp = (32 * st + r32) - 4 * hi;
                if (role == 0) {
                    u32x2 pk[16];
#pragma unroll
                    for (int i = 0; i < 16; ++i) { const int cr = 32 * ct + (i & 3) + 8 * (i >> 2);
                        pk[i] = pack_quad_bf16((cmp <= cr) ? acc[i] * __expf(gcb[cr] - gcs) : 0.f); }
                    if ((lane & 3) == 0) {
                        unsigned long long aq_ = (unsigned long long)(GPAQK + hi * 256 + perm16(r32) + 32 * st); asm volatile("" : "+v"(aq_));
                        g_u32x2* aqb = (g_u32x2*)aq_;
#pragma unroll
                        for (int i = 0; i < 16; ++i) { const int cr = 32 * ct + (i & 3) + 8 * (i >> 2); aqb[cr * 16] = pk[i]; }
                    }
                } else {
                    LAS float* asb = AS + r32 * 68 + hi * 4;
                    asm volatile("" : "+v"(asb));
#pragma unroll
                    for (int i = 0; i < 16; ++i) { const int cr = 32 * ct + (i & 3) + 8 * (i >> 2);
                        asb[32 * st * 68 + cr] = (cmp < cr) ? acc[i] * beb[cr] * __expf(gcb[cr] - gcs) : 0.f; }
                }
            }
        }
        LDS_WAIT();
        __syncthreads();
        LAS bf16_t* TS = (LAS bf16_t*)((LAS unsigned char*)AS + 32 * 68 * 4);
        if (active) {
            if (role == 0) {
                prep_rows<2>(QKVB, cw, b, h, n, lane, betaS, QS  , GPQG);
            } else {
#pragma unroll
                for (int gq = 0; gq < 8; ++gq) {
                    float t[8];
#pragma unroll
                    for (int j = 0; j < 8; ++j) { const int c = perm16(8 * gq + j); t[j] = bf2f(KS[c * 64 + lane]) * ekS[c]; }
                    *(u32x4*)(GPKGT + lane * 64 + 8 * gq) = (u32x4){pk2(t[0], t[1]), pk2(t[2], t[3]), pk2(t[4], t[5]), pk2(t[6], t[7])};
                }
#pragma unroll 8
                for (int c = 0; c < 64; ++c) KS[c * 64 + lane] = (bf16_t)f2bf(bf2f(KS[c * 64 + lane]) * egS[c]);
                gdn_tinv(AS, TS, lane);
            }
        }
        LDS_WAIT();
        __syncthreads();
        if (active) {
            for (int rp_ = 0; rp_ < ((PREP_REP & 8) ? 2 : 1); ++rp_) {
            if (role == 0) gdn_tmul<false>(TS, QS, lane, 1.0f, GPU);
            else gdn_tmul<true>(TS, KS, lane, -1.0f, GPW);
            }
        }
        LDS_WAIT();
    }
}

constexpr int GS_STAGE = 40960 + 1024;
constexpr int GS_NSTAGE = 3;
constexpr int GS_OBUF = GS_NSTAGE * GS_STAGE;
static_assert(GS_OBUF + 16384 <= LDS_BYTES - 64, "gdn scan LDS");

#define GS_POST(n, ZQ) do { \
            if (n > 0) {         \
                LAS const bf16_t* ob = (LAS const bf16_t*)(lds + GS_OBUF + ((n - 1) & 1) * 8192); \
                const f32x4 gn = *(const f32x4*)(gnorm + 4 * vq); \
            _Pragma("unroll") \
                for (int it = 0; it < 8; ++it) { \
                    const int c = (wave - 2) * 32 + 4 * it + rg, p = (n - 1) * 64 + c; \
                    const u32x2 ov = *(LAS const u32x2*)(ob + c * 64 + 4 * vq); \
                    const float v0 = __uint_as_float(ov.x << 16), v1 = __uint_as_float(ov.x & 0xffff0000u), v2 = __uint_as_float(ov.y << 16), v3 = __uint_as_float(ov.y & 0xffff0000u); \
                    const float ss = row_sum16((v0 * v0 + v1 * v1) + (v2 * v2 + v3 * v3)); \
                    const float rn = __builtin_amdgcn_rsqf(ss * (1.0f / 64.0f) + EPS); \
                    const u32x2 zz = ZQ[it]; \
                    const float z0 = __uint_as_float(zz.x << 16), z1 = __uint_as_float(zz.x & 0xffff0000u), z2 = __uint_as_float(zz.y << 16), z3 = __uint_as_float(zz.y & 0xffff0000u); \
                    const float y0 = v0 * rn * gn[0] * z0, y1 = v1 * rn * gn[1] * z1, y2 = v2 * rn * gn[2] * z2, y3 = v3 * rn * gn[3] * z3;       \
                    { bf16_t* dst_ = ((p >= NMETA) && (p < LTOK)) ? MIX + (size_t)(b * SEQ + p - NMETA) * 1024 + 512 + h * 64 + 4 * vq : DUMP + lane * 4;       \
                      *(u32x2*)dst_ = (u32x2){pk2(y0, y1), pk2(y2, y3)}; } \
                } \
            } \
        } while (0)
DI void gdn_scan(const Params& P, LAS unsigned char* lds, int bh, int tid, int wave, int lane) {
    const int b = bh >> 3, h = bh & 7, r32 = lane & 31, hi = lane >> 5;
    const int task0 = (b * 8 + h) * NCHUNK;
    const bf16_t* GP0 = (const bf16_t*)(P.ws + WS_GP);
    const float* GLg = (const float*)(P.ws + WS_GL);
    const bf16_t* ZB = (const bf16_t*)(P.ws + WS_ZB); bf16_t* MIX = (bf16_t*)(P.ws + WS_MIX); const float* gnorm = P.in[12];
    bf16_t* DUMP = (bf16_t*)(P.ws + WS_DUMP) + bh * 4096 + wave * 512;
    const int lw = wave - 4;
    const int prow = lane >> 3, pch = lane & 7;
#define GS_DMA(n_, stg_) do { LAS unsigned char* sg_ = lds + (stg_) * GS_STAGE; \
        _Pragma("unroll") for (int i = 0; i < 10; ++i) { const int a_ = i >> 1, pi_ = lw * 2 + (i & 1), row_ = 8 * pi_ + prow; \
            const int sch_ = (a_ < 4) ? (pch ^ (row_ & 7)) : pch; \
            __builtin_amdgcn_global_load_lds((const unsigned*)(GP0 + (size_t)a_ * (GP_ARR / 2) + (size_t)(task0 + (n_)) * 4096 + row_ * 64 + sch_ * 8), \
                                             (LAS unsigned*)(sg_ + a_ * 8192 + pi_ * 1024), 16, 0, 0); } \
        __builtin_amdgcn_global_load_lds((const unsigned*)(GLg + task0 + (n_)), (LAS unsigned*)(sg_ + 40960 + lw * 256), 4, 0, 0); } while (0)
    if (wave >= 4) { GS_DMA(0, 0); GS_DMA(1, 1); asm volatile("s_waitcnt vmcnt(11)" ::: "memory"); }
    const int vq = lane & 15, rg = lane >> 4;
    u32x2 zqA[8], zqB[8];
#define GS_ZLOADX(ZQ, n_) do { _Pragma("unroll") for (int it = 0; it < 8; ++it) { int p_ = (n_) * 64 + (wave - 2) * 32 + 4 * it + rg; p_ = p_ < LTOK ? p_ : LTOK - 1; \
            ZQ[it] = *(const u32x2*)(ZB + (size_t)(b * LP + p_) * 512 + h * 64 + 4 * vq); } } while (0)
    if (wave == 2 || wave == 3) { GS_ZLOADX(zqB, 0); }
    BAR_LDS();
    f32x16 S0 = {}, S1 = {};
    const int vbase = 32 * wave;
    if (wave < 2) {
    int stg = 0;
    for (int n = 0; n <= NCHUNK; ++n) {
        {
            if (n < NCHUNK) {
                LAS const unsigned char* sg = lds + stg * GS_STAGE;
                LAS const bf16_t* Wm = (LAS const bf16_t*)sg; LAS const bf16_t* QGm = (LAS const bf16_t*)(sg + 8192); LAS const bf16_t* AQm = (LAS const bf16_t*)(sg + 16384);
                LAS const bf16_t* KGm = (LAS const bf16_t*)(sg + 24576); LAS const bf16_t* Um = (LAS const bf16_t*)(sg + 32768);
                const float gl = *(LAS const float*)(sg + 40960);
                bf16x8 Sb[2][2]; Sb[0][0] = pack8(S0, 0); Sb[0][1] = pack8(S0, 1); Sb[1][0] = pack8(S1, 0); Sb[1][1] = pack8(S1, 1);
                bf16x8 fw[2][4], fq[2][4];
                f32x16 vn[2], o[2];
#pragma unroll
                for (int ct = 0; ct < 2; ++ct)
#pragma unroll
                    for (int k4 = 0; k4 < 4; ++k4) { fw[ct][k4] = lds_frag(Wm, 32 * ct + r32, k4 * 2 + hi); fq[ct][k4] = lds_frag(QGm, 32 * ct + r32, k4 * 2 + hi); }
#pragma unroll
                for (int ct = 0; ct < 2; ++ct)
#pragma unroll
                    for (int i = 0; i < 16; ++i) vn[ct][i] = bf2f(Um[(32 * ct + crow(i, hi)) * 64 + vbase + r32]);
                o[0] = f32x16{}; o[1] = f32x16{};
                __builtin_amdgcn_sched_barrier(0);
#pragma unroll
                for (int k4 = 0; k4 < 4; ++k4) {
                    vn[0] = MFMA32(fw[0][k4], Sb[k4 >> 1][k4 & 1], vn[0]); o[0] = MFMA32(fq[0][k4], Sb[k4 >> 1][k4 & 1], o[0]);
                    vn[1] = MFMA32(fw[1][k4], Sb[k4 >> 1][k4 & 1], vn[1]); o[1] = MFMA32(fq[1][k4], Sb[k4 >> 1][k4 & 1], o[1]);
                }
                __builtin_amdgcn_sched_barrier(0);
                bf16x8 fa[2][4], fk[2][4];
#pragma unroll
                for (int g = 0; g < 4; ++g) { fa[0][g] = lds_frag(AQm, r32, g * 2 + hi); fa[1][g] = lds_frag(AQm, 32 + r32, g * 2 + hi);
                                              fk[0][g] = lds_frag(KGm, r32, g * 2 + hi); fk[1][g] = lds_frag(KGm, 32 + r32, g * 2 + hi); }
#pragma unroll
                for (int i = 0; i < 16; ++i) { S0[i] *= gl; S1[i] *= gl; }
                __builtin_amdgcn_sched_barrier(0);
                bf16x8 Vb[2][2]; Vb[0][0] = pack8(vn[0], 0); Vb[0][1] = pack8(vn[0], 1); Vb[1][0] = pack8(vn[1], 0); Vb[1][1] = pack8(vn[1], 1);
#pragma unroll
                for (int g = 0; g < 4; ++g) {
                    o[0] = MFMA32(fa[0][g], Vb[g >> 1][g & 1], o[0]); S0 = MFMA32(fk[0][g], Vb[g >> 1][g & 1], S0);
                    o[1] = MFMA32(fa[1][g], Vb[g >> 1][g & 1], o[1]); S1 = MFMA32(fk[1][g], Vb[g >> 1][g & 1], S1);
                }
                LAS bf16_t* ob = (LAS bf16_t*)(lds + GS_OBUF + (n & 1) * 8192);
#pragma unroll
                for (int ct = 0; ct < 2; ++ct)
#pragma unroll
                    for (int i = 0; i < 16; ++i) ob[(32 * ct + crow(i, hi)) * 64 + vbase + r32] = (bf16_t)f2bf(o[ct][i]);
            }
        }
        BAR_LDS();
        stg = stg + 1 >= GS_NSTAGE ? 0 : stg + 1;
    }
    } else if (wave < 4) {
    for (int n = 0; n <= NCHUNK; n += 2) {
        GS_POST(n, zqA);     if (n + 1 < NCHUNK) { GS_ZLOADX(zqA, n + 1); } BAR_LDS();
        GS_POST((n + 1), zqB); if (n + 2 < NCHUNK) { GS_ZLOADX(zqB, n + 2); } BAR_LDS();
    }
    } else {
    int stg = 0;
    for (int n = 0; n <= NCHUNK; ++n) {
        {
            if (n + 2 < NCHUNK) { const int s2_ = stg + 2 >= GS_NSTAGE ? stg + 2 - GS_NSTAGE : stg + 2; GS_DMA(n + 2, s2_); asm volatile("s_waitcnt vmcnt(11)" ::: "memory"); }
            else asm volatile("s_waitcnt vmcnt(0)" ::: "memory");
        }
        BAR_LDS();
        stg = stg + 1 >= GS_NSTAGE ? 0 : stg + 1;
    }
    }
#undef GS_DMA
#undef GS_ZLOADX
}
#define XB_TMO      128
#define XB_XCNT(j)  (256  + 64 * (j))
#define XB_XSUB(j)  (1280 + 64 * (j))
#define XB_XGEN(j)  (2304 + 64 * (j))
#define XB_TOP      3328
#define XB_TOPGEN   3392
#define XCD_BAR_WORDS 3456
#define XB_SPIN_CAP (1u << 18)

__device__ __forceinline__ unsigned xb_ld(unsigned* p)              { return __hip_atomic_load(p, __ATOMIC_RELAXED, __HIP_MEMORY_SCOPE_AGENT); }
__device__ __forceinline__ unsigned xb_add(unsigned* p, unsigned v) { return __hip_atomic_fetch_add(p, v, __ATOMIC_RELAXED, __HIP_MEMORY_SCOPE_AGENT); }
__device__ __forceinline__ unsigned xb_xcc_id() { return (unsigned)__builtin_amdgcn_s_getreg((3 << 11) | 20) & 0xFu; }
#define XB_SPIN(cond, bar) do { unsigned _sp = 0; while (cond) { __builtin_amdgcn_s_sleep(1); \
    if ((++_sp & 255u) == 0u) { if (xb_ld(&(bar)[XB_TMO])) break; if (_sp > XB_SPIN_CAP) { atomicAdd(&(bar)[XB_TMO], 1u); break; } } } } while (0)

struct XcdBarrier {
    unsigned* bar; unsigned x;
    volatile LAS unsigned* st;
};

__device__ __forceinline__ XcdBarrier xcd_barrier_post(unsigned* bar, volatile LAS unsigned* st) {
    XcdBarrier b; b.bar = bar; b.x = xb_xcc_id(); b.st = st;
    if (threadIdx.x == 0) (void)xb_add(&bar[XB_XCNT(b.x)], 1u);
    return b;
}
__device__ __forceinline__ void xcd_barrier_complete(unsigned* bar, unsigned x, unsigned& nloc, unsigned& nx) {
    const unsigned G = gridDim.x * gridDim.y * gridDim.z;
    unsigned sum, cnt, mine, sp = 0u;
    for (;;) {
        sum = 0u; cnt = 0u; mine = 0u;
#pragma unroll
        for (unsigned j = 0; j < 16; ++j) { const unsigned c = xb_ld(&bar[XB_XCNT(j)]); sum += c; cnt += (c > 0u) ? 1u : 0u; mine = (j == x) ? c : mine; }
        if (sum == G) break;
        __builtin_amdgcn_s_sleep(1);
        if ((++sp & 255u) == 0u) { if (xb_ld(&bar[XB_TMO])) break; if (sp > XB_SPIN_CAP) { atomicAdd(&bar[XB_TMO], 1u); break; } }
    }
    nloc = mine > 0u ? mine : 1u; nx = cnt > 0u ? cnt : 1u;
}

__device__ __forceinline__ void xcd_barrier(const XcdBarrier& b) {
    asm volatile("s_waitcnt vmcnt(0)" ::: "memory");
    __syncthreads();
    if (threadIdx.x == 0) {
        unsigned* bar = b.bar;
        __builtin_amdgcn_s_waitcnt(0);
        unsigned nloc = b.st[0], nx = b.st[1];
        if (nloc == 0u) { xcd_barrier_complete(bar, b.x, nloc, nx); b.st[0] = nloc; b.st[1] = nx; }
        const unsigned old = xb_add(&bar[XB_XSUB(b.x)], 1u);
        const unsigned gen = old / nloc;
        if (old + 1u == (gen + 1u) * nloc) {
            __builtin_amdgcn_fence(__ATOMIC_RELEASE, "agent");
            asm volatile("s_waitcnt vmcnt(0)" ::: "memory");
            const unsigned og = xb_add(&bar[XB_TOP], 1u);
            const unsigned tg = og / nx;
            if (og + 1u == (tg + 1u) * nx) xb_add(&bar[XB_TOPGEN], 1u);
            else XB_SPIN(xb_ld(&bar[XB_TOPGEN]) == tg, bar);
            __builtin_amdgcn_fence(__ATOMIC_ACQUIRE, "agent");
            xb_add(&bar[XB_XGEN(b.x)], 1u);
            asm volatile("s_waitcnt vmcnt(0)" ::: "memory");
        } else {
            XB_SPIN(xb_ld(&bar[XB_XGEN(b.x)]) == gen, bar);
            __builtin_amdgcn_fence(__ATOMIC_ACQUIRE, "agent");
            asm volatile("s_waitcnt vmcnt(0)" ::: "memory");
        }
    }
    __syncthreads();
}


constexpr int AT_STAGE = 32768;
constexpr int AT_NSTAGE = 4;
constexpr int AT_XBUF = 0;
constexpr int AT_WSF = AT_NSTAGE * AT_STAGE;
constexpr int AT_UNIT = AT_WSF + 2048;
constexpr float AT_THR = 8.0f;

DI float max3f(float a, float b, float c) { return __builtin_fmaxf(__builtin_fmaxf(a, b), c); }
DI s16x4 tr_read(LAS const unsigned char* p) { return __builtin_bit_cast(s16x4, __builtin_amdgcn_ds_read_tr16_b64_v4i16((LAS v4i16_t*)p)); }

template <int VAR> DI void attn_unit(const Params& P, LAS unsigned char* lds, int bh, int qi, int tid, int wave, int lane, float lam) {
    const int b = bh >> 2, h = bh & 3, r32 = lane & 31, hi = lane >> 5, qsub = wave >> 1, map = wave & 1, hh = 2 * h + map;
    const bf16_t* QB = (const bf16_t*)(P.ws + WS_QB); const bf16_t* KT = (const bf16_t*)(P.ws + WS_KT); const bf16_t* VT = (const bf16_t*)(P.ws + WS_VT);
    const int ntiles = 2 * qi + 3, my_nt = (qsub < 2) ? ntiles - 1 : ntiles;
    const bf16_t* k1 = KT + ((size_t)((b * 8 + 2 * h) * NKT) << 12) + tid * 8;
    const bf16_t* k2 = KT + ((size_t)((b * 8 + 2 * h + 1) * NKT) << 12) + tid * 8;
    const bf16_t* vv = VT + ((size_t)((b * 4 + h) * NKT) << 13) + tid * 8;
#define AT_DMA(t, sb) do { LAS unsigned char* d_ = lds + (sb) * AT_STAGE + wave * 1024; \
        __builtin_amdgcn_global_load_lds((const unsigned*)(k1 + ((size_t)(t) << 12)), (LAS unsigned*)d_, 16, 0, 0); \
        __builtin_amdgcn_global_load_lds((const unsigned*)(k2 + ((size_t)(t) << 12)), (LAS unsigned*)(d_ + 8192), 16, 0, 0); \
        __builtin_amdgcn_global_load_lds((const unsigned*)(vv + ((size_t)(t) << 13)), (LAS unsigned*)(d_ + 16384), 16, 0, 0); \
        __builtin_amdgcn_global_load_lds((const unsigned*)(vv + ((size_t)(t) << 13) + 4096), (LAS unsigned*)(d_ + 24576), 16, 0, 0); } while (0)
    bf16x8 qr[4];
    { const bf16_t* q = QB + ((size_t)((b * 8 + hh) * SEQ + qi * 128 + qsub * 32 + r32) << 6) + hi * 8;
#pragma unroll
      for (int d0 = 0; d0 < 4; ++d0) qr[d0] = *(const bf16x8*)(q + d0 * 16); }
    asm volatile("s_waitcnt vmcnt(0)" : "+v"(qr[0]), "+v"(qr[1]), "+v"(qr[2]), "+v"(qr[3]) :: "memory");
    AT_DMA(0, 0); AT_DMA(1, 1); AT_DMA(2, 2);
    asm volatile("s_waitcnt vmcnt(8)" ::: "memory");
    BAR_LDS();
    LAS float* wsf = (LAS float*)(lds + AT_WSF) + wave * 64;
    float m_run = 0.f, l_run = 0.f;
    f32x16 negm = {};
    f32x16 o[4]; o[0] = f32x16{}; o[1] = f32x16{}; o[2] = f32x16{}; o[3] = f32x16{};
    for (int t = 0; t < ntiles; ++t) {
        if (t + 3 < ntiles) AT_DMA(t + 3, (t + 3) % AT_NSTAGE);
        if (t < my_nt) {
            LAS const unsigned char* sg = lds + (t % AT_NSTAGE) * AT_STAGE;
            LAS const unsigned char* kb = sg + map * 8192 + hi * 1024 + r32 * 16;
            f32x16 p0 = negm, p1 = negm;
            bf16x8 kf[8];
#pragma unroll
            for (int d0 = 0; d0 < 4; ++d0) { kf[2 * d0] = *(LAS const bf16x8*)(kb + d0 * 2048); kf[2 * d0 + 1] = *(LAS const bf16x8*)(kb + d0 * 2048 + 512); }
            __builtin_amdgcn_sched_barrier(0);
            __builtin_amdgcn_s_setprio(1);
#pragma unroll
            for (int d0 = 0; d0 < 4; ++d0) { p0 = MFMA32(kf[2 * d0], qr[d0], p0); p1 = MFMA32(kf[2 * d0 + 1], qr[d0], p1); }
            __builtin_amdgcn_s_setprio(0);
            const bool first = (t == 0);
            if (first) {
#pragma unroll
                for (int r = 0; r < 16; ++r) { if (crow(r, hi) >= NMETA) p0[r] = -INFINITY; p1[r] = -INFINITY; }
            }
            float ma = max3f(p0[0], p0[1], p1[0]), mb = max3f(p0[2], p0[3], p1[1]); ma = max3f(ma, p1[2], p1[3]);
#pragma unroll
            for (int r = 4; r < 16; r += 4) { ma = max3f(ma, p0[r], p0[r + 1]); mb = max3f(mb, p0[r + 2], p0[r + 3]); ma = max3f(ma, p1[r], p1[r + 1]); mb = max3f(mb, p1[r + 2], p1[r + 3]); }
            const float rm = swap32_max(max3f(ma, mb, mb));
            if (first || __any(rm > AT_THR)) {
                const float dl = first ? rm : fmaxf(rm, 0.f);
                m_run += dl;
#pragma unroll
                for (int r = 0; r < 16; ++r) { p0[r] -= dl; p1[r] -= dl; negm[r] = -m_run; }
                const float alpha = __builtin_amdgcn_exp2f(-dl);
                l_run *= alpha;
                if (!first) {
                    if (hi == 0) wsf[r32] = alpha;
                    LDS_WAIT();
#pragma unroll
                    for (int r = 0; r < 16; ++r) { const float a = wsf[crow(r, hi)];
#pragma unroll
                        for (int d0 = 0; d0 < 4; ++d0) o[d0][r] *= a; }
                    LDS_WAIT();
                }
            }
            float ls0 = 0.f, ls1 = 0.f;
#pragma unroll
            for (int r = 0; r < 16; ++r) { if (VAR != 2) { p0[r] = __builtin_amdgcn_exp2f(p0[r]); p1[r] = __builtin_amdgcn_exp2f(p1[r]); } ls0 += p0[r]; ls1 += p1[r]; }
            l_run += ls0 + ls1;
            const bf16x8 pa0 = pack8(p0, 0), pa1 = pack8(p0, 1), pa2 = pack8(p1, 0), pa3 = pack8(p1, 1);
            LAS const unsigned char* vb = sg + 16384 + ((lane >> 4) & 1) * 32 + (lane & 3) * 8 + (4 * hi + ((lane & 15) >> 2)) * 64;
            s16x4 va_[8], vb_[8];
            const unsigned vba = (unsigned)(uintptr_t)vb;
#define AT_VLD(V, d0_) do { _Pragma("unroll") for (int ks = 0; ks < 4; ++ks) { \
                asm volatile("ds_read_b64_tr_b16 %0, %1 offset:%c2" : "=v"(V[2 * ks]) : "v"(vba), "i"((d0_) * 4096 + ks * 1024)); \
                asm volatile("ds_read_b64_tr_b16 %0, %1 offset:%c2" : "=v"(V[2 * ks + 1]) : "v"(vba), "i"((d0_) * 4096 + ks * 1024 + 512)); } } while (0)
#define AT_VF(V, ks) ((bf16x8){V[2 * (ks)][0], V[2 * (ks)][1], V[2 * (ks)][2], V[2 * (ks)][3], V[2 * (ks) + 1][0], V[2 * (ks) + 1][1], V[2 * (ks) + 1][2], V[2 * (ks) + 1][3]})
#define AT_WAITL(n, V) do { asm volatile("s_waitcnt lgkmcnt(" #n ")" : "+v"(V[0]), "+v"(V[1]), "+v"(V[2]), "+v"(V[3]), "+v"(V[4]), "+v"(V[5]), "+v"(V[6]), "+v"(V[7])); __builtin_amdgcn_sched_barrier(0); } while (0)
#define AT_PV(V, d0_) do { __builtin_amdgcn_s_setprio(1); o[d0_] = MFMA32(pa0, AT_VF(V, 0), o[d0_]); o[d0_] = MFMA32(pa1, AT_VF(V, 1), o[d0_]); o[d0_] = MFMA32(pa2, AT_VF(V, 2), o[d0_]); o[d0_] = MFMA32(pa3, AT_VF(V, 3), o[d0_]); __builtin_amdgcn_s_setprio(0); } while (0)
            if (VAR != 1) {
            asm volatile("s_waitcnt lgkmcnt(0)" ::: "memory"); __builtin_amdgcn_sched_barrier(0);
            AT_VLD(va_, 0); AT_VLD(vb_, 1);
            AT_WAITL(8, va_); AT_PV(va_, 0); __builtin_amdgcn_sched_barrier(0); AT_VLD(va_, 2);
            AT_WAITL(8, vb_); AT_PV(vb_, 1); __builtin_amdgcn_sched_barrier(0); AT_VLD(vb_, 3);
            AT_WAITL(8, va_); AT_PV(va_, 2); __builtin_amdgcn_sched_barrier(0);
            AT_WAITL(0, vb_); AT_PV(vb_, 3);
            } else { o[0][0] += (float)pa0[0] + (float)pa1[1] + (float)pa2[2] + (float)pa3[3]; }
#undef AT_VF
#undef AT_WAITL
#undef AT_VLD
#undef AT_PV
        }
        if (t + 3 < ntiles) asm volatile("s_waitcnt vmcnt(8)" ::: "memory"); else if (t + 2 < ntiles) asm volatile("s_waitcnt vmcnt(4)" ::: "memory"); else asm volatile("s_waitcnt vmcnt(0)" ::: "memory");
        BAR_LDS();
    }
    if (VAR != 0) { if (o[0][0] + o[1][1] + o[2][2] + o[3][3] + l_run == 123.456f) ((float*)(P.ws + WS_DUMP))[tid] = 1.f; __syncthreads(); return; }
    l_run = swap32_add(l_run);
    const float sc = (map ? lam : 1.0f) / l_run;
    if (hi == 0) wsf[r32] = sc;
    LDS_WAIT();
#pragma unroll
    for (int r = 0; r < 16; ++r) { const float a = wsf[crow(r, hi)];
#pragma unroll
        for (int d0 = 0; d0 < 4; ++d0) o[d0][r] *= a; }
    LAS float* xb = (LAS float*)(lds + AT_XBUF + qsub * 16384);
    if (map) {
#pragma unroll
        for (int d0 = 0; d0 < 4; ++d0)
#pragma unroll
            for (int r = 0; r < 16; ++r) xb[(d0 * 16 + r) * 64 + lane] = o[d0][r];
    }
    __syncthreads();
    if (!map) {
        const float* dn = P.in[8];
        bf16_t* MIX = (bf16_t*)(P.ws + WS_MIX);
        float ss[16];
#pragma unroll
        for (int r = 0; r < 16; ++r) { ss[r] = 0.f;
#pragma unroll
            for (int d0 = 0; d0 < 4; ++d0) { o[d0][r] -= xb[(d0 * 16 + r) * 64 + lane]; ss[r] += o[d0][r] * o[d0][r]; } }
#pragma unroll
        for (int r = 0; r < 16; ++r) {
            ss[r] = half_sum32(ss[r]);
            ss[r] = 0.8f / sqrtf(ss[r] * (1.0f / 128.0f) + EPS);
        }
        float dg[4];
#pragma unroll
        for (int d0 = 0; d0 < 4; ++d0) dg[d0] = dn[32 * d0 + r32];
#pragma unroll
        for (int r = 0; r < 16; ++r) {
            bf16_t* orow = MIX + (size_t)(b * SEQ + qi * 128 + qsub * 32 + crow(r, hi)) * 1024 + h * 128 + r32;
#pragma unroll
            for (int d0 = 0; d0 < 4; ++d0) orow[32 * d0] = (bf16_t)f2bf(o[d0][r] * ss[r] * dg[d0]);
        }
    }
    __syncthreads();
#undef AT_DMA
}

template <int VAR> DI void attn_phase(const Params& P, LAS unsigned char* lds, int tid, int wave, int lane, int max_units) {
    unsigned* ctl = (unsigned*)(P.ws + WS_CTL);
    const float* lq1 = P.in[4]; const float* lk1 = P.in[5]; const float* lq2 = P.in[6]; const float* lk2 = P.in[7];
    const float lam = __expf(wave_sum(lq1[lane] * lk1[lane])) - __expf(wave_sum(lq2[lane] * lk2[lane])) + 0.2f;
    LAS volatile int* ub = (LAS volatile int*)(lds + AT_UNIT);
    const unsigned x0 = xb_xcc_id() & 7u;
    for (;;) {
        if (tid == 0) {
            int u = -1;
            for (unsigned j = 0; j < 8u && u < 0; ++j) { const unsigned x = (x0 + j) & 7u;
                if (__hip_atomic_load(ctl + CW_ATTQ + 64 * x, __ATOMIC_RELAXED, __HIP_MEMORY_SCOPE_AGENT) >= 64u) continue;
                const unsigned i = __hip_atomic_fetch_add(ctl + CW_ATTQ + 64 * x, 1u, __ATOMIC_RELAXED, __HIP_MEMORY_SCOPE_AGENT);
                if (i < 64u) u = (int)(x * 64u + i); }
            *ub = u;
        }
        __syncthreads();
        const int u = *ub;
        __syncthreads();
        if (u < 0) break;
        attn_unit<VAR>(P, lds, u >> 6, 63 - (u & 63), tid, wave, lane, lam);
        if (--max_units == 0) break;
    }
}

struct EpiOutProj {
    static constexpr bool PERM = false, AFTER_DRAIN = false;
    const float* x; float* out; bf16_t* u2;
    DI void operator()(const pg8::f32x4 (&acc)[2][2][4][2], const pg8::Unit& u, int wr, int wc, int fr, int fq) const {
        const int row0 = u.pm * 256 + wr * 64 + fr, col0 = u.pn * 256 + wc * 32 + 4 * fq;
#pragma unroll
        for (int ai = 0; ai < 2; ++ai) {
            f32x4 xv[4][2][2];
#pragma unroll
            for (int m = 0; m < 4; ++m) { const size_t off = (size_t)(row0 + ai * 128 + m * 16) * 1024 + col0;
#pragma unroll
                for (int bj = 0; bj < 2; ++bj)
#pragma unroll
                    for (int n = 0; n < 2; ++n) xv[m][bj][n] = *(const f32x4*)(x + off + bj * 128 + n * 16); }
#pragma unroll
            for (int m = 0; m < 4; ++m) { const size_t off = (size_t)(row0 + ai * 128 + m * 16) * 1024 + col0;
#pragma unroll
                for (int bj = 0; bj < 2; ++bj)
#pragma unroll
                    for (int n = 0; n < 2; ++n) { const f32x4 hv = acc[ai][bj][m][n] + xv[m][bj][n]; *(f32x4*)(out + off + bj * 128 + n * 16) = hv;
                        *(u32x2*)(u2 + off + bj * 128 + n * 16) = (u32x2){pk2(hv[0], hv[1]), pk2(hv[2], hv[3])}; } }
        }
    }
};

typedef float f32x4v __attribute__((ext_vector_type(4)));
#ifdef ROUTE_PROBE
#define ROUTE_MID_HOOK() do { XcdBarrier xb2; xb2.bar = (unsigned*)(P.ws + WS_CTL) + CW_BAR; xb2.x = xb_xcc_id(); xb2.st = (volatile LAS unsigned*)(ldsb + LDS_BYTES - 64); xcd_barrier(xb2); \
    if (blockIdx.x == 0 && threadIdx.x == 0) __hip_atomic_store((unsigned long long*)(P.ws + WS_CTL + 65536) + 20, (unsigned long long)__builtin_amdgcn_s_memrealtime(), __ATOMIC_RELAXED, __HIP_MEMORY_SCOPE_AGENT); } while (0)
#else
#define ROUTE_MID_HOOK() do {} while (0)
#endif
DI void route_tile(const Params& P, int tile, int par, LAS float* sc  , int lane, LAS unsigned char* ldsb) {
    const float* h2 = P.out; const float* WR = (const float*)(P.ws + WS_WR);
    const int r16 = lane & 15, kq = lane >> 4;
    const float* arow = h2 + (size_t)(tile * 16 + r16) * 1024 + par * 512 + kq * 8;
    const float* b0 = WR + (size_t)r16 * 1024 + par * 512 + kq * 8; const float* b1 = b0 + 16 * 1024; const float* b2 = WR + (size_t)(32 + (r16 & 3)) * 1024 + par * 512 + kq * 8;
    const float z2 = (r16 < 4) ? 1.0f : 0.0f;
    f32x4v c0 = {}, c1 = {}, c2 = {};
    float ss = 0.f;
    f32x4 bA[4][4], bB[4][4];
#define RT_LOAD(B, tb) do { _Pragma("unroll") for (int j = 0; j < 4; ++j) { const int o_ = 32 * ((tb) + (j >> 1)) + 4 * (j & 1); \
        B[j][0] = *(const f32x4*)(arow + o_); B[j][1] = *(const f32x4*)(b0 + o_); B[j][2] = *(const f32x4*)(b1 + o_); B[j][3] = *(const f32x4*)(b2 + o_); } } while (0)
#define RT_COMP(B) do { _Pragma("unroll") for (int j = 0; j < 4; ++j) { const f32x4 a = B[j][0]; ss += (a.x * a.x + a.y * a.y) + (a.z * a.z + a.w * a.w); \
        _Pragma("unroll") for (int i = 0; i < 4; ++i) { c0 = __builtin_amdgcn_mfma_f32_16x16x4f32(a[i], B[j][1][i], c0, 0, 0, 0); \
            c1 = __builtin_amdgcn_mfma_f32_16x16x4f32(a[i], B[j][2][i], c1, 0, 0, 0); c2 = __builtin_amdgcn_mfma_f32_16x16x4f32(a[i], B[j][3][i] * z2, c2, 0, 0, 0); } } } while (0)
    RT_LOAD(bA, 0);
#pragma unroll
    for (int tb = 0; tb < 16; tb += 4) {
        RT_LOAD(bB, tb + 2); __builtin_amdgcn_sched_barrier(0); RT_COMP(bA); __builtin_amdgcn_sched_barrier(0);
        if (tb + 4 < 16) { RT_LOAD(bA, tb + 4); } __builtin_amdgcn_sched_barrier(0); RT_COMP(bB); __builtin_amdgcn_sched_barrier(0); }
#undef RT_LOAD
#undef RT_COMP
    ss += swz_xor16(ss); ss = swap32_add(ss);
    LAS float* my = sc + par * 800;
#pragma unroll
    for (int r = 0; r < 4; ++r) { const int row = 4 * kq + r; my[row * 48 + r16] = c0[r]; my[row * 48 + 16 + r16] = c1[r]; my[row * 48 + 32 + r16] = c2[r]; }
    if (lane < 16) my[768 + lane] = ss;
    LAS int* lcnt = (LAS int*)(ldsb + 4 * 32768 + 1024);
    if (threadIdx.x < 32) lcnt[threadIdx.x] = 0;
    int pa = 0, pb = 0, ea_ = 0, eb_ = 0; float w1_ = 0.f, w2_ = 0.f, rs_ = 0.f;
    LDS_WAIT();
    __syncthreads();
    ROUTE_MID_HOOK();
    if (par == 0 && lane < 16) {
        LAS const float* l0 = sc + lane * 48; LAS const float* l1 = sc + 800 + lane * 48;
        const float rs = __builtin_amdgcn_rsqf((sc[768 + lane] + sc[800 + 768 + lane]) * (1.0f / 1024.0f) + EPS);
#define LG(j) (l0[j] + l1[j])
        const int t = tile * 16 + lane;
        const float* bg = P.in[16]; const float* br = P.in[18];
        const f32x4 bgv = *(const f32x4*)bg;
        float gl[4]; int gs = 0; float gm;
#pragma unroll
        for (int j = 0; j < 4; ++j) gl[j] = LG(j) * rs + bgv[j];
        gm = gl[0];
#pragma unroll
        for (int j = 1; j < 4; ++j) { const bool gt = gl[j] > gm; gm = gt ? gl[j] : gm; gs = gt ? j : gs; }
        const f32x4 br0 = *(const f32x4*)(br + gs * 8), br1 = *(const f32x4*)(br + gs * 8 + 4);
        float gsum = 0.f;
#pragma unroll
        for (int j = 0; j < 4; ++j) gsum += __expf(gl[j] - gm);
        const float psel = 1.0f / gsum;
        float e1 = -INFINITY, e2 = -INFINITY; int i1 = 0, i2 = 0;
#pragma unroll
        for (int j = 0; j < 8; ++j) {
            const float v = LG(4 + gs * 8 + j) * rs + (j < 4 ? br0[j & 3] : br1[j & 3]);
            const bool g1 = v > e1, g2 = v > e2;
            e2 = g1 ? e1 : (g2 ? v : e2); i2 = g1 ? i1 : (g2 ? j : i2);
            e1 = g1 ? v : e1; i1 = g1 ? j : i1;
        }
        const float x2 = __expf(e2 - e1), w1 = psel / (1.0f + x2), w2 = psel * x2 / (1.0f + x2);
        const int ea = gs * 8 + i1, eb = gs * 8 + i2;
        pa = (int)__hip_atomic_fetch_add(lcnt + ea, 1, __ATOMIC_RELAXED, __HIP_MEMORY_SCOPE_WORKGROUP); pb = (int)__hip_atomic_fetch_add(lcnt + eb, 1, __ATOMIC_RELAXED, __HIP_MEMORY_SCOPE_WORKGROUP);
        ea_ = ea; eb_ = eb; w1_ = w1; w2_ = w2; rs_ = rs;
        ((int*)(P.ws + WS_TOKE))[2 * t] = ea; ((int*)(P.ws + WS_TOKE))[2 * t + 1] = eb;
        ((float*)(P.ws + WS_TOKW))[2 * t] = w1; ((float*)(P.ws + WS_TOKW))[2 * t + 1] = w2;
        ((float*)(P.ws + WS_RS2))[t] = rs;
#undef LG
    }
    LDS_WAIT();
    __syncthreads();
    if (threadIdx.x < 32) { const int c = lcnt[threadIdx.x];
        lcnt[32 + threadIdx.x] = c ? (int)atomicAdd((unsigned*)(P.ws + WS_CTL) + CW_CNT + 64 * threadIdx.x, (unsigned)c) : 0; }
    LDS_WAIT();
    __syncthreads();
    if (par == 0 && lane < 16) { const int t = tile * 16 + lane;
        const int qa = lcnt[32 + ea_] + pa, qb = lcnt[32 + eb_] + pb;
        ((int*)(P.ws + WS_TOKP))[2 * t] = qa; ((int*)(P.ws + WS_TOKP))[2 * t + 1] = qb;
        ((int*)(P.ws + WS_LIST))[ea_ * 16384 + qa] = t; ((int*)(P.ws + WS_LIST))[eb_ * 16384 + qb] = t;
        ((float*)(P.ws + WS_LISTW))[ea_ * 16384 + qa] = w1_; ((float*)(P.ws + WS_LISTW))[eb_ * 16384 + qb] = w2_;
        ((float*)(P.ws + WS_LISTRS))[ea_ * 16384 + qa] = rs_; ((float*)(P.ws + WS_LISTRS))[eb_ * 16384 + qb] = rs_; }
    LDS_WAIT();
    __syncthreads();
}

#ifndef P4A_REP
#define P4A_REP 0
#endif
template <int P4A_PART> DI void phase4a(const Params& P, LAS unsigned char* lds, int gw, int NGW, int wave, int lane) {
    LAS float* scr = (LAS float*)(lds + wave * 16384);
    if (P4A_PART & 1) for (int tile = (gw >> 1); tile < MTOK / 16; tile += (NGW >> 1)) route_tile(P, tile, wave & 1, (LAS float*)(lds + (wave >> 1) * 32768), lane, lds);
    if (!(P4A_PART & 2)) return;
    bf16_t* WGU = (bf16_t*)(P.ws + WS_WGU); bf16_t* WD = (bf16_t*)(P.ws + WS_WD);
    const float* wg = P.in[19]; const float* wu = P.in[20]; const float* wd = P.in[21]; const float* gf = P.in[14];
    constexpr int I_GU = 16 * 16, I_D = 4 * 32, NIT = 32 * (I_GU + I_D);
    struct TItem { const float* src; const float* gn; bf16_t* dst; int stride, ldk; };
    auto mk = [&](int it) { TItem d; const int e = it / (I_GU + I_D), r = it % (I_GU + I_D);
        if (r < I_GU) { const int n0 = (r & 15) * 32, j = n0 >> 8, up = (n0 >> 7) & 1, k0 = (r >> 4) * 64;
            d.src = (up ? wu : wg) + (size_t)e * 1024 * 256 + (size_t)k0 * 256 + 128 * j + (n0 & 127); d.gn = gf + k0; d.stride = 256; d.ldk = 1024;
            d.dst = WGU + (size_t)e * 512 * 1024 + (size_t)n0 * 1024 + k0; }
        else { const int r2 = r - I_GU, k0 = (r2 >> 5) * 64, n0 = (r2 & 31) * 32;
            d.src = wd + (size_t)e * 256 * 1024 + (size_t)k0 * 1024 + n0; d.gn = nullptr; d.stride = 1024; d.ldk = 256;
            d.dst = WD + (size_t)e * 1024 * 256 + (size_t)n0 * 256 + k0; }
        return d; };
#define TI_LOAD(D, V, GV) do { if (D.gn) { GV[0] = *(const f32x4*)(D.gn + 8 * (lane & 7)); GV[1] = *(const f32x4*)(D.gn + 8 * (lane & 7) + 4); } else { GV[0] = (f32x4){1.f, 1.f, 1.f, 1.f}; GV[1] = GV[0]; } \
        _Pragma("unroll") for (int i = 0; i < 32; ++i) { const int kk = 2 * i + (lane >> 5); V[i] = D.src[(size_t)kk * D.stride + (lane & 31)]; } } while (0)
#define TI_FIN(D, V, GV) do { _Pragma("unroll") for (int i = 0; i < 32; ++i) scr[(2 * i + (lane >> 5)) * 33 + (lane & 31)] = V[i]; \
        LDS_WAIT(); const int c_ = lane & 7; \
        _Pragma("unroll") for (int j = 0; j < 4; ++j) { const int n_ = (lane >> 3) + 8 * j; const LAS float* s_ = scr + (8 * c_) * 33 + n_; \
            u32x4 o_; o_.x = pk2(s_[0 * 33] * GV[0][0], s_[1 * 33] * GV[0][1]); o_.y = pk2(s_[2 * 33] * GV[0][2], s_[3 * 33] * GV[0][3]); o_.z = pk2(s_[4 * 33] * GV[1][0], s_[5 * 33] * GV[1][1]); o_.w = pk2(s_[6 * 33] * GV[1][2], s_[7 * 33] * GV[1][3]); \
            *(u32x4*)(D.dst + (size_t)n_ * D.ldk + 8 * c_) = o_; } \
        LDS_WAIT(); } while (0)
    for (int rp_ = 0; rp_ < (P4A_REP ? 2 : 1); ++rp_) {
        float va[32], vb[32]; f32x4 ga[2], gb[2];
        int it = gw;
        if (it < NIT) { TItem da = mk(it); TI_LOAD(da, va, ga);
            for (;;) {
                const int itb = it + NGW; TItem db = da; const bool hb = itb < NIT;
                if (hb) { db = mk(itb); TI_LOAD(db, vb, gb); }
                TI_FIN(da, va, ga);
                if (!hb) break;
                it = itb + NGW; const bool ha = it < NIT;
                if (ha) { da = mk(it); TI_LOAD(da, va, ga); }
                TI_FIN(db, vb, gb);
                if (!ha) break;
            }
        }
    }
#undef TI_LOAD
#undef TI_FIN
}

DI void expert_layout(const Params& P, int lane, int& cnt, int& base, int& tend) {
    const unsigned* c = (const unsigned*)(P.ws + WS_CTL) + CW_CNT;
    cnt = (lane < 32) ? (int)__hip_atomic_load(c + 64 * lane, __ATOMIC_RELAXED, __HIP_MEMORY_SCOPE_AGENT) : 0;
    const int tiles = (cnt + 255) >> 8;
    int inc = 0;
#pragma unroll
    for (int i = 0; i < 32; ++i) { const int ti = __builtin_amdgcn_readlane(tiles, i); inc += (i <= lane) ? ti : 0; }
    tend = inc; base = (inc - tiles) << 8;
}

DI void phase4b(const Params& P, int gw, int NGW, int lane) {
    int cnt, base, tend; expert_layout(P, lane, cnt, base, tend);
    bf16_t* XS = (bf16_t*)(P.ws + WS_XS); float* SLOTW = (float*)(P.ws + WS_SLOTW);
    const int* TOKE = (const int*)(P.ws + WS_TOKE); const float* TOKW = (const float*)(P.ws + WS_TOKW); int* TOKP = (int*)(P.ws + WS_TOKP); const float* RS2 = (const float*)(P.ws + WS_RS2);
    for (int t = gw; t < MTOK; t += NGW) {
        const f32x4* hr = (const f32x4*)(P.out + (size_t)t * 1024);
        const float rs = RS2[t];
        u32x2 w[4];
#pragma unroll
        for (int j = 0; j < 4; ++j) { const f32x4 v = hr[64 * j + lane]; w[j] = (u32x2){pk2(v.x * rs, v.y * rs), pk2(v.z * rs, v.w * rs)}; }
#pragma unroll
        for (int k = 0; k < 2; ++k) {
            const int e = __builtin_amdgcn_readfirstlane(TOKE[2 * t + k]), slot = __builtin_amdgcn_readlane(base, e) + TOKP[2 * t + k];
            u32x2* orow = (u32x2*)(XS + (size_t)slot * 1024);
#pragma unroll
            for (int j = 0; j < 4; ++j) orow[64 * j + lane] = w[j];
            if (lane == 0) { SLOTW[slot] = TOKW[2 * t + k]; TOKP[2 * t + k] = slot; }
        }
    }
    for (int e = 0; e < 32; ++e) {
        const int ce = __builtin_amdgcn_readlane(cnt, e), be = __builtin_amdgcn_readlane(base, e), end = be + (((ce + 255) >> 8) << 8);
        for (int r = be + ce + gw; r < end; r += NGW) { u32x2* orow = (u32x2*)(XS + (size_t)r * 1024);
#pragma unroll
            for (int j = 0; j < 4; ++j) orow[64 * j + lane] = (u32x2){0u, 0u};
            if (lane == 0) SLOTW[r] = 0.f; }
    }
}

#define XCD_ORDER(blk_, G_) ((((G_) & 7) == 0) ? ((blk_) & 7) * ((G_) >> 3) + ((blk_) >> 3) : (blk_))
struct GroupedOrder {
    int tend; int total; int G, c, NS; int cnt, base; const int* LIST;
    DI unsigned rowoff(const pg8::Unit& u, int r) const {
        const int e = __builtin_amdgcn_readfirstlane(u.pn >> NS), ce = __builtin_amdgcn_readlane(cnt, e), t0 = __builtin_amdgcn_readlane(base, e) >> 8;
        const int pos = (u.pm - t0) * 256 + r;
        const int tok = pos < ce ? LIST[e * 16384 + pos] : 0;
        return (unsigned)tok * 2048u;
    }
    DI bool next(int i, pg8::Unit& u) const {
        const int L = i * G + c; if (L >= (total << NS)) return false;
        const int mt = L >> NS, j = L & ((1 << NS) - 1);
        const int e = __builtin_popcountll(__ballot(((int)(threadIdx.x & 63) < 32) && tend <= mt));
        u.pm = mt; u.pn = (e << NS) + j; return true;
    }
    DI void a_ready(const pg8::Unit&) const {}
    DI void done(const pg8::Unit&) const {}
};
struct EpiGateUp {
    static constexpr bool PERM = true, AFTER_DRAIN = false;
    const float* LISTW; const float* LISTRS; bf16_t* YS; int cnt, base;
    DI void operator()(const pg8::f32x4 (&acc)[2][2][4][2], const pg8::Unit& u, int wr, int wc, int fr, int fq) const {
        const int f0 = (u.pn & 1) * 128 + wc * 32 + fq * 8;
        const int e = __builtin_amdgcn_readfirstlane(u.pn >> 1), ce = __builtin_amdgcn_readlane(cnt, e), t0 = __builtin_amdgcn_readlane(base, e) >> 8;
        float cwv[2][4], rsv[2][4];
#pragma unroll
        for (int ai = 0; ai < 2; ++ai)
#pragma unroll
            for (int m = 0; m < 4; ++m) { const int pos = (u.pm - t0) * 256 + ai * 128 + wr * 64 + m * 16 + fr; const bool ok = pos < ce;
                cwv[ai][m] = ok ? LISTW[e * 16384 + pos] : 0.f; rsv[ai][m] = ok ? LISTRS[e * 16384 + pos] : 0.f; }
        __builtin_amdgcn_sched_barrier(0);
#pragma unroll
        for (int ai = 0; ai < 2; ++ai)
#pragma unroll
            for (int m = 0; m < 4; ++m) {
                const int r = ai * 128 + wr * 64 + m * 16 + fr, row = u.pm * 256 + r;
                const float rs = rsv[ai][m], cr = cwv[ai][m] * rs;
                float a[8];
#pragma unroll
                for (int i = 0; i < 4; ++i) {
                    const float g0 = acc[ai][0][m][0][i] * rs, g1 = acc[ai][0][m][1][i] * rs;
                    a[i] = g0 * __builtin_amdgcn_rcpf(1.0f + __expf(-g0)) * acc[ai][1][m][0][i] * cr; a[4 + i] = g1 * __builtin_amdgcn_rcpf(1.0f + __expf(-g1)) * acc[ai][1][m][1][i] * cr;
                }
                *(u32x4*)(YS + (size_t)row * 256 + f0) = (u32x4){pk2(a[0], a[1]), pk2(a[2], a[3]), pk2(a[4], a[5]), pk2(a[6], a[7])};
            }
    }
};
struct EpiDown {
    static constexpr bool PERM = true, AFTER_DRAIN = false;
    bf16_t* YO;
    DI void operator()(const pg8::f32x4 (&acc)[2][2][4][2], const pg8::Unit& u, int wr, int wc, int fr, int fq) const {
        const int c0 = (u.pn & 3) * 256 + wc * 32 + fq * 8;
#pragma unroll
        for (int ai = 0; ai < 2; ++ai)
#pragma unroll
            for (int m = 0; m < 4; ++m) {
                bf16_t* rowp = YO + (size_t)(u.pm * 256 + ai * 128 + wr * 64 + m * 16 + fr) * 1024 + c0;
#pragma unroll
                for (int bj = 0; bj < 2; ++bj) { const pg8::f32x4 v0 = acc[ai][bj][m][0], v1 = acc[ai][bj][m][1];
                    *(u32x4*)(rowp + bj * 128) = (u32x4){pk2(v0[0], v0[1]), pk2(v0[2], v0[3]), pk2(v1[0], v1[1]), pk2(v1[2], v1[3])}; }
            }
    }
};

DI void phase7(const Params& P, int gw, int NGW, int lane) {
    int cnt_, base_, tend_; expert_layout(P, lane, cnt_, base_, tend_);
    const bf16_t* YO = (const bf16_t*)(P.ws + WS_YO); const int* TOKP = (const int*)(P.ws + WS_TOKP); const int* TOKE = (const int*)(P.ws + WS_TOKE); const f32x4* nf = (const f32x4*)P.in[22];
    f32x4 nfv[4];
#pragma unroll
    for (int j = 0; j < 4; ++j) nfv[j] = nf[64 * j + lane];
    for (int t0 = gw; t0 < MTOK; t0 += 2 * NGW) {
        f32x4 v[2][4]; u32x2 hv[2][4], ya[2][4], yb[2][4];
#pragma unroll
        for (int r = 0; r < 2; ++r) { const int t = (t0 + r * NGW) < MTOK ? (t0 + r * NGW) : t0;
            const u32x2* hr = (const u32x2*)((const bf16_t*)(P.ws + WS_U2) + (size_t)t * 1024);
            const int e0 = __builtin_amdgcn_readfirstlane(TOKE[2 * t]), e1 = __builtin_amdgcn_readfirstlane(TOKE[2 * t + 1]);
            const int s0 = __builtin_amdgcn_readlane(base_, e0) + TOKP[2 * t], s1 = __builtin_amdgcn_readlane(base_, e1) + TOKP[2 * t + 1];
            const u32x2* y0 = (const u32x2*)(YO + (size_t)s0 * 1024); const u32x2* y1 = (const u32x2*)(YO + (size_t)s1 * 1024);
#pragma unroll
            for (int j = 0; j < 4; ++j) { hv[r][j] = hr[64 * j + lane]; ya[r][j] = y0[64 * j + lane]; yb[r][j] = y1[64 * j + lane]; } }
#pragma unroll
        for (int r = 0; r < 2; ++r) { const int t = t0 + r * NGW;
            if (t < MTOK) {
                float s = 0.f;
#pragma unroll
                for (int j = 0; j < 4; ++j) { const u32x2 a = ya[r][j], c = yb[r][j], hq = hv[r][j];
                    v[r][j] = (f32x4){__uint_as_float(hq.x << 16), __uint_as_float(hq.x & 0xffff0000u), __uint_as_float(hq.y << 16), __uint_as_float(hq.y & 0xffff0000u)};
                    v[r][j].x += __uint_as_float(a.x << 16) + __uint_as_float(c.x << 16); v[r][j].y += __uint_as_float(a.x & 0xffff0000u) + __uint_as_float(c.x & 0xffff0000u);
                    v[r][j].z += __uint_as_float(a.y << 16) + __uint_as_float(c.y << 16); v[r][j].w += __uint_as_float(a.y & 0xffff0000u) + __uint_as_float(c.y & 0xffff0000u);
                    s += (v[r][j].x * v[r][j].x + v[r][j].y * v[r][j].y) + (v[r][j].z * v[r][j].z + v[r][j].w * v[r][j].w); }
                s = wave_sum(s);
                const float rs = __builtin_amdgcn_rsqf(s * (1.0f / 1024.0f) + EPS);
                f32x4* hw = (f32x4*)(P.out + (size_t)t * 1024);
#pragma unroll
                for (int j = 0; j < 4; ++j) hw[64 * j + lane] = v[r][j] * rs * nfv[j];
            } }
    }
}

struct EpiNull { static constexpr bool PERM = true, AFTER_DRAIN = false; float* d;
    DI void operator()(const pg8::f32x4 (&acc)[2][2][4][2], const pg8::Unit& u, int wr, int wc, int fr, int fq) const {
        pg8::f32x4 s = acc[0][0][0][0];
#pragma unroll
        for (int ai = 0; ai < 2; ++ai)
#pragma unroll
            for (int bj = 0; bj < 2; ++bj)
#pragma unroll
                for (int m = 0; m < 4; ++m)
#pragma unroll
                    for (int n = 0; n < 2; ++n) s += acc[ai][bj][m][n];
        if (s[0] == 12345.678f) d[threadIdx.x] = s[1] + s[2] + s[3]; } };
#ifndef PHMASK
#define PHMASK 2047
#endif
#ifndef P1_STAGGER_TICKS
#define P1_STAGGER_TICKS 0
#endif
#ifndef ATT_VAR
#define ATT_VAR 0
#endif
#ifndef REPMASK
#define REPMASK 0
#endif
#define REP(bit) for (int rep_ = 0; rep_ < ((REPMASK & (bit)) ? 2 : 1); ++rep_)
#define REPSYNC(bit) if ((REPMASK & (bit)) && rep_ == 0) GRID_BAR()
typedef const __attribute__((address_space(4))) Params* KParams;
DI Params load_params(KParams kp) { Params p;
#pragma unroll
    for (int i = 0; i < 23; ++i) p.in[i] = kp->in[i];
    p.out = kp->out; p.ws = kp->ws; return p; }
__global__ void __launch_bounds__(NTHREADS, 2) hymba_fwd(Params Pin) {
    extern __shared__ __attribute__((aligned(16))) unsigned char lds_raw[];
    LAS unsigned char* lds = (LAS unsigned char*)lds_raw;
    cg::grid_group grid = cg::this_grid();
    volatile LAS unsigned* bst = (volatile LAS unsigned*)(lds + LDS_BYTES - 64);
    if (threadIdx.x < 2) bst[threadIdx.x] = 0u;
    __syncthreads();
    const XcdBarrier xbar = xcd_barrier_post((unsigned*)(Pin.ws + WS_CTL) + CW_BAR, bst);
#ifndef TPROBE
#define TPROBE (-1)
#endif
#ifndef TPROBE_A
#define TPROBE_A TPROBE
#define TPROBE_B (TPROBE + 1)
#endif
    int nstamp_ = 0;
#define STAMP() do { if (TPROBE >= 0) { if (blockIdx.x == 0 && threadIdx.x == 0) __hip_atomic_store((unsigned long long*)(Pin.ws + WS_CTL + 65536) + nstamp_, (unsigned long long)__builtin_amdgcn_s_memrealtime(), __ATOMIC_RELAXED, __HIP_MEMORY_SCOPE_AGENT); ++nstamp_; } } while (0)
#define GRID_BAR() do { xcd_barrier(xbar); STAMP(); } while (0)
    STAMP();
    const int G = gridDim.x, blk = blockIdx.x, NGW = G * NWAVES, NGT = G * NTHREADS;
#define PHASE_IDS() KParams kp_ = (KParams)__builtin_amdgcn_kernarg_segment_ptr(); asm volatile("" : "+s"(kp_)); const Params P = load_params(kp_); int tid = threadIdx.x; asm volatile("" : "+v"(tid)); const int lane = tid & 63, wave = __builtin_amdgcn_readfirstlane(tid >> 6), gw = blk * NWAVES + wave, gtid = blk * NTHREADS + tid; (void)lane; (void)gw; (void)gtid; (void)wave

    REP(1) { if (PHMASK & 1) { PHASE_IDS(); phase0(P, lds, gw, NGW, gtid, NGT, wave, lane); } REPSYNC(1); }
    GRID_BAR();
#ifdef P1_EV
#define P1_PASS(DM) { PHASE_IDS(); \
        pg8::Gemm g{(const bf16_t*)(P.ws + WS_XB), (const bf16_t*)(P.ws + WS_WINT), MROWS, NPROJ, 1024}; \
        pg8::StaticOrder S; S.init(MROWS, NPROJ, G, blk); \
        EpiInProjT<P1_EV> E{(const float*)(P.ws + WS_RS1), (const float*)(P.ws + WS_COS), (const float*)(P.ws + WS_SIN), P.in[10], P.in[11], \
                    (bf16_t*)(P.ws + WS_QB), (bf16_t*)(P.ws + WS_KT), (bf16_t*)(P.ws + WS_VT), (bf16_t*)(P.ws + WS_QKVB), (bf16_t*)(P.ws + WS_ZB), (float*)(P.ws + WS_GB), P.ws + 248 * MiB, DM, (unsigned long long*)(P.ws + WS_CTL + 65536) + 40}; \
        pg8::gemm_phase<EpiInProjT<P1_EV>, pg8::StaticOrder, true, true>(lds, g, S, E); } GRID_BAR();
    P1_PASS(0)
    P1_PASS(1)
#else
    REP(2) { if (PHMASK & 2) { PHASE_IDS();
        pg8::Gemm g{(const bf16_t*)(P.ws + WS_XB), (const bf16_t*)(P.ws + WS_WINT), MROWS, NPROJ, 1024};
        if (P1_STAGGER_TICKS > 0 && (blk & 1)) { const unsigned long long s0_ = __builtin_amdgcn_s_memrealtime(); while (__builtin_amdgcn_s_memrealtime() - s0_ < (unsigned long long)P1_STAGGER_TICKS) __builtin_amdgcn_s_sleep(8); }
        pg8::StaticOrder S; S.init(MROWS, NPROJ, G, blk);
#ifdef P1_EV
        EpiInProjT<P1_EV> E{(const float*)(P.ws + WS_RS1), (const float*)(P.ws + WS_COS), (const float*)(P.ws + WS_SIN), P.in[10], P.in[11],
                    (bf16_t*)(P.ws + WS_QB), (bf16_t*)(P.ws + WS_KT), (bf16_t*)(P.ws + WS_VT), (bf16_t*)(P.ws + WS_QKVB), (bf16_t*)(P.ws + WS_ZB), (float*)(P.ws + WS_GB), P.ws + 248 * MiB, rep_, (unsigned long long*)(P.ws + WS_CTL + 65536) + 40};
        pg8::gemm_phase<EpiInProjT<P1_EV>, pg8::StaticOrder, true, true>(lds, g, S, E);
#else
        EpiInProj E{(const float*)(P.ws + WS_RS1), (const float*)(P.ws + WS_COS), (const float*)(P.ws + WS_SIN), P.in[10], P.in[11],
                    (bf16_t*)(P.ws + WS_QB), (bf16_t*)(P.ws + WS_KT), (bf16_t*)(P.ws + WS_VT), (bf16_t*)(P.ws + WS_QKVB), (bf16_t*)(P.ws + WS_ZB), (float*)(P.ws + WS_GB), P.ws + 248 * MiB, 0, (unsigned long long*)(P.ws + WS_CTL + 65536) + 40};
        if (rep_ == 0) pg8::gemm_phase<EpiInProj, pg8::StaticOrder, true, true>(lds, g, S, E);
        else { EpiNull EN{(float*)(P.ws + WS_DUMP)}; pg8::gemm_phase<EpiNull, pg8::StaticOrder, true, true>(lds, g, S, EN); }
#endif
    } REPSYNC(2); }
    GRID_BAR();
#endif
    REP(4) { if (PHMASK & 4) { PHASE_IDS(); gdn_prep_phase(P, lds, blk, G, wave, lane); } REPSYNC(4); }
    {
        unsigned* prep = (unsigned*)(Pin.ws + WS_CTL) + CW_PREP;
        asm volatile("s_waitcnt vmcnt(0)" ::: "memory");
        __syncthreads();
        if (threadIdx.x == 0) { __builtin_amdgcn_fence(__ATOMIC_RELEASE, "agent"); asm volatile("s_waitcnt vmcnt(0)" ::: "memory");
            __hip_atomic_fetch_add(prep, 1u, __ATOMIC_RELAXED, __HIP_MEMORY_SCOPE_AGENT); }
        if (blk < 16) {
            if (threadIdx.x == 0) { unsigned sp = 0;
                while (__hip_atomic_load(prep, __ATOMIC_RELAXED, __HIP_MEMORY_SCOPE_AGENT) < (unsigned)G) { __builtin_amdgcn_s_sleep(2); if (++sp > (1u << 22)) break; }
                __builtin_amdgcn_fence(__ATOMIC_ACQUIRE, "agent"); asm volatile("s_waitcnt vmcnt(0)" ::: "memory"); }
            __syncthreads();
        }
    }
    REP(8) { if ((PHMASK & 8) && blk < 16) { PHASE_IDS(); gdn_scan(P, lds, blk, tid, wave, lane); } }
    REP(16) {
    if (PHMASK & 16) { PHASE_IDS(); if (rep_ == 0) attn_phase<0>(P, lds, tid, wave, lane, 1 << 30); else attn_phase<ATT_VAR>(P, lds, tid, wave, lane, 1 << 30); }
    if ((REPMASK & 16) && rep_ == 0) { GRID_BAR(); if (blk == 0 && threadIdx.x < 8) { PHASE_IDS(); __hip_atomic_store((unsigned*)(P.ws + WS_CTL) + CW_ATTQ + 64 * threadIdx.x, 0u, __ATOMIC_RELAXED, __HIP_MEMORY_SCOPE_AGENT); } GRID_BAR(); }
    }
    GRID_BAR();
    REP(32) { if (PHMASK & 32) { PHASE_IDS();
        pg8::Gemm g{(const bf16_t*)(P.ws + WS_MIX), (const bf16_t*)(P.ws + WS_WOUT), MTOK, 1024, 1024};
        pg8::StaticOrder S; S.init(MTOK, 1024, G, blk);
        EpiOutProj E{P.in[0], P.out, (bf16_t*)(P.ws + WS_U2)};
        pg8::gemm_phase<EpiOutProj, pg8::StaticOrder, true, true>(lds, g, S, E);
    } REPSYNC(32); }
    GRID_BAR();
#ifdef P4A_SPLIT
    if (PHMASK & 64) { PHASE_IDS(); phase4a<1>(P, lds, gw, NGW, wave, lane); }
    GRID_BAR();
    if (PHMASK & 64) { PHASE_IDS(); phase4a<2>(P, lds, gw, NGW, wave, lane); }
#else
    if (PHMASK & 64) { PHASE_IDS(); phase4a<3>(P, lds, gw, NGW, wave, lane); }
#endif
    GRID_BAR();
    int cnt, base, tend, total; { PHASE_IDS(); expert_layout(P, lane, cnt, base, tend); total = __builtin_amdgcn_readlane(tend, 31); }
    REP(256) { if (PHMASK & 256) { PHASE_IDS();
        pg8::Gemm g{(const bf16_t*)(P.ws + WS_U2), (const bf16_t*)(P.ws + WS_WGU), XS_ROWS, 32 * 512, 1024};
        GroupedOrder S{tend, total, G, XCD_ORDER(blk, G), 1, cnt, base, (const int*)(P.ws + WS_LIST)};
        EpiGateUp E{(const float*)(P.ws + WS_LISTW), (const float*)(P.ws + WS_LISTRS), (bf16_t*)(P.ws + WS_YS), cnt, base};
        pg8::gemm_phase_g<EpiGateUp, GroupedOrder, true, true>(lds, g, S, E);
    } REPSYNC(256); }
    GRID_BAR();
    REP(512) { if (PHMASK & 512) { PHASE_IDS();
        int kd = 256; asm volatile("" : "+s"(kd));
        pg8::Gemm g{(const bf16_t*)(P.ws + WS_YS), (const bf16_t*)(P.ws + WS_WD), XS_ROWS, 32 * 1024, kd};
        GroupedOrder S{tend, total, G, XCD_ORDER(blk, G), 2, cnt, base, (const int*)(P.ws + WS_LIST)};
        EpiDown E{(bf16_t*)(P.ws + WS_YO)};
        pg8::gemm_phase<EpiDown, GroupedOrder, true, true>(lds, g, S, E);
    } REPSYNC(512); }
    GRID_BAR();
    if (PHMASK & 1024) { PHASE_IDS(); phase7(P, gw, NGW, lane); }
    if (TPROBE >= 0) {
        GRID_BAR();
        const unsigned long long* st = (const unsigned long long*)(Pin.ws + WS_CTL + 65536);
        const unsigned long long t0 = __hip_atomic_load(st + TPROBE_A, __ATOMIC_RELAXED, __HIP_MEMORY_SCOPE_AGENT), t1 = __hip_atomic_load(st + TPROBE_B, __ATOMIC_RELAXED, __HIP_MEMORY_SCOPE_AGENT);
        const unsigned long long dt = (t1 - t0) * 4ull, s0 = __builtin_amdgcn_s_memrealtime();
        while (__builtin_amdgcn_s_memrealtime() - s0 < dt) __builtin_amdgcn_s_sleep(8);
    }
}

extern "C" void kernel_launch(void* const* d_in, const int* in_sizes, int n_in, void* d_out, int out_size, void* d_ws, size_t ws_size, hipStream_t stream) {
    static int grid_blocks = 0;
    if (grid_blocks == 0) {
        if (n_in != 23 || out_size != MTOK * DMODEL || ws_size < WS_END) { fprintf(stderr, "kernel_launch: unexpected shapes (n_in %d out %d ws %zu)\n", n_in, out_size, ws_size); grid_blocks = -1; return; }
        int dev = 0, cus = 0, per_cu = 0;
        hipGetDevice(&dev);
        hipDeviceGetAttribute(&cus, hipDeviceAttributeMultiprocessorCount, dev);
        hipFuncSetAttribute((const void*)hymba_fwd, hipFuncAttributeMaxDynamicSharedMemorySize, LDS_BYTES);
        hipOccupancyMaxActiveBlocksPerMultiprocessor(&per_cu, (const void*)hymba_fwd, NTHREADS, LDS_BYTES);
        if (per_cu < 1) { fprintf(stderr, "kernel_launch: occupancy query says %d blocks/CU\n", per_cu); per_cu = 1; }
        grid_blocks = cus;
        (void)hipGetLastError();
    }
    if (grid_blocks < 0) return;
    hipMemsetAsync((char*)d_ws + WS_CTL, 0, CTL_BYTES, stream);
    Params p{};
    for (int i = 0; i < 23; ++i) p.in[i] = (const float*)d_in[i];
    p.out = (float*)d_out; p.ws = (unsigned char*)d_ws;
    void* args[] = {&p};
    hipError_t e = hipLaunchCooperativeKernel((const void*)hymba_fwd, dim3(grid_blocks), dim3(NTHREADS), args, LDS_BYTES, stream);
    if (e != hipSuccess) fprintf(stderr, "cooperative launch failed: %s (grid %d)\n", hipGetErrorString(e), grid_blocks);
}
```

```cpp
#include <hip/hip_runtime.h>
#include <hip/hip_cooperative_groups.h>
#include <cstdio>
#include <cstdint>
namespace cg = cooperative_groups;
#ifndef PG8_EPI_AGAIN
#define PG8_EPI_AGAIN(x) do {} while (0)
#endif
namespace pg8 {
#define PG8_LAS __attribute__((address_space(3)))
typedef unsigned short bf16_t;
typedef short bf16x8 __attribute__((ext_vector_type(8)));
typedef float f32x4 __attribute__((ext_vector_type(4)));
typedef unsigned u32x4 __attribute__((ext_vector_type(4)));
constexpr int BM = 256, BK = 64, HALF = 128, HTB = HALF * BK * 2  , STAGE_BYTES = 8 * HTB, NXCD = 8, WGM = 8;

__host__ __device__ __forceinline__ int lds_byte(int r, int c) { const int st = (r >> 4) * 2 + (c >> 5), rr = r & 15, cc = c & 31, ob = rr * 64 + cc * 2; return st * 1024 + (ob ^ (((ob >> 9) & 1) << 5)); }
__host__ __device__ __forceinline__ void stage_rc(int b, int& R, int& C) { const int st = b / 1024, sb = b % 1024, swz = sb ^ (((sb >> 9) & 1) << 5); R = (st >> 1) * 16 + swz / 64; C = (st & 1) * 32 + (swz % 64) / 2; }
__host__ __device__ __forceinline__ int perm32(int rho) { const int n = rho >> 4, i = rho & 15; return 8 * (i >> 2) + 4 * n + (i & 3); }

template <class T, class = void> struct epi_timed { static constexpr bool v = false; };
template <class T> struct epi_timed<T, decltype((void)T::TIMED)> { static constexpr bool v = true; };
#ifndef PG8_TBLK
#define PG8_TBLK 0
#define PG8_TTID 0
#endif
struct Unit { int pm, pn; };
struct Gemm { const bf16_t* A; const bf16_t* Bt; int M, N, K; };

struct StaticOrder {
    int nM, nN, nwg, G, c;
    __host__ __device__ void init(int M, int N, int G_, int c_) { nM = M / BM; nN = N / BM; nwg = nM * nN; G = G_; c = c_; }
    __host__ __device__ bool next(int i, Unit& u) const {
        const long L = (long)i * G + c; if (L >= nwg) return false;
        int wgid = (int)L; { const int q = nwg / NXCD, r = nwg % NXCD, xcd = wgid % NXCD, off = wgid / NXCD; wgid = (xcd < r ? xcd * (q + 1) : r * (q + 1) + (xcd - r) * q) + off; }
        const int nig = WGM * nN, gid = wgid / nig, fm = gid * WGM, gsz = (nM - fm) < WGM ? (nM - fm) : WGM;
        u.pm = fm + ((wgid % nig) % gsz); u.pn = (wgid % nig) / gsz; return true;
    }
    __device__ __forceinline__ void a_ready(const Unit&) const {}
    __device__ __forceinline__ void done(const Unit&) const {}
};

__device__ __forceinline__ unsigned cvt_pk_bf16(float lo, float hi) { unsigned r; asm volatile("v_cvt_pk_bf16_f32 %0, %1, %2" : "=v"(r) : "v"(lo), "v"(hi)); return r; }
typedef float f32x2 __attribute__((ext_vector_type(2)));
template <class Epi, class Sched, bool ALIGN_EPI = false, bool SP2 = false>
__device__ __forceinline__ void gemm_phase(PG8_LAS unsigned char* lds, const Gemm g, const Sched& S, const Epi& E) {
    int tid_o = threadIdx.x; asm volatile("" : "+v"(tid_o));
    const int tid = tid_o, wid = __builtin_amdgcn_readfirstlane(tid >> 6), lane = tid & 63, wr = wid >> 2, wc = wid & 3, fr = lane & 15, fq = lane >> 4;
    const int K = g.K, nt = K / BK;
    unsigned voffA[2], voffB[2];
#pragma unroll
    for (int i = 0; i < 2; ++i) { int R, C; stage_rc(tid * 16 + i * 8192, R, C); const int Rb = Epi::PERM ? ((R & ~31) + perm32(R & 31)) : R;
        voffA[i] = (unsigned)(R * K + C) * 2u; voffB[i] = (unsigned)(Rb * K + C) * 2u; }
    const size_t kstep = (size_t)(BK * 2);
    const size_t hstep = (size_t)HALF * K * 2;
    const size_t tstep = 2 * hstep;
    const unsigned ldsw = (unsigned)wid * 1024u;
    const int aoff = lds_byte(wr * 64 + fr, fq * 8), boff = lds_byte(wc * 32 + fr, fq * 8);
#define PG8_SA(b, h) (((b) * 2 + (h)) * HTB)
#define PG8_SB(b, h) ((4 + (b) * 2 + (h)) * HTB)
#define PG8_STAGE(bufoff, gbase, voff) do { _Pragma("unroll") for (int _i = 0; _i < 2; ++_i) \
        __builtin_amdgcn_global_load_lds((const unsigned*)((const char*)(gbase) + (voff)[_i]), (PG8_LAS unsigned*)(lds + (bufoff) + ldsw + _i * 8192), 16, 0, 0); } while (0)
#define PG8_LDA(dst, b, h) do { _Pragma("unroll") for (int m = 0; m < 4; ++m) _Pragma("unroll") for (int k = 0; k < 2; ++k) dst[m][k] = *(const PG8_LAS bf16x8*)(lds + PG8_SA(b, h) + aoff + m * 2048 + k * 1024); } while (0)
#define PG8_LDB(dst, b, h) do { _Pragma("unroll") for (int n = 0; n < 2; ++n) _Pragma("unroll") for (int k = 0; k < 2; ++k) dst[n][k] = *(const PG8_LAS bf16x8*)(lds + PG8_SB(b, h) + boff + n * 2048 + k * 1024); } while (0)
#define PG8_MMA(ai, bj, At, Bt) do { __builtin_amdgcn_s_setprio(1); _Pragma("unroll") for (int m = 0; m < 4; ++m) _Pragma("unroll") for (int n = 0; n < 2; ++n) _Pragma("unroll") for (int k = 0; k < 2; ++k) \
        acc[ai][bj][m][n] = __builtin_amdgcn_mfma_f32_16x16x32_bf16(Bt[n][k], At[m][k], acc[ai][bj][m][n], 0, 0, 0); __builtin_amdgcn_s_setprio(0); } while (0)
#define PG8_WAIT_V(n) asm volatile("s_waitcnt vmcnt(" #n ")" ::: "memory")
#define PG8_WAIT_L(n) asm volatile("s_waitcnt lgkmcnt(" #n ")" ::: "memory")
#define PG8_BAR __builtin_amdgcn_s_barrier()
#define PG8_SCHED __builtin_amdgcn_sched_barrier(0)
    Unit cur, nxt; int ui = 0;
    if (!S.next(0, cur)) return;
    f32x4 acc[2][2][4][2];
#pragma unroll
    for (int a = 0; a < 2; ++a)
#pragma unroll
        for (int b = 0; b < 2; ++b)
#pragma unroll
            for (int m = 0; m < 4; ++m)
#pragma unroll
                for (int n = 0; n < 2; ++n) acc[a][b][m][n] = (f32x4){0.f, 0.f, 0.f, 0.f};
    bf16x8 At[4][2], B0[2][2], B1[2][2];
    const char* cA = (const char*)g.A + (size_t)cur.pm * tstep; const char* cB = (const char*)g.Bt + (size_t)cur.pn * tstep;
    S.a_ready(cur);
    if constexpr (SP2) {
        PG8_STAGE(PG8_SB(0, 0), cB, voffB); PG8_STAGE(PG8_SB(0, 1), cB + hstep, voffB); PG8_STAGE(PG8_SA(0, 0), cA, voffA); PG8_STAGE(PG8_SA(0, 1), cA + hstep, voffA);
        if (wr == 1) PG8_BAR;
        PG8_WAIT_V(2); PG8_BAR;
        PG8_STAGE(PG8_SB(1, 0), cB + kstep, voffB); PG8_STAGE(PG8_SA(1, 0), cA + kstep, voffA); PG8_STAGE(PG8_SB(1, 1), cB + hstep + kstep, voffB);
        PG8_WAIT_V(6); PG8_BAR;
    } else {
        PG8_STAGE(PG8_SB(0, 0), cB, voffB); PG8_STAGE(PG8_SA(0, 0), cA, voffA); PG8_STAGE(PG8_SB(0, 1), cB + hstep, voffB); PG8_STAGE(PG8_SA(0, 1), cA + hstep, voffA);
        if (wr == 1) PG8_BAR;
        PG8_WAIT_V(4); PG8_BAR;
        PG8_STAGE(PG8_SB(1, 0), cB + kstep, voffB); PG8_STAGE(PG8_SA(1, 0), cA + kstep, voffA); PG8_STAGE(PG8_SB(1, 1), cB + hstep + kstep, voffB);
        PG8_WAIT_V(6); PG8_BAR;
    }
#ifdef PG8_TSEL
    unsigned long long tsum_ = 0;
#endif
    for (;;) {
        const bool has_next = S.next(ui + 1, nxt);
        const char* nA = has_next ? (const char*)g.A + (size_t)nxt.pm * tstep : cA; const char* nB = has_next ? (const char*)g.Bt + (size_t)nxt.pn * tstep : cB;
        for (int t = 0; t < nt; t += 2) {
            const bool last = (t == nt - 2);
            const char* a1 = cA + (size_t)(t + 1) * kstep;
            const char* a2 = last ? nA : cA + (size_t)(t + 2) * kstep; const char* b2 = last ? nB : cB + (size_t)(t + 2) * kstep;
            const char* a3 = a2 + kstep; const char* b3 = b2 + kstep;
            if (last && has_next) S.a_ready(nxt);
            if constexpr (SP2) {
            PG8_LDB(B0, 0, 0); PG8_LDB(B1, 0, 1); PG8_SCHED; PG8_LDA(At, 0, 0); PG8_STAGE(PG8_SA(1, 1), a1 + hstep, voffA);
            PG8_WAIT_V(8); PG8_WAIT_L(0); PG8_BAR; PG8_MMA(0, 0, At, B0); PG8_MMA(0, 1, At, B1); PG8_BAR; PG8_SCHED;
            PG8_LDA(At, 0, 1); PG8_STAGE(PG8_SB(0, 0), b2, voffB); PG8_STAGE(PG8_SB(0, 1), b2 + hstep, voffB); PG8_STAGE(PG8_SA(0, 0), a2, voffA);
            PG8_WAIT_V(8); PG8_WAIT_L(0); PG8_BAR; PG8_MMA(1, 0, At, B0); PG8_MMA(1, 1, At, B1); PG8_BAR; PG8_SCHED;
            PG8_LDB(B0, 1, 0); PG8_LDB(B1, 1, 1); PG8_SCHED; PG8_LDA(At, 1, 0); PG8_STAGE(PG8_SA(0, 1), a2 + hstep, voffA);
            PG8_WAIT_V(8); PG8_WAIT_L(0); PG8_BAR; PG8_MMA(0, 0, At, B0); PG8_MMA(0, 1, At, B1); PG8_BAR; PG8_SCHED;
            PG8_LDA(At, 1, 1); PG8_STAGE(PG8_SB(1, 0), b3, voffB); PG8_STAGE(PG8_SB(1, 1), b3 + hstep, voffB); PG8_STAGE(PG8_SA(1, 0), a3, voffA);
            PG8_WAIT_V(8); PG8_WAIT_L(0); PG8_BAR; PG8_MMA(1, 0, At, B0); PG8_MMA(1, 1, At, B1); PG8_BAR; PG8_SCHED;
            } else {
            PG8_LDB(B0, 0, 0); PG8_SCHED; PG8_LDA(At, 0, 0); PG8_STAGE(PG8_SA(1, 1), a1 + hstep, voffA);
            PG8_WAIT_L(8); PG8_BAR; PG8_WAIT_L(0); PG8_MMA(0, 0, At, B0); PG8_BAR; PG8_SCHED;
            PG8_LDB(B1, 0, 1); PG8_STAGE(PG8_SB(0, 0), b2, voffB);
            PG8_BAR; PG8_WAIT_L(0); PG8_MMA(0, 1, At, B1); PG8_BAR;
            PG8_LDA(At, 0, 1); PG8_STAGE(PG8_SA(0, 0), a2, voffA);
            PG8_BAR; PG8_WAIT_L(0); PG8_MMA(1, 0, At, B0); PG8_BAR; PG8_SCHED;
            PG8_STAGE(PG8_SB(0, 1), b2 + hstep, voffB);
            PG8_WAIT_V(6); PG8_BAR; PG8_MMA(1, 1, At, B1); PG8_BAR;
            PG8_LDB(B0, 1, 0); PG8_SCHED; PG8_LDA(At, 1, 0); PG8_STAGE(PG8_SA(0, 1), a2 + hstep, voffA);
            PG8_WAIT_L(8); PG8_BAR; PG8_WAIT_L(0); PG8_MMA(0, 0, At, B0); PG8_BAR; PG8_SCHED;
            PG8_LDB(B1, 1, 1); PG8_STAGE(PG8_SB(1, 0), b3, voffB);
            PG8_BAR; PG8_WAIT_L(0); PG8_MMA(0, 1, At, B1); PG8_BAR;
            PG8_LDA(At, 1, 1); PG8_STAGE(PG8_SA(1, 0), a3, voffA);
            PG8_BAR; PG8_WAIT_L(0); PG8_MMA(1, 0, At, B0); PG8_BAR; PG8_SCHED;
            PG8_STAGE(PG8_SB(1, 1), b3 + hstep, voffB);
            PG8_WAIT_V(6); PG8_BAR; PG8_MMA(1, 1, At, B1); PG8_BAR;
            }
        }
#ifdef PG8_TSEL
        unsigned long long tA_ = 0, tb2_ = 0;
        if constexpr (epi_timed<Epi>::v) tA_ = __builtin_amdgcn_s_memrealtime();
#endif
        if constexpr (ALIGN_EPI) { if (wr == 0) PG8_BAR; }
#ifdef PG8_TSEL
        if constexpr (epi_timed<Epi>::v) tb2_ = __builtin_amdgcn_s_memrealtime();
#endif
#ifdef PG8_TSEL
        unsigned long long tb_ = 0;
        if constexpr (epi_timed<Epi>::v) { if (PG8_TSEL == 2) tb_ = tA_; else tb_ = __builtin_amdgcn_s_memrealtime(); }
#endif
        if constexpr (!Epi::AFTER_DRAIN) { E(acc, cur, wr, wc, fr, fq); PG8_EPI_AGAIN(E(acc, cur, wr, wc, fr, fq)); S.done(cur); }
#ifdef PG8_TSEL
        if constexpr (epi_timed<Epi>::v) { if (PG8_TSEL == 1) asm volatile("s_waitcnt vmcnt(0)" ::: "memory");
            if (PG8_TSEL == 2) tsum_ += tb2_ - tb_; else tsum_ += __builtin_amdgcn_s_memrealtime() - tb_; }
#endif
        if (!has_next) break;
#pragma unroll
        for (int a = 0; a < 2; ++a)
#pragma unroll
            for (int b = 0; b < 2; ++b)
#pragma unroll
                for (int m = 0; m < 4; ++m)
#pragma unroll
                    for (int n = 0; n < 2; ++n) acc[a][b][m][n] = (f32x4){0.f, 0.f, 0.f, 0.f};
        cur = nxt; cA = nA; cB = nB; ++ui;
        if constexpr (ALIGN_EPI) { if (wr == 1) PG8_BAR; }
    }
    PG8_WAIT_V(0);
    if constexpr (!ALIGN_EPI) { if (wr == 0) PG8_BAR; }
    PG8_BAR;
    if constexpr (Epi::AFTER_DRAIN) { E.fused(acc, cur, wr, wc, fr, fq, lds, wid, lane); S.done(cur); }
#ifdef PG8_TSEL
    if constexpr (epi_timed<Epi>::v) { if (blockIdx.x == PG8_TBLK && tid == PG8_TTID) __hip_atomic_store(E.tslot, tsum_, __ATOMIC_RELAXED, __HIP_MEMORY_SCOPE_AGENT); }
#endif
#undef PG8_SA
#undef PG8_SB
#undef PG8_STAGE
#undef PG8_LDA
#undef PG8_LDB
#undef PG8_MMA
#undef PG8_WAIT_V
#undef PG8_WAIT_L
#undef PG8_BAR
#undef PG8_SCHED
}
static_assert(true, "gather variant of gemm_phase (SP2 = true only): identical schedule, the A operand's rows are gathered through Sched::rowoff");
template <class Epi, class Sched, bool ALIGN_EPI = false, bool SP2 = false>
__device__ __forceinline__ void gemm_phase_g(PG8_LAS unsigned char* lds, const Gemm g, const Sched& S, const Epi& E) {
    int tid_o = threadIdx.x; asm volatile("" : "+v"(tid_o));
    const int tid = tid_o, wid = __builtin_amdgcn_readfirstlane(tid >> 6), lane = tid & 63, wr = wid >> 2, wc = wid & 3, fr = lane & 15, fq = lane >> 4;
    const int K = g.K, nt = K / BK;
    unsigned voffA[2], voffB[2]; int RA_[2]; unsigned CA_[2];
#pragma unroll
    for (int i = 0; i < 2; ++i) { int R, C; stage_rc(tid * 16 + i * 8192, R, C); const int Rb = Epi::PERM ? ((R & ~31) + perm32(R & 31)) : R;
        voffA[i] = (unsigned)(R * K + C) * 2u; voffB[i] = (unsigned)(Rb * K + C) * 2u; RA_[i] = R; CA_[i] = (unsigned)C * 2u; }
    const size_t kstep = (size_t)(BK * 2);
    const size_t hstep = (size_t)HALF * K * 2;
    const size_t tstep = 2 * hstep;
    const unsigned ldsw = (unsigned)wid * 1024u;
    const int aoff = lds_byte(wr * 64 + fr, fq * 8), boff = lds_byte(wc * 32 + fr, fq * 8);
#define PG8_SA(b, h) (((b) * 2 + (h)) * HTB)
#define PG8_SB(b, h) ((4 + (b) * 2 + (h)) * HTB)
#define PG8_STAGE(bufoff, gbase, voff) do { _Pragma("unroll") for (int _i = 0; _i < 2; ++_i) \
        __builtin_amdgcn_global_load_lds((const unsigned*)((const char*)(gbase) + (voff)[_i]), (PG8_LAS unsigned*)(lds + (bufoff) + ldsw + _i * 8192), 16, 0, 0); } while (0)
#define PG8_LDA(dst, b, h) do { _Pragma("unroll") for (int m = 0; m < 4; ++m) _Pragma("unroll") for (int k = 0; k < 2; ++k) dst[m][k] = *(const PG8_LAS bf16x8*)(lds + PG8_SA(b, h) + aoff + m * 2048 + k * 1024); } while (0)
#define PG8_LDB(dst, b, h) do { _Pragma("unroll") for (int n = 0; n < 2; ++n) _Pragma("unroll") for (int k = 0; k < 2; ++k) dst[n][k] = *(const PG8_LAS bf16x8*)(lds + PG8_SB(b, h) + boff + n * 2048 + k * 1024); } while (0)
#define PG8_MMA(ai, bj, At, Bt) do { __builtin_amdgcn_s_setprio(1); _Pragma("unroll") for (int m = 0; m < 4; ++m) _Pragma("unroll") for (int n = 0; n < 2; ++n) _Pragma("unroll") for (int k = 0; k < 2; ++k) \
        acc[ai][bj][m][n] = __builtin_amdgcn_mfma_f32_16x16x32_bf16(Bt[n][k], At[m][k], acc[ai][bj][m][n], 0, 0, 0); __builtin_amdgcn_s_setprio(0); } while (0)
#define PG8_WAIT_V(n) asm volatile("s_waitcnt vmcnt(" #n ")" ::: "memory")
#define PG8_WAIT_L(n) asm volatile("s_waitcnt lgkmcnt(" #n ")" ::: "memory")
#define PG8_BAR __builtin_amdgcn_s_barrier()
#define PG8_SCHED __builtin_amdgcn_sched_barrier(0)
    Unit cur, nxt; int ui = 0;
    if (!S.next(0, cur)) return;
    f32x4 acc[2][2][4][2];
#pragma unroll
    for (int a = 0; a < 2; ++a)
#pragma unroll
        for (int b = 0; b < 2; ++b)
#pragma unroll
            for (int m = 0; m < 4; ++m)
#pragma unroll
                for (int n = 0; n < 2; ++n) acc[a][b][m][n] = (f32x4){0.f, 0.f, 0.f, 0.f};
    bf16x8 At[4][2], B0[2][2], B1[2][2];
    const char* cA = (const char*)g.A; const char* cB = (const char*)g.Bt + (size_t)cur.pn * tstep;
    unsigned cA0[2], cA1[2], nA0[2], nA1[2];
#pragma unroll
    for (int i = 0; i < 2; ++i) { cA0[i] = S.rowoff(cur, RA_[i]) + CA_[i]; cA1[i] = S.rowoff(cur, 128 + RA_[i]) + CA_[i]; }
    S.a_ready(cur);
    if constexpr (SP2) {
        PG8_STAGE(PG8_SB(0, 0), cB, voffB); PG8_STAGE(PG8_SB(0, 1), cB + hstep, voffB); PG8_STAGE(PG8_SA(0, 0), cA, cA0); PG8_STAGE(PG8_SA(0, 1), cA, cA1);
        if (wr == 1) PG8_BAR;
        PG8_WAIT_V(2); PG8_BAR;
        PG8_STAGE(PG8_SB(1, 0), cB + kstep, voffB); PG8_STAGE(PG8_SA(1, 0), cA + kstep, cA0); PG8_STAGE(PG8_SB(1, 1), cB + hstep + kstep, voffB);
        PG8_WAIT_V(6); PG8_BAR;
    } else {
        PG8_STAGE(PG8_SB(0, 0), cB, voffB); PG8_STAGE(PG8_SA(0, 0), cA, voffA); PG8_STAGE(PG8_SB(0, 1), cB + hstep, voffB); PG8_STAGE(PG8_SA(0, 1), cA + hstep, voffA);
        if (wr == 1) PG8_BAR;
        PG8_WAIT_V(4); PG8_BAR;
        PG8_STAGE(PG8_SB(1, 0), cB + kstep, voffB); PG8_STAGE(PG8_SA(1, 0), cA + kstep, voffA); PG8_STAGE(PG8_SB(1, 1), cB + hstep + kstep, voffB);
        PG8_WAIT_V(6); PG8_BAR;
    }
    for (;;) {
        const bool has_next = S.next(ui + 1, nxt);
        const char* nA = cA; const char* nB = has_next ? (const char*)g.Bt + (size_t)nxt.pn * tstep : cB;
#pragma unroll
        for (int i = 0; i < 2; ++i) { nA0[i] = has_next ? S.rowoff(nxt, RA_[i]) + CA_[i] : cA0[i]; nA1[i] = has_next ? S.rowoff(nxt, 128 + RA_[i]) + CA_[i] : cA1[i]; }
        for (int t = 0; t < nt; t += 2) {
            const bool last = (t == nt - 2);
            const char* a1 = cA + (size_t)(t + 1) * kstep;
            const char* a2 = last ? nA : cA + (size_t)(t + 2) * kstep; const char* b2 = last ? nB : cB + (size_t)(t + 2) * kstep;
            const char* a3 = a2 + kstep; const char* b3 = b2 + kstep;
            unsigned sA0[2], sA1[2];
#pragma unroll
            for (int i = 0; i < 2; ++i) { sA0[i] = last ? nA0[i] : cA0[i]; sA1[i] = last ? nA1[i] : cA1[i]; }
            if (last && has_next) S.a_ready(nxt);
            if constexpr (SP2) {
            PG8_LDB(B0, 0, 0); PG8_LDB(B1, 0, 1); PG8_SCHED; PG8_LDA(At, 0, 0); PG8_STAGE(PG8_SA(1, 1), a1, cA1);
            PG8_WAIT_V(8); PG8_WAIT_L(0); PG8_BAR; PG8_MMA(0, 0, At, B0); PG8_MMA(0, 1, At, B1); PG8_BAR; PG8_SCHED;
            PG8_LDA(At, 0, 1); PG8_STAGE(PG8_SB(0, 0), b2, voffB); PG8_STAGE(PG8_SB(0, 1), b2 + hstep, voffB); PG8_STAGE(PG8_SA(0, 0), a2, sA0);
            PG8_WAIT_V(8); PG8_WAIT_L(0); PG8_BAR; PG8_MMA(1, 0, At, B0); PG8_MMA(1, 1, At, B1); PG8_BAR; PG8_SCHED;
            PG8_LDB(B0, 1, 0); PG8_LDB(B1, 1, 1); PG8_SCHED; PG8_LDA(At, 1, 0); PG8_STAGE(PG8_SA(0, 1), a2, sA1);
            PG8_WAIT_V(8); PG8_WAIT_L(0); PG8_BAR; PG8_MMA(0, 0, At, B0); PG8_MMA(0, 1, At, B1); PG8_BAR; PG8_SCHED;
            PG8_LDA(At, 1, 1); PG8_STAGE(PG8_SB(1, 0), b3, voffB); PG8_STAGE(PG8_SB(1, 1), b3 + hstep, voffB); PG8_STAGE(PG8_SA(1, 0), a3, sA0);
            PG8_WAIT_V(8); PG8_WAIT_L(0); PG8_BAR; PG8_MMA(1, 0, At, B0); PG8_MMA(1, 1, At, B1); PG8_BAR; PG8_SCHED;
            } else {
            PG8_LDB(B0, 0, 0); PG8_SCHED; PG8_LDA(At, 0, 0); PG8_STAGE(PG8_SA(1, 1), a1 + hstep, voffA);
            PG8_WAIT_L(8); PG8_BAR; PG8_WAIT_L(0); PG8_MMA(0, 0, At, B0); PG8_BAR; PG8_SCHED;
            PG8_LDB(B1, 0, 1); PG8_STAGE(PG8_SB(0, 0), b2, voffB);
            PG8_BAR; PG8_WAIT_L(0); PG8_MMA(0, 1, At, B1); PG8_BAR;
            PG8_LDA(At, 0, 1); PG8_STAGE(PG8_SA(0, 0), a2, voffA);
            PG8_BAR; PG8_WAIT_L(0); PG8_MMA(1, 0, At, B0); PG8_BAR; PG8_SCHED;
            PG8_STAGE(PG8_SB(0, 1), b2 + hstep, voffB);
            PG8_WAIT_V(6); PG8_BAR; PG8_MMA(1, 1, At, B1); PG8_BAR;
            PG8_LDB(B0, 1, 0); PG8_SCHED; PG8_LDA(At, 1, 0); PG8_STAGE(PG8_SA(0, 1), a2 + hstep, voffA);
            PG8_WAIT_L(8); PG8_BAR; PG8_WAIT_L(0); PG8_MMA(0, 0, At, B0); PG8_BAR; PG8_SCHED;
            PG8_LDB(B1, 1, 1); PG8_STAGE(PG8_SB(1, 0), b3, voffB);
            PG8_BAR; PG8_WAIT_L(0); PG8_MMA(0, 1, At, B1); PG8_BAR;
            PG8_LDA(At, 1, 1); PG8_STAGE(PG8_SA(1, 0), a3, voffA);
            PG8_BAR; PG8_WAIT_L(0); PG8_MMA(1, 0, At, B0); PG8_BAR; PG8_SCHED;
            PG8_STAGE(PG8_SB(1, 1), b3 + hstep, voffB);
            PG8_WAIT_V(6); PG8_BAR; PG8_MMA(1, 1, At, B1); PG8_BAR;
            }
        }
        if constexpr (ALIGN_EPI) { if (wr == 0) PG8_BAR; }
        if constexpr (!Epi::AFTER_DRAIN) { E(acc, cur, wr, wc, fr, fq); PG8_EPI_AGAIN(E(acc, cur, wr, wc, fr, fq)); S.done(cur); }
        if (!has_next) break;
#pragma unroll
        for (int a = 0; a < 2; ++a)
#pragma unroll
            for (int b = 0; b < 2; ++b)
#pragma unroll
                for (int m = 0; m < 4; ++m)
#pragma unroll
                    for (int n = 0; n < 2; ++n) acc[a][b][m][n] = (f32x4){0.f, 0.f, 0.f, 0.f};
        cur = nxt; cA = nA; cB = nB; ++ui;
#pragma unroll
        for (int i = 0; i < 2; ++i) { cA0[i] = nA0[i]; cA1[i] = nA1[i]; }
        if constexpr (ALIGN_EPI) { if (wr == 1) PG8_BAR; }
    }
    PG8_WAIT_V(0);
    if constexpr (!ALIGN_EPI) { if (wr == 0) PG8_BAR; }
    PG8_BAR;
    if constexpr (Epi::AFTER_DRAIN) { E.fused(acc, cur, wr, wc, fr, fq, lds, wid, lane); S.done(cur); }
#undef PG8_SA
#undef PG8_SB
#undef PG8_STAGE
#undef PG8_LDA
#undef PG8_LDB
#undef PG8_MMA
#undef PG8_WAIT_V
#undef PG8_WAIT_L
#undef PG8_BAR
#undef PG8_SCHED
}
}

#define DI __device__ __forceinline__
#define LAS __attribute__((address_space(3)))
typedef unsigned short bf16_t;
typedef short bf16x8 __attribute__((ext_vector_type(8)));
typedef short s16x4 __attribute__((ext_vector_type(4)));
typedef short v4i16_t __attribute__((ext_vector_type(4)));
typedef float f32x4 __attribute__((ext_vector_type(4)));
typedef float f32x16 __attribute__((ext_vector_type(16)));
typedef unsigned u32x4 __attribute__((ext_vector_type(4)));
typedef unsigned u32x2 __attribute__((ext_vector_type(2)));
typedef float f32x2_t __attribute__((ext_vector_type(2)));
typedef __bf16 bf16x2_t __attribute__((ext_vector_type(2)));

constexpr int NWAVES = 8, NTHREADS = 512;
constexpr int SEQ = 8192, DMODEL = 1024, NMETA = 16, LTOK = SEQ + NMETA  , LP = 8256  , NCHUNK = 129;
constexpr int MTOK = 2 * SEQ;
constexpr int MROWS = 16640;
constexpr int NPROJ = 3840;
constexpr int NKT = 129;
constexpr float EPS = 1e-6f;
constexpr float C2Q = 0.125f * 1.4426950408889634f;
constexpr int XS_ROWS = 41216;

constexpr size_t MiB = 1u << 20;
constexpr size_t WS_CTL = 0, CTL_BYTES = 1 * MiB;
constexpr size_t WS_RS1 = 1 * MiB;
constexpr size_t WS_RS2 = WS_RS1 + 128 * 1024;
constexpr size_t WS_TOKE = WS_RS2 + 128 * 1024;
constexpr size_t WS_TOKW = WS_TOKE + 128 * 1024;
constexpr size_t WS_TOKP = WS_TOKW + 128 * 1024;
constexpr size_t WS_SLOTW = WS_TOKP + 128 * 1024;
constexpr size_t WS_WR = WS_SLOTW + 192 * 1024;
constexpr size_t WS_GL = WS_WR + 160 * 1024;
constexpr size_t WS_DUMP = 2 * MiB;
constexpr size_t WS_COS = 2 * MiB;
constexpr size_t WS_SIN = WS_COS + 1280 * 1024;
constexpr size_t WS_GB = WS_SIN + 1280 * 1024;
constexpr size_t WS_WOUT = 6 * MiB;
constexpr size_t WS_WINT = 8 * MiB;
constexpr size_t WS_XB = WS_WINT + (size_t)NPROJ * 1024 * 2;
constexpr size_t WS_MIX = 8 * MiB;
constexpr size_t WS_QKVB = 48 * MiB;
constexpr size_t WS_QB = WS_QKVB + (size_t)2 * LP * 1536 * 2 + 128 * 1024;
constexpr size_t WS_KT = WS_QB + 16 * MiB;
constexpr size_t WS_VT = WS_KT + (size_t)16 * NKT * 4096 * 2;
constexpr size_t WS_ZB = WS_VT + (size_t)8 * NKT * 8192 * 2;
constexpr size_t WS_GP = WS_ZB + (size_t)2 * LP * 512 * 2;
constexpr size_t GP_ARR = (size_t)2064 * 4096 * 2;
constexpr size_t WS_GP_END = WS_GP + 5 * GP_ARR;
constexpr size_t WS_WGU = 48 * MiB;
constexpr size_t WS_WD = 80 * MiB;
constexpr size_t WS_U2 = 96 * MiB;
constexpr size_t WS_LIST = 240 * MiB;
constexpr size_t WS_LISTW = 242 * MiB;
constexpr size_t WS_LISTRS = 244 * MiB;
constexpr size_t WS_XS = 96 * MiB;
constexpr size_t WS_YO = 128 * MiB;
constexpr size_t WS_YS = 8 * MiB;
constexpr size_t WS_END = 256 * MiB;
static_assert(WS_GB + (size_t)2 * LP * 16 * 4 <= WS_WOUT, "small region");
static_assert(WS_XB + (size_t)MROWS * 1024 * 2 <= WS_QKVB, "XB");
static_assert(WS_GP_END <= WS_END, "GDN prep arrays");
static_assert(WS_YS + (size_t)XS_ROWS * 256 * 2 <= WS_END, "YS");
static_assert(WS_WD + (size_t)32 * 1024 * 256 * 2 <= WS_XS, "WD");
constexpr int CW_ATTQ = 2112;
constexpr int CW_PREP = 2688;
constexpr int CW_CNT = 64;
constexpr int CW_TILE = 8192;
constexpr int CW_BAR = 4096;

constexpr int LDS_BYTES = 147456;

struct Params { const float* in[23]; float* out; unsigned char* ws; };

DI unsigned f2bf(float f) { unsigned u = __float_as_uint(f); return (u + 0x7fffu + ((u >> 16) & 1u)) >> 16; }
DI unsigned pk2(float lo, float hi) { f32x2_t v = {lo, hi}; bf16x2_t b = __builtin_convertvector(v, bf16x2_t); return __builtin_bit_cast(unsigned, b); }
DI float bf2f(unsigned short h) { return __uint_as_float(((unsigned)h) << 16); }
DI float rlane(float v, int l) { return __int_as_float(__builtin_amdgcn_readlane(__float_as_int(v), l)); }
#define DPP_ADD(v, ctrl) ((v) + __int_as_float(__builtin_amdgcn_update_dpp(0, __float_as_int(v), (ctrl), 0xF, 0xF, true)))
DI u32x2 pack_quad_bf16(float v) {
    const float v1 = __int_as_float(__builtin_amdgcn_update_dpp(0, __float_as_int(v), 0xB1, 0xF, 0xF, true));
    const unsigned p = pk2(v, v1);
    const unsigned q = (unsigned)__builtin_amdgcn_update_dpp(0, (int)p, 0x4E, 0xF, 0xF, true);
    return (u32x2){p, q};
}
typedef __attribute__((address_space(1))) u32x2 g_u32x2;
DI void store_quad_bf16(bf16_t* dst  , float v, int lane) {
    const float v1 = __int_as_float(__builtin_amdgcn_update_dpp(0, __float_as_int(v), 0xB1, 0xF, 0xF, true));
    const unsigned p = pk2(v, v1);
    const unsigned q = (unsigned)__builtin_amdgcn_update_dpp(0, (int)p, 0x4E, 0xF, 0xF, true);
    if ((lane & 3) == 0) *(u32x2*)dst = (u32x2){p, q};
}
DI float wave_sum_dpp(float v) {
    v = DPP_ADD(v, 0xB1);
    v = DPP_ADD(v, 0x4E);
    v = DPP_ADD(v, 0x141);
    v = DPP_ADD(v, 0x140);
    return (rlane(v, 0) + rlane(v, 16)) + (rlane(v, 32) + rlane(v, 48));
}
DI float wave_sum(float v) { return wave_sum_dpp(v); }
DI float swz_xor16(float v) { return __int_as_float(__builtin_amdgcn_ds_swizzle(__float_as_int(v), 0x401F)); }
DI float row_sum16(float v) { v = DPP_ADD(v, 0xB1); v = DPP_ADD(v, 0x4E); v = DPP_ADD(v, 0x141); v = DPP_ADD(v, 0x140); return v; }
DI float half_sum32(float v) { v = row_sum16(v); return v + swz_xor16(v); }
DI float swap32_add(float v) { auto rr = __builtin_amdgcn_permlane32_swap(__float_as_uint(v), __float_as_uint(v), false, false); return __uint_as_float(rr[0]) + __uint_as_float(rr[1]); }
DI float swap32_max(float v) { auto rr = __builtin_amdgcn_permlane32_swap(__float_as_uint(v), __float_as_uint(v), false, false); return fmaxf(__uint_as_float(rr[0]), __uint_as_float(rr[1])); }
#define LDS_WAIT() asm volatile("s_waitcnt lgkmcnt(0)" ::: "memory")
#define BAR_LDS() do { asm volatile("s_waitcnt lgkmcnt(0)" ::: "memory"); __builtin_amdgcn_s_barrier(); asm volatile("" ::: "memory"); } while (0)
#define MFMA32(a, b, c) __builtin_amdgcn_mfma_f32_32x32x16_bf16((a), (b), (c), 0, 0, 0)
DI int crow(int r, int hi) { return (r & 3) + 8 * (r >> 2) + 4 * hi; }
DI int perm16(int x) { return (x & ~12) | ((x & 4) << 1) | ((x & 8) >> 1); }
DI bf16x8 pack8(const f32x16& x, int s) {
    u32x4 p; p.x = pk2(x[8 * s], x[8 * s + 1]); p.y = pk2(x[8 * s + 2], x[8 * s + 3]); p.z = pk2(x[8 * s + 4], x[8 * s + 5]); p.w = pk2(x[8 * s + 6], x[8 * s + 7]);
    return __builtin_bit_cast(bf16x8, p);
}
DI int orig_col(int n) {
    if (n >= 1024) return n;
    const int hh = n >> 6, c2 = n & 63, g8 = c2 >> 3, i = c2 & 7;
    return (hh << 6) + ((i < 4) ? 4 * g8 + i : 32 + 4 * g8 + (i - 4));
}
DI size_t kt_off(int b, int hh, int p, int d) {
    const int tile = p < 16 ? 0 : 1 + ((p - 16) >> 6), kv = p < 16 ? p : ((p - 16) & 63);
    return ((size_t)((b * 8 + hh) * NKT + tile) << 12) + ((d >> 3) << 9) + (kv << 3) + (d & 7);
}
DI size_t vt_off(int b, int h, int p, int d) {
    const int tile = p < 16 ? 0 : 1 + ((p - 16) >> 6), kv = p < 16 ? p : ((p - 16) & 63);
    return ((size_t)((b * 4 + h) * NKT + tile) << 13) + ((d >> 5) << 11) + ((kv >> 4) << 9) + ((kv & 15) << 5) + (d & 31);
}

template <class Src> DI void transpose_item(const Src& src, bf16_t* WT, size_t ldk, int k0, int n0, LAS float* scr, int lane) {
    float v[32];
    const int c = lane & 7;
    f32x4 g0, g1; src.gain(k0 + 8 * c, g0, g1);
#pragma unroll
    for (int i = 0; i < 32; ++i) v[i] = src(k0 + 2 * i + (lane >> 5), n0 + (lane & 31));
#pragma unroll
    for (int i = 0; i < 32; ++i) scr[(2 * i + (lane >> 5)) * 33 + (lane & 31)] = v[i];
    LDS_WAIT();
#pragma unroll
    for (int j = 0; j < 4; ++j) { const int n = (lane >> 3) + 8 * j; const LAS float* s = scr + (8 * c) * 33 + n;
        u32x4 o; o.x = pk2(s[0 * 33] * g0[0], s[1 * 33] * g0[1]); o.y = pk2(s[2 * 33] * g0[2], s[3 * 33] * g0[3]); o.z = pk2(s[4 * 33] * g1[0], s[5 * 33] * g1[1]); o.w = pk2(s[6 * 33] * g1[2], s[7 * 33] * g1[3]);
        *(u32x4*)(WT + (size_t)(n0 + n) * ldk + k0 + 8 * c) = o; }
    LDS_WAIT();
}
struct SrcWin { const float* w; const float* g; DI float operator()(int k, int n) const { return n >= 3600 ? 0.f : w[(size_t)k * 3600 + orig_col(n)]; }
    DI void gain(int k, f32x4& a, f32x4& b) const { a = *(const f32x4*)(g + k); b = *(const f32x4*)(g + k + 4); } };
struct SrcPlain { const float* w; int N; DI float operator()(int k, int n) const { return w[(size_t)k * N + n]; }
    DI void gain(int, f32x4& a, f32x4& b) const { a = (f32x4){1.f, 1.f, 1.f, 1.f}; b = a; } };
struct SrcGU { const float* w; const float* g; int fadj; DI float operator()(int k, int n) const { return w[(size_t)k * 256 + n + fadj] * g[k]; } };

#ifndef P0_REP
#define P0_REP 0
#endif
DI void phase0(const Params& P, LAS unsigned char* lds, int gw, int NGW, int gtid, int NGT, int wave, int lane) {
    LAS float* scr = (LAS float*)(lds + wave * 16384);
    bf16_t* WINT = (bf16_t*)(P.ws + WS_WINT); bf16_t* WOUT = (bf16_t*)(P.ws + WS_WOUT); bf16_t* XB = (bf16_t*)(P.ws + WS_XB);
    float* RS1 = (float*)(P.ws + WS_RS1);
    constexpr int I_IN = 16 * (NPROJ / 32), I_OUT = 16 * 32;
    const SrcWin sw{P.in[3], P.in[2]}; const SrcPlain so{P.in[13], 1024};
    for (int rp_ = 0; rp_ < ((P0_REP & 1) ? 2 : 1); ++rp_)
    for (int it = gw; it < I_IN + I_OUT; it += NGW) {
        if (it < I_IN) transpose_item(sw, WINT, 1024, (it / (NPROJ / 32)) * 64, (it % (NPROJ / 32)) * 32, scr, lane);
        else { const int r = it - I_IN; transpose_item(so, WOUT, 1024, (r >> 5) * 64, (r & 31) * 32, scr, lane); }
    }
    const float* x = P.in[0]; const float* meta = P.in[1];
    for (int rp_ = 0; rp_ < ((P0_REP & 2) ? 2 : 1); ++rp_)
    for (int m0 = gw; m0 < MROWS; m0 += 4 * NGW) {
        f32x4 v[4][4];
#pragma unroll
        for (int r = 0; r < 4; ++r) { const int m = m0 + r * NGW;
            const bool real = m < MTOK + NMETA;
            const f32x4* xr = (const f32x4*)((m < MTOK) ? x + (size_t)m * 1024 : meta + (size_t)((real ? m : MTOK) - MTOK) * 1024);
#pragma unroll
            for (int j = 0; j < 4; ++j) v[r][j] = (m < MROWS) ? xr[64 * j + lane] : (f32x4){0.f, 0.f, 0.f, 0.f}; }
#pragma unroll
        for (int r = 0; r < 4; ++r) { const int m = m0 + r * NGW;
            if (m < MROWS) {
                const bool real = m < MTOK + NMETA;
                float s = 0.f;
#pragma unroll
                for (int j = 0; j < 4; ++j) { if (!real) v[r][j] = (f32x4){0.f, 0.f, 0.f, 0.f}; s += (v[r][j].x * v[r][j].x + v[r][j].y * v[r][j].y) + (v[r][j].z * v[r][j].z + v[r][j].w * v[r][j].w); }
                s = wave_sum(s);
                if (lane == 0) RS1[m] = real ? __builtin_amdgcn_rsqf(s * (1.0f / 1024.0f) + EPS) : 0.f;
                u32x2* orow = (u32x2*)(XB + (size_t)m * 1024);
#pragma unroll
                for (int j = 0; j < 4; ++j) orow[64 * j + lane] = (u32x2){pk2(v[r][j].x, v[r][j].y), pk2(v[r][j].z, v[r][j].w)};
            } }
    }
    float* COS = (float*)(P.ws + WS_COS); float* SIN = (float*)(P.ws + WS_SIN);
    for (int rp_ = 0; rp_ < ((P0_REP & 4) ? 2 : 1); ++rp_)
    for (int i = gtid; i < LTOK * 32; i += NGT) {
        const int p = i >> 5, f = i & 31;
        const double rev = (double)p * exp2(-(double)f * (13.287712379549449 / 32.0)) * 0.15915494309189535;
        const float fr = (float)(rev - floor(rev));
        COS[i] = __builtin_amdgcn_cosf(fr); SIN[i] = __builtin_amdgcn_sinf(fr);
    }
    float* WR = (float*)(P.ws + WS_WR); const float* gf = P.in[14]; const float* wgrp = P.in[15]; const float* wrt = P.in[17];
    for (int i = gtid; i < 36 * 1024; i += NGT) { const int j = i >> 10, k = i & 1023; WR[i] = gf[k] * (j < 4 ? wgrp[k * 4 + j] : wrt[k * 32 + (j - 4)]); }
}

#ifndef EPI_NT
#define EPI_NT 0
#endif
#if EPI_NT
#define NT_ST(p, v) __builtin_nontemporal_store((v), (p))
#else
#define NT_ST(p, v) do { if (EV == 1) { auto p_ = (p); *(decltype(p_))(dmask ? dumpb + ((unsigned long long)p_ & 0xFFFF0ull) : (unsigned char*)p_) = (v); } else *(p) = (v); } while (0)
#endif
template <int EV> struct EpiInProjT {
    static constexpr bool PERM = true, AFTER_DRAIN = false, TIMED = true;
    const float* RS1; const float* COS; const float* SIN; const float* a_log; const float* dt_bias;
    bf16_t* QB; bf16_t* KT; bf16_t* VT; bf16_t* QKVB; bf16_t* ZB; float* GB; unsigned char* dumpb; int dmask; unsigned long long* tslot;
    DI void tail(const pg8::f32x4 (&acc)[2][2][4][2], const pg8::Unit& u, int wr, int wc, int fr, int fq) const {
        const int pn = u.pn;
#pragma unroll
        for (int ai = 0; ai < 2; ++ai)
#pragma unroll
            for (int m = 0; m < 4; ++m) {
                const int row = u.pm * 256 + ai * 128 + wr * 64 + m * 16 + fr;
                if (row < MTOK + NMETA) {
                    const float rs = RS1[row];
                    const bool meta = row >= MTOK;
                    const int p = meta ? row - MTOK : (row & 8191) + NMETA;
                    const int b0 = meta ? 0 : (row >> 13), nb = meta ? 2 : 1;
#pragma unroll
                    for (int bj = 0; bj < 2; ++bj) {
                        float xv[8];
#pragma unroll
                        for (int i = 0; i < 4; ++i) { xv[i] = acc[ai][bj][m][0][i] * rs; xv[4 + i] = acc[ai][bj][m][1][i] * rs; }
                        if (pn < 4) {
                            const int hh = (pn & 1) * 4 + bj * 2 + (wc >> 1), d0 = 4 * (4 * (wc & 1) + fq);
                            const f32x4 cs = *(const f32x4*)(COS + p * 32 + d0), sn = *(const f32x4*)(SIN + p * 32 + d0);
                            float lo[4], hi[4];
#pragma unroll
                            for (int i = 0; i < 4; ++i) { lo[i] = xv[i] * cs[i] - xv[4 + i] * sn[i]; hi[i] = xv[4 + i] * cs[i] + xv[i] * sn[i]; }
                            if (pn < 2) {
                                if (!meta) {
                                    bf16_t* q = QB + ((size_t)((b0 * 8 + hh) * SEQ + (p - NMETA)) << 6) + d0;
                                    *(u32x2*)q = (u32x2){pk2(lo[0] * C2Q, lo[1] * C2Q), pk2(lo[2] * C2Q, lo[3] * C2Q)};
                                    *(u32x2*)(q + 32) = (u32x2){pk2(hi[0] * C2Q, hi[1] * C2Q), pk2(hi[2] * C2Q, hi[3] * C2Q)};
                                }
                            } else {
                                for (int bb = b0; bb < b0 + nb; ++bb) {
                                    *(u32x2*)(KT + kt_off(bb, hh, p, d0)) = (u32x2){pk2(lo[0], lo[1]), pk2(lo[2], lo[3])};
                                    *(u32x2*)(KT + kt_off(bb, hh, p, d0 + 32)) = (u32x2){pk2(hi[0], hi[1]), pk2(hi[2], hi[3])};
                                }
                            }
                        } else {
                            const u32x4 w = (u32x4){pk2(xv[0], xv[1]), pk2(xv[2], xv[3]), pk2(xv[4], xv[5]), pk2(xv[6], xv[7])};
                            const int cl = bj * 128 + wc * 32 + fq * 8;
                            if (pn < 6) {
                                const int h = (pn - 4) * 2 + bj, d = wc * 32 + fq * 8;
                                for (int bb = b0; bb < b0 + nb; ++bb) *(u32x4*)(VT + vt_off(bb, h, p, d)) = w;
                            } else if (pn < 12) {
                                for (int bb = b0; bb < b0 + nb; ++bb) *(u32x4*)(QKVB + (size_t)(bb * LP + p) * 1536 + (pn - 6) * 256 + cl) = w;
                            } else if (pn < 14) {
                                float sz[8];
#pragma unroll
                                for (int i = 0; i < 8; ++i) sz[i] = xv[i] * __builtin_amdgcn_rcpf(1.0f + __expf(-xv[i]));
                                const u32x4 wz = (u32x4){pk2(sz[0], sz[1]), pk2(sz[2], sz[3]), pk2(sz[4], sz[5]), pk2(sz[6], sz[7])};
                                for (int bb = b0; bb < b0 + nb; ++bb) *(u32x4*)(ZB + (size_t)(bb * LP + p) * 512 + (pn - 12) * 256 + cl) = wz;
                            } else if (cl < 16) {
                                float o[8];
                                if (cl == 0) {
#pragma unroll
                                    for (int i = 0; i < 8; ++i) { const float t = xv[i] + dt_bias[i]; const float sp = fmaxf(t, 0.f) + __logf(1.0f + __expf(-fabsf(t))); o[i] = -__expf(a_log[i]) * sp; }
                                } else {
#pragma unroll
                                    for (int i = 0; i < 8; ++i) o[i] = __builtin_amdgcn_rcpf(1.0f + __expf(-xv[i]));
                                }
                                for (int bb = b0; bb < b0 + nb; ++bb) { float* g = GB + ((size_t)(bb * LP + p) << 4) + cl;
                                    *(f32x4*)g = (f32x4){o[0], o[1], o[2], o[3]}; *(f32x4*)(g + 4) = (f32x4){o[4], o[5], o[6], o[7]}; }
                            }
                        }
                    }
                }
            }
    }

    DI void operator()(const pg8::f32x4 (&acc)[2][2][4][2], const pg8::Unit& u, int wr, int wc, int fr, int fq) const {
        if (u.pm >= MTOK / 256) { tail(acc, u, wr, wc, fr, fq); return; }
        const int pn = u.pn, rowb = u.pm * 256 + wr * 64 + fr;
        float rs[2][4];
#pragma unroll
        for (int ai = 0; ai < 2; ++ai)
#pragma unroll
            for (int m = 0; m < 4; ++m) rs[ai][m] = (EV == 2) ? 1.0f : RS1[rowb + ai * 128 + m * 16];
        __builtin_amdgcn_sched_barrier(0);
        const int b = rowb >> 13, s0 = rowb & 8191;
        if (pn < 4) {
            const int d0 = 4 * (4 * (wc & 1) + fq);
#pragma unroll
            for (int ai = 0; ai < 2; ++ai) {
                f32x4 cs[4], sn[4];
#pragma unroll
                for (int m = 0; m < 4; ++m) { const int p = s0 + ai * 128 + m * 16 + NMETA; if (EV == 2) { cs[m] = (f32x4){1.f, 1.f, 1.f, 1.f}; sn[m] = (f32x4){0.f, 0.f, 0.f, 0.f}; } else { cs[m] = *(const f32x4*)(COS + p * 32 + d0); sn[m] = *(const f32x4*)(SIN + p * 32 + d0); } }
                __builtin_amdgcn_sched_barrier(0);
#pragma unroll
                for (int m = 0; m < 4; ++m)
#pragma unroll
                    for (int bj = 0; bj < 2; ++bj) {
                        const int hh = (pn & 1) * 4 + bj * 2 + (wc >> 1), s = s0 + ai * 128 + m * 16;
                        float lo[4], hi[4];
#pragma unroll
                        for (int i = 0; i < 4; ++i) { const float x1 = acc[ai][bj][m][0][i] * rs[ai][m], x2 = acc[ai][bj][m][1][i] * rs[ai][m];
                            lo[i] = x1 * cs[m][i] - x2 * sn[m][i]; hi[i] = x2 * cs[m][i] + x1 * sn[m][i]; }
                        if (pn < 2) { bf16_t* q = QB + ((size_t)((b * 8 + hh) * SEQ + s) << 6) + d0;
                            NT_ST((u32x2*)q, ((u32x2){pk2(lo[0] * C2Q, lo[1] * C2Q), pk2(lo[2] * C2Q, lo[3] * C2Q)}));
                            NT_ST((u32x2*)(q + 32), ((u32x2){pk2(hi[0] * C2Q, hi[1] * C2Q), pk2(hi[2] * C2Q, hi[3] * C2Q)}));
                        } else { bf16_t* k = KT + ((size_t)((b * 8 + hh) * NKT + 1 + (s >> 6)) << 12) + ((d0 >> 3) << 9) + ((s & 63) << 3) + (d0 & 7);
                            NT_ST((u32x2*)k, ((u32x2){pk2(lo[0], lo[1]), pk2(lo[2], lo[3])}));
                            NT_ST((u32x2*)(k + 4 * 512), ((u32x2){pk2(hi[0], hi[1]), pk2(hi[2], hi[3])})); }
                    }
            }
            return;
        }
        const int cl = wc * 32 + fq * 8;
#pragma unroll
        for (int ai = 0; ai < 2; ++ai)
#pragma unroll
            for (int m = 0; m < 4; ++m)
#pragma unroll
                for (int bj = 0; bj < 2; ++bj) {
                    const int s = s0 + ai * 128 + m * 16, p = s + NMETA;
                    float xv[8];
#pragma unroll
                    for (int i = 0; i < 4; ++i) { xv[i] = acc[ai][bj][m][0][i] * rs[ai][m]; xv[4 + i] = acc[ai][bj][m][1][i] * rs[ai][m]; }
                    if (pn < 6) {
                        const int h = (pn - 4) * 2 + bj;
                        NT_ST((u32x4*)(VT + ((size_t)((b * 4 + h) * NKT + 1 + (s >> 6)) << 13) + ((cl >> 5) << 11) + (((s & 63) >> 4) << 9) + ((s & 15) << 5) + (cl & 31)),
                            ((u32x4){pk2(xv[0], xv[1]), pk2(xv[2], xv[3]), pk2(xv[4], xv[5]), pk2(xv[6], xv[7])}));
                    } else if (pn < 12) {
                        NT_ST((u32x4*)(QKVB + (size_t)(b * LP + p) * 1536 + (pn - 6) * 256 + bj * 128 + cl), ((u32x4){pk2(xv[0], xv[1]), pk2(xv[2], xv[3]), pk2(xv[4], xv[5]), pk2(xv[6], xv[7])}));
                    } else if (pn < 14) {
#pragma unroll
                        for (int i = 0; i < 8; ++i) xv[i] = xv[i] * __builtin_amdgcn_rcpf(1.0f + __expf(-xv[i]));
                        NT_ST((u32x4*)(ZB + (size_t)(b * LP + p) * 512 + (pn - 12) * 256 + bj * 128 + cl), ((u32x4){pk2(xv[0], xv[1]), pk2(xv[2], xv[3]), pk2(xv[4], xv[5]), pk2(xv[6], xv[7])}));
                    } else if (bj == 0 && cl < 16) {
                        float o[8];
                        if (cl == 0) {
#pragma unroll
                            for (int i = 0; i < 8; ++i) { const float t = xv[i] + dt_bias[i]; const float sp = fmaxf(t, 0.f) + __logf(1.0f + __expf(-fabsf(t))); o[i] = -__expf(a_log[i]) * sp; }
                        } else {
#pragma unroll
                            for (int i = 0; i < 8; ++i) o[i] = __builtin_amdgcn_rcpf(1.0f + __expf(-xv[i]));
                        }
                        float* g = GB + ((size_t)(b * LP + p) << 4) + cl;
                        *(f32x4*)g = (f32x4){o[0], o[1], o[2], o[3]}; *(f32x4*)(g + 4) = (f32x4){o[4], o[5], o[6], o[7]};
                    }
                }
    }
};
typedef EpiInProjT<0> EpiInProj;

DI bf16x8 lds_frag(LAS const bf16_t* M, int row, int ch) { return *(LAS const bf16x8*)((LAS const unsigned char*)M + row * 128 + ((ch ^ (row & 7)) << 4)); }
DI s16x4 tr_read_b64(LAS const unsigned char* p) { return __builtin_bit_cast(s16x4, __builtin_amdgcn_ds_read_tr16_b64_v4i16((LAS v4i16_t*)p)); }
DI bf16x8 lds_frag_plain(LAS const bf16_t* M, int row, int ch) { return *(LAS const bf16x8*)((LAS const unsigned char*)M + row * 128 + (ch << 4)); }
DI int swz_idx(int row, int d) { return row * 64 + ((((d >> 3) ^ (row & 7)) << 3) | (d & 7)); }

#ifndef PREP_REP
#define PREP_REP 0
#endif
constexpr int PREP_PAIR = 35840;

template <int MAT> DI void prep_rows(const bf16_t* QKVB, const float* cw, int b, int h, int n, int lane, LAS const float* egS,
                                     LAS bf16_t* DS  , bf16_t* QG) {
    const int colb = MAT * 512 + h * 64, col = colb + lane, p0 = n * 64;
    const float c0 = cw[col], c1 = cw[1536 + col], c2 = cw[3072 + col], c3 = cw[4608 + col];
    const bf16_t* blk = QKVB + (size_t)(b * LP + p0) * 1536 + colb;
    float x0 = 0.f, x1 = 0.f, x2 = 0.f;
    if (n > 0) { x0 = bf2f(blk[lane - 3 * 1536]); x1 = bf2f(blk[lane - 2 * 1536]); x2 = bf2f(blk[lane - 1 * 1536]); }
    u32x4 stg[8];
#pragma unroll
    for (int i = 0; i < 8; ++i) stg[i] = *(const u32x4*)(blk + (size_t)(8 * i + (lane >> 3)) * 1536 + (lane & 7) * 8);
#pragma unroll
    for (int i = 0; i < 8; ++i) *(LAS u32x4*)(DS + (8 * i + (lane >> 3)) * 64 + (lane & 7) * 8) = stg[i];
    LDS_WAIT();
    const int nvalid = (LTOK - p0) < 64 ? (LTOK - p0) : 64;
#pragma unroll 4
    for (int c = 0; c < nvalid; ++c) {
        const float x3 = bf2f(DS[c * 64 + lane]);
        float y = c0 * x0 + c1 * x1 + c2 * x2 + c3 * x3;
        y = y * __builtin_amdgcn_rcpf(1.0f + __expf(-y));
        x0 = x1; x1 = x2; x2 = x3;
        if (MAT == 2) { DS[c * 64 + lane] = (bf16_t)f2bf(y * egS[c]); }
        else {
            const float ss = wave_sum(y * y);
            const float yn = y * __builtin_amdgcn_rsqf(ss + EPS);
            if (MAT == 0) {
                const float qn = yn * 0.125f;
                DS[c * 64 + lane] = (bf16_t)f2bf(qn);
                QG[c * 64 + perm16(lane)] = (bf16_t)f2bf(qn * egS[c]);
            } else {
                DS[c * 64 + lane] = (bf16_t)f2bf(yn);
            }
        }
    }
    for (int c = nvalid; c < 64; ++c) { DS[c * 64 + lane] = 0; if (MAT == 0) QG[c * 64 + perm16(lane)] = 0; }
}

DI void gdn_tinv(LAS const float* AST, LAS bf16_t* TS, int lane) {
    const int hb = lane >> 5, j = lane & 31, r32 = j, hi = hb;
    LAS const float* Ab = AST + (32 * hb) * 68 + 32 * hb;
    float x[32];
#pragma unroll
    for (int r = 0; r < 32; ++r) x[r] = (r == j) ? 1.0f : 0.0f;
#pragma unroll
    for (int jj = 0; jj < 31; ++jj) {
        const float xj = x[jj];
        LAS const float* ap = Ab + jj * 68;
#pragma unroll
        for (int r4 = (jj + 1) / 4; r4 < 8; ++r4) {
            const f32x4 a = *(LAS const f32x4*)(ap + 4 * r4);
#pragma unroll
            for (int e = 0; e < 4; ++e) if (4 * r4 + e > jj) x[4 * r4 + e] -= a[e] * xj;
        }
    }
    bf16x8 a21[2];
#pragma unroll
    for (int s = 0; s < 2; ++s) { float t[8];
#pragma unroll
        for (int jj = 0; jj < 8; ++jj) t[jj] = AST[(16 * s + 8 * hi + jj) * 68 + 32 + r32];
        const u32x4 p = (u32x4){pk2(t[0], t[1]), pk2(t[2], t[3]), pk2(t[4], t[5]), pk2(t[6], t[7])}; a21[s] = __builtin_bit_cast(bf16x8, p); }
    f32x16 M = {};
#pragma unroll
    for (int s = 0; s < 2; ++s) { float t[8];
#pragma unroll
        for (int jj = 0; jj < 8; ++jj) {
            const auto rr = __builtin_amdgcn_permlane32_swap(__float_as_uint(x[16 * s + 8 + jj]), __float_as_uint(x[16 * s + 8 + jj]), false, false);
            t[jj] = hi ? __uint_as_float(rr[0]) : x[16 * s + jj];
        }
        const u32x4 p = (u32x4){pk2(t[0], t[1]), pk2(t[2], t[3]), pk2(t[4], t[5]), pk2(t[6], t[7])};
        M = MFMA32(a21[s], __builtin_bit_cast(bf16x8, p), M);
    }
    asm volatile("s_waitcnt lgkmcnt(0)" ::: "memory");
#pragma unroll
    for (int i = 0; i < 32; ++i) TS[(32 * hb + i) * 64 + 32 * hb + j] = (bf16_t)f2bf(x[i]);
    asm volatile("s_waitcnt lgkmcnt(0)" ::: "memory");
    f32x16 T21 = {};
#pragma unroll
    for (int s = 0; s < 2; ++s) {
        const u32x2 lo = *(LAS const u32x2*)(TS + (32 + r32) * 64 + 32 + 16 * s + 4 * hi), hi8 = *(LAS const u32x2*)(TS + (32 + r32) * 64 + 32 + 16 * s + 8 + 4 * hi);
        const u32x4 p = (u32x4){lo.x, lo.y, hi8.x, hi8.y};
        T21 = MFMA32(__builtin_bit_cast(bf16x8, p), pack8(M, s), T21);
    }
#pragma unroll
    for (int i = 0; i < 16; ++i) TS[(32 + crow(i, hi)) * 64 + r32] = (bf16_t)f2bf(-T21[i]);
    asm volatile("s_waitcnt lgkmcnt(0)" ::: "memory");
}

template <bool PERM> DI void gdn_tmul(LAS const bf16_t* TS, LAS const bf16_t* RS, int lane, float sgn, bf16_t* out) {
    const int r32 = lane & 31, hi = lane >> 5;
    LAS const unsigned char* rb = (LAS const unsigned char*)RS + ((8 * hi + ((lane & 15) >> 2)) * 64 + 16 * ((lane >> 4) & 1) + 4 * (lane & 3)) * 2;
#pragma unroll
    for (int ct = 0; ct < 2; ++ct)
#pragma unroll
        for (int cb = 0; cb < 2; ++cb) {
            f32x16 acc = {};
#pragma unroll
            for (int ks = 0; ks < (ct == 0 ? 2 : 4); ++ks) {
                const bf16x8 fa = lds_frag_plain(TS, 32 * ct + r32, 2 * ks + hi);
                const s16x4 lo = tr_read_b64(rb + (16 * ks * 64 + 32 * cb) * 2), h4 = tr_read_b64(rb + ((16 * ks + 4) * 64 + 32 * cb) * 2);
                const bf16x8 fb = (bf16x8){lo[0], lo[1], lo[2], lo[3], h4[0], h4[1], h4[2], h4[3]};
                acc = MFMA32(fa, fb, acc);
            }
            u32x2 pk[16];
#pragma unroll
            for (int i = 0; i < 16; ++i) pk[i] = pack_quad_bf16(sgn * acc[i]);
            if ((lane & 3) == 0) {
                unsigned long long ob_ = (unsigned long long)(out + hi * 256 + (PERM ? perm16(32 * cb + r32) : 32 * cb + r32)); asm volatile("" : "+v"(ob_));
                g_u32x2* ob = (g_u32x2*)ob_;
#pragma unroll
                for (int i = 0; i < 16; ++i) ob[(32 * ct + (i & 3) + 8 * (i >> 2)) * 16] = pk[i];
            }
        }
}

DI void gdn_prep_phase(const Params& P, LAS unsigned char* lds, int blk, int G, int wave, int lane_in) {
    const int pair = wave >> 1, role = wave & 1;
    LAS unsigned char* pb = lds + pair * PREP_PAIR;
    LAS bf16_t* QS = (LAS bf16_t*)pb; LAS bf16_t* KS = (LAS bf16_t*)(pb + 8192); LAS float* AS = (LAS float*)(pb + 16384);
    LAS float* gcS = (LAS float*)(pb + 16384 + 17408 + role * 1024); LAS float* betaS = gcS + 64; LAS float* egS = gcS + 128; LAS float* ekS = gcS + 192;
    const bf16_t* QKVB = (const bf16_t*)(P.ws + WS_QKVB); const float* GB = (const float*)(P.ws + WS_GB); const float* cw = P.in[9];
    const int NP = G * 4, NTASK = 2 * 8 * NCHUNK;
    for (int it = 0; it * NP < NTASK; ++it) {
        int lane = lane_in; asm volatile("" : "+v"(lane));
        const int r32 = lane & 31, hi = lane >> 5;
        const int task = it * NP + blk * 4 + pair;
        const bool active = task < NTASK;
        const int bh = task < 2048 ? (task >> 7) : (task - 2048), n = task < 2048 ? (task & 127) : 128, b = bh >> 3, h = bh & 7;
        const int sidx = bh * NCHUNK + n;
        bf16_t* GPW = (bf16_t*)(P.ws + WS_GP) + (size_t)sidx * 4096; bf16_t* GPQG = GPW + GP_ARR / 2; bf16_t* GPAQK = GPQG + GP_ARR / 2; bf16_t* GPKGT = GPAQK + GP_ARR / 2; bf16_t* GPU = GPKGT + GP_ARR / 2;
        float gc = 0.f, beta = 0.f;
        if (active) {
            const int pl = n * 64 + lane;
            float g = 0.f;
            if (pl < LTOK) { const float* gb = GB + ((size_t)(b * LP + pl) << 4); g = gb[h]; beta = gb[8 + h]; }
            gcS[lane] = g; LDS_WAIT();
            gc = 0.f;
#pragma unroll
            for (int j4 = 0; j4 < 16; ++j4) { const f32x4 t = *(LAS const f32x4*)(gcS + 4 * j4);
                gc += (4 * j4 <= lane ? t[0] : 0.f) + (4 * j4 + 1 <= lane ? t[1] : 0.f) + (4 * j4 + 2 <= lane ? t[2] : 0.f) + (4 * j4 + 3 <= lane ? t[3] : 0.f); }
            const float glast = rlane(gc, 63);
            LDS_WAIT();
            gcS[lane] = gc; betaS[lane] = beta; egS[lane] = (role == 0) ? __expf(gc) : beta * __expf(gc); ekS[lane] = __expf(glast - gc);
            if (role == 0 && lane == 0) ((float*)(P.ws + WS_GL))[sidx] = __expf(glast);
            LDS_WAIT();
            for (int rp_ = 0; rp_ < ((PREP_REP & 1) ? 2 : 1); ++rp_) {
            if (role == 0) prep_rows<0>(QKVB, cw, b, h, n, lane, egS, QS, GPQG);
            else prep_rows<1>(QKVB, cw, b, h, n, lane, egS, KS, GPQG);
            }
        }
        LDS_WAIT();
        __syncthreads();
        if (active) {
            for (int rp_ = 0; rp_ < ((PREP_REP & 2) ? 2 : 1); ++rp_)
#pragma unroll
            for (int t4 = 0; t4 < 4; ++t4) {
                const int ct = t4 >> 1, st = t4 & 1;
                f32x16 acc = {};
                if (!(ct == 0 && st == 1)) {
#pragma unroll
                    for (int ks = 0; ks < 4; ++ks) {
                        const bf16x8 fa = lds_frag_plain(role == 0 ? QS : KS, 32 * ct + r32, 2 * ks + hi), fb = lds_frag_plain(KS, 32 * st + r32, 2 * ks + hi);
                        acc = MFMA32(fa, fb, acc);
                    }
                }
                const float gcs = gcS[32 * st + r32];
                LAS const float* gcb = gcS + hi * 4; LAS const float* beb = betaS + hi * 4;
                asm volatile("" : "+v"(gcb), "+v"(beb));
                const int cmp = (32 * st + r32) - 4 * hi;
                f32x4 gq[4], bq[4];
#pragma unroll
                for (int q = 0; q < 4; ++q) { gq[q] = *(LAS const f32x4*)(gcb + 32 * ct + 8 * q); bq[q] = *(LAS const f32x4*)(beb + 32 * ct + 8 * q); }
                float dec[16];
#pragma unroll
                for (int i = 0; i < 16; ++i) dec[i] = __expf(fminf(gq[i >> 2][i & 3] - gcs, 0.f));
                if (role == 0) {
                    u32x2 pk[16];
#pragma unroll
                    for (int i = 0; i < 16; ++i) { const int cr = 32 * ct + (i & 3) + 8 * (i >> 2);
                        const float val = acc[i] * dec[i];
                        pk[i] = pack_quad_bf16((cmp <= cr) ? val : 0.f); }
                    if ((lane & 3) == 0) {
                        unsigned long long aq_ = (unsigned long long)(GPAQK + hi * 256 + perm16(r32) + 32 * st); asm volatile("" : "+v"(aq_));
                        g_u32x2* aqb = (g_u32x2*)aq_;
#pragma unroll
                        for (int i = 0; i < 16; ++i) { const int cr = 32 * ct + (i & 3) + 8 * (i >> 2); aqb[cr * 16] = pk[i]; }
                    }
                } else {
                    LAS float* asb = AS + r32 * 68 + hi * 4;
                    asm volatile("" : "+v"(asb));
#pragma unroll
                    for (int i = 0; i < 16; ++i) { const int cr = 32 * ct + (i & 3) + 8 * (i >> 2);
                        const float val = acc[i] * bq[i >> 2][i & 3] * dec[i];
                        asb[32 * st * 68 + cr] = (cmp < cr) ? val : 0.f; }
                }
            }
        }
        LDS_WAIT();
        __syncthreads();
        LAS bf16_t* TS = (LAS bf16_t*)((LAS unsigned char*)AS + 32 * 68 * 4);
        if (active) {
            if (role == 0) {
                prep_rows<2>(QKVB, cw, b, h, n, lane, betaS, QS  , GPQG);
            } else {
#pragma unroll
                for (int gq = 0; gq < 8; ++gq) {
                    float t[8];
#pragma unroll
                    for (int j = 0; j < 8; ++j) { const int c = perm16(8 * gq + j); t[j] = bf2f(KS[c * 64 + lane]) * ekS[c]; }
                    *(u32x4*)(GPKGT + lane * 64 + 8 * gq) = (u32x4){pk2(t[0], t[1]), pk2(t[2], t[3]), pk2(t[4], t[5]), pk2(t[6], t[7])};
                }
#pragma unroll 8
                for (int c = 0; c < 64; ++c) KS[c * 64 + lane] = (bf16_t)f2bf(bf2f(KS[c * 64 + lane]) * egS[c]);
                gdn_tinv(AS, TS, lane);
            }
        }
        LDS_WAIT();
        __syncthreads();
        if (active) {
            for (int rp_ = 0; rp_ < ((PREP_REP & 8) ? 2 : 1); ++rp_) {
            if (role == 0) gdn_tmul<false>(TS, QS, lane, 1.0f, GPU);
            else gdn_tmul<true>(TS, KS, lane, -1.0f, GPW);
            }
        }
        LDS_WAIT();
    }
}

constexpr int GS_STAGE = 40960 + 1024;
constexpr int GS_NSTAGE = 3;
constexpr int GS_OBUF = GS_NSTAGE * GS_STAGE;
static_assert(GS_OBUF + 16384 <= LDS_BYTES - 64, "gdn scan LDS");

#define GS_POST(n, ZQ) do { \
            if (n > 0) {         \
                LAS const bf16_t* ob = (LAS const bf16_t*)(lds + GS_OBUF + ((n - 1) & 1) * 8192); \
                const f32x4 gn = *(const f32x4*)(gnorm + 4 * vq); \
            _Pragma("unroll") \
                for (int it = 0; it < 8; ++it) { \
                    const int c = (wave - 2) * 32 + 4 * it + rg, p = (n - 1) * 64 + c; \
                    const u32x2 ov = *(LAS const u32x2*)(ob + c * 64 + 4 * vq); \
                    const float v0 = __uint_as_float(ov.x << 16), v1 = __uint_as_float(ov.x & 0xffff0000u), v2 = __uint_as_float(ov.y << 16), v3 = __uint_as_float(ov.y & 0xffff0000u); \
                    const float ss = row_sum16((v0 * v0 + v1 * v1) + (v2 * v2 + v3 * v3)); \
                    const float rn = __builtin_amdgcn_rsqf(ss * (1.0f / 64.0f) + EPS); \
                    const u32x2 zz = ZQ[it]; \
                    const float z0 = __uint_as_float(zz.x << 16), z1 = __uint_as_float(zz.x & 0xffff0000u), z2 = __uint_as_float(zz.y << 16), z3 = __uint_as_float(zz.y & 0xffff0000u); \
                    const float y0 = v0 * rn * gn[0] * z0, y1 = v1 * rn * gn[1] * z1, y2 = v2 * rn * gn[2] * z2, y3 = v3 * rn * gn[3] * z3;       \
                    { bf16_t* dst_ = ((p >= NMETA) && (p < LTOK)) ? MIX + (size_t)(b * SEQ + p - NMETA) * 1024 + 512 + h * 64 + 4 * vq : DUMP + lane * 4;       \
                      *(u32x2*)dst_ = (u32x2){pk2(y0, y1), pk2(y2, y3)}; } \
                } \
            } \
        } while (0)
DI void gdn_scan(const Params& P, LAS unsigned char* lds, int bh, int tid, int wave, int lane) {
    const int b = bh >> 3, h = bh & 7, r32 = lane & 31, hi = lane >> 5;
    const int task0 = (b * 8 + h) * NCHUNK;
    const bf16_t* GP0 = (const bf16_t*)(P.ws + WS_GP);
    const float* GLg = (const float*)(P.ws + WS_GL);
    const bf16_t* ZB = (const bf16_t*)(P.ws + WS_ZB); bf16_t* MIX = (bf16_t*)(P.ws + WS_MIX); const float* gnorm = P.in[12];
    bf16_t* DUMP = (bf16_t*)(P.ws + WS_DUMP) + bh * 4096 + wave * 512;
    const int lw = wave - 4;
    const int prow = lane >> 3, pch = lane & 7;
#define GS_DMA(n_, stg_) do { LAS unsigned char* sg_ = lds + (stg_) * GS_STAGE; \
        _Pragma("unroll") for (int i = 0; i < 10; ++i) { const int a_ = i >> 1, pi_ = lw * 2 + (i & 1), row_ = 8 * pi_ + prow; \
            const int sch_ = (a_ < 4) ? (pch ^ (row_ & 7)) : pch; \
            __builtin_amdgcn_global_load_lds((const unsigned*)(GP0 + (size_t)a_ * (GP_ARR / 2) + (size_t)(task0 + (n_)) * 4096 + row_ * 64 + sch_ * 8), \
                                             (LAS unsigned*)(sg_ + a_ * 8192 + pi_ * 1024), 16, 0, 0); } \
        __builtin_amdgcn_global_load_lds((const unsigned*)(GLg + task0 + (n_)), (LAS unsigned*)(sg_ + 40960 + lw * 256), 4, 0, 0); } while (0)
    if (wave >= 4) { GS_DMA(0, 0); GS_DMA(1, 1); asm volatile("s_waitcnt vmcnt(11)" ::: "memory"); }
    const int vq = lane & 15, rg = lane >> 4;
    u32x2 zqA[8], zqB[8];
#define GS_ZLOADX(ZQ, n_) do { _Pragma("unroll") for (int it = 0; it < 8; ++it) { int p_ = (n_) * 64 + (wave - 2) * 32 + 4 * it + rg; p_ = p_ < LTOK ? p_ : LTOK - 1; \
            ZQ[it] = *(const u32x2*)(ZB + (size_t)(b * LP + p_) * 512 + h * 64 + 4 * vq); } } while (0)
    if (wave == 2 || wave == 3) { GS_ZLOADX(zqB, 0); }
    BAR_LDS();
    f32x16 S0 = {}, S1 = {};
    const int vbase = 32 * wave;
    if (wave < 2) {
    int stg = 0;
    for (int n = 0; n <= NCHUNK; ++n) {
        {
            if (n < NCHUNK) {
                LAS const unsigned char* sg = lds + stg * GS_STAGE;
                LAS const bf16_t* Wm = (LAS const bf16_t*)sg; LAS const bf16_t* QGm = (LAS const bf16_t*)(sg + 8192); LAS const bf16_t* AQm = (LAS const bf16_t*)(sg + 16384);
                LAS const bf16_t* KGm = (LAS const bf16_t*)(sg + 24576); LAS const bf16_t* Um = (LAS const bf16_t*)(sg + 32768);
                const float gl = *(LAS const float*)(sg + 40960);
                bf16x8 Sb[2][2]; Sb[0][0] = pack8(S0, 0); Sb[0][1] = pack8(S0, 1); Sb[1][0] = pack8(S1, 0); Sb[1][1] = pack8(S1, 1);
                bf16x8 fw[2][4], fq[2][4];
                f32x16 vn[2], o[2];
#pragma unroll
                for (int ct = 0; ct < 2; ++ct)
#pragma unroll
                    for (int k4 = 0; k4 < 4; ++k4) { fw[ct][k4] = lds_frag(Wm, 32 * ct + r32, k4 * 2 + hi); fq[ct][k4] = lds_frag(QGm, 32 * ct + r32, k4 * 2 + hi); }
#pragma unroll
                for (int ct = 0; ct < 2; ++ct)
#pragma unroll
                    for (int i = 0; i < 16; ++i) vn[ct][i] = bf2f(Um[(32 * ct + crow(i, hi)) * 64 + vbase + r32]);
                o[0] = f32x16{}; o[1] = f32x16{};
                __builtin_amdgcn_sched_barrier(0);
#pragma unroll
                for (int k4 = 0; k4 < 4; ++k4) {
                    vn[0] = MFMA32(fw[0][k4], Sb[k4 >> 1][k4 & 1], vn[0]); o[0] = MFMA32(fq[0][k4], Sb[k4 >> 1][k4 & 1], o[0]);
                    vn[1] = MFMA32(fw[1][k4], Sb[k4 >> 1][k4 & 1], vn[1]); o[1] = MFMA32(fq[1][k4], Sb[k4 >> 1][k4 & 1], o[1]);
                }
                __builtin_amdgcn_sched_barrier(0);
                bf16x8 fa[2][4], fk[2][4];
#pragma unroll
                for (int g = 0; g < 4; ++g) { fa[0][g] = lds_frag(AQm, r32, g * 2 + hi); fa[1][g] = lds_frag(AQm, 32 + r32, g * 2 + hi);
                                              fk[0][g] = lds_frag(KGm, r32, g * 2 + hi); fk[1][g] = lds_frag(KGm, 32 + r32, g * 2 + hi); }
#pragma unroll
                for (int i = 0; i < 16; ++i) { S0[i] *= gl; S1[i] *= gl; }
                __builtin_amdgcn_sched_barrier(0);
                bf16x8 Vb[2][2]; Vb[0][0] = pack8(vn[0], 0); Vb[0][1] = pack8(vn[0], 1); Vb[1][0] = pack8(vn[1], 0); Vb[1][1] = pack8(vn[1], 1);
#pragma unroll
                for (int g = 0; g < 4; ++g) {
                    o[0] = MFMA32(fa[0][g], Vb[g >> 1][g & 1], o[0]); S0 = MFMA32(fk[0][g], Vb[g >> 1][g & 1], S0);
                    o[1] = MFMA32(fa[1][g], Vb[g >> 1][g & 1], o[1]); S1 = MFMA32(fk[1][g], Vb[g >> 1][g & 1], S1);
                }
                LAS bf16_t* ob = (LAS bf16_t*)(lds + GS_OBUF + (n & 1) * 8192);
#pragma unroll
                for (int ct = 0; ct < 2; ++ct)
#pragma unroll
                    for (int i = 0; i < 16; ++i) ob[(32 * ct + crow(i, hi)) * 64 + vbase + r32] = (bf16_t)f2bf(o[ct][i]);
            }
        }
        BAR_LDS();
        stg = stg + 1 >= GS_NSTAGE ? 0 : stg + 1;
    }
    } else if (wave < 4) {
    for (int n = 0; n <= NCHUNK; n += 2) {
        GS_POST(n, zqA);     if (n + 1 < NCHUNK) { GS_ZLOADX(zqA, n + 1); } BAR_LDS();
        GS_POST((n + 1), zqB); if (n + 2 < NCHUNK) { GS_ZLOADX(zqB, n + 2); } BAR_LDS();
    }
    } else {
    int stg = 0;
    for (int n = 0; n <= NCHUNK; ++n) {
        {
            if (n + 2 < NCHUNK) { const int s2_ = stg + 2 >= GS_NSTAGE ? stg + 2 - GS_NSTAGE : stg + 2; GS_DMA(n + 2, s2_); asm volatile("s_waitcnt vmcnt(11)" ::: "memory"); }
            else asm volatile("s_waitcnt vmcnt(0)" ::: "memory");
        }
        BAR_LDS();
        stg = stg + 1 >= GS_NSTAGE ? 0 : stg + 1;
    }
    }
#undef GS_DMA
#undef GS_ZLOADX
}
#define XB_TMO      128
#define XB_XCNT(j)  (256  + 64 * (j))
#define XB_XSUB(j)  (1280 + 64 * (j))
#define XB_XGEN(j)  (2304 + 64 * (j))
#define XB_TOP      3328
#define XB_TOPGEN   3392
#define XCD_BAR_WORDS 3456
#define XB_SPIN_CAP (1u << 18)

__device__ __forceinline__ unsigned xb_ld(unsigned* p)              { return __hip_atomic_load(p, __ATOMIC_RELAXED, __HIP_MEMORY_SCOPE_AGENT); }
__device__ __forceinline__ unsigned xb_add(unsigned* p, unsigned v) { return __hip_atomic_fetch_add(p, v, __ATOMIC_RELAXED, __HIP_MEMORY_SCOPE_AGENT); }
__device__ __forceinline__ unsigned xb_xcc_id() { return (unsigned)__builtin_amdgcn_s_getreg((3 << 11) | 20) & 0xFu; }
#define XB_SPIN(cond, bar) do { unsigned _sp = 0; while (cond) { __builtin_amdgcn_s_sleep(1); \
    if ((++_sp & 255u) == 0u) { if (xb_ld(&(bar)[XB_TMO])) break; if (_sp > XB_SPIN_CAP) { atomicAdd(&(bar)[XB_TMO], 1u); break; } } } } while (0)

struct XcdBarrier {
    unsigned* bar; unsigned x;
    volatile LAS unsigned* st;
};

__device__ __forceinline__ XcdBarrier xcd_barrier_post(unsigned* bar, volatile LAS unsigned* st) {
    XcdBarrier b; b.bar = bar; b.x = xb_xcc_id(); b.st = st;
    if (threadIdx.x == 0) (void)xb_add(&bar[XB_XCNT(b.x)], 1u);
    return b;
}
__device__ __forceinline__ void xcd_barrier_complete(unsigned* bar, unsigned x, unsigned& nloc, unsigned& nx) {
    const unsigned G = gridDim.x * gridDim.y * gridDim.z;
    unsigned sum, cnt, mine, sp = 0u;
    for (;;) {
        sum = 0u; cnt = 0u; mine = 0u;
#pragma unroll
        for (unsigned j = 0; j < 16; ++j) { const unsigned c = xb_ld(&bar[XB_XCNT(j)]); sum += c; cnt += (c > 0u) ? 1u : 0u; mine = (j == x) ? c : mine; }
        if (sum == G) break;
        __builtin_amdgcn_s_sleep(1);
        if ((++sp & 255u) == 0u) { if (xb_ld(&bar[XB_TMO])) break; if (sp > XB_SPIN_CAP) { atomicAdd(&bar[XB_TMO], 1u); break; } }
    }
    nloc = mine > 0u ? mine : 1u; nx = cnt > 0u ? cnt : 1u;
}

__device__ __forceinline__ void xcd_barrier(const XcdBarrier& b) {
    asm volatile("s_waitcnt vmcnt(0)" ::: "memory");
    __syncthreads();
    if (threadIdx.x == 0) {
        unsigned* bar = b.bar;
        __builtin_amdgcn_s_waitcnt(0);
        unsigned nloc = b.st[0], nx = b.st[1];
        if (nloc == 0u) { xcd_barrier_complete(bar, b.x, nloc, nx); b.st[0] = nloc; b.st[1] = nx; }
        const unsigned old = xb_add(&bar[XB_XSUB(b.x)], 1u);
        const unsigned gen = old / nloc;
        if (old + 1u == (gen + 1u) * nloc) {
            __builtin_amdgcn_fence(__ATOMIC_RELEASE, "agent");
            asm volatile("s_waitcnt vmcnt(0)" ::: "memory");
            const unsigned og = xb_add(&bar[XB_TOP], 1u);
            const unsigned tg = og / nx;
            if (og + 1u == (tg + 1u) * nx) xb_add(&bar[XB_TOPGEN], 1u);
            else XB_SPIN(xb_ld(&bar[XB_TOPGEN]) == tg, bar);
            __builtin_amdgcn_fence(__ATOMIC_ACQUIRE, "agent");
            xb_add(&bar[XB_XGEN(b.x)], 1u);
            asm volatile("s_waitcnt vmcnt(0)" ::: "memory");
        } else {
            XB_SPIN(xb_ld(&bar[XB_XGEN(b.x)]) == gen, bar);
            __builtin_amdgcn_fence(__ATOMIC_ACQUIRE, "agent");
            asm volatile("s_waitcnt vmcnt(0)" ::: "memory");
        }
    }
    __syncthreads();
}


constexpr int AT_STAGE = 32768;
constexpr int AT_NSTAGE = 4;
constexpr int AT_XBUF = 0;
constexpr int AT_WSF = AT_NSTAGE * AT_STAGE;
constexpr int AT_UNIT = AT_WSF + 2048;
constexpr float AT_THR = 8.0f;

DI float max3f(float a, float b, float c) { return __builtin_fmaxf(__builtin_fmaxf(a, b), c); }
DI s16x4 tr_read(LAS const unsigned char* p) { return __builtin_bit_cast(s16x4, __builtin_amdgcn_ds_read_tr16_b64_v4i16((LAS v4i16_t*)p)); }

template <int VAR> DI void attn_unit(const Params& P, LAS unsigned char* lds, int bh, int qi, int tid, int wave, int lane, float lam) {
    const int b = bh >> 2, h = bh & 3, r32 = lane & 31, hi = lane >> 5, qsub = wave >> 1, map = wave & 1, hh = 2 * h + map;
    const bf16_t* QB = (const bf16_t*)(P.ws + WS_QB); const bf16_t* KT = (const bf16_t*)(P.ws + WS_KT); const bf16_t* VT = (const bf16_t*)(P.ws + WS_VT);
    const int ntiles = 2 * qi + 3, my_nt = (qsub < 2) ? ntiles - 1 : ntiles;
    const bf16_t* k1 = KT + ((size_t)((b * 8 + 2 * h) * NKT) << 12) + tid * 8;
    const bf16_t* k2 = KT + ((size_t)((b * 8 + 2 * h + 1) * NKT) << 12) + tid * 8;
    const bf16_t* vv = VT + ((size_t)((b * 4 + h) * NKT) << 13) + tid * 8;
#define AT_DMA(t, sb) do { LAS unsigned char* d_ = lds + (sb) * AT_STAGE + wave * 1024; \
        __builtin_amdgcn_global_load_lds((const unsigned*)(k1 + ((size_t)(t) << 12)), (LAS unsigned*)d_, 16, 0, 0); \
        __builtin_amdgcn_global_load_lds((const unsigned*)(k2 + ((size_t)(t) << 12)), (LAS unsigned*)(d_ + 8192), 16, 0, 0); \
        __builtin_amdgcn_global_load_lds((const unsigned*)(vv + ((size_t)(t) << 13)), (LAS unsigned*)(d_ + 16384), 16, 0, 0); \
        __builtin_amdgcn_global_load_lds((const unsigned*)(vv + ((size_t)(t) << 13) + 4096), (LAS unsigned*)(d_ + 24576), 16, 0, 0); } while (0)
    bf16x8 qr[4];
    { const bf16_t* q = QB + ((size_t)((b * 8 + hh) * SEQ + qi * 128 + qsub * 32 + r32) << 6) + hi * 8;
#pragma unroll
      for (int d0 = 0; d0 < 4; ++d0) qr[d0] = *(const bf16x8*)(q + d0 * 16); }
    asm volatile("s_waitcnt vmcnt(0)" : "+v"(qr[0]), "+v"(qr[1]), "+v"(qr[2]), "+v"(qr[3]) :: "memory");
    AT_DMA(0, 0); AT_DMA(1, 1); AT_DMA(2, 2);
    asm volatile("s_waitcnt vmcnt(8)" ::: "memory");
    BAR_LDS();
    LAS float* wsf = (LAS float*)(lds + AT_WSF) + wave * 64;
    float m_run = 0.f, l_run = 0.f;
    f32x16 negm = {};
    f32x16 o[4]; o[0] = f32x16{}; o[1] = f32x16{}; o[2] = f32x16{}; o[3] = f32x16{};
    for (int t = 0; t < ntiles; ++t) {
        if (t + 3 < ntiles) AT_DMA(t + 3, (t + 3) % AT_NSTAGE);
        if (t < my_nt) {
            LAS const unsigned char* sg = lds + (t % AT_NSTAGE) * AT_STAGE;
            LAS const unsigned char* kb = sg + map * 8192 + hi * 1024 + r32 * 16;
            f32x16 p0 = negm, p1 = negm;
            bf16x8 kf[8];
#pragma unroll
            for (int d0 = 0; d0 < 4; ++d0) { kf[2 * d0] = *(LAS const bf16x8*)(kb + d0 * 2048); kf[2 * d0 + 1] = *(LAS const bf16x8*)(kb + d0 * 2048 + 512); }
            __builtin_amdgcn_sched_barrier(0);
            __builtin_amdgcn_s_setprio(1);
#pragma unroll
            for (int d0 = 0; d0 < 4; ++d0) { p0 = MFMA32(kf[2 * d0], qr[d0], p0); p1 = MFMA32(kf[2 * d0 + 1], qr[d0], p1); }
            __builtin_amdgcn_s_setprio(0);
            const bool first = (t == 0);
            if (first) {
#pragma unroll
                for (int r = 0; r < 16; ++r) { if (crow(r, hi) >= NMETA) p0[r] = -INFINITY; p1[r] = -INFINITY; }
            }
            float ma = max3f(p0[0], p0[1], p1[0]), mb = max3f(p0[2], p0[3], p1[1]); ma = max3f(ma, p1[2], p1[3]);
#pragma unroll
            for (int r = 4; r < 16; r += 4) { ma = max3f(ma, p0[r], p0[r + 1]); mb = max3f(mb, p0[r + 2], p0[r + 3]); ma = max3f(ma, p1[r], p1[r + 1]); mb = max3f(mb, p1[r + 2], p1[r + 3]); }
            const float rm = swap32_max(max3f(ma, mb, mb));
            if (first || __any(rm > AT_THR)) {
                const float dl = first ? rm : fmaxf(rm, 0.f);
                m_run += dl;
#pragma unroll
                for (int r = 0; r < 16; ++r) { p0[r] -= dl; p1[r] -= dl; negm[r] = -m_run; }
                const float alpha = __builtin_amdgcn_exp2f(-dl);
                l_run *= alpha;
                if (!first) {
                    if (hi == 0) wsf[r32] = alpha;
                    LDS_WAIT();
#pragma unroll
                    for (int r = 0; r < 16; ++r) { const float a = wsf[crow(r, hi)];
#pragma unroll
                        for (int d0 = 0; d0 < 4; ++d0) o[d0][r] *= a; }
                    LDS_WAIT();
                }
            }
            float ls0 = 0.f, ls1 = 0.f;
#pragma unroll
            for (int r = 0; r < 16; ++r) { if (VAR != 2) { p0[r] = __builtin_amdgcn_exp2f(p0[r]); p1[r] = __builtin_amdgcn_exp2f(p1[r]); } ls0 += p0[r]; ls1 += p1[r]; }
            l_run += ls0 + ls1;
            const bf16x8 pa0 = pack8(p0, 0), pa1 = pack8(p0, 1), pa2 = pack8(p1, 0), pa3 = pack8(p1, 1);
            LAS const unsigned char* vb = sg + 16384 + ((lane >> 4) & 1) * 32 + (lane & 3) * 8 + (4 * hi + ((lane & 15) >> 2)) * 64;
            s16x4 va_[8], vb_[8];
            const unsigned vba = (unsigned)(uintptr_t)vb;
#define AT_VLD(V, d0_) do { _Pragma("unroll") for (int ks = 0; ks < 4; ++ks) { \
                asm volatile("ds_read_b64_tr_b16 %0, %1 offset:%c2" : "=v"(V[2 * ks]) : "v"(vba), "i"((d0_) * 4096 + ks * 1024)); \
                asm volatile("ds_read_b64_tr_b16 %0, %1 offset:%c2" : "=v"(V[2 * ks + 1]) : "v"(vba), "i"((d0_) * 4096 + ks * 1024 + 512)); } } while (0)
#define AT_VF(V, ks) ((bf16x8){V[2 * (ks)][0], V[2 * (ks)][1], V[2 * (ks)][2], V[2 * (ks)][3], V[2 * (ks) + 1][0], V[2 * (ks) + 1][1], V[2 * (ks) + 1][2], V[2 * (ks) + 1][3]})
#define AT_WAITL(n, V) do { asm volatile("s_waitcnt lgkmcnt(" #n ")" : "+v"(V[0]), "+v"(V[1]), "+v"(V[2]), "+v"(V[3]), "+v"(V[4]), "+v"(V[5]), "+v"(V[6]), "+v"(V[7])); __builtin_amdgcn_sched_barrier(0); } while (0)
#define AT_PV(V, d0_) do { __builtin_amdgcn_s_setprio(1); o[d0_] = MFMA32(pa0, AT_VF(V, 0), o[d0_]); o[d0_] = MFMA32(pa1, AT_VF(V, 1), o[d0_]); o[d0_] = MFMA32(pa2, AT_VF(V, 2), o[d0_]); o[d0_] = MFMA32(pa3, AT_VF(V, 3), o[d0_]); __builtin_amdgcn_s_setprio(0); } while (0)
            if (VAR != 1) {
            asm volatile("s_waitcnt lgkmcnt(0)" ::: "memory"); __builtin_amdgcn_sched_barrier(0);
            AT_VLD(va_, 0); AT_VLD(vb_, 1);
            AT_WAITL(8, va_); AT_PV(va_, 0); __builtin_amdgcn_sched_barrier(0); AT_VLD(va_, 2);
            AT_WAITL(8, vb_); AT_PV(vb_, 1); __builtin_amdgcn_sched_barrier(0); AT_VLD(vb_, 3);
            AT_WAITL(8, va_); AT_PV(va_, 2); __builtin_amdgcn_sched_barrier(0);
            AT_WAITL(0, vb_); AT_PV(vb_, 3);
            } else { o[0][0] += (float)pa0[0] + (float)pa1[1] + (float)pa2[2] + (float)pa3[3]; }
#undef AT_VF
#undef AT_WAITL
#undef AT_VLD
#undef AT_PV
        }
        if (t + 3 < ntiles) asm volatile("s_waitcnt vmcnt(8)" ::: "memory"); else if (t + 2 < ntiles) asm volatile("s_waitcnt vmcnt(4)" ::: "memory"); else asm volatile("s_waitcnt vmcnt(0)" ::: "memory");
        BAR_LDS();
    }
    if (VAR != 0) { if (o[0][0] + o[1][1] + o[2][2] + o[3][3] + l_run == 123.456f) ((float*)(P.ws + WS_DUMP))[tid] = 1.f; __syncthreads(); return; }
    l_run = swap32_add(l_run);
    const float sc = (map ? lam : 1.0f) / l_run;
    if (hi == 0) wsf[r32] = sc;
    LDS_WAIT();
#pragma unroll
    for (int r = 0; r < 16; ++r) { const float a = wsf[crow(r, hi)];
#pragma unroll
        for (int d0 = 0; d0 < 4; ++d0) o[d0][r] *= a; }
    LAS float* xb = (LAS float*)(lds + AT_XBUF + qsub * 16384);
    if (map) {
#pragma unroll
        for (int d0 = 0; d0 < 4; ++d0)
#pragma unroll
            for (int r = 0; r < 16; ++r) xb[(d0 * 16 + r) * 64 + lane] = o[d0][r];
    }
    __syncthreads();
    if (!map) {
        const float* dn = P.in[8];
        bf16_t* MIX = (bf16_t*)(P.ws + WS_MIX);
        float ss[16];
#pragma unroll
        for (int r = 0; r < 16; ++r) { ss[r] = 0.f;
#pragma unroll
            for (int d0 = 0; d0 < 4; ++d0) { o[d0][r] -= xb[(d0 * 16 + r) * 64 + lane]; ss[r] += o[d0][r] * o[d0][r]; } }
#pragma unroll
        for (int r = 0; r < 16; ++r) {
            ss[r] = half_sum32(ss[r]);
            ss[r] = 0.8f / sqrtf(ss[r] * (1.0f / 128.0f) + EPS);
        }
        float dg[4];
#pragma unroll
        for (int d0 = 0; d0 < 4; ++d0) dg[d0] = dn[32 * d0 + r32];
#pragma unroll
        for (int r = 0; r < 16; ++r) {
            bf16_t* orow = MIX + (size_t)(b * SEQ + qi * 128 + qsub * 32 + crow(r, hi)) * 1024 + h * 128 + r32;
#pragma unroll
            for (int d0 = 0; d0 < 4; ++d0) orow[32 * d0] = (bf16_t)f2bf(o[d0][r] * ss[r] * dg[d0]);
        }
    }
    __syncthreads();
#undef AT_DMA
}

template <int VAR> DI void attn_phase(const Params& P, LAS unsigned char* lds, int tid, int wave, int lane, int max_units) {
    unsigned* ctl = (unsigned*)(P.ws + WS_CTL);
    const float* lq1 = P.in[4]; const float* lk1 = P.in[5]; const float* lq2 = P.in[6]; const float* lk2 = P.in[7];
    const float lam = __expf(wave_sum(lq1[lane] * lk1[lane])) - __expf(wave_sum(lq2[lane] * lk2[lane])) + 0.2f;
    LAS volatile int* ub = (LAS volatile int*)(lds + AT_UNIT);
    const unsigned x0 = xb_xcc_id() & 7u;
    for (;;) {
        if (tid == 0) {
            int u = -1;
            for (unsigned j = 0; j < 8u && u < 0; ++j) { const unsigned x = (x0 + j) & 7u;
                if (__hip_atomic_load(ctl + CW_ATTQ + 64 * x, __ATOMIC_RELAXED, __HIP_MEMORY_SCOPE_AGENT) >= 64u) continue;
                const unsigned i = __hip_atomic_fetch_add(ctl + CW_ATTQ + 64 * x, 1u, __ATOMIC_RELAXED, __HIP_MEMORY_SCOPE_AGENT);
                if (i < 64u) u = (int)(x * 64u + i); }
            *ub = u;
        }
        __syncthreads();
        const int u = *ub;
        __syncthreads();
        if (u < 0) break;
        attn_unit<VAR>(P, lds, u >> 6, 63 - (u & 63), tid, wave, lane, lam);
        if (--max_units == 0) break;
    }
}

struct EpiOutProj {
    static constexpr bool PERM = false, AFTER_DRAIN = false;
    const float* x; float* out; bf16_t* u2;
    DI void operator()(const pg8::f32x4 (&acc)[2][2][4][2], const pg8::Unit& u, int wr, int wc, int fr, int fq) const {
        const int row0 = u.pm * 256 + wr * 64 + fr, col0 = u.pn * 256 + wc * 32 + 4 * fq;
#pragma unroll
        for (int ai = 0; ai < 2; ++ai) {
            f32x4 xv[4][2][2];
#pragma unroll
            for (int m = 0; m < 4; ++m) { const size_t off = (size_t)(row0 + ai * 128 + m * 16) * 1024 + col0;
#pragma unroll
                for (int bj = 0; bj < 2; ++bj)
#pragma unroll
                    for (int n = 0; n < 2; ++n) xv[m][bj][n] = *(const f32x4*)(x + off + bj * 128 + n * 16); }
#pragma unroll
            for (int m = 0; m < 4; ++m) { const size_t off = (size_t)(row0 + ai * 128 + m * 16) * 1024 + col0;
#pragma unroll
                for (int bj = 0; bj < 2; ++bj)
#pragma unroll
                    for (int n = 0; n < 2; ++n) { const f32x4 hv = acc[ai][bj][m][n] + xv[m][bj][n]; *(f32x4*)(out + off + bj * 128 + n * 16) = hv;
                        *(u32x2*)(u2 + off + bj * 128 + n * 16) = (u32x2){pk2(hv[0], hv[1]), pk2(hv[2], hv[3])}; } }
        }
    }
};

typedef float f32x4v __attribute__((ext_vector_type(4)));
#ifdef ROUTE_PROBE
#define ROUTE_MID_HOOK() do { XcdBarrier xb2; xb2.bar = (unsigned*)(P.ws + WS_CTL) + CW_BAR; xb2.x = xb_xcc_id(); xb2.st = (volatile LAS unsigned*)(ldsb + LDS_BYTES - 64); xcd_barrier(xb2); \
    if (blockIdx.x == 0 && threadIdx.x == 0) __hip_atomic_store((unsigned long long*)(P.ws + WS_CTL + 65536) + 20, (unsigned long long)__builtin_amdgcn_s_memrealtime(), __ATOMIC_RELAXED, __HIP_MEMORY_SCOPE_AGENT); } while (0)
#else
#define ROUTE_MID_HOOK() do {} while (0)
#endif
DI void route_tile(const Params& P, int tile, int par, LAS float* sc  , int lane, LAS unsigned char* ldsb) {
    const float* h2 = P.out; const float* WR = (const float*)(P.ws + WS_WR);
    const int r16 = lane & 15, kq = lane >> 4;
    const float* arow = h2 + (size_t)(tile * 16 + r16) * 1024 + par * 512 + kq * 8;
    const float* b0 = WR + (size_t)r16 * 1024 + par * 512 + kq * 8; const float* b1 = b0 + 16 * 1024; const float* b2 = WR + (size_t)(32 + (r16 & 3)) * 1024 + par * 512 + kq * 8;
    const float z2 = (r16 < 4) ? 1.0f : 0.0f;
    f32x4v c0 = {}, c1 = {}, c2 = {};
    float ss = 0.f;
    f32x4 bA[4][4], bB[4][4];
#define RT_LOAD(B, tb) do { _Pragma("unroll") for (int j = 0; j < 4; ++j) { const int o_ = 32 * ((tb) + (j >> 1)) + 4 * (j & 1); \
        B[j][0] = *(const f32x4*)(arow + o_); B[j][1] = *(const f32x4*)(b0 + o_); B[j][2] = *(const f32x4*)(b1 + o_); B[j][3] = *(const f32x4*)(b2 + o_); } } while (0)
#define RT_COMP(B) do { _Pragma("unroll") for (int j = 0; j < 4; ++j) { const f32x4 a = B[j][0]; ss += (a.x * a.x + a.y * a.y) + (a.z * a.z + a.w * a.w); \
        _Pragma("unroll") for (int i = 0; i < 4; ++i) { c0 = __builtin_amdgcn_mfma_f32_16x16x4f32(a[i], B[j][1][i], c0, 0, 0, 0); \
            c1 = __builtin_amdgcn_mfma_f32_16x16x4f32(a[i], B[j][2][i], c1, 0, 0, 0); c2 = __builtin_amdgcn_mfma_f32_16x16x4f32(a[i], B[j][3][i] * z2, c2, 0, 0, 0); } } } while (0)
    RT_LOAD(bA, 0);
#pragma unroll
    for (int tb = 0; tb < 16; tb += 4) {
        RT_LOAD(bB, tb + 2); __builtin_amdgcn_sched_barrier(0); RT_COMP(bA); __builtin_amdgcn_sched_barrier(0);
        if (tb + 4 < 16) { RT_LOAD(bA, tb + 4); } __builtin_amdgcn_sched_barrier(0); RT_COMP(bB); __builtin_amdgcn_sched_barrier(0); }
#undef RT_LOAD
#undef RT_COMP
    ss += swz_xor16(ss); ss = swap32_add(ss);
    LAS float* my = sc + par * 800;
#pragma unroll
    for (int r = 0; r < 4; ++r) { const int row = 4 * kq + r; my[row * 48 + r16] = c0[r]; my[row * 48 + 16 + r16] = c1[r]; my[row * 48 + 32 + r16] = c2[r]; }
    if (lane < 16) my[768 + lane] = ss;
    LAS int* lcnt = (LAS int*)(ldsb + 4 * 32768 + 1024);
    if (threadIdx.x < 32) lcnt[threadIdx.x] = 0;
    int pa = 0, pb = 0, ea_ = 0, eb_ = 0; float w1_ = 0.f, w2_ = 0.f, rs_ = 0.f;
    LDS_WAIT();
    __syncthreads();
    ROUTE_MID_HOOK();
    if (par == 0 && lane < 16) {
        LAS const float* l0 = sc + lane * 48; LAS const float* l1 = sc + 800 + lane * 48;
        const float rs = __builtin_amdgcn_rsqf((sc[768 + lane] + sc[800 + 768 + lane]) * (1.0f / 1024.0f) + EPS);
#define LG(j) (l0[j] + l1[j])
        const int t = tile * 16 + lane;
        const float* bg = P.in[16]; const float* br = P.in[18];
        const f32x4 bgv = *(const f32x4*)bg;
        float gl[4]; int gs = 0; float gm;
#pragma unroll
        for (int j = 0; j < 4; ++j) gl[j] = LG(j) * rs + bgv[j];
        gm = gl[0];
#pragma unroll
        for (int j = 1; j < 4; ++j) { const bool gt = gl[j] > gm; gm = gt ? gl[j] : gm; gs = gt ? j : gs; }
        const f32x4 br0 = *(const f32x4*)(br + gs * 8), br1 = *(const f32x4*)(br + gs * 8 + 4);
        float gsum = 0.f;
#pragma unroll
        for (int j = 0; j < 4; ++j) gsum += __expf(gl[j] - gm);
        const float psel = 1.0f / gsum;
        float e1 = -INFINITY, e2 = -INFINITY; int i1 = 0, i2 = 0;
#pragma unroll
        for (int j = 0; j < 8; ++j) {
            const float v = LG(4 + gs * 8 + j) * rs + (j < 4 ? br0[j & 3] : br1[j & 3]);
            const bool g1 = v > e1, g2 = v > e2;
            e2 = g1 ? e1 : (g2 ? v : e2); i2 = g1 ? i1 : (g2 ? j : i2);
            e1 = g1 ? v : e1; i1 = g1 ? j : i1;
        }
        const float x2 = __expf(e2 - e1), w1 = psel / (1.0f + x2), w2 = psel * x2 / (1.0f + x2);
        const int ea = gs * 8 + i1, eb = gs * 8 + i2;
        pa = (int)__hip_atomic_fetch_add(lcnt + ea, 1, __ATOMIC_RELAXED, __HIP_MEMORY_SCOPE_WORKGROUP); pb = (int)__hip_atomic_fetch_add(lcnt + eb, 1, __ATOMIC_RELAXED, __HIP_MEMORY_SCOPE_WORKGROUP);
        ea_ = ea; eb_ = eb; w1_ = w1; w2_ = w2; rs_ = rs;
        ((int*)(P.ws + WS_TOKE))[2 * t] = ea; ((int*)(P.ws + WS_TOKE))[2 * t + 1] = eb;
        ((float*)(P.ws + WS_TOKW))[2 * t] = w1; ((float*)(P.ws + WS_TOKW))[2 * t + 1] = w2;
        ((float*)(P.ws + WS_RS2))[t] = rs;
#undef LG
    }
    LDS_WAIT();
    __syncthreads();
    if (threadIdx.x < 32) { const int c = lcnt[threadIdx.x];
        lcnt[32 + threadIdx.x] = c ? (int)atomicAdd((unsigned*)(P.ws + WS_CTL) + CW_CNT + 64 * threadIdx.x, (unsigned)c) : 0; }
    LDS_WAIT();
    __syncthreads();
    if (par == 0 && lane < 16) { const int t = tile * 16 + lane;
        const int qa = lcnt[32 + ea_] + pa, qb = lcnt[32 + eb_] + pb;
        ((int*)(P.ws + WS_TOKP))[2 * t] = qa; ((int*)(P.ws + WS_TOKP))[2 * t + 1] = qb;
        ((int*)(P.ws + WS_LIST))[ea_ * 16384 + qa] = t; ((int*)(P.ws + WS_LIST))[eb_ * 16384 + qb] = t;
        ((float*)(P.ws + WS_LISTW))[ea_ * 16384 + qa] = w1_; ((float*)(P.ws + WS_LISTW))[eb_ * 16384 + qb] = w2_;
        ((float*)(P.ws + WS_LISTRS))[ea_ * 16384 + qa] = rs_; ((float*)(P.ws + WS_LISTRS))[eb_ * 16384 + qb] = rs_; }
    LDS_WAIT();
    __syncthreads();
}

#ifndef P4A_REP
#define P4A_REP 0
#endif
template <int P4A_PART> DI void phase4a(const Params& P, LAS unsigned char* lds, int gw, int NGW, int wave, int lane) {
    LAS float* scr = (LAS float*)(lds + wave * 16384);
    if (P4A_PART & 1) for (int tile = (gw >> 1); tile < MTOK / 16; tile += (NGW >> 1)) route_tile(P, tile, wave & 1, (LAS float*)(lds + (wave >> 1) * 32768), lane, lds);
    if (!(P4A_PART & 2)) return;
    bf16_t* WGU = (bf16_t*)(P.ws + WS_WGU); bf16_t* WD = (bf16_t*)(P.ws + WS_WD);
    const float* wg = P.in[19]; const float* wu = P.in[20]; const float* wd = P.in[21]; const float* gf = P.in[14];
    constexpr int I_GU = 16 * 16, I_D = 4 * 32, NIT = 32 * (I_GU + I_D);
    struct TItem { const float* src; const float* gn; bf16_t* dst; int stride, ldk; };
    auto mk = [&](int it) { TItem d; const int e = it / (I_GU + I_D), r = it % (I_GU + I_D);
        if (r < I_GU) { const int n0 = (r & 15) * 32, j = n0 >> 8, up = (n0 >> 7) & 1, k0 = (r >> 4) * 64;
            d.src = (up ? wu : wg) + (size_t)e * 1024 * 256 + (size_t)k0 * 256 + 128 * j + (n0 & 127); d.gn = gf + k0; d.stride = 256; d.ldk = 1024;
            d.dst = WGU + (size_t)e * 512 * 1024 + (size_t)n0 * 1024 + k0; }
        else { const int r2 = r - I_GU, k0 = (r2 >> 5) * 64, n0 = (r2 & 31) * 32;
            d.src = wd + (size_t)e * 256 * 1024 + (size_t)k0 * 1024 + n0; d.gn = nullptr; d.stride = 1024; d.ldk = 256;
            d.dst = WD + (size_t)e * 1024 * 256 + (size_t)n0 * 256 + k0; }
        return d; };
#define TI_LOAD(D, V, GV) do { if (D.gn) { GV[0] = *(const f32x4*)(D.gn + 8 * (lane & 7)); GV[1] = *(const f32x4*)(D.gn + 8 * (lane & 7) + 4); } else { GV[0] = (f32x4){1.f, 1.f, 1.f, 1.f}; GV[1] = GV[0]; } \
        _Pragma("unroll") for (int i = 0; i < 32; ++i) { const int kk = 2 * i + (lane >> 5); V[i] = D.src[(size_t)kk * D.stride + (lane & 31)]; } } while (0)
#define TI_FIN(D, V, GV) do { _Pragma("unroll") for (int i = 0; i < 32; ++i) scr[(2 * i + (lane >> 5)) * 33 + (lane & 31)] = V[i]; \
        LDS_WAIT(); const int c_ = lane & 7; \
        _Pragma("unroll") for (int j = 0; j < 4; ++j) { const int n_ = (lane >> 3) + 8 * j; const LAS float* s_ = scr + (8 * c_) * 33 + n_; \
            u32x4 o_; o_.x = pk2(s_[0 * 33] * GV[0][0], s_[1 * 33] * GV[0][1]); o_.y = pk2(s_[2 * 33] * GV[0][2], s_[3 * 33] * GV[0][3]); o_.z = pk2(s_[4 * 33] * GV[1][0], s_[5 * 33] * GV[1][1]); o_.w = pk2(s_[6 * 33] * GV[1][2], s_[7 * 33] * GV[1][3]); \
            *(u32x4*)(D.dst + (size_t)n_ * D.ldk + 8 * c_) = o_; } \
        LDS_WAIT(); } while (0)
    for (int rp_ = 0; rp_ < (P4A_REP ? 2 : 1); ++rp_) {
        float va[32], vb[32]; f32x4 ga[2], gb[2];
        int it = gw;
        if (it < NIT) { TItem da = mk(it); TI_LOAD(da, va, ga);
            for (;;) {
                const int itb = it + NGW; TItem db = da; const bool hb = itb < NIT;
                if (hb) { db = mk(itb); TI_LOAD(db, vb, gb); }
                TI_FIN(da, va, ga);
                if (!hb) break;
                it = itb + NGW; const bool ha = it < NIT;
                if (ha) { da = mk(it); TI_LOAD(da, va, ga); }
                TI_FIN(db, vb, gb);
                if (!ha) break;
            }
        }
    }
#undef TI_LOAD
#undef TI_FIN
}

DI void expert_layout(const Params& P, int lane, int& cnt, int& base, int& tend) {
    const unsigned* c = (const unsigned*)(P.ws + WS_CTL) + CW_CNT;
    cnt = (lane < 32) ? (int)__hip_atomic_load(c + 64 * lane, __ATOMIC_RELAXED, __HIP_MEMORY_SCOPE_AGENT) : 0;
    const int tiles = (cnt + 255) >> 8;
    int inc = 0;
#pragma unroll
    for (int i = 0; i < 32; ++i) { const int ti = __builtin_amdgcn_readlane(tiles, i); inc += (i <= lane) ? ti : 0; }
    tend = inc; base = (inc - tiles) << 8;
}

DI void phase4b(const Params& P, int gw, int NGW, int lane) {
    int cnt, base, tend; expert_layout(P, lane, cnt, base, tend);
    bf16_t* XS = (bf16_t*)(P.ws + WS_XS); float* SLOTW = (float*)(P.ws + WS_SLOTW);
    const int* TOKE = (const int*)(P.ws + WS_TOKE); const float* TOKW = (const float*)(P.ws + WS_TOKW); int* TOKP = (int*)(P.ws + WS_TOKP); const float* RS2 = (const float*)(P.ws + WS_RS2);
    for (int t = gw; t < MTOK; t += NGW) {
        const f32x4* hr = (const f32x4*)(P.out + (size_t)t * 1024);
        const float rs = RS2[t];
        u32x2 w[4];
#pragma unroll
        for (int j = 0; j < 4; ++j) { const f32x4 v = hr[64 * j + lane]; w[j] = (u32x2){pk2(v.x * rs, v.y * rs), pk2(v.z * rs, v.w * rs)}; }
#pragma unroll
        for (int k = 0; k < 2; ++k) {
            const int e = __builtin_amdgcn_readfirstlane(TOKE[2 * t + k]), slot = __builtin_amdgcn_readlane(base, e) + TOKP[2 * t + k];
            u32x2* orow = (u32x2*)(XS + (size_t)slot * 1024);
#pragma unroll
            for (int j = 0; j < 4; ++j) orow[64 * j + lane] = w[j];
            if (lane == 0) { SLOTW[slot] = TOKW[2 * t + k]; TOKP[2 * t + k] = slot; }
        }
    }
    for (int e = 0; e < 32; ++e) {
        const int ce = __builtin_amdgcn_readlane(cnt, e), be = __builtin_amdgcn_readlane(base, e), end = be + (((ce + 255) >> 8) << 8);
        for (int r = be + ce + gw; r < end; r += NGW) { u32x2* orow = (u32x2*)(XS + (size_t)r * 1024);
#pragma unroll
            for (int j = 0; j < 4; ++j) orow[64 * j + lane] = (u32x2){0u, 0u};
            if (lane == 0) SLOTW[r] = 0.f; }
    }
}

#define XCD_ORDER(blk_, G_) ((((G_) & 7) == 0) ? ((blk_) & 7) * ((G_) >> 3) + ((blk_) >> 3) : (blk_))
struct GroupedOrder {
    int tend; int total; int G, c, NS; int cnt, base; const int* LIST;
    DI unsigned rowoff(const pg8::Unit& u, int r) const {
        const int e = __builtin_amdgcn_readfirstlane(u.pn >> NS), ce = __builtin_amdgcn_readlane(cnt, e), t0 = __builtin_amdgcn_readlane(base, e) >> 8;
        const int pos = (u.pm - t0) * 256 + r;
        const int tok = pos < ce ? LIST[e * 16384 + pos] : 0;
        return (unsigned)tok * 2048u;
    }
    DI bool next(int i, pg8::Unit& u) const {
        const int L = i * G + c; if (L >= (total << NS)) return false;
        const int mt = L >> NS, j = L & ((1 << NS) - 1);
        const int e = __builtin_popcountll(__ballot(((int)(threadIdx.x & 63) < 32) && tend <= mt));
        u.pm = mt; u.pn = (e << NS) + j; return true;
    }
    DI void a_ready(const pg8::Unit&) const {}
    DI void done(const pg8::Unit&) const {}
};
struct EpiGateUp {
    static constexpr bool PERM = true, AFTER_DRAIN = false;
    const float* LISTW; const float* LISTRS; bf16_t* YS; int cnt, base;
    DI void operator()(const pg8::f32x4 (&acc)[2][2][4][2], const pg8::Unit& u, int wr, int wc, int fr, int fq) const {
        const int f0 = (u.pn & 1) * 128 + wc * 32 + fq * 8;
        const int e = __builtin_amdgcn_readfirstlane(u.pn >> 1), ce = __builtin_amdgcn_readlane(cnt, e), t0 = __builtin_amdgcn_readlane(base, e) >> 8;
        float cwv[2][4], rsv[2][4];
#pragma unroll
        for (int ai = 0; ai < 2; ++ai)
#pragma unroll
            for (int m = 0; m < 4; ++m) { const int pos = (u.pm - t0) * 256 + ai * 128 + wr * 64 + m * 16 + fr; const bool ok = pos < ce;
                cwv[ai][m] = ok ? LISTW[e * 16384 + pos] : 0.f; rsv[ai][m] = ok ? LISTRS[e * 16384 + pos] : 0.f; }
        __builtin_amdgcn_sched_barrier(0);
#pragma unroll
        for (int ai = 0; ai < 2; ++ai)
#pragma unroll
            for (int m = 0; m < 4; ++m) {
                const int r = ai * 128 + wr * 64 + m * 16 + fr, row = u.pm * 256 + r;
                const float rs = rsv[ai][m], cr = cwv[ai][m] * rs;
                float a[8];
#pragma unroll
                for (int i = 0; i < 4; ++i) {
                    const float g0 = acc[ai][0][m][0][i] * rs, g1 = acc[ai][0][m][1][i] * rs;
                    a[i] = g0 * __builtin_amdgcn_rcpf(1.0f + __expf(-g0)) * acc[ai][1][m][0][i] * cr; a[4 + i] = g1 * __builtin_amdgcn_rcpf(1.0f + __expf(-g1)) * acc[ai][1][m][1][i] * cr;
                }
                *(u32x4*)(YS + (size_t)row * 256 + f0) = (u32x4){pk2(a[0], a[1]), pk2(a[2], a[3]), pk2(a[4], a[5]), pk2(a[6], a[7])};
            }
    }
};
struct EpiDown {
    static constexpr bool PERM = true, AFTER_DRAIN = false;
    bf16_t* YO;
    DI void operator()(const pg8::f32x4 (&acc)[2][2][4][2], const pg8::Unit& u, int wr, int wc, int fr, int fq) const {
        const int c0 = (u.pn & 3) * 256 + wc * 32 + fq * 8;
#pragma unroll
        for (int ai = 0; ai < 2; ++ai)
#pragma unroll
            for (int m = 0; m < 4; ++m) {
                bf16_t* rowp = YO + (size_t)(u.pm * 256 + ai * 128 + wr * 64 + m * 16 + fr) * 1024 + c0;
#pragma unroll
                for (int bj = 0; bj < 2; ++bj) { const pg8::f32x4 v0 = acc[ai][bj][m][0], v1 = acc[ai][bj][m][1];
                    *(u32x4*)(rowp + bj * 128) = (u32x4){pk2(v0[0], v0[1]), pk2(v0[2], v0[3]), pk2(v1[0], v1[1]), pk2(v1[2], v1[3])}; }
            }
    }
};

DI void phase7(const Params& P, int gw, int NGW, int lane) {
    int cnt_, base_, tend_; expert_layout(P, lane, cnt_, base_, tend_);
    const bf16_t* YO = (const bf16_t*)(P.ws + WS_YO); const int* TOKP = (const int*)(P.ws + WS_TOKP); const int* TOKE = (const int*)(P.ws + WS_TOKE); const f32x4* nf = (const f32x4*)P.in[22];
    f32x4 nfv[4];
#pragma unroll
    for (int j = 0; j < 4; ++j) nfv[j] = nf[64 * j + lane];
    for (int t0 = gw; t0 < MTOK; t0 += 2 * NGW) {
        f32x4 v[2][4]; u32x2 hv[2][4], ya[2][4], yb[2][4];
#pragma unroll
        for (int r = 0; r < 2; ++r) { const int t = (t0 + r * NGW) < MTOK ? (t0 + r * NGW) : t0;
            const u32x2* hr = (const u32x2*)((const bf16_t*)(P.ws + WS_U2) + (size_t)t * 1024);
            const int e0 = __builtin_amdgcn_readfirstlane(TOKE[2 * t]), e1 = __builtin_amdgcn_readfirstlane(TOKE[2 * t + 1]);
            const int s0 = __builtin_amdgcn_readlane(base_, e0) + TOKP[2 * t], s1 = __builtin_amdgcn_readlane(base_, e1) + TOKP[2 * t + 1];
            const u32x2* y0 = (const u32x2*)(YO + (size_t)s0 * 1024); const u32x2* y1 = (const u32x2*)(YO + (size_t)s1 * 1024);
#pragma unroll
            for (int j = 0; j < 4; ++j) { hv[r][j] = hr[64 * j + lane]; ya[r][j] = y0[64 * j + lane]; yb[r][j] = y1[64 * j + lane]; } }
#pragma unroll
        for (int r = 0; r < 2; ++r) { const int t = t0 + r * NGW;
            if (t < MTOK) {
                float s = 0.f;
#pragma unroll
                for (int j = 0; j < 4; ++j) { const u32x2 a = ya[r][j], c = yb[r][j], hq = hv[r][j];
                    v[r][j] = (f32x4){__uint_as_float(hq.x << 16), __uint_as_float(hq.x & 0xffff0000u), __uint_as_float(hq.y << 16), __uint_as_float(hq.y & 0xffff0000u)};
                    v[r][j].x += __uint_as_float(a.x << 16) + __uint_as_float(c.x << 16); v[r][j].y += __uint_as_float(a.x & 0xffff0000u) + __uint_as_float(c.x & 0xffff0000u);
                    v[r][j].z += __uint_as_float(a.y << 16) + __uint_as_float(c.y << 16); v[r][j].w += __uint_as_float(a.y & 0xffff0000u) + __uint_as_float(c.y & 0xffff0000u);
                    s += (v[r][j].x * v[r][j].x + v[r][j].y * v[r][j].y) + (v[r][j].z * v[r][j].z + v[r][j].w * v[r][j].w); }
                s = wave_sum(s);
                const float rs = __builtin_amdgcn_rsqf(s * (1.0f / 1024.0f) + EPS);
                f32x4* hw = (f32x4*)(P.out + (size_t)t * 1024);
#pragma unroll
                for (int j = 0; j < 4; ++j) hw[64 * j + lane] = v[r][j] * rs * nfv[j];
            } }
    }
}

struct EpiNull { static constexpr bool PERM = true, AFTER_DRAIN = false; float* d;
    DI void operator()(const pg8::f32x4 (&acc)[2][2][4][2], const pg8::Unit& u, int wr, int wc, int fr, int fq) const {
        pg8::f32x4 s = acc[0][0][0][0];
#pragma unroll
        for (int ai = 0; ai < 2; ++ai)
#pragma unroll
            for (int bj = 0; bj < 2; ++bj)
#pragma unroll
                for (int m = 0; m < 4; ++m)
#pragma unroll
                    for (int n = 0; n < 2; ++n) s += acc[ai][bj][m][n];
        if (s[0] == 12345.678f) d[threadIdx.x] = s[1] + s[2] + s[3]; } };
#ifndef PHMASK
#define PHMASK 2047
#endif
#ifndef P1_STAGGER_TICKS
#define P1_STAGGER_TICKS 0
#endif
#ifndef ATT_VAR
#define ATT_VAR 0
#endif
#ifndef REPMASK
#define REPMASK 0
#endif
#define REP(bit) for (int rep_ = 0; rep_ < ((REPMASK & (bit)) ? 2 : 1); ++rep_)
#define REPSYNC(bit) if ((REPMASK & (bit)) && rep_ == 0) GRID_BAR()
typedef const __attribute__((address_space(4))) Params* KParams;
DI Params load_params(KParams kp) { Params p;
#pragma unroll
    for (int i = 0; i < 23; ++i) p.in[i] = kp->in[i];
    p.out = kp->out; p.ws = kp->ws; return p; }
__global__ void __launch_bounds__(NTHREADS, 2) hymba_fwd(Params Pin) {
    extern __shared__ __attribute__((aligned(16))) unsigned char lds_raw[];
    LAS unsigned char* lds = (LAS unsigned char*)lds_raw;
    cg::grid_group grid = cg::this_grid();
    volatile LAS unsigned* bst = (volatile LAS unsigned*)(lds + LDS_BYTES - 64);
    if (threadIdx.x < 2) bst[threadIdx.x] = 0u;
    __syncthreads();
    const XcdBarrier xbar = xcd_barrier_post((unsigned*)(Pin.ws + WS_CTL) + CW_BAR, bst);
#ifndef TPROBE
#define TPROBE (-1)
#endif
#ifndef TPROBE_A
#define TPROBE_A TPROBE
#define TPROBE_B (TPROBE + 1)
#endif
    int nstamp_ = 0;
#define STAMP() do { if (TPROBE >= 0) { if (blockIdx.x == 0 && threadIdx.x == 0) __hip_atomic_store((unsigned long long*)(Pin.ws + WS_CTL + 65536) + nstamp_, (unsigned long long)__builtin_amdgcn_s_memrealtime(), __ATOMIC_RELAXED, __HIP_MEMORY_SCOPE_AGENT); ++nstamp_; } } while (0)
#define GRID_BAR() do { xcd_barrier(xbar); STAMP(); } while (0)
    STAMP();
    const int G = gridDim.x, blk = blockIdx.x, NGW = G * NWAVES, NGT = G * NTHREADS;
#define PHASE_IDS() KParams kp_ = (KParams)__builtin_amdgcn_kernarg_segment_ptr(); asm volatile("" : "+s"(kp_)); const Params P = load_params(kp_); int tid = threadIdx.x; asm volatile("" : "+v"(tid)); const int lane = tid & 63, wave = __builtin_amdgcn_readfirstlane(tid >> 6), gw = blk * NWAVES + wave, gtid = blk * NTHREADS + tid; (void)lane; (void)gw; (void)gtid; (void)wave

    REP(1) { if (PHMASK & 1) { PHASE_IDS(); phase0(P, lds, gw, NGW, gtid, NGT, wave, lane); } REPSYNC(1); }
    GRID_BAR();
#ifdef P1_EV
#define P1_PASS(DM) { PHASE_IDS(); \
        pg8::Gemm g{(const bf16_t*)(P.ws + WS_XB), (const bf16_t*)(P.ws + WS_WINT), MROWS, NPROJ, 1024}; \
        pg8::StaticOrder S; S.init(MROWS, NPROJ, G, blk); \
        EpiInProjT<P1_EV> E{(const float*)(P.ws + WS_RS1), (const float*)(P.ws + WS_COS), (const float*)(P.ws + WS_SIN), P.in[10], P.in[11], \
                    (bf16_t*)(P.ws + WS_QB), (bf16_t*)(P.ws + WS_KT), (bf16_t*)(P.ws + WS_VT), (bf16_t*)(P.ws + WS_QKVB), (bf16_t*)(P.ws + WS_ZB), (float*)(P.ws + WS_GB), P.ws + 248 * MiB, DM, (unsigned long long*)(P.ws + WS_CTL + 65536) + 40}; \
        pg8::gemm_phase<EpiInProjT<P1_EV>, pg8::StaticOrder, true, true>(lds, g, S, E); } GRID_BAR();
    P1_PASS(0)
    P1_PASS(1)
#else
    REP(2) { if (PHMASK & 2) { PHASE_IDS();
        pg8::Gemm g{(const bf16_t*)(P.ws + WS_XB), (const bf16_t*)(P.ws + WS_WINT), MROWS, NPROJ, 1024};
        if (P1_STAGGER_TICKS > 0 && (blk & 1)) { const unsigned long long s0_ = __builtin_amdgcn_s_memrealtime(); while (__builtin_amdgcn_s_memrealtime() - s0_ < (unsigned long long)P1_STAGGER_TICKS) __builtin_amdgcn_s_sleep(8); }
        pg8::StaticOrder S; S.init(MROWS, NPROJ, G, blk);
#ifdef P1_EV
        EpiInProjT<P1_EV> E{(const float*)(P.ws + WS_RS1), (const float*)(P.ws + WS_COS), (const float*)(P.ws + WS_SIN), P.in[10], P.in[11],
                    (bf16_t*)(P.ws + WS_QB), (bf16_t*)(P.ws + WS_KT), (bf16_t*)(P.ws + WS_VT), (bf16_t*)(P.ws + WS_QKVB), (bf16_t*)(P.ws + WS_ZB), (float*)(P.ws + WS_GB), P.ws + 248 * MiB, rep_, (unsigned long long*)(P.ws + WS_CTL + 65536) + 40};
        pg8::gemm_phase<EpiInProjT<P1_EV>, pg8::StaticOrder, true, true>(lds, g, S, E);
#else
        EpiInProj E{(const float*)(P.ws + WS_RS1), (const float*)(P.ws + WS_COS), (const float*)(P.ws + WS_SIN), P.in[10], P.in[11],
                    (bf16_t*)(P.ws + WS_QB), (bf16_t*)(P.ws + WS_KT), (bf16_t*)(P.ws + WS_VT), (bf16_t*)(P.ws + WS_QKVB), (bf16_t*)(P.ws + WS_ZB), (float*)(P.ws + WS_GB), P.ws + 248 * MiB, 0, (unsigned long long*)(P.ws + WS_CTL + 65536) + 40};
        if (rep_ == 0) pg8::gemm_phase<EpiInProj, pg8::StaticOrder, true, true>(lds, g, S, E);
        else { EpiNull EN{(float*)(P.ws + WS_DUMP)}; pg8::gemm_phase<EpiNull, pg8::StaticOrder, true, true>(lds, g, S, EN); }
#endif
    } REPSYNC(2); }
    GRID_BAR();
#endif
    REP(4) { if (PHMASK & 4) { PHASE_IDS(); gdn_prep_phase(P, lds, blk, G, wave, lane); } REPSYNC(4); }
    {
        unsigned* prep = (unsigned*)(Pin.ws + WS_CTL) + CW_PREP;
        asm volatile("s_waitcnt vmcnt(0)" ::: "memory");
        __syncthreads();
        if (threadIdx.x == 0) { __builtin_amdgcn_fence(__ATOMIC_RELEASE, "agent"); asm volatile("s_waitcnt vmcnt(0)" ::: "memory");
            __hip_atomic_fetch_add(prep, 1u, __ATOMIC_RELAXED, __HIP_MEMORY_SCOPE_AGENT); }
        if (blk < 16) {
            if (threadIdx.x == 0) { unsigned sp = 0;
                while (__hip_atomic_load(prep, __ATOMIC_RELAXED, __HIP_MEMORY_SCOPE_AGENT) < (unsigned)G) { __builtin_amdgcn_s_sleep(2); if (++sp > (1u << 22)) break; }
                __builtin_amdgcn_fence(__ATOMIC_ACQUIRE, "agent"); asm volatile("s_waitcnt vmcnt(0)" ::: "memory"); }
            __syncthreads();
        }
    }
    REP(8) { if ((PHMASK & 8) && blk < 16) { PHASE_IDS(); gdn_scan(P, lds, blk, tid, wave, lane); } }
    REP(16) {
    if (PHMASK & 16) { PHASE_IDS(); if (rep_ == 0) attn_phase<0>(P, lds, tid, wave, lane, 1 << 30); else attn_phase<ATT_VAR>(P, lds, tid, wave, lane, 1 << 30); }
    if ((REPMASK & 16) && rep_ == 0) { GRID_BAR(); if (blk == 0 && threadIdx.x < 8) { PHASE_IDS(); __hip_atomic_store((unsigned*)(P.ws + WS_CTL) + CW_ATTQ + 64 * threadIdx.x, 0u, __ATOMIC_RELAXED, __HIP_MEMORY_SCOPE_AGENT); } GRID_BAR(); }
    }
    GRID_BAR();
    REP(32) { if (PHMASK & 32) { PHASE_IDS();
        pg8::Gemm g{(const bf16_t*)(P.ws + WS_MIX), (const bf16_t*)(P.ws + WS_WOUT), MTOK, 1024, 1024};
        pg8::StaticOrder S; S.init(MTOK, 1024, G, blk);
        EpiOutProj E{P.in[0], P.out, (bf16_t*)(P.ws + WS_U2)};
        pg8::gemm_phase<EpiOutProj, pg8::StaticOrder, true, true>(lds, g, S, E);
    } REPSYNC(32); }
    GRID_BAR();
#ifdef P4A_SPLIT
    if (PHMASK & 64) { PHASE_IDS(); phase4a<1>(P, lds, gw, NGW, wave, lane); }
    GRID_BAR();
    if (PHMASK & 64) { PHASE_IDS(); phase4a<2>(P, lds, gw, NGW, wave, lane); }
#else
    if (PHMASK & 64) { PHASE_IDS(); phase4a<3>(P, lds, gw, NGW, wave, lane); }
#endif
    GRID_BAR();
    int cnt, base, tend, total; { PHASE_IDS(); expert_layout(P, lane, cnt, base, tend); total = __builtin_amdgcn_readlane(tend, 31); }
    REP(256) { if (PHMASK & 256) { PHASE_IDS();
        pg8::Gemm g{(const bf16_t*)(P.ws + WS_U2), (const bf16_t*)(P.ws + WS_WGU), XS_ROWS, 32 * 512, 1024};
        GroupedOrder S{tend, total, G, XCD_ORDER(blk, G), 1, cnt, base, (const int*)(P.ws + WS_LIST)};
        EpiGateUp E{(const float*)(P.ws + WS_LISTW), (const float*)(P.ws + WS_LISTRS), (bf16_t*)(P.ws + WS_YS), cnt, base};
        pg8::gemm_phase_g<EpiGateUp, GroupedOrder, true, true>(lds, g, S, E);
    } REPSYNC(256); }
    GRID_BAR();
    REP(512) { if (PHMASK & 512) { PHASE_IDS();
        int kd = 256; asm volatile("" : "+s"(kd));
        pg8::Gemm g{(const bf16_t*)(P.ws + WS_YS), (const bf16_t*)(P.ws + WS_WD), XS_ROWS, 32 * 1024, kd};
        GroupedOrder S{tend, total, G, XCD_ORDER(blk, G), 2, cnt, base, (const int*)(P.ws + WS_LIST)};
        EpiDown E{(bf16_t*)(P.ws + WS_YO)};
        pg8::gemm_phase<EpiDown, GroupedOrder, true, true>(lds, g, S, E);
    } REPSYNC(512); }
    GRID_BAR();
    if (PHMASK & 1024) { PHASE_IDS(); phase7(P, gw, NGW, lane); }
    if (TPROBE >= 0) {
        GRID_BAR();
        const unsigned long long* st = (const unsigned long long*)(Pin.ws + WS_CTL + 65536);
        const unsigned long long t0 = __hip_atomic_load(st + TPROBE_A, __ATOMIC_RELAXED, __HIP_MEMORY_SCOPE_AGENT), t1 = __hip_atomic_load(st + TPROBE_B, __ATOMIC_RELAXED, __HIP_MEMORY_SCOPE_AGENT);
        const unsigned long long dt = (t1 - t0) * 4ull, s0 = __builtin_amdgcn_s_memrealtime();
        while (__builtin_amdgcn_s_memrealtime() - s0 < dt) __builtin_amdgcn_s_sleep(8);
    }
}

extern "C" void kernel_launch(void* const* d_in, const int* in_sizes, int n_in, void* d_out, int out_size, void* d_ws, size_t ws_size, hipStream_t stream) {
    static int grid_blocks = 0;
    if (grid_blocks == 0) {
        if (n_in != 23 || out_size != MTOK * DMODEL || ws_size < WS_END) { fprintf(stderr, "kernel_launch: unexpected shapes (n_in %d out %d ws %zu)\n", n_in, out_size, ws_size); grid_blocks = -1; return; }
        int dev = 0, cus = 0, per_cu = 0;
        hipGetDevice(&dev);
        hipDeviceGetAttribute(&cus, hipDeviceAttributeMultiprocessorCount, dev);
        hipFuncSetAttribute((const void*)hymba_fwd, hipFuncAttributeMaxDynamicSharedMemorySize, LDS_BYTES);
        hipOccupancyMaxActiveBlocksPerMultiprocessor(&per_cu, (const void*)hymba_fwd, NTHREADS, LDS_BYTES);
        if (per_cu < 1) { fprintf(stderr, "kernel_launch: occupancy query says %d blocks/CU\n", per_cu); per_cu = 1; }
        grid_blocks = cus;
        (void)hipGetLastError();
    }
    if (grid_blocks < 0) return;
    hipMemsetAsync((char*)d_ws + WS_CTL, 0, CTL_BYTES, stream);
    Params p{};
    for (int i = 0; i < 23; ++i) p.in[i] = (const float*)d_in[i];
    p.out = (float*)d_out; p.ws = (unsigned char*)d_ws;
    void* args[] = {&p};
    hipError_t e = hipLaunchCooperativeKernel((const void*)hymba_fwd, dim3(grid_blocks), dim3(NTHREADS), args, LDS_BYTES, stream);
    if (e != hipSuccess) fprintf(stderr, "cooperative launch failed: %s (grid %d)\n", hipGetErrorString(e), grid_blocks);
}
```
